# Optimizing an MI355X kernel written in HIP

```python
import math
import jax, jax.numpy as jnp
from jax import lax
import numpy as np

D_MODEL = 1024
BATCH = 8
SEQ = 8192
DEPTH = 1

MEM_LEN = 256
EPS = 1e-6

ATT_HEAD_DIM = 64
ATT_WIDTH = D_MODEL // 2
ATT_HEADS = ATT_WIDTH // ATT_HEAD_DIM
DILATED_CONFIGS = ((128, 1), (512, 4), (2048, 16))
ATT_BLOCK = 128
ROPE_THETA = 500000.0
ROPE_DIM = ATT_HEAD_DIM // 4

M_WIDTH = D_MODEL - ATT_WIDTH
M_HEADS = 4
M_HEAD_DIM = M_WIDTH // M_HEADS
CONV_WIDTH = 4
M_CHUNK = 128

IN_WIDTH = 3 * ATT_WIDTH + 3 * M_WIDTH + 2 * M_HEADS
MIX_WIDTH = ATT_WIDTH + M_WIDTH

X_HEADS = 4
X_HEAD_DIM = 64
X_WIDTH = X_HEADS * X_HEAD_DIM

N_GROUPS = 4
EXPERTS_PER_GROUP = 4
N_EXPERTS = N_GROUPS * EXPERTS_PER_GROUP
TOP_K = 2
EXPERT_FF = 512
MOE_BLOCK = 128

kernel_name = 'hymba_longnet_mlstm_hmoe_block'


def rms_norm(x, g):
    xf = x.astype(jnp.float32)
    y = xf * lax.rsqrt(jnp.mean(xf * xf, axis=-1, keepdims=True) + EPS)
    return (y * g.astype(jnp.float32)).astype(x.dtype)


def partial_rotary(t, positions):
    half = ROPE_DIM // 2
    inv_freq = ROPE_THETA ** (-jnp.arange(0, ROPE_DIM, 2, dtype=jnp.float32) / ROPE_DIM)
    ang = positions.astype(jnp.float32)[..., None] * inv_freq
    cos = jnp.cos(ang)[:, :, None, :]
    sin = jnp.sin(ang)[:, :, None, :]
    tr = t[..., :ROPE_DIM].astype(jnp.float32)
    t1, t2 = tr[..., :half], tr[..., half:]
    rot = jnp.concatenate([t1 * cos - t2 * sin, t2 * cos + t1 * sin], axis=-1)
    return jnp.concatenate([rot.astype(t.dtype), t[..., ROPE_DIM:]], axis=-1)


def causal_window_attention(q, k, v, window, blk):
    N, L, H, Dh = q.shape
    assert window <= blk
    nb = -(-L // blk)
    Lp = nb * blk
    pad = ((0, 0), (0, Lp - L), (0, 0), (0, 0))
    qb, kb, vb = (jnp.pad(t, pad).reshape(N, nb, blk, H, Dh) for t in (q, k, v))

    def with_prev(t):
        prev = jnp.pad(t, ((0, 0), (1, 0), (0, 0), (0, 0), (0, 0)))[:, :-1]
        return jnp.concatenate([prev, t], axis=2)

    kk, vv = with_prev(kb), with_prev(vb)
    s = jnp.einsum('nbqhd,nbkhd->nbhqk', qb, kk).astype(jnp.float32) * (Dh ** -0.5)
    qi = jnp.arange(blk)[:, None] + blk
    ki = jnp.arange(2 * blk)[None, :]
    dist = qi - ki
    band = (dist >= 0) & (dist <= window)
    valid_key = (jnp.arange(nb)[:, None, None] * blk + ki[None] - blk) >= 0
    mask = band[None] & valid_key
    s = jnp.where(mask[None, :, None, :, :], s, -jnp.inf)
    lse = jax.nn.logsumexp(s, axis=-1)
    p = jnp.exp(s - lse[..., None])
    o = jnp.einsum('nbhqk,nbkhd->nbqhd', p.astype(v.dtype), vv).astype(jnp.float32)
    o = o.reshape(N, Lp, H, Dh)[:, :L]
    lse = lse.transpose(0, 1, 3, 2).reshape(N, Lp, H)[:, :L]
    return o, lse


def dilated_attention(q, k, v):
    B, S, H, Dh = q.shape
    outs, lses = [], []
    for window, d in DILATED_CONFIGS:
        L = S // d

        def to_sub(t):
            return t.reshape(B, L, d, H, Dh).transpose(0, 2, 1, 3, 4).reshape(B * d, L, H, Dh)

        o, lse = causal_window_attention(to_sub(q), to_sub(k), to_sub(v), window // d, ATT_BLOCK)
        outs.append(o.reshape(B, d, L, H, Dh).transpose(0, 2, 1, 3, 4).reshape(B, S, H, Dh))
        lses.append(lse.reshape(B, d, L, H).transpose(0, 2, 1, 3).reshape(B, S, H))
    w = jax.nn.softmax(jnp.stack(lses, axis=0), axis=0)
    return jnp.einsum('cbsh,cbshd->bshd', w, jnp.stack(outs, axis=0))


def mlstm_chunkwise(q, k, v, i_pre, f_pre):
    B, H, S, Dh = q.shape
    L = M_CHUNK
    nc = S // L
    q, k, v = (t.reshape(B, H, nc, L, Dh) for t in (q, k, v))
    ig = i_pre.reshape(B, H, nc, L)
    lf = jax.nn.log_sigmoid(f_pre).reshape(B, H, nc, L)
    b = jnp.cumsum(lf, axis=-1)
    b_last = b[..., -1]

    g = b_last[..., None] - b + ig
    m_loc = jnp.max(g, axis=-1)
    wk = jnp.exp(g - m_loc[..., None])
    C_loc = jnp.einsum('bhcl,bhcld,bhcle->bhcde', wk, k, v)
    n_loc = jnp.einsum('bhcl,bhcld->bhcd', wk, k)

    def step(carry, inp):
        C, n, m = carry
        Cl, nl, ml, bl = inp
        m_new = jnp.maximum(bl + m, ml)
        a = jnp.exp(bl + m - m_new)
        c = jnp.exp(ml - m_new)
        C_new = a[..., None, None] * C + c[..., None, None] * Cl
        n_new = a[..., None] * n + c[..., None] * nl
        return (C_new, n_new, m_new), (C, n, m)

    init = (jnp.zeros((B, H, Dh, Dh), jnp.float32), jnp.zeros((B, H, Dh), jnp.float32),
            jnp.zeros((B, H), jnp.float32))
    xs = (jnp.moveaxis(C_loc, 2, 0), jnp.moveaxis(n_loc, 2, 0),
          jnp.moveaxis(m_loc, 2, 0), jnp.moveaxis(b_last, 2, 0))
    _, (C_prev, n_prev, m_prev) = lax.scan(step, init, xs)
    C_prev = jnp.moveaxis(C_prev, 0, 2)
    n_prev = jnp.moveaxis(n_prev, 0, 2)
    m_prev = jnp.moveaxis(m_prev, 0, 2)

    causal = jnp.tril(jnp.ones((L, L), dtype=bool))
    Dlog = b[..., :, None] - b[..., None, :] + ig[..., None, :]
    Dlog = jnp.where(causal, Dlog, -jnp.inf)
    m_intra = jnp.max(Dlog, axis=-1)
    m_inter = b + m_prev[..., None]
    m_t = jnp.maximum(m_inter, m_intra)
    Dw = jnp.exp(Dlog - m_t[..., None])
    inter_w = jnp.exp(m_inter - m_t)
    s = jnp.einsum('bhcld,bhcsd->bhcls', q, k) * Dw
    num = jnp.einsum('bhcls,bhcse->bhcle', s, v) + \
        inter_w[..., None] * jnp.einsum('bhcld,bhcde->bhcle', q, C_prev)
    den = jnp.sum(s, axis=-1) + inter_w * jnp.einsum('bhcld,bhcd->bhcl', q, n_prev)
    h = num / jnp.maximum(jnp.abs(den), jnp.exp(-m_t))[..., None]
    return h.reshape(B, H, S, Dh)


def hybrid_mixer(h, positions, w_in, conv_w, conv_b, w_q_m, w_k_m, b_i, b_f, g_mhn, skip_m, w_out):
    B, S, _ = h.shape
    sizes = [ATT_WIDTH] * 3 + [M_WIDTH] * 3 + [M_HEADS, M_HEADS]
    splits = [int(c) for c in np.cumsum(sizes)[:-1]]
    z = h @ w_in
    aq, ak, av, mu, mv, mo, mi, mf = jnp.split(z, splits, axis=-1)

    aq = partial_rotary(aq.reshape(B, S, ATT_HEADS, ATT_HEAD_DIM), positions)
    ak = partial_rotary(ak.reshape(B, S, ATT_HEADS, ATT_HEAD_DIM), positions)
    av = av.reshape(B, S, ATT_HEADS, ATT_HEAD_DIM)
    y_att = dilated_attention(aq, ak, av).reshape(B, S, ATT_WIDTH).astype(h.dtype)

    f32 = jnp.float32
    mu_pad = jnp.pad(mu.astype(f32), ((0, 0), (CONV_WIDTH - 1, 0), (0, 0)))
    c = sum(mu_pad[:, j:j + S] * conv_w[j].astype(f32) for j in range(CONV_WIDTH)) + conv_b.astype(f32)
    c = jax.nn.silu(c)
    ch = c.reshape(B, S, M_HEADS, M_HEAD_DIM)
    mq = jnp.einsum('bshd,hde->bhse', ch, w_q_m.astype(f32))
    mk = jnp.einsum('bshd,hde->bhse', ch, w_k_m.astype(f32)) * (M_HEAD_DIM ** -0.5)
    mvh = mv.astype(f32).reshape(B, S, M_HEADS, M_HEAD_DIM).transpose(0, 2, 1, 3)
    ig = (mi.astype(f32) + b_i.astype(f32)).transpose(0, 2, 1)
    fg = (mf.astype(f32) + b_f.astype(f32)).transpose(0, 2, 1)
    hc = mlstm_chunkwise(mq, mk, mvh, ig, fg).transpose(0, 2, 1, 3)
    hn = hc * lax.rsqrt(jnp.mean(hc * hc, axis=-1, keepdims=True) + EPS)
    hn = hn.reshape(B, S, M_WIDTH) * g_mhn.astype(f32)
    y_m = jax.nn.sigmoid(mo.astype(f32)) * (hn + skip_m.astype(f32) * c)

    y = jnp.concatenate([y_att, y_m.astype(h.dtype)], axis=-1)
    return y @ w_out


def memory_cross_attention(h, mem_n, w_q, w_kv, w_o):
    B, S, _ = h.shape
    M = mem_n.shape[1]
    q = (h @ w_q).reshape(B, S, X_HEADS, X_HEAD_DIM)
    kv = (mem_n @ w_kv).reshape(B, M, 2, X_HEADS, X_HEAD_DIM)
    k, v = kv[:, :, 0], kv[:, :, 1]
    s = jnp.einsum('bshd,bmhd->bhsm', q, k).astype(jnp.float32) * (X_HEAD_DIM ** -0.5)
    p = jax.nn.softmax(s, axis=-1).astype(v.dtype)
    o = jnp.einsum('bhsm,bmhd->bshd', p, v).reshape(B, S, X_WIDTH)
    return o @ w_o


def hierarchical_moe(h, w_rg, b_rg, w_re, b_re, w1, w3, w2):
    N, D = h.shape
    f32 = jnp.float32
    glog = (h @ w_rg).astype(f32) + b_rg.astype(f32)
    gprob = jax.nn.softmax(glog, axis=-1)
    g_idx = jnp.argmax(glog, axis=-1)
    g_w = jnp.take_along_axis(gprob, g_idx[:, None], axis=-1)[:, 0]
    elog = ((h @ w_re).astype(f32) + b_re.astype(f32)).reshape(N, N_GROUPS, EXPERTS_PER_GROUP)
    elog = jnp.take_along_axis(elog, g_idx[:, None, None], axis=1)[:, 0]
    top_v, top_i = lax.top_k(elog, TOP_K)
    e_w = jax.nn.softmax(top_v, axis=-1) * g_w[:, None]
    e_id = g_idx[:, None] * EXPERTS_PER_GROUP + top_i

    A = N * TOP_K
    flat_e = e_id.reshape(A)
    flat_tok = jnp.repeat(jnp.arange(N, dtype=jnp.int32), TOP_K)
    flat_w = e_w.reshape(A)
    order = jnp.argsort(flat_e)
    se, stok, sw = flat_e[order], flat_tok[order], flat_w[order]
    counts = jnp.bincount(flat_e, length=N_EXPERTS)
    starts = jnp.cumsum(counts) - counts
    padded = ((counts + MOE_BLOCK - 1) // MOE_BLOCK) * MOE_BLOCK
    pends = jnp.cumsum(padded)
    pstarts = pends - padded
    dest = pstarts[se] + (jnp.arange(A) - starts[se])
    P = (-(-A // MOE_BLOCK) + N_EXPERTS) * MOE_BLOCK
    nblk = P // MOE_BLOCK
    row_tok = jnp.full((P,), N, dtype=jnp.int32).at[dest].set(stok)
    row_w = jnp.zeros((P,), f32).at[dest].set(sw)
    blk_e = jnp.minimum(jnp.searchsorted(pends, jnp.arange(nblk) * MOE_BLOCK, side='right'),
                        N_EXPERTS - 1)
    h_pad = jnp.concatenate([h, jnp.zeros((1, D), h.dtype)], axis=0)
    xb = h_pad[row_tok].reshape(nblk, MOE_BLOCK, D)

    def expert_block(args):
        xblk, e = args
        return (jax.nn.silu(xblk @ w1[e]) * (xblk @ w3[e])) @ w2[e]

    yb = lax.map(expert_block, (xb, blk_e)).reshape(P, D)
    out = jnp.zeros((N + 1, D), f32).at[row_tok].add(yb.astype(f32) * row_w[:, None])
    return out[:N]


def setup_inputs(seed: int = 0) -> dict:
    key = jax.random.key(seed)
    ks = jax.random.split(key, 32)
    f32 = jnp.float32
    L, D = DEPTH, D_MODEL

    def nrm(k, shape, scale):
        return jax.random.normal(k, shape, f32) * scale

    def gain(k, shape):
        return 1.0 + 0.02 * jax.random.normal(k, shape, f32)

    return {
        'x': nrm(ks[0], (BATCH, SEQ, D), 1.0),
        'mem': nrm(ks[1], (BATCH, MEM_LEN, D), 1.0),
        'positions': jnp.tile(jnp.arange(SEQ, dtype=jnp.int32)[None, :], (BATCH, 1)),
        'g_mix': gain(ks[2], (L, D)),
        'w_in': nrm(ks[3], (L, D, IN_WIDTH), D ** -0.5),
        'conv_w': nrm(ks[4], (L, CONV_WIDTH, M_WIDTH), CONV_WIDTH ** -0.5),
        'conv_b': nrm(ks[5], (L, M_WIDTH), 0.02),
        'w_q_m': nrm(ks[6], (L, M_HEADS, M_HEAD_DIM, M_HEAD_DIM), M_HEAD_DIM ** -0.5),
        'w_k_m': nrm(ks[7], (L, M_HEADS, M_HEAD_DIM, M_HEAD_DIM), M_HEAD_DIM ** -0.5),
        'b_i': nrm(ks[8], (L, M_HEADS), 0.1),
        'b_f': 3.0 + 3.0 * jax.random.uniform(ks[9], (L, M_HEADS), f32),
        'g_mhn': gain(ks[10], (L, M_WIDTH)),
        'skip_m': gain(ks[11], (L, M_WIDTH)),
        'w_out': nrm(ks[12], (L, MIX_WIDTH, D), MIX_WIDTH ** -0.5),
        'g_cross': gain(ks[13], (L, D)),
        'g_mem': gain(ks[14], (L, D)),
        'w_q_x': nrm(ks[15], (L, D, X_WIDTH), D ** -0.5),
        'w_kv_x': nrm(ks[16], (L, D, 2 * X_WIDTH), D ** -0.5),
        'w_o_x': nrm(ks[17], (L, X_WIDTH, D), X_WIDTH ** -0.5),
        'g_ffn': gain(ks[18], (L, D)),
        'w_router_g': nrm(ks[19], (L, D, N_GROUPS), D ** -0.5),
        'b_router_g': nrm(ks[20], (L, N_GROUPS), 0.01),
        'w_router_e': nrm(ks[21], (L, D, N_EXPERTS), D ** -0.5),
        'b_router_e': nrm(ks[22], (L, N_EXPERTS), 0.01),
        'w1': nrm(ks[23], (L, N_EXPERTS, D, EXPERT_FF), D ** -0.5),
        'w3': nrm(ks[24], (L, N_EXPERTS, D, EXPERT_FF), D ** -0.5),
        'w2': nrm(ks[25], (L, N_EXPERTS, EXPERT_FF, D), EXPERT_FF ** -0.5),
        'g_final': gain(ks[26], (D,)),
    }


def reference(x, mem, positions, g_mix, w_in, conv_w, conv_b, w_q_m, w_k_m, b_i, b_f, g_mhn,
              skip_m, w_out, g_cross, g_mem, w_q_x, w_kv_x, w_o_x, g_ffn, w_router_g,
              b_router_g, w_router_e, b_router_e, w1, w3, w2, g_final):
    B, S, D = x.shape
    for l in range(DEPTH):
        h = rms_norm(x, g_mix[l])
        x = x + hybrid_mixer(h, positions, w_in[l], conv_w[l], conv_b[l], w_q_m[l], w_k_m[l],
                             b_i[l], b_f[l], g_mhn[l], skip_m[l], w_out[l]).astype(x.dtype)
        h = rms_norm(x, g_cross[l])
        x = x + memory_cross_attention(h, rms_norm(mem, g_mem[l]), w_q_x[l], w_kv_x[l],
                                       w_o_x[l]).astype(x.dtype)
        h = rms_norm(x, g_ffn[l]).reshape(B * S, D)
        x = x + hierarchical_moe(h, w_router_g[l], b_router_g[l], w_router_e[l], b_router_e[l],
                                 w1[l], w3[l], w2[l]).reshape(B, S, D).astype(x.dtype)
    return rms_norm(x, g_final)
```

```cpp
#include <hip/hip_runtime.h>
#include <cstdio>
#include <cstdint>
namespace pg8 {
#define PG8_LAS __attribute__((address_space(3)))
typedef unsigned short bf16_t;
typedef short bf16x8 __attribute__((ext_vector_type(8)));
typedef float f32x4 __attribute__((ext_vector_type(4)));
typedef unsigned u32x4 __attribute__((ext_vector_type(4)));
constexpr int BM = 256, BK = 64, HALF = 128, HTB = HALF * BK * 2  , STAGE_BYTES = 8 * HTB, NXCD = 8, WGM = 8;

__host__ __device__ __forceinline__ int lds_byte(int r, int c) { const int st = (r >> 4) * 2 + (c >> 5), rr = r & 15, cc = c & 31, ob = rr * 64 + cc * 2; return st * 1024 + (ob ^ (((ob >> 9) & 1) << 5)); }
__host__ __device__ __forceinline__ void stage_rc(int b, int& R, int& C) { const int st = b / 1024, sb = b % 1024, swz = sb ^ (((sb >> 9) & 1) << 5); R = (st >> 1) * 16 + swz / 64; C = (st & 1) * 32 + (swz % 64) / 2; }
__host__ __device__ __forceinline__ int perm32(int rho) { const int n = rho >> 4, i = rho & 15; return 8 * (i >> 2) + 4 * n + (i & 3); }

struct Unit { int pm, pn, aux; };
struct Gemm { const bf16_t* A; const bf16_t* Bt; int M, N, K; };

struct StaticOrder {
    int nM, nN, nwg, G, c;
    __host__ __device__ void init(int M, int N, int G_, int c_) { nM = M / BM; nN = N / BM; nwg = nM * nN; G = G_; c = c_; }
    __host__ __device__ bool next(int i, Unit& u) const {
        const long L = (long)i * G + c; if (L >= nwg) return false;
        int wgid = (int)L; { const int q = nwg / NXCD, r = nwg % NXCD, xcd = wgid % NXCD, off = wgid / NXCD; wgid = (xcd < r ? xcd * (q + 1) : r * (q + 1) + (xcd - r) * q) + off; }
        const int nig = WGM * nN, gid = wgid / nig, fm = gid * WGM, gsz = (nM - fm) < WGM ? (nM - fm) : WGM;
        u.pm = fm + ((wgid % nig) % gsz); u.pn = (wgid % nig) / gsz; u.aux = 0; return true;
    }
    __device__ __forceinline__ void a_ready(const Unit&) const {}
    __device__ __forceinline__ void done(const Unit&) const {}
};

__device__ __forceinline__ unsigned cvt_pk_bf16(float lo, float hi) { unsigned r; asm volatile("v_cvt_pk_bf16_f32 %0, %1, %2" : "=v"(r) : "v"(lo), "v"(hi)); return r; }
template <class Epi, class Sched, bool ALIGN_EPI = false, bool SP2 = false>
__device__ __forceinline__ void gemm_phase(PG8_LAS unsigned char* lds, const Gemm g, const Sched& S, const Epi& E) {
    const int tid = threadIdx.x, wid = __builtin_amdgcn_readfirstlane(tid >> 6), lane = tid & 63, wr = wid >> 2, wc = wid & 3, fr = lane & 15, fq = lane >> 4;
    const int K = g.K, nt = K / BK;
    unsigned voffA[2], voffB[2];
#pragma unroll
    for (int i = 0; i < 2; ++i) { int R, C; stage_rc(tid * 16 + i * 8192, R, C); const int Rb = Epi::PERM ? ((R & ~31) + perm32(R & 31)) : R;
        voffA[i] = (unsigned)(R * K + C) * 2u; voffB[i] = (unsigned)(Rb * K + C) * 2u; }
    const size_t kstep = (size_t)(BK * 2);
    const size_t hstep = (size_t)HALF * K * 2;
    const size_t tstep = 2 * hstep;
    const unsigned ldsw = (unsigned)wid * 1024u;
    const int aoff = lds_byte(wr * 64 + fr, fq * 8), boff = lds_byte(wc * 32 + fr, fq * 8);
#define PG8_SA(b, h) (((b) * 2 + (h)) * HTB)
#define PG8_SB(b, h) ((4 + (b) * 2 + (h)) * HTB)
#define PG8_STAGE(bufoff, gbase, voff) do { _Pragma("unroll") for (int _i = 0; _i < 2; ++_i) \
        __builtin_amdgcn_global_load_lds((const unsigned*)((const char*)(gbase) + (voff)[_i]), (PG8_LAS unsigned*)(lds + (bufoff) + ldsw + _i * 8192), 16, 0, 0); } while (0)
#define PG8_LDA(dst, b, h) do { _Pragma("unroll") for (int m = 0; m < 4; ++m) _Pragma("unroll") for (int k = 0; k < 2; ++k) dst[m][k] = *(const PG8_LAS bf16x8*)(lds + PG8_SA(b, h) + aoff + m * 2048 + k * 1024); } while (0)
#define PG8_LDB(dst, b, h) do { _Pragma("unroll") for (int n = 0; n < 2; ++n) _Pragma("unroll") for (int k = 0; k < 2; ++k) dst[n][k] = *(const PG8_LAS bf16x8*)(lds + PG8_SB(b, h) + boff + n * 2048 + k * 1024); } while (0)
#define PG8_MMA(ai, bj, At, Bt) do { __builtin_amdgcn_s_setprio(1); _Pragma("unroll") for (int m = 0; m < 4; ++m) _Pragma("unroll") for (int n = 0; n < 2; ++n) _Pragma("unroll") for (int k = 0; k < 2; ++k) \
        acc[ai][bj][m][n] = __builtin_amdgcn_mfma_f32_16x16x32_bf16(Bt[n][k], At[m][k], acc[ai][bj][m][n], 0, 0, 0); __builtin_amdgcn_s_setprio(0); } while (0)
#define PG8_WAIT_V(n) asm volatile("s_waitcnt vmcnt(" #n ")" ::: "memory")
#define PG8_WAIT_L(n) asm volatile("s_waitcnt lgkmcnt(" #n ")" ::: "memory")
#define PG8_BAR __builtin_amdgcn_s_barrier()
#define PG8_SCHED __builtin_amdgcn_sched_barrier(0)
    Unit cur, nxt; int ui = 0;
    if (!S.next(0, cur)) return;
    f32x4 acc[2][2][4][2];
#pragma unroll
    for (int a = 0; a < 2; ++a)
#pragma unroll
        for (int b = 0; b < 2; ++b)
#pragma unroll
            for (int m = 0; m < 4; ++m)
#pragma unroll
                for (int n = 0; n < 2; ++n) acc[a][b][m][n] = (f32x4){0.f, 0.f, 0.f, 0.f};
    bf16x8 At[4][2], B0[2][2], B1[2][2];
    const char* cA = (const char*)g.A + (size_t)cur.pm * tstep; const char* cB = (const char*)g.Bt + (size_t)cur.pn * tstep;
    S.a_ready(cur);
    if constexpr (SP2) {
        PG8_STAGE(PG8_SB(0, 0), cB, voffB); PG8_STAGE(PG8_SB(0, 1), cB + hstep, voffB); PG8_STAGE(PG8_SA(0, 0), cA, voffA); PG8_STAGE(PG8_SA(0, 1), cA + hstep, voffA);
        if (wr == 1) PG8_BAR;
        PG8_WAIT_V(2); PG8_BAR;
        PG8_STAGE(PG8_SB(1, 0), cB + kstep, voffB); PG8_STAGE(PG8_SA(1, 0), cA + kstep, voffA); PG8_STAGE(PG8_SB(1, 1), cB + hstep + kstep, voffB);
        PG8_WAIT_V(6); PG8_BAR;
    } else {
        PG8_STAGE(PG8_SB(0, 0), cB, voffB); PG8_STAGE(PG8_SA(0, 0), cA, voffA); PG8_STAGE(PG8_SB(0, 1), cB + hstep, voffB); PG8_STAGE(PG8_SA(0, 1), cA + hstep, voffA);
        if (wr == 1) PG8_BAR;
        PG8_WAIT_V(4); PG8_BAR;
        PG8_STAGE(PG8_SB(1, 0), cB + kstep, voffB); PG8_STAGE(PG8_SA(1, 0), cA + kstep, voffA); PG8_STAGE(PG8_SB(1, 1), cB + hstep + kstep, voffB);
        PG8_WAIT_V(6); PG8_BAR;
    }
    for (;;) {
        const bool has_next = S.next(ui + 1, nxt);
        const char* nA = has_next ? (const char*)g.A + (size_t)nxt.pm * tstep : cA; const char* nB = has_next ? (const char*)g.Bt + (size_t)nxt.pn * tstep : cB;
        for (int t = 0; t < nt; t += 2) {
            const bool last = (t == nt - 2);
            const char* a1 = cA + (size_t)(t + 1) * kstep;
            const char* a2 = last ? nA : cA + (size_t)(t + 2) * kstep; const char* b2 = last ? nB : cB + (size_t)(t + 2) * kstep;
            const char* a3 = a2 + kstep; const char* b3 = b2 + kstep;
            if (last && has_next) S.a_ready(nxt);
            if constexpr (SP2) {
            PG8_LDB(B0, 0, 0); PG8_LDB(B1, 0, 1); PG8_SCHED; PG8_LDA(At, 0, 0); PG8_STAGE(PG8_SA(1, 1), a1 + hstep, voffA);
            PG8_WAIT_V(8); PG8_WAIT_L(0); PG8_BAR; PG8_MMA(0, 0, At, B0); PG8_MMA(0, 1, At, B1); PG8_BAR; PG8_SCHED;
            PG8_LDA(At, 0, 1); PG8_STAGE(PG8_SB(0, 0), b2, voffB); PG8_STAGE(PG8_SB(0, 1), b2 + hstep, voffB); PG8_STAGE(PG8_SA(0, 0), a2, voffA);
            PG8_WAIT_V(8); PG8_WAIT_L(0); PG8_BAR; PG8_MMA(1, 0, At, B0); PG8_MMA(1, 1, At, B1); PG8_BAR; PG8_SCHED;
            PG8_LDB(B0, 1, 0); PG8_LDB(B1, 1, 1); PG8_SCHED; PG8_LDA(At, 1, 0); PG8_STAGE(PG8_SA(0, 1), a2 + hstep, voffA);
            PG8_WAIT_V(8); PG8_WAIT_L(0); PG8_BAR; PG8_MMA(0, 0, At, B0); PG8_MMA(0, 1, At, B1); PG8_BAR; PG8_SCHED;
            PG8_LDA(At, 1, 1); PG8_STAGE(PG8_SB(1, 0), b3, voffB); PG8_STAGE(PG8_SB(1, 1), b3 + hstep, voffB); PG8_STAGE(PG8_SA(1, 0), a3, voffA);
            PG8_WAIT_V(8); PG8_WAIT_L(0); PG8_BAR; PG8_MMA(1, 0, At, B0); PG8_MMA(1, 1, At, B1); PG8_BAR; PG8_SCHED;
            } else {
            PG8_LDB(B0, 0, 0); PG8_SCHED; PG8_LDA(At, 0, 0); PG8_STAGE(PG8_SA(1, 1), a1 + hstep, voffA);
            PG8_WAIT_L(8); PG8_BAR; PG8_WAIT_L(0); PG8_MMA(0, 0, At, B0); PG8_BAR; PG8_SCHED;
            PG8_LDB(B1, 0, 1); PG8_STAGE(PG8_SB(0, 0), b2, voffB);
            PG8_BAR; PG8_WAIT_L(0); PG8_MMA(0, 1, At, B1); PG8_BAR;
            PG8_LDA(At, 0, 1); PG8_STAGE(PG8_SA(0, 0), a2, voffA);
            PG8_BAR; PG8_WAIT_L(0); PG8_MMA(1, 0, At, B0); PG8_BAR; PG8_SCHED;
            PG8_STAGE(PG8_SB(0, 1), b2 + hstep, voffB);
            PG8_WAIT_V(6); PG8_BAR; PG8_MMA(1, 1, At, B1); PG8_BAR;
            PG8_LDB(B0, 1, 0); PG8_SCHED; PG8_LDA(At, 1, 0); PG8_STAGE(PG8_SA(0, 1), a2 + hstep, voffA);
            PG8_WAIT_L(8); PG8_BAR; PG8_WAIT_L(0); PG8_MMA(0, 0, At, B0); PG8_BAR; PG8_SCHED;
            PG8_LDB(B1, 1, 1); PG8_STAGE(PG8_SB(1, 0), b3, voffB);
            PG8_BAR; PG8_WAIT_L(0); PG8_MMA(0, 1, At, B1); PG8_BAR;
            PG8_LDA(At, 1, 1); PG8_STAGE(PG8_SA(1, 0), a3, voffA);
            PG8_BAR; PG8_WAIT_L(0); PG8_MMA(1, 0, At, B0); PG8_BAR; PG8_SCHED;
            PG8_STAGE(PG8_SB(1, 1), b3 + hstep, voffB);
            PG8_WAIT_V(6); PG8_BAR; PG8_MMA(1, 1, At, B1); PG8_BAR;
            }
        }
        if constexpr (ALIGN_EPI) { if (wr == 0) PG8_BAR; }
        if constexpr (!Epi::AFTER_DRAIN) { E(acc, cur, wr, wc, fr, fq); S.done(cur); }
        if (!has_next) break;
#pragma unroll
        for (int a = 0; a < 2; ++a)
#pragma unroll
            for (int b = 0; b < 2; ++b)
#pragma unroll
                for (int m = 0; m < 4; ++m)
#pragma unroll
                    for (int n = 0; n < 2; ++n) acc[a][b][m][n] = (f32x4){0.f, 0.f, 0.f, 0.f};
        cur = nxt; cA = nA; cB = nB; ++ui;
        if constexpr (ALIGN_EPI) { if (wr == 1) PG8_BAR; }
    }
    PG8_WAIT_V(0);
    if constexpr (!ALIGN_EPI) { if (wr == 0) PG8_BAR; }
    PG8_BAR;
    if constexpr (Epi::AFTER_DRAIN) { E.fused(acc, cur, wr, wc, fr, fq, lds, wid, lane); S.done(cur); }
#undef PG8_SA
#undef PG8_SB
#undef PG8_STAGE
#undef PG8_LDA
#undef PG8_LDB
#undef PG8_MMA
#undef PG8_WAIT_V
#undef PG8_WAIT_L
#undef PG8_BAR
#undef PG8_SCHED
}
}

#define GAS __attribute__((address_space(1)))
#define LAS __attribute__((address_space(3)))
typedef unsigned short bf16;
typedef unsigned v4u __attribute__((ext_vector_type(4)));
typedef unsigned v2u __attribute__((ext_vector_type(2)));
typedef float f32x4 __attribute__((ext_vector_type(4)));
typedef short bf16x8 __attribute__((ext_vector_type(8)));
typedef GAS unsigned gu32;

constexpr int NWAVES = 8, NTHR = 512;
constexpr int BATCH = 8, SEQ = 8192, T = BATCH * SEQ, D = 1024, MEMLEN = 256, TMEM = BATCH * MEMLEN;
constexpr int INW = 3080, NIN = 3072, NKV = 512;
constexpr int NBUCKET = 24, ROWS_MAX = T + NBUCKET * 256;
constexpr float EPSN = 1e-6f;
constexpr float C2 = 0.125f * 1.4426950408889634f;
constexpr float LOG2E = 1.4426950408889634f;

constexpr size_t MiB = 1u << 20;
constexpr size_t WS_CTL = 0, CTL_ZERO_BYTES = 1 * MiB;
constexpr size_t WS_ROPE = 2 * MiB;
constexpr size_t WS_IG = 6 * MiB;
constexpr size_t WS_FG = 7 * MiB;
constexpr size_t WS_LSE = 8 * MiB;
constexpr size_t WS_SS1 = 14 * MiB;
constexpr size_t WS_SS3 = 18 * MiB;
constexpr size_t WS_KVX = 22 * MiB;
constexpr size_t WS_NLOC = 24 * MiB;
constexpr size_t WS_NPREV = 25 * MiB;
constexpr size_t WS_MLOC = 26 * MiB;
constexpr size_t WS_BLAST = 26 * MiB + 64 * 1024;
constexpr size_t WS_MPREV = 26 * MiB + 128 * 1024;
constexpr size_t WS_TOKINFO = 27 * MiB;
constexpr size_t WS_TOKMAP = 28 * MiB;
constexpr size_t WS_WSORT = 29 * MiB;
constexpr size_t WS_WR = 30 * MiB;
constexpr size_t WS_WG = 30 * MiB + 512 * 1024;
constexpr size_t WS_PAR = 31 * MiB;
constexpr int PAR_CONVW = 0, PAR_CONVB = 2048, PAR_GMHN = 2560, PAR_SKIP = 3072, PAR_BRG = 3584, PAR_BRE = 3600, PAR_GFIN = 3616, PAR_N = 4640;
constexpr size_t WS_WIN = 32 * MiB;
constexpr size_t WS_WOUT = 39 * MiB;
constexpr size_t WS_WQX = 41 * MiB;
constexpr size_t WS_WOX = 41 * MiB + 512 * 1024;
constexpr size_t WS_WM = 42 * MiB;
constexpr size_t WS_W13 = 44 * MiB;
constexpr size_t WS_W2P = 76 * MiB;
constexpr size_t WS_XN = 128 * MiB;
constexpr size_t WS_CLOC = 128 * MiB;
constexpr size_t WS_Q = 264 * MiB;
constexpr size_t WS_K = 328 * MiB, WS_V = 392 * MiB, WS_MU = 456 * MiB, WS_MV = 520 * MiB, WS_MO = 584 * MiB;
constexpr size_t WS_MQ = 648 * MiB, WS_MK = 712 * MiB;
constexpr size_t WS_Y = 264 * MiB;
constexpr size_t WS_CPREV = 392 * MiB;
constexpr size_t WS_X1B = 648 * MiB;
constexpr size_t WS_QX = 776 * MiB;
constexpr size_t WS_OX = 808 * MiB;
constexpr size_t WS_HBS = 264 * MiB;
constexpr size_t WS_ACT = 404 * MiB;
constexpr size_t WS_END = 840 * MiB;
constexpr size_t DO_OATT = 0, DO_C = 192 * MiB;

constexpr int CW_BAR = 4096;
constexpr int CW_CNT = 8192;
constexpr int CW_FILL = 8192 + 64;

constexpr int LDS_BYTES = 163840;
constexpr int LDS_MISC = 159744;
constexpr int LDS_RS = 135168;
constexpr int LDS_TAB = 136192;

#define LDS_WAIT() asm volatile("s_waitcnt lgkmcnt(0)" ::: "memory")
#define VM_WAIT() asm volatile("s_waitcnt vmcnt(0)" ::: "memory")
__device__ __forceinline__ unsigned f2bf(float f) { unsigned u = __builtin_bit_cast(unsigned, f); return (u + 0x7fffu + ((u >> 16) & 1u)) >> 16; }
__device__ __forceinline__ unsigned pk2(float lo, float hi) { return f2bf(lo) | (f2bf(hi) << 16); }
__device__ __forceinline__ float bf2f(unsigned h) { return __uint_as_float(h << 16); }
__device__ __forceinline__ float bflo(unsigned w) { return __uint_as_float(w << 16); }
__device__ __forceinline__ float bfhi(unsigned w) { return __uint_as_float(w & 0xffff0000u); }
__device__ __forceinline__ float wave_sum(float v) {
#pragma unroll
    for (int o = 1; o < 64; o <<= 1) v += __shfl_xor(v, o);
    return v;
}
__device__ __forceinline__ float wave_max(float v) {
#pragma unroll
    for (int o = 1; o < 64; o <<= 1) v = fmaxf(v, __shfl_xor(v, o));
    return v;
}
__device__ __forceinline__ float sigmoidf_(float x) { return 1.0f / (1.0f + __expf(-x)); }

#define XB_TMO      128
#define XB_XCNT(j)  (256  + 64 * (j))
#define XB_XSUB(j)  (1280 + 64 * (j))
#define XB_XGEN(j)  (2304 + 64 * (j))
#define XB_TOP      3328
#define XB_TOPGEN   3392
#define XCD_BAR_WORDS 3456
#define XB_SPIN_CAP (1u << 22)
__device__ __forceinline__ unsigned xb_ld(unsigned* p)              { return __hip_atomic_load(p, __ATOMIC_RELAXED, __HIP_MEMORY_SCOPE_AGENT); }
__device__ __forceinline__ unsigned xb_add(unsigned* p, unsigned v) { return __hip_atomic_fetch_add(p, v, __ATOMIC_RELAXED, __HIP_MEMORY_SCOPE_AGENT); }
__device__ __forceinline__ unsigned xb_xcc_id() { return (unsigned)__builtin_amdgcn_s_getreg((3 << 11) | 20) & 0xFu; }
#define XB_SPIN(cond, bar) do { unsigned _sp = 0; while (cond) { __builtin_amdgcn_s_sleep(1); \
    if ((++_sp & 255u) == 0u) { if (xb_ld(&(bar)[XB_TMO])) break; if (_sp > XB_SPIN_CAP) { atomicAdd(&(bar)[XB_TMO], 1u); break; } } } } while (0)
struct XcdBarrier { unsigned* bar; unsigned x; volatile LAS unsigned* st; };
__device__ __forceinline__ XcdBarrier xcd_barrier_post(unsigned* bar, volatile LAS unsigned* st) {
    XcdBarrier b; b.bar = bar; b.x = xb_xcc_id(); b.st = st;
    if (threadIdx.x == 0) (void)xb_add(&bar[XB_XCNT(b.x)], 1u);
    return b;
}
__device__ __forceinline__ void xcd_barrier_complete(unsigned* bar, unsigned x, unsigned& nloc, unsigned& nx) {
    const unsigned G = gridDim.x * gridDim.y * gridDim.z;
    unsigned sum, cnt, mine, sp = 0u;
    for (;;) {
        sum = 0u; cnt = 0u; mine = 0u;
#pragma unroll
        for (unsigned j = 0; j < 16; ++j) { const unsigned c = xb_ld(&bar[XB_XCNT(j)]); sum += c; cnt += (c > 0u) ? 1u : 0u; mine = (j == x) ? c : mine; }
        if (sum == G) break;
        __builtin_amdgcn_s_sleep(1);
        if ((++sp & 255u) == 0u) { if (xb_ld(&bar[XB_TMO])) break; if (sp > XB_SPIN_CAP) { atomicAdd(&bar[XB_TMO], 1u); break; } }
    }
    nloc = mine > 0u ? mine : 1u; nx = cnt > 0u ? cnt : 1u;
}
__device__ __forceinline__ void xcd_barrier(const XcdBarrier& b) {
    asm volatile("s_waitcnt vmcnt(0)" ::: "memory");
    __syncthreads();
    if (threadIdx.x == 0) {
        unsigned* bar = b.bar;
        __builtin_amdgcn_s_waitcnt(0);
        unsigned nloc = b.st[0], nx = b.st[1];
        if (nloc == 0u) { xcd_barrier_complete(bar, b.x, nloc, nx); b.st[0] = nloc; b.st[1] = nx; }
        const unsigned old = xb_add(&bar[XB_XSUB(b.x)], 1u);
        const unsigned gen = old / nloc;
        if (old + 1u == (gen + 1u) * nloc) {
            __builtin_amdgcn_fence(__ATOMIC_RELEASE, "agent");
            asm volatile("s_waitcnt vmcnt(0)" ::: "memory");
            const unsigned og = xb_add(&bar[XB_TOP], 1u);
            const unsigned tg = og / nx;
            if (og + 1u == (tg + 1u) * nx) xb_add(&bar[XB_TOPGEN], 1u);
            else XB_SPIN(xb_ld(&bar[XB_TOPGEN]) == tg, bar);
            __builtin_amdgcn_fence(__ATOMIC_ACQUIRE, "agent");
            xb_add(&bar[XB_XGEN(b.x)], 1u);
            asm volatile("s_waitcnt vmcnt(0)" ::: "memory");
        } else {
            XB_SPIN(xb_ld(&bar[XB_XGEN(b.x)]) == gen, bar);
            __builtin_amdgcn_fence(__ATOMIC_ACQUIRE, "agent");
            asm volatile("s_waitcnt vmcnt(0)" ::: "memory");
        }
    }
    __syncthreads();
}

struct Args { const void* in[28]; float* out; unsigned char* ws; int ph_lo, ph_hi; };

template <int MI, int NJ>
__device__ __forceinline__ void wave_mma(const bf16* A, int lda, const bf16* Bt, int ldb, int K, f32x4 (&acc)[MI][NJ], int fr, int fq) {
    for (int k0 = 0; k0 < K; k0 += 32) {
        bf16x8 a[MI], b[NJ];
#pragma unroll
        for (int i = 0; i < MI; ++i) a[i] = *(const bf16x8*)(A + (16 * i + fr) * lda + k0 + 8 * fq);
#pragma unroll
        for (int j = 0; j < NJ; ++j) b[j] = *(const bf16x8*)(Bt + (16 * j + fr) * ldb + k0 + 8 * fq);
#pragma unroll
        for (int i = 0; i < MI; ++i)
#pragma unroll
            for (int j = 0; j < NJ; ++j) acc[i][j] = __builtin_amdgcn_mfma_f32_16x16x32_bf16(b[j], a[i], acc[i][j], 0, 0, 0);
    }
}

__device__ __forceinline__ void transpose_item(const float* src, int src_ld, int k0, int n0, bf16* dst, int dst_ld, int dst_row0, int dst_col0,
                                               const float* gain, float scale, float* scr, int lane) {
#pragma unroll 8
    for (int i = 0; i < 32; ++i) { const int kk = 2 * i + (lane >> 5);
        const float gsc = gain ? gain[k0 + kk] * scale : scale;
        scr[kk * 33 + (lane & 31)] = src[(size_t)(k0 + kk) * src_ld + n0 + (lane & 31)] * gsc; }
    LDS_WAIT(); asm volatile("" ::: "memory");
    const int c = lane & 7;
#pragma unroll
    for (int j = 0; j < 4; ++j) { const int n = (lane >> 3) + 8 * j; const float* s = scr + (8 * c) * 33 + n;
        v4u o; o.x = pk2(s[0 * 33], s[1 * 33]); o.y = pk2(s[2 * 33], s[3 * 33]); o.z = pk2(s[4 * 33], s[5 * 33]); o.w = pk2(s[6 * 33], s[7 * 33]);
        *(v4u*)(dst + (size_t)(dst_row0 + n) * dst_ld + dst_col0 + 8 * c) = o; }
    LDS_WAIT(); asm volatile("" ::: "memory");
}

__device__ __forceinline__ void p0_prologue(const Args& A, unsigned char* lds, int tid, int lane, int wave) {
    unsigned char* ws = A.ws;
    const float* x = (const float*)A.in[0]; const float* mem = (const float*)A.in[1]; const int* positions = (const int*)A.in[2];
    const float* g_mix = (const float*)A.in[3]; const float* w_in = (const float*)A.in[4];
    const float* w_q_m = (const float*)A.in[7]; const float* w_k_m = (const float*)A.in[8];
    const float* b_i = (const float*)A.in[9]; const float* b_f = (const float*)A.in[10];
    const float* w_out = (const float*)A.in[13]; const float* g_cross = (const float*)A.in[14]; const float* g_mem = (const float*)A.in[15];
    const float* w_q_x = (const float*)A.in[16]; const float* w_kv_x = (const float*)A.in[17]; const float* w_o_x = (const float*)A.in[18];
    const float* g_ffn = (const float*)A.in[19]; const float* w_rg = (const float*)A.in[20]; const float* w_re = (const float*)A.in[22];
    const float* w1 = (const float*)A.in[24]; const float* w3 = (const float*)A.in[25]; const float* w2 = (const float*)A.in[26];
    const int G = gridDim.x, gw = blockIdx.x * NWAVES + wave, NGW = G * NWAVES, gt = blockIdx.x * NTHR + tid, NGT = G * NTHR;

    float* WGl = (float*)(lds + 131072 - 32768 - 0) ;
    for (int i = tid; i < 8 * 1024; i += NTHR) { const int k = i >> 3, j = i & 7; WGl[j * 1024 + k] = g_mix[k] * w_in[(size_t)k * INW + NIN + j]; }

    float* scr = (float*)(lds + wave * 8704);
    constexpr int I_IN = 16 * 96, I_KV = 16 * 16, I_OUT = 16 * 32, I_QX = 16 * 8, I_OX = 4 * 32, I_M = 64, I_13 = 16 * 2 * 256, I_2P = 24 * 2 * 256;
    constexpr int NITEMS = I_IN + I_KV + I_OUT + I_QX + I_OX + I_M + I_13 + I_2P;
    for (int it = gw; it < NITEMS; it += NGW) {
        int r = it;
        if (r < I_IN) { const int kb = r / 96, nb = r % 96; transpose_item(w_in, INW, 64 * kb, 32 * nb, (bf16*)(ws + WS_WIN), 1024, 32 * nb, 64 * kb, g_mix, (32 * nb < 512) ? C2 : 1.0f, scr, lane); continue; } r -= I_IN;
        if (r < I_KV) { const int kb = r / 16, nb = r % 16; transpose_item(w_kv_x, 512, 64 * kb, 32 * nb, (bf16*)(ws + WS_WIN), 1024, NIN + 32 * nb, 64 * kb, g_mem, 1.0f, scr, lane); continue; } r -= I_KV;
        if (r < I_OUT) { const int kb = r / 32, nb = r % 32; transpose_item(w_out, 1024, 64 * kb, 32 * nb, (bf16*)(ws + WS_WOUT), 1024, 32 * nb, 64 * kb, nullptr, 1.0f, scr, lane); continue; } r -= I_OUT;
        if (r < I_QX) { const int kb = r / 8, nb = r % 8; transpose_item(w_q_x, 256, 64 * kb, 32 * nb, (bf16*)(ws + WS_WQX), 1024, 32 * nb, 64 * kb, g_cross, C2, scr, lane); continue; } r -= I_QX;
        if (r < I_OX) { const int kb = r / 32, nb = r % 32; transpose_item(w_o_x, 1024, 64 * kb, 32 * nb, (bf16*)(ws + WS_WOX), 256, 32 * nb, 64 * kb, nullptr, 1.0f, scr, lane); continue; } r -= I_OX;
        if (r < I_M) { const int which = r / 32, h = (r % 32) / 8, kb = (r % 8) / 4, nb = r % 4;
            transpose_item((which ? w_k_m : w_q_m) + (size_t)h * 128 * 128, 128, 64 * kb, 32 * nb, (bf16*)(ws + WS_WM) + (size_t)(which * 4 + h) * 128 * 128, 128, 32 * nb, 64 * kb, nullptr,
                           which ? 0.08838834764831845f : 1.0f, scr, lane); continue; } r -= I_M;
        if (r < I_13) { const int e = r / 512, which = (r % 512) / 256, kb = (r % 256) / 16, nb = r % 16; const int n0 = 32 * nb;
            transpose_item((which ? w3 : w1) + (size_t)e * 1024 * 512, 512, 64 * kb, n0, (bf16*)(ws + WS_W13) + (size_t)e * 1024 * 1024, 1024, (n0 / 128) * 256 + which * 128 + (n0 % 128), 64 * kb, g_ffn, 1.0f, scr, lane); continue; } r -= I_13;
        { const int bk = r / 512, hf = (r % 512) / 256, kb = (r % 256) / 32, nb = r % 32; const int g = bk / 6, p = bk % 6;
          const int pa = (p < 3) ? 0 : (p < 5 ? 1 : 2), pb = (p < 3) ? p + 1 : (p < 5 ? p - 1 : 3); const int e = 4 * g + (hf ? pb : pa);
          transpose_item(w2 + (size_t)e * 512 * 1024, 1024, 64 * kb, 32 * nb, (bf16*)(ws + WS_W2P) + (size_t)bk * 1024 * 1024, 1024, 32 * nb, hf * 512 + 64 * kb, nullptr, 1.0f, scr, lane); }
    }
    for (int i = gt; i < PAR_N; i += NGT) { float v;
        if (i < PAR_CONVB) v = ((const float*)A.in[5])[i]; else if (i < PAR_GMHN) v = ((const float*)A.in[6])[i - PAR_CONVB]; else if (i < PAR_SKIP) v = ((const float*)A.in[11])[i - PAR_GMHN];
        else if (i < PAR_BRG) v = ((const float*)A.in[12])[i - PAR_SKIP]; else if (i < PAR_BRE) v = ((const float*)A.in[21])[i - PAR_BRG]; else if (i < PAR_GFIN) v = ((const float*)A.in[23])[i - PAR_BRE];
        else v = ((const float*)A.in[27])[i - PAR_GFIN];
        ((float*)(ws + WS_PAR))[i] = v; }
    for (int i = gt; i < 20 * 1024; i += NGT) { const int e = i >> 10, k = i & 1023;
        ((float*)(ws + WS_WR))[i] = g_ffn[k] * (e < 4 ? w_rg[k * 4 + e] : w_re[k * 16 + (e - 4)]); }
    for (int i = gt; i < T * 8; i += NGT) { const int t = i >> 3, j = i & 7; const float invf = powf(500000.0f, -(float)j * 0.125f);
        const float ang = (float)positions[t] * invf; float sn, cs; sincosf(ang, &sn, &cs);
        ((float*)(ws + WS_ROPE))[t * 16 + j] = cs; ((float*)(ws + WS_ROPE))[t * 16 + 8 + j] = sn; }
    __syncthreads();
    for (int m = gw; m < T + TMEM; m += NGW) {
        const bool ismem = m >= T;
        const f32x4* xr = (const f32x4*)(ismem ? mem + (size_t)(m - T) * D : x + (size_t)m * D) + lane;
        f32x4 v[4]; float s = 0.f;
#pragma unroll
        for (int j = 0; j < 4; ++j) { v[j] = xr[64 * j]; s += (v[j].x * v[j].x + v[j].y * v[j].y) + (v[j].z * v[j].z + v[j].w * v[j].w); }
        const float rstd = 1.0f / sqrtf(wave_sum(s) * (1.0f / D) + EPSN);
        unsigned long long* o8 = (unsigned long long*)(ws + WS_XN + (size_t)m * D * 2) + lane;
#pragma unroll
        for (int j = 0; j < 4; ++j) o8[64 * j] = (unsigned long long)pk2(v[j].x * rstd, v[j].y * rstd) | ((unsigned long long)pk2(v[j].z * rstd, v[j].w * rstd) << 32);
        if (!ismem) {
            float gd[8];
#pragma unroll
            for (int g = 0; g < 8; ++g) { float a = 0.f;
#pragma unroll
                for (int j = 0; j < 4; ++j) { const f32x4 w = *(const f32x4*)(WGl + g * 1024 + 256 * j + 4 * lane); a += (v[j].x * w.x + v[j].y * w.y) + (v[j].z * w.z + v[j].w * w.w); }
                gd[g] = wave_sum(a) * rstd; }
            if (lane < 8) { float val = 0.f;
#pragma unroll
                for (int g = 0; g < 8; ++g) val = (lane == g) ? gd[g] : val;
                const int b = m / SEQ, sq = m % SEQ, h = lane & 3;
                if (lane < 4) ((float*)(ws + WS_IG))[(size_t)(b * 4 + h) * SEQ + sq] = val + b_i[h];
                else ((float*)(ws + WS_FG))[(size_t)(b * 4 + h) * SEQ + sq] = val + b_f[h]; }
        }
    }
}

struct InProjOrder {
    pg8::StaticOrder so;
    __device__ __forceinline__ bool next(int i, pg8::Unit& u) const {
        if (so.next(i, u)) return true;
        const long L = (long)i * so.G + so.c - so.nwg;
        if (L >= 0 && L < 16) { u.pm = 256 + (int)(L >> 1); u.pn = 12 + (int)(L & 1); u.aux = 1; return true; }
        return false;
    }
    __device__ __forceinline__ void a_ready(const pg8::Unit&) const {}
    __device__ __forceinline__ void done(const pg8::Unit&) const {}
};
__device__ __forceinline__ v4u pack8(const f32x4& a, const f32x4& b) { v4u w; w.x = pk2(a[0], a[1]); w.y = pk2(a[2], a[3]); w.z = pk2(b[0], b[1]); w.w = pk2(b[2], b[3]); return w; }
struct EpiInProj {
    static constexpr bool PERM = true, AFTER_DRAIN = false;
    bf16* base; bf16* kvx; const float* rope;
    __device__ __forceinline__ void operator()(const f32x4 (&acc)[2][2][4][2], const pg8::Unit& u, int wr, int wc, int fr, int fq) const {
        if (u.aux) {
            const int row0 = (u.pm - 256) * 256 + wr * 64 + fr, col0 = (u.pn - 12) * 256 + wc * 32 + 8 * fq;
#pragma unroll
            for (int ai = 0; ai < 2; ++ai)
#pragma unroll
                for (int m = 0; m < 4; ++m) { bf16* rowp = kvx + (size_t)(row0 + ai * 128 + m * 16) * NKV + col0;
#pragma unroll
                    for (int bj = 0; bj < 2; ++bj) *(v4u*)(rowp + bj * 128) = pack8(acc[ai][bj][m][0], acc[ai][bj][m][1]); }
            return;
        }
        const int buf = u.pn >> 1; bf16* B = base + (size_t)buf * T * 512;
        const int row0 = u.pm * 256 + wr * 64 + fr, col0 = (u.pn & 1) * 256 + wc * 32 + 8 * fq;
        const bool dorope = (buf < 2) && ((wc & 1) == 0);
#pragma unroll
        for (int ai = 0; ai < 2; ++ai)
#pragma unroll
            for (int m = 0; m < 4; ++m) { const int row = row0 + ai * 128 + m * 16; bf16* rowp = B + (size_t)row * 512 + col0;
                f32x4 cs0, cs1, sn0, sn1;
                if (dorope) { const f32x4* rp = (const f32x4*)(rope + (size_t)row * 16); cs0 = rp[0]; cs1 = rp[1]; sn0 = rp[2]; sn1 = rp[3]; }
#pragma unroll
                for (int bj = 0; bj < 2; ++bj) { f32x4 v0 = acc[ai][bj][m][0], v1 = acc[ai][bj][m][1];
                    if (dorope) { f32x4 o0, o1;
#pragma unroll
                        for (int i = 0; i < 4; ++i) { o0[i] = __shfl_xor(v0[i], 16); o1[i] = __shfl_xor(v1[i], 16); }
                        if (fq == 0) { v0 = v0 * cs0 - o0 * sn0; v1 = v1 * cs1 - o1 * sn1; }
                        else if (fq == 1) { v0 = v0 * cs0 + o0 * sn0; v1 = v1 * cs1 + o1 * sn1; } }
                    *(v4u*)(rowp + bj * 128) = pack8(v0, v1); } }
    }
};

constexpr int AT_QLD = 72, AT_KLD = 72, AT_VLD = 280, AT_PLD = 168;
constexpr int AT_Q = 0, AT_K = AT_Q + 128 * AT_QLD * 2, AT_V = AT_K + 272 * AT_KLD * 2, AT_P = AT_V + 64 * AT_VLD * 2, AT_END = AT_P + 8 * 16 * AT_PLD * 2;
static_assert(AT_END <= LDS_MISC, "attention LDS");
__device__ __forceinline__ void attn_item(const Args& A, unsigned char* lds, int item, int tid, int lane, int wave) {
    unsigned char* ws = A.ws;
    const int cfg = item >> 12; int rem = item & 4095; const int b = rem >> 9; rem &= 511; const int h = rem >> 6; const int sub = rem & 63;
    const int d = (cfg == 0) ? 1 : (cfg == 1 ? 4 : 16), nblk = 64 / d, r = sub / nblk, nb = sub % nblk;
    const bf16* Qg = (const bf16*)(ws + WS_Q) + h * 64; const bf16* Kg = (const bf16*)(ws + WS_K) + h * 64; const bf16* Vg = (const bf16*)(ws + WS_V) + h * 64;
    bf16* Qs = (bf16*)(lds + AT_Q); bf16* Ks = (bf16*)(lds + AT_K); bf16* Vt = (bf16*)(lds + AT_V); bf16* Ps = (bf16*)(lds + AT_P) + wave * 16 * AT_PLD;
    const size_t tokb = (size_t)b * SEQ + r;
    for (int id = tid; id < 128 * 8; id += NTHR) { const int row = id >> 3, ch = id & 7;
        *(v4u*)(Qs + row * AT_QLD + ch * 8) = *(const v4u*)(Qg + (tokb + (size_t)(128 * nb + row) * d) * 512 + ch * 8); }
    for (int id = tid; id < 272 * 8; id += NTHR) { const int kk = id >> 3, ch = id & 7; const int u = 128 * (nb - 1) + kk;
        v4u kv = (v4u){0u, 0u, 0u, 0u}, vv = (v4u){0u, 0u, 0u, 0u};
        if (kk < 256 && u >= 0) { const size_t off = (tokb + (size_t)u * d) * 512 + ch * 8; kv = *(const v4u*)(Kg + off); vv = *(const v4u*)(Vg + off); }
        *(v4u*)(Ks + kk * AT_KLD + ch * 8) = kv;
        bf16* vp = Vt + (ch * 8) * AT_VLD + kk;
        vp[0 * AT_VLD] = (bf16)(vv.x & 0xffffu); vp[1 * AT_VLD] = (bf16)(vv.x >> 16); vp[2 * AT_VLD] = (bf16)(vv.y & 0xffffu); vp[3 * AT_VLD] = (bf16)(vv.y >> 16);
        vp[4 * AT_VLD] = (bf16)(vv.z & 0xffffu); vp[5 * AT_VLD] = (bf16)(vv.z >> 16); vp[6 * AT_VLD] = (bf16)(vv.w & 0xffffu); vp[7 * AT_VLD] = (bf16)(vv.w >> 16); }
    __syncthreads();
    const int fr = lane & 15, fq = lane >> 4;
    f32x4 s[1][10];
#pragma unroll
    for (int j = 0; j < 10; ++j) s[0][j] = (f32x4){0.f, 0.f, 0.f, 0.f};
    wave_mma<1, 10>(Qs + 16 * wave * AT_QLD, AT_QLD, Ks + 16 * wave * AT_KLD, AT_KLD, 64, s, fr, fq);
    const int qi = 16 * wave + fr;
    float mx = -1e30f;
#pragma unroll
    for (int j = 0; j < 10; ++j)
#pragma unroll
        for (int e = 0; e < 4; ++e) { const int kk = 16 * wave + 16 * j + 4 * fq + e;
            const bool ok = (kk >= qi) && (kk <= qi + 128) && (nb > 0 || kk >= 128);
            s[0][j][e] = ok ? s[0][j][e] : -1e30f; mx = fmaxf(mx, s[0][j][e]); }
    mx = fmaxf(mx, __shfl_xor(mx, 16)); mx = fmaxf(mx, __shfl_xor(mx, 32));
    float l = 0.f;
#pragma unroll
    for (int j = 0; j < 10; ++j) { f32x4 p;
#pragma unroll
        for (int e = 0; e < 4; ++e) { p[e] = exp2f(s[0][j][e] - mx); l += p[e]; }
        *(v2u*)(Ps + fr * AT_PLD + 16 * j + 4 * fq) = (v2u){pk2(p[0], p[1]), pk2(p[2], p[3])}; }
    l += __shfl_xor(l, 16); l += __shfl_xor(l, 32);
    __syncthreads();
    f32x4 o[1][4];
#pragma unroll
    for (int j = 0; j < 4; ++j) o[0][j] = (f32x4){0.f, 0.f, 0.f, 0.f};
    wave_mma<1, 4>(Ps, AT_PLD, Vt + 16 * wave, AT_VLD, 160, o, fr, fq);
    const float rl = 1.0f / l;
    const size_t tok = tokb + (size_t)(128 * nb + qi) * d;
    bf16* og = (bf16*)((unsigned char*)A.out + DO_OATT) + ((size_t)cfg * T + tok) * 512 + h * 64;
#pragma unroll
    for (int j = 0; j < 4; ++j) *(v2u*)(og + 16 * j + 4 * fq) = (v2u){pk2(o[0][j][0] * rl, o[0][j][1] * rl), pk2(o[0][j][2] * rl, o[0][j][3] * rl)};
    if (fq == 0) ((float*)(ws + WS_LSE))[((size_t)cfg * T + tok) * 8 + h] = mx + log2f(l);
    __syncthreads();
}

constexpr int ML_LD = 136;
constexpr int ML_A = 0, ML_W = ML_A + 128 * ML_LD * 2, ML_KT = ML_W + 128 * ML_LD * 2, ML_VT = ML_KT + 128 * ML_LD * 2, ML_G = ML_VT + 128 * ML_LD * 2, ML_END = ML_G + 4096;
static_assert(ML_END <= LDS_MISC, "mlstm LDS");
__device__ __forceinline__ float log_sigmoidf_(float x) { return (x > 0.f) ? -log1pf(__expf(-x)) : (x - log1pf(__expf(x))); }

__device__ __forceinline__ float scan128_sum(const float* in, float* out, int lane) {
    const float v0 = in[2 * lane], v1 = in[2 * lane + 1]; float x = v0 + v1;
#pragma unroll
    for (int off = 1; off < 64; off <<= 1) { const float t = __shfl_up(x, off); if (lane >= off) x += t; }
    out[2 * lane] = x - v1; out[2 * lane + 1] = x;
    return __shfl(x, 63);
}
__device__ __forceinline__ void scan128_max(const float* in, float* out, int lane) {
    const float v0 = in[2 * lane], v1 = in[2 * lane + 1]; float x = fmaxf(v0, v1);
    float pre = -INFINITY;
    float y = x;
#pragma unroll
    for (int off = 1; off < 64; off <<= 1) { const float t = __shfl_up(y, off); if (lane >= off) y = fmaxf(y, t); }
    pre = __shfl_up(y, 1); if (lane == 0) pre = -INFINITY;
    out[2 * lane] = fmaxf(pre, v0); out[2 * lane + 1] = fmaxf(pre, x);
}

__device__ __forceinline__ void mlstm1_item(const Args& A, unsigned char* lds, int item, int tid, int lane, int wave) {
    unsigned char* ws = A.ws;
    const float* conv_w = (const float*)(ws + WS_PAR) + PAR_CONVW; const float* conv_b = (const float*)(ws + WS_PAR) + PAR_CONVB;
    const int bh = item >> 6, c = item & 63, b = bh >> 2, h = bh & 3;
    const size_t t0 = (size_t)b * SEQ + 128 * c;
    bf16* cA = (bf16*)(lds + ML_A); bf16* Wl = (bf16*)(lds + ML_W); bf16* kT = (bf16*)(lds + ML_KT); bf16* vT = (bf16*)(lds + ML_VT);
    float* gl = (float*)(lds + ML_G);
    const bf16* MU = (const bf16*)(ws + WS_MU) + h * 128; const bf16* MV = (const bf16*)(ws + WS_MV) + h * 128;
    bf16* Cg = (bf16*)((unsigned char*)A.out + DO_C) + h * 128;
    if (tid < 128) { const size_t gi = (size_t)bh * SEQ + 128 * c + tid; gl[128 + tid] = ((const float*)(ws + WS_IG))[gi]; gl[tid] = log_sigmoidf_(((const float*)(ws + WS_FG))[gi]); }
    for (int id = tid; id < 128 * 16; id += NTHR) { const int l = id >> 4, ch = (id & 15) * 8;
        float a[8];
        { const f32x4 b0 = *(const f32x4*)(conv_b + h * 128 + ch), b1 = *(const f32x4*)(conv_b + h * 128 + ch + 4);
          a[0] = b0[0]; a[1] = b0[1]; a[2] = b0[2]; a[3] = b0[3]; a[4] = b1[0]; a[5] = b1[1]; a[6] = b1[2]; a[7] = b1[3]; }
#pragma unroll
        for (int j = 0; j < 4; ++j) { const int sp = 128 * c + l + j - 3;
            if (sp >= 0) { const v4u m = *(const v4u*)(MU + ((size_t)b * SEQ + sp) * 512 + ch);
                const f32x4 w0 = *(const f32x4*)(conv_w + j * 512 + h * 128 + ch), w1 = *(const f32x4*)(conv_w + j * 512 + h * 128 + ch + 4);
                a[0] += bflo(m.x) * w0[0]; a[1] += bfhi(m.x) * w0[1]; a[2] += bflo(m.y) * w0[2]; a[3] += bfhi(m.y) * w0[3];
                a[4] += bflo(m.z) * w1[0]; a[5] += bfhi(m.z) * w1[1]; a[6] += bflo(m.w) * w1[2]; a[7] += bfhi(m.w) * w1[3]; } }
#pragma unroll
        for (int i = 0; i < 8; ++i) a[i] = a[i] * sigmoidf_(a[i]);
        const v4u o = (v4u){pk2(a[0], a[1]), pk2(a[2], a[3]), pk2(a[4], a[5]), pk2(a[6], a[7])};
        *(v4u*)(cA + l * ML_LD + ch) = o; *(v4u*)(Cg + (t0 + l) * 512 + ch) = o; }
    const bf16* Wq = (const bf16*)(ws + WS_WM) + (size_t)h * 128 * 128; const bf16* Wk = Wq + 4 * 128 * 128;
    for (int id = tid; id < 128 * 16; id += NTHR) { const int row = id >> 4, ch = (id & 15) * 8;
        *(v4u*)(Wl + row * ML_LD + ch) = *(const v4u*)(Wq + row * 128 + ch);
        const v4u vv = *(const v4u*)(MV + (t0 + row) * 512 + ch); bf16* vp = vT + ch * ML_LD + row;
        vp[0 * ML_LD] = (bf16)(vv.x & 0xffffu); vp[1 * ML_LD] = (bf16)(vv.x >> 16); vp[2 * ML_LD] = (bf16)(vv.y & 0xffffu); vp[3 * ML_LD] = (bf16)(vv.y >> 16);
        vp[4 * ML_LD] = (bf16)(vv.z & 0xffffu); vp[5 * ML_LD] = (bf16)(vv.z >> 16); vp[6 * ML_LD] = (bf16)(vv.w & 0xffffu); vp[7 * ML_LD] = (bf16)(vv.w >> 16); }
    __syncthreads();
    if (wave == 0) {
        const float blast = scan128_sum(gl, gl, lane);
        const float g0 = blast - gl[2 * lane] + gl[128 + 2 * lane], g1 = blast - gl[2 * lane + 1] + gl[128 + 2 * lane + 1];
        const float mloc = wave_max(fmaxf(g0, g1));
        gl[256 + 2 * lane] = __expf(g0 - mloc); gl[256 + 2 * lane + 1] = __expf(g1 - mloc);
        if (lane == 0) { ((float*)(ws + WS_MLOC))[item] = mloc; ((float*)(ws + WS_BLAST))[item] = blast; }
    }
    __syncthreads();
    const int fr = lane & 15, fq = lane >> 4, l = 16 * wave + fr;
    { f32x4 acc[1][8];
#pragma unroll
      for (int j = 0; j < 8; ++j) acc[0][j] = (f32x4){0.f, 0.f, 0.f, 0.f};
      wave_mma<1, 8>(cA + 16 * wave * ML_LD, ML_LD, Wl, ML_LD, 128, acc, fr, fq);
      bf16* qg = (bf16*)(ws + WS_MQ) + (t0 + l) * 512 + h * 128;
#pragma unroll
      for (int j = 0; j < 8; ++j) *(v2u*)(qg + 16 * j + 4 * fq) = (v2u){pk2(acc[0][j][0], acc[0][j][1]), pk2(acc[0][j][2], acc[0][j][3])}; }
    __syncthreads();
    for (int id = tid; id < 128 * 16; id += NTHR) { const int row = id >> 4, ch = (id & 15) * 8; *(v4u*)(Wl + row * ML_LD + ch) = *(const v4u*)(Wk + row * 128 + ch); }
    __syncthreads();
    { f32x4 acc[1][8];
#pragma unroll
      for (int j = 0; j < 8; ++j) acc[0][j] = (f32x4){0.f, 0.f, 0.f, 0.f};
      wave_mma<1, 8>(cA + 16 * wave * ML_LD, ML_LD, Wl, ML_LD, 128, acc, fr, fq);
      bf16* kg = (bf16*)(ws + WS_MK) + (t0 + l) * 512 + h * 128; const float wk = gl[256 + l];
#pragma unroll
      for (int j = 0; j < 8; ++j) { *(v2u*)(kg + 16 * j + 4 * fq) = (v2u){pk2(acc[0][j][0], acc[0][j][1]), pk2(acc[0][j][2], acc[0][j][3])};
#pragma unroll
          for (int e = 0; e < 4; ++e) kT[(16 * j + 4 * fq + e) * ML_LD + l] = (bf16)f2bf(acc[0][j][e] * wk); } }
    __syncthreads();
    { f32x4 acc[1][8];
#pragma unroll
      for (int j = 0; j < 8; ++j) acc[0][j] = (f32x4){0.f, 0.f, 0.f, 0.f};
      wave_mma<1, 8>(vT + 16 * wave * ML_LD, ML_LD, kT, ML_LD, 128, acc, fr, fq);
      float* cg = (float*)(ws + WS_CLOC) + ((size_t)item * 128 + l) * 128;
#pragma unroll
      for (int j = 0; j < 8; ++j) *(f32x4*)(cg + 16 * j + 4 * fq) = acc[0][j]; }
    if (tid < 128) { float s = 0.f; const bf16* kr = kT + tid * ML_LD;
        for (int i = 0; i < 128; i += 8) { const v4u w = *(const v4u*)(kr + i); s += (bflo(w.x) + bfhi(w.x)) + (bflo(w.y) + bfhi(w.y)) + (bflo(w.z) + bfhi(w.z)) + (bflo(w.w) + bfhi(w.w)); }
        ((float*)(ws + WS_NLOC))[(size_t)item * 128 + tid] = s; }
    __syncthreads();
}

__device__ __forceinline__ void p3_scan_combine(const Args& A, int tid) {
    unsigned char* ws = A.ws;
    const int G = gridDim.x, NGT = G * NTHR;
    for (int gid = blockIdx.x * NTHR + tid; gid < 32 * 4096; gid += NGT) {
        const int bh = gid >> 12, rem = gid & 4095, e = rem >> 5, dq = rem & 31;
        const float* MLOC = (const float*)(ws + WS_MLOC) + bh * 64; const float* BL = (const float*)(ws + WS_BLAST) + bh * 64;
        f32x4 C = (f32x4){0.f, 0.f, 0.f, 0.f}, n = (f32x4){0.f, 0.f, 0.f, 0.f}; float m = 0.f;
        for (int c = 0; c < 64; ++c) {
            const size_t idx = (size_t)bh * 64 + c;
            const f32x4 Cl = *(const f32x4*)((const float*)(ws + WS_CLOC) + (idx * 128 + e) * 128 + 4 * dq);
            *(v2u*)((bf16*)(ws + WS_CPREV) + (idx * 128 + e) * 128 + 4 * dq) = (v2u){pk2(C[0], C[1]), pk2(C[2], C[3])};
            const float ml = MLOC[c], bl = BL[c];
            const float mnew = fmaxf(bl + m, ml), a = __expf(bl + m - mnew), cc = __expf(ml - mnew);
            if (e == 0) { *(f32x4*)((float*)(ws + WS_NPREV) + idx * 128 + 4 * dq) = n;
                const f32x4 nl = *(const f32x4*)((const float*)(ws + WS_NLOC) + idx * 128 + 4 * dq); n = n * a + nl * cc;
                if (dq == 0) ((float*)(ws + WS_MPREV))[idx] = m; }
            C = C * a + Cl * cc; m = mnew;
        }
    }
    const bf16* OA = (const bf16*)((const unsigned char*)A.out + DO_OATT); const float* LSE = (const float*)(ws + WS_LSE);
    for (size_t id = (size_t)blockIdx.x * NTHR + tid; id < (size_t)T * 64; id += NGT) {
        const size_t t = id >> 6; const int h = (int)(id & 63) >> 3, ch = (int)(id & 7) * 8;
        const float l0 = LSE[t * 8 + h], l1 = LSE[((size_t)T + t) * 8 + h], l2 = LSE[((size_t)2 * T + t) * 8 + h];
        const float mx = fmaxf(l0, fmaxf(l1, l2)); float w0 = exp2f(l0 - mx), w1 = exp2f(l1 - mx), w2 = exp2f(l2 - mx);
        const float rs = 1.0f / (w0 + w1 + w2); w0 *= rs; w1 *= rs; w2 *= rs;
        const v4u a = *(const v4u*)(OA + t * 512 + h * 64 + ch), b = *(const v4u*)(OA + ((size_t)T + t) * 512 + h * 64 + ch), c = *(const v4u*)(OA + ((size_t)2 * T + t) * 512 + h * 64 + ch);
        v4u o;
        o.x = pk2(w0 * bflo(a.x) + w1 * bflo(b.x) + w2 * bflo(c.x), w0 * bfhi(a.x) + w1 * bfhi(b.x) + w2 * bfhi(c.x));
        o.y = pk2(w0 * bflo(a.y) + w1 * bflo(b.y) + w2 * bflo(c.y), w0 * bfhi(a.y) + w1 * bfhi(b.y) + w2 * bfhi(c.y));
        o.z = pk2(w0 * bflo(a.z) + w1 * bflo(b.z) + w2 * bflo(c.z), w0 * bfhi(a.z) + w1 * bfhi(b.z) + w2 * bfhi(c.z));
        o.w = pk2(w0 * bflo(a.w) + w1 * bflo(b.w) + w2 * bflo(c.w), w0 * bfhi(a.w) + w1 * bfhi(b.w) + w2 * bfhi(c.w));
        *(v4u*)((bf16*)(ws + WS_Y) + t * 1024 + h * 64 + ch) = o;
    }
}

__device__ __forceinline__ void mlstm2_item(const Args& A, unsigned char* lds, int item, int tid, int lane, int wave) {
    unsigned char* ws = A.ws;
    const float* g_mhn = (const float*)(ws + WS_PAR) + PAR_GMHN; const float* skip_m = (const float*)(ws + WS_PAR) + PAR_SKIP;
    const int bh = item >> 6, c = item & 63, b = bh >> 2, h = bh & 3;
    const size_t t0 = (size_t)b * SEQ + 128 * c;
    bf16* qA = (bf16*)(lds + ML_A); bf16* kA = (bf16*)(lds + ML_W); bf16* vT = (bf16*)(lds + ML_KT); bf16* CpT = (bf16*)(lds + ML_VT);
    float* gl = (float*)(lds + ML_G);
    const bf16* MQ = (const bf16*)(ws + WS_MQ) + h * 128; const bf16* MK = (const bf16*)(ws + WS_MK) + h * 128; const bf16* MV = (const bf16*)(ws + WS_MV) + h * 128;
    const bf16* CP = (const bf16*)(ws + WS_CPREV) + (size_t)item * 128 * 128;
    if (tid < 128) { const size_t gi = (size_t)bh * SEQ + 128 * c + tid; gl[896 + tid] = ((const float*)(ws + WS_IG))[gi]; gl[tid] = log_sigmoidf_(((const float*)(ws + WS_FG))[gi]);
        gl[640 + tid] = ((const float*)(ws + WS_NPREV))[(size_t)item * 128 + tid]; }
    for (int id = tid; id < 128 * 16; id += NTHR) { const int row = id >> 4, ch = (id & 15) * 8;
        *(v4u*)(qA + row * ML_LD + ch) = *(const v4u*)(MQ + (t0 + row) * 512 + ch);
        *(v4u*)(kA + row * ML_LD + ch) = *(const v4u*)(MK + (t0 + row) * 512 + ch);
        *(v4u*)(CpT + row * ML_LD + ch) = *(const v4u*)(CP + row * 128 + ch);
        const v4u vv = *(const v4u*)(MV + (t0 + row) * 512 + ch); bf16* vp = vT + ch * ML_LD + row;
        vp[0 * ML_LD] = (bf16)(vv.x & 0xffffu); vp[1 * ML_LD] = (bf16)(vv.x >> 16); vp[2 * ML_LD] = (bf16)(vv.y & 0xffffu); vp[3 * ML_LD] = (bf16)(vv.y >> 16);
        vp[4 * ML_LD] = (bf16)(vv.z & 0xffffu); vp[5 * ML_LD] = (bf16)(vv.z >> 16); vp[6 * ML_LD] = (bf16)(vv.w & 0xffffu); vp[7 * ML_LD] = (bf16)(vv.w >> 16); }
    __syncthreads();
    if (wave == 0) {
        const float mprev = ((const float*)(ws + WS_MPREV))[item];
        (void)scan128_sum(gl, gl, lane);
        gl[128 + 2 * lane] = gl[896 + 2 * lane] - gl[2 * lane]; gl[128 + 2 * lane + 1] = gl[896 + 2 * lane + 1] - gl[2 * lane + 1];
        scan128_max(gl + 128, gl + 896, lane);
#pragma unroll
        for (int q = 0; q < 2; ++q) { const int i = 2 * lane + q; const float bb = gl[i];
            const float mintra = bb + gl[896 + i], minter = bb + mprev, mt = fmaxf(minter, mintra);
            gl[256 + i] = bb - mt; gl[384 + i] = __expf(minter - mt); gl[512 + i] = __expf(-mt); }
    } else if (wave >= 4) {
        const int row = tid - 256;
        if (row < 128) { float s = 0.f; const bf16* qr = qA + row * ML_LD;
            for (int i = 0; i < 128; i += 8) { const v4u w = *(const v4u*)(qr + i); const float* np = gl + 640 + i;
                s += bflo(w.x) * np[0] + bfhi(w.x) * np[1] + bflo(w.y) * np[2] + bfhi(w.y) * np[3] + bflo(w.z) * np[4] + bfhi(w.z) * np[5] + bflo(w.w) * np[6] + bfhi(w.w) * np[7]; }
            gl[768 + row] = s; }
    }
    __syncthreads();
    const int fr = lane & 15, fq = lane >> 4, l = 16 * wave + fr;
    float den;
    v2u sp[8];
    { f32x4 acc[1][8];
#pragma unroll
      for (int j = 0; j < 8; ++j) acc[0][j] = (f32x4){0.f, 0.f, 0.f, 0.f};
      wave_mma<1, 8>(qA + 16 * wave * ML_LD, ML_LD, kA, ML_LD, 128, acc, fr, fq);
      const float rc = gl[256 + l]; float ds = 0.f;
#pragma unroll
      for (int j = 0; j < 8; ++j) { float p[4];
#pragma unroll
          for (int e = 0; e < 4; ++e) { const int s = 16 * j + 4 * fq + e; p[e] = (s <= l) ? acc[0][j][e] * __expf(rc + gl[128 + s]) : 0.f; ds += p[e]; }
          sp[j] = (v2u){pk2(p[0], p[1]), pk2(p[2], p[3])}; }
      ds += __shfl_xor(ds, 16); ds += __shfl_xor(ds, 32); den = ds; }
    __syncthreads();
#pragma unroll
    for (int j = 0; j < 8; ++j) *(v2u*)(kA + l * ML_LD + 16 * j + 4 * fq) = sp[j];
    __syncthreads();
    f32x4 acc[1][8];
#pragma unroll
    for (int j = 0; j < 8; ++j) acc[0][j] = (f32x4){0.f, 0.f, 0.f, 0.f};
    wave_mma<1, 8>(qA + 16 * wave * ML_LD, ML_LD, CpT, ML_LD, 128, acc, fr, fq);
    const float iw = gl[384 + l];
#pragma unroll
    for (int j = 0; j < 8; ++j) acc[0][j] = acc[0][j] * iw;
    wave_mma<1, 8>(kA + 16 * wave * ML_LD, ML_LD, vT, ML_LD, 128, acc, fr, fq);
    den += iw * gl[768 + l];
    const float rden = 1.0f / fmaxf(fabsf(den), gl[512 + l]);
    float sq = 0.f;
#pragma unroll
    for (int j = 0; j < 8; ++j) { acc[0][j] = acc[0][j] * rden; sq += (acc[0][j][0] * acc[0][j][0] + acc[0][j][1] * acc[0][j][1]) + (acc[0][j][2] * acc[0][j][2] + acc[0][j][3] * acc[0][j][3]); }
    sq += __shfl_xor(sq, 16); sq += __shfl_xor(sq, 32);
    const float rn = 1.0f / sqrtf(sq * (1.0f / 128.0f) + EPSN);
    const bf16* MOg = (const bf16*)(ws + WS_MO) + (t0 + l) * 512 + h * 128; const bf16* Cg = (const bf16*)((const unsigned char*)A.out + DO_C) + (t0 + l) * 512 + h * 128;
    bf16* yg = (bf16*)(ws + WS_Y) + (t0 + l) * 1024 + 512 + h * 128;
#pragma unroll
    for (int j = 0; j < 8; ++j) { const int e0 = 16 * j + 4 * fq;
        const v2u mo = *(const v2u*)(MOg + e0), cc = *(const v2u*)(Cg + e0);
        const f32x4 gm = *(const f32x4*)(g_mhn + h * 128 + e0), sk = *(const f32x4*)(skip_m + h * 128 + e0);
        const float y0 = sigmoidf_(bflo(mo.x)) * (acc[0][j][0] * rn * gm[0] + sk[0] * bflo(cc.x));
        const float y1 = sigmoidf_(bfhi(mo.x)) * (acc[0][j][1] * rn * gm[1] + sk[1] * bfhi(cc.x));
        const float y2 = sigmoidf_(bflo(mo.y)) * (acc[0][j][2] * rn * gm[2] + sk[2] * bflo(cc.y));
        const float y3 = sigmoidf_(bfhi(mo.y)) * (acc[0][j][3] * rn * gm[3] + sk[3] * bfhi(cc.y));
        *(v2u*)(yg + e0) = (v2u){pk2(y0, y1), pk2(y2, y3)}; }
    __syncthreads();
}

struct EpiOutProj {
    static constexpr bool PERM = false, AFTER_DRAIN = false;
    const float* x; float* x1; bf16* x1b; float* ss;
    __device__ __forceinline__ void operator()(const f32x4 (&acc)[2][2][4][2], const pg8::Unit& u, int wr, int wc, int fr, int fq) const {
        const int row0 = u.pm * 256 + wr * 64 + fr, col0 = u.pn * 256 + wc * 32 + 4 * fq;
#pragma unroll
        for (int ai = 0; ai < 2; ++ai)
#pragma unroll
            for (int m = 0; m < 4; ++m) { const int row = row0 + ai * 128 + m * 16; float sq = 0.f;
#pragma unroll
                for (int bj = 0; bj < 2; ++bj)
#pragma unroll
                    for (int n = 0; n < 2; ++n) { const size_t off = (size_t)row * D + col0 + bj * 128 + n * 16;
                        const f32x4 o = *(const f32x4*)(x + off) + acc[ai][bj][m][n];
                        *(f32x4*)(x1 + off) = o; *(v2u*)(x1b + off) = (v2u){pk2(o[0], o[1]), pk2(o[2], o[3])};
                        sq += (o[0] * o[0] + o[1] * o[1]) + (o[2] * o[2] + o[3] * o[3]); }
                sq += __shfl_xor(sq, 16); sq += __shfl_xor(sq, 32);
                if (fq == 0) ss[(size_t)row * 16 + u.pn * 4 + wc] = sq; }
    }
};
struct EpiQx {
    static constexpr bool PERM = true, AFTER_DRAIN = false;
    bf16* qx; const LAS float* rs;
    __device__ __forceinline__ void operator()(const f32x4 (&acc)[2][2][4][2], const pg8::Unit& u, int wr, int wc, int fr, int fq) const {
        const int rl0 = wr * 64 + fr, col0 = wc * 32 + 8 * fq;
#pragma unroll
        for (int ai = 0; ai < 2; ++ai)
#pragma unroll
            for (int m = 0; m < 4; ++m) { const int rl = rl0 + ai * 128 + m * 16; const float sc = rs[rl]; bf16* rowp = qx + (size_t)(u.pm * 256 + rl) * 256 + col0;
#pragma unroll
                for (int bj = 0; bj < 2; ++bj) *(v4u*)(rowp + bj * 128) = pack8(acc[ai][bj][m][0] * sc, acc[ai][bj][m][1] * sc);
                asm volatile("" ::: "memory"); }
    }
};
struct EpiOx {
    static constexpr bool PERM = false, AFTER_DRAIN = false;
    float* x1;
    __device__ __forceinline__ void operator()(const f32x4 (&acc)[2][2][4][2], const pg8::Unit& u, int wr, int wc, int fr, int fq) const {
        const int row0 = u.pm * 256 + wr * 64 + fr, col0 = u.pn * 256 + wc * 32 + 4 * fq;
#pragma unroll
        for (int ai = 0; ai < 2; ++ai)
#pragma unroll
            for (int m = 0; m < 4; ++m)
#pragma unroll
                for (int bj = 0; bj < 2; ++bj)
#pragma unroll
                    for (int n = 0; n < 2; ++n) { float* p = x1 + (size_t)(row0 + ai * 128 + m * 16) * D + col0 + bj * 128 + n * 16; *(f32x4*)p = *(const f32x4*)p + acc[ai][bj][m][n]; if (bj == 1 && n == 1) asm volatile("" ::: "memory"); }
    }
};
constexpr int CX_QLD = 72, CX_KLD = 72, CX_VLD = 264, CX_PLD = 264;
constexpr int CX_Q = 0, CX_K = CX_Q + 128 * CX_QLD * 2, CX_V = CX_K + 256 * CX_KLD * 2, CX_P = CX_V + 64 * CX_VLD * 2, CX_END = CX_P + 8 * 16 * CX_PLD * 2;
static_assert(CX_END <= LDS_MISC, "cross LDS");
__device__ __forceinline__ void cross_item(const Args& A, unsigned char* lds, int item, int tid, int lane, int wave) {
    unsigned char* ws = A.ws;
    const int rt = item >> 2, h = item & 3; const size_t t0 = (size_t)rt * 128; const int b = (int)(t0 / SEQ);
    bf16* Qs = (bf16*)(lds + CX_Q); bf16* Ks = (bf16*)(lds + CX_K); bf16* Vt = (bf16*)(lds + CX_V); bf16* Ps = (bf16*)(lds + CX_P) + wave * 16 * CX_PLD;
    const bf16* QX = (const bf16*)(ws + WS_QX) + h * 64; const bf16* KV = (const bf16*)(ws + WS_KVX) + (size_t)b * MEMLEN * NKV + h * 64;
    for (int id = tid; id < 128 * 8; id += NTHR) { const int row = id >> 3, ch = id & 7; *(v4u*)(Qs + row * CX_QLD + ch * 8) = *(const v4u*)(QX + (t0 + row) * 256 + ch * 8); }
    for (int id = tid; id < 256 * 8; id += NTHR) { const int kk = id >> 3, ch = id & 7;
        *(v4u*)(Ks + kk * CX_KLD + ch * 8) = *(const v4u*)(KV + (size_t)kk * NKV + ch * 8);
        const v4u vv = *(const v4u*)(KV + (size_t)kk * NKV + 256 + ch * 8); bf16* vp = Vt + (ch * 8) * CX_VLD + kk;
        vp[0 * CX_VLD] = (bf16)(vv.x & 0xffffu); vp[1 * CX_VLD] = (bf16)(vv.x >> 16); vp[2 * CX_VLD] = (bf16)(vv.y & 0xffffu); vp[3 * CX_VLD] = (bf16)(vv.y >> 16);
        vp[4 * CX_VLD] = (bf16)(vv.z & 0xffffu); vp[5 * CX_VLD] = (bf16)(vv.z >> 16); vp[6 * CX_VLD] = (bf16)(vv.w & 0xffffu); vp[7 * CX_VLD] = (bf16)(vv.w >> 16); }
    __syncthreads();
    const int fr = lane & 15, fq = lane >> 4;
    f32x4 s[1][16];
#pragma unroll
    for (int j = 0; j < 16; ++j) s[0][j] = (f32x4){0.f, 0.f, 0.f, 0.f};
    wave_mma<1, 16>(Qs + 16 * wave * CX_QLD, CX_QLD, Ks, CX_KLD, 64, s, fr, fq);
    float mx = -1e30f;
#pragma unroll
    for (int j = 0; j < 16; ++j)
#pragma unroll
        for (int e = 0; e < 4; ++e) mx = fmaxf(mx, s[0][j][e]);
    mx = fmaxf(mx, __shfl_xor(mx, 16)); mx = fmaxf(mx, __shfl_xor(mx, 32));
    float l = 0.f;
#pragma unroll
    for (int j = 0; j < 16; ++j) { f32x4 p;
#pragma unroll
        for (int e = 0; e < 4; ++e) { p[e] = exp2f(s[0][j][e] - mx); l += p[e]; }
        *(v2u*)(Ps + fr * CX_PLD + 16 * j + 4 * fq) = (v2u){pk2(p[0], p[1]), pk2(p[2], p[3])}; }
    l += __shfl_xor(l, 16); l += __shfl_xor(l, 32);
    __syncthreads();
    f32x4 o[1][4];
#pragma unroll
    for (int j = 0; j < 4; ++j) o[0][j] = (f32x4){0.f, 0.f, 0.f, 0.f};
    wave_mma<1, 4>(Ps, CX_PLD, Vt, CX_VLD, 256, o, fr, fq);
    const float rl = 1.0f / l;
    bf16* og = (bf16*)(ws + WS_OX) + (t0 + 16 * wave + fr) * 256 + h * 64;
#pragma unroll
    for (int j = 0; j < 4; ++j) *(v2u*)(og + 16 * j + 4 * fq) = (v2u){pk2(o[0][j][0] * rl, o[0][j][1] * rl), pk2(o[0][j][2] * rl, o[0][j][3] * rl)};
    __syncthreads();
}

struct TokInfo { int bucket; float wa, wb, rstd; };
__device__ __forceinline__ void p7a_route(const Args& A, unsigned char* lds, int tid, int lane, int wave) {
    unsigned char* ws = A.ws;
    const float* b_rg = (const float*)(ws + WS_PAR) + PAR_BRG; const float* b_re = (const float*)(ws + WS_PAR) + PAR_BRE;
    float* WRl = (float*)lds;
    for (int i = tid; i < 20 * 1024 / 4; i += NTHR) ((f32x4*)WRl)[i] = ((const f32x4*)(ws + WS_WR))[i];
    __syncthreads();
    const int G = gridDim.x, gw = blockIdx.x * NWAVES + wave, NGW = G * NWAVES;
    for (int m = gw; m < T; m += NGW) {
        const f32x4* xr = (const f32x4*)(A.out + (size_t)m * D) + lane;
        f32x4 v[4]; float s = 0.f;
#pragma unroll
        for (int j = 0; j < 4; ++j) { v[j] = xr[64 * j]; s += (v[j].x * v[j].x + v[j].y * v[j].y) + (v[j].z * v[j].z + v[j].w * v[j].w); }
        const float rstd = 1.0f / sqrtf(wave_sum(s) * (1.0f / D) + EPSN);
        float gl4[4];
#pragma unroll
        for (int e = 0; e < 4; ++e) { float a = 0.f;
#pragma unroll
            for (int j = 0; j < 4; ++j) { const f32x4 w = *(const f32x4*)(WRl + e * 1024 + 256 * j + 4 * lane); a += (v[j].x * w.x + v[j].y * w.y) + (v[j].z * w.z + v[j].w * w.w); }
            gl4[e] = wave_sum(a) * rstd + b_rg[e]; }
        int g = 0; float gm = gl4[0];
#pragma unroll
        for (int i = 1; i < 4; ++i) if (gl4[i] > gm) { gm = gl4[i]; g = i; }
        g = __builtin_amdgcn_readfirstlane(g);
        float gs = 0.f;
#pragma unroll
        for (int i = 0; i < 4; ++i) gs += __expf(gl4[i] - gm);
        const float gw_ = 1.0f / gs;
        float el[4];
        const float* WRe = WRl + (4 + 4 * g) * 1024;
#pragma unroll
        for (int e = 0; e < 4; ++e) { float a = 0.f;
#pragma unroll
            for (int j = 0; j < 4; ++j) { const f32x4 w = *(const f32x4*)(WRe + e * 1024 + 256 * j + 4 * lane); a += (v[j].x * w.x + v[j].y * w.y) + (v[j].z * w.z + v[j].w * w.w); }
            el[e] = wave_sum(a) * rstd + b_re[g * 4 + e]; }
        int i0 = 0; float v0 = el[0];
#pragma unroll
        for (int i = 1; i < 4; ++i) if (el[i] > v0) { v0 = el[i]; i0 = i; }
        int i1 = -1; float v1 = -INFINITY;
#pragma unroll
        for (int i = 0; i < 4; ++i) if (i != i0 && el[i] > v1) { v1 = el[i]; i1 = i; }
        const float e1 = __expf(v1 - v0); const float w0 = gw_ / (1.0f + e1), w1 = gw_ * e1 / (1.0f + e1);
        const int pa = i0 < i1 ? i0 : i1, pb = i0 < i1 ? i1 : i0;
        const int pidx = (pa == 0) ? (pb - 1) : (pa == 1 ? pb + 1 : 5);
        const int bucket = g * 6 + pidx;
        if (lane == 0) { TokInfo ti; ti.bucket = bucket; ti.wa = (i0 < i1) ? w0 : w1; ti.wb = (i0 < i1) ? w1 : w0; ti.rstd = rstd;
            ((TokInfo*)(ws + WS_TOKINFO))[m] = ti;
            atomicAdd((unsigned*)(ws + WS_CTL) + CW_CNT + bucket, 1u); }
    }
}
__device__ __forceinline__ int bucket_bases(const unsigned* cnt, int* base  ) {
    int acc = 0;
    for (int i = 0; i < NBUCKET; ++i) { base[i] = acc; acc += (int)((cnt[i] + 255u) >> 8) * 256; }
    base[NBUCKET] = acc; return acc;
}
__device__ __forceinline__ void p7b_sort(const Args& A, unsigned char* lds, int tid, int lane, int wave) {
    unsigned char* ws = A.ws;
    int* basel = (int*)lds;
    unsigned* cnt = (unsigned*)(ws + WS_CTL) + CW_CNT; unsigned* fill = (unsigned*)(ws + WS_CTL) + CW_FILL;
    if (tid == 0) { int acc = 0; for (int i = 0; i < NBUCKET; ++i) { const unsigned c = __hip_atomic_load(cnt + i, __ATOMIC_RELAXED, __HIP_MEMORY_SCOPE_AGENT); basel[i] = acc; basel[32 + i] = (int)c; acc += (int)((c + 255u) >> 8) * 256; } basel[NBUCKET] = acc; }
    __syncthreads();
    const int G = gridDim.x, gw = blockIdx.x * NWAVES + wave, NGW = G * NWAVES;
    int* TOKMAP = (int*)(ws + WS_TOKMAP); float* WSORT = (float*)(ws + WS_WSORT); bf16* HBS = (bf16*)(ws + WS_HBS);
    for (int m = gw; m < T; m += NGW) {
        const TokInfo ti = ((const TokInfo*)(ws + WS_TOKINFO))[m];
        int slot = 0;
        if (lane == 0) slot = basel[ti.bucket] + (int)atomicAdd(fill + ti.bucket, 1u);
        slot = __shfl(slot, 0);
        const f32x4* xr = (const f32x4*)(A.out + (size_t)m * D) + lane;
        unsigned long long* o8 = (unsigned long long*)(HBS + (size_t)slot * D) + lane;
#pragma unroll
        for (int j = 0; j < 4; ++j) { const f32x4 v = xr[64 * j]; o8[64 * j] = (unsigned long long)pk2(v.x * ti.rstd, v.y * ti.rstd) | ((unsigned long long)pk2(v.z * ti.rstd, v.w * ti.rstd) << 32); }
        if (lane == 0) { TOKMAP[slot] = m; WSORT[2 * slot] = ti.wa; WSORT[2 * slot + 1] = ti.wb; }
    }
    for (int bk = 0; bk < NBUCKET; ++bk) { const int lo = basel[bk] + basel[32 + bk], hi = basel[bk + 1];
        for (int r = lo + gw; r < hi; r += NGW) { unsigned long long* o8 = (unsigned long long*)(HBS + (size_t)r * D) + lane;
#pragma unroll
            for (int j = 0; j < 4; ++j) o8[64 * j] = 0ull;
            if (lane == 0) { TOKMAP[r] = -1; WSORT[2 * r] = 0.f; WSORT[2 * r + 1] = 0.f; } } }
}
struct MoeOrder {
    int G, c, nunits, ncol; const int* tab;
    __device__ __forceinline__ bool next(int i, pg8::Unit& u) const {
        const long L = (long)i * G + c; if (L >= nunits) return false;
        const int rt = (int)L / ncol, j = (int)L % ncol, bk = tab[rt];
        u.pm = rt; u.aux = j;
        if (ncol == 8) { const int g = bk / 6, p = bk % 6; const int pa = (p < 3) ? 0 : (p < 5 ? 1 : 2), pb = (p < 3) ? p + 1 : (p < 5 ? p - 1 : 3);
            const int e = 4 * g + ((j >> 2) ? pb : pa); u.pn = e * 4 + (j & 3); }
        else u.pn = bk * 4 + j;
        return true;
    }
    __device__ __forceinline__ void a_ready(const pg8::Unit&) const {}
    __device__ __forceinline__ void done(const pg8::Unit&) const {}
};
struct EpiUp {
    static constexpr bool PERM = true, AFTER_DRAIN = false;
    bf16* act; const float* wsort;
    __device__ __forceinline__ void operator()(const f32x4 (&acc)[2][2][4][2], const pg8::Unit& u, int wr, int wc, int fr, int fq) const {
        const int row0 = u.pm * 256 + wr * 64 + fr, half = u.aux >> 2, col0 = half * 512 + (u.aux & 3) * 128 + wc * 32 + 8 * fq;
#pragma unroll
        for (int ai = 0; ai < 2; ++ai)
#pragma unroll
            for (int m = 0; m < 4; ++m) { const int row = row0 + ai * 128 + m * 16; const float w = wsort[2 * row + half];
                f32x4 r0, r1;
#pragma unroll
                for (int i = 0; i < 4; ++i) { const float a0 = acc[ai][0][m][0][i], a1 = acc[ai][0][m][1][i];
                    r0[i] = a0 * sigmoidf_(a0) * acc[ai][1][m][0][i] * w; r1[i] = a1 * sigmoidf_(a1) * acc[ai][1][m][1][i] * w; }
                *(v4u*)(act + (size_t)row * D + col0) = pack8(r0, r1); }
    }
};
struct EpiDown {
    static constexpr bool PERM = false, AFTER_DRAIN = false;
    float* x2; const int* tokmap;
    __device__ __forceinline__ void operator()(const f32x4 (&acc)[2][2][4][2], const pg8::Unit& u, int wr, int wc, int fr, int fq) const {
        const int row0 = u.pm * 256 + wr * 64 + fr, col0 = u.aux * 256 + wc * 32 + 4 * fq;
#pragma unroll
        for (int ai = 0; ai < 2; ++ai)
#pragma unroll
            for (int m = 0; m < 4; ++m) { const int tok = tokmap[row0 + ai * 128 + m * 16];
                if (tok >= 0) {
#pragma unroll
                    for (int bj = 0; bj < 2; ++bj)
#pragma unroll
                        for (int n = 0; n < 2; ++n) { float* p = x2 + (size_t)tok * D + col0 + bj * 128 + n * 16; const f32x4 o = *(const f32x4*)p + acc[ai][bj][m][n]; *(f32x4*)p = o; } } }
    }
};
__device__ __forceinline__ void p10_final(const Args& A, int lane, int wave) {
    const float* g_final = (const float*)(A.ws + WS_PAR) + PAR_GFIN;
    const int G = gridDim.x, gw = blockIdx.x * NWAVES + wave, NGW = G * NWAVES;
    f32x4 gv[4];
#pragma unroll
    for (int j = 0; j < 4; ++j) gv[j] = *((const f32x4*)g_final + lane + 64 * j);
    for (int m = gw; m < T; m += NGW) {
        f32x4* xr = (f32x4*)(A.out + (size_t)m * D) + lane;
        f32x4 v[4]; float s = 0.f;
#pragma unroll
        for (int j = 0; j < 4; ++j) { v[j] = xr[64 * j]; s += (v[j].x * v[j].x + v[j].y * v[j].y) + (v[j].z * v[j].z + v[j].w * v[j].w); }
        const float rstd = 1.0f / sqrtf(wave_sum(s) * (1.0f / D) + EPSN);
#pragma unroll
        for (int j = 0; j < 4; ++j) xr[64 * j] = v[j] * rstd * gv[j];
    }
}

#ifndef MS
#define MS 4
#endif
#ifndef N_LAUNCHES
#define N_LAUNCHES 14
#endif
constexpr int N_PHASES = 14;
#ifndef QX_SP2
#define QX_SP2 false
#endif

#ifndef NVG
#define NVG 256
#endif
__global__ void __launch_bounds__(NTHR, 2) __attribute__((amdgpu_num_vgpr(NVG))) fwd_kernel(Args args) {
    __shared__ __attribute__((aligned(16))) unsigned char lds[LDS_BYTES];
    const int tid = threadIdx.x, lane = tid & 63, wave = __builtin_amdgcn_readfirstlane(tid >> 6);
    gu32* ctl = (gu32*)(args.ws + WS_CTL);
    for (int u = tid; u < (LDS_BYTES - LDS_MISC) / 4; u += NTHR) ((unsigned*)(lds + LDS_MISC))[u] = 0u;
    __syncthreads();
    const int lo = args.ph_lo, hi = args.ph_hi;
    const bool use_bar = (hi - lo) > 1;
    XcdBarrier bar; bar.bar = (unsigned*)ctl + CW_BAR; bar.x = 0; bar.st = (volatile LAS unsigned*)(lds + LDS_MISC) + 8;
    if (use_bar) bar = xcd_barrier_post((unsigned*)ctl + CW_BAR, (volatile LAS unsigned*)(lds + LDS_MISC) + 8);
#ifndef PH_MASK
#define PH_MASK 0xFFFF
#endif
#define IN(k) (((PH_MASK >> (k)) & 1) && lo <= (k) && (k) < hi)
#define SEAM(k) do { if (IN(k) && IN((k) + 1)) xcd_barrier(bar); } while (0)
    PG8_LAS unsigned char* ring = (PG8_LAS unsigned char*)lds;
    const int G = gridDim.x;
#define PHASE_PTRS Args pa = args; { unsigned char* w_ = args.ws; float* o_ = args.out; asm volatile("" : "+s"(w_), "+s"(o_)); pa.ws = w_; pa.out = o_; } unsigned char* const ws = pa.ws; (void)ws

#ifdef DUMMY_LIVE
    float dl0, dl1, dl2, dl3, dl4, dl5, dl6, dl7; asm volatile("" : "=v"(dl0), "=v"(dl1), "=v"(dl2), "=v"(dl3), "=v"(dl4), "=v"(dl5), "=v"(dl6), "=v"(dl7));
#endif
    if (IN(0)) { PHASE_PTRS; p0_prologue(pa, lds, tid, lane, wave); }
    SEAM(0);
    if (IN(1) && MS >= 1) { PHASE_PTRS;
        pg8::Gemm g{(const pg8::bf16_t*)(ws + WS_XN), (const pg8::bf16_t*)(ws + WS_WIN), T + TMEM, NIN + NKV, D};
        InProjOrder S; S.so.init(T, NIN, G, (int)blockIdx.x);
        EpiInProj E{(bf16*)(ws + WS_Q), (bf16*)(ws + WS_KVX), (const float*)(ws + WS_ROPE)};
        pg8::gemm_phase<EpiInProj, InProjOrder, true, true>(ring, g, S, E);
    }
    SEAM(1);
    if (IN(2) && MS >= 1) { PHASE_PTRS;
        const int n_att = (MS >= 2) ? 3 * 4096 : 0;
        for (int it = blockIdx.x; it < n_att + 2048; it += G) {
            if (it < n_att) attn_item(pa, lds, it, tid, lane, wave); else mlstm1_item(pa, lds, it - n_att, tid, lane, wave);
        }
    }
    SEAM(2);
    if (IN(3) && MS >= 1) { PHASE_PTRS;
        if (MS < 2) {
            for (size_t id = (size_t)blockIdx.x * NTHR + tid; id < (size_t)T * 64; id += (size_t)G * NTHR) { const size_t t = id >> 6; const int c8 = (int)(id & 63) * 8;
                *(v4u*)((bf16*)(ws + WS_Y) + t * 1024 + c8) = (v4u){0u, 0u, 0u, 0u}; }
        }
        p3_scan_combine(pa, tid);
    }
    SEAM(3);
    if (IN(4) && MS >= 1) { PHASE_PTRS; for (int it = blockIdx.x; it < 2048; it += G) mlstm2_item(pa, lds, it, tid, lane, wave); }
    SEAM(4);
    if (IN(5)) { PHASE_PTRS;
        if (MS >= 1) {
            pg8::Gemm g{(const pg8::bf16_t*)(ws + WS_Y), (const pg8::bf16_t*)(ws + WS_WOUT), T, D, D};
            pg8::StaticOrder S; S.init(T, D, G, (int)blockIdx.x);
            EpiOutProj E{(const float*)pa.in[0], pa.out, (bf16*)(ws + WS_X1B), (float*)(ws + WS_SS1)};
            pg8::gemm_phase<EpiOutProj, pg8::StaticOrder, true, true>(ring, g, S, E);
        } else {
            const int gw = blockIdx.x * NWAVES + wave, NGW = G * NWAVES;
            for (int m = gw; m < T; m += NGW) { const f32x4* xr = (const f32x4*)((const float*)pa.in[0] + (size_t)m * D) + lane; f32x4* o = (f32x4*)(pa.out + (size_t)m * D) + lane;
#pragma unroll
                for (int j = 0; j < 4; ++j) o[64 * j] = xr[64 * j]; }
        }
    }
    SEAM(5);
    if (IN(6) && MS >= 3) { PHASE_PTRS;
        pg8::Gemm g{(const pg8::bf16_t*)(ws + WS_X1B), (const pg8::bf16_t*)(ws + WS_WQX), T, 256, D};
        pg8::StaticOrder S; S.init(T, 256, G, (int)blockIdx.x);
        float* rs = (float*)(lds + LDS_RS);
        { pg8::Unit u0; if (S.next(0, u0) && tid < 256) { const f32x4* sp = (const f32x4*)((const float*)(ws + WS_SS1) + (size_t)(u0.pm * 256 + tid) * 16);
              const f32x4 a = sp[0], b = sp[1], c = sp[2], d = sp[3];
              const float s = ((a[0] + a[1]) + (a[2] + a[3])) + ((b[0] + b[1]) + (b[2] + b[3])) + ((c[0] + c[1]) + (c[2] + c[3])) + ((d[0] + d[1]) + (d[2] + d[3]));
              rs[tid] = 1.0f / sqrtf(s * (1.0f / D) + EPSN); } }
        __syncthreads();
        EpiQx E{(bf16*)(ws + WS_QX), (const LAS float*)rs};
        pg8::gemm_phase<EpiQx, pg8::StaticOrder, true, QX_SP2>(ring, g, S, E);
    }
    SEAM(6);
    if (IN(7) && MS >= 3) { PHASE_PTRS; for (int it = blockIdx.x; it < (T / 128) * 4; it += G) cross_item(pa, lds, it, tid, lane, wave); }
    SEAM(7);
    if (IN(8) && MS >= 3) { PHASE_PTRS;
        int kdyn = 256; asm volatile("" : "+s"(kdyn));
        pg8::Gemm g{(const pg8::bf16_t*)(ws + WS_OX), (const pg8::bf16_t*)(ws + WS_WOX), T, D, kdyn};
        pg8::StaticOrder S; S.init(T, D, G, (int)blockIdx.x);
        EpiOx E{pa.out};
        pg8::gemm_phase<EpiOx, pg8::StaticOrder, false, true>(ring, g, S, E);
    }
    SEAM(8);
    if (IN(9) && MS >= 4) { PHASE_PTRS; p7a_route(pa, lds, tid, lane, wave); }
    SEAM(9);
    if (IN(10) && MS >= 4) { PHASE_PTRS; p7b_sort(pa, lds, tid, lane, wave); }
    SEAM(10);
    if ((IN(11) || IN(12)) && MS >= 4) { PHASE_PTRS;
        int* tab = (int*)(lds + LDS_TAB);
        if (tid == 0) { int nrt = 0; const unsigned* cnt = (const unsigned*)(ws + WS_CTL) + CW_CNT;
            for (int i = 0; i < NBUCKET; ++i) { const int nt = (int)((__hip_atomic_load(cnt + i, __ATOMIC_RELAXED, __HIP_MEMORY_SCOPE_AGENT) + 255u) >> 8); for (int k = 0; k < nt; ++k) tab[1 + nrt++] = i; }
            tab[0] = nrt; }
        __syncthreads();
        const int nrt = tab[0];
        if (IN(11)) {
            pg8::Gemm g{(const pg8::bf16_t*)(ws + WS_HBS), (const pg8::bf16_t*)(ws + WS_W13), ROWS_MAX, 64 * 256, D};
            MoeOrder S{G, (int)blockIdx.x, nrt * 8, 8, tab + 1};
            EpiUp E{(bf16*)(ws + WS_ACT), (const float*)(ws + WS_WSORT)};
            pg8::gemm_phase<EpiUp, MoeOrder, true, true>(ring, g, S, E);
        }
        SEAM(11);
        if (IN(12)) {
            pg8::Gemm g{(const pg8::bf16_t*)(ws + WS_ACT), (const pg8::bf16_t*)(ws + WS_W2P), ROWS_MAX, 96 * 256, D};
            MoeOrder S{G, (int)blockIdx.x, nrt * 4, 4, tab + 1};
            EpiDown E{pa.out, (const int*)(ws + WS_TOKMAP)};
            pg8::gemm_phase<EpiDown, MoeOrder, true, true>(ring, g, S, E);
        }
    }
    SEAM(12);
    if (IN(13)) { PHASE_PTRS; p10_final(pa, lane, wave); }
#ifdef DUMMY_LIVE
    asm volatile("" :: "v"(dl0), "v"(dl1), "v"(dl2), "v"(dl3), "v"(dl4), "v"(dl5), "v"(dl6), "v"(dl7));
#endif
#undef IN
#undef SEAM
}

extern "C" void kernel_launch(void* const* d_in, const int* in_sizes, int n_in, void* d_out, int out_size, void* d_ws, size_t ws_size, hipStream_t stream) {
    static int grid = 0;
    if (grid == 0) {
        if (n_in != 28 || out_size != T * D || ws_size < WS_END) { fprintf(stderr, "kernel_launch: unexpected problem (n_in %d, out %d, ws %zu)\n", n_in, out_size, ws_size); grid = -1; return; }
        int dev = 0, cus = 0, per_cu = 0;
        if (hipGetDevice(&dev) != hipSuccess || hipDeviceGetAttribute(&cus, hipDeviceAttributeMultiprocessorCount, dev) != hipSuccess) { grid = -1; return; }
        if (hipOccupancyMaxActiveBlocksPerMultiprocessor(&per_cu, (const void*)fwd_kernel, NTHR, 0) != hipSuccess || per_cu < 1) { fprintf(stderr, "kernel_launch: occupancy query failed (%d)\n", per_cu); per_cu = 1; }
        (void)hipGetLastError();
        grid = cus * (per_cu > 1 ? 1 : per_cu);
        if (grid > 256) grid = 256;
    }
    if (grid < 0) return;
    (void)hipMemsetAsync((char*)d_ws + WS_CTL, 0, CTL_ZERO_BYTES, stream);
    Args a{};
    for (int i = 0; i < 28; ++i) a.in[i] = d_in[i];
    a.out = (float*)d_out; a.ws = (unsigned char*)d_ws;
    if (N_LAUNCHES == 1) {
        a.ph_lo = 0; a.ph_hi = N_PHASES;
        void* kargs[] = {&a};
        hipError_t e = hipLaunchCooperativeKernel((const void*)fwd_kernel, dim3(grid), dim3(NTHR), kargs, 0, stream);
        if (e != hipSuccess) fprintf(stderr, "kernel_launch: cooperative launch failed: %s (grid %d)\n", hipGetErrorString(e), grid);
    } else {
        for (int p = 0; p < N_PHASES; ++p) { a.ph_lo = p; a.ph_hi = p + 1; hipLaunchKernelGGL(fwd_kernel, dim3(grid), dim3(NTHR), 0, stream, a); }
    }
}
```

```cpp
#include <hip/hip_runtime.h>
#include <cstdio>
#include <cstdint>
namespace pg8 {
#define PG8_LAS __attribute__((address_space(3)))
typedef unsigned short bf16_t;
typedef short bf16x8 __attribute__((ext_vector_type(8)));
typedef float f32x4 __attribute__((ext_vector_type(4)));
typedef unsigned u32x4 __attribute__((ext_vector_type(4)));
constexpr int BM = 256, BK = 64, HALF = 128, HTB = HALF * BK * 2  , STAGE_BYTES = 8 * HTB, NXCD = 8, WGM = 8;

__host__ __device__ __forceinline__ int lds_byte(int r, int c) { const int st = (r >> 4) * 2 + (c >> 5), rr = r & 15, cc = c & 31, ob = rr * 64 + cc * 2; return st * 1024 + (ob ^ (((ob >> 9) & 1) << 5)); }
__host__ __device__ __forceinline__ void stage_rc(int b, int& R, int& C) { const int st = b / 1024, sb = b % 1024, swz = sb ^ (((sb >> 9) & 1) << 5); R = (st >> 1) * 16 + swz / 64; C = (st & 1) * 32 + (swz % 64) / 2; }
__host__ __device__ __forceinline__ int perm32(int rho) { const int n = rho >> 4, i = rho & 15; return 8 * (i >> 2) + 4 * n + (i & 3); }

struct Unit { int pm, pn, aux; };
struct Gemm { const bf16_t* A; const bf16_t* Bt; int M, N, K; };

struct StaticOrder {
    int nM, nN, nwg, G, c;
    __host__ __device__ void init(int M, int N, int G_, int c_) { nM = M / BM; nN = N / BM; nwg = nM * nN; G = G_; c = c_; }
    __host__ __device__ bool next(int i, Unit& u) const {
        const long L = (long)i * G + c; if (L >= nwg) return false;
        int wgid = (int)L; { const int q = nwg / NXCD, r = nwg % NXCD, xcd = wgid % NXCD, off = wgid / NXCD; wgid = (xcd < r ? xcd * (q + 1) : r * (q + 1) + (xcd - r) * q) + off; }
        const int nig = WGM * nN, gid = wgid / nig, fm = gid * WGM, gsz = (nM - fm) < WGM ? (nM - fm) : WGM;
        u.pm = fm + ((wgid % nig) % gsz); u.pn = (wgid % nig) / gsz; u.aux = 0; return true;
    }
    __device__ __forceinline__ void a_ready(const Unit&) const {}
    __device__ __forceinline__ void done(const Unit&) const {}
};

__device__ __forceinline__ unsigned cvt_pk_bf16(float lo, float hi) { unsigned r; asm volatile("v_cvt_pk_bf16_f32 %0, %1, %2" : "=v"(r) : "v"(lo), "v"(hi)); return r; }
template <class Epi, class Sched, bool ALIGN_EPI = false, bool SP2 = false>
__device__ __forceinline__ void gemm_phase(PG8_LAS unsigned char* lds, const Gemm g, const Sched& S, const Epi& E) {
    const int tid = threadIdx.x, wid = __builtin_amdgcn_readfirstlane(tid >> 6), lane = tid & 63, wr = wid >> 2, wc = wid & 3, fr = lane & 15, fq = lane >> 4;
    const int K = g.K, nt = K / BK;
    unsigned voffA[2], voffB[2];
#pragma unroll
    for (int i = 0; i < 2; ++i) { int R, C; stage_rc(tid * 16 + i * 8192, R, C); const int Rb = Epi::PERM ? ((R & ~31) + perm32(R & 31)) : R;
        voffA[i] = (unsigned)(R * K + C) * 2u; voffB[i] = (unsigned)(Rb * K + C) * 2u; }
    const size_t kstep = (size_t)(BK * 2);
    const size_t hstep = (size_t)HALF * K * 2;
    const size_t tstep = 2 * hstep;
    const unsigned ldsw = (unsigned)wid * 1024u;
    const int aoff = lds_byte(wr * 64 + fr, fq * 8), boff = lds_byte(wc * 32 + fr, fq * 8);
#define PG8_SA(b, h) (((b) * 2 + (h)) * HTB)
#define PG8_SB(b, h) ((4 + (b) * 2 + (h)) * HTB)
#define PG8_STAGE(bufoff, gbase, voff) do { _Pragma("unroll") for (int _i = 0; _i < 2; ++_i) \
        __builtin_amdgcn_global_load_lds((const unsigned*)((const char*)(gbase) + (voff)[_i]), (PG8_LAS unsigned*)(lds + (bufoff) + ldsw + _i * 8192), 16, 0, 0); } while (0)
#define PG8_LDA(dst, b, h) do { _Pragma("unroll") for (int m = 0; m < 4; ++m) _Pragma("unroll") for (int k = 0; k < 2; ++k) dst[m][k] = *(const PG8_LAS bf16x8*)(lds + PG8_SA(b, h) + aoff + m * 2048 + k * 1024); } while (0)
#define PG8_LDB(dst, b, h) do { _Pragma("unroll") for (int n = 0; n < 2; ++n) _Pragma("unroll") for (int k = 0; k < 2; ++k) dst[n][k] = *(const PG8_LAS bf16x8*)(lds + PG8_SB(b, h) + boff + n * 2048 + k * 1024); } while (0)
#define PG8_MMA(ai, bj, At, Bt) do { __builtin_amdgcn_s_setprio(1); _Pragma("unroll") for (int m = 0; m < 4; ++m) _Pragma("unroll") for (int n = 0; n < 2; ++n) _Pragma("unroll") for (int k = 0; k < 2; ++k) \
        acc[ai][bj][m][n] = __builtin_amdgcn_mfma_f32_16x16x32_bf16(Bt[n][k], At[m][k], acc[ai][bj][m][n], 0, 0, 0); __builtin_amdgcn_s_setprio(0); } while (0)
#define PG8_WAIT_V(n) asm volatile("s_waitcnt vmcnt(" #n ")" ::: "memory")
#define PG8_WAIT_L(n) asm volatile("s_waitcnt lgkmcnt(" #n ")" ::: "memory")
#define PG8_BAR __builtin_amdgcn_s_barrier()
#define PG8_SCHED __builtin_amdgcn_sched_barrier(0)
    Unit cur, nxt; int ui = 0;
    if (!S.next(0, cur)) return;
    f32x4 acc[2][2][4][2];
#pragma unroll
    for (int a = 0; a < 2; ++a)
#pragma unroll
        for (int b = 0; b < 2; ++b)
#pragma unroll
            for (int m = 0; m < 4; ++m)
#pragma unroll
                for (int n = 0; n < 2; ++n) acc[a][b][m][n] = (f32x4){0.f, 0.f, 0.f, 0.f};
    bf16x8 At[4][2], B0[2][2], B1[2][2];
    const char* cA = (const char*)g.A + (size_t)cur.pm * tstep; const char* cB = (const char*)g.Bt + (size_t)cur.pn * tstep;
    S.a_ready(cur);
    if constexpr (SP2) {
        PG8_STAGE(PG8_SB(0, 0), cB, voffB); PG8_STAGE(PG8_SB(0, 1), cB + hstep, voffB); PG8_STAGE(PG8_SA(0, 0), cA, voffA); PG8_STAGE(PG8_SA(0, 1), cA + hstep, voffA);
        if (wr == 1) PG8_BAR;
        PG8_WAIT_V(2); PG8_BAR;
        PG8_STAGE(PG8_SB(1, 0), cB + kstep, voffB); PG8_STAGE(PG8_SA(1, 0), cA + kstep, voffA); PG8_STAGE(PG8_SB(1, 1), cB + hstep + kstep, voffB);
        PG8_WAIT_V(6); PG8_BAR;
    } else {
        PG8_STAGE(PG8_SB(0, 0), cB, voffB); PG8_STAGE(PG8_SA(0, 0), cA, voffA); PG8_STAGE(PG8_SB(0, 1), cB + hstep, voffB); PG8_STAGE(PG8_SA(0, 1), cA + hstep, voffA);
        if (wr == 1) PG8_BAR;
        PG8_WAIT_V(4); PG8_BAR;
        PG8_STAGE(PG8_SB(1, 0), cB + kstep, voffB); PG8_STAGE(PG8_SA(1, 0), cA + kstep, voffA); PG8_STAGE(PG8_SB(1, 1), cB + hstep + kstep, voffB);
        PG8_WAIT_V(6); PG8_BAR;
    }
    for (;;) {
        const bool has_next = S.next(ui + 1, nxt);
        const char* nA = has_next ? (const char*)g.A + (size_t)nxt.pm * tstep : cA; const char* nB = has_next ? (const char*)g.Bt + (size_t)nxt.pn * tstep : cB;
        for (int t = 0; t < nt; t += 2) {
            const bool last = (t == nt - 2);
            const char* a1 = cA + (size_t)(t + 1) * kstep;
            const char* a2 = last ? nA : cA + (size_t)(t + 2) * kstep; const char* b2 = last ? nB : cB + (size_t)(t + 2) * kstep;
            const char* a3 = a2 + kstep; const char* b3 = b2 + kstep;
            if (last && has_next) S.a_ready(nxt);
            if constexpr (SP2) {
            PG8_LDB(B0, 0, 0); PG8_LDB(B1, 0, 1); PG8_SCHED; PG8_LDA(At, 0, 0); PG8_STAGE(PG8_SA(1, 1), a1 + hstep, voffA);
            PG8_WAIT_V(8); PG8_WAIT_L(0); PG8_BAR; PG8_MMA(0, 0, At, B0); PG8_MMA(0, 1, At, B1); PG8_BAR; PG8_SCHED;
            PG8_LDA(At, 0, 1); PG8_STAGE(PG8_SB(0, 0), b2, voffB); PG8_STAGE(PG8_SB(0, 1), b2 + hstep, voffB); PG8_STAGE(PG8_SA(0, 0), a2, voffA);
            PG8_WAIT_V(8); PG8_WAIT_L(0); PG8_BAR; PG8_MMA(1, 0, At, B0); PG8_MMA(1, 1, At, B1); PG8_BAR; PG8_SCHED;
            PG8_LDB(B0, 1, 0); PG8_LDB(B1, 1, 1); PG8_SCHED; PG8_LDA(At, 1, 0); PG8_STAGE(PG8_SA(0, 1), a2 + hstep, voffA);
            PG8_WAIT_V(8); PG8_WAIT_L(0); PG8_BAR; PG8_MMA(0, 0, At, B0); PG8_MMA(0, 1, At, B1); PG8_BAR; PG8_SCHED;
            PG8_LDA(At, 1, 1); PG8_STAGE(PG8_SB(1, 0), b3, voffB); PG8_STAGE(PG8_SB(1, 1), b3 + hstep, voffB); PG8_STAGE(PG8_SA(1, 0), a3, voffA);
            PG8_WAIT_V(8); PG8_WAIT_L(0); PG8_BAR; PG8_MMA(1, 0, At, B0); PG8_MMA(1, 1, At, B1); PG8_BAR; PG8_SCHED;
            } else {
            PG8_LDB(B0, 0, 0); PG8_SCHED; PG8_LDA(At, 0, 0); PG8_STAGE(PG8_SA(1, 1), a1 + hstep, voffA);
            PG8_WAIT_L(8); PG8_BAR; PG8_WAIT_L(0); PG8_MMA(0, 0, At, B0); PG8_BAR; PG8_SCHED;
            PG8_LDB(B1, 0, 1); PG8_STAGE(PG8_SB(0, 0), b2, voffB);
            PG8_BAR; PG8_WAIT_L(0); PG8_MMA(0, 1, At, B1); PG8_BAR;
            PG8_LDA(At, 0, 1); PG8_STAGE(PG8_SA(0, 0), a2, voffA);
            PG8_BAR; PG8_WAIT_L(0); PG8_MMA(1, 0, At, B0); PG8_BAR; PG8_SCHED;
            PG8_STAGE(PG8_SB(0, 1), b2 + hstep, voffB);
            PG8_WAIT_V(6); PG8_BAR; PG8_MMA(1, 1, At, B1); PG8_BAR;
            PG8_LDB(B0, 1, 0); PG8_SCHED; PG8_LDA(At, 1, 0); PG8_STAGE(PG8_SA(0, 1), a2 + hstep, voffA);
            PG8_WAIT_L(8); PG8_BAR; PG8_WAIT_L(0); PG8_MMA(0, 0, At, B0); PG8_BAR; PG8_SCHED;
            PG8_LDB(B1, 1, 1); PG8_STAGE(PG8_SB(1, 0), b3, voffB);
            PG8_BAR; PG8_WAIT_L(0); PG8_MMA(0, 1, At, B1); PG8_BAR;
            PG8_LDA(At, 1, 1); PG8_STAGE(PG8_SA(1, 0), a3, voffA);
            PG8_BAR; PG8_WAIT_L(0); PG8_MMA(1, 0, At, B0); PG8_BAR; PG8_SCHED;
            PG8_STAGE(PG8_SB(1, 1), b3 + hstep, voffB);
            PG8_WAIT_V(6); PG8_BAR; PG8_MMA(1, 1, At, B1); PG8_BAR;
            }
        }
        if constexpr (ALIGN_EPI) { if (wr == 0) PG8_BAR; }
        if constexpr (!Epi::AFTER_DRAIN) { E(acc, cur, wr, wc, fr, fq); S.done(cur); }
        if (!has_next) break;
#pragma unroll
        for (int a = 0; a < 2; ++a)
#pragma unroll
            for (int b = 0; b < 2; ++b)
#pragma unroll
                for (int m = 0; m < 4; ++m)
#pragma unroll
                    for (int n = 0; n < 2; ++n) acc[a][b][m][n] = (f32x4){0.f, 0.f, 0.f, 0.f};
        cur = nxt; cA = nA; cB = nB; ++ui;
        if constexpr (ALIGN_EPI) { if (wr == 1) PG8_BAR; }
    }
    PG8_WAIT_V(0);
    if constexpr (!ALIGN_EPI) { if (wr == 0) PG8_BAR; }
    PG8_BAR;
    if constexpr (Epi::AFTER_DRAIN) { E.fused(acc, cur, wr, wc, fr, fq, lds, wid, lane); S.done(cur); }
#undef PG8_SA
#undef PG8_SB
#undef PG8_STAGE
#undef PG8_LDA
#undef PG8_LDB
#undef PG8_MMA
#undef PG8_WAIT_V
#undef PG8_WAIT_L
#undef PG8_BAR
#undef PG8_SCHED
}
}

#define GAS __attribute__((address_space(1)))
#define LAS __attribute__((address_space(3)))
typedef unsigned short bf16;
typedef unsigned v4u __attribute__((ext_vector_type(4)));
typedef unsigned v2u __attribute__((ext_vector_type(2)));
typedef float f32x4 __attribute__((ext_vector_type(4)));
typedef short bf16x8 __attribute__((ext_vector_type(8)));
typedef GAS unsigned gu32;

constexpr int NWAVES = 8, NTHR = 512;
constexpr int BATCH = 8, SEQ = 8192, T = BATCH * SEQ, D = 1024, MEMLEN = 256, TMEM = BATCH * MEMLEN;
constexpr int INW = 3080, NIN = 3072, NKV = 512;
constexpr int NBUCKET = 24, ROWS_MAX = T + NBUCKET * 256;
constexpr float EPSN = 1e-6f;
constexpr float C2 = 0.125f * 1.4426950408889634f;
constexpr float LOG2E = 1.4426950408889634f;

constexpr size_t MiB = 1u << 20;
constexpr size_t WS_CTL = 0, CTL_ZERO_BYTES = 1 * MiB;
constexpr size_t WS_ROPE = 2 * MiB;
constexpr size_t WS_IG = 6 * MiB;
constexpr size_t WS_FG = 7 * MiB;
constexpr size_t WS_LSE = 8 * MiB;
constexpr size_t WS_SS1 = 14 * MiB;
constexpr size_t WS_SS3 = 18 * MiB;
constexpr size_t WS_KVX = 22 * MiB;
constexpr size_t WS_NLOC = 24 * MiB;
constexpr size_t WS_NPREV = 25 * MiB;
constexpr size_t WS_MLOC = 26 * MiB;
constexpr size_t WS_BLAST = 26 * MiB + 64 * 1024;
constexpr size_t WS_MPREV = 26 * MiB + 128 * 1024;
constexpr size_t WS_TOKINFO = 27 * MiB;
constexpr size_t WS_TOKMAP = 28 * MiB;
constexpr size_t WS_WSORT = 29 * MiB;
constexpr size_t WS_WR = 30 * MiB;
constexpr size_t WS_WG = 30 * MiB + 512 * 1024;
constexpr size_t WS_PAR = 31 * MiB;
constexpr int PAR_CONVW = 0, PAR_CONVB = 2048, PAR_GMHN = 2560, PAR_SKIP = 3072, PAR_BRG = 3584, PAR_BRE = 3600, PAR_GFIN = 3616, PAR_N = 4640;
constexpr size_t WS_WIN = 32 * MiB;
constexpr size_t WS_WOUT = 39 * MiB;
constexpr size_t WS_WQX = 41 * MiB;
constexpr size_t WS_WOX = 41 * MiB + 512 * 1024;
constexpr size_t WS_WM = 42 * MiB;
constexpr size_t WS_W13 = 44 * MiB;
constexpr size_t WS_W2P = 76 * MiB;
constexpr size_t WS_XN = 128 * MiB;
constexpr size_t WS_CLOC = 128 * MiB;
constexpr size_t WS_Q = 264 * MiB;
constexpr size_t WS_K = 328 * MiB, WS_V = 392 * MiB, WS_MU = 456 * MiB, WS_MV = 520 * MiB, WS_MO = 584 * MiB;
constexpr size_t WS_MQ = 648 * MiB, WS_MK = 712 * MiB;
constexpr size_t WS_Y = 264 * MiB;
constexpr size_t WS_CPREV = 392 * MiB;
constexpr size_t WS_X1B = 648 * MiB;
constexpr size_t WS_QX = 776 * MiB;
constexpr size_t WS_OX = 808 * MiB;
constexpr size_t WS_HBS = 264 * MiB;
constexpr size_t WS_ACT = 404 * MiB;
constexpr size_t WS_END = 840 * MiB;
constexpr size_t DO_OATT = 0, DO_C = 192 * MiB;

constexpr int CW_BAR = 4096;
constexpr int CW_CNT = 8192;
constexpr int CW_FILL = 8192 + 64;

constexpr int LDS_BYTES = 163840;
constexpr int LDS_MISC = 159744;
constexpr int LDS_RS = 135168;
constexpr int LDS_TAB = 136192;

#define LDS_WAIT() asm volatile("s_waitcnt lgkmcnt(0)" ::: "memory")
#define VM_WAIT() asm volatile("s_waitcnt vmcnt(0)" ::: "memory")
__device__ __forceinline__ unsigned f2bf(float f) { unsigned u = __builtin_bit_cast(unsigned, f); return (u + 0x7fffu + ((u >> 16) & 1u)) >> 16; }
__device__ __forceinline__ unsigned pk2(float lo, float hi) { return f2bf(lo) | (f2bf(hi) << 16); }
__device__ __forceinline__ float bf2f(unsigned h) { return __uint_as_float(h << 16); }
__device__ __forceinline__ float bflo(unsigned w) { return __uint_as_float(w << 16); }
__device__ __forceinline__ float bfhi(unsigned w) { return __uint_as_float(w & 0xffff0000u); }
__device__ __forceinline__ float wave_sum(float v) {
#pragma unroll
    for (int o = 1; o < 64; o <<= 1) v += __shfl_xor(v, o);
    return v;
}
__device__ __forceinline__ float wave_max(float v) {
#pragma unroll
    for (int o = 1; o < 64; o <<= 1) v = fmaxf(v, __shfl_xor(v, o));
    return v;
}
__device__ __forceinline__ float sigmoidf_(float x) { return 1.0f / (1.0f + __expf(-x)); }

#define XB_TMO      128
#define XB_XCNT(j)  (256  + 64 * (j))
#define XB_XSUB(j)  (1280 + 64 * (j))
#define XB_XGEN(j)  (2304 + 64 * (j))
#define XB_TOP      3328
#define XB_TOPGEN   3392
#define XCD_BAR_WORDS 3456
#define XB_SPIN_CAP (1u << 22)
__device__ __forceinline__ unsigned xb_ld(unsigned* p)              { return __hip_atomic_load(p, __ATOMIC_RELAXED, __HIP_MEMORY_SCOPE_AGENT); }
__device__ __forceinline__ unsigned xb_add(unsigned* p, unsigned v) { return __hip_atomic_fetch_add(p, v, __ATOMIC_RELAXED, __HIP_MEMORY_SCOPE_AGENT); }
__device__ __forceinline__ unsigned xb_xcc_id() { return (unsigned)__builtin_amdgcn_s_getreg((3 << 11) | 20) & 0xFu; }
#define XB_SPIN(cond, bar) do { unsigned _sp = 0; while (cond) { __builtin_amdgcn_s_sleep(1); \
    if ((++_sp & 255u) == 0u) { if (xb_ld(&(bar)[XB_TMO])) break; if (_sp > XB_SPIN_CAP) { atomicAdd(&(bar)[XB_TMO], 1u); break; } } } } while (0)
struct XcdBarrier { unsigned* bar; unsigned x; volatile LAS unsigned* st; };
__device__ __forceinline__ XcdBarrier xcd_barrier_post(unsigned* bar, volatile LAS unsigned* st) {
    XcdBarrier b; b.bar = bar; b.x = xb_xcc_id(); b.st = st;
    if (threadIdx.x == 0) (void)xb_add(&bar[XB_XCNT(b.x)], 1u);
    return b;
}
__device__ __forceinline__ void xcd_barrier_complete(unsigned* bar, unsigned x, unsigned& nloc, unsigned& nx) {
    const unsigned G = gridDim.x * gridDim.y * gridDim.z;
    unsigned sum, cnt, mine, sp = 0u;
    for (;;) {
        sum = 0u; cnt = 0u; mine = 0u;
#pragma unroll
        for (unsigned j = 0; j < 16; ++j) { const unsigned c = xb_ld(&bar[XB_XCNT(j)]); sum += c; cnt += (c > 0u) ? 1u : 0u; mine = (j == x) ? c : mine; }
        if (sum == G) break;
        __builtin_amdgcn_s_sleep(1);
        if ((++sp & 255u) == 0u) { if (xb_ld(&bar[XB_TMO])) break; if (sp > XB_SPIN_CAP) { atomicAdd(&bar[XB_TMO], 1u); break; } }
    }
    nloc = mine > 0u ? mine : 1u; nx = cnt > 0u ? cnt : 1u;
}
__device__ __forceinline__ void xcd_barrier(const XcdBarrier& b) {
    asm volatile("s_waitcnt vmcnt(0)" ::: "memory");
    __syncthreads();
    if (threadIdx.x == 0) {
        unsigned* bar = b.bar;
        __builtin_amdgcn_s_waitcnt(0);
        unsigned nloc = b.st[0], nx = b.st[1];
        if (nloc == 0u) { xcd_barrier_complete(bar, b.x, nloc, nx); b.st[0] = nloc; b.st[1] = nx; }
        const unsigned old = xb_add(&bar[XB_XSUB(b.x)], 1u);
        const unsigned gen = old / nloc;
        if (old + 1u == (gen + 1u) * nloc) {
            __builtin_amdgcn_fence(__ATOMIC_RELEASE, "agent");
            asm volatile("s_waitcnt vmcnt(0)" ::: "memory");
            const unsigned og = xb_add(&bar[XB_TOP], 1u);
            const unsigned tg = og / nx;
            if (og + 1u == (tg + 1u) * nx) xb_add(&bar[XB_TOPGEN], 1u);
            else XB_SPIN(xb_ld(&bar[XB_TOPGEN]) == tg, bar);
            __builtin_amdgcn_fence(__ATOMIC_ACQUIRE, "agent");
            xb_add(&bar[XB_XGEN(b.x)], 1u);
            asm volatile("s_waitcnt vmcnt(0)" ::: "memory");
        } else {
            XB_SPIN(xb_ld(&bar[XB_XGEN(b.x)]) == gen, bar);
            __builtin_amdgcn_fence(__ATOMIC_ACQUIRE, "agent");
            asm volatile("s_waitcnt vmcnt(0)" ::: "memory");
        }
    }
    __syncthreads();
}

struct Args { const void* in[28]; float* out; unsigned char* ws; int ph_lo, ph_hi; };

template <int MI, int NJ>
__device__ __forceinline__ void wave_mma(const bf16* A, int lda, const bf16* Bt, int ldb, int K, f32x4 (&acc)[MI][NJ], int fr, int fq) {
    for (int k0 = 0; k0 < K; k0 += 32) {
        bf16x8 a[MI], b[NJ];
#pragma unroll
        for (int i = 0; i < MI; ++i) a[i] = *(const bf16x8*)(A + (16 * i + fr) * lda + k0 + 8 * fq);
#pragma unroll
        for (int j = 0; j < NJ; ++j) b[j] = *(const bf16x8*)(Bt + (16 * j + fr) * ldb + k0 + 8 * fq);
#pragma unroll
        for (int i = 0; i < MI; ++i)
#pragma unroll
            for (int j = 0; j < NJ; ++j) acc[i][j] = __builtin_amdgcn_mfma_f32_16x16x32_bf16(b[j], a[i], acc[i][j], 0, 0, 0);
    }
}

__device__ __forceinline__ void transpose_item(const float* src, int src_ld, int k0, int n0, bf16* dst, int dst_ld, int dst_row0, int dst_col0,
                                               const float* gain, float scale, float* scr, int lane) {
#pragma unroll 8
    for (int i = 0; i < 32; ++i) { const int kk = 2 * i + (lane >> 5);
        const float gsc = gain ? gain[k0 + kk] * scale : scale;
        scr[kk * 33 + (lane & 31)] = src[(size_t)(k0 + kk) * src_ld + n0 + (lane & 31)] * gsc; }
    LDS_WAIT(); asm volatile("" ::: "memory");
    const int c = lane & 7;
#pragma unroll
    for (int j = 0; j < 4; ++j) { const int n = (lane >> 3) + 8 * j; const float* s = scr + (8 * c) * 33 + n;
        v4u o; o.x = pk2(s[0 * 33], s[1 * 33]); o.y = pk2(s[2 * 33], s[3 * 33]); o.z = pk2(s[4 * 33], s[5 * 33]); o.w = pk2(s[6 * 33], s[7 * 33]);
        *(v4u*)(dst + (size_t)(dst_row0 + n) * dst_ld + dst_col0 + 8 * c) = o; }
    LDS_WAIT(); asm volatile("" ::: "memory");
}

__device__ __forceinline__ void p0_prologue(const Args& A, unsigned char* lds, int tid, int lane, int wave) {
    unsigned char* ws = A.ws;
    const float* x = (const float*)A.in[0]; const float* mem = (const float*)A.in[1]; const int* positions = (const int*)A.in[2];
    const float* g_mix = (const float*)A.in[3]; const float* w_in = (const float*)A.in[4];
    const float* w_q_m = (const float*)A.in[7]; const float* w_k_m = (const float*)A.in[8];
    const float* b_i = (const float*)A.in[9]; const float* b_f = (const float*)A.in[10];
    const float* w_out = (const float*)A.in[13]; const float* g_cross = (const float*)A.in[14]; const float* g_mem = (const float*)A.in[15];
    const float* w_q_x = (const float*)A.in[16]; const float* w_kv_x = (const float*)A.in[17]; const float* w_o_x = (const float*)A.in[18];
    const float* g_ffn = (const float*)A.in[19]; const float* w_rg = (const float*)A.in[20]; const float* w_re = (const float*)A.in[22];
    const float* w1 = (const float*)A.in[24]; const float* w3 = (const float*)A.in[25]; const float* w2 = (const float*)A.in[26];
    const int G = gridDim.x, gw = blockIdx.x * NWAVES + wave, NGW = G * NWAVES, gt = blockIdx.x * NTHR + tid, NGT = G * NTHR;

    float* WGl = (float*)(lds + 131072 - 32768 - 0) ;
    for (int i = tid; i < 8 * 1024; i += NTHR) { const int k = i >> 3, j = i & 7; WGl[j * 1024 + k] = g_mix[k] * w_in[(size_t)k * INW + NIN + j]; }

    float* scr = (float*)(lds + wave * 8704);
    constexpr int I_IN = 16 * 96, I_KV = 16 * 16, I_OUT = 16 * 32, I_QX = 16 * 8, I_OX = 4 * 32, I_M = 64, I_13 = 16 * 2 * 256, I_2P = 24 * 2 * 256;
    constexpr int NITEMS = I_IN + I_KV + I_OUT + I_QX + I_OX + I_M + I_13 + I_2P;
    for (int it = gw; it < NITEMS; it += NGW) {
        int r = it;
        if (r < I_IN) { const int kb = r / 96, nb = r % 96; transpose_item(w_in, INW, 64 * kb, 32 * nb, (bf16*)(ws + WS_WIN), 1024, 32 * nb, 64 * kb, g_mix, (32 * nb < 512) ? C2 : 1.0f, scr, lane); continue; } r -= I_IN;
        if (r < I_KV) { const int kb = r / 16, nb = r % 16; transpose_item(w_kv_x, 512, 64 * kb, 32 * nb, (bf16*)(ws + WS_WIN), 1024, NIN + 32 * nb, 64 * kb, g_mem, 1.0f, scr, lane); continue; } r -= I_KV;
        if (r < I_OUT) { const int kb = r / 32, nb = r % 32; transpose_item(w_out, 1024, 64 * kb, 32 * nb, (bf16*)(ws + WS_WOUT), 1024, 32 * nb, 64 * kb, nullptr, 1.0f, scr, lane); continue; } r -= I_OUT;
        if (r < I_QX) { const int kb = r / 8, nb = r % 8; transpose_item(w_q_x, 256, 64 * kb, 32 * nb, (bf16*)(ws + WS_WQX), 1024, 32 * nb, 64 * kb, g_cross, C2, scr, lane); continue; } r -= I_QX;
        if (r < I_OX) { const int kb = r / 32, nb = r % 32; transpose_item(w_o_x, 1024, 64 * kb, 32 * nb, (bf16*)(ws + WS_WOX), 256, 32 * nb, 64 * kb, nullptr, 1.0f, scr, lane); continue; } r -= I_OX;
        if (r < I_M) { const int which = r / 32, h = (r % 32) / 8, kb = (r % 8) / 4, nb = r % 4;
            transpose_item((which ? w_k_m : w_q_m) + (size_t)h * 128 * 128, 128, 64 * kb, 32 * nb, (bf16*)(ws + WS_WM) + (size_t)(which * 4 + h) * 128 * 128, 128, 32 * nb, 64 * kb, nullptr,
                           which ? 0.08838834764831845f : 1.0f, scr, lane); continue; } r -= I_M;
        if (r < I_13) { const int e = r / 512, which = (r % 512) / 256, kb = (r % 256) / 16, nb = r % 16; const int n0 = 32 * nb;
            transpose_item((which ? w3 : w1) + (size_t)e * 1024 * 512, 512, 64 * kb, n0, (bf16*)(ws + WS_W13) + (size_t)e * 1024 * 1024, 1024, (n0 / 128) * 256 + which * 128 + (n0 % 128), 64 * kb, g_ffn, 1.0f, scr, lane); continue; } r -= I_13;
        { const int bk = r / 512, hf = (r % 512) / 256, kb = (r % 256) / 32, nb = r % 32; const int g = bk / 6, p = bk % 6;
          const int pa = (p < 3) ? 0 : (p < 5 ? 1 : 2), pb = (p < 3) ? p + 1 : (p < 5 ? p - 1 : 3); const int e = 4 * g + (hf ? pb : pa);
          transpose_item(w2 + (size_t)e * 512 * 1024, 1024, 64 * kb, 32 * nb, (bf16*)(ws + WS_W2P) + (size_t)bk * 1024 * 1024, 1024, 32 * nb, hf * 512 + 64 * kb, nullptr, 1.0f, scr, lane); }
    }
    for (int i = gt; i < PAR_N; i += NGT) { float v;
        if (i < PAR_CONVB) v = ((const float*)A.in[5])[i]; else if (i < PAR_GMHN) v = ((const float*)A.in[6])[i - PAR_CONVB]; else if (i < PAR_SKIP) v = ((const float*)A.in[11])[i - PAR_GMHN];
        else if (i < PAR_BRG) v = ((const float*)A.in[12])[i - PAR_SKIP]; else if (i < PAR_BRE) v = ((const float*)A.in[21])[i - PAR_BRG]; else if (i < PAR_GFIN) v = ((const float*)A.in[23])[i - PAR_BRE];
        else v = ((const float*)A.in[27])[i - PAR_GFIN];
        ((float*)(ws + WS_PAR))[i] = v; }
    for (int i = gt; i < 20 * 1024; i += NGT) { const int e = i >> 10, k = i & 1023;
        ((float*)(ws + WS_WR))[i] = g_ffn[k] * (e < 4 ? w_rg[k * 4 + e] : w_re[k * 16 + (e - 4)]); }
    for (int i = gt; i < T * 8; i += NGT) { const int t = i >> 3, j = i & 7; const float invf = powf(500000.0f, -(float)j * 0.125f);
        const float ang = (float)positions[t] * invf; float sn, cs; sincosf(ang, &sn, &cs);
        ((float*)(ws + WS_ROPE))[t * 16 + j] = cs; ((float*)(ws + WS_ROPE))[t * 16 + 8 + j] = sn; }
    __syncthreads();
    for (int m = gw; m < T + TMEM; m += NGW) {
        const bool ismem = m >= T;
        const f32x4* xr = (const f32x4*)(ismem ? mem + (size_t)(m - T) * D : x + (size_t)m * D) + lane;
        f32x4 v[4]; float s = 0.f;
#pragma unroll
        for (int j = 0; j < 4; ++j) { v[j] = xr[64 * j]; s += (v[j].x * v[j].x + v[j].y * v[j].y) + (v[j].z * v[j].z + v[j].w * v[j].w); }
        const float rstd = 1.0f / sqrtf(wave_sum(s) * (1.0f / D) + EPSN);
        unsigned long long* o8 = (unsigned long long*)(ws + WS_XN + (size_t)m * D * 2) + lane;
#pragma unroll
        for (int j = 0; j < 4; ++j) o8[64 * j] = (unsigned long long)pk2(v[j].x * rstd, v[j].y * rstd) | ((unsigned long long)pk2(v[j].z * rstd, v[j].w * rstd) << 32);
        if (!ismem) {
            float gd[8];
#pragma unroll
            for (int g = 0; g < 8; ++g) { float a = 0.f;
#pragma unroll
                for (int j = 0; j < 4; ++j) { const f32x4 w = *(const f32x4*)(WGl + g * 1024 + 256 * j + 4 * lane); a += (v[j].x * w.x + v[j].y * w.y) + (v[j].z * w.z + v[j].w * w.w); }
                gd[g] = wave_sum(a) * rstd; }
            if (lane < 8) { float val = 0.f;
#pragma unroll
                for (int g = 0; g < 8; ++g) val = (lane == g) ? gd[g] : val;
                const int b = m / SEQ, sq = m % SEQ, h = lane & 3;
                if (lane < 4) ((float*)(ws + WS_IG))[(size_t)(b * 4 + h) * SEQ + sq] = val + b_i[h];
                else ((float*)(ws + WS_FG))[(size_t)(b * 4 + h) * SEQ + sq] = val + b_f[h]; }
        }
    }
}

struct InProjOrder {
    pg8::StaticOrder so;
    __device__ __forceinline__ bool next(int i, pg8::Unit& u) const {
        if (so.next(i, u)) return true;
        const long L = (long)i * so.G + so.c - so.nwg;
        if (L >= 0 && L < 16) { u.pm = 256 + (int)(L >> 1); u.pn = 12 + (int)(L & 1); u.aux = 1; return true; }
        return false;
    }
    __device__ __forceinline__ void a_ready(const pg8::Unit&) const {}
    __device__ __forceinline__ void done(const pg8::Unit&) const {}
};
__device__ __forceinline__ v4u pack8(const f32x4& a, const f32x4& b) { v4u w; w.x = pk2(a[0], a[1]); w.y = pk2(a[2], a[3]); w.z = pk2(b[0], b[1]); w.w = pk2(b[2], b[3]); return w; }
struct EpiInProj {
    static constexpr bool PERM = true, AFTER_DRAIN = false;
    bf16* base; bf16* kvx; const float* rope;
    __device__ __forceinline__ void operator()(const f32x4 (&acc)[2][2][4][2], const pg8::Unit& u, int wr, int wc, int fr, int fq) const {
        if (u.aux) {
            const int row0 = (u.pm - 256) * 256 + wr * 64 + fr, col0 = (u.pn - 12) * 256 + wc * 32 + 8 * fq;
#pragma unroll
            for (int ai = 0; ai < 2; ++ai)
#pragma unroll
                for (int m = 0; m < 4; ++m) { bf16* rowp = kvx + (size_t)(row0 + ai * 128 + m * 16) * NKV + col0;
#pragma unroll
                    for (int bj = 0; bj < 2; ++bj) *(v4u*)(rowp + bj * 128) = pack8(acc[ai][bj][m][0], acc[ai][bj][m][1]); }
            return;
        }
        const int buf = u.pn >> 1; bf16* B = base + (size_t)buf * T * 512;
        const int row0 = u.pm * 256 + wr * 64 + fr, col0 = (u.pn & 1) * 256 + wc * 32 + 8 * fq;
        const bool dorope = (buf < 2) && ((wc & 1) == 0);
#pragma unroll
        for (int ai = 0; ai < 2; ++ai)
#pragma unroll
            for (int m = 0; m < 4; ++m) { const int row = row0 + ai * 128 + m * 16; bf16* rowp = B + (size_t)row * 512 + col0;
                f32x4 cs0, cs1, sn0, sn1;
                if (dorope) { const f32x4* rp = (const f32x4*)(rope + (size_t)row * 16); cs0 = rp[0]; cs1 = rp[1]; sn0 = rp[2]; sn1 = rp[3]; }
#pragma unroll
                for (int bj = 0; bj < 2; ++bj) { f32x4 v0 = acc[ai][bj][m][0], v1 = acc[ai][bj][m][1];
                    if (dorope) { f32x4 o0, o1;
#pragma unroll
                        for (int i = 0; i < 4; ++i) { o0[i] = __shfl_xor(v0[i], 16); o1[i] = __shfl_xor(v1[i], 16); }
                        if (fq == 0) { v0 = v0 * cs0 - o0 * sn0; v1 = v1 * cs1 - o1 * sn1; }
                        else if (fq == 1) { v0 = v0 * cs0 + o0 * sn0; v1 = v1 * cs1 + o1 * sn1; } }
                    *(v4u*)(rowp + bj * 128) = pack8(v0, v1); } }
    }
};

constexpr int AT_QLD = 72, AT_KLD = 72, AT_VLD = 280, AT_PLD = 168;
constexpr int AT_Q = 0, AT_K = AT_Q + 128 * AT_QLD * 2, AT_V = AT_K + 272 * AT_KLD * 2, AT_P = AT_V + 64 * AT_VLD * 2, AT_END = AT_P + 8 * 16 * AT_PLD * 2;
static_assert(AT_END <= LDS_MISC, "attention LDS");
__device__ __forceinline__ void attn_item(const Args& A, unsigned char* lds, int item, int tid, int lane, int wave) {
    unsigned char* ws = A.ws;
    const int cfg = item >> 12; int rem = item & 4095; const int b = rem >> 9; rem &= 511; const int h = rem >> 6; const int sub = rem & 63;
    const int d = (cfg == 0) ? 1 : (cfg == 1 ? 4 : 16), nblk = 64 / d, r = sub / nblk, nb = sub % nblk;
    const bf16* Qg = (const bf16*)(ws + WS_Q) + h * 64; const bf16* Kg = (const bf16*)(ws + WS_K) + h * 64; const bf16* Vg = (const bf16*)(ws + WS_V) + h * 64;
    bf16* Qs = (bf16*)(lds + AT_Q); bf16* Ks = (bf16*)(lds + AT_K); bf16* Vt = (bf16*)(lds + AT_V); bf16* Ps = (bf16*)(lds + AT_P) + wave * 16 * AT_PLD;
    const size_t tokb = (size_t)b * SEQ + r;
    for (int id = tid; id < 128 * 8; id += NTHR) { const int row = id >> 3, ch = id & 7;
        *(v4u*)(Qs + row * AT_QLD + ch * 8) = *(const v4u*)(Qg + (tokb + (size_t)(128 * nb + row) * d) * 512 + ch * 8); }
    for (int id = tid; id < 272 * 8; id += NTHR) { const int kk = id >> 3, ch = id & 7; const int u = 128 * (nb - 1) + kk;
        v4u kv = (v4u){0u, 0u, 0u, 0u}, vv = (v4u){0u, 0u, 0u, 0u};
        if (kk < 256 && u >= 0) { const size_t off = (tokb + (size_t)u * d) * 512 + ch * 8; kv = *(const v4u*)(Kg + off); vv = *(const v4u*)(Vg + off); }
        *(v4u*)(Ks + kk * AT_KLD + ch * 8) = kv;
        bf16* vp = Vt + (ch * 8) * AT_VLD + kk;
        vp[0 * AT_VLD] = (bf16)(vv.x & 0xffffu); vp[1 * AT_VLD] = (bf16)(vv.x >> 16); vp[2 * AT_VLD] = (bf16)(vv.y & 0xffffu); vp[3 * AT_VLD] = (bf16)(vv.y >> 16);
        vp[4 * AT_VLD] = (bf16)(vv.z & 0xffffu); vp[5 * AT_VLD] = (bf16)(vv.z >> 16); vp[6 * AT_VLD] = (bf16)(vv.w & 0xffffu); vp[7 * AT_VLD] = (bf16)(vv.w >> 16); }
    __syncthreads();
    const int fr = lane & 15, fq = lane >> 4;
    f32x4 s[1][10];
#pragma unroll
    for (int j = 0; j < 10; ++j) s[0][j] = (f32x4){0.f, 0.f, 0.f, 0.f};
    wave_mma<1, 10>(Qs + 16 * wave * AT_QLD, AT_QLD, Ks + 16 * wave * AT_KLD, AT_KLD, 64, s, fr, fq);
    const int qi = 16 * wave + fr;
    float mx = -1e30f;
#pragma unroll
    for (int j = 0; j < 10; ++j)
#pragma unroll
        for (int e = 0; e < 4; ++e) { const int kk = 16 * wave + 16 * j + 4 * fq + e;
            const bool ok = (kk >= qi) && (kk <= qi + 128) && (nb > 0 || kk >= 128);
            s[0][j][e] = ok ? s[0][j][e] : -1e30f; mx = fmaxf(mx, s[0][j][e]); }
    mx = fmaxf(mx, __shfl_xor(mx, 16)); mx = fmaxf(mx, __shfl_xor(mx, 32));
    float l = 0.f;
#pragma unroll
    for (int j = 0; j < 10; ++j) { f32x4 p;
#pragma unroll
        for (int e = 0; e < 4; ++e) { p[e] = exp2f(s[0][j][e] - mx); l += p[e]; }
        *(v2u*)(Ps + fr * AT_PLD + 16 * j + 4 * fq) = (v2u){pk2(p[0], p[1]), pk2(p[2], p[3])}; }
    l += __shfl_xor(l, 16); l += __shfl_xor(l, 32);
    __syncthreads();
    f32x4 o[1][4];
#pragma unroll
    for (int j = 0; j < 4; ++j) o[0][j] = (f32x4){0.f, 0.f, 0.f, 0.f};
    wave_mma<1, 4>(Ps, AT_PLD, Vt + 16 * wave, AT_VLD, 160, o, fr, fq);
    const float rl = 1.0f / l;
    const size_t tok = tokb + (size_t)(128 * nb + qi) * d;
    bf16* og = (bf16*)((unsigned char*)A.out + DO_OATT) + ((size_t)cfg * T + tok) * 512 + h * 64;
#pragma unroll
    for (int j = 0; j < 4; ++j) *(v2u*)(og + 16 * j + 4 * fq) = (v2u){pk2(o[0][j][0] * rl, o[0][j][1] * rl), pk2(o[0][j][2] * rl, o[0][j][3] * rl)};
    if (fq == 0) ((float*)(ws + WS_LSE))[((size_t)cfg * T + tok) * 8 + h] = mx + log2f(l);
    __syncthreads();
}

constexpr int ML_LD = 136;
constexpr int ML_A = 0, ML_W = ML_A + 128 * ML_LD * 2, ML_KT = ML_W + 128 * ML_LD * 2, ML_VT = ML_KT + 128 * ML_LD * 2, ML_G = ML_VT + 128 * ML_LD * 2, ML_END = ML_G + 4096;
static_assert(ML_END <= LDS_MISC, "mlstm LDS");
__device__ __forceinline__ float log_sigmoidf_(float x) { return (x > 0.f) ? -log1pf(__expf(-x)) : (x - log1pf(__expf(x))); }

__device__ __forceinline__ float scan128_sum(const float* in, float* out, int lane) {
    const float v0 = in[2 * lane], v1 = in[2 * lane + 1]; float x = v0 + v1;
#pragma unroll
    for (int off = 1; off < 64; off <<= 1) { const float t = __shfl_up(x, off); if (lane >= off) x += t; }
    out[2 * lane] = x - v1; out[2 * lane + 1] = x;
    return __shfl(x, 63);
}
__device__ __forceinline__ void scan128_max(const float* in, float* out, int lane) {
    const float v0 = in[2 * lane], v1 = in[2 * lane + 1]; float x = fmaxf(v0, v1);
    float pre = -INFINITY;
    float y = x;
#pragma unroll
    for (int off = 1; off < 64; off <<= 1) { const float t = __shfl_up(y, off); if (lane >= off) y = fmaxf(y, t); }
    pre = __shfl_up(y, 1); if (lane == 0) pre = -INFINITY;
    out[2 * lane] = fmaxf(pre, v0); out[2 * lane + 1] = fmaxf(pre, x);
}

__device__ __forceinline__ void mlstm1_item(const Args& A, unsigned char* lds, int item, int tid, int lane, int wave) {
    unsigned char* ws = A.ws;
    const float* conv_w = (const float*)(ws + WS_PAR) + PAR_CONVW; const float* conv_b = (const float*)(ws + WS_PAR) + PAR_CONVB;
    const int bh = item >> 6, c = item & 63, b = bh >> 2, h = bh & 3;
    const size_t t0 = (size_t)b * SEQ + 128 * c;
    bf16* cA = (bf16*)(lds + ML_A); bf16* Wl = (bf16*)(lds + ML_W); bf16* kT = (bf16*)(lds + ML_KT); bf16* vT = (bf16*)(lds + ML_VT);
    float* gl = (float*)(lds + ML_G);
    const bf16* MU = (const bf16*)(ws + WS_MU) + h * 128; const bf16* MV = (const bf16*)(ws + WS_MV) + h * 128;
    bf16* Cg = (bf16*)((unsigned char*)A.out + DO_C) + h * 128;
    if (tid < 128) { const size_t gi = (size_t)bh * SEQ + 128 * c + tid; gl[128 + tid] = ((const float*)(ws + WS_IG))[gi]; gl[tid] = log_sigmoidf_(((const float*)(ws + WS_FG))[gi]); }
    for (int id = tid; id < 128 * 16; id += NTHR) { const int l = id >> 4, ch = (id & 15) * 8;
        float a[8];
        { const f32x4 b0 = *(const f32x4*)(conv_b + h * 128 + ch), b1 = *(const f32x4*)(conv_b + h * 128 + ch + 4);
          a[0] = b0[0]; a[1] = b0[1]; a[2] = b0[2]; a[3] = b0[3]; a[4] = b1[0]; a[5] = b1[1]; a[6] = b1[2]; a[7] = b1[3]; }
#pragma unroll
        for (int j = 0; j < 4; ++j) { const int sp = 128 * c + l + j - 3;
            if (sp >= 0) { const v4u m = *(const v4u*)(MU + ((size_t)b * SEQ + sp) * 512 + ch);
                const f32x4 w0 = *(const f32x4*)(conv_w + j * 512 + h * 128 + ch), w1 = *(const f32x4*)(conv_w + j * 512 + h * 128 + ch + 4);
                a[0] += bflo(m.x) * w0[0]; a[1] += bfhi(m.x) * w0[1]; a[2] += bflo(m.y) * w0[2]; a[3] += bfhi(m.y) * w0[3];
                a[4] += bflo(m.z) * w1[0]; a[5] += bfhi(m.z) * w1[1]; a[6] += bflo(m.w) * w1[2]; a[7] += bfhi(m.w) * w1[3]; } }
#pragma unroll
        for (int i = 0; i < 8; ++i) a[i] = a[i] * sigmoidf_(a[i]);
        const v4u o = (v4u){pk2(a[0], a[1]), pk2(a[2], a[3]), pk2(a[4], a[5]), pk2(a[6], a[7])};
        *(v4u*)(cA + l * ML_LD + ch) = o; *(v4u*)(Cg + (t0 + l) * 512 + ch) = o; }
    const bf16* Wq = (const bf16*)(ws + WS_WM) + (size_t)h * 128 * 128; const bf16* Wk = Wq + 4 * 128 * 128;
    for (int id = tid; id < 128 * 16; id += NTHR) { const int row = id >> 4, ch = (id & 15) * 8;
        *(v4u*)(Wl + row * ML_LD + ch) = *(const v4u*)(Wq + row * 128 + ch);
        const v4u vv = *(const v4u*)(MV + (t0 + row) * 512 + ch); bf16* vp = vT + ch * ML_LD + row;
        vp[0 * ML_LD] = (bf16)(vv.x & 0xffffu); vp[1 * ML_LD] = (bf16)(vv.x >> 16); vp[2 * ML_LD] = (bf16)(vv.y & 0xffffu); vp[3 * ML_LD] = (bf16)(vv.y >> 16);
        vp[4 * ML_LD] = (bf16)(vv.z & 0xffffu); vp[5 * ML_LD] = (bf16)(vv.z >> 16); vp[6 * ML_LD] = (bf16)(vv.w & 0xffffu); vp[7 * ML_LD] = (bf16)(vv.w >> 16); }
    __syncthreads();
    if (wave == 0) {
        const float blast = scan128_sum(gl, gl, lane);
        const float g0 = blast - gl[2 * lane] + gl[128 + 2 * lane], g1 = blast - gl[2 * lane + 1] + gl[128 + 2 * lane + 1];
        const float mloc = wave_max(fmaxf(g0, g1));
        gl[256 + 2 * lane] = __expf(g0 - mloc); gl[256 + 2 * lane + 1] = __expf(g1 - mloc);
        if (lane == 0) { ((float*)(ws + WS_MLOC))[item] = mloc; ((float*)(ws + WS_BLAST))[item] = blast; }
    }
    __syncthreads();
    const int fr = lane & 15, fq = lane >> 4, l = 16 * wave + fr;
    { f32x4 acc[1][8];
#pragma unroll
      for (int j = 0; j < 8; ++j) acc[0][j] = (f32x4){0.f, 0.f, 0.f, 0.f};
      wave_mma<1, 8>(cA + 16 * wave * ML_LD, ML_LD, Wl, ML_LD, 128, acc, fr, fq);
      bf16* qg = (bf16*)(ws + WS_MQ) + (t0 + l) * 512 + h * 128;
#pragma unroll
      for (int j = 0; j < 8; ++j) *(v2u*)(qg + 16 * j + 4 * fq) = (v2u){pk2(acc[0][j][0], acc[0][j][1]), pk2(acc[0][j][2], acc[0][j][3])}; }
    __syncthreads();
    for (int id = tid; id < 128 * 16; id += NTHR) { const int row = id >> 4, ch = (id & 15) * 8; *(v4u*)(Wl + row * ML_LD + ch) = *(const v4u*)(Wk + row * 128 + ch); }
    __syncthreads();
    { f32x4 acc[1][8];
#pragma unroll
      for (int j = 0; j < 8; ++j) acc[0][j] = (f32x4){0.f, 0.f, 0.f, 0.f};
      wave_mma<1, 8>(cA + 16 * wave * ML_LD, ML_LD, Wl, ML_LD, 128, acc, fr, fq);
      bf16* kg = (bf16*)(ws + WS_MK) + (t0 + l) * 512 + h * 128; const float wk = gl[256 + l];
#pragma unroll
      for (int j = 0; j < 8; ++j) { *(v2u*)(kg + 16 * j + 4 * fq) = (v2u){pk2(acc[0][j][0], acc[0][j][1]), pk2(acc[0][j][2], acc[0][j][3])};
#pragma unroll
          for (int e = 0; e < 4; ++e) kT[(16 * j + 4 * fq + e) * ML_LD + l] = (bf16)f2bf(acc[0][j][e] * wk); } }
    __syncthreads();
    { f32x4 acc[1][8];
#pragma unroll
      for (int j = 0; j < 8; ++j) acc[0][j] = (f32x4){0.f, 0.f, 0.f, 0.f};
      wave_mma<1, 8>(vT + 16 * wave * ML_LD, ML_LD, kT, ML_LD, 128, acc, fr, fq);
      float* cg = (float*)(ws + WS_CLOC) + ((size_t)item * 128 + l) * 128;
#pragma unroll
      for (int j = 0; j < 8; ++j) *(f32x4*)(cg + 16 * j + 4 * fq) = acc[0][j]; }
    if (tid < 128) { float s = 0.f; const bf16* kr = kT + tid * ML_LD;
        for (int i = 0; i < 128; i += 8) { const v4u w = *(const v4u*)(kr + i); s += (bflo(w.x) + bfhi(w.x)) + (bflo(w.y) + bfhi(w.y)) + (bflo(w.z) + bfhi(w.z)) + (bflo(w.w) + bfhi(w.w)); }
        ((float*)(ws + WS_NLOC))[(size_t)item * 128 + tid] = s; }
    __syncthreads();
}

__device__ __forceinline__ void p3_scan_combine(const Args& A, int tid) {
    unsigned char* ws = A.ws;
    const int G = gridDim.x, NGT = G * NTHR;
    for (int gid = blockIdx.x * NTHR + tid; gid < 32 * 4096; gid += NGT) {
        const int bh = gid >> 12, rem = gid & 4095, e = rem >> 5, dq = rem & 31;
        const float* MLOC = (const float*)(ws + WS_MLOC) + bh * 64; const float* BL = (const float*)(ws + WS_BLAST) + bh * 64;
        f32x4 C = (f32x4){0.f, 0.f, 0.f, 0.f}, n = (f32x4){0.f, 0.f, 0.f, 0.f}; float m = 0.f;
        for (int c = 0; c < 64; ++c) {
            const size_t idx = (size_t)bh * 64 + c;
            const f32x4 Cl = *(const f32x4*)((const float*)(ws + WS_CLOC) + (idx * 128 + e) * 128 + 4 * dq);
            *(v2u*)((bf16*)(ws + WS_CPREV) + (idx * 128 + e) * 128 + 4 * dq) = (v2u){pk2(C[0], C[1]), pk2(C[2], C[3])};
            const float ml = MLOC[c], bl = BL[c];
            const float mnew = fmaxf(bl + m, ml), a = __expf(bl + m - mnew), cc = __expf(ml - mnew);
            if (e == 0) { *(f32x4*)((float*)(ws + WS_NPREV) + idx * 128 + 4 * dq) = n;
                const f32x4 nl = *(const f32x4*)((const float*)(ws + WS_NLOC) + idx * 128 + 4 * dq); n = n * a + nl * cc;
                if (dq == 0) ((float*)(ws + WS_MPREV))[idx] = m; }
            C = C * a + Cl * cc; m = mnew;
        }
    }
    const bf16* OA = (const bf16*)((const unsigned char*)A.out + DO_OATT); const float* LSE = (const float*)(ws + WS_LSE);
    for (size_t id = (size_t)blockIdx.x * NTHR + tid; id < (size_t)T * 64; id += NGT) {
        const size_t t = id >> 6; const int h = (int)(id & 63) >> 3, ch = (int)(id & 7) * 8;
        const float l0 = LSE[t * 8 + h], l1 = LSE[((size_t)T + t) * 8 + h], l2 = LSE[((size_t)2 * T + t) * 8 + h];
        const float mx = fmaxf(l0, fmaxf(l1, l2)); float w0 = exp2f(l0 - mx), w1 = exp2f(l1 - mx), w2 = exp2f(l2 - mx);
        const float rs = 1.0f / (w0 + w1 + w2); w0 *= rs; w1 *= rs; w2 *= rs;
        const v4u a = *(const v4u*)(OA + t * 512 + h * 64 + ch), b = *(const v4u*)(OA + ((size_t)T + t) * 512 + h * 64 + ch), c = *(const v4u*)(OA + ((size_t)2 * T + t) * 512 + h * 64 + ch);
        v4u o;
        o.x = pk2(w0 * bflo(a.x) + w1 * bflo(b.x) + w2 * bflo(c.x), w0 * bfhi(a.x) + w1 * bfhi(b.x) + w2 * bfhi(c.x));
        o.y = pk2(w0 * bflo(a.y) + w1 * bflo(b.y) + w2 * bflo(c.y), w0 * bfhi(a.y) + w1 * bfhi(b.y) + w2 * bfhi(c.y));
        o.z = pk2(w0 * bflo(a.z) + w1 * bflo(b.z) + w2 * bflo(c.z), w0 * bfhi(a.z) + w1 * bfhi(b.z) + w2 * bfhi(c.z));
        o.w = pk2(w0 * bflo(a.w) + w1 * bflo(b.w) + w2 * bflo(c.w), w0 * bfhi(a.w) + w1 * bfhi(b.w) + w2 * bfhi(c.w));
        *(v4u*)((bf16*)(ws + WS_Y) + t * 1024 + h * 64 + ch) = o;
    }
}

__device__ __forceinline__ void mlstm2_item(const Args& A, unsigned char* lds, int item, int tid, int lane, int wave) {
    unsigned char* ws = A.ws;
    const float* g_mhn = (const float*)(ws + WS_PAR) + PAR_GMHN; const float* skip_m = (const float*)(ws + WS_PAR) + PAR_SKIP;
    const int bh = item >> 6, c = item & 63, b = bh >> 2, h = bh & 3;
    const size_t t0 = (size_t)b * SEQ + 128 * c;
    bf16* qA = (bf16*)(lds + ML_A); bf16* kA = (bf16*)(lds + ML_W); bf16* vT = (bf16*)(lds + ML_KT); bf16* CpT = (bf16*)(lds + ML_VT);
    float* gl = (float*)(lds + ML_G);
    const bf16* MQ = (const bf16*)(ws + WS_MQ) + h * 128; const bf16* MK = (const bf16*)(ws + WS_MK) + h * 128; const bf16* MV = (const bf16*)(ws + WS_MV) + h * 128;
    const bf16* CP = (const bf16*)(ws + WS_CPREV) + (size_t)item * 128 * 128;
    if (tid < 128) { const size_t gi = (size_t)bh * SEQ + 128 * c + tid; gl[896 + tid] = ((const float*)(ws + WS_IG))[gi]; gl[tid] = log_sigmoidf_(((const float*)(ws + WS_FG))[gi]);
        gl[640 + tid] = ((const float*)(ws + WS_NPREV))[(size_t)item * 128 + tid]; }
    for (int id = tid; id < 128 * 16; id += NTHR) { const int row = id >> 4, ch = (id & 15) * 8;
        *(v4u*)(qA + row * ML_LD + ch) = *(const v4u*)(MQ + (t0 + row) * 512 + ch);
        *(v4u*)(kA + row * ML_LD + ch) = *(const v4u*)(MK + (t0 + row) * 512 + ch);
        *(v4u*)(CpT + row * ML_LD + ch) = *(const v4u*)(CP + row * 128 + ch);
        const v4u vv = *(const v4u*)(MV + (t0 + row) * 512 + ch); bf16* vp = vT + ch * ML_LD + row;
        vp[0 * ML_LD] = (bf16)(vv.x & 0xffffu); vp[1 * ML_LD] = (bf16)(vv.x >> 16); vp[2 * ML_LD] = (bf16)(vv.y & 0xffffu); vp[3 * ML_LD] = (bf16)(vv.y >> 16);
        vp[4 * ML_LD] = (bf16)(vv.z & 0xffffu); vp[5 * ML_LD] = (bf16)(vv.z >> 16); vp[6 * ML_LD] = (bf16)(vv.w & 0xffffu); vp[7 * ML_LD] = (bf16)(vv.w >> 16); }
    __syncthreads();
    if (wave == 0) {
        const float mprev = ((const float*)(ws + WS_MPREV))[item];
        (void)scan128_sum(gl, gl, lane);
        gl[128 + 2 * lane] = gl[896 + 2 * lane] - gl[2 * lane]; gl[128 + 2 * lane + 1] = gl[896 + 2 * lane + 1] - gl[2 * lane + 1];
        scan128_max(gl + 128, gl + 896, lane);
#pragma unroll
        for (int q = 0; q < 2; ++q) { const int i = 2 * lane + q; const float bb = gl[i];
            const float mintra = bb + gl[896 + i], minter = bb + mprev, mt = fmaxf(minter, mintra);
            gl[256 + i] = bb - mt; gl[384 + i] = __expf(minter - mt); gl[512 + i] = __expf(-mt); }
    } else if (wave >= 4) {
        const int row = tid - 256;
        if (row < 128) { float s = 0.f; const bf16* qr = qA + row * ML_LD;
            for (int i = 0; i < 128; i += 8) { const v4u w = *(const v4u*)(qr + i); const float* np = gl + 640 + i;
                s += bflo(w.x) * np[0] + bfhi(w.x) * np[1] + bflo(w.y) * np[2] + bfhi(w.y) * np[3] + bflo(w.z) * np[4] + bfhi(w.z) * np[5] + bflo(w.w) * np[6] + bfhi(w.w) * np[7]; }
            gl[768 + row] = s; }
    }
    __syncthreads();
    const int fr = lane & 15, fq = lane >> 4, l = 16 * wave + fr;
    float den;
    v2u sp[8];
    { f32x4 acc[1][8];
#pragma unroll
      for (int j = 0; j < 8; ++j) acc[0][j] = (f32x4){0.f, 0.f, 0.f, 0.f};
      wave_mma<1, 8>(qA + 16 * wave * ML_LD, ML_LD, kA, ML_LD, 128, acc, fr, fq);
      const float rc = gl[256 + l]; float ds = 0.f;
#pragma unroll
      for (int j = 0; j < 8; ++j) { float p[4];
#pragma unroll
          for (int e = 0; e < 4; ++e) { const int s = 16 * j + 4 * fq + e; p[e] = (s <= l) ? acc[0][j][e] * __expf(rc + gl[128 + s]) : 0.f; ds += p[e]; }
          sp[j] = (v2u){pk2(p[0], p[1]), pk2(p[2], p[3])}; }
      ds += __shfl_xor(ds, 16); ds += __shfl_xor(ds, 32); den = ds; }
    __syncthreads();
#pragma unroll
    for (int j = 0; j < 8; ++j) *(v2u*)(kA + l * ML_LD + 16 * j + 4 * fq) = sp[j];
    __syncthreads();
    f32x4 acc[1][8];
#pragma unroll
    for (int j = 0; j < 8; ++j) acc[0][j] = (f32x4){0.f, 0.f, 0.f, 0.f};
    wave_mma<1, 8>(qA + 16 * wave * ML_LD, ML_LD, CpT, ML_LD, 128, acc, fr, fq);
    const float iw = gl[384 + l];
#pragma unroll
    for (int j = 0; j < 8; ++j) acc[0][j] = acc[0][j] * iw;
    wave_mma<1, 8>(kA + 16 * wave * ML_LD, ML_LD, vT, ML_LD, 128, acc, fr, fq);
    den += iw * gl[768 + l];
    const float rden = 1.0f / fmaxf(fabsf(den), gl[512 + l]);
    float sq = 0.f;
#pragma unroll
    for (int j = 0; j < 8; ++j) { acc[0][j] = acc[0][j] * rden; sq += (acc[0][j][0] * acc[0][j][0] + acc[0][j][1] * acc[0][j][1]) + (acc[0][j][2] * acc[0][j][2] + acc[0][j][3] * acc[0][j][3]); }
    sq += __shfl_xor(sq, 16); sq += __shfl_xor(sq, 32);
    const float rn = 1.0f / sqrtf(sq * (1.0f / 128.0f) + EPSN);
    const bf16* MOg = (const bf16*)(ws + WS_MO) + (t0 + l) * 512 + h * 128; const bf16* Cg = (const bf16*)((const unsigned char*)A.out + DO_C) + (t0 + l) * 512 + h * 128;
    bf16* yg = (bf16*)(ws + WS_Y) + (t0 + l) * 1024 + 512 + h * 128;
#pragma unroll
    for (int j = 0; j < 8; ++j) { const int e0 = 16 * j + 4 * fq;
        const v2u mo = *(const v2u*)(MOg + e0), cc = *(const v2u*)(Cg + e0);
        const f32x4 gm = *(const f32x4*)(g_mhn + h * 128 + e0), sk = *(const f32x4*)(skip_m + h * 128 + e0);
        const float y0 = sigmoidf_(bflo(mo.x)) * (acc[0][j][0] * rn * gm[0] + sk[0] * bflo(cc.x));
        const float y1 = sigmoidf_(bfhi(mo.x)) * (acc[0][j][1] * rn * gm[1] + sk[1] * bfhi(cc.x));
        const float y2 = sigmoidf_(bflo(mo.y)) * (acc[0][j][2] * rn * gm[2] + sk[2] * bflo(cc.y));
        const float y3 = sigmoidf_(bfhi(mo.y)) * (acc[0][j][3] * rn * gm[3] + sk[3] * bfhi(cc.y));
        *(v2u*)(yg + e0) = (v2u){pk2(y0, y1), pk2(y2, y3)}; }
    __syncthreads();
}

struct EpiOutProj {
    static constexpr bool PERM = false, AFTER_DRAIN = false;
    const float* x; float* x1; bf16* x1b; float* ss;
    __device__ __forceinline__ void operator()(const f32x4 (&acc)[2][2][4][2], const pg8::Unit& u, int wr, int wc, int fr, int fq) const {
        const int row0 = u.pm * 256 + wr * 64 + fr, col0 = u.pn * 256 + wc * 32 + 4 * fq;
#pragma unroll
        for (int ai = 0; ai < 2; ++ai)
#pragma unroll
            for (int m = 0; m < 4; ++m) { const int row = row0 + ai * 128 + m * 16; float sq = 0.f;
#pragma unroll
                for (int bj = 0; bj < 2; ++bj)
#pragma unroll
                    for (int n = 0; n < 2; ++n) { const size_t off = (size_t)row * D + col0 + bj * 128 + n * 16;
                        const f32x4 o = *(const f32x4*)(x + off) + acc[ai][bj][m][n];
                        *(f32x4*)(x1 + off) = o; *(v2u*)(x1b + off) = (v2u){pk2(o[0], o[1]), pk2(o[2], o[3])};
                        sq += (o[0] * o[0] + o[1] * o[1]) + (o[2] * o[2] + o[3] * o[3]); }
                sq += __shfl_xor(sq, 16); sq += __shfl_xor(sq, 32);
                if (fq == 0) ss[(size_t)row * 16 + u.pn * 4 + wc] = sq; }
    }
};
struct EpiQx {
    static constexpr bool PERM = true, AFTER_DRAIN = false;
    bf16* qx; const LAS float* rs;
    __device__ __forceinline__ void operator()(const f32x4 (&acc)[2][2][4][2], const pg8::Unit& u, int wr, int wc, int fr, int fq) const {
        const int rl0 = wr * 64 + fr, col0 = wc * 32 + 8 * fq;
#pragma unroll
        for (int ai = 0; ai < 2; ++ai)
#pragma unroll
            for (int m = 0; m < 4; ++m) { const int rl = rl0 + ai * 128 + m * 16; const float sc = rs[rl]; bf16* rowp = qx + (size_t)(u.pm * 256 + rl) * 256 + col0;
#pragma unroll
                for (int bj = 0; bj < 2; ++bj) *(v4u*)(rowp + bj * 128) = pack8(acc[ai][bj][m][0] * sc, acc[ai][bj][m][1] * sc);
                asm volatile("" ::: "memory"); }
    }
};
struct EpiOx {
    static constexpr bool PERM = false, AFTER_DRAIN = false;
    float* x1;
    __device__ __forceinline__ void operator()(const f32x4 (&acc)[2][2][4][2], const pg8::Unit& u, int wr, int wc, int fr, int fq) const {
        const int row0 = u.pm * 256 + wr * 64 + fr, col0 = u.pn * 256 + wc * 32 + 4 * fq;
#pragma unroll
        for (int ai = 0; ai < 2; ++ai)
#pragma unroll
            for (int m = 0; m < 4; ++m)
#pragma unroll
                for (int bj = 0; bj < 2; ++bj)
#pragma unroll
                    for (int n = 0; n < 2; ++n) { float* p = x1 + (size_t)(row0 + ai * 128 + m * 16) * D + col0 + bj * 128 + n * 16; *(f32x4*)p = *(const f32x4*)p + acc[ai][bj][m][n]; if (bj == 1 && n == 1) asm volatile("" ::: "memory"); }
    }
};
constexpr int CX_QLD = 72, CX_KLD = 72, CX_VLD = 264, CX_PLD = 264;
constexpr int CX_Q = 0, CX_K = CX_Q + 128 * CX_QLD * 2, CX_V = CX_K + 256 * CX_KLD * 2, CX_P = CX_V + 64 * CX_VLD * 2, CX_END = CX_P + 8 * 16 * CX_PLD * 2;
static_assert(CX_END <= LDS_MISC, "cross LDS");
__device__ __forceinline__ void cross_item(const Args& A, unsigned char* lds, int item, int tid, int lane, int wave) {
    unsigned char* ws = A.ws;
    const int rt = item >> 2, h = item & 3; const size_t t0 = (size_t)rt * 128; const int b = (int)(t0 / SEQ);
    bf16* Qs = (bf16*)(lds + CX_Q); bf16* Ks = (bf16*)(lds + CX_K); bf16* Vt = (bf16*)(lds + CX_V); bf16* Ps = (bf16*)(lds + CX_P) + wave * 16 * CX_PLD;
    const bf16* QX = (const bf16*)(ws + WS_QX) + h * 64; const bf16* KV = (const bf16*)(ws + WS_KVX) + (size_t)b * MEMLEN * NKV + h * 64;
    for (int id = tid; id < 128 * 8; id += NTHR) { const int row = id >> 3, ch = id & 7; *(v4u*)(Qs + row * CX_QLD + ch * 8) = *(const v4u*)(QX + (t0 + row) * 256 + ch * 8); }
    for (int id = tid; id < 256 * 8; id += NTHR) { const int kk = id >> 3, ch = id & 7;
        *(v4u*)(Ks + kk * CX_KLD + ch * 8) = *(const v4u*)(KV + (size_t)kk * NKV + ch * 8);
        const v4u vv = *(const v4u*)(KV + (size_t)kk * NKV + 256 + ch * 8); bf16* vp = Vt + (ch * 8) * CX_VLD + kk;
        vp[0 * CX_VLD] = (bf16)(vv.x & 0xffffu); vp[1 * CX_VLD] = (bf16)(vv.x >> 16); vp[2 * CX_VLD] = (bf16)(vv.y & 0xffffu); vp[3 * CX_VLD] = (bf16)(vv.y >> 16);
        vp[4 * CX_VLD] = (bf16)(vv.z & 0xffffu); vp[5 * CX_VLD] = (bf16)(vv.z >> 16); vp[6 * CX_VLD] = (bf16)(vv.w & 0xffffu); vp[7 * CX_VLD] = (bf16)(vv.w >> 16); }
    __syncthreads();
    const int fr = lane & 15, fq = lane >> 4;
    f32x4 s[1][16];
#pragma unroll
    for (int j = 0; j < 16; ++j) s[0][j] = (f32x4){0.f, 0.f, 0.f, 0.f};
    wave_mma<1, 16>(Qs + 16 * wave * CX_QLD, CX_QLD, Ks, CX_KLD, 64, s, fr, fq);
    float mx = -1e30f;
#pragma unroll
    for (int j = 0; j < 16; ++j)
#pragma unroll
        for (int e = 0; e < 4; ++e) mx = fmaxf(mx, s[0][j][e]);
    mx = fmaxf(mx, __shfl_xor(mx, 16)); mx = fmaxf(mx, __shfl_xor(mx, 32));
    float l = 0.f;
#pragma unroll
    for (int j = 0; j < 16; ++j) { f32x4 p;
#pragma unroll
        for (int e = 0; e < 4; ++e) { p[e] = exp2f(s[0][j][e] - mx); l += p[e]; }
        *(v2u*)(Ps + fr * CX_PLD + 16 * j + 4 * fq) = (v2u){pk2(p[0], p[1]), pk2(p[2], p[3])}; }
    l += __shfl_xor(l, 16); l += __shfl_xor(l, 32);
    __syncthreads();
    f32x4 o[1][4];
#pragma unroll
    for (int j = 0; j < 4; ++j) o[0][j] = (f32x4){0.f, 0.f, 0.f, 0.f};
    wave_mma<1, 4>(Ps, CX_PLD, Vt, CX_VLD, 256, o, fr, fq);
    const float rl = 1.0f / l;
    bf16* og = (bf16*)(ws + WS_OX) + (t0 + 16 * wave + fr) * 256 + h * 64;
#pragma unroll
    for (int j = 0; j < 4; ++j) *(v2u*)(og + 16 * j + 4 * fq) = (v2u){pk2(o[0][j][0] * rl, o[0][j][1] * rl), pk2(o[0][j][2] * rl, o[0][j][3] * rl)};
    __syncthreads();
}

struct TokInfo { int bucket; float wa, wb, rstd; };
__device__ __forceinline__ void p7a_route(const Args& A, unsigned char* lds, int tid, int lane, int wave) {
    unsigned char* ws = A.ws;
    const float* b_rg = (const float*)(ws + WS_PAR) + PAR_BRG; const float* b_re = (const float*)(ws + WS_PAR) + PAR_BRE;
    float* WRl = (float*)lds;
    for (int i = tid; i < 20 * 1024 / 4; i += NTHR) ((f32x4*)WRl)[i] = ((const f32x4*)(ws + WS_WR))[i];
    __syncthreads();
    const int G = gridDim.x, gw = blockIdx.x * NWAVES + wave, NGW = G * NWAVES;
    for (int m = gw; m < T; m += NGW) {
        const f32x4* xr = (const f32x4*)(A.out + (size_t)m * D) + lane;
        f32x4 v[4]; float s = 0.f;
#pragma unroll
        for (int j = 0; j < 4; ++j) { v[j] = xr[64 * j]; s += (v[j].x * v[j].x + v[j].y * v[j].y) + (v[j].z * v[j].z + v[j].w * v[j].w); }
        const float rstd = 1.0f / sqrtf(wave_sum(s) * (1.0f / D) + EPSN);
        float gl4[4];
#pragma unroll
        for (int e = 0; e < 4; ++e) { float a = 0.f;
#pragma unroll
            for (int j = 0; j < 4; ++j) { const f32x4 w = *(const f32x4*)(WRl + e * 1024 + 256 * j + 4 * lane); a += (v[j].x * w.x + v[j].y * w.y) + (v[j].z * w.z + v[j].w * w.w); }
            gl4[e] = wave_sum(a) * rstd + b_rg[e]; }
        int g = 0; float gm = gl4[0];
#pragma unroll
        for (int i = 1; i < 4; ++i) if (gl4[i] > gm) { gm = gl4[i]; g = i; }
        g = __builtin_amdgcn_readfirstlane(g);
        float gs = 0.f;
#pragma unroll
        for (int i = 0; i < 4; ++i) gs += __expf(gl4[i] - gm);
        const float gw_ = 1.0f / gs;
        float el[4];
        const float* WRe = WRl + (4 + 4 * g) * 1024;
#pragma unroll
        for (int e = 0; e < 4; ++e) { float a = 0.f;
#pragma unroll
            for (int j = 0; j < 4; ++j) { const f32x4 w = *(const f32x4*)(WRe + e * 1024 + 256 * j + 4 * lane); a += (v[j].x * w.x + v[j].y * w.y) + (v[j].z * w.z + v[j].w * w.w); }
            el[e] = wave_sum(a) * rstd + b_re[g * 4 + e]; }
        int i0 = 0; float v0 = el[0];
#pragma unroll
        for (int i = 1; i < 4; ++i) if (el[i] > v0) { v0 = el[i]; i0 = i; }
        int i1 = -1; float v1 = -INFINITY;
#pragma unroll
        for (int i = 0; i < 4; ++i) if (i != i0 && el[i] > v1) { v1 = el[i]; i1 = i; }
        const float e1 = __expf(v1 - v0); const float w0 = gw_ / (1.0f + e1), w1 = gw_ * e1 / (1.0f + e1);
        const int pa = i0 < i1 ? i0 : i1, pb = i0 < i1 ? i1 : i0;
        const int pidx = (pa == 0) ? (pb - 1) : (pa == 1 ? pb + 1 : 5);
        const int bucket = g * 6 + pidx;
        if (lane == 0) { TokInfo ti; ti.bucket = bucket; ti.wa = (i0 < i1) ? w0 : w1; ti.wb = (i0 < i1) ? w1 : w0; ti.rstd = rstd;
            ((TokInfo*)(ws + WS_TOKINFO))[m] = ti;
            atomicAdd((unsigned*)(ws + WS_CTL) + CW_CNT + bucket, 1u); }
    }
}
__device__ __forceinline__ int bucket_bases(const unsigned* cnt, int* base  ) {
    int acc = 0;
    for (int i = 0; i < NBUCKET; ++i) { base[i] = acc; acc += (int)((cnt[i] + 255u) >> 8) * 256; }
    base[NBUCKET] = acc; return acc;
}
__device__ __forceinline__ void p7b_sort(const Args& A, unsigned char* lds, int tid, int lane, int wave) {
    unsigned char* ws = A.ws;
    int* basel = (int*)lds;
    unsigned* cnt = (unsigned*)(ws + WS_CTL) + CW_CNT; unsigned* fill = (unsigned*)(ws + WS_CTL) + CW_FILL;
    if (tid == 0) { int acc = 0; for (int i = 0; i < NBUCKET; ++i) { const unsigned c = __hip_atomic_load(cnt + i, __ATOMIC_RELAXED, __HIP_MEMORY_SCOPE_AGENT); basel[i] = acc; basel[32 + i] = (int)c; acc += (int)((c + 255u) >> 8) * 256; } basel[NBUCKET] = acc; }
    __syncthreads();
    const int G = gridDim.x, gw = blockIdx.x * NWAVES + wave, NGW = G * NWAVES;
    int* TOKMAP = (int*)(ws + WS_TOKMAP); float* WSORT = (float*)(ws + WS_WSORT); bf16* HBS = (bf16*)(ws + WS_HBS);
    for (int m = gw; m < T; m += NGW) {
        const TokInfo ti = ((const TokInfo*)(ws + WS_TOKINFO))[m];
        int slot = 0;
        if (lane == 0) slot = basel[ti.bucket] + (int)atomicAdd(fill + ti.bucket, 1u);
        slot = __shfl(slot, 0);
        const f32x4* xr = (const f32x4*)(A.out + (size_t)m * D) + lane;
        unsigned long long* o8 = (unsigned long long*)(HBS + (size_t)slot * D) + lane;
#pragma unroll
        for (int j = 0; j < 4; ++j) { const f32x4 v = xr[64 * j]; o8[64 * j] = (unsigned long long)pk2(v.x * ti.rstd, v.y * ti.rstd) | ((unsigned long long)pk2(v.z * ti.rstd, v.w * ti.rstd) << 32); }
        if (lane == 0) { TOKMAP[slot] = m; WSORT[2 * slot] = ti.wa; WSORT[2 * slot + 1] = ti.wb; }
    }
    for (int bk = 0; bk < NBUCKET; ++bk) { const int lo = basel[bk] + basel[32 + bk], hi = basel[bk + 1];
        for (int r = lo + gw; r < hi; r += NGW) { unsigned long long* o8 = (unsigned long long*)(HBS + (size_t)r * D) + lane;
#pragma unroll
            for (int j = 0; j < 4; ++j) o8[64 * j] = 0ull;
            if (lane == 0) { TOKMAP[r] = -1; WSORT[2 * r] = 0.f; WSORT[2 * r + 1] = 0.f; } } }
}
struct MoeOrder {
    int G, c, nunits, ncol; const int* tab;
    __device__ __forceinline__ bool next(int i, pg8::Unit& u) const {
        const long L = (long)i * G + c; if (L >= nunits) return false;
        const int rt = (int)L / ncol, j = (int)L % ncol, bk = tab[rt];
        u.pm = rt; u.aux = j;
        if (ncol == 8) { const int g = bk / 6, p = bk % 6; const int pa = (p < 3) ? 0 : (p < 5 ? 1 : 2), pb = (p < 3) ? p + 1 : (p < 5 ? p - 1 : 3);
            const int e = 4 * g + ((j >> 2) ? pb : pa); u.pn = e * 4 + (j & 3); }
        else u.pn = bk * 4 + j;
        return true;
    }
    __device__ __forceinline__ void a_ready(const pg8::Unit&) const {}
    __device__ __forceinline__ void done(const pg8::Unit&) const {}
};
struct EpiUp {
    static constexpr bool PERM = true, AFTER_DRAIN = false;
    bf16* act; const float* wsort;
    __device__ __forceinline__ void operator()(const f32x4 (&acc)[2][2][4][2], const pg8::Unit& u, int wr, int wc, int fr, int fq) const {
        const int row0 = u.pm * 256 + wr * 64 + fr, half = u.aux >> 2, col0 = half * 512 + (u.aux & 3) * 128 + wc * 32 + 8 * fq;
#pragma unroll
        for (int ai = 0; ai < 2; ++ai)
#pragma unroll
            for (int m = 0; m < 4; ++m) { const int row = row0 + ai * 128 + m * 16; const float w = wsort[2 * row + half];
                f32x4 r0, r1;
#pragma unroll
                for (int i = 0; i < 4; ++i) { const float a0 = acc[ai][0][m][0][i], a1 = acc[ai][0][m][1][i];
                    r0[i] = a0 * sigmoidf_(a0) * acc[ai][1][m][0][i] * w; r1[i] = a1 * sigmoidf_(a1) * acc[ai][1][m][1][i] * w; }
                *(v4u*)(act + (size_t)row * D + col0) = pack8(r0, r1); }
    }
};
struct EpiDown {
    static constexpr bool PERM = false, AFTER_DRAIN = false;
    float* x2; const int* tokmap;
    __device__ __forceinline__ void operator()(const f32x4 (&acc)[2][2][4][2], const pg8::Unit& u, int wr, int wc, int fr, int fq) const {
        const int row0 = u.pm * 256 + wr * 64 + fr, col0 = u.aux * 256 + wc * 32 + 4 * fq;
#pragma unroll
        for (int ai = 0; ai < 2; ++ai)
#pragma unroll
            for (int m = 0; m < 4; ++m) { const int tok = tokmap[row0 + ai * 128 + m * 16];
                if (tok >= 0) {
#pragma unroll
                    for (int bj = 0; bj < 2; ++bj)
#pragma unroll
                        for (int n = 0; n < 2; ++n) { float* p = x2 + (size_t)tok * D + col0 + bj * 128 + n * 16; const f32x4 o = *(const f32x4*)p + acc[ai][bj][m][n]; *(f32x4*)p = o; } } }
    }
};
__device__ __forceinline__ void p10_final(const Args& A, int lane, int wave) {
    const float* g_final = (const float*)(A.ws + WS_PAR) + PAR_GFIN;
    const int G = gridDim.x, gw = blockIdx.x * NWAVES + wave, NGW = G * NWAVES;
    f32x4 gv[4];
#pragma unroll
    for (int j = 0; j < 4; ++j) gv[j] = *((const f32x4*)g_final + lane + 64 * j);
    for (int m = gw; m < T; m += NGW) {
        f32x4* xr = (f32x4*)(A.out + (size_t)m * D) + lane;
        f32x4 v[4]; float s = 0.f;
#pragma unroll
        for (int j = 0; j < 4; ++j) { v[j] = xr[64 * j]; s += (v[j].x * v[j].x + v[j].y * v[j].y) + (v[j].z * v[j].z + v[j].w * v[j].w); }
        const float rstd = 1.0f / sqrtf(wave_sum(s) * (1.0f / D) + EPSN);
#pragma unroll
        for (int j = 0; j < 4; ++j) xr[64 * j] = v[j] * rstd * gv[j];
    }
}

#ifndef MS
#define MS 4
#endif
#ifndef N_LAUNCHES
#define N_LAUNCHES 1
#endif
constexpr int N_PHASES = 14;
#ifndef QX_SP2
#define QX_SP2 false
#endif

#ifndef NVG
#define NVG 256
#endif
__global__ void __launch_bounds__(NTHR, 2) __attribute__((amdgpu_num_vgpr(NVG))) fwd_kernel(Args args) {
    __shared__ __attribute__((aligned(16))) unsigned char lds[LDS_BYTES];
    const int tid = threadIdx.x, lane = tid & 63, wave = __builtin_amdgcn_readfirstlane(tid >> 6);
    gu32* ctl = (gu32*)(args.ws + WS_CTL);
    for (int u = tid; u < (LDS_BYTES - LDS_MISC) / 4; u += NTHR) ((unsigned*)(lds + LDS_MISC))[u] = 0u;
    __syncthreads();
    const int lo = args.ph_lo, hi = args.ph_hi;
    const bool use_bar = (hi - lo) > 1;
    XcdBarrier bar; bar.bar = (unsigned*)ctl + CW_BAR; bar.x = 0; bar.st = (volatile LAS unsigned*)(lds + LDS_MISC) + 8;
    if (use_bar) bar = xcd_barrier_post((unsigned*)ctl + CW_BAR, (volatile LAS unsigned*)(lds + LDS_MISC) + 8);
#ifndef PH_MASK
#define PH_MASK 0xFFFF
#endif
#define IN(k) (((PH_MASK >> (k)) & 1) && lo <= (k) && (k) < hi)
#define SEAM(k) do { if (IN(k) && IN((k) + 1)) xcd_barrier(bar); } while (0)
    PG8_LAS unsigned char* ring = (PG8_LAS unsigned char*)lds;
    const int G = gridDim.x;
#define PHASE_PTRS Args pa = args; { unsigned char* w_ = args.ws; float* o_ = args.out; asm volatile("" : "+s"(w_), "+s"(o_)); pa.ws = w_; pa.out = o_; } unsigned char* const ws = pa.ws; (void)ws

#ifdef DUMMY_LIVE
    float dl0, dl1, dl2, dl3, dl4, dl5, dl6, dl7; asm volatile("" : "=v"(dl0), "=v"(dl1), "=v"(dl2), "=v"(dl3), "=v"(dl4), "=v"(dl5), "=v"(dl6), "=v"(dl7));
#endif
    if (IN(0)) { PHASE_PTRS; p0_prologue(pa, lds, tid, lane, wave); }
    SEAM(0);
    if (IN(1) && MS >= 1) { PHASE_PTRS;
        pg8::Gemm g{(const pg8::bf16_t*)(ws + WS_XN), (const pg8::bf16_t*)(ws + WS_WIN), T + TMEM, NIN + NKV, D};
        InProjOrder S; S.so.init(T, NIN, G, (int)blockIdx.x);
        EpiInProj E{(bf16*)(ws + WS_Q), (bf16*)(ws + WS_KVX), (const float*)(ws + WS_ROPE)};
        pg8::gemm_phase<EpiInProj, InProjOrder, true, true>(ring, g, S, E);
    }
    SEAM(1);
    if (IN(2) && MS >= 1) { PHASE_PTRS;
        const int n_att = (MS >= 2) ? 3 * 4096 : 0;
        for (int it = blockIdx.x; it < n_att + 2048; it += G) {
            if (it < n_att) attn_item(pa, lds, it, tid, lane, wave); else mlstm1_item(pa, lds, it - n_att, tid, lane, wave);
        }
    }
    SEAM(2);
    if (IN(3) && MS >= 1) { PHASE_PTRS;
        if (MS < 2) {
            for (size_t id = (size_t)blockIdx.x * NTHR + tid; id < (size_t)T * 64; id += (size_t)G * NTHR) { const size_t t = id >> 6; const int c8 = (int)(id & 63) * 8;
                *(v4u*)((bf16*)(ws + WS_Y) + t * 1024 + c8) = (v4u){0u, 0u, 0u, 0u}; }
        }
        p3_scan_combine(pa, tid);
    }
    SEAM(3);
    if (IN(4) && MS >= 1) { PHASE_PTRS; for (int it = blockIdx.x; it < 2048; it += G) mlstm2_item(pa, lds, it, tid, lane, wave); }
    SEAM(4);
    if (IN(5)) { PHASE_PTRS;
        if (MS >= 1) {
            pg8::Gemm g{(const pg8::bf16_t*)(ws + WS_Y), (const pg8::bf16_t*)(ws + WS_WOUT), T, D, D};
            pg8::StaticOrder S; S.init(T, D, G, (int)blockIdx.x);
            EpiOutProj E{(const float*)pa.in[0], pa.out, (bf16*)(ws + WS_X1B), (float*)(ws + WS_SS1)};
            pg8::gemm_phase<EpiOutProj, pg8::StaticOrder, true, true>(ring, g, S, E);
        } else {
            const int gw = blockIdx.x * NWAVES + wave, NGW = G * NWAVES;
            for (int m = gw; m < T; m += NGW) { const f32x4* xr = (const f32x4*)((const float*)pa.in[0] + (size_t)m * D) + lane; f32x4* o = (f32x4*)(pa.out + (size_t)m * D) + lane;
#pragma unroll
                for (int j = 0; j < 4; ++j) o[64 * j] = xr[64 * j]; }
        }
    }
    SEAM(5);
    if (IN(6) && MS >= 3) { PHASE_PTRS;
        pg8::Gemm g{(const pg8::bf16_t*)(ws + WS_X1B), (const pg8::bf16_t*)(ws + WS_WQX), T, 256, D};
        pg8::StaticOrder S; S.init(T, 256, G, (int)blockIdx.x);
        float* rs = (float*)(lds + LDS_RS);
        { pg8::Unit u0; if (S.next(0, u0) && tid < 256) { const f32x4* sp = (const f32x4*)((const float*)(ws + WS_SS1) + (size_t)(u0.pm * 256 + tid) * 16);
              const f32x4 a = sp[0], b = sp[1], c = sp[2], d = sp[3];
              const float s = ((a[0] + a[1]) + (a[2] + a[3])) + ((b[0] + b[1]) + (b[2] + b[3])) + ((c[0] + c[1]) + (c[2] + c[3])) + ((d[0] + d[1]) + (d[2] + d[3]));
              rs[tid] = 1.0f / sqrtf(s * (1.0f / D) + EPSN); } }
        __syncthreads();
        EpiQx E{(bf16*)(ws + WS_QX), (const LAS float*)rs};
        pg8::gemm_phase<EpiQx, pg8::StaticOrder, true, QX_SP2>(ring, g, S, E);
    }
    SEAM(6);
    if (IN(7) && MS >= 3) { PHASE_PTRS; for (int it = blockIdx.x; it < (T / 128) * 4; it += G) cross_item(pa, lds, it, tid, lane, wave); }
    SEAM(7);
    if (IN(8) && MS >= 3) { PHASE_PTRS;
        int kdyn = 256; asm volatile("" : "+s"(kdyn));
        pg8::Gemm g{(const pg8::bf16_t*)(ws + WS_OX), (const pg8::bf16_t*)(ws + WS_WOX), T, D, kdyn};
        pg8::StaticOrder S; S.init(T, D, G, (int)blockIdx.x);
        EpiOx E{pa.out};
        pg8::gemm_phase<EpiOx, pg8::StaticOrder, false, true>(ring, g, S, E);
    }
    SEAM(8);
    if (IN(9) && MS >= 4) { PHASE_PTRS; p7a_route(pa, lds, tid, lane, wave); }
    SEAM(9);
    if (IN(10) && MS >= 4) { PHASE_PTRS; p7b_sort(pa, lds, tid, lane, wave); }
    SEAM(10);
    if ((IN(11) || IN(12)) && MS >= 4) { PHASE_PTRS;
        int* tab = (int*)(lds + LDS_TAB);
        if (tid == 0) { int nrt = 0; const unsigned* cnt = (const unsigned*)(ws + WS_CTL) + CW_CNT;
            for (int i = 0; i < NBUCKET; ++i) { const int nt = (int)((__hip_atomic_load(cnt + i, __ATOMIC_RELAXED, __HIP_MEMORY_SCOPE_AGENT) + 255u) >> 8); for (int k = 0; k < nt; ++k) tab[1 + nrt++] = i; }
            tab[0] = nrt; }
        __syncthreads();
        const int nrt = tab[0];
        if (IN(11)) {
            pg8::Gemm g{(const pg8::bf16_t*)(ws + WS_HBS), (const pg8::bf16_t*)(ws + WS_W13), ROWS_MAX, 64 * 256, D};
            MoeOrder S{G, (int)blockIdx.x, nrt * 8, 8, tab + 1};
            EpiUp E{(bf16*)(ws + WS_ACT), (const float*)(ws + WS_WSORT)};
            pg8::gemm_phase<EpiUp, MoeOrder, true, true>(ring, g, S, E);
        }
        SEAM(11);
        if (IN(12)) {
            pg8::Gemm g{(const pg8::bf16_t*)(ws + WS_ACT), (const pg8::bf16_t*)(ws + WS_W2P), ROWS_MAX, 96 * 256, D};
            MoeOrder S{G, (int)blockIdx.x, nrt * 4, 4, tab + 1};
            EpiDown E{pa.out, (const int*)(ws + WS_TOKMAP)};
            pg8::gemm_phase<EpiDown, MoeOrder, true, true>(ring, g, S, E);
        }
    }
    SEAM(12);
    if (IN(13)) { PHASE_PTRS; p10_final(pa, lane, wave); }
#ifdef DUMMY_LIVE
    asm volatile("" :: "v"(dl0), "v"(dl1), "v"(dl2), "v"(dl3), "v"(dl4), "v"(dl5), "v"(dl6), "v"(dl7));
#endif
#undef IN
#undef SEAM
}

extern "C" void kernel_launch(void* const* d_in, const int* in_sizes, int n_in, void* d_out, int out_size, void* d_ws, size_t ws_size, hipStream_t stream) {
    static int grid = 0;
    if (grid == 0) {
        if (n_in != 28 || out_size != T * D || ws_size < WS_END) { fprintf(stderr, "kernel_launch: unexpected problem (n_in %d, out %d, ws %zu)\n", n_in, out_size, ws_size); grid = -1; return; }
        int dev = 0, cus = 0, per_cu = 0;
        if (hipGetDevice(&dev) != hipSuccess || hipDeviceGetAttribute(&cus, hipDeviceAttributeMultiprocessorCount, dev) != hipSuccess) { grid = -1; return; }
        if (hipOccupancyMaxActiveBlocksPerMultiprocessor(&per_cu, (const void*)fwd_kernel, NTHR, 0) != hipSuccess || per_cu < 1) { fprintf(stderr, "kernel_launch: occupancy query failed (%d)\n", per_cu); per_cu = 1; }
        (void)hipGetLastError();
        grid = cus * (per_cu > 1 ? 1 : per_cu);
        if (grid > 256) grid = 256;
    }
    if (grid < 0) return;
    (void)hipMemsetAsync((char*)d_ws + WS_CTL, 0, CTL_ZERO_BYTES, stream);
    Args a{};
    for (int i = 0; i < 28; ++i) a.in[i] = d_in[i];
    a.out = (float*)d_out; a.ws = (unsigned char*)d_ws;
    if (N_LAUNCHES == 1) {
        a.ph_lo = 0; a.ph_hi = N_PHASES;
        void* kargs[] = {&a};
        hipError_t e = hipLaunchCooperativeKernel((const void*)fwd_kernel, dim3(grid), dim3(NTHR), kargs, 0, stream);
        if (e != hipSuccess) fprintf(stderr, "kernel_launch: cooperative launch failed: %s (grid %d)\n", hipGetErrorString(e), grid);
    } else {
        for (int p = 0; p < N_PHASES; ++p) { a.ph_lo = p; a.ph_hi = p + 1; hipLaunchKernelGGL(fwd_kernel, dim3(grid), dim3(NTHR), 0, stream, a); }
    }
}
```

```cpp
#include <hip/hip_runtime.h>
#include <cstdio>
#include <cstdint>
namespace pg8 {
#define PG8_LAS __attribute__((address_space(3)))
typedef unsigned short bf16_t;
typedef short bf16x8 __attribute__((ext_vector_type(8)));
typedef float f32x4 __attribute__((ext_vector_type(4)));
typedef unsigned u32x4 __attribute__((ext_vector_type(4)));
constexpr int BM = 256, BK = 64, HALF = 128, HTB = HALF * BK * 2  , STAGE_BYTES = 8 * HTB, NXCD = 8, WGM = 8;

__host__ __device__ __forceinline__ int lds_byte(int r, int c) { const int st = (r >> 4) * 2 + (c >> 5), rr = r & 15, cc = c & 31, ob = rr * 64 + cc * 2; return st * 1024 + (ob ^ (((ob >> 9) & 1) << 5)); }
__host__ __device__ __forceinline__ void stage_rc(int b, int& R, int& C) { const int st = b / 1024, sb = b % 1024, swz = sb ^ (((sb >> 9) & 1) << 5); R = (st >> 1) * 16 + swz / 64; C = (st & 1) * 32 + (swz % 64) / 2; }
__host__ __device__ __forceinline__ int perm32(int rho) { const int n = rho >> 4, i = rho & 15; return 8 * (i >> 2) + 4 * n + (i & 3); }

struct Unit { int pm, pn, aux; };
struct Gemm { const bf16_t* A; const bf16_t* Bt; int M, N, K; const int* rowmap; };

struct StaticOrder {
    int nM, nN, nwg, G, c;
    __host__ __device__ void init(int M, int N, int G_, int c_) { nM = M / BM; nN = N / BM; nwg = nM * nN; G = G_; c = c_; }
    __host__ __device__ bool next(int i, Unit& u) const {
        const long L = (long)i * G + c; if (L >= nwg) return false;
        int wgid = (int)L; { const int q = nwg / NXCD, r = nwg % NXCD, xcd = wgid % NXCD, off = wgid / NXCD; wgid = (xcd < r ? xcd * (q + 1) : r * (q + 1) + (xcd - r) * q) + off; }
        const int nig = WGM * nN, gid = wgid / nig, fm = gid * WGM, gsz = (nM - fm) < WGM ? (nM - fm) : WGM;
        u.pm = fm + ((wgid % nig) % gsz); u.pn = (wgid % nig) / gsz; u.aux = 0; return true;
    }
    __device__ __forceinline__ void a_ready(const Unit&) const {}
    __device__ __forceinline__ void done(const Unit&) const {}
};

__device__ __forceinline__ unsigned cvt_pk_bf16(float lo, float hi) { unsigned r; asm volatile("v_cvt_pk_bf16_f32 %0, %1, %2" : "=v"(r) : "v"(lo), "v"(hi)); return r; }
template <class Epi, class Sched, bool ALIGN_EPI = false, bool SP2 = false, bool GATHER = false>
__device__ __forceinline__ void gemm_phase(PG8_LAS unsigned char* lds, const Gemm g, const Sched& S, const Epi& E) {
    const int tid = threadIdx.x, wid = __builtin_amdgcn_readfirstlane(tid >> 6), lane = tid & 63, wr = wid >> 2, wc = wid & 3, fr = lane & 15, fq = lane >> 4;
    const int K = g.K, nt = K / BK;
    unsigned voffA[2], voffB[2];
#pragma unroll
    for (int i = 0; i < 2; ++i) { int R, C; stage_rc(tid * 16 + i * 8192, R, C); const int Rb = Epi::PERM ? ((R & ~31) + perm32(R & 31)) : R;
        voffA[i] = (unsigned)(R * K + C) * 2u; voffB[i] = (unsigned)(Rb * K + C) * 2u; }
    unsigned gc[2][2] = {{0u, 0u}, {0u, 0u}}, gn[2][2] = {{0u, 0u}, {0u, 0u}};
#define PG8_GLOAD(gv, pm_) do { _Pragma("unroll") for (int _h = 0; _h < 2; ++_h) _Pragma("unroll") for (int _i = 0; _i < 2; ++_i) { int _R, _C; stage_rc(tid * 16 + _i * 8192, _R, _C); \
        int _row = g.rowmap[(pm_) * BM + _h * HALF + _R]; _row = _row < 0 ? 0 : _row; gv[_h][_i] = (unsigned)(_row * K + _C) * 2u; } } while (0)
    const size_t kstep = (size_t)(BK * 2);
    const size_t hstep = (size_t)HALF * K * 2;
    const size_t tstep = 2 * hstep;
    const unsigned ldsw = (unsigned)wid * 1024u;
    const int aoff = lds_byte(wr * 64 + fr, fq * 8), boff = lds_byte(wc * 32 + fr, fq * 8);
#define PG8_SA(b, h) (((b) * 2 + (h)) * HTB)
#define PG8_SB(b, h) ((4 + (b) * 2 + (h)) * HTB)
#define PG8_STAGE(bufoff, gbase, voff) do { _Pragma("unroll") for (int _i = 0; _i < 2; ++_i) \
        __builtin_amdgcn_global_load_lds((const unsigned*)((const char*)(gbase) + (voff)[_i]), (PG8_LAS unsigned*)(lds + (bufoff) + ldsw + _i * 8192), 16, 0, 0); } while (0)
#define PG8_STAGE_A(bufoff, gbase, h, sel) do { if constexpr (GATHER) { unsigned vo_[2]; vo_[0] = (sel) ? gn[h][0] : gc[h][0]; vo_[1] = (sel) ? gn[h][1] : gc[h][1]; PG8_STAGE(bufoff, gbase, vo_); } \
        else { PG8_STAGE(bufoff, (gbase) + (h) * hstep, voffA); } } while (0)
#define PG8_LDA(dst, b, h) do { _Pragma("unroll") for (int m = 0; m < 4; ++m) _Pragma("unroll") for (int k = 0; k < 2; ++k) dst[m][k] = *(const PG8_LAS bf16x8*)(lds + PG8_SA(b, h) + aoff + m * 2048 + k * 1024); } while (0)
#define PG8_LDB(dst, b, h) do { _Pragma("unroll") for (int n = 0; n < 2; ++n) _Pragma("unroll") for (int k = 0; k < 2; ++k) dst[n][k] = *(const PG8_LAS bf16x8*)(lds + PG8_SB(b, h) + boff + n * 2048 + k * 1024); } while (0)
#define PG8_MMA(ai, bj, At, Bt) do { __builtin_amdgcn_s_setprio(1); _Pragma("unroll") for (int m = 0; m < 4; ++m) _Pragma("unroll") for (int n = 0; n < 2; ++n) _Pragma("unroll") for (int k = 0; k < 2; ++k) \
        acc[ai][bj][m][n] = __builtin_amdgcn_mfma_f32_16x16x32_bf16(Bt[n][k], At[m][k], acc[ai][bj][m][n], 0, 0, 0); __builtin_amdgcn_s_setprio(0); } while (0)
#define PG8_WAIT_V(n) asm volatile("s_waitcnt vmcnt(" #n ")" ::: "memory")
#define PG8_WAIT_L(n) asm volatile("s_waitcnt lgkmcnt(" #n ")" ::: "memory")
#define PG8_BAR __builtin_amdgcn_s_barrier()
#define PG8_SCHED __builtin_amdgcn_sched_barrier(0)
    Unit cur, nxt; int ui = 0;
    if (!S.next(0, cur)) return;
    f32x4 acc[2][2][4][2];
#pragma unroll
    for (int a = 0; a < 2; ++a)
#pragma unroll
        for (int b = 0; b < 2; ++b)
#pragma unroll
            for (int m = 0; m < 4; ++m)
#pragma unroll
                for (int n = 0; n < 2; ++n) acc[a][b][m][n] = (f32x4){0.f, 0.f, 0.f, 0.f};
    bf16x8 At[4][2], B0[2][2], B1[2][2];
    const char* cA = GATHER ? (const char*)g.A : (const char*)g.A + (size_t)cur.pm * tstep; const char* cB = (const char*)g.Bt + (size_t)cur.pn * tstep;
    if constexpr (GATHER) { PG8_GLOAD(gc, cur.pm); }
    S.a_ready(cur);
    if constexpr (SP2) {
        PG8_STAGE(PG8_SB(0, 0), cB, voffB); PG8_STAGE(PG8_SB(0, 1), cB + hstep, voffB); PG8_STAGE_A(PG8_SA(0, 0), cA, 0, false); PG8_STAGE_A(PG8_SA(0, 1), cA, 1, false);
        if (wr == 1) PG8_BAR;
        PG8_WAIT_V(2); PG8_BAR;
        PG8_STAGE(PG8_SB(1, 0), cB + kstep, voffB); PG8_STAGE_A(PG8_SA(1, 0), cA + kstep, 0, false); PG8_STAGE(PG8_SB(1, 1), cB + hstep + kstep, voffB);
        PG8_WAIT_V(6); PG8_BAR;
    } else {
        PG8_STAGE(PG8_SB(0, 0), cB, voffB); PG8_STAGE_A(PG8_SA(0, 0), cA, 0, false); PG8_STAGE(PG8_SB(0, 1), cB + hstep, voffB); PG8_STAGE_A(PG8_SA(0, 1), cA, 1, false);
        if (wr == 1) PG8_BAR;
        PG8_WAIT_V(4); PG8_BAR;
        PG8_STAGE(PG8_SB(1, 0), cB + kstep, voffB); PG8_STAGE_A(PG8_SA(1, 0), cA + kstep, 0, false); PG8_STAGE(PG8_SB(1, 1), cB + hstep + kstep, voffB);
        PG8_WAIT_V(6); PG8_BAR;
    }
    for (;;) {
        const bool has_next = S.next(ui + 1, nxt);
        const char* nA = GATHER ? cA : (has_next ? (const char*)g.A + (size_t)nxt.pm * tstep : cA);
        if constexpr (GATHER) { if (has_next) { PG8_GLOAD(gn, nxt.pm); } else { gn[0][0] = gc[0][0]; gn[0][1] = gc[0][1]; gn[1][0] = gc[1][0]; gn[1][1] = gc[1][1]; } }
        const char* nB = has_next ? (const char*)g.Bt + (size_t)nxt.pn * tstep : cB;
        for (int t = 0; t < nt; t += 2) {
            const bool last = (t == nt - 2);
            const char* a1 = cA + (size_t)(t + 1) * kstep;
            const char* a2 = last ? nA : cA + (size_t)(t + 2) * kstep; const char* b2 = last ? nB : cB + (size_t)(t + 2) * kstep;
            const char* a3 = a2 + kstep; const char* b3 = b2 + kstep;
            if (last && has_next) S.a_ready(nxt);
            if constexpr (SP2) {
            PG8_LDB(B0, 0, 0); PG8_LDB(B1, 0, 1); PG8_SCHED; PG8_LDA(At, 0, 0); PG8_STAGE_A(PG8_SA(1, 1), a1, 1, false);
            PG8_WAIT_V(8); PG8_WAIT_L(0); PG8_BAR; PG8_MMA(0, 0, At, B0); PG8_MMA(0, 1, At, B1); PG8_BAR; PG8_SCHED;
            PG8_LDA(At, 0, 1); PG8_STAGE(PG8_SB(0, 0), b2, voffB); PG8_STAGE(PG8_SB(0, 1), b2 + hstep, voffB); PG8_STAGE_A(PG8_SA(0, 0), a2, 0, last);
            PG8_WAIT_V(8); PG8_WAIT_L(0); PG8_BAR; PG8_MMA(1, 0, At, B0); PG8_MMA(1, 1, At, B1); PG8_BAR; PG8_SCHED;
            PG8_LDB(B0, 1, 0); PG8_LDB(B1, 1, 1); PG8_SCHED; PG8_LDA(At, 1, 0); PG8_STAGE_A(PG8_SA(0, 1), a2, 1, last);
            PG8_WAIT_V(8); PG8_WAIT_L(0); PG8_BAR; PG8_MMA(0, 0, At, B0); PG8_MMA(0, 1, At, B1); PG8_BAR; PG8_SCHED;
            PG8_LDA(At, 1, 1); PG8_STAGE(PG8_SB(1, 0), b3, voffB); PG8_STAGE(PG8_SB(1, 1), b3 + hstep, voffB); PG8_STAGE_A(PG8_SA(1, 0), a3, 0, last);
            PG8_WAIT_V(8); PG8_WAIT_L(0); PG8_BAR; PG8_MMA(1, 0, At, B0); PG8_MMA(1, 1, At, B1); PG8_BAR; PG8_SCHED;
            } else {
            PG8_LDB(B0, 0, 0); PG8_SCHED; PG8_LDA(At, 0, 0); PG8_STAGE_A(PG8_SA(1, 1), a1, 1, false);
            PG8_WAIT_L(8); PG8_BAR; PG8_WAIT_L(0); PG8_MMA(0, 0, At, B0); PG8_BAR; PG8_SCHED;
            PG8_LDB(B1, 0, 1); PG8_STAGE(PG8_SB(0, 0), b2, voffB);
            PG8_BAR; PG8_WAIT_L(0); PG8_MMA(0, 1, At, B1); PG8_BAR;
            PG8_LDA(At, 0, 1); PG8_STAGE_A(PG8_SA(0, 0), a2, 0, last);
            PG8_BAR; PG8_WAIT_L(0); PG8_MMA(1, 0, At, B0); PG8_BAR; PG8_SCHED;
            PG8_STAGE(PG8_SB(0, 1), b2 + hstep, voffB);
            PG8_WAIT_V(6); PG8_BAR; PG8_MMA(1, 1, At, B1); PG8_BAR;
            PG8_LDB(B0, 1, 0); PG8_SCHED; PG8_LDA(At, 1, 0); PG8_STAGE_A(PG8_SA(0, 1), a2, 1, last);
            PG8_WAIT_L(8); PG8_BAR; PG8_WAIT_L(0); PG8_MMA(0, 0, At, B0); PG8_BAR; PG8_SCHED;
            PG8_LDB(B1, 1, 1); PG8_STAGE(PG8_SB(1, 0), b3, voffB);
            PG8_BAR; PG8_WAIT_L(0); PG8_MMA(0, 1, At, B1); PG8_BAR;
            PG8_LDA(At, 1, 1); PG8_STAGE_A(PG8_SA(1, 0), a3, 0, last);
            PG8_BAR; PG8_WAIT_L(0); PG8_MMA(1, 0, At, B0); PG8_BAR; PG8_SCHED;
            PG8_STAGE(PG8_SB(1, 1), b3 + hstep, voffB);
            PG8_WAIT_V(6); PG8_BAR; PG8_MMA(1, 1, At, B1); PG8_BAR;
            }
        }
        if constexpr (ALIGN_EPI) { if (wr == 0) PG8_BAR; }
        if constexpr (!Epi::AFTER_DRAIN) { E(acc, cur, wr, wc, fr, fq); S.done(cur); }
        if (!has_next) break;
#pragma unroll
        for (int a = 0; a < 2; ++a)
#pragma unroll
            for (int b = 0; b < 2; ++b)
#pragma unroll
                for (int m = 0; m < 4; ++m)
#pragma unroll
                    for (int n = 0; n < 2; ++n) acc[a][b][m][n] = (f32x4){0.f, 0.f, 0.f, 0.f};
        cur = nxt; cA = nA; cB = nB; ++ui;
        if constexpr (GATHER) { gc[0][0] = gn[0][0]; gc[0][1] = gn[0][1]; gc[1][0] = gn[1][0]; gc[1][1] = gn[1][1]; }
        if constexpr (ALIGN_EPI) { if (wr == 1) PG8_BAR; }
    }
    PG8_WAIT_V(0);
    if constexpr (!ALIGN_EPI) { if (wr == 0) PG8_BAR; }
    PG8_BAR;
    if constexpr (Epi::AFTER_DRAIN) { E.fused(acc, cur, wr, wc, fr, fq, lds, wid, lane); S.done(cur); }
#undef PG8_SA
#undef PG8_SB
#undef PG8_STAGE
#undef PG8_STAGE_A
#undef PG8_GLOAD
#undef PG8_LDA
#undef PG8_LDB
#undef PG8_MMA
#undef PG8_WAIT_V
#undef PG8_WAIT_L
#undef PG8_BAR
#undef PG8_SCHED
}
}

#define GAS __attribute__((address_space(1)))
#define LAS __attribute__((address_space(3)))
typedef unsigned short bf16;
typedef unsigned v4u __attribute__((ext_vector_type(4)));
typedef unsigned v2u __attribute__((ext_vector_type(2)));
typedef float f32x4 __attribute__((ext_vector_type(4)));
typedef short bf16x8 __attribute__((ext_vector_type(8)));
typedef GAS unsigned gu32;

constexpr int NWAVES = 8, NTHR = 512;
constexpr int BATCH = 8, SEQ = 8192, T = BATCH * SEQ, D = 1024, MEMLEN = 256, TMEM = BATCH * MEMLEN;
constexpr int INW = 3080, NIN = 3072, NKV = 512;
constexpr int NBUCKET = 24, ROWS_MAX = T + NBUCKET * 256;
constexpr float EPSN = 1e-6f;
constexpr float C2 = 0.125f * 1.4426950408889634f;
constexpr float LOG2E = 1.4426950408889634f;

constexpr size_t MiB = 1u << 20;
constexpr size_t WS_CTL = 0, CTL_ZERO_BYTES = 1 * MiB;
constexpr size_t WS_ROPE = 2 * MiB;
constexpr size_t WS_IG = 6 * MiB;
constexpr size_t WS_FG = 7 * MiB;
constexpr size_t WS_LSE = 8 * MiB;
constexpr size_t WS_SS1 = 14 * MiB;
constexpr size_t WS_SS3 = 18 * MiB;
constexpr size_t WS_KVX = 22 * MiB;
constexpr size_t WS_NLOC = 24 * MiB;
constexpr size_t WS_NPREV = 25 * MiB;
constexpr size_t WS_MLOC = 26 * MiB;
constexpr size_t WS_BLAST = 26 * MiB + 64 * 1024;
constexpr size_t WS_MPREV = 26 * MiB + 128 * 1024;
constexpr size_t WS_TOKINFO = 27 * MiB;
constexpr size_t WS_TOKMAP = 28 * MiB;
constexpr size_t WS_WSORT = 29 * MiB;
constexpr size_t WS_WR = 30 * MiB;
constexpr size_t WS_WG = 30 * MiB + 512 * 1024;
constexpr size_t WS_PAR = 31 * MiB;
constexpr int PAR_CONVW = 0, PAR_CONVB = 2048, PAR_GMHN = 2560, PAR_SKIP = 3072, PAR_BRG = 3584, PAR_BRE = 3600, PAR_GFIN = 3616, PAR_N = 4640;
constexpr size_t WS_WIN = 32 * MiB;
constexpr size_t WS_WOUT = 39 * MiB;
constexpr size_t WS_WQX = 41 * MiB;
constexpr size_t WS_WOX = 41 * MiB + 512 * 1024;
constexpr size_t WS_WM = 42 * MiB;
constexpr size_t WS_W13 = 44 * MiB;
constexpr size_t WS_W2P = 76 * MiB;
constexpr size_t WS_XN = 128 * MiB;
constexpr size_t WS_CLOC = 128 * MiB;
constexpr size_t WS_Q = 264 * MiB;
constexpr size_t WS_K = 328 * MiB, WS_V = 392 * MiB, WS_MU = 456 * MiB, WS_MV = 520 * MiB, WS_MO = 584 * MiB;
constexpr size_t WS_MQ = 648 * MiB, WS_MK = 712 * MiB;
constexpr size_t WS_Y = 264 * MiB;
constexpr size_t WS_CPREV = 392 * MiB;
constexpr size_t WS_X1B = 648 * MiB;
constexpr size_t WS_QX = 776 * MiB;
constexpr size_t WS_OX = 808 * MiB;
constexpr size_t WS_HBS = 264 * MiB;
constexpr size_t WS_ACT = 404 * MiB;
constexpr size_t WS_END = 840 * MiB;
constexpr size_t DO_OATT = 0, DO_C = 192 * MiB;

constexpr int CW_BAR = 4096;
constexpr int CW_CNT = 8192;
constexpr int CW_FILL = 8192 + 64;

constexpr int LDS_BYTES = 163840;
constexpr int LDS_MISC = 159744;
constexpr int LDS_RS = 135168;
constexpr int LDS_TAB = 136192;

#define LDS_WAIT() asm volatile("s_waitcnt lgkmcnt(0)" ::: "memory")
#define VM_WAIT() asm volatile("s_waitcnt vmcnt(0)" ::: "memory")
__device__ __forceinline__ unsigned f2bf(float f) { unsigned u = __builtin_bit_cast(unsigned, f); return (u + 0x7fffu + ((u >> 16) & 1u)) >> 16; }
__device__ __forceinline__ unsigned pk2(float lo, float hi) { return f2bf(lo) | (f2bf(hi) << 16); }
__device__ __forceinline__ float bf2f(unsigned h) { return __uint_as_float(h << 16); }
__device__ __forceinline__ float bflo(unsigned w) { return __uint_as_float(w << 16); }
__device__ __forceinline__ float bfhi(unsigned w) { return __uint_as_float(w & 0xffff0000u); }
__device__ __forceinline__ float wave_sum(float v) {
#pragma unroll
    for (int o = 1; o < 64; o <<= 1) v += __shfl_xor(v, o);
    return v;
}
__device__ __forceinline__ float wave_max(float v) {
#pragma unroll
    for (int o = 1; o < 64; o <<= 1) v = fmaxf(v, __shfl_xor(v, o));
    return v;
}
__device__ __forceinline__ float sigmoidf_(float x) { return 1.0f / (1.0f + __expf(-x)); }

#define XB_TMO      128
#define XB_XCNT(j)  (256  + 64 * (j))
#define XB_XSUB(j)  (1280 + 64 * (j))
#define XB_XGEN(j)  (2304 + 64 * (j))
#define XB_TOP      3328
#define XB_TOPGEN   3392
#define XCD_BAR_WORDS 3456
#define XB_SPIN_CAP (1u << 22)
__device__ __forceinline__ unsigned xb_ld(unsigned* p)              { return __hip_atomic_load(p, __ATOMIC_RELAXED, __HIP_MEMORY_SCOPE_AGENT); }
__device__ __forceinline__ unsigned xb_add(unsigned* p, unsigned v) { return __hip_atomic_fetch_add(p, v, __ATOMIC_RELAXED, __HIP_MEMORY_SCOPE_AGENT); }
__device__ __forceinline__ unsigned xb_xcc_id() { return (unsigned)__builtin_amdgcn_s_getreg((3 << 11) | 20) & 0xFu; }
#define XB_SPIN(cond, bar) do { unsigned _sp = 0; while (cond) { __builtin_amdgcn_s_sleep(1); \
    if ((++_sp & 255u) == 0u) { if (xb_ld(&(bar)[XB_TMO])) break; if (_sp > XB_SPIN_CAP) { atomicAdd(&(bar)[XB_TMO], 1u); break; } } } } while (0)
struct XcdBarrier { unsigned* bar; unsigned x; volatile LAS unsigned* st; };
__device__ __forceinline__ XcdBarrier xcd_barrier_post(unsigned* bar, volatile LAS unsigned* st) {
    XcdBarrier b; b.bar = bar; b.x = xb_xcc_id(); b.st = st;
    if (threadIdx.x == 0) (void)xb_add(&bar[XB_XCNT(b.x)], 1u);
    return b;
}
__device__ __forceinline__ void xcd_barrier_complete(unsigned* bar, unsigned x, unsigned& nloc, unsigned& nx) {
    const unsigned G = gridDim.x * gridDim.y * gridDim.z;
    unsigned sum, cnt, mine, sp = 0u;
    for (;;) {
        sum = 0u; cnt = 0u; mine = 0u;
#pragma unroll
        for (unsigned j = 0; j < 16; ++j) { const unsigned c = xb_ld(&bar[XB_XCNT(j)]); sum += c; cnt += (c > 0u) ? 1u : 0u; mine = (j == x) ? c : mine; }
        if (sum == G) break;
        __builtin_amdgcn_s_sleep(1);
        if ((++sp & 255u) == 0u) { if (xb_ld(&bar[XB_TMO])) break; if (sp > XB_SPIN_CAP) { atomicAdd(&bar[XB_TMO], 1u); break; } }
    }
    nloc = mine > 0u ? mine : 1u; nx = cnt > 0u ? cnt : 1u;
}
__device__ __forceinline__ void xcd_barrier(const XcdBarrier& b) {
    asm volatile("s_waitcnt vmcnt(0)" ::: "memory");
    __syncthreads();
    if (threadIdx.x == 0) {
        unsigned* bar = b.bar;
        __builtin_amdgcn_s_waitcnt(0);
        unsigned nloc = b.st[0], nx = b.st[1];
        if (nloc == 0u) { xcd_barrier_complete(bar, b.x, nloc, nx); b.st[0] = nloc; b.st[1] = nx; }
        const unsigned old = xb_add(&bar[XB_XSUB(b.x)], 1u);
        const unsigned gen = old / nloc;
        if (old + 1u == (gen + 1u) * nloc) {
            __builtin_amdgcn_fence(__ATOMIC_RELEASE, "agent");
            asm volatile("s_waitcnt vmcnt(0)" ::: "memory");
            const unsigned og = xb_add(&bar[XB_TOP], 1u);
            const unsigned tg = og / nx;
            if (og + 1u == (tg + 1u) * nx) xb_add(&bar[XB_TOPGEN], 1u);
            else XB_SPIN(xb_ld(&bar[XB_TOPGEN]) == tg, bar);
            __builtin_amdgcn_fence(__ATOMIC_ACQUIRE, "agent");
            xb_add(&bar[XB_XGEN(b.x)], 1u);
            asm volatile("s_waitcnt vmcnt(0)" ::: "memory");
        } else {
            XB_SPIN(xb_ld(&bar[XB_XGEN(b.x)]) == gen, bar);
            __builtin_amdgcn_fence(__ATOMIC_ACQUIRE, "agent");
            asm volatile("s_waitcnt vmcnt(0)" ::: "memory");
        }
    }
    __syncthreads();
}

struct Args { const void* in[28]; float* out; unsigned char* ws; int ph_lo, ph_hi; };

template <int MI, int NJ>
__device__ __forceinline__ void wave_mma(const bf16* A, int lda, const bf16* Bt, int ldb, int K, f32x4 (&acc)[MI][NJ], int fr, int fq) {
    for (int k0 = 0; k0 < K; k0 += 32) {
        bf16x8 a[MI], b[NJ];
#pragma unroll
        for (int i = 0; i < MI; ++i) a[i] = *(const bf16x8*)(A + (16 * i + fr) * lda + k0 + 8 * fq);
#pragma unroll
        for (int j = 0; j < NJ; ++j) b[j] = *(const bf16x8*)(Bt + (16 * j + fr) * ldb + k0 + 8 * fq);
#pragma unroll
        for (int i = 0; i < MI; ++i)
#pragma unroll
            for (int j = 0; j < NJ; ++j) acc[i][j] = __builtin_amdgcn_mfma_f32_16x16x32_bf16(b[j], a[i], acc[i][j], 0, 0, 0);
    }
}

__device__ __forceinline__ void transpose_item(const float* src, int src_ld, int k0, int n0, bf16* dst, int dst_ld, int dst_row0, int dst_col0,
                                               const float* gain, float scale, float* scr, int lane) {
#pragma unroll 8
    for (int i = 0; i < 32; ++i) { const int kk = 2 * i + (lane >> 5);
        const float gsc = gain ? gain[k0 + kk] * scale : scale;
        scr[kk * 33 + (lane & 31)] = src[(size_t)(k0 + kk) * src_ld + n0 + (lane & 31)] * gsc; }
    LDS_WAIT(); asm volatile("" ::: "memory");
    const int c = lane & 7;
#pragma unroll
    for (int j = 0; j < 4; ++j) { const int n = (lane >> 3) + 8 * j; const float* s = scr + (8 * c) * 33 + n;
        v4u o; o.x = pk2(s[0 * 33], s[1 * 33]); o.y = pk2(s[2 * 33], s[3 * 33]); o.z = pk2(s[4 * 33], s[5 * 33]); o.w = pk2(s[6 * 33], s[7 * 33]);
        *(v4u*)(dst + (size_t)(dst_row0 + n) * dst_ld + dst_col0 + 8 * c) = o; }
    LDS_WAIT(); asm volatile("" ::: "memory");
}

__device__ __forceinline__ void p0_prologue(const Args& A, unsigned char* lds, int tid, int lane, int wave) {
    unsigned char* ws = A.ws;
    const float* x = (const float*)A.in[0]; const float* mem = (const float*)A.in[1]; const int* positions = (const int*)A.in[2];
    const float* g_mix = (const float*)A.in[3]; const float* w_in = (const float*)A.in[4];
    const float* w_q_m = (const float*)A.in[7]; const float* w_k_m = (const float*)A.in[8];
    const float* b_i = (const float*)A.in[9]; const float* b_f = (const float*)A.in[10];
    const float* w_out = (const float*)A.in[13]; const float* g_cross = (const float*)A.in[14]; const float* g_mem = (const float*)A.in[15];
    const float* w_q_x = (const float*)A.in[16]; const float* w_kv_x = (const float*)A.in[17]; const float* w_o_x = (const float*)A.in[18];
    const float* g_ffn = (const float*)A.in[19]; const float* w_rg = (const float*)A.in[20]; const float* w_re = (const float*)A.in[22];
    const float* w1 = (const float*)A.in[24]; const float* w3 = (const float*)A.in[25]; const float* w2 = (const float*)A.in[26];
    const int G = gridDim.x, gw = blockIdx.x * NWAVES + wave, NGW = G * NWAVES, gt = blockIdx.x * NTHR + tid, NGT = G * NTHR;

    float* WGl = (float*)(lds + 131072 - 32768 - 0) ;
    for (int i = tid; i < 8 * 1024; i += NTHR) { const int k = i >> 3, j = i & 7; WGl[j * 1024 + k] = g_mix[k] * w_in[(size_t)k * INW + NIN + j]; }

    float* scr = (float*)(lds + wave * 8704);
    constexpr int I_IN = 16 * 96, I_KV = 16 * 16, I_OUT = 16 * 32, I_QX = 16 * 8, I_OX = 4 * 32, I_M = 64, I_13 = 16 * 2 * 256, I_2P = 24 * 2 * 256;
    constexpr int NITEMS = I_IN + I_KV + I_OUT + I_QX + I_OX + I_M + I_13 + I_2P;
    for (int it = gw; it < NITEMS; it += NGW) {
        int r = it;
        if (r < I_IN) { const int kb = r / 96, nb = r % 96; transpose_item(w_in, INW, 64 * kb, 32 * nb, (bf16*)(ws + WS_WIN), 1024, 32 * nb, 64 * kb, g_mix, (32 * nb < 512) ? C2 : 1.0f, scr, lane); continue; } r -= I_IN;
        if (r < I_KV) { const int kb = r / 16, nb = r % 16; transpose_item(w_kv_x, 512, 64 * kb, 32 * nb, (bf16*)(ws + WS_WIN), 1024, NIN + 32 * nb, 64 * kb, g_mem, 1.0f, scr, lane); continue; } r -= I_KV;
        if (r < I_OUT) { const int kb = r / 32, nb = r % 32; transpose_item(w_out, 1024, 64 * kb, 32 * nb, (bf16*)(ws + WS_WOUT), 1024, 32 * nb, 64 * kb, nullptr, 1.0f, scr, lane); continue; } r -= I_OUT;
        if (r < I_QX) { const int kb = r / 8, nb = r % 8; transpose_item(w_q_x, 256, 64 * kb, 32 * nb, (bf16*)(ws + WS_WQX), 1024, 32 * nb, 64 * kb, g_cross, C2, scr, lane); continue; } r -= I_QX;
        if (r < I_OX) { const int kb = r / 32, nb = r % 32; transpose_item(w_o_x, 1024, 64 * kb, 32 * nb, (bf16*)(ws + WS_WOX), 256, 32 * nb, 64 * kb, nullptr, 1.0f, scr, lane); continue; } r -= I_OX;
        if (r < I_M) { const int which = r / 32, h = (r % 32) / 8, kb = (r % 8) / 4, nb = r % 4;
            transpose_item((which ? w_k_m : w_q_m) + (size_t)h * 128 * 128, 128, 64 * kb, 32 * nb, (bf16*)(ws + WS_WM) + (size_t)(which * 4 + h) * 128 * 128, 128, 32 * nb, 64 * kb, nullptr,
                           which ? 0.08838834764831845f : 1.0f, scr, lane); continue; } r -= I_M;
        if (r < I_13) { const int e = r / 512, which = (r % 512) / 256, kb = (r % 256) / 16, nb = r % 16; const int n0 = 32 * nb;
            transpose_item((which ? w3 : w1) + (size_t)e * 1024 * 512, 512, 64 * kb, n0, (bf16*)(ws + WS_W13) + (size_t)e * 1024 * 1024, 1024, (n0 / 128) * 256 + which * 128 + (n0 % 128), 64 * kb, g_ffn, 1.0f, scr, lane); continue; } r -= I_13;
        { const int bk = r / 512, hf = (r % 512) / 256, kb = (r % 256) / 32, nb = r % 32; const int g = bk / 6, p = bk % 6;
          const int pa = (p < 3) ? 0 : (p < 5 ? 1 : 2), pb = (p < 3) ? p + 1 : (p < 5 ? p - 1 : 3); const int e = 4 * g + (hf ? pb : pa);
          transpose_item(w2 + (size_t)e * 512 * 1024, 1024, 64 * kb, 32 * nb, (bf16*)(ws + WS_W2P) + (size_t)bk * 1024 * 1024, 1024, 32 * nb, hf * 512 + 64 * kb, nullptr, 1.0f, scr, lane); }
    }
    for (int i = gt; i < PAR_N; i += NGT) { float v;
        if (i < PAR_CONVB) v = ((const float*)A.in[5])[i]; else if (i < PAR_GMHN) v = ((const float*)A.in[6])[i - PAR_CONVB]; else if (i < PAR_SKIP) v = ((const float*)A.in[11])[i - PAR_GMHN];
        else if (i < PAR_BRG) v = ((const float*)A.in[12])[i - PAR_SKIP]; else if (i < PAR_BRE) v = ((const float*)A.in[21])[i - PAR_BRG]; else if (i < PAR_GFIN) v = ((const float*)A.in[23])[i - PAR_BRE];
        else v = ((const float*)A.in[27])[i - PAR_GFIN];
        ((float*)(ws + WS_PAR))[i] = v; }
    for (int i = gt; i < 20 * 1024; i += NGT) { const int e = i >> 10, k = i & 1023;
        ((float*)(ws + WS_WR))[i] = g_ffn[k] * (e < 4 ? w_rg[k * 4 + e] : w_re[k * 16 + (e - 4)]); }
    for (int i = gt; i < T * 8; i += NGT) { const int t = i >> 3, j = i & 7; const float invf = powf(500000.0f, -(float)j * 0.125f);
        const float ang = (float)positions[t] * invf; float sn, cs; sincosf(ang, &sn, &cs);
        ((float*)(ws + WS_ROPE))[t * 16 + j] = cs; ((float*)(ws + WS_ROPE))[t * 16 + 8 + j] = sn; }
    __syncthreads();
    for (int m = gw; m < T + TMEM; m += NGW) {
        const bool ismem = m >= T;
        const f32x4* xr = (const f32x4*)(ismem ? mem + (size_t)(m - T) * D : x + (size_t)m * D) + lane;
        f32x4 v[4]; float s = 0.f;
#pragma unroll
        for (int j = 0; j < 4; ++j) { v[j] = xr[64 * j]; s += (v[j].x * v[j].x + v[j].y * v[j].y) + (v[j].z * v[j].z + v[j].w * v[j].w); }
        const float rstd = 1.0f / sqrtf(wave_sum(s) * (1.0f / D) + EPSN);
        unsigned long long* o8 = (unsigned long long*)(ws + WS_XN + (size_t)m * D * 2) + lane;
#pragma unroll
        for (int j = 0; j < 4; ++j) o8[64 * j] = (unsigned long long)pk2(v[j].x * rstd, v[j].y * rstd) | ((unsigned long long)pk2(v[j].z * rstd, v[j].w * rstd) << 32);
        if (!ismem) {
            float gd[8];
#pragma unroll
            for (int g = 0; g < 8; ++g) { float a = 0.f;
#pragma unroll
                for (int j = 0; j < 4; ++j) { const f32x4 w = *(const f32x4*)(WGl + g * 1024 + 256 * j + 4 * lane); a += (v[j].x * w.x + v[j].y * w.y) + (v[j].z * w.z + v[j].w * w.w); }
                gd[g] = wave_sum(a) * rstd; }
            if (lane < 8) { float val = 0.f;
#pragma unroll
                for (int g = 0; g < 8; ++g) val = (lane == g) ? gd[g] : val;
                const int b = m / SEQ, sq = m % SEQ, h = lane & 3;
                if (lane < 4) ((float*)(ws + WS_IG))[(size_t)(b * 4 + h) * SEQ + sq] = val + b_i[h];
                else ((float*)(ws + WS_FG))[(size_t)(b * 4 + h) * SEQ + sq] = val + b_f[h]; }
        }
    }
}

struct InProjOrder {
    pg8::StaticOrder so;
    __device__ __forceinline__ bool next(int i, pg8::Unit& u) const {
        if (so.next(i, u)) return true;
        const long L = (long)i * so.G + so.c - so.nwg;
        if (L >= 0 && L < 16) { u.pm = 256 + (int)(L >> 1); u.pn = 12 + (int)(L & 1); u.aux = 1; return true; }
        return false;
    }
    __device__ __forceinline__ void a_ready(const pg8::Unit&) const {}
    __device__ __forceinline__ void done(const pg8::Unit&) const {}
};
__device__ __forceinline__ v4u pack8(const f32x4& a, const f32x4& b) { v4u w; w.x = pk2(a[0], a[1]); w.y = pk2(a[2], a[3]); w.z = pk2(b[0], b[1]); w.w = pk2(b[2], b[3]); return w; }
struct EpiInProj {
    static constexpr bool PERM = true, AFTER_DRAIN = false;
    bf16* base; bf16* kvx; const float* rope;
    __device__ __forceinline__ void operator()(const f32x4 (&acc)[2][2][4][2], const pg8::Unit& u, int wr, int wc, int fr, int fq) const {
        if (u.aux) {
            const int row0 = (u.pm - 256) * 256 + wr * 64 + fr, col0 = (u.pn - 12) * 256 + wc * 32 + 8 * fq;
#pragma unroll
            for (int ai = 0; ai < 2; ++ai)
#pragma unroll
                for (int m = 0; m < 4; ++m) { bf16* rowp = kvx + (size_t)(row0 + ai * 128 + m * 16) * NKV + col0;
#pragma unroll
                    for (int bj = 0; bj < 2; ++bj) *(v4u*)(rowp + bj * 128) = pack8(acc[ai][bj][m][0], acc[ai][bj][m][1]); }
            return;
        }
        const int buf = u.pn >> 1; bf16* B = base + (size_t)buf * T * 512;
        const int row0 = u.pm * 256 + wr * 64 + fr, col0 = (u.pn & 1) * 256 + wc * 32 + 8 * fq;
        const bool dorope = (buf < 2) && ((wc & 1) == 0);
#pragma unroll
        for (int ai = 0; ai < 2; ++ai)
#pragma unroll
            for (int m = 0; m < 4; ++m) { const int row = row0 + ai * 128 + m * 16; bf16* rowp = B + (size_t)row * 512 + col0;
                f32x4 cs0, cs1, sn0, sn1;
                if (dorope) { const f32x4* rp = (const f32x4*)(rope + (size_t)row * 16); cs0 = rp[0]; cs1 = rp[1]; sn0 = rp[2]; sn1 = rp[3]; }
#pragma unroll
                for (int bj = 0; bj < 2; ++bj) { f32x4 v0 = acc[ai][bj][m][0], v1 = acc[ai][bj][m][1];
                    if (dorope) { f32x4 o0, o1;
#pragma unroll
                        for (int i = 0; i < 4; ++i) { o0[i] = __shfl_xor(v0[i], 16); o1[i] = __shfl_xor(v1[i], 16); }
                        if (fq == 0) { v0 = v0 * cs0 - o0 * sn0; v1 = v1 * cs1 - o1 * sn1; }
                        else if (fq == 1) { v0 = v0 * cs0 + o0 * sn0; v1 = v1 * cs1 + o1 * sn1; } }
                    *(v4u*)(rowp + bj * 128) = pack8(v0, v1); } }
    }
};

constexpr int AT_QLD = 72, AT_KLD = 72, AT_VLD = 280, AT_PLD = 168;
constexpr int AT_Q = 0, AT_K = AT_Q + 128 * AT_QLD * 2, AT_V = AT_K + 272 * AT_KLD * 2, AT_P = AT_V + 64 * AT_VLD * 2, AT_END = AT_P + 8 * 16 * AT_PLD * 2;
static_assert(AT_END <= LDS_MISC, "attention LDS");
__device__ __forceinline__ void attn_item(const Args& A, unsigned char* lds, int item, int tid, int lane, int wave) {
    unsigned char* ws = A.ws;
    const int cfg = item >> 12; int rem = item & 4095; const int b = rem >> 9; rem &= 511; const int h = rem >> 6; const int sub = rem & 63;
    const int d = (cfg == 0) ? 1 : (cfg == 1 ? 4 : 16), nblk = 64 / d, r = sub / nblk, nb = sub % nblk;
    const bf16* Qg = (const bf16*)(ws + WS_Q) + h * 64; const bf16* Kg = (const bf16*)(ws + WS_K) + h * 64; const bf16* Vg = (const bf16*)(ws + WS_V) + h * 64;
    bf16* Qs = (bf16*)(lds + AT_Q); bf16* Ks = (bf16*)(lds + AT_K); bf16* Vt = (bf16*)(lds + AT_V); bf16* Ps = (bf16*)(lds + AT_P) + wave * 16 * AT_PLD;
    const size_t tokb = (size_t)b * SEQ + r;
    for (int id = tid; id < 128 * 8; id += NTHR) { const int row = id >> 3, ch = id & 7;
        *(v4u*)(Qs + row * AT_QLD + ch * 8) = *(const v4u*)(Qg + (tokb + (size_t)(128 * nb + row) * d) * 512 + ch * 8); }
    for (int id = tid; id < 272 * 8; id += NTHR) { const int kk = id >> 3, ch = id & 7; const int u = 128 * (nb - 1) + kk;
        v4u kv = (v4u){0u, 0u, 0u, 0u}, vv = (v4u){0u, 0u, 0u, 0u};
        if (kk < 256 && u >= 0) { const size_t off = (tokb + (size_t)u * d) * 512 + ch * 8; kv = *(const v4u*)(Kg + off); vv = *(const v4u*)(Vg + off); }
        *(v4u*)(Ks + kk * AT_KLD + ch * 8) = kv;
        bf16* vp = Vt + (ch * 8) * AT_VLD + kk;
        vp[0 * AT_VLD] = (bf16)(vv.x & 0xffffu); vp[1 * AT_VLD] = (bf16)(vv.x >> 16); vp[2 * AT_VLD] = (bf16)(vv.y & 0xffffu); vp[3 * AT_VLD] = (bf16)(vv.y >> 16);
        vp[4 * AT_VLD] = (bf16)(vv.z & 0xffffu); vp[5 * AT_VLD] = (bf16)(vv.z >> 16); vp[6 * AT_VLD] = (bf16)(vv.w & 0xffffu); vp[7 * AT_VLD] = (bf16)(vv.w >> 16); }
    __syncthreads();
    const int fr = lane & 15, fq = lane >> 4;
    f32x4 s[1][10];
#pragma unroll
    for (int j = 0; j < 10; ++j) s[0][j] = (f32x4){0.f, 0.f, 0.f, 0.f};
    wave_mma<1, 10>(Qs + 16 * wave * AT_QLD, AT_QLD, Ks + 16 * wave * AT_KLD, AT_KLD, 64, s, fr, fq);
    const int qi = 16 * wave + fr;
    float mx = -1e30f;
#pragma unroll
    for (int j = 0; j < 10; ++j)
#pragma unroll
        for (int e = 0; e < 4; ++e) { const int kk = 16 * wave + 16 * j + 4 * fq + e;
            const bool ok = (kk >= qi) && (kk <= qi + 128) && (nb > 0 || kk >= 128);
            s[0][j][e] = ok ? s[0][j][e] : -1e30f; mx = fmaxf(mx, s[0][j][e]); }
    mx = fmaxf(mx, __shfl_xor(mx, 16)); mx = fmaxf(mx, __shfl_xor(mx, 32));
    float l = 0.f;
#pragma unroll
    for (int j = 0; j < 10; ++j) { f32x4 p;
#pragma unroll
        for (int e = 0; e < 4; ++e) { p[e] = exp2f(s[0][j][e] - mx); l += p[e]; }
        *(v2u*)(Ps + fr * AT_PLD + 16 * j + 4 * fq) = (v2u){pk2(p[0], p[1]), pk2(p[2], p[3])}; }
    l += __shfl_xor(l, 16); l += __shfl_xor(l, 32);
    __syncthreads();
    f32x4 o[1][4];
#pragma unroll
    for (int j = 0; j < 4; ++j) o[0][j] = (f32x4){0.f, 0.f, 0.f, 0.f};
    wave_mma<1, 4>(Ps, AT_PLD, Vt + 16 * wave, AT_VLD, 160, o, fr, fq);
    const float rl = 1.0f / l;
    const size_t tok = tokb + (size_t)(128 * nb + qi) * d;
    bf16* og = (bf16*)((unsigned char*)A.out + DO_OATT) + ((size_t)cfg * T + tok) * 512 + h * 64;
#pragma unroll
    for (int j = 0; j < 4; ++j) *(v2u*)(og + 16 * j + 4 * fq) = (v2u){pk2(o[0][j][0] * rl, o[0][j][1] * rl), pk2(o[0][j][2] * rl, o[0][j][3] * rl)};
    if (fq == 0) ((float*)(ws + WS_LSE))[((size_t)cfg * T + tok) * 8 + h] = mx + log2f(l);
    __syncthreads();
}

constexpr int ML_LD = 136;
constexpr int ML_A = 0, ML_W = ML_A + 128 * ML_LD * 2, ML_KT = ML_W + 128 * ML_LD * 2, ML_VT = ML_KT + 128 * ML_LD * 2, ML_G = ML_VT + 128 * ML_LD * 2, ML_END = ML_G + 4096;
static_assert(ML_END <= LDS_MISC, "mlstm LDS");
__device__ __forceinline__ float log_sigmoidf_(float x) { return (x > 0.f) ? -log1pf(__expf(-x)) : (x - log1pf(__expf(x))); }

__device__ __forceinline__ float scan128_sum(const float* in, float* out, int lane) {
    const float v0 = in[2 * lane], v1 = in[2 * lane + 1]; float x = v0 + v1;
#pragma unroll
    for (int off = 1; off < 64; off <<= 1) { const float t = __shfl_up(x, off); if (lane >= off) x += t; }
    out[2 * lane] = x - v1; out[2 * lane + 1] = x;
    return __shfl(x, 63);
}
__device__ __forceinline__ void scan128_max(const float* in, float* out, int lane) {
    const float v0 = in[2 * lane], v1 = in[2 * lane + 1]; float x = fmaxf(v0, v1);
    float pre = -INFINITY;
    float y = x;
#pragma unroll
    for (int off = 1; off < 64; off <<= 1) { const float t = __shfl_up(y, off); if (lane >= off) y = fmaxf(y, t); }
    pre = __shfl_up(y, 1); if (lane == 0) pre = -INFINITY;
    out[2 * lane] = fmaxf(pre, v0); out[2 * lane + 1] = fmaxf(pre, x);
}

__device__ __forceinline__ void mlstm1_item(const Args& A, unsigned char* lds, int item, int tid, int lane, int wave) {
    unsigned char* ws = A.ws;
    const float* conv_w = (const float*)(ws + WS_PAR) + PAR_CONVW; const float* conv_b = (const float*)(ws + WS_PAR) + PAR_CONVB;
    const int bh = item >> 6, c = item & 63, b = bh >> 2, h = bh & 3;
    const size_t t0 = (size_t)b * SEQ + 128 * c;
    bf16* cA = (bf16*)(lds + ML_A); bf16* Wl = (bf16*)(lds + ML_W); bf16* kT = (bf16*)(lds + ML_KT); bf16* vT = (bf16*)(lds + ML_VT);
    float* gl = (float*)(lds + ML_G);
    const bf16* MU = (const bf16*)(ws + WS_MU) + h * 128; const bf16* MV = (const bf16*)(ws + WS_MV) + h * 128;
    bf16* Cg = (bf16*)((unsigned char*)A.out + DO_C) + h * 128;
    if (tid < 128) { const size_t gi = (size_t)bh * SEQ + 128 * c + tid; gl[128 + tid] = ((const float*)(ws + WS_IG))[gi]; gl[tid] = log_sigmoidf_(((const float*)(ws + WS_FG))[gi]); }
    for (int id = tid; id < 128 * 16; id += NTHR) { const int l = id >> 4, ch = (id & 15) * 8;
        float a[8];
        { const f32x4 b0 = *(const f32x4*)(conv_b + h * 128 + ch), b1 = *(const f32x4*)(conv_b + h * 128 + ch + 4);
          a[0] = b0[0]; a[1] = b0[1]; a[2] = b0[2]; a[3] = b0[3]; a[4] = b1[0]; a[5] = b1[1]; a[6] = b1[2]; a[7] = b1[3]; }
#pragma unroll
        for (int j = 0; j < 4; ++j) { const int sp = 128 * c + l + j - 3;
            if (sp >= 0) { const v4u m = *(const v4u*)(MU + ((size_t)b * SEQ + sp) * 512 + ch);
                const f32x4 w0 = *(const f32x4*)(conv_w + j * 512 + h * 128 + ch), w1 = *(const f32x4*)(conv_w + j * 512 + h * 128 + ch + 4);
                a[0] += bflo(m.x) * w0[0]; a[1] += bfhi(m.x) * w0[1]; a[2] += bflo(m.y) * w0[2]; a[3] += bfhi(m.y) * w0[3];
                a[4] += bflo(m.z) * w1[0]; a[5] += bfhi(m.z) * w1[1]; a[6] += bflo(m.w) * w1[2]; a[7] += bfhi(m.w) * w1[3]; } }
#pragma unroll
        for (int i = 0; i < 8; ++i) a[i] = a[i] * sigmoidf_(a[i]);
        const v4u o = (v4u){pk2(a[0], a[1]), pk2(a[2], a[3]), pk2(a[4], a[5]), pk2(a[6], a[7])};
        *(v4u*)(cA + l * ML_LD + ch) = o; *(v4u*)(Cg + (t0 + l) * 512 + ch) = o; }
    const bf16* Wq = (const bf16*)(ws + WS_WM) + (size_t)h * 128 * 128; const bf16* Wk = Wq + 4 * 128 * 128;
    for (int id = tid; id < 128 * 16; id += NTHR) { const int row = id >> 4, ch = (id & 15) * 8;
        *(v4u*)(Wl + row * ML_LD + ch) = *(const v4u*)(Wq + row * 128 + ch);
        const v4u vv = *(const v4u*)(MV + (t0 + row) * 512 + ch); bf16* vp = vT + ch * ML_LD + row;
        vp[0 * ML_LD] = (bf16)(vv.x & 0xffffu); vp[1 * ML_LD] = (bf16)(vv.x >> 16); vp[2 * ML_LD] = (bf16)(vv.y & 0xffffu); vp[3 * ML_LD] = (bf16)(vv.y >> 16);
        vp[4 * ML_LD] = (bf16)(vv.z & 0xffffu); vp[5 * ML_LD] = (bf16)(vv.z >> 16); vp[6 * ML_LD] = (bf16)(vv.w & 0xffffu); vp[7 * ML_LD] = (bf16)(vv.w >> 16); }
    __syncthreads();
    if (wave == 0) {
        const float blast = scan128_sum(gl, gl, lane);
        const float g0 = blast - gl[2 * lane] + gl[128 + 2 * lane], g1 = blast - gl[2 * lane + 1] + gl[128 + 2 * lane + 1];
        const float mloc = wave_max(fmaxf(g0, g1));
        gl[256 + 2 * lane] = __expf(g0 - mloc); gl[256 + 2 * lane + 1] = __expf(g1 - mloc);
        if (lane == 0) { ((float*)(ws + WS_MLOC))[item] = mloc; ((float*)(ws + WS_BLAST))[item] = blast; }
    }
    __syncthreads();
    const int fr = lane & 15, fq = lane >> 4, l = 16 * wave + fr;
    { f32x4 acc[1][8];
#pragma unroll
      for (int j = 0; j < 8; ++j) acc[0][j] = (f32x4){0.f, 0.f, 0.f, 0.f};
      wave_mma<1, 8>(cA + 16 * wave * ML_LD, ML_LD, Wl, ML_LD, 128, acc, fr, fq);
      bf16* qg = (bf16*)(ws + WS_MQ) + (t0 + l) * 512 + h * 128;
#pragma unroll
      for (int j = 0; j < 8; ++j) *(v2u*)(qg + 16 * j + 4 * fq) = (v2u){pk2(acc[0][j][0], acc[0][j][1]), pk2(acc[0][j][2], acc[0][j][3])}; }
    __syncthreads();
    for (int id = tid; id < 128 * 16; id += NTHR) { const int row = id >> 4, ch = (id & 15) * 8; *(v4u*)(Wl + row * ML_LD + ch) = *(const v4u*)(Wk + row * 128 + ch); }
    __syncthreads();
    { f32x4 acc[1][8];
#pragma unroll
      for (int j = 0; j < 8; ++j) acc[0][j] = (f32x4){0.f, 0.f, 0.f, 0.f};
      wave_mma<1, 8>(cA + 16 * wave * ML_LD, ML_LD, Wl, ML_LD, 128, acc, fr, fq);
      bf16* kg = (bf16*)(ws + WS_MK) + (t0 + l) * 512 + h * 128; const float wk = gl[256 + l];
#pragma unroll
      for (int j = 0; j < 8; ++j) { *(v2u*)(kg + 16 * j + 4 * fq) = (v2u){pk2(acc[0][j][0], acc[0][j][1]), pk2(acc[0][j][2], acc[0][j][3])};
#pragma unroll
          for (int e = 0; e < 4; ++e) kT[(16 * j + 4 * fq + e) * ML_LD + l] = (bf16)f2bf(acc[0][j][e] * wk); } }
    __syncthreads();
    { f32x4 acc[1][8];
#pragma unroll
      for (int j = 0; j < 8; ++j) acc[0][j] = (f32x4){0.f, 0.f, 0.f, 0.f};
      wave_mma<1, 8>(vT + 16 * wave * ML_LD, ML_LD, kT, ML_LD, 128, acc, fr, fq);
      float* cg = (float*)(ws + WS_CLOC) + ((size_t)item * 128 + l) * 128;
#pragma unroll
      for (int j = 0; j < 8; ++j) *(f32x4*)(cg + 16 * j + 4 * fq) = acc[0][j]; }
    if (tid < 128) { float s = 0.f; const bf16* kr = kT + tid * ML_LD;
        for (int i = 0; i < 128; i += 8) { const v4u w = *(const v4u*)(kr + i); s += (bflo(w.x) + bfhi(w.x)) + (bflo(w.y) + bfhi(w.y)) + (bflo(w.z) + bfhi(w.z)) + (bflo(w.w) + bfhi(w.w)); }
        ((float*)(ws + WS_NLOC))[(size_t)item * 128 + tid] = s; }
    __syncthreads();
}

__device__ __forceinline__ void p3_scan_combine(const Args& A, int tid) {
    unsigned char* ws = A.ws;
    const int G = gridDim.x, NGT = G * NTHR;
    for (int gid = blockIdx.x * NTHR + tid; gid < 32 * 4096; gid += NGT) {
        const int bh = gid >> 12, rem = gid & 4095, e = rem >> 5, dq = rem & 31;
        const float* MLOC = (const float*)(ws + WS_MLOC) + bh * 64; const float* BL = (const float*)(ws + WS_BLAST) + bh * 64;
        f32x4 C = (f32x4){0.f, 0.f, 0.f, 0.f}, n = (f32x4){0.f, 0.f, 0.f, 0.f}; float m = 0.f;
        for (int c = 0; c < 64; ++c) {
            const size_t idx = (size_t)bh * 64 + c;
            const f32x4 Cl = *(const f32x4*)((const float*)(ws + WS_CLOC) + (idx * 128 + e) * 128 + 4 * dq);
            *(v2u*)((bf16*)(ws + WS_CPREV) + (idx * 128 + e) * 128 + 4 * dq) = (v2u){pk2(C[0], C[1]), pk2(C[2], C[3])};
            const float ml = MLOC[c], bl = BL[c];
            const float mnew = fmaxf(bl + m, ml), a = __expf(bl + m - mnew), cc = __expf(ml - mnew);
            if (e == 0) { *(f32x4*)((float*)(ws + WS_NPREV) + idx * 128 + 4 * dq) = n;
                const f32x4 nl = *(const f32x4*)((const float*)(ws + WS_NLOC) + idx * 128 + 4 * dq); n = n * a + nl * cc;
                if (dq == 0) ((float*)(ws + WS_MPREV))[idx] = m; }
            C = C * a + Cl * cc; m = mnew;
        }
    }
    const bf16* OA = (const bf16*)((const unsigned char*)A.out + DO_OATT); const float* LSE = (const float*)(ws + WS_LSE);
    for (size_t id = (size_t)blockIdx.x * NTHR + tid; id < (size_t)T * 64; id += NGT) {
        const size_t t = id >> 6; const int h = (int)(id & 63) >> 3, ch = (int)(id & 7) * 8;
        const float l0 = LSE[t * 8 + h], l1 = LSE[((size_t)T + t) * 8 + h], l2 = LSE[((size_t)2 * T + t) * 8 + h];
        const float mx = fmaxf(l0, fmaxf(l1, l2)); float w0 = exp2f(l0 - mx), w1 = exp2f(l1 - mx), w2 = exp2f(l2 - mx);
        const float rs = 1.0f / (w0 + w1 + w2); w0 *= rs; w1 *= rs; w2 *= rs;
        const v4u a = *(const v4u*)(OA + t * 512 + h * 64 + ch), b = *(const v4u*)(OA + ((size_t)T + t) * 512 + h * 64 + ch), c = *(const v4u*)(OA + ((size_t)2 * T + t) * 512 + h * 64 + ch);
        v4u o;
        o.x = pk2(w0 * bflo(a.x) + w1 * bflo(b.x) + w2 * bflo(c.x), w0 * bfhi(a.x) + w1 * bfhi(b.x) + w2 * bfhi(c.x));
        o.y = pk2(w0 * bflo(a.y) + w1 * bflo(b.y) + w2 * bflo(c.y), w0 * bfhi(a.y) + w1 * bfhi(b.y) + w2 * bfhi(c.y));
        o.z = pk2(w0 * bflo(a.z) + w1 * bflo(b.z) + w2 * bflo(c.z), w0 * bfhi(a.z) + w1 * bfhi(b.z) + w2 * bfhi(c.z));
        o.w = pk2(w0 * bflo(a.w) + w1 * bflo(b.w) + w2 * bflo(c.w), w0 * bfhi(a.w) + w1 * bfhi(b.w) + w2 * bfhi(c.w));
        *(v4u*)((bf16*)(ws + WS_Y) + t * 1024 + h * 64 + ch) = o;
    }
}

__device__ __forceinline__ void mlstm2_item(const Args& A, unsigned char* lds, int item, int tid, int lane, int wave) {
    unsigned char* ws = A.ws;
    const float* g_mhn = (const float*)(ws + WS_PAR) + PAR_GMHN; const float* skip_m = (const float*)(ws + WS_PAR) + PAR_SKIP;
    const int bh = item >> 6, c = item & 63, b = bh >> 2, h = bh & 3;
    const size_t t0 = (size_t)b * SEQ + 128 * c;
    bf16* qA = (bf16*)(lds + ML_A); bf16* kA = (bf16*)(lds + ML_W); bf16* vT = (bf16*)(lds + ML_KT); bf16* CpT = (bf16*)(lds + ML_VT);
    float* gl = (float*)(lds + ML_G);
    const bf16* MQ = (const bf16*)(ws + WS_MQ) + h * 128; const bf16* MK = (const bf16*)(ws + WS_MK) + h * 128; const bf16* MV = (const bf16*)(ws + WS_MV) + h * 128;
    const bf16* CP = (const bf16*)(ws + WS_CPREV) + (size_t)item * 128 * 128;
    if (tid < 128) { const size_t gi = (size_t)bh * SEQ + 128 * c + tid; gl[896 + tid] = ((const float*)(ws + WS_IG))[gi]; gl[tid] = log_sigmoidf_(((const float*)(ws + WS_FG))[gi]);
        gl[640 + tid] = ((const float*)(ws + WS_NPREV))[(size_t)item * 128 + tid]; }
    for (int id = tid; id < 128 * 16; id += NTHR) { const int row = id >> 4, ch = (id & 15) * 8;
        *(v4u*)(qA + row * ML_LD + ch) = *(const v4u*)(MQ + (t0 + row) * 512 + ch);
        *(v4u*)(kA + row * ML_LD + ch) = *(const v4u*)(MK + (t0 + row) * 512 + ch);
        *(v4u*)(CpT + row * ML_LD + ch) = *(const v4u*)(CP + row * 128 + ch);
        const v4u vv = *(const v4u*)(MV + (t0 + row) * 512 + ch); bf16* vp = vT + ch * ML_LD + row;
        vp[0 * ML_LD] = (bf16)(vv.x & 0xffffu); vp[1 * ML_LD] = (bf16)(vv.x >> 16); vp[2 * ML_LD] = (bf16)(vv.y & 0xffffu); vp[3 * ML_LD] = (bf16)(vv.y >> 16);
        vp[4 * ML_LD] = (bf16)(vv.z & 0xffffu); vp[5 * ML_LD] = (bf16)(vv.z >> 16); vp[6 * ML_LD] = (bf16)(vv.w & 0xffffu); vp[7 * ML_LD] = (bf16)(vv.w >> 16); }
    __syncthreads();
    if (wave == 0) {
        const float mprev = ((const float*)(ws + WS_MPREV))[item];
        (void)scan128_sum(gl, gl, lane);
        gl[128 + 2 * lane] = gl[896 + 2 * lane] - gl[2 * lane]; gl[128 + 2 * lane + 1] = gl[896 + 2 * lane + 1] - gl[2 * lane + 1];
        scan128_max(gl + 128, gl + 896, lane);
#pragma unroll
        for (int q = 0; q < 2; ++q) { const int i = 2 * lane + q; const float bb = gl[i];
            const float mintra = bb + gl[896 + i], minter = bb + mprev, mt = fmaxf(minter, mintra);
            gl[256 + i] = bb - mt; gl[384 + i] = __expf(minter - mt); gl[512 + i] = __expf(-mt); }
    } else if (wave >= 4) {
        const int row = tid - 256;
        if (row < 128) { float s = 0.f; const bf16* qr = qA + row * ML_LD;
            for (int i = 0; i < 128; i += 8) { const v4u w = *(const v4u*)(qr + i); const float* np = gl + 640 + i;
                s += bflo(w.x) * np[0] + bfhi(w.x) * np[1] + bflo(w.y) * np[2] + bfhi(w.y) * np[3] + bflo(w.z) * np[4] + bfhi(w.z) * np[5] + bflo(w.w) * np[6] + bfhi(w.w) * np[7]; }
            gl[768 + row] = s; }
    }
    __syncthreads();
    const int fr = lane & 15, fq = lane >> 4, l = 16 * wave + fr;
    float den;
    v2u sp[8];
    { f32x4 acc[1][8];
#pragma unroll
      for (int j = 0; j < 8; ++j) acc[0][j] = (f32x4){0.f, 0.f, 0.f, 0.f};
      wave_mma<1, 8>(qA + 16 * wave * ML_LD, ML_LD, kA, ML_LD, 128, acc, fr, fq);
      const float rc = gl[256 + l]; float ds = 0.f;
#pragma unroll
      for (int j = 0; j < 8; ++j) { float p[4];
#pragma unroll
          for (int e = 0; e < 4; ++e) { const int s = 16 * j + 4 * fq + e; p[e] = (s <= l) ? acc[0][j][e] * __expf(rc + gl[128 + s]) : 0.f; ds += p[e]; }
          sp[j] = (v2u){pk2(p[0], p[1]), pk2(p[2], p[3])}; }
      ds += __shfl_xor(ds, 16); ds += __shfl_xor(ds, 32); den = ds; }
    __syncthreads();
#pragma unroll
    for (int j = 0; j < 8; ++j) *(v2u*)(kA + l * ML_LD + 16 * j + 4 * fq) = sp[j];
    __syncthreads();
    f32x4 acc[1][8];
#pragma unroll
    for (int j = 0; j < 8; ++j) acc[0][j] = (f32x4){0.f, 0.f, 0.f, 0.f};
    wave_mma<1, 8>(qA + 16 * wave * ML_LD, ML_LD, CpT, ML_LD, 128, acc, fr, fq);
    const float iw = gl[384 + l];
#pragma unroll
    for (int j = 0; j < 8; ++j) acc[0][j] = acc[0][j] * iw;
    wave_mma<1, 8>(kA + 16 * wave * ML_LD, ML_LD, vT, ML_LD, 128, acc, fr, fq);
    den += iw * gl[768 + l];
    const float rden = 1.0f / fmaxf(fabsf(den), gl[512 + l]);
    float sq = 0.f;
#pragma unroll
    for (int j = 0; j < 8; ++j) { acc[0][j] = acc[0][j] * rden; sq += (acc[0][j][0] * acc[0][j][0] + acc[0][j][1] * acc[0][j][1]) + (acc[0][j][2] * acc[0][j][2] + acc[0][j][3] * acc[0][j][3]); }
    sq += __shfl_xor(sq, 16); sq += __shfl_xor(sq, 32);
    const float rn = 1.0f / sqrtf(sq * (1.0f / 128.0f) + EPSN);
    const bf16* MOg = (const bf16*)(ws + WS_MO) + (t0 + l) * 512 + h * 128; const bf16* Cg = (const bf16*)((const unsigned char*)A.out + DO_C) + (t0 + l) * 512 + h * 128;
    bf16* yg = (bf16*)(ws + WS_Y) + (t0 + l) * 1024 + 512 + h * 128;
#pragma unroll
    for (int j = 0; j < 8; ++j) { const int e0 = 16 * j + 4 * fq;
        const v2u mo = *(const v2u*)(MOg + e0), cc = *(const v2u*)(Cg + e0);
        const f32x4 gm = *(const f32x4*)(g_mhn + h * 128 + e0), sk = *(const f32x4*)(skip_m + h * 128 + e0);
        const float y0 = sigmoidf_(bflo(mo.x)) * (acc[0][j][0] * rn * gm[0] + sk[0] * bflo(cc.x));
        const float y1 = sigmoidf_(bfhi(mo.x)) * (acc[0][j][1] * rn * gm[1] + sk[1] * bfhi(cc.x));
        const float y2 = sigmoidf_(bflo(mo.y)) * (acc[0][j][2] * rn * gm[2] + sk[2] * bflo(cc.y));
        const float y3 = sigmoidf_(bfhi(mo.y)) * (acc[0][j][3] * rn * gm[3] + sk[3] * bfhi(cc.y));
        *(v2u*)(yg + e0) = (v2u){pk2(y0, y1), pk2(y2, y3)}; }
    __syncthreads();
}

struct EpiOutProj {
    static constexpr bool PERM = false, AFTER_DRAIN = false;
    const float* x; float* x1; bf16* x1b; float* ss;
    __device__ __forceinline__ void operator()(const f32x4 (&acc)[2][2][4][2], const pg8::Unit& u, int wr, int wc, int fr, int fq) const {
        const int row0 = u.pm * 256 + wr * 64 + fr, col0 = u.pn * 256 + wc * 32 + 4 * fq;
#pragma unroll
        for (int ai = 0; ai < 2; ++ai)
#pragma unroll
            for (int m = 0; m < 4; ++m) { const int row = row0 + ai * 128 + m * 16; float sq = 0.f;
#pragma unroll
                for (int bj = 0; bj < 2; ++bj)
#pragma unroll
                    for (int n = 0; n < 2; ++n) { const size_t off = (size_t)row * D + col0 + bj * 128 + n * 16;
                        const f32x4 o = *(const f32x4*)(x + off) + acc[ai][bj][m][n];
                        *(f32x4*)(x1 + off) = o; *(v2u*)(x1b + off) = (v2u){pk2(o[0], o[1]), pk2(o[2], o[3])};
                        sq += (o[0] * o[0] + o[1] * o[1]) + (o[2] * o[2] + o[3] * o[3]); }
                sq += __shfl_xor(sq, 16); sq += __shfl_xor(sq, 32);
                if (fq == 0) ss[(size_t)row * 16 + u.pn * 4 + wc] = sq; }
    }
};
struct EpiQx {
    static constexpr bool PERM = true, AFTER_DRAIN = false;
    bf16* qx; const LAS float* rs;
    __device__ __forceinline__ void operator()(const f32x4 (&acc)[2][2][4][2], const pg8::Unit& u, int wr, int wc, int fr, int fq) const {
        const int rl0 = wr * 64 + fr, col0 = wc * 32 + 8 * fq;
#pragma unroll
        for (int ai = 0; ai < 2; ++ai)
#pragma unroll
            for (int m = 0; m < 4; ++m) { const int rl = rl0 + ai * 128 + m * 16; const float sc = rs[rl]; bf16* rowp = qx + (size_t)(u.pm * 256 + rl) * 256 + col0;
#pragma unroll
                for (int bj = 0; bj < 2; ++bj) *(v4u*)(rowp + bj * 128) = pack8(acc[ai][bj][m][0] * sc, acc[ai][bj][m][1] * sc);
                asm volatile("" ::: "memory"); }
    }
};
struct EpiOx {
    static constexpr bool PERM = false, AFTER_DRAIN = false;
    float* x1; float* xo;
    __device__ __forceinline__ void operator()(const f32x4 (&acc)[2][2][4][2], const pg8::Unit& u, int wr, int wc, int fr, int fq) const {
        const int row0 = u.pm * 256 + wr * 64 + fr, col0 = u.pn * 256 + wc * 32 + 4 * fq;
#pragma unroll
        for (int ai = 0; ai < 2; ++ai)
#pragma unroll
            for (int m = 0; m < 4; ++m)
#pragma unroll
                for (int bj = 0; bj < 2; ++bj)
#pragma unroll
                    for (int n = 0; n < 2; ++n) { const size_t off = (size_t)(row0 + ai * 128 + m * 16) * D + col0 + bj * 128 + n * 16; *(f32x4*)(xo + off) = *(const f32x4*)(x1 + off) + acc[ai][bj][m][n]; if (bj == 1 && n == 1) asm volatile("" ::: "memory"); }
    }
};
constexpr int CX_QLD = 72, CX_KLD = 72, CX_VLD = 264, CX_PLD = 264;
constexpr int CX_Q = 0, CX_K = CX_Q + 128 * CX_QLD * 2, CX_V = CX_K + 256 * CX_KLD * 2, CX_P = CX_V + 64 * CX_VLD * 2, CX_END = CX_P + 8 * 16 * CX_PLD * 2;
static_assert(CX_END <= LDS_MISC, "cross LDS");
__device__ __forceinline__ void cross_item(const Args& A, unsigned char* lds, int item, int tid, int lane, int wave) {
    unsigned char* ws = A.ws;
    const int rt = item >> 2, h = item & 3; const size_t t0 = (size_t)rt * 128; const int b = (int)(t0 / SEQ);
    bf16* Qs = (bf16*)(lds + CX_Q); bf16* Ks = (bf16*)(lds + CX_K); bf16* Vt = (bf16*)(lds + CX_V); bf16* Ps = (bf16*)(lds + CX_P) + wave * 16 * CX_PLD;
    const bf16* QX = (const bf16*)(ws + WS_QX) + h * 64; const bf16* KV = (const bf16*)(ws + WS_KVX) + (size_t)b * MEMLEN * NKV + h * 64;
    for (int id = tid; id < 128 * 8; id += NTHR) { const int row = id >> 3, ch = id & 7; *(v4u*)(Qs + row * CX_QLD + ch * 8) = *(const v4u*)(QX + (t0 + row) * 256 + ch * 8); }
    for (int id = tid; id < 256 * 8; id += NTHR) { const int kk = id >> 3, ch = id & 7;
        *(v4u*)(Ks + kk * CX_KLD + ch * 8) = *(const v4u*)(KV + (size_t)kk * NKV + ch * 8);
        const v4u vv = *(const v4u*)(KV + (size_t)kk * NKV + 256 + ch * 8); bf16* vp = Vt + (ch * 8) * CX_VLD + kk;
        vp[0 * CX_VLD] = (bf16)(vv.x & 0xffffu); vp[1 * CX_VLD] = (bf16)(vv.x >> 16); vp[2 * CX_VLD] = (bf16)(vv.y & 0xffffu); vp[3 * CX_VLD] = (bf16)(vv.y >> 16);
        vp[4 * CX_VLD] = (bf16)(vv.z & 0xffffu); vp[5 * CX_VLD] = (bf16)(vv.z >> 16); vp[6 * CX_VLD] = (bf16)(vv.w & 0xffffu); vp[7 * CX_VLD] = (bf16)(vv.w >> 16); }
    __syncthreads();
    const int fr = lane & 15, fq = lane >> 4;
    f32x4 s[1][16];
#pragma unroll
    for (int j = 0; j < 16; ++j) s[0][j] = (f32x4){0.f, 0.f, 0.f, 0.f};
    wave_mma<1, 16>(Qs + 16 * wave * CX_QLD, CX_QLD, Ks, CX_KLD, 64, s, fr, fq);
    float mx = -1e30f;
#pragma unroll
    for (int j = 0; j < 16; ++j)
#pragma unroll
        for (int e = 0; e < 4; ++e) mx = fmaxf(mx, s[0][j][e]);
    mx = fmaxf(mx, __shfl_xor(mx, 16)); mx = fmaxf(mx, __shfl_xor(mx, 32));
    float l = 0.f;
#pragma unroll
    for (int j = 0; j < 16; ++j) { f32x4 p;
#pragma unroll
        for (int e = 0; e < 4; ++e) { p[e] = exp2f(s[0][j][e] - mx); l += p[e]; }
        *(v2u*)(Ps + fr * CX_PLD + 16 * j + 4 * fq) = (v2u){pk2(p[0], p[1]), pk2(p[2], p[3])}; }
    l += __shfl_xor(l, 16); l += __shfl_xor(l, 32);
    __syncthreads();
    f32x4 o[1][4];
#pragma unroll
    for (int j = 0; j < 4; ++j) o[0][j] = (f32x4){0.f, 0.f, 0.f, 0.f};
    wave_mma<1, 4>(Ps, CX_PLD, Vt, CX_VLD, 256, o, fr, fq);
    const float rl = 1.0f / l;
    bf16* og = (bf16*)(ws + WS_OX) + (t0 + 16 * wave + fr) * 256 + h * 64;
#pragma unroll
    for (int j = 0; j < 4; ++j) *(v2u*)(og + 16 * j + 4 * fq) = (v2u){pk2(o[0][j][0] * rl, o[0][j][1] * rl), pk2(o[0][j][2] * rl, o[0][j][3] * rl)};
    __syncthreads();
}

struct TokInfo { int bucket; float wa, wb; int rank; };
constexpr size_t WS_CNTTAB = 31 * MiB + 512 * 1024;
__device__ __forceinline__ void p9_route(const Args& A, unsigned char* lds, int tid, int lane, int wave) {
    unsigned char* ws = A.ws;
    const float* b_rg = (const float*)(ws + WS_PAR) + PAR_BRG; const float* b_re = (const float*)(ws + WS_PAR) + PAR_BRE;
    LAS float* WRl = (LAS float*)lds;
    LAS int* bkl = (LAS int*)(lds + 81920);
    for (int i = tid; i < 20 * 1024 / 4; i += NTHR) ((LAS f32x4*)WRl)[i] = ((const f32x4*)(ws + WS_WR))[i];
    __syncthreads();
    bf16* HBN = (bf16*)(ws + WS_HBS);
    for (int chunk = blockIdx.x; chunk < T / 256; chunk += gridDim.x) {
        for (int r = 0; r < 32; ++r) {
            const int m = chunk * 256 + wave * 32 + r;
            const f32x4* xr = (const f32x4*)(A.out + (size_t)m * D) + lane;
            f32x4 v[4]; float s = 0.f;
#pragma unroll
            for (int j = 0; j < 4; ++j) { v[j] = xr[64 * j]; s += (v[j].x * v[j].x + v[j].y * v[j].y) + (v[j].z * v[j].z + v[j].w * v[j].w); }
            const float rstd = 1.0f / sqrtf(wave_sum(s) * (1.0f / D) + EPSN);
            unsigned long long* o8 = (unsigned long long*)(HBN + (size_t)m * D) + lane;
#pragma unroll
            for (int j = 0; j < 4; ++j) o8[64 * j] = (unsigned long long)pk2(v[j].x * rstd, v[j].y * rstd) | ((unsigned long long)pk2(v[j].z * rstd, v[j].w * rstd) << 32);
            float gl4[4];
#pragma unroll
            for (int e = 0; e < 4; ++e) { float a = 0.f;
#pragma unroll
                for (int j = 0; j < 4; ++j) { const f32x4 w = *(const LAS f32x4*)(WRl + e * 1024 + 256 * j + 4 * lane); a += (v[j].x * w.x + v[j].y * w.y) + (v[j].z * w.z + v[j].w * w.w); }
                gl4[e] = wave_sum(a) * rstd + b_rg[e]; }
            int g = 0; float gm = gl4[0];
#pragma unroll
            for (int i = 1; i < 4; ++i) if (gl4[i] > gm) { gm = gl4[i]; g = i; }
            g = __builtin_amdgcn_readfirstlane(g);
            float gs = 0.f;
#pragma unroll
            for (int i = 0; i < 4; ++i) gs += __expf(gl4[i] - gm);
            const float gw_ = 1.0f / gs;
            float el[4];
            const LAS float* WRe = WRl + (4 + 4 * g) * 1024;
#pragma unroll
            for (int e = 0; e < 4; ++e) { float a = 0.f;
#pragma unroll
                for (int j = 0; j < 4; ++j) { const f32x4 w = *(const LAS f32x4*)(WRe + e * 1024 + 256 * j + 4 * lane); a += (v[j].x * w.x + v[j].y * w.y) + (v[j].z * w.z + v[j].w * w.w); }
                el[e] = wave_sum(a) * rstd + b_re[g * 4 + e]; }
            int i0 = 0; float v0 = el[0];
#pragma unroll
            for (int i = 1; i < 4; ++i) if (el[i] > v0) { v0 = el[i]; i0 = i; }
            int i1 = -1; float v1 = -INFINITY;
#pragma unroll
            for (int i = 0; i < 4; ++i) if (i != i0 && el[i] > v1) { v1 = el[i]; i1 = i; }
            const float e1 = __expf(v1 - v0); const float w0 = gw_ / (1.0f + e1), w1 = gw_ * e1 / (1.0f + e1);
            const int pa = i0 < i1 ? i0 : i1, pb = i0 < i1 ? i1 : i0;
            const int pidx = (pa == 0) ? (pb - 1) : (pa == 1 ? pb + 1 : 5);
            const int bucket = g * 6 + pidx;
            if (lane == 0) { bkl[wave * 32 + r] = bucket; ((LAS float*)(bkl + 256))[wave * 32 + r] = (i0 < i1) ? w0 : w1; ((LAS float*)(bkl + 512))[wave * 32 + r] = (i0 < i1) ? w1 : w0; }
        }
        __syncthreads();
        if (tid < 256) { const int my = bkl[tid]; int rank = 0; for (int j = 0; j < tid; ++j) rank += (bkl[j] == my) ? 1 : 0;
            TokInfo ti; ti.bucket = my; ti.wa = ((LAS float*)(bkl + 256))[tid]; ti.wb = ((LAS float*)(bkl + 512))[tid]; ti.rank = rank;
            ((TokInfo*)(ws + WS_TOKINFO))[chunk * 256 + tid] = ti; }
        else if (tid < 256 + NBUCKET) { const int b = tid - 256; int c = 0; for (int j = 0; j < 256; ++j) c += (bkl[j] == b) ? 1 : 0;
            ((int*)(ws + WS_CNTTAB))[chunk * NBUCKET + b] = c; }
        __syncthreads();
    }
}
__device__ __forceinline__ void p10_slots(const Args& A, unsigned char* lds, int tid, int lane, int wave) {
    unsigned char* ws = A.ws;
    LAS int* tabl = (LAS int*)lds;
    LAS int* totl = (LAS int*)(lds + 32768);
    const int* CNTTAB = (const int*)(ws + WS_CNTTAB);
    for (int i = tid; i < 256 * NBUCKET; i += NTHR) tabl[i] = CNTTAB[i];
    __syncthreads();
    if (tid < NBUCKET) { int t = 0; for (int w = 0; w < 256; ++w) t += tabl[w * NBUCKET + tid]; totl[tid] = t; }
    __syncthreads();
    if (tid == 0) { int acc = 0; for (int b = 0; b < NBUCKET; ++b) { totl[32 + b] = acc; acc += ((totl[b] + 255) >> 8) * 256; } totl[32 + NBUCKET] = acc; }
    if (blockIdx.x == 0 && tid < NBUCKET) ((unsigned*)(ws + WS_CTL))[CW_CNT + tid] = (unsigned)totl[tid];
    __syncthreads();
    int* TOKMAP = (int*)(ws + WS_TOKMAP); float* WSORT = (float*)(ws + WS_WSORT);
    for (int chunk = blockIdx.x; chunk < T / 256; chunk += gridDim.x) {
        if (tid < NBUCKET) { int s = 0; for (int w = 0; w < chunk; ++w) s += tabl[w * NBUCKET + tid]; totl[64 + tid] = totl[32 + tid] + s; }
        __syncthreads();
        if (tid < 256) { const int m = chunk * 256 + tid; const TokInfo ti = ((const TokInfo*)(ws + WS_TOKINFO))[m]; const int slot = totl[64 + ti.bucket] + ti.rank;
            TOKMAP[slot] = m; WSORT[2 * slot] = ti.wa; WSORT[2 * slot + 1] = ti.wb; }
        __syncthreads();
    }
    for (int b = blockIdx.x; b < NBUCKET; b += gridDim.x)
        for (int r = totl[32 + b] + totl[b] + tid; r < totl[32 + b + 1]; r += NTHR) { TOKMAP[r] = -1; WSORT[2 * r] = 0.f; WSORT[2 * r + 1] = 0.f; }
}
struct MoeOrder {
    int G, c, nunits, ncol; const int* tab;
    __device__ __forceinline__ bool next(int i, pg8::Unit& u) const {
        const long L = (long)i * G + c; if (L >= nunits) return false;
        const int rt = (int)L / ncol, j = (int)L % ncol, bk = tab[rt];
        u.pm = rt; u.aux = j;
        if (ncol == 8) { const int g = bk / 6, p = bk % 6; const int pa = (p < 3) ? 0 : (p < 5 ? 1 : 2), pb = (p < 3) ? p + 1 : (p < 5 ? p - 1 : 3);
            const int e = 4 * g + ((j >> 2) ? pb : pa); u.pn = e * 4 + (j & 3); }
        else u.pn = bk * 4 + j;
        return true;
    }
    __device__ __forceinline__ void a_ready(const pg8::Unit&) const {}
    __device__ __forceinline__ void done(const pg8::Unit&) const {}
};
struct EpiUp {
    static constexpr bool PERM = true, AFTER_DRAIN = false;
    bf16* act; const float* wsort;
    __device__ __forceinline__ void operator()(const f32x4 (&acc)[2][2][4][2], const pg8::Unit& u, int wr, int wc, int fr, int fq) const {
        const int row0 = u.pm * 256 + wr * 64 + fr, half = u.aux >> 2, col0 = half * 512 + (u.aux & 3) * 128 + wc * 32 + 8 * fq;
#pragma unroll
        for (int ai = 0; ai < 2; ++ai)
#pragma unroll
            for (int m = 0; m < 4; ++m) { const int row = row0 + ai * 128 + m * 16; const float w = wsort[2 * row + half];
                f32x4 r0, r1;
#pragma unroll
                for (int i = 0; i < 4; ++i) { const float a0 = acc[ai][0][m][0][i], a1 = acc[ai][0][m][1][i];
                    r0[i] = a0 * sigmoidf_(a0) * acc[ai][1][m][0][i] * w; r1[i] = a1 * sigmoidf_(a1) * acc[ai][1][m][1][i] * w; }
                *(v4u*)(act + (size_t)row * D + col0) = pack8(r0, r1); }
    }
};
struct EpiDown {
    static constexpr bool PERM = false, AFTER_DRAIN = false;
    float* x2; float* xo; const int* tokmap;
    __device__ __forceinline__ void operator()(const f32x4 (&acc)[2][2][4][2], const pg8::Unit& u, int wr, int wc, int fr, int fq) const {
        const int row0 = u.pm * 256 + wr * 64 + fr, col0 = u.aux * 256 + wc * 32 + 4 * fq;
#pragma unroll
        for (int ai = 0; ai < 2; ++ai)
#pragma unroll
            for (int m = 0; m < 4; ++m) { const int tok = tokmap[row0 + ai * 128 + m * 16];
                if (tok >= 0) {
#pragma unroll
                    for (int bj = 0; bj < 2; ++bj)
#pragma unroll
                        for (int n = 0; n < 2; ++n) { const size_t off = (size_t)tok * D + col0 + bj * 128 + n * 16; *(f32x4*)(xo + off) = *(const f32x4*)(x2 + off) + acc[ai][bj][m][n]; } } }
    }
};
__device__ __forceinline__ void p10_final(const Args& A, float* outp, int lane, int wave) {
    const float* g_final = (const float*)(A.ws + WS_PAR) + PAR_GFIN;
    const int G = gridDim.x, gw = blockIdx.x * NWAVES + wave, NGW = G * NWAVES;
    f32x4 gv[4];
#pragma unroll
    for (int j = 0; j < 4; ++j) gv[j] = *((const f32x4*)g_final + lane + 64 * j);
    for (int m = gw; m < T; m += NGW) {
        f32x4* xr = (f32x4*)(A.out + (size_t)m * D) + lane;
        f32x4 v[4]; float s = 0.f;
#pragma unroll
        for (int j = 0; j < 4; ++j) { v[j] = xr[64 * j]; s += (v[j].x * v[j].x + v[j].y * v[j].y) + (v[j].z * v[j].z + v[j].w * v[j].w); }
        const float rstd = 1.0f / sqrtf(wave_sum(s) * (1.0f / D) + EPSN);
#pragma unroll
        for (int j = 0; j < 4; ++j) ((f32x4*)(outp + (size_t)m * D) + lane)[64 * j] = v[j] * rstd * gv[j];
    }
}

#ifndef MS
#define MS 4
#endif
#ifndef N_LAUNCHES
#define N_LAUNCHES 1
#endif
constexpr int N_PHASES = 14;
#ifndef DUP_MASK
#define DUP_MASK 0
#endif
#define REP(k) for (int rep_ = 0; rep_ < (((DUP_MASK >> (k)) & 1) ? 2 : 1); ++rep_)
#ifndef QX_SP2
#define QX_SP2 false
#endif

#ifndef NVG
#define NVG 256
#endif
__global__ void __launch_bounds__(NTHR, 2) __attribute__((amdgpu_num_vgpr(NVG))) fwd_kernel(Args args) {
    __shared__ __attribute__((aligned(16))) unsigned char lds[LDS_BYTES];
    const int tid = threadIdx.x, lane = tid & 63, wave = __builtin_amdgcn_readfirstlane(tid >> 6);
    gu32* ctl = (gu32*)(args.ws + WS_CTL);
    for (int u = tid; u < (LDS_BYTES - LDS_MISC) / 4; u += NTHR) ((unsigned*)(lds + LDS_MISC))[u] = 0u;
    __syncthreads();
    const int lo = args.ph_lo, hi = args.ph_hi;
    const bool use_bar = (hi - lo) > 1;
    XcdBarrier bar; bar.bar = (unsigned*)ctl + CW_BAR; bar.x = 0; bar.st = (volatile LAS unsigned*)(lds + LDS_MISC) + 8;
    if (use_bar) bar = xcd_barrier_post((unsigned*)ctl + CW_BAR, (volatile LAS unsigned*)(lds + LDS_MISC) + 8);
#ifndef PH_MASK
#define PH_MASK 0xFFFF
#endif
#define IN(k) (((PH_MASK >> (k)) & 1) && lo <= (k) && (k) < hi)
#define SEAM(k) do { if (IN(k) && IN((k) + 1)) xcd_barrier(bar); } while (0)
    PG8_LAS unsigned char* ring = (PG8_LAS unsigned char*)lds;
    const int G = gridDim.x;
#define PHASE_PTRS Args pa = args; { unsigned char* w_ = args.ws; float* o_ = args.out; asm volatile("" : "+s"(w_), "+s"(o_)); pa.ws = w_; pa.out = o_; } unsigned char* const ws = pa.ws; (void)ws

#ifdef DUMMY_LIVE
    float dl0, dl1, dl2, dl3, dl4, dl5, dl6, dl7; asm volatile("" : "=v"(dl0), "=v"(dl1), "=v"(dl2), "=v"(dl3), "=v"(dl4), "=v"(dl5), "=v"(dl6), "=v"(dl7));
#endif
    if (IN(0)) { PHASE_PTRS; REP(0) { p0_prologue(pa, lds, tid, lane, wave); __syncthreads(); } }
    SEAM(0);
    if (IN(1) && MS >= 1) { PHASE_PTRS;
        pg8::Gemm g{(const pg8::bf16_t*)(ws + WS_XN), (const pg8::bf16_t*)(ws + WS_WIN), T + TMEM, NIN + NKV, D};
        InProjOrder S; S.so.init(T, NIN, G, (int)blockIdx.x);
        EpiInProj E{(bf16*)(ws + WS_Q), (bf16*)(ws + WS_KVX), (const float*)(ws + WS_ROPE)};
        REP(1) pg8::gemm_phase<EpiInProj, InProjOrder, true, true>(ring, g, S, E);
    }
    SEAM(1);
    if (IN(2) && MS >= 1) { PHASE_PTRS;
        const int n_att = (MS >= 2) ? 3 * 4096 : 0;
        REP(14) for (int it = blockIdx.x; it < n_att; it += G) attn_item(pa, lds, it, tid, lane, wave);
        REP(15) for (int it = blockIdx.x; it < 2048; it += G) mlstm1_item(pa, lds, it, tid, lane, wave);
    }
    SEAM(2);
    if (IN(3) && MS >= 1) { PHASE_PTRS;
        if (MS < 2) {
            for (size_t id = (size_t)blockIdx.x * NTHR + tid; id < (size_t)T * 64; id += (size_t)G * NTHR) { const size_t t = id >> 6; const int c8 = (int)(id & 63) * 8;
                *(v4u*)((bf16*)(ws + WS_Y) + t * 1024 + c8) = (v4u){0u, 0u, 0u, 0u}; }
        }
        REP(3) p3_scan_combine(pa, tid);
    }
    SEAM(3);
    if (IN(4) && MS >= 1) { PHASE_PTRS; REP(4) for (int it = blockIdx.x; it < 2048; it += G) mlstm2_item(pa, lds, it, tid, lane, wave); }
    SEAM(4);
    if (IN(5)) { PHASE_PTRS;
        if (MS >= 1) {
            pg8::Gemm g{(const pg8::bf16_t*)(ws + WS_Y), (const pg8::bf16_t*)(ws + WS_WOUT), T, D, D};
            pg8::StaticOrder S; S.init(T, D, G, (int)blockIdx.x);
            EpiOutProj E{(const float*)pa.in[0], pa.out, (bf16*)(ws + WS_X1B), (float*)(ws + WS_SS1)};
            REP(5) pg8::gemm_phase<EpiOutProj, pg8::StaticOrder, true, true>(ring, g, S, E);
        } else {
            const int gw = blockIdx.x * NWAVES + wave, NGW = G * NWAVES;
            for (int m = gw; m < T; m += NGW) { const f32x4* xr = (const f32x4*)((const float*)pa.in[0] + (size_t)m * D) + lane; f32x4* o = (f32x4*)(pa.out + (size_t)m * D) + lane;
#pragma unroll
                for (int j = 0; j < 4; ++j) o[64 * j] = xr[64 * j]; }
        }
    }
    SEAM(5);
    if (IN(6) && MS >= 3) { PHASE_PTRS;
        pg8::Gemm g{(const pg8::bf16_t*)(ws + WS_X1B), (const pg8::bf16_t*)(ws + WS_WQX), T, 256, D};
        pg8::StaticOrder S; S.init(T, 256, G, (int)blockIdx.x);
        float* rs = (float*)(lds + LDS_RS);
        { pg8::Unit u0; if (S.next(0, u0) && tid < 256) { const f32x4* sp = (const f32x4*)((const float*)(ws + WS_SS1) + (size_t)(u0.pm * 256 + tid) * 16);
              const f32x4 a = sp[0], b = sp[1], c = sp[2], d = sp[3];
              const float s = ((a[0] + a[1]) + (a[2] + a[3])) + ((b[0] + b[1]) + (b[2] + b[3])) + ((c[0] + c[1]) + (c[2] + c[3])) + ((d[0] + d[1]) + (d[2] + d[3]));
              rs[tid] = 1.0f / sqrtf(s * (1.0f / D) + EPSN); } }
        __syncthreads();
        EpiQx E{(bf16*)(ws + WS_QX), (const LAS float*)rs};
        REP(6) pg8::gemm_phase<EpiQx, pg8::StaticOrder, true, QX_SP2>(ring, g, S, E);
    }
    SEAM(6);
    if (IN(7) && MS >= 3) { PHASE_PTRS; REP(7) for (int it = blockIdx.x; it < (T / 128) * 4; it += G) cross_item(pa, lds, it, tid, lane, wave); }
    SEAM(7);
    if (IN(8) && MS >= 3) { PHASE_PTRS;
        int kdyn = 256; asm volatile("" : "+s"(kdyn));
        pg8::Gemm g{(const pg8::bf16_t*)(ws + WS_OX), (const pg8::bf16_t*)(ws + WS_WOX), T, D, kdyn};
        pg8::StaticOrder S; S.init(T, D, G, (int)blockIdx.x);
        REP(8) { EpiOx E{pa.out, (((DUP_MASK >> 8) & 1) && rep_ == 0) ? (float*)(ws + 404 * MiB) : pa.out};
        pg8::gemm_phase<EpiOx, pg8::StaticOrder, false, true>(ring, g, S, E); }
    }
    SEAM(8);
    if (IN(9) && MS >= 4) { PHASE_PTRS; p9_route(pa, lds, tid, lane, wave); }
    SEAM(9);
    if (IN(10) && MS >= 4) { PHASE_PTRS; p10_slots(pa, lds, tid, lane, wave); }
    SEAM(10);
    if ((IN(11) || IN(12)) && MS >= 4) { PHASE_PTRS;
        int* tab = (int*)(lds + LDS_TAB);
        if (tid == 0) { int nrt = 0; const unsigned* cnt = (const unsigned*)(ws + WS_CTL) + CW_CNT;
            for (int i = 0; i < NBUCKET; ++i) { const int nt = (int)((__hip_atomic_load(cnt + i, __ATOMIC_RELAXED, __HIP_MEMORY_SCOPE_AGENT) + 255u) >> 8); for (int k = 0; k < nt; ++k) tab[1 + nrt++] = i; }
            tab[0] = nrt; }
        __syncthreads();
        const int nrt = tab[0];
        if (IN(11)) {
            pg8::Gemm g{(const pg8::bf16_t*)(ws + WS_HBS), (const pg8::bf16_t*)(ws + WS_W13), ROWS_MAX, 64 * 256, D, (const int*)(ws + WS_TOKMAP)};
            MoeOrder S{G, (int)blockIdx.x, nrt * 8, 8, tab + 1};
            EpiUp E{(bf16*)(ws + WS_ACT), (const float*)(ws + WS_WSORT)};
            REP(11) pg8::gemm_phase<EpiUp, MoeOrder, true, true, true>(ring, g, S, E);
        }
        SEAM(11);
        if (IN(12)) {
            pg8::Gemm g{(const pg8::bf16_t*)(ws + WS_ACT), (const pg8::bf16_t*)(ws + WS_W2P), ROWS_MAX, 96 * 256, D};
            MoeOrder S{G, (int)blockIdx.x, nrt * 4, 4, tab + 1};
            REP(12) { EpiDown E{pa.out, (((DUP_MASK >> 12) & 1) && rep_ == 0) ? (float*)(ws + 544 * MiB) : pa.out, (const int*)(ws + WS_TOKMAP)};
            pg8::gemm_phase<EpiDown, MoeOrder, true, true>(ring, g, S, E); }
        }
    }
    SEAM(12);
    if (IN(13)) { PHASE_PTRS; REP(13) p10_final(pa, (((DUP_MASK >> 13) & 1) && rep_ == 0) ? (float*)(ws + 544 * MiB) : pa.out, lane, wave); }
#ifdef DUMMY_LIVE
    asm volatile("" :: "v"(dl0), "v"(dl1), "v"(dl2), "v"(dl3), "v"(dl4), "v"(dl5), "v"(dl6), "v"(dl7));
#endif
#undef IN
#undef SEAM
}

extern "C" void kernel_launch(void* const* d_in, const int* in_sizes, int n_in, void* d_out, int out_size, void* d_ws, size_t ws_size, hipStream_t stream) {
    static int grid = 0;
    if (grid == 0) {
        if (n_in != 28 || out_size != T * D || ws_size < WS_END) { fprintf(stderr, "kernel_launch: unexpected problem (n_in %d, out %d, ws %zu)\n", n_in, out_size, ws_size); grid = -1; return; }
        int dev = 0, cus = 0, per_cu = 0;
        if (hipGetDevice(&dev) != hipSuccess || hipDeviceGetAttribute(&cus, hipDeviceAttributeMultiprocessorCount, dev) != hipSuccess) { grid = -1; return; }
        if (hipOccupancyMaxActiveBlocksPerMultiprocessor(&per_cu, (const void*)fwd_kernel, NTHR, 0) != hipSuccess || per_cu < 1) { fprintf(stderr, "kernel_launch: occupancy query failed (%d)\n", per_cu); per_cu = 1; }
        (void)hipGetLastError();
        grid = cus * (per_cu > 1 ? 1 : per_cu);
        if (grid > 256) grid = 256;
    }
    if (grid < 0) return;
    (void)hipMemsetAsync((char*)d_ws + WS_CTL, 0, CTL_ZERO_BYTES, stream);
    Args a{};
    for (int i = 0; i < 28; ++i) a.in[i] = d_in[i];
    a.out = (float*)d_out; a.ws = (unsigned char*)d_ws;
    if (N_LAUNCHES == 1) {
        a.ph_lo = 0; a.ph_hi = N_PHASES;
        void* kargs[] = {&a};
        hipError_t e = hipLaunchCooperativeKernel((const void*)fwd_kernel, dim3(grid), dim3(NTHR), kargs, 0, stream);
        if (e != hipSuccess) fprintf(stderr, "kernel_launch: cooperative launch failed: %s (grid %d)\n", hipGetErrorString(e), grid);
    } else {
        for (int p = 0; p < N_PHASES; ++p) { a.ph_lo = p; a.ph_hi = p + 1; hipLaunchKernelGGL(fwd_kernel, dim3(grid), dim3(NTHR), 0, stream, a); }
    }
}
```

```cpp
#include <hip/hip_runtime.h>
#include <cstdio>
#include <cstdint>
namespace pg8 {
#define PG8_LAS __attribute__((address_space(3)))
typedef unsigned short bf16_t;
typedef short bf16x8 __attribute__((ext_vector_type(8)));
typedef float f32x4 __attribute__((ext_vector_type(4)));
typedef unsigned u32x4 __attribute__((ext_vector_type(4)));
constexpr int BM = 256, BK = 64, HALF = 128, HTB = HALF * BK * 2  , STAGE_BYTES = 8 * HTB, NXCD = 8, WGM = 8;

__host__ __device__ __forceinline__ int lds_byte(int r, int c) { const int st = (r >> 4) * 2 + (c >> 5), rr = r & 15, cc = c & 31, ob = rr * 64 + cc * 2; return st * 1024 + (ob ^ (((ob >> 9) & 1) << 5)); }
__host__ __device__ __forceinline__ void stage_rc(int b, int& R, int& C) { const int st = b / 1024, sb = b % 1024, swz = sb ^ (((sb >> 9) & 1) << 5); R = (st >> 1) * 16 + swz / 64; C = (st & 1) * 32 + (swz % 64) / 2; }
__host__ __device__ __forceinline__ int perm32(int rho) { const int n = rho >> 4, i = rho & 15; return 8 * (i >> 2) + 4 * n + (i & 3); }

struct Unit { int pm, pn, aux; };
struct Gemm { const bf16_t* A; const bf16_t* Bt; int M, N, K; const int* rowmap; };

struct StaticOrder {
    int nM, nN, nwg, G, c;
    __host__ __device__ void init(int M, int N, int G_, int c_) { nM = M / BM; nN = N / BM; nwg = nM * nN; G = G_; c = c_; }
    __host__ __device__ bool next(int i, Unit& u) const {
        const long L = (long)i * G + c; if (L >= nwg) return false;
        int wgid = (int)L; { const int q = nwg / NXCD, r = nwg % NXCD, xcd = wgid % NXCD, off = wgid / NXCD; wgid = (xcd < r ? xcd * (q + 1) : r * (q + 1) + (xcd - r) * q) + off; }
        const int nig = WGM * nN, gid = wgid / nig, fm = gid * WGM, gsz = (nM - fm) < WGM ? (nM - fm) : WGM;
        u.pm = fm + ((wgid % nig) % gsz); u.pn = (wgid % nig) / gsz; u.aux = 0; return true;
    }
    __device__ __forceinline__ void a_ready(const Unit&) const {}
    __device__ __forceinline__ void done(const Unit&) const {}
};

__device__ __forceinline__ unsigned cvt_pk_bf16(float lo, float hi) { unsigned r; asm volatile("v_cvt_pk_bf16_f32 %0, %1, %2" : "=v"(r) : "v"(lo), "v"(hi)); return r; }
template <class Epi, class Sched, bool ALIGN_EPI = false, bool SP2 = false, bool GATHER = false>
__device__ __forceinline__ void gemm_phase(PG8_LAS unsigned char* lds, const Gemm g, const Sched& S, const Epi& E) {
    const int tid = threadIdx.x, wid = __builtin_amdgcn_readfirstlane(tid >> 6), lane = tid & 63, wr = wid >> 2, wc = wid & 3, fr = lane & 15, fq = lane >> 4;
    const int K = g.K, nt = K / BK;
    unsigned voffA[2], voffB[2];
#pragma unroll
    for (int i = 0; i < 2; ++i) { int R, C; stage_rc(tid * 16 + i * 8192, R, C); const int Rb = Epi::PERM ? ((R & ~31) + perm32(R & 31)) : R;
        voffA[i] = (unsigned)(R * K + C) * 2u; voffB[i] = (unsigned)(Rb * K + C) * 2u; }
    unsigned gc[2][2] = {{0u, 0u}, {0u, 0u}}, gn[2][2] = {{0u, 0u}, {0u, 0u}};
#define PG8_GLOAD(gv, pm_) do { _Pragma("unroll") for (int _h = 0; _h < 2; ++_h) _Pragma("unroll") for (int _i = 0; _i < 2; ++_i) { int _R, _C; stage_rc(tid * 16 + _i * 8192, _R, _C); \
        int _row = g.rowmap[(pm_) * BM + _h * HALF + _R]; _row = _row < 0 ? 0 : _row; gv[_h][_i] = (unsigned)(_row * K + _C) * 2u; } } while (0)
    const size_t kstep = (size_t)(BK * 2);
    const size_t hstep = (size_t)HALF * K * 2;
    const size_t tstep = 2 * hstep;
    const unsigned ldsw = (unsigned)wid * 1024u;
    const int aoff = lds_byte(wr * 64 + fr, fq * 8), boff = lds_byte(wc * 32 + fr, fq * 8);
#define PG8_SA(b, h) (((b) * 2 + (h)) * HTB)
#define PG8_SB(b, h) ((4 + (b) * 2 + (h)) * HTB)
#define PG8_STAGE(bufoff, gbase, voff) do { _Pragma("unroll") for (int _i = 0; _i < 2; ++_i) \
        __builtin_amdgcn_global_load_lds((const unsigned*)((const char*)(gbase) + (voff)[_i]), (PG8_LAS unsigned*)(lds + (bufoff) + ldsw + _i * 8192), 16, 0, 0); } while (0)
#define PG8_STAGE_A(bufoff, gbase, h, sel) do { if constexpr (GATHER) { unsigned vo_[2]; vo_[0] = (sel) ? gn[h][0] : gc[h][0]; vo_[1] = (sel) ? gn[h][1] : gc[h][1]; PG8_STAGE(bufoff, gbase, vo_); } \
        else { PG8_STAGE(bufoff, (gbase) + (h) * hstep, voffA); } } while (0)
#define PG8_LDA(dst, b, h) do { _Pragma("unroll") for (int m = 0; m < 4; ++m) _Pragma("unroll") for (int k = 0; k < 2; ++k) dst[m][k] = *(const PG8_LAS bf16x8*)(lds + PG8_SA(b, h) + aoff + m * 2048 + k * 1024); } while (0)
#define PG8_LDB(dst, b, h) do { _Pragma("unroll") for (int n = 0; n < 2; ++n) _Pragma("unroll") for (int k = 0; k < 2; ++k) dst[n][k] = *(const PG8_LAS bf16x8*)(lds + PG8_SB(b, h) + boff + n * 2048 + k * 1024); } while (0)
#define PG8_MMA(ai, bj, At, Bt) do { __builtin_amdgcn_s_setprio(1); _Pragma("unroll") for (int m = 0; m < 4; ++m) _Pragma("unroll") for (int n = 0; n < 2; ++n) _Pragma("unroll") for (int k = 0; k < 2; ++k) \
        acc[ai][bj][m][n] = __builtin_amdgcn_mfma_f32_16x16x32_bf16(Bt[n][k], At[m][k], acc[ai][bj][m][n], 0, 0, 0); __builtin_amdgcn_s_setprio(0); } while (0)
#define PG8_WAIT_V(n) asm volatile("s_waitcnt vmcnt(" #n ")" ::: "memory")
#define PG8_WAIT_L(n) asm volatile("s_waitcnt lgkmcnt(" #n ")" ::: "memory")
#define PG8_BAR __builtin_amdgcn_s_barrier()
#define PG8_SCHED __builtin_amdgcn_sched_barrier(0)
    Unit cur, nxt; int ui = 0;
    if (!S.next(0, cur)) return;
    f32x4 acc[2][2][4][2];
#pragma unroll
    for (int a = 0; a < 2; ++a)
#pragma unroll
        for (int b = 0; b < 2; ++b)
#pragma unroll
            for (int m = 0; m < 4; ++m)
#pragma unroll
                for (int n = 0; n < 2; ++n) acc[a][b][m][n] = (f32x4){0.f, 0.f, 0.f, 0.f};
    bf16x8 At[4][2], B0[2][2], B1[2][2];
    const char* cA = GATHER ? (const char*)g.A : (const char*)g.A + (size_t)cur.pm * tstep; const char* cB = (const char*)g.Bt + (size_t)cur.pn * tstep;
    if constexpr (GATHER) { PG8_GLOAD(gc, cur.pm); }
    S.a_ready(cur);
    if constexpr (SP2) {
        PG8_STAGE(PG8_SB(0, 0), cB, voffB); PG8_STAGE(PG8_SB(0, 1), cB + hstep, voffB); PG8_STAGE_A(PG8_SA(0, 0), cA, 0, false); PG8_STAGE_A(PG8_SA(0, 1), cA, 1, false);
        if (wr == 1) PG8_BAR;
        PG8_WAIT_V(2); PG8_BAR;
        PG8_STAGE(PG8_SB(1, 0), cB + kstep, voffB); PG8_STAGE_A(PG8_SA(1, 0), cA + kstep, 0, false); PG8_STAGE(PG8_SB(1, 1), cB + hstep + kstep, voffB);
        PG8_WAIT_V(6); PG8_BAR;
    } else {
        PG8_STAGE(PG8_SB(0, 0), cB, voffB); PG8_STAGE_A(PG8_SA(0, 0), cA, 0, false); PG8_STAGE(PG8_SB(0, 1), cB + hstep, voffB); PG8_STAGE_A(PG8_SA(0, 1), cA, 1, false);
        if (wr == 1) PG8_BAR;
        PG8_WAIT_V(4); PG8_BAR;
        PG8_STAGE(PG8_SB(1, 0), cB + kstep, voffB); PG8_STAGE_A(PG8_SA(1, 0), cA + kstep, 0, false); PG8_STAGE(PG8_SB(1, 1), cB + hstep + kstep, voffB);
        PG8_WAIT_V(6); PG8_BAR;
    }
    for (;;) {
        const bool has_next = S.next(ui + 1, nxt);
        const char* nA = GATHER ? cA : (has_next ? (const char*)g.A + (size_t)nxt.pm * tstep : cA);
        if constexpr (GATHER) { if (has_next) { PG8_GLOAD(gn, nxt.pm); } else { gn[0][0] = gc[0][0]; gn[0][1] = gc[0][1]; gn[1][0] = gc[1][0]; gn[1][1] = gc[1][1]; } }
        const char* nB = has_next ? (const char*)g.Bt + (size_t)nxt.pn * tstep : cB;
        for (int t = 0; t < nt; t += 2) {
            const bool last = (t == nt - 2);
            const char* a1 = cA + (size_t)(t + 1) * kstep;
            const char* a2 = last ? nA : cA + (size_t)(t + 2) * kstep; const char* b2 = last ? nB : cB + (size_t)(t + 2) * kstep;
            const char* a3 = a2 + kstep; const char* b3 = b2 + kstep;
            if (last && has_next) S.a_ready(nxt);
            if constexpr (SP2) {
            PG8_LDB(B0, 0, 0); PG8_LDB(B1, 0, 1); PG8_SCHED; PG8_LDA(At, 0, 0); PG8_STAGE_A(PG8_SA(1, 1), a1, 1, false);
            PG8_WAIT_V(8); PG8_WAIT_L(0); PG8_BAR; PG8_MMA(0, 0, At, B0); PG8_MMA(0, 1, At, B1); PG8_BAR; PG8_SCHED;
            PG8_LDA(At, 0, 1); PG8_STAGE(PG8_SB(0, 0), b2, voffB); PG8_STAGE(PG8_SB(0, 1), b2 + hstep, voffB); PG8_STAGE_A(PG8_SA(0, 0), a2, 0, last);
            PG8_WAIT_V(8); PG8_WAIT_L(0); PG8_BAR; PG8_MMA(1, 0, At, B0); PG8_MMA(1, 1, At, B1); PG8_BAR; PG8_SCHED;
            PG8_LDB(B0, 1, 0); PG8_LDB(B1, 1, 1); PG8_SCHED; PG8_LDA(At, 1, 0); PG8_STAGE_A(PG8_SA(0, 1), a2, 1, last);
            PG8_WAIT_V(8); PG8_WAIT_L(0); PG8_BAR; PG8_MMA(0, 0, At, B0); PG8_MMA(0, 1, At, B1); PG8_BAR; PG8_SCHED;
            PG8_LDA(At, 1, 1); PG8_STAGE(PG8_SB(1, 0), b3, voffB); PG8_STAGE(PG8_SB(1, 1), b3 + hstep, voffB); PG8_STAGE_A(PG8_SA(1, 0), a3, 0, last);
            PG8_WAIT_V(8); PG8_WAIT_L(0); PG8_BAR; PG8_MMA(1, 0, At, B0); PG8_MMA(1, 1, At, B1); PG8_BAR; PG8_SCHED;
            } else {
            PG8_LDB(B0, 0, 0); PG8_SCHED; PG8_LDA(At, 0, 0); PG8_STAGE_A(PG8_SA(1, 1), a1, 1, false);
            PG8_WAIT_L(8); PG8_BAR; PG8_WAIT_L(0); PG8_MMA(0, 0, At, B0); PG8_BAR; PG8_SCHED;
            PG8_LDB(B1, 0, 1); PG8_STAGE(PG8_SB(0, 0), b2, voffB);
            PG8_BAR; PG8_WAIT_L(0); PG8_MMA(0, 1, At, B1); PG8_BAR;
            PG8_LDA(At, 0, 1); PG8_STAGE_A(PG8_SA(0, 0), a2, 0, last);
            PG8_BAR; PG8_WAIT_L(0); PG8_MMA(1, 0, At, B0); PG8_BAR; PG8_SCHED;
            PG8_STAGE(PG8_SB(0, 1), b2 + hstep, voffB);
            PG8_WAIT_V(6); PG8_BAR; PG8_MMA(1, 1, At, B1); PG8_BAR;
            PG8_LDB(B0, 1, 0); PG8_SCHED; PG8_LDA(At, 1, 0); PG8_STAGE_A(PG8_SA(0, 1), a2, 1, last);
            PG8_WAIT_L(8); PG8_BAR; PG8_WAIT_L(0); PG8_MMA(0, 0, At, B0); PG8_BAR; PG8_SCHED;
            PG8_LDB(B1, 1, 1); PG8_STAGE(PG8_SB(1, 0), b3, voffB);
            PG8_BAR; PG8_WAIT_L(0); PG8_MMA(0, 1, At, B1); PG8_BAR;
            PG8_LDA(At, 1, 1); PG8_STAGE_A(PG8_SA(1, 0), a3, 0, last);
            PG8_BAR; PG8_WAIT_L(0); PG8_MMA(1, 0, At, B0); PG8_BAR; PG8_SCHED;
            PG8_STAGE(PG8_SB(1, 1), b3 + hstep, voffB);
            PG8_WAIT_V(6); PG8_BAR; PG8_MMA(1, 1, At, B1); PG8_BAR;
            }
        }
        if constexpr (ALIGN_EPI) { if (wr == 0) PG8_BAR; }
        if constexpr (!Epi::AFTER_DRAIN) { E(acc, cur, wr, wc, fr, fq); S.done(cur); }
        if (!has_next) break;
#pragma unroll
        for (int a = 0; a < 2; ++a)
#pragma unroll
            for (int b = 0; b < 2; ++b)
#pragma unroll
                for (int m = 0; m < 4; ++m)
#pragma unroll
                    for (int n = 0; n < 2; ++n) acc[a][b][m][n] = (f32x4){0.f, 0.f, 0.f, 0.f};
        cur = nxt; cA = nA; cB = nB; ++ui;
        if constexpr (GATHER) { gc[0][0] = gn[0][0]; gc[0][1] = gn[0][1]; gc[1][0] = gn[1][0]; gc[1][1] = gn[1][1]; }
        if constexpr (ALIGN_EPI) { if (wr == 1) PG8_BAR; }
    }
    PG8_WAIT_V(0);
    if constexpr (!ALIGN_EPI) { if (wr == 0) PG8_BAR; }
    PG8_BAR;
    if constexpr (Epi::AFTER_DRAIN) { E.fused(acc, cur, wr, wc, fr, fq, lds, wid, lane); S.done(cur); }
#undef PG8_SA
#undef PG8_SB
#undef PG8_STAGE
#undef PG8_STAGE_A
#undef PG8_GLOAD
#undef PG8_LDA
#undef PG8_LDB
#undef PG8_MMA
#undef PG8_WAIT_V
#undef PG8_WAIT_L
#undef PG8_BAR
#undef PG8_SCHED
}
}

#define GAS __attribute__((address_space(1)))
#define LAS __attribute__((address_space(3)))
typedef unsigned short bf16;
typedef unsigned v4u __attribute__((ext_vector_type(4)));
typedef unsigned v2u __attribute__((ext_vector_type(2)));
typedef float f32x4 __attribute__((ext_vector_type(4)));
typedef short bf16x8 __attribute__((ext_vector_type(8)));
typedef GAS unsigned gu32;

constexpr int NWAVES = 8, NTHR = 512;
constexpr int BATCH = 8, SEQ = 8192, T = BATCH * SEQ, D = 1024, MEMLEN = 256, TMEM = BATCH * MEMLEN;
constexpr int INW = 3080, NIN = 3072, NKV = 512;
constexpr int NBUCKET = 24, ROWS_MAX = T + NBUCKET * 256;
constexpr float EPSN = 1e-6f;
constexpr float C2 = 0.125f * 1.4426950408889634f;
constexpr float LOG2E = 1.4426950408889634f;

constexpr size_t MiB = 1u << 20;
constexpr size_t WS_CTL = 0, CTL_ZERO_BYTES = 1 * MiB;
constexpr size_t WS_ROPE = 2 * MiB;
constexpr size_t WS_IG = 6 * MiB;
constexpr size_t WS_FG = 7 * MiB;
constexpr size_t WS_LSE = 8 * MiB;
constexpr size_t WS_SS1 = 14 * MiB;
constexpr size_t WS_SS3 = 18 * MiB;
constexpr size_t WS_KVX = 22 * MiB;
constexpr size_t WS_NLOC = 24 * MiB;
constexpr size_t WS_NPREV = 25 * MiB;
constexpr size_t WS_MLOC = 26 * MiB;
constexpr size_t WS_BLAST = 26 * MiB + 64 * 1024;
constexpr size_t WS_MPREV = 26 * MiB + 128 * 1024;
constexpr size_t WS_TOKINFO = 27 * MiB;
constexpr size_t WS_TOKMAP = 28 * MiB;
constexpr size_t WS_WSORT = 29 * MiB;
constexpr size_t WS_WR = 30 * MiB;
constexpr size_t WS_WG = 30 * MiB + 512 * 1024;
constexpr size_t WS_PAR = 31 * MiB;
constexpr int PAR_CONVW = 0, PAR_CONVB = 2048, PAR_GMHN = 2560, PAR_SKIP = 3072, PAR_BRG = 3584, PAR_BRE = 3600, PAR_GFIN = 3616, PAR_N = 4640;
constexpr size_t WS_WIN = 32 * MiB;
constexpr size_t WS_WOUT = 39 * MiB;
constexpr size_t WS_WQX = 41 * MiB;
constexpr size_t WS_WOX = 41 * MiB + 512 * 1024;
constexpr size_t WS_WM = 42 * MiB;
constexpr size_t WS_W13 = 44 * MiB;
constexpr size_t WS_W2P = 76 * MiB;
constexpr size_t WS_XN = 128 * MiB;
constexpr size_t WS_CLOC = 128 * MiB;
constexpr size_t WS_Q = 264 * MiB;
constexpr size_t WS_K = 328 * MiB, WS_V = 392 * MiB, WS_MU = 456 * MiB, WS_MV = 520 * MiB, WS_MO = 584 * MiB;
constexpr size_t WS_MQ = 648 * MiB, WS_MK = 712 * MiB;
constexpr size_t WS_Y = 264 * MiB;
constexpr size_t WS_CPREV = 392 * MiB;
constexpr size_t WS_X1B = 648 * MiB;
constexpr size_t WS_QX = 776 * MiB;
constexpr size_t WS_OX = 808 * MiB;
constexpr size_t WS_HBS = 264 * MiB;
constexpr size_t WS_ACT = 404 * MiB;
constexpr size_t WS_END = 840 * MiB;
constexpr size_t DO_OATT = 0, DO_C = 192 * MiB;

constexpr int CW_BAR = 4096;
constexpr int CW_CNT = 8192;
constexpr int CW_FILL = 8192 + 64;

constexpr int LDS_BYTES = 163840;
constexpr int LDS_MISC = 159744;
constexpr int LDS_RS = 135168;
constexpr int LDS_TAB = 136192;

#define LDS_WAIT() asm volatile("s_waitcnt lgkmcnt(0)" ::: "memory")
#define VM_WAIT() asm volatile("s_waitcnt vmcnt(0)" ::: "memory")
__device__ __forceinline__ unsigned f2bf(float f) { unsigned u = __builtin_bit_cast(unsigned, f); return (u + 0x7fffu + ((u >> 16) & 1u)) >> 16; }
__device__ __forceinline__ unsigned pk2(float lo, float hi) { return f2bf(lo) | (f2bf(hi) << 16); }
__device__ __forceinline__ float bf2f(unsigned h) { return __uint_as_float(h << 16); }
__device__ __forceinline__ float bflo(unsigned w) { return __uint_as_float(w << 16); }
__device__ __forceinline__ float bfhi(unsigned w) { return __uint_as_float(w & 0xffff0000u); }
__device__ __forceinline__ float wave_sum(float v) {
#pragma unroll
    for (int o = 1; o < 64; o <<= 1) v += __shfl_xor(v, o);
    return v;
}
__device__ __forceinline__ float wave_max(float v) {
#pragma unroll
    for (int o = 1; o < 64; o <<= 1) v = fmaxf(v, __shfl_xor(v, o));
    return v;
}
__device__ __forceinline__ float sigmoidf_(float x) { return 1.0f / (1.0f + __expf(-x)); }

#define XB_TMO      128
#define XB_XCNT(j)  (256  + 64 * (j))
#define XB_XSUB(j)  (1280 + 64 * (j))
#define XB_XGEN(j)  (2304 + 64 * (j))
#define XB_TOP      3328
#define XB_TOPGEN   3392
#define XCD_BAR_WORDS 3456
#define XB_SPIN_CAP (1u << 22)
__device__ __forceinline__ unsigned xb_ld(unsigned* p)              { return __hip_atomic_load(p, __ATOMIC_RELAXED, __HIP_MEMORY_SCOPE_AGENT); }
__device__ __forceinline__ unsigned xb_add(unsigned* p, unsigned v) { return __hip_atomic_fetch_add(p, v, __ATOMIC_RELAXED, __HIP_MEMORY_SCOPE_AGENT); }
__device__ __forceinline__ unsigned xb_xcc_id() { return (unsigned)__builtin_amdgcn_s_getreg((3 << 11) | 20) & 0xFu; }
#define XB_SPIN(cond, bar) do { unsigned _sp = 0; while (cond) { __builtin_amdgcn_s_sleep(1); \
    if ((++_sp & 255u) == 0u) { if (xb_ld(&(bar)[XB_TMO])) break; if (_sp > XB_SPIN_CAP) { atomicAdd(&(bar)[XB_TMO], 1u); break; } } } } while (0)
struct XcdBarrier { unsigned* bar; unsigned x; volatile LAS unsigned* st; };
__device__ __forceinline__ XcdBarrier xcd_barrier_post(unsigned* bar, volatile LAS unsigned* st) {
    XcdBarrier b; b.bar = bar; b.x = xb_xcc_id(); b.st = st;
    if (threadIdx.x == 0) (void)xb_add(&bar[XB_XCNT(b.x)], 1u);
    return b;
}
__device__ __forceinline__ void xcd_barrier_complete(unsigned* bar, unsigned x, unsigned& nloc, unsigned& nx) {
    const unsigned G = gridDim.x * gridDim.y * gridDim.z;
    unsigned sum, cnt, mine, sp = 0u;
    for (;;) {
        sum = 0u; cnt = 0u; mine = 0u;
#pragma unroll
        for (unsigned j = 0; j < 16; ++j) { const unsigned c = xb_ld(&bar[XB_XCNT(j)]); sum += c; cnt += (c > 0u) ? 1u : 0u; mine = (j == x) ? c : mine; }
        if (sum == G) break;
        __builtin_amdgcn_s_sleep(1);
        if ((++sp & 255u) == 0u) { if (xb_ld(&bar[XB_TMO])) break; if (sp > XB_SPIN_CAP) { atomicAdd(&bar[XB_TMO], 1u); break; } }
    }
    nloc = mine > 0u ? mine : 1u; nx = cnt > 0u ? cnt : 1u;
}
__device__ __forceinline__ void xcd_barrier(const XcdBarrier& b) {
    asm volatile("s_waitcnt vmcnt(0)" ::: "memory");
    __syncthreads();
    if (threadIdx.x == 0) {
        unsigned* bar = b.bar;
        __builtin_amdgcn_s_waitcnt(0);
        unsigned nloc = b.st[0], nx = b.st[1];
        if (nloc == 0u) { xcd_barrier_complete(bar, b.x, nloc, nx); b.st[0] = nloc; b.st[1] = nx; }
        const unsigned old = xb_add(&bar[XB_XSUB(b.x)], 1u);
        const unsigned gen = old / nloc;
        if (old + 1u == (gen + 1u) * nloc) {
            __builtin_amdgcn_fence(__ATOMIC_RELEASE, "agent");
            asm volatile("s_waitcnt vmcnt(0)" ::: "memory");
            const unsigned og = xb_add(&bar[XB_TOP], 1u);
            const unsigned tg = og / nx;
            if (og + 1u == (tg + 1u) * nx) xb_add(&bar[XB_TOPGEN], 1u);
            else XB_SPIN(xb_ld(&bar[XB_TOPGEN]) == tg, bar);
            __builtin_amdgcn_fence(__ATOMIC_ACQUIRE, "agent");
            xb_add(&bar[XB_XGEN(b.x)], 1u);
            asm volatile("s_waitcnt vmcnt(0)" ::: "memory");
        } else {
            XB_SPIN(xb_ld(&bar[XB_XGEN(b.x)]) == gen, bar);
            __builtin_amdgcn_fence(__ATOMIC_ACQUIRE, "agent");
            asm volatile("s_waitcnt vmcnt(0)" ::: "memory");
        }
    }
    __syncthreads();
}

struct Args { const void* in[28]; float* out; unsigned char* ws; int ph_lo, ph_hi; };

template <int MI, int NJ>
__device__ __forceinline__ void wave_mma(const bf16* A, int lda, const bf16* Bt, int ldb, int K, f32x4 (&acc)[MI][NJ], int fr, int fq) {
    for (int k0 = 0; k0 < K; k0 += 32) {
        bf16x8 a[MI], b[NJ];
#pragma unroll
        for (int i = 0; i < MI; ++i) a[i] = *(const bf16x8*)(A + (16 * i + fr) * lda + k0 + 8 * fq);
#pragma unroll
        for (int j = 0; j < NJ; ++j) b[j] = *(const bf16x8*)(Bt + (16 * j + fr) * ldb + k0 + 8 * fq);
#pragma unroll
        for (int i = 0; i < MI; ++i)
#pragma unroll
            for (int j = 0; j < NJ; ++j) acc[i][j] = __builtin_amdgcn_mfma_f32_16x16x32_bf16(b[j], a[i], acc[i][j], 0, 0, 0);
    }
}

__device__ __forceinline__ void transpose_item(const float* src, int src_ld, int k0, int n0, bf16* dst, int dst_ld, int dst_row0, int dst_col0,
                                               const float* gain, float scale, LAS float* scr, int lane) {
    f32x4 ld[16];
#pragma unroll
    for (int i = 0; i < 16; ++i) { const int kk = 4 * i + (lane >> 4); ld[i] = *(const f32x4*)(src + (size_t)(k0 + kk) * src_ld + n0 + 4 * (lane & 15)); }
#pragma unroll
    for (int i = 0; i < 16; ++i) { const int kk = 4 * i + (lane >> 4); *(LAS f32x4*)(scr + kk * 64 + 4 * ((lane & 15) ^ ((kk >> 3) & 15))) = ld[i]; }
    const int c = lane & 7;
    f32x4 g0 = (f32x4){scale, scale, scale, scale}, g1 = g0;
    if (gain) { g0 = *(const f32x4*)(gain + k0 + 8 * c) * scale; g1 = *(const f32x4*)(gain + k0 + 8 * c + 4) * scale; }
    LDS_WAIT(); asm volatile("" ::: "memory");
#pragma unroll
    for (int j = 0; j < 8; ++j) { const int n = (lane >> 3) + 8 * j; const LAS float* s = scr + (8 * c) * 64 + 4 * ((n >> 2) ^ c) + (n & 3);
        v4u o; o.x = pk2(s[0 * 64] * g0[0], s[1 * 64] * g0[1]); o.y = pk2(s[2 * 64] * g0[2], s[3 * 64] * g0[3]); o.z = pk2(s[4 * 64] * g1[0], s[5 * 64] * g1[1]); o.w = pk2(s[6 * 64] * g1[2], s[7 * 64] * g1[3]);
        *(v4u*)(dst + (size_t)(dst_row0 + n) * dst_ld + dst_col0 + 8 * c) = o; }
    LDS_WAIT(); asm volatile("" ::: "memory");
}

__device__ __forceinline__ void p0_prologue(const Args& A, unsigned char* lds, int tid, int lane, int wave) {
    unsigned char* ws = A.ws;
    const float* x = (const float*)A.in[0]; const float* mem = (const float*)A.in[1]; const int* positions = (const int*)A.in[2];
    const float* g_mix = (const float*)A.in[3]; const float* w_in = (const float*)A.in[4];
    const float* w_q_m = (const float*)A.in[7]; const float* w_k_m = (const float*)A.in[8];
    const float* b_i = (const float*)A.in[9]; const float* b_f = (const float*)A.in[10];
    const float* w_out = (const float*)A.in[13]; const float* g_cross = (const float*)A.in[14]; const float* g_mem = (const float*)A.in[15];
    const float* w_q_x = (const float*)A.in[16]; const float* w_kv_x = (const float*)A.in[17]; const float* w_o_x = (const float*)A.in[18];
    const float* g_ffn = (const float*)A.in[19]; const float* w_rg = (const float*)A.in[20]; const float* w_re = (const float*)A.in[22];
    const float* w1 = (const float*)A.in[24]; const float* w3 = (const float*)A.in[25]; const float* w2 = (const float*)A.in[26];
    const int G = gridDim.x, gw = blockIdx.x * NWAVES + wave, NGW = G * NWAVES, gt = blockIdx.x * NTHR + tid, NGT = G * NTHR;

    LAS float* WGl = (LAS float*)lds;
    for (int i = tid; i < 8 * 1024; i += NTHR) { const int k = i >> 3, j = i & 7; WGl[j * 1024 + k] = g_mix[k] * w_in[(size_t)k * INW + NIN + j]; }

    for (int i = gt; i < PAR_N; i += NGT) { float v;
        if (i < PAR_CONVB) v = ((const float*)A.in[5])[i]; else if (i < PAR_GMHN) v = ((const float*)A.in[6])[i - PAR_CONVB]; else if (i < PAR_SKIP) v = ((const float*)A.in[11])[i - PAR_GMHN];
        else if (i < PAR_BRG) v = ((const float*)A.in[12])[i - PAR_SKIP]; else if (i < PAR_BRE) v = ((const float*)A.in[21])[i - PAR_BRG]; else if (i < PAR_GFIN) v = ((const float*)A.in[23])[i - PAR_BRE];
        else v = ((const float*)A.in[27])[i - PAR_GFIN];
        ((float*)(ws + WS_PAR))[i] = v; }
    for (int i = gt; i < 20 * 1024; i += NGT) { const int e = i >> 10, k = i & 1023;
        ((float*)(ws + WS_WR))[i] = g_ffn[k] * (e < 4 ? w_rg[k * 4 + e] : w_re[k * 16 + (e - 4)]); }
    for (int i = gt; i < T * 8; i += NGT) { const int t = i >> 3, j = i & 7; const float invf = powf(500000.0f, -(float)j * 0.125f);
        const float ang = (float)positions[t] * invf; float sn, cs; sincosf(ang, &sn, &cs);
        ((float*)(ws + WS_ROPE))[t * 16 + j] = cs; ((float*)(ws + WS_ROPE))[t * 16 + 8 + j] = sn; }
    __syncthreads();
    for (int m0 = 2 * gw; m0 < T + TMEM; m0 += 2 * NGW) {
        f32x4 v[2][4]; float rstd[2];
#pragma unroll
        for (int q = 0; q < 2; ++q) { const int m = m0 + q; const f32x4* xr = (const f32x4*)(m >= T ? mem + (size_t)(m - T) * D : x + (size_t)m * D) + lane;
#pragma unroll
            for (int j = 0; j < 4; ++j) v[q][j] = xr[64 * j]; }
#pragma unroll
        for (int q = 0; q < 2; ++q) { float s = 0.f;
#pragma unroll
            for (int j = 0; j < 4; ++j) s += (v[q][j].x * v[q][j].x + v[q][j].y * v[q][j].y) + (v[q][j].z * v[q][j].z + v[q][j].w * v[q][j].w);
            rstd[q] = 1.0f / sqrtf(wave_sum(s) * (1.0f / D) + EPSN);
            unsigned long long* o8 = (unsigned long long*)(ws + WS_XN + (size_t)(m0 + q) * D * 2) + lane;
#pragma unroll
            for (int j = 0; j < 4; ++j) o8[64 * j] = (unsigned long long)pk2(v[q][j].x * rstd[q], v[q][j].y * rstd[q]) | ((unsigned long long)pk2(v[q][j].z * rstd[q], v[q][j].w * rstd[q]) << 32); }
        if (m0 < T) {
            float val0 = 0.f, val1 = 0.f;
#pragma unroll
            for (int g = 0; g < 8; ++g) { float a0 = 0.f, a1 = 0.f;
#pragma unroll
                for (int j = 0; j < 4; ++j) { const f32x4 w = *(const LAS f32x4*)(WGl + g * 1024 + 256 * j + 4 * lane);
                    a0 += (v[0][j].x * w.x + v[0][j].y * w.y) + (v[0][j].z * w.z + v[0][j].w * w.w); a1 += (v[1][j].x * w.x + v[1][j].y * w.y) + (v[1][j].z * w.z + v[1][j].w * w.w); }
                a0 = wave_sum(a0) * rstd[0]; a1 = wave_sum(a1) * rstd[1];
                val0 = (lane == g) ? a0 : val0; val1 = (lane == g) ? a1 : val1; }
            if (lane < 8) { const int h = lane & 3;
#pragma unroll
                for (int q = 0; q < 2; ++q) { const int m = m0 + q, b = m / SEQ, sq = m % SEQ; const float val = q ? val1 : val0;
                    if (lane < 4) ((float*)(ws + WS_IG))[(size_t)(b * 4 + h) * SEQ + sq] = val + b_i[h];
                    else ((float*)(ws + WS_FG))[(size_t)(b * 4 + h) * SEQ + sq] = val + b_f[h]; } }
        }
    }
    __syncthreads();
    LAS float* scr = (LAS float*)(lds + wave * 16384);
    constexpr int I_IN = 16 * 48, I_KV = 16 * 8, I_OUT = 16 * 16, I_QX = 16 * 4, I_OX = 4 * 16, I_M = 32, I_13 = 16 * 2 * 128, I_2P = 24 * 2 * 128;
    constexpr int NITEMS = I_IN + I_KV + I_OUT + I_QX + I_OX + I_M + I_13 + I_2P;
    for (int it = gw; it < NITEMS; it += NGW) {
        int r = it;
        if (r < I_IN) { const int kb = r / 48, nb = r % 48; transpose_item(w_in, INW, 64 * kb, 64 * nb, (bf16*)(ws + WS_WIN), 1024, 64 * nb, 64 * kb, g_mix, (64 * nb < 512) ? C2 : 1.0f, scr, lane); continue; } r -= I_IN;
        if (r < I_KV) { const int kb = r / 8, nb = r % 8; transpose_item(w_kv_x, 512, 64 * kb, 64 * nb, (bf16*)(ws + WS_WIN), 1024, NIN + 64 * nb, 64 * kb, g_mem, 1.0f, scr, lane); continue; } r -= I_KV;
        if (r < I_OUT) { const int kb = r / 16, nb = r % 16; transpose_item(w_out, 1024, 64 * kb, 64 * nb, (bf16*)(ws + WS_WOUT), 1024, 64 * nb, 64 * kb, nullptr, 1.0f, scr, lane); continue; } r -= I_OUT;
        if (r < I_QX) { const int kb = r / 4, nb = r % 4; transpose_item(w_q_x, 256, 64 * kb, 64 * nb, (bf16*)(ws + WS_WQX), 1024, 64 * nb, 64 * kb, g_cross, C2, scr, lane); continue; } r -= I_QX;
        if (r < I_OX) { const int kb = r / 16, nb = r % 16; transpose_item(w_o_x, 1024, 64 * kb, 64 * nb, (bf16*)(ws + WS_WOX), 256, 64 * nb, 64 * kb, nullptr, 1.0f, scr, lane); continue; } r -= I_OX;
        if (r < I_M) { const int which = r / 16, h = (r % 16) / 4, kb = (r % 4) / 2, nb = r % 2;
            transpose_item((which ? w_k_m : w_q_m) + (size_t)h * 128 * 128, 128, 64 * kb, 64 * nb, (bf16*)(ws + WS_WM) + (size_t)(which * 4 + h) * 128 * 128, 128, 64 * nb, 64 * kb, nullptr,
                           which ? 0.08838834764831845f : 1.0f, scr, lane); continue; } r -= I_M;
        if (r < I_13) { const int e = r / 256, which = (r % 256) / 128, kb = (r % 128) / 8, nb = r % 8; const int n0 = 64 * nb;
            transpose_item((which ? w3 : w1) + (size_t)e * 1024 * 512, 512, 64 * kb, n0, (bf16*)(ws + WS_W13) + (size_t)e * 1024 * 1024, 1024, (n0 / 128) * 256 + which * 128 + (n0 % 128), 64 * kb, g_ffn, 1.0f, scr, lane); continue; } r -= I_13;
        { const int bk = r / 256, hf = (r % 256) / 128, kb = (r % 128) / 16, nb = r % 16; const int g = bk / 6, p = bk % 6;
          const int pa = (p < 3) ? 0 : (p < 5 ? 1 : 2), pb = (p < 3) ? p + 1 : (p < 5 ? p - 1 : 3); const int e = 4 * g + (hf ? pb : pa);
          transpose_item(w2 + (size_t)e * 512 * 1024, 1024, 64 * kb, 64 * nb, (bf16*)(ws + WS_W2P) + (size_t)bk * 1024 * 1024, 1024, 64 * nb, hf * 512 + 64 * kb, nullptr, 1.0f, scr, lane); }
    }
}

struct InProjOrder {
    pg8::StaticOrder so;
    __device__ __forceinline__ bool next(int i, pg8::Unit& u) const {
        if (so.next(i, u)) return true;
        const long L = (long)i * so.G + so.c - so.nwg;
        if (L >= 0 && L < 16) { u.pm = 256 + (int)(L >> 1); u.pn = 12 + (int)(L & 1); u.aux = 1; return true; }
        return false;
    }
    __device__ __forceinline__ void a_ready(const pg8::Unit&) const {}
    __device__ __forceinline__ void done(const pg8::Unit&) const {}
};
__device__ __forceinline__ v4u pack8(const f32x4& a, const f32x4& b) { v4u w; w.x = pk2(a[0], a[1]); w.y = pk2(a[2], a[3]); w.z = pk2(b[0], b[1]); w.w = pk2(b[2], b[3]); return w; }
struct EpiInProj {
    static constexpr bool PERM = true, AFTER_DRAIN = false;
    bf16* base; bf16* kvx; const float* rope;
    __device__ __forceinline__ void operator()(const f32x4 (&acc)[2][2][4][2], const pg8::Unit& u, int wr, int wc, int fr, int fq) const {
        if (u.aux) {
            const int row0 = (u.pm - 256) * 256 + wr * 64 + fr, col0 = (u.pn - 12) * 256 + wc * 32 + 8 * fq;
#pragma unroll
            for (int ai = 0; ai < 2; ++ai)
#pragma unroll
                for (int m = 0; m < 4; ++m) { bf16* rowp = kvx + (size_t)(row0 + ai * 128 + m * 16) * NKV + col0;
#pragma unroll
                    for (int bj = 0; bj < 2; ++bj) *(v4u*)(rowp + bj * 128) = pack8(acc[ai][bj][m][0], acc[ai][bj][m][1]); }
            return;
        }
        const int buf = u.pn >> 1; bf16* B = base + (size_t)buf * T * 512;
        const int row0 = u.pm * 256 + wr * 64 + fr, col0 = (u.pn & 1) * 256 + wc * 32 + 8 * fq;
        const bool dorope = (buf < 2) && ((wc & 1) == 0);
#pragma unroll
        for (int ai = 0; ai < 2; ++ai)
#pragma unroll
            for (int m = 0; m < 4; ++m) { const int row = row0 + ai * 128 + m * 16; bf16* rowp = B + (size_t)row * 512 + col0;
                f32x4 cs0, cs1, sn0, sn1;
                if (dorope) { const f32x4* rp = (const f32x4*)(rope + (size_t)row * 16); cs0 = rp[0]; cs1 = rp[1]; sn0 = rp[2]; sn1 = rp[3]; }
#pragma unroll
                for (int bj = 0; bj < 2; ++bj) { f32x4 v0 = acc[ai][bj][m][0], v1 = acc[ai][bj][m][1];
                    if (dorope) { f32x4 o0, o1;
#pragma unroll
                        for (int i = 0; i < 4; ++i) { o0[i] = __shfl_xor(v0[i], 16); o1[i] = __shfl_xor(v1[i], 16); }
                        if (fq == 0) { v0 = v0 * cs0 - o0 * sn0; v1 = v1 * cs1 - o1 * sn1; }
                        else if (fq == 1) { v0 = v0 * cs0 + o0 * sn0; v1 = v1 * cs1 + o1 * sn1; } }
                    *(v4u*)(rowp + bj * 128) = pack8(v0, v1); } }
    }
};

typedef short v4i16_t __attribute__((ext_vector_type(4)));
struct AttItem { int cfg, b, h, d, nb; size_t tokb; };
__device__ __forceinline__ AttItem attn_decode(int item) {
    AttItem a; a.cfg = item >> 12; int rem = item & 4095; a.b = rem >> 9; rem &= 511; a.h = rem >> 6; const int sub = rem & 63;
    a.d = (a.cfg == 0) ? 1 : (a.cfg == 1 ? 4 : 16); const int nblk = 64 / a.d, r = sub / nblk; a.nb = sub % nblk; a.tokb = (size_t)a.b * SEQ + r; return a;
}
__device__ __forceinline__ int attn_item_of(int k, int G) {
    if (G != 256) return (int)blockIdx.x + k * G;
    const int pair = (int)(blockIdx.x & 7) + 8 * (k / 6), j = (int)(blockIdx.x >> 3), ip = j * 6 + (k % 6);
    return ((ip >> 6) << 12) | (pair << 6) | (ip & 63);
}
__device__ __forceinline__ void attn_prefetch(const Args& A, LAS unsigned char* buf, int item, int lane, int wave, bf16x8 (&qf)[2]) {
    const AttItem a = attn_decode(item);
    const bf16* Kg = (const bf16*)(A.ws + WS_K) + a.h * 64; const bf16* Vg = (const bf16*)(A.ws + WS_V) + a.h * 64; const bf16* Qg = (const bf16*)(A.ws + WS_Q) + a.h * 64;
#pragma unroll
    for (int i = 0; i < 4; ++i) { const int inst = wave + 8 * i, row = 8 * inst + (lane >> 3); int u = 128 * (a.nb - 1) + row; u = (u < 0) ? row : u;
        const size_t off = (a.tokb + (size_t)u * a.d) * 512 + ((lane & 7) ^ (lane >> 3)) * 8;
        __builtin_amdgcn_global_load_lds((const unsigned*)(Kg + off), (LAS unsigned*)(buf + inst * 1024), 16, 0, 0);
        __builtin_amdgcn_global_load_lds((const unsigned*)(Vg + off), (LAS unsigned*)(buf + 32768 + inst * 1024), 16, 0, 0); }
    const size_t tq = a.tokb + (size_t)(128 * a.nb + 16 * wave + (lane & 15)) * a.d;
    qf[0] = *(const bf16x8*)(Qg + tq * 512 + 8 * (lane >> 4)); qf[1] = *(const bf16x8*)(Qg + tq * 512 + 32 + 8 * (lane >> 4));
}
__device__ __forceinline__ void attn_compute(const Args& A, LAS unsigned char* buf, int item, int lane, int wave, const bf16x8 (&qf)[2]) {
    const AttItem a = attn_decode(item);
    const int fr = lane & 15, g = lane >> 4, qi = 16 * wave + fr;
    f32x4 s[10];
#pragma unroll
    for (int tt = 0; tt < 10; ++tt) { const int t = (wave + tt < 16) ? wave + tt : 15, key = 16 * t + fr; s[tt] = (f32x4){0.f, 0.f, 0.f, 0.f};
#pragma unroll
        for (int ks = 0; ks < 2; ++ks) { const bf16x8 kf = *(const LAS bf16x8*)(buf + key * 128 + (((4 * ks + g) ^ (key & 7)) * 16));
            s[tt] = __builtin_amdgcn_mfma_f32_16x16x32_bf16(kf, qf[ks], s[tt], 0, 0, 0); } }
    float mx = -1e30f;
#pragma unroll
    for (int tt = 0; tt < 10; ++tt)
#pragma unroll
        for (int e = 0; e < 4; ++e) { const int kk = 16 * (wave + tt) + 4 * g + e;
            const bool ok = (kk >= qi) && (kk <= qi + 128) && (a.nb > 0 || kk >= 128);
            s[tt][e] = ok ? s[tt][e] : -1e30f; mx = fmaxf(mx, s[tt][e]); }
    mx = fmaxf(mx, __shfl_xor(mx, 16)); mx = fmaxf(mx, __shfl_xor(mx, 32));
    float l = 0.f;
#pragma unroll
    for (int tt = 0; tt < 10; ++tt)
#pragma unroll
        for (int e = 0; e < 4; ++e) { s[tt][e] = __builtin_amdgcn_exp2f(s[tt][e] - mx); l += s[tt][e]; }
    l += __shfl_xor(l, 16); l += __shfl_xor(l, 32);
    f32x4 o[4];
#pragma unroll
    for (int dt = 0; dt < 4; ++dt) o[dt] = (f32x4){0.f, 0.f, 0.f, 0.f};
#pragma unroll
    for (int k5 = 0; k5 < 5; ++k5) {
        const v4u pw = (v4u){pk2(s[2 * k5][0], s[2 * k5][1]), pk2(s[2 * k5][2], s[2 * k5][3]), pk2(s[2 * k5 + 1][0], s[2 * k5 + 1][1]), pk2(s[2 * k5 + 1][2], s[2 * k5 + 1][3])};
        const bf16x8 pf = __builtin_bit_cast(bf16x8, pw);
        const int t0 = (wave + 2 * k5 < 16) ? wave + 2 * k5 : 15, t1 = (wave + 2 * k5 + 1 < 16) ? wave + 2 * k5 + 1 : 15;
        const int r0 = 16 * t0 + 4 * g + (fr >> 2), r1 = 16 * t1 + 4 * g + (fr >> 2), p_ = fr & 3;
#pragma unroll
        for (int dt = 0; dt < 4; ++dt) { const int chunk = 2 * dt + (p_ >> 1);
            const v4i16_t v0 = __builtin_amdgcn_ds_read_tr16_b64_v4i16((LAS v4i16_t*)(buf + 32768 + r0 * 128 + ((chunk ^ (r0 & 7)) * 16) + 8 * (p_ & 1)));
            const v4i16_t v1 = __builtin_amdgcn_ds_read_tr16_b64_v4i16((LAS v4i16_t*)(buf + 32768 + r1 * 128 + ((chunk ^ (r1 & 7)) * 16) + 8 * (p_ & 1)));
            const bf16x8 vf = (bf16x8){v0[0], v0[1], v0[2], v0[3], v1[0], v1[1], v1[2], v1[3]};
            o[dt] = __builtin_amdgcn_mfma_f32_16x16x32_bf16(vf, pf, o[dt], 0, 0, 0); } }
    const float rl = 1.0f / l;
    const size_t tok = a.tokb + (size_t)(128 * a.nb + qi) * a.d;
    bf16* og = (bf16*)((unsigned char*)A.out + DO_OATT) + ((size_t)a.cfg * T + tok) * 512 + a.h * 64;
#pragma unroll
    for (int dt = 0; dt < 4; ++dt) *(v2u*)(og + 16 * dt + 4 * g) = (v2u){pk2(o[dt][0] * rl, o[dt][1] * rl), pk2(o[dt][2] * rl, o[dt][3] * rl)};
    if (g == 0) ((float*)(A.ws + WS_LSE))[((size_t)a.cfg * T + tok) * 8 + a.h] = mx + __builtin_amdgcn_logf(l);
}
__device__ __forceinline__ void attn_phase(const Args& A, unsigned char* lds, int n_total, int lane, int wave) {
    const int G = gridDim.x; LAS unsigned char* L = (LAS unsigned char*)lds;
    const int nk = (G == 256) ? n_total / 256 : (n_total - (int)blockIdx.x + G - 1) / G;
    if (nk <= 0) return;
    bf16x8 qa[2], qb[2];
    attn_prefetch(A, L, attn_item_of(0, G), lane, wave, qa);
    int cur = 0;
    for (int k = 0; k < nk; ++k) {
        asm volatile("s_waitcnt vmcnt(0)" ::: "memory");
        __syncthreads();
        qb[0] = qa[0]; qb[1] = qa[1];
        if (k + 1 < nk) attn_prefetch(A, L + (cur ^ 1) * 65536, attn_item_of(k + 1, G), lane, wave, qb);
        attn_compute(A, L + cur * 65536, attn_item_of(k, G), lane, wave, qa);
        qa[0] = qb[0]; qa[1] = qb[1]; cur ^= 1;
    }
    asm volatile("s_waitcnt vmcnt(0)" ::: "memory");
    __syncthreads();
}

constexpr int ML_LD = 136;
constexpr int ML_A = 0, ML_W = ML_A + 128 * ML_LD * 2, ML_KT = ML_W + 128 * ML_LD * 2, ML_VT = ML_KT + 128 * ML_LD * 2, ML_G = ML_VT + 128 * ML_LD * 2, ML_END = ML_G + 4096;
static_assert(ML_END <= LDS_MISC, "mlstm LDS");
__device__ __forceinline__ float log_sigmoidf_(float x) { return (x > 0.f) ? -log1pf(__expf(-x)) : (x - log1pf(__expf(x))); }

__device__ __forceinline__ float scan128_sum(const float* in, float* out, int lane) {
    const float v0 = in[2 * lane], v1 = in[2 * lane + 1]; float x = v0 + v1;
#pragma unroll
    for (int off = 1; off < 64; off <<= 1) { const float t = __shfl_up(x, off); if (lane >= off) x += t; }
    out[2 * lane] = x - v1; out[2 * lane + 1] = x;
    return __shfl(x, 63);
}
__device__ __forceinline__ void scan128_max(const float* in, float* out, int lane) {
    const float v0 = in[2 * lane], v1 = in[2 * lane + 1]; float x = fmaxf(v0, v1);
    float pre = -INFINITY;
    float y = x;
#pragma unroll
    for (int off = 1; off < 64; off <<= 1) { const float t = __shfl_up(y, off); if (lane >= off) y = fmaxf(y, t); }
    pre = __shfl_up(y, 1); if (lane == 0) pre = -INFINITY;
    out[2 * lane] = fmaxf(pre, v0); out[2 * lane + 1] = fmaxf(pre, x);
}

__device__ __forceinline__ void mlstm1_item(const Args& A, unsigned char* lds, int item, int tid, int lane, int wave) {
    unsigned char* ws = A.ws;
    const float* conv_w = (const float*)(ws + WS_PAR) + PAR_CONVW; const float* conv_b = (const float*)(ws + WS_PAR) + PAR_CONVB;
    const int bh = item >> 6, c = item & 63, b = bh >> 2, h = bh & 3;
    const size_t t0 = (size_t)b * SEQ + 128 * c;
    bf16* cA = (bf16*)(lds + ML_A); bf16* Wl = (bf16*)(lds + ML_W); bf16* kT = (bf16*)(lds + ML_KT); bf16* vT = (bf16*)(lds + ML_VT);
    float* gl = (float*)(lds + ML_G);
    const bf16* MU = (const bf16*)(ws + WS_MU) + h * 128; const bf16* MV = (const bf16*)(ws + WS_MV) + h * 128;
    bf16* Cg = (bf16*)((unsigned char*)A.out + DO_C) + h * 128;
    if (tid < 128) { const size_t gi = (size_t)bh * SEQ + 128 * c + tid; gl[128 + tid] = ((const float*)(ws + WS_IG))[gi]; gl[tid] = log_sigmoidf_(((const float*)(ws + WS_FG))[gi]); }
    for (int id = tid; id < 128 * 16; id += NTHR) { const int l = id >> 4, ch = (id & 15) * 8;
        float a[8];
        { const f32x4 b0 = *(const f32x4*)(conv_b + h * 128 + ch), b1 = *(const f32x4*)(conv_b + h * 128 + ch + 4);
          a[0] = b0[0]; a[1] = b0[1]; a[2] = b0[2]; a[3] = b0[3]; a[4] = b1[0]; a[5] = b1[1]; a[6] = b1[2]; a[7] = b1[3]; }
#pragma unroll
        for (int j = 0; j < 4; ++j) { const int sp = 128 * c + l + j - 3;
            if (sp >= 0) { const v4u m = *(const v4u*)(MU + ((size_t)b * SEQ + sp) * 512 + ch);
                const f32x4 w0 = *(const f32x4*)(conv_w + j * 512 + h * 128 + ch), w1 = *(const f32x4*)(conv_w + j * 512 + h * 128 + ch + 4);
                a[0] += bflo(m.x) * w0[0]; a[1] += bfhi(m.x) * w0[1]; a[2] += bflo(m.y) * w0[2]; a[3] += bfhi(m.y) * w0[3];
                a[4] += bflo(m.z) * w1[0]; a[5] += bfhi(m.z) * w1[1]; a[6] += bflo(m.w) * w1[2]; a[7] += bfhi(m.w) * w1[3]; } }
#pragma unroll
        for (int i = 0; i < 8; ++i) a[i] = a[i] * sigmoidf_(a[i]);
        const v4u o = (v4u){pk2(a[0], a[1]), pk2(a[2], a[3]), pk2(a[4], a[5]), pk2(a[6], a[7])};
        *(v4u*)(cA + l * ML_LD + ch) = o; *(v4u*)(Cg + (t0 + l) * 512 + ch) = o; }
    const bf16* Wq = (const bf16*)(ws + WS_WM) + (size_t)h * 128 * 128; const bf16* Wk = Wq + 4 * 128 * 128;
    for (int id = tid; id < 128 * 16; id += NTHR) { const int row = id >> 4, ch = (id & 15) * 8;
        *(v4u*)(Wl + row * ML_LD + ch) = *(const v4u*)(Wq + row * 128 + ch);
        const v4u vv = *(const v4u*)(MV + (t0 + row) * 512 + ch); bf16* vp = vT + ch * ML_LD + row;
        vp[0 * ML_LD] = (bf16)(vv.x & 0xffffu); vp[1 * ML_LD] = (bf16)(vv.x >> 16); vp[2 * ML_LD] = (bf16)(vv.y & 0xffffu); vp[3 * ML_LD] = (bf16)(vv.y >> 16);
        vp[4 * ML_LD] = (bf16)(vv.z & 0xffffu); vp[5 * ML_LD] = (bf16)(vv.z >> 16); vp[6 * ML_LD] = (bf16)(vv.w & 0xffffu); vp[7 * ML_LD] = (bf16)(vv.w >> 16); }
    __syncthreads();
    if (wave == 0) {
        const float blast = scan128_sum(gl, gl, lane);
        const float g0 = blast - gl[2 * lane] + gl[128 + 2 * lane], g1 = blast - gl[2 * lane + 1] + gl[128 + 2 * lane + 1];
        const float mloc = wave_max(fmaxf(g0, g1));
        gl[256 + 2 * lane] = __expf(g0 - mloc); gl[256 + 2 * lane + 1] = __expf(g1 - mloc);
        if (lane == 0) { ((float*)(ws + WS_MLOC))[item] = mloc; ((float*)(ws + WS_BLAST))[item] = blast; }
    }
    __syncthreads();
    const int fr = lane & 15, fq = lane >> 4, l = 16 * wave + fr;
    { f32x4 acc[1][8];
#pragma unroll
      for (int j = 0; j < 8; ++j) acc[0][j] = (f32x4){0.f, 0.f, 0.f, 0.f};
      wave_mma<1, 8>(cA + 16 * wave * ML_LD, ML_LD, Wl, ML_LD, 128, acc, fr, fq);
      bf16* qg = (bf16*)(ws + WS_MQ) + (t0 + l) * 512 + h * 128;
#pragma unroll
      for (int j = 0; j < 8; ++j) *(v2u*)(qg + 16 * j + 4 * fq) = (v2u){pk2(acc[0][j][0], acc[0][j][1]), pk2(acc[0][j][2], acc[0][j][3])}; }
    __syncthreads();
    for (int id = tid; id < 128 * 16; id += NTHR) { const int row = id >> 4, ch = (id & 15) * 8; *(v4u*)(Wl + row * ML_LD + ch) = *(const v4u*)(Wk + row * 128 + ch); }
    __syncthreads();
    { f32x4 acc[1][8];
#pragma unroll
      for (int j = 0; j < 8; ++j) acc[0][j] = (f32x4){0.f, 0.f, 0.f, 0.f};
      wave_mma<1, 8>(cA + 16 * wave * ML_LD, ML_LD, Wl, ML_LD, 128, acc, fr, fq);
      bf16* kg = (bf16*)(ws + WS_MK) + (t0 + l) * 512 + h * 128; const float wk = gl[256 + l];
#pragma unroll
      for (int j = 0; j < 8; ++j) { *(v2u*)(kg + 16 * j + 4 * fq) = (v2u){pk2(acc[0][j][0], acc[0][j][1]), pk2(acc[0][j][2], acc[0][j][3])};
#pragma unroll
          for (int e = 0; e < 4; ++e) kT[(16 * j + 4 * fq + e) * ML_LD + l] = (bf16)f2bf(acc[0][j][e] * wk); } }
    __syncthreads();
    { f32x4 acc[1][8];
#pragma unroll
      for (int j = 0; j < 8; ++j) acc[0][j] = (f32x4){0.f, 0.f, 0.f, 0.f};
      wave_mma<1, 8>(vT + 16 * wave * ML_LD, ML_LD, kT, ML_LD, 128, acc, fr, fq);
      float* cg = (float*)(ws + WS_CLOC) + ((size_t)item * 128 + l) * 128;
#pragma unroll
      for (int j = 0; j < 8; ++j) *(f32x4*)(cg + 16 * j + 4 * fq) = acc[0][j]; }
    if (tid < 128) { float s = 0.f; const bf16* kr = kT + tid * ML_LD;
        for (int i = 0; i < 128; i += 8) { const v4u w = *(const v4u*)(kr + i); s += (bflo(w.x) + bfhi(w.x)) + (bflo(w.y) + bfhi(w.y)) + (bflo(w.z) + bfhi(w.z)) + (bflo(w.w) + bfhi(w.w)); }
        ((float*)(ws + WS_NLOC))[(size_t)item * 128 + tid] = s; }
    __syncthreads();
}

__device__ __forceinline__ void p3_scan_combine(const Args& A, int tid) {
    unsigned char* ws = A.ws;
    const int G = gridDim.x, NGT = G * NTHR;
    for (int gid = blockIdx.x * NTHR + tid; gid < 32 * 4096; gid += NGT) {
        const int bh = gid >> 12, rem = gid & 4095, e = rem >> 5, dq = rem & 31;
        const float* MLOC = (const float*)(ws + WS_MLOC) + bh * 64; const float* BL = (const float*)(ws + WS_BLAST) + bh * 64;
        f32x4 C = (f32x4){0.f, 0.f, 0.f, 0.f}, n = (f32x4){0.f, 0.f, 0.f, 0.f}; float m = 0.f;
        for (int c = 0; c < 64; ++c) {
            const size_t idx = (size_t)bh * 64 + c;
            const f32x4 Cl = *(const f32x4*)((const float*)(ws + WS_CLOC) + (idx * 128 + e) * 128 + 4 * dq);
            *(v2u*)((bf16*)(ws + WS_CPREV) + (idx * 128 + e) * 128 + 4 * dq) = (v2u){pk2(C[0], C[1]), pk2(C[2], C[3])};
            const float ml = MLOC[c], bl = BL[c];
            const float mnew = fmaxf(bl + m, ml), a = __expf(bl + m - mnew), cc = __expf(ml - mnew);
            if (e == 0) { *(f32x4*)((float*)(ws + WS_NPREV) + idx * 128 + 4 * dq) = n;
                const f32x4 nl = *(const f32x4*)((const float*)(ws + WS_NLOC) + idx * 128 + 4 * dq); n = n * a + nl * cc;
                if (dq == 0) ((float*)(ws + WS_MPREV))[idx] = m; }
            C = C * a + Cl * cc; m = mnew;
        }
    }
    const bf16* OA = (const bf16*)((const unsigned char*)A.out + DO_OATT); const float* LSE = (const float*)(ws + WS_LSE);
    for (size_t id = (size_t)blockIdx.x * NTHR + tid; id < (size_t)T * 64; id += NGT) {
        const size_t t = id >> 6; const int h = (int)(id & 63) >> 3, ch = (int)(id & 7) * 8;
        const float l0 = LSE[t * 8 + h], l1 = LSE[((size_t)T + t) * 8 + h], l2 = LSE[((size_t)2 * T + t) * 8 + h];
        const float mx = fmaxf(l0, fmaxf(l1, l2)); float w0 = exp2f(l0 - mx), w1 = exp2f(l1 - mx), w2 = exp2f(l2 - mx);
        const float rs = 1.0f / (w0 + w1 + w2); w0 *= rs; w1 *= rs; w2 *= rs;
        const v4u a = *(const v4u*)(OA + t * 512 + h * 64 + ch), b = *(const v4u*)(OA + ((size_t)T + t) * 512 + h * 64 + ch), c = *(const v4u*)(OA + ((size_t)2 * T + t) * 512 + h * 64 + ch);
        v4u o;
        o.x = pk2(w0 * bflo(a.x) + w1 * bflo(b.x) + w2 * bflo(c.x), w0 * bfhi(a.x) + w1 * bfhi(b.x) + w2 * bfhi(c.x));
        o.y = pk2(w0 * bflo(a.y) + w1 * bflo(b.y) + w2 * bflo(c.y), w0 * bfhi(a.y) + w1 * bfhi(b.y) + w2 * bfhi(c.y));
        o.z = pk2(w0 * bflo(a.z) + w1 * bflo(b.z) + w2 * bflo(c.z), w0 * bfhi(a.z) + w1 * bfhi(b.z) + w2 * bfhi(c.z));
        o.w = pk2(w0 * bflo(a.w) + w1 * bflo(b.w) + w2 * bflo(c.w), w0 * bfhi(a.w) + w1 * bfhi(b.w) + w2 * bfhi(c.w));
        *(v4u*)((bf16*)(ws + WS_Y) + t * 1024 + h * 64 + ch) = o;
    }
}

__device__ __forceinline__ void mlstm2_item(const Args& A, unsigned char* lds, int item, int tid, int lane, int wave) {
    unsigned char* ws = A.ws;
    const float* g_mhn = (const float*)(ws + WS_PAR) + PAR_GMHN; const float* skip_m = (const float*)(ws + WS_PAR) + PAR_SKIP;
    const int bh = item >> 6, c = item & 63, b = bh >> 2, h = bh & 3;
    const size_t t0 = (size_t)b * SEQ + 128 * c;
    bf16* qA = (bf16*)(lds + ML_A); bf16* kA = (bf16*)(lds + ML_W); bf16* vT = (bf16*)(lds + ML_KT); bf16* CpT = (bf16*)(lds + ML_VT);
    float* gl = (float*)(lds + ML_G);
    const bf16* MQ = (const bf16*)(ws + WS_MQ) + h * 128; const bf16* MK = (const bf16*)(ws + WS_MK) + h * 128; const bf16* MV = (const bf16*)(ws + WS_MV) + h * 128;
    const bf16* CP = (const bf16*)(ws + WS_CPREV) + (size_t)item * 128 * 128;
    if (tid < 128) { const size_t gi = (size_t)bh * SEQ + 128 * c + tid; gl[896 + tid] = ((const float*)(ws + WS_IG))[gi]; gl[tid] = log_sigmoidf_(((const float*)(ws + WS_FG))[gi]);
        gl[640 + tid] = ((const float*)(ws + WS_NPREV))[(size_t)item * 128 + tid]; }
    for (int id = tid; id < 128 * 16; id += NTHR) { const int row = id >> 4, ch = (id & 15) * 8;
        *(v4u*)(qA + row * ML_LD + ch) = *(const v4u*)(MQ + (t0 + row) * 512 + ch);
        *(v4u*)(kA + row * ML_LD + ch) = *(const v4u*)(MK + (t0 + row) * 512 + ch);
        *(v4u*)(CpT + row * ML_LD + ch) = *(const v4u*)(CP + row * 128 + ch);
        const v4u vv = *(const v4u*)(MV + (t0 + row) * 512 + ch); bf16* vp = vT + ch * ML_LD + row;
        vp[0 * ML_LD] = (bf16)(vv.x & 0xffffu); vp[1 * ML_LD] = (bf16)(vv.x >> 16); vp[2 * ML_LD] = (bf16)(vv.y & 0xffffu); vp[3 * ML_LD] = (bf16)(vv.y >> 16);
        vp[4 * ML_LD] = (bf16)(vv.z & 0xffffu); vp[5 * ML_LD] = (bf16)(vv.z >> 16); vp[6 * ML_LD] = (bf16)(vv.w & 0xffffu); vp[7 * ML_LD] = (bf16)(vv.w >> 16); }
    __syncthreads();
    if (wave == 0) {
        const float mprev = ((const float*)(ws + WS_MPREV))[item];
        (void)scan128_sum(gl, gl, lane);
        gl[128 + 2 * lane] = gl[896 + 2 * lane] - gl[2 * lane]; gl[128 + 2 * lane + 1] = gl[896 + 2 * lane + 1] - gl[2 * lane + 1];
        scan128_max(gl + 128, gl + 896, lane);
#pragma unroll
        for (int q = 0; q < 2; ++q) { const int i = 2 * lane + q; const float bb = gl[i];
            const float mintra = bb + gl[896 + i], minter = bb + mprev, mt = fmaxf(minter, mintra);
            gl[256 + i] = bb - mt; gl[384 + i] = __expf(minter - mt); gl[512 + i] = __expf(-mt); }
    } else if (wave >= 4) {
        const int row = tid - 256;
        if (row < 128) { float s = 0.f; const bf16* qr = qA + row * ML_LD;
            for (int i = 0; i < 128; i += 8) { const v4u w = *(const v4u*)(qr + i); const float* np = gl + 640 + i;
                s += bflo(w.x) * np[0] + bfhi(w.x) * np[1] + bflo(w.y) * np[2] + bfhi(w.y) * np[3] + bflo(w.z) * np[4] + bfhi(w.z) * np[5] + bflo(w.w) * np[6] + bfhi(w.w) * np[7]; }
            gl[768 + row] = s; }
    }
    __syncthreads();
    const int fr = lane & 15, fq = lane >> 4, l = 16 * wave + fr;
    float den;
    v2u sp[8];
    { f32x4 acc[1][8];
#pragma unroll
      for (int j = 0; j < 8; ++j) acc[0][j] = (f32x4){0.f, 0.f, 0.f, 0.f};
      wave_mma<1, 8>(qA + 16 * wave * ML_LD, ML_LD, kA, ML_LD, 128, acc, fr, fq);
      const float rc = gl[256 + l]; float ds = 0.f;
#pragma unroll
      for (int j = 0; j < 8; ++j) { float p[4];
#pragma unroll
          for (int e = 0; e < 4; ++e) { const int s = 16 * j + 4 * fq + e; p[e] = (s <= l) ? acc[0][j][e] * __expf(rc + gl[128 + s]) : 0.f; ds += p[e]; }
          sp[j] = (v2u){pk2(p[0], p[1]), pk2(p[2], p[3])}; }
      ds += __shfl_xor(ds, 16); ds += __shfl_xor(ds, 32); den = ds; }
    __syncthreads();
#pragma unroll
    for (int j = 0; j < 8; ++j) *(v2u*)(kA + l * ML_LD + 16 * j + 4 * fq) = sp[j];
    __syncthreads();
    f32x4 acc[1][8];
#pragma unroll
    for (int j = 0; j < 8; ++j) acc[0][j] = (f32x4){0.f, 0.f, 0.f, 0.f};
    wave_mma<1, 8>(qA + 16 * wave * ML_LD, ML_LD, CpT, ML_LD, 128, acc, fr, fq);
    const float iw = gl[384 + l];
#pragma unroll
    for (int j = 0; j < 8; ++j) acc[0][j] = acc[0][j] * iw;
    wave_mma<1, 8>(kA + 16 * wave * ML_LD, ML_LD, vT, ML_LD, 128, acc, fr, fq);
    den += iw * gl[768 + l];
    const float rden = 1.0f / fmaxf(fabsf(den), gl[512 + l]);
    float sq = 0.f;
#pragma unroll
    for (int j = 0; j < 8; ++j) { acc[0][j] = acc[0][j] * rden; sq += (acc[0][j][0] * acc[0][j][0] + acc[0][j][1] * acc[0][j][1]) + (acc[0][j][2] * acc[0][j][2] + acc[0][j][3] * acc[0][j][3]); }
    sq += __shfl_xor(sq, 16); sq += __shfl_xor(sq, 32);
    const float rn = 1.0f / sqrtf(sq * (1.0f / 128.0f) + EPSN);
    const bf16* MOg = (const bf16*)(ws + WS_MO) + (t0 + l) * 512 + h * 128; const bf16* Cg = (const bf16*)((const unsigned char*)A.out + DO_C) + (t0 + l) * 512 + h * 128;
    bf16* yg = (bf16*)(ws + WS_Y) + (t0 + l) * 1024 + 512 + h * 128;
#pragma unroll
    for (int j = 0; j < 8; ++j) { const int e0 = 16 * j + 4 * fq;
        const v2u mo = *(const v2u*)(MOg + e0), cc = *(const v2u*)(Cg + e0);
        const f32x4 gm = *(const f32x4*)(g_mhn + h * 128 + e0), sk = *(const f32x4*)(skip_m + h * 128 + e0);
        const float y0 = sigmoidf_(bflo(mo.x)) * (acc[0][j][0] * rn * gm[0] + sk[0] * bflo(cc.x));
        const float y1 = sigmoidf_(bfhi(mo.x)) * (acc[0][j][1] * rn * gm[1] + sk[1] * bfhi(cc.x));
        const float y2 = sigmoidf_(bflo(mo.y)) * (acc[0][j][2] * rn * gm[2] + sk[2] * bflo(cc.y));
        const float y3 = sigmoidf_(bfhi(mo.y)) * (acc[0][j][3] * rn * gm[3] + sk[3] * bfhi(cc.y));
        *(v2u*)(yg + e0) = (v2u){pk2(y0, y1), pk2(y2, y3)}; }
    __syncthreads();
}

struct EpiOutProj {
    static constexpr bool PERM = false, AFTER_DRAIN = false;
    const float* x; float* x1; bf16* x1b; float* ss;
    __device__ __forceinline__ void operator()(const f32x4 (&acc)[2][2][4][2], const pg8::Unit& u, int wr, int wc, int fr, int fq) const {
        const int row0 = u.pm * 256 + wr * 64 + fr, col0 = u.pn * 256 + wc * 32 + 4 * fq;
#pragma unroll
        for (int ai = 0; ai < 2; ++ai)
#pragma unroll
            for (int m = 0; m < 4; ++m) { const int row = row0 + ai * 128 + m * 16; float sq = 0.f;
#pragma unroll
                for (int bj = 0; bj < 2; ++bj)
#pragma unroll
                    for (int n = 0; n < 2; ++n) { const size_t off = (size_t)row * D + col0 + bj * 128 + n * 16;
                        const f32x4 o = *(const f32x4*)(x + off) + acc[ai][bj][m][n];
                        *(f32x4*)(x1 + off) = o; *(v2u*)(x1b + off) = (v2u){pk2(o[0], o[1]), pk2(o[2], o[3])};
                        sq += (o[0] * o[0] + o[1] * o[1]) + (o[2] * o[2] + o[3] * o[3]); }
                sq += __shfl_xor(sq, 16); sq += __shfl_xor(sq, 32);
                if (fq == 0) ss[(size_t)row * 16 + u.pn * 4 + wc] = sq; }
    }
};
struct EpiQx {
    static constexpr bool PERM = true, AFTER_DRAIN = false;
    bf16* qx; const LAS float* rs;
    __device__ __forceinline__ void operator()(const f32x4 (&acc)[2][2][4][2], const pg8::Unit& u, int wr, int wc, int fr, int fq) const {
        const int rl0 = wr * 64 + fr, col0 = wc * 32 + 8 * fq;
#pragma unroll
        for (int ai = 0; ai < 2; ++ai)
#pragma unroll
            for (int m = 0; m < 4; ++m) { const int rl = rl0 + ai * 128 + m * 16; const float sc = rs[rl]; bf16* rowp = qx + (size_t)(u.pm * 256 + rl) * 256 + col0;
#pragma unroll
                for (int bj = 0; bj < 2; ++bj) *(v4u*)(rowp + bj * 128) = pack8(acc[ai][bj][m][0] * sc, acc[ai][bj][m][1] * sc);
                asm volatile("" ::: "memory"); }
    }
};
struct EpiOx {
    static constexpr bool PERM = false, AFTER_DRAIN = false;
    float* x1; float* xo;
    __device__ __forceinline__ void operator()(const f32x4 (&acc)[2][2][4][2], const pg8::Unit& u, int wr, int wc, int fr, int fq) const {
        const int row0 = u.pm * 256 + wr * 64 + fr, col0 = u.pn * 256 + wc * 32 + 4 * fq;
#pragma unroll
        for (int ai = 0; ai < 2; ++ai)
#pragma unroll
            for (int m = 0; m < 4; ++m)
#pragma unroll
                for (int bj = 0; bj < 2; ++bj)
#pragma unroll
                    for (int n = 0; n < 2; ++n) { const size_t off = (size_t)(row0 + ai * 128 + m * 16) * D + col0 + bj * 128 + n * 16; *(f32x4*)(xo + off) = *(const f32x4*)(x1 + off) + acc[ai][bj][m][n]; if (bj == 1 && n == 1) asm volatile("" ::: "memory"); }
    }
};
constexpr int CX_QLD = 72, CX_KLD = 72, CX_VLD = 264, CX_PLD = 264;
constexpr int CX_Q = 0, CX_K = CX_Q + 128 * CX_QLD * 2, CX_V = CX_K + 256 * CX_KLD * 2, CX_P = CX_V + 64 * CX_VLD * 2, CX_END = CX_P + 8 * 16 * CX_PLD * 2;
static_assert(CX_END <= LDS_MISC, "cross LDS");
__device__ __forceinline__ void cross_item(const Args& A, unsigned char* lds, int item, int tid, int lane, int wave) {
    unsigned char* ws = A.ws;
    const int rt = item >> 2, h = item & 3; const size_t t0 = (size_t)rt * 128; const int b = (int)(t0 / SEQ);
    bf16* Qs = (bf16*)(lds + CX_Q); bf16* Ks = (bf16*)(lds + CX_K); bf16* Vt = (bf16*)(lds + CX_V); bf16* Ps = (bf16*)(lds + CX_P) + wave * 16 * CX_PLD;
    const bf16* QX = (const bf16*)(ws + WS_QX) + h * 64; const bf16* KV = (const bf16*)(ws + WS_KVX) + (size_t)b * MEMLEN * NKV + h * 64;
    for (int id = tid; id < 128 * 8; id += NTHR) { const int row = id >> 3, ch = id & 7; *(v4u*)(Qs + row * CX_QLD + ch * 8) = *(const v4u*)(QX + (t0 + row) * 256 + ch * 8); }
    for (int id = tid; id < 256 * 8; id += NTHR) { const int kk = id >> 3, ch = id & 7;
        *(v4u*)(Ks + kk * CX_KLD + ch * 8) = *(const v4u*)(KV + (size_t)kk * NKV + ch * 8);
        const v4u vv = *(const v4u*)(KV + (size_t)kk * NKV + 256 + ch * 8); bf16* vp = Vt + (ch * 8) * CX_VLD + kk;
        vp[0 * CX_VLD] = (bf16)(vv.x & 0xffffu); vp[1 * CX_VLD] = (bf16)(vv.x >> 16); vp[2 * CX_VLD] = (bf16)(vv.y & 0xffffu); vp[3 * CX_VLD] = (bf16)(vv.y >> 16);
        vp[4 * CX_VLD] = (bf16)(vv.z & 0xffffu); vp[5 * CX_VLD] = (bf16)(vv.z >> 16); vp[6 * CX_VLD] = (bf16)(vv.w & 0xffffu); vp[7 * CX_VLD] = (bf16)(vv.w >> 16); }
    __syncthreads();
    const int fr = lane & 15, fq = lane >> 4;
    f32x4 s[1][16];
#pragma unroll
    for (int j = 0; j < 16; ++j) s[0][j] = (f32x4){0.f, 0.f, 0.f, 0.f};
    wave_mma<1, 16>(Qs + 16 * wave * CX_QLD, CX_QLD, Ks, CX_KLD, 64, s, fr, fq);
    float mx = -1e30f;
#pragma unroll
    for (int j = 0; j < 16; ++j)
#pragma unroll
        for (int e = 0; e < 4; ++e) mx = fmaxf(mx, s[0][j][e]);
    mx = fmaxf(mx, __shfl_xor(mx, 16)); mx = fmaxf(mx, __shfl_xor(mx, 32));
    float l = 0.f;
#pragma unroll
    for (int j = 0; j < 16; ++j) { f32x4 p;
#pragma unroll
        for (int e = 0; e < 4; ++e) { p[e] = exp2f(s[0][j][e] - mx); l += p[e]; }
        *(v2u*)(Ps + fr * CX_PLD + 16 * j + 4 * fq) = (v2u){pk2(p[0], p[1]), pk2(p[2], p[3])}; }
    l += __shfl_xor(l, 16); l += __shfl_xor(l, 32);
    __syncthreads();
    f32x4 o[1][4];
#pragma unroll
    for (int j = 0; j < 4; ++j) o[0][j] = (f32x4){0.f, 0.f, 0.f, 0.f};
    wave_mma<1, 4>(Ps, CX_PLD, Vt, CX_VLD, 256, o, fr, fq);
    const float rl = 1.0f / l;
    bf16* og = (bf16*)(ws + WS_OX) + (t0 + 16 * wave + fr) * 256 + h * 64;
#pragma unroll
    for (int j = 0; j < 4; ++j) *(v2u*)(og + 16 * j + 4 * fq) = (v2u){pk2(o[0][j][0] * rl, o[0][j][1] * rl), pk2(o[0][j][2] * rl, o[0][j][3] * rl)};
    __syncthreads();
}

struct TokInfo { int bucket; float wa, wb; int rank; };
constexpr size_t WS_CNTTAB = 31 * MiB + 512 * 1024;
__device__ __forceinline__ void p9_route(const Args& A, unsigned char* lds, int tid, int lane, int wave) {
    unsigned char* ws = A.ws;
    const float* b_rg = (const float*)(ws + WS_PAR) + PAR_BRG; const float* b_re = (const float*)(ws + WS_PAR) + PAR_BRE;
    LAS float* WRl = (LAS float*)lds;
    LAS int* bkl = (LAS int*)(lds + 81920);
    for (int i = tid; i < 20 * 1024 / 4; i += NTHR) ((LAS f32x4*)WRl)[i] = ((const f32x4*)(ws + WS_WR))[i];
    __syncthreads();
    bf16* HBN = (bf16*)(ws + WS_HBS);
    for (int chunk = blockIdx.x; chunk < T / 256; chunk += gridDim.x) {
        for (int r = 0; r < 32; ++r) {
            const int m = chunk * 256 + wave * 32 + r;
            const f32x4* xr = (const f32x4*)(A.out + (size_t)m * D) + lane;
            f32x4 v[4]; float s = 0.f;
#pragma unroll
            for (int j = 0; j < 4; ++j) { v[j] = xr[64 * j]; s += (v[j].x * v[j].x + v[j].y * v[j].y) + (v[j].z * v[j].z + v[j].w * v[j].w); }
            const float rstd = 1.0f / sqrtf(wave_sum(s) * (1.0f / D) + EPSN);
            unsigned long long* o8 = (unsigned long long*)(HBN + (size_t)m * D) + lane;
#pragma unroll
            for (int j = 0; j < 4; ++j) o8[64 * j] = (unsigned long long)pk2(v[j].x * rstd, v[j].y * rstd) | ((unsigned long long)pk2(v[j].z * rstd, v[j].w * rstd) << 32);
            float gl4[4];
#pragma unroll
            for (int e = 0; e < 4; ++e) { float a = 0.f;
#pragma unroll
                for (int j = 0; j < 4; ++j) { const f32x4 w = *(const LAS f32x4*)(WRl + e * 1024 + 256 * j + 4 * lane); a += (v[j].x * w.x + v[j].y * w.y) + (v[j].z * w.z + v[j].w * w.w); }
                gl4[e] = wave_sum(a) * rstd + b_rg[e]; }
            int g = 0; float gm = gl4[0];
#pragma unroll
            for (int i = 1; i < 4; ++i) if (gl4[i] > gm) { gm = gl4[i]; g = i; }
            g = __builtin_amdgcn_readfirstlane(g);
            float gs = 0.f;
#pragma unroll
            for (int i = 0; i < 4; ++i) gs += __expf(gl4[i] - gm);
            const float gw_ = 1.0f / gs;
            float el[4];
            const LAS float* WRe = WRl + (4 + 4 * g) * 1024;
#pragma unroll
            for (int e = 0; e < 4; ++e) { float a = 0.f;
#pragma unroll
                for (int j = 0; j < 4; ++j) { const f32x4 w = *(const LAS f32x4*)(WRe + e * 1024 + 256 * j + 4 * lane); a += (v[j].x * w.x + v[j].y * w.y) + (v[j].z * w.z + v[j].w * w.w); }
                el[e] = wave_sum(a) * rstd + b_re[g * 4 + e]; }
            int i0 = 0; float v0 = el[0];
#pragma unroll
            for (int i = 1; i < 4; ++i) if (el[i] > v0) { v0 = el[i]; i0 = i; }
            int i1 = -1; float v1 = -INFINITY;
#pragma unroll
            for (int i = 0; i < 4; ++i) if (i != i0 && el[i] > v1) { v1 = el[i]; i1 = i; }
            const float e1 = __expf(v1 - v0); const float w0 = gw_ / (1.0f + e1), w1 = gw_ * e1 / (1.0f + e1);
            const int pa = i0 < i1 ? i0 : i1, pb = i0 < i1 ? i1 : i0;
            const int pidx = (pa == 0) ? (pb - 1) : (pa == 1 ? pb + 1 : 5);
            const int bucket = g * 6 + pidx;
            if (lane == 0) { bkl[wave * 32 + r] = bucket; ((LAS float*)(bkl + 256))[wave * 32 + r] = (i0 < i1) ? w0 : w1; ((LAS float*)(bkl + 512))[wave * 32 + r] = (i0 < i1) ? w1 : w0; }
        }
        __syncthreads();
        if (tid < 256) { const int my = bkl[tid]; int rank = 0; for (int j = 0; j < tid; ++j) rank += (bkl[j] == my) ? 1 : 0;
            TokInfo ti; ti.bucket = my; ti.wa = ((LAS float*)(bkl + 256))[tid]; ti.wb = ((LAS float*)(bkl + 512))[tid]; ti.rank = rank;
            ((TokInfo*)(ws + WS_TOKINFO))[chunk * 256 + tid] = ti; }
        else if (tid < 256 + NBUCKET) { const int b = tid - 256; int c = 0; for (int j = 0; j < 256; ++j) c += (bkl[j] == b) ? 1 : 0;
            ((int*)(ws + WS_CNTTAB))[chunk * NBUCKET + b] = c; }
        __syncthreads();
    }
}
__device__ __forceinline__ void p10_slots(const Args& A, unsigned char* lds, int tid, int lane, int wave) {
    unsigned char* ws = A.ws;
    LAS int* tabl = (LAS int*)lds;
    LAS int* totl = (LAS int*)(lds + 32768);
    const int* CNTTAB = (const int*)(ws + WS_CNTTAB);
    for (int i = tid; i < 256 * NBUCKET; i += NTHR) tabl[i] = CNTTAB[i];
    __syncthreads();
    if (tid < NBUCKET) { int t = 0; for (int w = 0; w < 256; ++w) t += tabl[w * NBUCKET + tid]; totl[tid] = t; }
    __syncthreads();
    if (tid == 0) { int acc = 0; for (int b = 0; b < NBUCKET; ++b) { totl[32 + b] = acc; acc += ((totl[b] + 255) >> 8) * 256; } totl[32 + NBUCKET] = acc; }
    if (blockIdx.x == 0 && tid < NBUCKET) ((unsigned*)(ws + WS_CTL))[CW_CNT + tid] = (unsigned)totl[tid];
    __syncthreads();
    int* TOKMAP = (int*)(ws + WS_TOKMAP); float* WSORT = (float*)(ws + WS_WSORT);
    for (int chunk = blockIdx.x; chunk < T / 256; chunk += gridDim.x) {
        if (tid < NBUCKET) { int s = 0; for (int w = 0; w < chunk; ++w) s += tabl[w * NBUCKET + tid]; totl[64 + tid] = totl[32 + tid] + s; }
        __syncthreads();
        if (tid < 256) { const int m = chunk * 256 + tid; const TokInfo ti = ((const TokInfo*)(ws + WS_TOKINFO))[m]; const int slot = totl[64 + ti.bucket] + ti.rank;
            TOKMAP[slot] = m; WSORT[2 * slot] = ti.wa; WSORT[2 * slot + 1] = ti.wb; }
        __syncthreads();
    }
    for (int b = blockIdx.x; b < NBUCKET; b += gridDim.x)
        for (int r = totl[32 + b] + totl[b] + tid; r < totl[32 + b + 1]; r += NTHR) { TOKMAP[r] = -1; WSORT[2 * r] = 0.f; WSORT[2 * r + 1] = 0.f; }
}
struct MoeOrder {
    int G, c, nunits, ncol; const int* tab;
    __device__ __forceinline__ bool next(int i, pg8::Unit& u) const {
        const long L = (long)i * G + c; if (L >= nunits) return false;
        const int rt = (int)L / ncol, j = (int)L % ncol, bk = tab[rt];
        u.pm = rt; u.aux = j;
        if (ncol == 8) { const int g = bk / 6, p = bk % 6; const int pa = (p < 3) ? 0 : (p < 5 ? 1 : 2), pb = (p < 3) ? p + 1 : (p < 5 ? p - 1 : 3);
            const int e = 4 * g + ((j >> 2) ? pb : pa); u.pn = e * 4 + (j & 3); }
        else u.pn = bk * 4 + j;
        return true;
    }
    __device__ __forceinline__ void a_ready(const pg8::Unit&) const {}
    __device__ __forceinline__ void done(const pg8::Unit&) const {}
};
struct EpiUp {
    static constexpr bool PERM = true, AFTER_DRAIN = false;
    bf16* act; const float* wsort;
    __device__ __forceinline__ void operator()(const f32x4 (&acc)[2][2][4][2], const pg8::Unit& u, int wr, int wc, int fr, int fq) const {
        const int row0 = u.pm * 256 + wr * 64 + fr, half = u.aux >> 2, col0 = half * 512 + (u.aux & 3) * 128 + wc * 32 + 8 * fq;
#pragma unroll
        for (int ai = 0; ai < 2; ++ai)
#pragma unroll
            for (int m = 0; m < 4; ++m) { const int row = row0 + ai * 128 + m * 16; const float w = wsort[2 * row + half];
                f32x4 r0, r1;
#pragma unroll
                for (int i = 0; i < 4; ++i) { const float a0 = acc[ai][0][m][0][i], a1 = acc[ai][0][m][1][i];
                    r0[i] = a0 * sigmoidf_(a0) * acc[ai][1][m][0][i] * w; r1[i] = a1 * sigmoidf_(a1) * acc[ai][1][m][1][i] * w; }
                *(v4u*)(act + (size_t)row * D + col0) = pack8(r0, r1); }
    }
};
struct EpiDown {
    static constexpr bool PERM = false, AFTER_DRAIN = false;
    float* x2; float* xo; const int* tokmap;
    __device__ __forceinline__ void operator()(const f32x4 (&acc)[2][2][4][2], const pg8::Unit& u, int wr, int wc, int fr, int fq) const {
        const int row0 = u.pm * 256 + wr * 64 + fr, col0 = u.aux * 256 + wc * 32 + 4 * fq;
#pragma unroll
        for (int ai = 0; ai < 2; ++ai)
#pragma unroll
            for (int m = 0; m < 4; ++m) { const int tok = tokmap[row0 + ai * 128 + m * 16];
                if (tok >= 0) {
#pragma unroll
                    for (int bj = 0; bj < 2; ++bj)
#pragma unroll
                        for (int n = 0; n < 2; ++n) { const size_t off = (size_t)tok * D + col0 + bj * 128 + n * 16; *(f32x4*)(xo + off) = *(const f32x4*)(x2 + off) + acc[ai][bj][m][n]; } } }
    }
};
__device__ __forceinline__ void p10_final(const Args& A, float* outp, int lane, int wave) {
    const float* g_final = (const float*)(A.ws + WS_PAR) + PAR_GFIN;
    const int G = gridDim.x, gw = blockIdx.x * NWAVES + wave, NGW = G * NWAVES;
    f32x4 gv[4];
#pragma unroll
    for (int j = 0; j < 4; ++j) gv[j] = *((const f32x4*)g_final + lane + 64 * j);
    for (int m = gw; m < T; m += NGW) {
        f32x4* xr = (f32x4*)(A.out + (size_t)m * D) + lane;
        f32x4 v[4]; float s = 0.f;
#pragma unroll
        for (int j = 0; j < 4; ++j) { v[j] = xr[64 * j]; s += (v[j].x * v[j].x + v[j].y * v[j].y) + (v[j].z * v[j].z + v[j].w * v[j].w); }
        const float rstd = 1.0f / sqrtf(wave_sum(s) * (1.0f / D) + EPSN);
#pragma unroll
        for (int j = 0; j < 4; ++j) ((f32x4*)(outp + (size_t)m * D) + lane)[64 * j] = v[j] * rstd * gv[j];
    }
}

#ifndef MS
#define MS 4
#endif
#ifndef N_LAUNCHES
#define N_LAUNCHES 1
#endif
constexpr int N_PHASES = 14;
#ifndef DUP_MASK
#define DUP_MASK 0
#endif
#define REP(k) for (int rep_ = 0; rep_ < (((DUP_MASK >> (k)) & 1) ? 2 : 1); ++rep_)
#ifndef QX_SP2
#define QX_SP2 false
#endif

#ifndef NVG
#define NVG 256
#endif
__global__ void __launch_bounds__(NTHR, 2) __attribute__((amdgpu_num_vgpr(NVG))) fwd_kernel(Args args) {
    __shared__ __attribute__((aligned(16))) unsigned char lds[LDS_BYTES];
    const int tid = threadIdx.x, lane = tid & 63, wave = __builtin_amdgcn_readfirstlane(tid >> 6);
    gu32* ctl = (gu32*)(args.ws + WS_CTL);
    for (int u = tid; u < (LDS_BYTES - LDS_MISC) / 4; u += NTHR) ((unsigned*)(lds + LDS_MISC))[u] = 0u;
    __syncthreads();
    const int lo = args.ph_lo, hi = args.ph_hi;
    const bool use_bar = (hi - lo) > 1;
    XcdBarrier bar; bar.bar = (unsigned*)ctl + CW_BAR; bar.x = 0; bar.st = (volatile LAS unsigned*)(lds + LDS_MISC) + 8;
    if (use_bar) bar = xcd_barrier_post((unsigned*)ctl + CW_BAR, (volatile LAS unsigned*)(lds + LDS_MISC) + 8);
#ifndef PH_MASK
#define PH_MASK 0xFFFF
#endif
#define IN(k) (((PH_MASK >> (k)) & 1) && lo <= (k) && (k) < hi)
#define SEAM(k) do { if (IN(k) && IN((k) + 1)) xcd_barrier(bar); } while (0)
    PG8_LAS unsigned char* ring = (PG8_LAS unsigned char*)lds;
    const int G = gridDim.x;
#define PHASE_PTRS Args pa = args; { unsigned char* w_ = args.ws; float* o_ = args.out; asm volatile("" : "+s"(w_), "+s"(o_)); pa.ws = w_; pa.out = o_; } unsigned char* const ws = pa.ws; (void)ws

#ifdef DUMMY_LIVE
    float dl0, dl1, dl2, dl3, dl4, dl5, dl6, dl7; asm volatile("" : "=v"(dl0), "=v"(dl1), "=v"(dl2), "=v"(dl3), "=v"(dl4), "=v"(dl5), "=v"(dl6), "=v"(dl7));
#endif
    if (IN(0)) { PHASE_PTRS; REP(0) { p0_prologue(pa, lds, tid, lane, wave); __syncthreads(); } }
    SEAM(0);
    if (IN(1) && MS >= 1) { PHASE_PTRS;
        pg8::Gemm g{(const pg8::bf16_t*)(ws + WS_XN), (const pg8::bf16_t*)(ws + WS_WIN), T + TMEM, NIN + NKV, D};
        InProjOrder S; S.so.init(T, NIN, G, (int)blockIdx.x);
        EpiInProj E{(bf16*)(ws + WS_Q), (bf16*)(ws + WS_KVX), (const float*)(ws + WS_ROPE)};
        REP(1) pg8::gemm_phase<EpiInProj, InProjOrder, true, true>(ring, g, S, E);
    }
    SEAM(1);
    if (IN(2) && MS >= 1) { PHASE_PTRS;
        const int n_att = (MS >= 2) ? 3 * 4096 : 0;
        REP(14) attn_phase(pa, lds, n_att, lane, wave);
        REP(15) for (int it = blockIdx.x; it < 2048; it += G) mlstm1_item(pa, lds, it, tid, lane, wave);
    }
    SEAM(2);
    if (IN(3) && MS >= 1) { PHASE_PTRS;
        if (MS < 2) {
            for (size_t id = (size_t)blockIdx.x * NTHR + tid; id < (size_t)T * 64; id += (size_t)G * NTHR) { const size_t t = id >> 6; const int c8 = (int)(id & 63) * 8;
                *(v4u*)((bf16*)(ws + WS_Y) + t * 1024 + c8) = (v4u){0u, 0u, 0u, 0u}; }
        }
        REP(3) p3_scan_combine(pa, tid);
    }
    SEAM(3);
    if (IN(4) && MS >= 1) { PHASE_PTRS; REP(4) for (int it = blockIdx.x; it < 2048; it += G) mlstm2_item(pa, lds, it, tid, lane, wave); }
    SEAM(4);
    if (IN(5)) { PHASE_PTRS;
        if (MS >= 1) {
            pg8::Gemm g{(const pg8::bf16_t*)(ws + WS_Y), (const pg8::bf16_t*)(ws + WS_WOUT), T, D, D};
            pg8::StaticOrder S; S.init(T, D, G, (int)blockIdx.x);
            EpiOutProj E{(const float*)pa.in[0], pa.out, (bf16*)(ws + WS_X1B), (float*)(ws + WS_SS1)};
            REP(5) pg8::gemm_phase<EpiOutProj, pg8::StaticOrder, true, true>(ring, g, S, E);
        } else {
            const int gw = blockIdx.x * NWAVES + wave, NGW = G * NWAVES;
            for (int m = gw; m < T; m += NGW) { const f32x4* xr = (const f32x4*)((const float*)pa.in[0] + (size_t)m * D) + lane; f32x4* o = (f32x4*)(pa.out + (size_t)m * D) + lane;
#pragma unroll
                for (int j = 0; j < 4; ++j) o[64 * j] = xr[64 * j]; }
        }
    }
    SEAM(5);
    if (IN(6) && MS >= 3) { PHASE_PTRS;
        pg8::Gemm g{(const pg8::bf16_t*)(ws + WS_X1B), (const pg8::bf16_t*)(ws + WS_WQX), T, 256, D};
        pg8::StaticOrder S; S.init(T, 256, G, (int)blockIdx.x);
        float* rs = (float*)(lds + LDS_RS);
        { pg8::Unit u0; if (S.next(0, u0) && tid < 256) { const f32x4* sp = (const f32x4*)((const float*)(ws + WS_SS1) + (size_t)(u0.pm * 256 + tid) * 16);
              const f32x4 a = sp[0], b = sp[1], c = sp[2], d = sp[3];
              const float s = ((a[0] + a[1]) + (a[2] + a[3])) + ((b[0] + b[1]) + (b[2] + b[3])) + ((c[0] + c[1]) + (c[2] + c[3])) + ((d[0] + d[1]) + (d[2] + d[3]));
              rs[tid] = 1.0f / sqrtf(s * (1.0f / D) + EPSN); } }
        __syncthreads();
        EpiQx E{(bf16*)(ws + WS_QX), (const LAS float*)rs};
        REP(6) pg8::gemm_phase<EpiQx, pg8::StaticOrder, true, QX_SP2>(ring, g, S, E);
    }
    SEAM(6);
    if (IN(7) && MS >= 3) { PHASE_PTRS; REP(7) for (int it = blockIdx.x; it < (T / 128) * 4; it += G) cross_item(pa, lds, it, tid, lane, wave); }
    SEAM(7);
    if (IN(8) && MS >= 3) { PHASE_PTRS;
        int kdyn = 256; asm volatile("" : "+s"(kdyn));
        pg8::Gemm g{(const pg8::bf16_t*)(ws + WS_OX), (const pg8::bf16_t*)(ws + WS_WOX), T, D, kdyn};
        pg8::StaticOrder S; S.init(T, D, G, (int)blockIdx.x);
        REP(8) { EpiOx E{pa.out, (((DUP_MASK >> 8) & 1) && rep_ == 0) ? (float*)(ws + 404 * MiB) : pa.out};
        pg8::gemm_phase<EpiOx, pg8::StaticOrder, false, true>(ring, g, S, E); }
    }
    SEAM(8);
    if (IN(9) && MS >= 4) { PHASE_PTRS; p9_route(pa, lds, tid, lane, wave); }
    SEAM(9);
    if (IN(10) && MS >= 4) { PHASE_PTRS; p10_slots(pa, lds, tid, lane, wave); }
    SEAM(10);
    if ((IN(11) || IN(12)) && MS >= 4) { PHASE_PTRS;
        int* tab = (int*)(lds + LDS_TAB);
        if (tid == 0) { int nrt = 0; const unsigned* cnt = (const unsigned*)(ws + WS_CTL) + CW_CNT;
            for (int i = 0; i < NBUCKET; ++i) { const int nt = (int)((__hip_atomic_load(cnt + i, __ATOMIC_RELAXED, __HIP_MEMORY_SCOPE_AGENT) + 255u) >> 8); for (int k = 0; k < nt; ++k) tab[1 + nrt++] = i; }
            tab[0] = nrt; }
        __syncthreads();
        const int nrt = tab[0];
        if (IN(11)) {
            pg8::Gemm g{(const pg8::bf16_t*)(ws + WS_HBS), (const pg8::bf16_t*)(ws + WS_W13), ROWS_MAX, 64 * 256, D, (const int*)(ws + WS_TOKMAP)};
            MoeOrder S{G, (int)blockIdx.x, nrt * 8, 8, tab + 1};
            EpiUp E{(bf16*)(ws + WS_ACT), (const float*)(ws + WS_WSORT)};
            REP(11) pg8::gemm_phase<EpiUp, MoeOrder, true, true, true>(ring, g, S, E);
        }
        SEAM(11);
        if (IN(12)) {
            pg8::Gemm g{(const pg8::bf16_t*)(ws + WS_ACT), (const pg8::bf16_t*)(ws + WS_W2P), ROWS_MAX, 96 * 256, D};
            MoeOrder S{G, (int)blockIdx.x, nrt * 4, 4, tab + 1};
            REP(12) { EpiDown E{pa.out, (((DUP_MASK >> 12) & 1) && rep_ == 0) ? (float*)(ws + 544 * MiB) : pa.out, (const int*)(ws + WS_TOKMAP)};
            pg8::gemm_phase<EpiDown, MoeOrder, true, true>(ring, g, S, E); }
        }
    }
    SEAM(12);
    if (IN(13)) { PHASE_PTRS; REP(13) p10_final(pa, (((DUP_MASK >> 13) & 1) && rep_ == 0) ? (float*)(ws + 544 * MiB) : pa.out, lane, wave); }
#ifdef DUMMY_LIVE
    asm volatile("" :: "v"(dl0), "v"(dl1), "v"(dl2), "v"(dl3), "v"(dl4), "v"(dl5), "v"(dl6), "v"(dl7));
#endif
#undef IN
#undef SEAM
}

extern "C" void kernel_launch(void* const* d_in, const int* in_sizes, int n_in, void* d_out, int out_size, void* d_ws, size_t ws_size, hipStream_t stream) {
    static int grid = 0;
    if (grid == 0) {
        if (n_in != 28 || out_size != T * D || ws_size < WS_END) { fprintf(stderr, "kernel_launch: unexpected problem (n_in %d, out %d, ws %zu)\n", n_in, out_size, ws_size); grid = -1; return; }
        int dev = 0, cus = 0, per_cu = 0;
        if (hipGetDevice(&dev) != hipSuccess || hipDeviceGetAttribute(&cus, hipDeviceAttributeMultiprocessorCount, dev) != hipSuccess) { grid = -1; return; }
        if (hipOccupancyMaxActiveBlocksPerMultiprocessor(&per_cu, (const void*)fwd_kernel, NTHR, 0) != hipSuccess || per_cu < 1) { fprintf(stderr, "kernel_launch: occupancy query failed (%d)\n", per_cu); per_cu = 1; }
        (void)hipGetLastError();
        grid = cus * (per_cu > 1 ? 1 : per_cu);
        if (grid > 256) grid = 256;
    }
    if (grid < 0) return;
    (void)hipMemsetAsync((char*)d_ws + WS_CTL, 0, CTL_ZERO_BYTES, stream);
    Args a{};
    for (int i = 0; i < 28; ++i) a.in[i] = d_in[i];
    a.out = (float*)d_out; a.ws = (unsigned char*)d_ws;
    if (N_LAUNCHES == 1) {
        a.ph_lo = 0; a.ph_hi = N_PHASES;
        void* kargs[] = {&a};
        hipError_t e = hipLaunchCooperativeKernel((const void*)fwd_kernel, dim3(grid), dim3(NTHR), kargs, 0, stream);
        if (e != hipSuccess) fprintf(stderr, "kernel_launch: cooperative launch failed: %s (grid %d)\n", hipGetErrorString(e), grid);
    } else {
        for (int p = 0; p < N_PHASES; ++p) { a.ph_lo = p; a.ph_hi = p + 1; hipLaunchKernelGGL(fwd_kernel, dim3(grid), dim3(NTHR), 0, stream, a); }
    }
}
```

```cpp
#include <hip/hip_runtime.h>
#include <cstdio>
#include <cstdint>
namespace pg8 {
#define PG8_LAS __attribute__((address_space(3)))
typedef unsigned short bf16_t;
typedef short bf16x8 __attribute__((ext_vector_type(8)));
typedef float f32x4 __attribute__((ext_vector_type(4)));
typedef unsigned u32x4 __attribute__((ext_vector_type(4)));
constexpr int BM = 256, BK = 64, HALF = 128, HTB = HALF * BK * 2  , STAGE_BYTES = 8 * HTB, NXCD = 8, WGM = 8;

__host__ __device__ __forceinline__ int lds_byte(int r, int c) { const int st = (r >> 4) * 2 + (c >> 5), rr = r & 15, cc = c & 31, ob = rr * 64 + cc * 2; return st * 1024 + (ob ^ (((ob >> 9) & 1) << 5)); }
__host__ __device__ __forceinline__ void stage_rc(int b, int& R, int& C) { const int st = b / 1024, sb = b % 1024, swz = sb ^ (((sb >> 9) & 1) << 5); R = (st >> 1) * 16 + swz / 64; C = (st & 1) * 32 + (swz % 64) / 2; }
__host__ __device__ __forceinline__ int perm32(int rho) { const int n = rho >> 4, i = rho & 15; return 8 * (i >> 2) + 4 * n + (i & 3); }

struct Unit { int pm, pn, aux; };
struct Gemm { const bf16_t* A; const bf16_t* Bt; int M, N, K; const int* rowmap; };

struct StaticOrder {
    int nM, nN, nwg, G, c;
    __host__ __device__ void init(int M, int N, int G_, int c_) { nM = M / BM; nN = N / BM; nwg = nM * nN; G = G_; c = c_; }
    __host__ __device__ bool next(int i, Unit& u) const {
        const long L = (long)i * G + c; if (L >= nwg) return false;
        int wgid = (int)L; { const int q = nwg / NXCD, r = nwg % NXCD, xcd = wgid % NXCD, off = wgid / NXCD; wgid = (xcd < r ? xcd * (q + 1) : r * (q + 1) + (xcd - r) * q) + off; }
        const int nig = WGM * nN, gid = wgid / nig, fm = gid * WGM, gsz = (nM - fm) < WGM ? (nM - fm) : WGM;
        u.pm = fm + ((wgid % nig) % gsz); u.pn = (wgid % nig) / gsz; u.aux = 0; return true;
    }
    __device__ __forceinline__ void a_ready(const Unit&) const {}
    __device__ __forceinline__ void done(const Unit&) const {}
};

__device__ __forceinline__ unsigned cvt_pk_bf16(float lo, float hi) { unsigned r; asm volatile("v_cvt_pk_bf16_f32 %0, %1, %2" : "=v"(r) : "v"(lo), "v"(hi)); return r; }
template <class Epi, class Sched, bool ALIGN_EPI = false, bool SP2 = false, bool GATHER = false>
__device__ __forceinline__ void gemm_phase(PG8_LAS unsigned char* lds, const Gemm g, const Sched& S, const Epi& E) {
    const int tid = threadIdx.x, wid = __builtin_amdgcn_readfirstlane(tid >> 6), lane = tid & 63, wr = wid >> 2, wc = wid & 3, fr = lane & 15, fq = lane >> 4;
    const int K = g.K, nt = K / BK;
    unsigned voffA[2], voffB[2];
#pragma unroll
    for (int i = 0; i < 2; ++i) { int R, C; stage_rc(tid * 16 + i * 8192, R, C); const int Rb = Epi::PERM ? ((R & ~31) + perm32(R & 31)) : R;
        voffA[i] = (unsigned)(R * K + C) * 2u; voffB[i] = (unsigned)(Rb * K + C) * 2u; }
    unsigned gc[2][2] = {{0u, 0u}, {0u, 0u}}, gn[2][2] = {{0u, 0u}, {0u, 0u}};
#define PG8_GLOAD(gv, pm_) do { _Pragma("unroll") for (int _h = 0; _h < 2; ++_h) _Pragma("unroll") for (int _i = 0; _i < 2; ++_i) { int _R, _C; stage_rc(tid * 16 + _i * 8192, _R, _C); \
        int _row = g.rowmap[(pm_) * BM + _h * HALF + _R]; _row = _row < 0 ? 0 : _row; gv[_h][_i] = (unsigned)(_row * K + _C) * 2u; } } while (0)
    const size_t kstep = (size_t)(BK * 2);
    const size_t hstep = (size_t)HALF * K * 2;
    const size_t tstep = 2 * hstep;
    const unsigned ldsw = (unsigned)wid * 1024u;
    const int aoff = lds_byte(wr * 64 + fr, fq * 8), boff = lds_byte(wc * 32 + fr, fq * 8);
#define PG8_SA(b, h) (((b) * 2 + (h)) * HTB)
#define PG8_SB(b, h) ((4 + (b) * 2 + (h)) * HTB)
#define PG8_STAGE(bufoff, gbase, voff) do { _Pragma("unroll") for (int _i = 0; _i < 2; ++_i) \
        __builtin_amdgcn_global_load_lds((const unsigned*)((const char*)(gbase) + (voff)[_i]), (PG8_LAS unsigned*)(lds + (bufoff) + ldsw + _i * 8192), 16, 0, 0); } while (0)
#define PG8_STAGE_A(bufoff, gbase, h, sel) do { if constexpr (GATHER) { unsigned vo_[2]; vo_[0] = (sel) ? gn[h][0] : gc[h][0]; vo_[1] = (sel) ? gn[h][1] : gc[h][1]; PG8_STAGE(bufoff, gbase, vo_); } \
        else { PG8_STAGE(bufoff, (gbase) + (h) * hstep, voffA); } } while (0)
#define PG8_LDA(dst, b, h) do { _Pragma("unroll") for (int m = 0; m < 4; ++m) _Pragma("unroll") for (int k = 0; k < 2; ++k) dst[m][k] = *(const PG8_LAS bf16x8*)(lds + PG8_SA(b, h) + aoff + m * 2048 + k * 1024); } while (0)
#define PG8_LDB(dst, b, h) do { _Pragma("unroll") for (int n = 0; n < 2; ++n) _Pragma("unroll") for (int k = 0; k < 2; ++k) dst[n][k] = *(const PG8_LAS bf16x8*)(lds + PG8_SB(b, h) + boff + n * 2048 + k * 1024); } while (0)
#define PG8_MMA(ai, bj, At, Bt) do { __builtin_amdgcn_s_setprio(1); _Pragma("unroll") for (int m = 0; m < 4; ++m) _Pragma("unroll") for (int n = 0; n < 2; ++n) _Pragma("unroll") for (int k = 0; k < 2; ++k) \
        acc[ai][bj][m][n] = __builtin_amdgcn_mfma_f32_16x16x32_bf16(Bt[n][k], At[m][k], acc[ai][bj][m][n], 0, 0, 0); __builtin_amdgcn_s_setprio(0); } while (0)
#define PG8_WAIT_V(n) asm volatile("s_waitcnt vmcnt(" #n ")" ::: "memory")
#define PG8_WAIT_L(n) asm volatile("s_waitcnt lgkmcnt(" #n ")" ::: "memory")
#define PG8_BAR __builtin_amdgcn_s_barrier()
#define PG8_SCHED __builtin_amdgcn_sched_barrier(0)
    Unit cur, nxt; int ui = 0;
    if (!S.next(0, cur)) return;
    f32x4 acc[2][2][4][2];
#pragma unroll
    for (int a = 0; a < 2; ++a)
#pragma unroll
        for (int b = 0; b < 2; ++b)
#pragma unroll
            for (int m = 0; m < 4; ++m)
#pragma unroll
                for (int n = 0; n < 2; ++n) acc[a][b][m][n] = (f32x4){0.f, 0.f, 0.f, 0.f};
    bf16x8 At[4][2], B0[2][2], B1[2][2];
    const char* cA = GATHER ? (const char*)g.A : (const char*)g.A + (size_t)cur.pm * tstep; const char* cB = (const char*)g.Bt + (size_t)cur.pn * tstep;
    if constexpr (GATHER) { PG8_GLOAD(gc, cur.pm); }
    S.a_ready(cur);
    if constexpr (SP2) {
        PG8_STAGE(PG8_SB(0, 0), cB, voffB); PG8_STAGE(PG8_SB(0, 1), cB + hstep, voffB); PG8_STAGE_A(PG8_SA(0, 0), cA, 0, false); PG8_STAGE_A(PG8_SA(0, 1), cA, 1, false);
        if (wr == 1) PG8_BAR;
        PG8_WAIT_V(2); PG8_BAR;
        PG8_STAGE(PG8_SB(1, 0), cB + kstep, voffB); PG8_STAGE_A(PG8_SA(1, 0), cA + kstep, 0, false); PG8_STAGE(PG8_SB(1, 1), cB + hstep + kstep, voffB);
        PG8_WAIT_V(6); PG8_BAR;
    } else {
        PG8_STAGE(PG8_SB(0, 0), cB, voffB); PG8_STAGE_A(PG8_SA(0, 0), cA, 0, false); PG8_STAGE(PG8_SB(0, 1), cB + hstep, voffB); PG8_STAGE_A(PG8_SA(0, 1), cA, 1, false);
        if (wr == 1) PG8_BAR;
        PG8_WAIT_V(4); PG8_BAR;
        PG8_STAGE(PG8_SB(1, 0), cB + kstep, voffB); PG8_STAGE_A(PG8_SA(1, 0), cA + kstep, 0, false); PG8_STAGE(PG8_SB(1, 1), cB + hstep + kstep, voffB);
        PG8_WAIT_V(6); PG8_BAR;
    }
    for (;;) {
        const bool has_next = S.next(ui + 1, nxt);
        const char* nA = GATHER ? cA : (has_next ? (const char*)g.A + (size_t)nxt.pm * tstep : cA);
        if constexpr (GATHER) { if (has_next) { PG8_GLOAD(gn, nxt.pm); } else { gn[0][0] = gc[0][0]; gn[0][1] = gc[0][1]; gn[1][0] = gc[1][0]; gn[1][1] = gc[1][1]; } }
        const char* nB = has_next ? (const char*)g.Bt + (size_t)nxt.pn * tstep : cB;
        for (int t = 0; t < nt; t += 2) {
            const bool last = (t == nt - 2);
            const char* a1 = cA + (size_t)(t + 1) * kstep;
            const char* a2 = last ? nA : cA + (size_t)(t + 2) * kstep; const char* b2 = last ? nB : cB + (size_t)(t + 2) * kstep;
            const char* a3 = a2 + kstep; const char* b3 = b2 + kstep;
            if (last && has_next) S.a_ready(nxt);
            if constexpr (SP2) {
            PG8_LDB(B0, 0, 0); PG8_LDB(B1, 0, 1); PG8_SCHED; PG8_LDA(At, 0, 0); PG8_STAGE_A(PG8_SA(1, 1), a1, 1, false);
            PG8_WAIT_V(8); PG8_WAIT_L(0); PG8_BAR; PG8_MMA(0, 0, At, B0); PG8_MMA(0, 1, At, B1); PG8_BAR; PG8_SCHED;
            PG8_LDA(At, 0, 1); PG8_STAGE(PG8_SB(0, 0), b2, voffB); PG8_STAGE(PG8_SB(0, 1), b2 + hstep, voffB); PG8_STAGE_A(PG8_SA(0, 0), a2, 0, last);
            PG8_WAIT_V(8); PG8_WAIT_L(0); PG8_BAR; PG8_MMA(1, 0, At, B0); PG8_MMA(1, 1, At, B1); PG8_BAR; PG8_SCHED;
            PG8_LDB(B0, 1, 0); PG8_LDB(B1, 1, 1); PG8_SCHED; PG8_LDA(At, 1, 0); PG8_STAGE_A(PG8_SA(0, 1), a2, 1, last);
            PG8_WAIT_V(8); PG8_WAIT_L(0); PG8_BAR; PG8_MMA(0, 0, At, B0); PG8_MMA(0, 1, At, B1); PG8_BAR; PG8_SCHED;
            PG8_LDA(At, 1, 1); PG8_STAGE(PG8_SB(1, 0), b3, voffB); PG8_STAGE(PG8_SB(1, 1), b3 + hstep, voffB); PG8_STAGE_A(PG8_SA(1, 0), a3, 0, last);
            PG8_WAIT_V(8); PG8_WAIT_L(0); PG8_BAR; PG8_MMA(1, 0, At, B0); PG8_MMA(1, 1, At, B1); PG8_BAR; PG8_SCHED;
            } else {
            PG8_LDB(B0, 0, 0); PG8_SCHED; PG8_LDA(At, 0, 0); PG8_STAGE_A(PG8_SA(1, 1), a1, 1, false);
            PG8_WAIT_L(8); PG8_BAR; PG8_WAIT_L(0); PG8_MMA(0, 0, At, B0); PG8_BAR; PG8_SCHED;
            PG8_LDB(B1, 0, 1); PG8_STAGE(PG8_SB(0, 0), b2, voffB);
            PG8_BAR; PG8_WAIT_L(0); PG8_MMA(0, 1, At, B1); PG8_BAR;
            PG8_LDA(At, 0, 1); PG8_STAGE_A(PG8_SA(0, 0), a2, 0, last);
            PG8_BAR; PG8_WAIT_L(0); PG8_MMA(1, 0, At, B0); PG8_BAR; PG8_SCHED;
            PG8_STAGE(PG8_SB(0, 1), b2 + hstep, voffB);
            PG8_WAIT_V(6); PG8_BAR; PG8_MMA(1, 1, At, B1); PG8_BAR;
            PG8_LDB(B0, 1, 0); PG8_SCHED; PG8_LDA(At, 1, 0); PG8_STAGE_A(PG8_SA(0, 1), a2, 1, last);
            PG8_WAIT_L(8); PG8_BAR; PG8_WAIT_L(0); PG8_MMA(0, 0, At, B0); PG8_BAR; PG8_SCHED;
            PG8_LDB(B1, 1, 1); PG8_STAGE(PG8_SB(1, 0), b3, voffB);
            PG8_BAR; PG8_WAIT_L(0); PG8_MMA(0, 1, At, B1); PG8_BAR;
            PG8_LDA(At, 1, 1); PG8_STAGE_A(PG8_SA(1, 0), a3, 0, last);
            PG8_BAR; PG8_WAIT_L(0); PG8_MMA(1, 0, At, B0); PG8_BAR; PG8_SCHED;
            PG8_STAGE(PG8_SB(1, 1), b3 + hstep, voffB);
            PG8_WAIT_V(6); PG8_BAR; PG8_MMA(1, 1, At, B1); PG8_BAR;
            }
        }
        if constexpr (ALIGN_EPI) { if (wr == 0) PG8_BAR; }
        if constexpr (!Epi::AFTER_DRAIN) { E(acc, cur, wr, wc, fr, fq); S.done(cur); }
        if (!has_next) break;
#pragma unroll
        for (int a = 0; a < 2; ++a)
#pragma unroll
            for (int b = 0; b < 2; ++b)
#pragma unroll
                for (int m = 0; m < 4; ++m)
#pragma unroll
                    for (int n = 0; n < 2; ++n) acc[a][b][m][n] = (f32x4){0.f, 0.f, 0.f, 0.f};
        cur = nxt; cA = nA; cB = nB; ++ui;
        if constexpr (GATHER) { gc[0][0] = gn[0][0]; gc[0][1] = gn[0][1]; gc[1][0] = gn[1][0]; gc[1][1] = gn[1][1]; }
        if constexpr (ALIGN_EPI) { if (wr == 1) PG8_BAR; }
    }
    PG8_WAIT_V(0);
    if constexpr (!ALIGN_EPI) { if (wr == 0) PG8_BAR; }
    PG8_BAR;
    if constexpr (Epi::AFTER_DRAIN) { E.fused(acc, cur, wr, wc, fr, fq, lds, wid, lane); S.done(cur); }
#undef PG8_SA
#undef PG8_SB
#undef PG8_STAGE
#undef PG8_STAGE_A
#undef PG8_GLOAD
#undef PG8_LDA
#undef PG8_LDB
#undef PG8_MMA
#undef PG8_WAIT_V
#undef PG8_WAIT_L
#undef PG8_BAR
#undef PG8_SCHED
}
}

#define GAS __attribute__((address_space(1)))
#define LAS __attribute__((address_space(3)))
typedef unsigned short bf16;
typedef unsigned v4u __attribute__((ext_vector_type(4)));
typedef unsigned v2u __attribute__((ext_vector_type(2)));
typedef float f32x4 __attribute__((ext_vector_type(4)));
typedef short bf16x8 __attribute__((ext_vector_type(8)));
typedef GAS unsigned gu32;

constexpr int NWAVES = 8, NTHR = 512;
constexpr int BATCH = 8, SEQ = 8192, T = BATCH * SEQ, D = 1024, MEMLEN = 256, TMEM = BATCH * MEMLEN;
constexpr int INW = 3080, NIN = 3072, NKV = 512;
constexpr int NBUCKET = 24, ROWS_MAX = T + NBUCKET * 256;
constexpr float EPSN = 1e-6f;
constexpr float C2 = 0.125f * 1.4426950408889634f;
constexpr float LOG2E = 1.4426950408889634f;

constexpr size_t MiB = 1u << 20;
constexpr size_t WS_CTL = 0, CTL_ZERO_BYTES = 1 * MiB;
constexpr size_t WS_ROPE = 2 * MiB;
constexpr size_t WS_IG = 6 * MiB;
constexpr size_t WS_FG = 7 * MiB;
constexpr size_t WS_LSE = 8 * MiB;
constexpr size_t WS_SS1 = 14 * MiB;
constexpr size_t WS_SS3 = 18 * MiB;
constexpr size_t WS_KVX = 22 * MiB;
constexpr size_t WS_NLOC = 24 * MiB;
constexpr size_t WS_NPREV = 25 * MiB;
constexpr size_t WS_MLOC = 26 * MiB;
constexpr size_t WS_BLAST = 26 * MiB + 64 * 1024;
constexpr size_t WS_MPREV = 26 * MiB + 128 * 1024;
constexpr size_t WS_TOKINFO = 27 * MiB;
constexpr size_t WS_TOKMAP = 28 * MiB;
constexpr size_t WS_WSORT = 19 * MiB;
constexpr size_t WS_WR = 30 * MiB;
constexpr size_t WS_WG = 30 * MiB + 512 * 1024;
constexpr size_t WS_PAR = 31 * MiB;
constexpr int PAR_CONVW = 0, PAR_CONVB = 2048, PAR_GMHN = 2560, PAR_SKIP = 3072, PAR_BRG = 3584, PAR_BRE = 3600, PAR_GFIN = 3616, PAR_N = 4640;
constexpr size_t WS_WIN = 32 * MiB;
constexpr size_t WS_WOUT = 39 * MiB;
constexpr size_t WS_WQX = 41 * MiB;
constexpr size_t WS_WOX = 41 * MiB + 512 * 1024;
constexpr size_t WS_WM = 42 * MiB;
constexpr size_t WS_W13 = 44 * MiB;
constexpr size_t WS_W2P = 76 * MiB;
constexpr size_t WS_XN = 128 * MiB;
constexpr size_t WS_CLOC = 128 * MiB;
constexpr size_t WS_Q = 264 * MiB;
constexpr size_t WS_K = 328 * MiB, WS_V = 392 * MiB, WS_MU = 456 * MiB, WS_MV = 520 * MiB, WS_MO = 584 * MiB;
constexpr size_t WS_MQ = 648 * MiB, WS_MK = 712 * MiB;
constexpr size_t WS_Y = 264 * MiB;
constexpr size_t WS_CPREV = 392 * MiB;
constexpr size_t WS_X1B = 648 * MiB;
constexpr size_t WS_QX = 776 * MiB;
constexpr size_t WS_OX = 808 * MiB;
constexpr size_t WS_HBS = 264 * MiB;
constexpr size_t WS_ACT = 404 * MiB;
constexpr size_t WS_END = 840 * MiB;
constexpr size_t DO_OATT = 0, DO_C = 192 * MiB;

constexpr int CW_BAR = 4096;
constexpr int CW_CNT = 8192;
constexpr int CW_FILL = 8192 + 64;

constexpr int LDS_BYTES = 163840;
constexpr int LDS_MISC = 159744;
constexpr int LDS_RS = 135168;
constexpr int LDS_TAB = 136192;

#define LDS_WAIT() asm volatile("s_waitcnt lgkmcnt(0)" ::: "memory")
#define VM_WAIT() asm volatile("s_waitcnt vmcnt(0)" ::: "memory")
__device__ __forceinline__ unsigned f2bf(float f) { unsigned u = __builtin_bit_cast(unsigned, f); return (u + 0x7fffu + ((u >> 16) & 1u)) >> 16; }
__device__ __forceinline__ unsigned pk2(float lo, float hi) { return f2bf(lo) | (f2bf(hi) << 16); }
__device__ __forceinline__ float bf2f(unsigned h) { return __uint_as_float(h << 16); }
__device__ __forceinline__ float bflo(unsigned w) { return __uint_as_float(w << 16); }
__device__ __forceinline__ float bfhi(unsigned w) { return __uint_as_float(w & 0xffff0000u); }
__device__ __forceinline__ float wave_sum(float v) {
#pragma unroll
    for (int o = 1; o < 64; o <<= 1) v += __shfl_xor(v, o);
    return v;
}
__device__ __forceinline__ float wave_max(float v) {
#pragma unroll
    for (int o = 1; o < 64; o <<= 1) v = fmaxf(v, __shfl_xor(v, o));
    return v;
}
__device__ __forceinline__ float sigmoidf_(float x) { return 1.0f / (1.0f + __expf(-x)); }

#define XB_TMO      128
#define XB_XCNT(j)  (256  + 64 * (j))
#define XB_XSUB(j)  (1280 + 64 * (j))
#define XB_XGEN(j)  (2304 + 64 * (j))
#define XB_TOP      3328
#define XB_TOPGEN   3392
#define XCD_BAR_WORDS 3456
#define XB_SPIN_CAP (1u << 22)
__device__ __forceinline__ unsigned xb_ld(unsigned* p)              { return __hip_atomic_load(p, __ATOMIC_RELAXED, __HIP_MEMORY_SCOPE_AGENT); }
__device__ __forceinline__ unsigned xb_add(unsigned* p, unsigned v) { return __hip_atomic_fetch_add(p, v, __ATOMIC_RELAXED, __HIP_MEMORY_SCOPE_AGENT); }
__device__ __forceinline__ unsigned xb_xcc_id() { return (unsigned)__builtin_amdgcn_s_getreg((3 << 11) | 20) & 0xFu; }
#define XB_SPIN(cond, bar) do { unsigned _sp = 0; while (cond) { __builtin_amdgcn_s_sleep(1); \
    if ((++_sp & 255u) == 0u) { if (xb_ld(&(bar)[XB_TMO])) break; if (_sp > XB_SPIN_CAP) { atomicAdd(&(bar)[XB_TMO], 1u); break; } } } } while (0)
struct XcdBarrier { unsigned* bar; unsigned x; volatile LAS unsigned* st; };
__device__ __forceinline__ XcdBarrier xcd_barrier_post(unsigned* bar, volatile LAS unsigned* st) {
    XcdBarrier b; b.bar = bar; b.x = xb_xcc_id(); b.st = st;
    if (threadIdx.x == 0) (void)xb_add(&bar[XB_XCNT(b.x)], 1u);
    return b;
}
__device__ __forceinline__ void xcd_barrier_complete(unsigned* bar, unsigned x, unsigned& nloc, unsigned& nx) {
    const unsigned G = gridDim.x * gridDim.y * gridDim.z;
    unsigned sum, cnt, mine, sp = 0u;
    for (;;) {
        sum = 0u; cnt = 0u; mine = 0u;
#pragma unroll
        for (unsigned j = 0; j < 16; ++j) { const unsigned c = xb_ld(&bar[XB_XCNT(j)]); sum += c; cnt += (c > 0u) ? 1u : 0u; mine = (j == x) ? c : mine; }
        if (sum == G) break;
        __builtin_amdgcn_s_sleep(1);
        if ((++sp & 255u) == 0u) { if (xb_ld(&bar[XB_TMO])) break; if (sp > XB_SPIN_CAP) { atomicAdd(&bar[XB_TMO], 1u); break; } }
    }
    nloc = mine > 0u ? mine : 1u; nx = cnt > 0u ? cnt : 1u;
}
__device__ __forceinline__ void xcd_barrier(const XcdBarrier& b) {
    asm volatile("s_waitcnt vmcnt(0)" ::: "memory");
    __syncthreads();
    if (threadIdx.x == 0) {
        unsigned* bar = b.bar;
        __builtin_amdgcn_s_waitcnt(0);
        unsigned nloc = b.st[0], nx = b.st[1];
        if (nloc == 0u) { xcd_barrier_complete(bar, b.x, nloc, nx); b.st[0] = nloc; b.st[1] = nx; }
        const unsigned old = xb_add(&bar[XB_XSUB(b.x)], 1u);
        const unsigned gen = old / nloc;
        if (old + 1u == (gen + 1u) * nloc) {
            __builtin_amdgcn_fence(__ATOMIC_RELEASE, "agent");
            asm volatile("s_waitcnt vmcnt(0)" ::: "memory");
            const unsigned og = xb_add(&bar[XB_TOP], 1u);
            const unsigned tg = og / nx;
            if (og + 1u == (tg + 1u) * nx) xb_add(&bar[XB_TOPGEN], 1u);
            else XB_SPIN(xb_ld(&bar[XB_TOPGEN]) == tg, bar);
            __builtin_amdgcn_fence(__ATOMIC_ACQUIRE, "agent");
            xb_add(&bar[XB_XGEN(b.x)], 1u);
            asm volatile("s_waitcnt vmcnt(0)" ::: "memory");
        } else {
            XB_SPIN(xb_ld(&bar[XB_XGEN(b.x)]) == gen, bar);
            __builtin_amdgcn_fence(__ATOMIC_ACQUIRE, "agent");
            asm volatile("s_waitcnt vmcnt(0)" ::: "memory");
        }
    }
    __syncthreads();
}

struct Args { const void* in[28]; float* out; unsigned char* ws; int ph_lo, ph_hi; };

template <int MI, int NJ>
__device__ __forceinline__ void wave_mma(const bf16* A, int lda, const bf16* Bt, int ldb, int K, f32x4 (&acc)[MI][NJ], int fr, int fq) {
    for (int k0 = 0; k0 < K; k0 += 32) {
        bf16x8 a[MI], b[NJ];
#pragma unroll
        for (int i = 0; i < MI; ++i) a[i] = *(const bf16x8*)(A + (16 * i + fr) * lda + k0 + 8 * fq);
#pragma unroll
        for (int j = 0; j < NJ; ++j) b[j] = *(const bf16x8*)(Bt + (16 * j + fr) * ldb + k0 + 8 * fq);
#pragma unroll
        for (int i = 0; i < MI; ++i)
#pragma unroll
            for (int j = 0; j < NJ; ++j) acc[i][j] = __builtin_amdgcn_mfma_f32_16x16x32_bf16(b[j], a[i], acc[i][j], 0, 0, 0);
    }
}

__device__ __forceinline__ void transpose_item(const float* src, int src_ld, int k0, int n0, bf16* dst, int dst_ld, int dst_row0, int dst_col0,
                                               const float* gain, float scale, LAS float* scr, int lane) {
    f32x4 ld[16];
#pragma unroll
    for (int i = 0; i < 16; ++i) { const int kk = 4 * i + (lane >> 4); ld[i] = *(const f32x4*)(src + (size_t)(k0 + kk) * src_ld + n0 + 4 * (lane & 15)); }
#pragma unroll
    for (int i = 0; i < 16; ++i) { const int kk = 4 * i + (lane >> 4); *(LAS f32x4*)(scr + kk * 64 + 4 * ((lane & 15) ^ ((kk >> 3) & 15))) = ld[i]; }
    const int c = lane & 7;
    f32x4 g0 = (f32x4){scale, scale, scale, scale}, g1 = g0;
    if (gain) { g0 = *(const f32x4*)(gain + k0 + 8 * c) * scale; g1 = *(const f32x4*)(gain + k0 + 8 * c + 4) * scale; }
    LDS_WAIT(); asm volatile("" ::: "memory");
#pragma unroll
    for (int j = 0; j < 8; ++j) { const int n = (lane >> 3) + 8 * j; const LAS float* s = scr + (8 * c) * 64 + 4 * ((n >> 2) ^ c) + (n & 3);
        v4u o; o.x = pk2(s[0 * 64] * g0[0], s[1 * 64] * g0[1]); o.y = pk2(s[2 * 64] * g0[2], s[3 * 64] * g0[3]); o.z = pk2(s[4 * 64] * g1[0], s[5 * 64] * g1[1]); o.w = pk2(s[6 * 64] * g1[2], s[7 * 64] * g1[3]);
        *(v4u*)(dst + (size_t)(dst_row0 + n) * dst_ld + dst_col0 + 8 * c) = o; }
    LDS_WAIT(); asm volatile("" ::: "memory");
}

__device__ __forceinline__ void p0_prologue(const Args& A, unsigned char* lds, int tid, int lane, int wave) {
    unsigned char* ws = A.ws;
    const float* x = (const float*)A.in[0]; const float* mem = (const float*)A.in[1]; const int* positions = (const int*)A.in[2];
    const float* g_mix = (const float*)A.in[3]; const float* w_in = (const float*)A.in[4];
    const float* w_q_m = (const float*)A.in[7]; const float* w_k_m = (const float*)A.in[8];
    const float* b_i = (const float*)A.in[9]; const float* b_f = (const float*)A.in[10];
    const float* w_out = (const float*)A.in[13]; const float* g_cross = (const float*)A.in[14]; const float* g_mem = (const float*)A.in[15];
    const float* w_q_x = (const float*)A.in[16]; const float* w_kv_x = (const float*)A.in[17]; const float* w_o_x = (const float*)A.in[18];
    const float* g_ffn = (const float*)A.in[19]; const float* w_rg = (const float*)A.in[20]; const float* w_re = (const float*)A.in[22];
    const float* w1 = (const float*)A.in[24]; const float* w3 = (const float*)A.in[25]; const float* w2 = (const float*)A.in[26];
    const int G = gridDim.x, gw = blockIdx.x * NWAVES + wave, NGW = G * NWAVES, gt = blockIdx.x * NTHR + tid, NGT = G * NTHR;

    LAS float* WGl = (LAS float*)lds;
    for (int i = tid; i < 8 * 1024; i += NTHR) { const int k = i >> 3, j = i & 7; WGl[j * 1024 + k] = g_mix[k] * w_in[(size_t)k * INW + NIN + j]; }

    for (int i = gt; i < PAR_N; i += NGT) { float v;
        if (i < PAR_CONVB) v = ((const float*)A.in[5])[i]; else if (i < PAR_GMHN) v = ((const float*)A.in[6])[i - PAR_CONVB]; else if (i < PAR_SKIP) v = ((const float*)A.in[11])[i - PAR_GMHN];
        else if (i < PAR_BRG) v = ((const float*)A.in[12])[i - PAR_SKIP]; else if (i < PAR_BRE) v = ((const float*)A.in[21])[i - PAR_BRG]; else if (i < PAR_GFIN) v = ((const float*)A.in[23])[i - PAR_BRE];
        else v = ((const float*)A.in[27])[i - PAR_GFIN];
        ((float*)(ws + WS_PAR))[i] = v; }
    for (int i = gt; i < 20 * 1024; i += NGT) { const int e = i >> 10, k = i & 1023;
        ((float*)(ws + WS_WR))[i] = g_ffn[k] * (e < 4 ? w_rg[k * 4 + e] : w_re[k * 16 + (e - 4)]); }
    for (int i = gt; i < T * 8; i += NGT) { const int t = i >> 3, j = i & 7; const float invf = powf(500000.0f, -(float)j * 0.125f);
        const float ang = (float)positions[t] * invf; float sn, cs; sincosf(ang, &sn, &cs);
        ((float*)(ws + WS_ROPE))[t * 16 + j] = cs; ((float*)(ws + WS_ROPE))[t * 16 + 8 + j] = sn; }
    __syncthreads();
    for (int m0 = 2 * gw; m0 < T + TMEM; m0 += 2 * NGW) {
        f32x4 v[2][4]; float rstd[2];
#pragma unroll
        for (int q = 0; q < 2; ++q) { const int m = m0 + q; const f32x4* xr = (const f32x4*)(m >= T ? mem + (size_t)(m - T) * D : x + (size_t)m * D) + lane;
#pragma unroll
            for (int j = 0; j < 4; ++j) v[q][j] = xr[64 * j]; }
#pragma unroll
        for (int q = 0; q < 2; ++q) { float s = 0.f;
#pragma unroll
            for (int j = 0; j < 4; ++j) s += (v[q][j].x * v[q][j].x + v[q][j].y * v[q][j].y) + (v[q][j].z * v[q][j].z + v[q][j].w * v[q][j].w);
            rstd[q] = 1.0f / sqrtf(wave_sum(s) * (1.0f / D) + EPSN);
            unsigned long long* o8 = (unsigned long long*)(ws + WS_XN + (size_t)(m0 + q) * D * 2) + lane;
#pragma unroll
            for (int j = 0; j < 4; ++j) o8[64 * j] = (unsigned long long)pk2(v[q][j].x * rstd[q], v[q][j].y * rstd[q]) | ((unsigned long long)pk2(v[q][j].z * rstd[q], v[q][j].w * rstd[q]) << 32); }
        if (m0 < T) {
            float val0 = 0.f, val1 = 0.f;
#pragma unroll
            for (int g = 0; g < 8; ++g) { float a0 = 0.f, a1 = 0.f;
#pragma unroll
                for (int j = 0; j < 4; ++j) { const f32x4 w = *(const LAS f32x4*)(WGl + g * 1024 + 256 * j + 4 * lane);
                    a0 += (v[0][j].x * w.x + v[0][j].y * w.y) + (v[0][j].z * w.z + v[0][j].w * w.w); a1 += (v[1][j].x * w.x + v[1][j].y * w.y) + (v[1][j].z * w.z + v[1][j].w * w.w); }
                a0 = wave_sum(a0) * rstd[0]; a1 = wave_sum(a1) * rstd[1];
                val0 = (lane == g) ? a0 : val0; val1 = (lane == g) ? a1 : val1; }
            if (lane < 8) { const int h = lane & 3;
#pragma unroll
                for (int q = 0; q < 2; ++q) { const int m = m0 + q, b = m / SEQ, sq = m % SEQ; const float val = q ? val1 : val0;
                    if (lane < 4) ((float*)(ws + WS_IG))[(size_t)(b * 4 + h) * SEQ + sq] = val + b_i[h];
                    else ((float*)(ws + WS_FG))[(size_t)(b * 4 + h) * SEQ + sq] = val + b_f[h]; } }
        }
    }
    __syncthreads();
    LAS float* scr = (LAS float*)(lds + wave * 16384);
    constexpr int I_IN = 16 * 48, I_KV = 16 * 8, I_OUT = 16 * 16, I_QX = 16 * 4, I_OX = 4 * 16, I_M = 32, I_13 = 16 * 2 * 128, I_2P = 24 * 2 * 128;
    constexpr int NITEMS = I_IN + I_KV + I_OUT + I_QX + I_OX + I_M + I_13 + I_2P;
    for (int it = gw; it < NITEMS; it += NGW) {
        int r = it;
        if (r < I_IN) { const int kb = r / 48, nb = r % 48; transpose_item(w_in, INW, 64 * kb, 64 * nb, (bf16*)(ws + WS_WIN), 1024, 64 * nb, 64 * kb, g_mix, (64 * nb < 512) ? C2 : 1.0f, scr, lane); continue; } r -= I_IN;
        if (r < I_KV) { const int kb = r / 8, nb = r % 8; transpose_item(w_kv_x, 512, 64 * kb, 64 * nb, (bf16*)(ws + WS_WIN), 1024, NIN + 64 * nb, 64 * kb, g_mem, 1.0f, scr, lane); continue; } r -= I_KV;
        if (r < I_OUT) { const int kb = r / 16, nb = r % 16; transpose_item(w_out, 1024, 64 * kb, 64 * nb, (bf16*)(ws + WS_WOUT), 1024, 64 * nb, 64 * kb, nullptr, 1.0f, scr, lane); continue; } r -= I_OUT;
        if (r < I_QX) { const int kb = r / 4, nb = r % 4; transpose_item(w_q_x, 256, 64 * kb, 64 * nb, (bf16*)(ws + WS_WQX), 1024, 64 * nb, 64 * kb, g_cross, C2, scr, lane); continue; } r -= I_QX;
        if (r < I_OX) { const int kb = r / 16, nb = r % 16; transpose_item(w_o_x, 1024, 64 * kb, 64 * nb, (bf16*)(ws + WS_WOX), 256, 64 * nb, 64 * kb, nullptr, 1.0f, scr, lane); continue; } r -= I_OX;
        if (r < I_M) { const int which = r / 16, h = (r % 16) / 4, kb = (r % 4) / 2, nb = r % 2;
            transpose_item((which ? w_k_m : w_q_m) + (size_t)h * 128 * 128, 128, 64 * kb, 64 * nb, (bf16*)(ws + WS_WM) + (size_t)(which * 4 + h) * 128 * 128, 128, 64 * nb, 64 * kb, nullptr,
                           which ? 0.08838834764831845f : 1.0f, scr, lane); continue; } r -= I_M;
        if (r < I_13) { const int e = r / 256, which = (r % 256) / 128, kb = (r % 128) / 8, nb = r % 8; const int n0 = 64 * nb;
            transpose_item((which ? w3 : w1) + (size_t)e * 1024 * 512, 512, 64 * kb, n0, (bf16*)(ws + WS_W13) + (size_t)e * 1024 * 1024, 1024, (n0 / 128) * 256 + which * 128 + (n0 % 128), 64 * kb, g_ffn, 1.0f, scr, lane); continue; } r -= I_13;
        { const int bk = r / 256, hf = (r % 256) / 128, kb = (r % 128) / 16, nb = r % 16; const int g = bk / 6, p = bk % 6;
          const int pa = (p < 3) ? 0 : (p < 5 ? 1 : 2), pb = (p < 3) ? p + 1 : (p < 5 ? p - 1 : 3); const int e = 4 * g + (hf ? pb : pa);
          transpose_item(w2 + (size_t)e * 512 * 1024, 1024, 64 * kb, 64 * nb, (bf16*)(ws + WS_W2P) + (size_t)bk * 1024 * 1024, 1024, 64 * nb, hf * 512 + 64 * kb, nullptr, 1.0f, scr, lane); }
    }
}

struct InProjOrder {
    pg8::StaticOrder so;
    __device__ __forceinline__ bool next(int i, pg8::Unit& u) const {
        if (so.next(i, u)) return true;
        const long L = (long)i * so.G + so.c - so.nwg;
        if (L >= 0 && L < 16) { u.pm = 256 + (int)(L >> 1); u.pn = 12 + (int)(L & 1); u.aux = 1; return true; }
        return false;
    }
    __device__ __forceinline__ void a_ready(const pg8::Unit&) const {}
    __device__ __forceinline__ void done(const pg8::Unit&) const {}
};
__device__ __forceinline__ v4u pack8(const f32x4& a, const f32x4& b) { v4u w; w.x = pk2(a[0], a[1]); w.y = pk2(a[2], a[3]); w.z = pk2(b[0], b[1]); w.w = pk2(b[2], b[3]); return w; }
struct EpiInProj {
    static constexpr bool PERM = true, AFTER_DRAIN = false;
    bf16* base; bf16* kvx; const float* rope;
    __device__ __forceinline__ void operator()(const f32x4 (&acc)[2][2][4][2], const pg8::Unit& u, int wr, int wc, int fr, int fq) const {
        if (u.aux) {
            const int row0 = (u.pm - 256) * 256 + wr * 64 + fr, col0 = (u.pn - 12) * 256 + wc * 32 + 8 * fq;
#pragma unroll
            for (int ai = 0; ai < 2; ++ai)
#pragma unroll
                for (int m = 0; m < 4; ++m) { bf16* rowp = kvx + (size_t)(row0 + ai * 128 + m * 16) * NKV + col0;
#pragma unroll
                    for (int bj = 0; bj < 2; ++bj) *(v4u*)(rowp + bj * 128) = pack8(acc[ai][bj][m][0], acc[ai][bj][m][1]); }
            return;
        }
        const int buf = u.pn >> 1; bf16* B = base + (size_t)buf * T * 512;
        const int row0 = u.pm * 256 + wr * 64 + fr, col0 = (u.pn & 1) * 256 + wc * 32 + 8 * fq;
        const bool dorope = (buf < 2) && ((wc & 1) == 0);
#pragma unroll
        for (int ai = 0; ai < 2; ++ai)
#pragma unroll
            for (int m = 0; m < 4; ++m) { const int row = row0 + ai * 128 + m * 16; bf16* rowp = B + (size_t)row * 512 + col0;
                f32x4 cs0, cs1, sn0, sn1;
                if (dorope) { const f32x4* rp = (const f32x4*)(rope + (size_t)row * 16); cs0 = rp[0]; cs1 = rp[1]; sn0 = rp[2]; sn1 = rp[3]; }
#pragma unroll
                for (int bj = 0; bj < 2; ++bj) { f32x4 v0 = acc[ai][bj][m][0], v1 = acc[ai][bj][m][1];
                    if (dorope) { f32x4 o0, o1;
#pragma unroll
                        for (int i = 0; i < 4; ++i) { o0[i] = __shfl_xor(v0[i], 16); o1[i] = __shfl_xor(v1[i], 16); }
                        if (fq == 0) { v0 = v0 * cs0 - o0 * sn0; v1 = v1 * cs1 - o1 * sn1; }
                        else if (fq == 1) { v0 = v0 * cs0 + o0 * sn0; v1 = v1 * cs1 + o1 * sn1; } }
                    *(v4u*)(rowp + bj * 128) = pack8(v0, v1); } }
    }
};

typedef short v4i16_t __attribute__((ext_vector_type(4)));
struct AttItem { int cfg, b, h, d, nb; size_t tokb; };
__device__ __forceinline__ AttItem attn_decode(int item) {
    AttItem a; a.cfg = item >> 12; int rem = item & 4095; a.b = rem >> 9; rem &= 511; a.h = rem >> 6; const int sub = rem & 63;
    a.d = (a.cfg == 0) ? 1 : (a.cfg == 1 ? 4 : 16); const int nblk = 64 / a.d, r = sub / nblk; a.nb = sub % nblk; a.tokb = (size_t)a.b * SEQ + r; return a;
}
__device__ __forceinline__ int attn_item_of(int k, int G) {
    if (G != 256) return (int)blockIdx.x + k * G;
    const int pair = (int)(blockIdx.x & 7) + 8 * (k / 6), j = (int)(blockIdx.x >> 3), ip = j * 6 + (k % 6);
    return ((ip >> 6) << 12) | (pair << 6) | (ip & 63);
}
__device__ __forceinline__ void attn_prefetch(const Args& A, LAS unsigned char* buf, int item, int lane, int wave, bf16x8 (&qf)[2]) {
    const AttItem a = attn_decode(item);
    const bf16* Kg = (const bf16*)(A.ws + WS_K) + a.h * 64; const bf16* Vg = (const bf16*)(A.ws + WS_V) + a.h * 64; const bf16* Qg = (const bf16*)(A.ws + WS_Q) + a.h * 64;
#pragma unroll
    for (int i = 0; i < 4; ++i) { const int inst = wave + 8 * i, row = 8 * inst + (lane >> 3); int u = 128 * (a.nb - 1) + row; u = (u < 0) ? row : u;
        const size_t off = (a.tokb + (size_t)u * a.d) * 512 + ((lane & 7) ^ (lane >> 3)) * 8;
        __builtin_amdgcn_global_load_lds((const unsigned*)(Kg + off), (LAS unsigned*)(buf + inst * 1024), 16, 0, 0);
        __builtin_amdgcn_global_load_lds((const unsigned*)(Vg + off), (LAS unsigned*)(buf + 32768 + inst * 1024), 16, 0, 0); }
    const size_t tq = a.tokb + (size_t)(128 * a.nb + 16 * wave + (lane & 15)) * a.d;
    qf[0] = *(const bf16x8*)(Qg + tq * 512 + 8 * (lane >> 4)); qf[1] = *(const bf16x8*)(Qg + tq * 512 + 32 + 8 * (lane >> 4));
}
__device__ __forceinline__ void attn_compute(const Args& A, LAS unsigned char* buf, int item, int lane, int wave, const bf16x8 (&qf)[2]) {
    const AttItem a = attn_decode(item);
    const int fr = lane & 15, g = lane >> 4, qi = 16 * wave + fr;
    f32x4 s[10];
#pragma unroll
    for (int tt = 0; tt < 10; ++tt) { const int t = (wave + tt < 16) ? wave + tt : 15, key = 16 * t + fr; s[tt] = (f32x4){0.f, 0.f, 0.f, 0.f};
#pragma unroll
        for (int ks = 0; ks < 2; ++ks) { const bf16x8 kf = *(const LAS bf16x8*)(buf + key * 128 + (((4 * ks + g) ^ (key & 7)) * 16));
            s[tt] = __builtin_amdgcn_mfma_f32_16x16x32_bf16(kf, qf[ks], s[tt], 0, 0, 0); } }
    float mx = -1e30f;
#pragma unroll
    for (int tt = 0; tt < 10; ++tt)
#pragma unroll
        for (int e = 0; e < 4; ++e) { const int kk = 16 * (wave + tt) + 4 * g + e;
            const bool ok = (kk >= qi) && (kk <= qi + 128) && (a.nb > 0 || kk >= 128);
            s[tt][e] = ok ? s[tt][e] : -1e30f; mx = fmaxf(mx, s[tt][e]); }
    mx = fmaxf(mx, __shfl_xor(mx, 16)); mx = fmaxf(mx, __shfl_xor(mx, 32));
    float l = 0.f;
#pragma unroll
    for (int tt = 0; tt < 10; ++tt)
#pragma unroll
        for (int e = 0; e < 4; ++e) { s[tt][e] = __builtin_amdgcn_exp2f(s[tt][e] - mx); l += s[tt][e]; }
    l += __shfl_xor(l, 16); l += __shfl_xor(l, 32);
    f32x4 o[4];
#pragma unroll
    for (int dt = 0; dt < 4; ++dt) o[dt] = (f32x4){0.f, 0.f, 0.f, 0.f};
#pragma unroll
    for (int k5 = 0; k5 < 5; ++k5) {
        const v4u pw = (v4u){pk2(s[2 * k5][0], s[2 * k5][1]), pk2(s[2 * k5][2], s[2 * k5][3]), pk2(s[2 * k5 + 1][0], s[2 * k5 + 1][1]), pk2(s[2 * k5 + 1][2], s[2 * k5 + 1][3])};
        const bf16x8 pf = __builtin_bit_cast(bf16x8, pw);
        const int t0 = (wave + 2 * k5 < 16) ? wave + 2 * k5 : 15, t1 = (wave + 2 * k5 + 1 < 16) ? wave + 2 * k5 + 1 : 15;
        const int r0 = 16 * t0 + 4 * g + (fr >> 2), r1 = 16 * t1 + 4 * g + (fr >> 2), p_ = fr & 3;
#pragma unroll
        for (int dt = 0; dt < 4; ++dt) { const int chunk = 2 * dt + (p_ >> 1);
            const v4i16_t v0 = __builtin_amdgcn_ds_read_tr16_b64_v4i16((LAS v4i16_t*)(buf + 32768 + r0 * 128 + ((chunk ^ (r0 & 7)) * 16) + 8 * (p_ & 1)));
            const v4i16_t v1 = __builtin_amdgcn_ds_read_tr16_b64_v4i16((LAS v4i16_t*)(buf + 32768 + r1 * 128 + ((chunk ^ (r1 & 7)) * 16) + 8 * (p_ & 1)));
            const bf16x8 vf = (bf16x8){v0[0], v0[1], v0[2], v0[3], v1[0], v1[1], v1[2], v1[3]};
            o[dt] = __builtin_amdgcn_mfma_f32_16x16x32_bf16(vf, pf, o[dt], 0, 0, 0); } }
    const float rl = 1.0f / l;
    const size_t tok = a.tokb + (size_t)(128 * a.nb + qi) * a.d;
    bf16* og = (bf16*)((unsigned char*)A.out + DO_OATT) + ((size_t)a.cfg * T + tok) * 512 + a.h * 64;
#pragma unroll
    for (int dt = 0; dt < 4; ++dt) *(v2u*)(og + 16 * dt + 4 * g) = (v2u){pk2(o[dt][0] * rl, o[dt][1] * rl), pk2(o[dt][2] * rl, o[dt][3] * rl)};
    if (g == 0) ((float*)(A.ws + WS_LSE))[((size_t)a.cfg * T + tok) * 8 + a.h] = mx + __builtin_amdgcn_logf(l);
}
__device__ __forceinline__ void attn_phase(const Args& A, unsigned char* lds, int n_total, int lane, int wave) {
    const int G = gridDim.x; LAS unsigned char* L = (LAS unsigned char*)lds;
    const int nk = (G == 256) ? n_total / 256 : (n_total - (int)blockIdx.x + G - 1) / G;
    if (nk <= 0) return;
    bf16x8 qa[2], qb[2];
    attn_prefetch(A, L, attn_item_of(0, G), lane, wave, qa);
    int cur = 0;
    for (int k = 0; k < nk; ++k) {
        asm volatile("s_waitcnt vmcnt(0)" ::: "memory");
        __syncthreads();
        qb[0] = qa[0]; qb[1] = qa[1];
        if (k + 1 < nk) attn_prefetch(A, L + (cur ^ 1) * 65536, attn_item_of(k + 1, G), lane, wave, qb);
        attn_compute(A, L + cur * 65536, attn_item_of(k, G), lane, wave, qa);
        qa[0] = qb[0]; qa[1] = qb[1]; cur ^= 1;
    }
    asm volatile("s_waitcnt vmcnt(0)" ::: "memory");
    __syncthreads();
}

constexpr int ML_TILE = 32768;
constexpr int ML_G = 4 * ML_TILE;
static_assert(ML_G + 8192 <= LDS_MISC, "mlstm LDS");
__device__ __forceinline__ int sw_off(int row, int ch) { return 256 * row + 16 * (ch ^ (((row & 3) << 2) | ((row >> 2) & 3))); }
__device__ __forceinline__ bf16x8 rowfrag(LAS unsigned char* tile, int row0, int ks, int fr, int g) { return *(const LAS bf16x8*)(tile + sw_off(row0 + fr, 4 * ks + g)); }
__device__ __forceinline__ bf16x8 colfrag(LAS unsigned char* tile, int ks, int ct, int fr, int g) {
    const int r0 = 32 * ks + 8 * g + (fr >> 2), p = fr & 3, ch = 2 * ct + (p >> 1);
    const v4i16_t a = __builtin_amdgcn_ds_read_tr16_b64_v4i16((LAS v4i16_t*)(tile + sw_off(r0, ch) + 8 * (p & 1)));
    const v4i16_t b = __builtin_amdgcn_ds_read_tr16_b64_v4i16((LAS v4i16_t*)(tile + sw_off(r0 + 4, ch) + 8 * (p & 1)));
    return (bf16x8){a[0], a[1], a[2], a[3], b[0], b[1], b[2], b[3]};
}
__device__ __forceinline__ float log_sigmoidf_(float x) { return (x > 0.f) ? -log1pf(__expf(-x)) : (x - log1pf(__expf(x))); }
__device__ __forceinline__ float wscan_sum(float v0, float v1, float& o0, float& o1, int lane) {
    float x = v0 + v1;
#pragma unroll
    for (int off = 1; off < 64; off <<= 1) { const float t = __shfl_up(x, off); if (lane >= off) x += t; }
    o0 = x - v1; o1 = x; return __shfl(x, 63);
}
__device__ __forceinline__ void wscan_max(float v0, float v1, float& o0, float& o1, int lane) {
    float y = fmaxf(v0, v1);
#pragma unroll
    for (int off = 1; off < 64; off <<= 1) { const float t = __shfl_up(y, off); if (lane >= off) y = fmaxf(y, t); }
    float pre = __shfl_up(y, 1); if (lane == 0) pre = -INFINITY;
    o0 = fmaxf(pre, v0); o1 = fmaxf(pre, fmaxf(v0, v1));
}
__device__ __forceinline__ void tile_load(LAS unsigned char* tile, const bf16* src, size_t pitch, int tid) {
    v4u v[4];
#pragma unroll
    for (int i = 0; i < 4; ++i) { const int id = tid + NTHR * i, row = id >> 4, ch = id & 15; v[i] = *(const v4u*)(src + (size_t)row * pitch + ch * 8); }
#pragma unroll
    for (int i = 0; i < 4; ++i) { const int id = tid + NTHR * i, row = id >> 4, ch = id & 15; *(LAS v4u*)(tile + sw_off(row, ch)) = v[i]; }
}

__device__ __forceinline__ void mlstm1_item(const Args& A, unsigned char* lds_, int item, int& wres, int tid, int lane, int wave) {
    unsigned char* ws = A.ws; LAS unsigned char* lds = (LAS unsigned char*)lds_;
    const float* conv_w = (const float*)(ws + WS_PAR) + PAR_CONVW; const float* conv_b = (const float*)(ws + WS_PAR) + PAR_CONVB;
    const int bh = item >> 6, c = item & 63, b = bh >> 2, h = bh & 3;
    const size_t t0 = (size_t)b * SEQ + 128 * c;
    LAS unsigned char* cA = lds; LAS unsigned char* Wq = lds + ML_TILE; LAS unsigned char* Wk = lds + 2 * ML_TILE; LAS unsigned char* Vt = lds + 3 * ML_TILE;
    LAS float* gl = (LAS float*)(lds + ML_G);
    const bf16* MU = (const bf16*)(ws + WS_MU) + h * 128; const bf16* MV = (const bf16*)(ws + WS_MV) + h * 128;
    bf16* Cg = (bf16*)((unsigned char*)A.out + DO_C) + h * 128;
    const int fr = lane & 15, g = lane >> 4, m0 = 16 * wave;
    if (wres != h) { const bf16* Wg = (const bf16*)(ws + WS_WM) + (size_t)h * 128 * 128; tile_load(Wq, Wg, 128, tid); tile_load(Wk, Wg + 4 * 128 * 128, 128, tid); wres = h; }
    tile_load(Vt, MV + t0 * 512, 512, tid);
    { const int ch = (tid & 15) * 8;
      float w[4][8], bs[8];
#pragma unroll
      for (int j = 0; j < 4; ++j) { const f32x4 w0 = *(const f32x4*)(conv_w + j * 512 + h * 128 + ch), w1 = *(const f32x4*)(conv_w + j * 512 + h * 128 + ch + 4);
          w[j][0] = w0[0]; w[j][1] = w0[1]; w[j][2] = w0[2]; w[j][3] = w0[3]; w[j][4] = w1[0]; w[j][5] = w1[1]; w[j][6] = w1[2]; w[j][7] = w1[3]; }
      { const f32x4 b0 = *(const f32x4*)(conv_b + h * 128 + ch), b1 = *(const f32x4*)(conv_b + h * 128 + ch + 4);
        bs[0] = b0[0]; bs[1] = b0[1]; bs[2] = b0[2]; bs[3] = b0[3]; bs[4] = b1[0]; bs[5] = b1[1]; bs[6] = b1[2]; bs[7] = b1[3]; }
#pragma unroll
      for (int i = 0; i < 4; ++i) { const int l = (tid >> 4) + 32 * i;
          float a[8];
#pragma unroll
          for (int q = 0; q < 8; ++q) a[q] = bs[q];
#pragma unroll
          for (int j = 0; j < 4; ++j) { const int sp = 128 * c + l + j - 3;
              if (sp >= 0) { const v4u m = *(const v4u*)(MU + ((size_t)b * SEQ + sp) * 512 + ch);
                  a[0] += bflo(m.x) * w[j][0]; a[1] += bfhi(m.x) * w[j][1]; a[2] += bflo(m.y) * w[j][2]; a[3] += bfhi(m.y) * w[j][3];
                  a[4] += bflo(m.z) * w[j][4]; a[5] += bfhi(m.z) * w[j][5]; a[6] += bflo(m.w) * w[j][6]; a[7] += bfhi(m.w) * w[j][7]; } }
#pragma unroll
          for (int q = 0; q < 8; ++q) a[q] = a[q] * sigmoidf_(a[q]);
          const v4u o = (v4u){pk2(a[0], a[1]), pk2(a[2], a[3]), pk2(a[4], a[5]), pk2(a[6], a[7])};
          *(LAS v4u*)(cA + sw_off(l, tid & 15)) = o; *(v4u*)(Cg + (t0 + l) * 512 + ch) = o; } }
    { const size_t gi = (size_t)bh * SEQ + 128 * c + 2 * lane;
      const float i0 = ((const float*)(ws + WS_IG))[gi], i1 = ((const float*)(ws + WS_IG))[gi + 1];
      const float f0 = log_sigmoidf_(((const float*)(ws + WS_FG))[gi]), f1 = log_sigmoidf_(((const float*)(ws + WS_FG))[gi + 1]);
      float b0, b1; const float blast = wscan_sum(f0, f1, b0, b1, lane);
      const float g0 = blast - b0 + i0, g1 = blast - b1 + i1, mloc = wave_max(fmaxf(g0, g1));
      gl[2 * lane] = __expf(g0 - mloc); gl[2 * lane + 1] = __expf(g1 - mloc);
      if (wave == 0 && lane == 0) { ((float*)(ws + WS_MLOC))[item] = mloc; ((float*)(ws + WS_BLAST))[item] = blast; } }
    __syncthreads();
    { bf16x8 af[4];
#pragma unroll
      for (int ks = 0; ks < 4; ++ks) af[ks] = rowfrag(cA, m0, ks, fr, g);
      f32x4 acc[8];
#pragma unroll
      for (int j = 0; j < 8; ++j) { acc[j] = (f32x4){0.f, 0.f, 0.f, 0.f};
#pragma unroll
          for (int ks = 0; ks < 4; ++ks) acc[j] = __builtin_amdgcn_mfma_f32_16x16x32_bf16(rowfrag(Wq, 16 * j, ks, fr, g), af[ks], acc[j], 0, 0, 0); }
      bf16* qg = (bf16*)(ws + WS_MQ) + (t0 + m0 + fr) * 512 + h * 128;
#pragma unroll
      for (int j = 0; j < 8; ++j) *(v2u*)(qg + 16 * j + 4 * g) = (v2u){pk2(acc[j][0], acc[j][1]), pk2(acc[j][2], acc[j][3])};
#pragma unroll
      for (int j = 0; j < 8; ++j) { acc[j] = (f32x4){0.f, 0.f, 0.f, 0.f};
#pragma unroll
          for (int ks = 0; ks < 4; ++ks) acc[j] = __builtin_amdgcn_mfma_f32_16x16x32_bf16(rowfrag(Wk, 16 * j, ks, fr, g), af[ks], acc[j], 0, 0, 0); }
      bf16* kg = (bf16*)(ws + WS_MK) + (t0 + m0 + fr) * 512 + h * 128; const float wk = gl[m0 + fr];
#pragma unroll
      for (int j = 0; j < 8; ++j) { *(v2u*)(kg + 16 * j + 4 * g) = (v2u){pk2(acc[j][0], acc[j][1]), pk2(acc[j][2], acc[j][3])};
          *(LAS v2u*)(cA + sw_off(m0 + fr, 2 * j + (g >> 1)) + 8 * (g & 1)) = (v2u){pk2(acc[j][0] * wk, acc[j][1] * wk), pk2(acc[j][2] * wk, acc[j][3] * wk)}; } }
    __syncthreads();
    { f32x4 acc[8], accn = (f32x4){0.f, 0.f, 0.f, 0.f};
#pragma unroll
      for (int j = 0; j < 8; ++j) acc[j] = (f32x4){0.f, 0.f, 0.f, 0.f};
      const bf16x8 ones = (bf16x8){0x3f80, 0x3f80, 0x3f80, 0x3f80, 0x3f80, 0x3f80, 0x3f80, 0x3f80};
#pragma unroll
      for (int ks = 0; ks < 4; ++ks) { const bf16x8 vf = colfrag(Vt, ks, wave, fr, g);
#pragma unroll
          for (int j = 0; j < 8; ++j) { const bf16x8 kf = colfrag(cA, ks, j, fr, g); acc[j] = __builtin_amdgcn_mfma_f32_16x16x32_bf16(kf, vf, acc[j], 0, 0, 0);
              if (j == wave) accn = __builtin_amdgcn_mfma_f32_16x16x32_bf16(kf, ones, accn, 0, 0, 0); } }
      bf16* cg = (bf16*)(ws + WS_CLOC) + ((size_t)item * 128 + m0 + fr) * 128;
#pragma unroll
      for (int j = 0; j < 8; ++j) *(v2u*)(cg + 16 * j + 4 * g) = (v2u){pk2(acc[j][0], acc[j][1]), pk2(acc[j][2], acc[j][3])};
      if (fr == 0) *(f32x4*)((float*)(ws + WS_NLOC) + (size_t)item * 128 + 16 * wave + 4 * g) = accn; }
    __syncthreads();
}

__device__ __forceinline__ void p3_scan_combine(const Args& A, int tid) {
    unsigned char* ws = A.ws;
    const int G = gridDim.x, NGT = G * NTHR;
    for (int gid = blockIdx.x * NTHR + tid; gid < 32 * 4096; gid += NGT) {
        const int bh = gid >> 12, rem = gid & 4095, e = rem >> 5, dq = rem & 31;
        const float* MLOC = (const float*)(ws + WS_MLOC) + bh * 64; const float* BL = (const float*)(ws + WS_BLAST) + bh * 64;
        f32x4 C = (f32x4){0.f, 0.f, 0.f, 0.f}, n = (f32x4){0.f, 0.f, 0.f, 0.f}; float m = 0.f;
        for (int c = 0; c < 64; ++c) {
            const size_t idx = (size_t)bh * 64 + c;
            const v2u cw = *(const v2u*)((const bf16*)(ws + WS_CLOC) + (idx * 128 + e) * 128 + 4 * dq); const f32x4 Cl = (f32x4){bflo(cw.x), bfhi(cw.x), bflo(cw.y), bfhi(cw.y)};
            *(v2u*)((bf16*)(ws + WS_CPREV) + (idx * 128 + e) * 128 + 4 * dq) = (v2u){pk2(C[0], C[1]), pk2(C[2], C[3])};
            const float ml = MLOC[c], bl = BL[c];
            const float mnew = fmaxf(bl + m, ml), a = __expf(bl + m - mnew), cc = __expf(ml - mnew);
            if (e == 0) { *(f32x4*)((float*)(ws + WS_NPREV) + idx * 128 + 4 * dq) = n;
                const f32x4 nl = *(const f32x4*)((const float*)(ws + WS_NLOC) + idx * 128 + 4 * dq); n = n * a + nl * cc;
                if (dq == 0) ((float*)(ws + WS_MPREV))[idx] = m; }
            C = C * a + Cl * cc; m = mnew;
        }
    }
    const bf16* OA = (const bf16*)((const unsigned char*)A.out + DO_OATT); const float* LSE = (const float*)(ws + WS_LSE);
    for (size_t id = (size_t)blockIdx.x * NTHR + tid; id < (size_t)T * 64; id += NGT) {
        const size_t t = id >> 6; const int h = (int)(id & 63) >> 3, ch = (int)(id & 7) * 8;
        const float l0 = LSE[t * 8 + h], l1 = LSE[((size_t)T + t) * 8 + h], l2 = LSE[((size_t)2 * T + t) * 8 + h];
        const float mx = fmaxf(l0, fmaxf(l1, l2)); float w0 = exp2f(l0 - mx), w1 = exp2f(l1 - mx), w2 = exp2f(l2 - mx);
        const float rs = 1.0f / (w0 + w1 + w2); w0 *= rs; w1 *= rs; w2 *= rs;
        const v4u a = *(const v4u*)(OA + t * 512 + h * 64 + ch), b = *(const v4u*)(OA + ((size_t)T + t) * 512 + h * 64 + ch), c = *(const v4u*)(OA + ((size_t)2 * T + t) * 512 + h * 64 + ch);
        v4u o;
        o.x = pk2(w0 * bflo(a.x) + w1 * bflo(b.x) + w2 * bflo(c.x), w0 * bfhi(a.x) + w1 * bfhi(b.x) + w2 * bfhi(c.x));
        o.y = pk2(w0 * bflo(a.y) + w1 * bflo(b.y) + w2 * bflo(c.y), w0 * bfhi(a.y) + w1 * bfhi(b.y) + w2 * bfhi(c.y));
        o.z = pk2(w0 * bflo(a.z) + w1 * bflo(b.z) + w2 * bflo(c.z), w0 * bfhi(a.z) + w1 * bfhi(b.z) + w2 * bfhi(c.z));
        o.w = pk2(w0 * bflo(a.w) + w1 * bflo(b.w) + w2 * bflo(c.w), w0 * bfhi(a.w) + w1 * bfhi(b.w) + w2 * bfhi(c.w));
        *(v4u*)((bf16*)(ws + WS_Y) + t * 1024 + h * 64 + ch) = o;
    }
}

__device__ __forceinline__ void mlstm2_item(const Args& A, unsigned char* lds_, int item, int tid, int lane, int wave) {
    unsigned char* ws = A.ws; LAS unsigned char* lds = (LAS unsigned char*)lds_;
    const float* g_mhn = (const float*)(ws + WS_PAR) + PAR_GMHN; const float* skip_m = (const float*)(ws + WS_PAR) + PAR_SKIP;
    const int bh = item >> 6, c = item & 63, b = bh >> 2, h = bh & 3;
    const size_t t0 = (size_t)b * SEQ + 128 * c;
    LAS unsigned char* qA = lds; LAS unsigned char* kA = lds + ML_TILE; LAS unsigned char* Vt = lds + 2 * ML_TILE; LAS unsigned char* Cp = lds + 3 * ML_TILE;
    LAS float* gl = (LAS float*)(lds + ML_G);
    const int fr = lane & 15, g = lane >> 4, m0 = 16 * wave, l = m0 + fr;
    tile_load(qA, (const bf16*)(ws + WS_MQ) + t0 * 512 + h * 128, 512, tid);
    tile_load(kA, (const bf16*)(ws + WS_MK) + t0 * 512 + h * 128, 512, tid);
    tile_load(Vt, (const bf16*)(ws + WS_MV) + t0 * 512 + h * 128, 512, tid);
    tile_load(Cp, (const bf16*)(ws + WS_CPREV) + (size_t)item * 128 * 128, 128, tid);
    { const size_t gi = (size_t)bh * SEQ + 128 * c + 2 * lane; const float mprev = ((const float*)(ws + WS_MPREV))[item];
      const float i0 = ((const float*)(ws + WS_IG))[gi], i1 = ((const float*)(ws + WS_IG))[gi + 1];
      const float f0 = log_sigmoidf_(((const float*)(ws + WS_FG))[gi]), f1 = log_sigmoidf_(((const float*)(ws + WS_FG))[gi + 1]);
      float b0, b1; (void)wscan_sum(f0, f1, b0, b1, lane);
      const float a0 = i0 - b0, a1 = i1 - b1; float p0, p1; wscan_max(a0, a1, p0, p1, lane);
      const float mt0 = fmaxf(b0 + mprev, b0 + p0), mt1 = fmaxf(b1 + mprev, b1 + p1);
      gl[2 * lane] = a0; gl[2 * lane + 1] = a1; gl[128 + 2 * lane] = b0 - mt0; gl[128 + 2 * lane + 1] = b1 - mt1;
      gl[256 + 2 * lane] = __expf(b0 + mprev - mt0); gl[256 + 2 * lane + 1] = __expf(b1 + mprev - mt1); gl[384 + 2 * lane] = __expf(-mt0); gl[384 + 2 * lane + 1] = __expf(-mt1); }
    __syncthreads();
    bf16x8 qf[4];
#pragma unroll
    for (int ks = 0; ks < 4; ++ks) qf[ks] = rowfrag(qA, m0, ks, fr, g);
    float qn = 0.f;
    { const float* np = (const float*)(ws + WS_NPREV) + (size_t)item * 128;
#pragma unroll
      for (int ks = 0; ks < 4; ++ks) { const f32x4 n0 = *(const f32x4*)(np + 32 * ks + 8 * g), n1 = *(const f32x4*)(np + 32 * ks + 8 * g + 4); const v4u w = __builtin_bit_cast(v4u, qf[ks]);
          qn += bflo(w.x) * n0[0] + bfhi(w.x) * n0[1] + bflo(w.y) * n0[2] + bfhi(w.y) * n0[3] + bflo(w.z) * n1[0] + bfhi(w.z) * n1[1] + bflo(w.w) * n1[2] + bfhi(w.w) * n1[3]; }
      qn += __shfl_xor(qn, 16); qn += __shfl_xor(qn, 32); }
    float den = 0.f;
    { const float rc = gl[128 + l];
#pragma unroll
      for (int j = 0; j < 8; ++j) { f32x4 acc = (f32x4){0.f, 0.f, 0.f, 0.f};
          if (j <= wave) {
#pragma unroll
              for (int ks = 0; ks < 4; ++ks) acc = __builtin_amdgcn_mfma_f32_16x16x32_bf16(rowfrag(kA, 16 * j, ks, fr, g), qf[ks], acc, 0, 0, 0);
#pragma unroll
              for (int e = 0; e < 4; ++e) { const int sx = 16 * j + 4 * g + e; acc[e] = (sx <= l) ? acc[e] * __expf(rc + gl[sx]) : 0.f; den += acc[e]; } }
          *(LAS v2u*)(qA + sw_off(l, 2 * j + (g >> 1)) + 8 * (g & 1)) = (v2u){pk2(acc[0], acc[1]), pk2(acc[2], acc[3])}; }
      den += __shfl_xor(den, 16); den += __shfl_xor(den, 32); }
    f32x4 acc[8];
    const float iw = gl[256 + l];
#pragma unroll
    for (int j = 0; j < 8; ++j) { acc[j] = (f32x4){0.f, 0.f, 0.f, 0.f};
#pragma unroll
        for (int ks = 0; ks < 4; ++ks) acc[j] = __builtin_amdgcn_mfma_f32_16x16x32_bf16(rowfrag(Cp, 16 * j, ks, fr, g), qf[ks], acc[j], 0, 0, 0);
        acc[j] = acc[j] * iw; }
    asm volatile("s_waitcnt lgkmcnt(0)" ::: "memory");
#pragma unroll
    for (int ks = 0; ks < 4; ++ks) if (2 * ks <= wave) { const bf16x8 sf = rowfrag(qA, m0, ks, fr, g);
#pragma unroll
        for (int j = 0; j < 8; ++j) acc[j] = __builtin_amdgcn_mfma_f32_16x16x32_bf16(colfrag(Vt, ks, j, fr, g), sf, acc[j], 0, 0, 0); }
    den += iw * qn;
    const float rden = 1.0f / fmaxf(fabsf(den), gl[384 + l]);
    float sq = 0.f;
#pragma unroll
    for (int j = 0; j < 8; ++j) { acc[j] = acc[j] * rden; sq += (acc[j][0] * acc[j][0] + acc[j][1] * acc[j][1]) + (acc[j][2] * acc[j][2] + acc[j][3] * acc[j][3]); }
    sq += __shfl_xor(sq, 16); sq += __shfl_xor(sq, 32);
    const float rn = 1.0f / sqrtf(sq * (1.0f / 128.0f) + EPSN);
    const bf16* MOg = (const bf16*)(ws + WS_MO) + (t0 + l) * 512 + h * 128; const bf16* Cg = (const bf16*)((const unsigned char*)A.out + DO_C) + (t0 + l) * 512 + h * 128;
    bf16* yg = (bf16*)(ws + WS_Y) + (t0 + l) * 1024 + 512 + h * 128;
#pragma unroll
    for (int j = 0; j < 8; ++j) { const int e0 = 16 * j + 4 * g;
        const v2u mo = *(const v2u*)(MOg + e0), cc = *(const v2u*)(Cg + e0);
        const f32x4 gm = *(const f32x4*)(g_mhn + h * 128 + e0), sk = *(const f32x4*)(skip_m + h * 128 + e0);
        const float y0 = sigmoidf_(bflo(mo.x)) * (acc[j][0] * rn * gm[0] + sk[0] * bflo(cc.x));
        const float y1 = sigmoidf_(bfhi(mo.x)) * (acc[j][1] * rn * gm[1] + sk[1] * bfhi(cc.x));
        const float y2 = sigmoidf_(bflo(mo.y)) * (acc[j][2] * rn * gm[2] + sk[2] * bflo(cc.y));
        const float y3 = sigmoidf_(bfhi(mo.y)) * (acc[j][3] * rn * gm[3] + sk[3] * bfhi(cc.y));
        *(v2u*)(yg + e0) = (v2u){pk2(y0, y1), pk2(y2, y3)}; }
    __syncthreads();
}

struct EpiOutProj {
    static constexpr bool PERM = true, AFTER_DRAIN = false;
    const float* x; bf16* x1b; float* ss;
    __device__ __forceinline__ void operator()(const f32x4 (&acc)[2][2][4][2], const pg8::Unit& u, int wr, int wc, int fr, int fq) const {
        const int row0 = u.pm * 256 + wr * 64 + fr, col0 = u.pn * 256 + wc * 32 + 8 * fq;
#pragma unroll
        for (int ai = 0; ai < 2; ++ai)
#pragma unroll
            for (int m = 0; m < 4; ++m) { const int row = row0 + ai * 128 + m * 16; float sq = 0.f;
#pragma unroll
                for (int bj = 0; bj < 2; ++bj) { const size_t off = (size_t)row * D + col0 + bj * 128;
                    const f32x4 o0 = *(const f32x4*)(x + off) + acc[ai][bj][m][0], o1 = *(const f32x4*)(x + off + 4) + acc[ai][bj][m][1];
                    *(v4u*)(x1b + off) = pack8(o0, o1);
                    sq += ((o0[0] * o0[0] + o0[1] * o0[1]) + (o0[2] * o0[2] + o0[3] * o0[3])) + ((o1[0] * o1[0] + o1[1] * o1[1]) + (o1[2] * o1[2] + o1[3] * o1[3])); }
                sq += __shfl_xor(sq, 16); sq += __shfl_xor(sq, 32);
                if (fq == 0) ss[(size_t)row * 16 + u.pn * 4 + wc] = sq; }
    }
};
struct EpiQx {
    static constexpr bool PERM = true, AFTER_DRAIN = false;
    bf16* qx; const LAS float* rs;
    __device__ __forceinline__ void operator()(const f32x4 (&acc)[2][2][4][2], const pg8::Unit& u, int wr, int wc, int fr, int fq) const {
        const int rl0 = wr * 64 + fr, col0 = wc * 32 + 8 * fq;
#pragma unroll
        for (int ai = 0; ai < 2; ++ai)
#pragma unroll
            for (int m = 0; m < 4; ++m) { const int rl = rl0 + ai * 128 + m * 16; const float sc = rs[rl]; bf16* rowp = qx + (size_t)(u.pm * 256 + rl) * 256 + col0;
#pragma unroll
                for (int bj = 0; bj < 2; ++bj) *(v4u*)(rowp + bj * 128) = pack8(acc[ai][bj][m][0] * sc, acc[ai][bj][m][1] * sc);
                asm volatile("" ::: "memory"); }
    }
};
struct EpiOx {
    static constexpr bool PERM = true, AFTER_DRAIN = false;
    const bf16* x1b; bf16* x2b;
    __device__ __forceinline__ void operator()(const f32x4 (&acc)[2][2][4][2], const pg8::Unit& u, int wr, int wc, int fr, int fq) const {
        const int row0 = u.pm * 256 + wr * 64 + fr, col0 = u.pn * 256 + wc * 32 + 8 * fq;
#pragma unroll
        for (int ai = 0; ai < 2; ++ai)
#pragma unroll
            for (int m = 0; m < 4; ++m) {
#pragma unroll
                for (int bj = 0; bj < 2; ++bj) { const size_t off = (size_t)(row0 + ai * 128 + m * 16) * D + col0 + bj * 128; const v4u r = *(const v4u*)(x1b + off);
                    f32x4 o0 = acc[ai][bj][m][0], o1 = acc[ai][bj][m][1];
                    o0[0] += bflo(r.x); o0[1] += bfhi(r.x); o0[2] += bflo(r.y); o0[3] += bfhi(r.y); o1[0] += bflo(r.z); o1[1] += bfhi(r.z); o1[2] += bflo(r.w); o1[3] += bfhi(r.w);
                    *(v4u*)(x2b + off) = pack8(o0, o1); }
                asm volatile("" ::: "memory"); }
    }
};
constexpr int CX_QLD = 72, CX_KLD = 72, CX_VLD = 264, CX_PLD = 264;
constexpr int CX_Q = 0, CX_K = CX_Q + 128 * CX_QLD * 2, CX_V = CX_K + 256 * CX_KLD * 2, CX_P = CX_V + 64 * CX_VLD * 2, CX_END = CX_P + 8 * 16 * CX_PLD * 2;
static_assert(CX_END <= LDS_MISC, "cross LDS");
__device__ __forceinline__ void cross_item(const Args& A, unsigned char* lds, int item, int tid, int lane, int wave) {
    unsigned char* ws = A.ws;
    const int rt = item >> 2, h = item & 3; const size_t t0 = (size_t)rt * 128; const int b = (int)(t0 / SEQ);
    bf16* Qs = (bf16*)(lds + CX_Q); bf16* Ks = (bf16*)(lds + CX_K); bf16* Vt = (bf16*)(lds + CX_V); bf16* Ps = (bf16*)(lds + CX_P) + wave * 16 * CX_PLD;
    const bf16* QX = (const bf16*)(ws + WS_QX) + h * 64; const bf16* KV = (const bf16*)(ws + WS_KVX) + (size_t)b * MEMLEN * NKV + h * 64;
    for (int id = tid; id < 128 * 8; id += NTHR) { const int row = id >> 3, ch = id & 7; *(v4u*)(Qs + row * CX_QLD + ch * 8) = *(const v4u*)(QX + (t0 + row) * 256 + ch * 8); }
    for (int id = tid; id < 256 * 8; id += NTHR) { const int kk = id >> 3, ch = id & 7;
        *(v4u*)(Ks + kk * CX_KLD + ch * 8) = *(const v4u*)(KV + (size_t)kk * NKV + ch * 8);
        const v4u vv = *(const v4u*)(KV + (size_t)kk * NKV + 256 + ch * 8); bf16* vp = Vt + (ch * 8) * CX_VLD + kk;
        vp[0 * CX_VLD] = (bf16)(vv.x & 0xffffu); vp[1 * CX_VLD] = (bf16)(vv.x >> 16); vp[2 * CX_VLD] = (bf16)(vv.y & 0xffffu); vp[3 * CX_VLD] = (bf16)(vv.y >> 16);
        vp[4 * CX_VLD] = (bf16)(vv.z & 0xffffu); vp[5 * CX_VLD] = (bf16)(vv.z >> 16); vp[6 * CX_VLD] = (bf16)(vv.w & 0xffffu); vp[7 * CX_VLD] = (bf16)(vv.w >> 16); }
    __syncthreads();
    const int fr = lane & 15, fq = lane >> 4;
    f32x4 s[1][16];
#pragma unroll
    for (int j = 0; j < 16; ++j) s[0][j] = (f32x4){0.f, 0.f, 0.f, 0.f};
    wave_mma<1, 16>(Qs + 16 * wave * CX_QLD, CX_QLD, Ks, CX_KLD, 64, s, fr, fq);
    float mx = -1e30f;
#pragma unroll
    for (int j = 0; j < 16; ++j)
#pragma unroll
        for (int e = 0; e < 4; ++e) mx = fmaxf(mx, s[0][j][e]);
    mx = fmaxf(mx, __shfl_xor(mx, 16)); mx = fmaxf(mx, __shfl_xor(mx, 32));
    float l = 0.f;
#pragma unroll
    for (int j = 0; j < 16; ++j) { f32x4 p;
#pragma unroll
        for (int e = 0; e < 4; ++e) { p[e] = exp2f(s[0][j][e] - mx); l += p[e]; }
        *(v2u*)(Ps + fr * CX_PLD + 16 * j + 4 * fq) = (v2u){pk2(p[0], p[1]), pk2(p[2], p[3])}; }
    l += __shfl_xor(l, 16); l += __shfl_xor(l, 32);
    __syncthreads();
    f32x4 o[1][4];
#pragma unroll
    for (int j = 0; j < 4; ++j) o[0][j] = (f32x4){0.f, 0.f, 0.f, 0.f};
    wave_mma<1, 4>(Ps, CX_PLD, Vt, CX_VLD, 256, o, fr, fq);
    const float rl = 1.0f / l;
    bf16* og = (bf16*)(ws + WS_OX) + (t0 + 16 * wave + fr) * 256 + h * 64;
#pragma unroll
    for (int j = 0; j < 4; ++j) *(v2u*)(og + 16 * j + 4 * fq) = (v2u){pk2(o[0][j][0] * rl, o[0][j][1] * rl), pk2(o[0][j][2] * rl, o[0][j][3] * rl)};
    __syncthreads();
}

struct TokInfo { int bucket; float wa, wb; int rank; };
constexpr size_t WS_RSTD3 = 18 * MiB;
constexpr size_t WS_CNTTAB = 31 * MiB + 512 * 1024;
__device__ __forceinline__ void p9_route(const Args& A, unsigned char* lds, int tid, int lane, int wave) {
    unsigned char* ws = A.ws;
    const float* b_rg = (const float*)(ws + WS_PAR) + PAR_BRG; const float* b_re = (const float*)(ws + WS_PAR) + PAR_BRE;
    LAS float* WRl = (LAS float*)lds;
    LAS int* bkl = (LAS int*)(lds + 81920);
    for (int i = tid; i < 20 * 1024 / 4; i += NTHR) ((LAS f32x4*)WRl)[i] = ((const f32x4*)(ws + WS_WR))[i];
    __syncthreads();
    const bf16* X2B = (const bf16*)(ws + WS_HBS);
    for (int chunk = blockIdx.x; chunk < T / 256; chunk += gridDim.x) {
        for (int r = 0; r < 32; ++r) {
            const int m = chunk * 256 + wave * 32 + r;
            const v4u* xr = (const v4u*)(X2B + (size_t)m * D) + lane;
            f32x4 v[4]; float s = 0.f;
#pragma unroll
            for (int j = 0; j < 2; ++j) { const v4u r = xr[64 * j]; v[2 * j] = (f32x4){bflo(r.x), bfhi(r.x), bflo(r.y), bfhi(r.y)}; v[2 * j + 1] = (f32x4){bflo(r.z), bfhi(r.z), bflo(r.w), bfhi(r.w)}; }
#pragma unroll
            for (int j = 0; j < 4; ++j) s += (v[j].x * v[j].x + v[j].y * v[j].y) + (v[j].z * v[j].z + v[j].w * v[j].w);
            const float rstd = 1.0f / sqrtf(wave_sum(s) * (1.0f / D) + EPSN);
            float gl4[4];
#pragma unroll
            for (int e = 0; e < 4; ++e) { float a = 0.f;
#pragma unroll
                for (int j = 0; j < 4; ++j) { const f32x4 w = *(const LAS f32x4*)(WRl + e * 1024 + 512 * (j >> 1) + 8 * lane + 4 * (j & 1)); a += (v[j].x * w.x + v[j].y * w.y) + (v[j].z * w.z + v[j].w * w.w); }
                gl4[e] = wave_sum(a) * rstd + b_rg[e]; }
            int g = 0; float gm = gl4[0];
#pragma unroll
            for (int i = 1; i < 4; ++i) if (gl4[i] > gm) { gm = gl4[i]; g = i; }
            g = __builtin_amdgcn_readfirstlane(g);
            float gs = 0.f;
#pragma unroll
            for (int i = 0; i < 4; ++i) gs += __expf(gl4[i] - gm);
            const float gw_ = 1.0f / gs;
            float el[4];
            const LAS float* WRe = WRl + (4 + 4 * g) * 1024;
#pragma unroll
            for (int e = 0; e < 4; ++e) { float a = 0.f;
#pragma unroll
                for (int j = 0; j < 4; ++j) { const f32x4 w = *(const LAS f32x4*)(WRe + e * 1024 + 512 * (j >> 1) + 8 * lane + 4 * (j & 1)); a += (v[j].x * w.x + v[j].y * w.y) + (v[j].z * w.z + v[j].w * w.w); }
                el[e] = wave_sum(a) * rstd + b_re[g * 4 + e]; }
            int i0 = 0; float v0 = el[0];
#pragma unroll
            for (int i = 1; i < 4; ++i) if (el[i] > v0) { v0 = el[i]; i0 = i; }
            int i1 = -1; float v1 = -INFINITY;
#pragma unroll
            for (int i = 0; i < 4; ++i) if (i != i0 && el[i] > v1) { v1 = el[i]; i1 = i; }
            const float e1 = __expf(v1 - v0); const float w0 = gw_ / (1.0f + e1), w1 = gw_ * e1 / (1.0f + e1);
            const int pa = i0 < i1 ? i0 : i1, pb = i0 < i1 ? i1 : i0;
            const int pidx = (pa == 0) ? (pb - 1) : (pa == 1 ? pb + 1 : 5);
            const int bucket = g * 6 + pidx;
            if (lane == 0) { ((float*)(ws + WS_RSTD3))[m] = rstd; bkl[wave * 32 + r] = bucket; ((LAS float*)(bkl + 256))[wave * 32 + r] = (i0 < i1) ? w0 : w1; ((LAS float*)(bkl + 512))[wave * 32 + r] = (i0 < i1) ? w1 : w0; }
        }
        __syncthreads();
        if (tid < 256) { const int my = bkl[tid]; int rank = 0; for (int j = 0; j < tid; ++j) rank += (bkl[j] == my) ? 1 : 0;
            TokInfo ti; ti.bucket = my; ti.wa = ((LAS float*)(bkl + 256))[tid]; ti.wb = ((LAS float*)(bkl + 512))[tid]; ti.rank = rank;
            ((TokInfo*)(ws + WS_TOKINFO))[chunk * 256 + tid] = ti; }
        else if (tid < 256 + NBUCKET) { const int b = tid - 256; int c = 0; for (int j = 0; j < 256; ++j) c += (bkl[j] == b) ? 1 : 0;
            ((int*)(ws + WS_CNTTAB))[chunk * NBUCKET + b] = c; }
        __syncthreads();
    }
}
__device__ __forceinline__ void p10_slots(const Args& A, unsigned char* lds, int tid, int lane, int wave) {
    unsigned char* ws = A.ws;
    LAS int* tabl = (LAS int*)lds;
    LAS int* totl = (LAS int*)(lds + 32768);
    const int* CNTTAB = (const int*)(ws + WS_CNTTAB);
    for (int i = tid; i < 256 * NBUCKET; i += NTHR) tabl[i] = CNTTAB[i];
    __syncthreads();
    if (tid < NBUCKET) { int t = 0; for (int w = 0; w < 256; ++w) t += tabl[w * NBUCKET + tid]; totl[tid] = t; }
    __syncthreads();
    if (tid == 0) { int acc = 0; for (int b = 0; b < NBUCKET; ++b) { totl[32 + b] = acc; acc += ((totl[b] + 255) >> 8) * 256; } totl[32 + NBUCKET] = acc; }
    if (blockIdx.x == 0 && tid < NBUCKET) ((unsigned*)(ws + WS_CTL))[CW_CNT + tid] = (unsigned)totl[tid];
    __syncthreads();
    int* TOKMAP = (int*)(ws + WS_TOKMAP); float* WSORT = (float*)(ws + WS_WSORT);
    for (int chunk = blockIdx.x; chunk < T / 256; chunk += gridDim.x) {
        if (tid < NBUCKET) { int s = 0; for (int w = 0; w < chunk; ++w) s += tabl[w * NBUCKET + tid]; totl[64 + tid] = totl[32 + tid] + s; }
        __syncthreads();
        if (tid < 256) { const int m = chunk * 256 + tid; const TokInfo ti = ((const TokInfo*)(ws + WS_TOKINFO))[m]; const int slot = totl[64 + ti.bucket] + ti.rank;
            TOKMAP[slot] = m; *(f32x4*)(WSORT + 4 * slot) = (f32x4){ti.wa, ti.wb, ((const float*)(ws + WS_RSTD3))[m], 0.f}; }
        __syncthreads();
    }
    for (int b = blockIdx.x; b < NBUCKET; b += gridDim.x)
        for (int r = totl[32 + b] + totl[b] + tid; r < totl[32 + b + 1]; r += NTHR) { TOKMAP[r] = -1; *(f32x4*)(WSORT + 4 * r) = (f32x4){0.f, 0.f, 0.f, 0.f}; }
}
struct MoeOrder {
    int G, c, nunits, ncol; const int* tab;
    __device__ __forceinline__ bool next(int i, pg8::Unit& u) const {
        const long L = (long)i * G + c; if (L >= nunits) return false;
        const int rt = (int)L / ncol, j = (int)L % ncol, bk = tab[rt];
        u.pm = rt; u.aux = j;
        if (ncol == 8) { const int g = bk / 6, p = bk % 6; const int pa = (p < 3) ? 0 : (p < 5 ? 1 : 2), pb = (p < 3) ? p + 1 : (p < 5 ? p - 1 : 3);
            const int e = 4 * g + ((j >> 2) ? pb : pa); u.pn = e * 4 + (j & 3); }
        else u.pn = bk * 4 + j;
        return true;
    }
    __device__ __forceinline__ void a_ready(const pg8::Unit&) const {}
    __device__ __forceinline__ void done(const pg8::Unit&) const {}
};
struct EpiUp {
    static constexpr bool PERM = true, AFTER_DRAIN = false;
    bf16* act; const float* wsort;
    __device__ __forceinline__ void operator()(const f32x4 (&acc)[2][2][4][2], const pg8::Unit& u, int wr, int wc, int fr, int fq) const {
        const int row0 = u.pm * 256 + wr * 64 + fr, half = u.aux >> 2, col0 = half * 512 + (u.aux & 3) * 128 + wc * 32 + 8 * fq;
#pragma unroll
        for (int ai = 0; ai < 2; ++ai)
#pragma unroll
            for (int m = 0; m < 4; ++m) { const int row = row0 + ai * 128 + m * 16; const float w = wsort[4 * row + half], rs = wsort[4 * row + 2];
                f32x4 r0, r1;
#pragma unroll
                for (int i = 0; i < 4; ++i) { const float a0 = acc[ai][0][m][0][i] * rs, a1 = acc[ai][0][m][1][i] * rs;
                    r0[i] = a0 * sigmoidf_(a0) * (acc[ai][1][m][0][i] * rs) * w; r1[i] = a1 * sigmoidf_(a1) * (acc[ai][1][m][1][i] * rs) * w; }
                *(v4u*)(act + (size_t)row * D + col0) = pack8(r0, r1); }
    }
};
struct EpiDown {
    static constexpr bool PERM = true, AFTER_DRAIN = false;
    const bf16* x2b; float* xo; const int* tokmap;
    __device__ __forceinline__ void operator()(const f32x4 (&acc)[2][2][4][2], const pg8::Unit& u, int wr, int wc, int fr, int fq) const {
        const int row0 = u.pm * 256 + wr * 64 + fr, col0 = u.aux * 256 + wc * 32 + 8 * fq;
#pragma unroll
        for (int ai = 0; ai < 2; ++ai)
#pragma unroll
            for (int m = 0; m < 4; ++m) { const int tok = tokmap[row0 + ai * 128 + m * 16];
                if (tok >= 0) {
#pragma unroll
                    for (int bj = 0; bj < 2; ++bj) { const size_t off = (size_t)tok * D + col0 + bj * 128; const v4u r = *(const v4u*)(x2b + off);
                        f32x4 o0 = acc[ai][bj][m][0], o1 = acc[ai][bj][m][1];
                        o0[0] += bflo(r.x); o0[1] += bfhi(r.x); o0[2] += bflo(r.y); o0[3] += bfhi(r.y); o1[0] += bflo(r.z); o1[1] += bfhi(r.z); o1[2] += bflo(r.w); o1[3] += bfhi(r.w);
                        *(f32x4*)(xo + off) = o0; *(f32x4*)(xo + off + 4) = o1; } } }
    }
};
__device__ __forceinline__ void p10_final(const Args& A, float* outp, int lane, int wave) {
    const float* g_final = (const float*)(A.ws + WS_PAR) + PAR_GFIN;
    const int G = gridDim.x, gw = blockIdx.x * NWAVES + wave, NGW = G * NWAVES;
    f32x4 gv[4];
#pragma unroll
    for (int j = 0; j < 4; ++j) gv[j] = *((const f32x4*)g_final + lane + 64 * j);
    for (int m = gw; m < T; m += NGW) {
        f32x4* xr = (f32x4*)(A.out + (size_t)m * D) + lane;
        f32x4 v[4]; float s = 0.f;
#pragma unroll
        for (int j = 0; j < 4; ++j) { v[j] = xr[64 * j]; s += (v[j].x * v[j].x + v[j].y * v[j].y) + (v[j].z * v[j].z + v[j].w * v[j].w); }
        const float rstd = 1.0f / sqrtf(wave_sum(s) * (1.0f / D) + EPSN);
#pragma unroll
        for (int j = 0; j < 4; ++j) ((f32x4*)(outp + (size_t)m * D) + lane)[64 * j] = v[j] * rstd * gv[j];
    }
}

#ifndef MS
#define MS 4
#endif
#ifndef N_LAUNCHES
#define N_LAUNCHES 1
#endif
constexpr int N_PHASES = 14;
#ifndef DUP_MASK
#define DUP_MASK 0
#endif
#define REP(k) for (int rep_ = 0; rep_ < (((DUP_MASK >> (k)) & 1) ? 2 : 1); ++rep_)
#ifndef QX_SP2
#define QX_SP2 false
#endif

#ifndef NVG
#define NVG 256
#endif
__global__ void __launch_bounds__(NTHR, 2) __attribute__((amdgpu_num_vgpr(NVG))) fwd_kernel(Args args) {
    __shared__ __attribute__((aligned(16))) unsigned char lds[LDS_BYTES];
    const int tid = threadIdx.x, lane = tid & 63, wave = __builtin_amdgcn_readfirstlane(tid >> 6);
    gu32* ctl = (gu32*)(args.ws + WS_CTL);
    for (int u = tid; u < (LDS_BYTES - LDS_MISC) / 4; u += NTHR) ((unsigned*)(lds + LDS_MISC))[u] = 0u;
    __syncthreads();
    const int lo = args.ph_lo, hi = args.ph_hi;
    const bool use_bar = (hi - lo) > 1;
    XcdBarrier bar; bar.bar = (unsigned*)ctl + CW_BAR; bar.x = 0; bar.st = (volatile LAS unsigned*)(lds + LDS_MISC) + 8;
    if (use_bar) bar = xcd_barrier_post((unsigned*)ctl + CW_BAR, (volatile LAS unsigned*)(lds + LDS_MISC) + 8);
#ifndef PH_MASK
#define PH_MASK 0xFFFF
#endif
#define IN(k) (((PH_MASK >> (k)) & 1) && lo <= (k) && (k) < hi)
#define SEAM(k) do { if (IN(k) && IN((k) + 1)) xcd_barrier(bar); } while (0)
    PG8_LAS unsigned char* ring = (PG8_LAS unsigned char*)lds;
    const int G = gridDim.x;
#define PHASE_PTRS Args pa = args; { unsigned char* w_ = args.ws; float* o_ = args.out; asm volatile("" : "+s"(w_), "+s"(o_)); pa.ws = w_; pa.out = o_; } unsigned char* const ws = pa.ws; (void)ws

#ifdef DUMMY_LIVE
    float dl0, dl1, dl2, dl3, dl4, dl5, dl6, dl7; asm volatile("" : "=v"(dl0), "=v"(dl1), "=v"(dl2), "=v"(dl3), "=v"(dl4), "=v"(dl5), "=v"(dl6), "=v"(dl7));
#endif
    if (IN(0)) { PHASE_PTRS; REP(0) { p0_prologue(pa, lds, tid, lane, wave); __syncthreads(); } }
    SEAM(0);
    if (IN(1) && MS >= 1) { PHASE_PTRS;
        pg8::Gemm g{(const pg8::bf16_t*)(ws + WS_XN), (const pg8::bf16_t*)(ws + WS_WIN), T + TMEM, NIN + NKV, D};
        InProjOrder S; S.so.init(T, NIN, G, (int)blockIdx.x);
        EpiInProj E{(bf16*)(ws + WS_Q), (bf16*)(ws + WS_KVX), (const float*)(ws + WS_ROPE)};
        REP(1) pg8::gemm_phase<EpiInProj, InProjOrder, true, true>(ring, g, S, E);
    }
    SEAM(1);
    if (IN(2) && MS >= 1) { PHASE_PTRS;
        const int n_att = (MS >= 2) ? 3 * 4096 : 0;
        REP(14) attn_phase(pa, lds, n_att, lane, wave);
        REP(15) { int wres = -1; const int per = (2048 + G - 1) / G; __syncthreads(); for (int it = blockIdx.x * per; it < 2048 && it < (int)(blockIdx.x + 1) * per; ++it) mlstm1_item(pa, lds, it, wres, tid, lane, wave); }
    }
    SEAM(2);
    if (IN(3) && MS >= 1) { PHASE_PTRS;
        if (MS < 2) {
            for (size_t id = (size_t)blockIdx.x * NTHR + tid; id < (size_t)T * 64; id += (size_t)G * NTHR) { const size_t t = id >> 6; const int c8 = (int)(id & 63) * 8;
                *(v4u*)((bf16*)(ws + WS_Y) + t * 1024 + c8) = (v4u){0u, 0u, 0u, 0u}; }
        }
        REP(3) p3_scan_combine(pa, tid);
    }
    SEAM(3);
    if (IN(4) && MS >= 1) { PHASE_PTRS; REP(4) { const int per = (2048 + G - 1) / G; for (int it = blockIdx.x * per; it < 2048 && it < (int)(blockIdx.x + 1) * per; ++it) mlstm2_item(pa, lds, it, tid, lane, wave); } }
    SEAM(4);
    if (IN(5)) { PHASE_PTRS;
        if (MS >= 1) {
            pg8::Gemm g{(const pg8::bf16_t*)(ws + WS_Y), (const pg8::bf16_t*)(ws + WS_WOUT), T, D, D};
            pg8::StaticOrder S; S.init(T, D, G, (int)blockIdx.x);
            EpiOutProj E{(const float*)pa.in[0], (bf16*)(ws + WS_X1B), (float*)(ws + WS_SS1)};
            REP(5) pg8::gemm_phase<EpiOutProj, pg8::StaticOrder, true, true>(ring, g, S, E);
        } else {
            const int gw = blockIdx.x * NWAVES + wave, NGW = G * NWAVES;
            for (int m = gw; m < T; m += NGW) { const f32x4* xr = (const f32x4*)((const float*)pa.in[0] + (size_t)m * D) + lane; unsigned long long* o8 = (unsigned long long*)(ws + WS_X1B + (size_t)m * D * 2) + lane;
#pragma unroll
                for (int j = 0; j < 4; ++j) { const f32x4 v = xr[64 * j]; o8[64 * j] = (unsigned long long)pk2(v.x, v.y) | ((unsigned long long)pk2(v.z, v.w) << 32); } }
        }
    }
    SEAM(5);
    if (IN(6) && MS >= 3) { PHASE_PTRS;
        pg8::Gemm g{(const pg8::bf16_t*)(ws + WS_X1B), (const pg8::bf16_t*)(ws + WS_WQX), T, 256, D};
        pg8::StaticOrder S; S.init(T, 256, G, (int)blockIdx.x);
        float* rs = (float*)(lds + LDS_RS);
        { pg8::Unit u0; if (S.next(0, u0) && tid < 256) { const f32x4* sp = (const f32x4*)((const float*)(ws + WS_SS1) + (size_t)(u0.pm * 256 + tid) * 16);
              const f32x4 a = sp[0], b = sp[1], c = sp[2], d = sp[3];
              const float s = ((a[0] + a[1]) + (a[2] + a[3])) + ((b[0] + b[1]) + (b[2] + b[3])) + ((c[0] + c[1]) + (c[2] + c[3])) + ((d[0] + d[1]) + (d[2] + d[3]));
              rs[tid] = 1.0f / sqrtf(s * (1.0f / D) + EPSN); } }
        __syncthreads();
        EpiQx E{(bf16*)(ws + WS_QX), (const LAS float*)rs};
        REP(6) pg8::gemm_phase<EpiQx, pg8::StaticOrder, true, QX_SP2>(ring, g, S, E);
    }
    SEAM(6);
    if (IN(7) && MS >= 3) { PHASE_PTRS; REP(7) for (int it = blockIdx.x; it < (T / 128) * 4; it += G) cross_item(pa, lds, it, tid, lane, wave); }
    SEAM(7);
    if (IN(8) && MS >= 3) { PHASE_PTRS;
        int kdyn = 256; asm volatile("" : "+s"(kdyn));
        pg8::Gemm g{(const pg8::bf16_t*)(ws + WS_OX), (const pg8::bf16_t*)(ws + WS_WOX), T, D, kdyn};
        pg8::StaticOrder S; S.init(T, D, G, (int)blockIdx.x);
        EpiOx E{(const bf16*)(ws + WS_X1B), (bf16*)(ws + WS_HBS)};
        REP(8) pg8::gemm_phase<EpiOx, pg8::StaticOrder, false, true>(ring, g, S, E);
    }
    SEAM(8);
    if (IN(9) && MS >= 4) { PHASE_PTRS; p9_route(pa, lds, tid, lane, wave); }
    SEAM(9);
    if (IN(10) && MS >= 4) { PHASE_PTRS; p10_slots(pa, lds, tid, lane, wave); }
    SEAM(10);
    if ((IN(11) || IN(12)) && MS >= 4) { PHASE_PTRS;
        int* tab = (int*)(lds + LDS_TAB);
        if (tid == 0) { int nrt = 0; const unsigned* cnt = (const unsigned*)(ws + WS_CTL) + CW_CNT;
            for (int i = 0; i < NBUCKET; ++i) { const int nt = (int)((__hip_atomic_load(cnt + i, __ATOMIC_RELAXED, __HIP_MEMORY_SCOPE_AGENT) + 255u) >> 8); for (int k = 0; k < nt; ++k) tab[1 + nrt++] = i; }
            tab[0] = nrt; }
        __syncthreads();
        const int nrt = tab[0];
        if (IN(11)) {
            pg8::Gemm g{(const pg8::bf16_t*)(ws + WS_HBS), (const pg8::bf16_t*)(ws + WS_W13), ROWS_MAX, 64 * 256, D, (const int*)(ws + WS_TOKMAP)};
            MoeOrder S{G, (int)blockIdx.x, nrt * 8, 8, tab + 1};
            EpiUp E{(bf16*)(ws + WS_ACT), (const float*)(ws + WS_WSORT)};
            REP(11) pg8::gemm_phase<EpiUp, MoeOrder, true, true, true>(ring, g, S, E);
        }
        SEAM(11);
        if (IN(12)) {
            pg8::Gemm g{(const pg8::bf16_t*)(ws + WS_ACT), (const pg8::bf16_t*)(ws + WS_W2P), ROWS_MAX, 96 * 256, D};
            MoeOrder S{G, (int)blockIdx.x, nrt * 4, 4, tab + 1};
            EpiDown E{(const bf16*)(ws + WS_HBS), pa.out, (const int*)(ws + WS_TOKMAP)};
            REP(12) pg8::gemm_phase<EpiDown, MoeOrder, true, true>(ring, g, S, E);
        }
    }
    SEAM(12);
    if (IN(13)) { PHASE_PTRS; REP(13) p10_final(pa, (((DUP_MASK >> 13) & 1) && rep_ == 0) ? (float*)(ws + 544 * MiB) : pa.out, lane, wave); }
#ifdef DUMMY_LIVE
    asm volatile("" :: "v"(dl0), "v"(dl1), "v"(dl2), "v"(dl3), "v"(dl4), "v"(dl5), "v"(dl6), "v"(dl7));
#endif
#undef IN
#undef SEAM
}

extern "C" void kernel_launch(void* const* d_in, const int* in_sizes, int n_in, void* d_out, int out_size, void* d_ws, size_t ws_size, hipStream_t stream) {
    static int grid = 0;
    if (grid == 0) {
        if (n_in != 28 || out_size != T * D || ws_size < WS_END) { fprintf(stderr, "kernel_launch: unexpected problem (n_in %d, out %d, ws %zu)\n", n_in, out_size, ws_size); grid = -1; return; }
        int dev = 0, cus = 0, per_cu = 0;
        if (hipGetDevice(&dev) != hipSuccess || hipDeviceGetAttribute(&cus, hipDeviceAttributeMultiprocessorCount, dev) != hipSuccess) { grid = -1; return; }
        if (hipOccupancyMaxActiveBlocksPerMultiprocessor(&per_cu, (const void*)fwd_kernel, NTHR, 0) != hipSuccess || per_cu < 1) { fprintf(stderr, "kernel_launch: occupancy query failed (%d)\n", per_cu); per_cu = 1; }
        (void)hipGetLastError();
        grid = cus * (per_cu > 1 ? 1 : per_cu);
        if (grid > 256) grid = 256;
    }
    if (grid < 0) return;
    (void)hipMemsetAsync((char*)d_ws + WS_CTL, 0, CTL_ZERO_BYTES, stream);
    Args a{};
    for (int i = 0; i < 28; ++i) a.in[i] = d_in[i];
    a.out = (float*)d_out; a.ws = (unsigned char*)d_ws;
    if (N_LAUNCHES == 1) {
        a.ph_lo = 0; a.ph_hi = N_PHASES;
        void* kargs[] = {&a};
        hipError_t e = hipLaunchCooperativeKernel((const void*)fwd_kernel, dim3(grid), dim3(NTHR), kargs, 0, stream);
        if (e != hipSuccess) fprintf(stderr, "kernel_launch: cooperative launch failed: %s (grid %d)\n", hipGetErrorString(e), grid);
    } else {
        for (int p = 0; p < N_PHASES; ++p) { a.ph_lo = p; a.ph_hi = p + 1; hipLaunchKernelGGL(fwd_kernel, dim3(grid), dim3(NTHR), 0, stream, a); }
    }
}
```

```cpp
#include <hip/hip_runtime.h>
#include <cstdio>
#include <cstdint>
namespace pg8 {
#define PG8_LAS __attribute__((address_space(3)))
typedef unsigned short bf16_t;
typedef short bf16x8 __attribute__((ext_vector_type(8)));
typedef float f32x4 __attribute__((ext_vector_type(4)));
typedef unsigned u32x4 __attribute__((ext_vector_type(4)));
constexpr int BM = 256, BK = 64, HALF = 128, HTB = HALF * BK * 2  , STAGE_BYTES = 8 * HTB, NXCD = 8, WGM = 8;

__host__ __device__ __forceinline__ int lds_byte(int r, int c) { const int st = (r >> 4) * 2 + (c >> 5), rr = r & 15, cc = c & 31, ob = rr * 64 + cc * 2; return st * 1024 + (ob ^ (((ob >> 9) & 1) << 5)); }
__host__ __device__ __forceinline__ void stage_rc(int b, int& R, int& C) { const int st = b / 1024, sb = b % 1024, swz = sb ^ (((sb >> 9) & 1) << 5); R = (st >> 1) * 16 + swz / 64; C = (st & 1) * 32 + (swz % 64) / 2; }
__host__ __device__ __forceinline__ int perm32(int rho) { const int n = rho >> 4, i = rho & 15; return 8 * (i >> 2) + 4 * n + (i & 3); }

struct Unit { int pm, pn, aux; };
struct Gemm { const bf16_t* A; const bf16_t* Bt; int M, N, K; const int* rowmap; };

struct StaticOrder {
    int nM, nN, nwg, G, c;
    __host__ __device__ void init(int M, int N, int G_, int c_) { nM = M / BM; nN = N / BM; nwg = nM * nN; G = G_; c = c_; }
    __host__ __device__ bool next(int i, Unit& u) const {
        const long L = (long)i * G + c; if (L >= nwg) return false;
        int wgid = (int)L; { const int q = nwg / NXCD, r = nwg % NXCD, xcd = wgid % NXCD, off = wgid / NXCD; wgid = (xcd < r ? xcd * (q + 1) : r * (q + 1) + (xcd - r) * q) + off; }
        const int nig = WGM * nN, gid = wgid / nig, fm = gid * WGM, gsz = (nM - fm) < WGM ? (nM - fm) : WGM;
        u.pm = fm + ((wgid % nig) % gsz); u.pn = (wgid % nig) / gsz; u.aux = 0; return true;
    }
    __device__ __forceinline__ void a_ready(const Unit&) const {}
    __device__ __forceinline__ void done(const Unit&) const {}
};

__device__ __forceinline__ unsigned cvt_pk_bf16(float lo, float hi) { unsigned r; asm volatile("v_cvt_pk_bf16_f32 %0, %1, %2" : "=v"(r) : "v"(lo), "v"(hi)); return r; }
template <class Epi, class Sched, bool ALIGN_EPI = false, bool SP2 = false, bool GATHER = false>
__device__ __forceinline__ void gemm_phase(PG8_LAS unsigned char* lds, const Gemm g, const Sched& S, const Epi& E) {
    const int tid = threadIdx.x, wid = __builtin_amdgcn_readfirstlane(tid >> 6), lane = tid & 63, wr = wid >> 2, wc = wid & 3, fr = lane & 15, fq = lane >> 4;
    const int K = g.K, nt = K / BK;
    unsigned voffA[2], voffB[2];
#pragma unroll
    for (int i = 0; i < 2; ++i) { int R, C; stage_rc(tid * 16 + i * 8192, R, C); const int Rb = Epi::PERM ? ((R & ~31) + perm32(R & 31)) : R;
        voffA[i] = (unsigned)(R * K + C) * 2u; voffB[i] = (unsigned)(Rb * K + C) * 2u; }
    unsigned gc[2][2] = {{0u, 0u}, {0u, 0u}}, gn[2][2] = {{0u, 0u}, {0u, 0u}};
#define PG8_GLOAD(gv, pm_) do { _Pragma("unroll") for (int _h = 0; _h < 2; ++_h) _Pragma("unroll") for (int _i = 0; _i < 2; ++_i) { int _R, _C; stage_rc(tid * 16 + _i * 8192, _R, _C); \
        int _row = g.rowmap[(pm_) * BM + _h * HALF + _R]; _row = _row < 0 ? 0 : _row; gv[_h][_i] = (unsigned)(_row * K + _C) * 2u; } } while (0)
    const size_t kstep = (size_t)(BK * 2);
    const size_t hstep = (size_t)HALF * K * 2;
    const size_t tstep = 2 * hstep;
    const unsigned ldsw = (unsigned)wid * 1024u;
    const int aoff = lds_byte(wr * 64 + fr, fq * 8), boff = lds_byte(wc * 32 + fr, fq * 8);
#define PG8_SA(b, h) (((b) * 2 + (h)) * HTB)
#define PG8_SB(b, h) ((4 + (b) * 2 + (h)) * HTB)
#define PG8_STAGE(bufoff, gbase, voff) do { _Pragma("unroll") for (int _i = 0; _i < 2; ++_i) \
        __builtin_amdgcn_global_load_lds((const unsigned*)((const char*)(gbase) + (voff)[_i]), (PG8_LAS unsigned*)(lds + (bufoff) + ldsw + _i * 8192), 16, 0, 0); } while (0)
#define PG8_STAGE_A(bufoff, gbase, h, sel) do { if constexpr (GATHER) { unsigned vo_[2]; vo_[0] = (sel) ? gn[h][0] : gc[h][0]; vo_[1] = (sel) ? gn[h][1] : gc[h][1]; PG8_STAGE(bufoff, gbase, vo_); } \
        else { PG8_STAGE(bufoff, (gbase) + (h) * hstep, voffA); } } while (0)
#define PG8_LDA(dst, b, h) do { _Pragma("unroll") for (int m = 0; m < 4; ++m) _Pragma("unroll") for (int k = 0; k < 2; ++k) dst[m][k] = *(const PG8_LAS bf16x8*)(lds + PG8_SA(b, h) + aoff + m * 2048 + k * 1024); } while (0)
#define PG8_LDB(dst, b, h) do { _Pragma("unroll") for (int n = 0; n < 2; ++n) _Pragma("unroll") for (int k = 0; k < 2; ++k) dst[n][k] = *(const PG8_LAS bf16x8*)(lds + PG8_SB(b, h) + boff + n * 2048 + k * 1024); } while (0)
#define PG8_MMA(ai, bj, At, Bt) do { __builtin_amdgcn_s_setprio(1); _Pragma("unroll") for (int m = 0; m < 4; ++m) _Pragma("unroll") for (int n = 0; n < 2; ++n) _Pragma("unroll") for (int k = 0; k < 2; ++k) \
        acc[ai][bj][m][n] = __builtin_amdgcn_mfma_f32_16x16x32_bf16(Bt[n][k], At[m][k], acc[ai][bj][m][n], 0, 0, 0); __builtin_amdgcn_s_setprio(0); } while (0)
#define PG8_WAIT_V(n) asm volatile("s_waitcnt vmcnt(" #n ")" ::: "memory")
#define PG8_WAIT_L(n) asm volatile("s_waitcnt lgkmcnt(" #n ")" ::: "memory")
#define PG8_BAR __builtin_amdgcn_s_barrier()
#define PG8_SCHED __builtin_amdgcn_sched_barrier(0)
    Unit cur, nxt; int ui = 0;
    if (!S.next(0, cur)) return;
    f32x4 acc[2][2][4][2];
#pragma unroll
    for (int a = 0; a < 2; ++a)
#pragma unroll
        for (int b = 0; b < 2; ++b)
#pragma unroll
            for (int m = 0; m < 4; ++m)
#pragma unroll
                for (int n = 0; n < 2; ++n) acc[a][b][m][n] = (f32x4){0.f, 0.f, 0.f, 0.f};
    bf16x8 At[4][2], B0[2][2], B1[2][2];
    const char* cA = GATHER ? (const char*)g.A : (const char*)g.A + (size_t)cur.pm * tstep; const char* cB = (const char*)g.Bt + (size_t)cur.pn * tstep;
    if constexpr (GATHER) { PG8_GLOAD(gc, cur.pm); }
    S.a_ready(cur);
    if constexpr (SP2) {
        PG8_STAGE(PG8_SB(0, 0), cB, voffB); PG8_STAGE(PG8_SB(0, 1), cB + hstep, voffB); PG8_STAGE_A(PG8_SA(0, 0), cA, 0, false); PG8_STAGE_A(PG8_SA(0, 1), cA, 1, false);
        if (wr == 1) PG8_BAR;
        PG8_WAIT_V(2); PG8_BAR;
        PG8_STAGE(PG8_SB(1, 0), cB + kstep, voffB); PG8_STAGE_A(PG8_SA(1, 0), cA + kstep, 0, false); PG8_STAGE(PG8_SB(1, 1), cB + hstep + kstep, voffB);
        PG8_WAIT_V(6); PG8_BAR;
    } else {
        PG8_STAGE(PG8_SB(0, 0), cB, voffB); PG8_STAGE_A(PG8_SA(0, 0), cA, 0, false); PG8_STAGE(PG8_SB(0, 1), cB + hstep, voffB); PG8_STAGE_A(PG8_SA(0, 1), cA, 1, false);
        if (wr == 1) PG8_BAR;
        PG8_WAIT_V(4); PG8_BAR;
        PG8_STAGE(PG8_SB(1, 0), cB + kstep, voffB); PG8_STAGE_A(PG8_SA(1, 0), cA + kstep, 0, false); PG8_STAGE(PG8_SB(1, 1), cB + hstep + kstep, voffB);
        PG8_WAIT_V(6); PG8_BAR;
    }
    for (;;) {
        const bool has_next = S.next(ui + 1, nxt);
        const char* nA = GATHER ? cA : (has_next ? (const char*)g.A + (size_t)nxt.pm * tstep : cA);
        if constexpr (GATHER) { if (has_next) { PG8_GLOAD(gn, nxt.pm); } else { gn[0][0] = gc[0][0]; gn[0][1] = gc[0][1]; gn[1][0] = gc[1][0]; gn[1][1] = gc[1][1]; } }
        const char* nB = has_next ? (const char*)g.Bt + (size_t)nxt.pn * tstep : cB;
        for (int t = 0; t < nt; t += 2) {
            const bool last = (t == nt - 2);
            const char* a1 = cA + (size_t)(t + 1) * kstep;
            const char* a2 = last ? nA : cA + (size_t)(t + 2) * kstep; const char* b2 = last ? nB : cB + (size_t)(t + 2) * kstep;
            const char* a3 = a2 + kstep; const char* b3 = b2 + kstep;
            if (last && has_next) S.a_ready(nxt);
            if constexpr (SP2) {
            PG8_LDB(B0, 0, 0); PG8_LDB(B1, 0, 1); PG8_SCHED; PG8_LDA(At, 0, 0); PG8_STAGE_A(PG8_SA(1, 1), a1, 1, false);
            PG8_WAIT_V(8); PG8_WAIT_L(0); PG8_BAR; PG8_MMA(0, 0, At, B0); PG8_MMA(0, 1, At, B1); PG8_BAR; PG8_SCHED;
            PG8_LDA(At, 0, 1); PG8_STAGE(PG8_SB(0, 0), b2, voffB); PG8_STAGE(PG8_SB(0, 1), b2 + hstep, voffB); PG8_STAGE_A(PG8_SA(0, 0), a2, 0, last);
            PG8_WAIT_V(8); PG8_WAIT_L(0); PG8_BAR; PG8_MMA(1, 0, At, B0); PG8_MMA(1, 1, At, B1); PG8_BAR; PG8_SCHED;
            PG8_LDB(B0, 1, 0); PG8_LDB(B1, 1, 1); PG8_SCHED; PG8_LDA(At, 1, 0); PG8_STAGE_A(PG8_SA(0, 1), a2, 1, last);
            PG8_WAIT_V(8); PG8_WAIT_L(0); PG8_BAR; PG8_MMA(0, 0, At, B0); PG8_MMA(0, 1, At, B1); PG8_BAR; PG8_SCHED;
            PG8_LDA(At, 1, 1); PG8_STAGE(PG8_SB(1, 0), b3, voffB); PG8_STAGE(PG8_SB(1, 1), b3 + hstep, voffB); PG8_STAGE_A(PG8_SA(1, 0), a3, 0, last);
            PG8_WAIT_V(8); PG8_WAIT_L(0); PG8_BAR; PG8_MMA(1, 0, At, B0); PG8_MMA(1, 1, At, B1); PG8_BAR; PG8_SCHED;
            } else {
            PG8_LDB(B0, 0, 0); PG8_SCHED; PG8_LDA(At, 0, 0); PG8_STAGE_A(PG8_SA(1, 1), a1, 1, false);
            PG8_WAIT_L(8); PG8_BAR; PG8_WAIT_L(0); PG8_MMA(0, 0, At, B0); PG8_BAR; PG8_SCHED;
            PG8_LDB(B1, 0, 1); PG8_STAGE(PG8_SB(0, 0), b2, voffB);
            PG8_BAR; PG8_WAIT_L(0); PG8_MMA(0, 1, At, B1); PG8_BAR;
            PG8_LDA(At, 0, 1); PG8_STAGE_A(PG8_SA(0, 0), a2, 0, last);
            PG8_BAR; PG8_WAIT_L(0); PG8_MMA(1, 0, At, B0); PG8_BAR; PG8_SCHED;
            PG8_STAGE(PG8_SB(0, 1), b2 + hstep, voffB);
            PG8_WAIT_V(6); PG8_BAR; PG8_MMA(1, 1, At, B1); PG8_BAR;
            PG8_LDB(B0, 1, 0); PG8_SCHED; PG8_LDA(At, 1, 0); PG8_STAGE_A(PG8_SA(0, 1), a2, 1, last);
            PG8_WAIT_L(8); PG8_BAR; PG8_WAIT_L(0); PG8_MMA(0, 0, At, B0); PG8_BAR; PG8_SCHED;
            PG8_LDB(B1, 1, 1); PG8_STAGE(PG8_SB(1, 0), b3, voffB);
            PG8_BAR; PG8_WAIT_L(0); PG8_MMA(0, 1, At, B1); PG8_BAR;
            PG8_LDA(At, 1, 1); PG8_STAGE_A(PG8_SA(1, 0), a3, 0, last);
            PG8_BAR; PG8_WAIT_L(0); PG8_MMA(1, 0, At, B0); PG8_BAR; PG8_SCHED;
            PG8_STAGE(PG8_SB(1, 1), b3 + hstep, voffB);
            PG8_WAIT_V(6); PG8_BAR; PG8_MMA(1, 1, At, B1); PG8_BAR;
            }
        }
        if constexpr (ALIGN_EPI) { if (wr == 0) PG8_BAR; }
        if constexpr (!Epi::AFTER_DRAIN) { E(acc, cur, wr, wc, fr, fq); S.done(cur); }
        if (!has_next) break;
#pragma unroll
        for (int a = 0; a < 2; ++a)
#pragma unroll
            for (int b = 0; b < 2; ++b)
#pragma unroll
                for (int m = 0; m < 4; ++m)
#pragma unroll
                    for (int n = 0; n < 2; ++n) acc[a][b][m][n] = (f32x4){0.f, 0.f, 0.f, 0.f};
        cur = nxt; cA = nA; cB = nB; ++ui;
        if constexpr (GATHER) { gc[0][0] = gn[0][0]; gc[0][1] = gn[0][1]; gc[1][0] = gn[1][0]; gc[1][1] = gn[1][1]; }
        if constexpr (ALIGN_EPI) { if (wr == 1) PG8_BAR; }
    }
    PG8_WAIT_V(0);
    if constexpr (!ALIGN_EPI) { if (wr == 0) PG8_BAR; }
    PG8_BAR;
    if constexpr (Epi::AFTER_DRAIN) { E.fused(acc, cur, wr, wc, fr, fq, lds, wid, lane); S.done(cur); }
#undef PG8_SA
#undef PG8_SB
#undef PG8_STAGE
#undef PG8_STAGE_A
#undef PG8_GLOAD
#undef PG8_LDA
#undef PG8_LDB
#undef PG8_MMA
#undef PG8_WAIT_V
#undef PG8_WAIT_L
#undef PG8_BAR
#undef PG8_SCHED
}
}

#define GAS __attribute__((address_space(1)))
#define LAS __attribute__((address_space(3)))
typedef unsigned short bf16;
typedef unsigned v4u __attribute__((ext_vector_type(4)));
typedef unsigned v2u __attribute__((ext_vector_type(2)));
typedef float f32x4 __attribute__((ext_vector_type(4)));
typedef short bf16x8 __attribute__((ext_vector_type(8)));
typedef GAS unsigned gu32;

constexpr int NWAVES = 8, NTHR = 512;
constexpr int BATCH = 8, SEQ = 8192, T = BATCH * SEQ, D = 1024, MEMLEN = 256, TMEM = BATCH * MEMLEN;
constexpr int INW = 3080, NIN = 3072, NKV = 512;
constexpr int NBUCKET = 24, ROWS_MAX = T + NBUCKET * 256;
constexpr float EPSN = 1e-6f;
constexpr float C2 = 0.125f * 1.4426950408889634f;
constexpr float LOG2E = 1.4426950408889634f;

constexpr size_t MiB = 1u << 20;
constexpr size_t WS_CTL = 0, CTL_ZERO_BYTES = 1 * MiB;
constexpr size_t WS_ROPE = 2 * MiB;
constexpr size_t WS_IG = 6 * MiB;
constexpr size_t WS_FG = 7 * MiB;
constexpr size_t WS_LSE = 8 * MiB;
constexpr size_t WS_SS1 = 14 * MiB;
constexpr size_t WS_SS3 = 18 * MiB;
constexpr size_t WS_KVX = 22 * MiB;
constexpr size_t WS_NLOC = 24 * MiB;
constexpr size_t WS_NPREV = 25 * MiB;
constexpr size_t WS_MLOC = 26 * MiB;
constexpr size_t WS_BLAST = 26 * MiB + 64 * 1024;
constexpr size_t WS_MPREV = 26 * MiB + 128 * 1024;
constexpr size_t WS_TOKINFO = 27 * MiB;
constexpr size_t WS_TOKMAP = 28 * MiB;
constexpr size_t WS_WSORT = 19 * MiB;
constexpr size_t WS_WR = 30 * MiB;
constexpr size_t WS_WG = 30 * MiB + 512 * 1024;
constexpr size_t WS_PAR = 31 * MiB;
constexpr int PAR_CONVW = 0, PAR_CONVB = 2048, PAR_GMHN = 2560, PAR_SKIP = 3072, PAR_BRG = 3584, PAR_BRE = 3600, PAR_GFIN = 3616, PAR_N = 4640;
constexpr size_t WS_WIN = 32 * MiB;
constexpr size_t WS_WOUT = 39 * MiB;
constexpr size_t WS_WQX = 41 * MiB;
constexpr size_t WS_WOX = 41 * MiB + 512 * 1024;
constexpr size_t WS_WM = 42 * MiB;
constexpr size_t WS_W13 = 44 * MiB;
constexpr size_t WS_W2P = 76 * MiB;
constexpr size_t WS_XN = 128 * MiB;
constexpr size_t WS_CLOC = 128 * MiB;
constexpr size_t WS_Q = 264 * MiB;
constexpr size_t WS_K = 328 * MiB, WS_V = 392 * MiB, WS_MU = 456 * MiB, WS_MV = 520 * MiB, WS_MO = 584 * MiB;
constexpr size_t WS_MQ = 648 * MiB, WS_MK = 712 * MiB;
constexpr size_t WS_Y = 264 * MiB;
constexpr size_t WS_CPREV = 392 * MiB;
constexpr size_t WS_X1B = 648 * MiB;
constexpr size_t WS_QX = 776 * MiB;
constexpr size_t WS_OX = 808 * MiB;
constexpr size_t WS_HBS = 264 * MiB;
constexpr size_t WS_ACT = 404 * MiB;
constexpr size_t WS_END = 840 * MiB;
constexpr size_t DO_OATT = 0, DO_C = 192 * MiB;

constexpr int CW_BAR = 4096;
constexpr int CW_CNT = 8192;
constexpr int CW_FILL = 8192 + 64;

constexpr int LDS_BYTES = 163840;
constexpr int LDS_MISC = 159744;
constexpr int LDS_RS = 135168;
constexpr int LDS_TAB = 136192;

#define LDS_WAIT() asm volatile("s_waitcnt lgkmcnt(0)" ::: "memory")
#define VM_WAIT() asm volatile("s_waitcnt vmcnt(0)" ::: "memory")
__device__ __forceinline__ unsigned f2bf(float f) { unsigned u = __builtin_bit_cast(unsigned, f); return (u + 0x7fffu + ((u >> 16) & 1u)) >> 16; }
__device__ __forceinline__ unsigned pk2(float lo, float hi) { return f2bf(lo) | (f2bf(hi) << 16); }
__device__ __forceinline__ float bf2f(unsigned h) { return __uint_as_float(h << 16); }
__device__ __forceinline__ float bflo(unsigned w) { return __uint_as_float(w << 16); }
__device__ __forceinline__ float bfhi(unsigned w) { return __uint_as_float(w & 0xffff0000u); }
__device__ __forceinline__ float wave_sum(float v) {
#pragma unroll
    for (int o = 1; o < 64; o <<= 1) v += __shfl_xor(v, o);
    return v;
}
__device__ __forceinline__ float wave_max(float v) {
#pragma unroll
    for (int o = 1; o < 64; o <<= 1) v = fmaxf(v, __shfl_xor(v, o));
    return v;
}
__device__ __forceinline__ float sigmoidf_(float x) { return 1.0f / (1.0f + __expf(-x)); }

#define XB_TMO      128
#define XB_XCNT(j)  (256  + 64 * (j))
#define XB_XSUB(j)  (1280 + 64 * (j))
#define XB_XGEN(j)  (2304 + 64 * (j))
#define XB_TOP      3328
#define XB_TOPGEN   3392
#define XCD_BAR_WORDS 3456
#define XB_SPIN_CAP (1u << 22)
__device__ __forceinline__ unsigned xb_ld(unsigned* p)              { return __hip_atomic_load(p, __ATOMIC_RELAXED, __HIP_MEMORY_SCOPE_AGENT); }
__device__ __forceinline__ unsigned xb_add(unsigned* p, unsigned v) { return __hip_atomic_fetch_add(p, v, __ATOMIC_RELAXED, __HIP_MEMORY_SCOPE_AGENT); }
__device__ __forceinline__ unsigned xb_xcc_id() { return (unsigned)__builtin_amdgcn_s_getreg((3 << 11) | 20) & 0xFu; }
#define XB_SPIN(cond, bar) do { unsigned _sp = 0; while (cond) { __builtin_amdgcn_s_sleep(1); \
    if ((++_sp & 255u) == 0u) { if (xb_ld(&(bar)[XB_TMO])) break; if (_sp > XB_SPIN_CAP) { atomicAdd(&(bar)[XB_TMO], 1u); break; } } } } while (0)
struct XcdBarrier { unsigned* bar; unsigned x; volatile LAS unsigned* st; };
__device__ __forceinline__ XcdBarrier xcd_barrier_post(unsigned* bar, volatile LAS unsigned* st) {
    XcdBarrier b; b.bar = bar; b.x = xb_xcc_id(); b.st = st;
    if (threadIdx.x == 0) (void)xb_add(&bar[XB_XCNT(b.x)], 1u);
    return b;
}
__device__ __forceinline__ void xcd_barrier_complete(unsigned* bar, unsigned x, unsigned& nloc, unsigned& nx) {
    const unsigned G = gridDim.x * gridDim.y * gridDim.z;
    unsigned sum, cnt, mine, sp = 0u;
    for (;;) {
        sum = 0u; cnt = 0u; mine = 0u;
#pragma unroll
        for (unsigned j = 0; j < 16; ++j) { const unsigned c = xb_ld(&bar[XB_XCNT(j)]); sum += c; cnt += (c > 0u) ? 1u : 0u; mine = (j == x) ? c : mine; }
        if (sum == G) break;
        __builtin_amdgcn_s_sleep(1);
        if ((++sp & 255u) == 0u) { if (xb_ld(&bar[XB_TMO])) break; if (sp > XB_SPIN_CAP) { atomicAdd(&bar[XB_TMO], 1u); break; } }
    }
    nloc = mine > 0u ? mine : 1u; nx = cnt > 0u ? cnt : 1u;
}
__device__ __forceinline__ void xcd_barrier(const XcdBarrier& b) {
    asm volatile("s_waitcnt vmcnt(0)" ::: "memory");
    __syncthreads();
    if (threadIdx.x == 0) {
        unsigned* bar = b.bar;
        __builtin_amdgcn_s_waitcnt(0);
        unsigned nloc = b.st[0], nx = b.st[1];
        if (nloc == 0u) { xcd_barrier_complete(bar, b.x, nloc, nx); b.st[0] = nloc; b.st[1] = nx; }
        const unsigned old = xb_add(&bar[XB_XSUB(b.x)], 1u);
        const unsigned gen = old / nloc;
        if (old + 1u == (gen + 1u) * nloc) {
            __builtin_amdgcn_fence(__ATOMIC_RELEASE, "agent");
            asm volatile("s_waitcnt vmcnt(0)" ::: "memory");
            const unsigned og = xb_add(&bar[XB_TOP], 1u);
            const unsigned tg = og / nx;
            if (og + 1u == (tg + 1u) * nx) xb_add(&bar[XB_TOPGEN], 1u);
            else XB_SPIN(xb_ld(&bar[XB_TOPGEN]) == tg, bar);
            __builtin_amdgcn_fence(__ATOMIC_ACQUIRE, "agent");
            xb_add(&bar[XB_XGEN(b.x)], 1u);
            asm volatile("s_waitcnt vmcnt(0)" ::: "memory");
        } else {
            XB_SPIN(xb_ld(&bar[XB_XGEN(b.x)]) == gen, bar);
            __builtin_amdgcn_fence(__ATOMIC_ACQUIRE, "agent");
            asm volatile("s_waitcnt vmcnt(0)" ::: "memory");
        }
    }
    __syncthreads();
}

struct Args { const void* in[28]; float* out; unsigned char* ws; int ph_lo, ph_hi; };

template <int MI, int NJ>
__device__ __forceinline__ void wave_mma(const bf16* A, int lda, const bf16* Bt, int ldb, int K, f32x4 (&acc)[MI][NJ], int fr, int fq) {
    for (int k0 = 0; k0 < K; k0 += 32) {
        bf16x8 a[MI], b[NJ];
#pragma unroll
        for (int i = 0; i < MI; ++i) a[i] = *(const bf16x8*)(A + (16 * i + fr) * lda + k0 + 8 * fq);
#pragma unroll
        for (int j = 0; j < NJ; ++j) b[j] = *(const bf16x8*)(Bt + (16 * j + fr) * ldb + k0 + 8 * fq);
#pragma unroll
        for (int i = 0; i < MI; ++i)
#pragma unroll
            for (int j = 0; j < NJ; ++j) acc[i][j] = __builtin_amdgcn_mfma_f32_16x16x32_bf16(b[j], a[i], acc[i][j], 0, 0, 0);
    }
}

__device__ __forceinline__ void transpose_item(const float* src, int src_ld, int k0, int n0, bf16* dst, int dst_ld, int dst_row0, int dst_col0,
                                               const float* gain, float scale, LAS float* scr, int lane) {
    f32x4 ld[16];
#pragma unroll
    for (int i = 0; i < 16; ++i) { const int kk = 4 * i + (lane >> 4); ld[i] = *(const f32x4*)(src + (size_t)(k0 + kk) * src_ld + n0 + 4 * (lane & 15)); }
#pragma unroll
    for (int i = 0; i < 16; ++i) { const int kk = 4 * i + (lane >> 4); *(LAS f32x4*)(scr + kk * 64 + 4 * ((lane & 15) ^ ((kk >> 3) & 15))) = ld[i]; }
    const int c = lane & 7;
    f32x4 g0 = (f32x4){scale, scale, scale, scale}, g1 = g0;
    if (gain) { g0 = *(const f32x4*)(gain + k0 + 8 * c) * scale; g1 = *(const f32x4*)(gain + k0 + 8 * c + 4) * scale; }
    LDS_WAIT(); asm volatile("" ::: "memory");
#pragma unroll
    for (int j = 0; j < 8; ++j) { const int n = (lane >> 3) + 8 * j; const LAS float* s = scr + (8 * c) * 64 + 4 * ((n >> 2) ^ c) + (n & 3);
        v4u o; o.x = pk2(s[0 * 64] * g0[0], s[1 * 64] * g0[1]); o.y = pk2(s[2 * 64] * g0[2], s[3 * 64] * g0[3]); o.z = pk2(s[4 * 64] * g1[0], s[5 * 64] * g1[1]); o.w = pk2(s[6 * 64] * g1[2], s[7 * 64] * g1[3]);
        *(v4u*)(dst + (size_t)(dst_row0 + n) * dst_ld + dst_col0 + 8 * c) = o; }
    LDS_WAIT(); asm volatile("" ::: "memory");
}

__device__ __forceinline__ void p0_prologue(const Args& A, unsigned char* lds, int tid, int lane, int wave) {
    unsigned char* ws = A.ws;
    const float* x = (const float*)A.in[0]; const float* mem = (const float*)A.in[1]; const int* positions = (const int*)A.in[2];
    const float* g_mix = (const float*)A.in[3]; const float* w_in = (const float*)A.in[4];
    const float* w_q_m = (const float*)A.in[7]; const float* w_k_m = (const float*)A.in[8];
    const float* b_i = (const float*)A.in[9]; const float* b_f = (const float*)A.in[10];
    const float* w_out = (const float*)A.in[13]; const float* g_cross = (const float*)A.in[14]; const float* g_mem = (const float*)A.in[15];
    const float* w_q_x = (const float*)A.in[16]; const float* w_kv_x = (const float*)A.in[17]; const float* w_o_x = (const float*)A.in[18];
    const float* g_ffn = (const float*)A.in[19]; const float* w_rg = (const float*)A.in[20]; const float* w_re = (const float*)A.in[22];
    const float* w1 = (const float*)A.in[24]; const float* w3 = (const float*)A.in[25]; const float* w2 = (const float*)A.in[26];
    const int G = gridDim.x, gw = blockIdx.x * NWAVES + wave, NGW = G * NWAVES, gt = blockIdx.x * NTHR + tid, NGT = G * NTHR;

    LAS float* WGl = (LAS float*)lds;
    for (int i = tid; i < 8 * 1024; i += NTHR) { const int k = i >> 3, j = i & 7; WGl[j * 1024 + k] = g_mix[k] * w_in[(size_t)k * INW + NIN + j]; }

    for (int i = gt; i < PAR_N; i += NGT) { float v;
        if (i < PAR_CONVB) v = ((const float*)A.in[5])[i]; else if (i < PAR_GMHN) v = ((const float*)A.in[6])[i - PAR_CONVB]; else if (i < PAR_SKIP) v = ((const float*)A.in[11])[i - PAR_GMHN];
        else if (i < PAR_BRG) v = ((const float*)A.in[12])[i - PAR_SKIP]; else if (i < PAR_BRE) v = ((const float*)A.in[21])[i - PAR_BRG]; else if (i < PAR_GFIN) v = ((const float*)A.in[23])[i - PAR_BRE];
        else v = ((const float*)A.in[27])[i - PAR_GFIN];
        ((float*)(ws + WS_PAR))[i] = v; }
    for (int i = gt; i < 20 * 1024; i += NGT) { const int e = i >> 10, k = i & 1023;
        ((float*)(ws + WS_WR))[i] = g_ffn[k] * (e < 4 ? w_rg[k * 4 + e] : w_re[k * 16 + (e - 4)]); }
    for (int i = gt; i < T * 8; i += NGT) { const int t = i >> 3, j = i & 7; const float invf = powf(500000.0f, -(float)j * 0.125f);
        const float ang = (float)positions[t] * invf; float sn, cs; sincosf(ang, &sn, &cs);
        ((float*)(ws + WS_ROPE))[t * 16 + j] = cs; ((float*)(ws + WS_ROPE))[t * 16 + 8 + j] = sn; }
    __syncthreads();
    for (int m0 = 2 * gw; m0 < T + TMEM; m0 += 2 * NGW) {
        f32x4 v[2][4]; float rstd[2];
#pragma unroll
        for (int q = 0; q < 2; ++q) { const int m = m0 + q; const f32x4* xr = (const f32x4*)(m >= T ? mem + (size_t)(m - T) * D : x + (size_t)m * D) + lane;
#pragma unroll
            for (int j = 0; j < 4; ++j) v[q][j] = xr[64 * j]; }
#pragma unroll
        for (int q = 0; q < 2; ++q) { float s = 0.f;
#pragma unroll
            for (int j = 0; j < 4; ++j) s += (v[q][j].x * v[q][j].x + v[q][j].y * v[q][j].y) + (v[q][j].z * v[q][j].z + v[q][j].w * v[q][j].w);
            rstd[q] = 1.0f / sqrtf(wave_sum(s) * (1.0f / D) + EPSN);
            unsigned long long* o8 = (unsigned long long*)(ws + WS_XN + (size_t)(m0 + q) * D * 2) + lane;
#pragma unroll
            for (int j = 0; j < 4; ++j) o8[64 * j] = (unsigned long long)pk2(v[q][j].x * rstd[q], v[q][j].y * rstd[q]) | ((unsigned long long)pk2(v[q][j].z * rstd[q], v[q][j].w * rstd[q]) << 32); }
        if (m0 < T) {
            float val0 = 0.f, val1 = 0.f;
#pragma unroll
            for (int g = 0; g < 8; ++g) { float a0 = 0.f, a1 = 0.f;
#pragma unroll
                for (int j = 0; j < 4; ++j) { const f32x4 w = *(const LAS f32x4*)(WGl + g * 1024 + 256 * j + 4 * lane);
                    a0 += (v[0][j].x * w.x + v[0][j].y * w.y) + (v[0][j].z * w.z + v[0][j].w * w.w); a1 += (v[1][j].x * w.x + v[1][j].y * w.y) + (v[1][j].z * w.z + v[1][j].w * w.w); }
                a0 = wave_sum(a0) * rstd[0]; a1 = wave_sum(a1) * rstd[1];
                val0 = (lane == g) ? a0 : val0; val1 = (lane == g) ? a1 : val1; }
            if (lane < 8) { const int h = lane & 3;
#pragma unroll
                for (int q = 0; q < 2; ++q) { const int m = m0 + q, b = m / SEQ, sq = m % SEQ; const float val = q ? val1 : val0;
                    if (lane < 4) ((float*)(ws + WS_IG))[(size_t)(b * 4 + h) * SEQ + sq] = val + b_i[h];
                    else ((float*)(ws + WS_FG))[(size_t)(b * 4 + h) * SEQ + sq] = val + b_f[h]; } }
        }
    }
    __syncthreads();
    LAS float* scr = (LAS float*)(lds + wave * 16384);
    constexpr int I_IN = 16 * 48, I_KV = 16 * 8, I_OUT = 16 * 16, I_QX = 16 * 4, I_OX = 4 * 16, I_M = 32, I_13 = 16 * 2 * 128, I_2P = 24 * 2 * 128;
    constexpr int NITEMS = I_IN + I_KV + I_OUT + I_QX + I_OX + I_M + I_13 + I_2P;
    for (int it = gw; it < NITEMS; it += NGW) {
        int r = it;
        if (r < I_IN) { const int kb = r / 48, nb = r % 48; transpose_item(w_in, INW, 64 * kb, 64 * nb, (bf16*)(ws + WS_WIN), 1024, 64 * nb, 64 * kb, g_mix, (64 * nb < 512) ? C2 : 1.0f, scr, lane); continue; } r -= I_IN;
        if (r < I_KV) { const int kb = r / 8, nb = r % 8; transpose_item(w_kv_x, 512, 64 * kb, 64 * nb, (bf16*)(ws + WS_WIN), 1024, NIN + 64 * nb, 64 * kb, g_mem, 1.0f, scr, lane); continue; } r -= I_KV;
        if (r < I_OUT) { const int kb = r / 16, nb = r % 16; transpose_item(w_out, 1024, 64 * kb, 64 * nb, (bf16*)(ws + WS_WOUT), 1024, 64 * nb, 64 * kb, nullptr, 1.0f, scr, lane); continue; } r -= I_OUT;
        if (r < I_QX) { const int kb = r / 4, nb = r % 4; transpose_item(w_q_x, 256, 64 * kb, 64 * nb, (bf16*)(ws + WS_WQX), 1024, 64 * nb, 64 * kb, g_cross, C2, scr, lane); continue; } r -= I_QX;
        if (r < I_OX) { const int kb = r / 16, nb = r % 16; transpose_item(w_o_x, 1024, 64 * kb, 64 * nb, (bf16*)(ws + WS_WOX), 256, 64 * nb, 64 * kb, nullptr, 1.0f, scr, lane); continue; } r -= I_OX;
        if (r < I_M) { const int which = r / 16, h = (r % 16) / 4, kb = (r % 4) / 2, nb = r % 2;
            transpose_item((which ? w_k_m : w_q_m) + (size_t)h * 128 * 128, 128, 64 * kb, 64 * nb, (bf16*)(ws + WS_WM) + (size_t)(which * 4 + h) * 128 * 128, 128, 64 * nb, 64 * kb, nullptr,
                           which ? 0.08838834764831845f : 1.0f, scr, lane); continue; } r -= I_M;
        if (r < I_13) { const int e = r / 256, which = (r % 256) / 128, kb = (r % 128) / 8, nb = r % 8; const int n0 = 64 * nb;
            transpose_item((which ? w3 : w1) + (size_t)e * 1024 * 512, 512, 64 * kb, n0, (bf16*)(ws + WS_W13) + (size_t)e * 1024 * 1024, 1024, (n0 / 128) * 256 + which * 128 + (n0 % 128), 64 * kb, g_ffn, 1.0f, scr, lane); continue; } r -= I_13;
        { const int bk = r / 256, hf = (r % 256) / 128, kb = (r % 128) / 16, nb = r % 16; const int g = bk / 6, p = bk % 6;
          const int pa = (p < 3) ? 0 : (p < 5 ? 1 : 2), pb = (p < 3) ? p + 1 : (p < 5 ? p - 1 : 3); const int e = 4 * g + (hf ? pb : pa);
          transpose_item(w2 + (size_t)e * 512 * 1024, 1024, 64 * kb, 64 * nb, (bf16*)(ws + WS_W2P) + (size_t)bk * 1024 * 1024, 1024, 64 * nb, hf * 512 + 64 * kb, nullptr, 1.0f, scr, lane); }
    }
}

struct InProjOrder {
    pg8::StaticOrder so;
    __device__ __forceinline__ bool next(int i, pg8::Unit& u) const {
        if (so.next(i, u)) return true;
        const long L = (long)i * so.G + so.c - so.nwg;
        if (L >= 0 && L < 16) { u.pm = 256 + (int)(L >> 1); u.pn = 12 + (int)(L & 1); u.aux = 1; return true; }
        return false;
    }
    __device__ __forceinline__ void a_ready(const pg8::Unit&) const {}
    __device__ __forceinline__ void done(const pg8::Unit&) const {}
};
__device__ __forceinline__ v4u pack8(const f32x4& a, const f32x4& b) { v4u w; w.x = pk2(a[0], a[1]); w.y = pk2(a[2], a[3]); w.z = pk2(b[0], b[1]); w.w = pk2(b[2], b[3]); return w; }
struct EpiInProj {
    static constexpr bool PERM = true, AFTER_DRAIN = false;
    bf16* base; bf16* kvx; const float* rope;
    __device__ __forceinline__ void operator()(const f32x4 (&acc)[2][2][4][2], const pg8::Unit& u, int wr, int wc, int fr, int fq) const {
        if (u.aux) {
            const int row0 = (u.pm - 256) * 256 + wr * 64 + fr, col0 = (u.pn - 12) * 256 + wc * 32 + 8 * fq;
#pragma unroll
            for (int ai = 0; ai < 2; ++ai)
#pragma unroll
                for (int m = 0; m < 4; ++m) { bf16* rowp = kvx + (size_t)(row0 + ai * 128 + m * 16) * NKV + col0;
#pragma unroll
                    for (int bj = 0; bj < 2; ++bj) *(v4u*)(rowp + bj * 128) = pack8(acc[ai][bj][m][0], acc[ai][bj][m][1]); }
            return;
        }
        const int buf = u.pn >> 1; bf16* B = base + (size_t)buf * T * 512;
        const int row0 = u.pm * 256 + wr * 64 + fr, col0 = (u.pn & 1) * 256 + wc * 32 + 8 * fq;
        const bool dorope = (buf < 2) && ((wc & 1) == 0);
#pragma unroll
        for (int ai = 0; ai < 2; ++ai)
#pragma unroll
            for (int m = 0; m < 4; ++m) { const int row = row0 + ai * 128 + m * 16; bf16* rowp = B + (size_t)row * 512 + col0;
                f32x4 cs0, cs1, sn0, sn1;
                if (dorope) { const f32x4* rp = (const f32x4*)(rope + (size_t)row * 16); cs0 = rp[0]; cs1 = rp[1]; sn0 = rp[2]; sn1 = rp[3]; }
#pragma unroll
                for (int bj = 0; bj < 2; ++bj) { f32x4 v0 = acc[ai][bj][m][0], v1 = acc[ai][bj][m][1];
                    if (dorope) { f32x4 o0, o1;
#pragma unroll
                        for (int i = 0; i < 4; ++i) { o0[i] = __shfl_xor(v0[i], 16); o1[i] = __shfl_xor(v1[i], 16); }
                        if (fq == 0) { v0 = v0 * cs0 - o0 * sn0; v1 = v1 * cs1 - o1 * sn1; }
                        else if (fq == 1) { v0 = v0 * cs0 + o0 * sn0; v1 = v1 * cs1 + o1 * sn1; } }
                    *(v4u*)(rowp + bj * 128) = pack8(v0, v1); } }
    }
};

typedef short v4i16_t __attribute__((ext_vector_type(4)));
struct AttItem { int cfg, b, h, d, nb; size_t tokb; };
__device__ __forceinline__ AttItem attn_decode(int item) {
    AttItem a; a.cfg = item >> 12; int rem = item & 4095; a.b = rem >> 9; rem &= 511; a.h = rem >> 6; const int sub = rem & 63;
    a.d = (a.cfg == 0) ? 1 : (a.cfg == 1 ? 4 : 16); const int nblk = 64 / a.d, r = sub / nblk; a.nb = sub % nblk; a.tokb = (size_t)a.b * SEQ + r; return a;
}
__device__ __forceinline__ int attn_item_of(int k, int G) {
    if (G != 256) return (int)blockIdx.x + k * G;
    const int pair = (int)(blockIdx.x & 7) + 8 * (k / 6), j = (int)(blockIdx.x >> 3), ip = j * 6 + (k % 6);
    return ((ip >> 6) << 12) | (pair << 6) | (ip & 63);
}
__device__ __forceinline__ void attn_prefetch(const Args& A, LAS unsigned char* buf, int item, int lane, int wave, bf16x8 (&qf)[2]) {
    const AttItem a = attn_decode(item);
    const bf16* Kg = (const bf16*)(A.ws + WS_K) + a.h * 64; const bf16* Vg = (const bf16*)(A.ws + WS_V) + a.h * 64; const bf16* Qg = (const bf16*)(A.ws + WS_Q) + a.h * 64;
#pragma unroll
    for (int i = 0; i < 4; ++i) { const int inst = wave + 8 * i, row = 8 * inst + (lane >> 3); int u = 128 * (a.nb - 1) + row; u = (u < 0) ? row : u;
        const size_t off = (a.tokb + (size_t)u * a.d) * 512 + ((lane & 7) ^ (lane >> 3)) * 8;
        __builtin_amdgcn_global_load_lds((const unsigned*)(Kg + off), (LAS unsigned*)(buf + inst * 1024), 16, 0, 0);
        __builtin_amdgcn_global_load_lds((const unsigned*)(Vg + off), (LAS unsigned*)(buf + 32768 + inst * 1024), 16, 0, 0); }
    const size_t tq = a.tokb + (size_t)(128 * a.nb + 16 * wave + (lane & 15)) * a.d;
    qf[0] = *(const bf16x8*)(Qg + tq * 512 + 8 * (lane >> 4)); qf[1] = *(const bf16x8*)(Qg + tq * 512 + 32 + 8 * (lane >> 4));
}
__device__ __forceinline__ void attn_compute(const Args& A, LAS unsigned char* buf, int item, int lane, int wave, const bf16x8 (&qf)[2]) {
    const AttItem a = attn_decode(item);
    const int fr = lane & 15, g = lane >> 4, qi = 16 * wave + fr;
    f32x4 s[10];
#pragma unroll
    for (int tt = 0; tt < 10; ++tt) { const int t = (wave + tt < 16) ? wave + tt : 15, key = 16 * t + fr; s[tt] = (f32x4){0.f, 0.f, 0.f, 0.f};
#pragma unroll
        for (int ks = 0; ks < 2; ++ks) { const bf16x8 kf = *(const LAS bf16x8*)(buf + key * 128 + (((4 * ks + g) ^ (key & 7)) * 16));
            s[tt] = __builtin_amdgcn_mfma_f32_16x16x32_bf16(kf, qf[ks], s[tt], 0, 0, 0); } }
    float mx = -1e30f;
#pragma unroll
    for (int tt = 0; tt < 10; ++tt)
#pragma unroll
        for (int e = 0; e < 4; ++e) { const int kk = 16 * (wave + tt) + 4 * g + e;
            const bool ok = (kk >= qi) && (kk <= qi + 128) && (a.nb > 0 || kk >= 128);
            s[tt][e] = ok ? s[tt][e] : -1e30f; mx = fmaxf(mx, s[tt][e]); }
    mx = fmaxf(mx, __shfl_xor(mx, 16)); mx = fmaxf(mx, __shfl_xor(mx, 32));
    float l = 0.f;
#pragma unroll
    for (int tt = 0; tt < 10; ++tt)
#pragma unroll
        for (int e = 0; e < 4; ++e) { s[tt][e] = __builtin_amdgcn_exp2f(s[tt][e] - mx); l += s[tt][e]; }
    l += __shfl_xor(l, 16); l += __shfl_xor(l, 32);
    f32x4 o[4];
#pragma unroll
    for (int dt = 0; dt < 4; ++dt) o[dt] = (f32x4){0.f, 0.f, 0.f, 0.f};
#pragma unroll
    for (int k5 = 0; k5 < 5; ++k5) {
        const v4u pw = (v4u){pk2(s[2 * k5][0], s[2 * k5][1]), pk2(s[2 * k5][2], s[2 * k5][3]), pk2(s[2 * k5 + 1][0], s[2 * k5 + 1][1]), pk2(s[2 * k5 + 1][2], s[2 * k5 + 1][3])};
        const bf16x8 pf = __builtin_bit_cast(bf16x8, pw);
        const int t0 = (wave + 2 * k5 < 16) ? wave + 2 * k5 : 15, t1 = (wave + 2 * k5 + 1 < 16) ? wave + 2 * k5 + 1 : 15;
        const int r0 = 16 * t0 + 4 * g + (fr >> 2), r1 = 16 * t1 + 4 * g + (fr >> 2), p_ = fr & 3;
#pragma unroll
        for (int dt = 0; dt < 4; ++dt) { const int chunk = 2 * dt + (p_ >> 1);
            const v4i16_t v0 = __builtin_amdgcn_ds_read_tr16_b64_v4i16((LAS v4i16_t*)(buf + 32768 + r0 * 128 + ((chunk ^ (r0 & 7)) * 16) + 8 * (p_ & 1)));
            const v4i16_t v1 = __builtin_amdgcn_ds_read_tr16_b64_v4i16((LAS v4i16_t*)(buf + 32768 + r1 * 128 + ((chunk ^ (r1 & 7)) * 16) + 8 * (p_ & 1)));
            const bf16x8 vf = (bf16x8){v0[0], v0[1], v0[2], v0[3], v1[0], v1[1], v1[2], v1[3]};
            o[dt] = __builtin_amdgcn_mfma_f32_16x16x32_bf16(vf, pf, o[dt], 0, 0, 0); } }
    const float rl = 1.0f / l;
    const size_t tok = a.tokb + (size_t)(128 * a.nb + qi) * a.d;
    bf16* og = (bf16*)((unsigned char*)A.out + DO_OATT) + ((size_t)a.cfg * T + tok) * 512 + a.h * 64;
#pragma unroll
    for (int dt = 0; dt < 4; ++dt) *(v2u*)(og + 16 * dt + 4 * g) = (v2u){pk2(o[dt][0] * rl, o[dt][1] * rl), pk2(o[dt][2] * rl, o[dt][3] * rl)};
    if (g == 0) ((float*)(A.ws + WS_LSE))[((size_t)a.cfg * T + tok) * 8 + a.h] = mx + __builtin_amdgcn_logf(l);
}
__device__ __forceinline__ void attn_phase(const Args& A, unsigned char* lds, int n_total, int lane, int wave) {
    const int G = gridDim.x; LAS unsigned char* L = (LAS unsigned char*)lds;
    const int nk = (G == 256) ? n_total / 256 : (n_total - (int)blockIdx.x + G - 1) / G;
    if (nk <= 0) return;
    bf16x8 qa[2], qb[2];
    attn_prefetch(A, L, attn_item_of(0, G), lane, wave, qa);
    int cur = 0;
    for (int k = 0; k < nk; ++k) {
        asm volatile("s_waitcnt vmcnt(0)" ::: "memory");
        __syncthreads();
        qb[0] = qa[0]; qb[1] = qa[1];
        if (k + 1 < nk) attn_prefetch(A, L + (cur ^ 1) * 65536, attn_item_of(k + 1, G), lane, wave, qb);
        attn_compute(A, L + cur * 65536, attn_item_of(k, G), lane, wave, qa);
        qa[0] = qb[0]; qa[1] = qb[1]; cur ^= 1;
    }
    asm volatile("s_waitcnt vmcnt(0)" ::: "memory");
    __syncthreads();
}

constexpr int ML_TILE = 32768;
constexpr int ML_G = 4 * ML_TILE;
static_assert(ML_G + 8192 <= LDS_MISC, "mlstm LDS");
__device__ __forceinline__ int sw_off(int row, int ch) { return 256 * row + 16 * (ch ^ (((row & 3) << 2) | ((row >> 2) & 3))); }
__device__ __forceinline__ bf16x8 rowfrag(LAS unsigned char* tile, int row0, int ks, int fr, int g) { return *(const LAS bf16x8*)(tile + sw_off(row0 + fr, 4 * ks + g)); }
__device__ __forceinline__ bf16x8 colfrag(LAS unsigned char* tile, int ks, int ct, int fr, int g) {
    const int r0 = 32 * ks + 8 * g + (fr >> 2), p = fr & 3, ch = 2 * ct + (p >> 1);
    const v4i16_t a = __builtin_amdgcn_ds_read_tr16_b64_v4i16((LAS v4i16_t*)(tile + sw_off(r0, ch) + 8 * (p & 1)));
    const v4i16_t b = __builtin_amdgcn_ds_read_tr16_b64_v4i16((LAS v4i16_t*)(tile + sw_off(r0 + 4, ch) + 8 * (p & 1)));
    return (bf16x8){a[0], a[1], a[2], a[3], b[0], b[1], b[2], b[3]};
}
__device__ __forceinline__ float log_sigmoidf_(float x) { return (x > 0.f) ? -log1pf(__expf(-x)) : (x - log1pf(__expf(x))); }
__device__ __forceinline__ float wscan_sum(float v0, float v1, float& o0, float& o1, int lane) {
    float x = v0 + v1;
#pragma unroll
    for (int off = 1; off < 64; off <<= 1) { const float t = __shfl_up(x, off); if (lane >= off) x += t; }
    o0 = x - v1; o1 = x; return __shfl(x, 63);
}
__device__ __forceinline__ void wscan_max(float v0, float v1, float& o0, float& o1, int lane) {
    float y = fmaxf(v0, v1);
#pragma unroll
    for (int off = 1; off < 64; off <<= 1) { const float t = __shfl_up(y, off); if (lane >= off) y = fmaxf(y, t); }
    float pre = __shfl_up(y, 1); if (lane == 0) pre = -INFINITY;
    o0 = fmaxf(pre, v0); o1 = fmaxf(pre, fmaxf(v0, v1));
}
__device__ __forceinline__ void tile_load(LAS unsigned char* tile, const bf16* src, size_t pitch, int tid) {
    v4u v[4];
#pragma unroll
    for (int i = 0; i < 4; ++i) { const int id = tid + NTHR * i, row = id >> 4, ch = id & 15; v[i] = *(const v4u*)(src + (size_t)row * pitch + ch * 8); }
#pragma unroll
    for (int i = 0; i < 4; ++i) { const int id = tid + NTHR * i, row = id >> 4, ch = id & 15; *(LAS v4u*)(tile + sw_off(row, ch)) = v[i]; }
}

__device__ __forceinline__ void mlstm1_item(const Args& A, unsigned char* lds_, int item, int& wres, int tid, int lane, int wave) {
    unsigned char* ws = A.ws; LAS unsigned char* lds = (LAS unsigned char*)lds_;
    const float* conv_w = (const float*)(ws + WS_PAR) + PAR_CONVW; const float* conv_b = (const float*)(ws + WS_PAR) + PAR_CONVB;
    const int bh = item >> 6, c = item & 63, b = bh >> 2, h = bh & 3;
    const size_t t0 = (size_t)b * SEQ + 128 * c;
    LAS unsigned char* cA = lds; LAS unsigned char* Wq = lds + ML_TILE; LAS unsigned char* Wk = lds + 2 * ML_TILE; LAS unsigned char* Vt = lds + 3 * ML_TILE;
    LAS float* gl = (LAS float*)(lds + ML_G);
    const bf16* MU = (const bf16*)(ws + WS_MU) + h * 128; const bf16* MV = (const bf16*)(ws + WS_MV) + h * 128;
    bf16* Cg = (bf16*)((unsigned char*)A.out + DO_C) + h * 128;
    const int fr = lane & 15, g = lane >> 4, m0 = 16 * wave;
    if (wres != h) { const bf16* Wg = (const bf16*)(ws + WS_WM) + (size_t)h * 128 * 128; tile_load(Wq, Wg, 128, tid); tile_load(Wk, Wg + 4 * 128 * 128, 128, tid); wres = h; }
    tile_load(Vt, MV + t0 * 512, 512, tid);
    { const int ch = (tid & 15) * 8;
      float w[4][8], bs[8];
#pragma unroll
      for (int j = 0; j < 4; ++j) { const f32x4 w0 = *(const f32x4*)(conv_w + j * 512 + h * 128 + ch), w1 = *(const f32x4*)(conv_w + j * 512 + h * 128 + ch + 4);
          w[j][0] = w0[0]; w[j][1] = w0[1]; w[j][2] = w0[2]; w[j][3] = w0[3]; w[j][4] = w1[0]; w[j][5] = w1[1]; w[j][6] = w1[2]; w[j][7] = w1[3]; }
      { const f32x4 b0 = *(const f32x4*)(conv_b + h * 128 + ch), b1 = *(const f32x4*)(conv_b + h * 128 + ch + 4);
        bs[0] = b0[0]; bs[1] = b0[1]; bs[2] = b0[2]; bs[3] = b0[3]; bs[4] = b1[0]; bs[5] = b1[1]; bs[6] = b1[2]; bs[7] = b1[3]; }
#pragma unroll
      for (int i = 0; i < 4; ++i) { const int l = (tid >> 4) + 32 * i;
          float a[8];
#pragma unroll
          for (int q = 0; q < 8; ++q) a[q] = bs[q];
#pragma unroll
          for (int j = 0; j < 4; ++j) { const int sp = 128 * c + l + j - 3;
              if (sp >= 0) { const v4u m = *(const v4u*)(MU + ((size_t)b * SEQ + sp) * 512 + ch);
                  a[0] += bflo(m.x) * w[j][0]; a[1] += bfhi(m.x) * w[j][1]; a[2] += bflo(m.y) * w[j][2]; a[3] += bfhi(m.y) * w[j][3];
                  a[4] += bflo(m.z) * w[j][4]; a[5] += bfhi(m.z) * w[j][5]; a[6] += bflo(m.w) * w[j][6]; a[7] += bfhi(m.w) * w[j][7]; } }
#pragma unroll
          for (int q = 0; q < 8; ++q) a[q] = a[q] * sigmoidf_(a[q]);
          const v4u o = (v4u){pk2(a[0], a[1]), pk2(a[2], a[3]), pk2(a[4], a[5]), pk2(a[6], a[7])};
          *(LAS v4u*)(cA + sw_off(l, tid & 15)) = o; *(v4u*)(Cg + (t0 + l) * 512 + ch) = o; } }
    { const size_t gi = (size_t)bh * SEQ + 128 * c + 2 * lane;
      const float i0 = ((const float*)(ws + WS_IG))[gi], i1 = ((const float*)(ws + WS_IG))[gi + 1];
      const float f0 = log_sigmoidf_(((const float*)(ws + WS_FG))[gi]), f1 = log_sigmoidf_(((const float*)(ws + WS_FG))[gi + 1]);
      float b0, b1; const float blast = wscan_sum(f0, f1, b0, b1, lane);
      const float g0 = blast - b0 + i0, g1 = blast - b1 + i1, mloc = wave_max(fmaxf(g0, g1));
      gl[2 * lane] = __expf(g0 - mloc); gl[2 * lane + 1] = __expf(g1 - mloc);
      if (wave == 0 && lane == 0) { ((float*)(ws + WS_MLOC))[item] = mloc; ((float*)(ws + WS_BLAST))[item] = blast; } }
    __syncthreads();
    { bf16x8 af[4];
#pragma unroll
      for (int ks = 0; ks < 4; ++ks) af[ks] = rowfrag(cA, m0, ks, fr, g);
      f32x4 acc[8];
#pragma unroll
      for (int j = 0; j < 8; ++j) { acc[j] = (f32x4){0.f, 0.f, 0.f, 0.f};
#pragma unroll
          for (int ks = 0; ks < 4; ++ks) acc[j] = __builtin_amdgcn_mfma_f32_16x16x32_bf16(rowfrag(Wq, 16 * j, ks, fr, g), af[ks], acc[j], 0, 0, 0); }
      bf16* qg = (bf16*)(ws + WS_MQ) + (t0 + m0 + fr) * 512 + h * 128;
#pragma unroll
      for (int j = 0; j < 8; ++j) *(v2u*)(qg + 16 * j + 4 * g) = (v2u){pk2(acc[j][0], acc[j][1]), pk2(acc[j][2], acc[j][3])};
#pragma unroll
      for (int j = 0; j < 8; ++j) { acc[j] = (f32x4){0.f, 0.f, 0.f, 0.f};
#pragma unroll
          for (int ks = 0; ks < 4; ++ks) acc[j] = __builtin_amdgcn_mfma_f32_16x16x32_bf16(rowfrag(Wk, 16 * j, ks, fr, g), af[ks], acc[j], 0, 0, 0); }
      bf16* kg = (bf16*)(ws + WS_MK) + (t0 + m0 + fr) * 512 + h * 128; const float wk = gl[m0 + fr];
#pragma unroll
      for (int j = 0; j < 8; ++j) { *(v2u*)(kg + 16 * j + 4 * g) = (v2u){pk2(acc[j][0], acc[j][1]), pk2(acc[j][2], acc[j][3])};
          *(LAS v2u*)(cA + sw_off(m0 + fr, 2 * j + (g >> 1)) + 8 * (g & 1)) = (v2u){pk2(acc[j][0] * wk, acc[j][1] * wk), pk2(acc[j][2] * wk, acc[j][3] * wk)}; } }
    __syncthreads();
    { f32x4 acc[8], accn = (f32x4){0.f, 0.f, 0.f, 0.f};
#pragma unroll
      for (int j = 0; j < 8; ++j) acc[j] = (f32x4){0.f, 0.f, 0.f, 0.f};
      const bf16x8 ones = (bf16x8){0x3f80, 0x3f80, 0x3f80, 0x3f80, 0x3f80, 0x3f80, 0x3f80, 0x3f80};
#pragma unroll
      for (int ks = 0; ks < 4; ++ks) { const bf16x8 vf = colfrag(Vt, ks, wave, fr, g);
#pragma unroll
          for (int j = 0; j < 8; ++j) { const bf16x8 kf = colfrag(cA, ks, j, fr, g); acc[j] = __builtin_amdgcn_mfma_f32_16x16x32_bf16(kf, vf, acc[j], 0, 0, 0);
              if (j == wave) accn = __builtin_amdgcn_mfma_f32_16x16x32_bf16(kf, ones, accn, 0, 0, 0); } }
      bf16* cg = (bf16*)(ws + WS_CLOC) + ((size_t)item * 128 + m0 + fr) * 128;
#pragma unroll
      for (int j = 0; j < 8; ++j) *(v2u*)(cg + 16 * j + 4 * g) = (v2u){pk2(acc[j][0], acc[j][1]), pk2(acc[j][2], acc[j][3])};
      if (fr == 0) *(f32x4*)((float*)(ws + WS_NLOC) + (size_t)item * 128 + 16 * wave + 4 * g) = accn; }
    __syncthreads();
}

__device__ __forceinline__ void p3_scan_combine(const Args& A, int tid) {
    unsigned char* ws = A.ws;
    const int G = gridDim.x, NGT = G * NTHR;
    for (int gid = blockIdx.x * NTHR + tid; gid < 32 * 4096; gid += NGT) {
        const int bh = gid >> 12, rem = gid & 4095, e = rem >> 5, dq = rem & 31;
        const float* MLOC = (const float*)(ws + WS_MLOC) + bh * 64; const float* BL = (const float*)(ws + WS_BLAST) + bh * 64;
        f32x4 C = (f32x4){0.f, 0.f, 0.f, 0.f}, n = (f32x4){0.f, 0.f, 0.f, 0.f}; float m = 0.f;
        for (int c = 0; c < 64; ++c) {
            const size_t idx = (size_t)bh * 64 + c;
            const v2u cw = *(const v2u*)((const bf16*)(ws + WS_CLOC) + (idx * 128 + e) * 128 + 4 * dq); const f32x4 Cl = (f32x4){bflo(cw.x), bfhi(cw.x), bflo(cw.y), bfhi(cw.y)};
            *(v2u*)((bf16*)(ws + WS_CPREV) + (idx * 128 + e) * 128 + 4 * dq) = (v2u){pk2(C[0], C[1]), pk2(C[2], C[3])};
            const float ml = MLOC[c], bl = BL[c];
            const float mnew = fmaxf(bl + m, ml), a = __expf(bl + m - mnew), cc = __expf(ml - mnew);
            if (e == 0) { *(f32x4*)((float*)(ws + WS_NPREV) + idx * 128 + 4 * dq) = n;
                const f32x4 nl = *(const f32x4*)((const float*)(ws + WS_NLOC) + idx * 128 + 4 * dq); n = n * a + nl * cc;
                if (dq == 0) ((float*)(ws + WS_MPREV))[idx] = m; }
            C = C * a + Cl * cc; m = mnew;
        }
    }
    const bf16* OA = (const bf16*)((const unsigned char*)A.out + DO_OATT); const float* LSE = (const float*)(ws + WS_LSE);
    for (size_t id = (size_t)blockIdx.x * NTHR + tid; id < (size_t)T * 64; id += NGT) {
        const size_t t = id >> 6; const int h = (int)(id & 63) >> 3, ch = (int)(id & 7) * 8;
        const float l0 = LSE[t * 8 + h], l1 = LSE[((size_t)T + t) * 8 + h], l2 = LSE[((size_t)2 * T + t) * 8 + h];
        const float mx = fmaxf(l0, fmaxf(l1, l2)); float w0 = exp2f(l0 - mx), w1 = exp2f(l1 - mx), w2 = exp2f(l2 - mx);
        const float rs = 1.0f / (w0 + w1 + w2); w0 *= rs; w1 *= rs; w2 *= rs;
        const v4u a = *(const v4u*)(OA + t * 512 + h * 64 + ch), b = *(const v4u*)(OA + ((size_t)T + t) * 512 + h * 64 + ch), c = *(const v4u*)(OA + ((size_t)2 * T + t) * 512 + h * 64 + ch);
        v4u o;
        o.x = pk2(w0 * bflo(a.x) + w1 * bflo(b.x) + w2 * bflo(c.x), w0 * bfhi(a.x) + w1 * bfhi(b.x) + w2 * bfhi(c.x));
        o.y = pk2(w0 * bflo(a.y) + w1 * bflo(b.y) + w2 * bflo(c.y), w0 * bfhi(a.y) + w1 * bfhi(b.y) + w2 * bfhi(c.y));
        o.z = pk2(w0 * bflo(a.z) + w1 * bflo(b.z) + w2 * bflo(c.z), w0 * bfhi(a.z) + w1 * bfhi(b.z) + w2 * bfhi(c.z));
        o.w = pk2(w0 * bflo(a.w) + w1 * bflo(b.w) + w2 * bflo(c.w), w0 * bfhi(a.w) + w1 * bfhi(b.w) + w2 * bfhi(c.w));
        *(v4u*)((bf16*)(ws + WS_Y) + t * 1024 + h * 64 + ch) = o;
    }
}

__device__ __forceinline__ void mlstm2_item(const Args& A, unsigned char* lds_, int item, int tid, int lane, int wave) {
    unsigned char* ws = A.ws; LAS unsigned char* lds = (LAS unsigned char*)lds_;
    const float* g_mhn = (const float*)(ws + WS_PAR) + PAR_GMHN; const float* skip_m = (const float*)(ws + WS_PAR) + PAR_SKIP;
    const int bh = item >> 6, c = item & 63, b = bh >> 2, h = bh & 3;
    const size_t t0 = (size_t)b * SEQ + 128 * c;
    LAS unsigned char* qA = lds; LAS unsigned char* kA = lds + ML_TILE; LAS unsigned char* Vt = lds + 2 * ML_TILE; LAS unsigned char* Cp = lds + 3 * ML_TILE;
    LAS float* gl = (LAS float*)(lds + ML_G);
    const int fr = lane & 15, g = lane >> 4, m0 = 16 * wave, l = m0 + fr;
    tile_load(qA, (const bf16*)(ws + WS_MQ) + t0 * 512 + h * 128, 512, tid);
    tile_load(kA, (const bf16*)(ws + WS_MK) + t0 * 512 + h * 128, 512, tid);
    tile_load(Vt, (const bf16*)(ws + WS_MV) + t0 * 512 + h * 128, 512, tid);
    tile_load(Cp, (const bf16*)(ws + WS_CPREV) + (size_t)item * 128 * 128, 128, tid);
    { const size_t gi = (size_t)bh * SEQ + 128 * c + 2 * lane; const float mprev = ((const float*)(ws + WS_MPREV))[item];
      const float i0 = ((const float*)(ws + WS_IG))[gi], i1 = ((const float*)(ws + WS_IG))[gi + 1];
      const float f0 = log_sigmoidf_(((const float*)(ws + WS_FG))[gi]), f1 = log_sigmoidf_(((const float*)(ws + WS_FG))[gi + 1]);
      float b0, b1; (void)wscan_sum(f0, f1, b0, b1, lane);
      const float a0 = i0 - b0, a1 = i1 - b1; float p0, p1; wscan_max(a0, a1, p0, p1, lane);
      const float mt0 = fmaxf(b0 + mprev, b0 + p0), mt1 = fmaxf(b1 + mprev, b1 + p1);
      gl[2 * lane] = a0; gl[2 * lane + 1] = a1; gl[128 + 2 * lane] = b0 - mt0; gl[128 + 2 * lane + 1] = b1 - mt1;
      gl[256 + 2 * lane] = __expf(b0 + mprev - mt0); gl[256 + 2 * lane + 1] = __expf(b1 + mprev - mt1); gl[384 + 2 * lane] = __expf(-mt0); gl[384 + 2 * lane + 1] = __expf(-mt1); }
    __syncthreads();
    bf16x8 qf[4];
#pragma unroll
    for (int ks = 0; ks < 4; ++ks) qf[ks] = rowfrag(qA, m0, ks, fr, g);
    float qn = 0.f;
    { const float* np = (const float*)(ws + WS_NPREV) + (size_t)item * 128;
#pragma unroll
      for (int ks = 0; ks < 4; ++ks) { const f32x4 n0 = *(const f32x4*)(np + 32 * ks + 8 * g), n1 = *(const f32x4*)(np + 32 * ks + 8 * g + 4); const v4u w = __builtin_bit_cast(v4u, qf[ks]);
          qn += bflo(w.x) * n0[0] + bfhi(w.x) * n0[1] + bflo(w.y) * n0[2] + bfhi(w.y) * n0[3] + bflo(w.z) * n1[0] + bfhi(w.z) * n1[1] + bflo(w.w) * n1[2] + bfhi(w.w) * n1[3]; }
      qn += __shfl_xor(qn, 16); qn += __shfl_xor(qn, 32); }
    float den = 0.f;
    { const float rc = gl[128 + l];
#pragma unroll
      for (int j = 0; j < 8; ++j) { f32x4 acc = (f32x4){0.f, 0.f, 0.f, 0.f};
          if (j <= wave) {
#pragma unroll
              for (int ks = 0; ks < 4; ++ks) acc = __builtin_amdgcn_mfma_f32_16x16x32_bf16(rowfrag(kA, 16 * j, ks, fr, g), qf[ks], acc, 0, 0, 0);
#pragma unroll
              for (int e = 0; e < 4; ++e) { const int sx = 16 * j + 4 * g + e; acc[e] = (sx <= l) ? acc[e] * __expf(rc + gl[sx]) : 0.f; den += acc[e]; } }
          *(LAS v2u*)(qA + sw_off(l, 2 * j + (g >> 1)) + 8 * (g & 1)) = (v2u){pk2(acc[0], acc[1]), pk2(acc[2], acc[3])}; }
      den += __shfl_xor(den, 16); den += __shfl_xor(den, 32); }
    f32x4 acc[8];
    const float iw = gl[256 + l];
#pragma unroll
    for (int j = 0; j < 8; ++j) { acc[j] = (f32x4){0.f, 0.f, 0.f, 0.f};
#pragma unroll
        for (int ks = 0; ks < 4; ++ks) acc[j] = __builtin_amdgcn_mfma_f32_16x16x32_bf16(rowfrag(Cp, 16 * j, ks, fr, g), qf[ks], acc[j], 0, 0, 0);
        acc[j] = acc[j] * iw; }
    asm volatile("s_waitcnt lgkmcnt(0)" ::: "memory");
#pragma unroll
    for (int ks = 0; ks < 4; ++ks) if (2 * ks <= wave) { const bf16x8 sf = rowfrag(qA, m0, ks, fr, g);
#pragma unroll
        for (int j = 0; j < 8; ++j) acc[j] = __builtin_amdgcn_mfma_f32_16x16x32_bf16(colfrag(Vt, ks, j, fr, g), sf, acc[j], 0, 0, 0); }
    den += iw * qn;
    const float rden = 1.0f / fmaxf(fabsf(den), gl[384 + l]);
    float sq = 0.f;
#pragma unroll
    for (int j = 0; j < 8; ++j) { acc[j] = acc[j] * rden; sq += (acc[j][0] * acc[j][0] + acc[j][1] * acc[j][1]) + (acc[j][2] * acc[j][2] + acc[j][3] * acc[j][3]); }
    sq += __shfl_xor(sq, 16); sq += __shfl_xor(sq, 32);
    const float rn = 1.0f / sqrtf(sq * (1.0f / 128.0f) + EPSN);
    const bf16* MOg = (const bf16*)(ws + WS_MO) + (t0 + l) * 512 + h * 128; const bf16* Cg = (const bf16*)((const unsigned char*)A.out + DO_C) + (t0 + l) * 512 + h * 128;
    bf16* yg = (bf16*)(ws + WS_Y) + (t0 + l) * 1024 + 512 + h * 128;
#pragma unroll
    for (int j = 0; j < 8; ++j) { const int e0 = 16 * j + 4 * g;
        const v2u mo = *(const v2u*)(MOg + e0), cc = *(const v2u*)(Cg + e0);
        const f32x4 gm = *(const f32x4*)(g_mhn + h * 128 + e0), sk = *(const f32x4*)(skip_m + h * 128 + e0);
        const float y0 = sigmoidf_(bflo(mo.x)) * (acc[j][0] * rn * gm[0] + sk[0] * bflo(cc.x));
        const float y1 = sigmoidf_(bfhi(mo.x)) * (acc[j][1] * rn * gm[1] + sk[1] * bfhi(cc.x));
        const float y2 = sigmoidf_(bflo(mo.y)) * (acc[j][2] * rn * gm[2] + sk[2] * bflo(cc.y));
        const float y3 = sigmoidf_(bfhi(mo.y)) * (acc[j][3] * rn * gm[3] + sk[3] * bfhi(cc.y));
        *(v2u*)(yg + e0) = (v2u){pk2(y0, y1), pk2(y2, y3)}; }
    __syncthreads();
}

struct EpiOutProj {
    static constexpr bool PERM = true, AFTER_DRAIN = false;
    const float* x; bf16* x1b; float* ss;
    __device__ __forceinline__ void operator()(const f32x4 (&acc)[2][2][4][2], const pg8::Unit& u, int wr, int wc, int fr, int fq) const {
        const int row0 = u.pm * 256 + wr * 64 + fr, col0 = u.pn * 256 + wc * 32 + 8 * fq;
#pragma unroll
        for (int ai = 0; ai < 2; ++ai)
#pragma unroll
            for (int m = 0; m < 4; ++m) { const int row = row0 + ai * 128 + m * 16; float sq = 0.f;
#pragma unroll
                for (int bj = 0; bj < 2; ++bj) { const size_t off = (size_t)row * D + col0 + bj * 128;
                    const f32x4 o0 = *(const f32x4*)(x + off) + acc[ai][bj][m][0], o1 = *(const f32x4*)(x + off + 4) + acc[ai][bj][m][1];
                    *(v4u*)(x1b + off) = pack8(o0, o1);
                    sq += ((o0[0] * o0[0] + o0[1] * o0[1]) + (o0[2] * o0[2] + o0[3] * o0[3])) + ((o1[0] * o1[0] + o1[1] * o1[1]) + (o1[2] * o1[2] + o1[3] * o1[3])); }
                sq += __shfl_xor(sq, 16); sq += __shfl_xor(sq, 32);
                if (fq == 0) ss[(size_t)row * 16 + u.pn * 4 + wc] = sq; }
    }
};
struct EpiQx {
    static constexpr bool PERM = true, AFTER_DRAIN = false;
    bf16* qx; const LAS float* rs;
    __device__ __forceinline__ void operator()(const f32x4 (&acc)[2][2][4][2], const pg8::Unit& u, int wr, int wc, int fr, int fq) const {
        const int rl0 = wr * 64 + fr, col0 = wc * 32 + 8 * fq;
#pragma unroll
        for (int ai = 0; ai < 2; ++ai)
#pragma unroll
            for (int m = 0; m < 4; ++m) { const int rl = rl0 + ai * 128 + m * 16; const float sc = rs[rl]; bf16* rowp = qx + (size_t)(u.pm * 256 + rl) * 256 + col0;
#pragma unroll
                for (int bj = 0; bj < 2; ++bj) *(v4u*)(rowp + bj * 128) = pack8(acc[ai][bj][m][0] * sc, acc[ai][bj][m][1] * sc);
                asm volatile("" ::: "memory"); }
    }
};
struct EpiOx {
    static constexpr bool PERM = true, AFTER_DRAIN = false;
    const bf16* x1b; bf16* x2b;
    __device__ __forceinline__ void operator()(const f32x4 (&acc)[2][2][4][2], const pg8::Unit& u, int wr, int wc, int fr, int fq) const {
        const int row0 = u.pm * 256 + wr * 64 + fr, col0 = u.pn * 256 + wc * 32 + 8 * fq;
#pragma unroll
        for (int ai = 0; ai < 2; ++ai)
#pragma unroll
            for (int m = 0; m < 4; ++m) {
#pragma unroll
                for (int bj = 0; bj < 2; ++bj) { const size_t off = (size_t)(row0 + ai * 128 + m * 16) * D + col0 + bj * 128; const v4u r = *(const v4u*)(x1b + off);
                    f32x4 o0 = acc[ai][bj][m][0], o1 = acc[ai][bj][m][1];
                    o0[0] += bflo(r.x); o0[1] += bfhi(r.x); o0[2] += bflo(r.y); o0[3] += bfhi(r.y); o1[0] += bflo(r.z); o1[1] += bfhi(r.z); o1[2] += bflo(r.w); o1[3] += bfhi(r.w);
                    *(v4u*)(x2b + off) = pack8(o0, o1); }
                asm volatile("" ::: "memory"); }
    }
};
constexpr int CX_QLD = 72, CX_KLD = 72, CX_VLD = 264, CX_PLD = 264;
constexpr int CX_Q = 0, CX_K = CX_Q + 128 * CX_QLD * 2, CX_V = CX_K + 256 * CX_KLD * 2, CX_P = CX_V + 64 * CX_VLD * 2, CX_END = CX_P + 8 * 16 * CX_PLD * 2;
static_assert(CX_END <= LDS_MISC, "cross LDS");
__device__ __forceinline__ void cross_item(const Args& A, unsigned char* lds, int item, int tid, int lane, int wave) {
    unsigned char* ws = A.ws;
    const int rt = item >> 2, h = item & 3; const size_t t0 = (size_t)rt * 128; const int b = (int)(t0 / SEQ);
    bf16* Qs = (bf16*)(lds + CX_Q); bf16* Ks = (bf16*)(lds + CX_K); bf16* Vt = (bf16*)(lds + CX_V); bf16* Ps = (bf16*)(lds + CX_P) + wave * 16 * CX_PLD;
    const bf16* QX = (const bf16*)(ws + WS_QX) + h * 64; const bf16* KV = (const bf16*)(ws + WS_KVX) + (size_t)b * MEMLEN * NKV + h * 64;
    for (int id = tid; id < 128 * 8; id += NTHR) { const int row = id >> 3, ch = id & 7; *(v4u*)(Qs + row * CX_QLD + ch * 8) = *(const v4u*)(QX + (t0 + row) * 256 + ch * 8); }
    for (int id = tid; id < 256 * 8; id += NTHR) { const int kk = id >> 3, ch = id & 7;
        *(v4u*)(Ks + kk * CX_KLD + ch * 8) = *(const v4u*)(KV + (size_t)kk * NKV + ch * 8);
        const v4u vv = *(const v4u*)(KV + (size_t)kk * NKV + 256 + ch * 8); bf16* vp = Vt + (ch * 8) * CX_VLD + kk;
        vp[0 * CX_VLD] = (bf16)(vv.x & 0xffffu); vp[1 * CX_VLD] = (bf16)(vv.x >> 16); vp[2 * CX_VLD] = (bf16)(vv.y & 0xffffu); vp[3 * CX_VLD] = (bf16)(vv.y >> 16);
        vp[4 * CX_VLD] = (bf16)(vv.z & 0xffffu); vp[5 * CX_VLD] = (bf16)(vv.z >> 16); vp[6 * CX_VLD] = (bf16)(vv.w & 0xffffu); vp[7 * CX_VLD] = (bf16)(vv.w >> 16); }
    __syncthreads();
    const int fr = lane & 15, fq = lane >> 4;
    f32x4 s[1][16];
#pragma unroll
    for (int j = 0; j < 16; ++j) s[0][j] = (f32x4){0.f, 0.f, 0.f, 0.f};
    wave_mma<1, 16>(Qs + 16 * wave * CX_QLD, CX_QLD, Ks, CX_KLD, 64, s, fr, fq);
    float mx = -1e30f;
#pragma unroll
    for (int j = 0; j < 16; ++j)
#pragma unroll
        for (int e = 0; e < 4; ++e) mx = fmaxf(mx, s[0][j][e]);
    mx = fmaxf(mx, __shfl_xor(mx, 16)); mx = fmaxf(mx, __shfl_xor(mx, 32));
    float l = 0.f;
#pragma unroll
    for (int j = 0; j < 16; ++j) { f32x4 p;
#pragma unroll
        for (int e = 0; e < 4; ++e) { p[e] = exp2f(s[0][j][e] - mx); l += p[e]; }
        *(v2u*)(Ps + fr * CX_PLD + 16 * j + 4 * fq) = (v2u){pk2(p[0], p[1]), pk2(p[2], p[3])}; }
    l += __shfl_xor(l, 16); l += __shfl_xor(l, 32);
    __syncthreads();
    f32x4 o[1][4];
#pragma unroll
    for (int j = 0; j < 4; ++j) o[0][j] = (f32x4){0.f, 0.f, 0.f, 0.f};
    wave_mma<1, 4>(Ps, CX_PLD, Vt, CX_VLD, 256, o, fr, fq);
    const float rl = 1.0f / l;
    bf16* og = (bf16*)(ws + WS_OX) + (t0 + 16 * wave + fr) * 256 + h * 64;
#pragma unroll
    for (int j = 0; j < 4; ++j) *(v2u*)(og + 16 * j + 4 * fq) = (v2u){pk2(o[0][j][0] * rl, o[0][j][1] * rl), pk2(o[0][j][2] * rl, o[0][j][3] * rl)};
    __syncthreads();
}

struct TokInfo { int bucket; float wa, wb; int rank; };
constexpr size_t WS_RSTD3 = 18 * MiB;
constexpr size_t WS_CNTTAB = 31 * MiB + 512 * 1024;
__device__ __forceinline__ void p9_route(const Args& A, unsigned char* lds, int tid, int lane, int wave) {
    unsigned char* ws = A.ws;
    const float* b_rg = (const float*)(ws + WS_PAR) + PAR_BRG; const float* b_re = (const float*)(ws + WS_PAR) + PAR_BRE;
    LAS float* WRl = (LAS float*)lds;
    LAS int* bkl = (LAS int*)(lds + 81920);
    for (int i = tid; i < 20 * 1024 / 4; i += NTHR) ((LAS f32x4*)WRl)[i] = ((const f32x4*)(ws + WS_WR))[i];
    __syncthreads();
    const bf16* X2B = (const bf16*)(ws + WS_HBS);
    for (int chunk = blockIdx.x; chunk < T / 256; chunk += gridDim.x) {
        for (int r = 0; r < 32; ++r) {
            const int m = chunk * 256 + wave * 32 + r;
            const v4u* xr = (const v4u*)(X2B + (size_t)m * D) + lane;
            f32x4 v[4]; float s = 0.f;
#pragma unroll
            for (int j = 0; j < 2; ++j) { const v4u r = xr[64 * j]; v[2 * j] = (f32x4){bflo(r.x), bfhi(r.x), bflo(r.y), bfhi(r.y)}; v[2 * j + 1] = (f32x4){bflo(r.z), bfhi(r.z), bflo(r.w), bfhi(r.w)}; }
#pragma unroll
            for (int j = 0; j < 4; ++j) s += (v[j].x * v[j].x + v[j].y * v[j].y) + (v[j].z * v[j].z + v[j].w * v[j].w);
            const float rstd = 1.0f / sqrtf(wave_sum(s) * (1.0f / D) + EPSN);
            float gl4[4];
#pragma unroll
            for (int e = 0; e < 4; ++e) { float a = 0.f;
#pragma unroll
                for (int j = 0; j < 4; ++j) { const f32x4 w = *(const LAS f32x4*)(WRl + e * 1024 + 512 * (j >> 1) + 8 * lane + 4 * (j & 1)); a += (v[j].x * w.x + v[j].y * w.y) + (v[j].z * w.z + v[j].w * w.w); }
                gl4[e] = wave_sum(a) * rstd + b_rg[e]; }
            int g = 0; float gm = gl4[0];
#pragma unroll
            for (int i = 1; i < 4; ++i) if (gl4[i] > gm) { gm = gl4[i]; g = i; }
            g = __builtin_amdgcn_readfirstlane(g);
            float gs = 0.f;
#pragma unroll
            for (int i = 0; i < 4; ++i) gs += __expf(gl4[i] - gm);
            const float gw_ = 1.0f / gs;
            float el[4];
            const LAS float* WRe = WRl + (4 + 4 * g) * 1024;
#pragma unroll
            for (int e = 0; e < 4; ++e) { float a = 0.f;
#pragma unroll
                for (int j = 0; j < 4; ++j) { const f32x4 w = *(const LAS f32x4*)(WRe + e * 1024 + 512 * (j >> 1) + 8 * lane + 4 * (j & 1)); a += (v[j].x * w.x + v[j].y * w.y) + (v[j].z * w.z + v[j].w * w.w); }
                el[e] = wave_sum(a) * rstd + b_re[g * 4 + e]; }
            int i0 = 0; float v0 = el[0];
#pragma unroll
            for (int i = 1; i < 4; ++i) if (el[i] > v0) { v0 = el[i]; i0 = i; }
            int i1 = -1; float v1 = -INFINITY;
#pragma unroll
            for (int i = 0; i < 4; ++i) if (i != i0 && el[i] > v1) { v1 = el[i]; i1 = i; }
            const float e1 = __expf(v1 - v0); const float w0 = gw_ / (1.0f + e1), w1 = gw_ * e1 / (1.0f + e1);
            const int pa = i0 < i1 ? i0 : i1, pb = i0 < i1 ? i1 : i0;
            const int pidx = (pa == 0) ? (pb - 1) : (pa == 1 ? pb + 1 : 5);
            const int bucket = g * 6 + pidx;
            if (lane == 0) { ((float*)(ws + WS_RSTD3))[m] = rstd; bkl[wave * 32 + r] = bucket; ((LAS float*)(bkl + 256))[wave * 32 + r] = (i0 < i1) ? w0 : w1; ((LAS float*)(bkl + 512))[wave * 32 + r] = (i0 < i1) ? w1 : w0; }
        }
        __syncthreads();
        if (tid < 256) { const int my = bkl[tid]; int rank = 0; for (int j = 0; j < tid; ++j) rank += (bkl[j] == my) ? 1 : 0;
            TokInfo ti; ti.bucket = my; ti.wa = ((LAS float*)(bkl + 256))[tid]; ti.wb = ((LAS float*)(bkl + 512))[tid]; ti.rank = rank;
            ((TokInfo*)(ws + WS_TOKINFO))[chunk * 256 + tid] = ti; }
        else if (tid < 256 + NBUCKET) { const int b = tid - 256; int c = 0; for (int j = 0; j < 256; ++j) c += (bkl[j] == b) ? 1 : 0;
            ((int*)(ws + WS_CNTTAB))[chunk * NBUCKET + b] = c; }
        __syncthreads();
    }
}
__device__ __forceinline__ void p10_slots(const Args& A, unsigned char* lds, int tid, int lane, int wave) {
    unsigned char* ws = A.ws;
    LAS int* tabl = (LAS int*)lds;
    LAS int* totl = (LAS int*)(lds + 32768);
    const int* CNTTAB = (const int*)(ws + WS_CNTTAB);
    for (int i = tid; i < 256 * NBUCKET; i += NTHR) tabl[i] = CNTTAB[i];
    __syncthreads();
    if (tid < NBUCKET) { int t = 0; for (int w = 0; w < 256; ++w) t += tabl[w * NBUCKET + tid]; totl[tid] = t; }
    __syncthreads();
    if (tid == 0) { int acc = 0; for (int b = 0; b < NBUCKET; ++b) { totl[32 + b] = acc; acc += ((totl[b] + 255) >> 8) * 256; } totl[32 + NBUCKET] = acc; }
    if (blockIdx.x == 0 && tid < NBUCKET) ((unsigned*)(ws + WS_CTL))[CW_CNT + tid] = (unsigned)totl[tid];
    __syncthreads();
    int* TOKMAP = (int*)(ws + WS_TOKMAP); float* WSORT = (float*)(ws + WS_WSORT);
    for (int chunk = blockIdx.x; chunk < T / 256; chunk += gridDim.x) {
        if (tid < NBUCKET) { int s = 0; for (int w = 0; w < chunk; ++w) s += tabl[w * NBUCKET + tid]; totl[64 + tid] = totl[32 + tid] + s; }
        __syncthreads();
        if (tid < 256) { const int m = chunk * 256 + tid; const TokInfo ti = ((const TokInfo*)(ws + WS_TOKINFO))[m]; const int slot = totl[64 + ti.bucket] + ti.rank;
            TOKMAP[slot] = m; *(f32x4*)(WSORT + 4 * slot) = (f32x4){ti.wa, ti.wb, ((const float*)(ws + WS_RSTD3))[m], 0.f}; }
        __syncthreads();
    }
    for (int b = blockIdx.x; b < NBUCKET; b += gridDim.x)
        for (int r = totl[32 + b] + totl[b] + tid; r < totl[32 + b + 1]; r += NTHR) { TOKMAP[r] = -1; *(f32x4*)(WSORT + 4 * r) = (f32x4){0.f, 0.f, 0.f, 0.f}; }
}
struct MoeOrder {
    int G, c, nunits, ncol; const int* tab;
    __device__ __forceinline__ bool next(int i, pg8::Unit& u) const {
        const long L = (long)i * G + c; if (L >= nunits) return false;
        const int rt = (int)L / ncol, j = (int)L % ncol, bk = tab[rt];
        u.pm = rt; u.aux = j;
        if (ncol == 8) { const int g = bk / 6, p = bk % 6; const int pa = (p < 3) ? 0 : (p < 5 ? 1 : 2), pb = (p < 3) ? p + 1 : (p < 5 ? p - 1 : 3);
            const int e = 4 * g + ((j >> 2) ? pb : pa); u.pn = e * 4 + (j & 3); }
        else u.pn = bk * 4 + j;
        return true;
    }
    __device__ __forceinline__ void a_ready(const pg8::Unit&) const {}
    __device__ __forceinline__ void done(const pg8::Unit&) const {}
};
struct EpiUp {
    static constexpr bool PERM = true, AFTER_DRAIN = false;
    bf16* act; const float* wsort;
    __device__ __forceinline__ void operator()(const f32x4 (&acc)[2][2][4][2], const pg8::Unit& u, int wr, int wc, int fr, int fq) const {
        const int row0 = u.pm * 256 + wr * 64 + fr, half = u.aux >> 2, col0 = half * 512 + (u.aux & 3) * 128 + wc * 32 + 8 * fq;
#pragma unroll
        for (int ai = 0; ai < 2; ++ai)
#pragma unroll
            for (int m = 0; m < 4; ++m) { const int row = row0 + ai * 128 + m * 16; const float w = wsort[4 * row + half], rs = wsort[4 * row + 2];
                f32x4 r0, r1;
#pragma unroll
                for (int i = 0; i < 4; ++i) { const float a0 = acc[ai][0][m][0][i] * rs, a1 = acc[ai][0][m][1][i] * rs;
                    r0[i] = a0 * sigmoidf_(a0) * (acc[ai][1][m][0][i] * rs) * w; r1[i] = a1 * sigmoidf_(a1) * (acc[ai][1][m][1][i] * rs) * w; }
                *(v4u*)(act + (size_t)row * D + col0) = pack8(r0, r1); }
    }
};
struct EpiDown {
    static constexpr bool PERM = true, AFTER_DRAIN = false;
    const bf16* x2b; float* xo; const int* tokmap;
    __device__ __forceinline__ void operator()(const f32x4 (&acc)[2][2][4][2], const pg8::Unit& u, int wr, int wc, int fr, int fq) const {
        const int row0 = u.pm * 256 + wr * 64 + fr, col0 = u.aux * 256 + wc * 32 + 8 * fq;
#pragma unroll
        for (int ai = 0; ai < 2; ++ai)
#pragma unroll
            for (int m = 0; m < 4; ++m) { const int tok = tokmap[row0 + ai * 128 + m * 16];
                if (tok >= 0) {
#pragma unroll
                    for (int bj = 0; bj < 2; ++bj) { const size_t off = (size_t)tok * D + col0 + bj * 128; const v4u r = *(const v4u*)(x2b + off);
                        f32x4 o0 = acc[ai][bj][m][0], o1 = acc[ai][bj][m][1];
                        o0[0] += bflo(r.x); o0[1] += bfhi(r.x); o0[2] += bflo(r.y); o0[3] += bfhi(r.y); o1[0] += bflo(r.z); o1[1] += bfhi(r.z); o1[2] += bflo(r.w); o1[3] += bfhi(r.w);
                        *(f32x4*)(xo + off) = o0; *(f32x4*)(xo + off + 4) = o1; } } }
    }
};
constexpr size_t WS_XCH = 20 * MiB + 512 * 1024;
constexpr int CW_SEAM = 16384;
constexpr int LDS_EX = 139264;
struct EpiDownNorm {
    static constexpr bool PERM = true, AFTER_DRAIN = false;
    const bf16* x2b; float* out; const int* tokmap; const float* gfin; float* xch; unsigned* cnt; LAS unsigned char* ex;
    __device__ __forceinline__ void operator()(const f32x4 (&acc_)[2][2][4][2], const pg8::Unit& u, int wr, int wc, int fr, int fq) const {
        f32x4 (&acc)[2][2][4][2] = const_cast<f32x4 (&)[2][2][4][2]>(acc_);
        int tid = threadIdx.x; asm volatile("" : "+v"(tid));
        const int lane = tid & 63, wid = __builtin_amdgcn_readfirstlane(tid >> 6);
        int rb = wr * 64 + fr; asm volatile("" : "+v"(rb));
        LAS float* P = (LAS float*)ex; LAS float* S = (LAS float*)(ex + 4096); LAS unsigned* flag = (LAS unsigned*)(ex + 6144);
        const int col0 = u.aux * 256 + wc * 32 + 8 * fq;
#pragma unroll
        for (int ai = 0; ai < 2; ++ai)
#pragma unroll
            for (int m = 0; m < 4; ++m) { const int rl = rb + ai * 128 + m * 16; const int tok = tokmap[u.pm * 256 + rl]; float sq = 0.f;
#pragma unroll
                for (int bj = 0; bj < 2; ++bj) { f32x4& o0 = acc[ai][bj][m][0]; f32x4& o1 = acc[ai][bj][m][1];
                    if (tok >= 0) { const v4u r = *(const v4u*)(x2b + (size_t)tok * D + col0 + bj * 128);
                        o0[0] += bflo(r.x); o0[1] += bfhi(r.x); o0[2] += bflo(r.y); o0[3] += bfhi(r.y); o1[0] += bflo(r.z); o1[1] += bfhi(r.z); o1[2] += bflo(r.w); o1[3] += bfhi(r.w); }
                    sq += ((o0[0] * o0[0] + o0[1] * o0[1]) + (o0[2] * o0[2] + o0[3] * o0[3])) + ((o1[0] * o1[0] + o1[1] * o1[1]) + (o1[2] * o1[2] + o1[3] * o1[3])); }
                sq += __shfl_xor(sq, 16); sq += __shfl_xor(sq, 32);
                if (fq == 0) P[rl * 4 + wc] = sq;
                asm volatile("" ::: "memory"); }
        asm volatile("s_waitcnt lgkmcnt(0)" ::: "memory"); __builtin_amdgcn_s_barrier(); asm volatile("" ::: "memory");
        if (tid < 256) { const f32x4 p = *(const LAS f32x4*)(P + tid * 4);
            __hip_atomic_store(xch + ((size_t)u.pm * 256 + tid) * 4 + u.aux, (p[0] + p[1]) + (p[2] + p[3]), __ATOMIC_RELAXED, __HIP_MEMORY_SCOPE_AGENT); }
        asm volatile("s_waitcnt vmcnt(0)" ::: "memory");
        if (wid < 4 && lane == 0) __hip_atomic_fetch_add(cnt + 64 * u.pm, 1u, __ATOMIC_RELAXED, __HIP_MEMORY_SCOPE_AGENT);
        if (wid == 0) { unsigned spins = 0;
            while ((unsigned)__builtin_amdgcn_readfirstlane(__hip_atomic_load(cnt + 64 * u.pm, __ATOMIC_RELAXED, __HIP_MEMORY_SCOPE_AGENT)) < 16u) { __builtin_amdgcn_s_sleep(2); if (++spins > (1u << 22)) break; }
            __builtin_amdgcn_fence(__ATOMIC_ACQUIRE, "agent");
            if (lane == 0) flag[0] = spins; }
        asm volatile("s_waitcnt vmcnt(0) lgkmcnt(0)" ::: "memory"); __builtin_amdgcn_s_barrier(); asm volatile("" ::: "memory");
        if (tid < 256) { const float* sl = xch + ((size_t)u.pm * 256 + tid) * 4; float t = 0.f;
#pragma unroll
            for (int k = 0; k < 4; ++k) t += __hip_atomic_load(sl + k, __ATOMIC_RELAXED, __HIP_MEMORY_SCOPE_AGENT);
            S[tid] = 1.0f / sqrtf(t * (1.0f / D) + EPSN); }
        asm volatile("s_waitcnt lgkmcnt(0)" ::: "memory"); __builtin_amdgcn_s_barrier(); asm volatile("" ::: "memory");
#pragma unroll
        for (int ai = 0; ai < 2; ++ai)
#pragma unroll
            for (int m = 0; m < 4; ++m) { const int rl = rb + ai * 128 + m * 16; const int tok = tokmap[u.pm * 256 + rl]; const float rs = S[rl];
                if (tok >= 0) {
#pragma unroll
                    for (int bj = 0; bj < 2; ++bj)
#pragma unroll
                        for (int n = 0; n < 2; ++n) { const int cc = col0 + bj * 128 + 4 * n; acc[ai][bj][m][n] = acc[ai][bj][m][n] * rs; acc[ai][bj][m][n] = acc[ai][bj][m][n] * *(const f32x4*)(gfin + cc);
                            *(f32x4*)(out + (size_t)tok * D + cc) = acc[ai][bj][m][n]; asm volatile("" ::: "memory"); } } }
    }
};
__device__ __forceinline__ void p10_final(const Args& A, float* outp, int lane, int wave) {
    const float* g_final = (const float*)(A.ws + WS_PAR) + PAR_GFIN;
    const int G = gridDim.x, gw = blockIdx.x * NWAVES + wave, NGW = G * NWAVES;
    f32x4 gv[4];
#pragma unroll
    for (int j = 0; j < 4; ++j) gv[j] = *((const f32x4*)g_final + lane + 64 * j);
    for (int m = gw; m < T; m += NGW) {
        f32x4* xr = (f32x4*)(A.out + (size_t)m * D) + lane;
        f32x4 v[4]; float s = 0.f;
#pragma unroll
        for (int j = 0; j < 4; ++j) { v[j] = xr[64 * j]; s += (v[j].x * v[j].x + v[j].y * v[j].y) + (v[j].z * v[j].z + v[j].w * v[j].w); }
        const float rstd = 1.0f / sqrtf(wave_sum(s) * (1.0f / D) + EPSN);
#pragma unroll
        for (int j = 0; j < 4; ++j) ((f32x4*)(outp + (size_t)m * D) + lane)[64 * j] = v[j] * rstd * gv[j];
    }
}

#ifndef MS
#define MS 4
#endif
#ifndef N_LAUNCHES
#define N_LAUNCHES 1
#endif
constexpr int N_PHASES = 14;
#ifndef FUSE_FINAL
#define FUSE_FINAL 1
#endif
#ifndef DUP_MASK
#define DUP_MASK 0
#endif
#define REP(k) for (int rep_ = 0; rep_ < (((DUP_MASK >> (k)) & 1) ? 2 : 1); ++rep_)
#ifndef QX_SP2
#define QX_SP2 false
#endif

#ifndef NVG
#define NVG 256
#endif
__global__ void __launch_bounds__(NTHR, 2) __attribute__((amdgpu_num_vgpr(NVG))) fwd_kernel(Args args) {
    __shared__ __attribute__((aligned(16))) unsigned char lds[LDS_BYTES];
    const int tid = threadIdx.x, lane = tid & 63, wave = __builtin_amdgcn_readfirstlane(tid >> 6);
    gu32* ctl = (gu32*)(args.ws + WS_CTL);
    for (int u = tid; u < (LDS_BYTES - LDS_MISC) / 4; u += NTHR) ((unsigned*)(lds + LDS_MISC))[u] = 0u;
    __syncthreads();
    const int lo = args.ph_lo, hi = args.ph_hi;
    const bool use_bar = (hi - lo) > 1;
    XcdBarrier bar; bar.bar = (unsigned*)ctl + CW_BAR; bar.x = 0; bar.st = (volatile LAS unsigned*)(lds + LDS_MISC) + 8;
    if (use_bar) bar = xcd_barrier_post((unsigned*)ctl + CW_BAR, (volatile LAS unsigned*)(lds + LDS_MISC) + 8);
#ifndef PH_MASK
#define PH_MASK 0xFFFF
#endif
#define IN(k) (((PH_MASK >> (k)) & 1) && lo <= (k) && (k) < hi)
#define SEAM(k) do { if (IN(k) && IN((k) + 1)) xcd_barrier(bar); } while (0)
    PG8_LAS unsigned char* ring = (PG8_LAS unsigned char*)lds;
    const int G = gridDim.x;
#define PHASE_PTRS Args pa = args; { unsigned char* w_ = args.ws; float* o_ = args.out; asm volatile("" : "+s"(w_), "+s"(o_)); pa.ws = w_; pa.out = o_; } unsigned char* const ws = pa.ws; (void)ws

#ifdef DUMMY_LIVE
    float dl0, dl1, dl2, dl3, dl4, dl5, dl6, dl7; asm volatile("" : "=v"(dl0), "=v"(dl1), "=v"(dl2), "=v"(dl3), "=v"(dl4), "=v"(dl5), "=v"(dl6), "=v"(dl7));
#endif
    if (IN(0)) { PHASE_PTRS; REP(0) { p0_prologue(pa, lds, tid, lane, wave); __syncthreads(); } }
    SEAM(0);
    if (IN(1) && MS >= 1) { PHASE_PTRS;
        pg8::Gemm g{(const pg8::bf16_t*)(ws + WS_XN), (const pg8::bf16_t*)(ws + WS_WIN), T + TMEM, NIN + NKV, D};
        InProjOrder S; S.so.init(T, NIN, G, (int)blockIdx.x);
        EpiInProj E{(bf16*)(ws + WS_Q), (bf16*)(ws + WS_KVX), (const float*)(ws + WS_ROPE)};
        REP(1) pg8::gemm_phase<EpiInProj, InProjOrder, true, true>(ring, g, S, E);
    }
    SEAM(1);
    if (IN(2) && MS >= 1) { PHASE_PTRS;
        const int n_att = (MS >= 2) ? 3 * 4096 : 0;
        REP(14) attn_phase(pa, lds, n_att, lane, wave);
        REP(15) { int wres = -1; const int per = (2048 + G - 1) / G; __syncthreads(); for (int it = blockIdx.x * per; it < 2048 && it < (int)(blockIdx.x + 1) * per; ++it) mlstm1_item(pa, lds, it, wres, tid, lane, wave); }
    }
    SEAM(2);
    if (IN(3) && MS >= 1) { PHASE_PTRS;
        if (MS < 2) {
            for (size_t id = (size_t)blockIdx.x * NTHR + tid; id < (size_t)T * 64; id += (size_t)G * NTHR) { const size_t t = id >> 6; const int c8 = (int)(id & 63) * 8;
                *(v4u*)((bf16*)(ws + WS_Y) + t * 1024 + c8) = (v4u){0u, 0u, 0u, 0u}; }
        }
        REP(3) p3_scan_combine(pa, tid);
    }
    SEAM(3);
    if (IN(4) && MS >= 1) { PHASE_PTRS; REP(4) { const int per = (2048 + G - 1) / G; for (int it = blockIdx.x * per; it < 2048 && it < (int)(blockIdx.x + 1) * per; ++it) mlstm2_item(pa, lds, it, tid, lane, wave); } }
    SEAM(4);
    if (IN(5)) { PHASE_PTRS;
        if (MS >= 1) {
            pg8::Gemm g{(const pg8::bf16_t*)(ws + WS_Y), (const pg8::bf16_t*)(ws + WS_WOUT), T, D, D};
            pg8::StaticOrder S; S.init(T, D, G, (int)blockIdx.x);
            EpiOutProj E{(const float*)pa.in[0], (bf16*)(ws + WS_X1B), (float*)(ws + WS_SS1)};
            REP(5) pg8::gemm_phase<EpiOutProj, pg8::StaticOrder, true, true>(ring, g, S, E);
        } else {
            const int gw = blockIdx.x * NWAVES + wave, NGW = G * NWAVES;
            for (int m = gw; m < T; m += NGW) { const f32x4* xr = (const f32x4*)((const float*)pa.in[0] + (size_t)m * D) + lane; unsigned long long* o8 = (unsigned long long*)(ws + WS_X1B + (size_t)m * D * 2) + lane;
#pragma unroll
                for (int j = 0; j < 4; ++j) { const f32x4 v = xr[64 * j]; o8[64 * j] = (unsigned long long)pk2(v.x, v.y) | ((unsigned long long)pk2(v.z, v.w) << 32); } }
        }
    }
    SEAM(5);
    if (IN(6) && MS >= 3) { PHASE_PTRS;
        pg8::Gemm g{(const pg8::bf16_t*)(ws + WS_X1B), (const pg8::bf16_t*)(ws + WS_WQX), T, 256, D};
        pg8::StaticOrder S; S.init(T, 256, G, (int)blockIdx.x);
        float* rs = (float*)(lds + LDS_RS);
        { pg8::Unit u0; if (S.next(0, u0) && tid < 256) { const f32x4* sp = (const f32x4*)((const float*)(ws + WS_SS1) + (size_t)(u0.pm * 256 + tid) * 16);
              const f32x4 a = sp[0], b = sp[1], c = sp[2], d = sp[3];
              const float s = ((a[0] + a[1]) + (a[2] + a[3])) + ((b[0] + b[1]) + (b[2] + b[3])) + ((c[0] + c[1]) + (c[2] + c[3])) + ((d[0] + d[1]) + (d[2] + d[3]));
              rs[tid] = 1.0f / sqrtf(s * (1.0f / D) + EPSN); } }
        __syncthreads();
        EpiQx E{(bf16*)(ws + WS_QX), (const LAS float*)rs};
        REP(6) pg8::gemm_phase<EpiQx, pg8::StaticOrder, true, QX_SP2>(ring, g, S, E);
    }
    SEAM(6);
    if (IN(7) && MS >= 3) { PHASE_PTRS; REP(7) for (int it = blockIdx.x; it < (T / 128) * 4; it += G) cross_item(pa, lds, it, tid, lane, wave); }
    SEAM(7);
    if (IN(8) && MS >= 3) { PHASE_PTRS;
        int kdyn = 256; asm volatile("" : "+s"(kdyn));
        pg8::Gemm g{(const pg8::bf16_t*)(ws + WS_OX), (const pg8::bf16_t*)(ws + WS_WOX), T, D, kdyn};
        pg8::StaticOrder S; S.init(T, D, G, (int)blockIdx.x);
        EpiOx E{(const bf16*)(ws + WS_X1B), (bf16*)(ws + WS_HBS)};
        REP(8) pg8::gemm_phase<EpiOx, pg8::StaticOrder, false, true>(ring, g, S, E);
    }
    SEAM(8);
    if (IN(9) && MS >= 4) { PHASE_PTRS; p9_route(pa, lds, tid, lane, wave); }
    SEAM(9);
    if (IN(10) && MS >= 4) { PHASE_PTRS; p10_slots(pa, lds, tid, lane, wave); }
    SEAM(10);
    if ((IN(11) || IN(12)) && MS >= 4) { PHASE_PTRS;
        int* tab = (int*)(lds + LDS_TAB);
        if (tid == 0) { int nrt = 0; const unsigned* cnt = (const unsigned*)(ws + WS_CTL) + CW_CNT;
            for (int i = 0; i < NBUCKET; ++i) { const int nt = (int)((__hip_atomic_load(cnt + i, __ATOMIC_RELAXED, __HIP_MEMORY_SCOPE_AGENT) + 255u) >> 8); for (int k = 0; k < nt; ++k) tab[1 + nrt++] = i; }
            tab[0] = nrt; }
        __syncthreads();
        const int nrt = tab[0];
        if (IN(11)) {
            pg8::Gemm g{(const pg8::bf16_t*)(ws + WS_HBS), (const pg8::bf16_t*)(ws + WS_W13), ROWS_MAX, 64 * 256, D, (const int*)(ws + WS_TOKMAP)};
            MoeOrder S{G, (int)blockIdx.x, nrt * 8, 8, tab + 1};
            EpiUp E{(bf16*)(ws + WS_ACT), (const float*)(ws + WS_WSORT)};
            REP(11) pg8::gemm_phase<EpiUp, MoeOrder, true, true, true>(ring, g, S, E);
        }
        SEAM(11);
        if (IN(12)) {
            pg8::Gemm g{(const pg8::bf16_t*)(ws + WS_ACT), (const pg8::bf16_t*)(ws + WS_W2P), ROWS_MAX, 96 * 256, D};
            MoeOrder S{G, (int)blockIdx.x, nrt * 4, 4, tab + 1};
#if FUSE_FINAL
            EpiDownNorm E{(const bf16*)(ws + WS_HBS), pa.out, (const int*)(ws + WS_TOKMAP), (const float*)(ws + WS_PAR) + PAR_GFIN, (float*)(ws + WS_XCH), (unsigned*)(ws + WS_CTL) + CW_SEAM, (LAS unsigned char*)(lds + LDS_EX)};
            pg8::gemm_phase<EpiDownNorm, MoeOrder, true, true>(ring, g, S, E);
#else
            EpiDown E{(const bf16*)(ws + WS_HBS), pa.out, (const int*)(ws + WS_TOKMAP)};
            REP(12) pg8::gemm_phase<EpiDown, MoeOrder, true, true>(ring, g, S, E);
#endif
        }
    }
    if (!FUSE_FINAL) SEAM(12);
    if (IN(13) && !FUSE_FINAL) { PHASE_PTRS; REP(13) p10_final(pa, (((DUP_MASK >> 13) & 1) && rep_ == 0) ? (float*)(ws + 544 * MiB) : pa.out, lane, wave); }
#ifdef DUMMY_LIVE
    asm volatile("" :: "v"(dl0), "v"(dl1), "v"(dl2), "v"(dl3), "v"(dl4), "v"(dl5), "v"(dl6), "v"(dl7));
#endif
#undef IN
#undef SEAM
}

extern "C" void kernel_launch(void* const* d_in, const int* in_sizes, int n_in, void* d_out, int out_size, void* d_ws, size_t ws_size, hipStream_t stream) {
    static int grid = 0;
    if (grid == 0) {
        if (n_in != 28 || out_size != T * D || ws_size < WS_END) { fprintf(stderr, "kernel_launch: unexpected problem (n_in %d, out %d, ws %zu)\n", n_in, out_size, ws_size); grid = -1; return; }
        int dev = 0, cus = 0, per_cu = 0;
        if (hipGetDevice(&dev) != hipSuccess || hipDeviceGetAttribute(&cus, hipDeviceAttributeMultiprocessorCount, dev) != hipSuccess) { grid = -1; return; }
        if (hipOccupancyMaxActiveBlocksPerMultiprocessor(&per_cu, (const void*)fwd_kernel, NTHR, 0) != hipSuccess || per_cu < 1) { fprintf(stderr, "kernel_launch: occupancy query failed (%d)\n", per_cu); per_cu = 1; }
        (void)hipGetLastError();
        grid = cus * (per_cu > 1 ? 1 : per_cu);
        if (grid > 256) grid = 256;
    }
    if (grid < 0) return;
    (void)hipMemsetAsync((char*)d_ws + WS_CTL, 0, CTL_ZERO_BYTES, stream);
    Args a{};
    for (int i = 0; i < 28; ++i) a.in[i] = d_in[i];
    a.out = (float*)d_out; a.ws = (unsigned char*)d_ws;
    if (N_LAUNCHES == 1) {
        a.ph_lo = 0; a.ph_hi = N_PHASES;
        void* kargs[] = {&a};
        hipError_t e = hipLaunchCooperativeKernel((const void*)fwd_kernel, dim3(grid), dim3(NTHR), kargs, 0, stream);
        if (e != hipSuccess) fprintf(stderr, "kernel_launch: cooperative launch failed: %s (grid %d)\n", hipGetErrorString(e), grid);
    } else {
        for (int p = 0; p < N_PHASES; ++p) { a.ph_lo = p; a.ph_hi = p + 1; hipLaunchKernelGGL(fwd_kernel, dim3(grid), dim3(NTHR), 0, stream, a); }
    }
}
```

```cpp
#include <hip/hip_runtime.h>
#include <cstdio>
#include <cstdint>
namespace pg8 {
#define PG8_LAS __attribute__((address_space(3)))
typedef unsigned short bf16_t;
typedef short bf16x8 __attribute__((ext_vector_type(8)));
typedef float f32x4 __attribute__((ext_vector_type(4)));
typedef unsigned u32x4 __attribute__((ext_vector_type(4)));
constexpr int BM = 256, BK = 64, HALF = 128, HTB = HALF * BK * 2  , STAGE_BYTES = 8 * HTB, NXCD = 8, WGM = 8;

__host__ __device__ __forceinline__ int lds_byte(int r, int c) { const int st = (r >> 4) * 2 + (c >> 5), rr = r & 15, cc = c & 31, ob = rr * 64 + cc * 2; return st * 1024 + (ob ^ (((ob >> 9) & 1) << 5)); }
__host__ __device__ __forceinline__ void stage_rc(int b, int& R, int& C) { const int st = b / 1024, sb = b % 1024, swz = sb ^ (((sb >> 9) & 1) << 5); R = (st >> 1) * 16 + swz / 64; C = (st & 1) * 32 + (swz % 64) / 2; }
__host__ __device__ __forceinline__ int perm32(int rho) { const int n = rho >> 4, i = rho & 15; return 8 * (i >> 2) + 4 * n + (i & 3); }

struct Unit { int pm, pn, aux; };
struct Gemm { const bf16_t* A; const bf16_t* Bt; int M, N, K; const int* rowmap; };

struct StaticOrder {
    int nM, nN, nwg, G, c;
    __host__ __device__ void init(int M, int N, int G_, int c_) { nM = M / BM; nN = N / BM; nwg = nM * nN; G = G_; c = c_; }
    __host__ __device__ bool next(int i, Unit& u) const {
        const long L = (long)i * G + c; if (L >= nwg) return false;
        int wgid = (int)L; { const int q = nwg / NXCD, r = nwg % NXCD, xcd = wgid % NXCD, off = wgid / NXCD; wgid = (xcd < r ? xcd * (q + 1) : r * (q + 1) + (xcd - r) * q) + off; }
        const int nig = WGM * nN, gid = wgid / nig, fm = gid * WGM, gsz = (nM - fm) < WGM ? (nM - fm) : WGM;
        u.pm = fm + ((wgid % nig) % gsz); u.pn = (wgid % nig) / gsz; u.aux = 0; return true;
    }
    __device__ __forceinline__ void a_ready(const Unit&) const {}
    __device__ __forceinline__ void done(const Unit&) const {}
};

__device__ __forceinline__ unsigned cvt_pk_bf16(float lo, float hi) { unsigned r; asm volatile("v_cvt_pk_bf16_f32 %0, %1, %2" : "=v"(r) : "v"(lo), "v"(hi)); return r; }
template <class Epi, class Sched, bool ALIGN_EPI = false, bool SP2 = false, bool GATHER = false>
__device__ __forceinline__ void gemm_phase(PG8_LAS unsigned char* lds, const Gemm g, const Sched& S, const Epi& E) {
    const int tid = threadIdx.x, wid = __builtin_amdgcn_readfirstlane(tid >> 6), lane = tid & 63, wr = wid >> 2, wc = wid & 3, fr = lane & 15, fq = lane >> 4;
    const int K = g.K, nt = K / BK;
    unsigned voffA[2], voffB[2];
#pragma unroll
    for (int i = 0; i < 2; ++i) { int R, C; stage_rc(tid * 16 + i * 8192, R, C); const int Rb = Epi::PERM ? ((R & ~31) + perm32(R & 31)) : R;
        voffA[i] = (unsigned)(R * K + C) * 2u; voffB[i] = (unsigned)(Rb * K + C) * 2u; }
    unsigned gc[2][2] = {{0u, 0u}, {0u, 0u}}, gn[2][2] = {{0u, 0u}, {0u, 0u}};
#define PG8_GLOAD(gv, pm_) do { _Pragma("unroll") for (int _h = 0; _h < 2; ++_h) _Pragma("unroll") for (int _i = 0; _i < 2; ++_i) { int _R, _C; stage_rc(tid * 16 + _i * 8192, _R, _C); \
        int _row = g.rowmap[(pm_) * BM + _h * HALF + _R]; _row = _row < 0 ? 0 : _row; gv[_h][_i] = (unsigned)(_row * K + _C) * 2u; } } while (0)
    const size_t kstep = (size_t)(BK * 2);
    const size_t hstep = (size_t)HALF * K * 2;
    const size_t tstep = 2 * hstep;
    const unsigned ldsw = (unsigned)wid * 1024u;
    const int aoff = lds_byte(wr * 64 + fr, fq * 8), boff = lds_byte(wc * 32 + fr, fq * 8);
#define PG8_SA(b, h) (((b) * 2 + (h)) * HTB)
#define PG8_SB(b, h) ((4 + (b) * 2 + (h)) * HTB)
#define PG8_STAGE(bufoff, gbase, voff) do { _Pragma("unroll") for (int _i = 0; _i < 2; ++_i) \
        __builtin_amdgcn_global_load_lds((const unsigned*)((const char*)(gbase) + (voff)[_i]), (PG8_LAS unsigned*)(lds + (bufoff) + ldsw + _i * 8192), 16, 0, 0); } while (0)
#define PG8_STAGE_A(bufoff, gbase, h, sel) do { if constexpr (GATHER) { unsigned vo_[2]; vo_[0] = (sel) ? gn[h][0] : gc[h][0]; vo_[1] = (sel) ? gn[h][1] : gc[h][1]; PG8_STAGE(bufoff, gbase, vo_); } \
        else { PG8_STAGE(bufoff, (gbase) + (h) * hstep, voffA); } } while (0)
#define PG8_LDA(dst, b, h) do { _Pragma("unroll") for (int m = 0; m < 4; ++m) _Pragma("unroll") for (int k = 0; k < 2; ++k) dst[m][k] = *(const PG8_LAS bf16x8*)(lds + PG8_SA(b, h) + aoff + m * 2048 + k * 1024); } while (0)
#define PG8_LDB(dst, b, h) do { _Pragma("unroll") for (int n = 0; n < 2; ++n) _Pragma("unroll") for (int k = 0; k < 2; ++k) dst[n][k] = *(const PG8_LAS bf16x8*)(lds + PG8_SB(b, h) + boff + n * 2048 + k * 1024); } while (0)
#define PG8_MMA(ai, bj, At, Bt) do { __builtin_amdgcn_s_setprio(1); _Pragma("unroll") for (int m = 0; m < 4; ++m) _Pragma("unroll") for (int n = 0; n < 2; ++n) _Pragma("unroll") for (int k = 0; k < 2; ++k) \
        acc[ai][bj][m][n] = __builtin_amdgcn_mfma_f32_16x16x32_bf16(Bt[n][k], At[m][k], acc[ai][bj][m][n], 0, 0, 0); __builtin_amdgcn_s_setprio(0); } while (0)
#define PG8_WAIT_V(n) asm volatile("s_waitcnt vmcnt(" #n ")" ::: "memory")
#define PG8_WAIT_L(n) asm volatile("s_waitcnt lgkmcnt(" #n ")" ::: "memory")
#define PG8_BAR __builtin_amdgcn_s_barrier()
#define PG8_SCHED __builtin_amdgcn_sched_barrier(0)
    Unit cur, nxt; int ui = 0;
    if (!S.next(0, cur)) return;
    f32x4 acc[2][2][4][2];
#pragma unroll
    for (int a = 0; a < 2; ++a)
#pragma unroll
        for (int b = 0; b < 2; ++b)
#pragma unroll
            for (int m = 0; m < 4; ++m)
#pragma unroll
                for (int n = 0; n < 2; ++n) acc[a][b][m][n] = (f32x4){0.f, 0.f, 0.f, 0.f};
    bf16x8 At[4][2], B0[2][2], B1[2][2];
    const char* cA = GATHER ? (const char*)g.A : (const char*)g.A + (size_t)cur.pm * tstep; const char* cB = (const char*)g.Bt + (size_t)cur.pn * tstep;
    if constexpr (GATHER) { PG8_GLOAD(gc, cur.pm); }
    S.a_ready(cur);
    if constexpr (SP2) {
        PG8_STAGE(PG8_SB(0, 0), cB, voffB); PG8_STAGE(PG8_SB(0, 1), cB + hstep, voffB); PG8_STAGE_A(PG8_SA(0, 0), cA, 0, false); PG8_STAGE_A(PG8_SA(0, 1), cA, 1, false);
        if (wr == 1) PG8_BAR;
        PG8_WAIT_V(2); PG8_BAR;
        PG8_STAGE(PG8_SB(1, 0), cB + kstep, voffB); PG8_STAGE_A(PG8_SA(1, 0), cA + kstep, 0, false); PG8_STAGE(PG8_SB(1, 1), cB + hstep + kstep, voffB);
        PG8_WAIT_V(6); PG8_BAR;
    } else {
        PG8_STAGE(PG8_SB(0, 0), cB, voffB); PG8_STAGE_A(PG8_SA(0, 0), cA, 0, false); PG8_STAGE(PG8_SB(0, 1), cB + hstep, voffB); PG8_STAGE_A(PG8_SA(0, 1), cA, 1, false);
        if (wr == 1) PG8_BAR;
        PG8_WAIT_V(4); PG8_BAR;
        PG8_STAGE(PG8_SB(1, 0), cB + kstep, voffB); PG8_STAGE_A(PG8_SA(1, 0), cA + kstep, 0, false); PG8_STAGE(PG8_SB(1, 1), cB + hstep + kstep, voffB);
        PG8_WAIT_V(6); PG8_BAR;
    }
    for (;;) {
        const bool has_next = S.next(ui + 1, nxt);
        const char* nA = GATHER ? cA : (has_next ? (const char*)g.A + (size_t)nxt.pm * tstep : cA);
        if constexpr (GATHER) { if (has_next) { PG8_GLOAD(gn, nxt.pm); } else { gn[0][0] = gc[0][0]; gn[0][1] = gc[0][1]; gn[1][0] = gc[1][0]; gn[1][1] = gc[1][1]; } }
        const char* nB = has_next ? (const char*)g.Bt + (size_t)nxt.pn * tstep : cB;
        for (int t = 0; t < nt; t += 2) {
            const bool last = (t == nt - 2);
            const char* a1 = cA + (size_t)(t + 1) * kstep;
            const char* a2 = last ? nA : cA + (size_t)(t + 2) * kstep; const char* b2 = last ? nB : cB + (size_t)(t + 2) * kstep;
            const char* a3 = a2 + kstep; const char* b3 = b2 + kstep;
            if (last && has_next) S.a_ready(nxt);
            if constexpr (SP2) {
            PG8_LDB(B0, 0, 0); PG8_LDB(B1, 0, 1); PG8_SCHED; PG8_LDA(At, 0, 0); PG8_STAGE_A(PG8_SA(1, 1), a1, 1, false);
            PG8_WAIT_V(8); PG8_WAIT_L(0); PG8_BAR; PG8_MMA(0, 0, At, B0); PG8_MMA(0, 1, At, B1); PG8_BAR; PG8_SCHED;
            PG8_LDA(At, 0, 1); PG8_STAGE(PG8_SB(0, 0), b2, voffB); PG8_STAGE(PG8_SB(0, 1), b2 + hstep, voffB); PG8_STAGE_A(PG8_SA(0, 0), a2, 0, last);
            PG8_WAIT_V(8); PG8_WAIT_L(0); PG8_BAR; PG8_MMA(1, 0, At, B0); PG8_MMA(1, 1, At, B1); PG8_BAR; PG8_SCHED;
            PG8_LDB(B0, 1, 0); PG8_LDB(B1, 1, 1); PG8_SCHED; PG8_LDA(At, 1, 0); PG8_STAGE_A(PG8_SA(0, 1), a2, 1, last);
            PG8_WAIT_V(8); PG8_WAIT_L(0); PG8_BAR; PG8_MMA(0, 0, At, B0); PG8_MMA(0, 1, At, B1); PG8_BAR; PG8_SCHED;
            PG8_LDA(At, 1, 1); PG8_STAGE(PG8_SB(1, 0), b3, voffB); PG8_STAGE(PG8_SB(1, 1), b3 + hstep, voffB); PG8_STAGE_A(PG8_SA(1, 0), a3, 0, last);
            PG8_WAIT_V(8); PG8_WAIT_L(0); PG8_BAR; PG8_MMA(1, 0, At, B0); PG8_MMA(1, 1, At, B1); PG8_BAR; PG8_SCHED;
            } else {
            PG8_LDB(B0, 0, 0); PG8_SCHED; PG8_LDA(At, 0, 0); PG8_STAGE_A(PG8_SA(1, 1), a1, 1, false);
            PG8_WAIT_L(8); PG8_BAR; PG8_WAIT_L(0); PG8_MMA(0, 0, At, B0); PG8_BAR; PG8_SCHED;
            PG8_LDB(B1, 0, 1); PG8_STAGE(PG8_SB(0, 0), b2, voffB);
            PG8_BAR; PG8_WAIT_L(0); PG8_MMA(0, 1, At, B1); PG8_BAR;
            PG8_LDA(At, 0, 1); PG8_STAGE_A(PG8_SA(0, 0), a2, 0, last);
            PG8_BAR; PG8_WAIT_L(0); PG8_MMA(1, 0, At, B0); PG8_BAR; PG8_SCHED;
            PG8_STAGE(PG8_SB(0, 1), b2 + hstep, voffB);
            PG8_WAIT_V(6); PG8_BAR; PG8_MMA(1, 1, At, B1); PG8_BAR;
            PG8_LDB(B0, 1, 0); PG8_SCHED; PG8_LDA(At, 1, 0); PG8_STAGE_A(PG8_SA(0, 1), a2, 1, last);
            PG8_WAIT_L(8); PG8_BAR; PG8_WAIT_L(0); PG8_MMA(0, 0, At, B0); PG8_BAR; PG8_SCHED;
            PG8_LDB(B1, 1, 1); PG8_STAGE(PG8_SB(1, 0), b3, voffB);
            PG8_BAR; PG8_WAIT_L(0); PG8_MMA(0, 1, At, B1); PG8_BAR;
            PG8_LDA(At, 1, 1); PG8_STAGE_A(PG8_SA(1, 0), a3, 0, last);
            PG8_BAR; PG8_WAIT_L(0); PG8_MMA(1, 0, At, B0); PG8_BAR; PG8_SCHED;
            PG8_STAGE(PG8_SB(1, 1), b3 + hstep, voffB);
            PG8_WAIT_V(6); PG8_BAR; PG8_MMA(1, 1, At, B1); PG8_BAR;
            }
        }
        if constexpr (ALIGN_EPI) { if (wr == 0) PG8_BAR; }
        if constexpr (!Epi::AFTER_DRAIN) { E(acc, cur, wr, wc, fr, fq); S.done(cur); }
        if (!has_next) break;
#pragma unroll
        for (int a = 0; a < 2; ++a)
#pragma unroll
            for (int b = 0; b < 2; ++b)
#pragma unroll
                for (int m = 0; m < 4; ++m)
#pragma unroll
                    for (int n = 0; n < 2; ++n) acc[a][b][m][n] = (f32x4){0.f, 0.f, 0.f, 0.f};
        cur = nxt; cA = nA; cB = nB; ++ui;
        if constexpr (GATHER) { gc[0][0] = gn[0][0]; gc[0][1] = gn[0][1]; gc[1][0] = gn[1][0]; gc[1][1] = gn[1][1]; }
        if constexpr (ALIGN_EPI) { if (wr == 1) PG8_BAR; }
    }
    PG8_WAIT_V(0);
    if constexpr (!ALIGN_EPI) { if (wr == 0) PG8_BAR; }
    PG8_BAR;
    if constexpr (Epi::AFTER_DRAIN) { E.fused(acc, cur, wr, wc, fr, fq, lds, wid, lane); S.done(cur); }
#undef PG8_SA
#undef PG8_SB
#undef PG8_STAGE
#undef PG8_STAGE_A
#undef PG8_GLOAD
#undef PG8_LDA
#undef PG8_LDB
#undef PG8_MMA
#undef PG8_WAIT_V
#undef PG8_WAIT_L
#undef PG8_BAR
#undef PG8_SCHED
}
}

#define GAS __attribute__((address_space(1)))
#define LAS __attribute__((address_space(3)))
typedef unsigned short bf16;
typedef unsigned v4u __attribute__((ext_vector_type(4)));
typedef unsigned v2u __attribute__((ext_vector_type(2)));
typedef float f32x4 __attribute__((ext_vector_type(4)));
typedef short bf16x8 __attribute__((ext_vector_type(8)));
typedef GAS unsigned gu32;

constexpr int NWAVES = 8, NTHR = 512;
constexpr int BATCH = 8, SEQ = 8192, T = BATCH * SEQ, D = 1024, MEMLEN = 256, TMEM = BATCH * MEMLEN;
constexpr int INW = 3080, NIN = 3072, NKV = 512;
constexpr int NBUCKET = 24, ROWS_MAX = T + NBUCKET * 256;
constexpr float EPSN = 1e-6f;
constexpr float C2 = 0.125f * 1.4426950408889634f;
constexpr float LOG2E = 1.4426950408889634f;

constexpr size_t MiB = 1u << 20;
constexpr size_t WS_CTL = 0, CTL_ZERO_BYTES = 1 * MiB;
constexpr size_t WS_ROPE = 2 * MiB;
constexpr size_t WS_IG = 6 * MiB;
constexpr size_t WS_FG = 7 * MiB;
constexpr size_t WS_LSE = 8 * MiB;
constexpr size_t WS_SS1 = 14 * MiB;
constexpr size_t WS_SS3 = 18 * MiB;
constexpr size_t WS_KVX = 22 * MiB;
constexpr size_t WS_NLOC = 24 * MiB;
constexpr size_t WS_NPREV = 25 * MiB;
constexpr size_t WS_MLOC = 26 * MiB;
constexpr size_t WS_BLAST = 26 * MiB + 64 * 1024;
constexpr size_t WS_MPREV = 26 * MiB + 128 * 1024;
constexpr size_t WS_TOKINFO = 27 * MiB;
constexpr size_t WS_TOKMAP = 28 * MiB;
constexpr size_t WS_WSORT = 19 * MiB;
constexpr size_t WS_WR = 30 * MiB;
constexpr size_t WS_WG = 30 * MiB + 512 * 1024;
constexpr size_t WS_PAR = 31 * MiB;
constexpr int PAR_CONVW = 0, PAR_CONVB = 2048, PAR_GMHN = 2560, PAR_SKIP = 3072, PAR_BRG = 3584, PAR_BRE = 3600, PAR_GFIN = 3616, PAR_N = 4640;
constexpr size_t WS_WIN = 32 * MiB;
constexpr size_t WS_WOUT = 39 * MiB;
constexpr size_t WS_WQX = 41 * MiB;
constexpr size_t WS_WOX = 41 * MiB + 512 * 1024;
constexpr size_t WS_WM = 42 * MiB;
constexpr size_t WS_W13 = 44 * MiB;
constexpr size_t WS_W2P = 76 * MiB;
constexpr size_t WS_XN = 128 * MiB;
constexpr size_t WS_CLOC = 128 * MiB;
constexpr size_t WS_Q = 264 * MiB;
constexpr size_t WS_K = 328 * MiB, WS_V = 392 * MiB, WS_MU = 456 * MiB, WS_MV = 520 * MiB, WS_MO = 584 * MiB;
constexpr size_t WS_MQ = 648 * MiB, WS_MK = 712 * MiB;
constexpr size_t WS_Y = 264 * MiB;
constexpr size_t WS_CPREV = 392 * MiB;
constexpr size_t WS_X1B = 648 * MiB;
constexpr size_t WS_QX = 776 * MiB;
constexpr size_t WS_OX = 808 * MiB;
constexpr size_t WS_HBS = 264 * MiB;
constexpr size_t WS_ACT = 404 * MiB;
constexpr size_t WS_END = 840 * MiB;
constexpr size_t DO_OATT = 0, DO_C = 192 * MiB;

constexpr int CW_BAR = 4096;
constexpr int CW_CNT = 8192;
constexpr int CW_FILL = 8192 + 64;

constexpr int LDS_BYTES = 163840;
constexpr int LDS_MISC = 159744;
constexpr int LDS_RS = 135168;
constexpr int LDS_TAB = 136192;

#define LDS_WAIT() asm volatile("s_waitcnt lgkmcnt(0)" ::: "memory")
#define VM_WAIT() asm volatile("s_waitcnt vmcnt(0)" ::: "memory")
__device__ __forceinline__ unsigned f2bf(float f) { unsigned u = __builtin_bit_cast(unsigned, f); return (u + 0x7fffu + ((u >> 16) & 1u)) >> 16; }
typedef float f32x2_t __attribute__((ext_vector_type(2))); typedef __bf16 bf16x2_t __attribute__((ext_vector_type(2)));
__device__ __forceinline__ unsigned pk2(float lo, float hi) { f32x2_t v = {lo, hi}; bf16x2_t b = __builtin_convertvector(v, bf16x2_t); return __builtin_bit_cast(unsigned, b); }
__device__ __forceinline__ float bf2f(unsigned h) { return __uint_as_float(h << 16); }
__device__ __forceinline__ float bflo(unsigned w) { return __uint_as_float(w << 16); }
__device__ __forceinline__ float bfhi(unsigned w) { return __uint_as_float(w & 0xffff0000u); }
__device__ __forceinline__ float wave_sum(float v) {
#pragma unroll
    for (int o = 1; o < 64; o <<= 1) v += __shfl_xor(v, o);
    return v;
}
__device__ __forceinline__ float wave_max(float v) {
#pragma unroll
    for (int o = 1; o < 64; o <<= 1) v = fmaxf(v, __shfl_xor(v, o));
    return v;
}
__device__ __forceinline__ float sigmoidf_(float x) { return 1.0f / (1.0f + __expf(-x)); }

#define XB_TMO      128
#define XB_XCNT(j)  (256  + 64 * (j))
#define XB_XSUB(j)  (1280 + 64 * (j))
#define XB_XGEN(j)  (2304 + 64 * (j))
#define XB_TOP      3328
#define XB_TOPGEN   3392
#define XCD_BAR_WORDS 3456
#define XB_SPIN_CAP (1u << 22)
__device__ __forceinline__ unsigned xb_ld(unsigned* p)              { return __hip_atomic_load(p, __ATOMIC_RELAXED, __HIP_MEMORY_SCOPE_AGENT); }
__device__ __forceinline__ unsigned xb_add(unsigned* p, unsigned v) { return __hip_atomic_fetch_add(p, v, __ATOMIC_RELAXED, __HIP_MEMORY_SCOPE_AGENT); }
__device__ __forceinline__ unsigned xb_xcc_id() { return (unsigned)__builtin_amdgcn_s_getreg((3 << 11) | 20) & 0xFu; }
#define XB_SPIN(cond, bar) do { unsigned _sp = 0; while (cond) { __builtin_amdgcn_s_sleep(1); \
    if ((++_sp & 255u) == 0u) { if (xb_ld(&(bar)[XB_TMO])) break; if (_sp > XB_SPIN_CAP) { atomicAdd(&(bar)[XB_TMO], 1u); break; } } } } while (0)
struct XcdBarrier { unsigned* bar; unsigned x; volatile LAS unsigned* st; };
__device__ __forceinline__ XcdBarrier xcd_barrier_post(unsigned* bar, volatile LAS unsigned* st) {
    XcdBarrier b; b.bar = bar; b.x = xb_xcc_id(); b.st = st;
    if (threadIdx.x == 0) (void)xb_add(&bar[XB_XCNT(b.x)], 1u);
    return b;
}
__device__ __forceinline__ void xcd_barrier_complete(unsigned* bar, unsigned x, unsigned& nloc, unsigned& nx) {
    const unsigned G = gridDim.x * gridDim.y * gridDim.z;
    unsigned sum, cnt, mine, sp = 0u;
    for (;;) {
        sum = 0u; cnt = 0u; mine = 0u;
#pragma unroll
        for (unsigned j = 0; j < 16; ++j) { const unsigned c = xb_ld(&bar[XB_XCNT(j)]); sum += c; cnt += (c > 0u) ? 1u : 0u; mine = (j == x) ? c : mine; }
        if (sum == G) break;
        __builtin_amdgcn_s_sleep(1);
        if ((++sp & 255u) == 0u) { if (xb_ld(&bar[XB_TMO])) break; if (sp > XB_SPIN_CAP) { atomicAdd(&bar[XB_TMO], 1u); break; } }
    }
    nloc = mine > 0u ? mine : 1u; nx = cnt > 0u ? cnt : 1u;
}
__device__ __forceinline__ void xcd_barrier(const XcdBarrier& b) {
    asm volatile("s_waitcnt vmcnt(0)" ::: "memory");
    __syncthreads();
    if (threadIdx.x == 0) {
        unsigned* bar = b.bar;
        __builtin_amdgcn_s_waitcnt(0);
        unsigned nloc = b.st[0], nx = b.st[1];
        if (nloc == 0u) { xcd_barrier_complete(bar, b.x, nloc, nx); b.st[0] = nloc; b.st[1] = nx; }
        const unsigned old = xb_add(&bar[XB_XSUB(b.x)], 1u);
        const unsigned gen = old / nloc;
        if (old + 1u == (gen + 1u) * nloc) {
            __builtin_amdgcn_fence(__ATOMIC_RELEASE, "agent");
            asm volatile("s_waitcnt vmcnt(0)" ::: "memory");
            const unsigned og = xb_add(&bar[XB_TOP], 1u);
            const unsigned tg = og / nx;
            if (og + 1u == (tg + 1u) * nx) xb_add(&bar[XB_TOPGEN], 1u);
            else XB_SPIN(xb_ld(&bar[XB_TOPGEN]) == tg, bar);
            __builtin_amdgcn_fence(__ATOMIC_ACQUIRE, "agent");
            xb_add(&bar[XB_XGEN(b.x)], 1u);
            asm volatile("s_waitcnt vmcnt(0)" ::: "memory");
        } else {
            XB_SPIN(xb_ld(&bar[XB_XGEN(b.x)]) == gen, bar);
            __builtin_amdgcn_fence(__ATOMIC_ACQUIRE, "agent");
            asm volatile("s_waitcnt vmcnt(0)" ::: "memory");
        }
    }
    __syncthreads();
}

struct Args { const void* in[28]; float* out; unsigned char* ws; int ph_lo, ph_hi; };

template <int MI, int NJ>
__device__ __forceinline__ void wave_mma(const bf16* A, int lda, const bf16* Bt, int ldb, int K, f32x4 (&acc)[MI][NJ], int fr, int fq) {
    for (int k0 = 0; k0 < K; k0 += 32) {
        bf16x8 a[MI], b[NJ];
#pragma unroll
        for (int i = 0; i < MI; ++i) a[i] = *(const bf16x8*)(A + (16 * i + fr) * lda + k0 + 8 * fq);
#pragma unroll
        for (int j = 0; j < NJ; ++j) b[j] = *(const bf16x8*)(Bt + (16 * j + fr) * ldb + k0 + 8 * fq);
#pragma unroll
        for (int i = 0; i < MI; ++i)
#pragma unroll
            for (int j = 0; j < NJ; ++j) acc[i][j] = __builtin_amdgcn_mfma_f32_16x16x32_bf16(b[j], a[i], acc[i][j], 0, 0, 0);
    }
}

__device__ __forceinline__ void transpose_item(const float* src, int src_ld, int k0, int n0, bf16* dst, int dst_ld, int dst_row0, int dst_col0,
                                               const float* gain, float scale, LAS float* scr, int lane) {
    f32x4 ld[16];
#pragma unroll
    for (int i = 0; i < 16; ++i) { const int kk = 4 * i + (lane >> 4); ld[i] = *(const f32x4*)(src + (size_t)(k0 + kk) * src_ld + n0 + 4 * (lane & 15)); }
#pragma unroll
    for (int i = 0; i < 16; ++i) { const int kk = 4 * i + (lane >> 4); *(LAS f32x4*)(scr + kk * 64 + 4 * ((lane & 15) ^ ((kk >> 3) & 15))) = ld[i]; }
    const int c = lane & 7;
    f32x4 g0 = (f32x4){scale, scale, scale, scale}, g1 = g0;
    if (gain) { g0 = *(const f32x4*)(gain + k0 + 8 * c) * scale; g1 = *(const f32x4*)(gain + k0 + 8 * c + 4) * scale; }
    LDS_WAIT(); asm volatile("" ::: "memory");
#pragma unroll
    for (int j = 0; j < 8; ++j) { const int n = (lane >> 3) + 8 * j; const LAS float* s = scr + (8 * c) * 64 + 4 * ((n >> 2) ^ c) + (n & 3);
        v4u o; o.x = pk2(s[0 * 64] * g0[0], s[1 * 64] * g0[1]); o.y = pk2(s[2 * 64] * g0[2], s[3 * 64] * g0[3]); o.z = pk2(s[4 * 64] * g1[0], s[5 * 64] * g1[1]); o.w = pk2(s[6 * 64] * g1[2], s[7 * 64] * g1[3]);
        *(v4u*)(dst + (size_t)(dst_row0 + n) * dst_ld + dst_col0 + 8 * c) = o; }
    LDS_WAIT(); asm volatile("" ::: "memory");
}

__device__ __forceinline__ void p0_prologue(const Args& A, unsigned char* lds, int tid, int lane, int wave) {
    unsigned char* ws = A.ws;
    const float* x = (const float*)A.in[0]; const float* mem = (const float*)A.in[1]; const int* positions = (const int*)A.in[2];
    const float* g_mix = (const float*)A.in[3]; const float* w_in = (const float*)A.in[4];
    const float* w_q_m = (const float*)A.in[7]; const float* w_k_m = (const float*)A.in[8];
    const float* b_i = (const float*)A.in[9]; const float* b_f = (const float*)A.in[10];
    const float* w_out = (const float*)A.in[13]; const float* g_cross = (const float*)A.in[14]; const float* g_mem = (const float*)A.in[15];
    const float* w_q_x = (const float*)A.in[16]; const float* w_kv_x = (const float*)A.in[17]; const float* w_o_x = (const float*)A.in[18];
    const float* g_ffn = (const float*)A.in[19]; const float* w_rg = (const float*)A.in[20]; const float* w_re = (const float*)A.in[22];
    const float* w1 = (const float*)A.in[24]; const float* w3 = (const float*)A.in[25]; const float* w2 = (const float*)A.in[26];
    const int G = gridDim.x, gw = blockIdx.x * NWAVES + wave, NGW = G * NWAVES, gt = blockIdx.x * NTHR + tid, NGT = G * NTHR;

    LAS float* WGl = (LAS float*)lds;
    for (int i = tid; i < 8 * 1024; i += NTHR) { const int k = i >> 3, j = i & 7; WGl[j * 1024 + k] = g_mix[k] * w_in[(size_t)k * INW + NIN + j]; }

    for (int i = gt; i < PAR_N; i += NGT) { float v;
        if (i < PAR_CONVB) v = ((const float*)A.in[5])[i]; else if (i < PAR_GMHN) v = ((const float*)A.in[6])[i - PAR_CONVB]; else if (i < PAR_SKIP) v = ((const float*)A.in[11])[i - PAR_GMHN];
        else if (i < PAR_BRG) v = ((const float*)A.in[12])[i - PAR_SKIP]; else if (i < PAR_BRE) v = ((const float*)A.in[21])[i - PAR_BRG]; else if (i < PAR_GFIN) v = ((const float*)A.in[23])[i - PAR_BRE];
        else v = ((const float*)A.in[27])[i - PAR_GFIN];
        ((float*)(ws + WS_PAR))[i] = v; }
    for (int i = gt; i < 20 * 1024; i += NGT) { const int e = i >> 10, k = i & 1023;
        ((float*)(ws + WS_WR))[i] = g_ffn[k] * (e < 4 ? w_rg[k * 4 + e] : w_re[k * 16 + (e - 4)]); }
    for (int i = gt; i < T * 8; i += NGT) { const int t = i >> 3, j = i & 7; const float invf = powf(500000.0f, -(float)j * 0.125f);
        const float ang = (float)positions[t] * invf; float sn, cs; sincosf(ang, &sn, &cs);
        ((float*)(ws + WS_ROPE))[t * 16 + j] = cs; ((float*)(ws + WS_ROPE))[t * 16 + 8 + j] = sn; }
    __syncthreads();
    for (int m0 = 2 * gw; m0 < T + TMEM; m0 += 2 * NGW) {
        f32x4 v[2][4]; float rstd[2];
#pragma unroll
        for (int q = 0; q < 2; ++q) { const int m = m0 + q; const f32x4* xr = (const f32x4*)(m >= T ? mem + (size_t)(m - T) * D : x + (size_t)m * D) + lane;
#pragma unroll
            for (int j = 0; j < 4; ++j) v[q][j] = xr[64 * j]; }
#pragma unroll
        for (int q = 0; q < 2; ++q) { float s = 0.f;
#pragma unroll
            for (int j = 0; j < 4; ++j) s += (v[q][j].x * v[q][j].x + v[q][j].y * v[q][j].y) + (v[q][j].z * v[q][j].z + v[q][j].w * v[q][j].w);
            rstd[q] = 1.0f / sqrtf(wave_sum(s) * (1.0f / D) + EPSN);
            unsigned long long* o8 = (unsigned long long*)(ws + WS_XN + (size_t)(m0 + q) * D * 2) + lane;
#pragma unroll
            for (int j = 0; j < 4; ++j) o8[64 * j] = (unsigned long long)pk2(v[q][j].x * rstd[q], v[q][j].y * rstd[q]) | ((unsigned long long)pk2(v[q][j].z * rstd[q], v[q][j].w * rstd[q]) << 32); }
        if (m0 < T) {
            float val0 = 0.f, val1 = 0.f;
#pragma unroll
            for (int g = 0; g < 8; ++g) { float a0 = 0.f, a1 = 0.f;
#pragma unroll
                for (int j = 0; j < 4; ++j) { const f32x4 w = *(const LAS f32x4*)(WGl + g * 1024 + 256 * j + 4 * lane);
                    a0 += (v[0][j].x * w.x + v[0][j].y * w.y) + (v[0][j].z * w.z + v[0][j].w * w.w); a1 += (v[1][j].x * w.x + v[1][j].y * w.y) + (v[1][j].z * w.z + v[1][j].w * w.w); }
                a0 = wave_sum(a0) * rstd[0]; a1 = wave_sum(a1) * rstd[1];
                val0 = (lane == g) ? a0 : val0; val1 = (lane == g) ? a1 : val1; }
            if (lane < 8) { const int h = lane & 3;
#pragma unroll
                for (int q = 0; q < 2; ++q) { const int m = m0 + q, b = m / SEQ, sq = m % SEQ; const float val = q ? val1 : val0;
                    if (lane < 4) ((float*)(ws + WS_IG))[(size_t)(b * 4 + h) * SEQ + sq] = val + b_i[h];
                    else ((float*)(ws + WS_FG))[(size_t)(b * 4 + h) * SEQ + sq] = val + b_f[h]; } }
        }
    }
    __syncthreads();
    LAS float* scr = (LAS float*)(lds + wave * 16384);
    constexpr int I_IN = 16 * 48, I_KV = 16 * 8, I_OUT = 16 * 16, I_QX = 16 * 4, I_OX = 4 * 16, I_M = 32, I_13 = 16 * 2 * 128, I_2P = 24 * 2 * 128;
    constexpr int NITEMS = I_IN + I_KV + I_OUT + I_QX + I_OX + I_M + I_13 + I_2P;
    for (int it = gw; it < NITEMS; it += NGW) {
        int r = it;
        if (r < I_IN) { const int kb = r / 48, nb = r % 48; transpose_item(w_in, INW, 64 * kb, 64 * nb, (bf16*)(ws + WS_WIN), 1024, 64 * nb, 64 * kb, g_mix, (64 * nb < 512) ? C2 : 1.0f, scr, lane); continue; } r -= I_IN;
        if (r < I_KV) { const int kb = r / 8, nb = r % 8; transpose_item(w_kv_x, 512, 64 * kb, 64 * nb, (bf16*)(ws + WS_WIN), 1024, NIN + 64 * nb, 64 * kb, g_mem, 1.0f, scr, lane); continue; } r -= I_KV;
        if (r < I_OUT) { const int kb = r / 16, nb = r % 16; transpose_item(w_out, 1024, 64 * kb, 64 * nb, (bf16*)(ws + WS_WOUT), 1024, 64 * nb, 64 * kb, nullptr, 1.0f, scr, lane); continue; } r -= I_OUT;
        if (r < I_QX) { const int kb = r / 4, nb = r % 4; transpose_item(w_q_x, 256, 64 * kb, 64 * nb, (bf16*)(ws + WS_WQX), 1024, 64 * nb, 64 * kb, g_cross, C2, scr, lane); continue; } r -= I_QX;
        if (r < I_OX) { const int kb = r / 16, nb = r % 16; transpose_item(w_o_x, 1024, 64 * kb, 64 * nb, (bf16*)(ws + WS_WOX), 256, 64 * nb, 64 * kb, nullptr, 1.0f, scr, lane); continue; } r -= I_OX;
        if (r < I_M) { const int which = r / 16, h = (r % 16) / 4, kb = (r % 4) / 2, nb = r % 2;
            transpose_item((which ? w_k_m : w_q_m) + (size_t)h * 128 * 128, 128, 64 * kb, 64 * nb, (bf16*)(ws + WS_WM) + (size_t)(which * 4 + h) * 128 * 128, 128, 64 * nb, 64 * kb, nullptr,
                           which ? 0.08838834764831845f : 1.0f, scr, lane); continue; } r -= I_M;
        if (r < I_13) { const int e = r / 256, which = (r % 256) / 128, kb = (r % 128) / 8, nb = r % 8; const int n0 = 64 * nb;
            transpose_item((which ? w3 : w1) + (size_t)e * 1024 * 512, 512, 64 * kb, n0, (bf16*)(ws + WS_W13) + (size_t)e * 1024 * 1024, 1024, (n0 / 128) * 256 + which * 128 + (n0 % 128), 64 * kb, g_ffn, 1.0f, scr, lane); continue; } r -= I_13;
        { const int bk = r / 256, hf = (r % 256) / 128, kb = (r % 128) / 16, nb = r % 16; const int g = bk / 6, p = bk % 6;
          const int pa = (p < 3) ? 0 : (p < 5 ? 1 : 2), pb = (p < 3) ? p + 1 : (p < 5 ? p - 1 : 3); const int e = 4 * g + (hf ? pb : pa);
          transpose_item(w2 + (size_t)e * 512 * 1024, 1024, 64 * kb, 64 * nb, (bf16*)(ws + WS_W2P) + (size_t)bk * 1024 * 1024, 1024, 64 * nb, hf * 512 + 64 * kb, nullptr, 1.0f, scr, lane); }
    }
}

struct InProjOrder {
    pg8::StaticOrder so;
    __device__ __forceinline__ bool next(int i, pg8::Unit& u) const {
        if (so.next(i, u)) return true;
        const long L = (long)i * so.G + so.c - so.nwg;
        if (L >= 0 && L < 16) { u.pm = 256 + (int)(L >> 1); u.pn = 12 + (int)(L & 1); u.aux = 1; return true; }
        return false;
    }
    __device__ __forceinline__ void a_ready(const pg8::Unit&) const {}
    __device__ __forceinline__ void done(const pg8::Unit&) const {}
};
__device__ __forceinline__ v4u pack8(const f32x4& a, const f32x4& b) { v4u w; w.x = pk2(a[0], a[1]); w.y = pk2(a[2], a[3]); w.z = pk2(b[0], b[1]); w.w = pk2(b[2], b[3]); return w; }
struct EpiInProj {
    static constexpr bool PERM = true, AFTER_DRAIN = false;
    bf16* base; bf16* kvx; const float* rope;
    __device__ __forceinline__ void operator()(const f32x4 (&acc)[2][2][4][2], const pg8::Unit& u, int wr, int wc, int fr, int fq) const {
        if (u.aux) {
            const int row0 = (u.pm - 256) * 256 + wr * 64 + fr, col0 = (u.pn - 12) * 256 + wc * 32 + 8 * fq;
#pragma unroll
            for (int ai = 0; ai < 2; ++ai)
#pragma unroll
                for (int m = 0; m < 4; ++m) { bf16* rowp = kvx + (size_t)(row0 + ai * 128 + m * 16) * NKV + col0;
#pragma unroll
                    for (int bj = 0; bj < 2; ++bj) *(v4u*)(rowp + bj * 128) = pack8(acc[ai][bj][m][0], acc[ai][bj][m][1]); }
            return;
        }
        const int buf = u.pn >> 1; bf16* B = base + (size_t)buf * T * 512;
        const int row0 = u.pm * 256 + wr * 64 + fr, col0 = (u.pn & 1) * 256 + wc * 32 + 8 * fq;
        const bool dorope = (buf < 2) && ((wc & 1) == 0);
#pragma unroll
        for (int ai = 0; ai < 2; ++ai)
#pragma unroll
            for (int m = 0; m < 4; ++m) { const int row = row0 + ai * 128 + m * 16; bf16* rowp = B + (size_t)row * 512 + col0;
                f32x4 cs0, cs1, sn0, sn1;
                if (dorope) { const f32x4* rp = (const f32x4*)(rope + (size_t)row * 16); cs0 = rp[0]; cs1 = rp[1]; sn0 = rp[2]; sn1 = rp[3]; }
#pragma unroll
                for (int bj = 0; bj < 2; ++bj) { f32x4 v0 = acc[ai][bj][m][0], v1 = acc[ai][bj][m][1];
                    if (dorope) { f32x4 o0, o1;
#pragma unroll
                        for (int i = 0; i < 4; ++i) { o0[i] = __shfl_xor(v0[i], 16); o1[i] = __shfl_xor(v1[i], 16); }
                        if (fq == 0) { v0 = v0 * cs0 - o0 * sn0; v1 = v1 * cs1 - o1 * sn1; }
                        else if (fq == 1) { v0 = v0 * cs0 + o0 * sn0; v1 = v1 * cs1 + o1 * sn1; } }
                    *(v4u*)(rowp + bj * 128) = pack8(v0, v1); } }
    }
};

typedef short v4i16_t __attribute__((ext_vector_type(4)));
struct AttItem { int cfg, b, h, d, nb; size_t tokb; };
__device__ __forceinline__ AttItem attn_decode(int item) {
    AttItem a; a.cfg = item >> 12; int rem = item & 4095; a.b = rem >> 9; rem &= 511; a.h = rem >> 6; const int sub = rem & 63;
    a.d = (a.cfg == 0) ? 1 : (a.cfg == 1 ? 4 : 16); const int nblk = 64 / a.d, r = sub / nblk; a.nb = sub % nblk; a.tokb = (size_t)a.b * SEQ + r; return a;
}
__device__ __forceinline__ int attn_item_of(int k, int G) {
    if (G != 256) return (int)blockIdx.x + k * G;
    const int pair = (int)(blockIdx.x & 7) + 8 * (k / 6), j = (int)(blockIdx.x >> 3), ip = j * 6 + (k % 6);
    return ((ip >> 6) << 12) | (pair << 6) | (ip & 63);
}
__device__ __forceinline__ void glds16(const void* gsrc, unsigned lds_dst) { unsigned keep;
    asm volatile("s_mov_b32 %0, m0\n\ts_mov_b32 m0, %2\n\ts_nop 0\n\tglobal_load_lds_dwordx4 %1, off\n\ts_mov_b32 m0, %0" : "=&s"(keep) : "v"(gsrc), "s"(lds_dst) : "memory"); }
__device__ __forceinline__ unsigned lds_addr_of(LAS unsigned char* p) { return (unsigned)(uintptr_t)p; }
__device__ __forceinline__ void attn_prefetch(const Args& A, LAS unsigned char* L, int item, int pslot, int oslot, bool load_prev, int lane, int wave, bf16x8 (&qf)[2]) {
    const AttItem a = attn_decode(item);
    const bf16* Kg = (const bf16*)(A.ws + WS_K) + a.h * 64; const bf16* Vg = (const bf16*)(A.ws + WS_V) + a.h * 64; const bf16* Qg = (const bf16*)(A.ws + WS_Q) + a.h * 64;
#pragma unroll
    for (int i = 0; i < 2; ++i) { const int inst = wave + 8 * i, row = 8 * inst + (lane >> 3);
        const size_t off = (a.tokb + (size_t)(128 * a.nb + row) * a.d) * 512 + ((lane & 7) ^ (lane >> 3)) * 8;
        glds16(Kg + off, (unsigned)__builtin_amdgcn_readfirstlane(lds_addr_of(L + oslot * 32768 + inst * 1024)));
        glds16(Vg + off, (unsigned)__builtin_amdgcn_readfirstlane(lds_addr_of(L + oslot * 32768 + 16384 + inst * 1024))); }
    if (load_prev) {
#pragma unroll
        for (int i = 0; i < 2; ++i) { const int inst = wave + 8 * i, row = 8 * inst + (lane >> 3);
            const size_t off = (a.tokb + (size_t)(128 * (a.nb - 1) + row) * a.d) * 512 + ((lane & 7) ^ (lane >> 3)) * 8;
            glds16(Kg + off, (unsigned)__builtin_amdgcn_readfirstlane(lds_addr_of(L + pslot * 32768 + inst * 1024)));
            glds16(Vg + off, (unsigned)__builtin_amdgcn_readfirstlane(lds_addr_of(L + pslot * 32768 + 16384 + inst * 1024))); } }
    const size_t tq = a.tokb + (size_t)(128 * a.nb + 16 * wave + (lane & 15)) * a.d;
    qf[0] = *(const bf16x8*)(Qg + tq * 512 + 8 * (lane >> 4)); qf[1] = *(const bf16x8*)(Qg + tq * 512 + 32 + 8 * (lane >> 4));
}
__device__ __forceinline__ void attn_compute(const Args& A, LAS unsigned char* L, int item, int pslot, int oslot, int lane, int wave, const bf16x8 (&qf)[2]) {
    const AttItem a = attn_decode(item);
    const int fr = lane & 15, g = lane >> 4, qi = 16 * wave + fr;
    f32x4 s[10];
#pragma unroll
    for (int tt = 0; tt < 9; ++tt) { const int t = wave + tt, key = 16 * (t & 7) + fr; LAS unsigned char* kb = L + ((t < 8) ? pslot : oslot) * 32768; s[tt] = (f32x4){0.f, 0.f, 0.f, 0.f};
#pragma unroll
        for (int ks = 0; ks < 2; ++ks) { const bf16x8 kf = *(const LAS bf16x8*)(kb + key * 128 + (((4 * ks + g) ^ (key & 7)) * 16));
            s[tt] = __builtin_amdgcn_mfma_f32_16x16x32_bf16(kf, qf[ks], s[tt], 0, 0, 0); } }
    s[9] = (f32x4){0.f, 0.f, 0.f, 0.f};
#pragma unroll
    for (int e = 0; e < 4; ++e) { s[0][e] = (4 * g + e >= fr) ? s[0][e] : -1e30f; s[8][e] = (4 * g + e <= fr) ? s[8][e] : -1e30f; }
    if (a.nb == 0) {
#pragma unroll
        for (int tt = 0; tt < 8; ++tt) if (wave + tt < 8) s[tt] = (f32x4){-1e30f, -1e30f, -1e30f, -1e30f};
    }
    float mx = -1e30f;
#pragma unroll
    for (int tt = 0; tt < 9; ++tt) mx = fmaxf(fmaxf(mx, fmaxf(s[tt][0], s[tt][1])), fmaxf(s[tt][2], s[tt][3]));
    mx = fmaxf(mx, __shfl_xor(mx, 16)); mx = fmaxf(mx, __shfl_xor(mx, 32));
    float l = 0.f;
#pragma unroll
    for (int tt = 0; tt < 9; ++tt)
#pragma unroll
        for (int e = 0; e < 4; ++e) { s[tt][e] = __builtin_amdgcn_exp2f(s[tt][e] - mx); l += s[tt][e]; }
    l += __shfl_xor(l, 16); l += __shfl_xor(l, 32);
    f32x4 o[4];
#pragma unroll
    for (int dt = 0; dt < 4; ++dt) o[dt] = (f32x4){0.f, 0.f, 0.f, 0.f};
#pragma unroll
    for (int k5 = 0; k5 < 5; ++k5) {
        const v4u pw = (v4u){pk2(s[2 * k5][0], s[2 * k5][1]), pk2(s[2 * k5][2], s[2 * k5][3]), pk2(s[2 * k5 + 1][0], s[2 * k5 + 1][1]), pk2(s[2 * k5 + 1][2], s[2 * k5 + 1][3])};
        const bf16x8 pf = __builtin_bit_cast(bf16x8, pw);
        const int t0 = wave + 2 * k5, t1 = (wave + 2 * k5 + 1 < 16) ? wave + 2 * k5 + 1 : 15;
        const int r0 = 16 * (t0 & 7) + 4 * g + (fr >> 2), r1 = 16 * (t1 & 7) + 4 * g + (fr >> 2), p_ = fr & 3;
        LAS unsigned char* v0b = L + ((t0 < 8) ? pslot : oslot) * 32768 + 16384; LAS unsigned char* v1b = L + ((t1 < 8) ? pslot : oslot) * 32768 + 16384;
#pragma unroll
        for (int dt = 0; dt < 4; ++dt) { const int chunk = 2 * dt + (p_ >> 1);
            const v4i16_t v0 = __builtin_amdgcn_ds_read_tr16_b64_v4i16((LAS v4i16_t*)(v0b + r0 * 128 + ((chunk ^ (r0 & 7)) * 16) + 8 * (p_ & 1)));
            const v4i16_t v1 = __builtin_amdgcn_ds_read_tr16_b64_v4i16((LAS v4i16_t*)(v1b + r1 * 128 + ((chunk ^ (r1 & 7)) * 16) + 8 * (p_ & 1)));
            const bf16x8 vf = (bf16x8){v0[0], v0[1], v0[2], v0[3], v1[0], v1[1], v1[2], v1[3]};
            o[dt] = __builtin_amdgcn_mfma_f32_16x16x32_bf16(vf, pf, o[dt], 0, 0, 0); } }
    const float rl = 1.0f / l;
    const size_t tok = a.tokb + (size_t)(128 * a.nb + qi) * a.d;
    bf16* og = (bf16*)((unsigned char*)A.out + DO_OATT) + ((size_t)a.cfg * T + tok) * 512 + a.h * 64;
#pragma unroll
    for (int dt = 0; dt < 4; ++dt) *(v2u*)(og + 16 * dt + 4 * g) = (v2u){pk2(o[dt][0] * rl, o[dt][1] * rl), pk2(o[dt][2] * rl, o[dt][3] * rl)};
    if (g == 0) ((float*)(A.ws + WS_LSE))[((size_t)a.cfg * T + tok) * 8 + a.h] = mx + __builtin_amdgcn_logf(l);
}
__device__ __forceinline__ void attn_phase(const Args& A, unsigned char* lds, int n_total, int lane, int wave) {
    const int G = gridDim.x; LAS unsigned char* L = (LAS unsigned char*)lds;
    const int nk = (G == 256) ? n_total / 256 : (n_total - (int)blockIdx.x + G - 1) / G;
    if (nk <= 0) return;
    bf16x8 qa[2], qb[2];
    int it = attn_item_of(0, G); int ps, os;
    { const AttItem a = attn_decode(it); os = 0; ps = (a.nb > 0) ? 1 : 0; attn_prefetch(A, L, it, ps, os, a.nb > 0, lane, wave, qa); }
    for (int k = 0; k < nk; ++k) {
        __builtin_amdgcn_s_waitcnt(0x0F70);
        asm volatile("s_waitcnt vmcnt(0)" ::: "memory");
        __syncthreads();
        qb[0] = qa[0]; qb[1] = qa[1];
        int nit = it, nps = ps, nos = os;
        if (k + 1 < nk) { nit = attn_item_of(k + 1, G); const AttItem c = attn_decode(it), n = attn_decode(nit);
            const bool succ = (nit == it + 1) && (n.nb == c.nb + 1);
            const int used = (1 << ps) | (1 << os); const int f1 = (used & 1) ? ((used & 2) ? ((used & 4) ? 3 : 2) : 1) : 0; const int used2 = used | (1 << f1);
            const int f2 = (used2 & 1) ? ((used2 & 2) ? ((used2 & 4) ? 3 : 2) : 1) : 0;
            bool lp;
            if (succ) { nps = os; nos = f1; lp = false; } else if (n.nb == 0) { nos = f1; nps = f1; lp = false; } else { nps = f1; nos = f2; lp = true; }
            attn_prefetch(A, L, nit, nps, nos, lp, lane, wave, qb); }
        attn_compute(A, L, it, ps, os, lane, wave, qa);
        qa[0] = qb[0]; qa[1] = qb[1]; it = nit; ps = nps; os = nos;
    }
    asm volatile("s_waitcnt vmcnt(0)" ::: "memory");
    __syncthreads();
}

constexpr int ML_TILE = 32768;
constexpr int ML_G = 4 * ML_TILE;
static_assert(ML_G + 8192 <= LDS_MISC, "mlstm LDS");
__device__ __forceinline__ int sw_off(int row, int ch) { return 256 * row + 16 * (ch ^ (((row & 3) << 2) | ((row >> 2) & 3))); }
__device__ __forceinline__ bf16x8 rowfrag(LAS unsigned char* tile, int row0, int ks, int fr, int g) { return *(const LAS bf16x8*)(tile + sw_off(row0 + fr, 4 * ks + g)); }
__device__ __forceinline__ bf16x8 colfrag(LAS unsigned char* tile, int ks, int ct, int fr, int g) {
    const int r0 = 32 * ks + 8 * g + (fr >> 2), p = fr & 3, ch = 2 * ct + (p >> 1);
    const v4i16_t a = __builtin_amdgcn_ds_read_tr16_b64_v4i16((LAS v4i16_t*)(tile + sw_off(r0, ch) + 8 * (p & 1)));
    const v4i16_t b = __builtin_amdgcn_ds_read_tr16_b64_v4i16((LAS v4i16_t*)(tile + sw_off(r0 + 4, ch) + 8 * (p & 1)));
    return (bf16x8){a[0], a[1], a[2], a[3], b[0], b[1], b[2], b[3]};
}
__device__ __forceinline__ float log_sigmoidf_(float x) { return (x > 0.f) ? -log1pf(__expf(-x)) : (x - log1pf(__expf(x))); }
__device__ __forceinline__ float wscan_sum(float v0, float v1, float& o0, float& o1, int lane) {
    float x = v0 + v1;
#pragma unroll
    for (int off = 1; off < 64; off <<= 1) { const float t = __shfl_up(x, off); if (lane >= off) x += t; }
    o0 = x - v1; o1 = x; return __shfl(x, 63);
}
__device__ __forceinline__ void wscan_max(float v0, float v1, float& o0, float& o1, int lane) {
    float y = fmaxf(v0, v1);
#pragma unroll
    for (int off = 1; off < 64; off <<= 1) { const float t = __shfl_up(y, off); if (lane >= off) y = fmaxf(y, t); }
    float pre = __shfl_up(y, 1); if (lane == 0) pre = -INFINITY;
    o0 = fmaxf(pre, v0); o1 = fmaxf(pre, fmaxf(v0, v1));
}
__device__ __forceinline__ void tile_load(LAS unsigned char* tile, const bf16* src, size_t pitch, int tid) {
    v4u v[4];
#pragma unroll
    for (int i = 0; i < 4; ++i) { const int id = tid + NTHR * i, row = id >> 4, ch = id & 15; v[i] = *(const v4u*)(src + (size_t)row * pitch + ch * 8); }
#pragma unroll
    for (int i = 0; i < 4; ++i) { const int id = tid + NTHR * i, row = id >> 4, ch = id & 15; *(LAS v4u*)(tile + sw_off(row, ch)) = v[i]; }
}

__device__ __forceinline__ void mlstm1_item(const Args& A, unsigned char* lds_, int item, int& wres, int tid, int lane, int wave) {
    unsigned char* ws = A.ws; LAS unsigned char* lds = (LAS unsigned char*)lds_;
    const float* conv_w = (const float*)(ws + WS_PAR) + PAR_CONVW; const float* conv_b = (const float*)(ws + WS_PAR) + PAR_CONVB;
    const int bh = item >> 6, c = item & 63, b = bh >> 2, h = bh & 3;
    const size_t t0 = (size_t)b * SEQ + 128 * c;
    LAS unsigned char* cA = lds; LAS unsigned char* Wq = lds + ML_TILE; LAS unsigned char* Wk = lds + 2 * ML_TILE; LAS unsigned char* Vt = lds + 3 * ML_TILE;
    LAS float* gl = (LAS float*)(lds + ML_G);
    const bf16* MU = (const bf16*)(ws + WS_MU) + h * 128; const bf16* MV = (const bf16*)(ws + WS_MV) + h * 128;
    bf16* Cg = (bf16*)((unsigned char*)A.out + DO_C) + h * 128;
    const int fr = lane & 15, g = lane >> 4, m0 = 16 * wave;
    if (wres != h) { const bf16* Wg = (const bf16*)(ws + WS_WM) + (size_t)h * 128 * 128; tile_load(Wq, Wg, 128, tid); tile_load(Wk, Wg + 4 * 128 * 128, 128, tid); wres = h; }
    tile_load(Vt, MV + t0 * 512, 512, tid);
    { const int ch = (tid & 15) * 8;
      float w[4][8], bs[8];
#pragma unroll
      for (int j = 0; j < 4; ++j) { const f32x4 w0 = *(const f32x4*)(conv_w + j * 512 + h * 128 + ch), w1 = *(const f32x4*)(conv_w + j * 512 + h * 128 + ch + 4);
          w[j][0] = w0[0]; w[j][1] = w0[1]; w[j][2] = w0[2]; w[j][3] = w0[3]; w[j][4] = w1[0]; w[j][5] = w1[1]; w[j][6] = w1[2]; w[j][7] = w1[3]; }
      { const f32x4 b0 = *(const f32x4*)(conv_b + h * 128 + ch), b1 = *(const f32x4*)(conv_b + h * 128 + ch + 4);
        bs[0] = b0[0]; bs[1] = b0[1]; bs[2] = b0[2]; bs[3] = b0[3]; bs[4] = b1[0]; bs[5] = b1[1]; bs[6] = b1[2]; bs[7] = b1[3]; }
#pragma unroll
      for (int i = 0; i < 4; ++i) { const int l = (tid >> 4) + 32 * i;
          float a[8];
#pragma unroll
          for (int q = 0; q < 8; ++q) a[q] = bs[q];
#pragma unroll
          for (int j = 0; j < 4; ++j) { const int sp = 128 * c + l + j - 3;
              if (sp >= 0) { const v4u m = *(const v4u*)(MU + ((size_t)b * SEQ + sp) * 512 + ch);
                  a[0] += bflo(m.x) * w[j][0]; a[1] += bfhi(m.x) * w[j][1]; a[2] += bflo(m.y) * w[j][2]; a[3] += bfhi(m.y) * w[j][3];
                  a[4] += bflo(m.z) * w[j][4]; a[5] += bfhi(m.z) * w[j][5]; a[6] += bflo(m.w) * w[j][6]; a[7] += bfhi(m.w) * w[j][7]; } }
#pragma unroll
          for (int q = 0; q < 8; ++q) a[q] = a[q] * sigmoidf_(a[q]);
          const v4u o = (v4u){pk2(a[0], a[1]), pk2(a[2], a[3]), pk2(a[4], a[5]), pk2(a[6], a[7])};
          *(LAS v4u*)(cA + sw_off(l, tid & 15)) = o; *(v4u*)(Cg + (t0 + l) * 512 + ch) = o; } }
    { const size_t gi = (size_t)bh * SEQ + 128 * c + 2 * lane;
      const float i0 = ((const float*)(ws + WS_IG))[gi], i1 = ((const float*)(ws + WS_IG))[gi + 1];
      const float f0 = log_sigmoidf_(((const float*)(ws + WS_FG))[gi]), f1 = log_sigmoidf_(((const float*)(ws + WS_FG))[gi + 1]);
      float b0, b1; const float blast = wscan_sum(f0, f1, b0, b1, lane);
      const float g0 = blast - b0 + i0, g1 = blast - b1 + i1, mloc = wave_max(fmaxf(g0, g1));
      gl[2 * lane] = __expf(g0 - mloc); gl[2 * lane + 1] = __expf(g1 - mloc);
      if (wave == 0 && lane == 0) { ((float*)(ws + WS_MLOC))[item] = mloc; ((float*)(ws + WS_BLAST))[item] = blast; } }
    __syncthreads();
    { bf16x8 af[4];
#pragma unroll
      for (int ks = 0; ks < 4; ++ks) af[ks] = rowfrag(cA, m0, ks, fr, g);
      f32x4 acc[8];
#pragma unroll
      for (int j = 0; j < 8; ++j) { acc[j] = (f32x4){0.f, 0.f, 0.f, 0.f};
#pragma unroll
          for (int ks = 0; ks < 4; ++ks) acc[j] = __builtin_amdgcn_mfma_f32_16x16x32_bf16(rowfrag(Wq, 16 * j, ks, fr, g), af[ks], acc[j], 0, 0, 0); }
      bf16* qg = (bf16*)(ws + WS_MQ) + (t0 + m0 + fr) * 512 + h * 128;
#pragma unroll
      for (int j = 0; j < 8; ++j) *(v2u*)(qg + 16 * j + 4 * g) = (v2u){pk2(acc[j][0], acc[j][1]), pk2(acc[j][2], acc[j][3])};
#pragma unroll
      for (int j = 0; j < 8; ++j) { acc[j] = (f32x4){0.f, 0.f, 0.f, 0.f};
#pragma unroll
          for (int ks = 0; ks < 4; ++ks) acc[j] = __builtin_amdgcn_mfma_f32_16x16x32_bf16(rowfrag(Wk, 16 * j, ks, fr, g), af[ks], acc[j], 0, 0, 0); }
      bf16* kg = (bf16*)(ws + WS_MK) + (t0 + m0 + fr) * 512 + h * 128; const float wk = gl[m0 + fr];
#pragma unroll
      for (int j = 0; j < 8; ++j) { *(v2u*)(kg + 16 * j + 4 * g) = (v2u){pk2(acc[j][0], acc[j][1]), pk2(acc[j][2], acc[j][3])};
          *(LAS v2u*)(cA + sw_off(m0 + fr, 2 * j + (g >> 1)) + 8 * (g & 1)) = (v2u){pk2(acc[j][0] * wk, acc[j][1] * wk), pk2(acc[j][2] * wk, acc[j][3] * wk)}; } }
    __syncthreads();
    { f32x4 acc[8], accn = (f32x4){0.f, 0.f, 0.f, 0.f};
#pragma unroll
      for (int j = 0; j < 8; ++j) acc[j] = (f32x4){0.f, 0.f, 0.f, 0.f};
      const bf16x8 ones = (bf16x8){0x3f80, 0x3f80, 0x3f80, 0x3f80, 0x3f80, 0x3f80, 0x3f80, 0x3f80};
#pragma unroll
      for (int ks = 0; ks < 4; ++ks) { const bf16x8 vf = colfrag(Vt, ks, wave, fr, g);
#pragma unroll
          for (int j = 0; j < 8; ++j) { const bf16x8 kf = colfrag(cA, ks, j, fr, g); acc[j] = __builtin_amdgcn_mfma_f32_16x16x32_bf16(kf, vf, acc[j], 0, 0, 0);
              if (j == wave) accn = __builtin_amdgcn_mfma_f32_16x16x32_bf16(kf, ones, accn, 0, 0, 0); } }
      bf16* cg = (bf16*)(ws + WS_CLOC) + ((size_t)item * 128 + m0 + fr) * 128;
#pragma unroll
      for (int j = 0; j < 8; ++j) *(v2u*)(cg + 16 * j + 4 * g) = (v2u){pk2(acc[j][0], acc[j][1]), pk2(acc[j][2], acc[j][3])};
      if (fr == 0) *(f32x4*)((float*)(ws + WS_NLOC) + (size_t)item * 128 + 16 * wave + 4 * g) = accn; }
    __syncthreads();
}

__device__ __forceinline__ void p3_scan_combine(const Args& A, int tid) {
    unsigned char* ws = A.ws;
    const int G = gridDim.x, NGT = G * NTHR;
    for (int gid = blockIdx.x * NTHR + tid; gid < 32 * 4096; gid += NGT) {
        const int bh = gid >> 12, rem = gid & 4095, e = rem >> 5, dq = rem & 31;
        const float* MLOC = (const float*)(ws + WS_MLOC) + bh * 64; const float* BL = (const float*)(ws + WS_BLAST) + bh * 64;
        f32x4 C = (f32x4){0.f, 0.f, 0.f, 0.f}, n = (f32x4){0.f, 0.f, 0.f, 0.f}; float m = 0.f;
        for (int c = 0; c < 64; ++c) {
            const size_t idx = (size_t)bh * 64 + c;
            const v2u cw = *(const v2u*)((const bf16*)(ws + WS_CLOC) + (idx * 128 + e) * 128 + 4 * dq); const f32x4 Cl = (f32x4){bflo(cw.x), bfhi(cw.x), bflo(cw.y), bfhi(cw.y)};
            *(v2u*)((bf16*)(ws + WS_CPREV) + (idx * 128 + e) * 128 + 4 * dq) = (v2u){pk2(C[0], C[1]), pk2(C[2], C[3])};
            const float ml = MLOC[c], bl = BL[c];
            const float mnew = fmaxf(bl + m, ml), a = __expf(bl + m - mnew), cc = __expf(ml - mnew);
            if (e == 0) { *(f32x4*)((float*)(ws + WS_NPREV) + idx * 128 + 4 * dq) = n;
                const f32x4 nl = *(const f32x4*)((const float*)(ws + WS_NLOC) + idx * 128 + 4 * dq); n = n * a + nl * cc;
                if (dq == 0) ((float*)(ws + WS_MPREV))[idx] = m; }
            C = C * a + Cl * cc; m = mnew;
        }
    }
    const bf16* OA = (const bf16*)((const unsigned char*)A.out + DO_OATT); const float* LSE = (const float*)(ws + WS_LSE);
    for (size_t id = (size_t)blockIdx.x * NTHR + tid; id < (size_t)T * 64; id += NGT) {
        const size_t t = id >> 6; const int h = (int)(id & 63) >> 3, ch = (int)(id & 7) * 8;
        const float l0 = LSE[t * 8 + h], l1 = LSE[((size_t)T + t) * 8 + h], l2 = LSE[((size_t)2 * T + t) * 8 + h];
        const float mx = fmaxf(l0, fmaxf(l1, l2)); float w0 = exp2f(l0 - mx), w1 = exp2f(l1 - mx), w2 = exp2f(l2 - mx);
        const float rs = 1.0f / (w0 + w1 + w2); w0 *= rs; w1 *= rs; w2 *= rs;
        const v4u a = *(const v4u*)(OA + t * 512 + h * 64 + ch), b = *(const v4u*)(OA + ((size_t)T + t) * 512 + h * 64 + ch), c = *(const v4u*)(OA + ((size_t)2 * T + t) * 512 + h * 64 + ch);
        v4u o;
        o.x = pk2(w0 * bflo(a.x) + w1 * bflo(b.x) + w2 * bflo(c.x), w0 * bfhi(a.x) + w1 * bfhi(b.x) + w2 * bfhi(c.x));
        o.y = pk2(w0 * bflo(a.y) + w1 * bflo(b.y) + w2 * bflo(c.y), w0 * bfhi(a.y) + w1 * bfhi(b.y) + w2 * bfhi(c.y));
        o.z = pk2(w0 * bflo(a.z) + w1 * bflo(b.z) + w2 * bflo(c.z), w0 * bfhi(a.z) + w1 * bfhi(b.z) + w2 * bfhi(c.z));
        o.w = pk2(w0 * bflo(a.w) + w1 * bflo(b.w) + w2 * bflo(c.w), w0 * bfhi(a.w) + w1 * bfhi(b.w) + w2 * bfhi(c.w));
        *(v4u*)((bf16*)(ws + WS_Y) + t * 1024 + h * 64 + ch) = o;
    }
}

__device__ __forceinline__ void mlstm2_item(const Args& A, unsigned char* lds_, int item, int tid, int lane, int wave) {
    unsigned char* ws = A.ws; LAS unsigned char* lds = (LAS unsigned char*)lds_;
    const float* g_mhn = (const float*)(ws + WS_PAR) + PAR_GMHN; const float* skip_m = (const float*)(ws + WS_PAR) + PAR_SKIP;
    const int bh = item >> 6, c = item & 63, b = bh >> 2, h = bh & 3;
    const size_t t0 = (size_t)b * SEQ + 128 * c;
    LAS unsigned char* qA = lds; LAS unsigned char* kA = lds + ML_TILE; LAS unsigned char* Vt = lds + 2 * ML_TILE; LAS unsigned char* Cp = lds + 3 * ML_TILE;
    LAS float* gl = (LAS float*)(lds + ML_G);
    const int fr = lane & 15, g = lane >> 4, m0 = 16 * wave, l = m0 + fr;
    tile_load(qA, (const bf16*)(ws + WS_MQ) + t0 * 512 + h * 128, 512, tid);
    tile_load(kA, (const bf16*)(ws + WS_MK) + t0 * 512 + h * 128, 512, tid);
    tile_load(Vt, (const bf16*)(ws + WS_MV) + t0 * 512 + h * 128, 512, tid);
    tile_load(Cp, (const bf16*)(ws + WS_CPREV) + (size_t)item * 128 * 128, 128, tid);
    { const size_t gi = (size_t)bh * SEQ + 128 * c + 2 * lane; const float mprev = ((const float*)(ws + WS_MPREV))[item];
      const float i0 = ((const float*)(ws + WS_IG))[gi], i1 = ((const float*)(ws + WS_IG))[gi + 1];
      const float f0 = log_sigmoidf_(((const float*)(ws + WS_FG))[gi]), f1 = log_sigmoidf_(((const float*)(ws + WS_FG))[gi + 1]);
      float b0, b1; (void)wscan_sum(f0, f1, b0, b1, lane);
      const float a0 = i0 - b0, a1 = i1 - b1; float p0, p1; wscan_max(a0, a1, p0, p1, lane);
      const float mt0 = fmaxf(b0 + mprev, b0 + p0), mt1 = fmaxf(b1 + mprev, b1 + p1);
      gl[2 * lane] = a0; gl[2 * lane + 1] = a1; gl[128 + 2 * lane] = b0 - mt0; gl[128 + 2 * lane + 1] = b1 - mt1;
      gl[256 + 2 * lane] = __expf(b0 + mprev - mt0); gl[256 + 2 * lane + 1] = __expf(b1 + mprev - mt1); gl[384 + 2 * lane] = __expf(-mt0); gl[384 + 2 * lane + 1] = __expf(-mt1); }
    __syncthreads();
    bf16x8 qf[4];
#pragma unroll
    for (int ks = 0; ks < 4; ++ks) qf[ks] = rowfrag(qA, m0, ks, fr, g);
    float qn = 0.f;
    { const float* np = (const float*)(ws + WS_NPREV) + (size_t)item * 128;
#pragma unroll
      for (int ks = 0; ks < 4; ++ks) { const f32x4 n0 = *(const f32x4*)(np + 32 * ks + 8 * g), n1 = *(const f32x4*)(np + 32 * ks + 8 * g + 4); const v4u w = __builtin_bit_cast(v4u, qf[ks]);
          qn += bflo(w.x) * n0[0] + bfhi(w.x) * n0[1] + bflo(w.y) * n0[2] + bfhi(w.y) * n0[3] + bflo(w.z) * n1[0] + bfhi(w.z) * n1[1] + bflo(w.w) * n1[2] + bfhi(w.w) * n1[3]; }
      qn += __shfl_xor(qn, 16); qn += __shfl_xor(qn, 32); }
    float den = 0.f;
    { const float rc = gl[128 + l];
#pragma unroll
      for (int j = 0; j < 8; ++j) { f32x4 acc = (f32x4){0.f, 0.f, 0.f, 0.f};
          if (j <= wave) {
#pragma unroll
              for (int ks = 0; ks < 4; ++ks) acc = __builtin_amdgcn_mfma_f32_16x16x32_bf16(rowfrag(kA, 16 * j, ks, fr, g), qf[ks], acc, 0, 0, 0);
#pragma unroll
              for (int e = 0; e < 4; ++e) { const int sx = 16 * j + 4 * g + e; acc[e] = (sx <= l) ? acc[e] * __expf(rc + gl[sx]) : 0.f; den += acc[e]; } }
          *(LAS v2u*)(qA + sw_off(l, 2 * j + (g >> 1)) + 8 * (g & 1)) = (v2u){pk2(acc[0], acc[1]), pk2(acc[2], acc[3])}; }
      den += __shfl_xor(den, 16); den += __shfl_xor(den, 32); }
    f32x4 acc[8];
    const float iw = gl[256 + l];
#pragma unroll
    for (int j = 0; j < 8; ++j) { acc[j] = (f32x4){0.f, 0.f, 0.f, 0.f};
#pragma unroll
        for (int ks = 0; ks < 4; ++ks) acc[j] = __builtin_amdgcn_mfma_f32_16x16x32_bf16(rowfrag(Cp, 16 * j, ks, fr, g), qf[ks], acc[j], 0, 0, 0);
        acc[j] = acc[j] * iw; }
    asm volatile("s_waitcnt lgkmcnt(0)" ::: "memory");
#pragma unroll
    for (int ks = 0; ks < 4; ++ks) if (2 * ks <= wave) { const bf16x8 sf = rowfrag(qA, m0, ks, fr, g);
#pragma unroll
        for (int j = 0; j < 8; ++j) acc[j] = __builtin_amdgcn_mfma_f32_16x16x32_bf16(colfrag(Vt, ks, j, fr, g), sf, acc[j], 0, 0, 0); }
    den += iw * qn;
    const float rden = 1.0f / fmaxf(fabsf(den), gl[384 + l]);
    float sq = 0.f;
#pragma unroll
    for (int j = 0; j < 8; ++j) { acc[j] = acc[j] * rden; sq += (acc[j][0] * acc[j][0] + acc[j][1] * acc[j][1]) + (acc[j][2] * acc[j][2] + acc[j][3] * acc[j][3]); }
    sq += __shfl_xor(sq, 16); sq += __shfl_xor(sq, 32);
    const float rn = 1.0f / sqrtf(sq * (1.0f / 128.0f) + EPSN);
    const bf16* MOg = (const bf16*)(ws + WS_MO) + (t0 + l) * 512 + h * 128; const bf16* Cg = (const bf16*)((const unsigned char*)A.out + DO_C) + (t0 + l) * 512 + h * 128;
    bf16* yg = (bf16*)(ws + WS_Y) + (t0 + l) * 1024 + 512 + h * 128;
#pragma unroll
    for (int j = 0; j < 8; ++j) { const int e0 = 16 * j + 4 * g;
        const v2u mo = *(const v2u*)(MOg + e0), cc = *(const v2u*)(Cg + e0);
        const f32x4 gm = *(const f32x4*)(g_mhn + h * 128 + e0), sk = *(const f32x4*)(skip_m + h * 128 + e0);
        const float y0 = sigmoidf_(bflo(mo.x)) * (acc[j][0] * rn * gm[0] + sk[0] * bflo(cc.x));
        const float y1 = sigmoidf_(bfhi(mo.x)) * (acc[j][1] * rn * gm[1] + sk[1] * bfhi(cc.x));
        const float y2 = sigmoidf_(bflo(mo.y)) * (acc[j][2] * rn * gm[2] + sk[2] * bflo(cc.y));
        const float y3 = sigmoidf_(bfhi(mo.y)) * (acc[j][3] * rn * gm[3] + sk[3] * bfhi(cc.y));
        *(v2u*)(yg + e0) = (v2u){pk2(y0, y1), pk2(y2, y3)}; }
    __syncthreads();
}

struct EpiOutProj {
    static constexpr bool PERM = true, AFTER_DRAIN = false;
    const float* x; bf16* x1b; float* ss;
    __device__ __forceinline__ void operator()(const f32x4 (&acc)[2][2][4][2], const pg8::Unit& u, int wr, int wc, int fr, int fq) const {
        const int row0 = u.pm * 256 + wr * 64 + fr, col0 = u.pn * 256 + wc * 32 + 8 * fq;
#pragma unroll
        for (int ai = 0; ai < 2; ++ai)
#pragma unroll
            for (int m = 0; m < 4; ++m) { const int row = row0 + ai * 128 + m * 16; float sq = 0.f;
#pragma unroll
                for (int bj = 0; bj < 2; ++bj) { const size_t off = (size_t)row * D + col0 + bj * 128;
                    const f32x4 o0 = *(const f32x4*)(x + off) + acc[ai][bj][m][0], o1 = *(const f32x4*)(x + off + 4) + acc[ai][bj][m][1];
                    *(v4u*)(x1b + off) = pack8(o0, o1);
                    sq += ((o0[0] * o0[0] + o0[1] * o0[1]) + (o0[2] * o0[2] + o0[3] * o0[3])) + ((o1[0] * o1[0] + o1[1] * o1[1]) + (o1[2] * o1[2] + o1[3] * o1[3])); }
                sq += __shfl_xor(sq, 16); sq += __shfl_xor(sq, 32);
                if (fq == 0) ss[(size_t)row * 16 + u.pn * 4 + wc] = sq; }
    }
};
struct EpiQx {
    static constexpr bool PERM = true, AFTER_DRAIN = false;
    bf16* qx; const LAS float* rs;
    __device__ __forceinline__ void operator()(const f32x4 (&acc)[2][2][4][2], const pg8::Unit& u, int wr, int wc, int fr, int fq) const {
        const int rl0 = wr * 64 + fr, col0 = wc * 32 + 8 * fq;
#pragma unroll
        for (int ai = 0; ai < 2; ++ai)
#pragma unroll
            for (int m = 0; m < 4; ++m) { const int rl = rl0 + ai * 128 + m * 16; const float sc = rs[rl]; bf16* rowp = qx + (size_t)(u.pm * 256 + rl) * 256 + col0;
#pragma unroll
                for (int bj = 0; bj < 2; ++bj) *(v4u*)(rowp + bj * 128) = pack8(acc[ai][bj][m][0] * sc, acc[ai][bj][m][1] * sc);
                asm volatile("" ::: "memory"); }
    }
};
struct EpiOx {
    static constexpr bool PERM = true, AFTER_DRAIN = false;
    const bf16* x1b; bf16* x2b;
    __device__ __forceinline__ void operator()(const f32x4 (&acc)[2][2][4][2], const pg8::Unit& u, int wr, int wc, int fr, int fq) const {
        const int row0 = u.pm * 256 + wr * 64 + fr, col0 = u.pn * 256 + wc * 32 + 8 * fq;
#pragma unroll
        for (int ai = 0; ai < 2; ++ai)
#pragma unroll
            for (int m = 0; m < 4; ++m) {
#pragma unroll
                for (int bj = 0; bj < 2; ++bj) { const size_t off = (size_t)(row0 + ai * 128 + m * 16) * D + col0 + bj * 128; const v4u r = *(const v4u*)(x1b + off);
                    f32x4 o0 = acc[ai][bj][m][0], o1 = acc[ai][bj][m][1];
                    o0[0] += bflo(r.x); o0[1] += bfhi(r.x); o0[2] += bflo(r.y); o0[3] += bfhi(r.y); o1[0] += bflo(r.z); o1[1] += bfhi(r.z); o1[2] += bflo(r.w); o1[3] += bfhi(r.w);
                    *(v4u*)(x2b + off) = pack8(o0, o1); }
                asm volatile("" ::: "memory"); }
    }
};
constexpr int CX_QLD = 72, CX_KLD = 72, CX_VLD = 264, CX_PLD = 264;
constexpr int CX_Q = 0, CX_K = CX_Q + 128 * CX_QLD * 2, CX_V = CX_K + 256 * CX_KLD * 2, CX_P = CX_V + 64 * CX_VLD * 2, CX_END = CX_P + 8 * 16 * CX_PLD * 2;
static_assert(CX_END <= LDS_MISC, "cross LDS");
__device__ __forceinline__ void cross_item(const Args& A, unsigned char* lds, int item, int tid, int lane, int wave) {
    unsigned char* ws = A.ws;
    const int rt = item >> 2, h = item & 3; const size_t t0 = (size_t)rt * 128; const int b = (int)(t0 / SEQ);
    bf16* Qs = (bf16*)(lds + CX_Q); bf16* Ks = (bf16*)(lds + CX_K); bf16* Vt = (bf16*)(lds + CX_V); bf16* Ps = (bf16*)(lds + CX_P) + wave * 16 * CX_PLD;
    const bf16* QX = (const bf16*)(ws + WS_QX) + h * 64; const bf16* KV = (const bf16*)(ws + WS_KVX) + (size_t)b * MEMLEN * NKV + h * 64;
    for (int id = tid; id < 128 * 8; id += NTHR) { const int row = id >> 3, ch = id & 7; *(v4u*)(Qs + row * CX_QLD + ch * 8) = *(const v4u*)(QX + (t0 + row) * 256 + ch * 8); }
    for (int id = tid; id < 256 * 8; id += NTHR) { const int kk = id >> 3, ch = id & 7;
        *(v4u*)(Ks + kk * CX_KLD + ch * 8) = *(const v4u*)(KV + (size_t)kk * NKV + ch * 8);
        const v4u vv = *(const v4u*)(KV + (size_t)kk * NKV + 256 + ch * 8); bf16* vp = Vt + (ch * 8) * CX_VLD + kk;
        vp[0 * CX_VLD] = (bf16)(vv.x & 0xffffu); vp[1 * CX_VLD] = (bf16)(vv.x >> 16); vp[2 * CX_VLD] = (bf16)(vv.y & 0xffffu); vp[3 * CX_VLD] = (bf16)(vv.y >> 16);
        vp[4 * CX_VLD] = (bf16)(vv.z & 0xffffu); vp[5 * CX_VLD] = (bf16)(vv.z >> 16); vp[6 * CX_VLD] = (bf16)(vv.w & 0xffffu); vp[7 * CX_VLD] = (bf16)(vv.w >> 16); }
    __syncthreads();
    const int fr = lane & 15, fq = lane >> 4;
    f32x4 s[1][16];
#pragma unroll
    for (int j = 0; j < 16; ++j) s[0][j] = (f32x4){0.f, 0.f, 0.f, 0.f};
    wave_mma<1, 16>(Qs + 16 * wave * CX_QLD, CX_QLD, Ks, CX_KLD, 64, s, fr, fq);
    float mx = -1e30f;
#pragma unroll
    for (int j = 0; j < 16; ++j)
#pragma unroll
        for (int e = 0; e < 4; ++e) mx = fmaxf(mx, s[0][j][e]);
    mx = fmaxf(mx, __shfl_xor(mx, 16)); mx = fmaxf(mx, __shfl_xor(mx, 32));
    float l = 0.f;
#pragma unroll
    for (int j = 0; j < 16; ++j) { f32x4 p;
#pragma unroll
        for (int e = 0; e < 4; ++e) { p[e] = exp2f(s[0][j][e] - mx); l += p[e]; }
        *(v2u*)(Ps + fr * CX_PLD + 16 * j + 4 * fq) = (v2u){pk2(p[0], p[1]), pk2(p[2], p[3])}; }
    l += __shfl_xor(l, 16); l += __shfl_xor(l, 32);
    __syncthreads();
    f32x4 o[1][4];
#pragma unroll
    for (int j = 0; j < 4; ++j) o[0][j] = (f32x4){0.f, 0.f, 0.f, 0.f};
    wave_mma<1, 4>(Ps, CX_PLD, Vt, CX_VLD, 256, o, fr, fq);
    const float rl = 1.0f / l;
    bf16* og = (bf16*)(ws + WS_OX) + (t0 + 16 * wave + fr) * 256 + h * 64;
#pragma unroll
    for (int j = 0; j < 4; ++j) *(v2u*)(og + 16 * j + 4 * fq) = (v2u){pk2(o[0][j][0] * rl, o[0][j][1] * rl), pk2(o[0][j][2] * rl, o[0][j][3] * rl)};
    __syncthreads();
}

struct TokInfo { int bucket; float wa, wb; int rank; };
constexpr size_t WS_RSTD3 = 18 * MiB;
constexpr size_t WS_CNTTAB = 31 * MiB + 512 * 1024;
__device__ __forceinline__ void p9_route(const Args& A, unsigned char* lds, int tid, int lane, int wave) {
    unsigned char* ws = A.ws;
    const float* b_rg = (const float*)(ws + WS_PAR) + PAR_BRG; const float* b_re = (const float*)(ws + WS_PAR) + PAR_BRE;
    LAS float* WRl = (LAS float*)lds;
    LAS int* bkl = (LAS int*)(lds + 81920);
    for (int i = tid; i < 20 * 1024 / 4; i += NTHR) ((LAS f32x4*)WRl)[i] = ((const f32x4*)(ws + WS_WR))[i];
    __syncthreads();
    const bf16* X2B = (const bf16*)(ws + WS_HBS);
    for (int chunk = blockIdx.x; chunk < T / 256; chunk += gridDim.x) {
        for (int r = 0; r < 32; ++r) {
            const int m = chunk * 256 + wave * 32 + r;
            const v4u* xr = (const v4u*)(X2B + (size_t)m * D) + lane;
            f32x4 v[4]; float s = 0.f;
#pragma unroll
            for (int j = 0; j < 2; ++j) { const v4u r = xr[64 * j]; v[2 * j] = (f32x4){bflo(r.x), bfhi(r.x), bflo(r.y), bfhi(r.y)}; v[2 * j + 1] = (f32x4){bflo(r.z), bfhi(r.z), bflo(r.w), bfhi(r.w)}; }
#pragma unroll
            for (int j = 0; j < 4; ++j) s += (v[j].x * v[j].x + v[j].y * v[j].y) + (v[j].z * v[j].z + v[j].w * v[j].w);
            const float rstd = 1.0f / sqrtf(wave_sum(s) * (1.0f / D) + EPSN);
            float gl4[4];
#pragma unroll
            for (int e = 0; e < 4; ++e) { float a = 0.f;
#pragma unroll
                for (int j = 0; j < 4; ++j) { const f32x4 w = *(const LAS f32x4*)(WRl + e * 1024 + 512 * (j >> 1) + 8 * lane + 4 * (j & 1)); a += (v[j].x * w.x + v[j].y * w.y) + (v[j].z * w.z + v[j].w * w.w); }
                gl4[e] = wave_sum(a) * rstd + b_rg[e]; }
            int g = 0; float gm = gl4[0];
#pragma unroll
            for (int i = 1; i < 4; ++i) if (gl4[i] > gm) { gm = gl4[i]; g = i; }
            g = __builtin_amdgcn_readfirstlane(g);
            float gs = 0.f;
#pragma unroll
            for (int i = 0; i < 4; ++i) gs += __expf(gl4[i] - gm);
            const float gw_ = 1.0f / gs;
            float el[4];
            const LAS float* WRe = WRl + (4 + 4 * g) * 1024;
#pragma unroll
            for (int e = 0; e < 4; ++e) { float a = 0.f;
#pragma unroll
                for (int j = 0; j < 4; ++j) { const f32x4 w = *(const LAS f32x4*)(WRe + e * 1024 + 512 * (j >> 1) + 8 * lane + 4 * (j & 1)); a += (v[j].x * w.x + v[j].y * w.y) + (v[j].z * w.z + v[j].w * w.w); }
                el[e] = wave_sum(a) * rstd + b_re[g * 4 + e]; }
            int i0 = 0; float v0 = el[0];
#pragma unroll
            for (int i = 1; i < 4; ++i) if (el[i] > v0) { v0 = el[i]; i0 = i; }
            int i1 = -1; float v1 = -INFINITY;
#pragma unroll
            for (int i = 0; i < 4; ++i) if (i != i0 && el[i] > v1) { v1 = el[i]; i1 = i; }
            const float e1 = __expf(v1 - v0); const float w0 = gw_ / (1.0f + e1), w1 = gw_ * e1 / (1.0f + e1);
            const int pa = i0 < i1 ? i0 : i1, pb = i0 < i1 ? i1 : i0;
            const int pidx = (pa == 0) ? (pb - 1) : (pa == 1 ? pb + 1 : 5);
            const int bucket = g * 6 + pidx;
            if (lane == 0) { ((float*)(ws + WS_RSTD3))[m] = rstd; bkl[wave * 32 + r] = bucket; ((LAS float*)(bkl + 256))[wave * 32 + r] = (i0 < i1) ? w0 : w1; ((LAS float*)(bkl + 512))[wave * 32 + r] = (i0 < i1) ? w1 : w0; }
        }
        __syncthreads();
        if (tid < 256) { const int my = bkl[tid]; int rank = 0; for (int j = 0; j < tid; ++j) rank += (bkl[j] == my) ? 1 : 0;
            TokInfo ti; ti.bucket = my; ti.wa = ((LAS float*)(bkl + 256))[tid]; ti.wb = ((LAS float*)(bkl + 512))[tid]; ti.rank = rank;
            ((TokInfo*)(ws + WS_TOKINFO))[chunk * 256 + tid] = ti; }
        else if (tid < 256 + NBUCKET) { const int b = tid - 256; int c = 0; for (int j = 0; j < 256; ++j) c += (bkl[j] == b) ? 1 : 0;
            ((int*)(ws + WS_CNTTAB))[chunk * NBUCKET + b] = c; }
        __syncthreads();
    }
}
__device__ __forceinline__ void p10_slots(const Args& A, unsigned char* lds, int tid, int lane, int wave) {
    unsigned char* ws = A.ws;
    LAS int* tabl = (LAS int*)lds;
    LAS int* totl = (LAS int*)(lds + 32768);
    const int* CNTTAB = (const int*)(ws + WS_CNTTAB);
    for (int i = tid; i < 256 * NBUCKET; i += NTHR) tabl[i] = CNTTAB[i];
    __syncthreads();
    if (tid < NBUCKET) { int t = 0; for (int w = 0; w < 256; ++w) t += tabl[w * NBUCKET + tid]; totl[tid] = t; }
    __syncthreads();
    if (tid == 0) { int acc = 0; for (int b = 0; b < NBUCKET; ++b) { totl[32 + b] = acc; acc += ((totl[b] + 255) >> 8) * 256; } totl[32 + NBUCKET] = acc; }
    if (blockIdx.x == 0 && tid < NBUCKET) ((unsigned*)(ws + WS_CTL))[CW_CNT + tid] = (unsigned)totl[tid];
    __syncthreads();
    int* TOKMAP = (int*)(ws + WS_TOKMAP); float* WSORT = (float*)(ws + WS_WSORT);
    for (int chunk = blockIdx.x; chunk < T / 256; chunk += gridDim.x) {
        if (tid < NBUCKET) { int s = 0; for (int w = 0; w < chunk; ++w) s += tabl[w * NBUCKET + tid]; totl[64 + tid] = totl[32 + tid] + s; }
        __syncthreads();
        if (tid < 256) { const int m = chunk * 256 + tid; const TokInfo ti = ((const TokInfo*)(ws + WS_TOKINFO))[m]; const int slot = totl[64 + ti.bucket] + ti.rank;
            TOKMAP[slot] = m; *(f32x4*)(WSORT + 4 * slot) = (f32x4){ti.wa, ti.wb, ((const float*)(ws + WS_RSTD3))[m], 0.f}; }
        __syncthreads();
    }
    for (int b = blockIdx.x; b < NBUCKET; b += gridDim.x)
        for (int r = totl[32 + b] + totl[b] + tid; r < totl[32 + b + 1]; r += NTHR) { TOKMAP[r] = -1; *(f32x4*)(WSORT + 4 * r) = (f32x4){0.f, 0.f, 0.f, 0.f}; }
}
struct MoeOrder {
    int G, c, nunits, ncol; const int* tab;
    __device__ __forceinline__ bool next(int i, pg8::Unit& u) const {
        const long L = (long)i * G + c; if (L >= nunits) return false;
        const int rt = (int)L / ncol, j = (int)L % ncol, bk = tab[rt];
        u.pm = rt; u.aux = j;
        if (ncol == 8) { const int g = bk / 6, p = bk % 6; const int pa = (p < 3) ? 0 : (p < 5 ? 1 : 2), pb = (p < 3) ? p + 1 : (p < 5 ? p - 1 : 3);
            const int e = 4 * g + ((j >> 2) ? pb : pa); u.pn = e * 4 + (j & 3); }
        else u.pn = bk * 4 + j;
        return true;
    }
    __device__ __forceinline__ void a_ready(const pg8::Unit&) const {}
    __device__ __forceinline__ void done(const pg8::Unit&) const {}
};
struct EpiUp {
    static constexpr bool PERM = true, AFTER_DRAIN = false;
    bf16* act; const float* wsort;
    __device__ __forceinline__ void operator()(const f32x4 (&acc)[2][2][4][2], const pg8::Unit& u, int wr, int wc, int fr, int fq) const {
        const int row0 = u.pm * 256 + wr * 64 + fr, half = u.aux >> 2, col0 = half * 512 + (u.aux & 3) * 128 + wc * 32 + 8 * fq;
#pragma unroll
        for (int ai = 0; ai < 2; ++ai)
#pragma unroll
            for (int m = 0; m < 4; ++m) { const int row = row0 + ai * 128 + m * 16; const float w = wsort[4 * row + half], rs = wsort[4 * row + 2];
                f32x4 r0, r1;
#pragma unroll
                for (int i = 0; i < 4; ++i) { const float a0 = acc[ai][0][m][0][i] * rs, a1 = acc[ai][0][m][1][i] * rs;
                    r0[i] = a0 * sigmoidf_(a0) * (acc[ai][1][m][0][i] * rs) * w; r1[i] = a1 * sigmoidf_(a1) * (acc[ai][1][m][1][i] * rs) * w; }
                *(v4u*)(act + (size_t)row * D + col0) = pack8(r0, r1); }
    }
};
struct EpiDown {
    static constexpr bool PERM = true, AFTER_DRAIN = false;
    const bf16* x2b; float* xo; const int* tokmap;
    __device__ __forceinline__ void operator()(const f32x4 (&acc)[2][2][4][2], const pg8::Unit& u, int wr, int wc, int fr, int fq) const {
        const int row0 = u.pm * 256 + wr * 64 + fr, col0 = u.aux * 256 + wc * 32 + 8 * fq;
#pragma unroll
        for (int ai = 0; ai < 2; ++ai)
#pragma unroll
            for (int m = 0; m < 4; ++m) { const int tok = tokmap[row0 + ai * 128 + m * 16];
                if (tok >= 0) {
#pragma unroll
                    for (int bj = 0; bj < 2; ++bj) { const size_t off = (size_t)tok * D + col0 + bj * 128; const v4u r = *(const v4u*)(x2b + off);
                        f32x4 o0 = acc[ai][bj][m][0], o1 = acc[ai][bj][m][1];
                        o0[0] += bflo(r.x); o0[1] += bfhi(r.x); o0[2] += bflo(r.y); o0[3] += bfhi(r.y); o1[0] += bflo(r.z); o1[1] += bfhi(r.z); o1[2] += bflo(r.w); o1[3] += bfhi(r.w);
                        *(f32x4*)(xo + off) = o0; *(f32x4*)(xo + off + 4) = o1; } } }
    }
};
constexpr size_t WS_XCH = 20 * MiB + 512 * 1024;
constexpr int CW_SEAM = 16384;
constexpr int LDS_EX = 139264;
struct EpiDownNorm {
    static constexpr bool PERM = true, AFTER_DRAIN = false;
    const bf16* x2b; float* out; const int* tokmap; const float* gfin; float* xch; unsigned* cnt; LAS unsigned char* ex;
    __device__ __forceinline__ void operator()(const f32x4 (&acc_)[2][2][4][2], const pg8::Unit& u, int wr, int wc, int fr, int fq) const {
        f32x4 (&acc)[2][2][4][2] = const_cast<f32x4 (&)[2][2][4][2]>(acc_);
        int tid = threadIdx.x; asm volatile("" : "+v"(tid));
        const int lane = tid & 63, wid = __builtin_amdgcn_readfirstlane(tid >> 6);
        int rb = wr * 64 + fr; asm volatile("" : "+v"(rb));
        LAS float* P = (LAS float*)ex; LAS float* S = (LAS float*)(ex + 4096); LAS unsigned* flag = (LAS unsigned*)(ex + 6144);
        const int col0 = u.aux * 256 + wc * 32 + 8 * fq;
#pragma unroll
        for (int ai = 0; ai < 2; ++ai)
#pragma unroll
            for (int m = 0; m < 4; ++m) { const int rl = rb + ai * 128 + m * 16; const int tok = tokmap[u.pm * 256 + rl]; float sq = 0.f;
#pragma unroll
                for (int bj = 0; bj < 2; ++bj) { f32x4& o0 = acc[ai][bj][m][0]; f32x4& o1 = acc[ai][bj][m][1];
                    if (tok >= 0) { const v4u r = *(const v4u*)(x2b + (size_t)tok * D + col0 + bj * 128);
                        o0[0] += bflo(r.x); o0[1] += bfhi(r.x); o0[2] += bflo(r.y); o0[3] += bfhi(r.y); o1[0] += bflo(r.z); o1[1] += bfhi(r.z); o1[2] += bflo(r.w); o1[3] += bfhi(r.w); }
                    sq += ((o0[0] * o0[0] + o0[1] * o0[1]) + (o0[2] * o0[2] + o0[3] * o0[3])) + ((o1[0] * o1[0] + o1[1] * o1[1]) + (o1[2] * o1[2] + o1[3] * o1[3])); }
                sq += __shfl_xor(sq, 16); sq += __shfl_xor(sq, 32);
                if (fq == 0) P[rl * 4 + wc] = sq;
                asm volatile("" ::: "memory"); }
        asm volatile("s_waitcnt lgkmcnt(0)" ::: "memory"); __builtin_amdgcn_s_barrier(); asm volatile("" ::: "memory");
        if (tid < 256) { const f32x4 p = *(const LAS f32x4*)(P + tid * 4);
            __hip_atomic_store(xch + ((size_t)u.pm * 256 + tid) * 4 + u.aux, (p[0] + p[1]) + (p[2] + p[3]), __ATOMIC_RELAXED, __HIP_MEMORY_SCOPE_AGENT); }
        asm volatile("s_waitcnt vmcnt(0)" ::: "memory");
        if (wid < 4 && lane == 0) __hip_atomic_fetch_add(cnt + 64 * u.pm, 1u, __ATOMIC_RELAXED, __HIP_MEMORY_SCOPE_AGENT);
        if (wid == 0) { unsigned spins = 0;
            while ((unsigned)__builtin_amdgcn_readfirstlane(__hip_atomic_load(cnt + 64 * u.pm, __ATOMIC_RELAXED, __HIP_MEMORY_SCOPE_AGENT)) < 16u) { __builtin_amdgcn_s_sleep(2); if (++spins > (1u << 22)) break; }
            __builtin_amdgcn_fence(__ATOMIC_ACQUIRE, "agent");
            if (lane == 0) flag[0] = spins; }
        asm volatile("s_waitcnt vmcnt(0) lgkmcnt(0)" ::: "memory"); __builtin_amdgcn_s_barrier(); asm volatile("" ::: "memory");
        if (tid < 256) { const float* sl = xch + ((size_t)u.pm * 256 + tid) * 4; float t = 0.f;
#pragma unroll
            for (int k = 0; k < 4; ++k) t += __hip_atomic_load(sl + k, __ATOMIC_RELAXED, __HIP_MEMORY_SCOPE_AGENT);
            S[tid] = 1.0f / sqrtf(t * (1.0f / D) + EPSN); }
        asm volatile("s_waitcnt lgkmcnt(0)" ::: "memory"); __builtin_amdgcn_s_barrier(); asm volatile("" ::: "memory");
#pragma unroll
        for (int ai = 0; ai < 2; ++ai)
#pragma unroll
            for (int m = 0; m < 4; ++m) { const int rl = rb + ai * 128 + m * 16; const int tok = tokmap[u.pm * 256 + rl]; const float rs = S[rl];
                if (tok >= 0) {
#pragma unroll
                    for (int bj = 0; bj < 2; ++bj)
#pragma unroll
                        for (int n = 0; n < 2; ++n) { const int cc = col0 + bj * 128 + 4 * n; acc[ai][bj][m][n] = acc[ai][bj][m][n] * rs; acc[ai][bj][m][n] = acc[ai][bj][m][n] * *(const f32x4*)(gfin + cc);
                            *(f32x4*)(out + (size_t)tok * D + cc) = acc[ai][bj][m][n]; asm volatile("" ::: "memory"); } } }
    }
};
__device__ __forceinline__ void p10_final(const Args& A, float* outp, int lane, int wave) {
    const float* g_final = (const float*)(A.ws + WS_PAR) + PAR_GFIN;
    const int G = gridDim.x, gw = blockIdx.x * NWAVES + wave, NGW = G * NWAVES;
    f32x4 gv[4];
#pragma unroll
    for (int j = 0; j < 4; ++j) gv[j] = *((const f32x4*)g_final + lane + 64 * j);
    for (int m = gw; m < T; m += NGW) {
        f32x4* xr = (f32x4*)(A.out + (size_t)m * D) + lane;
        f32x4 v[4]; float s = 0.f;
#pragma unroll
        for (int j = 0; j < 4; ++j) { v[j] = xr[64 * j]; s += (v[j].x * v[j].x + v[j].y * v[j].y) + (v[j].z * v[j].z + v[j].w * v[j].w); }
        const float rstd = 1.0f / sqrtf(wave_sum(s) * (1.0f / D) + EPSN);
#pragma unroll
        for (int j = 0; j < 4; ++j) ((f32x4*)(outp + (size_t)m * D) + lane)[64 * j] = v[j] * rstd * gv[j];
    }
}

#ifndef MS
#define MS 4
#endif
#ifndef N_LAUNCHES
#define N_LAUNCHES 1
#endif
constexpr int N_PHASES = 14;
#ifndef FUSE_FINAL
#define FUSE_FINAL 1
#endif
#ifndef DUP_MASK
#define DUP_MASK 0
#endif
#define REP(k) for (int rep_ = 0; rep_ < (((DUP_MASK >> (k)) & 1) ? 2 : 1); ++rep_)
#ifndef QX_SP2
#define QX_SP2 false
#endif

#ifndef NVG
#define NVG 256
#endif
__global__ void __launch_bounds__(NTHR, 2) __attribute__((amdgpu_num_vgpr(NVG))) fwd_kernel(Args args) {
    __shared__ __attribute__((aligned(16))) unsigned char lds[LDS_BYTES];
    const int tid = threadIdx.x, lane = tid & 63, wave = __builtin_amdgcn_readfirstlane(tid >> 6);
    gu32* ctl = (gu32*)(args.ws + WS_CTL);
    for (int u = tid; u < (LDS_BYTES - LDS_MISC) / 4; u += NTHR) ((unsigned*)(lds + LDS_MISC))[u] = 0u;
    __syncthreads();
    const int lo = args.ph_lo, hi = args.ph_hi;
    const bool use_bar = (hi - lo) > 1;
    XcdBarrier bar; bar.bar = (unsigned*)ctl + CW_BAR; bar.x = 0; bar.st = (volatile LAS unsigned*)(lds + LDS_MISC) + 8;
    if (use_bar) bar = xcd_barrier_post((unsigned*)ctl + CW_BAR, (volatile LAS unsigned*)(lds + LDS_MISC) + 8);
#ifndef PH_MASK
#define PH_MASK 0xFFFF
#endif
#define IN(k) (((PH_MASK >> (k)) & 1) && lo <= (k) && (k) < hi)
#define SEAM(k) do { if (IN(k) && IN((k) + 1)) xcd_barrier(bar); } while (0)
    PG8_LAS unsigned char* ring = (PG8_LAS unsigned char*)lds;
    const int G = gridDim.x;
#define PHASE_PTRS Args pa = args; { unsigned char* w_ = args.ws; float* o_ = args.out; asm volatile("" : "+s"(w_), "+s"(o_)); pa.ws = w_; pa.out = o_; } unsigned char* const ws = pa.ws; (void)ws

#ifdef DUMMY_LIVE
    float dl0, dl1, dl2, dl3, dl4, dl5, dl6, dl7; asm volatile("" : "=v"(dl0), "=v"(dl1), "=v"(dl2), "=v"(dl3), "=v"(dl4), "=v"(dl5), "=v"(dl6), "=v"(dl7));
#endif
    if (IN(0)) { PHASE_PTRS; REP(0) { p0_prologue(pa, lds, tid, lane, wave); __syncthreads(); } }
    SEAM(0);
    if (IN(1) && MS >= 1) { PHASE_PTRS;
        pg8::Gemm g{(const pg8::bf16_t*)(ws + WS_XN), (const pg8::bf16_t*)(ws + WS_WIN), T + TMEM, NIN + NKV, D};
        InProjOrder S; S.so.init(T, NIN, G, (int)blockIdx.x);
        EpiInProj E{(bf16*)(ws + WS_Q), (bf16*)(ws + WS_KVX), (const float*)(ws + WS_ROPE)};
        REP(1) pg8::gemm_phase<EpiInProj, InProjOrder, true, true>(ring, g, S, E);
    }
    SEAM(1);
    if (IN(2) && MS >= 1) { PHASE_PTRS;
        const int n_att = (MS >= 2) ? 3 * 4096 : 0;
        REP(14) attn_phase(pa, lds, n_att, lane, wave);
        REP(15) { int wres = -1; const int per = (2048 + G - 1) / G; __syncthreads(); for (int it = blockIdx.x * per; it < 2048 && it < (int)(blockIdx.x + 1) * per; ++it) mlstm1_item(pa, lds, it, wres, tid, lane, wave); }
    }
    SEAM(2);
    if (IN(3) && MS >= 1) { PHASE_PTRS;
        if (MS < 2) {
            for (size_t id = (size_t)blockIdx.x * NTHR + tid; id < (size_t)T * 64; id += (size_t)G * NTHR) { const size_t t = id >> 6; const int c8 = (int)(id & 63) * 8;
                *(v4u*)((bf16*)(ws + WS_Y) + t * 1024 + c8) = (v4u){0u, 0u, 0u, 0u}; }
        }
        REP(3) p3_scan_combine(pa, tid);
    }
    SEAM(3);
    if (IN(4) && MS >= 1) { PHASE_PTRS; REP(4) { const int per = (2048 + G - 1) / G; for (int it = blockIdx.x * per; it < 2048 && it < (int)(blockIdx.x + 1) * per; ++it) mlstm2_item(pa, lds, it, tid, lane, wave); } }
    SEAM(4);
    if (IN(5)) { PHASE_PTRS;
        if (MS >= 1) {
            pg8::Gemm g{(const pg8::bf16_t*)(ws + WS_Y), (const pg8::bf16_t*)(ws + WS_WOUT), T, D, D};
            pg8::StaticOrder S; S.init(T, D, G, (int)blockIdx.x);
            EpiOutProj E{(const float*)pa.in[0], (bf16*)(ws + WS_X1B), (float*)(ws + WS_SS1)};
            REP(5) pg8::gemm_phase<EpiOutProj, pg8::StaticOrder, true, true>(ring, g, S, E);
        } else {
            const int gw = blockIdx.x * NWAVES + wave, NGW = G * NWAVES;
            for (int m = gw; m < T; m += NGW) { const f32x4* xr = (const f32x4*)((const float*)pa.in[0] + (size_t)m * D) + lane; unsigned long long* o8 = (unsigned long long*)(ws + WS_X1B + (size_t)m * D * 2) + lane;
#pragma unroll
                for (int j = 0; j < 4; ++j) { const f32x4 v = xr[64 * j]; o8[64 * j] = (unsigned long long)pk2(v.x, v.y) | ((unsigned long long)pk2(v.z, v.w) << 32); } }
        }
    }
    SEAM(5);
    if (IN(6) && MS >= 3) { PHASE_PTRS;
        pg8::Gemm g{(const pg8::bf16_t*)(ws + WS_X1B), (const pg8::bf16_t*)(ws + WS_WQX), T, 256, D};
        pg8::StaticOrder S; S.init(T, 256, G, (int)blockIdx.x);
        float* rs = (float*)(lds + LDS_RS);
        { pg8::Unit u0; if (S.next(0, u0) && tid < 256) { const f32x4* sp = (const f32x4*)((const float*)(ws + WS_SS1) + (size_t)(u0.pm * 256 + tid) * 16);
              const f32x4 a = sp[0], b = sp[1], c = sp[2], d = sp[3];
              const float s = ((a[0] + a[1]) + (a[2] + a[3])) + ((b[0] + b[1]) + (b[2] + b[3])) + ((c[0] + c[1]) + (c[2] + c[3])) + ((d[0] + d[1]) + (d[2] + d[3]));
              rs[tid] = 1.0f / sqrtf(s * (1.0f / D) + EPSN); } }
        __syncthreads();
        EpiQx E{(bf16*)(ws + WS_QX), (const LAS float*)rs};
        REP(6) pg8::gemm_phase<EpiQx, pg8::StaticOrder, true, QX_SP2>(ring, g, S, E);
    }
    SEAM(6);
    if (IN(7) && MS >= 3) { PHASE_PTRS; REP(7) for (int it = blockIdx.x; it < (T / 128) * 4; it += G) cross_item(pa, lds, it, tid, lane, wave); }
    SEAM(7);
    if (IN(8) && MS >= 3) { PHASE_PTRS;
        int kdyn = 256; asm volatile("" : "+s"(kdyn));
        pg8::Gemm g{(const pg8::bf16_t*)(ws + WS_OX), (const pg8::bf16_t*)(ws + WS_WOX), T, D, kdyn};
        pg8::StaticOrder S; S.init(T, D, G, (int)blockIdx.x);
        EpiOx E{(const bf16*)(ws + WS_X1B), (bf16*)(ws + WS_HBS)};
        REP(8) pg8::gemm_phase<EpiOx, pg8::StaticOrder, false, true>(ring, g, S, E);
    }
    SEAM(8);
    if (IN(9) && MS >= 4) { PHASE_PTRS; p9_route(pa, lds, tid, lane, wave); }
    SEAM(9);
    if (IN(10) && MS >= 4) { PHASE_PTRS; p10_slots(pa, lds, tid, lane, wave); }
    SEAM(10);
    if ((IN(11) || IN(12)) && MS >= 4) { PHASE_PTRS;
        int* tab = (int*)(lds + LDS_TAB);
        if (tid == 0) { int nrt = 0; const unsigned* cnt = (const unsigned*)(ws + WS_CTL) + CW_CNT;
            for (int i = 0; i < NBUCKET; ++i) { const int nt = (int)((__hip_atomic_load(cnt + i, __ATOMIC_RELAXED, __HIP_MEMORY_SCOPE_AGENT) + 255u) >> 8); for (int k = 0; k < nt; ++k) tab[1 + nrt++] = i; }
            tab[0] = nrt; }
        __syncthreads();
        const int nrt = tab[0];
        if (IN(11)) {
            pg8::Gemm g{(const pg8::bf16_t*)(ws + WS_HBS), (const pg8::bf16_t*)(ws + WS_W13), ROWS_MAX, 64 * 256, D, (const int*)(ws + WS_TOKMAP)};
            MoeOrder S{G, (int)blockIdx.x, nrt * 8, 8, tab + 1};
            EpiUp E{(bf16*)(ws + WS_ACT), (const float*)(ws + WS_WSORT)};
            REP(11) pg8::gemm_phase<EpiUp, MoeOrder, true, true, true>(ring, g, S, E);
        }
        SEAM(11);
        if (IN(12)) {
            pg8::Gemm g{(const pg8::bf16_t*)(ws + WS_ACT), (const pg8::bf16_t*)(ws + WS_W2P), ROWS_MAX, 96 * 256, D};
            MoeOrder S{G, (int)blockIdx.x, nrt * 4, 4, tab + 1};
#if FUSE_FINAL
            EpiDownNorm E{(const bf16*)(ws + WS_HBS), pa.out, (const int*)(ws + WS_TOKMAP), (const float*)(ws + WS_PAR) + PAR_GFIN, (float*)(ws + WS_XCH), (unsigned*)(ws + WS_CTL) + CW_SEAM, (LAS unsigned char*)(lds + LDS_EX)};
            pg8::gemm_phase<EpiDownNorm, MoeOrder, true, true>(ring, g, S, E);
#else
            EpiDown E{(const bf16*)(ws + WS_HBS), pa.out, (const int*)(ws + WS_TOKMAP)};
            REP(12) pg8::gemm_phase<EpiDown, MoeOrder, true, true>(ring, g, S, E);
#endif
        }
    }
    if (!FUSE_FINAL) SEAM(12);
    if (IN(13) && !FUSE_FINAL) { PHASE_PTRS; REP(13) p10_final(pa, (((DUP_MASK >> 13) & 1) && rep_ == 0) ? (float*)(ws + 544 * MiB) : pa.out, lane, wave); }
#ifdef DUMMY_LIVE
    asm volatile("" :: "v"(dl0), "v"(dl1), "v"(dl2), "v"(dl3), "v"(dl4), "v"(dl5), "v"(dl6), "v"(dl7));
#endif
#undef IN
#undef SEAM
}

extern "C" void kernel_launch(void* const* d_in, const int* in_sizes, int n_in, void* d_out, int out_size, void* d_ws, size_t ws_size, hipStream_t stream) {
    static int grid = 0;
    if (grid == 0) {
        if (n_in != 28 || out_size != T * D || ws_size < WS_END) { fprintf(stderr, "kernel_launch: unexpected problem (n_in %d, out %d, ws %zu)\n", n_in, out_size, ws_size); grid = -1; return; }
        int dev = 0, cus = 0, per_cu = 0;
        if (hipGetDevice(&dev) != hipSuccess || hipDeviceGetAttribute(&cus, hipDeviceAttributeMultiprocessorCount, dev) != hipSuccess) { grid = -1; return; }
        if (hipOccupancyMaxActiveBlocksPerMultiprocessor(&per_cu, (const void*)fwd_kernel, NTHR, 0) != hipSuccess || per_cu < 1) { fprintf(stderr, "kernel_launch: occupancy query failed (%d)\n", per_cu); per_cu = 1; }
        (void)hipGetLastError();
        grid = cus * (per_cu > 1 ? 1 : per_cu);
        if (grid > 256) grid = 256;
    }
    if (grid < 0) return;
    (void)hipMemsetAsync((char*)d_ws + WS_CTL, 0, CTL_ZERO_BYTES, stream);
    Args a{};
    for (int i = 0; i < 28; ++i) a.in[i] = d_in[i];
    a.out = (float*)d_out; a.ws = (unsigned char*)d_ws;
    if (N_LAUNCHES == 1) {
        a.ph_lo = 0; a.ph_hi = N_PHASES;
        void* kargs[] = {&a};
        hipError_t e = hipLaunchCooperativeKernel((const void*)fwd_kernel, dim3(grid), dim3(NTHR), kargs, 0, stream);
        if (e != hipSuccess) fprintf(stderr, "kernel_launch: cooperative launch failed: %s (grid %d)\n", hipGetErrorString(e), grid);
    } else {
        for (int p = 0; p < N_PHASES; ++p) { a.ph_lo = p; a.ph_hi = p + 1; hipLaunchKernelGGL(fwd_kernel, dim3(grid), dim3(NTHR), 0, stream, a); }
    }
}
```

```cpp
#include <hip/hip_runtime.h>
#include <cstdio>
#include <cstdint>
namespace pg8 {
#define PG8_LAS __attribute__((address_space(3)))
typedef unsigned short bf16_t;
typedef short bf16x8 __attribute__((ext_vector_type(8)));
typedef float f32x4 __attribute__((ext_vector_type(4)));
typedef unsigned u32x4 __attribute__((ext_vector_type(4)));
constexpr int BM = 256, BK = 64, HALF = 128, HTB = HALF * BK * 2  , STAGE_BYTES = 8 * HTB, NXCD = 8, WGM = 8;

__host__ __device__ __forceinline__ int lds_byte(int r, int c) { const int st = (r >> 4) * 2 + (c >> 5), rr = r & 15, cc = c & 31, ob = rr * 64 + cc * 2; return st * 1024 + (ob ^ (((ob >> 9) & 1) << 5)); }
__host__ __device__ __forceinline__ void stage_rc(int b, int& R, int& C) { const int st = b / 1024, sb = b % 1024, swz = sb ^ (((sb >> 9) & 1) << 5); R = (st >> 1) * 16 + swz / 64; C = (st & 1) * 32 + (swz % 64) / 2; }
__host__ __device__ __forceinline__ int perm32(int rho) { const int n = rho >> 4, i = rho & 15; return 8 * (i >> 2) + 4 * n + (i & 3); }

struct Unit { int pm, pn, aux; };
struct Gemm { const bf16_t* A; const bf16_t* Bt; int M, N, K; const int* rowmap; };

struct StaticOrder {
    int nM, nN, nwg, G, c;
    __host__ __device__ void init(int M, int N, int G_, int c_) { nM = M / BM; nN = N / BM; nwg = nM * nN; G = G_; c = c_; }
    __host__ __device__ bool next(int i, Unit& u) const {
        const long L = (long)i * G + c; if (L >= nwg) return false;
        int wgid = (int)L; { const int q = nwg / NXCD, r = nwg % NXCD, xcd = wgid % NXCD, off = wgid / NXCD; wgid = (xcd < r ? xcd * (q + 1) : r * (q + 1) + (xcd - r) * q) + off; }
        const int nig = WGM * nN, gid = wgid / nig, fm = gid * WGM, gsz = (nM - fm) < WGM ? (nM - fm) : WGM;
        u.pm = fm + ((wgid % nig) % gsz); u.pn = (wgid % nig) / gsz; u.aux = 0; return true;
    }
    __device__ __forceinline__ void a_ready(const Unit&) const {}
    __device__ __forceinline__ void done(const Unit&) const {}
};

__device__ __forceinline__ unsigned cvt_pk_bf16(float lo, float hi) { unsigned r; asm volatile("v_cvt_pk_bf16_f32 %0, %1, %2" : "=v"(r) : "v"(lo), "v"(hi)); return r; }
template <class Epi, class Sched, bool ALIGN_EPI = false, bool SP2 = false, bool GATHER = false>
__device__ __forceinline__ void gemm_phase(PG8_LAS unsigned char* lds, const Gemm g, const Sched& S, const Epi& E) {
    int tid = threadIdx.x; asm volatile("" : "+v"(tid));
    const int wid = __builtin_amdgcn_readfirstlane(tid >> 6), lane = tid & 63, wr = wid >> 2, wc = wid & 3, fr = lane & 15, fq = lane >> 4;
    const int K = g.K, nt = K / BK;
    unsigned voffA[2], voffB[2];
#pragma unroll
    for (int i = 0; i < 2; ++i) { int R, C; stage_rc(tid * 16 + i * 8192, R, C); const int Rb = Epi::PERM ? ((R & ~31) + perm32(R & 31)) : R;
        voffA[i] = (unsigned)(R * K + C) * 2u; voffB[i] = (unsigned)(Rb * K + C) * 2u; }
    unsigned gc[2][2] = {{0u, 0u}, {0u, 0u}}, gn[2][2] = {{0u, 0u}, {0u, 0u}};
#define PG8_GLOAD(gv, pm_) do { _Pragma("unroll") for (int _h = 0; _h < 2; ++_h) _Pragma("unroll") for (int _i = 0; _i < 2; ++_i) { int _R, _C; stage_rc(tid * 16 + _i * 8192, _R, _C); \
        int _row = g.rowmap[(pm_) * BM + _h * HALF + _R]; _row = _row < 0 ? 0 : _row; gv[_h][_i] = (unsigned)(_row * K + _C) * 2u; } } while (0)
    const size_t kstep = (size_t)(BK * 2);
    const size_t hstep = (size_t)HALF * K * 2;
    const size_t tstep = 2 * hstep;
    const unsigned ldsw = (unsigned)wid * 1024u;
    const int aoff = lds_byte(wr * 64 + fr, fq * 8), boff = lds_byte(wc * 32 + fr, fq * 8);
#define PG8_SA(b, h) (((b) * 2 + (h)) * HTB)
#define PG8_SB(b, h) ((4 + (b) * 2 + (h)) * HTB)
#define PG8_STAGE(bufoff, gbase, voff) do { _Pragma("unroll") for (int _i = 0; _i < 2; ++_i) \
        __builtin_amdgcn_global_load_lds((const unsigned*)((const char*)(gbase) + (voff)[_i]), (PG8_LAS unsigned*)(lds + (bufoff) + ldsw + _i * 8192), 16, 0, 0); } while (0)
#define PG8_STAGE_A(bufoff, gbase, h, sel) do { if constexpr (GATHER) { unsigned vo_[2]; vo_[0] = (sel) ? gn[h][0] : gc[h][0]; vo_[1] = (sel) ? gn[h][1] : gc[h][1]; PG8_STAGE(bufoff, gbase, vo_); } \
        else { PG8_STAGE(bufoff, (gbase) + (h) * hstep, voffA); } } while (0)
#define PG8_LDA(dst, b, h) do { _Pragma("unroll") for (int m = 0; m < 4; ++m) _Pragma("unroll") for (int k = 0; k < 2; ++k) dst[m][k] = *(const PG8_LAS bf16x8*)(lds + PG8_SA(b, h) + aoff + m * 2048 + k * 1024); } while (0)
#define PG8_LDB(dst, b, h) do { _Pragma("unroll") for (int n = 0; n < 2; ++n) _Pragma("unroll") for (int k = 0; k < 2; ++k) dst[n][k] = *(const PG8_LAS bf16x8*)(lds + PG8_SB(b, h) + boff + n * 2048 + k * 1024); } while (0)
#define PG8_MMA(ai, bj, At, Bt) do { __builtin_amdgcn_s_setprio(1); _Pragma("unroll") for (int m = 0; m < 4; ++m) _Pragma("unroll") for (int n = 0; n < 2; ++n) _Pragma("unroll") for (int k = 0; k < 2; ++k) \
        acc[ai][bj][m][n] = __builtin_amdgcn_mfma_f32_16x16x32_bf16(Bt[n][k], At[m][k], acc[ai][bj][m][n], 0, 0, 0); __builtin_amdgcn_s_setprio(0); } while (0)
#define PG8_WAIT_V(n) asm volatile("s_waitcnt vmcnt(" #n ")" ::: "memory")
#define PG8_WAIT_L(n) asm volatile("s_waitcnt lgkmcnt(" #n ")" ::: "memory")
#define PG8_BAR __builtin_amdgcn_s_barrier()
#define PG8_SCHED __builtin_amdgcn_sched_barrier(0)
    Unit cur, nxt; int ui = 0;
    if (!S.next(0, cur)) return;
    f32x4 acc[2][2][4][2];
#pragma unroll
    for (int a = 0; a < 2; ++a)
#pragma unroll
        for (int b = 0; b < 2; ++b)
#pragma unroll
            for (int m = 0; m < 4; ++m)
#pragma unroll
                for (int n = 0; n < 2; ++n) acc[a][b][m][n] = (f32x4){0.f, 0.f, 0.f, 0.f};
    bf16x8 At[4][2], B0[2][2], B1[2][2];
    const char* cA = GATHER ? (const char*)g.A : (const char*)g.A + (size_t)cur.pm * tstep; const char* cB = (const char*)g.Bt + (size_t)cur.pn * tstep;
    if constexpr (GATHER) { PG8_GLOAD(gc, cur.pm); }
    S.a_ready(cur);
    if constexpr (SP2) {
        PG8_STAGE(PG8_SB(0, 0), cB, voffB); PG8_STAGE(PG8_SB(0, 1), cB + hstep, voffB); PG8_STAGE_A(PG8_SA(0, 0), cA, 0, false); PG8_STAGE_A(PG8_SA(0, 1), cA, 1, false);
        if (wr == 1) PG8_BAR;
        PG8_WAIT_V(2); PG8_BAR;
        PG8_STAGE(PG8_SB(1, 0), cB + kstep, voffB); PG8_STAGE_A(PG8_SA(1, 0), cA + kstep, 0, false); PG8_STAGE(PG8_SB(1, 1), cB + hstep + kstep, voffB);
        PG8_WAIT_V(6); PG8_BAR;
    } else {
        PG8_STAGE(PG8_SB(0, 0), cB, voffB); PG8_STAGE_A(PG8_SA(0, 0), cA, 0, false); PG8_STAGE(PG8_SB(0, 1), cB + hstep, voffB); PG8_STAGE_A(PG8_SA(0, 1), cA, 1, false);
        if (wr == 1) PG8_BAR;
        PG8_WAIT_V(4); PG8_BAR;
        PG8_STAGE(PG8_SB(1, 0), cB + kstep, voffB); PG8_STAGE_A(PG8_SA(1, 0), cA + kstep, 0, false); PG8_STAGE(PG8_SB(1, 1), cB + hstep + kstep, voffB);
        PG8_WAIT_V(6); PG8_BAR;
    }
    for (;;) {
        const bool has_next = S.next(ui + 1, nxt);
        const char* nA = GATHER ? cA : (has_next ? (const char*)g.A + (size_t)nxt.pm * tstep : cA);
        if constexpr (GATHER) { if (has_next) { PG8_GLOAD(gn, nxt.pm); } else { gn[0][0] = gc[0][0]; gn[0][1] = gc[0][1]; gn[1][0] = gc[1][0]; gn[1][1] = gc[1][1]; } }
        const char* nB = has_next ? (const char*)g.Bt + (size_t)nxt.pn * tstep : cB;
        for (int t = 0; t < nt; t += 2) {
            const bool last = (t == nt - 2);
            const char* a1 = cA + (size_t)(t + 1) * kstep;
            const char* a2 = last ? nA : cA + (size_t)(t + 2) * kstep; const char* b2 = last ? nB : cB + (size_t)(t + 2) * kstep;
            const char* a3 = a2 + kstep; const char* b3 = b2 + kstep;
            if (last && has_next) S.a_ready(nxt);
            if constexpr (SP2) {
            PG8_LDB(B0, 0, 0); PG8_LDB(B1, 0, 1); PG8_SCHED; PG8_LDA(At, 0, 0); PG8_STAGE_A(PG8_SA(1, 1), a1, 1, false);
            PG8_WAIT_V(8); PG8_WAIT_L(0); PG8_BAR; PG8_MMA(0, 0, At, B0); PG8_MMA(0, 1, At, B1); PG8_BAR; PG8_SCHED;
            PG8_LDA(At, 0, 1); PG8_STAGE(PG8_SB(0, 0), b2, voffB); PG8_STAGE(PG8_SB(0, 1), b2 + hstep, voffB); PG8_STAGE_A(PG8_SA(0, 0), a2, 0, last);
            PG8_WAIT_V(8); PG8_WAIT_L(0); PG8_BAR; PG8_MMA(1, 0, At, B0); PG8_MMA(1, 1, At, B1); PG8_BAR; PG8_SCHED;
            PG8_LDB(B0, 1, 0); PG8_LDB(B1, 1, 1); PG8_SCHED; PG8_LDA(At, 1, 0); PG8_STAGE_A(PG8_SA(0, 1), a2, 1, last);
            PG8_WAIT_V(8); PG8_WAIT_L(0); PG8_BAR; PG8_MMA(0, 0, At, B0); PG8_MMA(0, 1, At, B1); PG8_BAR; PG8_SCHED;
            PG8_LDA(At, 1, 1); PG8_STAGE(PG8_SB(1, 0), b3, voffB); PG8_STAGE(PG8_SB(1, 1), b3 + hstep, voffB); PG8_STAGE_A(PG8_SA(1, 0), a3, 0, last);
            PG8_WAIT_V(8); PG8_WAIT_L(0); PG8_BAR; PG8_MMA(1, 0, At, B0); PG8_MMA(1, 1, At, B1); PG8_BAR; PG8_SCHED;
            } else {
            PG8_LDB(B0, 0, 0); PG8_SCHED; PG8_LDA(At, 0, 0); PG8_STAGE_A(PG8_SA(1, 1), a1, 1, false);
            PG8_WAIT_L(8); PG8_BAR; PG8_WAIT_L(0); PG8_MMA(0, 0, At, B0); PG8_BAR; PG8_SCHED;
            PG8_LDB(B1, 0, 1); PG8_STAGE(PG8_SB(0, 0), b2, voffB);
            PG8_BAR; PG8_WAIT_L(0); PG8_MMA(0, 1, At, B1); PG8_BAR;
            PG8_LDA(At, 0, 1); PG8_STAGE_A(PG8_SA(0, 0), a2, 0, last);
            PG8_BAR; PG8_WAIT_L(0); PG8_MMA(1, 0, At, B0); PG8_BAR; PG8_SCHED;
            PG8_STAGE(PG8_SB(0, 1), b2 + hstep, voffB);
            PG8_WAIT_V(6); PG8_BAR; PG8_MMA(1, 1, At, B1); PG8_BAR;
            PG8_LDB(B0, 1, 0); PG8_SCHED; PG8_LDA(At, 1, 0); PG8_STAGE_A(PG8_SA(0, 1), a2, 1, last);
            PG8_WAIT_L(8); PG8_BAR; PG8_WAIT_L(0); PG8_MMA(0, 0, At, B0); PG8_BAR; PG8_SCHED;
            PG8_LDB(B1, 1, 1); PG8_STAGE(PG8_SB(1, 0), b3, voffB);
            PG8_BAR; PG8_WAIT_L(0); PG8_MMA(0, 1, At, B1); PG8_BAR;
            PG8_LDA(At, 1, 1); PG8_STAGE_A(PG8_SA(1, 0), a3, 0, last);
            PG8_BAR; PG8_WAIT_L(0); PG8_MMA(1, 0, At, B0); PG8_BAR; PG8_SCHED;
            PG8_STAGE(PG8_SB(1, 1), b3 + hstep, voffB);
            PG8_WAIT_V(6); PG8_BAR; PG8_MMA(1, 1, At, B1); PG8_BAR;
            }
        }
        if constexpr (ALIGN_EPI) { if (wr == 0) PG8_BAR; }
        if constexpr (!Epi::AFTER_DRAIN) { E(acc, cur, wr, wc, fr, fq); S.done(cur); }
        if (!has_next) break;
#pragma unroll
        for (int a = 0; a < 2; ++a)
#pragma unroll
            for (int b = 0; b < 2; ++b)
#pragma unroll
                for (int m = 0; m < 4; ++m)
#pragma unroll
                    for (int n = 0; n < 2; ++n) acc[a][b][m][n] = (f32x4){0.f, 0.f, 0.f, 0.f};
        cur = nxt; cA = nA; cB = nB; ++ui;
        if constexpr (GATHER) { gc[0][0] = gn[0][0]; gc[0][1] = gn[0][1]; gc[1][0] = gn[1][0]; gc[1][1] = gn[1][1]; }
        if constexpr (ALIGN_EPI) { if (wr == 1) PG8_BAR; }
    }
    PG8_WAIT_V(0);
    if constexpr (!ALIGN_EPI) { if (wr == 0) PG8_BAR; }
    PG8_BAR;
    if constexpr (Epi::AFTER_DRAIN) { E.fused(acc, cur, wr, wc, fr, fq, lds, wid, lane); S.done(cur); }
#undef PG8_SA
#undef PG8_SB
#undef PG8_STAGE
#undef PG8_STAGE_A
#undef PG8_GLOAD
#undef PG8_LDA
#undef PG8_LDB
#undef PG8_MMA
#undef PG8_WAIT_V
#undef PG8_WAIT_L
#undef PG8_BAR
#undef PG8_SCHED
}
}

#define GAS __attribute__((address_space(1)))
#define LAS __attribute__((address_space(3)))
typedef unsigned short bf16;
typedef unsigned v4u __attribute__((ext_vector_type(4)));
typedef unsigned v2u __attribute__((ext_vector_type(2)));
typedef float f32x4 __attribute__((ext_vector_type(4)));
typedef short bf16x8 __attribute__((ext_vector_type(8)));
typedef GAS unsigned gu32;

constexpr int NWAVES = 8, NTHR = 512;
constexpr int BATCH = 8, SEQ = 8192, T = BATCH * SEQ, D = 1024, MEMLEN = 256, TMEM = BATCH * MEMLEN;
constexpr int INW = 3080, NIN = 3072, NKV = 512;
constexpr int NBUCKET = 24, ROWS_MAX = T + NBUCKET * 256;
constexpr float EPSN = 1e-6f;
constexpr float C2 = 0.125f * 1.4426950408889634f;
constexpr float LOG2E = 1.4426950408889634f;

constexpr size_t MiB = 1u << 20;
constexpr size_t WS_CTL = 0, CTL_ZERO_BYTES = 1 * MiB;
constexpr size_t WS_ROPE = 2 * MiB;
constexpr size_t WS_IG = 6 * MiB;
constexpr size_t WS_FG = 7 * MiB;
constexpr size_t WS_LSE = 8 * MiB;
constexpr size_t WS_SS1 = 14 * MiB;
constexpr size_t WS_SS3 = 18 * MiB;
constexpr size_t WS_KVX = 22 * MiB;
constexpr size_t WS_NLOC = 24 * MiB;
constexpr size_t WS_NPREV = 25 * MiB;
constexpr size_t WS_MLOC = 26 * MiB;
constexpr size_t WS_BLAST = 26 * MiB + 64 * 1024;
constexpr size_t WS_MPREV = 26 * MiB + 128 * 1024;
constexpr size_t WS_TOKINFO = 27 * MiB;
constexpr size_t WS_TOKMAP = 28 * MiB;
constexpr size_t WS_WSORT = 19 * MiB;
constexpr size_t WS_WR = 30 * MiB;
constexpr size_t WS_WG = 30 * MiB + 512 * 1024;
constexpr size_t WS_PAR = 31 * MiB;
constexpr int PAR_CONVW = 0, PAR_CONVB = 2048, PAR_GMHN = 2560, PAR_SKIP = 3072, PAR_BRG = 3584, PAR_BRE = 3600, PAR_GFIN = 3616, PAR_N = 4640;
constexpr size_t WS_WIN = 32 * MiB;
constexpr size_t WS_WOUT = 39 * MiB;
constexpr size_t WS_WQX = 41 * MiB;
constexpr size_t WS_WOX = 41 * MiB + 512 * 1024;
constexpr size_t WS_WM = 42 * MiB;
constexpr size_t WS_W13 = 44 * MiB;
constexpr size_t WS_W2P = 76 * MiB;
constexpr size_t WS_XN = 128 * MiB;
constexpr size_t WS_CLOC = 128 * MiB;
constexpr size_t WS_GAGG = 192 * MiB;
constexpr size_t WS_GN = 200 * MiB;
constexpr size_t WS_GSC = 200 * MiB + 512 * 1024;
constexpr size_t WS_Q = 264 * MiB;
constexpr size_t WS_K = 328 * MiB, WS_V = 392 * MiB, WS_MU = 456 * MiB, WS_MV = 520 * MiB, WS_MO = 584 * MiB;
constexpr size_t WS_MQ = 648 * MiB, WS_MK = 712 * MiB;
constexpr size_t WS_Y = 264 * MiB;
constexpr size_t WS_CPREV = 392 * MiB;
constexpr size_t WS_X1B = 648 * MiB;
constexpr size_t WS_QX = 776 * MiB;
constexpr size_t WS_OX = 808 * MiB;
constexpr size_t WS_HBS = 264 * MiB;
constexpr size_t WS_ACT = 404 * MiB;
constexpr size_t WS_END = 840 * MiB;
constexpr size_t DO_OATT = 0, DO_C = 192 * MiB;

constexpr int CW_BAR = 4096;
constexpr int CW_CNT = 8192;
constexpr int CW_FILL = 8192 + 64;

constexpr int LDS_BYTES = 163840;
constexpr int LDS_MISC = 159744;
constexpr int LDS_RS = 135168;
constexpr int LDS_TAB = 136192;

#define LDS_WAIT() asm volatile("s_waitcnt lgkmcnt(0)" ::: "memory")
#define VM_WAIT() asm volatile("s_waitcnt vmcnt(0)" ::: "memory")
__device__ __forceinline__ unsigned f2bf(float f) { unsigned u = __builtin_bit_cast(unsigned, f); return (u + 0x7fffu + ((u >> 16) & 1u)) >> 16; }
typedef float f32x2_t __attribute__((ext_vector_type(2))); typedef __bf16 bf16x2_t __attribute__((ext_vector_type(2)));
__device__ __forceinline__ unsigned pk2(float lo, float hi) { f32x2_t v = {lo, hi}; bf16x2_t b = __builtin_convertvector(v, bf16x2_t); return __builtin_bit_cast(unsigned, b); }
__device__ __forceinline__ float bf2f(unsigned h) { return __uint_as_float(h << 16); }
__device__ __forceinline__ float bflo(unsigned w) { return __uint_as_float(w << 16); }
__device__ __forceinline__ float bfhi(unsigned w) { return __uint_as_float(w & 0xffff0000u); }
__device__ __forceinline__ float wave_sum(float v) {
#pragma unroll
    for (int o = 1; o < 64; o <<= 1) v += __shfl_xor(v, o);
    return v;
}
__device__ __forceinline__ float wave_max(float v) {
#pragma unroll
    for (int o = 1; o < 64; o <<= 1) v = fmaxf(v, __shfl_xor(v, o));
    return v;
}
__device__ __forceinline__ float fexp_(float x) { return __builtin_amdgcn_exp2f(x * 1.4426950408889634f); }
__device__ __forceinline__ float frcp_(float x) { return __builtin_amdgcn_rcpf(x); }
__device__ __forceinline__ float sigmoidf_(float x) { return __builtin_amdgcn_rcpf(1.0f + __builtin_amdgcn_exp2f(x * -1.4426950408889634f)); }

#define XB_TMO      128
#define XB_XCNT(j)  (256  + 64 * (j))
#define XB_XSUB(j)  (1280 + 64 * (j))
#define XB_XGEN(j)  (2304 + 64 * (j))
#define XB_TOP      3328
#define XB_TOPGEN   3392
#define XCD_BAR_WORDS 3456
#define XB_SPIN_CAP (1u << 22)
__device__ __forceinline__ unsigned xb_ld(unsigned* p)              { return __hip_atomic_load(p, __ATOMIC_RELAXED, __HIP_MEMORY_SCOPE_AGENT); }
__device__ __forceinline__ unsigned xb_add(unsigned* p, unsigned v) { return __hip_atomic_fetch_add(p, v, __ATOMIC_RELAXED, __HIP_MEMORY_SCOPE_AGENT); }
__device__ __forceinline__ unsigned xb_xcc_id() { return (unsigned)__builtin_amdgcn_s_getreg((3 << 11) | 20) & 0xFu; }
#define XB_SPIN(cond, bar) do { unsigned _sp = 0; while (cond) { __builtin_amdgcn_s_sleep(1); \
    if ((++_sp & 255u) == 0u) { if (xb_ld(&(bar)[XB_TMO])) break; if (_sp > XB_SPIN_CAP) { atomicAdd(&(bar)[XB_TMO], 1u); break; } } } } while (0)
struct XcdBarrier { unsigned* bar; unsigned x; volatile LAS unsigned* st; };
__device__ __forceinline__ XcdBarrier xcd_barrier_post(unsigned* bar, volatile LAS unsigned* st) {
    XcdBarrier b; b.bar = bar; b.x = xb_xcc_id(); b.st = st;
    if (threadIdx.x == 0) (void)xb_add(&bar[XB_XCNT(b.x)], 1u);
    return b;
}
__device__ __forceinline__ void xcd_barrier_complete(unsigned* bar, unsigned x, unsigned& nloc, unsigned& nx) {
    const unsigned G = gridDim.x * gridDim.y * gridDim.z;
    unsigned sum, cnt, mine, sp = 0u;
    for (;;) {
        sum = 0u; cnt = 0u; mine = 0u;
#pragma unroll
        for (unsigned j = 0; j < 16; ++j) { const unsigned c = xb_ld(&bar[XB_XCNT(j)]); sum += c; cnt += (c > 0u) ? 1u : 0u; mine = (j == x) ? c : mine; }
        if (sum == G) break;
        __builtin_amdgcn_s_sleep(1);
        if ((++sp & 255u) == 0u) { if (xb_ld(&bar[XB_TMO])) break; if (sp > XB_SPIN_CAP) { atomicAdd(&bar[XB_TMO], 1u); break; } }
    }
    nloc = mine > 0u ? mine : 1u; nx = cnt > 0u ? cnt : 1u;
}
__device__ __forceinline__ void xcd_barrier(const XcdBarrier& b) {
    asm volatile("s_waitcnt vmcnt(0)" ::: "memory");
    __syncthreads();
    if (threadIdx.x == 0) {
        unsigned* bar = b.bar;
        __builtin_amdgcn_s_waitcnt(0);
        unsigned nloc = b.st[0], nx = b.st[1];
        if (nloc == 0u) { xcd_barrier_complete(bar, b.x, nloc, nx); b.st[0] = nloc; b.st[1] = nx; }
        const unsigned old = xb_add(&bar[XB_XSUB(b.x)], 1u);
        const unsigned gen = old / nloc;
        if (old + 1u == (gen + 1u) * nloc) {
            __builtin_amdgcn_fence(__ATOMIC_RELEASE, "agent");
            asm volatile("s_waitcnt vmcnt(0)" ::: "memory");
            const unsigned og = xb_add(&bar[XB_TOP], 1u);
            const unsigned tg = og / nx;
            if (og + 1u == (tg + 1u) * nx) xb_add(&bar[XB_TOPGEN], 1u);
            else XB_SPIN(xb_ld(&bar[XB_TOPGEN]) == tg, bar);
            __builtin_amdgcn_fence(__ATOMIC_ACQUIRE, "agent");
            xb_add(&bar[XB_XGEN(b.x)], 1u);
            asm volatile("s_waitcnt vmcnt(0)" ::: "memory");
        } else {
            XB_SPIN(xb_ld(&bar[XB_XGEN(b.x)]) == gen, bar);
            __builtin_amdgcn_fence(__ATOMIC_ACQUIRE, "agent");
            asm volatile("s_waitcnt vmcnt(0)" ::: "memory");
        }
    }
    __syncthreads();
}

struct Args { const void* in[28]; float* out; unsigned char* ws; int ph_lo, ph_hi; };

template <int MI, int NJ>
__device__ __forceinline__ void wave_mma(const bf16* A, int lda, const bf16* Bt, int ldb, int K, f32x4 (&acc)[MI][NJ], int fr, int fq) {
    for (int k0 = 0; k0 < K; k0 += 32) {
        bf16x8 a[MI], b[NJ];
#pragma unroll
        for (int i = 0; i < MI; ++i) a[i] = *(const bf16x8*)(A + (16 * i + fr) * lda + k0 + 8 * fq);
#pragma unroll
        for (int j = 0; j < NJ; ++j) b[j] = *(const bf16x8*)(Bt + (16 * j + fr) * ldb + k0 + 8 * fq);
#pragma unroll
        for (int i = 0; i < MI; ++i)
#pragma unroll
            for (int j = 0; j < NJ; ++j) acc[i][j] = __builtin_amdgcn_mfma_f32_16x16x32_bf16(b[j], a[i], acc[i][j], 0, 0, 0);
    }
}

__device__ __forceinline__ void transpose_item(const float* src, int src_ld, int k0, int n0, bf16* dst, int dst_ld, int dst_row0, int dst_col0,
                                               const float* gain, float scale, LAS float* scr, int lane) {
    f32x4 ld[16];
#pragma unroll
    for (int i = 0; i < 16; ++i) { const int kk = 4 * i + (lane >> 4); ld[i] = *(const f32x4*)(src + (size_t)(k0 + kk) * src_ld + n0 + 4 * (lane & 15)); }
#pragma unroll
    for (int i = 0; i < 16; ++i) { const int kk = 4 * i + (lane >> 4); *(LAS f32x4*)(scr + kk * 64 + 4 * ((lane & 15) ^ ((kk >> 3) & 15))) = ld[i]; }
    const int c = lane & 7;
    f32x4 g0 = (f32x4){scale, scale, scale, scale}, g1 = g0;
    if (gain) { g0 = *(const f32x4*)(gain + k0 + 8 * c) * scale; g1 = *(const f32x4*)(gain + k0 + 8 * c + 4) * scale; }
    LDS_WAIT(); asm volatile("" ::: "memory");
#pragma unroll
    for (int j = 0; j < 8; ++j) { const int n = (lane >> 3) + 8 * j; const LAS float* s = scr + (8 * c) * 64 + 4 * ((n >> 2) ^ c) + (n & 3);
        v4u o; o.x = pk2(s[0 * 64] * g0[0], s[1 * 64] * g0[1]); o.y = pk2(s[2 * 64] * g0[2], s[3 * 64] * g0[3]); o.z = pk2(s[4 * 64] * g1[0], s[5 * 64] * g1[1]); o.w = pk2(s[6 * 64] * g1[2], s[7 * 64] * g1[3]);
        *(v4u*)(dst + (size_t)(dst_row0 + n) * dst_ld + dst_col0 + 8 * c) = o; }
    LDS_WAIT(); asm volatile("" ::: "memory");
}

__device__ __forceinline__ void p0_prologue(const Args& A, unsigned char* lds, int tid, int lane, int wave) {
    unsigned char* ws = A.ws;
    const float* x = (const float*)A.in[0]; const float* mem = (const float*)A.in[1]; const int* positions = (const int*)A.in[2];
    const float* g_mix = (const float*)A.in[3]; const float* w_in = (const float*)A.in[4];
    const float* w_q_m = (const float*)A.in[7]; const float* w_k_m = (const float*)A.in[8];
    const float* b_i = (const float*)A.in[9]; const float* b_f = (const float*)A.in[10];
    const float* w_out = (const float*)A.in[13]; const float* g_cross = (const float*)A.in[14]; const float* g_mem = (const float*)A.in[15];
    const float* w_q_x = (const float*)A.in[16]; const float* w_kv_x = (const float*)A.in[17]; const float* w_o_x = (const float*)A.in[18];
    const float* g_ffn = (const float*)A.in[19]; const float* w_rg = (const float*)A.in[20]; const float* w_re = (const float*)A.in[22];
    const float* w1 = (const float*)A.in[24]; const float* w3 = (const float*)A.in[25]; const float* w2 = (const float*)A.in[26];
    const int G = gridDim.x, gw = blockIdx.x * NWAVES + wave, NGW = G * NWAVES, gt = blockIdx.x * NTHR + tid, NGT = G * NTHR;

    LAS float* WGl = (LAS float*)lds;
    for (int i = tid; i < 8 * 1024; i += NTHR) { const int k = i >> 3, j = i & 7; WGl[j * 1024 + k] = g_mix[k] * w_in[(size_t)k * INW + NIN + j]; }

    for (int i = gt; i < PAR_N; i += NGT) { float v;
        if (i < PAR_CONVB) v = ((const float*)A.in[5])[i]; else if (i < PAR_GMHN) v = ((const float*)A.in[6])[i - PAR_CONVB]; else if (i < PAR_SKIP) v = ((const float*)A.in[11])[i - PAR_GMHN];
        else if (i < PAR_BRG) v = ((const float*)A.in[12])[i - PAR_SKIP]; else if (i < PAR_BRE) v = ((const float*)A.in[21])[i - PAR_BRG]; else if (i < PAR_GFIN) v = ((const float*)A.in[23])[i - PAR_BRE];
        else v = ((const float*)A.in[27])[i - PAR_GFIN];
        ((float*)(ws + WS_PAR))[i] = v; }
    for (int i = gt; i < 20 * 1024; i += NGT) { const int e = i >> 10, k = i & 1023;
        ((float*)(ws + WS_WR))[i] = g_ffn[k] * (e < 4 ? w_rg[k * 4 + e] : w_re[k * 16 + (e - 4)]); }
    for (int i = gt; i < T * 8; i += NGT) { const int t = i >> 3, j = i & 7; const float invf = powf(500000.0f, -(float)j * 0.125f);
        const float ang = (float)positions[t] * invf; float sn, cs; sincosf(ang, &sn, &cs);
        ((float*)(ws + WS_ROPE))[t * 16 + j] = cs; ((float*)(ws + WS_ROPE))[t * 16 + 8 + j] = sn; }
    __syncthreads();
    for (int m0 = 2 * gw; m0 < T + TMEM; m0 += 2 * NGW) {
        f32x4 v[2][4]; float rstd[2];
#pragma unroll
        for (int q = 0; q < 2; ++q) { const int m = m0 + q; const f32x4* xr = (const f32x4*)(m >= T ? mem + (size_t)(m - T) * D : x + (size_t)m * D) + lane;
#pragma unroll
            for (int j = 0; j < 4; ++j) v[q][j] = xr[64 * j]; }
#pragma unroll
        for (int q = 0; q < 2; ++q) { float s = 0.f;
#pragma unroll
            for (int j = 0; j < 4; ++j) s += (v[q][j].x * v[q][j].x + v[q][j].y * v[q][j].y) + (v[q][j].z * v[q][j].z + v[q][j].w * v[q][j].w);
            rstd[q] = 1.0f / sqrtf(wave_sum(s) * (1.0f / D) + EPSN);
            unsigned long long* o8 = (unsigned long long*)(ws + WS_XN + (size_t)(m0 + q) * D * 2) + lane;
#pragma unroll
            for (int j = 0; j < 4; ++j) o8[64 * j] = (unsigned long long)pk2(v[q][j].x * rstd[q], v[q][j].y * rstd[q]) | ((unsigned long long)pk2(v[q][j].z * rstd[q], v[q][j].w * rstd[q]) << 32); }
        if (m0 < T) {
            float val0 = 0.f, val1 = 0.f;
#pragma unroll
            for (int g = 0; g < 8; ++g) { float a0 = 0.f, a1 = 0.f;
#pragma unroll
                for (int j = 0; j < 4; ++j) { const f32x4 w = *(const LAS f32x4*)(WGl + g * 1024 + 256 * j + 4 * lane);
                    a0 += (v[0][j].x * w.x + v[0][j].y * w.y) + (v[0][j].z * w.z + v[0][j].w * w.w); a1 += (v[1][j].x * w.x + v[1][j].y * w.y) + (v[1][j].z * w.z + v[1][j].w * w.w); }
                a0 = wave_sum(a0) * rstd[0]; a1 = wave_sum(a1) * rstd[1];
                val0 = (lane == g) ? a0 : val0; val1 = (lane == g) ? a1 : val1; }
            if (lane < 8) { const int h = lane & 3;
#pragma unroll
                for (int q = 0; q < 2; ++q) { const int m = m0 + q, b = m / SEQ, sq = m % SEQ; const float val = q ? val1 : val0;
                    if (lane < 4) ((float*)(ws + WS_IG))[(size_t)(b * 4 + h) * SEQ + sq] = val + b_i[h];
                    else ((float*)(ws + WS_FG))[(size_t)(b * 4 + h) * SEQ + sq] = val + b_f[h]; } }
        }
    }
    __syncthreads();
    LAS float* scr = (LAS float*)(lds + wave * 16384);
    constexpr int I_IN = 16 * 48, I_KV = 16 * 8, I_OUT = 16 * 16, I_QX = 16 * 4, I_OX = 4 * 16, I_M = 32, I_13 = 16 * 2 * 128, I_2P = 24 * 2 * 128;
    constexpr int NITEMS = I_IN + I_KV + I_OUT + I_QX + I_OX + I_M + I_13 + I_2P;
    for (int it = gw; it < NITEMS; it += NGW) {
        int r = it;
        if (r < I_IN) { const int kb = r / 48, nb = r % 48; transpose_item(w_in, INW, 64 * kb, 64 * nb, (bf16*)(ws + WS_WIN), 1024, 64 * nb, 64 * kb, g_mix, (64 * nb < 512) ? C2 : 1.0f, scr, lane); continue; } r -= I_IN;
        if (r < I_KV) { const int kb = r / 8, nb = r % 8; transpose_item(w_kv_x, 512, 64 * kb, 64 * nb, (bf16*)(ws + WS_WIN), 1024, NIN + 64 * nb, 64 * kb, g_mem, 1.0f, scr, lane); continue; } r -= I_KV;
        if (r < I_OUT) { const int kb = r / 16, nb = r % 16; transpose_item(w_out, 1024, 64 * kb, 64 * nb, (bf16*)(ws + WS_WOUT), 1024, 64 * nb, 64 * kb, nullptr, 1.0f, scr, lane); continue; } r -= I_OUT;
        if (r < I_QX) { const int kb = r / 4, nb = r % 4; transpose_item(w_q_x, 256, 64 * kb, 64 * nb, (bf16*)(ws + WS_WQX), 1024, 64 * nb, 64 * kb, g_cross, C2, scr, lane); continue; } r -= I_QX;
        if (r < I_OX) { const int kb = r / 16, nb = r % 16; transpose_item(w_o_x, 1024, 64 * kb, 64 * nb, (bf16*)(ws + WS_WOX), 256, 64 * nb, 64 * kb, nullptr, 1.0f, scr, lane); continue; } r -= I_OX;
        if (r < I_M) { const int which = r / 16, h = (r % 16) / 4, kb = (r % 4) / 2, nb = r % 2;
            transpose_item((which ? w_k_m : w_q_m) + (size_t)h * 128 * 128, 128, 64 * kb, 64 * nb, (bf16*)(ws + WS_WM) + (size_t)(which * 4 + h) * 128 * 128, 128, 64 * nb, 64 * kb, nullptr,
                           which ? 0.08838834764831845f : 1.0f, scr, lane); continue; } r -= I_M;
        if (r < I_13) { const int e = r / 256, which = (r % 256) / 128, kb = (r % 128) / 8, nb = r % 8; const int n0 = 64 * nb;
            transpose_item((which ? w3 : w1) + (size_t)e * 1024 * 512, 512, 64 * kb, n0, (bf16*)(ws + WS_W13) + (size_t)e * 1024 * 1024, 1024, (n0 / 128) * 256 + which * 128 + (n0 % 128), 64 * kb, g_ffn, 1.0f, scr, lane); continue; } r -= I_13;
        { const int bk = r / 256, hf = (r % 256) / 128, kb = (r % 128) / 16, nb = r % 16; const int g = bk / 6, p = bk % 6;
          const int pa = (p < 3) ? 0 : (p < 5 ? 1 : 2), pb = (p < 3) ? p + 1 : (p < 5 ? p - 1 : 3); const int e = 4 * g + (hf ? pb : pa);
          transpose_item(w2 + (size_t)e * 512 * 1024, 1024, 64 * kb, 64 * nb, (bf16*)(ws + WS_W2P) + (size_t)bk * 1024 * 1024, 1024, 64 * nb, hf * 512 + 64 * kb, nullptr, 1.0f, scr, lane); }
    }
}

__device__ __forceinline__ v4u pack8(const f32x4& a, const f32x4& b) { v4u w; w.x = pk2(a[0], a[1]); w.y = pk2(a[2], a[3]); w.z = pk2(b[0], b[1]); w.w = pk2(b[2], b[3]); return w; }
struct EpiInProj {
    static constexpr bool PERM = true, AFTER_DRAIN = false;
    bf16* base; const float* rope;
    __device__ __forceinline__ void operator()(const f32x4 (&acc)[2][2][4][2], const pg8::Unit& u, int wr, int wc, int fr, int fq) const {
        const int buf = u.pn >> 1; bf16* B = base + (size_t)buf * T * 512;
        const int row0 = u.pm * 256 + wr * 64 + fr, col0 = (u.pn & 1) * 256 + wc * 32 + 8 * fq;
        const bool dorope = (buf < 2) && ((wc & 1) == 0);
#pragma unroll
        for (int ai = 0; ai < 2; ++ai)
#pragma unroll
            for (int m = 0; m < 4; ++m) { const int row = row0 + ai * 128 + m * 16; bf16* rowp = B + (size_t)row * 512 + col0;
                f32x4 cs0, cs1, sn0, sn1;
                if (dorope) { const f32x4* rp = (const f32x4*)(rope + (size_t)row * 16); cs0 = rp[0]; cs1 = rp[1]; sn0 = rp[2]; sn1 = rp[3]; }
#pragma unroll
                for (int bj = 0; bj < 2; ++bj) { f32x4 v0 = acc[ai][bj][m][0], v1 = acc[ai][bj][m][1];
                    if (dorope) { f32x4 o0, o1;
#pragma unroll
                        for (int i = 0; i < 4; ++i) { o0[i] = __shfl_xor(v0[i], 16); o1[i] = __shfl_xor(v1[i], 16); }
                        if (fq == 0) { v0 = v0 * cs0 - o0 * sn0; v1 = v1 * cs1 - o1 * sn1; }
                        else if (fq == 1) { v0 = v0 * cs0 + o0 * sn0; v1 = v1 * cs1 + o1 * sn1; } }
                    *(v4u*)(rowp + bj * 128) = pack8(v0, v1); } }
    }
};

typedef short v4i16_t __attribute__((ext_vector_type(4)));
struct AttItem { int cfg, b, h, d, nb; size_t tokb; };
__device__ __forceinline__ AttItem attn_decode(int item) {
    AttItem a; a.cfg = item >> 12; int rem = item & 4095; a.b = rem >> 9; rem &= 511; a.h = rem >> 6; const int sub = rem & 63;
    a.d = (a.cfg == 0) ? 1 : (a.cfg == 1 ? 4 : 16); const int nblk = 64 / a.d, r = sub / nblk; a.nb = sub % nblk; a.tokb = (size_t)a.b * SEQ + r; return a;
}
__device__ __forceinline__ int attn_item_of(int k, int G) {
    if (G != 256) return (int)blockIdx.x + k * G;
    const int pair = (int)(blockIdx.x & 7) + 8 * (k / 6), j = (int)(blockIdx.x >> 3), ip = j * 6 + (k % 6);
    return ((ip >> 6) << 12) | (pair << 6) | (ip & 63);
}
__device__ __forceinline__ void glds16(const void* gsrc, unsigned lds_dst) { unsigned keep;
    asm volatile("s_mov_b32 %0, m0\n\ts_mov_b32 m0, %2\n\ts_nop 0\n\tglobal_load_lds_dwordx4 %1, off\n\ts_mov_b32 m0, %0" : "=&s"(keep) : "v"(gsrc), "s"(lds_dst) : "memory"); }
__device__ __forceinline__ unsigned lds_addr_of(LAS unsigned char* p) { return (unsigned)(uintptr_t)p; }
__device__ __forceinline__ void attn_prefetch(const Args& A, LAS unsigned char* L, int item, int pslot, int oslot, bool load_prev, int lane, int wave, bf16x8 (&qf)[2]) {
    const AttItem a = attn_decode(item);
    const bf16* Kg = (const bf16*)(A.ws + WS_K) + a.h * 64; const bf16* Vg = (const bf16*)(A.ws + WS_V) + a.h * 64; const bf16* Qg = (const bf16*)(A.ws + WS_Q) + a.h * 64;
#pragma unroll
    for (int i = 0; i < 2; ++i) { const int inst = wave + 8 * i, row = 8 * inst + (lane >> 3);
        const size_t off = (a.tokb + (size_t)(128 * a.nb + row) * a.d) * 512 + ((lane & 7) ^ (lane >> 3)) * 8;
        glds16(Kg + off, (unsigned)__builtin_amdgcn_readfirstlane(lds_addr_of(L + oslot * 32768 + inst * 1024)));
        glds16(Vg + off, (unsigned)__builtin_amdgcn_readfirstlane(lds_addr_of(L + oslot * 32768 + 16384 + inst * 1024))); }
    if (load_prev) {
#pragma unroll
        for (int i = 0; i < 2; ++i) { const int inst = wave + 8 * i, row = 8 * inst + (lane >> 3);
            const size_t off = (a.tokb + (size_t)(128 * (a.nb - 1) + row) * a.d) * 512 + ((lane & 7) ^ (lane >> 3)) * 8;
            glds16(Kg + off, (unsigned)__builtin_amdgcn_readfirstlane(lds_addr_of(L + pslot * 32768 + inst * 1024)));
            glds16(Vg + off, (unsigned)__builtin_amdgcn_readfirstlane(lds_addr_of(L + pslot * 32768 + 16384 + inst * 1024))); } }
    const size_t tq = a.tokb + (size_t)(128 * a.nb + 16 * wave + (lane & 15)) * a.d;
    qf[0] = *(const bf16x8*)(Qg + tq * 512 + 8 * (lane >> 4)); qf[1] = *(const bf16x8*)(Qg + tq * 512 + 32 + 8 * (lane >> 4));
}
__device__ __forceinline__ void attn_compute(const Args& A, LAS unsigned char* L, int item, int pslot, int oslot, int lane, int wave, const bf16x8 (&qf)[2]) {
    const AttItem a = attn_decode(item);
    const int fr = lane & 15, g = lane >> 4, qi = 16 * wave + fr;
    f32x4 s[10];
#pragma unroll
    for (int tt = 0; tt < 9; ++tt) { const int t = wave + tt, key = 16 * (t & 7) + fr; LAS unsigned char* kb = L + ((t < 8) ? pslot : oslot) * 32768; s[tt] = (f32x4){0.f, 0.f, 0.f, 0.f};
#pragma unroll
        for (int ks = 0; ks < 2; ++ks) { const bf16x8 kf = *(const LAS bf16x8*)(kb + key * 128 + (((4 * ks + g) ^ (key & 7)) * 16));
            s[tt] = __builtin_amdgcn_mfma_f32_16x16x32_bf16(kf, qf[ks], s[tt], 0, 0, 0); } }
    s[9] = (f32x4){0.f, 0.f, 0.f, 0.f};
#pragma unroll
    for (int e = 0; e < 4; ++e) { s[0][e] = (4 * g + e >= fr) ? s[0][e] : -1e30f; s[8][e] = (4 * g + e <= fr) ? s[8][e] : -1e30f; }
    if (a.nb == 0) {
#pragma unroll
        for (int tt = 0; tt < 8; ++tt) if (wave + tt < 8) s[tt] = (f32x4){-1e30f, -1e30f, -1e30f, -1e30f};
    }
    float mx = -1e30f;
#pragma unroll
    for (int tt = 0; tt < 9; ++tt) mx = fmaxf(fmaxf(mx, fmaxf(s[tt][0], s[tt][1])), fmaxf(s[tt][2], s[tt][3]));
    mx = fmaxf(mx, __shfl_xor(mx, 16)); mx = fmaxf(mx, __shfl_xor(mx, 32));
    float l = 0.f;
#pragma unroll
    for (int tt = 0; tt < 9; ++tt)
#pragma unroll
        for (int e = 0; e < 4; ++e) { s[tt][e] = __builtin_amdgcn_exp2f(s[tt][e] - mx); l += s[tt][e]; }
    l += __shfl_xor(l, 16); l += __shfl_xor(l, 32);
    f32x4 o[4];
#pragma unroll
    for (int dt = 0; dt < 4; ++dt) o[dt] = (f32x4){0.f, 0.f, 0.f, 0.f};
#pragma unroll
    for (int k5 = 0; k5 < 5; ++k5) {
        const v4u pw = (v4u){pk2(s[2 * k5][0], s[2 * k5][1]), pk2(s[2 * k5][2], s[2 * k5][3]), pk2(s[2 * k5 + 1][0], s[2 * k5 + 1][1]), pk2(s[2 * k5 + 1][2], s[2 * k5 + 1][3])};
        const bf16x8 pf = __builtin_bit_cast(bf16x8, pw);
        const int t0 = wave + 2 * k5, t1 = (wave + 2 * k5 + 1 < 16) ? wave + 2 * k5 + 1 : 15;
        const int r0 = 16 * (t0 & 7) + 4 * g + (fr >> 2), r1 = 16 * (t1 & 7) + 4 * g + (fr >> 2), p_ = fr & 3;
        LAS unsigned char* v0b = L + ((t0 < 8) ? pslot : oslot) * 32768 + 16384; LAS unsigned char* v1b = L + ((t1 < 8) ? pslot : oslot) * 32768 + 16384;
#pragma unroll
        for (int dt = 0; dt < 4; ++dt) { const int chunk = 2 * dt + (p_ >> 1);
            const v4i16_t v0 = __builtin_amdgcn_ds_read_tr16_b64_v4i16((LAS v4i16_t*)(v0b + r0 * 128 + ((chunk ^ (r0 & 7)) * 16) + 8 * (p_ & 1)));
            const v4i16_t v1 = __builtin_amdgcn_ds_read_tr16_b64_v4i16((LAS v4i16_t*)(v1b + r1 * 128 + ((chunk ^ (r1 & 7)) * 16) + 8 * (p_ & 1)));
            const bf16x8 vf = (bf16x8){v0[0], v0[1], v0[2], v0[3], v1[0], v1[1], v1[2], v1[3]};
            o[dt] = __builtin_amdgcn_mfma_f32_16x16x32_bf16(vf, pf, o[dt], 0, 0, 0); } }
    const float rl = frcp_(l);
    const size_t tok = a.tokb + (size_t)(128 * a.nb + qi) * a.d;
    bf16* og = (bf16*)((unsigned char*)A.out + DO_OATT) + ((size_t)a.cfg * T + tok) * 512 + a.h * 64;
#pragma unroll
    for (int dt = 0; dt < 4; ++dt) *(v2u*)(og + 16 * dt + 4 * g) = (v2u){pk2(o[dt][0] * rl, o[dt][1] * rl), pk2(o[dt][2] * rl, o[dt][3] * rl)};
    if (g == 0) ((float*)(A.ws + WS_LSE))[((size_t)a.cfg * T + tok) * 8 + a.h] = mx + __builtin_amdgcn_logf(l);
}
__device__ __forceinline__ void attn_phase(const Args& A, unsigned char* lds, int n_total, int lane, int wave) {
    const int G = gridDim.x; LAS unsigned char* L = (LAS unsigned char*)lds;
    const int nk = (G == 256) ? n_total / 256 : (n_total - (int)blockIdx.x + G - 1) / G;
    if (nk <= 0) return;
    bf16x8 qa[2], qb[2];
    int it = attn_item_of(0, G); int ps, os;
    { const AttItem a = attn_decode(it); os = 0; ps = (a.nb > 0) ? 1 : 0; attn_prefetch(A, L, it, ps, os, a.nb > 0, lane, wave, qa); }
    for (int k = 0; k < nk; ++k) {
        __builtin_amdgcn_s_waitcnt(0x0F70);
        asm volatile("s_waitcnt vmcnt(0)" ::: "memory");
        __syncthreads();
        qb[0] = qa[0]; qb[1] = qa[1];
        int nit = it, nps = ps, nos = os;
        if (k + 1 < nk) { nit = attn_item_of(k + 1, G); const AttItem c = attn_decode(it), n = attn_decode(nit);
            const bool succ = (nit == it + 1) && (n.nb == c.nb + 1);
            const int used = (1 << ps) | (1 << os); const int f1 = (used & 1) ? ((used & 2) ? ((used & 4) ? 3 : 2) : 1) : 0; const int used2 = used | (1 << f1);
            const int f2 = (used2 & 1) ? ((used2 & 2) ? ((used2 & 4) ? 3 : 2) : 1) : 0;
            bool lp;
            if (succ) { nps = os; nos = f1; lp = false; } else if (n.nb == 0) { nos = f1; nps = f1; lp = false; } else { nps = f1; nos = f2; lp = true; }
            attn_prefetch(A, L, nit, nps, nos, lp, lane, wave, qb); }
        attn_compute(A, L, it, ps, os, lane, wave, qa);
        qa[0] = qb[0]; qa[1] = qb[1]; it = nit; ps = nps; os = nos;
    }
    asm volatile("s_waitcnt vmcnt(0)" ::: "memory");
    __syncthreads();
}

__device__ __forceinline__ void kv_tile(const Args& A, unsigned char* lds, int tile, int tid, int lane, int wave) {
    unsigned char* ws = A.ws;
    const int mt = tile >> 3, nt = tile & 7;
    const bf16* Ag = (const bf16*)(ws + WS_XN) + (size_t)(T + 64 * mt) * D; const bf16* Bg = (const bf16*)(ws + WS_WIN) + (size_t)(NIN + 64 * nt) * D;
    bf16* As = (bf16*)lds; bf16* Bs = (bf16*)(lds + 64 * 264 * 2);
    const int fr = lane & 15, fq = lane >> 4, wm = wave & 3, wn = wave >> 2;
    f32x4 acc[1][2]; acc[0][0] = (f32x4){0.f, 0.f, 0.f, 0.f}; acc[0][1] = (f32x4){0.f, 0.f, 0.f, 0.f};
    for (int kc = 0; kc < 4; ++kc) {
        for (int id = tid; id < 64 * 32; id += NTHR) { const int row = id >> 5, ch = id & 31;
            *(v4u*)(As + row * 264 + ch * 8) = *(const v4u*)(Ag + (size_t)row * D + kc * 256 + ch * 8);
            *(v4u*)(Bs + row * 264 + ch * 8) = *(const v4u*)(Bg + (size_t)row * D + kc * 256 + ch * 8); }
        __syncthreads();
        wave_mma<1, 2>(As + 16 * wm * 264, 264, Bs + 32 * wn * 264, 264, 256, acc, fr, fq);
        __syncthreads();
    }
    bf16* og = (bf16*)(ws + WS_KVX) + (size_t)(64 * mt + 16 * wm + fr) * NKV + 64 * nt + 32 * wn;
#pragma unroll
    for (int j = 0; j < 2; ++j) *(v2u*)(og + 16 * j + 4 * fq) = (v2u){pk2(acc[0][j][0], acc[0][j][1]), pk2(acc[0][j][2], acc[0][j][3])};
}

constexpr int ML_TILE = 32768;
constexpr int ML_G = 4 * ML_TILE;
static_assert(ML_G + 8192 <= LDS_MISC, "mlstm LDS");
__device__ __forceinline__ int sw_off(int row, int ch) { return 256 * row + 16 * (ch ^ (((row & 3) << 2) | ((row >> 2) & 3))); }
__device__ __forceinline__ bf16x8 rowfrag(LAS unsigned char* tile, int row0, int ks, int fr, int g) { return *(const LAS bf16x8*)(tile + sw_off(row0 + fr, 4 * ks + g)); }
__device__ __forceinline__ bf16x8 colfrag(LAS unsigned char* tile, int ks, int ct, int fr, int g) {
    const int r0 = 32 * ks + 8 * g + (fr >> 2), p = fr & 3, ch = 2 * ct + (p >> 1);
    const v4i16_t a = __builtin_amdgcn_ds_read_tr16_b64_v4i16((LAS v4i16_t*)(tile + sw_off(r0, ch) + 8 * (p & 1)));
    const v4i16_t b = __builtin_amdgcn_ds_read_tr16_b64_v4i16((LAS v4i16_t*)(tile + sw_off(r0 + 4, ch) + 8 * (p & 1)));
    return (bf16x8){a[0], a[1], a[2], a[3], b[0], b[1], b[2], b[3]};
}
__device__ __forceinline__ float log_sigmoidf_(float x) { return (x > 0.f) ? -log1pf(__expf(-x)) : (x - log1pf(__expf(x))); }
__device__ __forceinline__ float wscan_sum(float v0, float v1, float& o0, float& o1, int lane) {
    float x = v0 + v1;
#pragma unroll
    for (int off = 1; off < 64; off <<= 1) { const float t = __shfl_up(x, off); if (lane >= off) x += t; }
    o0 = x - v1; o1 = x; return __shfl(x, 63);
}
__device__ __forceinline__ void wscan_max(float v0, float v1, float& o0, float& o1, int lane) {
    float y = fmaxf(v0, v1);
#pragma unroll
    for (int off = 1; off < 64; off <<= 1) { const float t = __shfl_up(y, off); if (lane >= off) y = fmaxf(y, t); }
    float pre = __shfl_up(y, 1); if (lane == 0) pre = -INFINITY;
    o0 = fmaxf(pre, v0); o1 = fmaxf(pre, fmaxf(v0, v1));
}
__device__ __forceinline__ void tile_load(LAS unsigned char* tile, const bf16* src, size_t pitch, int tid) {
    v4u v[4];
#pragma unroll
    for (int i = 0; i < 4; ++i) { const int id = tid + NTHR * i, row = id >> 4, ch = id & 15; v[i] = *(const v4u*)(src + (size_t)row * pitch + ch * 8); }
#pragma unroll
    for (int i = 0; i < 4; ++i) { const int id = tid + NTHR * i, row = id >> 4, ch = id & 15; *(LAS v4u*)(tile + sw_off(row, ch)) = v[i]; }
}

__device__ __forceinline__ void ml_conv_tile(LAS unsigned char* cA, const bf16* MU, const float* conv_w, const float* conv_b, int b, int c, int h, int tid) {
    const int ch = (tid & 15) * 8;
    float w[4][8], bs[8];
#pragma unroll
    for (int j = 0; j < 4; ++j) { const f32x4 w0 = *(const f32x4*)(conv_w + j * 512 + h * 128 + ch), w1 = *(const f32x4*)(conv_w + j * 512 + h * 128 + ch + 4);
        w[j][0] = w0[0]; w[j][1] = w0[1]; w[j][2] = w0[2]; w[j][3] = w0[3]; w[j][4] = w1[0]; w[j][5] = w1[1]; w[j][6] = w1[2]; w[j][7] = w1[3]; }
    { const f32x4 b0 = *(const f32x4*)(conv_b + h * 128 + ch), b1 = *(const f32x4*)(conv_b + h * 128 + ch + 4);
      bs[0] = b0[0]; bs[1] = b0[1]; bs[2] = b0[2]; bs[3] = b0[3]; bs[4] = b1[0]; bs[5] = b1[1]; bs[6] = b1[2]; bs[7] = b1[3]; }
#pragma unroll
    for (int i = 0; i < 4; ++i) { const int l = (tid >> 4) + 32 * i;
        float a[8];
#pragma unroll
        for (int q = 0; q < 8; ++q) a[q] = bs[q];
#pragma unroll
        for (int j = 0; j < 4; ++j) { const int sp = 128 * c + l + j - 3;
            if (sp >= 0) { const v4u m = *(const v4u*)(MU + ((size_t)b * SEQ + sp) * 512 + ch);
                a[0] += bflo(m.x) * w[j][0]; a[1] += bfhi(m.x) * w[j][1]; a[2] += bflo(m.y) * w[j][2]; a[3] += bfhi(m.y) * w[j][3];
                a[4] += bflo(m.z) * w[j][4]; a[5] += bfhi(m.z) * w[j][5]; a[6] += bflo(m.w) * w[j][6]; a[7] += bfhi(m.w) * w[j][7]; } }
#pragma unroll
        for (int q = 0; q < 8; ++q) a[q] = a[q] * sigmoidf_(a[q]);
        *(LAS v4u*)(cA + sw_off(l, tid & 15)) = (v4u){pk2(a[0], a[1]), pk2(a[2], a[3]), pk2(a[4], a[5]), pk2(a[6], a[7])}; }
}
struct MGroup { f32x4 G[8]; f32x4 Gn; float B, M; };
__device__ __forceinline__ void mlstm_p1_item(const Args& A, unsigned char* lds_, int item, int& wres, MGroup& mg, int tid, int lane, int wave) {
    asm volatile("" : "+v"(tid), "+v"(lane));
    unsigned char* ws = A.ws; LAS unsigned char* lds = (LAS unsigned char*)lds_;
    const int bh = item >> 6, c = item & 63, b = bh >> 2, h = bh & 3;
    const size_t t0 = (size_t)b * SEQ + 128 * c;
    LAS unsigned char* cA = lds; LAS unsigned char* Wk = lds + 2 * ML_TILE; LAS unsigned char* Vt = lds + 3 * ML_TILE;
    LAS float* gl = (LAS float*)(lds + ML_G);
    const int fr = lane & 15, g = lane >> 4, m0 = 16 * wave;
    if (wres != h) { tile_load(Wk, (const bf16*)(ws + WS_WM) + (size_t)(4 + h) * 128 * 128, 128, tid); wres = h; }
    tile_load(Vt, (const bf16*)(ws + WS_MV) + t0 * 512 + h * 128, 512, tid);
    ml_conv_tile(cA, (const bf16*)(ws + WS_MU) + h * 128, (const float*)(ws + WS_PAR) + PAR_CONVW, (const float*)(ws + WS_PAR) + PAR_CONVB, b, c, h, tid);
    float blast, mloc;
    { const size_t gi = (size_t)bh * SEQ + 128 * c + 2 * lane;
      const float i0 = ((const float*)(ws + WS_IG))[gi], i1 = ((const float*)(ws + WS_IG))[gi + 1];
      const float f0 = log_sigmoidf_(((const float*)(ws + WS_FG))[gi]), f1 = log_sigmoidf_(((const float*)(ws + WS_FG))[gi + 1]);
      float b0, b1; blast = wscan_sum(f0, f1, b0, b1, lane);
      const float g0 = blast - b0 + i0, g1 = blast - b1 + i1; mloc = wave_max(fmaxf(g0, g1));
      gl[2 * lane] = fexp_(g0 - mloc); gl[2 * lane + 1] = fexp_(g1 - mloc); }
    __syncthreads();
    { bf16x8 af[4];
#pragma unroll
      for (int ks = 0; ks < 4; ++ks) af[ks] = rowfrag(cA, m0, ks, fr, g);
      const float wk = gl[m0 + fr];
#pragma unroll
      for (int j = 0; j < 8; ++j) { f32x4 acc = (f32x4){0.f, 0.f, 0.f, 0.f};
#pragma unroll
          for (int ks = 0; ks < 4; ++ks) acc = __builtin_amdgcn_mfma_f32_16x16x32_bf16(rowfrag(Wk, 16 * j, ks, fr, g), af[ks], acc, 0, 0, 0);
          *(LAS v2u*)(cA + sw_off(m0 + fr, 2 * j + (g >> 1)) + 8 * (g & 1)) = (v2u){pk2(acc[0] * wk, acc[1] * wk), pk2(acc[2] * wk, acc[3] * wk)}; } }
    __syncthreads();
    { f32x4 acc[8], accn = (f32x4){0.f, 0.f, 0.f, 0.f};
#pragma unroll
      for (int j = 0; j < 8; ++j) acc[j] = (f32x4){0.f, 0.f, 0.f, 0.f};
      const bf16x8 ones = (bf16x8){0x3f80, 0x3f80, 0x3f80, 0x3f80, 0x3f80, 0x3f80, 0x3f80, 0x3f80};
#pragma unroll
      for (int ks = 0; ks < 4; ++ks) { const bf16x8 vf = colfrag(Vt, ks, wave, fr, g);
#pragma unroll
          for (int j = 0; j < 8; ++j) { const bf16x8 kf = colfrag(cA, ks, j, fr, g); acc[j] = __builtin_amdgcn_mfma_f32_16x16x32_bf16(kf, vf, acc[j], 0, 0, 0);
              if (j == wave) accn = __builtin_amdgcn_mfma_f32_16x16x32_bf16(kf, ones, accn, 0, 0, 0); } }
      if ((c & 7) == 0) {
#pragma unroll
          for (int j = 0; j < 8; ++j) mg.G[j] = acc[j];
          mg.Gn = accn; mg.M = mloc; mg.B = blast;
      } else { const float mnew = fmaxf(blast + mg.M, mloc), a = fexp_(blast + mg.M - mnew), cc = fexp_(mloc - mnew);
#pragma unroll
          for (int j = 0; j < 8; ++j) mg.G[j] = mg.G[j] * a + acc[j] * cc;
          mg.Gn = mg.Gn * a + accn * cc; mg.M = mnew; mg.B += blast; }
      if ((c & 7) == 7) { const int gi = bh * 8 + (c >> 3);
          bf16* gg = (bf16*)(ws + WS_GAGG) + ((size_t)gi * 128 + m0 + fr) * 128;
#pragma unroll
          for (int j = 0; j < 8; ++j) *(v2u*)(gg + 16 * j + 4 * g) = (v2u){pk2(mg.G[j][0], mg.G[j][1]), pk2(mg.G[j][2], mg.G[j][3])};
          if (fr == 0) *(f32x4*)((float*)(ws + WS_GN) + (size_t)gi * 128 + 16 * wave + 4 * g) = mg.Gn;
          if (wave == 0 && lane == 0) { ((float*)(ws + WS_GSC))[2 * gi] = mg.B; ((float*)(ws + WS_GSC))[2 * gi + 1] = mg.M; } } }
    __syncthreads();
}

__device__ __forceinline__ void p3_scan_combine(const Args& A, int tid) {
    unsigned char* ws = A.ws;
    const int G = gridDim.x, NGT = G * NTHR;
    const bf16* OA = (const bf16*)((const unsigned char*)A.out + DO_OATT); const float* LSE = (const float*)(ws + WS_LSE);
    for (size_t id = (size_t)blockIdx.x * NTHR + tid; id < (size_t)T * 64; id += NGT) {
        const size_t t = id >> 6; const int h = (int)(id & 63) >> 3, ch = (int)(id & 7) * 8;
        const float l0 = LSE[t * 8 + h], l1 = LSE[((size_t)T + t) * 8 + h], l2 = LSE[((size_t)2 * T + t) * 8 + h];
        const float mx = fmaxf(l0, fmaxf(l1, l2)); float w0 = exp2f(l0 - mx), w1 = exp2f(l1 - mx), w2 = exp2f(l2 - mx);
        const float rs = 1.0f / (w0 + w1 + w2); w0 *= rs; w1 *= rs; w2 *= rs;
        const v4u a = *(const v4u*)(OA + t * 512 + h * 64 + ch), b = *(const v4u*)(OA + ((size_t)T + t) * 512 + h * 64 + ch), c = *(const v4u*)(OA + ((size_t)2 * T + t) * 512 + h * 64 + ch);
        v4u o;
        o.x = pk2(w0 * bflo(a.x) + w1 * bflo(b.x) + w2 * bflo(c.x), w0 * bfhi(a.x) + w1 * bfhi(b.x) + w2 * bfhi(c.x));
        o.y = pk2(w0 * bflo(a.y) + w1 * bflo(b.y) + w2 * bflo(c.y), w0 * bfhi(a.y) + w1 * bfhi(b.y) + w2 * bfhi(c.y));
        o.z = pk2(w0 * bflo(a.z) + w1 * bflo(b.z) + w2 * bflo(c.z), w0 * bfhi(a.z) + w1 * bfhi(b.z) + w2 * bfhi(c.z));
        o.w = pk2(w0 * bflo(a.w) + w1 * bflo(b.w) + w2 * bflo(c.w), w0 * bfhi(a.w) + w1 * bfhi(b.w) + w2 * bfhi(c.w));
        *(v4u*)((bf16*)(ws + WS_Y) + t * 1024 + h * 64 + ch) = o;
    }
}

struct MState { f32x4 C[8]; float n0, n1, m; };
__device__ __forceinline__ void mlstm2_entry(const Args& A, int bh, int grp, MState& st, int lane, int wave) {
    unsigned char* ws = A.ws; const int fr = lane & 15, g = lane >> 4, m0 = 16 * wave;
#pragma unroll
    for (int j = 0; j < 8; ++j) st.C[j] = (f32x4){0.f, 0.f, 0.f, 0.f};
    st.n0 = 0.f; st.n1 = 0.f; st.m = 0.f;
    for (int gp = 0; gp < grp; ++gp) { const int gi = bh * 8 + gp; const float B = ((const float*)(ws + WS_GSC))[2 * gi], M = ((const float*)(ws + WS_GSC))[2 * gi + 1];
        const float mnew = fmaxf(B + st.m, M), a = fexp_(B + st.m - mnew), cc = fexp_(M - mnew);
        const bf16* gg = (const bf16*)(ws + WS_GAGG) + ((size_t)gi * 128 + m0 + fr) * 128;
#pragma unroll
        for (int j = 0; j < 8; ++j) { const v2u w = *(const v2u*)(gg + 16 * j + 4 * g); st.C[j] = st.C[j] * a + (f32x4){bflo(w.x), bfhi(w.x), bflo(w.y), bfhi(w.y)} * cc; }
        const float* gn = (const float*)(ws + WS_GN) + (size_t)gi * 128 + 2 * lane;
        st.n0 = st.n0 * a + gn[0] * cc; st.n1 = st.n1 * a + gn[1] * cc; st.m = mnew; }
}
__device__ __forceinline__ void mlstm_p2_item(const Args& A, unsigned char* lds_, int item, MState& st, int tid, int lane, int wave) {
    asm volatile("" : "+v"(tid), "+v"(lane));
    unsigned char* ws = A.ws; LAS unsigned char* lds = (LAS unsigned char*)lds_;
    const float* g_mhn = (const float*)(ws + WS_PAR) + PAR_GMHN; const float* skip_m = (const float*)(ws + WS_PAR) + PAR_SKIP;
    const int bh = item >> 6, c = item & 63, b = bh >> 2, h = bh & 3;
    const size_t t0 = (size_t)b * SEQ + 128 * c;
    LAS unsigned char* T0 = lds; LAS unsigned char* T1 = lds + ML_TILE; LAS unsigned char* T2 = lds + 2 * ML_TILE; LAS unsigned char* T3 = lds + 3 * ML_TILE;
    LAS float* gl = (LAS float*)(lds + ML_G);
    const int fr = lane & 15, g = lane >> 4, m0 = 16 * wave, l = m0 + fr;
    { const bf16* Wg = (const bf16*)(ws + WS_WM) + (size_t)h * 128 * 128; tile_load(T1, Wg, 128, tid); tile_load(T2, Wg + 4 * 128 * 128, 128, tid); }
    tile_load(T3, (const bf16*)(ws + WS_MV) + t0 * 512 + h * 128, 512, tid);
    ml_conv_tile(T0, (const bf16*)(ws + WS_MU) + h * 128, (const float*)(ws + WS_PAR) + PAR_CONVW, (const float*)(ws + WS_PAR) + PAR_CONVB, b, c, h, tid);
    float blast, mloc;
    { const size_t gi = (size_t)bh * SEQ + 128 * c + 2 * lane; const float mprev = st.m;
      const float i0 = ((const float*)(ws + WS_IG))[gi], i1 = ((const float*)(ws + WS_IG))[gi + 1];
      const float f0 = log_sigmoidf_(((const float*)(ws + WS_FG))[gi]), f1 = log_sigmoidf_(((const float*)(ws + WS_FG))[gi + 1]);
      float b0, b1; blast = wscan_sum(f0, f1, b0, b1, lane);
      const float g0 = blast - b0 + i0, g1 = blast - b1 + i1; mloc = wave_max(fmaxf(g0, g1));
      gl[640 + 2 * lane] = fexp_(g0 - mloc); gl[640 + 2 * lane + 1] = fexp_(g1 - mloc);
      const float a0 = i0 - b0, a1 = i1 - b1; float p0, p1; wscan_max(a0, a1, p0, p1, lane);
      const float mt0 = fmaxf(b0 + mprev, b0 + p0), mt1 = fmaxf(b1 + mprev, b1 + p1);
      gl[2 * lane] = a0; gl[2 * lane + 1] = a1; gl[128 + 2 * lane] = b0 - mt0; gl[128 + 2 * lane + 1] = b1 - mt1;
      gl[256 + 2 * lane] = fexp_(b0 + mprev - mt0); gl[256 + 2 * lane + 1] = fexp_(b1 + mprev - mt1); gl[384 + 2 * lane] = fexp_(-mt0); gl[384 + 2 * lane + 1] = fexp_(-mt1);
      gl[512 + 2 * lane] = st.n0; gl[512 + 2 * lane + 1] = st.n1; }
    __syncthreads();
    v2u cp[8], qp[8], kp[8];
    { bf16x8 af[4];
#pragma unroll
      for (int ks = 0; ks < 4; ++ks) af[ks] = rowfrag(T0, m0, ks, fr, g);
#pragma unroll
      for (int j = 0; j < 8; ++j) cp[j] = *(const LAS v2u*)(T0 + sw_off(l, 2 * j + (g >> 1)) + 8 * (g & 1));
#pragma unroll
      for (int j = 0; j < 8; ++j) { f32x4 acc = (f32x4){0.f, 0.f, 0.f, 0.f};
#pragma unroll
          for (int ks = 0; ks < 4; ++ks) acc = __builtin_amdgcn_mfma_f32_16x16x32_bf16(rowfrag(T1, 16 * j, ks, fr, g), af[ks], acc, 0, 0, 0);
          qp[j] = (v2u){pk2(acc[0], acc[1]), pk2(acc[2], acc[3])}; }
#pragma unroll
      for (int j = 0; j < 8; ++j) { f32x4 acc = (f32x4){0.f, 0.f, 0.f, 0.f};
#pragma unroll
          for (int ks = 0; ks < 4; ++ks) acc = __builtin_amdgcn_mfma_f32_16x16x32_bf16(rowfrag(T2, 16 * j, ks, fr, g), af[ks], acc, 0, 0, 0);
          kp[j] = (v2u){pk2(acc[0], acc[1]), pk2(acc[2], acc[3])}; } }
    __syncthreads();
#pragma unroll
    for (int j = 0; j < 8; ++j) { const int off = sw_off(l, 2 * j + (g >> 1)) + 8 * (g & 1);
        *(LAS v2u*)(T1 + off) = qp[j]; *(LAS v2u*)(T0 + off) = kp[j]; *(LAS v2u*)(T2 + off) = (v2u){pk2(st.C[j][0], st.C[j][1]), pk2(st.C[j][2], st.C[j][3])}; }
    __syncthreads();
    bf16x8 qf[4];
#pragma unroll
    for (int ks = 0; ks < 4; ++ks) qf[ks] = rowfrag(T1, m0, ks, fr, g);
    float qn = 0.f;
    { const LAS float* np = gl + 512;
#pragma unroll
      for (int ks = 0; ks < 4; ++ks) { const f32x4 n0 = *(const LAS f32x4*)(np + 32 * ks + 8 * g), n1 = *(const LAS f32x4*)(np + 32 * ks + 8 * g + 4); const v4u w = __builtin_bit_cast(v4u, qf[ks]);
          qn += bflo(w.x) * n0[0] + bfhi(w.x) * n0[1] + bflo(w.y) * n0[2] + bfhi(w.y) * n0[3] + bflo(w.z) * n1[0] + bfhi(w.z) * n1[1] + bflo(w.w) * n1[2] + bfhi(w.w) * n1[3]; }
      qn += __shfl_xor(qn, 16); qn += __shfl_xor(qn, 32); }
    float den = 0.f;
    { const float rc = gl[128 + l];
#pragma unroll
      for (int j = 0; j < 8; ++j) { f32x4 acc = (f32x4){0.f, 0.f, 0.f, 0.f};
          if (j <= wave) {
#pragma unroll
              for (int ks = 0; ks < 4; ++ks) acc = __builtin_amdgcn_mfma_f32_16x16x32_bf16(rowfrag(T0, 16 * j, ks, fr, g), qf[ks], acc, 0, 0, 0);
#pragma unroll
              for (int e = 0; e < 4; ++e) { const int sx = 16 * j + 4 * g + e; acc[e] = (sx <= l) ? acc[e] * fexp_(rc + gl[sx]) : 0.f; den += acc[e]; } }
          *(LAS v2u*)(T1 + sw_off(l, 2 * j + (g >> 1)) + 8 * (g & 1)) = (v2u){pk2(acc[0], acc[1]), pk2(acc[2], acc[3])}; }
      den += __shfl_xor(den, 16); den += __shfl_xor(den, 32); }
    f32x4 acc[8];
    const float iw = gl[256 + l];
#pragma unroll
    for (int j = 0; j < 8; ++j) { acc[j] = (f32x4){0.f, 0.f, 0.f, 0.f};
#pragma unroll
        for (int ks = 0; ks < 4; ++ks) acc[j] = __builtin_amdgcn_mfma_f32_16x16x32_bf16(rowfrag(T2, 16 * j, ks, fr, g), qf[ks], acc[j], 0, 0, 0);
        acc[j] = acc[j] * iw; }
    asm volatile("s_waitcnt lgkmcnt(0)" ::: "memory");
#pragma unroll
    for (int ks = 0; ks < 4; ++ks) if (2 * ks <= wave) { const bf16x8 sf = rowfrag(T1, m0, ks, fr, g);
#pragma unroll
        for (int j = 0; j < 8; ++j) acc[j] = __builtin_amdgcn_mfma_f32_16x16x32_bf16(colfrag(T3, ks, j, fr, g), sf, acc[j], 0, 0, 0); }
    den += iw * qn;
    const float rden = frcp_(fmaxf(fabsf(den), gl[384 + l]));
    float sq = 0.f;
#pragma unroll
    for (int j = 0; j < 8; ++j) { acc[j] = acc[j] * rden; sq += (acc[j][0] * acc[j][0] + acc[j][1] * acc[j][1]) + (acc[j][2] * acc[j][2] + acc[j][3] * acc[j][3]); }
    sq += __shfl_xor(sq, 16); sq += __shfl_xor(sq, 32);
    const float rn = __builtin_amdgcn_rsqf(sq * (1.0f / 128.0f) + EPSN);
    const bf16* MOg = (const bf16*)(ws + WS_MO) + (t0 + l) * 512 + h * 128;
    bf16* yg = (bf16*)(ws + WS_Y) + (t0 + l) * 1024 + 512 + h * 128;
#pragma unroll
    for (int j = 0; j < 8; ++j) { const int e0 = 16 * j + 4 * g;
        const v2u mo = *(const v2u*)(MOg + e0), cc = cp[j];
        const f32x4 gm = *(const f32x4*)(g_mhn + h * 128 + e0), sk = *(const f32x4*)(skip_m + h * 128 + e0);
        const float y0 = sigmoidf_(bflo(mo.x)) * (acc[j][0] * rn * gm[0] + sk[0] * bflo(cc.x));
        const float y1 = sigmoidf_(bfhi(mo.x)) * (acc[j][1] * rn * gm[1] + sk[1] * bfhi(cc.x));
        const float y2 = sigmoidf_(bflo(mo.y)) * (acc[j][2] * rn * gm[2] + sk[2] * bflo(cc.y));
        const float y3 = sigmoidf_(bfhi(mo.y)) * (acc[j][3] * rn * gm[3] + sk[3] * bfhi(cc.y));
        *(v2u*)(yg + e0) = (v2u){pk2(y0, y1), pk2(y2, y3)}; }
    { f32x4 accn = (f32x4){0.f, 0.f, 0.f, 0.f};
#pragma unroll
      for (int j = 0; j < 8; ++j) acc[j] = (f32x4){0.f, 0.f, 0.f, 0.f};
#pragma unroll
      for (int ks = 0; ks < 4; ++ks) { const f32x4 w0 = *(const LAS f32x4*)(gl + 640 + 32 * ks + 8 * g), w1 = *(const LAS f32x4*)(gl + 640 + 32 * ks + 8 * g + 4);
          const v4u vr = __builtin_bit_cast(v4u, colfrag(T3, ks, wave, fr, g));
          const v4u vs = (v4u){pk2(bflo(vr.x) * w0[0], bfhi(vr.x) * w0[1]), pk2(bflo(vr.y) * w0[2], bfhi(vr.y) * w0[3]), pk2(bflo(vr.z) * w1[0], bfhi(vr.z) * w1[1]), pk2(bflo(vr.w) * w1[2], bfhi(vr.w) * w1[3])};
          const v4u wv = (v4u){pk2(w0[0], w0[1]), pk2(w0[2], w0[3]), pk2(w1[0], w1[1]), pk2(w1[2], w1[3])};
          const bf16x8 vf = __builtin_bit_cast(bf16x8, vs), wf = __builtin_bit_cast(bf16x8, wv);
#pragma unroll
          for (int j = 0; j < 8; ++j) { const bf16x8 kf = colfrag(T0, ks, j, fr, g); acc[j] = __builtin_amdgcn_mfma_f32_16x16x32_bf16(kf, vf, acc[j], 0, 0, 0);
              if (j == wave) accn = __builtin_amdgcn_mfma_f32_16x16x32_bf16(kf, wf, accn, 0, 0, 0); } }
      const float mnew = fmaxf(blast + st.m, mloc), a = fexp_(blast + st.m - mnew), cc = fexp_(mloc - mnew);
#pragma unroll
      for (int j = 0; j < 8; ++j) st.C[j] = st.C[j] * a + acc[j] * cc;
      if (fr == 0) *(LAS f32x4*)(gl + 768 + 16 * wave + 4 * g) = accn;
      __syncthreads();
      st.n0 = st.n0 * a + gl[768 + 2 * lane] * cc; st.n1 = st.n1 * a + gl[768 + 2 * lane + 1] * cc; st.m = mnew; }
}

struct EpiOutProj {
    static constexpr bool PERM = true, AFTER_DRAIN = false;
    const float* x; bf16* x1b; float* ss;
    __device__ __forceinline__ void operator()(const f32x4 (&acc)[2][2][4][2], const pg8::Unit& u, int wr, int wc, int fr, int fq) const {
        const int row0 = u.pm * 256 + wr * 64 + fr, col0 = u.pn * 256 + wc * 32 + 8 * fq;
#pragma unroll
        for (int ai = 0; ai < 2; ++ai)
#pragma unroll
            for (int m = 0; m < 4; ++m) { const int row = row0 + ai * 128 + m * 16; float sq = 0.f;
#pragma unroll
                for (int bj = 0; bj < 2; ++bj) { const size_t off = (size_t)row * D + col0 + bj * 128;
                    const f32x4 o0 = *(const f32x4*)(x + off) + acc[ai][bj][m][0], o1 = *(const f32x4*)(x + off + 4) + acc[ai][bj][m][1];
                    *(v4u*)(x1b + off) = pack8(o0, o1);
                    sq += ((o0[0] * o0[0] + o0[1] * o0[1]) + (o0[2] * o0[2] + o0[3] * o0[3])) + ((o1[0] * o1[0] + o1[1] * o1[1]) + (o1[2] * o1[2] + o1[3] * o1[3])); }
                sq += __shfl_xor(sq, 16); sq += __shfl_xor(sq, 32);
                if (fq == 0) ss[(size_t)row * 16 + u.pn * 4 + wc] = sq; }
    }
};
struct FixedOrder {
    int pm, n;
    __device__ __forceinline__ bool next(int i, pg8::Unit& u) const { if (i >= n) return false; u.pm = pm; u.pn = i; u.aux = 0; return true; }
    __device__ __forceinline__ void a_ready(const pg8::Unit&) const {}
    __device__ __forceinline__ void done(const pg8::Unit&) const {}
};
struct EpiQx {
    static constexpr bool PERM = true, AFTER_DRAIN = false;
    bf16* qx; const LAS float* rs;
    __device__ __forceinline__ void operator()(const f32x4 (&acc)[2][2][4][2], const pg8::Unit& u, int wr, int wc, int fr, int fq) const {
        const int rl0 = wr * 64 + fr, col0 = wc * 32 + 8 * fq;
#pragma unroll
        for (int ai = 0; ai < 2; ++ai)
#pragma unroll
            for (int m = 0; m < 4; ++m) { const int rl = rl0 + ai * 128 + m * 16; const float sc = rs[rl]; bf16* rowp = qx + (size_t)(u.pm * 256 + rl) * 256 + col0;
#pragma unroll
                for (int bj = 0; bj < 2; ++bj) *(v4u*)(rowp + bj * 128) = pack8(acc[ai][bj][m][0] * sc, acc[ai][bj][m][1] * sc);
                asm volatile("" ::: "memory"); }
    }
};
struct EpiOx {
    static constexpr bool PERM = true, AFTER_DRAIN = false;
    const bf16* x1b; bf16* x2b;
    __device__ __forceinline__ void operator()(const f32x4 (&acc)[2][2][4][2], const pg8::Unit& u, int wr, int wc, int fr, int fq) const {
        const int row0 = u.pm * 256 + wr * 64 + fr, col0 = u.pn * 256 + wc * 32 + 8 * fq;
#pragma unroll
        for (int ai = 0; ai < 2; ++ai)
#pragma unroll
            for (int m = 0; m < 4; ++m) {
#pragma unroll
                for (int bj = 0; bj < 2; ++bj) { const size_t off = (size_t)(row0 + ai * 128 + m * 16) * D + col0 + bj * 128; const v4u r = *(const v4u*)(x1b + off);
                    f32x4 o0 = acc[ai][bj][m][0], o1 = acc[ai][bj][m][1];
                    o0[0] += bflo(r.x); o0[1] += bfhi(r.x); o0[2] += bflo(r.y); o0[3] += bfhi(r.y); o1[0] += bflo(r.z); o1[1] += bfhi(r.z); o1[2] += bflo(r.w); o1[3] += bfhi(r.w);
                    *(v4u*)(x2b + off) = pack8(o0, o1); }
                asm volatile("" ::: "memory"); }
    }
};
constexpr int CX_QLD = 72, CX_KLD = 72, CX_VLD = 264, CX_PLD = 264;
constexpr int CX_Q = 0, CX_K = CX_Q + 128 * CX_QLD * 2, CX_V = CX_K + 256 * CX_KLD * 2, CX_P = CX_V + 64 * CX_VLD * 2, CX_END = CX_P + 8 * 16 * CX_PLD * 2;
static_assert(CX_END <= LDS_MISC, "cross LDS");
__device__ __forceinline__ void cross_item(const Args& A, unsigned char* lds, int item, int tid, int lane, int wave) {
    asm volatile("" : "+v"(tid), "+v"(lane));
    unsigned char* ws = A.ws;
    const int rt = item >> 2, h = item & 3; const size_t t0 = (size_t)rt * 128; const int b = (int)(t0 / SEQ);
    bf16* Qs = (bf16*)(lds + CX_Q); bf16* Ks = (bf16*)(lds + CX_K); bf16* Vt = (bf16*)(lds + CX_V); bf16* Ps = (bf16*)(lds + CX_P) + wave * 16 * CX_PLD;
    const bf16* QX = (const bf16*)(ws + WS_QX) + h * 64; const bf16* KV = (const bf16*)(ws + WS_KVX) + (size_t)b * MEMLEN * NKV + h * 64;
    for (int id = tid; id < 128 * 8; id += NTHR) { const int row = id >> 3, ch = id & 7; *(v4u*)(Qs + row * CX_QLD + ch * 8) = *(const v4u*)(QX + (t0 + row) * 256 + ch * 8); }
    for (int id = tid; id < 256 * 8; id += NTHR) { const int kk = id >> 3, ch = id & 7;
        *(v4u*)(Ks + kk * CX_KLD + ch * 8) = *(const v4u*)(KV + (size_t)kk * NKV + ch * 8);
        const v4u vv = *(const v4u*)(KV + (size_t)kk * NKV + 256 + ch * 8); bf16* vp = Vt + (ch * 8) * CX_VLD + kk;
        vp[0 * CX_VLD] = (bf16)(vv.x & 0xffffu); vp[1 * CX_VLD] = (bf16)(vv.x >> 16); vp[2 * CX_VLD] = (bf16)(vv.y & 0xffffu); vp[3 * CX_VLD] = (bf16)(vv.y >> 16);
        vp[4 * CX_VLD] = (bf16)(vv.z & 0xffffu); vp[5 * CX_VLD] = (bf16)(vv.z >> 16); vp[6 * CX_VLD] = (bf16)(vv.w & 0xffffu); vp[7 * CX_VLD] = (bf16)(vv.w >> 16); }
    __syncthreads();
    const int fr = lane & 15, fq = lane >> 4;
    f32x4 s[1][16];
#pragma unroll
    for (int j = 0; j < 16; ++j) s[0][j] = (f32x4){0.f, 0.f, 0.f, 0.f};
    wave_mma<1, 16>(Qs + 16 * wave * CX_QLD, CX_QLD, Ks, CX_KLD, 64, s, fr, fq);
    float mx = -1e30f;
#pragma unroll
    for (int j = 0; j < 16; ++j)
#pragma unroll
        for (int e = 0; e < 4; ++e) mx = fmaxf(mx, s[0][j][e]);
    mx = fmaxf(mx, __shfl_xor(mx, 16)); mx = fmaxf(mx, __shfl_xor(mx, 32));
    float l = 0.f;
#pragma unroll
    for (int j = 0; j < 16; ++j) { f32x4 p;
#pragma unroll
        for (int e = 0; e < 4; ++e) { p[e] = __builtin_amdgcn_exp2f(s[0][j][e] - mx); l += p[e]; }
        *(v2u*)(Ps + fr * CX_PLD + 16 * j + 4 * fq) = (v2u){pk2(p[0], p[1]), pk2(p[2], p[3])}; }
    l += __shfl_xor(l, 16); l += __shfl_xor(l, 32);
    __syncthreads();
    f32x4 o[1][4];
#pragma unroll
    for (int j = 0; j < 4; ++j) o[0][j] = (f32x4){0.f, 0.f, 0.f, 0.f};
    wave_mma<1, 4>(Ps, CX_PLD, Vt, CX_VLD, 256, o, fr, fq);
    const float rl = frcp_(l);
    bf16* og = (bf16*)(ws + WS_OX) + (t0 + 16 * wave + fr) * 256 + h * 64;
#pragma unroll
    for (int j = 0; j < 4; ++j) *(v2u*)(og + 16 * j + 4 * fq) = (v2u){pk2(o[0][j][0] * rl, o[0][j][1] * rl), pk2(o[0][j][2] * rl, o[0][j][3] * rl)};
    __syncthreads();
}

struct TokInfo { int bucket; float wa, wb; int rank; };
constexpr size_t WS_RSTD3 = 18 * MiB;
constexpr size_t WS_CNTTAB = 31 * MiB + 512 * 1024;
__device__ __forceinline__ void p9_route(const Args& A, unsigned char* lds, int tid, int lane, int wave) {
    unsigned char* ws = A.ws;
    const float* b_rg = (const float*)(ws + WS_PAR) + PAR_BRG; const float* b_re = (const float*)(ws + WS_PAR) + PAR_BRE;
    LAS float* WRl = (LAS float*)lds;
    LAS int* bkl = (LAS int*)(lds + 81920);
    for (int i = tid; i < 20 * 1024 / 4; i += NTHR) ((LAS f32x4*)WRl)[i] = ((const f32x4*)(ws + WS_WR))[i];
    __syncthreads();
    const bf16* X2B = (const bf16*)(ws + WS_HBS);
    for (int chunk = blockIdx.x; chunk < T / 256; chunk += gridDim.x) {
        for (int r = 0; r < 32; ++r) {
            const int m = chunk * 256 + wave * 32 + r;
            const v4u* xr = (const v4u*)(X2B + (size_t)m * D) + lane;
            f32x4 v[4]; float s = 0.f;
#pragma unroll
            for (int j = 0; j < 2; ++j) { const v4u r = xr[64 * j]; v[2 * j] = (f32x4){bflo(r.x), bfhi(r.x), bflo(r.y), bfhi(r.y)}; v[2 * j + 1] = (f32x4){bflo(r.z), bfhi(r.z), bflo(r.w), bfhi(r.w)}; }
#pragma unroll
            for (int j = 0; j < 4; ++j) s += (v[j].x * v[j].x + v[j].y * v[j].y) + (v[j].z * v[j].z + v[j].w * v[j].w);
            const float rstd = 1.0f / sqrtf(wave_sum(s) * (1.0f / D) + EPSN);
            float gl4[4];
#pragma unroll
            for (int e = 0; e < 4; ++e) { float a = 0.f;
#pragma unroll
                for (int j = 0; j < 4; ++j) { const f32x4 w = *(const LAS f32x4*)(WRl + e * 1024 + 512 * (j >> 1) + 8 * lane + 4 * (j & 1)); a += (v[j].x * w.x + v[j].y * w.y) + (v[j].z * w.z + v[j].w * w.w); }
                gl4[e] = wave_sum(a) * rstd + b_rg[e]; }
            int g = 0; float gm = gl4[0];
#pragma unroll
            for (int i = 1; i < 4; ++i) if (gl4[i] > gm) { gm = gl4[i]; g = i; }
            g = __builtin_amdgcn_readfirstlane(g);
            float gs = 0.f;
#pragma unroll
            for (int i = 0; i < 4; ++i) gs += __expf(gl4[i] - gm);
            const float gw_ = 1.0f / gs;
            float el[4];
            const LAS float* WRe = WRl + (4 + 4 * g) * 1024;
#pragma unroll
            for (int e = 0; e < 4; ++e) { float a = 0.f;
#pragma unroll
                for (int j = 0; j < 4; ++j) { const f32x4 w = *(const LAS f32x4*)(WRe + e * 1024 + 512 * (j >> 1) + 8 * lane + 4 * (j & 1)); a += (v[j].x * w.x + v[j].y * w.y) + (v[j].z * w.z + v[j].w * w.w); }
                el[e] = wave_sum(a) * rstd + b_re[g * 4 + e]; }
            int i0 = 0; float v0 = el[0];
#pragma unroll
            for (int i = 1; i < 4; ++i) if (el[i] > v0) { v0 = el[i]; i0 = i; }
            int i1 = -1; float v1 = -INFINITY;
#pragma unroll
            for (int i = 0; i < 4; ++i) if (i != i0 && el[i] > v1) { v1 = el[i]; i1 = i; }
            const float e1 = __expf(v1 - v0); const float w0 = gw_ / (1.0f + e1), w1 = gw_ * e1 / (1.0f + e1);
            const int pa = i0 < i1 ? i0 : i1, pb = i0 < i1 ? i1 : i0;
            const int pidx = (pa == 0) ? (pb - 1) : (pa == 1 ? pb + 1 : 5);
            const int bucket = g * 6 + pidx;
            if (lane == 0) { ((float*)(ws + WS_RSTD3))[m] = rstd; bkl[wave * 32 + r] = bucket; ((LAS float*)(bkl + 256))[wave * 32 + r] = (i0 < i1) ? w0 : w1; ((LAS float*)(bkl + 512))[wave * 32 + r] = (i0 < i1) ? w1 : w0; }
        }
        __syncthreads();
        if (tid < 256) { const int my = bkl[tid]; int rank = 0; for (int j = 0; j < tid; ++j) rank += (bkl[j] == my) ? 1 : 0;
            TokInfo ti; ti.bucket = my; ti.wa = ((LAS float*)(bkl + 256))[tid]; ti.wb = ((LAS float*)(bkl + 512))[tid]; ti.rank = rank;
            ((TokInfo*)(ws + WS_TOKINFO))[chunk * 256 + tid] = ti; }
        else if (tid < 256 + NBUCKET) { const int b = tid - 256; int c = 0; for (int j = 0; j < 256; ++j) c += (bkl[j] == b) ? 1 : 0;
            ((int*)(ws + WS_CNTTAB))[chunk * NBUCKET + b] = c; }
        __syncthreads();
    }
}
__device__ __forceinline__ void p10_slots(const Args& A, unsigned char* lds, int tid, int lane, int wave) {
    unsigned char* ws = A.ws;
    LAS int* tabl = (LAS int*)lds;
    LAS int* totl = (LAS int*)(lds + 32768);
    const int* CNTTAB = (const int*)(ws + WS_CNTTAB);
    for (int i = tid; i < 256 * NBUCKET; i += NTHR) tabl[i] = CNTTAB[i];
    __syncthreads();
    if (tid < NBUCKET) { int t = 0; for (int w = 0; w < 256; ++w) t += tabl[w * NBUCKET + tid]; totl[tid] = t; }
    __syncthreads();
    if (tid == 0) { int acc = 0; for (int b = 0; b < NBUCKET; ++b) { totl[32 + b] = acc; acc += ((totl[b] + 255) >> 8) * 256; } totl[32 + NBUCKET] = acc; }
    if (blockIdx.x == 0 && tid < NBUCKET) ((unsigned*)(ws + WS_CTL))[CW_CNT + tid] = (unsigned)totl[tid];
    __syncthreads();
    int* TOKMAP = (int*)(ws + WS_TOKMAP); float* WSORT = (float*)(ws + WS_WSORT);
    for (int chunk = blockIdx.x; chunk < T / 256; chunk += gridDim.x) {
        if (tid < NBUCKET) { int s = 0; for (int w = 0; w < chunk; ++w) s += tabl[w * NBUCKET + tid]; totl[64 + tid] = totl[32 + tid] + s; }
        __syncthreads();
        if (tid < 256) { const int m = chunk * 256 + tid; const TokInfo ti = ((const TokInfo*)(ws + WS_TOKINFO))[m]; const int slot = totl[64 + ti.bucket] + ti.rank;
            TOKMAP[slot] = m; *(f32x4*)(WSORT + 4 * slot) = (f32x4){ti.wa, ti.wb, ((const float*)(ws + WS_RSTD3))[m], 0.f}; }
        __syncthreads();
    }
    for (int b = blockIdx.x; b < NBUCKET; b += gridDim.x)
        for (int r = totl[32 + b] + totl[b] + tid; r < totl[32 + b + 1]; r += NTHR) { TOKMAP[r] = -1; *(f32x4*)(WSORT + 4 * r) = (f32x4){0.f, 0.f, 0.f, 0.f}; }
}
struct MoeOrder {
    int G, c, nunits, ncol; const int* tab;
    __device__ __forceinline__ bool next(int i, pg8::Unit& u) const {
        const long L = (long)i * G + c; if (L >= nunits) return false;
        const int rt = (int)L / ncol, j = (int)L % ncol, bk = tab[rt];
        u.pm = rt; u.aux = j;
        if (ncol == 8) { const int g = bk / 6, p = bk % 6; const int pa = (p < 3) ? 0 : (p < 5 ? 1 : 2), pb = (p < 3) ? p + 1 : (p < 5 ? p - 1 : 3);
            const int e = 4 * g + ((j >> 2) ? pb : pa); u.pn = e * 4 + (j & 3); }
        else u.pn = bk * 4 + j;
        return true;
    }
    __device__ __forceinline__ void a_ready(const pg8::Unit&) const {}
    __device__ __forceinline__ void done(const pg8::Unit&) const {}
};
struct EpiUp {
    static constexpr bool PERM = true, AFTER_DRAIN = false;
    bf16* act; const float* wsort;
    __device__ __forceinline__ void operator()(const f32x4 (&acc)[2][2][4][2], const pg8::Unit& u, int wr, int wc, int fr, int fq) const {
        const int row0 = u.pm * 256 + wr * 64 + fr, half = u.aux >> 2, col0 = half * 512 + (u.aux & 3) * 128 + wc * 32 + 8 * fq;
#pragma unroll
        for (int ai = 0; ai < 2; ++ai)
#pragma unroll
            for (int m = 0; m < 4; ++m) { const int row = row0 + ai * 128 + m * 16; const float w = wsort[4 * row + half], rs = wsort[4 * row + 2];
                f32x4 r0, r1;
#pragma unroll
                for (int i = 0; i < 4; ++i) { const float a0 = acc[ai][0][m][0][i] * rs, a1 = acc[ai][0][m][1][i] * rs;
                    r0[i] = a0 * sigmoidf_(a0) * (acc[ai][1][m][0][i] * rs) * w; r1[i] = a1 * sigmoidf_(a1) * (acc[ai][1][m][1][i] * rs) * w; }
                *(v4u*)(act + (size_t)row * D + col0) = pack8(r0, r1); }
    }
};
struct EpiDown {
    static constexpr bool PERM = true, AFTER_DRAIN = false;
    const bf16* x2b; float* xo; const int* tokmap;
    __device__ __forceinline__ void operator()(const f32x4 (&acc)[2][2][4][2], const pg8::Unit& u, int wr, int wc, int fr, int fq) const {
        const int row0 = u.pm * 256 + wr * 64 + fr, col0 = u.aux * 256 + wc * 32 + 8 * fq;
#pragma unroll
        for (int ai = 0; ai < 2; ++ai)
#pragma unroll
            for (int m = 0; m < 4; ++m) { const int tok = tokmap[row0 + ai * 128 + m * 16];
                if (tok >= 0) {
#pragma unroll
                    for (int bj = 0; bj < 2; ++bj) { const size_t off = (size_t)tok * D + col0 + bj * 128; const v4u r = *(const v4u*)(x2b + off);
                        f32x4 o0 = acc[ai][bj][m][0], o1 = acc[ai][bj][m][1];
                        o0[0] += bflo(r.x); o0[1] += bfhi(r.x); o0[2] += bflo(r.y); o0[3] += bfhi(r.y); o1[0] += bflo(r.z); o1[1] += bfhi(r.z); o1[2] += bflo(r.w); o1[3] += bfhi(r.w);
                        *(f32x4*)(xo + off) = o0; *(f32x4*)(xo + off + 4) = o1; } } }
    }
};
constexpr size_t WS_XCH = 20 * MiB + 512 * 1024;
constexpr int CW_SEAM = 16384;
constexpr int LDS_EX = 139264;
struct EpiDownNorm {
    static constexpr bool PERM = true, AFTER_DRAIN = false;
    const bf16* x2b; float* out; const int* tokmap; const float* gfin; float* xch; unsigned* cnt; LAS unsigned char* ex;
    __device__ __forceinline__ void operator()(const f32x4 (&acc_)[2][2][4][2], const pg8::Unit& u, int wr, int wc, int fr, int fq) const {
        f32x4 (&acc)[2][2][4][2] = const_cast<f32x4 (&)[2][2][4][2]>(acc_);
        int tid = threadIdx.x; asm volatile("" : "+v"(tid));
        const int lane = tid & 63, wid = __builtin_amdgcn_readfirstlane(tid >> 6);
        int rb = wr * 64 + fr; asm volatile("" : "+v"(rb));
        LAS float* P = (LAS float*)ex; LAS float* S = (LAS float*)(ex + 4096); LAS unsigned* flag = (LAS unsigned*)(ex + 6144);
        const int col0 = u.aux * 256 + wc * 32 + 8 * fq;
#pragma unroll
        for (int ai = 0; ai < 2; ++ai)
#pragma unroll
            for (int m = 0; m < 4; ++m) { const int rl = rb + ai * 128 + m * 16; const int tok = tokmap[u.pm * 256 + rl]; float sq = 0.f;
#pragma unroll
                for (int bj = 0; bj < 2; ++bj) { f32x4& o0 = acc[ai][bj][m][0]; f32x4& o1 = acc[ai][bj][m][1];
                    if (tok >= 0) { const v4u r = *(const v4u*)(x2b + (size_t)tok * D + col0 + bj * 128);
                        o0[0] += bflo(r.x); o0[1] += bfhi(r.x); o0[2] += bflo(r.y); o0[3] += bfhi(r.y); o1[0] += bflo(r.z); o1[1] += bfhi(r.z); o1[2] += bflo(r.w); o1[3] += bfhi(r.w); }
                    sq += ((o0[0] * o0[0] + o0[1] * o0[1]) + (o0[2] * o0[2] + o0[3] * o0[3])) + ((o1[0] * o1[0] + o1[1] * o1[1]) + (o1[2] * o1[2] + o1[3] * o1[3])); }
                sq += __shfl_xor(sq, 16); sq += __shfl_xor(sq, 32);
                if (fq == 0) P[rl * 4 + wc] = sq;
                asm volatile("" ::: "memory"); }
        asm volatile("s_waitcnt lgkmcnt(0)" ::: "memory"); __builtin_amdgcn_s_barrier(); asm volatile("" ::: "memory");
        if (tid < 256) { const f32x4 p = *(const LAS f32x4*)(P + tid * 4);
            __hip_atomic_store(xch + ((size_t)u.pm * 256 + tid) * 4 + u.aux, (p[0] + p[1]) + (p[2] + p[3]), __ATOMIC_RELAXED, __HIP_MEMORY_SCOPE_AGENT); }
        asm volatile("s_waitcnt vmcnt(0)" ::: "memory");
        if (wid < 4 && lane == 0) __hip_atomic_fetch_add(cnt + 64 * u.pm, 1u, __ATOMIC_RELAXED, __HIP_MEMORY_SCOPE_AGENT);
        if (wid == 0) { unsigned spins = 0;
            while ((unsigned)__builtin_amdgcn_readfirstlane(__hip_atomic_load(cnt + 64 * u.pm, __ATOMIC_RELAXED, __HIP_MEMORY_SCOPE_AGENT)) < 16u) { __builtin_amdgcn_s_sleep(2); if (++spins > (1u << 22)) break; }
            __builtin_amdgcn_fence(__ATOMIC_ACQUIRE, "agent");
            if (lane == 0) flag[0] = spins; }
        asm volatile("s_waitcnt vmcnt(0) lgkmcnt(0)" ::: "memory"); __builtin_amdgcn_s_barrier(); asm volatile("" ::: "memory");
        if (tid < 256) { const float* sl = xch + ((size_t)u.pm * 256 + tid) * 4; float t = 0.f;
#pragma unroll
            for (int k = 0; k < 4; ++k) t += __hip_atomic_load(sl + k, __ATOMIC_RELAXED, __HIP_MEMORY_SCOPE_AGENT);
            S[tid] = 1.0f / sqrtf(t * (1.0f / D) + EPSN); }
        asm volatile("s_waitcnt lgkmcnt(0)" ::: "memory"); __builtin_amdgcn_s_barrier(); asm volatile("" ::: "memory");
#pragma unroll
        for (int ai = 0; ai < 2; ++ai)
#pragma unroll
            for (int m = 0; m < 4; ++m) { const int rl = rb + ai * 128 + m * 16; const int tok = tokmap[u.pm * 256 + rl]; const float rs = S[rl];
                if (tok >= 0) {
#pragma unroll
                    for (int bj = 0; bj < 2; ++bj)
#pragma unroll
                        for (int n = 0; n < 2; ++n) { const int cc = col0 + bj * 128 + 4 * n; acc[ai][bj][m][n] = acc[ai][bj][m][n] * rs; acc[ai][bj][m][n] = acc[ai][bj][m][n] * *(const f32x4*)(gfin + cc);
                            *(f32x4*)(out + (size_t)tok * D + cc) = acc[ai][bj][m][n]; asm volatile("" ::: "memory"); } } }
    }
};
__device__ __forceinline__ void p10_final(const Args& A, float* outp, int lane, int wave) {
    const float* g_final = (const float*)(A.ws + WS_PAR) + PAR_GFIN;
    const int G = gridDim.x, gw = blockIdx.x * NWAVES + wave, NGW = G * NWAVES;
    f32x4 gv[4];
#pragma unroll
    for (int j = 0; j < 4; ++j) gv[j] = *((const f32x4*)g_final + lane + 64 * j);
    for (int m = gw; m < T; m += NGW) {
        f32x4* xr = (f32x4*)(A.out + (size_t)m * D) + lane;
        f32x4 v[4]; float s = 0.f;
#pragma unroll
        for (int j = 0; j < 4; ++j) { v[j] = xr[64 * j]; s += (v[j].x * v[j].x + v[j].y * v[j].y) + (v[j].z * v[j].z + v[j].w * v[j].w); }
        const float rstd = 1.0f / sqrtf(wave_sum(s) * (1.0f / D) + EPSN);
#pragma unroll
        for (int j = 0; j < 4; ++j) ((f32x4*)(outp + (size_t)m * D) + lane)[64 * j] = v[j] * rstd * gv[j];
    }
}

#ifndef MS
#define MS 4
#endif
#ifndef N_LAUNCHES
#define N_LAUNCHES 1
#endif
constexpr int N_PHASES = 14;
#ifndef FUSE_FINAL
#define FUSE_FINAL 1
#endif
#ifndef DUP_MASK
#define DUP_MASK 0
#endif
#define REP(k) for (int rep_ = 0; rep_ < (((DUP_MASK >> (k)) & 1) ? 2 : 1); ++rep_)
#ifndef QX_SP2
#define QX_SP2 false
#endif

#ifndef NVG
#define NVG 256
#endif
__global__ void __launch_bounds__(NTHR, 2) __attribute__((amdgpu_num_vgpr(NVG))) fwd_kernel(Args args) {
    __shared__ __attribute__((aligned(16))) unsigned char lds[LDS_BYTES];
    const int tid = threadIdx.x, lane = tid & 63, wave = __builtin_amdgcn_readfirstlane(tid >> 6);
    gu32* ctl = (gu32*)(args.ws + WS_CTL);
    for (int u = tid; u < (LDS_BYTES - LDS_MISC) / 4; u += NTHR) ((unsigned*)(lds + LDS_MISC))[u] = 0u;
    __syncthreads();
    const int lo = args.ph_lo, hi = args.ph_hi;
    const bool use_bar = (hi - lo) > 1;
    XcdBarrier bar; bar.bar = (unsigned*)ctl + CW_BAR; bar.x = 0; bar.st = (volatile LAS unsigned*)(lds + LDS_MISC) + 8;
    if (use_bar) bar = xcd_barrier_post((unsigned*)ctl + CW_BAR, (volatile LAS unsigned*)(lds + LDS_MISC) + 8);
#ifndef PH_MASK
#define PH_MASK 0xFFFF
#endif
#define IN(k) (((PH_MASK >> (k)) & 1) && lo <= (k) && (k) < hi)
#define SEAM(k) do { if (IN(k) && IN((k) + 1)) xcd_barrier(bar); } while (0)
    PG8_LAS unsigned char* ring = (PG8_LAS unsigned char*)lds;
    const int G = gridDim.x;
#define PHASE_PTRS Args pa = args; { unsigned char* w_ = args.ws; float* o_ = args.out; asm volatile("" : "+s"(w_), "+s"(o_)); pa.ws = w_; pa.out = o_; } unsigned char* const ws = pa.ws; (void)ws; int tid = (int)threadIdx.x; asm volatile("" : "+v"(tid)); const int lane = tid & 63; (void)lane

#ifdef DUMMY_LIVE
    float dl0, dl1, dl2, dl3, dl4, dl5, dl6, dl7; asm volatile("" : "=v"(dl0), "=v"(dl1), "=v"(dl2), "=v"(dl3), "=v"(dl4), "=v"(dl5), "=v"(dl6), "=v"(dl7));
#endif
    if (IN(0)) { PHASE_PTRS; REP(0) { p0_prologue(pa, lds, tid, lane, wave); __syncthreads(); } }
    SEAM(0);
    if (IN(1) && MS >= 1) { PHASE_PTRS;
        pg8::Gemm g{(const pg8::bf16_t*)(ws + WS_XN), (const pg8::bf16_t*)(ws + WS_WIN), T, NIN, D};
        pg8::StaticOrder S; S.init(T, NIN, G, (int)blockIdx.x);
        EpiInProj E{(bf16*)(ws + WS_Q), (const float*)(ws + WS_ROPE)};
        REP(1) pg8::gemm_phase<EpiInProj, pg8::StaticOrder, true, true>(ring, g, S, E);
    }
    SEAM(1);
    if (IN(2) && MS >= 1) { PHASE_PTRS;
        const int n_att = (MS >= 2) ? 3 * 4096 : 0;
        for (int tile = blockIdx.x; tile < 256; tile += G) kv_tile(pa, lds, tile, tid, lane, wave);
        __syncthreads();
        REP(14) attn_phase(pa, lds, n_att, lane, wave);
        { int wres = -1; MGroup mg; __syncthreads(); for (int it = blockIdx.x * 8; it < 2048; it += G * 8) for (int q = 0; q < 8; ++q) mlstm_p1_item(pa, lds, it + q, wres, mg, tid, lane, wave); }
    }
    if (IN(2) && IN(4)) xcd_barrier(bar);
    if (IN(4) && MS >= 1) { PHASE_PTRS;
        p3_scan_combine(pa, tid);
        for (int it = blockIdx.x * 8; it < 2048; it += G * 8) { MState st; mlstm2_entry(pa, it >> 6, (it & 63) >> 3, st, lane, wave);
            for (int q = 0; q < 8; ++q) mlstm_p2_item(pa, lds, it + q, st, tid, lane, wave); }
    }
    SEAM(4);
    if (IN(5)) { PHASE_PTRS;
        if (MS >= 1) {
            pg8::Gemm g{(const pg8::bf16_t*)(ws + WS_Y), (const pg8::bf16_t*)(ws + WS_WOUT), T, D, D};
            pg8::StaticOrder S; S.init(T, D, G, (int)blockIdx.x);
            EpiOutProj E{(const float*)pa.in[0], (bf16*)(ws + WS_X1B), (float*)(ws + WS_SS1)};
            REP(5) pg8::gemm_phase<EpiOutProj, pg8::StaticOrder, true, true>(ring, g, S, E);
        } else {
            const int gw = blockIdx.x * NWAVES + wave, NGW = G * NWAVES;
            for (int m = gw; m < T; m += NGW) { const f32x4* xr = (const f32x4*)((const float*)pa.in[0] + (size_t)m * D) + lane; unsigned long long* o8 = (unsigned long long*)(ws + WS_X1B + (size_t)m * D * 2) + lane;
#pragma unroll
                for (int j = 0; j < 4; ++j) { const f32x4 v = xr[64 * j]; o8[64 * j] = (unsigned long long)pk2(v.x, v.y) | ((unsigned long long)pk2(v.z, v.w) << 32); } }
        }
    }
    SEAM(5);
    if (IN(6) && MS >= 3) { PHASE_PTRS;
        pg8::StaticOrder S0; S0.init(T, 256, G, (int)blockIdx.x);
        float* rs = (float*)(lds + LDS_RS);
        pg8::Unit u0;
        if (S0.next(0, u0)) {
            if (tid < 256) { const f32x4* sp = (const f32x4*)((const float*)(ws + WS_SS1) + (size_t)(u0.pm * 256 + tid) * 16);
                const f32x4 a = sp[0], b = sp[1], c = sp[2], d = sp[3];
                const float s = ((a[0] + a[1]) + (a[2] + a[3])) + ((b[0] + b[1]) + (b[2] + b[3])) + ((c[0] + c[1]) + (c[2] + c[3])) + ((d[0] + d[1]) + (d[2] + d[3]));
                rs[tid] = 1.0f / sqrtf(s * (1.0f / D) + EPSN); }
            __syncthreads();
            { pg8::Gemm g{(const pg8::bf16_t*)(ws + WS_X1B), (const pg8::bf16_t*)(ws + WS_WQX), T, 256, D};
              FixedOrder S{u0.pm, 1}; EpiQx E{(bf16*)(ws + WS_QX), (const LAS float*)rs};
              pg8::gemm_phase<EpiQx, FixedOrder, true, QX_SP2>(ring, g, S, E); }
            VM_WAIT(); __syncthreads();
            for (int q = 0; q < 8; ++q) cross_item(pa, lds, (2 * u0.pm + (q >> 2)) * 4 + (q & 3), tid, lane, wave);
            VM_WAIT(); __syncthreads();
            { int kdyn = 256; asm volatile("" : "+s"(kdyn));
              pg8::Gemm g{(const pg8::bf16_t*)(ws + WS_OX), (const pg8::bf16_t*)(ws + WS_WOX), T, D, kdyn};
              FixedOrder S{u0.pm, 4}; EpiOx E{(const bf16*)(ws + WS_X1B), (bf16*)(ws + WS_HBS)};
              pg8::gemm_phase<EpiOx, FixedOrder, false, false>(ring, g, S, E); }
            __syncthreads();
        }
    }
    SEAM(8);
    if (IN(9) && MS >= 4) { PHASE_PTRS; p9_route(pa, lds, tid, lane, wave); }
    SEAM(9);
    if (IN(10) && MS >= 4) { PHASE_PTRS; p10_slots(pa, lds, tid, lane, wave); }
    SEAM(10);
    if ((IN(11) || IN(12)) && MS >= 4) { PHASE_PTRS;
        int* tab = (int*)(lds + LDS_TAB);
        if (tid == 0) { int nrt = 0; const unsigned* cnt = (const unsigned*)(ws + WS_CTL) + CW_CNT;
            for (int i = 0; i < NBUCKET; ++i) { const int nt = (int)((__hip_atomic_load(cnt + i, __ATOMIC_RELAXED, __HIP_MEMORY_SCOPE_AGENT) + 255u) >> 8); for (int k = 0; k < nt; ++k) tab[1 + nrt++] = i; }
            tab[0] = nrt; }
        __syncthreads();
        const int nrt = tab[0];
        if (IN(11)) {
            pg8::Gemm g{(const pg8::bf16_t*)(ws + WS_HBS), (const pg8::bf16_t*)(ws + WS_W13), ROWS_MAX, 64 * 256, D, (const int*)(ws + WS_TOKMAP)};
            MoeOrder S{G, (int)blockIdx.x, nrt * 8, 8, tab + 1};
            EpiUp E{(bf16*)(ws + WS_ACT), (const float*)(ws + WS_WSORT)};
            REP(11) pg8::gemm_phase<EpiUp, MoeOrder, true, true, true>(ring, g, S, E);
        }
        SEAM(11);
        if (IN(12)) {
            pg8::Gemm g{(const pg8::bf16_t*)(ws + WS_ACT), (const pg8::bf16_t*)(ws + WS_W2P), ROWS_MAX, 96 * 256, D};
            MoeOrder S{G, (int)blockIdx.x, nrt * 4, 4, tab + 1};
#if FUSE_FINAL
            EpiDownNorm E{(const bf16*)(ws + WS_HBS), pa.out, (const int*)(ws + WS_TOKMAP), (const float*)(ws + WS_PAR) + PAR_GFIN, (float*)(ws + WS_XCH), (unsigned*)(ws + WS_CTL) + CW_SEAM, (LAS unsigned char*)(lds + LDS_EX)};
            pg8::gemm_phase<EpiDownNorm, MoeOrder, true, true>(ring, g, S, E);
#else
            EpiDown E{(const bf16*)(ws + WS_HBS), pa.out, (const int*)(ws + WS_TOKMAP)};
            REP(12) pg8::gemm_phase<EpiDown, MoeOrder, true, true>(ring, g, S, E);
#endif
        }
    }
    if (!FUSE_FINAL) SEAM(12);
    if (IN(13) && !FUSE_FINAL) { PHASE_PTRS; REP(13) p10_final(pa, (((DUP_MASK >> 13) & 1) && rep_ == 0) ? (float*)(ws + 544 * MiB) : pa.out, lane, wave); }
#ifdef DUMMY_LIVE
    asm volatile("" :: "v"(dl0), "v"(dl1), "v"(dl2), "v"(dl3), "v"(dl4), "v"(dl5), "v"(dl6), "v"(dl7));
#endif
#undef IN
#undef SEAM
}

extern "C" void kernel_launch(void* const* d_in, const int* in_sizes, int n_in, void* d_out, int out_size, void* d_ws, size_t ws_size, hipStream_t stream) {
    static int grid = 0;
    if (grid == 0) {
        if (n_in != 28 || out_size != T * D || ws_size < WS_END) { fprintf(stderr, "kernel_launch: unexpected problem (n_in %d, out %d, ws %zu)\n", n_in, out_size, ws_size); grid = -1; return; }
        int dev = 0, cus = 0, per_cu = 0;
        if (hipGetDevice(&dev) != hipSuccess || hipDeviceGetAttribute(&cus, hipDeviceAttributeMultiprocessorCount, dev) != hipSuccess) { grid = -1; return; }
        if (hipOccupancyMaxActiveBlocksPerMultiprocessor(&per_cu, (const void*)fwd_kernel, NTHR, 0) != hipSuccess || per_cu < 1) { fprintf(stderr, "kernel_launch: occupancy query failed (%d)\n", per_cu); per_cu = 1; }
        (void)hipGetLastError();
        grid = cus * (per_cu > 1 ? 1 : per_cu);
        if (grid > 256) grid = 256;
    }
    if (grid < 0) return;
    (void)hipMemsetAsync((char*)d_ws + WS_CTL, 0, CTL_ZERO_BYTES, stream);
    Args a{};
    for (int i = 0; i < 28; ++i) a.in[i] = d_in[i];
    a.out = (float*)d_out; a.ws = (unsigned char*)d_ws;
    if (N_LAUNCHES == 1) {
        a.ph_lo = 0; a.ph_hi = N_PHASES;
        void* kargs[] = {&a};
        hipError_t e = hipLaunchCooperativeKernel((const void*)fwd_kernel, dim3(grid), dim3(NTHR), kargs, 0, stream);
        if (e != hipSuccess) fprintf(stderr, "kernel_launch: cooperative launch failed: %s (grid %d)\n", hipGetErrorString(e), grid);
    } else {
        for (int p = 0; p < N_PHASES; ++p) { a.ph_lo = p; a.ph_hi = p + 1; hipLaunchKernelGGL(fwd_kernel, dim3(grid), dim3(NTHR), 0, stream, a); }
    }
}
```

```cpp
#include <hip/hip_runtime.h>
#include <cstdio>
#include <cstdint>
namespace pg8 {
#define PG8_LAS __attribute__((address_space(3)))
typedef unsigned short bf16_t;
typedef short bf16x8 __attribute__((ext_vector_type(8)));
typedef float f32x4 __attribute__((ext_vector_type(4)));
typedef unsigned u32x4 __attribute__((ext_vector_type(4)));
constexpr int BM = 256, BK = 64, HALF = 128, HTB = HALF * BK * 2  , STAGE_BYTES = 8 * HTB, NXCD = 8, WGM = 8;

__host__ __device__ __forceinline__ int lds_byte(int r, int c) { const int st = (r >> 4) * 2 + (c >> 5), rr = r & 15, cc = c & 31, ob = rr * 64 + cc * 2; return st * 1024 + (ob ^ (((ob >> 9) & 1) << 5)); }
__host__ __device__ __forceinline__ void stage_rc(int b, int& R, int& C) { const int st = b / 1024, sb = b % 1024, swz = sb ^ (((sb >> 9) & 1) << 5); R = (st >> 1) * 16 + swz / 64; C = (st & 1) * 32 + (swz % 64) / 2; }
__host__ __device__ __forceinline__ int perm32(int rho) { const int n = rho >> 4, i = rho & 15; return 8 * (i >> 2) + 4 * n + (i & 3); }

struct Unit { int pm, pn, aux; };
struct Gemm { const bf16_t* A; const bf16_t* Bt; int M, N, K; const int* rowmap; };

struct StaticOrder {
    int nM, nN, nwg, G, c;
    __host__ __device__ __forceinline__ void init(int M, int N, int G_, int c_) { nM = M / BM; nN = N / BM; nwg = nM * nN; G = G_; c = c_; }
    __host__ __device__ __forceinline__ bool next(int i, Unit& u) const {
        const long L = (long)i * G + c; if (L >= nwg) return false;
        int wgid = (int)L; { const int q = nwg / NXCD, r = nwg % NXCD, xcd = wgid % NXCD, off = wgid / NXCD; wgid = (xcd < r ? xcd * (q + 1) : r * (q + 1) + (xcd - r) * q) + off; }
        const int nig = WGM * nN, gid = wgid / nig, fm = gid * WGM, gsz = (nM - fm) < WGM ? (nM - fm) : WGM;
        u.pm = fm + ((wgid % nig) % gsz); u.pn = (wgid % nig) / gsz; u.aux = 0; return true;
    }
    __device__ __forceinline__ void a_ready(const Unit&) const {}
    __device__ __forceinline__ void done(const Unit&) const {}
};

__device__ __forceinline__ unsigned cvt_pk_bf16(float lo, float hi) { unsigned r; asm volatile("v_cvt_pk_bf16_f32 %0, %1, %2" : "=v"(r) : "v"(lo), "v"(hi)); return r; }
template <class Epi, class Sched, bool ALIGN_EPI = false, bool SP2 = false, bool GATHER = false>
__device__ __forceinline__ void gemm_phase(PG8_LAS unsigned char* lds, const Gemm g, const Sched& S, const Epi& E) {
    int tid = threadIdx.x; asm volatile("" : "+v"(tid));
    const int wid = __builtin_amdgcn_readfirstlane(tid >> 6), lane = tid & 63, wr = wid >> 2, wc = wid & 3, fr = lane & 15, fq = lane >> 4;
    const int K = g.K, nt = K / BK;
    unsigned voffA[2], voffB[2];
#pragma unroll
    for (int i = 0; i < 2; ++i) { int R, C; stage_rc(tid * 16 + i * 8192, R, C); const int Rb = Epi::PERM ? ((R & ~31) + perm32(R & 31)) : R;
        voffA[i] = (unsigned)(R * K + C) * 2u; voffB[i] = (unsigned)(Rb * K + C) * 2u; }
    unsigned gc[2][2] = {{0u, 0u}, {0u, 0u}}, gn[2][2] = {{0u, 0u}, {0u, 0u}};
#define PG8_GLOAD(gv, pm_) do { _Pragma("unroll") for (int _h = 0; _h < 2; ++_h) _Pragma("unroll") for (int _i = 0; _i < 2; ++_i) { int _R, _C; stage_rc(tid * 16 + _i * 8192, _R, _C); \
        int _row = g.rowmap[(pm_) * BM + _h * HALF + _R]; _row = _row < 0 ? 0 : _row; gv[_h][_i] = (unsigned)(_row * K + _C) * 2u; } } while (0)
    const size_t kstep = (size_t)(BK * 2);
    const size_t hstep = (size_t)HALF * K * 2;
    const size_t tstep = 2 * hstep;
    const unsigned ldsw = (unsigned)wid * 1024u;
    const int aoff = lds_byte(wr * 64 + fr, fq * 8), boff = lds_byte(wc * 32 + fr, fq * 8);
#define PG8_SA(b, h) (((b) * 2 + (h)) * HTB)
#define PG8_SB(b, h) ((4 + (b) * 2 + (h)) * HTB)
#define PG8_STAGE(bufoff, gbase, voff) do { _Pragma("unroll") for (int _i = 0; _i < 2; ++_i) \
        __builtin_amdgcn_global_load_lds((const unsigned*)((const char*)(gbase) + (voff)[_i]), (PG8_LAS unsigned*)(lds + (bufoff) + ldsw + _i * 8192), 16, 0, 0); } while (0)
#define PG8_STAGE_A(bufoff, gbase, h, sel) do { if constexpr (GATHER) { unsigned vo_[2]; vo_[0] = (sel) ? gn[h][0] : gc[h][0]; vo_[1] = (sel) ? gn[h][1] : gc[h][1]; PG8_STAGE(bufoff, gbase, vo_); } \
        else { PG8_STAGE(bufoff, (gbase) + (h) * hstep, voffA); } } while (0)
#define PG8_LDA(dst, b, h) do { _Pragma("unroll") for (int m = 0; m < 4; ++m) _Pragma("unroll") for (int k = 0; k < 2; ++k) dst[m][k] = *(const PG8_LAS bf16x8*)(lds + PG8_SA(b, h) + aoff + m * 2048 + k * 1024); } while (0)
#define PG8_LDB(dst, b, h) do { _Pragma("unroll") for (int n = 0; n < 2; ++n) _Pragma("unroll") for (int k = 0; k < 2; ++k) dst[n][k] = *(const PG8_LAS bf16x8*)(lds + PG8_SB(b, h) + boff + n * 2048 + k * 1024); } while (0)
#define PG8_MMA(ai, bj, At, Bt) do { __builtin_amdgcn_s_setprio(1); _Pragma("unroll") for (int m = 0; m < 4; ++m) _Pragma("unroll") for (int n = 0; n < 2; ++n) _Pragma("unroll") for (int k = 0; k < 2; ++k) \
        acc[ai][bj][m][n] = __builtin_amdgcn_mfma_f32_16x16x32_bf16(Bt[n][k], At[m][k], acc[ai][bj][m][n], 0, 0, 0); __builtin_amdgcn_s_setprio(0); } while (0)
#define PG8_WAIT_V(n) asm volatile("s_waitcnt vmcnt(" #n ")" ::: "memory")
#define PG8_WAIT_L(n) asm volatile("s_waitcnt lgkmcnt(" #n ")" ::: "memory")
#define PG8_BAR __builtin_amdgcn_s_barrier()
#define PG8_SCHED __builtin_amdgcn_sched_barrier(0)
    Unit cur, nxt; int ui = 0;
    if (!S.next(0, cur)) return;
    f32x4 acc[2][2][4][2];
#pragma unroll
    for (int a = 0; a < 2; ++a)
#pragma unroll
        for (int b = 0; b < 2; ++b)
#pragma unroll
            for (int m = 0; m < 4; ++m)
#pragma unroll
                for (int n = 0; n < 2; ++n) acc[a][b][m][n] = (f32x4){0.f, 0.f, 0.f, 0.f};
    bf16x8 At[4][2], B0[2][2], B1[2][2];
    const char* cA = GATHER ? (const char*)g.A : (const char*)g.A + (size_t)cur.pm * tstep; const char* cB = (const char*)g.Bt + (size_t)cur.pn * tstep;
    if constexpr (GATHER) { PG8_GLOAD(gc, cur.pm); }
    S.a_ready(cur);
    if constexpr (SP2) {
        PG8_STAGE(PG8_SB(0, 0), cB, voffB); PG8_STAGE(PG8_SB(0, 1), cB + hstep, voffB); PG8_STAGE_A(PG8_SA(0, 0), cA, 0, false); PG8_STAGE_A(PG8_SA(0, 1), cA, 1, false);
        if (wr == 1) PG8_BAR;
        PG8_WAIT_V(2); PG8_BAR;
        PG8_STAGE(PG8_SB(1, 0), cB + kstep, voffB); PG8_STAGE_A(PG8_SA(1, 0), cA + kstep, 0, false); PG8_STAGE(PG8_SB(1, 1), cB + hstep + kstep, voffB);
        PG8_WAIT_V(6); PG8_BAR;
    } else {
        PG8_STAGE(PG8_SB(0, 0), cB, voffB); PG8_STAGE_A(PG8_SA(0, 0), cA, 0, false); PG8_STAGE(PG8_SB(0, 1), cB + hstep, voffB); PG8_STAGE_A(PG8_SA(0, 1), cA, 1, false);
        if (wr == 1) PG8_BAR;
        PG8_WAIT_V(4); PG8_BAR;
        PG8_STAGE(PG8_SB(1, 0), cB + kstep, voffB); PG8_STAGE_A(PG8_SA(1, 0), cA + kstep, 0, false); PG8_STAGE(PG8_SB(1, 1), cB + hstep + kstep, voffB);
        PG8_WAIT_V(6); PG8_BAR;
    }
    for (;;) {
        const bool has_next = S.next(ui + 1, nxt);
        const char* nA = GATHER ? cA : (has_next ? (const char*)g.A + (size_t)nxt.pm * tstep : cA);
        if constexpr (GATHER) { if (has_next) { PG8_GLOAD(gn, nxt.pm); } else { gn[0][0] = gc[0][0]; gn[0][1] = gc[0][1]; gn[1][0] = gc[1][0]; gn[1][1] = gc[1][1]; } }
        const char* nB = has_next ? (const char*)g.Bt + (size_t)nxt.pn * tstep : cB;
        for (int t = 0; t < nt; t += 2) {
            const bool last = (t == nt - 2);
            const char* a1 = cA + (size_t)(t + 1) * kstep;
            const char* a2 = last ? nA : cA + (size_t)(t + 2) * kstep; const char* b2 = last ? nB : cB + (size_t)(t + 2) * kstep;
            const char* a3 = a2 + kstep; const char* b3 = b2 + kstep;
            if (last && has_next) S.a_ready(nxt);
            if constexpr (SP2) {
            PG8_LDB(B0, 0, 0); PG8_LDB(B1, 0, 1); PG8_SCHED; PG8_LDA(At, 0, 0); PG8_STAGE_A(PG8_SA(1, 1), a1, 1, false);
            PG8_WAIT_V(8); PG8_WAIT_L(0); PG8_BAR; PG8_MMA(0, 0, At, B0); PG8_MMA(0, 1, At, B1); PG8_BAR; PG8_SCHED;
            PG8_LDA(At, 0, 1); PG8_STAGE(PG8_SB(0, 0), b2, voffB); PG8_STAGE(PG8_SB(0, 1), b2 + hstep, voffB); PG8_STAGE_A(PG8_SA(0, 0), a2, 0, last);
            PG8_WAIT_V(8); PG8_WAIT_L(0); PG8_BAR; PG8_MMA(1, 0, At, B0); PG8_MMA(1, 1, At, B1); PG8_BAR; PG8_SCHED;
            PG8_LDB(B0, 1, 0); PG8_LDB(B1, 1, 1); PG8_SCHED; PG8_LDA(At, 1, 0); PG8_STAGE_A(PG8_SA(0, 1), a2, 1, last);
            PG8_WAIT_V(8); PG8_WAIT_L(0); PG8_BAR; PG8_MMA(0, 0, At, B0); PG8_MMA(0, 1, At, B1); PG8_BAR; PG8_SCHED;
            PG8_LDA(At, 1, 1); PG8_STAGE(PG8_SB(1, 0), b3, voffB); PG8_STAGE(PG8_SB(1, 1), b3 + hstep, voffB); PG8_STAGE_A(PG8_SA(1, 0), a3, 0, last);
            PG8_WAIT_V(8); PG8_WAIT_L(0); PG8_BAR; PG8_MMA(1, 0, At, B0); PG8_MMA(1, 1, At, B1); PG8_BAR; PG8_SCHED;
            } else {
            PG8_LDB(B0, 0, 0); PG8_SCHED; PG8_LDA(At, 0, 0); PG8_STAGE_A(PG8_SA(1, 1), a1, 1, false);
            PG8_WAIT_L(8); PG8_BAR; PG8_WAIT_L(0); PG8_MMA(0, 0, At, B0); PG8_BAR; PG8_SCHED;
            PG8_LDB(B1, 0, 1); PG8_STAGE(PG8_SB(0, 0), b2, voffB);
            PG8_BAR; PG8_WAIT_L(0); PG8_MMA(0, 1, At, B1); PG8_BAR;
            PG8_LDA(At, 0, 1); PG8_STAGE_A(PG8_SA(0, 0), a2, 0, last);
            PG8_BAR; PG8_WAIT_L(0); PG8_MMA(1, 0, At, B0); PG8_BAR; PG8_SCHED;
            PG8_STAGE(PG8_SB(0, 1), b2 + hstep, voffB);
            PG8_WAIT_V(6); PG8_BAR; PG8_MMA(1, 1, At, B1); PG8_BAR;
            PG8_LDB(B0, 1, 0); PG8_SCHED; PG8_LDA(At, 1, 0); PG8_STAGE_A(PG8_SA(0, 1), a2, 1, last);
            PG8_WAIT_L(8); PG8_BAR; PG8_WAIT_L(0); PG8_MMA(0, 0, At, B0); PG8_BAR; PG8_SCHED;
            PG8_LDB(B1, 1, 1); PG8_STAGE(PG8_SB(1, 0), b3, voffB);
            PG8_BAR; PG8_WAIT_L(0); PG8_MMA(0, 1, At, B1); PG8_BAR;
            PG8_LDA(At, 1, 1); PG8_STAGE_A(PG8_SA(1, 0), a3, 0, last);
            PG8_BAR; PG8_WAIT_L(0); PG8_MMA(1, 0, At, B0); PG8_BAR; PG8_SCHED;
            PG8_STAGE(PG8_SB(1, 1), b3 + hstep, voffB);
            PG8_WAIT_V(6); PG8_BAR; PG8_MMA(1, 1, At, B1); PG8_BAR;
            }
        }
        if constexpr (ALIGN_EPI) { if (wr == 0) PG8_BAR; }
        if constexpr (!Epi::AFTER_DRAIN) { E(acc, cur, wr, wc, fr, fq); S.done(cur); }
        if (!has_next) break;
#pragma unroll
        for (int a = 0; a < 2; ++a)
#pragma unroll
            for (int b = 0; b < 2; ++b)
#pragma unroll
                for (int m = 0; m < 4; ++m)
#pragma unroll
                    for (int n = 0; n < 2; ++n) acc[a][b][m][n] = (f32x4){0.f, 0.f, 0.f, 0.f};
        cur = nxt; cA = nA; cB = nB; ++ui;
        if constexpr (GATHER) { gc[0][0] = gn[0][0]; gc[0][1] = gn[0][1]; gc[1][0] = gn[1][0]; gc[1][1] = gn[1][1]; }
        if constexpr (ALIGN_EPI) { if (wr == 1) PG8_BAR; }
    }
    PG8_WAIT_V(0);
    if constexpr (!ALIGN_EPI) { if (wr == 0) PG8_BAR; }
    PG8_BAR;
    if constexpr (Epi::AFTER_DRAIN) { E.fused(acc, cur, wr, wc, fr, fq, lds, wid, lane); S.done(cur); }
#undef PG8_SA
#undef PG8_SB
#undef PG8_STAGE
#undef PG8_STAGE_A
#undef PG8_GLOAD
#undef PG8_LDA
#undef PG8_LDB
#undef PG8_MMA
#undef PG8_WAIT_V
#undef PG8_WAIT_L
#undef PG8_BAR
#undef PG8_SCHED
}
}

#define GAS __attribute__((address_space(1)))
#define LAS __attribute__((address_space(3)))
typedef unsigned short bf16;
typedef unsigned v4u __attribute__((ext_vector_type(4)));
typedef unsigned v2u __attribute__((ext_vector_type(2)));
typedef float f32x4 __attribute__((ext_vector_type(4)));
typedef short bf16x8 __attribute__((ext_vector_type(8)));
typedef GAS unsigned gu32;

constexpr int NWAVES = 8, NTHR = 512;
constexpr int BATCH = 8, SEQ = 8192, T = BATCH * SEQ, D = 1024, MEMLEN = 256, TMEM = BATCH * MEMLEN;
constexpr int INW = 3080, NIN = 3072, NKV = 512;
constexpr int NBUCKET = 24, ROWS_MAX = T + NBUCKET * 256;
constexpr float EPSN = 1e-6f;
constexpr float C2 = 0.125f * 1.4426950408889634f;
constexpr float LOG2E = 1.4426950408889634f;

constexpr size_t MiB = 1u << 20;
constexpr size_t WS_CTL = 0, CTL_ZERO_BYTES = 1 * MiB;
constexpr size_t WS_ROPE = 2 * MiB;
constexpr size_t WS_IG = 6 * MiB;
constexpr size_t WS_FG = 7 * MiB;
constexpr size_t WS_LSE = 8 * MiB;
constexpr size_t WS_SS1 = 14 * MiB;
constexpr size_t WS_SS3 = 18 * MiB;
constexpr size_t WS_KVX = 22 * MiB;
constexpr size_t WS_NLOC = 24 * MiB;
constexpr size_t WS_NPREV = 25 * MiB;
constexpr size_t WS_MLOC = 26 * MiB;
constexpr size_t WS_BLAST = 26 * MiB + 64 * 1024;
constexpr size_t WS_MPREV = 26 * MiB + 128 * 1024;
constexpr size_t WS_TOKINFO = 27 * MiB;
constexpr size_t WS_TOKMAP = 28 * MiB;
constexpr size_t WS_WSORT = 19 * MiB;
constexpr size_t WS_WR = 30 * MiB;
constexpr size_t WS_WG = 30 * MiB + 512 * 1024;
constexpr size_t WS_PAR = 31 * MiB;
constexpr int PAR_CONVW = 0, PAR_CONVB = 2048, PAR_GMHN = 2560, PAR_SKIP = 3072, PAR_BRG = 3584, PAR_BRE = 3600, PAR_GFIN = 3616, PAR_N = 4640;
constexpr size_t WS_WIN = 32 * MiB;
constexpr size_t WS_WOUT = 39 * MiB;
constexpr size_t WS_WQX = 41 * MiB;
constexpr size_t WS_WOX = 41 * MiB + 512 * 1024;
constexpr size_t WS_WM = 42 * MiB;
constexpr size_t WS_W13 = 44 * MiB;
constexpr size_t WS_W2P = 76 * MiB;
constexpr size_t WS_XN = 128 * MiB;
constexpr size_t WS_CLOC = 128 * MiB;
constexpr size_t WS_GAGG = 192 * MiB;
constexpr size_t WS_GN = 200 * MiB;
constexpr size_t WS_GSC = 200 * MiB + 512 * 1024;
constexpr size_t WS_Q = 264 * MiB;
constexpr size_t WS_K = 328 * MiB, WS_V = 392 * MiB, WS_MU = 456 * MiB, WS_MV = 520 * MiB, WS_MO = 584 * MiB;
constexpr size_t WS_MQ = 648 * MiB, WS_MK = 712 * MiB;
constexpr size_t WS_Y = 264 * MiB;
constexpr size_t WS_CPREV = 392 * MiB;
constexpr size_t WS_X1B = 648 * MiB;
constexpr size_t WS_QX = 776 * MiB;
constexpr size_t WS_OX = 808 * MiB;
constexpr size_t WS_HBS = 264 * MiB;
constexpr size_t WS_ACT = 404 * MiB;
constexpr size_t WS_END = 840 * MiB;
constexpr size_t DO_OATT = 0, DO_C = 192 * MiB;

constexpr int CW_BAR = 4096;
constexpr int CW_CNT = 8192;
constexpr int CW_FILL = 8192 + 64;

constexpr int LDS_BYTES = 163840;
constexpr int LDS_MISC = 159744;
constexpr int LDS_RS = 135168;
constexpr int LDS_TAB = 136192;

#define LDS_WAIT() asm volatile("s_waitcnt lgkmcnt(0)" ::: "memory")
#define VM_WAIT() asm volatile("s_waitcnt vmcnt(0)" ::: "memory")
__device__ __forceinline__ unsigned f2bf(float f) { unsigned u = __builtin_bit_cast(unsigned, f); return (u + 0x7fffu + ((u >> 16) & 1u)) >> 16; }
typedef float f32x2_t __attribute__((ext_vector_type(2))); typedef __bf16 bf16x2_t __attribute__((ext_vector_type(2)));
__device__ __forceinline__ unsigned pk2(float lo, float hi) { f32x2_t v = {lo, hi}; bf16x2_t b = __builtin_convertvector(v, bf16x2_t); return __builtin_bit_cast(unsigned, b); }
__device__ __forceinline__ float bf2f(unsigned h) { return __uint_as_float(h << 16); }
__device__ __forceinline__ float bflo(unsigned w) { return __uint_as_float(w << 16); }
__device__ __forceinline__ float bfhi(unsigned w) { return __uint_as_float(w & 0xffff0000u); }
__device__ __forceinline__ float wave_sum(float v) {
#pragma unroll
    for (int o = 1; o < 64; o <<= 1) v += __shfl_xor(v, o);
    return v;
}
__device__ __forceinline__ float wave_max(float v) {
#pragma unroll
    for (int o = 1; o < 64; o <<= 1) v = fmaxf(v, __shfl_xor(v, o));
    return v;
}
__device__ __forceinline__ float fexp_(float x) { return __builtin_amdgcn_exp2f(x * 1.4426950408889634f); }
__device__ __forceinline__ float frcp_(float x) { return __builtin_amdgcn_rcpf(x); }
__device__ __forceinline__ float sigmoidf_(float x) { return __builtin_amdgcn_rcpf(1.0f + __builtin_amdgcn_exp2f(x * -1.4426950408889634f)); }

#define XB_TMO      128
#define XB_XCNT(j)  (256  + 64 * (j))
#define XB_XSUB(j)  (1280 + 64 * (j))
#define XB_XGEN(j)  (2304 + 64 * (j))
#define XB_TOP      3328
#define XB_TOPGEN   3392
#define XCD_BAR_WORDS 3456
#define XB_SPIN_CAP (1u << 22)
__device__ __forceinline__ unsigned xb_ld(unsigned* p)              { return __hip_atomic_load(p, __ATOMIC_RELAXED, __HIP_MEMORY_SCOPE_AGENT); }
__device__ __forceinline__ unsigned xb_add(unsigned* p, unsigned v) { return __hip_atomic_fetch_add(p, v, __ATOMIC_RELAXED, __HIP_MEMORY_SCOPE_AGENT); }
__device__ __forceinline__ unsigned xb_xcc_id() { return (unsigned)__builtin_amdgcn_s_getreg((3 << 11) | 20) & 0xFu; }
#define XB_SPIN(cond, bar) do { unsigned _sp = 0; while (cond) { __builtin_amdgcn_s_sleep(1); \
    if ((++_sp & 255u) == 0u) { if (xb_ld(&(bar)[XB_TMO])) break; if (_sp > XB_SPIN_CAP) { atomicAdd(&(bar)[XB_TMO], 1u); break; } } } } while (0)
struct XcdBarrier { unsigned* bar; unsigned x; volatile LAS unsigned* st; };
__device__ __forceinline__ XcdBarrier xcd_barrier_post(unsigned* bar, volatile LAS unsigned* st) {
    XcdBarrier b; b.bar = bar; b.x = xb_xcc_id(); b.st = st;
    if (threadIdx.x == 0) (void)xb_add(&bar[XB_XCNT(b.x)], 1u);
    return b;
}
__device__ __forceinline__ void xcd_barrier_complete(unsigned* bar, unsigned x, unsigned& nloc, unsigned& nx) {
    const unsigned G = gridDim.x * gridDim.y * gridDim.z;
    unsigned sum, cnt, mine, sp = 0u;
    for (;;) {
        sum = 0u; cnt = 0u; mine = 0u;
#pragma unroll
        for (unsigned j = 0; j < 16; ++j) { const unsigned c = xb_ld(&bar[XB_XCNT(j)]); sum += c; cnt += (c > 0u) ? 1u : 0u; mine = (j == x) ? c : mine; }
        if (sum == G) break;
        __builtin_amdgcn_s_sleep(1);
        if ((++sp & 255u) == 0u) { if (xb_ld(&bar[XB_TMO])) break; if (sp > XB_SPIN_CAP) { atomicAdd(&bar[XB_TMO], 1u); break; } }
    }
    nloc = mine > 0u ? mine : 1u; nx = cnt > 0u ? cnt : 1u;
}
__device__ __forceinline__ void xcd_barrier(const XcdBarrier& b) {
    asm volatile("s_waitcnt vmcnt(0)" ::: "memory");
    __syncthreads();
    if (threadIdx.x == 0) {
        unsigned* bar = b.bar;
        __builtin_amdgcn_s_waitcnt(0);
        unsigned nloc = b.st[0], nx = b.st[1];
        if (nloc == 0u) { xcd_barrier_complete(bar, b.x, nloc, nx); b.st[0] = nloc; b.st[1] = nx; }
        const unsigned old = xb_add(&bar[XB_XSUB(b.x)], 1u);
        const unsigned gen = old / nloc;
        if (old + 1u == (gen + 1u) * nloc) {
            __builtin_amdgcn_fence(__ATOMIC_RELEASE, "agent");
            asm volatile("s_waitcnt vmcnt(0)" ::: "memory");
            const unsigned og = xb_add(&bar[XB_TOP], 1u);
            const unsigned tg = og / nx;
            if (og + 1u == (tg + 1u) * nx) xb_add(&bar[XB_TOPGEN], 1u);
            else XB_SPIN(xb_ld(&bar[XB_TOPGEN]) == tg, bar);
            __builtin_amdgcn_fence(__ATOMIC_ACQUIRE, "agent");
            xb_add(&bar[XB_XGEN(b.x)], 1u);
            asm volatile("s_waitcnt vmcnt(0)" ::: "memory");
        } else {
            XB_SPIN(xb_ld(&bar[XB_XGEN(b.x)]) == gen, bar);
            __builtin_amdgcn_fence(__ATOMIC_ACQUIRE, "agent");
            asm volatile("s_waitcnt vmcnt(0)" ::: "memory");
        }
    }
    __syncthreads();
}

struct Args { const void* in[28]; float* out; unsigned char* ws; int ph_lo, ph_hi; };

template <int MI, int NJ>
__device__ __forceinline__ void wave_mma(const bf16* A, int lda, const bf16* Bt, int ldb, int K, f32x4 (&acc)[MI][NJ], int fr, int fq) {
    for (int k0 = 0; k0 < K; k0 += 32) {
        bf16x8 a[MI], b[NJ];
#pragma unroll
        for (int i = 0; i < MI; ++i) a[i] = *(const bf16x8*)(A + (16 * i + fr) * lda + k0 + 8 * fq);
#pragma unroll
        for (int j = 0; j < NJ; ++j) b[j] = *(const bf16x8*)(Bt + (16 * j + fr) * ldb + k0 + 8 * fq);
#pragma unroll
        for (int i = 0; i < MI; ++i)
#pragma unroll
            for (int j = 0; j < NJ; ++j) acc[i][j] = __builtin_amdgcn_mfma_f32_16x16x32_bf16(b[j], a[i], acc[i][j], 0, 0, 0);
    }
}

__device__ __forceinline__ void transpose_item(const float* src, int src_ld, int k0, int n0, bf16* dst, int dst_ld, int dst_row0, int dst_col0,
                                               const float* gain, float scale, LAS float* scr, int lane) {
    f32x4 ld[16];
#pragma unroll
    for (int i = 0; i < 16; ++i) { const int kk = 4 * i + (lane >> 4); ld[i] = *(const f32x4*)(src + (size_t)(k0 + kk) * src_ld + n0 + 4 * (lane & 15)); }
#pragma unroll
    for (int i = 0; i < 16; ++i) { const int kk = 4 * i + (lane >> 4); *(LAS f32x4*)(scr + kk * 64 + 4 * ((lane & 15) ^ ((kk >> 3) & 15))) = ld[i]; }
    const int c = lane & 7;
    f32x4 g0 = (f32x4){scale, scale, scale, scale}, g1 = g0;
    if (gain) { g0 = *(const f32x4*)(gain + k0 + 8 * c) * scale; g1 = *(const f32x4*)(gain + k0 + 8 * c + 4) * scale; }
    LDS_WAIT(); asm volatile("" ::: "memory");
#pragma unroll
    for (int j = 0; j < 8; ++j) { const int n = (lane >> 3) + 8 * j; const LAS float* s = scr + (8 * c) * 64 + 4 * ((n >> 2) ^ c) + (n & 3);
        v4u o; o.x = pk2(s[0 * 64] * g0[0], s[1 * 64] * g0[1]); o.y = pk2(s[2 * 64] * g0[2], s[3 * 64] * g0[3]); o.z = pk2(s[4 * 64] * g1[0], s[5 * 64] * g1[1]); o.w = pk2(s[6 * 64] * g1[2], s[7 * 64] * g1[3]);
        *(v4u*)(dst + (size_t)(dst_row0 + n) * dst_ld + dst_col0 + 8 * c) = o; }
    LDS_WAIT(); asm volatile("" ::: "memory");
}

__device__ __forceinline__ void p0_prologue(const Args& A, unsigned char* lds, int tid, int lane, int wave) {
    unsigned char* ws = A.ws;
    const float* x = (const float*)A.in[0]; const float* mem = (const float*)A.in[1]; const int* positions = (const int*)A.in[2];
    const float* g_mix = (const float*)A.in[3]; const float* w_in = (const float*)A.in[4];
    const float* w_q_m = (const float*)A.in[7]; const float* w_k_m = (const float*)A.in[8];
    const float* b_i = (const float*)A.in[9]; const float* b_f = (const float*)A.in[10];
    const float* w_out = (const float*)A.in[13]; const float* g_cross = (const float*)A.in[14]; const float* g_mem = (const float*)A.in[15];
    const float* w_q_x = (const float*)A.in[16]; const float* w_kv_x = (const float*)A.in[17]; const float* w_o_x = (const float*)A.in[18];
    const float* g_ffn = (const float*)A.in[19]; const float* w_rg = (const float*)A.in[20]; const float* w_re = (const float*)A.in[22];
    const float* w1 = (const float*)A.in[24]; const float* w3 = (const float*)A.in[25]; const float* w2 = (const float*)A.in[26];
    const int G = gridDim.x, gw = blockIdx.x * NWAVES + wave, NGW = G * NWAVES, gt = blockIdx.x * NTHR + tid, NGT = G * NTHR;

    LAS float* WGl = (LAS float*)lds;
    for (int i = tid; i < 8 * 1024; i += NTHR) { const int k = i >> 3, j = i & 7; WGl[j * 1024 + k] = g_mix[k] * w_in[(size_t)k * INW + NIN + j]; }

    for (int i = gt; i < PAR_N; i += NGT) { float v;
        if (i < PAR_CONVB) v = ((const float*)A.in[5])[i]; else if (i < PAR_GMHN) v = ((const float*)A.in[6])[i - PAR_CONVB]; else if (i < PAR_SKIP) v = ((const float*)A.in[11])[i - PAR_GMHN];
        else if (i < PAR_BRG) v = ((const float*)A.in[12])[i - PAR_SKIP]; else if (i < PAR_BRE) v = ((const float*)A.in[21])[i - PAR_BRG]; else if (i < PAR_GFIN) v = ((const float*)A.in[23])[i - PAR_BRE];
        else v = ((const float*)A.in[27])[i - PAR_GFIN];
        ((float*)(ws + WS_PAR))[i] = v; }
    for (int i = gt; i < 20 * 1024; i += NGT) { const int e = i >> 10, k = i & 1023;
        ((float*)(ws + WS_WR))[i] = g_ffn[k] * (e < 4 ? w_rg[k * 4 + e] : w_re[k * 16 + (e - 4)]); }
    for (int i = gt; i < T * 8; i += NGT) { const int t = i >> 3, j = i & 7; const float invf = powf(500000.0f, -(float)j * 0.125f);
        const float ang = (float)positions[t] * invf; float sn, cs; sincosf(ang, &sn, &cs);
        ((float*)(ws + WS_ROPE))[t * 16 + j] = cs; ((float*)(ws + WS_ROPE))[t * 16 + 8 + j] = sn; }
    __syncthreads();
    for (int m0 = 2 * gw; m0 < T + TMEM; m0 += 2 * NGW) {
        f32x4 v[2][4]; float rstd[2];
#pragma unroll
        for (int q = 0; q < 2; ++q) { const int m = m0 + q; const f32x4* xr = (const f32x4*)(m >= T ? mem + (size_t)(m - T) * D : x + (size_t)m * D) + lane;
#pragma unroll
            for (int j = 0; j < 4; ++j) v[q][j] = xr[64 * j]; }
#pragma unroll
        for (int q = 0; q < 2; ++q) { float s = 0.f;
#pragma unroll
            for (int j = 0; j < 4; ++j) s += (v[q][j].x * v[q][j].x + v[q][j].y * v[q][j].y) + (v[q][j].z * v[q][j].z + v[q][j].w * v[q][j].w);
            rstd[q] = 1.0f / sqrtf(wave_sum(s) * (1.0f / D) + EPSN);
            unsigned long long* o8 = (unsigned long long*)(ws + WS_XN + (size_t)(m0 + q) * D * 2) + lane;
#pragma unroll
            for (int j = 0; j < 4; ++j) o8[64 * j] = (unsigned long long)pk2(v[q][j].x * rstd[q], v[q][j].y * rstd[q]) | ((unsigned long long)pk2(v[q][j].z * rstd[q], v[q][j].w * rstd[q]) << 32); }
        if (m0 < T) {
            float val0 = 0.f, val1 = 0.f;
#pragma unroll
            for (int g = 0; g < 8; ++g) { float a0 = 0.f, a1 = 0.f;
#pragma unroll
                for (int j = 0; j < 4; ++j) { const f32x4 w = *(const LAS f32x4*)(WGl + g * 1024 + 256 * j + 4 * lane);
                    a0 += (v[0][j].x * w.x + v[0][j].y * w.y) + (v[0][j].z * w.z + v[0][j].w * w.w); a1 += (v[1][j].x * w.x + v[1][j].y * w.y) + (v[1][j].z * w.z + v[1][j].w * w.w); }
                a0 = wave_sum(a0) * rstd[0]; a1 = wave_sum(a1) * rstd[1];
                val0 = (lane == g) ? a0 : val0; val1 = (lane == g) ? a1 : val1; }
            if (lane < 8) { const int h = lane & 3;
#pragma unroll
                for (int q = 0; q < 2; ++q) { const int m = m0 + q, b = m / SEQ, sq = m % SEQ; const float val = q ? val1 : val0;
                    if (lane < 4) ((float*)(ws + WS_IG))[(size_t)(b * 4 + h) * SEQ + sq] = val + b_i[h];
                    else ((float*)(ws + WS_FG))[(size_t)(b * 4 + h) * SEQ + sq] = val + b_f[h]; } }
        }
    }
    __syncthreads();
    LAS float* scr = (LAS float*)(lds + wave * 16384);
    constexpr int I_IN = 16 * 48, I_KV = 16 * 8, I_OUT = 16 * 16, I_QX = 16 * 4, I_OX = 4 * 16, I_M = 32, I_13 = 16 * 2 * 128, I_2P = 24 * 2 * 128;
    constexpr int NITEMS = I_IN + I_KV + I_OUT + I_QX + I_OX + I_M + I_13 + I_2P;
    for (int it = gw; it < NITEMS; it += NGW) {
        int r = it;
        if (r < I_IN) { const int kb = r / 48, nb = r % 48; transpose_item(w_in, INW, 64 * kb, 64 * nb, (bf16*)(ws + WS_WIN), 1024, 64 * nb, 64 * kb, g_mix, (64 * nb < 512) ? C2 : 1.0f, scr, lane); continue; } r -= I_IN;
        if (r < I_KV) { const int kb = r / 8, nb = r % 8; transpose_item(w_kv_x, 512, 64 * kb, 64 * nb, (bf16*)(ws + WS_WIN), 1024, NIN + 64 * nb, 64 * kb, g_mem, 1.0f, scr, lane); continue; } r -= I_KV;
        if (r < I_OUT) { const int kb = r / 16, nb = r % 16; transpose_item(w_out, 1024, 64 * kb, 64 * nb, (bf16*)(ws + WS_WOUT), 1024, 64 * nb, 64 * kb, nullptr, 1.0f, scr, lane); continue; } r -= I_OUT;
        if (r < I_QX) { const int kb = r / 4, nb = r % 4; transpose_item(w_q_x, 256, 64 * kb, 64 * nb, (bf16*)(ws + WS_WQX), 1024, 64 * nb, 64 * kb, g_cross, C2, scr, lane); continue; } r -= I_QX;
        if (r < I_OX) { const int kb = r / 16, nb = r % 16; transpose_item(w_o_x, 1024, 64 * kb, 64 * nb, (bf16*)(ws + WS_WOX), 256, 64 * nb, 64 * kb, nullptr, 1.0f, scr, lane); continue; } r -= I_OX;
        if (r < I_M) { const int which = r / 16, h = (r % 16) / 4, kb = (r % 4) / 2, nb = r % 2;
            transpose_item((which ? w_k_m : w_q_m) + (size_t)h * 128 * 128, 128, 64 * kb, 64 * nb, (bf16*)(ws + WS_WM) + (size_t)(which * 4 + h) * 128 * 128, 128, 64 * nb, 64 * kb, nullptr,
                           which ? 0.08838834764831845f : 1.0f, scr, lane); continue; } r -= I_M;
        if (r < I_13) { const int e = r / 256, which = (r % 256) / 128, kb = (r % 128) / 8, nb = r % 8; const int n0 = 64 * nb;
            transpose_item((which ? w3 : w1) + (size_t)e * 1024 * 512, 512, 64 * kb, n0, (bf16*)(ws + WS_W13) + (size_t)e * 1024 * 1024, 1024, (n0 / 128) * 256 + which * 128 + (n0 % 128), 64 * kb, g_ffn, 1.0f, scr, lane); continue; } r -= I_13;
        { const int bk = r / 256, hf = (r % 256) / 128, kb = (r % 128) / 16, nb = r % 16; const int g = bk / 6, p = bk % 6;
          const int pa = (p < 3) ? 0 : (p < 5 ? 1 : 2), pb = (p < 3) ? p + 1 : (p < 5 ? p - 1 : 3); const int e = 4 * g + (hf ? pb : pa);
          transpose_item(w2 + (size_t)e * 512 * 1024, 1024, 64 * kb, 64 * nb, (bf16*)(ws + WS_W2P) + (size_t)bk * 1024 * 1024, 1024, 64 * nb, hf * 512 + 64 * kb, nullptr, 1.0f, scr, lane); }
    }
}

__device__ __forceinline__ v4u pack8(const f32x4& a, const f32x4& b) { v4u w; w.x = pk2(a[0], a[1]); w.y = pk2(a[2], a[3]); w.z = pk2(b[0], b[1]); w.w = pk2(b[2], b[3]); return w; }
struct EpiInProj {
    static constexpr bool PERM = true, AFTER_DRAIN = false;
    bf16* base; const float* rope;
    __device__ __forceinline__ void operator()(const f32x4 (&acc)[2][2][4][2], const pg8::Unit& u, int wr, int wc, int fr, int fq) const {
        const int buf = u.pn >> 1; bf16* B = base + (size_t)buf * T * 512;
        const int row0 = u.pm * 256 + wr * 64 + fr, col0 = (u.pn & 1) * 256 + wc * 32 + 8 * fq;
        const bool dorope = (buf < 2) && ((wc & 1) == 0);
#pragma unroll
        for (int ai = 0; ai < 2; ++ai)
#pragma unroll
            for (int m = 0; m < 4; ++m) { const int row = row0 + ai * 128 + m * 16; bf16* rowp = B + (size_t)row * 512 + col0;
                f32x4 cs0, cs1, sn0, sn1;
                if (dorope) { const f32x4* rp = (const f32x4*)(rope + (size_t)row * 16); cs0 = rp[0]; cs1 = rp[1]; sn0 = rp[2]; sn1 = rp[3]; }
#pragma unroll
                for (int bj = 0; bj < 2; ++bj) { f32x4 v0 = acc[ai][bj][m][0], v1 = acc[ai][bj][m][1];
                    if (dorope) { f32x4 o0, o1;
#pragma unroll
                        for (int i = 0; i < 4; ++i) { o0[i] = __shfl_xor(v0[i], 16); o1[i] = __shfl_xor(v1[i], 16); }
                        if (fq == 0) { v0 = v0 * cs0 - o0 * sn0; v1 = v1 * cs1 - o1 * sn1; }
                        else if (fq == 1) { v0 = v0 * cs0 + o0 * sn0; v1 = v1 * cs1 + o1 * sn1; } }
                    *(v4u*)(rowp + bj * 128) = pack8(v0, v1); } }
    }
};

typedef short v4i16_t __attribute__((ext_vector_type(4)));
struct AttItem { int cfg, b, h, d, nb; size_t tokb; };
__device__ __forceinline__ AttItem attn_decode(int item) {
    AttItem a; a.cfg = item >> 12; int rem = item & 4095; a.b = rem >> 9; rem &= 511; a.h = rem >> 6; const int sub = rem & 63;
    a.d = (a.cfg == 0) ? 1 : (a.cfg == 1 ? 4 : 16); const int nblk = 64 / a.d, r = sub / nblk; a.nb = sub % nblk; a.tokb = (size_t)a.b * SEQ + r; return a;
}
__device__ __forceinline__ int attn_item_of(int k, int G) {
    if (G != 256) return (int)blockIdx.x + k * G;
    const int pair = (int)(blockIdx.x & 7) + 8 * (k / 6), j = (int)(blockIdx.x >> 3), ip = j * 6 + (k % 6);
    return ((ip >> 6) << 12) | (pair << 6) | (ip & 63);
}
__device__ __forceinline__ void glds16(const void* gsrc, unsigned lds_dst) { unsigned keep;
    asm volatile("s_mov_b32 %0, m0\n\ts_mov_b32 m0, %2\n\ts_nop 0\n\tglobal_load_lds_dwordx4 %1, off\n\ts_mov_b32 m0, %0" : "=&s"(keep) : "v"(gsrc), "s"(lds_dst) : "memory"); }
__device__ __forceinline__ unsigned lds_addr_of(LAS unsigned char* p) { return (unsigned)(uintptr_t)p; }
__device__ __forceinline__ void attn_prefetch(const Args& A, LAS unsigned char* L, int item, int pslot, int oslot, bool load_prev, int lane, int wave, bf16x8 (&qf)[2]) {
    const AttItem a = attn_decode(item);
    const bf16* Kg = (const bf16*)(A.ws + WS_K) + a.h * 64; const bf16* Vg = (const bf16*)(A.ws + WS_V) + a.h * 64; const bf16* Qg = (const bf16*)(A.ws + WS_Q) + a.h * 64;
#pragma unroll
    for (int i = 0; i < 2; ++i) { const int inst = wave + 8 * i, row = 8 * inst + (lane >> 3);
        const size_t off = (a.tokb + (size_t)(128 * a.nb + row) * a.d) * 512 + ((lane & 7) ^ (lane >> 3)) * 8;
        glds16(Kg + off, (unsigned)__builtin_amdgcn_readfirstlane(lds_addr_of(L + oslot * 32768 + inst * 1024)));
        glds16(Vg + off, (unsigned)__builtin_amdgcn_readfirstlane(lds_addr_of(L + oslot * 32768 + 16384 + inst * 1024))); }
    if (load_prev) {
#pragma unroll
        for (int i = 0; i < 2; ++i) { const int inst = wave + 8 * i, row = 8 * inst + (lane >> 3);
            const size_t off = (a.tokb + (size_t)(128 * (a.nb - 1) + row) * a.d) * 512 + ((lane & 7) ^ (lane >> 3)) * 8;
            glds16(Kg + off, (unsigned)__builtin_amdgcn_readfirstlane(lds_addr_of(L + pslot * 32768 + inst * 1024)));
            glds16(Vg + off, (unsigned)__builtin_amdgcn_readfirstlane(lds_addr_of(L + pslot * 32768 + 16384 + inst * 1024))); } }
    const size_t tq = a.tokb + (size_t)(128 * a.nb + 16 * wave + (lane & 15)) * a.d;
    qf[0] = *(const bf16x8*)(Qg + tq * 512 + 8 * (lane >> 4)); qf[1] = *(const bf16x8*)(Qg + tq * 512 + 32 + 8 * (lane >> 4));
}
__device__ __forceinline__ void attn_compute(const Args& A, LAS unsigned char* L, int item, int pslot, int oslot, int lane, int wave, const bf16x8 (&qf)[2]) {
    const AttItem a = attn_decode(item);
    const int fr = lane & 15, g = lane >> 4, qi = 16 * wave + fr;
    f32x4 s[10];
#pragma unroll
    for (int tt = 0; tt < 9; ++tt) { const int t = wave + tt, key = 16 * (t & 7) + fr; LAS unsigned char* kb = L + ((t < 8) ? pslot : oslot) * 32768; s[tt] = (f32x4){0.f, 0.f, 0.f, 0.f};
#pragma unroll
        for (int ks = 0; ks < 2; ++ks) { const bf16x8 kf = *(const LAS bf16x8*)(kb + key * 128 + (((4 * ks + g) ^ (key & 7)) * 16));
            s[tt] = __builtin_amdgcn_mfma_f32_16x16x32_bf16(kf, qf[ks], s[tt], 0, 0, 0); } }
    s[9] = (f32x4){0.f, 0.f, 0.f, 0.f};
#pragma unroll
    for (int e = 0; e < 4; ++e) { s[0][e] = (4 * g + e >= fr) ? s[0][e] : -1e30f; s[8][e] = (4 * g + e <= fr) ? s[8][e] : -1e30f; }
    if (a.nb == 0) {
#pragma unroll
        for (int tt = 0; tt < 8; ++tt) if (wave + tt < 8) s[tt] = (f32x4){-1e30f, -1e30f, -1e30f, -1e30f};
    }
    float mx = -1e30f;
#pragma unroll
    for (int tt = 0; tt < 9; ++tt) mx = fmaxf(fmaxf(mx, fmaxf(s[tt][0], s[tt][1])), fmaxf(s[tt][2], s[tt][3]));
    mx = fmaxf(mx, __shfl_xor(mx, 16)); mx = fmaxf(mx, __shfl_xor(mx, 32));
    float l = 0.f;
#pragma unroll
    for (int tt = 0; tt < 9; ++tt)
#pragma unroll
        for (int e = 0; e < 4; ++e) { s[tt][e] = __builtin_amdgcn_exp2f(s[tt][e] - mx); l += s[tt][e]; }
    l += __shfl_xor(l, 16); l += __shfl_xor(l, 32);
    f32x4 o[4];
#pragma unroll
    for (int dt = 0; dt < 4; ++dt) o[dt] = (f32x4){0.f, 0.f, 0.f, 0.f};
#pragma unroll
    for (int k5 = 0; k5 < 5; ++k5) {
        const v4u pw = (v4u){pk2(s[2 * k5][0], s[2 * k5][1]), pk2(s[2 * k5][2], s[2 * k5][3]), pk2(s[2 * k5 + 1][0], s[2 * k5 + 1][1]), pk2(s[2 * k5 + 1][2], s[2 * k5 + 1][3])};
        const bf16x8 pf = __builtin_bit_cast(bf16x8, pw);
        const int t0 = wave + 2 * k5, t1 = (wave + 2 * k5 + 1 < 16) ? wave + 2 * k5 + 1 : 15;
        const int r0 = 16 * (t0 & 7) + 4 * g + (fr >> 2), r1 = 16 * (t1 & 7) + 4 * g + (fr >> 2), p_ = fr & 3;
        LAS unsigned char* v0b = L + ((t0 < 8) ? pslot : oslot) * 32768 + 16384; LAS unsigned char* v1b = L + ((t1 < 8) ? pslot : oslot) * 32768 + 16384;
#pragma unroll
        for (int dt = 0; dt < 4; ++dt) { const int chunk = 2 * dt + (p_ >> 1);
            const v4i16_t v0 = __builtin_amdgcn_ds_read_tr16_b64_v4i16((LAS v4i16_t*)(v0b + r0 * 128 + ((chunk ^ (r0 & 7)) * 16) + 8 * (p_ & 1)));
            const v4i16_t v1 = __builtin_amdgcn_ds_read_tr16_b64_v4i16((LAS v4i16_t*)(v1b + r1 * 128 + ((chunk ^ (r1 & 7)) * 16) + 8 * (p_ & 1)));
            const bf16x8 vf = (bf16x8){v0[0], v0[1], v0[2], v0[3], v1[0], v1[1], v1[2], v1[3]};
            o[dt] = __builtin_amdgcn_mfma_f32_16x16x32_bf16(vf, pf, o[dt], 0, 0, 0); } }
    const float rl = frcp_(l);
    const size_t tok = a.tokb + (size_t)(128 * a.nb + qi) * a.d;
    bf16* og = (bf16*)((unsigned char*)A.out + DO_OATT) + ((size_t)a.cfg * T + tok) * 512 + a.h * 64;
#pragma unroll
    for (int dt = 0; dt < 4; ++dt) *(v2u*)(og + 16 * dt + 4 * g) = (v2u){pk2(o[dt][0] * rl, o[dt][1] * rl), pk2(o[dt][2] * rl, o[dt][3] * rl)};
    if (g == 0) ((float*)(A.ws + WS_LSE))[((size_t)a.cfg * T + tok) * 8 + a.h] = mx + __builtin_amdgcn_logf(l);
}
__device__ __forceinline__ void attn_phase(const Args& A, unsigned char* lds, int n_total, int lane, int wave) {
    const int G = gridDim.x; LAS unsigned char* L = (LAS unsigned char*)lds;
    const int nk = (G == 256) ? n_total / 256 : (n_total - (int)blockIdx.x + G - 1) / G;
    if (nk <= 0) return;
    bf16x8 qa[2], qb[2];
    int it = attn_item_of(0, G); int ps, os;
    { const AttItem a = attn_decode(it); os = 0; ps = (a.nb > 0) ? 1 : 0; attn_prefetch(A, L, it, ps, os, a.nb > 0, lane, wave, qa); }
    for (int k = 0; k < nk; ++k) {
        __builtin_amdgcn_s_waitcnt(0x0F70);
        asm volatile("s_waitcnt vmcnt(0)" ::: "memory");
        __syncthreads();
        qb[0] = qa[0]; qb[1] = qa[1];
        int nit = it, nps = ps, nos = os;
        if (k + 1 < nk) { nit = attn_item_of(k + 1, G); const AttItem c = attn_decode(it), n = attn_decode(nit);
            const bool succ = (nit == it + 1) && (n.nb == c.nb + 1);
            const int used = (1 << ps) | (1 << os); const int f1 = (used & 1) ? ((used & 2) ? ((used & 4) ? 3 : 2) : 1) : 0; const int used2 = used | (1 << f1);
            const int f2 = (used2 & 1) ? ((used2 & 2) ? ((used2 & 4) ? 3 : 2) : 1) : 0;
            bool lp;
            if (succ) { nps = os; nos = f1; lp = false; } else if (n.nb == 0) { nos = f1; nps = f1; lp = false; } else { nps = f1; nos = f2; lp = true; }
            attn_prefetch(A, L, nit, nps, nos, lp, lane, wave, qb); }
        attn_compute(A, L, it, ps, os, lane, wave, qa);
        qa[0] = qb[0]; qa[1] = qb[1]; it = nit; ps = nps; os = nos;
    }
    asm volatile("s_waitcnt vmcnt(0)" ::: "memory");
    __syncthreads();
}

__device__ __forceinline__ void kv_tile(const Args& A, unsigned char* lds, int tile, int tid, int lane, int wave) {
    unsigned char* ws = A.ws;
    const int mt = tile >> 3, nt = tile & 7;
    const bf16* Ag = (const bf16*)(ws + WS_XN) + (size_t)(T + 64 * mt) * D; const bf16* Bg = (const bf16*)(ws + WS_WIN) + (size_t)(NIN + 64 * nt) * D;
    bf16* As = (bf16*)lds; bf16* Bs = (bf16*)(lds + 64 * 264 * 2);
    const int fr = lane & 15, fq = lane >> 4, wm = wave & 3, wn = wave >> 2;
    f32x4 acc[1][2]; acc[0][0] = (f32x4){0.f, 0.f, 0.f, 0.f}; acc[0][1] = (f32x4){0.f, 0.f, 0.f, 0.f};
    for (int kc = 0; kc < 4; ++kc) {
        for (int id = tid; id < 64 * 32; id += NTHR) { const int row = id >> 5, ch = id & 31;
            *(v4u*)(As + row * 264 + ch * 8) = *(const v4u*)(Ag + (size_t)row * D + kc * 256 + ch * 8);
            *(v4u*)(Bs + row * 264 + ch * 8) = *(const v4u*)(Bg + (size_t)row * D + kc * 256 + ch * 8); }
        __syncthreads();
        wave_mma<1, 2>(As + 16 * wm * 264, 264, Bs + 32 * wn * 264, 264, 256, acc, fr, fq);
        __syncthreads();
    }
    bf16* og = (bf16*)(ws + WS_KVX) + (size_t)(64 * mt + 16 * wm + fr) * NKV + 64 * nt + 32 * wn;
#pragma unroll
    for (int j = 0; j < 2; ++j) *(v2u*)(og + 16 * j + 4 * fq) = (v2u){pk2(acc[0][j][0], acc[0][j][1]), pk2(acc[0][j][2], acc[0][j][3])};
}

constexpr int ML_TILE = 32768;
constexpr int ML_G = 4 * ML_TILE;
static_assert(ML_G + 8192 <= LDS_MISC, "mlstm LDS");
__device__ __forceinline__ int sw_off(int row, int ch) { return 256 * row + 16 * (ch ^ (((row & 3) << 2) | ((row >> 2) & 3))); }
__device__ __forceinline__ bf16x8 rowfrag(LAS unsigned char* tile, int row0, int ks, int fr, int g) { return *(const LAS bf16x8*)(tile + sw_off(row0 + fr, 4 * ks + g)); }
__device__ __forceinline__ bf16x8 colfrag(LAS unsigned char* tile, int ks, int ct, int fr, int g) {
    const int r0 = 32 * ks + 8 * g + (fr >> 2), p = fr & 3, ch = 2 * ct + (p >> 1);
    const v4i16_t a = __builtin_amdgcn_ds_read_tr16_b64_v4i16((LAS v4i16_t*)(tile + sw_off(r0, ch) + 8 * (p & 1)));
    const v4i16_t b = __builtin_amdgcn_ds_read_tr16_b64_v4i16((LAS v4i16_t*)(tile + sw_off(r0 + 4, ch) + 8 * (p & 1)));
    return (bf16x8){a[0], a[1], a[2], a[3], b[0], b[1], b[2], b[3]};
}
__device__ __forceinline__ float log_sigmoidf_(float x) { return (x > 0.f) ? -log1pf(__expf(-x)) : (x - log1pf(__expf(x))); }
__device__ __forceinline__ float wscan_sum(float v0, float v1, float& o0, float& o1, int lane) {
    float x = v0 + v1;
#pragma unroll
    for (int off = 1; off < 64; off <<= 1) { const float t = __shfl_up(x, off); if (lane >= off) x += t; }
    o0 = x - v1; o1 = x; return __shfl(x, 63);
}
__device__ __forceinline__ void wscan_max(float v0, float v1, float& o0, float& o1, int lane) {
    float y = fmaxf(v0, v1);
#pragma unroll
    for (int off = 1; off < 64; off <<= 1) { const float t = __shfl_up(y, off); if (lane >= off) y = fmaxf(y, t); }
    float pre = __shfl_up(y, 1); if (lane == 0) pre = -INFINITY;
    o0 = fmaxf(pre, v0); o1 = fmaxf(pre, fmaxf(v0, v1));
}
__device__ __forceinline__ void tile_load(LAS unsigned char* tile, const bf16* src, size_t pitch, int tid) {
    v4u v[4];
#pragma unroll
    for (int i = 0; i < 4; ++i) { const int id = tid + NTHR * i, row = id >> 4, ch = id & 15; v[i] = *(const v4u*)(src + (size_t)row * pitch + ch * 8); }
#pragma unroll
    for (int i = 0; i < 4; ++i) { const int id = tid + NTHR * i, row = id >> 4, ch = id & 15; *(LAS v4u*)(tile + sw_off(row, ch)) = v[i]; }
}

__device__ __forceinline__ void ml_conv_tile(LAS unsigned char* cA, const bf16* MU, const float* conv_w, const float* conv_b, int b, int c, int h, int tid) {
    const int ch = (tid & 15) * 8;
    float w[4][8], bs[8];
#pragma unroll
    for (int j = 0; j < 4; ++j) { const f32x4 w0 = *(const f32x4*)(conv_w + j * 512 + h * 128 + ch), w1 = *(const f32x4*)(conv_w + j * 512 + h * 128 + ch + 4);
        w[j][0] = w0[0]; w[j][1] = w0[1]; w[j][2] = w0[2]; w[j][3] = w0[3]; w[j][4] = w1[0]; w[j][5] = w1[1]; w[j][6] = w1[2]; w[j][7] = w1[3]; }
    { const f32x4 b0 = *(const f32x4*)(conv_b + h * 128 + ch), b1 = *(const f32x4*)(conv_b + h * 128 + ch + 4);
      bs[0] = b0[0]; bs[1] = b0[1]; bs[2] = b0[2]; bs[3] = b0[3]; bs[4] = b1[0]; bs[5] = b1[1]; bs[6] = b1[2]; bs[7] = b1[3]; }
#pragma unroll
    for (int i = 0; i < 4; ++i) { const int l = (tid >> 4) + 32 * i;
        float a[8];
#pragma unroll
        for (int q = 0; q < 8; ++q) a[q] = bs[q];
#pragma unroll
        for (int j = 0; j < 4; ++j) { const int sp = 128 * c + l + j - 3;
            if (sp >= 0) { const v4u m = *(const v4u*)(MU + ((size_t)b * SEQ + sp) * 512 + ch);
                a[0] += bflo(m.x) * w[j][0]; a[1] += bfhi(m.x) * w[j][1]; a[2] += bflo(m.y) * w[j][2]; a[3] += bfhi(m.y) * w[j][3];
                a[4] += bflo(m.z) * w[j][4]; a[5] += bfhi(m.z) * w[j][5]; a[6] += bflo(m.w) * w[j][6]; a[7] += bfhi(m.w) * w[j][7]; } }
#pragma unroll
        for (int q = 0; q < 8; ++q) a[q] = a[q] * sigmoidf_(a[q]);
        *(LAS v4u*)(cA + sw_off(l, tid & 15)) = (v4u){pk2(a[0], a[1]), pk2(a[2], a[3]), pk2(a[4], a[5]), pk2(a[6], a[7])}; }
}
struct MGroup { f32x4 G[8]; f32x4 Gn; float B, M; };
__device__ __forceinline__ void mlstm_p1_item(const Args& A, unsigned char* lds_, int item, int& wres, MGroup& mg, int tid, int lane, int wave) {
    asm volatile("" : "+v"(tid), "+v"(lane));
    unsigned char* ws = A.ws; LAS unsigned char* lds = (LAS unsigned char*)lds_;
    const int bh = item >> 6, c = item & 63, b = bh >> 2, h = bh & 3;
    const size_t t0 = (size_t)b * SEQ + 128 * c;
    LAS unsigned char* cA = lds; LAS unsigned char* Wk = lds + 2 * ML_TILE; LAS unsigned char* Vt = lds + 3 * ML_TILE;
    LAS float* gl = (LAS float*)(lds + ML_G);
    const int fr = lane & 15, g = lane >> 4, m0 = 16 * wave;
    if (wres != h) { tile_load(Wk, (const bf16*)(ws + WS_WM) + (size_t)(4 + h) * 128 * 128, 128, tid); wres = h; }
    tile_load(Vt, (const bf16*)(ws + WS_MV) + t0 * 512 + h * 128, 512, tid);
    ml_conv_tile(cA, (const bf16*)(ws + WS_MU) + h * 128, (const float*)(ws + WS_PAR) + PAR_CONVW, (const float*)(ws + WS_PAR) + PAR_CONVB, b, c, h, tid);
    float blast, mloc;
    { const size_t gi = (size_t)bh * SEQ + 128 * c + 2 * lane;
      const float i0 = ((const float*)(ws + WS_IG))[gi], i1 = ((const float*)(ws + WS_IG))[gi + 1];
      const float f0 = log_sigmoidf_(((const float*)(ws + WS_FG))[gi]), f1 = log_sigmoidf_(((const float*)(ws + WS_FG))[gi + 1]);
      float b0, b1; blast = wscan_sum(f0, f1, b0, b1, lane);
      const float g0 = blast - b0 + i0, g1 = blast - b1 + i1; mloc = wave_max(fmaxf(g0, g1));
      gl[2 * lane] = fexp_(g0 - mloc); gl[2 * lane + 1] = fexp_(g1 - mloc); }
    __syncthreads();
    { bf16x8 af[4];
#pragma unroll
      for (int ks = 0; ks < 4; ++ks) af[ks] = rowfrag(cA, m0, ks, fr, g);
      const float wk = gl[m0 + fr];
#pragma unroll
      for (int j = 0; j < 8; ++j) { f32x4 acc = (f32x4){0.f, 0.f, 0.f, 0.f};
#pragma unroll
          for (int ks = 0; ks < 4; ++ks) acc = __builtin_amdgcn_mfma_f32_16x16x32_bf16(rowfrag(Wk, 16 * j, ks, fr, g), af[ks], acc, 0, 0, 0);
          *(LAS v2u*)(cA + sw_off(m0 + fr, 2 * j + (g >> 1)) + 8 * (g & 1)) = (v2u){pk2(acc[0] * wk, acc[1] * wk), pk2(acc[2] * wk, acc[3] * wk)}; } }
    __syncthreads();
    { f32x4 acc[8], accn = (f32x4){0.f, 0.f, 0.f, 0.f};
#pragma unroll
      for (int j = 0; j < 8; ++j) acc[j] = (f32x4){0.f, 0.f, 0.f, 0.f};
      const bf16x8 ones = (bf16x8){0x3f80, 0x3f80, 0x3f80, 0x3f80, 0x3f80, 0x3f80, 0x3f80, 0x3f80};
#pragma unroll
      for (int ks = 0; ks < 4; ++ks) { const bf16x8 vf = colfrag(Vt, ks, wave, fr, g);
#pragma unroll
          for (int j = 0; j < 8; ++j) { const bf16x8 kf = colfrag(cA, ks, j, fr, g); acc[j] = __builtin_amdgcn_mfma_f32_16x16x32_bf16(kf, vf, acc[j], 0, 0, 0);
              if (j == wave) accn = __builtin_amdgcn_mfma_f32_16x16x32_bf16(kf, ones, accn, 0, 0, 0); } }
      if ((c & 7) == 0) {
#pragma unroll
          for (int j = 0; j < 8; ++j) mg.G[j] = acc[j];
          mg.Gn = accn; mg.M = mloc; mg.B = blast;
      } else { const float mnew = fmaxf(blast + mg.M, mloc), a = fexp_(blast + mg.M - mnew), cc = fexp_(mloc - mnew);
#pragma unroll
          for (int j = 0; j < 8; ++j) mg.G[j] = mg.G[j] * a + acc[j] * cc;
          mg.Gn = mg.Gn * a + accn * cc; mg.M = mnew; mg.B += blast; }
      if ((c & 7) == 7) { const int gi = bh * 8 + (c >> 3);
          bf16* gg = (bf16*)(ws + WS_GAGG) + ((size_t)gi * 128 + m0 + fr) * 128;
#pragma unroll
          for (int j = 0; j < 8; ++j) *(v2u*)(gg + 16 * j + 4 * g) = (v2u){pk2(mg.G[j][0], mg.G[j][1]), pk2(mg.G[j][2], mg.G[j][3])};
          if (fr == 0) *(f32x4*)((float*)(ws + WS_GN) + (size_t)gi * 128 + 16 * wave + 4 * g) = mg.Gn;
          if (wave == 0 && lane == 0) { ((float*)(ws + WS_GSC))[2 * gi] = mg.B; ((float*)(ws + WS_GSC))[2 * gi + 1] = mg.M; } } }
    __syncthreads();
}

__device__ __forceinline__ void p3_scan_combine(const Args& A, int tid) {
    unsigned char* ws = A.ws;
    const int G = gridDim.x, NGT = G * NTHR;
    const bf16* OA = (const bf16*)((const unsigned char*)A.out + DO_OATT); const float* LSE = (const float*)(ws + WS_LSE);
    for (size_t id = (size_t)blockIdx.x * NTHR + tid; id < (size_t)T * 64; id += NGT) {
        const size_t t = id >> 6; const int h = (int)(id & 63) >> 3, ch = (int)(id & 7) * 8;
        const float l0 = LSE[t * 8 + h], l1 = LSE[((size_t)T + t) * 8 + h], l2 = LSE[((size_t)2 * T + t) * 8 + h];
        const float mx = fmaxf(l0, fmaxf(l1, l2)); float w0 = exp2f(l0 - mx), w1 = exp2f(l1 - mx), w2 = exp2f(l2 - mx);
        const float rs = 1.0f / (w0 + w1 + w2); w0 *= rs; w1 *= rs; w2 *= rs;
        const v4u a = *(const v4u*)(OA + t * 512 + h * 64 + ch), b = *(const v4u*)(OA + ((size_t)T + t) * 512 + h * 64 + ch), c = *(const v4u*)(OA + ((size_t)2 * T + t) * 512 + h * 64 + ch);
        v4u o;
        o.x = pk2(w0 * bflo(a.x) + w1 * bflo(b.x) + w2 * bflo(c.x), w0 * bfhi(a.x) + w1 * bfhi(b.x) + w2 * bfhi(c.x));
        o.y = pk2(w0 * bflo(a.y) + w1 * bflo(b.y) + w2 * bflo(c.y), w0 * bfhi(a.y) + w1 * bfhi(b.y) + w2 * bfhi(c.y));
        o.z = pk2(w0 * bflo(a.z) + w1 * bflo(b.z) + w2 * bflo(c.z), w0 * bfhi(a.z) + w1 * bfhi(b.z) + w2 * bfhi(c.z));
        o.w = pk2(w0 * bflo(a.w) + w1 * bflo(b.w) + w2 * bflo(c.w), w0 * bfhi(a.w) + w1 * bfhi(b.w) + w2 * bfhi(c.w));
        *(v4u*)((bf16*)(ws + WS_Y) + t * 1024 + h * 64 + ch) = o;
    }
}

struct MState { f32x4 C[8]; float n0, n1, m; };
__device__ __forceinline__ void mlstm2_entry(const Args& A, int bh, int grp, MState& st, int lane, int wave) {
    unsigned char* ws = A.ws; const int fr = lane & 15, g = lane >> 4, m0 = 16 * wave;
#pragma unroll
    for (int j = 0; j < 8; ++j) st.C[j] = (f32x4){0.f, 0.f, 0.f, 0.f};
    st.n0 = 0.f; st.n1 = 0.f; st.m = 0.f;
    for (int gp = 0; gp < grp; ++gp) { const int gi = bh * 8 + gp; const float B = ((const float*)(ws + WS_GSC))[2 * gi], M = ((const float*)(ws + WS_GSC))[2 * gi + 1];
        const float mnew = fmaxf(B + st.m, M), a = fexp_(B + st.m - mnew), cc = fexp_(M - mnew);
        const bf16* gg = (const bf16*)(ws + WS_GAGG) + ((size_t)gi * 128 + m0 + fr) * 128;
#pragma unroll
        for (int j = 0; j < 8; ++j) { const v2u w = *(const v2u*)(gg + 16 * j + 4 * g); st.C[j] = st.C[j] * a + (f32x4){bflo(w.x), bfhi(w.x), bflo(w.y), bfhi(w.y)} * cc; }
        const float* gn = (const float*)(ws + WS_GN) + (size_t)gi * 128 + 2 * lane;
        st.n0 = st.n0 * a + gn[0] * cc; st.n1 = st.n1 * a + gn[1] * cc; st.m = mnew; }
}
__device__ __forceinline__ void mlstm_p2_item(const Args& A, unsigned char* lds_, int item, MState& st, int tid, int lane, int wave) {
    asm volatile("" : "+v"(tid), "+v"(lane));
    unsigned char* ws = A.ws; LAS unsigned char* lds = (LAS unsigned char*)lds_;
    const float* g_mhn = (const float*)(ws + WS_PAR) + PAR_GMHN; const float* skip_m = (const float*)(ws + WS_PAR) + PAR_SKIP;
    const int bh = item >> 6, c = item & 63, b = bh >> 2, h = bh & 3;
    const size_t t0 = (size_t)b * SEQ + 128 * c;
    LAS unsigned char* T0 = lds; LAS unsigned char* T1 = lds + ML_TILE; LAS unsigned char* T2 = lds + 2 * ML_TILE; LAS unsigned char* T3 = lds + 3 * ML_TILE;
    LAS float* gl = (LAS float*)(lds + ML_G);
    const int fr = lane & 15, g = lane >> 4, m0 = 16 * wave, l = m0 + fr;
    { const bf16* Wg = (const bf16*)(ws + WS_WM) + (size_t)h * 128 * 128; tile_load(T1, Wg, 128, tid); tile_load(T2, Wg + 4 * 128 * 128, 128, tid); }
    tile_load(T3, (const bf16*)(ws + WS_MV) + t0 * 512 + h * 128, 512, tid);
    ml_conv_tile(T0, (const bf16*)(ws + WS_MU) + h * 128, (const float*)(ws + WS_PAR) + PAR_CONVW, (const float*)(ws + WS_PAR) + PAR_CONVB, b, c, h, tid);
    float blast, mloc;
    { const size_t gi = (size_t)bh * SEQ + 128 * c + 2 * lane; const float mprev = st.m;
      const float i0 = ((const float*)(ws + WS_IG))[gi], i1 = ((const float*)(ws + WS_IG))[gi + 1];
      const float f0 = log_sigmoidf_(((const float*)(ws + WS_FG))[gi]), f1 = log_sigmoidf_(((const float*)(ws + WS_FG))[gi + 1]);
      float b0, b1; blast = wscan_sum(f0, f1, b0, b1, lane);
      const float g0 = blast - b0 + i0, g1 = blast - b1 + i1; mloc = wave_max(fmaxf(g0, g1));
      gl[640 + 2 * lane] = fexp_(g0 - mloc); gl[640 + 2 * lane + 1] = fexp_(g1 - mloc);
      const float a0 = i0 - b0, a1 = i1 - b1; float p0, p1; wscan_max(a0, a1, p0, p1, lane);
      const float mt0 = fmaxf(b0 + mprev, b0 + p0), mt1 = fmaxf(b1 + mprev, b1 + p1);
      gl[2 * lane] = a0; gl[2 * lane + 1] = a1; gl[128 + 2 * lane] = b0 - mt0; gl[128 + 2 * lane + 1] = b1 - mt1;
      gl[256 + 2 * lane] = fexp_(b0 + mprev - mt0); gl[256 + 2 * lane + 1] = fexp_(b1 + mprev - mt1); gl[384 + 2 * lane] = fexp_(-mt0); gl[384 + 2 * lane + 1] = fexp_(-mt1);
      gl[512 + 2 * lane] = st.n0; gl[512 + 2 * lane + 1] = st.n1; }
    __syncthreads();
    v2u cp[8], qp[8], kp[8];
    { bf16x8 af[4];
#pragma unroll
      for (int ks = 0; ks < 4; ++ks) af[ks] = rowfrag(T0, m0, ks, fr, g);
#pragma unroll
      for (int j = 0; j < 8; ++j) cp[j] = *(const LAS v2u*)(T0 + sw_off(l, 2 * j + (g >> 1)) + 8 * (g & 1));
#pragma unroll
      for (int j = 0; j < 8; ++j) { f32x4 acc = (f32x4){0.f, 0.f, 0.f, 0.f};
#pragma unroll
          for (int ks = 0; ks < 4; ++ks) acc = __builtin_amdgcn_mfma_f32_16x16x32_bf16(rowfrag(T1, 16 * j, ks, fr, g), af[ks], acc, 0, 0, 0);
          qp[j] = (v2u){pk2(acc[0], acc[1]), pk2(acc[2], acc[3])}; }
#pragma unroll
      for (int j = 0; j < 8; ++j) { f32x4 acc = (f32x4){0.f, 0.f, 0.f, 0.f};
#pragma unroll
          for (int ks = 0; ks < 4; ++ks) acc = __builtin_amdgcn_mfma_f32_16x16x32_bf16(rowfrag(T2, 16 * j, ks, fr, g), af[ks], acc, 0, 0, 0);
          kp[j] = (v2u){pk2(acc[0], acc[1]), pk2(acc[2], acc[3])}; } }
    __syncthreads();
#pragma unroll
    for (int j = 0; j < 8; ++j) { const int off = sw_off(l, 2 * j + (g >> 1)) + 8 * (g & 1);
        *(LAS v2u*)(T1 + off) = qp[j]; *(LAS v2u*)(T0 + off) = kp[j]; *(LAS v2u*)(T2 + off) = (v2u){pk2(st.C[j][0], st.C[j][1]), pk2(st.C[j][2], st.C[j][3])}; }
    __syncthreads();
    bf16x8 qf[4];
#pragma unroll
    for (int ks = 0; ks < 4; ++ks) qf[ks] = rowfrag(T1, m0, ks, fr, g);
    float qn = 0.f;
    { const LAS float* np = gl + 512;
#pragma unroll
      for (int ks = 0; ks < 4; ++ks) { const f32x4 n0 = *(const LAS f32x4*)(np + 32 * ks + 8 * g), n1 = *(const LAS f32x4*)(np + 32 * ks + 8 * g + 4); const v4u w = __builtin_bit_cast(v4u, qf[ks]);
          qn += bflo(w.x) * n0[0] + bfhi(w.x) * n0[1] + bflo(w.y) * n0[2] + bfhi(w.y) * n0[3] + bflo(w.z) * n1[0] + bfhi(w.z) * n1[1] + bflo(w.w) * n1[2] + bfhi(w.w) * n1[3]; }
      qn += __shfl_xor(qn, 16); qn += __shfl_xor(qn, 32); }
    float den = 0.f;
    { const float rc = gl[128 + l];
#pragma unroll
      for (int j = 0; j < 8; ++j) { f32x4 acc = (f32x4){0.f, 0.f, 0.f, 0.f};
          if (j <= wave) {
#pragma unroll
              for (int ks = 0; ks < 4; ++ks) acc = __builtin_amdgcn_mfma_f32_16x16x32_bf16(rowfrag(T0, 16 * j, ks, fr, g), qf[ks], acc, 0, 0, 0);
#pragma unroll
              for (int e = 0; e < 4; ++e) { const int sx = 16 * j + 4 * g + e; acc[e] = (sx <= l) ? acc[e] * fexp_(rc + gl[sx]) : 0.f; den += acc[e]; } }
          *(LAS v2u*)(T1 + sw_off(l, 2 * j + (g >> 1)) + 8 * (g & 1)) = (v2u){pk2(acc[0], acc[1]), pk2(acc[2], acc[3])}; }
      den += __shfl_xor(den, 16); den += __shfl_xor(den, 32); }
    f32x4 acc[8];
    const float iw = gl[256 + l];
#pragma unroll
    for (int j = 0; j < 8; ++j) { acc[j] = (f32x4){0.f, 0.f, 0.f, 0.f};
#pragma unroll
        for (int ks = 0; ks < 4; ++ks) acc[j] = __builtin_amdgcn_mfma_f32_16x16x32_bf16(rowfrag(T2, 16 * j, ks, fr, g), qf[ks], acc[j], 0, 0, 0);
        acc[j] = acc[j] * iw; }
    asm volatile("s_waitcnt lgkmcnt(0)" ::: "memory");
#pragma unroll
    for (int ks = 0; ks < 4; ++ks) if (2 * ks <= wave) { const bf16x8 sf = rowfrag(T1, m0, ks, fr, g);
#pragma unroll
        for (int j = 0; j < 8; ++j) acc[j] = __builtin_amdgcn_mfma_f32_16x16x32_bf16(colfrag(T3, ks, j, fr, g), sf, acc[j], 0, 0, 0); }
    den += iw * qn;
    const float rden = frcp_(fmaxf(fabsf(den), gl[384 + l]));
    float sq = 0.f;
#pragma unroll
    for (int j = 0; j < 8; ++j) { acc[j] = acc[j] * rden; sq += (acc[j][0] * acc[j][0] + acc[j][1] * acc[j][1]) + (acc[j][2] * acc[j][2] + acc[j][3] * acc[j][3]); }
    sq += __shfl_xor(sq, 16); sq += __shfl_xor(sq, 32);
    const float rn = __builtin_amdgcn_rsqf(sq * (1.0f / 128.0f) + EPSN);
    const bf16* MOg = (const bf16*)(ws + WS_MO) + (t0 + l) * 512 + h * 128;
    bf16* yg = (bf16*)(ws + WS_Y) + (t0 + l) * 1024 + 512 + h * 128;
#pragma unroll
    for (int j = 0; j < 8; ++j) { const int e0 = 16 * j + 4 * g;
        const v2u mo = *(const v2u*)(MOg + e0), cc = cp[j];
        const f32x4 gm = *(const f32x4*)(g_mhn + h * 128 + e0), sk = *(const f32x4*)(skip_m + h * 128 + e0);
        const float y0 = sigmoidf_(bflo(mo.x)) * (acc[j][0] * rn * gm[0] + sk[0] * bflo(cc.x));
        const float y1 = sigmoidf_(bfhi(mo.x)) * (acc[j][1] * rn * gm[1] + sk[1] * bfhi(cc.x));
        const float y2 = sigmoidf_(bflo(mo.y)) * (acc[j][2] * rn * gm[2] + sk[2] * bflo(cc.y));
        const float y3 = sigmoidf_(bfhi(mo.y)) * (acc[j][3] * rn * gm[3] + sk[3] * bfhi(cc.y));
        *(v2u*)(yg + e0) = (v2u){pk2(y0, y1), pk2(y2, y3)}; }
    { f32x4 accn = (f32x4){0.f, 0.f, 0.f, 0.f};
#pragma unroll
      for (int j = 0; j < 8; ++j) acc[j] = (f32x4){0.f, 0.f, 0.f, 0.f};
#pragma unroll
      for (int ks = 0; ks < 4; ++ks) { const f32x4 w0 = *(const LAS f32x4*)(gl + 640 + 32 * ks + 8 * g), w1 = *(const LAS f32x4*)(gl + 640 + 32 * ks + 8 * g + 4);
          const v4u vr = __builtin_bit_cast(v4u, colfrag(T3, ks, wave, fr, g));
          const v4u vs = (v4u){pk2(bflo(vr.x) * w0[0], bfhi(vr.x) * w0[1]), pk2(bflo(vr.y) * w0[2], bfhi(vr.y) * w0[3]), pk2(bflo(vr.z) * w1[0], bfhi(vr.z) * w1[1]), pk2(bflo(vr.w) * w1[2], bfhi(vr.w) * w1[3])};
          const v4u wv = (v4u){pk2(w0[0], w0[1]), pk2(w0[2], w0[3]), pk2(w1[0], w1[1]), pk2(w1[2], w1[3])};
          const bf16x8 vf = __builtin_bit_cast(bf16x8, vs), wf = __builtin_bit_cast(bf16x8, wv);
#pragma unroll
          for (int j = 0; j < 8; ++j) { const bf16x8 kf = colfrag(T0, ks, j, fr, g); acc[j] = __builtin_amdgcn_mfma_f32_16x16x32_bf16(kf, vf, acc[j], 0, 0, 0);
              if (j == wave) accn = __builtin_amdgcn_mfma_f32_16x16x32_bf16(kf, wf, accn, 0, 0, 0); } }
      const float mnew = fmaxf(blast + st.m, mloc), a = fexp_(blast + st.m - mnew), cc = fexp_(mloc - mnew);
#pragma unroll
      for (int j = 0; j < 8; ++j) st.C[j] = st.C[j] * a + acc[j] * cc;
      if (fr == 0) *(LAS f32x4*)(gl + 768 + 16 * wave + 4 * g) = accn;
      __syncthreads();
      st.n0 = st.n0 * a + gl[768 + 2 * lane] * cc; st.n1 = st.n1 * a + gl[768 + 2 * lane + 1] * cc; st.m = mnew; }
}

struct EpiOutProj {
    static constexpr bool PERM = true, AFTER_DRAIN = false;
    const float* x; bf16* x1b; float* ss;
    __device__ __forceinline__ void operator()(const f32x4 (&acc)[2][2][4][2], const pg8::Unit& u, int wr, int wc, int fr, int fq) const {
        const int row0 = u.pm * 256 + wr * 64 + fr, col0 = u.pn * 256 + wc * 32 + 8 * fq;
#pragma unroll
        for (int ai = 0; ai < 2; ++ai)
#pragma unroll
            for (int m = 0; m < 4; ++m) { const int row = row0 + ai * 128 + m * 16; float sq = 0.f;
#pragma unroll
                for (int bj = 0; bj < 2; ++bj) { const size_t off = (size_t)row * D + col0 + bj * 128;
                    const f32x4 o0 = *(const f32x4*)(x + off) + acc[ai][bj][m][0], o1 = *(const f32x4*)(x + off + 4) + acc[ai][bj][m][1];
                    *(v4u*)(x1b + off) = pack8(o0, o1);
                    sq += ((o0[0] * o0[0] + o0[1] * o0[1]) + (o0[2] * o0[2] + o0[3] * o0[3])) + ((o1[0] * o1[0] + o1[1] * o1[1]) + (o1[2] * o1[2] + o1[3] * o1[3])); }
                sq += __shfl_xor(sq, 16); sq += __shfl_xor(sq, 32);
                if (fq == 0) ss[(size_t)row * 16 + u.pn * 4 + wc] = sq; }
    }
};
struct FixedOrder {
    int pm, n;
    __device__ __forceinline__ bool next(int i, pg8::Unit& u) const { if (i >= n) return false; u.pm = pm; u.pn = i; u.aux = 0; return true; }
    __device__ __forceinline__ void a_ready(const pg8::Unit&) const {}
    __device__ __forceinline__ void done(const pg8::Unit&) const {}
};
struct EpiQx {
    static constexpr bool PERM = true, AFTER_DRAIN = false;
    bf16* qx; const LAS float* rs;
    __device__ __forceinline__ void operator()(const f32x4 (&acc)[2][2][4][2], const pg8::Unit& u, int wr, int wc, int fr, int fq) const {
        const int rl0 = wr * 64 + fr, col0 = wc * 32 + 8 * fq;
#pragma unroll
        for (int ai = 0; ai < 2; ++ai)
#pragma unroll
            for (int m = 0; m < 4; ++m) { const int rl = rl0 + ai * 128 + m * 16; const float sc = rs[rl]; bf16* rowp = qx + (size_t)(u.pm * 256 + rl) * 256 + col0;
#pragma unroll
                for (int bj = 0; bj < 2; ++bj) *(v4u*)(rowp + bj * 128) = pack8(acc[ai][bj][m][0] * sc, acc[ai][bj][m][1] * sc);
                asm volatile("" ::: "memory"); }
    }
};
struct EpiOx {
    static constexpr bool PERM = true, AFTER_DRAIN = false;
    const bf16* x1b; bf16* x2b;
    __device__ __forceinline__ void operator()(const f32x4 (&acc)[2][2][4][2], const pg8::Unit& u, int wr, int wc, int fr, int fq) const {
        const int row0 = u.pm * 256 + wr * 64 + fr, col0 = u.pn * 256 + wc * 32 + 8 * fq;
#pragma unroll
        for (int ai = 0; ai < 2; ++ai)
#pragma unroll
            for (int m = 0; m < 4; ++m) {
#pragma unroll
                for (int bj = 0; bj < 2; ++bj) { const size_t off = (size_t)(row0 + ai * 128 + m * 16) * D + col0 + bj * 128; const v4u r = *(const v4u*)(x1b + off);
                    f32x4 o0 = acc[ai][bj][m][0], o1 = acc[ai][bj][m][1];
                    o0[0] += bflo(r.x); o0[1] += bfhi(r.x); o0[2] += bflo(r.y); o0[3] += bfhi(r.y); o1[0] += bflo(r.z); o1[1] += bfhi(r.z); o1[2] += bflo(r.w); o1[3] += bfhi(r.w);
                    *(v4u*)(x2b + off) = pack8(o0, o1); }
                asm volatile("" ::: "memory"); }
    }
};
__device__ __forceinline__ void cross_dma(const bf16* KV, int h, LAS unsigned char* buf, int lane, int wave) {
#pragma unroll
    for (int i = 0; i < 4; ++i) { const int inst = wave + 8 * i, row = 8 * inst + (lane >> 3);
        const bf16* src = KV + (size_t)row * NKV + h * 64 + ((lane & 7) ^ (lane >> 3)) * 8;
        glds16(src, (unsigned)__builtin_amdgcn_readfirstlane(lds_addr_of(buf + inst * 1024)));
        glds16(src + 256, (unsigned)__builtin_amdgcn_readfirstlane(lds_addr_of(buf + 32768 + inst * 1024))); }
}
__device__ __forceinline__ void cross_unit(const Args& A, unsigned char* lds, int pm, int tid, int lane, int wave) {
    asm volatile("" : "+v"(tid), "+v"(lane));
    unsigned char* ws = A.ws; LAS unsigned char* L = (LAS unsigned char*)lds;
    const size_t t0 = (size_t)pm * 256; const int b = (int)(t0 / SEQ);
    const bf16* KV = (const bf16*)(ws + WS_KVX) + (size_t)b * MEMLEN * NKV;
    const int fr = lane & 15, g = lane >> 4;
    cross_dma(KV, 0, L, lane, wave);
    for (int h = 0; h < 4; ++h) {
        asm volatile("s_waitcnt vmcnt(0)" ::: "memory");
        __syncthreads();
        LAS unsigned char* buf = L + (h & 1) * 65536;
        if (h < 3) cross_dma(KV, h + 1, L + ((h + 1) & 1) * 65536, lane, wave);
#pragma unroll 1
        for (int rt = 0; rt < 2; ++rt) {
            const size_t row = t0 + 32 * wave + 16 * rt + fr;
            const bf16* qg = (const bf16*)(ws + WS_QX) + row * 256 + h * 64;
            const bf16x8 q0 = *(const bf16x8*)(qg + 8 * g), q1 = *(const bf16x8*)(qg + 32 + 8 * g);
            f32x4 s[16];
#pragma unroll
            for (int t = 0; t < 16; ++t) { const int key = 16 * t + fr;
                s[t] = __builtin_amdgcn_mfma_f32_16x16x32_bf16(*(const LAS bf16x8*)(buf + key * 128 + (((g) ^ (key & 7)) * 16)), q0, (f32x4){0.f, 0.f, 0.f, 0.f}, 0, 0, 0);
                s[t] = __builtin_amdgcn_mfma_f32_16x16x32_bf16(*(const LAS bf16x8*)(buf + key * 128 + (((4 + g) ^ (key & 7)) * 16)), q1, s[t], 0, 0, 0); }
            float mx = -1e30f;
#pragma unroll
            for (int t = 0; t < 16; ++t) mx = fmaxf(fmaxf(mx, fmaxf(s[t][0], s[t][1])), fmaxf(s[t][2], s[t][3]));
            mx = fmaxf(mx, __shfl_xor(mx, 16)); mx = fmaxf(mx, __shfl_xor(mx, 32));
            float l = 0.f;
#pragma unroll
            for (int t = 0; t < 16; ++t)
#pragma unroll
                for (int e = 0; e < 4; ++e) { s[t][e] = __builtin_amdgcn_exp2f(s[t][e] - mx); l += s[t][e]; }
            l += __shfl_xor(l, 16); l += __shfl_xor(l, 32);
            f32x4 o[4];
#pragma unroll
            for (int dt = 0; dt < 4; ++dt) o[dt] = (f32x4){0.f, 0.f, 0.f, 0.f};
#pragma unroll
            for (int k8 = 0; k8 < 8; ++k8) {
                const v4u pw = (v4u){pk2(s[2 * k8][0], s[2 * k8][1]), pk2(s[2 * k8][2], s[2 * k8][3]), pk2(s[2 * k8 + 1][0], s[2 * k8 + 1][1]), pk2(s[2 * k8 + 1][2], s[2 * k8 + 1][3])};
                const bf16x8 pf = __builtin_bit_cast(bf16x8, pw);
                const int r0 = 32 * k8 + 4 * g + (fr >> 2), r1 = r0 + 16, p_ = fr & 3;
#pragma unroll
                for (int dt = 0; dt < 4; ++dt) { const int chunk = 2 * dt + (p_ >> 1);
                    const v4i16_t v0 = __builtin_amdgcn_ds_read_tr16_b64_v4i16((LAS v4i16_t*)(buf + 32768 + r0 * 128 + ((chunk ^ (r0 & 7)) * 16) + 8 * (p_ & 1)));
                    const v4i16_t v1 = __builtin_amdgcn_ds_read_tr16_b64_v4i16((LAS v4i16_t*)(buf + 32768 + r1 * 128 + ((chunk ^ (r1 & 7)) * 16) + 8 * (p_ & 1)));
                    const bf16x8 vf = (bf16x8){v0[0], v0[1], v0[2], v0[3], v1[0], v1[1], v1[2], v1[3]};
                    o[dt] = __builtin_amdgcn_mfma_f32_16x16x32_bf16(vf, pf, o[dt], 0, 0, 0); } }
            const float rl = frcp_(l);
            bf16* og = (bf16*)(ws + WS_OX) + row * 256 + h * 64;
#pragma unroll
            for (int dt = 0; dt < 4; ++dt) *(v2u*)(og + 16 * dt + 4 * g) = (v2u){pk2(o[dt][0] * rl, o[dt][1] * rl), pk2(o[dt][2] * rl, o[dt][3] * rl)};
        }
    }
    asm volatile("s_waitcnt vmcnt(0)" ::: "memory");
    __syncthreads();
}

struct TokInfo { int bucket; float wa, wb; int rank; };
constexpr size_t WS_RSTD3 = 18 * MiB;
constexpr size_t WS_CNTTAB = 31 * MiB + 512 * 1024;
__device__ __forceinline__ void p9_route(const Args& A, unsigned char* lds, int tid, int lane, int wave) {
    unsigned char* ws = A.ws;
    const float* b_rg = (const float*)(ws + WS_PAR) + PAR_BRG; const float* b_re = (const float*)(ws + WS_PAR) + PAR_BRE;
    LAS float* WRl = (LAS float*)lds;
    LAS int* bkl = (LAS int*)(lds + 81920);
    for (int i = tid; i < 20 * 1024 / 4; i += NTHR) ((LAS f32x4*)WRl)[i] = ((const f32x4*)(ws + WS_WR))[i];
    __syncthreads();
    const bf16* X2B = (const bf16*)(ws + WS_HBS);
    for (int chunk = blockIdx.x; chunk < T / 256; chunk += gridDim.x) {
        for (int r = 0; r < 32; ++r) {
            const int m = chunk * 256 + wave * 32 + r;
            const v4u* xr = (const v4u*)(X2B + (size_t)m * D) + lane;
            f32x4 v[4]; float s = 0.f;
#pragma unroll
            for (int j = 0; j < 2; ++j) { const v4u r = xr[64 * j]; v[2 * j] = (f32x4){bflo(r.x), bfhi(r.x), bflo(r.y), bfhi(r.y)}; v[2 * j + 1] = (f32x4){bflo(r.z), bfhi(r.z), bflo(r.w), bfhi(r.w)}; }
#pragma unroll
            for (int j = 0; j < 4; ++j) s += (v[j].x * v[j].x + v[j].y * v[j].y) + (v[j].z * v[j].z + v[j].w * v[j].w);
            const float rstd = 1.0f / sqrtf(wave_sum(s) * (1.0f / D) + EPSN);
            float gl4[4];
#pragma unroll
            for (int e = 0; e < 4; ++e) { float a = 0.f;
#pragma unroll
                for (int j = 0; j < 4; ++j) { const f32x4 w = *(const LAS f32x4*)(WRl + e * 1024 + 512 * (j >> 1) + 8 * lane + 4 * (j & 1)); a += (v[j].x * w.x + v[j].y * w.y) + (v[j].z * w.z + v[j].w * w.w); }
                gl4[e] = wave_sum(a) * rstd + b_rg[e]; }
            int g = 0; float gm = gl4[0];
#pragma unroll
            for (int i = 1; i < 4; ++i) if (gl4[i] > gm) { gm = gl4[i]; g = i; }
            g = __builtin_amdgcn_readfirstlane(g);
            float gs = 0.f;
#pragma unroll
            for (int i = 0; i < 4; ++i) gs += __expf(gl4[i] - gm);
            const float gw_ = 1.0f / gs;
            float el[4];
            const LAS float* WRe = WRl + (4 + 4 * g) * 1024;
#pragma unroll
            for (int e = 0; e < 4; ++e) { float a = 0.f;
#pragma unroll
                for (int j = 0; j < 4; ++j) { const f32x4 w = *(const LAS f32x4*)(WRe + e * 1024 + 512 * (j >> 1) + 8 * lane + 4 * (j & 1)); a += (v[j].x * w.x + v[j].y * w.y) + (v[j].z * w.z + v[j].w * w.w); }
                el[e] = wave_sum(a) * rstd + b_re[g * 4 + e]; }
            int i0 = 0; float v0 = el[0];
#pragma unroll
            for (int i = 1; i < 4; ++i) if (el[i] > v0) { v0 = el[i]; i0 = i; }
            int i1 = -1; float v1 = -INFINITY;
#pragma unroll
            for (int i = 0; i < 4; ++i) if (i != i0 && el[i] > v1) { v1 = el[i]; i1 = i; }
            const float e1 = __expf(v1 - v0); const float w0 = gw_ / (1.0f + e1), w1 = gw_ * e1 / (1.0f + e1);
            const int pa = i0 < i1 ? i0 : i1, pb = i0 < i1 ? i1 : i0;
            const int pidx = (pa == 0) ? (pb - 1) : (pa == 1 ? pb + 1 : 5);
            const int bucket = g * 6 + pidx;
            if (lane == 0) { ((float*)(ws + WS_RSTD3))[m] = rstd; bkl[wave * 32 + r] = bucket; ((LAS float*)(bkl + 256))[wave * 32 + r] = (i0 < i1) ? w0 : w1; ((LAS float*)(bkl + 512))[wave * 32 + r] = (i0 < i1) ? w1 : w0; }
        }
        __syncthreads();
        if (tid < 256) { const int my = bkl[tid]; int rank = 0; for (int j = 0; j < tid; ++j) rank += (bkl[j] == my) ? 1 : 0;
            TokInfo ti; ti.bucket = my; ti.wa = ((LAS float*)(bkl + 256))[tid]; ti.wb = ((LAS float*)(bkl + 512))[tid]; ti.rank = rank;
            ((TokInfo*)(ws + WS_TOKINFO))[chunk * 256 + tid] = ti; }
        else if (tid < 256 + NBUCKET) { const int b = tid - 256; int c = 0; for (int j = 0; j < 256; ++j) c += (bkl[j] == b) ? 1 : 0;
            ((int*)(ws + WS_CNTTAB))[chunk * NBUCKET + b] = c; }
        __syncthreads();
    }
}
__device__ __forceinline__ void p10_slots(const Args& A, unsigned char* lds, int tid, int lane, int wave) {
    unsigned char* ws = A.ws;
    LAS int* tabl = (LAS int*)lds;
    LAS int* totl = (LAS int*)(lds + 32768);
    const int* CNTTAB = (const int*)(ws + WS_CNTTAB);
    for (int i = tid; i < 256 * NBUCKET; i += NTHR) tabl[i] = CNTTAB[i];
    __syncthreads();
    if (tid < NBUCKET) { int t = 0; for (int w = 0; w < 256; ++w) t += tabl[w * NBUCKET + tid]; totl[tid] = t; }
    __syncthreads();
    if (tid == 0) { int acc = 0; for (int b = 0; b < NBUCKET; ++b) { totl[32 + b] = acc; acc += ((totl[b] + 255) >> 8) * 256; } totl[32 + NBUCKET] = acc; }
    if (blockIdx.x == 0 && tid < NBUCKET) ((unsigned*)(ws + WS_CTL))[CW_CNT + tid] = (unsigned)totl[tid];
    __syncthreads();
    int* TOKMAP = (int*)(ws + WS_TOKMAP); float* WSORT = (float*)(ws + WS_WSORT);
    for (int chunk = blockIdx.x; chunk < T / 256; chunk += gridDim.x) {
        if (tid < NBUCKET) { int s = 0; for (int w = 0; w < chunk; ++w) s += tabl[w * NBUCKET + tid]; totl[64 + tid] = totl[32 + tid] + s; }
        __syncthreads();
        if (tid < 256) { const int m = chunk * 256 + tid; const TokInfo ti = ((const TokInfo*)(ws + WS_TOKINFO))[m]; const int slot = totl[64 + ti.bucket] + ti.rank;
            TOKMAP[slot] = m; *(f32x4*)(WSORT + 4 * slot) = (f32x4){ti.wa, ti.wb, ((const float*)(ws + WS_RSTD3))[m], 0.f}; }
        __syncthreads();
    }
    for (int b = blockIdx.x; b < NBUCKET; b += gridDim.x)
        for (int r = totl[32 + b] + totl[b] + tid; r < totl[32 + b + 1]; r += NTHR) { TOKMAP[r] = -1; *(f32x4*)(WSORT + 4 * r) = (f32x4){0.f, 0.f, 0.f, 0.f}; }
}
struct MoeOrder {
    int G, c, nunits, ncol; const int* tab;
    __device__ __forceinline__ bool next(int i, pg8::Unit& u) const {
        const long L = (long)i * G + c; if (L >= nunits) return false;
        const int rt = (int)L / ncol, j = (int)L % ncol, bk = tab[rt];
        u.pm = rt; u.aux = j;
        if (ncol == 8) { const int g = bk / 6, p = bk % 6; const int pa = (p < 3) ? 0 : (p < 5 ? 1 : 2), pb = (p < 3) ? p + 1 : (p < 5 ? p - 1 : 3);
            const int e = 4 * g + ((j >> 2) ? pb : pa); u.pn = e * 4 + (j & 3); }
        else u.pn = bk * 4 + j;
        return true;
    }
    __device__ __forceinline__ void a_ready(const pg8::Unit&) const {}
    __device__ __forceinline__ void done(const pg8::Unit&) const {}
};
struct EpiUp {
    static constexpr bool PERM = true, AFTER_DRAIN = false;
    bf16* act; const float* wsort;
    __device__ __forceinline__ void operator()(const f32x4 (&acc)[2][2][4][2], const pg8::Unit& u, int wr, int wc, int fr, int fq) const {
        const int row0 = u.pm * 256 + wr * 64 + fr, half = u.aux >> 2, col0 = half * 512 + (u.aux & 3) * 128 + wc * 32 + 8 * fq;
#pragma unroll
        for (int ai = 0; ai < 2; ++ai)
#pragma unroll
            for (int m = 0; m < 4; ++m) { const int row = row0 + ai * 128 + m * 16; const float w = wsort[4 * row + half], rs = wsort[4 * row + 2];
                f32x4 r0, r1;
#pragma unroll
                for (int i = 0; i < 4; ++i) { const float a0 = acc[ai][0][m][0][i] * rs, a1 = acc[ai][0][m][1][i] * rs;
                    r0[i] = a0 * sigmoidf_(a0) * (acc[ai][1][m][0][i] * rs) * w; r1[i] = a1 * sigmoidf_(a1) * (acc[ai][1][m][1][i] * rs) * w; }
                *(v4u*)(act + (size_t)row * D + col0) = pack8(r0, r1); }
    }
};
struct EpiDown {
    static constexpr bool PERM = true, AFTER_DRAIN = false;
    const bf16* x2b; float* xo; const int* tokmap;
    __device__ __forceinline__ void operator()(const f32x4 (&acc)[2][2][4][2], const pg8::Unit& u, int wr, int wc, int fr, int fq) const {
        const int row0 = u.pm * 256 + wr * 64 + fr, col0 = u.aux * 256 + wc * 32 + 8 * fq;
#pragma unroll
        for (int ai = 0; ai < 2; ++ai)
#pragma unroll
            for (int m = 0; m < 4; ++m) { const int tok = tokmap[row0 + ai * 128 + m * 16];
                if (tok >= 0) {
#pragma unroll
                    for (int bj = 0; bj < 2; ++bj) { const size_t off = (size_t)tok * D + col0 + bj * 128; const v4u r = *(const v4u*)(x2b + off);
                        f32x4 o0 = acc[ai][bj][m][0], o1 = acc[ai][bj][m][1];
                        o0[0] += bflo(r.x); o0[1] += bfhi(r.x); o0[2] += bflo(r.y); o0[3] += bfhi(r.y); o1[0] += bflo(r.z); o1[1] += bfhi(r.z); o1[2] += bflo(r.w); o1[3] += bfhi(r.w);
                        *(f32x4*)(xo + off) = o0; *(f32x4*)(xo + off + 4) = o1; } } }
    }
};
constexpr size_t WS_XCH = 20 * MiB + 512 * 1024;
constexpr int CW_SEAM = 16384;
constexpr int LDS_EX = 139264;
struct EpiDownNorm {
    static constexpr bool PERM = true, AFTER_DRAIN = false;
    const bf16* x2b; float* out; const int* tokmap; const float* gfin; float* xch; unsigned* cnt; LAS unsigned char* ex;
    __device__ __forceinline__ void operator()(const f32x4 (&acc_)[2][2][4][2], const pg8::Unit& u, int wr, int wc, int fr, int fq) const {
        f32x4 (&acc)[2][2][4][2] = const_cast<f32x4 (&)[2][2][4][2]>(acc_);
        int tid = threadIdx.x; asm volatile("" : "+v"(tid));
        const int lane = tid & 63, wid = __builtin_amdgcn_readfirstlane(tid >> 6);
        int rb = wr * 64 + fr; asm volatile("" : "+v"(rb));
        LAS float* P = (LAS float*)ex; LAS float* S = (LAS float*)(ex + 4096); LAS unsigned* flag = (LAS unsigned*)(ex + 6144);
        const int col0 = u.aux * 256 + wc * 32 + 8 * fq;
#pragma unroll
        for (int ai = 0; ai < 2; ++ai)
#pragma unroll
            for (int m = 0; m < 4; ++m) { const int rl = rb + ai * 128 + m * 16; const int tok = tokmap[u.pm * 256 + rl]; float sq = 0.f;
#pragma unroll
                for (int bj = 0; bj < 2; ++bj) { f32x4& o0 = acc[ai][bj][m][0]; f32x4& o1 = acc[ai][bj][m][1];
                    if (tok >= 0) { const v4u r = *(const v4u*)(x2b + (size_t)tok * D + col0 + bj * 128);
                        o0[0] += bflo(r.x); o0[1] += bfhi(r.x); o0[2] += bflo(r.y); o0[3] += bfhi(r.y); o1[0] += bflo(r.z); o1[1] += bfhi(r.z); o1[2] += bflo(r.w); o1[3] += bfhi(r.w); }
                    sq += ((o0[0] * o0[0] + o0[1] * o0[1]) + (o0[2] * o0[2] + o0[3] * o0[3])) + ((o1[0] * o1[0] + o1[1] * o1[1]) + (o1[2] * o1[2] + o1[3] * o1[3])); }
                sq += __shfl_xor(sq, 16); sq += __shfl_xor(sq, 32);
                if (fq == 0) P[rl * 4 + wc] = sq;
                asm volatile("" ::: "memory"); }
        asm volatile("s_waitcnt lgkmcnt(0)" ::: "memory"); __builtin_amdgcn_s_barrier(); asm volatile("" ::: "memory");
        if (tid < 256) { const f32x4 p = *(const LAS f32x4*)(P + tid * 4);
            __hip_atomic_store(xch + ((size_t)u.pm * 256 + tid) * 4 + u.aux, (p[0] + p[1]) + (p[2] + p[3]), __ATOMIC_RELAXED, __HIP_MEMORY_SCOPE_AGENT); }
        asm volatile("s_waitcnt vmcnt(0)" ::: "memory");
        if (wid < 4 && lane == 0) __hip_atomic_fetch_add(cnt + 64 * u.pm, 1u, __ATOMIC_RELAXED, __HIP_MEMORY_SCOPE_AGENT);
        if (wid == 0) { unsigned spins = 0;
            while ((unsigned)__builtin_amdgcn_readfirstlane(__hip_atomic_load(cnt + 64 * u.pm, __ATOMIC_RELAXED, __HIP_MEMORY_SCOPE_AGENT)) < 16u) { __builtin_amdgcn_s_sleep(2); if (++spins > (1u << 22)) break; }
            __builtin_amdgcn_fence(__ATOMIC_ACQUIRE, "agent");
            if (lane == 0) flag[0] = spins; }
        asm volatile("s_waitcnt vmcnt(0) lgkmcnt(0)" ::: "memory"); __builtin_amdgcn_s_barrier(); asm volatile("" ::: "memory");
        if (tid < 256) { const float* sl = xch + ((size_t)u.pm * 256 + tid) * 4; float t = 0.f;
#pragma unroll
            for (int k = 0; k < 4; ++k) t += __hip_atomic_load(sl + k, __ATOMIC_RELAXED, __HIP_MEMORY_SCOPE_AGENT);
            S[tid] = 1.0f / sqrtf(t * (1.0f / D) + EPSN); }
        asm volatile("s_waitcnt lgkmcnt(0)" ::: "memory"); __builtin_amdgcn_s_barrier(); asm volatile("" ::: "memory");
#pragma unroll
        for (int ai = 0; ai < 2; ++ai)
#pragma unroll
            for (int m = 0; m < 4; ++m) { const int rl = rb + ai * 128 + m * 16; const int tok = tokmap[u.pm * 256 + rl]; const float rs = S[rl];
                if (tok >= 0) {
#pragma unroll
                    for (int bj = 0; bj < 2; ++bj)
#pragma unroll
                        for (int n = 0; n < 2; ++n) { const int cc = col0 + bj * 128 + 4 * n; acc[ai][bj][m][n] = acc[ai][bj][m][n] * rs; acc[ai][bj][m][n] = acc[ai][bj][m][n] * *(const f32x4*)(gfin + cc);
                            *(f32x4*)(out + (size_t)tok * D + cc) = acc[ai][bj][m][n]; asm volatile("" ::: "memory"); } } }
    }
};
__device__ __forceinline__ void p10_final(const Args& A, float* outp, int lane, int wave) {
    const float* g_final = (const float*)(A.ws + WS_PAR) + PAR_GFIN;
    const int G = gridDim.x, gw = blockIdx.x * NWAVES + wave, NGW = G * NWAVES;
    f32x4 gv[4];
#pragma unroll
    for (int j = 0; j < 4; ++j) gv[j] = *((const f32x4*)g_final + lane + 64 * j);
    for (int m = gw; m < T; m += NGW) {
        f32x4* xr = (f32x4*)(A.out + (size_t)m * D) + lane;
        f32x4 v[4]; float s = 0.f;
#pragma unroll
        for (int j = 0; j < 4; ++j) { v[j] = xr[64 * j]; s += (v[j].x * v[j].x + v[j].y * v[j].y) + (v[j].z * v[j].z + v[j].w * v[j].w); }
        const float rstd = 1.0f / sqrtf(wave_sum(s) * (1.0f / D) + EPSN);
#pragma unroll
        for (int j = 0; j < 4; ++j) ((f32x4*)(outp + (size_t)m * D) + lane)[64 * j] = v[j] * rstd * gv[j];
    }
}

#ifndef MS
#define MS 4
#endif
#ifndef N_LAUNCHES
#define N_LAUNCHES 1
#endif
constexpr int N_PHASES = 14;
#ifndef FUSE_FINAL
#define FUSE_FINAL 1
#endif
#ifndef DUP_MASK
#define DUP_MASK 0
#endif
#define REP(k) for (int rep_ = 0; rep_ < (((DUP_MASK >> (k)) & 1) ? 2 : 1); ++rep_)
#ifndef QX_SP2
#define QX_SP2 false
#endif

#ifndef NVG
#define NVG 256
#endif
__global__ void __launch_bounds__(NTHR, 2) __attribute__((amdgpu_num_vgpr(NVG))) fwd_kernel(Args args) {
    __shared__ __attribute__((aligned(16))) unsigned char lds[LDS_BYTES];
    const int tid = threadIdx.x, lane = tid & 63, wave = __builtin_amdgcn_readfirstlane(tid >> 6);
    gu32* ctl = (gu32*)(args.ws + WS_CTL);
    for (int u = tid; u < (LDS_BYTES - LDS_MISC) / 4; u += NTHR) ((unsigned*)(lds + LDS_MISC))[u] = 0u;
    __syncthreads();
    const int lo = args.ph_lo, hi = args.ph_hi;
    const bool use_bar = (hi - lo) > 1;
    XcdBarrier bar; bar.bar = (unsigned*)ctl + CW_BAR; bar.x = 0; bar.st = (volatile LAS unsigned*)(lds + LDS_MISC) + 8;
    if (use_bar) bar = xcd_barrier_post((unsigned*)ctl + CW_BAR, (volatile LAS unsigned*)(lds + LDS_MISC) + 8);
#ifndef PH_MASK
#define PH_MASK 0xFFFF
#endif
#define IN(k) (((PH_MASK >> (k)) & 1) && lo <= (k) && (k) < hi)
#define SEAM(k) do { if (IN(k) && IN((k) + 1)) xcd_barrier(bar); } while (0)
    PG8_LAS unsigned char* ring = (PG8_LAS unsigned char*)lds;
    const int G = gridDim.x;
#define PHASE_PTRS Args pa = args; { unsigned char* w_ = args.ws; float* o_ = args.out; asm volatile("" : "+s"(w_), "+s"(o_)); pa.ws = w_; pa.out = o_; } unsigned char* const ws = pa.ws; (void)ws; int tid = (int)threadIdx.x; asm volatile("" : "+v"(tid)); const int lane = tid & 63; (void)lane

#ifdef DUMMY_LIVE
    float dl0, dl1, dl2, dl3, dl4, dl5, dl6, dl7; asm volatile("" : "=v"(dl0), "=v"(dl1), "=v"(dl2), "=v"(dl3), "=v"(dl4), "=v"(dl5), "=v"(dl6), "=v"(dl7));
#endif
    if (IN(0)) { PHASE_PTRS; REP(0) { p0_prologue(pa, lds, tid, lane, wave); __syncthreads(); } }
    SEAM(0);
    if (IN(1) && MS >= 1) { PHASE_PTRS;
        pg8::Gemm g{(const pg8::bf16_t*)(ws + WS_XN), (const pg8::bf16_t*)(ws + WS_WIN), T, NIN, D};
        pg8::StaticOrder S; S.init(T, NIN, G, (int)blockIdx.x);
        EpiInProj E{(bf16*)(ws + WS_Q), (const float*)(ws + WS_ROPE)};
        REP(1) pg8::gemm_phase<EpiInProj, pg8::StaticOrder, true, true>(ring, g, S, E);
    }
    SEAM(1);
    if (IN(2) && MS >= 1) { PHASE_PTRS;
        const int n_att = (MS >= 2) ? 3 * 4096 : 0;
        for (int tile = blockIdx.x; tile < 256; tile += G) kv_tile(pa, lds, tile, tid, lane, wave);
        __syncthreads();
        REP(14) attn_phase(pa, lds, n_att, lane, wave);
        { int wres = -1; MGroup mg; __syncthreads(); for (int it = blockIdx.x * 8; it < 2048; it += G * 8) for (int q = 0; q < 8; ++q) mlstm_p1_item(pa, lds, it + q, wres, mg, tid, lane, wave); }
    }
    if (IN(2) && IN(4)) xcd_barrier(bar);
    if (IN(4) && MS >= 1) { PHASE_PTRS;
        p3_scan_combine(pa, tid);
        for (int it = blockIdx.x * 8; it < 2048; it += G * 8) { MState st; mlstm2_entry(pa, it >> 6, (it & 63) >> 3, st, lane, wave);
            for (int q = 0; q < 8; ++q) mlstm_p2_item(pa, lds, it + q, st, tid, lane, wave); }
    }
    SEAM(4);
    if (IN(5)) { PHASE_PTRS;
        if (MS >= 1) {
            pg8::Gemm g{(const pg8::bf16_t*)(ws + WS_Y), (const pg8::bf16_t*)(ws + WS_WOUT), T, D, D};
            pg8::StaticOrder S; S.init(T, D, G, (int)blockIdx.x);
            EpiOutProj E{(const float*)pa.in[0], (bf16*)(ws + WS_X1B), (float*)(ws + WS_SS1)};
            REP(5) pg8::gemm_phase<EpiOutProj, pg8::StaticOrder, true, true>(ring, g, S, E);
        } else {
            const int gw = blockIdx.x * NWAVES + wave, NGW = G * NWAVES;
            for (int m = gw; m < T; m += NGW) { const f32x4* xr = (const f32x4*)((const float*)pa.in[0] + (size_t)m * D) + lane; unsigned long long* o8 = (unsigned long long*)(ws + WS_X1B + (size_t)m * D * 2) + lane;
#pragma unroll
                for (int j = 0; j < 4; ++j) { const f32x4 v = xr[64 * j]; o8[64 * j] = (unsigned long long)pk2(v.x, v.y) | ((unsigned long long)pk2(v.z, v.w) << 32); } }
        }
    }
    SEAM(5);
    if (IN(6) && MS >= 3) { PHASE_PTRS;
        pg8::StaticOrder S0; S0.init(T, 256, G, (int)blockIdx.x);
        float* rs = (float*)(lds + LDS_RS);
        pg8::Unit u0;
        if (S0.next(0, u0)) {
            if (tid < 256) { const f32x4* sp = (const f32x4*)((const float*)(ws + WS_SS1) + (size_t)(u0.pm * 256 + tid) * 16);
                const f32x4 a = sp[0], b = sp[1], c = sp[2], d = sp[3];
                const float s = ((a[0] + a[1]) + (a[2] + a[3])) + ((b[0] + b[1]) + (b[2] + b[3])) + ((c[0] + c[1]) + (c[2] + c[3])) + ((d[0] + d[1]) + (d[2] + d[3]));
                rs[tid] = 1.0f / sqrtf(s * (1.0f / D) + EPSN); }
            __syncthreads();
            { pg8::Gemm g{(const pg8::bf16_t*)(ws + WS_X1B), (const pg8::bf16_t*)(ws + WS_WQX), T, 256, D};
              FixedOrder S{u0.pm, 1}; EpiQx E{(bf16*)(ws + WS_QX), (const LAS float*)rs};
              pg8::gemm_phase<EpiQx, FixedOrder, true, QX_SP2>(ring, g, S, E); }
            VM_WAIT(); __syncthreads();
            cross_unit(pa, lds, u0.pm, tid, lane, wave);
            { int kdyn = 256; asm volatile("" : "+s"(kdyn));
              pg8::Gemm g{(const pg8::bf16_t*)(ws + WS_OX), (const pg8::bf16_t*)(ws + WS_WOX), T, D, kdyn};
              FixedOrder S{u0.pm, 4}; EpiOx E{(const bf16*)(ws + WS_X1B), (bf16*)(ws + WS_HBS)};
              pg8::gemm_phase<EpiOx, FixedOrder, false, false>(ring, g, S, E); }
            __syncthreads();
        }
    }
    SEAM(8);
    if (IN(9) && MS >= 4) { PHASE_PTRS; p9_route(pa, lds, tid, lane, wave); }
    SEAM(9);
    if (IN(10) && MS >= 4) { PHASE_PTRS; p10_slots(pa, lds, tid, lane, wave); }
    SEAM(10);
    if ((IN(11) || IN(12)) && MS >= 4) { PHASE_PTRS;
        int* tab = (int*)(lds + LDS_TAB);
        if (tid == 0) { int nrt = 0; const unsigned* cnt = (const unsigned*)(ws + WS_CTL) + CW_CNT;
            for (int i = 0; i < NBUCKET; ++i) { const int nt = (int)((__hip_atomic_load(cnt + i, __ATOMIC_RELAXED, __HIP_MEMORY_SCOPE_AGENT) + 255u) >> 8); for (int k = 0; k < nt; ++k) tab[1 + nrt++] = i; }
            tab[0] = nrt; }
        __syncthreads();
        const int nrt = tab[0];
        if (IN(11)) {
            pg8::Gemm g{(const pg8::bf16_t*)(ws + WS_HBS), (const pg8::bf16_t*)(ws + WS_W13), ROWS_MAX, 64 * 256, D, (const int*)(ws + WS_TOKMAP)};
            MoeOrder S{G, (int)blockIdx.x, nrt * 8, 8, tab + 1};
            EpiUp E{(bf16*)(ws + WS_ACT), (const float*)(ws + WS_WSORT)};
            REP(11) pg8::gemm_phase<EpiUp, MoeOrder, true, true, true>(ring, g, S, E);
        }
        SEAM(11);
        if (IN(12)) {
            pg8::Gemm g{(const pg8::bf16_t*)(ws + WS_ACT), (const pg8::bf16_t*)(ws + WS_W2P), ROWS_MAX, 96 * 256, D};
            MoeOrder S{G, (int)blockIdx.x, nrt * 4, 4, tab + 1};
#if FUSE_FINAL
            EpiDownNorm E{(const bf16*)(ws + WS_HBS), pa.out, (const int*)(ws + WS_TOKMAP), (const float*)(ws + WS_PAR) + PAR_GFIN, (float*)(ws + WS_XCH), (unsigned*)(ws + WS_CTL) + CW_SEAM, (LAS unsigned char*)(lds + LDS_EX)};
            pg8::gemm_phase<EpiDownNorm, MoeOrder, true, true>(ring, g, S, E);
#else
            EpiDown E{(const bf16*)(ws + WS_HBS), pa.out, (const int*)(ws + WS_TOKMAP)};
            REP(12) pg8::gemm_phase<EpiDown, MoeOrder, true, true>(ring, g, S, E);
#endif
        }
    }
    if (!FUSE_FINAL) SEAM(12);
    if (IN(13) && !FUSE_FINAL) { PHASE_PTRS; REP(13) p10_final(pa, (((DUP_MASK >> 13) & 1) && rep_ == 0) ? (float*)(ws + 544 * MiB) : pa.out, lane, wave); }
#ifdef DUMMY_LIVE
    asm volatile("" :: "v"(dl0), "v"(dl1), "v"(dl2), "v"(dl3), "v"(dl4), "v"(dl5), "v"(dl6), "v"(dl7));
#endif
#undef IN
#undef SEAM
}

extern "C" void kernel_launch(void* const* d_in, const int* in_sizes, int n_in, void* d_out, int out_size, void* d_ws, size_t ws_size, hipStream_t stream) {
    static int grid = 0;
    if (grid == 0) {
        if (n_in != 28 || out_size != T * D || ws_size < WS_END) { fprintf(stderr, "kernel_launch: unexpected problem (n_in %d, out %d, ws %zu)\n", n_in, out_size, ws_size); grid = -1; return; }
        int dev = 0, cus = 0, per_cu = 0;
        if (hipGetDevice(&dev) != hipSuccess || hipDeviceGetAttribute(&cus, hipDeviceAttributeMultiprocessorCount, dev) != hipSuccess) { grid = -1; return; }
        if (hipOccupancyMaxActiveBlocksPerMultiprocessor(&per_cu, (const void*)fwd_kernel, NTHR, 0) != hipSuccess || per_cu < 1) { fprintf(stderr, "kernel_launch: occupancy query failed (%d)\n", per_cu); per_cu = 1; }
        (void)hipGetLastError();
        grid = cus * (per_cu > 1 ? 1 : per_cu);
        if (grid > 256) grid = 256;
    }
    if (grid < 0) return;
    (void)hipMemsetAsync((char*)d_ws + WS_CTL, 0, CTL_ZERO_BYTES, stream);
    Args a{};
    for (int i = 0; i < 28; ++i) a.in[i] = d_in[i];
    a.out = (float*)d_out; a.ws = (unsigned char*)d_ws;
    if (N_LAUNCHES == 1) {
        a.ph_lo = 0; a.ph_hi = N_PHASES;
        void* kargs[] = {&a};
        hipError_t e = hipLaunchCooperativeKernel((const void*)fwd_kernel, dim3(grid), dim3(NTHR), kargs, 0, stream);
        if (e != hipSuccess) fprintf(stderr, "kernel_launch: cooperative launch failed: %s (grid %d)\n", hipGetErrorString(e), grid);
    } else {
        for (int p = 0; p < N_PHASES; ++p) { a.ph_lo = p; a.ph_hi = p + 1; hipLaunchKernelGGL(fwd_kernel, dim3(grid), dim3(NTHR), 0, stream, a); }
    }
}
```

```cpp
#include <hip/hip_runtime.h>
#include <cstdio>
#include <cstdint>
namespace pg8 {
#define PG8_LAS __attribute__((address_space(3)))
typedef unsigned short bf16_t;
typedef short bf16x8 __attribute__((ext_vector_type(8)));
typedef float f32x4 __attribute__((ext_vector_type(4)));
typedef unsigned u32x4 __attribute__((ext_vector_type(4)));
constexpr int BM = 256, BK = 64, HALF = 128, HTB = HALF * BK * 2  , STAGE_BYTES = 8 * HTB, NXCD = 8, WGM = 8;

__host__ __device__ __forceinline__ int lds_byte(int r, int c) { const int st = (r >> 4) * 2 + (c >> 5), rr = r & 15, cc = c & 31, ob = rr * 64 + cc * 2; return st * 1024 + (ob ^ (((ob >> 9) & 1) << 5)); }
__host__ __device__ __forceinline__ void stage_rc(int b, int& R, int& C) { const int st = b / 1024, sb = b % 1024, swz = sb ^ (((sb >> 9) & 1) << 5); R = (st >> 1) * 16 + swz / 64; C = (st & 1) * 32 + (swz % 64) / 2; }
__host__ __device__ __forceinline__ int perm32(int rho) { const int n = rho >> 4, i = rho & 15; return 8 * (i >> 2) + 4 * n + (i & 3); }

struct Unit { int pm, pn, aux; };
struct Gemm { const bf16_t* A; const bf16_t* Bt; int M, N, K; const int* rowmap; };

struct StaticOrder {
    int nM, nN, nwg, G, c;
    __host__ __device__ __forceinline__ void init(int M, int N, int G_, int c_) { nM = M / BM; nN = N / BM; nwg = nM * nN; G = G_; c = c_; }
    __host__ __device__ __forceinline__ bool next(int i, Unit& u) const {
        const long L = (long)i * G + c; if (L >= nwg) return false;
        int wgid = (int)L; { const int q = nwg / NXCD, r = nwg % NXCD, xcd = wgid % NXCD, off = wgid / NXCD; wgid = (xcd < r ? xcd * (q + 1) : r * (q + 1) + (xcd - r) * q) + off; }
        const int nig = WGM * nN, gid = wgid / nig, fm = gid * WGM, gsz = (nM - fm) < WGM ? (nM - fm) : WGM;
        u.pm = fm + ((wgid % nig) % gsz); u.pn = (wgid % nig) / gsz; u.aux = 0; return true;
    }
    __device__ __forceinline__ void a_ready(const Unit&) const {}
    __device__ __forceinline__ void done(const Unit&) const {}
};

__device__ __forceinline__ unsigned cvt_pk_bf16(float lo, float hi) { unsigned r; asm volatile("v_cvt_pk_bf16_f32 %0, %1, %2" : "=v"(r) : "v"(lo), "v"(hi)); return r; }
template <class Epi, class Sched, bool ALIGN_EPI = false, bool SP2 = false, bool GATHER = false>
__device__ __forceinline__ void gemm_phase(PG8_LAS unsigned char* lds, const Gemm g, const Sched& S, const Epi& E) {
    int tid = threadIdx.x; asm volatile("" : "+v"(tid));
    const int wid = __builtin_amdgcn_readfirstlane(tid >> 6), lane = tid & 63, wr = wid >> 2, wc = wid & 3, fr = lane & 15, fq = lane >> 4;
    const int K = g.K, nt = K / BK;
    unsigned voffA[2], voffB[2];
#pragma unroll
    for (int i = 0; i < 2; ++i) { int R, C; stage_rc(tid * 16 + i * 8192, R, C); const int Rb = Epi::PERM ? ((R & ~31) + perm32(R & 31)) : R;
        voffA[i] = (unsigned)(R * K + C) * 2u; voffB[i] = (unsigned)(Rb * K + C) * 2u; }
    unsigned gc[2][2] = {{0u, 0u}, {0u, 0u}}, gn[2][2] = {{0u, 0u}, {0u, 0u}};
#define PG8_GLOAD(gv, pm_) do { _Pragma("unroll") for (int _h = 0; _h < 2; ++_h) _Pragma("unroll") for (int _i = 0; _i < 2; ++_i) { int _R, _C; stage_rc(tid * 16 + _i * 8192, _R, _C); \
        int _row = g.rowmap[(pm_) * BM + _h * HALF + _R]; _row = _row < 0 ? 0 : _row; gv[_h][_i] = (unsigned)(_row * K + _C) * 2u; } } while (0)
    const size_t kstep = (size_t)(BK * 2);
    const size_t hstep = (size_t)HALF * K * 2;
    const size_t tstep = 2 * hstep;
    const unsigned ldsw = (unsigned)wid * 1024u;
    const int aoff = lds_byte(wr * 64 + fr, fq * 8), boff = lds_byte(wc * 32 + fr, fq * 8);
#define PG8_SA(b, h) (((b) * 2 + (h)) * HTB)
#define PG8_SB(b, h) ((4 + (b) * 2 + (h)) * HTB)
#define PG8_STAGE(bufoff, gbase, voff) do { _Pragma("unroll") for (int _i = 0; _i < 2; ++_i) \
        __builtin_amdgcn_global_load_lds((const unsigned*)((const char*)(gbase) + (voff)[_i]), (PG8_LAS unsigned*)(lds + (bufoff) + ldsw + _i * 8192), 16, 0, 0); } while (0)
#define PG8_STAGE_A(bufoff, gbase, h, sel) do { if constexpr (GATHER) { unsigned vo_[2]; vo_[0] = (sel) ? gn[h][0] : gc[h][0]; vo_[1] = (sel) ? gn[h][1] : gc[h][1]; PG8_STAGE(bufoff, gbase, vo_); } \
        else { PG8_STAGE(bufoff, (gbase) + (h) * hstep, voffA); } } while (0)
#define PG8_LDA(dst, b, h) do { _Pragma("unroll") for (int m = 0; m < 4; ++m) _Pragma("unroll") for (int k = 0; k < 2; ++k) dst[m][k] = *(const PG8_LAS bf16x8*)(lds + PG8_SA(b, h) + aoff + m * 2048 + k * 1024); } while (0)
#define PG8_LDB(dst, b, h) do { _Pragma("unroll") for (int n = 0; n < 2; ++n) _Pragma("unroll") for (int k = 0; k < 2; ++k) dst[n][k] = *(const PG8_LAS bf16x8*)(lds + PG8_SB(b, h) + boff + n * 2048 + k * 1024); } while (0)
#define PG8_MMA(ai, bj, At, Bt) do { __builtin_amdgcn_s_setprio(1); _Pragma("unroll") for (int m = 0; m < 4; ++m) _Pragma("unroll") for (int n = 0; n < 2; ++n) _Pragma("unroll") for (int k = 0; k < 2; ++k) \
        acc[ai][bj][m][n] = __builtin_amdgcn_mfma_f32_16x16x32_bf16(Bt[n][k], At[m][k], acc[ai][bj][m][n], 0, 0, 0); __builtin_amdgcn_s_setprio(0); } while (0)
#define PG8_WAIT_V(n) asm volatile("s_waitcnt vmcnt(" #n ")" ::: "memory")
#define PG8_WAIT_L(n) asm volatile("s_waitcnt lgkmcnt(" #n ")" ::: "memory")
#define PG8_BAR __builtin_amdgcn_s_barrier()
#define PG8_SCHED __builtin_amdgcn_sched_barrier(0)
    Unit cur, nxt; int ui = 0;
    if (!S.next(0, cur)) return;
    f32x4 acc[2][2][4][2];
#pragma unroll
    for (int a = 0; a < 2; ++a)
#pragma unroll
        for (int b = 0; b < 2; ++b)
#pragma unroll
            for (int m = 0; m < 4; ++m)
#pragma unroll
                for (int n = 0; n < 2; ++n) acc[a][b][m][n] = (f32x4){0.f, 0.f, 0.f, 0.f};
    bf16x8 At[4][2], B0[2][2], B1[2][2];
    const char* cA = GATHER ? (const char*)g.A : (const char*)g.A + (size_t)cur.pm * tstep; const char* cB = (const char*)g.Bt + (size_t)cur.pn * tstep;
    if constexpr (GATHER) { PG8_GLOAD(gc, cur.pm); }
    S.a_ready(cur);
    if constexpr (SP2) {
        PG8_STAGE(PG8_SB(0, 0), cB, voffB); PG8_STAGE(PG8_SB(0, 1), cB + hstep, voffB); PG8_STAGE_A(PG8_SA(0, 0), cA, 0, false); PG8_STAGE_A(PG8_SA(0, 1), cA, 1, false);
        if (wr == 1) PG8_BAR;
        PG8_WAIT_V(2); PG8_BAR;
        PG8_STAGE(PG8_SB(1, 0), cB + kstep, voffB); PG8_STAGE_A(PG8_SA(1, 0), cA + kstep, 0, false); PG8_STAGE(PG8_SB(1, 1), cB + hstep + kstep, voffB);
        PG8_WAIT_V(6); PG8_BAR;
    } else {
        PG8_STAGE(PG8_SB(0, 0), cB, voffB); PG8_STAGE_A(PG8_SA(0, 0), cA, 0, false); PG8_STAGE(PG8_SB(0, 1), cB + hstep, voffB); PG8_STAGE_A(PG8_SA(0, 1), cA, 1, false);
        if (wr == 1) PG8_BAR;
        PG8_WAIT_V(4); PG8_BAR;
        PG8_STAGE(PG8_SB(1, 0), cB + kstep, voffB); PG8_STAGE_A(PG8_SA(1, 0), cA + kstep, 0, false); PG8_STAGE(PG8_SB(1, 1), cB + hstep + kstep, voffB);
        PG8_WAIT_V(6); PG8_BAR;
    }
    for (;;) {
        const bool has_next = S.next(ui + 1, nxt);
        const char* nA = GATHER ? cA : (has_next ? (const char*)g.A + (size_t)nxt.pm * tstep : cA);
        if constexpr (GATHER) { if (has_next) { PG8_GLOAD(gn, nxt.pm); } else { gn[0][0] = gc[0][0]; gn[0][1] = gc[0][1]; gn[1][0] = gc[1][0]; gn[1][1] = gc[1][1]; } }
        const char* nB = has_next ? (const char*)g.Bt + (size_t)nxt.pn * tstep : cB;
        for (int t = 0; t < nt; t += 2) {
            const bool last = (t == nt - 2);
            const char* a1 = cA + (size_t)(t + 1) * kstep;
            const char* a2 = last ? nA : cA + (size_t)(t + 2) * kstep; const char* b2 = last ? nB : cB + (size_t)(t + 2) * kstep;
            const char* a3 = a2 + kstep; const char* b3 = b2 + kstep;
            if (last && has_next) S.a_ready(nxt);
            if constexpr (SP2) {
            PG8_LDB(B0, 0, 0); PG8_LDB(B1, 0, 1); PG8_SCHED; PG8_LDA(At, 0, 0); PG8_STAGE_A(PG8_SA(1, 1), a1, 1, false);
            PG8_WAIT_V(8); PG8_WAIT_L(0); PG8_BAR; PG8_MMA(0, 0, At, B0); PG8_MMA(0, 1, At, B1); PG8_BAR; PG8_SCHED;
            PG8_LDA(At, 0, 1); PG8_STAGE(PG8_SB(0, 0), b2, voffB); PG8_STAGE(PG8_SB(0, 1), b2 + hstep, voffB); PG8_STAGE_A(PG8_SA(0, 0), a2, 0, last);
            PG8_WAIT_V(8); PG8_WAIT_L(0); PG8_BAR; PG8_MMA(1, 0, At, B0); PG8_MMA(1, 1, At, B1); PG8_BAR; PG8_SCHED;
            PG8_LDB(B0, 1, 0); PG8_LDB(B1, 1, 1); PG8_SCHED; PG8_LDA(At, 1, 0); PG8_STAGE_A(PG8_SA(0, 1), a2, 1, last);
            PG8_WAIT_V(8); PG8_WAIT_L(0); PG8_BAR; PG8_MMA(0, 0, At, B0); PG8_MMA(0, 1, At, B1); PG8_BAR; PG8_SCHED;
            PG8_LDA(At, 1, 1); PG8_STAGE(PG8_SB(1, 0), b3, voffB); PG8_STAGE(PG8_SB(1, 1), b3 + hstep, voffB); PG8_STAGE_A(PG8_SA(1, 0), a3, 0, last);
            PG8_WAIT_V(8); PG8_WAIT_L(0); PG8_BAR; PG8_MMA(1, 0, At, B0); PG8_MMA(1, 1, At, B1); PG8_BAR; PG8_SCHED;
            } else {
            PG8_LDB(B0, 0, 0); PG8_SCHED; PG8_LDA(At, 0, 0); PG8_STAGE_A(PG8_SA(1, 1), a1, 1, false);
            PG8_WAIT_L(8); PG8_BAR; PG8_WAIT_L(0); PG8_MMA(0, 0, At, B0); PG8_BAR; PG8_SCHED;
            PG8_LDB(B1, 0, 1); PG8_STAGE(PG8_SB(0, 0), b2, voffB);
            PG8_BAR; PG8_WAIT_L(0); PG8_MMA(0, 1, At, B1); PG8_BAR;
            PG8_LDA(At, 0, 1); PG8_STAGE_A(PG8_SA(0, 0), a2, 0, last);
            PG8_BAR; PG8_WAIT_L(0); PG8_MMA(1, 0, At, B0); PG8_BAR; PG8_SCHED;
            PG8_STAGE(PG8_SB(0, 1), b2 + hstep, voffB);
            PG8_WAIT_V(6); PG8_BAR; PG8_MMA(1, 1, At, B1); PG8_BAR;
            PG8_LDB(B0, 1, 0); PG8_SCHED; PG8_LDA(At, 1, 0); PG8_STAGE_A(PG8_SA(0, 1), a2, 1, last);
            PG8_WAIT_L(8); PG8_BAR; PG8_WAIT_L(0); PG8_MMA(0, 0, At, B0); PG8_BAR; PG8_SCHED;
            PG8_LDB(B1, 1, 1); PG8_STAGE(PG8_SB(1, 0), b3, voffB);
            PG8_BAR; PG8_WAIT_L(0); PG8_MMA(0, 1, At, B1); PG8_BAR;
            PG8_LDA(At, 1, 1); PG8_STAGE_A(PG8_SA(1, 0), a3, 0, last);
            PG8_BAR; PG8_WAIT_L(0); PG8_MMA(1, 0, At, B0); PG8_BAR; PG8_SCHED;
            PG8_STAGE(PG8_SB(1, 1), b3 + hstep, voffB);
            PG8_WAIT_V(6); PG8_BAR; PG8_MMA(1, 1, At, B1); PG8_BAR;
            }
        }
        if constexpr (ALIGN_EPI) { if (wr == 0) PG8_BAR; }
        if constexpr (!Epi::AFTER_DRAIN) { E(acc, cur, wr, wc, fr, fq); S.done(cur); }
        if (!has_next) break;
#pragma unroll
        for (int a = 0; a < 2; ++a)
#pragma unroll
            for (int b = 0; b < 2; ++b)
#pragma unroll
                for (int m = 0; m < 4; ++m)
#pragma unroll
                    for (int n = 0; n < 2; ++n) acc[a][b][m][n] = (f32x4){0.f, 0.f, 0.f, 0.f};
        cur = nxt; cA = nA; cB = nB; ++ui;
        if constexpr (GATHER) { gc[0][0] = gn[0][0]; gc[0][1] = gn[0][1]; gc[1][0] = gn[1][0]; gc[1][1] = gn[1][1]; }
        if constexpr (ALIGN_EPI) { if (wr == 1) PG8_BAR; }
    }
    PG8_WAIT_V(0);
    if constexpr (!ALIGN_EPI) { if (wr == 0) PG8_BAR; }
    PG8_BAR;
    if constexpr (Epi::AFTER_DRAIN) { E.fused(acc, cur, wr, wc, fr, fq, lds, wid, lane); S.done(cur); }
#undef PG8_SA
#undef PG8_SB
#undef PG8_STAGE
#undef PG8_STAGE_A
#undef PG8_GLOAD
#undef PG8_LDA
#undef PG8_LDB
#undef PG8_MMA
#undef PG8_WAIT_V
#undef PG8_WAIT_L
#undef PG8_BAR
#undef PG8_SCHED
}
}

#define GAS __attribute__((address_space(1)))
#define LAS __attribute__((address_space(3)))
typedef unsigned short bf16;
typedef unsigned v4u __attribute__((ext_vector_type(4)));
typedef unsigned v2u __attribute__((ext_vector_type(2)));
typedef float f32x4 __attribute__((ext_vector_type(4)));
typedef short bf16x8 __attribute__((ext_vector_type(8)));
typedef GAS unsigned gu32;

constexpr int NWAVES = 8, NTHR = 512;
constexpr int BATCH = 8, SEQ = 8192, T = BATCH * SEQ, D = 1024, MEMLEN = 256, TMEM = BATCH * MEMLEN;
constexpr int INW = 3080, NIN = 3072, NKV = 512;
constexpr int NBUCKET = 24, ROWS_MAX = T + NBUCKET * 256;
constexpr float EPSN = 1e-6f;
constexpr float C2 = 0.125f * 1.4426950408889634f;
constexpr float LOG2E = 1.4426950408889634f;

constexpr size_t MiB = 1u << 20;
constexpr size_t WS_CTL = 0, CTL_ZERO_BYTES = 1 * MiB;
constexpr size_t WS_ROPE = 2 * MiB;
constexpr size_t WS_IG = 6 * MiB;
constexpr size_t WS_FG = 7 * MiB;
constexpr size_t WS_LSE = 8 * MiB;
constexpr size_t WS_SS1 = 14 * MiB;
constexpr size_t WS_SS3 = 18 * MiB;
constexpr size_t WS_KVX = 22 * MiB;
constexpr size_t WS_NLOC = 24 * MiB;
constexpr size_t WS_NPREV = 25 * MiB;
constexpr size_t WS_MLOC = 26 * MiB;
constexpr size_t WS_BLAST = 26 * MiB + 64 * 1024;
constexpr size_t WS_MPREV = 26 * MiB + 128 * 1024;
constexpr size_t WS_TOKINFO = 27 * MiB;
constexpr size_t WS_TOKMAP = 28 * MiB;
constexpr size_t WS_WSORT = 19 * MiB;
constexpr size_t WS_WR = 30 * MiB;
constexpr size_t WS_WG = 30 * MiB + 512 * 1024;
constexpr size_t WS_PAR = 31 * MiB;
constexpr int PAR_CONVW = 0, PAR_CONVB = 2048, PAR_GMHN = 2560, PAR_SKIP = 3072, PAR_BRG = 3584, PAR_BRE = 3600, PAR_GFIN = 3616, PAR_N = 4640;
constexpr size_t WS_WIN = 32 * MiB;
constexpr size_t WS_WOUT = 39 * MiB;
constexpr size_t WS_WQX = 41 * MiB;
constexpr size_t WS_WOX = 41 * MiB + 512 * 1024;
constexpr size_t WS_WM = 42 * MiB;
constexpr size_t WS_W13 = 44 * MiB;
constexpr size_t WS_W2P = 76 * MiB;
constexpr size_t WS_XN = 128 * MiB;
constexpr size_t WS_CLOC = 128 * MiB;
constexpr size_t WS_GAGG = 192 * MiB;
constexpr size_t WS_GN = 200 * MiB;
constexpr size_t WS_GSC = 200 * MiB + 512 * 1024;
constexpr size_t WS_Q = 264 * MiB;
constexpr size_t WS_K = 328 * MiB, WS_V = 392 * MiB, WS_MU = 456 * MiB, WS_MV = 520 * MiB, WS_MO = 584 * MiB;
constexpr size_t WS_MQ = 648 * MiB, WS_MK = 712 * MiB;
constexpr size_t WS_Y = 264 * MiB;
constexpr size_t WS_CPREV = 392 * MiB;
constexpr size_t WS_X1B = 648 * MiB;
constexpr size_t WS_QX = 776 * MiB;
constexpr size_t WS_OX = 808 * MiB;
constexpr size_t WS_HBS = 264 * MiB;
constexpr size_t WS_ACT = 404 * MiB;
constexpr size_t WS_END = 840 * MiB;
constexpr size_t DO_OATT = 0, DO_C = 192 * MiB;

constexpr int CW_BAR = 4096;
constexpr int CW_CNT = 8192;
constexpr int CW_FILL = 8192 + 64;

constexpr int LDS_BYTES = 163840;
constexpr int LDS_MISC = 159744;
constexpr int LDS_RS = 135168;
constexpr int LDS_TAB = 136192;

#define LDS_WAIT() asm volatile("s_waitcnt lgkmcnt(0)" ::: "memory")
#define VM_WAIT() asm volatile("s_waitcnt vmcnt(0)" ::: "memory")
__device__ __forceinline__ unsigned f2bf(float f) { unsigned u = __builtin_bit_cast(unsigned, f); return (u + 0x7fffu + ((u >> 16) & 1u)) >> 16; }
typedef float f32x2_t __attribute__((ext_vector_type(2))); typedef __bf16 bf16x2_t __attribute__((ext_vector_type(2)));
__device__ __forceinline__ unsigned pk2(float lo, float hi) { f32x2_t v = {lo, hi}; bf16x2_t b = __builtin_convertvector(v, bf16x2_t); return __builtin_bit_cast(unsigned, b); }
__device__ __forceinline__ float bf2f(unsigned h) { return __uint_as_float(h << 16); }
__device__ __forceinline__ float bflo(unsigned w) { return __uint_as_float(w << 16); }
__device__ __forceinline__ float bfhi(unsigned w) { return __uint_as_float(w & 0xffff0000u); }
__device__ __forceinline__ float wave_sum(float v) {
#pragma unroll
    for (int o = 1; o < 64; o <<= 1) v += __shfl_xor(v, o);
    return v;
}
__device__ __forceinline__ float wave_max(float v) {
#pragma unroll
    for (int o = 1; o < 64; o <<= 1) v = fmaxf(v, __shfl_xor(v, o));
    return v;
}
__device__ __forceinline__ float fexp_(float x) { return __builtin_amdgcn_exp2f(x * 1.4426950408889634f); }
__device__ __forceinline__ float frcp_(float x) { return __builtin_amdgcn_rcpf(x); }
__device__ __forceinline__ float sigmoidf_(float x) { return __builtin_amdgcn_rcpf(1.0f + __builtin_amdgcn_exp2f(x * -1.4426950408889634f)); }

#define XB_TMO      128
#define XB_XCNT(j)  (256  + 64 * (j))
#define XB_XSUB(j)  (1280 + 64 * (j))
#define XB_XGEN(j)  (2304 + 64 * (j))
#define XB_TOP      3328
#define XB_TOPGEN   3392
#define XCD_BAR_WORDS 3456
#define XB_SPIN_CAP (1u << 22)
__device__ __forceinline__ unsigned xb_ld(unsigned* p)              { return __hip_atomic_load(p, __ATOMIC_RELAXED, __HIP_MEMORY_SCOPE_AGENT); }
__device__ __forceinline__ unsigned xb_add(unsigned* p, unsigned v) { return __hip_atomic_fetch_add(p, v, __ATOMIC_RELAXED, __HIP_MEMORY_SCOPE_AGENT); }
__device__ __forceinline__ unsigned xb_xcc_id() { return (unsigned)__builtin_amdgcn_s_getreg((3 << 11) | 20) & 0xFu; }
#define XB_SPIN(cond, bar) do { unsigned _sp = 0; while (cond) { __builtin_amdgcn_s_sleep(1); \
    if ((++_sp & 255u) == 0u) { if (xb_ld(&(bar)[XB_TMO])) break; if (_sp > XB_SPIN_CAP) { atomicAdd(&(bar)[XB_TMO], 1u); break; } } } } while (0)
struct XcdBarrier { unsigned* bar; unsigned x; volatile LAS unsigned* st; };
__device__ __forceinline__ XcdBarrier xcd_barrier_post(unsigned* bar, volatile LAS unsigned* st) {
    XcdBarrier b; b.bar = bar; b.x = xb_xcc_id(); b.st = st;
    if (threadIdx.x == 0) (void)xb_add(&bar[XB_XCNT(b.x)], 1u);
    return b;
}
__device__ __forceinline__ void xcd_barrier_complete(unsigned* bar, unsigned x, unsigned& nloc, unsigned& nx) {
    const unsigned G = gridDim.x * gridDim.y * gridDim.z;
    unsigned sum, cnt, mine, sp = 0u;
    for (;;) {
        sum = 0u; cnt = 0u; mine = 0u;
#pragma unroll
        for (unsigned j = 0; j < 16; ++j) { const unsigned c = xb_ld(&bar[XB_XCNT(j)]); sum += c; cnt += (c > 0u) ? 1u : 0u; mine = (j == x) ? c : mine; }
        if (sum == G) break;
        __builtin_amdgcn_s_sleep(1);
        if ((++sp & 255u) == 0u) { if (xb_ld(&bar[XB_TMO])) break; if (sp > XB_SPIN_CAP) { atomicAdd(&bar[XB_TMO], 1u); break; } }
    }
    nloc = mine > 0u ? mine : 1u; nx = cnt > 0u ? cnt : 1u;
}
__device__ __forceinline__ void xcd_barrier(const XcdBarrier& b) {
    asm volatile("s_waitcnt vmcnt(0)" ::: "memory");
    __syncthreads();
    if (threadIdx.x == 0) {
        unsigned* bar = b.bar;
        __builtin_amdgcn_s_waitcnt(0);
        unsigned nloc = b.st[0], nx = b.st[1];
        if (nloc == 0u) { xcd_barrier_complete(bar, b.x, nloc, nx); b.st[0] = nloc; b.st[1] = nx; }
        const unsigned old = xb_add(&bar[XB_XSUB(b.x)], 1u);
        const unsigned gen = old / nloc;
        if (old + 1u == (gen + 1u) * nloc) {
            __builtin_amdgcn_fence(__ATOMIC_RELEASE, "agent");
            asm volatile("s_waitcnt vmcnt(0)" ::: "memory");
            const unsigned og = xb_add(&bar[XB_TOP], 1u);
            const unsigned tg = og / nx;
            if (og + 1u == (tg + 1u) * nx) xb_add(&bar[XB_TOPGEN], 1u);
            else XB_SPIN(xb_ld(&bar[XB_TOPGEN]) == tg, bar);
            __builtin_amdgcn_fence(__ATOMIC_ACQUIRE, "agent");
            xb_add(&bar[XB_XGEN(b.x)], 1u);
            asm volatile("s_waitcnt vmcnt(0)" ::: "memory");
        } else {
            XB_SPIN(xb_ld(&bar[XB_XGEN(b.x)]) == gen, bar);
            __builtin_amdgcn_fence(__ATOMIC_ACQUIRE, "agent");
            asm volatile("s_waitcnt vmcnt(0)" ::: "memory");
        }
    }
    __syncthreads();
}

struct Args { const void* in[28]; float* out; unsigned char* ws; int ph_lo, ph_hi; };

template <int MI, int NJ>
__device__ __forceinline__ void wave_mma(const bf16* A, int lda, const bf16* Bt, int ldb, int K, f32x4 (&acc)[MI][NJ], int fr, int fq) {
    for (int k0 = 0; k0 < K; k0 += 32) {
        bf16x8 a[MI], b[NJ];
#pragma unroll
        for (int i = 0; i < MI; ++i) a[i] = *(const bf16x8*)(A + (16 * i + fr) * lda + k0 + 8 * fq);
#pragma unroll
        for (int j = 0; j < NJ; ++j) b[j] = *(const bf16x8*)(Bt + (16 * j + fr) * ldb + k0 + 8 * fq);
#pragma unroll
        for (int i = 0; i < MI; ++i)
#pragma unroll
            for (int j = 0; j < NJ; ++j) acc[i][j] = __builtin_amdgcn_mfma_f32_16x16x32_bf16(b[j], a[i], acc[i][j], 0, 0, 0);
    }
}

__device__ __forceinline__ void transpose_item(const float* src, int src_ld, int k0, int n0, bf16* dst, int dst_ld, int dst_row0, int dst_col0,
                                               const float* gain, float scale, LAS float* scr, int lane) {
    f32x4 ld[16];
#pragma unroll
    for (int i = 0; i < 16; ++i) { const int kk = 4 * i + (lane >> 4); ld[i] = *(const f32x4*)(src + (size_t)(k0 + kk) * src_ld + n0 + 4 * (lane & 15)); }
#pragma unroll
    for (int i = 0; i < 16; ++i) { const int kk = 4 * i + (lane >> 4); *(LAS f32x4*)(scr + kk * 64 + 4 * ((lane & 15) ^ ((kk >> 3) & 15))) = ld[i]; }
    const int c = lane & 7;
    f32x4 g0 = (f32x4){scale, scale, scale, scale}, g1 = g0;
    if (gain) { g0 = *(const f32x4*)(gain + k0 + 8 * c) * scale; g1 = *(const f32x4*)(gain + k0 + 8 * c + 4) * scale; }
    LDS_WAIT(); asm volatile("" ::: "memory");
#pragma unroll
    for (int j = 0; j < 8; ++j) { const int n = (lane >> 3) + 8 * j; const LAS float* s = scr + (8 * c) * 64 + 4 * ((n >> 2) ^ c) + (n & 3);
        v4u o; o.x = pk2(s[0 * 64] * g0[0], s[1 * 64] * g0[1]); o.y = pk2(s[2 * 64] * g0[2], s[3 * 64] * g0[3]); o.z = pk2(s[4 * 64] * g1[0], s[5 * 64] * g1[1]); o.w = pk2(s[6 * 64] * g1[2], s[7 * 64] * g1[3]);
        *(v4u*)(dst + (size_t)(dst_row0 + n) * dst_ld + dst_col0 + 8 * c) = o; }
    LDS_WAIT(); asm volatile("" ::: "memory");
}

__device__ __forceinline__ void p0_prologue(const Args& A, unsigned char* lds, int tid, int lane, int wave) {
    unsigned char* ws = A.ws;
    const float* x = (const float*)A.in[0]; const float* mem = (const float*)A.in[1]; const int* positions = (const int*)A.in[2];
    const float* g_mix = (const float*)A.in[3]; const float* w_in = (const float*)A.in[4];
    const float* w_q_m = (const float*)A.in[7]; const float* w_k_m = (const float*)A.in[8];
    const float* b_i = (const float*)A.in[9]; const float* b_f = (const float*)A.in[10];
    const float* w_out = (const float*)A.in[13]; const float* g_cross = (const float*)A.in[14]; const float* g_mem = (const float*)A.in[15];
    const float* w_q_x = (const float*)A.in[16]; const float* w_kv_x = (const float*)A.in[17]; const float* w_o_x = (const float*)A.in[18];
    const float* g_ffn = (const float*)A.in[19]; const float* w_rg = (const float*)A.in[20]; const float* w_re = (const float*)A.in[22];
    const float* w1 = (const float*)A.in[24]; const float* w3 = (const float*)A.in[25]; const float* w2 = (const float*)A.in[26];
    const int G = gridDim.x, gw = blockIdx.x * NWAVES + wave, NGW = G * NWAVES, gt = blockIdx.x * NTHR + tid, NGT = G * NTHR;

    LAS float* WGl = (LAS float*)lds;
    for (int i = tid; i < 8 * 1024; i += NTHR) { const int k = i >> 3, j = i & 7; WGl[j * 1024 + k] = g_mix[k] * w_in[(size_t)k * INW + NIN + j]; }

    for (int i = gt; i < PAR_N; i += NGT) { float v;
        if (i < PAR_CONVB) v = ((const float*)A.in[5])[i]; else if (i < PAR_GMHN) v = ((const float*)A.in[6])[i - PAR_CONVB]; else if (i < PAR_SKIP) v = ((const float*)A.in[11])[i - PAR_GMHN];
        else if (i < PAR_BRG) v = ((const float*)A.in[12])[i - PAR_SKIP]; else if (i < PAR_BRE) v = ((const float*)A.in[21])[i - PAR_BRG]; else if (i < PAR_GFIN) v = ((const float*)A.in[23])[i - PAR_BRE];
        else v = ((const float*)A.in[27])[i - PAR_GFIN];
        ((float*)(ws + WS_PAR))[i] = v; }
    for (int i = gt; i < 32 * 1024; i += NGT) { const int e = i >> 10, k = i & 1023;
        const float w = (e < 20) ? g_ffn[k] * (e < 4 ? w_rg[k * 4 + e] : w_re[k * 16 + (e - 4)]) : 0.f;
        const unsigned hi = f2bf(w); const float lo = w - bf2f(hi);
        ((bf16*)(ws + WS_WR))[i] = (bf16)hi; ((bf16*)(ws + WS_WR))[32 * 1024 + i] = (bf16)f2bf(lo); }
    for (int i = gt; i < T * 8; i += NGT) { const int t = i >> 3, j = i & 7; const float invf = powf(500000.0f, -(float)j * 0.125f);
        const float ang = (float)positions[t] * invf; float sn, cs; sincosf(ang, &sn, &cs);
        ((float*)(ws + WS_ROPE))[t * 16 + j] = cs; ((float*)(ws + WS_ROPE))[t * 16 + 8 + j] = sn; }
    __syncthreads();
    for (int m0 = 2 * gw; m0 < T + TMEM; m0 += 2 * NGW) {
        f32x4 v[2][4]; float rstd[2];
#pragma unroll
        for (int q = 0; q < 2; ++q) { const int m = m0 + q; const f32x4* xr = (const f32x4*)(m >= T ? mem + (size_t)(m - T) * D : x + (size_t)m * D) + lane;
#pragma unroll
            for (int j = 0; j < 4; ++j) v[q][j] = xr[64 * j]; }
#pragma unroll
        for (int q = 0; q < 2; ++q) { float s = 0.f;
#pragma unroll
            for (int j = 0; j < 4; ++j) s += (v[q][j].x * v[q][j].x + v[q][j].y * v[q][j].y) + (v[q][j].z * v[q][j].z + v[q][j].w * v[q][j].w);
            rstd[q] = 1.0f / sqrtf(wave_sum(s) * (1.0f / D) + EPSN);
            unsigned long long* o8 = (unsigned long long*)(ws + WS_XN + (size_t)(m0 + q) * D * 2) + lane;
#pragma unroll
            for (int j = 0; j < 4; ++j) o8[64 * j] = (unsigned long long)pk2(v[q][j].x * rstd[q], v[q][j].y * rstd[q]) | ((unsigned long long)pk2(v[q][j].z * rstd[q], v[q][j].w * rstd[q]) << 32); }
        if (m0 < T) {
            float val0 = 0.f, val1 = 0.f;
#pragma unroll
            for (int g = 0; g < 8; ++g) { float a0 = 0.f, a1 = 0.f;
#pragma unroll
                for (int j = 0; j < 4; ++j) { const f32x4 w = *(const LAS f32x4*)(WGl + g * 1024 + 256 * j + 4 * lane);
                    a0 += (v[0][j].x * w.x + v[0][j].y * w.y) + (v[0][j].z * w.z + v[0][j].w * w.w); a1 += (v[1][j].x * w.x + v[1][j].y * w.y) + (v[1][j].z * w.z + v[1][j].w * w.w); }
                a0 = wave_sum(a0) * rstd[0]; a1 = wave_sum(a1) * rstd[1];
                val0 = (lane == g) ? a0 : val0; val1 = (lane == g) ? a1 : val1; }
            if (lane < 8) { const int h = lane & 3;
#pragma unroll
                for (int q = 0; q < 2; ++q) { const int m = m0 + q, b = m / SEQ, sq = m % SEQ; const float val = q ? val1 : val0;
                    if (lane < 4) ((float*)(ws + WS_IG))[(size_t)(b * 4 + h) * SEQ + sq] = val + b_i[h];
                    else ((float*)(ws + WS_FG))[(size_t)(b * 4 + h) * SEQ + sq] = val + b_f[h]; } }
        }
    }
    __syncthreads();
    LAS float* scr = (LAS float*)(lds + wave * 16384);
    constexpr int I_IN = 16 * 48, I_KV = 16 * 8, I_OUT = 16 * 16, I_QX = 16 * 4, I_OX = 4 * 16, I_M = 32, I_13 = 16 * 2 * 128, I_2P = 24 * 2 * 128;
    constexpr int NITEMS = I_IN + I_KV + I_OUT + I_QX + I_OX + I_M + I_13 + I_2P;
    for (int it = gw; it < NITEMS; it += NGW) {
        int r = it;
        if (r < I_IN) { const int kb = r / 48, nb = r % 48; transpose_item(w_in, INW, 64 * kb, 64 * nb, (bf16*)(ws + WS_WIN), 1024, 64 * nb, 64 * kb, g_mix, (64 * nb < 512) ? C2 : 1.0f, scr, lane); continue; } r -= I_IN;
        if (r < I_KV) { const int kb = r / 8, nb = r % 8; transpose_item(w_kv_x, 512, 64 * kb, 64 * nb, (bf16*)(ws + WS_WIN), 1024, NIN + 64 * nb, 64 * kb, g_mem, 1.0f, scr, lane); continue; } r -= I_KV;
        if (r < I_OUT) { const int kb = r / 16, nb = r % 16; transpose_item(w_out, 1024, 64 * kb, 64 * nb, (bf16*)(ws + WS_WOUT), 1024, 64 * nb, 64 * kb, nullptr, 1.0f, scr, lane); continue; } r -= I_OUT;
        if (r < I_QX) { const int kb = r / 4, nb = r % 4; transpose_item(w_q_x, 256, 64 * kb, 64 * nb, (bf16*)(ws + WS_WQX), 1024, 64 * nb, 64 * kb, g_cross, C2, scr, lane); continue; } r -= I_QX;
        if (r < I_OX) { const int kb = r / 16, nb = r % 16; transpose_item(w_o_x, 1024, 64 * kb, 64 * nb, (bf16*)(ws + WS_WOX), 256, 64 * nb, 64 * kb, nullptr, 1.0f, scr, lane); continue; } r -= I_OX;
        if (r < I_M) { const int which = r / 16, h = (r % 16) / 4, kb = (r % 4) / 2, nb = r % 2;
            transpose_item((which ? w_k_m : w_q_m) + (size_t)h * 128 * 128, 128, 64 * kb, 64 * nb, (bf16*)(ws + WS_WM) + (size_t)(which * 4 + h) * 128 * 128, 128, 64 * nb, 64 * kb, nullptr,
                           which ? 0.08838834764831845f : 1.0f, scr, lane); continue; } r -= I_M;
        if (r < I_13) { const int e = r / 256, which = (r % 256) / 128, kb = (r % 128) / 8, nb = r % 8; const int n0 = 64 * nb;
            transpose_item((which ? w3 : w1) + (size_t)e * 1024 * 512, 512, 64 * kb, n0, (bf16*)(ws + WS_W13) + (size_t)e * 1024 * 1024, 1024, (n0 / 128) * 256 + which * 128 + (n0 % 128), 64 * kb, g_ffn, 1.0f, scr, lane); continue; } r -= I_13;
        { const int bk = r / 256, hf = (r % 256) / 128, kb = (r % 128) / 16, nb = r % 16; const int g = bk / 6, p = bk % 6;
          const int pa = (p < 3) ? 0 : (p < 5 ? 1 : 2), pb = (p < 3) ? p + 1 : (p < 5 ? p - 1 : 3); const int e = 4 * g + (hf ? pb : pa);
          transpose_item(w2 + (size_t)e * 512 * 1024, 1024, 64 * kb, 64 * nb, (bf16*)(ws + WS_W2P) + (size_t)bk * 1024 * 1024, 1024, 64 * nb, hf * 512 + 64 * kb, nullptr, 1.0f, scr, lane); }
    }
}

__device__ __forceinline__ v4u pack8(const f32x4& a, const f32x4& b) { v4u w; w.x = pk2(a[0], a[1]); w.y = pk2(a[2], a[3]); w.z = pk2(b[0], b[1]); w.w = pk2(b[2], b[3]); return w; }
struct EpiInProj {
    static constexpr bool PERM = true, AFTER_DRAIN = false;
    bf16* base; const float* rope;
    __device__ __forceinline__ void operator()(const f32x4 (&acc)[2][2][4][2], const pg8::Unit& u, int wr, int wc, int fr, int fq) const {
        const int buf = u.pn >> 1; bf16* B = base + (size_t)buf * T * 512;
        const int row0 = u.pm * 256 + wr * 64 + fr, col0 = (u.pn & 1) * 256 + wc * 32 + 8 * fq;
        const bool dorope = (buf < 2) && ((wc & 1) == 0);
#pragma unroll
        for (int ai = 0; ai < 2; ++ai)
#pragma unroll
            for (int m = 0; m < 4; ++m) { const int row = row0 + ai * 128 + m * 16; bf16* rowp = B + (size_t)row * 512 + col0;
                f32x4 cs0, cs1, sn0, sn1;
                if (dorope) { const f32x4* rp = (const f32x4*)(rope + (size_t)row * 16); cs0 = rp[0]; cs1 = rp[1]; sn0 = rp[2]; sn1 = rp[3]; }
#pragma unroll
                for (int bj = 0; bj < 2; ++bj) { f32x4 v0 = acc[ai][bj][m][0], v1 = acc[ai][bj][m][1];
                    if (dorope) { f32x4 o0, o1;
#pragma unroll
                        for (int i = 0; i < 4; ++i) { o0[i] = __shfl_xor(v0[i], 16); o1[i] = __shfl_xor(v1[i], 16); }
                        if (fq == 0) { v0 = v0 * cs0 - o0 * sn0; v1 = v1 * cs1 - o1 * sn1; }
                        else if (fq == 1) { v0 = v0 * cs0 + o0 * sn0; v1 = v1 * cs1 + o1 * sn1; } }
                    *(v4u*)(rowp + bj * 128) = pack8(v0, v1); } }
    }
};

typedef short v4i16_t __attribute__((ext_vector_type(4)));
struct AttItem { int cfg, b, h, d, nb; size_t tokb; };
__device__ __forceinline__ AttItem attn_decode(int item) {
    AttItem a; a.cfg = item >> 12; int rem = item & 4095; a.b = rem >> 9; rem &= 511; a.h = rem >> 6; const int sub = rem & 63;
    a.d = (a.cfg == 0) ? 1 : (a.cfg == 1 ? 4 : 16); const int nblk = 64 / a.d, r = sub / nblk; a.nb = sub % nblk; a.tokb = (size_t)a.b * SEQ + r; return a;
}
__device__ __forceinline__ int attn_item_of(int k, int G) {
    if (G != 256) return (int)blockIdx.x + k * G;
    const int pair = (int)(blockIdx.x & 7) + 8 * (k / 6), j = (int)(blockIdx.x >> 3), ip = j * 6 + (k % 6);
    return ((ip >> 6) << 12) | (pair << 6) | (ip & 63);
}
__device__ __forceinline__ void glds16(const void* gsrc, unsigned lds_dst) { unsigned keep;
    asm volatile("s_mov_b32 %0, m0\n\ts_mov_b32 m0, %2\n\ts_nop 0\n\tglobal_load_lds_dwordx4 %1, off\n\ts_mov_b32 m0, %0" : "=&s"(keep) : "v"(gsrc), "s"(lds_dst) : "memory"); }
__device__ __forceinline__ unsigned lds_addr_of(LAS unsigned char* p) { return (unsigned)(uintptr_t)p; }
__device__ __forceinline__ void attn_prefetch(const Args& A, LAS unsigned char* L, int item, int pslot, int oslot, bool load_prev, int lane, int wave, bf16x8 (&qf)[2]) {
    const AttItem a = attn_decode(item);
    const bf16* Kg = (const bf16*)(A.ws + WS_K) + a.h * 64; const bf16* Vg = (const bf16*)(A.ws + WS_V) + a.h * 64; const bf16* Qg = (const bf16*)(A.ws + WS_Q) + a.h * 64;
#pragma unroll
    for (int i = 0; i < 2; ++i) { const int inst = wave + 8 * i, row = 8 * inst + (lane >> 3);
        const size_t off = (a.tokb + (size_t)(128 * a.nb + row) * a.d) * 512 + ((lane & 7) ^ (lane >> 3)) * 8;
        glds16(Kg + off, (unsigned)__builtin_amdgcn_readfirstlane(lds_addr_of(L + oslot * 32768 + inst * 1024)));
        glds16(Vg + off, (unsigned)__builtin_amdgcn_readfirstlane(lds_addr_of(L + oslot * 32768 + 16384 + inst * 1024))); }
    if (load_prev) {
#pragma unroll
        for (int i = 0; i < 2; ++i) { const int inst = wave + 8 * i, row = 8 * inst + (lane >> 3);
            const size_t off = (a.tokb + (size_t)(128 * (a.nb - 1) + row) * a.d) * 512 + ((lane & 7) ^ (lane >> 3)) * 8;
            glds16(Kg + off, (unsigned)__builtin_amdgcn_readfirstlane(lds_addr_of(L + pslot * 32768 + inst * 1024)));
            glds16(Vg + off, (unsigned)__builtin_amdgcn_readfirstlane(lds_addr_of(L + pslot * 32768 + 16384 + inst * 1024))); } }
    const size_t tq = a.tokb + (size_t)(128 * a.nb + 16 * wave + (lane & 15)) * a.d;
    qf[0] = *(const bf16x8*)(Qg + tq * 512 + 8 * (lane >> 4)); qf[1] = *(const bf16x8*)(Qg + tq * 512 + 32 + 8 * (lane >> 4));
}
__device__ __forceinline__ void attn_compute(const Args& A, LAS unsigned char* L, int item, int pslot, int oslot, int lane, int wave, const bf16x8 (&qf)[2]) {
    const AttItem a = attn_decode(item);
    const int fr = lane & 15, g = lane >> 4, qi = 16 * wave + fr;
    f32x4 s[10];
#pragma unroll
    for (int tt = 0; tt < 9; ++tt) { const int t = wave + tt, key = 16 * (t & 7) + fr; LAS unsigned char* kb = L + ((t < 8) ? pslot : oslot) * 32768; s[tt] = (f32x4){0.f, 0.f, 0.f, 0.f};
#pragma unroll
        for (int ks = 0; ks < 2; ++ks) { const bf16x8 kf = *(const LAS bf16x8*)(kb + key * 128 + (((4 * ks + g) ^ (key & 7)) * 16));
            s[tt] = __builtin_amdgcn_mfma_f32_16x16x32_bf16(kf, qf[ks], s[tt], 0, 0, 0); } }
    s[9] = (f32x4){0.f, 0.f, 0.f, 0.f};
#pragma unroll
    for (int e = 0; e < 4; ++e) { s[0][e] = (4 * g + e >= fr) ? s[0][e] : -1e30f; s[8][e] = (4 * g + e <= fr) ? s[8][e] : -1e30f; }
    if (a.nb == 0) {
#pragma unroll
        for (int tt = 0; tt < 8; ++tt) if (wave + tt < 8) s[tt] = (f32x4){-1e30f, -1e30f, -1e30f, -1e30f};
    }
    float mx = -1e30f;
#pragma unroll
    for (int tt = 0; tt < 9; ++tt) mx = fmaxf(fmaxf(mx, fmaxf(s[tt][0], s[tt][1])), fmaxf(s[tt][2], s[tt][3]));
    mx = fmaxf(mx, __shfl_xor(mx, 16)); mx = fmaxf(mx, __shfl_xor(mx, 32));
    float l = 0.f;
#pragma unroll
    for (int tt = 0; tt < 9; ++tt)
#pragma unroll
        for (int e = 0; e < 4; ++e) { s[tt][e] = __builtin_amdgcn_exp2f(s[tt][e] - mx); l += s[tt][e]; }
    l += __shfl_xor(l, 16); l += __shfl_xor(l, 32);
    f32x4 o[4];
#pragma unroll
    for (int dt = 0; dt < 4; ++dt) o[dt] = (f32x4){0.f, 0.f, 0.f, 0.f};
#pragma unroll
    for (int k5 = 0; k5 < 5; ++k5) {
        const v4u pw = (v4u){pk2(s[2 * k5][0], s[2 * k5][1]), pk2(s[2 * k5][2], s[2 * k5][3]), pk2(s[2 * k5 + 1][0], s[2 * k5 + 1][1]), pk2(s[2 * k5 + 1][2], s[2 * k5 + 1][3])};
        const bf16x8 pf = __builtin_bit_cast(bf16x8, pw);
        const int t0 = wave + 2 * k5, t1 = (wave + 2 * k5 + 1 < 16) ? wave + 2 * k5 + 1 : 15;
        const int r0 = 16 * (t0 & 7) + 4 * g + (fr >> 2), r1 = 16 * (t1 & 7) + 4 * g + (fr >> 2), p_ = fr & 3;
        LAS unsigned char* v0b = L + ((t0 < 8) ? pslot : oslot) * 32768 + 16384; LAS unsigned char* v1b = L + ((t1 < 8) ? pslot : oslot) * 32768 + 16384;
#pragma unroll
        for (int dt = 0; dt < 4; ++dt) { const int chunk = 2 * dt + (p_ >> 1);
            const v4i16_t v0 = __builtin_amdgcn_ds_read_tr16_b64_v4i16((LAS v4i16_t*)(v0b + r0 * 128 + ((chunk ^ (r0 & 7)) * 16) + 8 * (p_ & 1)));
            const v4i16_t v1 = __builtin_amdgcn_ds_read_tr16_b64_v4i16((LAS v4i16_t*)(v1b + r1 * 128 + ((chunk ^ (r1 & 7)) * 16) + 8 * (p_ & 1)));
            const bf16x8 vf = (bf16x8){v0[0], v0[1], v0[2], v0[3], v1[0], v1[1], v1[2], v1[3]};
            o[dt] = __builtin_amdgcn_mfma_f32_16x16x32_bf16(vf, pf, o[dt], 0, 0, 0); } }
    const float rl = frcp_(l);
    const size_t tok = a.tokb + (size_t)(128 * a.nb + qi) * a.d;
    bf16* og = (bf16*)((unsigned char*)A.out + DO_OATT) + ((size_t)a.cfg * T + tok) * 512 + a.h * 64;
#pragma unroll
    for (int dt = 0; dt < 4; ++dt) *(v2u*)(og + 16 * dt + 4 * g) = (v2u){pk2(o[dt][0] * rl, o[dt][1] * rl), pk2(o[dt][2] * rl, o[dt][3] * rl)};
    if (g == 0) ((float*)(A.ws + WS_LSE))[((size_t)a.cfg * T + tok) * 8 + a.h] = mx + __builtin_amdgcn_logf(l);
}
__device__ __forceinline__ void attn_phase(const Args& A, unsigned char* lds, int n_total, int lane, int wave) {
    const int G = gridDim.x; LAS unsigned char* L = (LAS unsigned char*)lds;
    const int nk = (G == 256) ? n_total / 256 : (n_total - (int)blockIdx.x + G - 1) / G;
    if (nk <= 0) return;
    bf16x8 qa[2], qb[2];
    int it = attn_item_of(0, G); int ps, os;
    { const AttItem a = attn_decode(it); os = 0; ps = (a.nb > 0) ? 1 : 0; attn_prefetch(A, L, it, ps, os, a.nb > 0, lane, wave, qa); }
    for (int k = 0; k < nk; ++k) {
        __builtin_amdgcn_s_waitcnt(0x0F70);
        asm volatile("s_waitcnt vmcnt(0)" ::: "memory");
        __syncthreads();
        qb[0] = qa[0]; qb[1] = qa[1];
        int nit = it, nps = ps, nos = os;
        if (k + 1 < nk) { nit = attn_item_of(k + 1, G); const AttItem c = attn_decode(it), n = attn_decode(nit);
            const bool succ = (nit == it + 1) && (n.nb == c.nb + 1);
            const int used = (1 << ps) | (1 << os); const int f1 = (used & 1) ? ((used & 2) ? ((used & 4) ? 3 : 2) : 1) : 0; const int used2 = used | (1 << f1);
            const int f2 = (used2 & 1) ? ((used2 & 2) ? ((used2 & 4) ? 3 : 2) : 1) : 0;
            bool lp;
            if (succ) { nps = os; nos = f1; lp = false; } else if (n.nb == 0) { nos = f1; nps = f1; lp = false; } else { nps = f1; nos = f2; lp = true; }
            attn_prefetch(A, L, nit, nps, nos, lp, lane, wave, qb); }
        attn_compute(A, L, it, ps, os, lane, wave, qa);
        qa[0] = qb[0]; qa[1] = qb[1]; it = nit; ps = nps; os = nos;
    }
    asm volatile("s_waitcnt vmcnt(0)" ::: "memory");
    __syncthreads();
}

__device__ __forceinline__ void kv_tile(const Args& A, unsigned char* lds, int tile, int tid, int lane, int wave) {
    unsigned char* ws = A.ws;
    const int mt = tile >> 3, nt = tile & 7;
    const bf16* Ag = (const bf16*)(ws + WS_XN) + (size_t)(T + 64 * mt) * D; const bf16* Bg = (const bf16*)(ws + WS_WIN) + (size_t)(NIN + 64 * nt) * D;
    bf16* As = (bf16*)lds; bf16* Bs = (bf16*)(lds + 64 * 264 * 2);
    const int fr = lane & 15, fq = lane >> 4, wm = wave & 3, wn = wave >> 2;
    f32x4 acc[1][2]; acc[0][0] = (f32x4){0.f, 0.f, 0.f, 0.f}; acc[0][1] = (f32x4){0.f, 0.f, 0.f, 0.f};
    for (int kc = 0; kc < 4; ++kc) {
        for (int id = tid; id < 64 * 32; id += NTHR) { const int row = id >> 5, ch = id & 31;
            *(v4u*)(As + row * 264 + ch * 8) = *(const v4u*)(Ag + (size_t)row * D + kc * 256 + ch * 8);
            *(v4u*)(Bs + row * 264 + ch * 8) = *(const v4u*)(Bg + (size_t)row * D + kc * 256 + ch * 8); }
        __syncthreads();
        wave_mma<1, 2>(As + 16 * wm * 264, 264, Bs + 32 * wn * 264, 264, 256, acc, fr, fq);
        __syncthreads();
    }
    bf16* og = (bf16*)(ws + WS_KVX) + (size_t)(64 * mt + 16 * wm + fr) * NKV + 64 * nt + 32 * wn;
#pragma unroll
    for (int j = 0; j < 2; ++j) *(v2u*)(og + 16 * j + 4 * fq) = (v2u){pk2(acc[0][j][0], acc[0][j][1]), pk2(acc[0][j][2], acc[0][j][3])};
}

constexpr int ML_TILE = 32768;
constexpr int ML_G = 4 * ML_TILE;
static_assert(ML_G + 8192 <= LDS_MISC, "mlstm LDS");
__device__ __forceinline__ int sw_off(int row, int ch) { return 256 * row + 16 * (ch ^ (((row & 3) << 2) | ((row >> 2) & 3))); }
__device__ __forceinline__ bf16x8 rowfrag(LAS unsigned char* tile, int row0, int ks, int fr, int g) { return *(const LAS bf16x8*)(tile + sw_off(row0 + fr, 4 * ks + g)); }
__device__ __forceinline__ bf16x8 colfrag(LAS unsigned char* tile, int ks, int ct, int fr, int g) {
    const int r0 = 32 * ks + 8 * g + (fr >> 2), p = fr & 3, ch = 2 * ct + (p >> 1);
    const v4i16_t a = __builtin_amdgcn_ds_read_tr16_b64_v4i16((LAS v4i16_t*)(tile + sw_off(r0, ch) + 8 * (p & 1)));
    const v4i16_t b = __builtin_amdgcn_ds_read_tr16_b64_v4i16((LAS v4i16_t*)(tile + sw_off(r0 + 4, ch) + 8 * (p & 1)));
    return (bf16x8){a[0], a[1], a[2], a[3], b[0], b[1], b[2], b[3]};
}
__device__ __forceinline__ float log_sigmoidf_(float x) { return (x > 0.f) ? -log1pf(__expf(-x)) : (x - log1pf(__expf(x))); }
__device__ __forceinline__ float wscan_sum(float v0, float v1, float& o0, float& o1, int lane) {
    float x = v0 + v1;
#pragma unroll
    for (int off = 1; off < 64; off <<= 1) { const float t = __shfl_up(x, off); if (lane >= off) x += t; }
    o0 = x - v1; o1 = x; return __shfl(x, 63);
}
__device__ __forceinline__ void wscan_max(float v0, float v1, float& o0, float& o1, int lane) {
    float y = fmaxf(v0, v1);
#pragma unroll
    for (int off = 1; off < 64; off <<= 1) { const float t = __shfl_up(y, off); if (lane >= off) y = fmaxf(y, t); }
    float pre = __shfl_up(y, 1); if (lane == 0) pre = -INFINITY;
    o0 = fmaxf(pre, v0); o1 = fmaxf(pre, fmaxf(v0, v1));
}
__device__ __forceinline__ void tile_load(LAS unsigned char* tile, const bf16* src, size_t pitch, int tid) {
    v4u v[4];
#pragma unroll
    for (int i = 0; i < 4; ++i) { const int id = tid + NTHR * i, row = id >> 4, ch = id & 15; v[i] = *(const v4u*)(src + (size_t)row * pitch + ch * 8); }
#pragma unroll
    for (int i = 0; i < 4; ++i) { const int id = tid + NTHR * i, row = id >> 4, ch = id & 15; *(LAS v4u*)(tile + sw_off(row, ch)) = v[i]; }
}

__device__ __forceinline__ void ml_conv_tile(LAS unsigned char* cA, const bf16* MU, const float* conv_w, const float* conv_b, int b, int c, int h, int tid) {
    const int ch = (tid & 15) * 8;
    float w[4][8], bs[8];
#pragma unroll
    for (int j = 0; j < 4; ++j) { const f32x4 w0 = *(const f32x4*)(conv_w + j * 512 + h * 128 + ch), w1 = *(const f32x4*)(conv_w + j * 512 + h * 128 + ch + 4);
        w[j][0] = w0[0]; w[j][1] = w0[1]; w[j][2] = w0[2]; w[j][3] = w0[3]; w[j][4] = w1[0]; w[j][5] = w1[1]; w[j][6] = w1[2]; w[j][7] = w1[3]; }
    { const f32x4 b0 = *(const f32x4*)(conv_b + h * 128 + ch), b1 = *(const f32x4*)(conv_b + h * 128 + ch + 4);
      bs[0] = b0[0]; bs[1] = b0[1]; bs[2] = b0[2]; bs[3] = b0[3]; bs[4] = b1[0]; bs[5] = b1[1]; bs[6] = b1[2]; bs[7] = b1[3]; }
#pragma unroll
    for (int i = 0; i < 4; ++i) { const int l = (tid >> 4) + 32 * i;
        float a[8];
#pragma unroll
        for (int q = 0; q < 8; ++q) a[q] = bs[q];
#pragma unroll
        for (int j = 0; j < 4; ++j) { const int sp = 128 * c + l + j - 3;
            if (sp >= 0) { const v4u m = *(const v4u*)(MU + ((size_t)b * SEQ + sp) * 512 + ch);
                a[0] += bflo(m.x) * w[j][0]; a[1] += bfhi(m.x) * w[j][1]; a[2] += bflo(m.y) * w[j][2]; a[3] += bfhi(m.y) * w[j][3];
                a[4] += bflo(m.z) * w[j][4]; a[5] += bfhi(m.z) * w[j][5]; a[6] += bflo(m.w) * w[j][6]; a[7] += bfhi(m.w) * w[j][7]; } }
#pragma unroll
        for (int q = 0; q < 8; ++q) a[q] = a[q] * sigmoidf_(a[q]);
        *(LAS v4u*)(cA + sw_off(l, tid & 15)) = (v4u){pk2(a[0], a[1]), pk2(a[2], a[3]), pk2(a[4], a[5]), pk2(a[6], a[7])}; }
}
struct MGroup { f32x4 G[8]; f32x4 Gn; float B, M; };
__device__ __forceinline__ void mlstm_p1_item(const Args& A, unsigned char* lds_, int item, int& wres, MGroup& mg, int tid, int lane, int wave) {
    asm volatile("" : "+v"(tid), "+v"(lane));
    unsigned char* ws = A.ws; LAS unsigned char* lds = (LAS unsigned char*)lds_;
    const int bh = item >> 6, c = item & 63, b = bh >> 2, h = bh & 3;
    const size_t t0 = (size_t)b * SEQ + 128 * c;
    LAS unsigned char* cA = lds; LAS unsigned char* Wk = lds + 2 * ML_TILE; LAS unsigned char* Vt = lds + 3 * ML_TILE;
    LAS float* gl = (LAS float*)(lds + ML_G);
    const int fr = lane & 15, g = lane >> 4, m0 = 16 * wave;
    if (wres != h) { tile_load(Wk, (const bf16*)(ws + WS_WM) + (size_t)(4 + h) * 128 * 128, 128, tid); wres = h; }
    tile_load(Vt, (const bf16*)(ws + WS_MV) + t0 * 512 + h * 128, 512, tid);
    ml_conv_tile(cA, (const bf16*)(ws + WS_MU) + h * 128, (const float*)(ws + WS_PAR) + PAR_CONVW, (const float*)(ws + WS_PAR) + PAR_CONVB, b, c, h, tid);
    float blast, mloc;
    { const size_t gi = (size_t)bh * SEQ + 128 * c + 2 * lane;
      const float i0 = ((const float*)(ws + WS_IG))[gi], i1 = ((const float*)(ws + WS_IG))[gi + 1];
      const float f0 = log_sigmoidf_(((const float*)(ws + WS_FG))[gi]), f1 = log_sigmoidf_(((const float*)(ws + WS_FG))[gi + 1]);
      float b0, b1; blast = wscan_sum(f0, f1, b0, b1, lane);
      const float g0 = blast - b0 + i0, g1 = blast - b1 + i1; mloc = wave_max(fmaxf(g0, g1));
      gl[2 * lane] = fexp_(g0 - mloc); gl[2 * lane + 1] = fexp_(g1 - mloc); }
    __syncthreads();
    { bf16x8 af[4];
#pragma unroll
      for (int ks = 0; ks < 4; ++ks) af[ks] = rowfrag(cA, m0, ks, fr, g);
      const float wk = gl[m0 + fr];
#pragma unroll
      for (int j = 0; j < 8; ++j) { f32x4 acc = (f32x4){0.f, 0.f, 0.f, 0.f};
#pragma unroll
          for (int ks = 0; ks < 4; ++ks) acc = __builtin_amdgcn_mfma_f32_16x16x32_bf16(rowfrag(Wk, 16 * j, ks, fr, g), af[ks], acc, 0, 0, 0);
          *(LAS v2u*)(cA + sw_off(m0 + fr, 2 * j + (g >> 1)) + 8 * (g & 1)) = (v2u){pk2(acc[0] * wk, acc[1] * wk), pk2(acc[2] * wk, acc[3] * wk)}; } }
    __syncthreads();
    { f32x4 acc[8], accn = (f32x4){0.f, 0.f, 0.f, 0.f};
#pragma unroll
      for (int j = 0; j < 8; ++j) acc[j] = (f32x4){0.f, 0.f, 0.f, 0.f};
      const bf16x8 ones = (bf16x8){0x3f80, 0x3f80, 0x3f80, 0x3f80, 0x3f80, 0x3f80, 0x3f80, 0x3f80};
#pragma unroll
      for (int ks = 0; ks < 4; ++ks) { const bf16x8 vf = colfrag(Vt, ks, wave, fr, g);
#pragma unroll
          for (int j = 0; j < 8; ++j) { const bf16x8 kf = colfrag(cA, ks, j, fr, g); acc[j] = __builtin_amdgcn_mfma_f32_16x16x32_bf16(kf, vf, acc[j], 0, 0, 0);
              if (j == wave) accn = __builtin_amdgcn_mfma_f32_16x16x32_bf16(kf, ones, accn, 0, 0, 0); } }
      if ((c & 7) == 0) {
#pragma unroll
          for (int j = 0; j < 8; ++j) mg.G[j] = acc[j];
          mg.Gn = accn; mg.M = mloc; mg.B = blast;
      } else { const float mnew = fmaxf(blast + mg.M, mloc), a = fexp_(blast + mg.M - mnew), cc = fexp_(mloc - mnew);
#pragma unroll
          for (int j = 0; j < 8; ++j) mg.G[j] = mg.G[j] * a + acc[j] * cc;
          mg.Gn = mg.Gn * a + accn * cc; mg.M = mnew; mg.B += blast; }
      if ((c & 7) == 7) { const int gi = bh * 8 + (c >> 3);
          bf16* gg = (bf16*)(ws + WS_GAGG) + ((size_t)gi * 128 + m0 + fr) * 128;
#pragma unroll
          for (int j = 0; j < 8; ++j) *(v2u*)(gg + 16 * j + 4 * g) = (v2u){pk2(mg.G[j][0], mg.G[j][1]), pk2(mg.G[j][2], mg.G[j][3])};
          if (fr == 0) *(f32x4*)((float*)(ws + WS_GN) + (size_t)gi * 128 + 16 * wave + 4 * g) = mg.Gn;
          if (wave == 0 && lane == 0) { ((float*)(ws + WS_GSC))[2 * gi] = mg.B; ((float*)(ws + WS_GSC))[2 * gi + 1] = mg.M; } } }
    __syncthreads();
}

__device__ __forceinline__ void combine_rows(const Args& A, size_t row0, int nrows, int tid) {
    unsigned char* ws = A.ws;
    const bf16* OA = (const bf16*)((const unsigned char*)A.out + DO_OATT); const float* LSE = (const float*)(ws + WS_LSE);
    for (int id = tid; id < nrows * 64; id += NTHR) {
        const size_t t = row0 + (id >> 6); const int h = (id & 63) >> 3, ch = (id & 7) * 8;
        const float l0 = LSE[t * 8 + h], l1 = LSE[((size_t)T + t) * 8 + h], l2 = LSE[((size_t)2 * T + t) * 8 + h];
        const float mx = fmaxf(l0, fmaxf(l1, l2)); float w0 = __builtin_amdgcn_exp2f(l0 - mx), w1 = __builtin_amdgcn_exp2f(l1 - mx), w2 = __builtin_amdgcn_exp2f(l2 - mx);
        const float rs = frcp_(w0 + w1 + w2); w0 *= rs; w1 *= rs; w2 *= rs;
        const v4u a = *(const v4u*)(OA + t * 512 + h * 64 + ch), b = *(const v4u*)(OA + ((size_t)T + t) * 512 + h * 64 + ch), c = *(const v4u*)(OA + ((size_t)2 * T + t) * 512 + h * 64 + ch);
        v4u o;
        o.x = pk2(w0 * bflo(a.x) + w1 * bflo(b.x) + w2 * bflo(c.x), w0 * bfhi(a.x) + w1 * bfhi(b.x) + w2 * bfhi(c.x));
        o.y = pk2(w0 * bflo(a.y) + w1 * bflo(b.y) + w2 * bflo(c.y), w0 * bfhi(a.y) + w1 * bfhi(b.y) + w2 * bfhi(c.y));
        o.z = pk2(w0 * bflo(a.z) + w1 * bflo(b.z) + w2 * bflo(c.z), w0 * bfhi(a.z) + w1 * bfhi(b.z) + w2 * bfhi(c.z));
        o.w = pk2(w0 * bflo(a.w) + w1 * bflo(b.w) + w2 * bflo(c.w), w0 * bfhi(a.w) + w1 * bfhi(b.w) + w2 * bfhi(c.w));
        *(v4u*)((bf16*)(ws + WS_Y) + t * 1024 + h * 64 + ch) = o;
    }
}

struct MState { f32x4 C[8]; float n0, n1, m; };
__device__ __forceinline__ void mlstm2_entry(const Args& A, int bh, int grp, MState& st, int lane, int wave) {
    unsigned char* ws = A.ws; const int fr = lane & 15, g = lane >> 4, m0 = 16 * wave;
#pragma unroll
    for (int j = 0; j < 8; ++j) st.C[j] = (f32x4){0.f, 0.f, 0.f, 0.f};
    st.n0 = 0.f; st.n1 = 0.f; st.m = 0.f;
    for (int gp = 0; gp < grp; ++gp) { const int gi = bh * 8 + gp; const float B = ((const float*)(ws + WS_GSC))[2 * gi], M = ((const float*)(ws + WS_GSC))[2 * gi + 1];
        const float mnew = fmaxf(B + st.m, M), a = fexp_(B + st.m - mnew), cc = fexp_(M - mnew);
        const bf16* gg = (const bf16*)(ws + WS_GAGG) + ((size_t)gi * 128 + m0 + fr) * 128;
#pragma unroll
        for (int j = 0; j < 8; ++j) { const v2u w = *(const v2u*)(gg + 16 * j + 4 * g); st.C[j] = st.C[j] * a + (f32x4){bflo(w.x), bfhi(w.x), bflo(w.y), bfhi(w.y)} * cc; }
        const float* gn = (const float*)(ws + WS_GN) + (size_t)gi * 128 + 2 * lane;
        st.n0 = st.n0 * a + gn[0] * cc; st.n1 = st.n1 * a + gn[1] * cc; st.m = mnew; }
}
__device__ __forceinline__ void mlstm_p2_item(const Args& A, unsigned char* lds_, int item, MState& st, int tid, int lane, int wave) {
    asm volatile("" : "+v"(tid), "+v"(lane));
    unsigned char* ws = A.ws; LAS unsigned char* lds = (LAS unsigned char*)lds_;
    const float* g_mhn = (const float*)(ws + WS_PAR) + PAR_GMHN; const float* skip_m = (const float*)(ws + WS_PAR) + PAR_SKIP;
    const int bh = item >> 6, c = item & 63, b = bh >> 2, h = bh & 3;
    const size_t t0 = (size_t)b * SEQ + 128 * c;
    LAS unsigned char* T0 = lds; LAS unsigned char* T1 = lds + ML_TILE; LAS unsigned char* T2 = lds + 2 * ML_TILE; LAS unsigned char* T3 = lds + 3 * ML_TILE;
    LAS float* gl = (LAS float*)(lds + ML_G);
    const int fr = lane & 15, g = lane >> 4, m0 = 16 * wave, l = m0 + fr;
    { const bf16* Wg = (const bf16*)(ws + WS_WM) + (size_t)h * 128 * 128; tile_load(T1, Wg, 128, tid); tile_load(T2, Wg + 4 * 128 * 128, 128, tid); }
    tile_load(T3, (const bf16*)(ws + WS_MV) + t0 * 512 + h * 128, 512, tid);
    ml_conv_tile(T0, (const bf16*)(ws + WS_MU) + h * 128, (const float*)(ws + WS_PAR) + PAR_CONVW, (const float*)(ws + WS_PAR) + PAR_CONVB, b, c, h, tid);
    float blast, mloc;
    { const size_t gi = (size_t)bh * SEQ + 128 * c + 2 * lane; const float mprev = st.m;
      const float i0 = ((const float*)(ws + WS_IG))[gi], i1 = ((const float*)(ws + WS_IG))[gi + 1];
      const float f0 = log_sigmoidf_(((const float*)(ws + WS_FG))[gi]), f1 = log_sigmoidf_(((const float*)(ws + WS_FG))[gi + 1]);
      float b0, b1; blast = wscan_sum(f0, f1, b0, b1, lane);
      const float g0 = blast - b0 + i0, g1 = blast - b1 + i1; mloc = wave_max(fmaxf(g0, g1));
      gl[640 + 2 * lane] = fexp_(g0 - mloc); gl[640 + 2 * lane + 1] = fexp_(g1 - mloc);
      const float a0 = i0 - b0, a1 = i1 - b1; float p0, p1; wscan_max(a0, a1, p0, p1, lane);
      const float mt0 = fmaxf(b0 + mprev, b0 + p0), mt1 = fmaxf(b1 + mprev, b1 + p1);
      gl[2 * lane] = a0; gl[2 * lane + 1] = a1; gl[128 + 2 * lane] = b0 - mt0; gl[128 + 2 * lane + 1] = b1 - mt1;
      gl[256 + 2 * lane] = fexp_(b0 + mprev - mt0); gl[256 + 2 * lane + 1] = fexp_(b1 + mprev - mt1); gl[384 + 2 * lane] = fexp_(-mt0); gl[384 + 2 * lane + 1] = fexp_(-mt1);
      gl[512 + 2 * lane] = st.n0; gl[512 + 2 * lane + 1] = st.n1; }
    __syncthreads();
    v2u cp[8], qp[8], kp[8];
    { bf16x8 af[4];
#pragma unroll
      for (int ks = 0; ks < 4; ++ks) af[ks] = rowfrag(T0, m0, ks, fr, g);
#pragma unroll
      for (int j = 0; j < 8; ++j) cp[j] = *(const LAS v2u*)(T0 + sw_off(l, 2 * j + (g >> 1)) + 8 * (g & 1));
#pragma unroll
      for (int j = 0; j < 8; ++j) { f32x4 acc = (f32x4){0.f, 0.f, 0.f, 0.f};
#pragma unroll
          for (int ks = 0; ks < 4; ++ks) acc = __builtin_amdgcn_mfma_f32_16x16x32_bf16(rowfrag(T1, 16 * j, ks, fr, g), af[ks], acc, 0, 0, 0);
          qp[j] = (v2u){pk2(acc[0], acc[1]), pk2(acc[2], acc[3])}; }
#pragma unroll
      for (int j = 0; j < 8; ++j) { f32x4 acc = (f32x4){0.f, 0.f, 0.f, 0.f};
#pragma unroll
          for (int ks = 0; ks < 4; ++ks) acc = __builtin_amdgcn_mfma_f32_16x16x32_bf16(rowfrag(T2, 16 * j, ks, fr, g), af[ks], acc, 0, 0, 0);
          kp[j] = (v2u){pk2(acc[0], acc[1]), pk2(acc[2], acc[3])}; } }
    __syncthreads();
#pragma unroll
    for (int j = 0; j < 8; ++j) { const int off = sw_off(l, 2 * j + (g >> 1)) + 8 * (g & 1);
        *(LAS v2u*)(T1 + off) = qp[j]; *(LAS v2u*)(T0 + off) = kp[j]; *(LAS v2u*)(T2 + off) = (v2u){pk2(st.C[j][0], st.C[j][1]), pk2(st.C[j][2], st.C[j][3])}; }
    __syncthreads();
    bf16x8 qf[4];
#pragma unroll
    for (int ks = 0; ks < 4; ++ks) qf[ks] = rowfrag(T1, m0, ks, fr, g);
    float qn = 0.f;
    { const LAS float* np = gl + 512;
#pragma unroll
      for (int ks = 0; ks < 4; ++ks) { const f32x4 n0 = *(const LAS f32x4*)(np + 32 * ks + 8 * g), n1 = *(const LAS f32x4*)(np + 32 * ks + 8 * g + 4); const v4u w = __builtin_bit_cast(v4u, qf[ks]);
          qn += bflo(w.x) * n0[0] + bfhi(w.x) * n0[1] + bflo(w.y) * n0[2] + bfhi(w.y) * n0[3] + bflo(w.z) * n1[0] + bfhi(w.z) * n1[1] + bflo(w.w) * n1[2] + bfhi(w.w) * n1[3]; }
      qn += __shfl_xor(qn, 16); qn += __shfl_xor(qn, 32); }
    float den = 0.f;
    { const float rc = gl[128 + l];
#pragma unroll
      for (int j = 0; j < 8; ++j) { f32x4 acc = (f32x4){0.f, 0.f, 0.f, 0.f};
          if (j <= wave) {
#pragma unroll
              for (int ks = 0; ks < 4; ++ks) acc = __builtin_amdgcn_mfma_f32_16x16x32_bf16(rowfrag(T0, 16 * j, ks, fr, g), qf[ks], acc, 0, 0, 0);
#pragma unroll
              for (int e = 0; e < 4; ++e) { const int sx = 16 * j + 4 * g + e; acc[e] = (sx <= l) ? acc[e] * fexp_(rc + gl[sx]) : 0.f; den += acc[e]; } }
          *(LAS v2u*)(T1 + sw_off(l, 2 * j + (g >> 1)) + 8 * (g & 1)) = (v2u){pk2(acc[0], acc[1]), pk2(acc[2], acc[3])}; }
      den += __shfl_xor(den, 16); den += __shfl_xor(den, 32); }
    f32x4 acc[8];
    const float iw = gl[256 + l];
#pragma unroll
    for (int j = 0; j < 8; ++j) { acc[j] = (f32x4){0.f, 0.f, 0.f, 0.f};
#pragma unroll
        for (int ks = 0; ks < 4; ++ks) acc[j] = __builtin_amdgcn_mfma_f32_16x16x32_bf16(rowfrag(T2, 16 * j, ks, fr, g), qf[ks], acc[j], 0, 0, 0);
        acc[j] = acc[j] * iw; }
    asm volatile("s_waitcnt lgkmcnt(0)" ::: "memory");
#pragma unroll
    for (int ks = 0; ks < 4; ++ks) if (2 * ks <= wave) { const bf16x8 sf = rowfrag(T1, m0, ks, fr, g);
#pragma unroll
        for (int j = 0; j < 8; ++j) acc[j] = __builtin_amdgcn_mfma_f32_16x16x32_bf16(colfrag(T3, ks, j, fr, g), sf, acc[j], 0, 0, 0); }
    den += iw * qn;
    const float rden = frcp_(fmaxf(fabsf(den), gl[384 + l]));
    float sq = 0.f;
#pragma unroll
    for (int j = 0; j < 8; ++j) { acc[j] = acc[j] * rden; sq += (acc[j][0] * acc[j][0] + acc[j][1] * acc[j][1]) + (acc[j][2] * acc[j][2] + acc[j][3] * acc[j][3]); }
    sq += __shfl_xor(sq, 16); sq += __shfl_xor(sq, 32);
    const float rn = __builtin_amdgcn_rsqf(sq * (1.0f / 128.0f) + EPSN);
    const bf16* MOg = (const bf16*)(ws + WS_MO) + (t0 + l) * 512 + h * 128;
    bf16* yg = (bf16*)(ws + WS_Y) + (t0 + l) * 1024 + 512 + h * 128;
#pragma unroll
    for (int j = 0; j < 8; ++j) { const int e0 = 16 * j + 4 * g;
        const v2u mo = *(const v2u*)(MOg + e0), cc = cp[j];
        const f32x4 gm = *(const f32x4*)(g_mhn + h * 128 + e0), sk = *(const f32x4*)(skip_m + h * 128 + e0);
        const float y0 = sigmoidf_(bflo(mo.x)) * (acc[j][0] * rn * gm[0] + sk[0] * bflo(cc.x));
        const float y1 = sigmoidf_(bfhi(mo.x)) * (acc[j][1] * rn * gm[1] + sk[1] * bfhi(cc.x));
        const float y2 = sigmoidf_(bflo(mo.y)) * (acc[j][2] * rn * gm[2] + sk[2] * bflo(cc.y));
        const float y3 = sigmoidf_(bfhi(mo.y)) * (acc[j][3] * rn * gm[3] + sk[3] * bfhi(cc.y));
        *(v2u*)(yg + e0) = (v2u){pk2(y0, y1), pk2(y2, y3)}; }
    { f32x4 accn = (f32x4){0.f, 0.f, 0.f, 0.f};
#pragma unroll
      for (int j = 0; j < 8; ++j) acc[j] = (f32x4){0.f, 0.f, 0.f, 0.f};
#pragma unroll
      for (int ks = 0; ks < 4; ++ks) { const f32x4 w0 = *(const LAS f32x4*)(gl + 640 + 32 * ks + 8 * g), w1 = *(const LAS f32x4*)(gl + 640 + 32 * ks + 8 * g + 4);
          const v4u vr = __builtin_bit_cast(v4u, colfrag(T3, ks, wave, fr, g));
          const v4u vs = (v4u){pk2(bflo(vr.x) * w0[0], bfhi(vr.x) * w0[1]), pk2(bflo(vr.y) * w0[2], bfhi(vr.y) * w0[3]), pk2(bflo(vr.z) * w1[0], bfhi(vr.z) * w1[1]), pk2(bflo(vr.w) * w1[2], bfhi(vr.w) * w1[3])};
          const v4u wv = (v4u){pk2(w0[0], w0[1]), pk2(w0[2], w0[3]), pk2(w1[0], w1[1]), pk2(w1[2], w1[3])};
          const bf16x8 vf = __builtin_bit_cast(bf16x8, vs), wf = __builtin_bit_cast(bf16x8, wv);
#pragma unroll
          for (int j = 0; j < 8; ++j) { const bf16x8 kf = colfrag(T0, ks, j, fr, g); acc[j] = __builtin_amdgcn_mfma_f32_16x16x32_bf16(kf, vf, acc[j], 0, 0, 0);
              if (j == wave) accn = __builtin_amdgcn_mfma_f32_16x16x32_bf16(kf, wf, accn, 0, 0, 0); } }
      const float mnew = fmaxf(blast + st.m, mloc), a = fexp_(blast + st.m - mnew), cc = fexp_(mloc - mnew);
#pragma unroll
      for (int j = 0; j < 8; ++j) st.C[j] = st.C[j] * a + acc[j] * cc;
      if (fr == 0) *(LAS f32x4*)(gl + 768 + 16 * wave + 4 * g) = accn;
      __syncthreads();
      st.n0 = st.n0 * a + gl[768 + 2 * lane] * cc; st.n1 = st.n1 * a + gl[768 + 2 * lane + 1] * cc; st.m = mnew; }
}

struct EpiOutProj {
    static constexpr bool PERM = true, AFTER_DRAIN = false;
    const float* x; bf16* x1b; float* ss;
    __device__ __forceinline__ void operator()(const f32x4 (&acc)[2][2][4][2], const pg8::Unit& u, int wr, int wc, int fr, int fq) const {
        int row0 = u.pm * 256 + wr * 64 + fr; asm volatile("" : "+v"(row0));
        const int col0 = u.pn * 256 + wc * 32 + 8 * fq;
#pragma unroll
        for (int ai = 0; ai < 2; ++ai)
#pragma unroll
            for (int m = 0; m < 4; ++m) { const int row = row0 + ai * 128 + m * 16; float sq = 0.f;
#pragma unroll
                for (int bj = 0; bj < 2; ++bj) { const size_t off = (size_t)row * D + col0 + bj * 128;
                    const f32x4 o0 = *(const f32x4*)(x + off) + acc[ai][bj][m][0], o1 = *(const f32x4*)(x + off + 4) + acc[ai][bj][m][1];
                    *(v4u*)(x1b + off) = pack8(o0, o1);
                    sq += ((o0[0] * o0[0] + o0[1] * o0[1]) + (o0[2] * o0[2] + o0[3] * o0[3])) + ((o1[0] * o1[0] + o1[1] * o1[1]) + (o1[2] * o1[2] + o1[3] * o1[3])); }
                sq += __shfl_xor(sq, 16); sq += __shfl_xor(sq, 32);
                if (fq == 0) ss[(size_t)row * 16 + u.pn * 4 + wc] = sq; }
    }
};
struct FixedOrder {
    int pm, n;
    __device__ __forceinline__ bool next(int i, pg8::Unit& u) const { if (i >= n) return false; u.pm = pm; u.pn = i; u.aux = 0; return true; }
    __device__ __forceinline__ void a_ready(const pg8::Unit&) const {}
    __device__ __forceinline__ void done(const pg8::Unit&) const {}
};
struct EpiQx {
    static constexpr bool PERM = true, AFTER_DRAIN = false;
    bf16* qx; const LAS float* rs;
    __device__ __forceinline__ void operator()(const f32x4 (&acc)[2][2][4][2], const pg8::Unit& u, int wr, int wc, int fr, int fq) const {
        const int rl0 = wr * 64 + fr, col0 = wc * 32 + 8 * fq;
#pragma unroll
        for (int ai = 0; ai < 2; ++ai)
#pragma unroll
            for (int m = 0; m < 4; ++m) { const int rl = rl0 + ai * 128 + m * 16; const float sc = rs[rl]; bf16* rowp = qx + (size_t)(u.pm * 256 + rl) * 256 + col0;
#pragma unroll
                for (int bj = 0; bj < 2; ++bj) *(v4u*)(rowp + bj * 128) = pack8(acc[ai][bj][m][0] * sc, acc[ai][bj][m][1] * sc);
                asm volatile("" ::: "memory"); }
    }
};
struct EpiOx {
    static constexpr bool PERM = true, AFTER_DRAIN = false;
    const bf16* x1b; bf16* x2b;
    __device__ __forceinline__ void operator()(const f32x4 (&acc)[2][2][4][2], const pg8::Unit& u, int wr, int wc, int fr, int fq) const {
        int row0 = u.pm * 256 + wr * 64 + fr; asm volatile("" : "+v"(row0));
        const int col0 = u.pn * 256 + wc * 32 + 8 * fq;
#pragma unroll
        for (int ai = 0; ai < 2; ++ai)
#pragma unroll
            for (int m = 0; m < 4; ++m) {
#pragma unroll
                for (int bj = 0; bj < 2; ++bj) { const size_t off = (size_t)(row0 + ai * 128 + m * 16) * D + col0 + bj * 128; const v4u r = *(const v4u*)(x1b + off);
                    f32x4 o0 = acc[ai][bj][m][0], o1 = acc[ai][bj][m][1];
                    o0[0] += bflo(r.x); o0[1] += bfhi(r.x); o0[2] += bflo(r.y); o0[3] += bfhi(r.y); o1[0] += bflo(r.z); o1[1] += bfhi(r.z); o1[2] += bflo(r.w); o1[3] += bfhi(r.w);
                    *(v4u*)(x2b + off) = pack8(o0, o1); }
                asm volatile("" ::: "memory"); }
    }
};
__device__ __forceinline__ void cross_dma(const bf16* KV, int h, LAS unsigned char* buf, int lane, int wave) {
#pragma unroll
    for (int i = 0; i < 4; ++i) { const int inst = wave + 8 * i, row = 8 * inst + (lane >> 3);
        const bf16* src = KV + (size_t)row * NKV + h * 64 + ((lane & 7) ^ (lane >> 3)) * 8;
        glds16(src, (unsigned)__builtin_amdgcn_readfirstlane(lds_addr_of(buf + inst * 1024)));
        glds16(src + 256, (unsigned)__builtin_amdgcn_readfirstlane(lds_addr_of(buf + 32768 + inst * 1024))); }
}
__device__ __forceinline__ void cross_unit(const Args& A, unsigned char* lds, int pm, int tid, int lane, int wave) {
    asm volatile("" : "+v"(tid), "+v"(lane));
    unsigned char* ws = A.ws; LAS unsigned char* L = (LAS unsigned char*)lds;
    const size_t t0 = (size_t)pm * 256; const int b = (int)(t0 / SEQ);
    const bf16* KV = (const bf16*)(ws + WS_KVX) + (size_t)b * MEMLEN * NKV;
    const int fr = lane & 15, g = lane >> 4;
    cross_dma(KV, 0, L, lane, wave);
    for (int h = 0; h < 4; ++h) {
        asm volatile("s_waitcnt vmcnt(0)" ::: "memory");
        __syncthreads();
        LAS unsigned char* buf = L + (h & 1) * 65536;
        if (h < 3) cross_dma(KV, h + 1, L + ((h + 1) & 1) * 65536, lane, wave);
#pragma unroll 1
        for (int rt = 0; rt < 2; ++rt) {
            const size_t row = t0 + 32 * wave + 16 * rt + fr;
            const bf16* qg = (const bf16*)(ws + WS_QX) + row * 256 + h * 64;
            const bf16x8 q0 = *(const bf16x8*)(qg + 8 * g), q1 = *(const bf16x8*)(qg + 32 + 8 * g);
            f32x4 s[16];
#pragma unroll
            for (int t = 0; t < 16; ++t) { const int key = 16 * t + fr;
                s[t] = __builtin_amdgcn_mfma_f32_16x16x32_bf16(*(const LAS bf16x8*)(buf + key * 128 + (((g) ^ (key & 7)) * 16)), q0, (f32x4){0.f, 0.f, 0.f, 0.f}, 0, 0, 0);
                s[t] = __builtin_amdgcn_mfma_f32_16x16x32_bf16(*(const LAS bf16x8*)(buf + key * 128 + (((4 + g) ^ (key & 7)) * 16)), q1, s[t], 0, 0, 0); }
            float mx = -1e30f;
#pragma unroll
            for (int t = 0; t < 16; ++t) mx = fmaxf(fmaxf(mx, fmaxf(s[t][0], s[t][1])), fmaxf(s[t][2], s[t][3]));
            mx = fmaxf(mx, __shfl_xor(mx, 16)); mx = fmaxf(mx, __shfl_xor(mx, 32));
            float l = 0.f;
#pragma unroll
            for (int t = 0; t < 16; ++t)
#pragma unroll
                for (int e = 0; e < 4; ++e) { s[t][e] = __builtin_amdgcn_exp2f(s[t][e] - mx); l += s[t][e]; }
            l += __shfl_xor(l, 16); l += __shfl_xor(l, 32);
            f32x4 o[4];
#pragma unroll
            for (int dt = 0; dt < 4; ++dt) o[dt] = (f32x4){0.f, 0.f, 0.f, 0.f};
#pragma unroll
            for (int k8 = 0; k8 < 8; ++k8) {
                const v4u pw = (v4u){pk2(s[2 * k8][0], s[2 * k8][1]), pk2(s[2 * k8][2], s[2 * k8][3]), pk2(s[2 * k8 + 1][0], s[2 * k8 + 1][1]), pk2(s[2 * k8 + 1][2], s[2 * k8 + 1][3])};
                const bf16x8 pf = __builtin_bit_cast(bf16x8, pw);
                const int r0 = 32 * k8 + 4 * g + (fr >> 2), r1 = r0 + 16, p_ = fr & 3;
#pragma unroll
                for (int dt = 0; dt < 4; ++dt) { const int chunk = 2 * dt + (p_ >> 1);
                    const v4i16_t v0 = __builtin_amdgcn_ds_read_tr16_b64_v4i16((LAS v4i16_t*)(buf + 32768 + r0 * 128 + ((chunk ^ (r0 & 7)) * 16) + 8 * (p_ & 1)));
                    const v4i16_t v1 = __builtin_amdgcn_ds_read_tr16_b64_v4i16((LAS v4i16_t*)(buf + 32768 + r1 * 128 + ((chunk ^ (r1 & 7)) * 16) + 8 * (p_ & 1)));
                    const bf16x8 vf = (bf16x8){v0[0], v0[1], v0[2], v0[3], v1[0], v1[1], v1[2], v1[3]};
                    o[dt] = __builtin_amdgcn_mfma_f32_16x16x32_bf16(vf, pf, o[dt], 0, 0, 0); } }
            const float rl = frcp_(l);
            bf16* og = (bf16*)(ws + WS_OX) + row * 256 + h * 64;
#pragma unroll
            for (int dt = 0; dt < 4; ++dt) *(v2u*)(og + 16 * dt + 4 * g) = (v2u){pk2(o[dt][0] * rl, o[dt][1] * rl), pk2(o[dt][2] * rl, o[dt][3] * rl)};
        }
    }
    asm volatile("s_waitcnt vmcnt(0)" ::: "memory");
    __syncthreads();
}

struct TokInfo { int bucket; float wa, wb; int rank; };
constexpr size_t WS_RSTD3 = 18 * MiB;
constexpr size_t WS_CNTTAB = 31 * MiB + 512 * 1024;
__device__ __forceinline__ void p9_route(const Args& A, unsigned char* lds_, int tid, int lane, int wave) {
    asm volatile("" : "+v"(tid), "+v"(lane));
    unsigned char* ws = A.ws; LAS unsigned char* lds = (LAS unsigned char*)lds_;
    const float* b_rg = (const float*)(ws + WS_PAR) + PAR_BRG; const float* b_re = (const float*)(ws + WS_PAR) + PAR_BRE;
    constexpr int WLD = 2064;
    LAS unsigned char* Wh = lds; LAS unsigned char* Wl = lds + 20 * WLD;
    LAS float* lg = (LAS float*)(lds + 2 * 20 * WLD) + wave * (32 * 24);
    LAS int* bkl = (LAS int*)(lds + 2 * 20 * WLD + 8 * 32 * 24 * 4);
    for (int id = tid; id < 2 * 20 * 128; id += NTHR) { const int t = id / 2560, row = (id % 2560) >> 7, ch = id & 127;
        *(LAS v4u*)(lds + (t * 20 + row) * WLD + ch * 16) = *(const v4u*)((const bf16*)(ws + WS_WR) + ((size_t)t * 32 + row) * 1024 + ch * 8); }
    __syncthreads();
    const bf16* X2B = (const bf16*)(ws + WS_HBS);
    const int fr = lane & 15, g = lane >> 4;
    for (int chunk = blockIdx.x; chunk < T / 256; chunk += gridDim.x) {
        const bf16* xa = X2B + ((size_t)chunk * 256 + 32 * wave + fr) * D + 8 * g;
        f32x4 acc[2][2]; float sq[2] = {0.f, 0.f};
#pragma unroll
        for (int rt = 0; rt < 2; ++rt) { acc[rt][0] = (f32x4){0.f, 0.f, 0.f, 0.f}; acc[rt][1] = (f32x4){0.f, 0.f, 0.f, 0.f}; }
#pragma unroll 4
        for (int ks = 0; ks < 32; ++ks) {
            const bf16x8 a0 = *(const bf16x8*)(xa + 32 * ks), a1 = *(const bf16x8*)(xa + 16 * D + 32 * ks);
            { const v4u w0 = __builtin_bit_cast(v4u, a0), w1 = __builtin_bit_cast(v4u, a1);
              sq[0] += (bflo(w0.x) * bflo(w0.x) + bfhi(w0.x) * bfhi(w0.x)) + (bflo(w0.y) * bflo(w0.y) + bfhi(w0.y) * bfhi(w0.y)) + (bflo(w0.z) * bflo(w0.z) + bfhi(w0.z) * bfhi(w0.z)) + (bflo(w0.w) * bflo(w0.w) + bfhi(w0.w) * bfhi(w0.w));
              sq[1] += (bflo(w1.x) * bflo(w1.x) + bfhi(w1.x) * bfhi(w1.x)) + (bflo(w1.y) * bflo(w1.y) + bfhi(w1.y) * bfhi(w1.y)) + (bflo(w1.z) * bflo(w1.z) + bfhi(w1.z) * bfhi(w1.z)) + (bflo(w1.w) * bflo(w1.w) + bfhi(w1.w) * bfhi(w1.w)); }
#pragma unroll
            for (int ct = 0; ct < 2; ++ct) { const int wrow = (16 * ct + fr < 20) ? 16 * ct + fr : fr;
                const bf16x8 bh = *(const LAS bf16x8*)(Wh + wrow * WLD + 64 * ks + 16 * g), bl = *(const LAS bf16x8*)(Wl + wrow * WLD + 64 * ks + 16 * g);
                acc[0][ct] = __builtin_amdgcn_mfma_f32_16x16x32_bf16(bh, a0, acc[0][ct], 0, 0, 0); acc[0][ct] = __builtin_amdgcn_mfma_f32_16x16x32_bf16(bl, a0, acc[0][ct], 0, 0, 0);
                acc[1][ct] = __builtin_amdgcn_mfma_f32_16x16x32_bf16(bh, a1, acc[1][ct], 0, 0, 0); acc[1][ct] = __builtin_amdgcn_mfma_f32_16x16x32_bf16(bl, a1, acc[1][ct], 0, 0, 0); } }
#pragma unroll
        for (int rt = 0; rt < 2; ++rt) { sq[rt] += __shfl_xor(sq[rt], 16); sq[rt] += __shfl_xor(sq[rt], 32);
            LAS float* lr = lg + (16 * rt + fr) * 24;
            *(LAS f32x4*)(lr + 4 * g) = acc[rt][0];
            if (g == 0) { *(LAS f32x4*)(lr + 16) = acc[rt][1]; lr[20] = 1.0f / sqrtf(sq[rt] * (1.0f / D) + EPSN); } }
        asm volatile("s_waitcnt lgkmcnt(0)" ::: "memory");
        if (lane < 32) { const LAS float* lr = lg + lane * 24; const float rstd = lr[20];
            float gl4[4];
#pragma unroll
            for (int i = 0; i < 4; ++i) gl4[i] = lr[i] * rstd + b_rg[i];
            int gsel = 0; float gm = gl4[0];
#pragma unroll
            for (int i = 1; i < 4; ++i) if (gl4[i] > gm) { gm = gl4[i]; gsel = i; }
            float gs = 0.f;
#pragma unroll
            for (int i = 0; i < 4; ++i) gs += __expf(gl4[i] - gm);
            const float gw_ = 1.0f / gs;
            float el[4];
#pragma unroll
            for (int i = 0; i < 4; ++i) el[i] = lr[4 + 4 * gsel + i] * rstd + b_re[gsel * 4 + i];
            int i0 = 0; float v0 = el[0];
#pragma unroll
            for (int i = 1; i < 4; ++i) if (el[i] > v0) { v0 = el[i]; i0 = i; }
            int i1 = -1; float v1 = -INFINITY;
#pragma unroll
            for (int i = 0; i < 4; ++i) if (i != i0 && el[i] > v1) { v1 = el[i]; i1 = i; }
            const float e1 = __expf(v1 - v0); const float w0 = gw_ / (1.0f + e1), w1 = gw_ * e1 / (1.0f + e1);
            const int pa = i0 < i1 ? i0 : i1, pb = i0 < i1 ? i1 : i0;
            const int pidx = (pa == 0) ? (pb - 1) : (pa == 1 ? pb + 1 : 5);
            const int r = 32 * wave + lane;
            ((float*)(ws + WS_RSTD3))[chunk * 256 + r] = rstd; bkl[r] = gsel * 6 + pidx; ((LAS float*)(bkl + 256))[r] = (i0 < i1) ? w0 : w1; ((LAS float*)(bkl + 512))[r] = (i0 < i1) ? w1 : w0; }
        __syncthreads();
        if (tid < 256) { const int my = bkl[tid]; int rank = 0; for (int j = 0; j < tid; ++j) rank += (bkl[j] == my) ? 1 : 0;
            TokInfo ti; ti.bucket = my; ti.wa = ((LAS float*)(bkl + 256))[tid]; ti.wb = ((LAS float*)(bkl + 512))[tid]; ti.rank = rank;
            ((TokInfo*)(ws + WS_TOKINFO))[chunk * 256 + tid] = ti; }
        else if (tid < 256 + NBUCKET) { const int b = tid - 256; int c = 0; for (int j = 0; j < 256; ++j) c += (bkl[j] == b) ? 1 : 0;
            ((int*)(ws + WS_CNTTAB))[chunk * NBUCKET + b] = c; }
        __syncthreads();
    }
}
__device__ __forceinline__ void p10_slots(const Args& A, unsigned char* lds, int tid, int lane, int wave) {
    unsigned char* ws = A.ws;
    LAS int* tabl = (LAS int*)lds;
    LAS int* totl = (LAS int*)(lds + 32768);
    const int* CNTTAB = (const int*)(ws + WS_CNTTAB);
    for (int i = tid; i < 256 * NBUCKET; i += NTHR) tabl[i] = CNTTAB[i];
    __syncthreads();
    if (tid < NBUCKET) { int t = 0; for (int w = 0; w < 256; ++w) t += tabl[w * NBUCKET + tid]; totl[tid] = t; }
    __syncthreads();
    if (tid == 0) { int acc = 0; for (int b = 0; b < NBUCKET; ++b) { totl[32 + b] = acc; acc += ((totl[b] + 255) >> 8) * 256; } totl[32 + NBUCKET] = acc; }
    if (blockIdx.x == 0 && tid < NBUCKET) ((unsigned*)(ws + WS_CTL))[CW_CNT + tid] = (unsigned)totl[tid];
    __syncthreads();
    int* TOKMAP = (int*)(ws + WS_TOKMAP); float* WSORT = (float*)(ws + WS_WSORT);
    for (int chunk = blockIdx.x; chunk < T / 256; chunk += gridDim.x) {
        if (tid < NBUCKET) { int s = 0; for (int w = 0; w < chunk; ++w) s += tabl[w * NBUCKET + tid]; totl[64 + tid] = totl[32 + tid] + s; }
        __syncthreads();
        if (tid < 256) { const int m = chunk * 256 + tid; const TokInfo ti = ((const TokInfo*)(ws + WS_TOKINFO))[m]; const int slot = totl[64 + ti.bucket] + ti.rank;
            TOKMAP[slot] = m; *(f32x4*)(WSORT + 4 * slot) = (f32x4){ti.wa, ti.wb, ((const float*)(ws + WS_RSTD3))[m], 0.f}; }
        __syncthreads();
    }
    for (int b = blockIdx.x; b < NBUCKET; b += gridDim.x)
        for (int r = totl[32 + b] + totl[b] + tid; r < totl[32 + b + 1]; r += NTHR) { TOKMAP[r] = -1; *(f32x4*)(WSORT + 4 * r) = (f32x4){0.f, 0.f, 0.f, 0.f}; }
}
struct MoeOrder {
    int G, c, nunits, ncol; const int* tab;
    __device__ __forceinline__ bool next(int i, pg8::Unit& u) const {
        const long L = (long)i * G + c; if (L >= nunits) return false;
        const int rt = (int)L / ncol, j = (int)L % ncol, bk = tab[rt];
        u.pm = rt; u.aux = j;
        if (ncol == 8) { const int g = bk / 6, p = bk % 6; const int pa = (p < 3) ? 0 : (p < 5 ? 1 : 2), pb = (p < 3) ? p + 1 : (p < 5 ? p - 1 : 3);
            const int e = 4 * g + ((j >> 2) ? pb : pa); u.pn = e * 4 + (j & 3); }
        else u.pn = bk * 4 + j;
        return true;
    }
    __device__ __forceinline__ void a_ready(const pg8::Unit&) const {}
    __device__ __forceinline__ void done(const pg8::Unit&) const {}
};
struct EpiUp {
    static constexpr bool PERM = true, AFTER_DRAIN = false;
    bf16* act; const float* wsort;
    __device__ __forceinline__ void operator()(const f32x4 (&acc)[2][2][4][2], const pg8::Unit& u, int wr, int wc, int fr, int fq) const {
        const int row0 = u.pm * 256 + wr * 64 + fr, half = u.aux >> 2, col0 = half * 512 + (u.aux & 3) * 128 + wc * 32 + 8 * fq;
#pragma unroll
        for (int ai = 0; ai < 2; ++ai)
#pragma unroll
            for (int m = 0; m < 4; ++m) { const int row = row0 + ai * 128 + m * 16; const float w = wsort[4 * row + half], rs = wsort[4 * row + 2];
                f32x4 r0, r1;
#pragma unroll
                for (int i = 0; i < 4; ++i) { const float a0 = acc[ai][0][m][0][i] * rs, a1 = acc[ai][0][m][1][i] * rs;
                    r0[i] = a0 * sigmoidf_(a0) * (acc[ai][1][m][0][i] * rs) * w; r1[i] = a1 * sigmoidf_(a1) * (acc[ai][1][m][1][i] * rs) * w; }
                *(v4u*)(act + (size_t)row * D + col0) = pack8(r0, r1); }
    }
};
struct EpiDown {
    static constexpr bool PERM = true, AFTER_DRAIN = false;
    const bf16* x2b; float* xo; const int* tokmap;
    __device__ __forceinline__ void operator()(const f32x4 (&acc)[2][2][4][2], const pg8::Unit& u, int wr, int wc, int fr, int fq) const {
        const int row0 = u.pm * 256 + wr * 64 + fr, col0 = u.aux * 256 + wc * 32 + 8 * fq;
#pragma unroll
        for (int ai = 0; ai < 2; ++ai)
#pragma unroll
            for (int m = 0; m < 4; ++m) { const int tok = tokmap[row0 + ai * 128 + m * 16];
                if (tok >= 0) {
#pragma unroll
                    for (int bj = 0; bj < 2; ++bj) { const size_t off = (size_t)tok * D + col0 + bj * 128; const v4u r = *(const v4u*)(x2b + off);
                        f32x4 o0 = acc[ai][bj][m][0], o1 = acc[ai][bj][m][1];
                        o0[0] += bflo(r.x); o0[1] += bfhi(r.x); o0[2] += bflo(r.y); o0[3] += bfhi(r.y); o1[0] += bflo(r.z); o1[1] += bfhi(r.z); o1[2] += bflo(r.w); o1[3] += bfhi(r.w);
                        *(f32x4*)(xo + off) = o0; *(f32x4*)(xo + off + 4) = o1; } } }
    }
};
constexpr size_t WS_XCH = 20 * MiB + 512 * 1024;
constexpr int CW_SEAM = 16384;
constexpr int LDS_EX = 139264;
struct EpiDownNorm {
    static constexpr bool PERM = true, AFTER_DRAIN = false;
    const bf16* x2b; float* out; const int* tokmap; const float* gfin; float* xch; unsigned* cnt; LAS unsigned char* ex;
    __device__ __forceinline__ void operator()(const f32x4 (&acc_)[2][2][4][2], const pg8::Unit& u, int wr, int wc, int fr, int fq) const {
        f32x4 (&acc)[2][2][4][2] = const_cast<f32x4 (&)[2][2][4][2]>(acc_);
        int tid = threadIdx.x; asm volatile("" : "+v"(tid));
        const int lane = tid & 63, wid = __builtin_amdgcn_readfirstlane(tid >> 6);
        int rb = wr * 64 + fr; asm volatile("" : "+v"(rb));
        LAS float* P = (LAS float*)ex; LAS float* S = (LAS float*)(ex + 4096); LAS unsigned* flag = (LAS unsigned*)(ex + 6144);
        const int col0 = u.aux * 256 + wc * 32 + 8 * fq;
#pragma unroll
        for (int ai = 0; ai < 2; ++ai)
#pragma unroll
            for (int m = 0; m < 4; ++m) { const int rl = rb + ai * 128 + m * 16; const int tok = tokmap[u.pm * 256 + rl]; float sq = 0.f;
#pragma unroll
                for (int bj = 0; bj < 2; ++bj) { f32x4& o0 = acc[ai][bj][m][0]; f32x4& o1 = acc[ai][bj][m][1];
                    if (tok >= 0) { const v4u r = *(const v4u*)(x2b + (size_t)tok * D + col0 + bj * 128);
                        o0[0] += bflo(r.x); o0[1] += bfhi(r.x); o0[2] += bflo(r.y); o0[3] += bfhi(r.y); o1[0] += bflo(r.z); o1[1] += bfhi(r.z); o1[2] += bflo(r.w); o1[3] += bfhi(r.w); }
                    sq += ((o0[0] * o0[0] + o0[1] * o0[1]) + (o0[2] * o0[2] + o0[3] * o0[3])) + ((o1[0] * o1[0] + o1[1] * o1[1]) + (o1[2] * o1[2] + o1[3] * o1[3])); }
                sq += __shfl_xor(sq, 16); sq += __shfl_xor(sq, 32);
                if (fq == 0) P[rl * 4 + wc] = sq;
                asm volatile("" ::: "memory"); }
        asm volatile("s_waitcnt lgkmcnt(0)" ::: "memory"); __builtin_amdgcn_s_barrier(); asm volatile("" ::: "memory");
        if (tid < 256) { const f32x4 p = *(const LAS f32x4*)(P + tid * 4);
            __hip_atomic_store(xch + ((size_t)u.pm * 256 + tid) * 4 + u.aux, (p[0] + p[1]) + (p[2] + p[3]), __ATOMIC_RELAXED, __HIP_MEMORY_SCOPE_AGENT); }
        asm volatile("s_waitcnt vmcnt(0)" ::: "memory");
        if (wid < 4 && lane == 0) __hip_atomic_fetch_add(cnt + 64 * u.pm, 1u, __ATOMIC_RELAXED, __HIP_MEMORY_SCOPE_AGENT);
        if (wid == 0) { unsigned spins = 0;
            while ((unsigned)__builtin_amdgcn_readfirstlane(__hip_atomic_load(cnt + 64 * u.pm, __ATOMIC_RELAXED, __HIP_MEMORY_SCOPE_AGENT)) < 16u) { __builtin_amdgcn_s_sleep(2); if (++spins > (1u << 22)) break; }
            __builtin_amdgcn_fence(__ATOMIC_ACQUIRE, "agent");
            if (lane == 0) flag[0] = spins; }
        asm volatile("s_waitcnt vmcnt(0) lgkmcnt(0)" ::: "memory"); __builtin_amdgcn_s_barrier(); asm volatile("" ::: "memory");
        if (tid < 256) { const float* sl = xch + ((size_t)u.pm * 256 + tid) * 4; float t = 0.f;
#pragma unroll
            for (int k = 0; k < 4; ++k) t += __hip_atomic_load(sl + k, __ATOMIC_RELAXED, __HIP_MEMORY_SCOPE_AGENT);
            S[tid] = 1.0f / sqrtf(t * (1.0f / D) + EPSN); }
        asm volatile("s_waitcnt lgkmcnt(0)" ::: "memory"); __builtin_amdgcn_s_barrier(); asm volatile("" ::: "memory");
#pragma unroll
        for (int ai = 0; ai < 2; ++ai)
#pragma unroll
            for (int m = 0; m < 4; ++m) { const int rl = rb + ai * 128 + m * 16; const int tok = tokmap[u.pm * 256 + rl]; const float rs = S[rl];
                if (tok >= 0) {
#pragma unroll
                    for (int bj = 0; bj < 2; ++bj)
#pragma unroll
                        for (int n = 0; n < 2; ++n) { const int cc = col0 + bj * 128 + 4 * n; acc[ai][bj][m][n] = acc[ai][bj][m][n] * rs; acc[ai][bj][m][n] = acc[ai][bj][m][n] * *(const f32x4*)(gfin + cc);
                            *(f32x4*)(out + (size_t)tok * D + cc) = acc[ai][bj][m][n]; asm volatile("" ::: "memory"); } } }
    }
};
__device__ __forceinline__ void p10_final(const Args& A, float* outp, int lane, int wave) {
    const float* g_final = (const float*)(A.ws + WS_PAR) + PAR_GFIN;
    const int G = gridDim.x, gw = blockIdx.x * NWAVES + wave, NGW = G * NWAVES;
    f32x4 gv[4];
#pragma unroll
    for (int j = 0; j < 4; ++j) gv[j] = *((const f32x4*)g_final + lane + 64 * j);
    for (int m = gw; m < T; m += NGW) {
        f32x4* xr = (f32x4*)(A.out + (size_t)m * D) + lane;
        f32x4 v[4]; float s = 0.f;
#pragma unroll
        for (int j = 0; j < 4; ++j) { v[j] = xr[64 * j]; s += (v[j].x * v[j].x + v[j].y * v[j].y) + (v[j].z * v[j].z + v[j].w * v[j].w); }
        const float rstd = 1.0f / sqrtf(wave_sum(s) * (1.0f / D) + EPSN);
#pragma unroll
        for (int j = 0; j < 4; ++j) ((f32x4*)(outp + (size_t)m * D) + lane)[64 * j] = v[j] * rstd * gv[j];
    }
}

#ifndef MS
#define MS 4
#endif
#ifndef N_LAUNCHES
#define N_LAUNCHES 1
#endif
constexpr int N_PHASES = 14;
#ifndef STAGGER
#define STAGGER 0
#endif
#ifndef FUSE_FINAL
#define FUSE_FINAL 1
#endif
#ifndef DUP_MASK
#define DUP_MASK 0
#endif
#define REP(k) for (int rep_ = 0; rep_ < (((DUP_MASK >> (k)) & 1) ? 2 : 1); ++rep_)
#ifndef QX_SP2
#define QX_SP2 false
#endif

#ifndef NVG
#define NVG 256
#endif
__global__ void __launch_bounds__(NTHR, 2) __attribute__((amdgpu_num_vgpr(NVG))) fwd_kernel(Args args) {
    __shared__ __attribute__((aligned(16))) unsigned char lds[LDS_BYTES];
    const int tid = threadIdx.x, lane = tid & 63, wave = __builtin_amdgcn_readfirstlane(tid >> 6);
    gu32* ctl = (gu32*)(args.ws + WS_CTL);
    for (int u = tid; u < (LDS_BYTES - LDS_MISC) / 4; u += NTHR) ((unsigned*)(lds + LDS_MISC))[u] = 0u;
    __syncthreads();
    const int lo = args.ph_lo, hi = args.ph_hi;
    const bool use_bar = (hi - lo) > 1;
    XcdBarrier bar; bar.bar = (unsigned*)ctl + CW_BAR; bar.x = 0; bar.st = (volatile LAS unsigned*)(lds + LDS_MISC) + 8;
    if (use_bar) bar = xcd_barrier_post((unsigned*)ctl + CW_BAR, (volatile LAS unsigned*)(lds + LDS_MISC) + 8);
#ifndef PH_MASK
#define PH_MASK 0xFFFF
#endif
#define IN(k) (((PH_MASK >> (k)) & 1) && lo <= (k) && (k) < hi)
#define SEAM(k) do { if (IN(k) && IN((k) + 1)) xcd_barrier(bar); } while (0)
    PG8_LAS unsigned char* ring = (PG8_LAS unsigned char*)lds;
    const int G = gridDim.x;
#define PHASE_PTRS Args pa = args; { unsigned char* w_ = args.ws; float* o_ = args.out; asm volatile("" : "+s"(w_), "+s"(o_)); pa.ws = w_; pa.out = o_; } unsigned char* const ws = pa.ws; (void)ws; int tid = (int)threadIdx.x; asm volatile("" : "+v"(tid)); const int lane = tid & 63; (void)lane

#ifdef DUMMY_LIVE
    float dl0, dl1, dl2, dl3, dl4, dl5, dl6, dl7; asm volatile("" : "=v"(dl0), "=v"(dl1), "=v"(dl2), "=v"(dl3), "=v"(dl4), "=v"(dl5), "=v"(dl6), "=v"(dl7));
#endif
    if (IN(0)) { PHASE_PTRS; REP(0) { p0_prologue(pa, lds, tid, lane, wave); __syncthreads(); } }
    SEAM(0);
    if (IN(1) && MS >= 1) { PHASE_PTRS;
        pg8::Gemm g{(const pg8::bf16_t*)(ws + WS_XN), (const pg8::bf16_t*)(ws + WS_WIN), T, NIN, D};
        pg8::StaticOrder S; S.init(T, NIN, G, (int)blockIdx.x);
        EpiInProj E{(bf16*)(ws + WS_Q), (const float*)(ws + WS_ROPE)};
        REP(1) pg8::gemm_phase<EpiInProj, pg8::StaticOrder, true, true>(ring, g, S, E);
    }
    SEAM(1);
    if (IN(2) && MS >= 1) { PHASE_PTRS;
        const int n_att = (MS >= 2) ? 3 * 4096 : 0;
        for (int tile = blockIdx.x; tile < 256; tile += G) kv_tile(pa, lds, tile, tid, lane, wave);
        __syncthreads();
        REP(14) attn_phase(pa, lds, n_att, lane, wave);
        { int wres = -1; MGroup mg; __syncthreads(); for (int it = blockIdx.x * 8; it < 2048; it += G * 8) for (int q = 0; q < 8; ++q) mlstm_p1_item(pa, lds, it + q, wres, mg, tid, lane, wave); }
    }
    if (IN(2) && IN(4)) xcd_barrier(bar);
    if (IN(4) && MS >= 1) { PHASE_PTRS;
        for (int rt = blockIdx.x; rt < T / 256; rt += G) combine_rows(pa, (size_t)rt * 256, 256, tid);
        for (int it = blockIdx.x * 8; it < 2048; it += G * 8) { MState st; mlstm2_entry(pa, it >> 6, (it & 63) >> 3, st, lane, wave);
            for (int q = 0; q < 8; ++q) mlstm_p2_item(pa, lds, it + q, st, tid, lane, wave); }
    }
    SEAM(4);
    if (IN(5) && MS >= 1) { PHASE_PTRS;
        const int pm = (int)blockIdx.x;
        if (pm < T / 256) {
            { pg8::Gemm g{(const pg8::bf16_t*)(ws + WS_Y), (const pg8::bf16_t*)(ws + WS_WOUT), T, D, D};
              FixedOrder S{pm, 4}; EpiOutProj E{(const float*)pa.in[0], (bf16*)(ws + WS_X1B), (float*)(ws + WS_SS1)};
              pg8::gemm_phase<EpiOutProj, FixedOrder, true, true>(ring, g, S, E); }
            VM_WAIT(); __syncthreads();
            float* rs = (float*)(lds + LDS_RS);
            if (tid < 256) { const f32x4* sp = (const f32x4*)((const float*)(ws + WS_SS1) + (size_t)(pm * 256 + tid) * 16);
                const f32x4 a = sp[0], b = sp[1], c = sp[2], d = sp[3];
                const float s = ((a[0] + a[1]) + (a[2] + a[3])) + ((b[0] + b[1]) + (b[2] + b[3])) + ((c[0] + c[1]) + (c[2] + c[3])) + ((d[0] + d[1]) + (d[2] + d[3]));
                rs[tid] = 1.0f / sqrtf(s * (1.0f / D) + EPSN); }
            __syncthreads();
            { pg8::Gemm g{(const pg8::bf16_t*)(ws + WS_X1B), (const pg8::bf16_t*)(ws + WS_WQX), T, 256, D};
              FixedOrder S{pm, 1}; EpiQx E{(bf16*)(ws + WS_QX), (const LAS float*)rs};
              pg8::gemm_phase<EpiQx, FixedOrder, true, QX_SP2>(ring, g, S, E); }
            VM_WAIT(); __syncthreads();
            cross_unit(pa, lds, pm, tid, lane, wave);
            { int kdyn = 256; asm volatile("" : "+s"(kdyn));
              pg8::Gemm g{(const pg8::bf16_t*)(ws + WS_OX), (const pg8::bf16_t*)(ws + WS_WOX), T, D, kdyn};
              FixedOrder S{pm, 4}; EpiOx E{(const bf16*)(ws + WS_X1B), (bf16*)(ws + WS_HBS)};
              pg8::gemm_phase<EpiOx, FixedOrder, false, false>(ring, g, S, E); }
            VM_WAIT(); __builtin_amdgcn_fence(__ATOMIC_ACQUIRE, "agent"); VM_WAIT(); __syncthreads();
        }
        if (MS >= 4) p9_route(pa, lds, tid, lane, wave);
    }
    SEAM(9);
    if (IN(10) && MS >= 4) { PHASE_PTRS; p10_slots(pa, lds, tid, lane, wave); }
    SEAM(10);
    if ((IN(11) || IN(12)) && MS >= 4) { PHASE_PTRS;
        int* tab = (int*)(lds + LDS_TAB);
        if (tid == 0) { int nrt = 0; const unsigned* cnt = (const unsigned*)(ws + WS_CTL) + CW_CNT;
            for (int i = 0; i < NBUCKET; ++i) { const int nt = (int)((__hip_atomic_load(cnt + i, __ATOMIC_RELAXED, __HIP_MEMORY_SCOPE_AGENT) + 255u) >> 8); for (int k = 0; k < nt; ++k) tab[1 + nrt++] = i; }
            tab[0] = nrt; }
        __syncthreads();
        const int nrt = tab[0];
        if (IN(11)) {
            if (STAGGER && ((blockIdx.x >> 2) & 1)) { for (int i = 0; i < STAGGER; ++i) __builtin_amdgcn_s_sleep(127); }
            pg8::Gemm g{(const pg8::bf16_t*)(ws + WS_HBS), (const pg8::bf16_t*)(ws + WS_W13), ROWS_MAX, 64 * 256, D, (const int*)(ws + WS_TOKMAP)};
            MoeOrder S{G, (int)blockIdx.x, nrt * 8, 8, tab + 1};
            EpiUp E{(bf16*)(ws + WS_ACT), (const float*)(ws + WS_WSORT)};
            REP(11) pg8::gemm_phase<EpiUp, MoeOrder, true, true, true>(ring, g, S, E);
        }
        SEAM(11);
        if (IN(12)) {
            pg8::Gemm g{(const pg8::bf16_t*)(ws + WS_ACT), (const pg8::bf16_t*)(ws + WS_W2P), ROWS_MAX, 96 * 256, D};
            MoeOrder S{G, (int)blockIdx.x, nrt * 4, 4, tab + 1};
#if FUSE_FINAL
            EpiDownNorm E{(const bf16*)(ws + WS_HBS), pa.out, (const int*)(ws + WS_TOKMAP), (const float*)(ws + WS_PAR) + PAR_GFIN, (float*)(ws + WS_XCH), (unsigned*)(ws + WS_CTL) + CW_SEAM, (LAS unsigned char*)(lds + LDS_EX)};
            pg8::gemm_phase<EpiDownNorm, MoeOrder, true, true>(ring, g, S, E);
#else
            EpiDown E{(const bf16*)(ws + WS_HBS), pa.out, (const int*)(ws + WS_TOKMAP)};
            REP(12) pg8::gemm_phase<EpiDown, MoeOrder, true, true>(ring, g, S, E);
#endif
        }
    }
    if (!FUSE_FINAL) SEAM(12);
    if (IN(13) && !FUSE_FINAL) { PHASE_PTRS; REP(13) p10_final(pa, (((DUP_MASK >> 13) & 1) && rep_ == 0) ? (float*)(ws + 544 * MiB) : pa.out, lane, wave); }
#ifdef DUMMY_LIVE
    asm volatile("" :: "v"(dl0), "v"(dl1), "v"(dl2), "v"(dl3), "v"(dl4), "v"(dl5), "v"(dl6), "v"(dl7));
#endif
#undef IN
#undef SEAM
}

extern "C" void kernel_launch(void* const* d_in, const int* in_sizes, int n_in, void* d_out, int out_size, void* d_ws, size_t ws_size, hipStream_t stream) {
    static int grid = 0;
    if (grid == 0) {
        if (n_in != 28 || out_size != T * D || ws_size < WS_END) { fprintf(stderr, "kernel_launch: unexpected problem (n_in %d, out %d, ws %zu)\n", n_in, out_size, ws_size); grid = -1; return; }
        int dev = 0, cus = 0, per_cu = 0;
        if (hipGetDevice(&dev) != hipSuccess || hipDeviceGetAttribute(&cus, hipDeviceAttributeMultiprocessorCount, dev) != hipSuccess) { grid = -1; return; }
        if (hipOccupancyMaxActiveBlocksPerMultiprocessor(&per_cu, (const void*)fwd_kernel, NTHR, 0) != hipSuccess || per_cu < 1) { fprintf(stderr, "kernel_launch: occupancy query failed (%d)\n", per_cu); per_cu = 1; }
        (void)hipGetLastError();
        grid = cus * (per_cu > 1 ? 1 : per_cu);
        if (grid > 256) grid = 256;
    }
    if (grid < 0) return;
    (void)hipMemsetAsync((char*)d_ws + WS_CTL, 0, CTL_ZERO_BYTES, stream);
    Args a{};
    for (int i = 0; i < 28; ++i) a.in[i] = d_in[i];
    a.out = (float*)d_out; a.ws = (unsigned char*)d_ws;
    if (N_LAUNCHES == 1) {
        a.ph_lo = 0; a.ph_hi = N_PHASES;
        void* kargs[] = {&a};
        hipError_t e = hipLaunchCooperativeKernel((const void*)fwd_kernel, dim3(grid), dim3(NTHR), kargs, 0, stream);
        if (e != hipSuccess) fprintf(stderr, "kernel_launch: cooperative launch failed: %s (grid %d)\n", hipGetErrorString(e), grid);
    } else {
        for (int p = 0; p < N_PHASES; ++p) { a.ph_lo = p; a.ph_hi = p + 1; hipLaunchKernelGGL(fwd_kernel, dim3(grid), dim3(NTHR), 0, stream, a); }
    }
}
```

```cpp
#include <hip/hip_runtime.h>
#include <cstdio>
#include <cstdint>
namespace pg8 {
#define PG8_LAS __attribute__((address_space(3)))
typedef unsigned short bf16_t;
typedef short bf16x8 __attribute__((ext_vector_type(8)));
typedef float f32x4 __attribute__((ext_vector_type(4)));
typedef unsigned u32x4 __attribute__((ext_vector_type(4)));
constexpr int BM = 256, BK = 64, HALF = 128, HTB = HALF * BK * 2  , STAGE_BYTES = 8 * HTB, NXCD = 8, WGM = 8;

__host__ __device__ __forceinline__ int lds_byte(int r, int c) { const int st = (r >> 4) * 2 + (c >> 5), rr = r & 15, cc = c & 31, ob = rr * 64 + cc * 2; return st * 1024 + (ob ^ (((ob >> 9) & 1) << 5)); }
__host__ __device__ __forceinline__ void stage_rc(int b, int& R, int& C) { const int st = b / 1024, sb = b % 1024, swz = sb ^ (((sb >> 9) & 1) << 5); R = (st >> 1) * 16 + swz / 64; C = (st & 1) * 32 + (swz % 64) / 2; }
__host__ __device__ __forceinline__ int perm32(int rho) { const int n = rho >> 4, i = rho & 15; return 8 * (i >> 2) + 4 * n + (i & 3); }

struct Unit { int pm, pn, aux; };
struct Gemm { const bf16_t* A; const bf16_t* Bt; int M, N, K; const int* rowmap; };

struct StaticOrder {
    int nM, nN, nwg, G, c;
    __host__ __device__ __forceinline__ void init(int M, int N, int G_, int c_) { nM = M / BM; nN = N / BM; nwg = nM * nN; G = G_; c = c_; }
    __host__ __device__ __forceinline__ bool next(int i, Unit& u) const {
        const long L = (long)i * G + c; if (L >= nwg) return false;
        int wgid = (int)L; { const int q = nwg / NXCD, r = nwg % NXCD, xcd = wgid % NXCD, off = wgid / NXCD; wgid = (xcd < r ? xcd * (q + 1) : r * (q + 1) + (xcd - r) * q) + off; }
        const int nig = WGM * nN, gid = wgid / nig, fm = gid * WGM, gsz = (nM - fm) < WGM ? (nM - fm) : WGM;
        u.pm = fm + ((wgid % nig) % gsz); u.pn = (wgid % nig) / gsz; u.aux = 0; return true;
    }
    __device__ __forceinline__ void a_ready(const Unit&) const {}
    __device__ __forceinline__ void done(const Unit&) const {}
};

__device__ __forceinline__ unsigned cvt_pk_bf16(float lo, float hi) { unsigned r; asm volatile("v_cvt_pk_bf16_f32 %0, %1, %2" : "=v"(r) : "v"(lo), "v"(hi)); return r; }
template <class Epi, class Sched, bool ALIGN_EPI = false, bool SP2 = false, bool GATHER = false>
__device__ __forceinline__ void gemm_phase(PG8_LAS unsigned char* lds, const Gemm g, const Sched& S, const Epi& E) {
    int tid = threadIdx.x; asm volatile("" : "+v"(tid));
    const int wid = __builtin_amdgcn_readfirstlane(tid >> 6), lane = tid & 63, wr = wid >> 2, wc = wid & 3, fr = lane & 15, fq = lane >> 4;
    const int K = g.K, nt = K / BK;
    unsigned voffA[2], voffB[2];
#pragma unroll
    for (int i = 0; i < 2; ++i) { int R, C; stage_rc(tid * 16 + i * 8192, R, C); const int Rb = Epi::PERM ? ((R & ~31) + perm32(R & 31)) : R;
        voffA[i] = (unsigned)(R * K + C) * 2u; voffB[i] = (unsigned)(Rb * K + C) * 2u; }
    unsigned gc[2][2] = {{0u, 0u}, {0u, 0u}}, gn[2][2] = {{0u, 0u}, {0u, 0u}};
#define PG8_GLOAD(gv, pm_) do { _Pragma("unroll") for (int _h = 0; _h < 2; ++_h) _Pragma("unroll") for (int _i = 0; _i < 2; ++_i) { int _R, _C; stage_rc(tid * 16 + _i * 8192, _R, _C); \
        int _row = g.rowmap[(pm_) * BM + _h * HALF + _R]; _row = _row < 0 ? 0 : _row; gv[_h][_i] = (unsigned)(_row * K + _C) * 2u; } } while (0)
    const size_t kstep = (size_t)(BK * 2);
    const size_t hstep = (size_t)HALF * K * 2;
    const size_t tstep = 2 * hstep;
    const unsigned ldsw = (unsigned)wid * 1024u;
    const int aoff = lds_byte(wr * 64 + fr, fq * 8), boff = lds_byte(wc * 32 + fr, fq * 8);
#define PG8_SA(b, h) (((b) * 2 + (h)) * HTB)
#define PG8_SB(b, h) ((4 + (b) * 2 + (h)) * HTB)
#define PG8_STAGE(bufoff, gbase, voff) do { _Pragma("unroll") for (int _i = 0; _i < 2; ++_i) \
        __builtin_amdgcn_global_load_lds((const unsigned*)((const char*)(gbase) + (voff)[_i]), (PG8_LAS unsigned*)(lds + (bufoff) + ldsw + _i * 8192), 16, 0, 0); } while (0)
#define PG8_STAGE_A(bufoff, gbase, h, sel) do { if constexpr (GATHER) { unsigned vo_[2]; vo_[0] = (sel) ? gn[h][0] : gc[h][0]; vo_[1] = (sel) ? gn[h][1] : gc[h][1]; PG8_STAGE(bufoff, gbase, vo_); } \
        else { PG8_STAGE(bufoff, (gbase) + (h) * hstep, voffA); } } while (0)
#define PG8_LDA(dst, b, h) do { _Pragma("unroll") for (int m = 0; m < 4; ++m) _Pragma("unroll") for (int k = 0; k < 2; ++k) dst[m][k] = *(const PG8_LAS bf16x8*)(lds + PG8_SA(b, h) + aoff + m * 2048 + k * 1024); } while (0)
#define PG8_LDB(dst, b, h) do { _Pragma("unroll") for (int n = 0; n < 2; ++n) _Pragma("unroll") for (int k = 0; k < 2; ++k) dst[n][k] = *(const PG8_LAS bf16x8*)(lds + PG8_SB(b, h) + boff + n * 2048 + k * 1024); } while (0)
#define PG8_MMA(ai, bj, At, Bt) do { __builtin_amdgcn_s_setprio(1); _Pragma("unroll") for (int m = 0; m < 4; ++m) _Pragma("unroll") for (int n = 0; n < 2; ++n) _Pragma("unroll") for (int k = 0; k < 2; ++k) \
        acc[ai][bj][m][n] = __builtin_amdgcn_mfma_f32_16x16x32_bf16(Bt[n][k], At[m][k], acc[ai][bj][m][n], 0, 0, 0); __builtin_amdgcn_s_setprio(0); } while (0)
#define PG8_WAIT_V(n) asm volatile("s_waitcnt vmcnt(" #n ")" ::: "memory")
#define PG8_WAIT_L(n) asm volatile("s_waitcnt lgkmcnt(" #n ")" ::: "memory")
#define PG8_BAR __builtin_amdgcn_s_barrier()
#define PG8_SCHED __builtin_amdgcn_sched_barrier(0)
    Unit cur, nxt; int ui = 0;
    if (!S.next(0, cur)) return;
    f32x4 acc[2][2][4][2];
#pragma unroll
    for (int a = 0; a < 2; ++a)
#pragma unroll
        for (int b = 0; b < 2; ++b)
#pragma unroll
            for (int m = 0; m < 4; ++m)
#pragma unroll
                for (int n = 0; n < 2; ++n) acc[a][b][m][n] = (f32x4){0.f, 0.f, 0.f, 0.f};
    bf16x8 At[4][2], B0[2][2], B1[2][2];
    const char* cA = GATHER ? (const char*)g.A : (const char*)g.A + (size_t)cur.pm * tstep; const char* cB = (const char*)g.Bt + (size_t)cur.pn * tstep;
    if constexpr (GATHER) { PG8_GLOAD(gc, cur.pm); }
    S.a_ready(cur);
    if constexpr (SP2) {
        PG8_STAGE(PG8_SB(0, 0), cB, voffB); PG8_STAGE(PG8_SB(0, 1), cB + hstep, voffB); PG8_STAGE_A(PG8_SA(0, 0), cA, 0, false); PG8_STAGE_A(PG8_SA(0, 1), cA, 1, false);
        if (wr == 1) PG8_BAR;
        PG8_WAIT_V(2); PG8_BAR;
        PG8_STAGE(PG8_SB(1, 0), cB + kstep, voffB); PG8_STAGE_A(PG8_SA(1, 0), cA + kstep, 0, false); PG8_STAGE(PG8_SB(1, 1), cB + hstep + kstep, voffB);
        PG8_WAIT_V(6); PG8_BAR;
    } else {
        PG8_STAGE(PG8_SB(0, 0), cB, voffB); PG8_STAGE_A(PG8_SA(0, 0), cA, 0, false); PG8_STAGE(PG8_SB(0, 1), cB + hstep, voffB); PG8_STAGE_A(PG8_SA(0, 1), cA, 1, false);
        if (wr == 1) PG8_BAR;
        PG8_WAIT_V(4); PG8_BAR;
        PG8_STAGE(PG8_SB(1, 0), cB + kstep, voffB); PG8_STAGE_A(PG8_SA(1, 0), cA + kstep, 0, false); PG8_STAGE(PG8_SB(1, 1), cB + hstep + kstep, voffB);
        PG8_WAIT_V(6); PG8_BAR;
    }
    for (;;) {
        const bool has_next = S.next(ui + 1, nxt);
        const char* nA = GATHER ? cA : (has_next ? (const char*)g.A + (size_t)nxt.pm * tstep : cA);
        if constexpr (GATHER) { if (has_next) { PG8_GLOAD(gn, nxt.pm); } else { gn[0][0] = gc[0][0]; gn[0][1] = gc[0][1]; gn[1][0] = gc[1][0]; gn[1][1] = gc[1][1]; } }
        const char* nB = has_next ? (const char*)g.Bt + (size_t)nxt.pn * tstep : cB;
        for (int t = 0; t < nt; t += 2) {
            const bool last = (t == nt - 2);
            const char* a1 = cA + (size_t)(t + 1) * kstep;
            const char* a2 = last ? nA : cA + (size_t)(t + 2) * kstep; const char* b2 = last ? nB : cB + (size_t)(t + 2) * kstep;
            const char* a3 = a2 + kstep; const char* b3 = b2 + kstep;
            if (last && has_next) S.a_ready(nxt);
            if constexpr (SP2) {
            PG8_LDB(B0, 0, 0); PG8_LDB(B1, 0, 1); PG8_SCHED; PG8_LDA(At, 0, 0); PG8_STAGE_A(PG8_SA(1, 1), a1, 1, false);
            PG8_WAIT_V(8); PG8_WAIT_L(0); PG8_BAR; PG8_MMA(0, 0, At, B0); PG8_MMA(0, 1, At, B1); PG8_BAR; PG8_SCHED;
            PG8_LDA(At, 0, 1); PG8_STAGE(PG8_SB(0, 0), b2, voffB); PG8_STAGE(PG8_SB(0, 1), b2 + hstep, voffB); PG8_STAGE_A(PG8_SA(0, 0), a2, 0, last);
            PG8_WAIT_V(8); PG8_WAIT_L(0); PG8_BAR; PG8_MMA(1, 0, At, B0); PG8_MMA(1, 1, At, B1); PG8_BAR; PG8_SCHED;
            PG8_LDB(B0, 1, 0); PG8_LDB(B1, 1, 1); PG8_SCHED; PG8_LDA(At, 1, 0); PG8_STAGE_A(PG8_SA(0, 1), a2, 1, last);
            PG8_WAIT_V(8); PG8_WAIT_L(0); PG8_BAR; PG8_MMA(0, 0, At, B0); PG8_MMA(0, 1, At, B1); PG8_BAR; PG8_SCHED;
            PG8_LDA(At, 1, 1); PG8_STAGE(PG8_SB(1, 0), b3, voffB); PG8_STAGE(PG8_SB(1, 1), b3 + hstep, voffB); PG8_STAGE_A(PG8_SA(1, 0), a3, 0, last);
            PG8_WAIT_V(8); PG8_WAIT_L(0); PG8_BAR; PG8_MMA(1, 0, At, B0); PG8_MMA(1, 1, At, B1); PG8_BAR; PG8_SCHED;
            } else {
            PG8_LDB(B0, 0, 0); PG8_SCHED; PG8_LDA(At, 0, 0); PG8_STAGE_A(PG8_SA(1, 1), a1, 1, false);
            PG8_WAIT_L(8); PG8_BAR; PG8_WAIT_L(0); PG8_MMA(0, 0, At, B0); PG8_BAR; PG8_SCHED;
            PG8_LDB(B1, 0, 1); PG8_STAGE(PG8_SB(0, 0), b2, voffB);
            PG8_BAR; PG8_WAIT_L(0); PG8_MMA(0, 1, At, B1); PG8_BAR;
            PG8_LDA(At, 0, 1); PG8_STAGE_A(PG8_SA(0, 0), a2, 0, last);
            PG8_BAR; PG8_WAIT_L(0); PG8_MMA(1, 0, At, B0); PG8_BAR; PG8_SCHED;
            PG8_STAGE(PG8_SB(0, 1), b2 + hstep, voffB);
            PG8_WAIT_V(6); PG8_BAR; PG8_MMA(1, 1, At, B1); PG8_BAR;
            PG8_LDB(B0, 1, 0); PG8_SCHED; PG8_LDA(At, 1, 0); PG8_STAGE_A(PG8_SA(0, 1), a2, 1, last);
            PG8_WAIT_L(8); PG8_BAR; PG8_WAIT_L(0); PG8_MMA(0, 0, At, B0); PG8_BAR; PG8_SCHED;
            PG8_LDB(B1, 1, 1); PG8_STAGE(PG8_SB(1, 0), b3, voffB);
            PG8_BAR; PG8_WAIT_L(0); PG8_MMA(0, 1, At, B1); PG8_BAR;
            PG8_LDA(At, 1, 1); PG8_STAGE_A(PG8_SA(1, 0), a3, 0, last);
            PG8_BAR; PG8_WAIT_L(0); PG8_MMA(1, 0, At, B0); PG8_BAR; PG8_SCHED;
            PG8_STAGE(PG8_SB(1, 1), b3 + hstep, voffB);
            PG8_WAIT_V(6); PG8_BAR; PG8_MMA(1, 1, At, B1); PG8_BAR;
            }
        }
        if constexpr (ALIGN_EPI) { if (wr == 0) PG8_BAR; }
        if constexpr (!Epi::AFTER_DRAIN) { E(acc, cur, wr, wc, fr, fq); S.done(cur); }
        if (!has_next) break;
#pragma unroll
        for (int a = 0; a < 2; ++a)
#pragma unroll
            for (int b = 0; b < 2; ++b)
#pragma unroll
                for (int m = 0; m < 4; ++m)
#pragma unroll
                    for (int n = 0; n < 2; ++n) acc[a][b][m][n] = (f32x4){0.f, 0.f, 0.f, 0.f};
        cur = nxt; cA = nA; cB = nB; ++ui;
        if constexpr (GATHER) { gc[0][0] = gn[0][0]; gc[0][1] = gn[0][1]; gc[1][0] = gn[1][0]; gc[1][1] = gn[1][1]; }
        if constexpr (ALIGN_EPI) { if (wr == 1) PG8_BAR; }
    }
    PG8_WAIT_V(0);
    if constexpr (!ALIGN_EPI) { if (wr == 0) PG8_BAR; }
    PG8_BAR;
    if constexpr (Epi::AFTER_DRAIN) { E.fused(acc, cur, wr, wc, fr, fq, lds, wid, lane); S.done(cur); }
#undef PG8_SA
#undef PG8_SB
#undef PG8_STAGE
#undef PG8_STAGE_A
#undef PG8_GLOAD
#undef PG8_LDA
#undef PG8_LDB
#undef PG8_MMA
#undef PG8_WAIT_V
#undef PG8_WAIT_L
#undef PG8_BAR
#undef PG8_SCHED
}
}

#define GAS __attribute__((address_space(1)))
#define LAS __attribute__((address_space(3)))
typedef unsigned short bf16;
typedef unsigned v4u __attribute__((ext_vector_type(4)));
typedef unsigned v2u __attribute__((ext_vector_type(2)));
typedef float f32x4 __attribute__((ext_vector_type(4)));
typedef short bf16x8 __attribute__((ext_vector_type(8)));
typedef GAS unsigned gu32;

constexpr int NWAVES = 8, NTHR = 512;
constexpr int BATCH = 8, SEQ = 8192, T = BATCH * SEQ, D = 1024, MEMLEN = 256, TMEM = BATCH * MEMLEN;
constexpr int INW = 3080, NIN = 3072, NKV = 512;
constexpr int NBUCKET = 24, ROWS_MAX = T + NBUCKET * 256;
constexpr float EPSN = 1e-6f;
constexpr float C2 = 0.125f * 1.4426950408889634f;
constexpr float LOG2E = 1.4426950408889634f;

constexpr size_t MiB = 1u << 20;
constexpr size_t WS_CTL = 0, CTL_ZERO_BYTES = 1 * MiB;
constexpr size_t WS_ROPE = 2 * MiB;
constexpr size_t WS_IG = 6 * MiB;
constexpr size_t WS_FG = 7 * MiB;
constexpr size_t WS_LSE = 8 * MiB;
constexpr size_t WS_SS1 = 14 * MiB;
constexpr size_t WS_SS3 = 18 * MiB;
constexpr size_t WS_KVX = 22 * MiB;
constexpr size_t WS_NLOC = 24 * MiB;
constexpr size_t WS_NPREV = 25 * MiB;
constexpr size_t WS_MLOC = 26 * MiB;
constexpr size_t WS_BLAST = 26 * MiB + 64 * 1024;
constexpr size_t WS_MPREV = 26 * MiB + 128 * 1024;
constexpr size_t WS_TOKINFO = 27 * MiB;
constexpr size_t WS_TOKMAP = 28 * MiB;
constexpr size_t WS_WSORT = 19 * MiB;
constexpr size_t WS_WR = 30 * MiB;
constexpr size_t WS_WG = 30 * MiB + 512 * 1024;
constexpr size_t WS_PAR = 31 * MiB;
constexpr int PAR_CONVW = 0, PAR_CONVB = 2048, PAR_GMHN = 2560, PAR_SKIP = 3072, PAR_BRG = 3584, PAR_BRE = 3600, PAR_GFIN = 3616, PAR_N = 4640;
constexpr size_t WS_WIN = 32 * MiB;
constexpr size_t WS_WOUT = 39 * MiB;
constexpr size_t WS_WQX = 41 * MiB;
constexpr size_t WS_WOX = 41 * MiB + 512 * 1024;
constexpr size_t WS_WM = 42 * MiB;
constexpr size_t WS_W13 = 44 * MiB;
constexpr size_t WS_W2P = 76 * MiB;
constexpr size_t WS_XN = 128 * MiB;
constexpr size_t WS_CLOC = 128 * MiB;
constexpr size_t WS_GAGG = 192 * MiB;
constexpr size_t WS_GN = 200 * MiB;
constexpr size_t WS_GSC = 200 * MiB + 512 * 1024;
constexpr size_t WS_Q = 264 * MiB;
constexpr size_t WS_K = 328 * MiB, WS_V = 392 * MiB, WS_MU = 456 * MiB, WS_MV = 520 * MiB, WS_MO = 584 * MiB;
constexpr size_t WS_MQ = 648 * MiB, WS_MK = 712 * MiB;
constexpr size_t WS_Y = 264 * MiB;
constexpr size_t WS_CPREV = 392 * MiB;
constexpr size_t WS_X1B = 648 * MiB;
constexpr size_t WS_QX = 776 * MiB;
constexpr size_t WS_OX = 808 * MiB;
constexpr size_t WS_HBS = 264 * MiB;
constexpr size_t WS_ACT = 404 * MiB;
constexpr size_t WS_END = 840 * MiB;
constexpr size_t DO_OATT = 0, DO_C = 192 * MiB;

constexpr int CW_BAR = 4096;
constexpr int CW_CNT = 8192;
constexpr int CW_FILL = 8192 + 64;

constexpr int LDS_BYTES = 163840;
constexpr int LDS_MISC = 159744;
constexpr int LDS_RS = 135168;
constexpr int LDS_TAB = 136192;

#define LDS_WAIT() asm volatile("s_waitcnt lgkmcnt(0)" ::: "memory")
#define VM_WAIT() asm volatile("s_waitcnt vmcnt(0)" ::: "memory")
__device__ __forceinline__ unsigned f2bf(float f) { unsigned u = __builtin_bit_cast(unsigned, f); return (u + 0x7fffu + ((u >> 16) & 1u)) >> 16; }
typedef float f32x2_t __attribute__((ext_vector_type(2))); typedef __bf16 bf16x2_t __attribute__((ext_vector_type(2)));
__device__ __forceinline__ unsigned pk2(float lo, float hi) { f32x2_t v = {lo, hi}; bf16x2_t b = __builtin_convertvector(v, bf16x2_t); return __builtin_bit_cast(unsigned, b); }
__device__ __forceinline__ float bf2f(unsigned h) { return __uint_as_float(h << 16); }
__device__ __forceinline__ float bflo(unsigned w) { return __uint_as_float(w << 16); }
__device__ __forceinline__ float bfhi(unsigned w) { return __uint_as_float(w & 0xffff0000u); }
__device__ __forceinline__ float wave_sum(float v) {
#pragma unroll
    for (int o = 1; o < 64; o <<= 1) v += __shfl_xor(v, o);
    return v;
}
__device__ __forceinline__ float wave_max(float v) {
#pragma unroll
    for (int o = 1; o < 64; o <<= 1) v = fmaxf(v, __shfl_xor(v, o));
    return v;
}
__device__ __forceinline__ float fexp_(float x) { return __builtin_amdgcn_exp2f(x * 1.4426950408889634f); }
__device__ __forceinline__ float frcp_(float x) { return __builtin_amdgcn_rcpf(x); }
__device__ __forceinline__ float sigmoidf_(float x) { return __builtin_amdgcn_rcpf(1.0f + __builtin_amdgcn_exp2f(x * -1.4426950408889634f)); }

#define XB_TMO      128
#define XB_XCNT(j)  (256  + 64 * (j))
#define XB_XSUB(j)  (1280 + 64 * (j))
#define XB_XGEN(j)  (2304 + 64 * (j))
#define XB_TOP      3328
#define XB_TOPGEN   3392
#define XCD_BAR_WORDS 3456
#define XB_SPIN_CAP (1u << 22)
__device__ __forceinline__ unsigned xb_ld(unsigned* p)              { return __hip_atomic_load(p, __ATOMIC_RELAXED, __HIP_MEMORY_SCOPE_AGENT); }
__device__ __forceinline__ unsigned xb_add(unsigned* p, unsigned v) { return __hip_atomic_fetch_add(p, v, __ATOMIC_RELAXED, __HIP_MEMORY_SCOPE_AGENT); }
__device__ __forceinline__ unsigned xb_xcc_id() { return (unsigned)__builtin_amdgcn_s_getreg((3 << 11) | 20) & 0xFu; }
#define XB_SPIN(cond, bar) do { unsigned _sp = 0; while (cond) { __builtin_amdgcn_s_sleep(1); \
    if ((++_sp & 255u) == 0u) { if (xb_ld(&(bar)[XB_TMO])) break; if (_sp > XB_SPIN_CAP) { atomicAdd(&(bar)[XB_TMO], 1u); break; } } } } while (0)
struct XcdBarrier { unsigned* bar; unsigned x; volatile LAS unsigned* st; };
__device__ __forceinline__ XcdBarrier xcd_barrier_post(unsigned* bar, volatile LAS unsigned* st) {
    XcdBarrier b; b.bar = bar; b.x = xb_xcc_id(); b.st = st;
    if (threadIdx.x == 0) (void)xb_add(&bar[XB_XCNT(b.x)], 1u);
    return b;
}
__device__ __forceinline__ void xcd_barrier_complete(unsigned* bar, unsigned x, unsigned& nloc, unsigned& nx) {
    const unsigned G = gridDim.x * gridDim.y * gridDim.z;
    unsigned sum, cnt, mine, sp = 0u;
    for (;;) {
        sum = 0u; cnt = 0u; mine = 0u;
#pragma unroll
        for (unsigned j = 0; j < 16; ++j) { const unsigned c = xb_ld(&bar[XB_XCNT(j)]); sum += c; cnt += (c > 0u) ? 1u : 0u; mine = (j == x) ? c : mine; }
        if (sum == G) break;
        __builtin_amdgcn_s_sleep(1);
        if ((++sp & 255u) == 0u) { if (xb_ld(&bar[XB_TMO])) break; if (sp > XB_SPIN_CAP) { atomicAdd(&bar[XB_TMO], 1u); break; } }
    }
    nloc = mine > 0u ? mine : 1u; nx = cnt > 0u ? cnt : 1u;
}
__device__ __forceinline__ void xcd_barrier(const XcdBarrier& b) {
    asm volatile("s_waitcnt vmcnt(0)" ::: "memory");
    __syncthreads();
    if (threadIdx.x == 0) {
        unsigned* bar = b.bar;
        __builtin_amdgcn_s_waitcnt(0);
        unsigned nloc = b.st[0], nx = b.st[1];
        if (nloc == 0u) { xcd_barrier_complete(bar, b.x, nloc, nx); b.st[0] = nloc; b.st[1] = nx; }
        const unsigned old = xb_add(&bar[XB_XSUB(b.x)], 1u);
        const unsigned gen = old / nloc;
        if (old + 1u == (gen + 1u) * nloc) {
            __builtin_amdgcn_fence(__ATOMIC_RELEASE, "agent");
            asm volatile("s_waitcnt vmcnt(0)" ::: "memory");
            const unsigned og = xb_add(&bar[XB_TOP], 1u);
            const unsigned tg = og / nx;
            if (og + 1u == (tg + 1u) * nx) xb_add(&bar[XB_TOPGEN], 1u);
            else XB_SPIN(xb_ld(&bar[XB_TOPGEN]) == tg, bar);
            __builtin_amdgcn_fence(__ATOMIC_ACQUIRE, "agent");
            xb_add(&bar[XB_XGEN(b.x)], 1u);
            asm volatile("s_waitcnt vmcnt(0)" ::: "memory");
        } else {
            XB_SPIN(xb_ld(&bar[XB_XGEN(b.x)]) == gen, bar);
            __builtin_amdgcn_fence(__ATOMIC_ACQUIRE, "agent");
            asm volatile("s_waitcnt vmcnt(0)" ::: "memory");
        }
    }
    __syncthreads();
}

struct Args { const void* in[28]; float* out; unsigned char* ws; int ph_lo, ph_hi; };

template <int MI, int NJ>
__device__ __forceinline__ void wave_mma(const bf16* A, int lda, const bf16* Bt, int ldb, int K, f32x4 (&acc)[MI][NJ], int fr, int fq) {
    for (int k0 = 0; k0 < K; k0 += 32) {
        bf16x8 a[MI], b[NJ];
#pragma unroll
        for (int i = 0; i < MI; ++i) a[i] = *(const bf16x8*)(A + (16 * i + fr) * lda + k0 + 8 * fq);
#pragma unroll
        for (int j = 0; j < NJ; ++j) b[j] = *(const bf16x8*)(Bt + (16 * j + fr) * ldb + k0 + 8 * fq);
#pragma unroll
        for (int i = 0; i < MI; ++i)
#pragma unroll
            for (int j = 0; j < NJ; ++j) acc[i][j] = __builtin_amdgcn_mfma_f32_16x16x32_bf16(b[j], a[i], acc[i][j], 0, 0, 0);
    }
}

__device__ __forceinline__ void transpose_item(const float* src, int src_ld, int k0, int n0, bf16* dst, int dst_ld, int dst_row0, int dst_col0,
                                               const float* gain, float scale, LAS float* scr, int lane) {
    f32x4 ld[16];
#pragma unroll
    for (int i = 0; i < 16; ++i) { const int kk = 4 * i + (lane >> 4); ld[i] = *(const f32x4*)(src + (size_t)(k0 + kk) * src_ld + n0 + 4 * (lane & 15)); }
#pragma unroll
    for (int i = 0; i < 16; ++i) { const int kk = 4 * i + (lane >> 4); *(LAS f32x4*)(scr + kk * 64 + 4 * ((lane & 15) ^ ((kk >> 3) & 15))) = ld[i]; }
    const int c = lane & 7;
    f32x4 g0 = (f32x4){scale, scale, scale, scale}, g1 = g0;
    if (gain) { g0 = *(const f32x4*)(gain + k0 + 8 * c) * scale; g1 = *(const f32x4*)(gain + k0 + 8 * c + 4) * scale; }
    LDS_WAIT(); asm volatile("" ::: "memory");
#pragma unroll
    for (int j = 0; j < 8; ++j) { const int n = (lane >> 3) + 8 * j; const LAS float* s = scr + (8 * c) * 64 + 4 * ((n >> 2) ^ c) + (n & 3);
        v4u o; o.x = pk2(s[0 * 64] * g0[0], s[1 * 64] * g0[1]); o.y = pk2(s[2 * 64] * g0[2], s[3 * 64] * g0[3]); o.z = pk2(s[4 * 64] * g1[0], s[5 * 64] * g1[1]); o.w = pk2(s[6 * 64] * g1[2], s[7 * 64] * g1[3]);
        *(v4u*)(dst + (size_t)(dst_row0 + n) * dst_ld + dst_col0 + 8 * c) = o; }
    LDS_WAIT(); asm volatile("" ::: "memory");
}

__device__ __forceinline__ void p0_prologue(const Args& A, unsigned char* lds, int tid, int lane, int wave) {
    unsigned char* ws = A.ws;
    const float* x = (const float*)A.in[0]; const float* mem = (const float*)A.in[1]; const int* positions = (const int*)A.in[2];
    const float* g_mix = (const float*)A.in[3]; const float* w_in = (const float*)A.in[4];
    const float* w_q_m = (const float*)A.in[7]; const float* w_k_m = (const float*)A.in[8];
    const float* b_i = (const float*)A.in[9]; const float* b_f = (const float*)A.in[10];
    const float* w_out = (const float*)A.in[13]; const float* g_cross = (const float*)A.in[14]; const float* g_mem = (const float*)A.in[15];
    const float* w_q_x = (const float*)A.in[16]; const float* w_kv_x = (const float*)A.in[17]; const float* w_o_x = (const float*)A.in[18];
    const float* g_ffn = (const float*)A.in[19]; const float* w_rg = (const float*)A.in[20]; const float* w_re = (const float*)A.in[22];
    const float* w1 = (const float*)A.in[24]; const float* w3 = (const float*)A.in[25]; const float* w2 = (const float*)A.in[26];
    const int G = gridDim.x, gw = blockIdx.x * NWAVES + wave, NGW = G * NWAVES, gt = blockIdx.x * NTHR + tid, NGT = G * NTHR;

    LAS float* WGl = (LAS float*)lds;
    for (int i = tid; i < 8 * 1024; i += NTHR) { const int k = i >> 3, j = i & 7; WGl[j * 1024 + k] = g_mix[k] * w_in[(size_t)k * INW + NIN + j]; }

    for (int i = gt; i < PAR_N; i += NGT) { float v;
        if (i < PAR_CONVB) v = ((const float*)A.in[5])[i]; else if (i < PAR_GMHN) v = ((const float*)A.in[6])[i - PAR_CONVB]; else if (i < PAR_SKIP) v = ((const float*)A.in[11])[i - PAR_GMHN];
        else if (i < PAR_BRG) v = ((const float*)A.in[12])[i - PAR_SKIP]; else if (i < PAR_BRE) v = ((const float*)A.in[21])[i - PAR_BRG]; else if (i < PAR_GFIN) v = ((const float*)A.in[23])[i - PAR_BRE];
        else v = ((const float*)A.in[27])[i - PAR_GFIN];
        ((float*)(ws + WS_PAR))[i] = v; }
    for (int i = gt; i < 32 * 1024; i += NGT) { const int e = i >> 10, k = i & 1023;
        const float w = (e < 20) ? g_ffn[k] * (e < 4 ? w_rg[k * 4 + e] : w_re[k * 16 + (e - 4)]) : 0.f;
        const unsigned hi = f2bf(w); const float lo = w - bf2f(hi);
        ((bf16*)(ws + WS_WR))[i] = (bf16)hi; ((bf16*)(ws + WS_WR))[32 * 1024 + i] = (bf16)f2bf(lo); }
    for (int i = gt; i < T * 8; i += NGT) { const int t = i >> 3, j = i & 7; const float invf = powf(500000.0f, -(float)j * 0.125f);
        const float ang = (float)positions[t] * invf; float sn, cs; sincosf(ang, &sn, &cs);
        ((float*)(ws + WS_ROPE))[t * 16 + j] = cs; ((float*)(ws + WS_ROPE))[t * 16 + 8 + j] = sn; }
    __syncthreads();
    for (int m0 = 2 * gw; m0 < T + TMEM; m0 += 2 * NGW) {
        f32x4 v[2][4]; float rstd[2];
#pragma unroll
        for (int q = 0; q < 2; ++q) { const int m = m0 + q; const f32x4* xr = (const f32x4*)(m >= T ? mem + (size_t)(m - T) * D : x + (size_t)m * D) + lane;
#pragma unroll
            for (int j = 0; j < 4; ++j) v[q][j] = xr[64 * j]; }
#pragma unroll
        for (int q = 0; q < 2; ++q) { float s = 0.f;
#pragma unroll
            for (int j = 0; j < 4; ++j) s += (v[q][j].x * v[q][j].x + v[q][j].y * v[q][j].y) + (v[q][j].z * v[q][j].z + v[q][j].w * v[q][j].w);
            rstd[q] = 1.0f / sqrtf(wave_sum(s) * (1.0f / D) + EPSN);
            unsigned long long* o8 = (unsigned long long*)(ws + WS_XN + (size_t)(m0 + q) * D * 2) + lane;
#pragma unroll
            for (int j = 0; j < 4; ++j) o8[64 * j] = (unsigned long long)pk2(v[q][j].x * rstd[q], v[q][j].y * rstd[q]) | ((unsigned long long)pk2(v[q][j].z * rstd[q], v[q][j].w * rstd[q]) << 32); }
        if (m0 < T) {
            float ga[2][8];
#pragma unroll
            for (int g = 0; g < 8; ++g) { float a0 = 0.f, a1 = 0.f;
#pragma unroll
                for (int j = 0; j < 4; ++j) { const f32x4 w = *(const LAS f32x4*)(WGl + g * 1024 + 256 * j + 4 * lane);
                    a0 += (v[0][j].x * w.x + v[0][j].y * w.y) + (v[0][j].z * w.z + v[0][j].w * w.w); a1 += (v[1][j].x * w.x + v[1][j].y * w.y) + (v[1][j].z * w.z + v[1][j].w * w.w); }
                ga[0][g] = a0; ga[1][g] = a1; }
            float val0, val1;
            { const bool b5 = (lane & 32) != 0, b4 = (lane & 16) != 0, b3 = (lane & 8) != 0;
#pragma unroll
              for (int q = 0; q < 2; ++q) { float r[4], s2[2];
#pragma unroll
                  for (int i = 0; i < 4; ++i) { const float keep = b5 ? ga[q][i + 4] : ga[q][i], send = b5 ? ga[q][i] : ga[q][i + 4]; r[i] = keep + __shfl_xor(send, 32); }
#pragma unroll
                  for (int i = 0; i < 2; ++i) { const float keep = b4 ? r[i + 2] : r[i], send = b4 ? r[i] : r[i + 2]; s2[i] = keep + __shfl_xor(send, 16); }
                  float p = (b3 ? s2[1] : s2[0]) + __shfl_xor(b3 ? s2[0] : s2[1], 8);
                  p += __shfl_xor(p, 4); p += __shfl_xor(p, 2); p += __shfl_xor(p, 1);
                  if (q == 0) val0 = p * rstd[0]; else val1 = p * rstd[1]; } }
            if ((lane & 7) == 0) { const int gidx = lane >> 3, h = gidx & 3;
#pragma unroll
                for (int q = 0; q < 2; ++q) { const int m = m0 + q, b = m / SEQ, sq = m % SEQ; const float val = q ? val1 : val0;
                    if (gidx < 4) ((float*)(ws + WS_IG))[(size_t)(b * 4 + h) * SEQ + sq] = val + b_i[h];
                    else ((float*)(ws + WS_FG))[(size_t)(b * 4 + h) * SEQ + sq] = val + b_f[h]; } }
        }
    }
    __syncthreads();
    LAS float* scr = (LAS float*)(lds + wave * 16384);
    constexpr int I_IN = 16 * 48, I_KV = 16 * 8, I_OUT = 16 * 16, I_QX = 16 * 4, I_OX = 4 * 16, I_M = 32, I_13 = 16 * 2 * 128, I_2P = 24 * 2 * 128;
    constexpr int NITEMS = I_IN + I_KV + I_OUT + I_QX + I_OX + I_M + I_13 + I_2P;
    for (int it = gw; it < NITEMS; it += NGW) {
        int r = it;
        if (r < I_IN) { const int kb = r / 48, nb = r % 48; transpose_item(w_in, INW, 64 * kb, 64 * nb, (bf16*)(ws + WS_WIN), 1024, 64 * nb, 64 * kb, g_mix, (64 * nb < 512) ? C2 : 1.0f, scr, lane); continue; } r -= I_IN;
        if (r < I_KV) { const int kb = r / 8, nb = r % 8; transpose_item(w_kv_x, 512, 64 * kb, 64 * nb, (bf16*)(ws + WS_WIN), 1024, NIN + 64 * nb, 64 * kb, g_mem, 1.0f, scr, lane); continue; } r -= I_KV;
        if (r < I_OUT) { const int kb = r / 16, nb = r % 16; transpose_item(w_out, 1024, 64 * kb, 64 * nb, (bf16*)(ws + WS_WOUT), 1024, 64 * nb, 64 * kb, nullptr, 1.0f, scr, lane); continue; } r -= I_OUT;
        if (r < I_QX) { const int kb = r / 4, nb = r % 4; transpose_item(w_q_x, 256, 64 * kb, 64 * nb, (bf16*)(ws + WS_WQX), 1024, 64 * nb, 64 * kb, g_cross, C2, scr, lane); continue; } r -= I_QX;
        if (r < I_OX) { const int kb = r / 16, nb = r % 16; transpose_item(w_o_x, 1024, 64 * kb, 64 * nb, (bf16*)(ws + WS_WOX), 256, 64 * nb, 64 * kb, nullptr, 1.0f, scr, lane); continue; } r -= I_OX;
        if (r < I_M) { const int which = r / 16, h = (r % 16) / 4, kb = (r % 4) / 2, nb = r % 2;
            transpose_item((which ? w_k_m : w_q_m) + (size_t)h * 128 * 128, 128, 64 * kb, 64 * nb, (bf16*)(ws + WS_WM) + (size_t)(which * 4 + h) * 128 * 128, 128, 64 * nb, 64 * kb, nullptr,
                           which ? 0.08838834764831845f : 1.0f, scr, lane); continue; } r -= I_M;
        if (r < I_13) { const int e = r / 256, which = (r % 256) / 128, kb = (r % 128) / 8, nb = r % 8; const int n0 = 64 * nb;
            transpose_item((which ? w3 : w1) + (size_t)e * 1024 * 512, 512, 64 * kb, n0, (bf16*)(ws + WS_W13) + (size_t)e * 1024 * 1024, 1024, (n0 / 128) * 256 + which * 128 + (n0 % 128), 64 * kb, g_ffn, 1.0f, scr, lane); continue; } r -= I_13;
        { const int bk = r / 256, hf = (r % 256) / 128, kb = (r % 128) / 16, nb = r % 16; const int g = bk / 6, p = bk % 6;
          const int pa = (p < 3) ? 0 : (p < 5 ? 1 : 2), pb = (p < 3) ? p + 1 : (p < 5 ? p - 1 : 3); const int e = 4 * g + (hf ? pb : pa);
          transpose_item(w2 + (size_t)e * 512 * 1024, 1024, 64 * kb, 64 * nb, (bf16*)(ws + WS_W2P) + (size_t)bk * 1024 * 1024, 1024, 64 * nb, hf * 512 + 64 * kb, nullptr, 1.0f, scr, lane); }
    }
}

__device__ __forceinline__ v4u pack8(const f32x4& a, const f32x4& b) { v4u w; w.x = pk2(a[0], a[1]); w.y = pk2(a[2], a[3]); w.z = pk2(b[0], b[1]); w.w = pk2(b[2], b[3]); return w; }
struct EpiInProj {
    static constexpr bool PERM = true, AFTER_DRAIN = false;
    bf16* base; const float* rope;
    __device__ __forceinline__ void operator()(const f32x4 (&acc)[2][2][4][2], const pg8::Unit& u, int wr, int wc, int fr, int fq) const {
        const int buf = u.pn >> 1; bf16* B = base + (size_t)buf * T * 512;
        int row0 = u.pm * 256 + wr * 64 + fr; asm volatile("" : "+v"(row0));
        const int col0 = (u.pn & 1) * 256 + wc * 32 + 8 * fq;
        const bool dorope = (buf < 2) && ((wc & 1) == 0);
#pragma unroll
        for (int ai = 0; ai < 2; ++ai)
#pragma unroll
            for (int m = 0; m < 4; ++m) { const int row = row0 + ai * 128 + m * 16; bf16* rowp = B + (size_t)row * 512 + col0;
                f32x4 cs0, cs1, sn0, sn1;
                if (dorope) { const f32x4* rp = (const f32x4*)(rope + (size_t)row * 16); cs0 = rp[0]; cs1 = rp[1]; sn0 = rp[2]; sn1 = rp[3]; }
#pragma unroll
                for (int bj = 0; bj < 2; ++bj) { f32x4 v0 = acc[ai][bj][m][0], v1 = acc[ai][bj][m][1];
                    if (dorope) { f32x4 o0, o1;
#pragma unroll
                        for (int i = 0; i < 4; ++i) { o0[i] = __shfl_xor(v0[i], 16); o1[i] = __shfl_xor(v1[i], 16); }
                        if (fq == 0) { v0 = v0 * cs0 - o0 * sn0; v1 = v1 * cs1 - o1 * sn1; }
                        else if (fq == 1) { v0 = v0 * cs0 + o0 * sn0; v1 = v1 * cs1 + o1 * sn1; } }
                    *(v4u*)(rowp + bj * 128) = pack8(v0, v1); } }
    }
};

typedef short v4i16_t __attribute__((ext_vector_type(4)));
struct AttItem { int cfg, b, h, d, nb; size_t tokb; };
__device__ __forceinline__ AttItem attn_decode(int item) {
    AttItem a; a.cfg = item >> 12; int rem = item & 4095; a.b = rem >> 9; rem &= 511; a.h = rem >> 6; const int sub = rem & 63;
    a.d = (a.cfg == 0) ? 1 : (a.cfg == 1 ? 4 : 16); const int nblk = 64 / a.d, r = sub / nblk; a.nb = sub % nblk; a.tokb = (size_t)a.b * SEQ + r; return a;
}
__device__ __forceinline__ int attn_item_of(int k, int G) {
    if (G != 256) return (int)blockIdx.x + k * G;
    const int pair = (int)(blockIdx.x & 7) + 8 * (k / 6), j = (int)(blockIdx.x >> 3), ip = j * 6 + (k % 6);
    return ((ip >> 6) << 12) | (pair << 6) | (ip & 63);
}
__device__ __forceinline__ void glds16(const void* gsrc, unsigned lds_dst) { unsigned keep;
    asm volatile("s_mov_b32 %0, m0\n\ts_mov_b32 m0, %2\n\ts_nop 0\n\tglobal_load_lds_dwordx4 %1, off\n\ts_mov_b32 m0, %0" : "=&s"(keep) : "v"(gsrc), "s"(lds_dst) : "memory"); }
__device__ __forceinline__ unsigned lds_addr_of(LAS unsigned char* p) { return (unsigned)(uintptr_t)p; }
__device__ __forceinline__ void attn_prefetch(const Args& A, LAS unsigned char* L, int item, int pslot, int oslot, bool load_prev, int lane, int wave, bf16x8 (&qf)[2]) {
    const AttItem a = attn_decode(item);
    const bf16* Kg = (const bf16*)(A.ws + WS_K) + a.h * 64; const bf16* Vg = (const bf16*)(A.ws + WS_V) + a.h * 64; const bf16* Qg = (const bf16*)(A.ws + WS_Q) + a.h * 64;
#pragma unroll
    for (int i = 0; i < 2; ++i) { const int inst = wave + 8 * i, row = 8 * inst + (lane >> 3);
        const size_t off = (a.tokb + (size_t)(128 * a.nb + row) * a.d) * 512 + ((lane & 7) ^ (lane >> 3)) * 8;
        glds16(Kg + off, (unsigned)__builtin_amdgcn_readfirstlane(lds_addr_of(L + oslot * 32768 + inst * 1024)));
        glds16(Vg + off, (unsigned)__builtin_amdgcn_readfirstlane(lds_addr_of(L + oslot * 32768 + 16384 + inst * 1024))); }
    if (load_prev) {
#pragma unroll
        for (int i = 0; i < 2; ++i) { const int inst = wave + 8 * i, row = 8 * inst + (lane >> 3);
            const size_t off = (a.tokb + (size_t)(128 * (a.nb - 1) + row) * a.d) * 512 + ((lane & 7) ^ (lane >> 3)) * 8;
            glds16(Kg + off, (unsigned)__builtin_amdgcn_readfirstlane(lds_addr_of(L + pslot * 32768 + inst * 1024)));
            glds16(Vg + off, (unsigned)__builtin_amdgcn_readfirstlane(lds_addr_of(L + pslot * 32768 + 16384 + inst * 1024))); } }
    const size_t tq = a.tokb + (size_t)(128 * a.nb + 16 * wave + (lane & 15)) * a.d;
    qf[0] = *(const bf16x8*)(Qg + tq * 512 + 8 * (lane >> 4)); qf[1] = *(const bf16x8*)(Qg + tq * 512 + 32 + 8 * (lane >> 4));
}
__device__ __forceinline__ void attn_compute(const Args& A, LAS unsigned char* L, int item, int pslot, int oslot, int lane, int wave, const bf16x8 (&qf)[2]) {
    const AttItem a = attn_decode(item);
    const int fr = lane & 15, g = lane >> 4, qi = 16 * wave + fr;
    f32x4 s[10];
#pragma unroll
    for (int tt = 0; tt < 9; ++tt) { const int t = wave + tt, key = 16 * (t & 7) + fr; LAS unsigned char* kb = L + ((t < 8) ? pslot : oslot) * 32768; s[tt] = (f32x4){0.f, 0.f, 0.f, 0.f};
#pragma unroll
        for (int ks = 0; ks < 2; ++ks) { const bf16x8 kf = *(const LAS bf16x8*)(kb + key * 128 + (((4 * ks + g) ^ (key & 7)) * 16));
            s[tt] = __builtin_amdgcn_mfma_f32_16x16x32_bf16(kf, qf[ks], s[tt], 0, 0, 0); } }
    s[9] = (f32x4){0.f, 0.f, 0.f, 0.f};
#pragma unroll
    for (int e = 0; e < 4; ++e) { s[0][e] = (4 * g + e >= fr) ? s[0][e] : -1e30f; s[8][e] = (4 * g + e <= fr) ? s[8][e] : -1e30f; }
    if (__builtin_expect(a.nb == 0, 0)) {
        asm volatile("" ::: "memory");
#pragma unroll
        for (int tt = 0; tt < 8; ++tt) if (wave + tt < 8) s[tt] = (f32x4){-1e30f, -1e30f, -1e30f, -1e30f};
        asm volatile("" : "+v"(s[0]), "+v"(s[1]), "+v"(s[2]), "+v"(s[3]), "+v"(s[4]), "+v"(s[5]), "+v"(s[6]), "+v"(s[7]));
    }
    float mx;
    { float m0_, m1_;
      asm("v_max3_f32 %0, %1, %2, %3" : "=v"(m0_) : "v"(s[0][0]), "v"(s[0][1]), "v"(s[0][2]));
      asm("v_max3_f32 %0, %1, %2, %3" : "=v"(m1_) : "v"(s[0][3]), "v"(s[1][0]), "v"(s[1][1]));
      asm("v_max3_f32 %0, %1, %2, %3" : "=v"(m0_) : "v"(m0_), "v"(s[1][2]), "v"(s[1][3]));
#pragma unroll
      for (int tt = 2; tt < 9; ++tt) { asm("v_max3_f32 %0, %1, %2, %3" : "=v"(m0_) : "v"(m0_), "v"(s[tt][0]), "v"(s[tt][1])); asm("v_max3_f32 %0, %1, %2, %3" : "=v"(m1_) : "v"(m1_), "v"(s[tt][2]), "v"(s[tt][3])); }
      asm("v_max_f32_e32 %0, %1, %2" : "=v"(mx) : "v"(m0_), "v"(m1_)); }
    mx = fmaxf(mx, __shfl_xor(mx, 16)); mx = fmaxf(mx, __shfl_xor(mx, 32));
    float l = 0.f;
#pragma unroll
    for (int tt = 0; tt < 9; ++tt)
#pragma unroll
        for (int e = 0; e < 4; ++e) { s[tt][e] = __builtin_amdgcn_exp2f(s[tt][e] - mx); l += s[tt][e]; }
    l += __shfl_xor(l, 16); l += __shfl_xor(l, 32);
    f32x4 o[4];
#pragma unroll
    for (int dt = 0; dt < 4; ++dt) o[dt] = (f32x4){0.f, 0.f, 0.f, 0.f};
#pragma unroll
    for (int k5 = 0; k5 < 5; ++k5) {
        const v4u pw = (v4u){pk2(s[2 * k5][0], s[2 * k5][1]), pk2(s[2 * k5][2], s[2 * k5][3]), pk2(s[2 * k5 + 1][0], s[2 * k5 + 1][1]), pk2(s[2 * k5 + 1][2], s[2 * k5 + 1][3])};
        const bf16x8 pf = __builtin_bit_cast(bf16x8, pw);
        const int t0 = wave + 2 * k5, t1 = (wave + 2 * k5 + 1 < 16) ? wave + 2 * k5 + 1 : 15;
        const int r0 = 16 * (t0 & 7) + 4 * g + (fr >> 2), r1 = 16 * (t1 & 7) + 4 * g + (fr >> 2), p_ = fr & 3;
        LAS unsigned char* v0b = L + ((t0 < 8) ? pslot : oslot) * 32768 + 16384; LAS unsigned char* v1b = L + ((t1 < 8) ? pslot : oslot) * 32768 + 16384;
#pragma unroll
        for (int dt = 0; dt < 4; ++dt) { const int chunk = 2 * dt + (p_ >> 1);
            const v4i16_t v0 = __builtin_amdgcn_ds_read_tr16_b64_v4i16((LAS v4i16_t*)(v0b + r0 * 128 + ((chunk ^ (r0 & 7)) * 16) + 8 * (p_ & 1)));
            const v4i16_t v1 = __builtin_amdgcn_ds_read_tr16_b64_v4i16((LAS v4i16_t*)(v1b + r1 * 128 + ((chunk ^ (r1 & 7)) * 16) + 8 * (p_ & 1)));
            const bf16x8 vf = (bf16x8){v0[0], v0[1], v0[2], v0[3], v1[0], v1[1], v1[2], v1[3]};
            o[dt] = __builtin_amdgcn_mfma_f32_16x16x32_bf16(vf, pf, o[dt], 0, 0, 0); } }
    const float rl = frcp_(l);
    const size_t tok = a.tokb + (size_t)(128 * a.nb + qi) * a.d;
    bf16* og = (bf16*)((unsigned char*)A.out + DO_OATT) + ((size_t)a.cfg * T + tok) * 512 + a.h * 64;
#pragma unroll
    for (int dt = 0; dt < 4; ++dt) *(v2u*)(og + 16 * dt + 4 * g) = (v2u){pk2(o[dt][0] * rl, o[dt][1] * rl), pk2(o[dt][2] * rl, o[dt][3] * rl)};
    if (g == 0) ((float*)(A.ws + WS_LSE))[((size_t)a.cfg * T + tok) * 8 + a.h] = mx + __builtin_amdgcn_logf(l);
}
__device__ __forceinline__ void attn_phase(const Args& A, unsigned char* lds, int n_total, int lane, int wave) {
    const int G = gridDim.x; LAS unsigned char* L = (LAS unsigned char*)lds;
    const int nk = (G == 256) ? n_total / 256 : (n_total - (int)blockIdx.x + G - 1) / G;
    if (nk <= 0) return;
    bf16x8 qa[2], qb[2];
    int it = attn_item_of(0, G); int ps, os;
    { const AttItem a = attn_decode(it); os = 0; ps = (a.nb > 0) ? 1 : 0; attn_prefetch(A, L, it, ps, os, a.nb > 0, lane, wave, qa); }
    for (int k = 0; k < nk; ++k) {
        __builtin_amdgcn_s_waitcnt(0x0F70);
        asm volatile("s_waitcnt vmcnt(0)" ::: "memory");
        __syncthreads();
        qb[0] = qa[0]; qb[1] = qa[1];
        int nit = it, nps = ps, nos = os;
        if (k + 1 < nk) { nit = attn_item_of(k + 1, G); const AttItem c = attn_decode(it), n = attn_decode(nit);
            const bool succ = (nit == it + 1) && (n.nb == c.nb + 1);
            const int used = (1 << ps) | (1 << os); const int f1 = (used & 1) ? ((used & 2) ? ((used & 4) ? 3 : 2) : 1) : 0; const int used2 = used | (1 << f1);
            const int f2 = (used2 & 1) ? ((used2 & 2) ? ((used2 & 4) ? 3 : 2) : 1) : 0;
            bool lp;
            if (succ) { nps = os; nos = f1; lp = false; } else if (n.nb == 0) { nos = f1; nps = f1; lp = false; } else { nps = f1; nos = f2; lp = true; }
            attn_prefetch(A, L, nit, nps, nos, lp, lane, wave, qb); }
        attn_compute(A, L, it, ps, os, lane, wave, qa);
        qa[0] = qb[0]; qa[1] = qb[1]; it = nit; ps = nps; os = nos;
    }
    asm volatile("s_waitcnt vmcnt(0)" ::: "memory");
    __syncthreads();
}

__device__ __forceinline__ void kv_tile(const Args& A, unsigned char* lds, int tile, int tid, int lane, int wave) {
    unsigned char* ws = A.ws;
    const int mt = tile >> 3, nt = tile & 7;
    const bf16* Ag = (const bf16*)(ws + WS_XN) + (size_t)(T + 64 * mt) * D; const bf16* Bg = (const bf16*)(ws + WS_WIN) + (size_t)(NIN + 64 * nt) * D;
    bf16* As = (bf16*)lds; bf16* Bs = (bf16*)(lds + 64 * 264 * 2);
    const int fr = lane & 15, fq = lane >> 4, wm = wave & 3, wn = wave >> 2;
    f32x4 acc[1][2]; acc[0][0] = (f32x4){0.f, 0.f, 0.f, 0.f}; acc[0][1] = (f32x4){0.f, 0.f, 0.f, 0.f};
    for (int kc = 0; kc < 4; ++kc) {
        for (int id = tid; id < 64 * 32; id += NTHR) { const int row = id >> 5, ch = id & 31;
            *(v4u*)(As + row * 264 + ch * 8) = *(const v4u*)(Ag + (size_t)row * D + kc * 256 + ch * 8);
            *(v4u*)(Bs + row * 264 + ch * 8) = *(const v4u*)(Bg + (size_t)row * D + kc * 256 + ch * 8); }
        __syncthreads();
        wave_mma<1, 2>(As + 16 * wm * 264, 264, Bs + 32 * wn * 264, 264, 256, acc, fr, fq);
        __syncthreads();
    }
    bf16* og = (bf16*)(ws + WS_KVX) + (size_t)(64 * mt + 16 * wm + fr) * NKV + 64 * nt + 32 * wn;
#pragma unroll
    for (int j = 0; j < 2; ++j) *(v2u*)(og + 16 * j + 4 * fq) = (v2u){pk2(acc[0][j][0], acc[0][j][1]), pk2(acc[0][j][2], acc[0][j][3])};
}

constexpr int ML_TILE = 32768;
constexpr int ML_G = 4 * ML_TILE;
static_assert(ML_G + 8192 <= LDS_MISC, "mlstm LDS");
__device__ __forceinline__ int sw_off(int row, int ch) { return 256 * row + 16 * (ch ^ (((row & 3) << 2) | ((row >> 2) & 3))); }
__device__ __forceinline__ bf16x8 rowfrag(LAS unsigned char* tile, int row0, int ks, int fr, int g) { return *(const LAS bf16x8*)(tile + sw_off(row0 + fr, 4 * ks + g)); }
__device__ __forceinline__ bf16x8 colfrag(LAS unsigned char* tile, int ks, int ct, int fr, int g) {
    const int r0 = 32 * ks + 8 * g + (fr >> 2), p = fr & 3, ch = 2 * ct + (p >> 1);
    const v4i16_t a = __builtin_amdgcn_ds_read_tr16_b64_v4i16((LAS v4i16_t*)(tile + sw_off(r0, ch) + 8 * (p & 1)));
    const v4i16_t b = __builtin_amdgcn_ds_read_tr16_b64_v4i16((LAS v4i16_t*)(tile + sw_off(r0 + 4, ch) + 8 * (p & 1)));
    return (bf16x8){a[0], a[1], a[2], a[3], b[0], b[1], b[2], b[3]};
}
__device__ __forceinline__ float log_sigmoidf_(float x) { return (x > 0.f) ? -log1pf(__expf(-x)) : (x - log1pf(__expf(x))); }
__device__ __forceinline__ float wscan_sum(float v0, float v1, float& o0, float& o1, int lane) {
    float x = v0 + v1;
#pragma unroll
    for (int off = 1; off < 64; off <<= 1) { const float t = __shfl_up(x, off); if (lane >= off) x += t; }
    o0 = x - v1; o1 = x; return __shfl(x, 63);
}
__device__ __forceinline__ void wscan_max(float v0, float v1, float& o0, float& o1, int lane) {
    float y = fmaxf(v0, v1);
#pragma unroll
    for (int off = 1; off < 64; off <<= 1) { const float t = __shfl_up(y, off); if (lane >= off) y = fmaxf(y, t); }
    float pre = __shfl_up(y, 1); if (lane == 0) pre = -INFINITY;
    o0 = fmaxf(pre, v0); o1 = fmaxf(pre, fmaxf(v0, v1));
}
__device__ __forceinline__ void tile_load(LAS unsigned char* tile, const bf16* src, size_t pitch, int tid) {
    v4u v[4];
#pragma unroll
    for (int i = 0; i < 4; ++i) { const int id = tid + NTHR * i, row = id >> 4, ch = id & 15; v[i] = *(const v4u*)(src + (size_t)row * pitch + ch * 8); }
#pragma unroll
    for (int i = 0; i < 4; ++i) { const int id = tid + NTHR * i, row = id >> 4, ch = id & 15; *(LAS v4u*)(tile + sw_off(row, ch)) = v[i]; }
}

__device__ __forceinline__ void ml_conv_tile(LAS unsigned char* cA, const bf16* MU, const float* conv_w, const float* conv_b, int b, int c, int h, int tid) {
    const int ch = (tid & 15) * 8;
    float w[4][8], bs[8];
#pragma unroll
    for (int j = 0; j < 4; ++j) { const f32x4 w0 = *(const f32x4*)(conv_w + j * 512 + h * 128 + ch), w1 = *(const f32x4*)(conv_w + j * 512 + h * 128 + ch + 4);
        w[j][0] = w0[0]; w[j][1] = w0[1]; w[j][2] = w0[2]; w[j][3] = w0[3]; w[j][4] = w1[0]; w[j][5] = w1[1]; w[j][6] = w1[2]; w[j][7] = w1[3]; }
    { const f32x4 b0 = *(const f32x4*)(conv_b + h * 128 + ch), b1 = *(const f32x4*)(conv_b + h * 128 + ch + 4);
      bs[0] = b0[0]; bs[1] = b0[1]; bs[2] = b0[2]; bs[3] = b0[3]; bs[4] = b1[0]; bs[5] = b1[1]; bs[6] = b1[2]; bs[7] = b1[3]; }
#pragma unroll
    for (int i = 0; i < 4; ++i) { const int l = (tid >> 4) + 32 * i;
        float a[8];
#pragma unroll
        for (int q = 0; q < 8; ++q) a[q] = bs[q];
#pragma unroll
        for (int j = 0; j < 4; ++j) { const int sp = 128 * c + l + j - 3;
            if (sp >= 0) { const v4u m = *(const v4u*)(MU + ((size_t)b * SEQ + sp) * 512 + ch);
                a[0] += bflo(m.x) * w[j][0]; a[1] += bfhi(m.x) * w[j][1]; a[2] += bflo(m.y) * w[j][2]; a[3] += bfhi(m.y) * w[j][3];
                a[4] += bflo(m.z) * w[j][4]; a[5] += bfhi(m.z) * w[j][5]; a[6] += bflo(m.w) * w[j][6]; a[7] += bfhi(m.w) * w[j][7]; } }
#pragma unroll
        for (int q = 0; q < 8; ++q) a[q] = a[q] * sigmoidf_(a[q]);
        *(LAS v4u*)(cA + sw_off(l, tid & 15)) = (v4u){pk2(a[0], a[1]), pk2(a[2], a[3]), pk2(a[4], a[5]), pk2(a[6], a[7])}; }
}
struct MGroup { f32x4 G[8]; f32x4 Gn; float B, M; };
__device__ __forceinline__ void mlstm_p1_item(const Args& A, unsigned char* lds_, int item, int& wres, MGroup& mg, int tid, int lane, int wave) {
    asm volatile("" : "+v"(tid), "+v"(lane));
    unsigned char* ws = A.ws; LAS unsigned char* lds = (LAS unsigned char*)lds_;
    const int bh = item >> 6, c = item & 63, b = bh >> 2, h = bh & 3;
    const size_t t0 = (size_t)b * SEQ + 128 * c;
    LAS unsigned char* cA = lds; LAS unsigned char* Wk = lds + 2 * ML_TILE; LAS unsigned char* Vt = lds + 3 * ML_TILE;
    LAS float* gl = (LAS float*)(lds + ML_G);
    const int fr = lane & 15, g = lane >> 4, m0 = 16 * wave;
    if (wres != h) { tile_load(Wk, (const bf16*)(ws + WS_WM) + (size_t)(4 + h) * 128 * 128, 128, tid); wres = h; }
    tile_load(Vt, (const bf16*)(ws + WS_MV) + t0 * 512 + h * 128, 512, tid);
    ml_conv_tile(cA, (const bf16*)(ws + WS_MU) + h * 128, (const float*)(ws + WS_PAR) + PAR_CONVW, (const float*)(ws + WS_PAR) + PAR_CONVB, b, c, h, tid);
    float blast, mloc;
    { const size_t gi = (size_t)bh * SEQ + 128 * c + 2 * lane;
      const float i0 = ((const float*)(ws + WS_IG))[gi], i1 = ((const float*)(ws + WS_IG))[gi + 1];
      const float f0 = log_sigmoidf_(((const float*)(ws + WS_FG))[gi]), f1 = log_sigmoidf_(((const float*)(ws + WS_FG))[gi + 1]);
      float b0, b1; blast = wscan_sum(f0, f1, b0, b1, lane);
      const float g0 = blast - b0 + i0, g1 = blast - b1 + i1; mloc = wave_max(fmaxf(g0, g1));
      gl[2 * lane] = fexp_(g0 - mloc); gl[2 * lane + 1] = fexp_(g1 - mloc); }
    __syncthreads();
    { bf16x8 af[4];
#pragma unroll
      for (int ks = 0; ks < 4; ++ks) af[ks] = rowfrag(cA, m0, ks, fr, g);
      const float wk = gl[m0 + fr];
#pragma unroll
      for (int j = 0; j < 8; ++j) { f32x4 acc = (f32x4){0.f, 0.f, 0.f, 0.f};
#pragma unroll
          for (int ks = 0; ks < 4; ++ks) acc = __builtin_amdgcn_mfma_f32_16x16x32_bf16(rowfrag(Wk, 16 * j, ks, fr, g), af[ks], acc, 0, 0, 0);
          *(LAS v2u*)(cA + sw_off(m0 + fr, 2 * j + (g >> 1)) + 8 * (g & 1)) = (v2u){pk2(acc[0] * wk, acc[1] * wk), pk2(acc[2] * wk, acc[3] * wk)}; } }
    __syncthreads();
    { f32x4 acc[8], accn = (f32x4){0.f, 0.f, 0.f, 0.f};
#pragma unroll
      for (int j = 0; j < 8; ++j) acc[j] = (f32x4){0.f, 0.f, 0.f, 0.f};
      const bf16x8 ones = (bf16x8){0x3f80, 0x3f80, 0x3f80, 0x3f80, 0x3f80, 0x3f80, 0x3f80, 0x3f80};
#pragma unroll
      for (int ks = 0; ks < 4; ++ks) { const bf16x8 vf = colfrag(Vt, ks, wave, fr, g);
#pragma unroll
          for (int j = 0; j < 8; ++j) { const bf16x8 kf = colfrag(cA, ks, j, fr, g); acc[j] = __builtin_amdgcn_mfma_f32_16x16x32_bf16(kf, vf, acc[j], 0, 0, 0);
              if (j == wave) accn = __builtin_amdgcn_mfma_f32_16x16x32_bf16(kf, ones, accn, 0, 0, 0); } }
      if ((c & 7) == 0) {
#pragma unroll
          for (int j = 0; j < 8; ++j) mg.G[j] = acc[j];
          mg.Gn = accn; mg.M = mloc; mg.B = blast;
      } else { const float mnew = fmaxf(blast + mg.M, mloc), a = fexp_(blast + mg.M - mnew), cc = fexp_(mloc - mnew);
#pragma unroll
          for (int j = 0; j < 8; ++j) mg.G[j] = mg.G[j] * a + acc[j] * cc;
          mg.Gn = mg.Gn * a + accn * cc; mg.M = mnew; mg.B += blast; }
      if ((c & 7) == 7) { const int gi = bh * 8 + (c >> 3);
          bf16* gg = (bf16*)(ws + WS_GAGG) + ((size_t)gi * 128 + m0 + fr) * 128;
#pragma unroll
          for (int j = 0; j < 8; ++j) *(v2u*)(gg + 16 * j + 4 * g) = (v2u){pk2(mg.G[j][0], mg.G[j][1]), pk2(mg.G[j][2], mg.G[j][3])};
          if (fr == 0) *(f32x4*)((float*)(ws + WS_GN) + (size_t)gi * 128 + 16 * wave + 4 * g) = mg.Gn;
          if (wave == 0 && lane == 0) { ((float*)(ws + WS_GSC))[2 * gi] = mg.B; ((float*)(ws + WS_GSC))[2 * gi + 1] = mg.M; } } }
    __syncthreads();
}

__device__ __forceinline__ void combine_rows(const Args& A, size_t row0, int nrows, int tid) {
    unsigned char* ws = A.ws;
    const bf16* OA = (const bf16*)((const unsigned char*)A.out + DO_OATT); const float* LSE = (const float*)(ws + WS_LSE);
    for (int id = tid; id < nrows * 64; id += NTHR) {
        const size_t t = row0 + (id >> 6); const int h = (id & 63) >> 3, ch = (id & 7) * 8;
        const float l0 = LSE[t * 8 + h], l1 = LSE[((size_t)T + t) * 8 + h], l2 = LSE[((size_t)2 * T + t) * 8 + h];
        const float mx = fmaxf(l0, fmaxf(l1, l2)); float w0 = __builtin_amdgcn_exp2f(l0 - mx), w1 = __builtin_amdgcn_exp2f(l1 - mx), w2 = __builtin_amdgcn_exp2f(l2 - mx);
        const float rs = frcp_(w0 + w1 + w2); w0 *= rs; w1 *= rs; w2 *= rs;
        const v4u a = *(const v4u*)(OA + t * 512 + h * 64 + ch), b = *(const v4u*)(OA + ((size_t)T + t) * 512 + h * 64 + ch), c = *(const v4u*)(OA + ((size_t)2 * T + t) * 512 + h * 64 + ch);
        v4u o;
        o.x = pk2(w0 * bflo(a.x) + w1 * bflo(b.x) + w2 * bflo(c.x), w0 * bfhi(a.x) + w1 * bfhi(b.x) + w2 * bfhi(c.x));
        o.y = pk2(w0 * bflo(a.y) + w1 * bflo(b.y) + w2 * bflo(c.y), w0 * bfhi(a.y) + w1 * bfhi(b.y) + w2 * bfhi(c.y));
        o.z = pk2(w0 * bflo(a.z) + w1 * bflo(b.z) + w2 * bflo(c.z), w0 * bfhi(a.z) + w1 * bfhi(b.z) + w2 * bfhi(c.z));
        o.w = pk2(w0 * bflo(a.w) + w1 * bflo(b.w) + w2 * bflo(c.w), w0 * bfhi(a.w) + w1 * bfhi(b.w) + w2 * bfhi(c.w));
        *(v4u*)((bf16*)(ws + WS_Y) + t * 1024 + h * 64 + ch) = o;
    }
}

struct MState { f32x4 C[8]; float n0, n1, m; };
__device__ __forceinline__ void mlstm2_entry(const Args& A, int bh, int grp, MState& st, int lane, int wave) {
    unsigned char* ws = A.ws; const int fr = lane & 15, g = lane >> 4, m0 = 16 * wave;
#pragma unroll
    for (int j = 0; j < 8; ++j) st.C[j] = (f32x4){0.f, 0.f, 0.f, 0.f};
    st.n0 = 0.f; st.n1 = 0.f; st.m = 0.f;
    for (int gp = 0; gp < grp; ++gp) { const int gi = bh * 8 + gp; const float B = ((const float*)(ws + WS_GSC))[2 * gi], M = ((const float*)(ws + WS_GSC))[2 * gi + 1];
        const float mnew = fmaxf(B + st.m, M), a = fexp_(B + st.m - mnew), cc = fexp_(M - mnew);
        const bf16* gg = (const bf16*)(ws + WS_GAGG) + ((size_t)gi * 128 + m0 + fr) * 128;
#pragma unroll
        for (int j = 0; j < 8; ++j) { const v2u w = *(const v2u*)(gg + 16 * j + 4 * g); st.C[j] = st.C[j] * a + (f32x4){bflo(w.x), bfhi(w.x), bflo(w.y), bfhi(w.y)} * cc; }
        const float* gn = (const float*)(ws + WS_GN) + (size_t)gi * 128 + 2 * lane;
        st.n0 = st.n0 * a + gn[0] * cc; st.n1 = st.n1 * a + gn[1] * cc; st.m = mnew; }
}
__device__ __forceinline__ void mlstm_p2_item(const Args& A, unsigned char* lds_, int item, MState& st, int tid, int lane, int wave) {
    asm volatile("" : "+v"(tid), "+v"(lane));
    unsigned char* ws = A.ws; LAS unsigned char* lds = (LAS unsigned char*)lds_;
    const float* g_mhn = (const float*)(ws + WS_PAR) + PAR_GMHN; const float* skip_m = (const float*)(ws + WS_PAR) + PAR_SKIP;
    const int bh = item >> 6, c = item & 63, b = bh >> 2, h = bh & 3;
    const size_t t0 = (size_t)b * SEQ + 128 * c;
    LAS unsigned char* T0 = lds; LAS unsigned char* T1 = lds + ML_TILE; LAS unsigned char* T2 = lds + 2 * ML_TILE; LAS unsigned char* T3 = lds + 3 * ML_TILE;
    LAS float* gl = (LAS float*)(lds + ML_G);
    const int fr = lane & 15, g = lane >> 4, m0 = 16 * wave, l = m0 + fr;
    { const bf16* Wg = (const bf16*)(ws + WS_WM) + (size_t)h * 128 * 128; tile_load(T1, Wg, 128, tid); tile_load(T2, Wg + 4 * 128 * 128, 128, tid); }
    tile_load(T3, (const bf16*)(ws + WS_MV) + t0 * 512 + h * 128, 512, tid);
    ml_conv_tile(T0, (const bf16*)(ws + WS_MU) + h * 128, (const float*)(ws + WS_PAR) + PAR_CONVW, (const float*)(ws + WS_PAR) + PAR_CONVB, b, c, h, tid);
    float blast, mloc;
    { const size_t gi = (size_t)bh * SEQ + 128 * c + 2 * lane; const float mprev = st.m;
      const float i0 = ((const float*)(ws + WS_IG))[gi], i1 = ((const float*)(ws + WS_IG))[gi + 1];
      const float f0 = log_sigmoidf_(((const float*)(ws + WS_FG))[gi]), f1 = log_sigmoidf_(((const float*)(ws + WS_FG))[gi + 1]);
      float b0, b1; blast = wscan_sum(f0, f1, b0, b1, lane);
      const float g0 = blast - b0 + i0, g1 = blast - b1 + i1; mloc = wave_max(fmaxf(g0, g1));
      gl[640 + 2 * lane] = fexp_(g0 - mloc); gl[640 + 2 * lane + 1] = fexp_(g1 - mloc);
      const float a0 = i0 - b0, a1 = i1 - b1; float p0, p1; wscan_max(a0, a1, p0, p1, lane);
      const float mt0 = fmaxf(b0 + mprev, b0 + p0), mt1 = fmaxf(b1 + mprev, b1 + p1);
      gl[2 * lane] = a0; gl[2 * lane + 1] = a1; gl[128 + 2 * lane] = b0 - mt0; gl[128 + 2 * lane + 1] = b1 - mt1;
      gl[256 + 2 * lane] = fexp_(b0 + mprev - mt0); gl[256 + 2 * lane + 1] = fexp_(b1 + mprev - mt1); gl[384 + 2 * lane] = fexp_(-mt0); gl[384 + 2 * lane + 1] = fexp_(-mt1);
      gl[512 + 2 * lane] = st.n0; gl[512 + 2 * lane + 1] = st.n1; }
    __syncthreads();
    v2u cp[8], qp[8], kp[8];
    { bf16x8 af[4];
#pragma unroll
      for (int ks = 0; ks < 4; ++ks) af[ks] = rowfrag(T0, m0, ks, fr, g);
#pragma unroll
      for (int j = 0; j < 8; ++j) cp[j] = *(const LAS v2u*)(T0 + sw_off(l, 2 * j + (g >> 1)) + 8 * (g & 1));
#pragma unroll
      for (int j = 0; j < 8; ++j) { f32x4 acc = (f32x4){0.f, 0.f, 0.f, 0.f};
#pragma unroll
          for (int ks = 0; ks < 4; ++ks) acc = __builtin_amdgcn_mfma_f32_16x16x32_bf16(rowfrag(T1, 16 * j, ks, fr, g), af[ks], acc, 0, 0, 0);
          qp[j] = (v2u){pk2(acc[0], acc[1]), pk2(acc[2], acc[3])}; }
#pragma unroll
      for (int j = 0; j < 8; ++j) { f32x4 acc = (f32x4){0.f, 0.f, 0.f, 0.f};
#pragma unroll
          for (int ks = 0; ks < 4; ++ks) acc = __builtin_amdgcn_mfma_f32_16x16x32_bf16(rowfrag(T2, 16 * j, ks, fr, g), af[ks], acc, 0, 0, 0);
          kp[j] = (v2u){pk2(acc[0], acc[1]), pk2(acc[2], acc[3])}; } }
    __syncthreads();
#pragma unroll
    for (int j = 0; j < 8; ++j) { const int off = sw_off(l, 2 * j + (g >> 1)) + 8 * (g & 1);
        *(LAS v2u*)(T1 + off) = qp[j]; *(LAS v2u*)(T0 + off) = kp[j]; *(LAS v2u*)(T2 + off) = (v2u){pk2(st.C[j][0], st.C[j][1]), pk2(st.C[j][2], st.C[j][3])}; }
    __syncthreads();
    bf16x8 qf[4];
#pragma unroll
    for (int ks = 0; ks < 4; ++ks) qf[ks] = rowfrag(T1, m0, ks, fr, g);
    float qn = 0.f;
    { const LAS float* np = gl + 512;
#pragma unroll
      for (int ks = 0; ks < 4; ++ks) { const f32x4 n0 = *(const LAS f32x4*)(np + 32 * ks + 8 * g), n1 = *(const LAS f32x4*)(np + 32 * ks + 8 * g + 4); const v4u w = __builtin_bit_cast(v4u, qf[ks]);
          qn += bflo(w.x) * n0[0] + bfhi(w.x) * n0[1] + bflo(w.y) * n0[2] + bfhi(w.y) * n0[3] + bflo(w.z) * n1[0] + bfhi(w.z) * n1[1] + bflo(w.w) * n1[2] + bfhi(w.w) * n1[3]; }
      qn += __shfl_xor(qn, 16); qn += __shfl_xor(qn, 32); }
    float den = 0.f;
    { const float rc = gl[128 + l];
#pragma unroll
      for (int j = 0; j < 8; ++j) { f32x4 acc = (f32x4){0.f, 0.f, 0.f, 0.f};
          if (j <= wave) {
#pragma unroll
              for (int ks = 0; ks < 4; ++ks) acc = __builtin_amdgcn_mfma_f32_16x16x32_bf16(rowfrag(T0, 16 * j, ks, fr, g), qf[ks], acc, 0, 0, 0);
#pragma unroll
              for (int e = 0; e < 4; ++e) { const int sx = 16 * j + 4 * g + e; acc[e] = (sx <= l) ? acc[e] * fexp_(rc + gl[sx]) : 0.f; den += acc[e]; } }
          *(LAS v2u*)(T1 + sw_off(l, 2 * j + (g >> 1)) + 8 * (g & 1)) = (v2u){pk2(acc[0], acc[1]), pk2(acc[2], acc[3])}; }
      den += __shfl_xor(den, 16); den += __shfl_xor(den, 32); }
    f32x4 acc[8];
    const float iw = gl[256 + l];
#pragma unroll
    for (int j = 0; j < 8; ++j) { acc[j] = (f32x4){0.f, 0.f, 0.f, 0.f};
#pragma unroll
        for (int ks = 0; ks < 4; ++ks) acc[j] = __builtin_amdgcn_mfma_f32_16x16x32_bf16(rowfrag(T2, 16 * j, ks, fr, g), qf[ks], acc[j], 0, 0, 0);
        acc[j] = acc[j] * iw; }
    asm volatile("s_waitcnt lgkmcnt(0)" ::: "memory");
#pragma unroll
    for (int ks = 0; ks < 4; ++ks) if (2 * ks <= wave) { const bf16x8 sf = rowfrag(T1, m0, ks, fr, g);
#pragma unroll
        for (int j = 0; j < 8; ++j) acc[j] = __builtin_amdgcn_mfma_f32_16x16x32_bf16(colfrag(T3, ks, j, fr, g), sf, acc[j], 0, 0, 0); }
    den += iw * qn;
    const float rden = frcp_(fmaxf(fabsf(den), gl[384 + l]));
    float sq = 0.f;
#pragma unroll
    for (int j = 0; j < 8; ++j) { acc[j] = acc[j] * rden; sq += (acc[j][0] * acc[j][0] + acc[j][1] * acc[j][1]) + (acc[j][2] * acc[j][2] + acc[j][3] * acc[j][3]); }
    sq += __shfl_xor(sq, 16); sq += __shfl_xor(sq, 32);
    const float rn = __builtin_amdgcn_rsqf(sq * (1.0f / 128.0f) + EPSN);
    const bf16* MOg = (const bf16*)(ws + WS_MO) + (t0 + l) * 512 + h * 128;
    bf16* yg = (bf16*)(ws + WS_Y) + (t0 + l) * 1024 + 512 + h * 128;
#pragma unroll
    for (int j = 0; j < 8; ++j) { const int e0 = 16 * j + 4 * g;
        const v2u mo = *(const v2u*)(MOg + e0), cc = cp[j];
        const f32x4 gm = *(const f32x4*)(g_mhn + h * 128 + e0), sk = *(const f32x4*)(skip_m + h * 128 + e0);
        const float y0 = sigmoidf_(bflo(mo.x)) * (acc[j][0] * rn * gm[0] + sk[0] * bflo(cc.x));
        const float y1 = sigmoidf_(bfhi(mo.x)) * (acc[j][1] * rn * gm[1] + sk[1] * bfhi(cc.x));
        const float y2 = sigmoidf_(bflo(mo.y)) * (acc[j][2] * rn * gm[2] + sk[2] * bflo(cc.y));
        const float y3 = sigmoidf_(bfhi(mo.y)) * (acc[j][3] * rn * gm[3] + sk[3] * bfhi(cc.y));
        *(v2u*)(yg + e0) = (v2u){pk2(y0, y1), pk2(y2, y3)}; }
    { f32x4 accn = (f32x4){0.f, 0.f, 0.f, 0.f};
#pragma unroll
      for (int j = 0; j < 8; ++j) acc[j] = (f32x4){0.f, 0.f, 0.f, 0.f};
#pragma unroll
      for (int ks = 0; ks < 4; ++ks) { const f32x4 w0 = *(const LAS f32x4*)(gl + 640 + 32 * ks + 8 * g), w1 = *(const LAS f32x4*)(gl + 640 + 32 * ks + 8 * g + 4);
          const v4u vr = __builtin_bit_cast(v4u, colfrag(T3, ks, wave, fr, g));
          const v4u vs = (v4u){pk2(bflo(vr.x) * w0[0], bfhi(vr.x) * w0[1]), pk2(bflo(vr.y) * w0[2], bfhi(vr.y) * w0[3]), pk2(bflo(vr.z) * w1[0], bfhi(vr.z) * w1[1]), pk2(bflo(vr.w) * w1[2], bfhi(vr.w) * w1[3])};
          const v4u wv = (v4u){pk2(w0[0], w0[1]), pk2(w0[2], w0[3]), pk2(w1[0], w1[1]), pk2(w1[2], w1[3])};
          const bf16x8 vf = __builtin_bit_cast(bf16x8, vs), wf = __builtin_bit_cast(bf16x8, wv);
#pragma unroll
          for (int j = 0; j < 8; ++j) { const bf16x8 kf = colfrag(T0, ks, j, fr, g); acc[j] = __builtin_amdgcn_mfma_f32_16x16x32_bf16(kf, vf, acc[j], 0, 0, 0);
              if (j == wave) accn = __builtin_amdgcn_mfma_f32_16x16x32_bf16(kf, wf, accn, 0, 0, 0); } }
      const float mnew = fmaxf(blast + st.m, mloc), a = fexp_(blast + st.m - mnew), cc = fexp_(mloc - mnew);
#pragma unroll
      for (int j = 0; j < 8; ++j) st.C[j] = st.C[j] * a + acc[j] * cc;
      if (fr == 0) *(LAS f32x4*)(gl + 768 + 16 * wave + 4 * g) = accn;
      __syncthreads();
      st.n0 = st.n0 * a + gl[768 + 2 * lane] * cc; st.n1 = st.n1 * a + gl[768 + 2 * lane + 1] * cc; st.m = mnew; }
}

struct EpiOutProj {
    static constexpr bool PERM = true, AFTER_DRAIN = false;
    const float* x; bf16* x1b; float* ss;
    __device__ __forceinline__ void operator()(const f32x4 (&acc)[2][2][4][2], const pg8::Unit& u, int wr, int wc, int fr, int fq) const {
        int row0 = u.pm * 256 + wr * 64 + fr; asm volatile("" : "+v"(row0));
        const int col0 = u.pn * 256 + wc * 32 + 8 * fq;
#pragma unroll
        for (int ai = 0; ai < 2; ++ai)
#pragma unroll
            for (int m = 0; m < 4; ++m) { const int row = row0 + ai * 128 + m * 16; float sq = 0.f;
#pragma unroll
                for (int bj = 0; bj < 2; ++bj) { const size_t off = (size_t)row * D + col0 + bj * 128;
                    const f32x4 o0 = *(const f32x4*)(x + off) + acc[ai][bj][m][0], o1 = *(const f32x4*)(x + off + 4) + acc[ai][bj][m][1];
                    *(v4u*)(x1b + off) = pack8(o0, o1);
                    sq += ((o0[0] * o0[0] + o0[1] * o0[1]) + (o0[2] * o0[2] + o0[3] * o0[3])) + ((o1[0] * o1[0] + o1[1] * o1[1]) + (o1[2] * o1[2] + o1[3] * o1[3])); }
                sq += __shfl_xor(sq, 16); sq += __shfl_xor(sq, 32);
                if (fq == 0) ss[(size_t)row * 16 + u.pn * 4 + wc] = sq; }
    }
};
struct FixedOrder {
    int pm, n;
    __device__ __forceinline__ bool next(int i, pg8::Unit& u) const { if (i >= n) return false; u.pm = pm; u.pn = i; u.aux = 0; return true; }
    __device__ __forceinline__ void a_ready(const pg8::Unit&) const {}
    __device__ __forceinline__ void done(const pg8::Unit&) const {}
};
struct EpiQx {
    static constexpr bool PERM = true, AFTER_DRAIN = false;
    bf16* qx; const LAS float* rs;
    __device__ __forceinline__ void operator()(const f32x4 (&acc)[2][2][4][2], const pg8::Unit& u, int wr, int wc, int fr, int fq) const {
        const int rl0 = wr * 64 + fr, col0 = wc * 32 + 8 * fq;
#pragma unroll
        for (int ai = 0; ai < 2; ++ai)
#pragma unroll
            for (int m = 0; m < 4; ++m) { const int rl = rl0 + ai * 128 + m * 16; const float sc = rs[rl]; bf16* rowp = qx + (size_t)(u.pm * 256 + rl) * 256 + col0;
#pragma unroll
                for (int bj = 0; bj < 2; ++bj) *(v4u*)(rowp + bj * 128) = pack8(acc[ai][bj][m][0] * sc, acc[ai][bj][m][1] * sc);
                asm volatile("" ::: "memory"); }
    }
};
struct EpiOx {
    static constexpr bool PERM = true, AFTER_DRAIN = false;
    const bf16* x1b; bf16* x2b;
    __device__ __forceinline__ void operator()(const f32x4 (&acc)[2][2][4][2], const pg8::Unit& u, int wr, int wc, int fr, int fq) const {
        int row0 = u.pm * 256 + wr * 64 + fr; asm volatile("" : "+v"(row0));
        const int col0 = u.pn * 256 + wc * 32 + 8 * fq;
#pragma unroll
        for (int ai = 0; ai < 2; ++ai)
#pragma unroll
            for (int m = 0; m < 4; ++m) {
#pragma unroll
                for (int bj = 0; bj < 2; ++bj) { const size_t off = (size_t)(row0 + ai * 128 + m * 16) * D + col0 + bj * 128; const v4u r = *(const v4u*)(x1b + off);
                    f32x4 o0 = acc[ai][bj][m][0], o1 = acc[ai][bj][m][1];
                    o0[0] += bflo(r.x); o0[1] += bfhi(r.x); o0[2] += bflo(r.y); o0[3] += bfhi(r.y); o1[0] += bflo(r.z); o1[1] += bfhi(r.z); o1[2] += bflo(r.w); o1[3] += bfhi(r.w);
                    *(v4u*)(x2b + off) = pack8(o0, o1); }
                asm volatile("" ::: "memory"); }
    }
};
__device__ __forceinline__ void cross_dma(const bf16* KV, int h, LAS unsigned char* buf, int lane, int wave) {
#pragma unroll
    for (int i = 0; i < 4; ++i) { const int inst = wave + 8 * i, row = 8 * inst + (lane >> 3);
        const bf16* src = KV + (size_t)row * NKV + h * 64 + ((lane & 7) ^ (lane >> 3)) * 8;
        glds16(src, (unsigned)__builtin_amdgcn_readfirstlane(lds_addr_of(buf + inst * 1024)));
        glds16(src + 256, (unsigned)__builtin_amdgcn_readfirstlane(lds_addr_of(buf + 32768 + inst * 1024))); }
}
__device__ __forceinline__ void cross_unit(const Args& A, unsigned char* lds, int pm, int tid, int lane, int wave) {
    asm volatile("" : "+v"(tid), "+v"(lane));
    unsigned char* ws = A.ws; LAS unsigned char* L = (LAS unsigned char*)lds;
    const size_t t0 = (size_t)pm * 256; const int b = (int)(t0 / SEQ);
    const bf16* KV = (const bf16*)(ws + WS_KVX) + (size_t)b * MEMLEN * NKV;
    const int fr = lane & 15, g = lane >> 4;
    cross_dma(KV, 0, L, lane, wave);
    for (int h = 0; h < 4; ++h) {
        asm volatile("s_waitcnt vmcnt(0)" ::: "memory");
        __syncthreads();
        LAS unsigned char* buf = L + (h & 1) * 65536;
        if (h < 3) cross_dma(KV, h + 1, L + ((h + 1) & 1) * 65536, lane, wave);
#pragma unroll 1
        for (int rt = 0; rt < 2; ++rt) {
            const size_t row = t0 + 32 * wave + 16 * rt + fr;
            const bf16* qg = (const bf16*)(ws + WS_QX) + row * 256 + h * 64;
            const bf16x8 q0 = *(const bf16x8*)(qg + 8 * g), q1 = *(const bf16x8*)(qg + 32 + 8 * g);
            f32x4 s[16];
#pragma unroll
            for (int t = 0; t < 16; ++t) { const int key = 16 * t + fr;
                s[t] = __builtin_amdgcn_mfma_f32_16x16x32_bf16(*(const LAS bf16x8*)(buf + key * 128 + (((g) ^ (key & 7)) * 16)), q0, (f32x4){0.f, 0.f, 0.f, 0.f}, 0, 0, 0);
                s[t] = __builtin_amdgcn_mfma_f32_16x16x32_bf16(*(const LAS bf16x8*)(buf + key * 128 + (((4 + g) ^ (key & 7)) * 16)), q1, s[t], 0, 0, 0); }
            float mx = -1e30f;
#pragma unroll
            for (int t = 0; t < 16; ++t) mx = fmaxf(fmaxf(mx, fmaxf(s[t][0], s[t][1])), fmaxf(s[t][2], s[t][3]));
            mx = fmaxf(mx, __shfl_xor(mx, 16)); mx = fmaxf(mx, __shfl_xor(mx, 32));
            float l = 0.f;
#pragma unroll
            for (int t = 0; t < 16; ++t)
#pragma unroll
                for (int e = 0; e < 4; ++e) { s[t][e] = __builtin_amdgcn_exp2f(s[t][e] - mx); l += s[t][e]; }
            l += __shfl_xor(l, 16); l += __shfl_xor(l, 32);
            f32x4 o[4];
#pragma unroll
            for (int dt = 0; dt < 4; ++dt) o[dt] = (f32x4){0.f, 0.f, 0.f, 0.f};
#pragma unroll
            for (int k8 = 0; k8 < 8; ++k8) {
                const v4u pw = (v4u){pk2(s[2 * k8][0], s[2 * k8][1]), pk2(s[2 * k8][2], s[2 * k8][3]), pk2(s[2 * k8 + 1][0], s[2 * k8 + 1][1]), pk2(s[2 * k8 + 1][2], s[2 * k8 + 1][3])};
                const bf16x8 pf = __builtin_bit_cast(bf16x8, pw);
                const int r0 = 32 * k8 + 4 * g + (fr >> 2), r1 = r0 + 16, p_ = fr & 3;
#pragma unroll
                for (int dt = 0; dt < 4; ++dt) { const int chunk = 2 * dt + (p_ >> 1);
                    const v4i16_t v0 = __builtin_amdgcn_ds_read_tr16_b64_v4i16((LAS v4i16_t*)(buf + 32768 + r0 * 128 + ((chunk ^ (r0 & 7)) * 16) + 8 * (p_ & 1)));
                    const v4i16_t v1 = __builtin_amdgcn_ds_read_tr16_b64_v4i16((LAS v4i16_t*)(buf + 32768 + r1 * 128 + ((chunk ^ (r1 & 7)) * 16) + 8 * (p_ & 1)));
                    const bf16x8 vf = (bf16x8){v0[0], v0[1], v0[2], v0[3], v1[0], v1[1], v1[2], v1[3]};
                    o[dt] = __builtin_amdgcn_mfma_f32_16x16x32_bf16(vf, pf, o[dt], 0, 0, 0); } }
            const float rl = frcp_(l);
            bf16* og = (bf16*)(ws + WS_OX) + row * 256 + h * 64;
#pragma unroll
            for (int dt = 0; dt < 4; ++dt) *(v2u*)(og + 16 * dt + 4 * g) = (v2u){pk2(o[dt][0] * rl, o[dt][1] * rl), pk2(o[dt][2] * rl, o[dt][3] * rl)};
        }
    }
    asm volatile("s_waitcnt vmcnt(0)" ::: "memory");
    __syncthreads();
}

struct TokInfo { int bucket; float wa, wb; int rank; };
constexpr size_t WS_RSTD3 = 18 * MiB;
constexpr size_t WS_CNTTAB = 31 * MiB + 512 * 1024;
__device__ __forceinline__ void p9_route(const Args& A, unsigned char* lds_, int tid, int lane, int wave) {
    asm volatile("" : "+v"(tid), "+v"(lane));
    unsigned char* ws = A.ws; LAS unsigned char* lds = (LAS unsigned char*)lds_;
    const float* b_rg = (const float*)(ws + WS_PAR) + PAR_BRG; const float* b_re = (const float*)(ws + WS_PAR) + PAR_BRE;
    constexpr int WLD = 2064;
    LAS unsigned char* Wh = lds; LAS unsigned char* Wl = lds + 20 * WLD;
    LAS float* lg = (LAS float*)(lds + 2 * 20 * WLD) + wave * (32 * 24);
    LAS int* bkl = (LAS int*)(lds + 2 * 20 * WLD + 8 * 32 * 24 * 4);
    for (int id = tid; id < 2 * 20 * 128; id += NTHR) { const int t = id / 2560, row = (id % 2560) >> 7, ch = id & 127;
        *(LAS v4u*)(lds + (t * 20 + row) * WLD + ch * 16) = *(const v4u*)((const bf16*)(ws + WS_WR) + ((size_t)t * 32 + row) * 1024 + ch * 8); }
    __syncthreads();
    const bf16* X2B = (const bf16*)(ws + WS_HBS);
    const int fr = lane & 15, g = lane >> 4;
    for (int chunk = blockIdx.x; chunk < T / 256; chunk += gridDim.x) {
        const bf16* xa = X2B + ((size_t)chunk * 256 + 32 * wave + fr) * D + 8 * g;
        f32x4 acc[2][2]; float sq[2] = {0.f, 0.f};
#pragma unroll
        for (int rt = 0; rt < 2; ++rt) { acc[rt][0] = (f32x4){0.f, 0.f, 0.f, 0.f}; acc[rt][1] = (f32x4){0.f, 0.f, 0.f, 0.f}; }
#pragma unroll 4
        for (int ks = 0; ks < 32; ++ks) {
            const bf16x8 a0 = *(const bf16x8*)(xa + 32 * ks), a1 = *(const bf16x8*)(xa + 16 * D + 32 * ks);
            { const v4u w0 = __builtin_bit_cast(v4u, a0), w1 = __builtin_bit_cast(v4u, a1);
              sq[0] += (bflo(w0.x) * bflo(w0.x) + bfhi(w0.x) * bfhi(w0.x)) + (bflo(w0.y) * bflo(w0.y) + bfhi(w0.y) * bfhi(w0.y)) + (bflo(w0.z) * bflo(w0.z) + bfhi(w0.z) * bfhi(w0.z)) + (bflo(w0.w) * bflo(w0.w) + bfhi(w0.w) * bfhi(w0.w));
              sq[1] += (bflo(w1.x) * bflo(w1.x) + bfhi(w1.x) * bfhi(w1.x)) + (bflo(w1.y) * bflo(w1.y) + bfhi(w1.y) * bfhi(w1.y)) + (bflo(w1.z) * bflo(w1.z) + bfhi(w1.z) * bfhi(w1.z)) + (bflo(w1.w) * bflo(w1.w) + bfhi(w1.w) * bfhi(w1.w)); }
#pragma unroll
            for (int ct = 0; ct < 2; ++ct) { const int wrow = (16 * ct + fr < 20) ? 16 * ct + fr : fr;
                const bf16x8 bh = *(const LAS bf16x8*)(Wh + wrow * WLD + 64 * ks + 16 * g), bl = *(const LAS bf16x8*)(Wl + wrow * WLD + 64 * ks + 16 * g);
                acc[0][ct] = __builtin_amdgcn_mfma_f32_16x16x32_bf16(bh, a0, acc[0][ct], 0, 0, 0); acc[0][ct] = __builtin_amdgcn_mfma_f32_16x16x32_bf16(bl, a0, acc[0][ct], 0, 0, 0);
                acc[1][ct] = __builtin_amdgcn_mfma_f32_16x16x32_bf16(bh, a1, acc[1][ct], 0, 0, 0); acc[1][ct] = __builtin_amdgcn_mfma_f32_16x16x32_bf16(bl, a1, acc[1][ct], 0, 0, 0); } }
#pragma unroll
        for (int rt = 0; rt < 2; ++rt) { sq[rt] += __shfl_xor(sq[rt], 16); sq[rt] += __shfl_xor(sq[rt], 32);
            LAS float* lr = lg + (16 * rt + fr) * 24;
            *(LAS f32x4*)(lr + 4 * g) = acc[rt][0];
            if (g == 0) { *(LAS f32x4*)(lr + 16) = acc[rt][1]; lr[20] = 1.0f / sqrtf(sq[rt] * (1.0f / D) + EPSN); } }
        asm volatile("s_waitcnt lgkmcnt(0)" ::: "memory");
        if (lane < 32) { const LAS float* lr = lg + lane * 24; const float rstd = lr[20];
            float gl4[4];
#pragma unroll
            for (int i = 0; i < 4; ++i) gl4[i] = lr[i] * rstd + b_rg[i];
            int gsel = 0; float gm = gl4[0];
#pragma unroll
            for (int i = 1; i < 4; ++i) if (gl4[i] > gm) { gm = gl4[i]; gsel = i; }
            float gs = 0.f;
#pragma unroll
            for (int i = 0; i < 4; ++i) gs += __expf(gl4[i] - gm);
            const float gw_ = 1.0f / gs;
            float el[4];
#pragma unroll
            for (int i = 0; i < 4; ++i) el[i] = lr[4 + 4 * gsel + i] * rstd + b_re[gsel * 4 + i];
            int i0 = 0; float v0 = el[0];
#pragma unroll
            for (int i = 1; i < 4; ++i) if (el[i] > v0) { v0 = el[i]; i0 = i; }
            int i1 = -1; float v1 = -INFINITY;
#pragma unroll
            for (int i = 0; i < 4; ++i) if (i != i0 && el[i] > v1) { v1 = el[i]; i1 = i; }
            const float e1 = __expf(v1 - v0); const float w0 = gw_ / (1.0f + e1), w1 = gw_ * e1 / (1.0f + e1);
            const int pa = i0 < i1 ? i0 : i1, pb = i0 < i1 ? i1 : i0;
            const int pidx = (pa == 0) ? (pb - 1) : (pa == 1 ? pb + 1 : 5);
            const int r = 32 * wave + lane;
            ((float*)(ws + WS_RSTD3))[chunk * 256 + r] = rstd; bkl[r] = gsel * 6 + pidx; ((LAS float*)(bkl + 256))[r] = (i0 < i1) ? w0 : w1; ((LAS float*)(bkl + 512))[r] = (i0 < i1) ? w1 : w0; }
        __syncthreads();
        if (tid < 256) { const int my = bkl[tid]; int rank = 0; for (int j = 0; j < tid; ++j) rank += (bkl[j] == my) ? 1 : 0;
            TokInfo ti; ti.bucket = my; ti.wa = ((LAS float*)(bkl + 256))[tid]; ti.wb = ((LAS float*)(bkl + 512))[tid]; ti.rank = rank;
            ((TokInfo*)(ws + WS_TOKINFO))[chunk * 256 + tid] = ti; }
        else if (tid < 256 + NBUCKET) { const int b = tid - 256; int c = 0; for (int j = 0; j < 256; ++j) c += (bkl[j] == b) ? 1 : 0;
            ((int*)(ws + WS_CNTTAB))[chunk * NBUCKET + b] = c; }
        __syncthreads();
    }
}
__device__ __forceinline__ void p10_slots(const Args& A, unsigned char* lds, int tid, int lane, int wave) {
    unsigned char* ws = A.ws;
    LAS int* tabl = (LAS int*)lds;
    LAS int* totl = (LAS int*)(lds + 32768);
    const int* CNTTAB = (const int*)(ws + WS_CNTTAB);
    for (int i = tid; i < 256 * NBUCKET; i += NTHR) tabl[i] = CNTTAB[i];
    __syncthreads();
    if (tid < NBUCKET) { int t = 0; for (int w = 0; w < 256; ++w) t += tabl[w * NBUCKET + tid]; totl[tid] = t; }
    __syncthreads();
    if (tid == 0) { int acc = 0; for (int b = 0; b < NBUCKET; ++b) { totl[32 + b] = acc; acc += ((totl[b] + 255) >> 8) * 256; } totl[32 + NBUCKET] = acc; }
    if (blockIdx.x == 0 && tid < NBUCKET) ((unsigned*)(ws + WS_CTL))[CW_CNT + tid] = (unsigned)totl[tid];
    __syncthreads();
    int* TOKMAP = (int*)(ws + WS_TOKMAP); float* WSORT = (float*)(ws + WS_WSORT);
    for (int chunk = blockIdx.x; chunk < T / 256; chunk += gridDim.x) {
        if (tid < NBUCKET) { int s = 0; for (int w = 0; w < chunk; ++w) s += tabl[w * NBUCKET + tid]; totl[64 + tid] = totl[32 + tid] + s; }
        __syncthreads();
        if (tid < 256) { const int m = chunk * 256 + tid; const TokInfo ti = ((const TokInfo*)(ws + WS_TOKINFO))[m]; const int slot = totl[64 + ti.bucket] + ti.rank;
            TOKMAP[slot] = m; *(f32x4*)(WSORT + 4 * slot) = (f32x4){ti.wa, ti.wb, ((const float*)(ws + WS_RSTD3))[m], 0.f}; }
        __syncthreads();
    }
    for (int b = blockIdx.x; b < NBUCKET; b += gridDim.x)
        for (int r = totl[32 + b] + totl[b] + tid; r < totl[32 + b + 1]; r += NTHR) { TOKMAP[r] = -1; *(f32x4*)(WSORT + 4 * r) = (f32x4){0.f, 0.f, 0.f, 0.f}; }
}
struct MoeOrder {
    int G, c, nunits, ncol; const int* tab;
    __device__ __forceinline__ bool next(int i, pg8::Unit& u) const {
        const long L = (long)i * G + c; if (L >= nunits) return false;
        const int rt = (int)L / ncol, j = (int)L % ncol, bk = tab[rt];
        u.pm = rt; u.aux = j;
        if (ncol == 8) { const int g = bk / 6, p = bk % 6; const int pa = (p < 3) ? 0 : (p < 5 ? 1 : 2), pb = (p < 3) ? p + 1 : (p < 5 ? p - 1 : 3);
            const int e = 4 * g + ((j >> 2) ? pb : pa); u.pn = e * 4 + (j & 3); }
        else u.pn = bk * 4 + j;
        return true;
    }
    __device__ __forceinline__ void a_ready(const pg8::Unit&) const {}
    __device__ __forceinline__ void done(const pg8::Unit&) const {}
};
struct EpiUp {
    static constexpr bool PERM = true, AFTER_DRAIN = false;
    bf16* act; const float* wsort;
    __device__ __forceinline__ void operator()(const f32x4 (&acc)[2][2][4][2], const pg8::Unit& u, int wr, int wc, int fr, int fq) const {
        int row0 = u.pm * 256 + wr * 64 + fr; asm volatile("" : "+v"(row0));
        const int half = u.aux >> 2, col0 = half * 512 + (u.aux & 3) * 128 + wc * 32 + 8 * fq;
#pragma unroll
        for (int ai = 0; ai < 2; ++ai)
#pragma unroll
            for (int m = 0; m < 4; ++m) { const int row = row0 + ai * 128 + m * 16; const float w = wsort[4 * row + half], rs = wsort[4 * row + 2];
                f32x4 r0, r1;
#pragma unroll
                for (int i = 0; i < 4; ++i) { const float a0 = acc[ai][0][m][0][i] * rs, a1 = acc[ai][0][m][1][i] * rs;
                    r0[i] = a0 * sigmoidf_(a0) * (acc[ai][1][m][0][i] * rs) * w; r1[i] = a1 * sigmoidf_(a1) * (acc[ai][1][m][1][i] * rs) * w; }
                *(v4u*)(act + (size_t)row * D + col0) = pack8(r0, r1); }
    }
};
struct EpiDown {
    static constexpr bool PERM = true, AFTER_DRAIN = false;
    const bf16* x2b; float* xo; const int* tokmap;
    __device__ __forceinline__ void operator()(const f32x4 (&acc)[2][2][4][2], const pg8::Unit& u, int wr, int wc, int fr, int fq) const {
        const int row0 = u.pm * 256 + wr * 64 + fr, col0 = u.aux * 256 + wc * 32 + 8 * fq;
#pragma unroll
        for (int ai = 0; ai < 2; ++ai)
#pragma unroll
            for (int m = 0; m < 4; ++m) { const int tok = tokmap[row0 + ai * 128 + m * 16];
                if (tok >= 0) {
#pragma unroll
                    for (int bj = 0; bj < 2; ++bj) { const size_t off = (size_t)tok * D + col0 + bj * 128; const v4u r = *(const v4u*)(x2b + off);
                        f32x4 o0 = acc[ai][bj][m][0], o1 = acc[ai][bj][m][1];
                        o0[0] += bflo(r.x); o0[1] += bfhi(r.x); o0[2] += bflo(r.y); o0[3] += bfhi(r.y); o1[0] += bflo(r.z); o1[1] += bfhi(r.z); o1[2] += bflo(r.w); o1[3] += bfhi(r.w);
                        *(f32x4*)(xo + off) = o0; *(f32x4*)(xo + off + 4) = o1; } } }
    }
};
constexpr size_t WS_XCH = 20 * MiB + 512 * 1024;
constexpr int CW_SEAM = 16384;
constexpr int LDS_EX = 139264;
struct EpiDownNorm {
    static constexpr bool PERM = true, AFTER_DRAIN = false;
    const bf16* x2b; float* out; const int* tokmap; const float* gfin; float* xch; unsigned* cnt; LAS unsigned char* ex;
    __device__ __forceinline__ void operator()(const f32x4 (&acc_)[2][2][4][2], const pg8::Unit& u, int wr, int wc, int fr, int fq) const {
        f32x4 (&acc)[2][2][4][2] = const_cast<f32x4 (&)[2][2][4][2]>(acc_);
        int tid = threadIdx.x; asm volatile("" : "+v"(tid));
        const int lane = tid & 63, wid = __builtin_amdgcn_readfirstlane(tid >> 6);
        int rb = wr * 64 + fr; asm volatile("" : "+v"(rb));
        LAS float* P = (LAS float*)ex; LAS float* S = (LAS float*)(ex + 4096); LAS unsigned* flag = (LAS unsigned*)(ex + 6144);
        const int col0 = u.aux * 256 + wc * 32 + 8 * fq;
#pragma unroll
        for (int ai = 0; ai < 2; ++ai)
#pragma unroll
            for (int m = 0; m < 4; ++m) { const int rl = rb + ai * 128 + m * 16; const int tok = tokmap[u.pm * 256 + rl]; float sq = 0.f;
#pragma unroll
                for (int bj = 0; bj < 2; ++bj) { f32x4& o0 = acc[ai][bj][m][0]; f32x4& o1 = acc[ai][bj][m][1];
                    if (tok >= 0) { const v4u r = *(const v4u*)(x2b + (size_t)tok * D + col0 + bj * 128);
                        o0[0] += bflo(r.x); o0[1] += bfhi(r.x); o0[2] += bflo(r.y); o0[3] += bfhi(r.y); o1[0] += bflo(r.z); o1[1] += bfhi(r.z); o1[2] += bflo(r.w); o1[3] += bfhi(r.w); }
                    sq += ((o0[0] * o0[0] + o0[1] * o0[1]) + (o0[2] * o0[2] + o0[3] * o0[3])) + ((o1[0] * o1[0] + o1[1] * o1[1]) + (o1[2] * o1[2] + o1[3] * o1[3])); }
                sq += __shfl_xor(sq, 16); sq += __shfl_xor(sq, 32);
                if (fq == 0) P[rl * 4 + wc] = sq;
                asm volatile("" ::: "memory"); }
        asm volatile("s_waitcnt lgkmcnt(0)" ::: "memory"); __builtin_amdgcn_s_barrier(); asm volatile("" ::: "memory");
        if (tid < 256) { const f32x4 p = *(const LAS f32x4*)(P + tid * 4);
            __hip_atomic_store(xch + ((size_t)u.pm * 256 + tid) * 4 + u.aux, (p[0] + p[1]) + (p[2] + p[3]), __ATOMIC_RELAXED, __HIP_MEMORY_SCOPE_AGENT); }
        asm volatile("s_waitcnt vmcnt(0)" ::: "memory");
        if (wid < 4 && lane == 0) __hip_atomic_fetch_add(cnt + 64 * u.pm, 1u, __ATOMIC_RELAXED, __HIP_MEMORY_SCOPE_AGENT);
        if (wid == 0) { unsigned spins = 0;
            while ((unsigned)__builtin_amdgcn_readfirstlane(__hip_atomic_load(cnt + 64 * u.pm, __ATOMIC_RELAXED, __HIP_MEMORY_SCOPE_AGENT)) < 16u) { __builtin_amdgcn_s_sleep(2); if (++spins > (1u << 22)) break; }
            __builtin_amdgcn_fence(__ATOMIC_ACQUIRE, "agent");
            if (lane == 0) flag[0] = spins; }
        asm volatile("s_waitcnt vmcnt(0) lgkmcnt(0)" ::: "memory"); __builtin_amdgcn_s_barrier(); asm volatile("" ::: "memory");
        if (tid < 256) { const float* sl = xch + ((size_t)u.pm * 256 + tid) * 4; float t = 0.f;
#pragma unroll
            for (int k = 0; k < 4; ++k) t += __hip_atomic_load(sl + k, __ATOMIC_RELAXED, __HIP_MEMORY_SCOPE_AGENT);
            S[tid] = 1.0f / sqrtf(t * (1.0f / D) + EPSN); }
        asm volatile("s_waitcnt lgkmcnt(0)" ::: "memory"); __builtin_amdgcn_s_barrier(); asm volatile("" ::: "memory");
#pragma unroll
        for (int ai = 0; ai < 2; ++ai)
#pragma unroll
            for (int m = 0; m < 4; ++m) { const int rl = rb + ai * 128 + m * 16; const int tok = tokmap[u.pm * 256 + rl]; const float rs = S[rl];
                if (tok >= 0) {
#pragma unroll
                    for (int bj = 0; bj < 2; ++bj)
#pragma unroll
                        for (int n = 0; n < 2; ++n) { const int cc = col0 + bj * 128 + 4 * n; acc[ai][bj][m][n] = acc[ai][bj][m][n] * rs; acc[ai][bj][m][n] = acc[ai][bj][m][n] * *(const f32x4*)(gfin + cc);
                            *(f32x4*)(out + (size_t)tok * D + cc) = acc[ai][bj][m][n]; asm volatile("" ::: "memory"); } } }
    }
};
__device__ __forceinline__ void p10_final(const Args& A, float* outp, int lane, int wave) {
    const float* g_final = (const float*)(A.ws + WS_PAR) + PAR_GFIN;
    const int G = gridDim.x, gw = blockIdx.x * NWAVES + wave, NGW = G * NWAVES;
    f32x4 gv[4];
#pragma unroll
    for (int j = 0; j < 4; ++j) gv[j] = *((const f32x4*)g_final + lane + 64 * j);
    for (int m = gw; m < T; m += NGW) {
        f32x4* xr = (f32x4*)(A.out + (size_t)m * D) + lane;
        f32x4 v[4]; float s = 0.f;
#pragma unroll
        for (int j = 0; j < 4; ++j) { v[j] = xr[64 * j]; s += (v[j].x * v[j].x + v[j].y * v[j].y) + (v[j].z * v[j].z + v[j].w * v[j].w); }
        const float rstd = 1.0f / sqrtf(wave_sum(s) * (1.0f / D) + EPSN);
#pragma unroll
        for (int j = 0; j < 4; ++j) ((f32x4*)(outp + (size_t)m * D) + lane)[64 * j] = v[j] * rstd * gv[j];
    }
}

#ifndef MS
#define MS 4
#endif
#ifndef N_LAUNCHES
#define N_LAUNCHES 1
#endif
constexpr int N_PHASES = 14;
#ifndef STAGGER
#define STAGGER 0
#endif
#ifndef FUSE_FINAL
#define FUSE_FINAL 1
#endif
#ifndef DUP_MASK
#define DUP_MASK 0
#endif
#define REP(k) for (int rep_ = 0; rep_ < (((DUP_MASK >> (k)) & 1) ? 2 : 1); ++rep_)
#ifndef QX_SP2
#define QX_SP2 false
#endif

#ifndef NVG
#define NVG 256
#endif
__global__ void __launch_bounds__(NTHR, 2) __attribute__((amdgpu_num_vgpr(NVG))) fwd_kernel(Args args) {
    __shared__ __attribute__((aligned(16))) unsigned char lds[LDS_BYTES];
    const int tid = threadIdx.x, lane = tid & 63, wave = __builtin_amdgcn_readfirstlane(tid >> 6);
    gu32* ctl = (gu32*)(args.ws + WS_CTL);
    for (int u = tid; u < (LDS_BYTES - LDS_MISC) / 4; u += NTHR) ((unsigned*)(lds + LDS_MISC))[u] = 0u;
    __syncthreads();
    const int lo = args.ph_lo, hi = args.ph_hi;
    const bool use_bar = (hi - lo) > 1;
    XcdBarrier bar; bar.bar = (unsigned*)ctl + CW_BAR; bar.x = 0; bar.st = (volatile LAS unsigned*)(lds + LDS_MISC) + 8;
    if (use_bar) bar = xcd_barrier_post((unsigned*)ctl + CW_BAR, (volatile LAS unsigned*)(lds + LDS_MISC) + 8);
#ifndef PH_MASK
#define PH_MASK 0xFFFF
#endif
#define IN(k) (((PH_MASK >> (k)) & 1) && lo <= (k) && (k) < hi)
#define SEAM(k) do { if (IN(k) && IN((k) + 1)) xcd_barrier(bar); } while (0)
    PG8_LAS unsigned char* ring = (PG8_LAS unsigned char*)lds;
    const int G = gridDim.x;
#define PHASE_PTRS Args pa = args; { unsigned char* w_ = args.ws; float* o_ = args.out; asm volatile("" : "+s"(w_), "+s"(o_)); pa.ws = w_; pa.out = o_; } unsigned char* const ws = pa.ws; (void)ws; int tid = (int)threadIdx.x; asm volatile("" : "+v"(tid)); const int lane = tid & 63; (void)lane

#ifdef DUMMY_LIVE
    float dl0, dl1, dl2, dl3, dl4, dl5, dl6, dl7; asm volatile("" : "=v"(dl0), "=v"(dl1), "=v"(dl2), "=v"(dl3), "=v"(dl4), "=v"(dl5), "=v"(dl6), "=v"(dl7));
#endif
    if (IN(0)) { PHASE_PTRS; REP(0) { p0_prologue(pa, lds, tid, lane, wave); __syncthreads(); } }
    SEAM(0);
    if (IN(1) && MS >= 1) { PHASE_PTRS;
        pg8::Gemm g{(const pg8::bf16_t*)(ws + WS_XN), (const pg8::bf16_t*)(ws + WS_WIN), T, NIN, D};
        pg8::StaticOrder S; S.init(T, NIN, G, (int)blockIdx.x);
        EpiInProj E{(bf16*)(ws + WS_Q), (const float*)(ws + WS_ROPE)};
        REP(1) pg8::gemm_phase<EpiInProj, pg8::StaticOrder, true, true>(ring, g, S, E);
    }
    SEAM(1);
    if (IN(2) && MS >= 1) { PHASE_PTRS;
        const int n_att = (MS >= 2) ? 3 * 4096 : 0;
        for (int tile = blockIdx.x; tile < 256; tile += G) kv_tile(pa, lds, tile, tid, lane, wave);
        __syncthreads();
        REP(14) attn_phase(pa, lds, n_att, lane, wave);
        { int wres = -1; MGroup mg; __syncthreads(); for (int it = blockIdx.x * 8; it < 2048; it += G * 8) for (int q = 0; q < 8; ++q) mlstm_p1_item(pa, lds, it + q, wres, mg, tid, lane, wave); }
    }
    if (IN(2) && IN(4)) xcd_barrier(bar);
    if (IN(4) && MS >= 1) { PHASE_PTRS;
        for (int rt = blockIdx.x; rt < T / 256; rt += G) combine_rows(pa, (size_t)rt * 256, 256, tid);
        for (int it = blockIdx.x * 8; it < 2048; it += G * 8) { MState st; mlstm2_entry(pa, it >> 6, (it & 63) >> 3, st, lane, wave);
            for (int q = 0; q < 8; ++q) mlstm_p2_item(pa, lds, it + q, st, tid, lane, wave); }
    }
    SEAM(4);
    if (IN(5) && MS >= 1) { PHASE_PTRS;
        const int pm = (int)blockIdx.x;
        if (pm < T / 256) {
            { pg8::Gemm g{(const pg8::bf16_t*)(ws + WS_Y), (const pg8::bf16_t*)(ws + WS_WOUT), T, D, D};
              FixedOrder S{pm, 4}; EpiOutProj E{(const float*)pa.in[0], (bf16*)(ws + WS_X1B), (float*)(ws + WS_SS1)};
              pg8::gemm_phase<EpiOutProj, FixedOrder, true, true>(ring, g, S, E); }
            VM_WAIT(); __syncthreads();
            float* rs = (float*)(lds + LDS_RS);
            if (tid < 256) { const f32x4* sp = (const f32x4*)((const float*)(ws + WS_SS1) + (size_t)(pm * 256 + tid) * 16);
                const f32x4 a = sp[0], b = sp[1], c = sp[2], d = sp[3];
                const float s = ((a[0] + a[1]) + (a[2] + a[3])) + ((b[0] + b[1]) + (b[2] + b[3])) + ((c[0] + c[1]) + (c[2] + c[3])) + ((d[0] + d[1]) + (d[2] + d[3]));
                rs[tid] = 1.0f / sqrtf(s * (1.0f / D) + EPSN); }
            __syncthreads();
            { pg8::Gemm g{(const pg8::bf16_t*)(ws + WS_X1B), (const pg8::bf16_t*)(ws + WS_WQX), T, 256, D};
              FixedOrder S{pm, 1}; EpiQx E{(bf16*)(ws + WS_QX), (const LAS float*)rs};
              pg8::gemm_phase<EpiQx, FixedOrder, true, QX_SP2>(ring, g, S, E); }
            VM_WAIT(); __syncthreads();
            cross_unit(pa, lds, pm, tid, lane, wave);
            { int kdyn = 256; asm volatile("" : "+s"(kdyn));
              pg8::Gemm g{(const pg8::bf16_t*)(ws + WS_OX), (const pg8::bf16_t*)(ws + WS_WOX), T, D, kdyn};
              FixedOrder S{pm, 4}; EpiOx E{(const bf16*)(ws + WS_X1B), (bf16*)(ws + WS_HBS)};
              pg8::gemm_phase<EpiOx, FixedOrder, false, false>(ring, g, S, E); }
            VM_WAIT(); __builtin_amdgcn_fence(__ATOMIC_ACQUIRE, "agent"); VM_WAIT(); __syncthreads();
        }
        if (MS >= 4) p9_route(pa, lds, tid, lane, wave);
    }
    SEAM(9);
    if (IN(10) && MS >= 4) { PHASE_PTRS; p10_slots(pa, lds, tid, lane, wave); }
    SEAM(10);
    if ((IN(11) || IN(12)) && MS >= 4) { PHASE_PTRS;
        int* tab = (int*)(lds + LDS_TAB);
        if (tid == 0) { int nrt = 0; const unsigned* cnt = (const unsigned*)(ws + WS_CTL) + CW_CNT;
            for (int i = 0; i < NBUCKET; ++i) { const int nt = (int)((__hip_atomic_load(cnt + i, __ATOMIC_RELAXED, __HIP_MEMORY_SCOPE_AGENT) + 255u) >> 8); for (int k = 0; k < nt; ++k) tab[1 + nrt++] = i; }
            tab[0] = nrt; }
        __syncthreads();
        const int nrt = tab[0];
        if (IN(11)) {
            if (STAGGER && ((blockIdx.x >> 2) & 1)) { for (int i = 0; i < STAGGER; ++i) __builtin_amdgcn_s_sleep(127); }
            pg8::Gemm g{(const pg8::bf16_t*)(ws + WS_HBS), (const pg8::bf16_t*)(ws + WS_W13), ROWS_MAX, 64 * 256, D, (const int*)(ws + WS_TOKMAP)};
            MoeOrder S{G, (int)blockIdx.x, nrt * 8, 8, tab + 1};
            EpiUp E{(bf16*)(ws + WS_ACT), (const float*)(ws + WS_WSORT)};
            REP(11) pg8::gemm_phase<EpiUp, MoeOrder, true, true, true>(ring, g, S, E);
        }
        SEAM(11);
        if (IN(12)) {
            pg8::Gemm g{(const pg8::bf16_t*)(ws + WS_ACT), (const pg8::bf16_t*)(ws + WS_W2P), ROWS_MAX, 96 * 256, D};
            MoeOrder S{G, (int)blockIdx.x, nrt * 4, 4, tab + 1};
#if FUSE_FINAL
            EpiDownNorm E{(const bf16*)(ws + WS_HBS), pa.out, (const int*)(ws + WS_TOKMAP), (const float*)(ws + WS_PAR) + PAR_GFIN, (float*)(ws + WS_XCH), (unsigned*)(ws + WS_CTL) + CW_SEAM, (LAS unsigned char*)(lds + LDS_EX)};
            pg8::gemm_phase<EpiDownNorm, MoeOrder, true, true>(ring, g, S, E);
#else
            EpiDown E{(const bf16*)(ws + WS_HBS), pa.out, (const int*)(ws + WS_TOKMAP)};
            REP(12) pg8::gemm_phase<EpiDown, MoeOrder, true, true>(ring, g, S, E);
#endif
        }
    }
    if (!FUSE_FINAL) SEAM(12);
    if (IN(13) && !FUSE_FINAL) { PHASE_PTRS; REP(13) p10_final(pa, (((DUP_MASK >> 13) & 1) && rep_ == 0) ? (float*)(ws + 544 * MiB) : pa.out, lane, wave); }
#ifdef DUMMY_LIVE
    asm volatile("" :: "v"(dl0), "v"(dl1), "v"(dl2), "v"(dl3), "v"(dl4), "v"(dl5), "v"(dl6), "v"(dl7));
#endif
#undef IN
#undef SEAM
}

extern "C" void kernel_launch(void* const* d_in, const int* in_sizes, int n_in, void* d_out, int out_size, void* d_ws, size_t ws_size, hipStream_t stream) {
    static int grid = 0;
    if (grid == 0) {
        if (n_in != 28 || out_size != T * D || ws_size < WS_END) { fprintf(stderr, "kernel_launch: unexpected problem (n_in %d, out %d, ws %zu)\n", n_in, out_size, ws_size); grid = -1; return; }
        int dev = 0, cus = 0, per_cu = 0;
        if (hipGetDevice(&dev) != hipSuccess || hipDeviceGetAttribute(&cus, hipDeviceAttributeMultiprocessorCount, dev) != hipSuccess) { grid = -1; return; }
        if (hipOccupancyMaxActiveBlocksPerMultiprocessor(&per_cu, (const void*)fwd_kernel, NTHR, 0) != hipSuccess || per_cu < 1) { fprintf(stderr, "kernel_launch: occupancy query failed (%d)\n", per_cu); per_cu = 1; }
        (void)hipGetLastError();
        grid = cus * (per_cu > 1 ? 1 : per_cu);
        if (grid > 256) grid = 256;
    }
    if (grid < 0) return;
    (void)hipMemsetAsync((char*)d_ws + WS_CTL, 0, CTL_ZERO_BYTES, stream);
    Args a{};
    for (int i = 0; i < 28; ++i) a.in[i] = d_in[i];
    a.out = (float*)d_out; a.ws = (unsigned char*)d_ws;
    if (N_LAUNCHES == 1) {
        a.ph_lo = 0; a.ph_hi = N_PHASES;
        void* kargs[] = {&a};
        hipError_t e = hipLaunchCooperativeKernel((const void*)fwd_kernel, dim3(grid), dim3(NTHR), kargs, 0, stream);
        if (e != hipSuccess) fprintf(stderr, "kernel_launch: cooperative launch failed: %s (grid %d)\n", hipGetErrorString(e), grid);
    } else {
        for (int p = 0; p < N_PHASES; ++p) { a.ph_lo = p; a.ph_hi = p + 1; hipLaunchKernelGGL(fwd_kernel, dim3(grid), dim3(NTHR), 0, stream, a); }
    }
}
```

```cpp
#include <hip/hip_runtime.h>
#include <cstdio>
#include <cstdint>
namespace pg8 {
#define PG8_LAS __attribute__((address_space(3)))
typedef unsigned short bf16_t;
typedef short bf16x8 __attribute__((ext_vector_type(8)));
typedef float f32x4 __attribute__((ext_vector_type(4)));
typedef unsigned u32x4 __attribute__((ext_vector_type(4)));
constexpr int BM = 256, BK = 64, HALF = 128, HTB = HALF * BK * 2  , STAGE_BYTES = 8 * HTB, NXCD = 8, WGM = 8;

__host__ __device__ __forceinline__ int lds_byte(int r, int c) { const int st = (r >> 4) * 2 + (c >> 5), rr = r & 15, cc = c & 31, ob = rr * 64 + cc * 2; return st * 1024 + (ob ^ (((ob >> 9) & 1) << 5)); }
__host__ __device__ __forceinline__ void stage_rc(int b, int& R, int& C) { const int st = b / 1024, sb = b % 1024, swz = sb ^ (((sb >> 9) & 1) << 5); R = (st >> 1) * 16 + swz / 64; C = (st & 1) * 32 + (swz % 64) / 2; }
__host__ __device__ __forceinline__ int perm32(int rho) { const int n = rho >> 4, i = rho & 15; return 8 * (i >> 2) + 4 * n + (i & 3); }

struct Unit { int pm, pn, aux; };
struct Gemm { const bf16_t* A; const bf16_t* Bt; int M, N, K; const int* rowmap; };

struct StaticOrder {
    int nM, nN, nwg, G, c;
    __host__ __device__ __forceinline__ void init(int M, int N, int G_, int c_) { nM = M / BM; nN = N / BM; nwg = nM * nN; G = G_; c = c_; }
    __host__ __device__ __forceinline__ bool next(int i, Unit& u) const {
        const long L = (long)i * G + c; if (L >= nwg) return false;
        int wgid = (int)L; { const int q = nwg / NXCD, r = nwg % NXCD, xcd = wgid % NXCD, off = wgid / NXCD; wgid = (xcd < r ? xcd * (q + 1) : r * (q + 1) + (xcd - r) * q) + off; }
        const int nig = WGM * nN, gid = wgid / nig, fm = gid * WGM, gsz = (nM - fm) < WGM ? (nM - fm) : WGM;
        u.pm = fm + ((wgid % nig) % gsz); u.pn = (wgid % nig) / gsz; u.aux = 0; return true;
    }
    __device__ __forceinline__ void a_ready(const Unit&) const {}
    __device__ __forceinline__ void done(const Unit&) const {}
};

__device__ __forceinline__ unsigned cvt_pk_bf16(float lo, float hi) { unsigned r; asm volatile("v_cvt_pk_bf16_f32 %0, %1, %2" : "=v"(r) : "v"(lo), "v"(hi)); return r; }
template <class Epi, class Sched, bool ALIGN_EPI = false, bool SP2 = false, bool GATHER = false>
__device__ __forceinline__ void gemm_phase(PG8_LAS unsigned char* lds, const Gemm g, const Sched& S, const Epi& E) {
    int tid = threadIdx.x; asm volatile("" : "+v"(tid));
    const int wid = __builtin_amdgcn_readfirstlane(tid >> 6), lane = tid & 63, wr = wid >> 2, wc = wid & 3, fr = lane & 15, fq = lane >> 4;
    const int K = g.K, nt = K / BK;
    unsigned voffA[2], voffB[2];
#pragma unroll
    for (int i = 0; i < 2; ++i) { int R, C; stage_rc(tid * 16 + i * 8192, R, C); const int Rb = Epi::PERM ? ((R & ~31) + perm32(R & 31)) : R;
        voffA[i] = (unsigned)(R * K + C) * 2u; voffB[i] = (unsigned)(Rb * K + C) * 2u; }
    unsigned gc[2][2] = {{0u, 0u}, {0u, 0u}}, gn[2][2] = {{0u, 0u}, {0u, 0u}};
#define PG8_GLOAD(gv, pm_) do { _Pragma("unroll") for (int _h = 0; _h < 2; ++_h) _Pragma("unroll") for (int _i = 0; _i < 2; ++_i) { int _R, _C; stage_rc(tid * 16 + _i * 8192, _R, _C); \
        int _row = g.rowmap[(pm_) * BM + _h * HALF + _R]; _row = _row < 0 ? 0 : _row; gv[_h][_i] = (unsigned)(_row * K + _C) * 2u; } } while (0)
    const size_t kstep = (size_t)(BK * 2);
    const size_t hstep = (size_t)HALF * K * 2;
    const size_t tstep = 2 * hstep;
    const unsigned ldsw = (unsigned)wid * 1024u;
    const int aoff = lds_byte(wr * 64 + fr, fq * 8), boff = lds_byte(wc * 32 + fr, fq * 8);
#define PG8_SA(b, h) (((b) * 2 + (h)) * HTB)
#define PG8_SB(b, h) ((4 + (b) * 2 + (h)) * HTB)
#define PG8_STAGE(bufoff, gbase, voff) do { _Pragma("unroll") for (int _i = 0; _i < 2; ++_i) \
        __builtin_amdgcn_global_load_lds((const unsigned*)((const char*)(gbase) + (voff)[_i]), (PG8_LAS unsigned*)(lds + (bufoff) + ldsw + _i * 8192), 16, 0, 0); } while (0)
#define PG8_STAGE_A(bufoff, gbase, h, sel) do { if constexpr (GATHER) { unsigned vo_[2]; vo_[0] = (sel) ? gn[h][0] : gc[h][0]; vo_[1] = (sel) ? gn[h][1] : gc[h][1]; PG8_STAGE(bufoff, gbase, vo_); } \
        else { PG8_STAGE(bufoff, (gbase) + (h) * hstep, voffA); } } while (0)
#define PG8_LDA(dst, b, h) do { _Pragma("unroll") for (int m = 0; m < 4; ++m) _Pragma("unroll") for (int k = 0; k < 2; ++k) dst[m][k] = *(const PG8_LAS bf16x8*)(lds + PG8_SA(b, h) + aoff + m * 2048 + k * 1024); } while (0)
#define PG8_LDB(dst, b, h) do { _Pragma("unroll") for (int n = 0; n < 2; ++n) _Pragma("unroll") for (int k = 0; k < 2; ++k) dst[n][k] = *(const PG8_LAS bf16x8*)(lds + PG8_SB(b, h) + boff + n * 2048 + k * 1024); } while (0)
#define PG8_MMA(ai, bj, At, Bt) do { __builtin_amdgcn_s_setprio(1); _Pragma("unroll") for (int m = 0; m < 4; ++m) _Pragma("unroll") for (int n = 0; n < 2; ++n) _Pragma("unroll") for (int k = 0; k < 2; ++k) \
        acc[ai][bj][m][n] = __builtin_amdgcn_mfma_f32_16x16x32_bf16(Bt[n][k], At[m][k], acc[ai][bj][m][n], 0, 0, 0); __builtin_amdgcn_s_setprio(0); } while (0)
#define PG8_WAIT_V(n) asm volatile("s_waitcnt vmcnt(" #n ")" ::: "memory")
#define PG8_WAIT_L(n) asm volatile("s_waitcnt lgkmcnt(" #n ")" ::: "memory")
#define PG8_BAR __builtin_amdgcn_s_barrier()
#define PG8_SCHED __builtin_amdgcn_sched_barrier(0)
    Unit cur, nxt; int ui = 0;
    if (!S.next(0, cur)) return;
    f32x4 acc[2][2][4][2];
#pragma unroll
    for (int a = 0; a < 2; ++a)
#pragma unroll
        for (int b = 0; b < 2; ++b)
#pragma unroll
            for (int m = 0; m < 4; ++m)
#pragma unroll
                for (int n = 0; n < 2; ++n) acc[a][b][m][n] = (f32x4){0.f, 0.f, 0.f, 0.f};
    bf16x8 At[4][2], B0[2][2], B1[2][2];
    const char* cA = GATHER ? (const char*)g.A : (const char*)g.A + (size_t)cur.pm * tstep; const char* cB = (const char*)g.Bt + (size_t)cur.pn * tstep;
    if constexpr (GATHER) { PG8_GLOAD(gc, cur.pm); }
    S.a_ready(cur);
    if constexpr (SP2) {
        PG8_STAGE(PG8_SB(0, 0), cB, voffB); PG8_STAGE(PG8_SB(0, 1), cB + hstep, voffB); PG8_STAGE_A(PG8_SA(0, 0), cA, 0, false); PG8_STAGE_A(PG8_SA(0, 1), cA, 1, false);
        if (wr == 1) PG8_BAR;
        PG8_WAIT_V(2); PG8_BAR;
        PG8_STAGE(PG8_SB(1, 0), cB + kstep, voffB); PG8_STAGE_A(PG8_SA(1, 0), cA + kstep, 0, false); PG8_STAGE(PG8_SB(1, 1), cB + hstep + kstep, voffB);
        PG8_WAIT_V(6); PG8_BAR;
    } else {
        PG8_STAGE(PG8_SB(0, 0), cB, voffB); PG8_STAGE_A(PG8_SA(0, 0), cA, 0, false); PG8_STAGE(PG8_SB(0, 1), cB + hstep, voffB); PG8_STAGE_A(PG8_SA(0, 1), cA, 1, false);
        if (wr == 1) PG8_BAR;
        PG8_WAIT_V(4); PG8_BAR;
        PG8_STAGE(PG8_SB(1, 0), cB + kstep, voffB); PG8_STAGE_A(PG8_SA(1, 0), cA + kstep, 0, false); PG8_STAGE(PG8_SB(1, 1), cB + hstep + kstep, voffB);
        PG8_WAIT_V(6); PG8_BAR;
    }
    for (;;) {
        const bool has_next = S.next(ui + 1, nxt);
        const char* nA = GATHER ? cA : (has_next ? (const char*)g.A + (size_t)nxt.pm * tstep : cA);
        if constexpr (GATHER) { if (has_next) { PG8_GLOAD(gn, nxt.pm); } else { gn[0][0] = gc[0][0]; gn[0][1] = gc[0][1]; gn[1][0] = gc[1][0]; gn[1][1] = gc[1][1]; } }
        const char* nB = has_next ? (const char*)g.Bt + (size_t)nxt.pn * tstep : cB;
        for (int t = 0; t < nt; t += 2) {
            const bool last = (t == nt - 2);
            const char* a1 = cA + (size_t)(t + 1) * kstep;
            const char* a2 = last ? nA : cA + (size_t)(t + 2) * kstep; const char* b2 = last ? nB : cB + (size_t)(t + 2) * kstep;
            const char* a3 = a2 + kstep; const char* b3 = b2 + kstep;
            if (last && has_next) S.a_ready(nxt);
            if constexpr (SP2) {
            PG8_LDB(B0, 0, 0); PG8_LDB(B1, 0, 1); PG8_SCHED; PG8_LDA(At, 0, 0); PG8_STAGE_A(PG8_SA(1, 1), a1, 1, false);
            PG8_WAIT_V(8); PG8_WAIT_L(0); PG8_BAR; PG8_MMA(0, 0, At, B0); PG8_MMA(0, 1, At, B1); PG8_BAR; PG8_SCHED;
            PG8_LDA(At, 0, 1); PG8_STAGE(PG8_SB(0, 0), b2, voffB); PG8_STAGE(PG8_SB(0, 1), b2 + hstep, voffB); PG8_STAGE_A(PG8_SA(0, 0), a2, 0, last);
            PG8_WAIT_V(8); PG8_WAIT_L(0); PG8_BAR; PG8_MMA(1, 0, At, B0); PG8_MMA(1, 1, At, B1); PG8_BAR; PG8_SCHED;
            PG8_LDB(B0, 1, 0); PG8_LDB(B1, 1, 1); PG8_SCHED; PG8_LDA(At, 1, 0); PG8_STAGE_A(PG8_SA(0, 1), a2, 1, last);
            PG8_WAIT_V(8); PG8_WAIT_L(0); PG8_BAR; PG8_MMA(0, 0, At, B0); PG8_MMA(0, 1, At, B1); PG8_BAR; PG8_SCHED;
            PG8_LDA(At, 1, 1); PG8_STAGE(PG8_SB(1, 0), b3, voffB); PG8_STAGE(PG8_SB(1, 1), b3 + hstep, voffB); PG8_STAGE_A(PG8_SA(1, 0), a3, 0, last);
            PG8_WAIT_V(8); PG8_WAIT_L(0); PG8_BAR; PG8_MMA(1, 0, At, B0); PG8_MMA(1, 1, At, B1); PG8_BAR; PG8_SCHED;
            } else {
            PG8_LDB(B0, 0, 0); PG8_SCHED; PG8_LDA(At, 0, 0); PG8_STAGE_A(PG8_SA(1, 1), a1, 1, false);
            PG8_WAIT_L(8); PG8_BAR; PG8_WAIT_L(0); PG8_MMA(0, 0, At, B0); PG8_BAR; PG8_SCHED;
            PG8_LDB(B1, 0, 1); PG8_STAGE(PG8_SB(0, 0), b2, voffB);
            PG8_BAR; PG8_WAIT_L(0); PG8_MMA(0, 1, At, B1); PG8_BAR;
            PG8_LDA(At, 0, 1); PG8_STAGE_A(PG8_SA(0, 0), a2, 0, last);
            PG8_BAR; PG8_WAIT_L(0); PG8_MMA(1, 0, At, B0); PG8_BAR; PG8_SCHED;
            PG8_STAGE(PG8_SB(0, 1), b2 + hstep, voffB);
            PG8_WAIT_V(6); PG8_BAR; PG8_MMA(1, 1, At, B1); PG8_BAR;
            PG8_LDB(B0, 1, 0); PG8_SCHED; PG8_LDA(At, 1, 0); PG8_STAGE_A(PG8_SA(0, 1), a2, 1, last);
            PG8_WAIT_L(8); PG8_BAR; PG8_WAIT_L(0); PG8_MMA(0, 0, At, B0); PG8_BAR; PG8_SCHED;
            PG8_LDB(B1, 1, 1); PG8_STAGE(PG8_SB(1, 0), b3, voffB);
            PG8_BAR; PG8_WAIT_L(0); PG8_MMA(0, 1, At, B1); PG8_BAR;
            PG8_LDA(At, 1, 1); PG8_STAGE_A(PG8_SA(1, 0), a3, 0, last);
            PG8_BAR; PG8_WAIT_L(0); PG8_MMA(1, 0, At, B0); PG8_BAR; PG8_SCHED;
            PG8_STAGE(PG8_SB(1, 1), b3 + hstep, voffB);
            PG8_WAIT_V(6); PG8_BAR; PG8_MMA(1, 1, At, B1); PG8_BAR;
            }
        }
        if constexpr (ALIGN_EPI) { if (wr == 0) PG8_BAR; }
        if constexpr (!Epi::AFTER_DRAIN) { E(acc, cur, wr, wc, fr, fq); S.done(cur); }
        if (!has_next) break;
#pragma unroll
        for (int a = 0; a < 2; ++a)
#pragma unroll
            for (int b = 0; b < 2; ++b)
#pragma unroll
                for (int m = 0; m < 4; ++m)
#pragma unroll
                    for (int n = 0; n < 2; ++n) acc[a][b][m][n] = (f32x4){0.f, 0.f, 0.f, 0.f};
        cur = nxt; cA = nA; cB = nB; ++ui;
        if constexpr (GATHER) { gc[0][0] = gn[0][0]; gc[0][1] = gn[0][1]; gc[1][0] = gn[1][0]; gc[1][1] = gn[1][1]; }
        if constexpr (ALIGN_EPI) { if (wr == 1) PG8_BAR; }
    }
    PG8_WAIT_V(0);
    if constexpr (!ALIGN_EPI) { if (wr == 0) PG8_BAR; }
    PG8_BAR;
    if constexpr (Epi::AFTER_DRAIN) { E.fused(acc, cur, wr, wc, fr, fq, lds, wid, lane); S.done(cur); }
#undef PG8_SA
#undef PG8_SB
#undef PG8_STAGE
#undef PG8_STAGE_A
#undef PG8_GLOAD
#undef PG8_LDA
#undef PG8_LDB
#undef PG8_MMA
#undef PG8_WAIT_V
#undef PG8_WAIT_L
#undef PG8_BAR
#undef PG8_SCHED
}
}

#define GAS __attribute__((address_space(1)))
#define LAS __attribute__((address_space(3)))
typedef unsigned short bf16;
typedef unsigned v4u __attribute__((ext_vector_type(4)));
typedef unsigned v2u __attribute__((ext_vector_type(2)));
typedef float f32x4 __attribute__((ext_vector_type(4)));
typedef short bf16x8 __attribute__((ext_vector_type(8)));
typedef GAS unsigned gu32;

constexpr int NWAVES = 8, NTHR = 512;
constexpr int BATCH = 8, SEQ = 8192, T = BATCH * SEQ, D = 1024, MEMLEN = 256, TMEM = BATCH * MEMLEN;
constexpr int INW = 3080, NIN = 3072, NKV = 512;
constexpr int NBUCKET = 24, ROWS_MAX = T + NBUCKET * 256;
constexpr float EPSN = 1e-6f;
constexpr float C2 = 0.125f * 1.4426950408889634f;
constexpr float LOG2E = 1.4426950408889634f;

constexpr size_t MiB = 1u << 20;
constexpr size_t WS_CTL = 0, CTL_ZERO_BYTES = 1 * MiB;
constexpr size_t WS_ROPE = 2 * MiB;
constexpr size_t WS_IG = 6 * MiB;
constexpr size_t WS_FG = 7 * MiB;
constexpr size_t WS_LSE = 8 * MiB;
constexpr size_t WS_SS1 = 14 * MiB;
constexpr size_t WS_SS3 = 18 * MiB;
constexpr size_t WS_KVX = 22 * MiB;
constexpr size_t WS_NLOC = 24 * MiB;
constexpr size_t WS_NPREV = 25 * MiB;
constexpr size_t WS_MLOC = 26 * MiB;
constexpr size_t WS_BLAST = 26 * MiB + 64 * 1024;
constexpr size_t WS_MPREV = 26 * MiB + 128 * 1024;
constexpr size_t WS_TOKINFO = 27 * MiB;
constexpr size_t WS_TOKMAP = 28 * MiB;
constexpr size_t WS_WSORT = 19 * MiB;
constexpr size_t WS_WR = 30 * MiB;
constexpr size_t WS_WG = 30 * MiB + 512 * 1024;
constexpr size_t WS_PAR = 31 * MiB;
constexpr int PAR_CONVW = 0, PAR_CONVB = 2048, PAR_GMHN = 2560, PAR_SKIP = 3072, PAR_BRG = 3584, PAR_BRE = 3600, PAR_GFIN = 3616, PAR_N = 4640;
constexpr size_t WS_WIN = 32 * MiB;
constexpr size_t WS_WOUT = 39 * MiB;
constexpr size_t WS_WQX = 41 * MiB;
constexpr size_t WS_WOX = 41 * MiB + 512 * 1024;
constexpr size_t WS_WM = 42 * MiB;
constexpr size_t WS_W13 = 44 * MiB;
constexpr size_t WS_W2P = 76 * MiB;
constexpr size_t WS_XN = 128 * MiB;
constexpr size_t WS_CLOC = 128 * MiB;
constexpr size_t WS_GAGG = 192 * MiB;
constexpr size_t WS_GN = 200 * MiB;
constexpr size_t WS_GSC = 200 * MiB + 512 * 1024;
constexpr size_t WS_Q = 264 * MiB;
constexpr size_t WS_K = 328 * MiB, WS_V = 392 * MiB, WS_MU = 456 * MiB, WS_MV = 520 * MiB, WS_MO = 584 * MiB;
constexpr size_t WS_MQ = 648 * MiB, WS_MK = 712 * MiB;
constexpr size_t WS_Y = 264 * MiB;
constexpr size_t WS_CPREV = 392 * MiB;
constexpr size_t WS_X1B = 648 * MiB;
constexpr size_t WS_QX = 776 * MiB;
constexpr size_t WS_OX = 808 * MiB;
constexpr size_t WS_HBS = 264 * MiB;
constexpr size_t WS_ACT = 404 * MiB;
constexpr size_t WS_END = 840 * MiB;
constexpr size_t DO_OATT = 0, DO_C = 192 * MiB;

constexpr int CW_BAR = 4096;
constexpr int CW_CNT = 8192;
constexpr int CW_FILL = 8192 + 64;

constexpr int LDS_BYTES = 163840;
constexpr int LDS_MISC = 159744;
constexpr int LDS_RS = 135168;
constexpr int LDS_TAB = 136192;

#define LDS_WAIT() asm volatile("s_waitcnt lgkmcnt(0)" ::: "memory")
#define VM_WAIT() asm volatile("s_waitcnt vmcnt(0)" ::: "memory")
__device__ __forceinline__ unsigned f2bf(float f) { unsigned u = __builtin_bit_cast(unsigned, f); return (u + 0x7fffu + ((u >> 16) & 1u)) >> 16; }
typedef float f32x2_t __attribute__((ext_vector_type(2))); typedef __bf16 bf16x2_t __attribute__((ext_vector_type(2)));
__device__ __forceinline__ unsigned pk2(float lo, float hi) { f32x2_t v = {lo, hi}; bf16x2_t b = __builtin_convertvector(v, bf16x2_t); return __builtin_bit_cast(unsigned, b); }
__device__ __forceinline__ float bf2f(unsigned h) { return __uint_as_float(h << 16); }
__device__ __forceinline__ float bflo(unsigned w) { return __uint_as_float(w << 16); }
__device__ __forceinline__ float bfhi(unsigned w) { return __uint_as_float(w & 0xffff0000u); }
__device__ __forceinline__ float wave_sum(float v) {
#pragma unroll
    for (int o = 1; o < 64; o <<= 1) v += __shfl_xor(v, o);
    return v;
}
__device__ __forceinline__ float wave_max(float v) {
#pragma unroll
    for (int o = 1; o < 64; o <<= 1) v = fmaxf(v, __shfl_xor(v, o));
    return v;
}
__device__ __forceinline__ float fexp_(float x) { return __builtin_amdgcn_exp2f(x * 1.4426950408889634f); }
__device__ __forceinline__ float frcp_(float x) { return __builtin_amdgcn_rcpf(x); }
__device__ __forceinline__ float sigmoidf_(float x) { return __builtin_amdgcn_rcpf(1.0f + __builtin_amdgcn_exp2f(x * -1.4426950408889634f)); }

#define XB_TMO      128
#define XB_XCNT(j)  (256  + 64 * (j))
#define XB_XSUB(j)  (1280 + 64 * (j))
#define XB_XGEN(j)  (2304 + 64 * (j))
#define XB_TOP      3328
#define XB_TOPGEN   3392
#define XCD_BAR_WORDS 3456
#define XB_SPIN_CAP (1u << 22)
__device__ __forceinline__ unsigned xb_ld(unsigned* p)              { return __hip_atomic_load(p, __ATOMIC_RELAXED, __HIP_MEMORY_SCOPE_AGENT); }
__device__ __forceinline__ unsigned xb_add(unsigned* p, unsigned v) { return __hip_atomic_fetch_add(p, v, __ATOMIC_RELAXED, __HIP_MEMORY_SCOPE_AGENT); }
__device__ __forceinline__ unsigned xb_xcc_id() { return (unsigned)__builtin_amdgcn_s_getreg((3 << 11) | 20) & 0xFu; }
#define XB_SPIN(cond, bar) do { unsigned _sp = 0; while (cond) { __builtin_amdgcn_s_sleep(1); \
    if ((++_sp & 255u) == 0u) { if (xb_ld(&(bar)[XB_TMO])) break; if (_sp > XB_SPIN_CAP) { atomicAdd(&(bar)[XB_TMO], 1u); break; } } } } while (0)
struct XcdBarrier { unsigned* bar; unsigned x; volatile LAS unsigned* st; };
__device__ __forceinline__ XcdBarrier xcd_barrier_post(unsigned* bar, volatile LAS unsigned* st) {
    XcdBarrier b; b.bar = bar; b.x = xb_xcc_id(); b.st = st;
    if (threadIdx.x == 0) (void)xb_add(&bar[XB_XCNT(b.x)], 1u);
    return b;
}
__device__ __forceinline__ void xcd_barrier_complete(unsigned* bar, unsigned x, unsigned& nloc, unsigned& nx) {
    const unsigned G = gridDim.x * gridDim.y * gridDim.z;
    unsigned sum, cnt, mine, sp = 0u;
    for (;;) {
        sum = 0u; cnt = 0u; mine = 0u;
#pragma unroll
        for (unsigned j = 0; j < 16; ++j) { const unsigned c = xb_ld(&bar[XB_XCNT(j)]); sum += c; cnt += (c > 0u) ? 1u : 0u; mine = (j == x) ? c : mine; }
        if (sum == G) break;
        __builtin_amdgcn_s_sleep(1);
        if ((++sp & 255u) == 0u) { if (xb_ld(&bar[XB_TMO])) break; if (sp > XB_SPIN_CAP) { atomicAdd(&bar[XB_TMO], 1u); break; } }
    }
    nloc = mine > 0u ? mine : 1u; nx = cnt > 0u ? cnt : 1u;
}
__device__ __forceinline__ void xcd_barrier(const XcdBarrier& b) {
    asm volatile("s_waitcnt vmcnt(0)" ::: "memory");
    __syncthreads();
    if (threadIdx.x == 0) {
        unsigned* bar = b.bar;
        __builtin_amdgcn_s_waitcnt(0);
        unsigned nloc = b.st[0], nx = b.st[1];
        if (nloc == 0u) { xcd_barrier_complete(bar, b.x, nloc, nx); b.st[0] = nloc; b.st[1] = nx; }
        const unsigned old = xb_add(&bar[XB_XSUB(b.x)], 1u);
        const unsigned gen = old / nloc;
        if (old + 1u == (gen + 1u) * nloc) {
            __builtin_amdgcn_fence(__ATOMIC_RELEASE, "agent");
            asm volatile("s_waitcnt vmcnt(0)" ::: "memory");
            const unsigned og = xb_add(&bar[XB_TOP], 1u);
            const unsigned tg = og / nx;
            if (og + 1u == (tg + 1u) * nx) xb_add(&bar[XB_TOPGEN], 1u);
            else XB_SPIN(xb_ld(&bar[XB_TOPGEN]) == tg, bar);
            __builtin_amdgcn_fence(__ATOMIC_ACQUIRE, "agent");
            xb_add(&bar[XB_XGEN(b.x)], 1u);
            asm volatile("s_waitcnt vmcnt(0)" ::: "memory");
        } else {
            XB_SPIN(xb_ld(&bar[XB_XGEN(b.x)]) == gen, bar);
            __builtin_amdgcn_fence(__ATOMIC_ACQUIRE, "agent");
            asm volatile("s_waitcnt vmcnt(0)" ::: "memory");
        }
    }
    __syncthreads();
}

struct Args { const void* in[28]; float* out; unsigned char* ws; int ph_lo, ph_hi; };

template <int MI, int NJ>
__device__ __forceinline__ void wave_mma(const bf16* A, int lda, const bf16* Bt, int ldb, int K, f32x4 (&acc)[MI][NJ], int fr, int fq) {
    for (int k0 = 0; k0 < K; k0 += 32) {
        bf16x8 a[MI], b[NJ];
#pragma unroll
        for (int i = 0; i < MI; ++i) a[i] = *(const bf16x8*)(A + (16 * i + fr) * lda + k0 + 8 * fq);
#pragma unroll
        for (int j = 0; j < NJ; ++j) b[j] = *(const bf16x8*)(Bt + (16 * j + fr) * ldb + k0 + 8 * fq);
#pragma unroll
        for (int i = 0; i < MI; ++i)
#pragma unroll
            for (int j = 0; j < NJ; ++j) acc[i][j] = __builtin_amdgcn_mfma_f32_16x16x32_bf16(b[j], a[i], acc[i][j], 0, 0, 0);
    }
}

__device__ __forceinline__ void transpose_item(const float* src, int src_ld, int k0, int n0, bf16* dst, int dst_ld, int dst_row0, int dst_col0,
                                               const float* gain, float scale, LAS float* scr, int lane) {
    f32x4 ld[16];
#pragma unroll
    for (int i = 0; i < 16; ++i) { const int kk = 4 * i + (lane >> 4); ld[i] = *(const f32x4*)(src + (size_t)(k0 + kk) * src_ld + n0 + 4 * (lane & 15)); }
#pragma unroll
    for (int i = 0; i < 16; ++i) { const int kk = 4 * i + (lane >> 4); *(LAS f32x4*)(scr + kk * 64 + 4 * ((lane & 15) ^ ((kk >> 3) & 15))) = ld[i]; }
    const int c = lane & 7;
    f32x4 g0 = (f32x4){scale, scale, scale, scale}, g1 = g0;
    if (gain) { g0 = *(const f32x4*)(gain + k0 + 8 * c) * scale; g1 = *(const f32x4*)(gain + k0 + 8 * c + 4) * scale; }
    LDS_WAIT(); asm volatile("" ::: "memory");
#pragma unroll
    for (int j = 0; j < 8; ++j) { const int n = (lane >> 3) + 8 * j; const LAS float* s = scr + (8 * c) * 64 + 4 * ((n >> 2) ^ c) + (n & 3);
        v4u o; o.x = pk2(s[0 * 64] * g0[0], s[1 * 64] * g0[1]); o.y = pk2(s[2 * 64] * g0[2], s[3 * 64] * g0[3]); o.z = pk2(s[4 * 64] * g1[0], s[5 * 64] * g1[1]); o.w = pk2(s[6 * 64] * g1[2], s[7 * 64] * g1[3]);
        *(v4u*)(dst + (size_t)(dst_row0 + n) * dst_ld + dst_col0 + 8 * c) = o; }
    LDS_WAIT(); asm volatile("" ::: "memory");
}

__device__ __forceinline__ void p0_prologue(const Args& A, unsigned char* lds, int tid, int lane, int wave) {
    unsigned char* ws = A.ws;
    const float* x = (const float*)A.in[0]; const float* mem = (const float*)A.in[1]; const int* positions = (const int*)A.in[2];
    const float* g_mix = (const float*)A.in[3]; const float* w_in = (const float*)A.in[4];
    const float* w_q_m = (const float*)A.in[7]; const float* w_k_m = (const float*)A.in[8];
    const float* b_i = (const float*)A.in[9]; const float* b_f = (const float*)A.in[10];
    const float* w_out = (const float*)A.in[13]; const float* g_cross = (const float*)A.in[14]; const float* g_mem = (const float*)A.in[15];
    const float* w_q_x = (const float*)A.in[16]; const float* w_kv_x = (const float*)A.in[17]; const float* w_o_x = (const float*)A.in[18];
    const float* g_ffn = (const float*)A.in[19]; const float* w_rg = (const float*)A.in[20]; const float* w_re = (const float*)A.in[22];
    const float* w1 = (const float*)A.in[24]; const float* w3 = (const float*)A.in[25]; const float* w2 = (const float*)A.in[26];
    const int G = gridDim.x, gw = blockIdx.x * NWAVES + wave, NGW = G * NWAVES, gt = blockIdx.x * NTHR + tid, NGT = G * NTHR;

    LAS float* WGl = (LAS float*)lds;
    for (int i = tid; i < 8 * 1024; i += NTHR) { const int k = i >> 3, j = i & 7; WGl[j * 1024 + k] = g_mix[k] * w_in[(size_t)k * INW + NIN + j]; }

    for (int i = gt; i < PAR_N; i += NGT) { float v;
        if (i < PAR_CONVB) v = ((const float*)A.in[5])[i]; else if (i < PAR_GMHN) v = ((const float*)A.in[6])[i - PAR_CONVB]; else if (i < PAR_SKIP) v = ((const float*)A.in[11])[i - PAR_GMHN];
        else if (i < PAR_BRG) v = ((const float*)A.in[12])[i - PAR_SKIP]; else if (i < PAR_BRE) v = ((const float*)A.in[21])[i - PAR_BRG]; else if (i < PAR_GFIN) v = ((const float*)A.in[23])[i - PAR_BRE];
        else v = ((const float*)A.in[27])[i - PAR_GFIN];
        ((float*)(ws + WS_PAR))[i] = v; }
    for (int i = gt; i < 32 * 1024; i += NGT) { const int e = i >> 10, k = i & 1023;
        const float w = (e < 20) ? g_ffn[k] * (e < 4 ? w_rg[k * 4 + e] : w_re[k * 16 + (e - 4)]) : 0.f;
        const unsigned hi = f2bf(w); const float lo = w - bf2f(hi);
        ((bf16*)(ws + WS_WR))[i] = (bf16)hi; ((bf16*)(ws + WS_WR))[32 * 1024 + i] = (bf16)f2bf(lo); }
    for (int i = gt; i < T * 8; i += NGT) { const int t = i >> 3, j = i & 7; const float invf = powf(500000.0f, -(float)j * 0.125f);
        const float ang = (float)positions[t] * invf; float sn, cs; sincosf(ang, &sn, &cs);
        ((float*)(ws + WS_ROPE))[t * 16 + j] = cs; ((float*)(ws + WS_ROPE))[t * 16 + 8 + j] = sn; }
    __syncthreads();
    for (int m0 = 2 * gw; m0 < T + TMEM; m0 += 2 * NGW) {
        f32x4 v[2][4]; float rstd[2];
#pragma unroll
        for (int q = 0; q < 2; ++q) { const int m = m0 + q; const f32x4* xr = (const f32x4*)(m >= T ? mem + (size_t)(m - T) * D : x + (size_t)m * D) + lane;
#pragma unroll
            for (int j = 0; j < 4; ++j) v[q][j] = xr[64 * j]; }
#pragma unroll
        for (int q = 0; q < 2; ++q) { float s = 0.f;
#pragma unroll
            for (int j = 0; j < 4; ++j) s += (v[q][j].x * v[q][j].x + v[q][j].y * v[q][j].y) + (v[q][j].z * v[q][j].z + v[q][j].w * v[q][j].w);
            rstd[q] = 1.0f / sqrtf(wave_sum(s) * (1.0f / D) + EPSN);
            unsigned long long* o8 = (unsigned long long*)(ws + WS_XN + (size_t)(m0 + q) * D * 2) + lane;
#pragma unroll
            for (int j = 0; j < 4; ++j) o8[64 * j] = (unsigned long long)pk2(v[q][j].x * rstd[q], v[q][j].y * rstd[q]) | ((unsigned long long)pk2(v[q][j].z * rstd[q], v[q][j].w * rstd[q]) << 32); }
        if (m0 < T) {
            float ga[2][8];
#pragma unroll
            for (int g = 0; g < 8; ++g) { float a0 = 0.f, a1 = 0.f;
#pragma unroll
                for (int j = 0; j < 4; ++j) { const f32x4 w = *(const LAS f32x4*)(WGl + g * 1024 + 256 * j + 4 * lane);
                    a0 += (v[0][j].x * w.x + v[0][j].y * w.y) + (v[0][j].z * w.z + v[0][j].w * w.w); a1 += (v[1][j].x * w.x + v[1][j].y * w.y) + (v[1][j].z * w.z + v[1][j].w * w.w); }
                ga[0][g] = a0; ga[1][g] = a1; }
            float val0, val1;
            { const bool b5 = (lane & 32) != 0, b4 = (lane & 16) != 0, b3 = (lane & 8) != 0;
#pragma unroll
              for (int q = 0; q < 2; ++q) { float r[4], s2[2];
#pragma unroll
                  for (int i = 0; i < 4; ++i) { const float keep = b5 ? ga[q][i + 4] : ga[q][i], send = b5 ? ga[q][i] : ga[q][i + 4]; r[i] = keep + __shfl_xor(send, 32); }
#pragma unroll
                  for (int i = 0; i < 2; ++i) { const float keep = b4 ? r[i + 2] : r[i], send = b4 ? r[i] : r[i + 2]; s2[i] = keep + __shfl_xor(send, 16); }
                  float p = (b3 ? s2[1] : s2[0]) + __shfl_xor(b3 ? s2[0] : s2[1], 8);
                  p += __shfl_xor(p, 4); p += __shfl_xor(p, 2); p += __shfl_xor(p, 1);
                  if (q == 0) val0 = p * rstd[0]; else val1 = p * rstd[1]; } }
            if ((lane & 7) == 0) { const int gidx = lane >> 3, h = gidx & 3;
#pragma unroll
                for (int q = 0; q < 2; ++q) { const int m = m0 + q, b = m / SEQ, sq = m % SEQ; const float val = q ? val1 : val0;
                    if (gidx < 4) ((float*)(ws + WS_IG))[(size_t)(b * 4 + h) * SEQ + sq] = val + b_i[h];
                    else ((float*)(ws + WS_FG))[(size_t)(b * 4 + h) * SEQ + sq] = val + b_f[h]; } }
        }
    }
    __syncthreads();
    LAS float* scr = (LAS float*)(lds + wave * 16384);
    constexpr int I_IN = 16 * 48, I_KV = 16 * 8, I_OUT = 16 * 16, I_QX = 16 * 4, I_OX = 4 * 16, I_M = 32, I_13 = 16 * 2 * 128, I_2P = 24 * 2 * 128;
    constexpr int NITEMS = I_IN + I_KV + I_OUT + I_QX + I_OX + I_M + I_13 + I_2P;
    for (int it = gw; it < NITEMS; it += NGW) {
        int r = it;
        if (r < I_IN) { const int kb = r / 48, nb = r % 48; transpose_item(w_in, INW, 64 * kb, 64 * nb, (bf16*)(ws + WS_WIN), 1024, 64 * nb, 64 * kb, g_mix, (64 * nb < 512) ? C2 : 1.0f, scr, lane); continue; } r -= I_IN;
        if (r < I_KV) { const int kb = r / 8, nb = r % 8; transpose_item(w_kv_x, 512, 64 * kb, 64 * nb, (bf16*)(ws + WS_WIN), 1024, NIN + 64 * nb, 64 * kb, g_mem, 1.0f, scr, lane); continue; } r -= I_KV;
        if (r < I_OUT) { const int kb = r / 16, nb = r % 16; transpose_item(w_out, 1024, 64 * kb, 64 * nb, (bf16*)(ws + WS_WOUT), 1024, 64 * nb, 64 * kb, nullptr, 1.0f, scr, lane); continue; } r -= I_OUT;
        if (r < I_QX) { const int kb = r / 4, nb = r % 4; transpose_item(w_q_x, 256, 64 * kb, 64 * nb, (bf16*)(ws + WS_WQX), 1024, 64 * nb, 64 * kb, g_cross, C2, scr, lane); continue; } r -= I_QX;
        if (r < I_OX) { const int kb = r / 16, nb = r % 16; transpose_item(w_o_x, 1024, 64 * kb, 64 * nb, (bf16*)(ws + WS_WOX), 256, 64 * nb, 64 * kb, nullptr, 1.0f, scr, lane); continue; } r -= I_OX;
        if (r < I_M) { const int which = r / 16, h = (r % 16) / 4, kb = (r % 4) / 2, nb = r % 2;
            transpose_item((which ? w_k_m : w_q_m) + (size_t)h * 128 * 128, 128, 64 * kb, 64 * nb, (bf16*)(ws + WS_WM) + (size_t)(which * 4 + h) * 128 * 128, 128, 64 * nb, 64 * kb, nullptr,
                           which ? 0.08838834764831845f : 1.0f, scr, lane); continue; } r -= I_M;
        if (r < I_13) { const int e = r / 256, which = (r % 256) / 128, kb = (r % 128) / 8, nb = r % 8; const int n0 = 64 * nb;
            transpose_item((which ? w3 : w1) + (size_t)e * 1024 * 512, 512, 64 * kb, n0, (bf16*)(ws + WS_W13) + (size_t)e * 1024 * 1024, 1024, (n0 / 128) * 256 + which * 128 + (n0 % 128), 64 * kb, g_ffn, 1.0f, scr, lane); continue; } r -= I_13;
        { const int bk = r / 256, hf = (r % 256) / 128, kb = (r % 128) / 16, nb = r % 16; const int g = bk / 6, p = bk % 6;
          const int pa = (p < 3) ? 0 : (p < 5 ? 1 : 2), pb = (p < 3) ? p + 1 : (p < 5 ? p - 1 : 3); const int e = 4 * g + (hf ? pb : pa);
          transpose_item(w2 + (size_t)e * 512 * 1024, 1024, 64 * kb, 64 * nb, (bf16*)(ws + WS_W2P) + (size_t)bk * 1024 * 1024, 1024, 64 * nb, hf * 512 + 64 * kb, nullptr, 1.0f, scr, lane); }
    }
}

__device__ __forceinline__ v4u pack8(const f32x4& a, const f32x4& b) { v4u w; w.x = pk2(a[0], a[1]); w.y = pk2(a[2], a[3]); w.z = pk2(b[0], b[1]); w.w = pk2(b[2], b[3]); return w; }
struct EpiInProj {
    static constexpr bool PERM = true, AFTER_DRAIN = false;
    bf16* base; const float* rope;
    __device__ __forceinline__ void operator()(const f32x4 (&acc)[2][2][4][2], const pg8::Unit& u, int wr, int wc, int fr, int fq) const {
        const int buf = u.pn >> 1; bf16* B = base + (size_t)buf * T * 512;
        int row0 = u.pm * 256 + wr * 64 + fr; asm volatile("" : "+v"(row0));
        const int col0 = (u.pn & 1) * 256 + wc * 32 + 8 * fq;
        const bool dorope = (buf < 2) && ((wc & 1) == 0);
#pragma unroll
        for (int ai = 0; ai < 2; ++ai)
#pragma unroll
            for (int m = 0; m < 4; ++m) { const int row = row0 + ai * 128 + m * 16; bf16* rowp = B + (size_t)row * 512 + col0;
                f32x4 cs0, cs1, sn0, sn1;
                if (dorope) { const f32x4* rp = (const f32x4*)(rope + (size_t)row * 16); cs0 = rp[0]; cs1 = rp[1]; sn0 = rp[2]; sn1 = rp[3]; }
#pragma unroll
                for (int bj = 0; bj < 2; ++bj) { f32x4 v0 = acc[ai][bj][m][0], v1 = acc[ai][bj][m][1];
                    if (dorope) { f32x4 o0, o1;
#pragma unroll
                        for (int i = 0; i < 4; ++i) { o0[i] = __shfl_xor(v0[i], 16); o1[i] = __shfl_xor(v1[i], 16); }
                        if (fq == 0) { v0 = v0 * cs0 - o0 * sn0; v1 = v1 * cs1 - o1 * sn1; }
                        else if (fq == 1) { v0 = v0 * cs0 + o0 * sn0; v1 = v1 * cs1 + o1 * sn1; } }
                    *(v4u*)(rowp + bj * 128) = pack8(v0, v1); } }
    }
};

typedef short v4i16_t __attribute__((ext_vector_type(4)));
struct AttItem { int cfg, b, h, d, nb; size_t tokb; };
__device__ __forceinline__ AttItem attn_decode(int item) {
    AttItem a; a.cfg = item >> 12; int rem = item & 4095; a.b = rem >> 9; rem &= 511; a.h = rem >> 6; const int sub = rem & 63;
    a.d = (a.cfg == 0) ? 1 : (a.cfg == 1 ? 4 : 16); const int nblk = 64 / a.d, r = sub / nblk; a.nb = sub % nblk; a.tokb = (size_t)a.b * SEQ + r; return a;
}
__device__ __forceinline__ int attn_item_of(int k, int G) {
    if (G != 256) return (int)blockIdx.x + k * G;
    const int pair = (int)(blockIdx.x & 7) + 8 * (k / 6), j = (int)(blockIdx.x >> 3), ip = j * 6 + (k % 6);
    return ((ip >> 6) << 12) | (pair << 6) | (ip & 63);
}
__device__ __forceinline__ void glds16(const void* gsrc, unsigned lds_dst) { unsigned keep;
    asm volatile("s_mov_b32 %0, m0\n\ts_mov_b32 m0, %2\n\ts_nop 0\n\tglobal_load_lds_dwordx4 %1, off\n\ts_mov_b32 m0, %0" : "=&s"(keep) : "v"(gsrc), "s"(lds_dst) : "memory"); }
__device__ __forceinline__ unsigned lds_addr_of(LAS unsigned char* p) { return (unsigned)(uintptr_t)p; }
__device__ __forceinline__ void attn_prefetch(const Args& A, LAS unsigned char* L, int item, int pslot, int oslot, bool load_prev, int lane, int wave, bf16x8 (&qf)[2]) {
    const AttItem a = attn_decode(item);
    const bf16* Kg = (const bf16*)(A.ws + WS_K) + a.h * 64; const bf16* Vg = (const bf16*)(A.ws + WS_V) + a.h * 64; const bf16* Qg = (const bf16*)(A.ws + WS_Q) + a.h * 64;
#pragma unroll
    for (int i = 0; i < 2; ++i) { const int inst = wave + 8 * i, row = 8 * inst + (lane >> 3);
        const size_t off = (a.tokb + (size_t)(128 * a.nb + row) * a.d) * 512 + ((lane & 7) ^ (lane >> 3)) * 8;
        glds16(Kg + off, (unsigned)__builtin_amdgcn_readfirstlane(lds_addr_of(L + oslot * 32768 + inst * 1024)));
        glds16(Vg + off, (unsigned)__builtin_amdgcn_readfirstlane(lds_addr_of(L + oslot * 32768 + 16384 + inst * 1024))); }
    if (load_prev) {
#pragma unroll
        for (int i = 0; i < 2; ++i) { const int inst = wave + 8 * i, row = 8 * inst + (lane >> 3);
            const size_t off = (a.tokb + (size_t)(128 * (a.nb - 1) + row) * a.d) * 512 + ((lane & 7) ^ (lane >> 3)) * 8;
            glds16(Kg + off, (unsigned)__builtin_amdgcn_readfirstlane(lds_addr_of(L + pslot * 32768 + inst * 1024)));
            glds16(Vg + off, (unsigned)__builtin_amdgcn_readfirstlane(lds_addr_of(L + pslot * 32768 + 16384 + inst * 1024))); } }
    const size_t tq = a.tokb + (size_t)(128 * a.nb + 16 * wave + (lane & 15)) * a.d;
    qf[0] = *(const bf16x8*)(Qg + tq * 512 + 8 * (lane >> 4)); qf[1] = *(const bf16x8*)(Qg + tq * 512 + 32 + 8 * (lane >> 4));
}
__device__ __forceinline__ void attn_compute(const Args& A, LAS unsigned char* L, int item, int pslot, int oslot, int lane, int wave, const bf16x8 (&qf)[2]) {
    const AttItem a = attn_decode(item);
    const int fr = lane & 15, g = lane >> 4, qi = 16 * wave + fr;
    f32x4 s[10];
#pragma unroll
    for (int tt = 0; tt < 9; ++tt) { const int t = wave + tt, key = 16 * (t & 7) + fr; LAS unsigned char* kb = L + ((t < 8) ? pslot : oslot) * 32768; s[tt] = (f32x4){0.f, 0.f, 0.f, 0.f};
#pragma unroll
        for (int ks = 0; ks < 2; ++ks) { const bf16x8 kf = *(const LAS bf16x8*)(kb + key * 128 + (((4 * ks + g) ^ (key & 7)) * 16));
            s[tt] = __builtin_amdgcn_mfma_f32_16x16x32_bf16(kf, qf[ks], s[tt], 0, 0, 0); } }
    s[9] = (f32x4){0.f, 0.f, 0.f, 0.f};
#pragma unroll
    for (int e = 0; e < 4; ++e) { s[0][e] = (4 * g + e >= fr) ? s[0][e] : -1e30f; s[8][e] = (4 * g + e <= fr) ? s[8][e] : -1e30f; }
    if (__builtin_expect(a.nb == 0, 0)) {
        asm volatile("" ::: "memory");
#pragma unroll
        for (int tt = 0; tt < 8; ++tt) if (wave + tt < 8) s[tt] = (f32x4){-1e30f, -1e30f, -1e30f, -1e30f};
        asm volatile("" : "+v"(s[0]), "+v"(s[1]), "+v"(s[2]), "+v"(s[3]), "+v"(s[4]), "+v"(s[5]), "+v"(s[6]), "+v"(s[7]));
    }
    float mx;
    { float m0_, m1_;
      asm("v_max3_f32 %0, %1, %2, %3" : "=v"(m0_) : "v"(s[0][0]), "v"(s[0][1]), "v"(s[0][2]));
      asm("v_max3_f32 %0, %1, %2, %3" : "=v"(m1_) : "v"(s[0][3]), "v"(s[1][0]), "v"(s[1][1]));
      asm("v_max3_f32 %0, %1, %2, %3" : "=v"(m0_) : "v"(m0_), "v"(s[1][2]), "v"(s[1][3]));
#pragma unroll
      for (int tt = 2; tt < 9; ++tt) { asm("v_max3_f32 %0, %1, %2, %3" : "=v"(m0_) : "v"(m0_), "v"(s[tt][0]), "v"(s[tt][1])); asm("v_max3_f32 %0, %1, %2, %3" : "=v"(m1_) : "v"(m1_), "v"(s[tt][2]), "v"(s[tt][3])); }
      asm("v_max_f32_e32 %0, %1, %2" : "=v"(mx) : "v"(m0_), "v"(m1_)); }
    mx = fmaxf(mx, __shfl_xor(mx, 16)); mx = fmaxf(mx, __shfl_xor(mx, 32));
    float l = 0.f;
#pragma unroll
    for (int tt = 0; tt < 9; ++tt)
#pragma unroll
        for (int e = 0; e < 4; ++e) { s[tt][e] = __builtin_amdgcn_exp2f(s[tt][e] - mx); l += s[tt][e]; }
    l += __shfl_xor(l, 16); l += __shfl_xor(l, 32);
    f32x4 o[4];
#pragma unroll
    for (int dt = 0; dt < 4; ++dt) o[dt] = (f32x4){0.f, 0.f, 0.f, 0.f};
#pragma unroll
    for (int k5 = 0; k5 < 5; ++k5) {
        const v4u pw = (v4u){pk2(s[2 * k5][0], s[2 * k5][1]), pk2(s[2 * k5][2], s[2 * k5][3]), pk2(s[2 * k5 + 1][0], s[2 * k5 + 1][1]), pk2(s[2 * k5 + 1][2], s[2 * k5 + 1][3])};
        const bf16x8 pf = __builtin_bit_cast(bf16x8, pw);
        const int t0 = wave + 2 * k5, t1 = (wave + 2 * k5 + 1 < 16) ? wave + 2 * k5 + 1 : 15;
        const int r0 = 16 * (t0 & 7) + 4 * g + (fr >> 2), r1 = 16 * (t1 & 7) + 4 * g + (fr >> 2), p_ = fr & 3;
        LAS unsigned char* v0b = L + ((t0 < 8) ? pslot : oslot) * 32768 + 16384; LAS unsigned char* v1b = L + ((t1 < 8) ? pslot : oslot) * 32768 + 16384;
#pragma unroll
        for (int dt = 0; dt < 4; ++dt) { const int chunk = 2 * dt + (p_ >> 1);
            const v4i16_t v0 = __builtin_amdgcn_ds_read_tr16_b64_v4i16((LAS v4i16_t*)(v0b + r0 * 128 + ((chunk ^ (r0 & 7)) * 16) + 8 * (p_ & 1)));
            const v4i16_t v1 = __builtin_amdgcn_ds_read_tr16_b64_v4i16((LAS v4i16_t*)(v1b + r1 * 128 + ((chunk ^ (r1 & 7)) * 16) + 8 * (p_ & 1)));
            const bf16x8 vf = (bf16x8){v0[0], v0[1], v0[2], v0[3], v1[0], v1[1], v1[2], v1[3]};
            o[dt] = __builtin_amdgcn_mfma_f32_16x16x32_bf16(vf, pf, o[dt], 0, 0, 0); } }
    const float rl = frcp_(l);
    const size_t tok = a.tokb + (size_t)(128 * a.nb + qi) * a.d;
    bf16* og = (bf16*)((unsigned char*)A.out + DO_OATT) + ((size_t)a.cfg * T + tok) * 512 + a.h * 64;
#pragma unroll
    for (int dt = 0; dt < 4; ++dt) *(v2u*)(og + 16 * dt + 4 * g) = (v2u){pk2(o[dt][0] * rl, o[dt][1] * rl), pk2(o[dt][2] * rl, o[dt][3] * rl)};
    if (g == 0) ((float*)(A.ws + WS_LSE))[((size_t)a.cfg * T + tok) * 8 + a.h] = mx + __builtin_amdgcn_logf(l);
}
__device__ __forceinline__ void attn_phase(const Args& A, unsigned char* lds, int n_total, int lane, int wave) {
    const int G = gridDim.x; LAS unsigned char* L = (LAS unsigned char*)lds;
    const int nk = (G == 256) ? n_total / 256 : (n_total - (int)blockIdx.x + G - 1) / G;
    if (nk <= 0) return;
    bf16x8 qa[2], qb[2];
    int it = attn_item_of(0, G); int ps, os;
    { const AttItem a = attn_decode(it); os = 0; ps = (a.nb > 0) ? 1 : 0; attn_prefetch(A, L, it, ps, os, a.nb > 0, lane, wave, qa); }
    for (int k = 0; k < nk; ++k) {
        __builtin_amdgcn_s_waitcnt(0x0F70);
        asm volatile("s_waitcnt vmcnt(0)" ::: "memory");
        __syncthreads();
        qb[0] = qa[0]; qb[1] = qa[1];
        int nit = it, nps = ps, nos = os;
        if (k + 1 < nk) { nit = attn_item_of(k + 1, G); const AttItem c = attn_decode(it), n = attn_decode(nit);
            const bool succ = (nit == it + 1) && (n.nb == c.nb + 1);
            const int used = (1 << ps) | (1 << os); const int f1 = (used & 1) ? ((used & 2) ? ((used & 4) ? 3 : 2) : 1) : 0; const int used2 = used | (1 << f1);
            const int f2 = (used2 & 1) ? ((used2 & 2) ? ((used2 & 4) ? 3 : 2) : 1) : 0;
            bool lp;
            if (succ) { nps = os; nos = f1; lp = false; } else if (n.nb == 0) { nos = f1; nps = f1; lp = false; } else { nps = f1; nos = f2; lp = true; }
            attn_prefetch(A, L, nit, nps, nos, lp, lane, wave, qb); }
        attn_compute(A, L, it, ps, os, lane, wave, qa);
        qa[0] = qb[0]; qa[1] = qb[1]; it = nit; ps = nps; os = nos;
    }
    asm volatile("s_waitcnt vmcnt(0)" ::: "memory");
    __syncthreads();
}

__device__ __forceinline__ void kv_tile(const Args& A, unsigned char* lds, int tile, int tid, int lane, int wave) {
    unsigned char* ws = A.ws;
    const int mt = tile >> 3, nt = tile & 7;
    const bf16* Ag = (const bf16*)(ws + WS_XN) + (size_t)(T + 64 * mt) * D; const bf16* Bg = (const bf16*)(ws + WS_WIN) + (size_t)(NIN + 64 * nt) * D;
    bf16* As = (bf16*)lds; bf16* Bs = (bf16*)(lds + 64 * 264 * 2);
    const int fr = lane & 15, fq = lane >> 4, wm = wave & 3, wn = wave >> 2;
    f32x4 acc[1][2]; acc[0][0] = (f32x4){0.f, 0.f, 0.f, 0.f}; acc[0][1] = (f32x4){0.f, 0.f, 0.f, 0.f};
    for (int kc = 0; kc < 4; ++kc) {
        for (int id = tid; id < 64 * 32; id += NTHR) { const int row = id >> 5, ch = id & 31;
            *(v4u*)(As + row * 264 + ch * 8) = *(const v4u*)(Ag + (size_t)row * D + kc * 256 + ch * 8);
            *(v4u*)(Bs + row * 264 + ch * 8) = *(const v4u*)(Bg + (size_t)row * D + kc * 256 + ch * 8); }
        __syncthreads();
        wave_mma<1, 2>(As + 16 * wm * 264, 264, Bs + 32 * wn * 264, 264, 256, acc, fr, fq);
        __syncthreads();
    }
    bf16* og = (bf16*)(ws + WS_KVX) + (size_t)(64 * mt + 16 * wm + fr) * NKV + 64 * nt + 32 * wn;
#pragma unroll
    for (int j = 0; j < 2; ++j) *(v2u*)(og + 16 * j + 4 * fq) = (v2u){pk2(acc[0][j][0], acc[0][j][1]), pk2(acc[0][j][2], acc[0][j][3])};
}

constexpr int ML_TILE = 32768;
constexpr int ML_G = 4 * ML_TILE;
static_assert(ML_G + 8192 <= LDS_MISC, "mlstm LDS");
__device__ __forceinline__ int sw_off(int row, int ch) { return 256 * row + 16 * (ch ^ (((row & 3) << 2) | ((row >> 2) & 3))); }
__device__ __forceinline__ bf16x8 rowfrag(LAS unsigned char* tile, int row0, int ks, int fr, int g) { return *(const LAS bf16x8*)(tile + sw_off(row0 + fr, 4 * ks + g)); }
__device__ __forceinline__ bf16x8 colfrag(LAS unsigned char* tile, int ks, int ct, int fr, int g) {
    const int r0 = 32 * ks + 8 * g + (fr >> 2), p = fr & 3, ch = 2 * ct + (p >> 1);
    const v4i16_t a = __builtin_amdgcn_ds_read_tr16_b64_v4i16((LAS v4i16_t*)(tile + sw_off(r0, ch) + 8 * (p & 1)));
    const v4i16_t b = __builtin_amdgcn_ds_read_tr16_b64_v4i16((LAS v4i16_t*)(tile + sw_off(r0 + 4, ch) + 8 * (p & 1)));
    return (bf16x8){a[0], a[1], a[2], a[3], b[0], b[1], b[2], b[3]};
}
__device__ __forceinline__ float log_sigmoidf_(float x) { return (x > 0.f) ? -log1pf(__expf(-x)) : (x - log1pf(__expf(x))); }
__device__ __forceinline__ float wscan_sum(float v0, float v1, float& o0, float& o1, int lane) {
    float x = v0 + v1;
#pragma unroll
    for (int off = 1; off < 64; off <<= 1) { const float t = __shfl_up(x, off); if (lane >= off) x += t; }
    o0 = x - v1; o1 = x; return __shfl(x, 63);
}
__device__ __forceinline__ void wscan_max(float v0, float v1, float& o0, float& o1, int lane) {
    float y = fmaxf(v0, v1);
#pragma unroll
    for (int off = 1; off < 64; off <<= 1) { const float t = __shfl_up(y, off); if (lane >= off) y = fmaxf(y, t); }
    float pre = __shfl_up(y, 1); if (lane == 0) pre = -INFINITY;
    o0 = fmaxf(pre, v0); o1 = fmaxf(pre, fmaxf(v0, v1));
}
__device__ __forceinline__ void tile_load(LAS unsigned char* tile, const bf16* src, size_t pitch, int tid) {
    v4u v[4];
#pragma unroll
    for (int i = 0; i < 4; ++i) { const int id = tid + NTHR * i, row = id >> 4, ch = id & 15; v[i] = *(const v4u*)(src + (size_t)row * pitch + ch * 8); }
#pragma unroll
    for (int i = 0; i < 4; ++i) { const int id = tid + NTHR * i, row = id >> 4, ch = id & 15; *(LAS v4u*)(tile + sw_off(row, ch)) = v[i]; }
}

__device__ __forceinline__ void ml_conv_tile(LAS unsigned char* cA, const bf16* MU, const float* conv_w, const float* conv_b, int b, int c, int h, int tid) {
    const int ch = (tid & 15) * 8, l0 = (tid >> 4) * 4;
    float w[4][8], bs[8];
#pragma unroll
    for (int j = 0; j < 4; ++j) { const f32x4 w0 = *(const f32x4*)(conv_w + j * 512 + h * 128 + ch), w1 = *(const f32x4*)(conv_w + j * 512 + h * 128 + ch + 4);
        w[j][0] = w0[0]; w[j][1] = w0[1]; w[j][2] = w0[2]; w[j][3] = w0[3]; w[j][4] = w1[0]; w[j][5] = w1[1]; w[j][6] = w1[2]; w[j][7] = w1[3]; }
    { const f32x4 b0 = *(const f32x4*)(conv_b + h * 128 + ch), b1 = *(const f32x4*)(conv_b + h * 128 + ch + 4);
      bs[0] = b0[0]; bs[1] = b0[1]; bs[2] = b0[2]; bs[3] = b0[3]; bs[4] = b1[0]; bs[5] = b1[1]; bs[6] = b1[2]; bs[7] = b1[3]; }
    v4u m[7];
#pragma unroll
    for (int r = 0; r < 7; ++r) { const int sp = 128 * c + l0 + r - 3; m[r] = (v4u){0u, 0u, 0u, 0u};
        if (sp >= 0) m[r] = *(const v4u*)(MU + ((size_t)b * SEQ + sp) * 512 + ch); }
#pragma unroll
    for (int i = 0; i < 4; ++i) { float a[8];
#pragma unroll
        for (int q = 0; q < 8; ++q) a[q] = bs[q];
#pragma unroll
        for (int j = 0; j < 4; ++j) { const v4u mm = m[i + j];
            a[0] += bflo(mm.x) * w[j][0]; a[1] += bfhi(mm.x) * w[j][1]; a[2] += bflo(mm.y) * w[j][2]; a[3] += bfhi(mm.y) * w[j][3];
            a[4] += bflo(mm.z) * w[j][4]; a[5] += bfhi(mm.z) * w[j][5]; a[6] += bflo(mm.w) * w[j][6]; a[7] += bfhi(mm.w) * w[j][7]; }
#pragma unroll
        for (int q = 0; q < 8; ++q) a[q] = a[q] * sigmoidf_(a[q]);
        *(LAS v4u*)(cA + sw_off(l0 + i, tid & 15)) = (v4u){pk2(a[0], a[1]), pk2(a[2], a[3]), pk2(a[4], a[5]), pk2(a[6], a[7])}; }
}
struct MGroup { f32x4 G[8]; f32x4 Gn; float B, M; };
__device__ __forceinline__ void mlstm_p1_item(const Args& A, unsigned char* lds_, int item, int& wres, MGroup& mg, int tid, int lane, int wave) {
    asm volatile("" : "+v"(tid), "+v"(lane));
    unsigned char* ws = A.ws; LAS unsigned char* lds = (LAS unsigned char*)lds_;
    const int bh = item >> 6, c = item & 63, b = bh >> 2, h = bh & 3;
    const size_t t0 = (size_t)b * SEQ + 128 * c;
    LAS unsigned char* cA = lds; LAS unsigned char* Wk = lds + 2 * ML_TILE; LAS unsigned char* Vt = lds + 3 * ML_TILE;
    LAS float* gl = (LAS float*)(lds + ML_G);
    const int fr = lane & 15, g = lane >> 4, m0 = 16 * wave;
    if (wres != h) { tile_load(Wk, (const bf16*)(ws + WS_WM) + (size_t)(4 + h) * 128 * 128, 128, tid); wres = h; }
    tile_load(Vt, (const bf16*)(ws + WS_MV) + t0 * 512 + h * 128, 512, tid);
    ml_conv_tile(cA, (const bf16*)(ws + WS_MU) + h * 128, (const float*)(ws + WS_PAR) + PAR_CONVW, (const float*)(ws + WS_PAR) + PAR_CONVB, b, c, h, tid);
    float blast, mloc;
    { const size_t gi = (size_t)bh * SEQ + 128 * c + 2 * lane;
      const float i0 = ((const float*)(ws + WS_IG))[gi], i1 = ((const float*)(ws + WS_IG))[gi + 1];
      const float f0 = log_sigmoidf_(((const float*)(ws + WS_FG))[gi]), f1 = log_sigmoidf_(((const float*)(ws + WS_FG))[gi + 1]);
      float b0, b1; blast = wscan_sum(f0, f1, b0, b1, lane);
      const float g0 = blast - b0 + i0, g1 = blast - b1 + i1; mloc = wave_max(fmaxf(g0, g1));
      gl[2 * lane] = fexp_(g0 - mloc); gl[2 * lane + 1] = fexp_(g1 - mloc); }
    __syncthreads();
    { bf16x8 af[4];
#pragma unroll
      for (int ks = 0; ks < 4; ++ks) af[ks] = rowfrag(cA, m0, ks, fr, g);
      const float wk = gl[m0 + fr];
#pragma unroll
      for (int j = 0; j < 8; ++j) { f32x4 acc = (f32x4){0.f, 0.f, 0.f, 0.f};
#pragma unroll
          for (int ks = 0; ks < 4; ++ks) acc = __builtin_amdgcn_mfma_f32_16x16x32_bf16(rowfrag(Wk, 16 * j, ks, fr, g), af[ks], acc, 0, 0, 0);
          *(LAS v2u*)(cA + sw_off(m0 + fr, 2 * j + (g >> 1)) + 8 * (g & 1)) = (v2u){pk2(acc[0] * wk, acc[1] * wk), pk2(acc[2] * wk, acc[3] * wk)}; } }
    __syncthreads();
    { f32x4 acc[8], accn = (f32x4){0.f, 0.f, 0.f, 0.f};
#pragma unroll
      for (int j = 0; j < 8; ++j) acc[j] = (f32x4){0.f, 0.f, 0.f, 0.f};
      const bf16x8 ones = (bf16x8){0x3f80, 0x3f80, 0x3f80, 0x3f80, 0x3f80, 0x3f80, 0x3f80, 0x3f80};
#pragma unroll
      for (int ks = 0; ks < 4; ++ks) { const bf16x8 vf = colfrag(Vt, ks, wave, fr, g);
#pragma unroll
          for (int j = 0; j < 8; ++j) { const bf16x8 kf = colfrag(cA, ks, j, fr, g); acc[j] = __builtin_amdgcn_mfma_f32_16x16x32_bf16(kf, vf, acc[j], 0, 0, 0);
              if (j == wave) accn = __builtin_amdgcn_mfma_f32_16x16x32_bf16(kf, ones, accn, 0, 0, 0); } }
      if ((c & 7) == 0) {
#pragma unroll
          for (int j = 0; j < 8; ++j) mg.G[j] = acc[j];
          mg.Gn = accn; mg.M = mloc; mg.B = blast;
      } else { const float mnew = fmaxf(blast + mg.M, mloc), a = fexp_(blast + mg.M - mnew), cc = fexp_(mloc - mnew);
#pragma unroll
          for (int j = 0; j < 8; ++j) mg.G[j] = mg.G[j] * a + acc[j] * cc;
          mg.Gn = mg.Gn * a + accn * cc; mg.M = mnew; mg.B += blast; }
      if ((c & 7) == 7) { const int gi = bh * 8 + (c >> 3);
          bf16* gg = (bf16*)(ws + WS_GAGG) + ((size_t)gi * 128 + m0 + fr) * 128;
#pragma unroll
          for (int j = 0; j < 8; ++j) *(v2u*)(gg + 16 * j + 4 * g) = (v2u){pk2(mg.G[j][0], mg.G[j][1]), pk2(mg.G[j][2], mg.G[j][3])};
          if (fr == 0) *(f32x4*)((float*)(ws + WS_GN) + (size_t)gi * 128 + 16 * wave + 4 * g) = mg.Gn;
          if (wave == 0 && lane == 0) { ((float*)(ws + WS_GSC))[2 * gi] = mg.B; ((float*)(ws + WS_GSC))[2 * gi + 1] = mg.M; } } }
    __syncthreads();
}

__device__ __forceinline__ void combine_rows(const Args& A, size_t row0, int nrows, int tid) {
    unsigned char* ws = A.ws;
    const bf16* OA = (const bf16*)((const unsigned char*)A.out + DO_OATT); const float* LSE = (const float*)(ws + WS_LSE);
    for (int id = tid; id < nrows * 64; id += NTHR) {
        const size_t t = row0 + (id >> 6); const int h = (id & 63) >> 3, ch = (id & 7) * 8;
        const float l0 = LSE[t * 8 + h], l1 = LSE[((size_t)T + t) * 8 + h], l2 = LSE[((size_t)2 * T + t) * 8 + h];
        const float mx = fmaxf(l0, fmaxf(l1, l2)); float w0 = __builtin_amdgcn_exp2f(l0 - mx), w1 = __builtin_amdgcn_exp2f(l1 - mx), w2 = __builtin_amdgcn_exp2f(l2 - mx);
        const float rs = frcp_(w0 + w1 + w2); w0 *= rs; w1 *= rs; w2 *= rs;
        const v4u a = *(const v4u*)(OA + t * 512 + h * 64 + ch), b = *(const v4u*)(OA + ((size_t)T + t) * 512 + h * 64 + ch), c = *(const v4u*)(OA + ((size_t)2 * T + t) * 512 + h * 64 + ch);
        v4u o;
        o.x = pk2(w0 * bflo(a.x) + w1 * bflo(b.x) + w2 * bflo(c.x), w0 * bfhi(a.x) + w1 * bfhi(b.x) + w2 * bfhi(c.x));
        o.y = pk2(w0 * bflo(a.y) + w1 * bflo(b.y) + w2 * bflo(c.y), w0 * bfhi(a.y) + w1 * bfhi(b.y) + w2 * bfhi(c.y));
        o.z = pk2(w0 * bflo(a.z) + w1 * bflo(b.z) + w2 * bflo(c.z), w0 * bfhi(a.z) + w1 * bfhi(b.z) + w2 * bfhi(c.z));
        o.w = pk2(w0 * bflo(a.w) + w1 * bflo(b.w) + w2 * bflo(c.w), w0 * bfhi(a.w) + w1 * bfhi(b.w) + w2 * bfhi(c.w));
        *(v4u*)((bf16*)(ws + WS_Y) + t * 1024 + h * 64 + ch) = o;
    }
}

struct MState { f32x4 C[8]; float n0, n1, m; };
__device__ __forceinline__ void mlstm2_entry(const Args& A, int bh, int grp, MState& st, int lane, int wave) {
    unsigned char* ws = A.ws; const int fr = lane & 15, g = lane >> 4, m0 = 16 * wave;
#pragma unroll
    for (int j = 0; j < 8; ++j) st.C[j] = (f32x4){0.f, 0.f, 0.f, 0.f};
    st.n0 = 0.f; st.n1 = 0.f; st.m = 0.f;
    for (int gp = 0; gp < grp; ++gp) { const int gi = bh * 8 + gp; const float B = ((const float*)(ws + WS_GSC))[2 * gi], M = ((const float*)(ws + WS_GSC))[2 * gi + 1];
        const float mnew = fmaxf(B + st.m, M), a = fexp_(B + st.m - mnew), cc = fexp_(M - mnew);
        const bf16* gg = (const bf16*)(ws + WS_GAGG) + ((size_t)gi * 128 + m0 + fr) * 128;
#pragma unroll
        for (int j = 0; j < 8; ++j) { const v2u w = *(const v2u*)(gg + 16 * j + 4 * g); st.C[j] = st.C[j] * a + (f32x4){bflo(w.x), bfhi(w.x), bflo(w.y), bfhi(w.y)} * cc; }
        const float* gn = (const float*)(ws + WS_GN) + (size_t)gi * 128 + 2 * lane;
        st.n0 = st.n0 * a + gn[0] * cc; st.n1 = st.n1 * a + gn[1] * cc; st.m = mnew; }
}
__device__ __forceinline__ void mlstm_p2_item(const Args& A, unsigned char* lds_, int item, MState& st, int tid, int lane, int wave) {
    asm volatile("" : "+v"(tid), "+v"(lane));
    unsigned char* ws = A.ws; LAS unsigned char* lds = (LAS unsigned char*)lds_;
    const float* g_mhn = (const float*)(ws + WS_PAR) + PAR_GMHN; const float* skip_m = (const float*)(ws + WS_PAR) + PAR_SKIP;
    const int bh = item >> 6, c = item & 63, b = bh >> 2, h = bh & 3;
    const size_t t0 = (size_t)b * SEQ + 128 * c;
    LAS unsigned char* T0 = lds; LAS unsigned char* T1 = lds + ML_TILE; LAS unsigned char* T2 = lds + 2 * ML_TILE; LAS unsigned char* T3 = lds + 3 * ML_TILE;
    LAS float* gl = (LAS float*)(lds + ML_G);
    const int fr = lane & 15, g = lane >> 4, m0 = 16 * wave, l = m0 + fr;
    { const bf16* Wg = (const bf16*)(ws + WS_WM) + (size_t)h * 128 * 128; tile_load(T1, Wg, 128, tid); tile_load(T2, Wg + 4 * 128 * 128, 128, tid); }
    tile_load(T3, (const bf16*)(ws + WS_MV) + t0 * 512 + h * 128, 512, tid);
    ml_conv_tile(T0, (const bf16*)(ws + WS_MU) + h * 128, (const float*)(ws + WS_PAR) + PAR_CONVW, (const float*)(ws + WS_PAR) + PAR_CONVB, b, c, h, tid);
    float blast, mloc;
    { const size_t gi = (size_t)bh * SEQ + 128 * c + 2 * lane; const float mprev = st.m;
      const float i0 = ((const float*)(ws + WS_IG))[gi], i1 = ((const float*)(ws + WS_IG))[gi + 1];
      const float f0 = log_sigmoidf_(((const float*)(ws + WS_FG))[gi]), f1 = log_sigmoidf_(((const float*)(ws + WS_FG))[gi + 1]);
      float b0, b1; blast = wscan_sum(f0, f1, b0, b1, lane);
      const float g0 = blast - b0 + i0, g1 = blast - b1 + i1; mloc = wave_max(fmaxf(g0, g1));
      gl[640 + 2 * lane] = fexp_(g0 - mloc); gl[640 + 2 * lane + 1] = fexp_(g1 - mloc);
      const float a0 = i0 - b0, a1 = i1 - b1; float p0, p1; wscan_max(a0, a1, p0, p1, lane);
      const float mt0 = fmaxf(b0 + mprev, b0 + p0), mt1 = fmaxf(b1 + mprev, b1 + p1);
      gl[2 * lane] = a0; gl[2 * lane + 1] = a1; gl[128 + 2 * lane] = b0 - mt0; gl[128 + 2 * lane + 1] = b1 - mt1;
      gl[256 + 2 * lane] = fexp_(b0 + mprev - mt0); gl[256 + 2 * lane + 1] = fexp_(b1 + mprev - mt1); gl[384 + 2 * lane] = fexp_(-mt0); gl[384 + 2 * lane + 1] = fexp_(-mt1);
      gl[512 + 2 * lane] = st.n0; gl[512 + 2 * lane + 1] = st.n1; }
    __syncthreads();
    v2u cp[8], qp[8], kp[8];
    { bf16x8 af[4];
#pragma unroll
      for (int ks = 0; ks < 4; ++ks) af[ks] = rowfrag(T0, m0, ks, fr, g);
#pragma unroll
      for (int j = 0; j < 8; ++j) cp[j] = *(const LAS v2u*)(T0 + sw_off(l, 2 * j + (g >> 1)) + 8 * (g & 1));
#pragma unroll
      for (int j = 0; j < 8; ++j) { f32x4 acc = (f32x4){0.f, 0.f, 0.f, 0.f};
#pragma unroll
          for (int ks = 0; ks < 4; ++ks) acc = __builtin_amdgcn_mfma_f32_16x16x32_bf16(rowfrag(T1, 16 * j, ks, fr, g), af[ks], acc, 0, 0, 0);
          qp[j] = (v2u){pk2(acc[0], acc[1]), pk2(acc[2], acc[3])}; }
#pragma unroll
      for (int j = 0; j < 8; ++j) { f32x4 acc = (f32x4){0.f, 0.f, 0.f, 0.f};
#pragma unroll
          for (int ks = 0; ks < 4; ++ks) acc = __builtin_amdgcn_mfma_f32_16x16x32_bf16(rowfrag(T2, 16 * j, ks, fr, g), af[ks], acc, 0, 0, 0);
          kp[j] = (v2u){pk2(acc[0], acc[1]), pk2(acc[2], acc[3])}; } }
    __syncthreads();
#pragma unroll
    for (int j = 0; j < 8; ++j) { const int off = sw_off(l, 2 * j + (g >> 1)) + 8 * (g & 1);
        *(LAS v2u*)(T1 + off) = qp[j]; *(LAS v2u*)(T0 + off) = kp[j]; *(LAS v2u*)(T2 + off) = (v2u){pk2(st.C[j][0], st.C[j][1]), pk2(st.C[j][2], st.C[j][3])}; }
    __syncthreads();
    bf16x8 qf[4];
#pragma unroll
    for (int ks = 0; ks < 4; ++ks) qf[ks] = rowfrag(T1, m0, ks, fr, g);
    float qn = 0.f;
    { const LAS float* np = gl + 512;
#pragma unroll
      for (int ks = 0; ks < 4; ++ks) { const f32x4 n0 = *(const LAS f32x4*)(np + 32 * ks + 8 * g), n1 = *(const LAS f32x4*)(np + 32 * ks + 8 * g + 4); const v4u w = __builtin_bit_cast(v4u, qf[ks]);
          qn += bflo(w.x) * n0[0] + bfhi(w.x) * n0[1] + bflo(w.y) * n0[2] + bfhi(w.y) * n0[3] + bflo(w.z) * n1[0] + bfhi(w.z) * n1[1] + bflo(w.w) * n1[2] + bfhi(w.w) * n1[3]; }
      qn += __shfl_xor(qn, 16); qn += __shfl_xor(qn, 32); }
    float den = 0.f;
    { const float rc = gl[128 + l];
#pragma unroll
      for (int j = 0; j < 8; ++j) { f32x4 acc = (f32x4){0.f, 0.f, 0.f, 0.f};
          if (j <= wave) {
#pragma unroll
              for (int ks = 0; ks < 4; ++ks) acc = __builtin_amdgcn_mfma_f32_16x16x32_bf16(rowfrag(T0, 16 * j, ks, fr, g), qf[ks], acc, 0, 0, 0);
#pragma unroll
              for (int e = 0; e < 4; ++e) { const int sx = 16 * j + 4 * g + e; acc[e] = (sx <= l) ? acc[e] * fexp_(rc + gl[sx]) : 0.f; den += acc[e]; } }
          *(LAS v2u*)(T1 + sw_off(l, 2 * j + (g >> 1)) + 8 * (g & 1)) = (v2u){pk2(acc[0], acc[1]), pk2(acc[2], acc[3])}; }
      den += __shfl_xor(den, 16); den += __shfl_xor(den, 32); }
    f32x4 acc[8];
    const float iw = gl[256 + l];
#pragma unroll
    for (int j = 0; j < 8; ++j) { acc[j] = (f32x4){0.f, 0.f, 0.f, 0.f};
#pragma unroll
        for (int ks = 0; ks < 4; ++ks) acc[j] = __builtin_amdgcn_mfma_f32_16x16x32_bf16(rowfrag(T2, 16 * j, ks, fr, g), qf[ks], acc[j], 0, 0, 0);
        acc[j] = acc[j] * iw; }
    asm volatile("s_waitcnt lgkmcnt(0)" ::: "memory");
#pragma unroll
    for (int ks = 0; ks < 4; ++ks) if (2 * ks <= wave) { const bf16x8 sf = rowfrag(T1, m0, ks, fr, g);
#pragma unroll
        for (int j = 0; j < 8; ++j) acc[j] = __builtin_amdgcn_mfma_f32_16x16x32_bf16(colfrag(T3, ks, j, fr, g), sf, acc[j], 0, 0, 0); }
    den += iw * qn;
    const float rden = frcp_(fmaxf(fabsf(den), gl[384 + l]));
    float sq = 0.f;
#pragma unroll
    for (int j = 0; j < 8; ++j) { acc[j] = acc[j] * rden; sq += (acc[j][0] * acc[j][0] + acc[j][1] * acc[j][1]) + (acc[j][2] * acc[j][2] + acc[j][3] * acc[j][3]); }
    sq += __shfl_xor(sq, 16); sq += __shfl_xor(sq, 32);
    const float rn = __builtin_amdgcn_rsqf(sq * (1.0f / 128.0f) + EPSN);
    const bf16* MOg = (const bf16*)(ws + WS_MO) + (t0 + l) * 512 + h * 128;
    bf16* yg = (bf16*)(ws + WS_Y) + (t0 + l) * 1024 + 512 + h * 128;
#pragma unroll
    for (int j = 0; j < 8; ++j) { const int e0 = 16 * j + 4 * g;
        const v2u mo = *(const v2u*)(MOg + e0), cc = cp[j];
        const f32x4 gm = *(const f32x4*)(g_mhn + h * 128 + e0), sk = *(const f32x4*)(skip_m + h * 128 + e0);
        const float y0 = sigmoidf_(bflo(mo.x)) * (acc[j][0] * rn * gm[0] + sk[0] * bflo(cc.x));
        const float y1 = sigmoidf_(bfhi(mo.x)) * (acc[j][1] * rn * gm[1] + sk[1] * bfhi(cc.x));
        const float y2 = sigmoidf_(bflo(mo.y)) * (acc[j][2] * rn * gm[2] + sk[2] * bflo(cc.y));
        const float y3 = sigmoidf_(bfhi(mo.y)) * (acc[j][3] * rn * gm[3] + sk[3] * bfhi(cc.y));
        *(v2u*)(yg + e0) = (v2u){pk2(y0, y1), pk2(y2, y3)}; }
    { f32x4 accn = (f32x4){0.f, 0.f, 0.f, 0.f};
#pragma unroll
      for (int j = 0; j < 8; ++j) acc[j] = (f32x4){0.f, 0.f, 0.f, 0.f};
#pragma unroll
      for (int ks = 0; ks < 4; ++ks) { const f32x4 w0 = *(const LAS f32x4*)(gl + 640 + 32 * ks + 8 * g), w1 = *(const LAS f32x4*)(gl + 640 + 32 * ks + 8 * g + 4);
          const v4u vr = __builtin_bit_cast(v4u, colfrag(T3, ks, wave, fr, g));
          const v4u vs = (v4u){pk2(bflo(vr.x) * w0[0], bfhi(vr.x) * w0[1]), pk2(bflo(vr.y) * w0[2], bfhi(vr.y) * w0[3]), pk2(bflo(vr.z) * w1[0], bfhi(vr.z) * w1[1]), pk2(bflo(vr.w) * w1[2], bfhi(vr.w) * w1[3])};
          const v4u wv = (v4u){pk2(w0[0], w0[1]), pk2(w0[2], w0[3]), pk2(w1[0], w1[1]), pk2(w1[2], w1[3])};
          const bf16x8 vf = __builtin_bit_cast(bf16x8, vs), wf = __builtin_bit_cast(bf16x8, wv);
#pragma unroll
          for (int j = 0; j < 8; ++j) { const bf16x8 kf = colfrag(T0, ks, j, fr, g); acc[j] = __builtin_amdgcn_mfma_f32_16x16x32_bf16(kf, vf, acc[j], 0, 0, 0);
              if (j == wave) accn = __builtin_amdgcn_mfma_f32_16x16x32_bf16(kf, wf, accn, 0, 0, 0); } }
      const float mnew = fmaxf(blast + st.m, mloc), a = fexp_(blast + st.m - mnew), cc = fexp_(mloc - mnew);
#pragma unroll
      for (int j = 0; j < 8; ++j) st.C[j] = st.C[j] * a + acc[j] * cc;
      if (fr == 0) *(LAS f32x4*)(gl + 768 + 16 * wave + 4 * g) = accn;
      __syncthreads();
      st.n0 = st.n0 * a + gl[768 + 2 * lane] * cc; st.n1 = st.n1 * a + gl[768 + 2 * lane + 1] * cc; st.m = mnew; }
}

struct EpiOutProj {
    static constexpr bool PERM = true, AFTER_DRAIN = false;
    const float* x; bf16* x1b; float* ss;
    __device__ __forceinline__ void operator()(const f32x4 (&acc)[2][2][4][2], const pg8::Unit& u, int wr, int wc, int fr, int fq) const {
        int row0 = u.pm * 256 + wr * 64 + fr; asm volatile("" : "+v"(row0));
        const int col0 = u.pn * 256 + wc * 32 + 8 * fq;
#pragma unroll
        for (int ai = 0; ai < 2; ++ai)
#pragma unroll
            for (int m = 0; m < 4; ++m) { const int row = row0 + ai * 128 + m * 16; float sq = 0.f;
#pragma unroll
                for (int bj = 0; bj < 2; ++bj) { const size_t off = (size_t)row * D + col0 + bj * 128;
                    const f32x4 o0 = *(const f32x4*)(x + off) + acc[ai][bj][m][0], o1 = *(const f32x4*)(x + off + 4) + acc[ai][bj][m][1];
                    *(v4u*)(x1b + off) = pack8(o0, o1);
                    sq += ((o0[0] * o0[0] + o0[1] * o0[1]) + (o0[2] * o0[2] + o0[3] * o0[3])) + ((o1[0] * o1[0] + o1[1] * o1[1]) + (o1[2] * o1[2] + o1[3] * o1[3])); }
                sq += __shfl_xor(sq, 16); sq += __shfl_xor(sq, 32);
                if (fq == 0) ss[(size_t)row * 16 + u.pn * 4 + wc] = sq; }
    }
};
struct FixedOrder {
    int pm, n;
    __device__ __forceinline__ bool next(int i, pg8::Unit& u) const { if (i >= n) return false; u.pm = pm; u.pn = i; u.aux = 0; return true; }
    __device__ __forceinline__ void a_ready(const pg8::Unit&) const {}
    __device__ __forceinline__ void done(const pg8::Unit&) const {}
};
struct EpiQx {
    static constexpr bool PERM = true, AFTER_DRAIN = false;
    bf16* qx; const LAS float* rs;
    __device__ __forceinline__ void operator()(const f32x4 (&acc)[2][2][4][2], const pg8::Unit& u, int wr, int wc, int fr, int fq) const {
        const int rl0 = wr * 64 + fr, col0 = wc * 32 + 8 * fq;
#pragma unroll
        for (int ai = 0; ai < 2; ++ai)
#pragma unroll
            for (int m = 0; m < 4; ++m) { const int rl = rl0 + ai * 128 + m * 16; const float sc = rs[rl]; bf16* rowp = qx + (size_t)(u.pm * 256 + rl) * 256 + col0;
#pragma unroll
                for (int bj = 0; bj < 2; ++bj) *(v4u*)(rowp + bj * 128) = pack8(acc[ai][bj][m][0] * sc, acc[ai][bj][m][1] * sc);
                asm volatile("" ::: "memory"); }
    }
};
struct EpiOx {
    static constexpr bool PERM = true, AFTER_DRAIN = false;
    const bf16* x1b; bf16* x2b;
    __device__ __forceinline__ void operator()(const f32x4 (&acc)[2][2][4][2], const pg8::Unit& u, int wr, int wc, int fr, int fq) const {
        int row0 = u.pm * 256 + wr * 64 + fr; asm volatile("" : "+v"(row0));
        const int col0 = u.pn * 256 + wc * 32 + 8 * fq;
#pragma unroll
        for (int ai = 0; ai < 2; ++ai)
#pragma unroll
            for (int m = 0; m < 4; ++m) {
#pragma unroll
                for (int bj = 0; bj < 2; ++bj) { const size_t off = (size_t)(row0 + ai * 128 + m * 16) * D + col0 + bj * 128; const v4u r = *(const v4u*)(x1b + off);
                    f32x4 o0 = acc[ai][bj][m][0], o1 = acc[ai][bj][m][1];
                    o0[0] += bflo(r.x); o0[1] += bfhi(r.x); o0[2] += bflo(r.y); o0[3] += bfhi(r.y); o1[0] += bflo(r.z); o1[1] += bfhi(r.z); o1[2] += bflo(r.w); o1[3] += bfhi(r.w);
                    *(v4u*)(x2b + off) = pack8(o0, o1); }
                asm volatile("" ::: "memory"); }
    }
};
__device__ __forceinline__ void cross_dma(const bf16* KV, int h, LAS unsigned char* buf, int lane, int wave) {
#pragma unroll
    for (int i = 0; i < 4; ++i) { const int inst = wave + 8 * i, row = 8 * inst + (lane >> 3);
        const bf16* src = KV + (size_t)row * NKV + h * 64 + ((lane & 7) ^ (lane >> 3)) * 8;
        glds16(src, (unsigned)__builtin_amdgcn_readfirstlane(lds_addr_of(buf + inst * 1024)));
        glds16(src + 256, (unsigned)__builtin_amdgcn_readfirstlane(lds_addr_of(buf + 32768 + inst * 1024))); }
}
__device__ __forceinline__ void cross_unit(const Args& A, unsigned char* lds, int pm, int tid, int lane, int wave) {
    asm volatile("" : "+v"(tid), "+v"(lane));
    unsigned char* ws = A.ws; LAS unsigned char* L = (LAS unsigned char*)lds;
    const size_t t0 = (size_t)pm * 256; const int b = (int)(t0 / SEQ);
    const bf16* KV = (const bf16*)(ws + WS_KVX) + (size_t)b * MEMLEN * NKV;
    const int fr = lane & 15, g = lane >> 4;
    cross_dma(KV, 0, L, lane, wave);
    for (int h = 0; h < 4; ++h) {
        asm volatile("s_waitcnt vmcnt(0)" ::: "memory");
        __syncthreads();
        LAS unsigned char* buf = L + (h & 1) * 65536;
        if (h < 3) cross_dma(KV, h + 1, L + ((h + 1) & 1) * 65536, lane, wave);
#pragma unroll 1
        for (int rt = 0; rt < 2; ++rt) {
            const size_t row = t0 + 32 * wave + 16 * rt + fr;
            const bf16* qg = (const bf16*)(ws + WS_QX) + row * 256 + h * 64;
            const bf16x8 q0 = *(const bf16x8*)(qg + 8 * g), q1 = *(const bf16x8*)(qg + 32 + 8 * g);
            f32x4 s[16];
#pragma unroll
            for (int t = 0; t < 16; ++t) { const int key = 16 * t + fr;
                s[t] = __builtin_amdgcn_mfma_f32_16x16x32_bf16(*(const LAS bf16x8*)(buf + key * 128 + (((g) ^ (key & 7)) * 16)), q0, (f32x4){0.f, 0.f, 0.f, 0.f}, 0, 0, 0);
                s[t] = __builtin_amdgcn_mfma_f32_16x16x32_bf16(*(const LAS bf16x8*)(buf + key * 128 + (((4 + g) ^ (key & 7)) * 16)), q1, s[t], 0, 0, 0); }
            float mx = -1e30f;
#pragma unroll
            for (int t = 0; t < 16; ++t) mx = fmaxf(fmaxf(mx, fmaxf(s[t][0], s[t][1])), fmaxf(s[t][2], s[t][3]));
            mx = fmaxf(mx, __shfl_xor(mx, 16)); mx = fmaxf(mx, __shfl_xor(mx, 32));
            float l = 0.f;
#pragma unroll
            for (int t = 0; t < 16; ++t)
#pragma unroll
                for (int e = 0; e < 4; ++e) { s[t][e] = __builtin_amdgcn_exp2f(s[t][e] - mx); l += s[t][e]; }
            l += __shfl_xor(l, 16); l += __shfl_xor(l, 32);
            f32x4 o[4];
#pragma unroll
            for (int dt = 0; dt < 4; ++dt) o[dt] = (f32x4){0.f, 0.f, 0.f, 0.f};
#pragma unroll
            for (int k8 = 0; k8 < 8; ++k8) {
                const v4u pw = (v4u){pk2(s[2 * k8][0], s[2 * k8][1]), pk2(s[2 * k8][2], s[2 * k8][3]), pk2(s[2 * k8 + 1][0], s[2 * k8 + 1][1]), pk2(s[2 * k8 + 1][2], s[2 * k8 + 1][3])};
                const bf16x8 pf = __builtin_bit_cast(bf16x8, pw);
                const int r0 = 32 * k8 + 4 * g + (fr >> 2), r1 = r0 + 16, p_ = fr & 3;
#pragma unroll
                for (int dt = 0; dt < 4; ++dt) { const int chunk = 2 * dt + (p_ >> 1);
                    const v4i16_t v0 = __builtin_amdgcn_ds_read_tr16_b64_v4i16((LAS v4i16_t*)(buf + 32768 + r0 * 128 + ((chunk ^ (r0 & 7)) * 16) + 8 * (p_ & 1)));
                    const v4i16_t v1 = __builtin_amdgcn_ds_read_tr16_b64_v4i16((LAS v4i16_t*)(buf + 32768 + r1 * 128 + ((chunk ^ (r1 & 7)) * 16) + 8 * (p_ & 1)));
                    const bf16x8 vf = (bf16x8){v0[0], v0[1], v0[2], v0[3], v1[0], v1[1], v1[2], v1[3]};
                    o[dt] = __builtin_amdgcn_mfma_f32_16x16x32_bf16(vf, pf, o[dt], 0, 0, 0); } }
            const float rl = frcp_(l);
            bf16* og = (bf16*)(ws + WS_OX) + row * 256 + h * 64;
#pragma unroll
            for (int dt = 0; dt < 4; ++dt) *(v2u*)(og + 16 * dt + 4 * g) = (v2u){pk2(o[dt][0] * rl, o[dt][1] * rl), pk2(o[dt][2] * rl, o[dt][3] * rl)};
        }
    }
    asm volatile("s_waitcnt vmcnt(0)" ::: "memory");
    __syncthreads();
}

struct TokInfo { int bucket; float wa, wb; int rank; };
constexpr size_t WS_RSTD3 = 18 * MiB;
constexpr size_t WS_CNTTAB = 31 * MiB + 512 * 1024;
__device__ __forceinline__ void p9_route(const Args& A, unsigned char* lds_, int tid, int lane, int wave) {
    asm volatile("" : "+v"(tid), "+v"(lane));
    unsigned char* ws = A.ws; LAS unsigned char* lds = (LAS unsigned char*)lds_;
    const float* b_rg = (const float*)(ws + WS_PAR) + PAR_BRG; const float* b_re = (const float*)(ws + WS_PAR) + PAR_BRE;
    constexpr int WLD = 2064;
    LAS unsigned char* Wh = lds; LAS unsigned char* Wl = lds + 20 * WLD;
    LAS float* lg = (LAS float*)(lds + 2 * 20 * WLD) + wave * (32 * 24);
    LAS int* bkl = (LAS int*)(lds + 2 * 20 * WLD + 8 * 32 * 24 * 4);
    for (int id = tid; id < 2 * 20 * 128; id += NTHR) { const int t = id / 2560, row = (id % 2560) >> 7, ch = id & 127;
        *(LAS v4u*)(lds + (t * 20 + row) * WLD + ch * 16) = *(const v4u*)((const bf16*)(ws + WS_WR) + ((size_t)t * 32 + row) * 1024 + ch * 8); }
    __syncthreads();
    const bf16* X2B = (const bf16*)(ws + WS_HBS);
    const int fr = lane & 15, g = lane >> 4;
    for (int chunk = blockIdx.x; chunk < T / 256; chunk += gridDim.x) {
        const bf16* xa = X2B + ((size_t)chunk * 256 + 32 * wave + fr) * D + 8 * g;
        f32x4 acc[2][2]; float sq[2] = {0.f, 0.f};
#pragma unroll
        for (int rt = 0; rt < 2; ++rt) { acc[rt][0] = (f32x4){0.f, 0.f, 0.f, 0.f}; acc[rt][1] = (f32x4){0.f, 0.f, 0.f, 0.f}; }
#pragma unroll 4
        for (int ks = 0; ks < 32; ++ks) {
            const bf16x8 a0 = *(const bf16x8*)(xa + 32 * ks), a1 = *(const bf16x8*)(xa + 16 * D + 32 * ks);
            { const v4u w0 = __builtin_bit_cast(v4u, a0), w1 = __builtin_bit_cast(v4u, a1);
              sq[0] += (bflo(w0.x) * bflo(w0.x) + bfhi(w0.x) * bfhi(w0.x)) + (bflo(w0.y) * bflo(w0.y) + bfhi(w0.y) * bfhi(w0.y)) + (bflo(w0.z) * bflo(w0.z) + bfhi(w0.z) * bfhi(w0.z)) + (bflo(w0.w) * bflo(w0.w) + bfhi(w0.w) * bfhi(w0.w));
              sq[1] += (bflo(w1.x) * bflo(w1.x) + bfhi(w1.x) * bfhi(w1.x)) + (bflo(w1.y) * bflo(w1.y) + bfhi(w1.y) * bfhi(w1.y)) + (bflo(w1.z) * bflo(w1.z) + bfhi(w1.z) * bfhi(w1.z)) + (bflo(w1.w) * bflo(w1.w) + bfhi(w1.w) * bfhi(w1.w)); }
#pragma unroll
            for (int ct = 0; ct < 2; ++ct) { const int wrow = (16 * ct + fr < 20) ? 16 * ct + fr : fr;
                const bf16x8 bh = *(const LAS bf16x8*)(Wh + wrow * WLD + 64 * ks + 16 * g), bl = *(const LAS bf16x8*)(Wl + wrow * WLD + 64 * ks + 16 * g);
                acc[0][ct] = __builtin_amdgcn_mfma_f32_16x16x32_bf16(bh, a0, acc[0][ct], 0, 0, 0); acc[0][ct] = __builtin_amdgcn_mfma_f32_16x16x32_bf16(bl, a0, acc[0][ct], 0, 0, 0);
                acc[1][ct] = __builtin_amdgcn_mfma_f32_16x16x32_bf16(bh, a1, acc[1][ct], 0, 0, 0); acc[1][ct] = __builtin_amdgcn_mfma_f32_16x16x32_bf16(bl, a1, acc[1][ct], 0, 0, 0); } }
#pragma unroll
        for (int rt = 0; rt < 2; ++rt) { sq[rt] += __shfl_xor(sq[rt], 16); sq[rt] += __shfl_xor(sq[rt], 32);
            LAS float* lr = lg + (16 * rt + fr) * 24;
            *(LAS f32x4*)(lr + 4 * g) = acc[rt][0];
            if (g == 0) { *(LAS f32x4*)(lr + 16) = acc[rt][1]; lr[20] = 1.0f / sqrtf(sq[rt] * (1.0f / D) + EPSN); } }
        asm volatile("s_waitcnt lgkmcnt(0)" ::: "memory");
        if (lane < 32) { const LAS float* lr = lg + lane * 24; const float rstd = lr[20];
            float gl4[4];
#pragma unroll
            for (int i = 0; i < 4; ++i) gl4[i] = lr[i] * rstd + b_rg[i];
            int gsel = 0; float gm = gl4[0];
#pragma unroll
            for (int i = 1; i < 4; ++i) if (gl4[i] > gm) { gm = gl4[i]; gsel = i; }
            float gs = 0.f;
#pragma unroll
            for (int i = 0; i < 4; ++i) gs += __expf(gl4[i] - gm);
            const float gw_ = 1.0f / gs;
            float el[4];
#pragma unroll
            for (int i = 0; i < 4; ++i) el[i] = lr[4 + 4 * gsel + i] * rstd + b_re[gsel * 4 + i];
            int i0 = 0; float v0 = el[0];
#pragma unroll
            for (int i = 1; i < 4; ++i) if (el[i] > v0) { v0 = el[i]; i0 = i; }
            int i1 = -1; float v1 = -INFINITY;
#pragma unroll
            for (int i = 0; i < 4; ++i) if (i != i0 && el[i] > v1) { v1 = el[i]; i1 = i; }
            const float e1 = __expf(v1 - v0); const float w0 = gw_ / (1.0f + e1), w1 = gw_ * e1 / (1.0f + e1);
            const int pa = i0 < i1 ? i0 : i1, pb = i0 < i1 ? i1 : i0;
            const int pidx = (pa == 0) ? (pb - 1) : (pa == 1 ? pb + 1 : 5);
            const int r = 32 * wave + lane;
            ((float*)(ws + WS_RSTD3))[chunk * 256 + r] = rstd; bkl[r] = gsel * 6 + pidx; ((LAS float*)(bkl + 256))[r] = (i0 < i1) ? w0 : w1; ((LAS float*)(bkl + 512))[r] = (i0 < i1) ? w1 : w0; }
        __syncthreads();
        if (tid < 256) { const int my = bkl[tid]; int rank = 0; for (int j = 0; j < tid; ++j) rank += (bkl[j] == my) ? 1 : 0;
            TokInfo ti; ti.bucket = my; ti.wa = ((LAS float*)(bkl + 256))[tid]; ti.wb = ((LAS float*)(bkl + 512))[tid]; ti.rank = rank;
            ((TokInfo*)(ws + WS_TOKINFO))[chunk * 256 + tid] = ti; }
        else if (tid < 256 + NBUCKET) { const int b = tid - 256; int c = 0; for (int j = 0; j < 256; ++j) c += (bkl[j] == b) ? 1 : 0;
            ((int*)(ws + WS_CNTTAB))[chunk * NBUCKET + b] = c; }
        __syncthreads();
    }
}
__device__ __forceinline__ void p10_slots(const Args& A, unsigned char* lds, int tid, int lane, int wave) {
    unsigned char* ws = A.ws;
    LAS int* tabl = (LAS int*)lds;
    LAS int* totl = (LAS int*)(lds + 32768);
    const int* CNTTAB = (const int*)(ws + WS_CNTTAB);
    for (int i = tid; i < 256 * NBUCKET; i += NTHR) tabl[i] = CNTTAB[i];
    __syncthreads();
    if (tid < NBUCKET) { int t = 0; for (int w = 0; w < 256; ++w) t += tabl[w * NBUCKET + tid]; totl[tid] = t; }
    __syncthreads();
    if (tid == 0) { int acc = 0; for (int b = 0; b < NBUCKET; ++b) { totl[32 + b] = acc; acc += ((totl[b] + 255) >> 8) * 256; } totl[32 + NBUCKET] = acc; }
    if (blockIdx.x == 0 && tid < NBUCKET) ((unsigned*)(ws + WS_CTL))[CW_CNT + tid] = (unsigned)totl[tid];
    __syncthreads();
    int* TOKMAP = (int*)(ws + WS_TOKMAP); float* WSORT = (float*)(ws + WS_WSORT);
    for (int chunk = blockIdx.x; chunk < T / 256; chunk += gridDim.x) {
        if (tid < NBUCKET) { int s = 0; for (int w = 0; w < chunk; ++w) s += tabl[w * NBUCKET + tid]; totl[64 + tid] = totl[32 + tid] + s; }
        __syncthreads();
        if (tid < 256) { const int m = chunk * 256 + tid; const TokInfo ti = ((const TokInfo*)(ws + WS_TOKINFO))[m]; const int slot = totl[64 + ti.bucket] + ti.rank;
            TOKMAP[slot] = m; *(f32x4*)(WSORT + 4 * slot) = (f32x4){ti.wa, ti.wb, ((const float*)(ws + WS_RSTD3))[m], 0.f}; }
        __syncthreads();
    }
    for (int b = blockIdx.x; b < NBUCKET; b += gridDim.x)
        for (int r = totl[32 + b] + totl[b] + tid; r < totl[32 + b + 1]; r += NTHR) { TOKMAP[r] = -1; *(f32x4*)(WSORT + 4 * r) = (f32x4){0.f, 0.f, 0.f, 0.f}; }
}
struct MoeOrder {
    int G, c, nunits, ncol; const int* tab;
    __device__ __forceinline__ bool next(int i, pg8::Unit& u) const {
        const long L = (long)i * G + c; if (L >= nunits) return false;
        const int rt = (int)L / ncol, j = (int)L % ncol, bk = tab[rt];
        u.pm = rt; u.aux = j;
        if (ncol == 8) { const int g = bk / 6, p = bk % 6; const int pa = (p < 3) ? 0 : (p < 5 ? 1 : 2), pb = (p < 3) ? p + 1 : (p < 5 ? p - 1 : 3);
            const int e = 4 * g + ((j >> 2) ? pb : pa); u.pn = e * 4 + (j & 3); }
        else u.pn = bk * 4 + j;
        return true;
    }
    __device__ __forceinline__ void a_ready(const pg8::Unit&) const {}
    __device__ __forceinline__ void done(const pg8::Unit&) const {}
};
struct EpiUp {
    static constexpr bool PERM = true, AFTER_DRAIN = false;
    bf16* act; const float* wsort;
    __device__ __forceinline__ void operator()(const f32x4 (&acc)[2][2][4][2], const pg8::Unit& u, int wr, int wc, int fr, int fq) const {
        int row0 = u.pm * 256 + wr * 64 + fr; asm volatile("" : "+v"(row0));
        const int half = u.aux >> 2, col0 = half * 512 + (u.aux & 3) * 128 + wc * 32 + 8 * fq;
#pragma unroll
        for (int ai = 0; ai < 2; ++ai)
#pragma unroll
            for (int m = 0; m < 4; ++m) { const int row = row0 + ai * 128 + m * 16; const float w = wsort[4 * row + half], rs = wsort[4 * row + 2];
                f32x4 r0, r1;
#pragma unroll
                for (int i = 0; i < 4; ++i) { const float a0 = acc[ai][0][m][0][i] * rs, a1 = acc[ai][0][m][1][i] * rs;
                    r0[i] = a0 * sigmoidf_(a0) * (acc[ai][1][m][0][i] * rs) * w; r1[i] = a1 * sigmoidf_(a1) * (acc[ai][1][m][1][i] * rs) * w; }
                *(v4u*)(act + (size_t)row * D + col0) = pack8(r0, r1); }
    }
};
struct EpiDown {
    static constexpr bool PERM = true, AFTER_DRAIN = false;
    const bf16* x2b; float* xo; const int* tokmap;
    __device__ __forceinline__ void operator()(const f32x4 (&acc)[2][2][4][2], const pg8::Unit& u, int wr, int wc, int fr, int fq) const {
        const int row0 = u.pm * 256 + wr * 64 + fr, col0 = u.aux * 256 + wc * 32 + 8 * fq;
#pragma unroll
        for (int ai = 0; ai < 2; ++ai)
#pragma unroll
            for (int m = 0; m < 4; ++m) { const int tok = tokmap[row0 + ai * 128 + m * 16];
                if (tok >= 0) {
#pragma unroll
                    for (int bj = 0; bj < 2; ++bj) { const size_t off = (size_t)tok * D + col0 + bj * 128; const v4u r = *(const v4u*)(x2b + off);
                        f32x4 o0 = acc[ai][bj][m][0], o1 = acc[ai][bj][m][1];
                        o0[0] += bflo(r.x); o0[1] += bfhi(r.x); o0[2] += bflo(r.y); o0[3] += bfhi(r.y); o1[0] += bflo(r.z); o1[1] += bfhi(r.z); o1[2] += bflo(r.w); o1[3] += bfhi(r.w);
                        *(f32x4*)(xo + off) = o0; *(f32x4*)(xo + off + 4) = o1; } } }
    }
};
constexpr size_t WS_XCH = 20 * MiB + 512 * 1024;
constexpr int CW_SEAM = 16384;
constexpr int LDS_EX = 139264;
struct EpiDownNorm {
    static constexpr bool PERM = true, AFTER_DRAIN = false;
    const bf16* x2b; float* out; const int* tokmap; const float* gfin; float* xch; unsigned* cnt; LAS unsigned char* ex;
    __device__ __forceinline__ void operator()(const f32x4 (&acc_)[2][2][4][2], const pg8::Unit& u, int wr, int wc, int fr, int fq) const {
        f32x4 (&acc)[2][2][4][2] = const_cast<f32x4 (&)[2][2][4][2]>(acc_);
        int tid = threadIdx.x; asm volatile("" : "+v"(tid));
        const int lane = tid & 63, wid = __builtin_amdgcn_readfirstlane(tid >> 6);
        int rb = wr * 64 + fr; asm volatile("" : "+v"(rb));
        LAS float* P = (LAS float*)ex; LAS float* S = (LAS float*)(ex + 4096); LAS unsigned* flag = (LAS unsigned*)(ex + 6144);
        const int col0 = u.aux * 256 + wc * 32 + 8 * fq;
#pragma unroll
        for (int ai = 0; ai < 2; ++ai)
#pragma unroll
            for (int m = 0; m < 4; ++m) { const int rl = rb + ai * 128 + m * 16; const int tok = tokmap[u.pm * 256 + rl]; float sq = 0.f;
#pragma unroll
                for (int bj = 0; bj < 2; ++bj) { f32x4& o0 = acc[ai][bj][m][0]; f32x4& o1 = acc[ai][bj][m][1];
                    if (tok >= 0) { const v4u r = *(const v4u*)(x2b + (size_t)tok * D + col0 + bj * 128);
                        o0[0] += bflo(r.x); o0[1] += bfhi(r.x); o0[2] += bflo(r.y); o0[3] += bfhi(r.y); o1[0] += bflo(r.z); o1[1] += bfhi(r.z); o1[2] += bflo(r.w); o1[3] += bfhi(r.w); }
                    sq += ((o0[0] * o0[0] + o0[1] * o0[1]) + (o0[2] * o0[2] + o0[3] * o0[3])) + ((o1[0] * o1[0] + o1[1] * o1[1]) + (o1[2] * o1[2] + o1[3] * o1[3])); }
                sq += __shfl_xor(sq, 16); sq += __shfl_xor(sq, 32);
                if (fq == 0) P[rl * 4 + wc] = sq;
                asm volatile("" ::: "memory"); }
        asm volatile("s_waitcnt lgkmcnt(0)" ::: "memory"); __builtin_amdgcn_s_barrier(); asm volatile("" ::: "memory");
        if (tid < 256) { const f32x4 p = *(const LAS f32x4*)(P + tid * 4);
            __hip_atomic_store(xch + ((size_t)u.pm * 256 + tid) * 4 + u.aux, (p[0] + p[1]) + (p[2] + p[3]), __ATOMIC_RELAXED, __HIP_MEMORY_SCOPE_AGENT); }
        asm volatile("s_waitcnt vmcnt(0)" ::: "memory");
        if (wid < 4 && lane == 0) __hip_atomic_fetch_add(cnt + 64 * u.pm, 1u, __ATOMIC_RELAXED, __HIP_MEMORY_SCOPE_AGENT);
        if (wid == 0) { unsigned spins = 0;
            while ((unsigned)__builtin_amdgcn_readfirstlane(__hip_atomic_load(cnt + 64 * u.pm, __ATOMIC_RELAXED, __HIP_MEMORY_SCOPE_AGENT)) < 16u) { __builtin_amdgcn_s_sleep(2); if (++spins > (1u << 22)) break; }
            __builtin_amdgcn_fence(__ATOMIC_ACQUIRE, "agent");
            if (lane == 0) flag[0] = spins; }
        asm volatile("s_waitcnt vmcnt(0) lgkmcnt(0)" ::: "memory"); __builtin_amdgcn_s_barrier(); asm volatile("" ::: "memory");
        if (tid < 256) { const float* sl = xch + ((size_t)u.pm * 256 + tid) * 4; float t = 0.f;
#pragma unroll
            for (int k = 0; k < 4; ++k) t += __hip_atomic_load(sl + k, __ATOMIC_RELAXED, __HIP_MEMORY_SCOPE_AGENT);
            S[tid] = 1.0f / sqrtf(t * (1.0f / D) + EPSN); }
        asm volatile("s_waitcnt lgkmcnt(0)" ::: "memory"); __builtin_amdgcn_s_barrier(); asm volatile("" ::: "memory");
#pragma unroll
        for (int ai = 0; ai < 2; ++ai)
#pragma unroll
            for (int m = 0; m < 4; ++m) { const int rl = rb + ai * 128 + m * 16; const int tok = tokmap[u.pm * 256 + rl]; const float rs = S[rl];
                if (tok >= 0) {
#pragma unroll
                    for (int bj = 0; bj < 2; ++bj)
#pragma unroll
                        for (int n = 0; n < 2; ++n) { const int cc = col0 + bj * 128 + 4 * n; acc[ai][bj][m][n] = acc[ai][bj][m][n] * rs; acc[ai][bj][m][n] = acc[ai][bj][m][n] * *(const f32x4*)(gfin + cc);
                            *(f32x4*)(out + (size_t)tok * D + cc) = acc[ai][bj][m][n]; asm volatile("" ::: "memory"); } } }
    }
};
__device__ __forceinline__ void p10_final(const Args& A, float* outp, int lane, int wave) {
    const float* g_final = (const float*)(A.ws + WS_PAR) + PAR_GFIN;
    const int G = gridDim.x, gw = blockIdx.x * NWAVES + wave, NGW = G * NWAVES;
    f32x4 gv[4];
#pragma unroll
    for (int j = 0; j < 4; ++j) gv[j] = *((const f32x4*)g_final + lane + 64 * j);
    for (int m = gw; m < T; m += NGW) {
        f32x4* xr = (f32x4*)(A.out + (size_t)m * D) + lane;
        f32x4 v[4]; float s = 0.f;
#pragma unroll
        for (int j = 0; j < 4; ++j) { v[j] = xr[64 * j]; s += (v[j].x * v[j].x + v[j].y * v[j].y) + (v[j].z * v[j].z + v[j].w * v[j].w); }
        const float rstd = 1.0f / sqrtf(wave_sum(s) * (1.0f / D) + EPSN);
#pragma unroll
        for (int j = 0; j < 4; ++j) ((f32x4*)(outp + (size_t)m * D) + lane)[64 * j] = v[j] * rstd * gv[j];
    }
}

#ifndef MS
#define MS 4
#endif
#ifndef N_LAUNCHES
#define N_LAUNCHES 1
#endif
constexpr int N_PHASES = 14;
#ifndef STAGGER
#define STAGGER 0
#endif
#ifndef FUSE_FINAL
#define FUSE_FINAL 1
#endif
#ifndef DUP_MASK
#define DUP_MASK 0
#endif
#define REP(k) for (int rep_ = 0; rep_ < (((DUP_MASK >> (k)) & 1) ? 2 : 1); ++rep_)
#ifndef QX_SP2
#define QX_SP2 false
#endif

#ifndef NVG
#define NVG 256
#endif
__global__ void __launch_bounds__(NTHR, 2) __attribute__((amdgpu_num_vgpr(NVG))) fwd_kernel(Args args) {
    __shared__ __attribute__((aligned(16))) unsigned char lds[LDS_BYTES];
    const int tid = threadIdx.x, lane = tid & 63, wave = __builtin_amdgcn_readfirstlane(tid >> 6);
    gu32* ctl = (gu32*)(args.ws + WS_CTL);
    for (int u = tid; u < (LDS_BYTES - LDS_MISC) / 4; u += NTHR) ((unsigned*)(lds + LDS_MISC))[u] = 0u;
    __syncthreads();
    const int lo = args.ph_lo, hi = args.ph_hi;
    const bool use_bar = (hi - lo) > 1;
    XcdBarrier bar; bar.bar = (unsigned*)ctl + CW_BAR; bar.x = 0; bar.st = (volatile LAS unsigned*)(lds + LDS_MISC) + 8;
    if (use_bar) bar = xcd_barrier_post((unsigned*)ctl + CW_BAR, (volatile LAS unsigned*)(lds + LDS_MISC) + 8);
#ifndef PH_MASK
#define PH_MASK 0xFFFF
#endif
#define IN(k) (((PH_MASK >> (k)) & 1) && lo <= (k) && (k) < hi)
#define SEAM(k) do { if (IN(k) && IN((k) + 1)) xcd_barrier(bar); } while (0)
    PG8_LAS unsigned char* ring = (PG8_LAS unsigned char*)lds;
    const int G = gridDim.x;
#define PHASE_PTRS Args pa = args; { unsigned char* w_ = args.ws; float* o_ = args.out; asm volatile("" : "+s"(w_), "+s"(o_)); pa.ws = w_; pa.out = o_; } unsigned char* const ws = pa.ws; (void)ws; int tid = (int)threadIdx.x; asm volatile("" : "+v"(tid)); const int lane = tid & 63; (void)lane

#ifdef DUMMY_LIVE
    float dl0, dl1, dl2, dl3, dl4, dl5, dl6, dl7; asm volatile("" : "=v"(dl0), "=v"(dl1), "=v"(dl2), "=v"(dl3), "=v"(dl4), "=v"(dl5), "=v"(dl6), "=v"(dl7));
#endif
    if (IN(0)) { PHASE_PTRS; REP(0) { p0_prologue(pa, lds, tid, lane, wave); __syncthreads(); } }
    SEAM(0);
    if (IN(1) && MS >= 1) { PHASE_PTRS;
        pg8::Gemm g{(const pg8::bf16_t*)(ws + WS_XN), (const pg8::bf16_t*)(ws + WS_WIN), T, NIN, D};
        pg8::StaticOrder S; S.init(T, NIN, G, (int)blockIdx.x);
        EpiInProj E{(bf16*)(ws + WS_Q), (const float*)(ws + WS_ROPE)};
        REP(1) pg8::gemm_phase<EpiInProj, pg8::StaticOrder, true, true>(ring, g, S, E);
    }
    SEAM(1);
    if (IN(2) && MS >= 1) { PHASE_PTRS;
        const int n_att = (MS >= 2) ? 3 * 4096 : 0;
        for (int tile = blockIdx.x; tile < 256; tile += G) kv_tile(pa, lds, tile, tid, lane, wave);
        __syncthreads();
        REP(14) attn_phase(pa, lds, n_att, lane, wave);
        { int wres = -1; MGroup mg; __syncthreads(); for (int it = blockIdx.x * 8; it < 2048; it += G * 8) for (int q = 0; q < 8; ++q) mlstm_p1_item(pa, lds, it + q, wres, mg, tid, lane, wave); }
    }
    if (IN(2) && IN(4)) xcd_barrier(bar);
    if (IN(4) && MS >= 1) { PHASE_PTRS;
        for (int rt = blockIdx.x; rt < T / 256; rt += G) combine_rows(pa, (size_t)rt * 256, 256, tid);
        for (int it = blockIdx.x * 8; it < 2048; it += G * 8) { MState st; mlstm2_entry(pa, it >> 6, (it & 63) >> 3, st, lane, wave);
            for (int q = 0; q < 8; ++q) mlstm_p2_item(pa, lds, it + q, st, tid, lane, wave); }
    }
    SEAM(4);
    if (IN(5) && MS >= 1) { PHASE_PTRS;
        const int pm = (int)blockIdx.x;
        if (pm < T / 256) {
            { pg8::Gemm g{(const pg8::bf16_t*)(ws + WS_Y), (const pg8::bf16_t*)(ws + WS_WOUT), T, D, D};
              FixedOrder S{pm, 4}; EpiOutProj E{(const float*)pa.in[0], (bf16*)(ws + WS_X1B), (float*)(ws + WS_SS1)};
              pg8::gemm_phase<EpiOutProj, FixedOrder, true, true>(ring, g, S, E); }
            VM_WAIT(); __syncthreads();
            float* rs = (float*)(lds + LDS_RS);
            if (tid < 256) { const f32x4* sp = (const f32x4*)((const float*)(ws + WS_SS1) + (size_t)(pm * 256 + tid) * 16);
                const f32x4 a = sp[0], b = sp[1], c = sp[2], d = sp[3];
                const float s = ((a[0] + a[1]) + (a[2] + a[3])) + ((b[0] + b[1]) + (b[2] + b[3])) + ((c[0] + c[1]) + (c[2] + c[3])) + ((d[0] + d[1]) + (d[2] + d[3]));
                rs[tid] = 1.0f / sqrtf(s * (1.0f / D) + EPSN); }
            __syncthreads();
            { pg8::Gemm g{(const pg8::bf16_t*)(ws + WS_X1B), (const pg8::bf16_t*)(ws + WS_WQX), T, 256, D};
              FixedOrder S{pm, 1}; EpiQx E{(bf16*)(ws + WS_QX), (const LAS float*)rs};
              pg8::gemm_phase<EpiQx, FixedOrder, true, QX_SP2>(ring, g, S, E); }
            VM_WAIT(); __syncthreads();
            cross_unit(pa, lds, pm, tid, lane, wave);
            { int kdyn = 256; asm volatile("" : "+s"(kdyn));
              pg8::Gemm g{(const pg8::bf16_t*)(ws + WS_OX), (const pg8::bf16_t*)(ws + WS_WOX), T, D, kdyn};
              FixedOrder S{pm, 4}; EpiOx E{(const bf16*)(ws + WS_X1B), (bf16*)(ws + WS_HBS)};
              pg8::gemm_phase<EpiOx, FixedOrder, false, false>(ring, g, S, E); }
            VM_WAIT(); __builtin_amdgcn_fence(__ATOMIC_ACQUIRE, "agent"); VM_WAIT(); __syncthreads();
        }
        if (MS >= 4) p9_route(pa, lds, tid, lane, wave);
    }
    SEAM(9);
    if (IN(10) && MS >= 4) { PHASE_PTRS; p10_slots(pa, lds, tid, lane, wave); }
    SEAM(10);
    if ((IN(11) || IN(12)) && MS >= 4) { PHASE_PTRS;
        int* tab = (int*)(lds + LDS_TAB);
        if (tid == 0) { int nrt = 0; const unsigned* cnt = (const unsigned*)(ws + WS_CTL) + CW_CNT;
            for (int i = 0; i < NBUCKET; ++i) { const int nt = (int)((__hip_atomic_load(cnt + i, __ATOMIC_RELAXED, __HIP_MEMORY_SCOPE_AGENT) + 255u) >> 8); for (int k = 0; k < nt; ++k) tab[1 + nrt++] = i; }
            tab[0] = nrt; }
        __syncthreads();
        const int nrt = tab[0];
        if (IN(11)) {
            if (STAGGER && ((blockIdx.x >> 2) & 1)) { for (int i = 0; i < STAGGER; ++i) __builtin_amdgcn_s_sleep(127); }
            pg8::Gemm g{(const pg8::bf16_t*)(ws + WS_HBS), (const pg8::bf16_t*)(ws + WS_W13), ROWS_MAX, 64 * 256, D, (const int*)(ws + WS_TOKMAP)};
            MoeOrder S{G, (int)blockIdx.x, nrt * 8, 8, tab + 1};
            EpiUp E{(bf16*)(ws + WS_ACT), (const float*)(ws + WS_WSORT)};
            REP(11) pg8::gemm_phase<EpiUp, MoeOrder, true, true, true>(ring, g, S, E);
        }
        SEAM(11);
        if (IN(12)) {
            pg8::Gemm g{(const pg8::bf16_t*)(ws + WS_ACT), (const pg8::bf16_t*)(ws + WS_W2P), ROWS_MAX, 96 * 256, D};
            MoeOrder S{G, (int)blockIdx.x, nrt * 4, 4, tab + 1};
#if FUSE_FINAL
            EpiDownNorm E{(const bf16*)(ws + WS_HBS), pa.out, (const int*)(ws + WS_TOKMAP), (const float*)(ws + WS_PAR) + PAR_GFIN, (float*)(ws + WS_XCH), (unsigned*)(ws + WS_CTL) + CW_SEAM, (LAS unsigned char*)(lds + LDS_EX)};
            pg8::gemm_phase<EpiDownNorm, MoeOrder, true, true>(ring, g, S, E);
#else
            EpiDown E{(const bf16*)(ws + WS_HBS), pa.out, (const int*)(ws + WS_TOKMAP)};
            REP(12) pg8::gemm_phase<EpiDown, MoeOrder, true, true>(ring, g, S, E);
#endif
        }
    }
    if (!FUSE_FINAL) SEAM(12);
    if (IN(13) && !FUSE_FINAL) { PHASE_PTRS; REP(13) p10_final(pa, (((DUP_MASK >> 13) & 1) && rep_ == 0) ? (float*)(ws + 544 * MiB) : pa.out, lane, wave); }
#ifdef DUMMY_LIVE
    asm volatile("" :: "v"(dl0), "v"(dl1), "v"(dl2), "v"(dl3), "v"(dl4), "v"(dl5), "v"(dl6), "v"(dl7));
#endif
#undef IN
#undef SEAM
}

extern "C" void kernel_launch(void* const* d_in, const int* in_sizes, int n_in, void* d_out, int out_size, void* d_ws, size_t ws_size, hipStream_t stream) {
    static int grid = 0;
    if (grid == 0) {
        if (n_in != 28 || out_size != T * D || ws_size < WS_END) { fprintf(stderr, "kernel_launch: unexpected problem (n_in %d, out %d, ws %zu)\n", n_in, out_size, ws_size); grid = -1; return; }
        int dev = 0, cus = 0, per_cu = 0;
        if (hipGetDevice(&dev) != hipSuccess || hipDeviceGetAttribute(&cus, hipDeviceAttributeMultiprocessorCount, dev) != hipSuccess) { grid = -1; return; }
        if (hipOccupancyMaxActiveBlocksPerMultiprocessor(&per_cu, (const void*)fwd_kernel, NTHR, 0) != hipSuccess || per_cu < 1) { fprintf(stderr, "kernel_launch: occupancy query failed (%d)\n", per_cu); per_cu = 1; }
        (void)hipGetLastError();
        grid = cus * (per_cu > 1 ? 1 : per_cu);
        if (grid > 256) grid = 256;
    }
    if (grid < 0) return;
    (void)hipMemsetAsync((char*)d_ws + WS_CTL, 0, CTL_ZERO_BYTES, stream);
    Args a{};
    for (int i = 0; i < 28; ++i) a.in[i] = d_in[i];
    a.out = (float*)d_out; a.ws = (unsigned char*)d_ws;
    if (N_LAUNCHES == 1) {
        a.ph_lo = 0; a.ph_hi = N_PHASES;
        void* kargs[] = {&a};
        hipError_t e = hipLaunchCooperativeKernel((const void*)fwd_kernel, dim3(grid), dim3(NTHR), kargs, 0, stream);
        if (e != hipSuccess) fprintf(stderr, "kernel_launch: cooperative launch failed: %s (grid %d)\n", hipGetErrorString(e), grid);
    } else {
        for (int p = 0; p < N_PHASES; ++p) { a.ph_lo = p; a.ph_hi = p + 1; hipLaunchKernelGGL(fwd_kernel, dim3(grid), dim3(NTHR), 0, stream, a); }
    }
}
```

```cpp
#include <hip/hip_runtime.h>
#include <cstdio>
#include <cstdint>
__device__ __forceinline__ int lane_id_() { int l; asm volatile("v_mbcnt_lo_u32_b32 %0, -1, 0\n\tv_mbcnt_hi_u32_b32 %0, -1, %0" : "=v"(l)); return l; }
namespace pg8 {
#define PG8_LAS __attribute__((address_space(3)))
typedef unsigned short bf16_t;
typedef short bf16x8 __attribute__((ext_vector_type(8)));
typedef float f32x4 __attribute__((ext_vector_type(4)));
typedef unsigned u32x4 __attribute__((ext_vector_type(4)));
constexpr int BM = 256, BK = 64, HALF = 128, HTB = HALF * BK * 2  , STAGE_BYTES = 8 * HTB, NXCD = 8, WGM = 8;

__host__ __device__ __forceinline__ int lds_byte(int r, int c) { const int st = (r >> 4) * 2 + (c >> 5), rr = r & 15, cc = c & 31, ob = rr * 64 + cc * 2; return st * 1024 + (ob ^ (((ob >> 9) & 1) << 5)); }
__host__ __device__ __forceinline__ void stage_rc(int b, int& R, int& C) { const int st = b / 1024, sb = b % 1024, swz = sb ^ (((sb >> 9) & 1) << 5); R = (st >> 1) * 16 + swz / 64; C = (st & 1) * 32 + (swz % 64) / 2; }
__host__ __device__ __forceinline__ int perm32(int rho) { const int n = rho >> 4, i = rho & 15; return 8 * (i >> 2) + 4 * n + (i & 3); }

struct Unit { int pm, pn, aux; };
struct Gemm { const bf16_t* A; const bf16_t* Bt; int M, N, K; const int* rowmap; };

struct StaticOrder {
    int nM, nN, nwg, G, c;
    __host__ __device__ __forceinline__ void init(int M, int N, int G_, int c_) { nM = M / BM; nN = N / BM; nwg = nM * nN; G = G_; c = c_; }
    __host__ __device__ __forceinline__ bool next(int i, Unit& u) const {
        const long L = (long)i * G + c; if (L >= nwg) return false;
        int wgid = (int)L; { const int q = nwg / NXCD, r = nwg % NXCD, xcd = wgid % NXCD, off = wgid / NXCD; wgid = (xcd < r ? xcd * (q + 1) : r * (q + 1) + (xcd - r) * q) + off; }
        const int nig = WGM * nN, gid = wgid / nig, fm = gid * WGM, gsz = (nM - fm) < WGM ? (nM - fm) : WGM;
        u.pm = fm + ((wgid % nig) % gsz); u.pn = (wgid % nig) / gsz; u.aux = 0; return true;
    }
    __device__ __forceinline__ void a_ready(const Unit&) const {}
    __device__ __forceinline__ void done(const Unit&) const {}
};

__device__ __forceinline__ unsigned cvt_pk_bf16(float lo, float hi) { unsigned r; asm volatile("v_cvt_pk_bf16_f32 %0, %1, %2" : "=v"(r) : "v"(lo), "v"(hi)); return r; }
__device__ __forceinline__ void glds16s(const void* sbase, unsigned voff, unsigned lds_dst) { unsigned keep;
    asm volatile("s_mov_b32 %0, m0\n\ts_mov_b32 m0, %3\n\ts_nop 0\n\tglobal_load_lds_dwordx4 %1, %2\n\ts_mov_b32 m0, %0" : "=&s"(keep) : "v"(voff), "s"(sbase), "s"(lds_dst) : "memory"); }
typedef int v8i_t __attribute__((ext_vector_type(8))); typedef int v4i_t __attribute__((ext_vector_type(4)));
typedef float f32x16_t __attribute__((ext_vector_type(16)));
template <int Q> __device__ __forceinline__ f32x4 ex4(const f32x16_t& v) { return __builtin_shufflevector(v, v, 4 * Q, 4 * Q + 1, 4 * Q + 2, 4 * Q + 3); }
template <int Q> __device__ __forceinline__ void in4(f32x16_t& v, const f32x4 c) {
    const f32x16_t w = __builtin_shufflevector(c, c, 0, 1, 2, 3, 0, 1, 2, 3, 0, 1, 2, 3, 0, 1, 2, 3);
    v = __builtin_shufflevector(v, w, Q == 0 ? 16 : 0, Q == 0 ? 17 : 1, Q == 0 ? 18 : 2, Q == 0 ? 19 : 3, Q == 1 ? 20 : 4, Q == 1 ? 21 : 5, Q == 1 ? 22 : 6, Q == 1 ? 23 : 7,
                                Q == 2 ? 24 : 8, Q == 2 ? 25 : 9, Q == 2 ? 26 : 10, Q == 2 ? 27 : 11, Q == 3 ? 28 : 12, Q == 3 ? 29 : 13, Q == 3 ? 30 : 14, Q == 3 ? 31 : 15); }
template <bool F8> struct Frags { bf16x8 a[4][2], b0[2][2], b1[2][2]; };
template <> struct Frags<true> { v8i_t a[4], b0[2], b1[2]; };
template <class Epi, class Sched, bool ALIGN_EPI = false, bool SP2 = false, bool GATHER = false, int PREC = 0>
__device__ __forceinline__ void gemm_phase(PG8_LAS unsigned char* lds, const Gemm g, const Sched& S, const Epi& E, const int wv) {
    constexpr bool FP8 = PREC == 1, I8 = PREC == 2, BYTEK = PREC != 0;
    int tid = wv * 64 + lane_id_(); asm volatile("" : "+v"(tid));
    const int wid = __builtin_amdgcn_readfirstlane(tid >> 6), lane = tid & 63, wr = wid >> 2, wc = wid & 3, fr = lane & 15, fq = lane >> 4;
    const int K = BYTEK ? g.K / 2 : g.K; int nt = g.K / (BYTEK ? 128 : BK);
    if constexpr (BYTEK) asm volatile("" : "+s"(nt));
    unsigned voffA[2], voffB[2];
#pragma unroll
    for (int i = 0; i < 2; ++i) { int R, C; stage_rc(tid * 16 + i * 8192, R, C); const int Rb = Epi::PERM ? ((R & ~31) + perm32(R & 31)) : R;
        voffA[i] = (unsigned)(R * K + C) * 2u; voffB[i] = (unsigned)(Rb * K + C) * 2u; }
    unsigned gc[2][2] = {{0u, 0u}, {0u, 0u}}, gn[2][2] = {{0u, 0u}, {0u, 0u}};
#define PG8_GLOAD(gv, pm_) do { _Pragma("unroll") for (int _h = 0; _h < 2; ++_h) _Pragma("unroll") for (int _i = 0; _i < 2; ++_i) { int _R, _C; stage_rc(tid * 16 + _i * 8192, _R, _C); \
        int _row = g.rowmap[(pm_) * BM + _h * HALF + _R]; _row = _row < 0 ? 0 : _row; gv[_h][_i] = (unsigned)(_row * K + _C) * 2u; } } while (0)
    const size_t kstep = (size_t)(BK * 2);
    const size_t hstep = (size_t)HALF * K * 2;
    const size_t tstep = 2 * hstep;
    const unsigned ldsw = (unsigned)wid * 1024u;
    const int aoff = lds_byte(wr * 64 + fr, fq * 8); int boff = lds_byte(wc * 32 + fr, fq * 8) + 4 * HTB;
    asm volatile("" : "+v"(boff));
#define PG8_SA(b, h) (((b) * 2 + (h)) * HTB)
#define PG8_SB(b, h) ((4 + (b) * 2 + (h)) * HTB)
#define PG8_SBR(b, h) (((b) * 2 + (h)) * HTB)
#define PG8_STAGE(bufoff, gbase, voff) do { _Pragma("unroll") for (int _i = 0; _i < 2; ++_i) \
        glds16s((const char*)(gbase), (voff)[_i], (unsigned)(uintptr_t)(lds + (bufoff) + ldsw + _i * 8192)); } while (0)
#define PG8_STAGE_A(bufoff, gbase, h, sel) do { if constexpr (GATHER) { unsigned vo_[2]; vo_[0] = (sel) ? gn[h][0] : gc[h][0]; vo_[1] = (sel) ? gn[h][1] : gc[h][1]; PG8_STAGE(bufoff, gbase, vo_); } \
        else { PG8_STAGE(bufoff, (gbase) + (h) * hstep, voffA); } } while (0)
#define PG8_RD16(off) (*(const PG8_LAS v4i_t*)(lds + (off)))
#define PG8_LDA(dst, b, h) do { if constexpr (FP8) { _Pragma("unroll") for (int m = 0; m < 4; ++m) { const v4i_t p0_ = PG8_RD16(PG8_SA(b, h) + aoff + m * 2048), p1_ = PG8_RD16(PG8_SA(b, h) + aoff + m * 2048 + 1024); \
            dst[m] = (v8i_t){p0_[0], p0_[1], p0_[2], p0_[3], p1_[0], p1_[1], p1_[2], p1_[3]}; } } \
        else { _Pragma("unroll") for (int m = 0; m < 4; ++m) _Pragma("unroll") for (int k = 0; k < 2; ++k) dst[m][k] = *(const PG8_LAS bf16x8*)(lds + PG8_SA(b, h) + aoff + m * 2048 + k * 1024); } } while (0)
#define PG8_LDB(dst, b, h) do { if constexpr (FP8) { _Pragma("unroll") for (int n = 0; n < 2; ++n) { const v4i_t p0_ = PG8_RD16(PG8_SBR(b, h) + boff + n * 2048), p1_ = PG8_RD16(PG8_SBR(b, h) + boff + n * 2048 + 1024); \
            dst[n] = (v8i_t){p0_[0], p0_[1], p0_[2], p0_[3], p1_[0], p1_[1], p1_[2], p1_[3]}; } } \
        else { _Pragma("unroll") for (int n = 0; n < 2; ++n) _Pragma("unroll") for (int k = 0; k < 2; ++k) dst[n][k] = *(const PG8_LAS bf16x8*)(lds + PG8_SBR(b, h) + boff + n * 2048 + k * 1024); } } while (0)
#define PG8_MM8(ai, bj, At, Bt, m, n) do { f32x4 c_ = ex4<((m) & 1) * 2 + (n)>(accw[ai][bj][(m) >> 1]); \
        c_ = __builtin_amdgcn_mfma_scale_f32_16x16x128_f8f6f4(Bt[n], At[m], c_, 0, 0, 0, 0x7f7f7f7f, 0, 0x7f7f7f7f); in4<((m) & 1) * 2 + (n)>(accw[ai][bj][(m) >> 1], c_); } while (0)
#define PG8_MMA(ai, bj, At, Bt) do { __builtin_amdgcn_s_setprio(1); \
        if constexpr (FP8) { PG8_MM8(ai, bj, At, Bt, 0, 0); PG8_MM8(ai, bj, At, Bt, 0, 1); PG8_MM8(ai, bj, At, Bt, 1, 0); PG8_MM8(ai, bj, At, Bt, 1, 1); \
                             PG8_MM8(ai, bj, At, Bt, 2, 0); PG8_MM8(ai, bj, At, Bt, 2, 1); PG8_MM8(ai, bj, At, Bt, 3, 0); PG8_MM8(ai, bj, At, Bt, 3, 1); } \
        else if constexpr (I8) { _Pragma("unroll") for (int m = 0; m < 4; ++m) _Pragma("unroll") for (int n = 0; n < 2; ++n) _Pragma("unroll") for (int k = 0; k < 2; ++k) \
            acc[ai][bj][m][n] = __builtin_bit_cast(f32x4, __builtin_amdgcn_mfma_i32_16x16x64_i8(__builtin_bit_cast(v4i_t, Bt[n][k]), __builtin_bit_cast(v4i_t, At[m][k]), __builtin_bit_cast(v4i_t, acc[ai][bj][m][n]), 0, 0, 0)); } \
        else { _Pragma("unroll") for (int m = 0; m < 4; ++m) _Pragma("unroll") for (int n = 0; n < 2; ++n) _Pragma("unroll") for (int k = 0; k < 2; ++k) \
            acc[ai][bj][m][n] = __builtin_amdgcn_mfma_f32_16x16x32_bf16(Bt[n][k], At[m][k], acc[ai][bj][m][n], 0, 0, 0); } \
        __builtin_amdgcn_s_setprio(0); } while (0)
#define PG8_WAIT_V(n) asm volatile("s_waitcnt vmcnt(" #n ")" ::: "memory")
#define PG8_WAIT_L(n) asm volatile("s_waitcnt lgkmcnt(" #n ")" ::: "memory")
#define PG8_BAR __builtin_amdgcn_s_barrier()
#define PG8_SCHED __builtin_amdgcn_sched_barrier(0)
    Unit cur, nxt; int ui = 0;
    if (!S.next(0, cur)) return;
    f32x4 acc[2][2][4][2];
#pragma unroll
    for (int a = 0; a < 2; ++a)
#pragma unroll
        for (int b = 0; b < 2; ++b)
#pragma unroll
            for (int m = 0; m < 4; ++m)
#pragma unroll
                for (int n = 0; n < 2; ++n) acc[a][b][m][n] = (f32x4){0.f, 0.f, 0.f, 0.f};
    Frags<FP8> fr_; auto& At = fr_.a; auto& B0 = fr_.b0; auto& B1 = fr_.b1;
    f32x16_t accw[2][2][2];
#define PG8_ZW do { _Pragma("unroll") for (int a = 0; a < 2; ++a) _Pragma("unroll") for (int b = 0; b < 2; ++b) _Pragma("unroll") for (int q = 0; q < 2; ++q) \
        accw[a][b][q] = (f32x16_t){0.f, 0.f, 0.f, 0.f, 0.f, 0.f, 0.f, 0.f, 0.f, 0.f, 0.f, 0.f, 0.f, 0.f, 0.f, 0.f}; } while (0)
#define PG8_UNW do { _Pragma("unroll") for (int a = 0; a < 2; ++a) _Pragma("unroll") for (int b = 0; b < 2; ++b) { \
        acc[a][b][0][0] = ex4<0>(accw[a][b][0]); acc[a][b][0][1] = ex4<1>(accw[a][b][0]); acc[a][b][1][0] = ex4<2>(accw[a][b][0]); acc[a][b][1][1] = ex4<3>(accw[a][b][0]); \
        acc[a][b][2][0] = ex4<0>(accw[a][b][1]); acc[a][b][2][1] = ex4<1>(accw[a][b][1]); acc[a][b][3][0] = ex4<2>(accw[a][b][1]); acc[a][b][3][1] = ex4<3>(accw[a][b][1]); } } while (0)
    if constexpr (FP8) PG8_ZW;
    const char* cA = GATHER ? (const char*)g.A : (const char*)g.A + (size_t)cur.pm * tstep; const char* cB = (const char*)g.Bt + (size_t)cur.pn * tstep;
    if constexpr (GATHER) { PG8_GLOAD(gc, cur.pm); }
    S.a_ready(cur);
    if constexpr (SP2) {
        PG8_STAGE(PG8_SB(0, 0), cB, voffB); PG8_STAGE(PG8_SB(0, 1), cB + hstep, voffB); PG8_STAGE_A(PG8_SA(0, 0), cA, 0, false); PG8_STAGE_A(PG8_SA(0, 1), cA, 1, false);
        if (wr == 1) PG8_BAR;
        PG8_WAIT_V(2); PG8_BAR;
        PG8_STAGE(PG8_SB(1, 0), cB + kstep, voffB); PG8_STAGE_A(PG8_SA(1, 0), cA + kstep, 0, false); PG8_STAGE(PG8_SB(1, 1), cB + hstep + kstep, voffB);
        PG8_WAIT_V(6); PG8_BAR;
    } else {
        PG8_STAGE(PG8_SB(0, 0), cB, voffB); PG8_STAGE_A(PG8_SA(0, 0), cA, 0, false); PG8_STAGE(PG8_SB(0, 1), cB + hstep, voffB); PG8_STAGE_A(PG8_SA(0, 1), cA, 1, false);
        if (wr == 1) PG8_BAR;
        PG8_WAIT_V(4); PG8_BAR;
        PG8_STAGE(PG8_SB(1, 0), cB + kstep, voffB); PG8_STAGE_A(PG8_SA(1, 0), cA + kstep, 0, false); PG8_STAGE(PG8_SB(1, 1), cB + hstep + kstep, voffB);
        PG8_WAIT_V(6); PG8_BAR;
    }
    for (;;) {
        const bool has_next = S.next(ui + 1, nxt);
        const char* nA = GATHER ? cA : (has_next ? (const char*)g.A + (size_t)nxt.pm * tstep : cA);
        if constexpr (GATHER) { if (has_next) { PG8_GLOAD(gn, nxt.pm); } else { gn[0][0] = gc[0][0]; gn[0][1] = gc[0][1]; gn[1][0] = gc[1][0]; gn[1][1] = gc[1][1]; } }
        const char* nB = has_next ? (const char*)g.Bt + (size_t)nxt.pn * tstep : cB;
        for (int t = 0; t < nt; t += 2) {
            const bool last = (t == nt - 2);
            const char* a1 = cA + (size_t)(t + 1) * kstep;
            const char* a2 = last ? nA : cA + (size_t)(t + 2) * kstep; const char* b2 = last ? nB : cB + (size_t)(t + 2) * kstep;
            const char* a3 = a2 + kstep; const char* b3 = b2 + kstep;
            if (last && has_next) S.a_ready(nxt);
            if constexpr (SP2) {
            PG8_LDB(B0, 0, 0); PG8_LDB(B1, 0, 1); PG8_SCHED; PG8_LDA(At, 0, 0); PG8_STAGE_A(PG8_SA(1, 1), a1, 1, false);
            PG8_WAIT_V(8); PG8_WAIT_L(0); PG8_BAR; PG8_MMA(0, 0, At, B0); PG8_MMA(0, 1, At, B1); PG8_BAR; PG8_SCHED;
            PG8_LDA(At, 0, 1); PG8_STAGE(PG8_SB(0, 0), b2, voffB); PG8_STAGE(PG8_SB(0, 1), b2 + hstep, voffB); PG8_STAGE_A(PG8_SA(0, 0), a2, 0, last);
            PG8_WAIT_V(8); PG8_WAIT_L(0); PG8_BAR; PG8_MMA(1, 0, At, B0); PG8_MMA(1, 1, At, B1); PG8_BAR; PG8_SCHED;
            PG8_LDB(B0, 1, 0); PG8_LDB(B1, 1, 1); PG8_SCHED; PG8_LDA(At, 1, 0); PG8_STAGE_A(PG8_SA(0, 1), a2, 1, last);
            PG8_WAIT_V(8); PG8_WAIT_L(0); PG8_BAR; PG8_MMA(0, 0, At, B0); PG8_MMA(0, 1, At, B1); PG8_BAR; PG8_SCHED;
            PG8_LDA(At, 1, 1); PG8_STAGE(PG8_SB(1, 0), b3, voffB); PG8_STAGE(PG8_SB(1, 1), b3 + hstep, voffB); PG8_STAGE_A(PG8_SA(1, 0), a3, 0, last);
            PG8_WAIT_V(8); PG8_WAIT_L(0); PG8_BAR; PG8_MMA(1, 0, At, B0); PG8_MMA(1, 1, At, B1); PG8_BAR; PG8_SCHED;
            } else {
            PG8_LDB(B0, 0, 0); PG8_SCHED; PG8_LDA(At, 0, 0); PG8_STAGE_A(PG8_SA(1, 1), a1, 1, false);
            PG8_WAIT_L(8); PG8_BAR; PG8_WAIT_L(0); PG8_MMA(0, 0, At, B0); PG8_BAR; PG8_SCHED;
            PG8_LDB(B1, 0, 1); PG8_STAGE(PG8_SB(0, 0), b2, voffB);
            PG8_BAR; PG8_WAIT_L(0); PG8_MMA(0, 1, At, B1); PG8_BAR;
            PG8_LDA(At, 0, 1); PG8_STAGE_A(PG8_SA(0, 0), a2, 0, last);
            PG8_BAR; PG8_WAIT_L(0); PG8_MMA(1, 0, At, B0); PG8_BAR; PG8_SCHED;
            PG8_STAGE(PG8_SB(0, 1), b2 + hstep, voffB);
            PG8_WAIT_V(6); PG8_BAR; PG8_MMA(1, 1, At, B1); PG8_BAR;
            PG8_LDB(B0, 1, 0); PG8_SCHED; PG8_LDA(At, 1, 0); PG8_STAGE_A(PG8_SA(0, 1), a2, 1, last);
            PG8_WAIT_L(8); PG8_BAR; PG8_WAIT_L(0); PG8_MMA(0, 0, At, B0); PG8_BAR; PG8_SCHED;
            PG8_LDB(B1, 1, 1); PG8_STAGE(PG8_SB(1, 0), b3, voffB);
            PG8_BAR; PG8_WAIT_L(0); PG8_MMA(0, 1, At, B1); PG8_BAR;
            PG8_LDA(At, 1, 1); PG8_STAGE_A(PG8_SA(1, 0), a3, 0, last);
            PG8_BAR; PG8_WAIT_L(0); PG8_MMA(1, 0, At, B0); PG8_BAR; PG8_SCHED;
            PG8_STAGE(PG8_SB(1, 1), b3 + hstep, voffB);
            PG8_WAIT_V(6); PG8_BAR; PG8_MMA(1, 1, At, B1); PG8_BAR;
            }
        }
        if constexpr (ALIGN_EPI) { if (wr == 0) PG8_BAR; }
        if constexpr (FP8) PG8_UNW;
        if constexpr (!Epi::AFTER_DRAIN) { E(acc, cur, wr, wc, fr, fq); S.done(cur); }
        if (!has_next) break;
#pragma unroll
        for (int a = 0; a < 2; ++a)
#pragma unroll
            for (int b = 0; b < 2; ++b)
#pragma unroll
                for (int m = 0; m < 4; ++m)
#pragma unroll
                    for (int n = 0; n < 2; ++n) acc[a][b][m][n] = (f32x4){0.f, 0.f, 0.f, 0.f};
        if constexpr (FP8) PG8_ZW;
        cur = nxt; cA = nA; cB = nB; ++ui;
        if constexpr (GATHER) { gc[0][0] = gn[0][0]; gc[0][1] = gn[0][1]; gc[1][0] = gn[1][0]; gc[1][1] = gn[1][1]; }
        if constexpr (ALIGN_EPI) { if (wr == 1) PG8_BAR; }
    }
    PG8_WAIT_V(0);
    if constexpr (!ALIGN_EPI) { if (wr == 0) PG8_BAR; }
    PG8_BAR;
    if constexpr (Epi::AFTER_DRAIN) { E.fused(acc, cur, wr, wc, fr, fq, lds, wid, lane); S.done(cur); }
#undef PG8_SA
#undef PG8_SB
#undef PG8_SBR
#undef PG8_STAGE
#undef PG8_STAGE_A
#undef PG8_GLOAD
#undef PG8_LDA
#undef PG8_LDB
#undef PG8_MMA
#undef PG8_MM8
#undef PG8_ZW
#undef PG8_UNW
#undef PG8_RD16
#undef PG8_WAIT_V
#undef PG8_WAIT_L
#undef PG8_BAR
#undef PG8_SCHED
}
}


#define GAS __attribute__((address_space(1)))
#define LAS __attribute__((address_space(3)))
typedef unsigned short bf16;
typedef unsigned v4u __attribute__((ext_vector_type(4)));
typedef unsigned v2u __attribute__((ext_vector_type(2)));
typedef float f32x4 __attribute__((ext_vector_type(4)));
typedef short bf16x8 __attribute__((ext_vector_type(8)));
typedef GAS unsigned gu32;

constexpr int NWAVES = 8, NTHR = 512;
constexpr int BATCH = 8, SEQ = 8192, T = BATCH * SEQ, D = 1024, MEMLEN = 256, TMEM = BATCH * MEMLEN;
constexpr int INW = 3080, NIN = 3072, NKV = 512;
constexpr int NBUCKET = 24, ROWS_MAX = T + NBUCKET * 256;
constexpr float EPSN = 1e-6f;
constexpr float C2 = 0.125f * 1.4426950408889634f;
constexpr float LOG2E = 1.4426950408889634f;

constexpr size_t MiB = 1u << 20;
constexpr size_t WS_CTL = 0, CTL_ZERO_BYTES = 1 * MiB;
constexpr size_t WS_ROPE = 2 * MiB;
constexpr size_t WS_IG = 6 * MiB;
constexpr size_t WS_FG = 7 * MiB;
constexpr size_t WS_LSE = 8 * MiB;
constexpr size_t WS_SS1 = 14 * MiB;
constexpr size_t WS_SS3 = 18 * MiB;
constexpr size_t WS_RINV = 21 * MiB + 768 * 1024;
constexpr size_t WS_KVX = 22 * MiB;
constexpr size_t WS_NLOC = 24 * MiB;
constexpr size_t WS_NPREV = 25 * MiB;
constexpr size_t WS_MLOC = 26 * MiB;
constexpr size_t WS_BLAST = 26 * MiB + 64 * 1024;
constexpr size_t WS_MPREV = 26 * MiB + 128 * 1024;
constexpr size_t WS_TOKINFO = 27 * MiB;
constexpr size_t WS_TOKMAP = 28 * MiB;
constexpr size_t WS_WSORT = 19 * MiB;
constexpr size_t WS_WR = 30 * MiB;
constexpr size_t WS_WG = 30 * MiB + 512 * 1024;
constexpr size_t WS_PAR = 31 * MiB;
constexpr int PAR_CONVW = 0, PAR_CONVB = 2048, PAR_GMHN = 2560, PAR_SKIP = 3072, PAR_BRG = 3584, PAR_BRE = 3600, PAR_GFIN = 3616, PAR_N = 4640;
constexpr size_t WS_WIN = 32 * MiB;
constexpr size_t WS_WOUT = 39 * MiB;
constexpr size_t WS_WQX = 41 * MiB;
constexpr size_t WS_WOX = 41 * MiB + 512 * 1024;
constexpr size_t WS_WM = 42 * MiB;
constexpr size_t WS_W13 = 44 * MiB;
constexpr size_t WS_W2P = 76 * MiB;
constexpr size_t WS_XN = 128 * MiB;
constexpr size_t WS_CLOC = 128 * MiB;
constexpr size_t WS_GAGG = 776 * MiB;
constexpr size_t WS_GN = 784 * MiB;
constexpr size_t WS_GSC = 784 * MiB + 512 * 1024;
constexpr size_t WS_Q = 264 * MiB;
constexpr size_t WS_K = 328 * MiB, WS_V = 392 * MiB, WS_MU = 456 * MiB, WS_MV = 520 * MiB, WS_MO = 584 * MiB;
constexpr size_t WS_MQ = 648 * MiB, WS_MK = 712 * MiB;
constexpr size_t WS_Y = 264 * MiB;
constexpr size_t WS_CPREV = 392 * MiB;
constexpr size_t WS_X1B = 648 * MiB;
constexpr size_t WS_QX = 776 * MiB;
constexpr size_t WS_OX = 808 * MiB;
constexpr size_t WS_HBS = 264 * MiB;
constexpr size_t WS_ACT = 404 * MiB;
constexpr size_t WS_X8 = 648 * MiB;
constexpr size_t WS_WIN8 = 44 * MiB;
constexpr size_t WS_RS8 = 48 * MiB;
constexpr int CW_CMAX = 65536, CW_CMDONE = 65536 + 4096;
constexpr size_t WS_X2Q = 544 * MiB;
constexpr size_t WS_W13Q = 840 * MiB;
constexpr size_t WS_END = 856 * MiB;
constexpr size_t DO_OATT = 0, DO_C = 192 * MiB;

constexpr int CW_BAR = 4096;
constexpr int CW_CNT = 8192;
constexpr int CW_FILL = 8192 + 64;

constexpr int LDS_BYTES = 163840;
constexpr int LDS_MISC = 159744;
constexpr int LDS_RS = 135168;
constexpr int LDS_TAB = 136192;

#define LDS_WAIT() asm volatile("s_waitcnt lgkmcnt(0)" ::: "memory")
#define VM_WAIT() asm volatile("s_waitcnt vmcnt(0)" ::: "memory")
__device__ __forceinline__ unsigned f2bf(float f) { unsigned u = __builtin_bit_cast(unsigned, f); return (u + 0x7fffu + ((u >> 16) & 1u)) >> 16; }
typedef float f32x2_t __attribute__((ext_vector_type(2))); typedef __bf16 bf16x2_t __attribute__((ext_vector_type(2)));
__device__ __forceinline__ unsigned pk2(float lo, float hi) { f32x2_t v = {lo, hi}; bf16x2_t b = __builtin_convertvector(v, bf16x2_t); return __builtin_bit_cast(unsigned, b); }
__device__ __forceinline__ unsigned pk4_i8(float a, float b, float c, float d, float s) {
    const unsigned ua = __float_as_uint(fmaf(a, s, 12582912.0f)), ub = __float_as_uint(fmaf(b, s, 12582912.0f)), uc = __float_as_uint(fmaf(c, s, 12582912.0f)), ud = __float_as_uint(fmaf(d, s, 12582912.0f));
    return __builtin_amdgcn_perm(__builtin_amdgcn_perm(ud, uc, 0x0c0c0400u), __builtin_amdgcn_perm(ub, ua, 0x0c0c0400u), 0x05040100u); }
__device__ __forceinline__ unsigned pk4_fp8(float a, float b, float c, float d) { int v = __builtin_amdgcn_cvt_pk_fp8_f32(a, b, 0, false); v = __builtin_amdgcn_cvt_pk_fp8_f32(c, d, v, true); return (unsigned)v; }
__device__ __forceinline__ float bf2f(unsigned h) { return __uint_as_float(h << 16); }
__device__ __forceinline__ float bflo(unsigned w) { return __uint_as_float(w << 16); }
__device__ __forceinline__ float bfhi(unsigned w) { return __uint_as_float(w & 0xffff0000u); }
__device__ __forceinline__ float wave_sum(float v) {
#pragma unroll
    for (int o = 1; o < 64; o <<= 1) v += __shfl_xor(v, o);
    return v;
}
__device__ __forceinline__ float wave_max(float v) {
#pragma unroll
    for (int o = 1; o < 64; o <<= 1) v = fmaxf(v, __shfl_xor(v, o));
    return v;
}
__device__ __forceinline__ float fexp_(float x) { return __builtin_amdgcn_exp2f(x * 1.4426950408889634f); }
__device__ __forceinline__ float frcp_(float x) { return __builtin_amdgcn_rcpf(x); }
__device__ __forceinline__ float sigmoidf_(float x) { return __builtin_amdgcn_rcpf(1.0f + __builtin_amdgcn_exp2f(x * -1.4426950408889634f)); }

#define XB_TMO      128
#define XB_XCNT(j)  (256  + 64 * (j))
#define XB_XSUB(j)  (1280 + 64 * (j))
#define XB_XGEN(j)  (2304 + 64 * (j))
#define XB_TOP      3328
#define XB_TOPGEN   3392
#define XCD_BAR_WORDS 3456
#define XB_SPIN_CAP (1u << 22)
__device__ __forceinline__ unsigned xb_ld(unsigned* p)              { return __hip_atomic_load(p, __ATOMIC_RELAXED, __HIP_MEMORY_SCOPE_AGENT); }
__device__ __forceinline__ unsigned xb_add(unsigned* p, unsigned v) { return __hip_atomic_fetch_add(p, v, __ATOMIC_RELAXED, __HIP_MEMORY_SCOPE_AGENT); }
__device__ __forceinline__ unsigned xb_xcc_id() { return (unsigned)__builtin_amdgcn_s_getreg((3 << 11) | 20) & 0xFu; }
#define XB_SPIN(cond, bar) do { unsigned _sp = 0; while (cond) { __builtin_amdgcn_s_sleep(1); \
    if ((++_sp & 255u) == 0u) { if (xb_ld(&(bar)[XB_TMO])) break; if (_sp > XB_SPIN_CAP) { atomicAdd(&(bar)[XB_TMO], 1u); break; } } } } while (0)
struct XcdBarrier { unsigned* bar; unsigned x; volatile LAS unsigned* st; int wv; };
__device__ __forceinline__ XcdBarrier xcd_barrier_post(unsigned* bar, volatile LAS unsigned* st, int wv) {
    XcdBarrier b; b.bar = bar; b.x = xb_xcc_id(); b.st = st; b.wv = wv;
    if (wv == 0 && lane_id_() == 0) (void)xb_add(&bar[XB_XCNT(b.x)], 1u);
    return b;
}
__device__ __forceinline__ void xcd_barrier_complete(unsigned* bar, unsigned x, unsigned& nloc, unsigned& nx) {
    const unsigned G = gridDim.x * gridDim.y * gridDim.z;
    unsigned sum, cnt, mine, sp = 0u;
    for (;;) {
        sum = 0u; cnt = 0u; mine = 0u;
#pragma unroll
        for (unsigned j = 0; j < 16; ++j) { const unsigned c = xb_ld(&bar[XB_XCNT(j)]); sum += c; cnt += (c > 0u) ? 1u : 0u; mine = (j == x) ? c : mine; }
        if (sum == G) break;
        __builtin_amdgcn_s_sleep(1);
        if ((++sp & 255u) == 0u) { if (xb_ld(&bar[XB_TMO])) break; if (sp > XB_SPIN_CAP) { atomicAdd(&bar[XB_TMO], 1u); break; } }
    }
    nloc = mine > 0u ? mine : 1u; nx = cnt > 0u ? cnt : 1u;
}
__device__ __forceinline__ void xcd_barrier(const XcdBarrier& b) {
    asm volatile("s_waitcnt vmcnt(0)" ::: "memory");
    __syncthreads();
    if (b.wv == 0 && lane_id_() == 0) {
        unsigned* bar = b.bar;
        __builtin_amdgcn_s_waitcnt(0);
        unsigned nloc = b.st[0], nx = b.st[1];
        if (nloc == 0u) { xcd_barrier_complete(bar, b.x, nloc, nx); b.st[0] = nloc; b.st[1] = nx; }
        const unsigned old = xb_add(&bar[XB_XSUB(b.x)], 1u);
        const unsigned gen = old / nloc;
        if (old + 1u == (gen + 1u) * nloc) {
            __builtin_amdgcn_fence(__ATOMIC_RELEASE, "agent");
            asm volatile("s_waitcnt vmcnt(0)" ::: "memory");
            const unsigned og = xb_add(&bar[XB_TOP], 1u);
            const unsigned tg = og / nx;
            if (og + 1u == (tg + 1u) * nx) xb_add(&bar[XB_TOPGEN], 1u);
            else XB_SPIN(xb_ld(&bar[XB_TOPGEN]) == tg, bar);
            __builtin_amdgcn_fence(__ATOMIC_ACQUIRE, "agent");
            xb_add(&bar[XB_XGEN(b.x)], 1u);
            asm volatile("s_waitcnt vmcnt(0)" ::: "memory");
        } else {
            XB_SPIN(xb_ld(&bar[XB_XGEN(b.x)]) == gen, bar);
            __builtin_amdgcn_fence(__ATOMIC_ACQUIRE, "agent");
            asm volatile("s_waitcnt vmcnt(0)" ::: "memory");
        }
    }
    __syncthreads();
}

struct Args { const void* in[28]; float* out; unsigned char* ws; int ph_lo, ph_hi; };

template <int MI, int NJ>
__device__ __forceinline__ void wave_mma(const bf16* A, int lda, const bf16* Bt, int ldb, int K, f32x4 (&acc)[MI][NJ], int fr, int fq) {
    for (int k0 = 0; k0 < K; k0 += 32) {
        bf16x8 a[MI], b[NJ];
#pragma unroll
        for (int i = 0; i < MI; ++i) a[i] = *(const bf16x8*)(A + (16 * i + fr) * lda + k0 + 8 * fq);
#pragma unroll
        for (int j = 0; j < NJ; ++j) b[j] = *(const bf16x8*)(Bt + (16 * j + fr) * ldb + k0 + 8 * fq);
#pragma unroll
        for (int i = 0; i < MI; ++i)
#pragma unroll
            for (int j = 0; j < NJ; ++j) acc[i][j] = __builtin_amdgcn_mfma_f32_16x16x32_bf16(b[j], a[i], acc[i][j], 0, 0, 0);
    }
}

__device__ __forceinline__ void transpose_item(const float* src, int src_ld, int k0, int n0, bf16* dst, int dst_ld, int dst_row0, int dst_col0,
                                               const float* gain, float scale, LAS float* scr, int lane) {
    f32x4 ld[16];
#pragma unroll
    for (int i = 0; i < 16; ++i) { const int kk = 4 * i + (lane >> 4); ld[i] = *(const f32x4*)(src + (size_t)(k0 + kk) * src_ld + n0 + 4 * (lane & 15)); }
#pragma unroll
    for (int i = 0; i < 16; ++i) { const int kk = 4 * i + (lane >> 4); *(LAS f32x4*)(scr + kk * 64 + 4 * ((lane & 15) ^ ((kk >> 3) & 15))) = ld[i]; }
    const int c = lane & 7;
    f32x4 g0 = (f32x4){scale, scale, scale, scale}, g1 = g0;
    if (gain) { g0 = *(const f32x4*)(gain + k0 + 8 * c) * scale; g1 = *(const f32x4*)(gain + k0 + 8 * c + 4) * scale; }
    LDS_WAIT(); asm volatile("" ::: "memory");
#pragma unroll
    for (int j = 0; j < 8; ++j) { const int n = (lane >> 3) + 8 * j; const LAS float* s = scr + (8 * c) * 64 + 4 * ((n >> 2) ^ c) + (n & 3);
        v4u o; o.x = pk2(s[0 * 64] * g0[0], s[1 * 64] * g0[1]); o.y = pk2(s[2 * 64] * g0[2], s[3 * 64] * g0[3]); o.z = pk2(s[4 * 64] * g1[0], s[5 * 64] * g1[1]); o.w = pk2(s[6 * 64] * g1[2], s[7 * 64] * g1[3]);
        *(v4u*)(dst + (size_t)(dst_row0 + n) * dst_ld + dst_col0 + 8 * c) = o; }
    LDS_WAIT(); asm volatile("" ::: "memory");
}

__device__ __forceinline__ void transpose_item_q8(const float* src, int src_ld, int k0, int n0, unsigned char* dst, int dst_ld, int dst_row0, int dst_col0,
                                                  const float* gain, float scale, LAS float* scr, int lane) {
    f32x4 ld[16];
#pragma unroll
    for (int i = 0; i < 16; ++i) { const int kk = 4 * i + (lane >> 4); ld[i] = *(const f32x4*)(src + (size_t)(k0 + kk) * src_ld + n0 + 4 * (lane & 15)); }
#pragma unroll
    for (int i = 0; i < 16; ++i) { const int kk = 4 * i + (lane >> 4); *(LAS f32x4*)(scr + kk * 64 + 4 * ((lane & 15) ^ ((kk >> 3) & 15))) = ld[i]; }
    const int c = lane & 7;
    f32x4 g0 = (f32x4){scale, scale, scale, scale}, g1 = g0;
    if (gain) { g0 = *(const f32x4*)(gain + k0 + 8 * c) * scale; g1 = *(const f32x4*)(gain + k0 + 8 * c + 4) * scale; }
    LDS_WAIT(); asm volatile("" ::: "memory");
#pragma unroll
    for (int j = 0; j < 8; ++j) { const int n = (lane >> 3) + 8 * j; const LAS float* sp = scr + (8 * c) * 64 + 4 * ((n >> 2) ^ c) + (n & 3);
        v2u o; o.x = pk4_fp8(sp[0 * 64] * g0[0], sp[1 * 64] * g0[1], sp[2 * 64] * g0[2], sp[3 * 64] * g0[3]); o.y = pk4_fp8(sp[4 * 64] * g1[0], sp[5 * 64] * g1[1], sp[6 * 64] * g1[2], sp[7 * 64] * g1[3]);
        *(v2u*)(dst + (size_t)(dst_row0 + n) * dst_ld + dst_col0 + 8 * c) = o; }
    LDS_WAIT(); asm volatile("" ::: "memory");
}
__device__ __forceinline__ void transpose_item_i8(const float* src, int src_ld, int k0, int n0, unsigned char* dst, int dst_ld, int dst_row0, int dst_col0,
                                                  const float* gain, float scale, const unsigned* cmax, LAS float* scr, int lane) {
    f32x4 ld[16];
#pragma unroll
    for (int i = 0; i < 16; ++i) { const int kk = 4 * i + (lane >> 4); ld[i] = *(const f32x4*)(src + (size_t)(k0 + kk) * src_ld + n0 + 4 * (lane & 15)); }
#pragma unroll
    for (int i = 0; i < 16; ++i) { const int kk = 4 * i + (lane >> 4); *(LAS f32x4*)(scr + kk * 64 + 4 * ((lane & 15) ^ ((kk >> 3) & 15))) = ld[i]; }
    const int c = lane & 7;
    const f32x4 g0 = *(const f32x4*)(gain + k0 + 8 * c) * scale, g1 = *(const f32x4*)(gain + k0 + 8 * c + 4) * scale;
    LDS_WAIT(); asm volatile("" ::: "memory");
#pragma unroll
    for (int j = 0; j < 8; ++j) { const int n = (lane >> 3) + 8 * j; const LAS float* sp = scr + (8 * c) * 64 + 4 * ((n >> 2) ^ c) + (n & 3);
        const float cm = __uint_as_float(__hip_atomic_load(cmax + dst_row0 + n, __ATOMIC_RELAXED, __HIP_MEMORY_SCOPE_AGENT)); const float sc = cm > 0.f ? 127.0f / cm : 0.f;
        v2u o; o.x = pk4_i8(sp[0 * 64] * g0[0], sp[1 * 64] * g0[1], sp[2 * 64] * g0[2], sp[3 * 64] * g0[3], sc); o.y = pk4_i8(sp[4 * 64] * g1[0], sp[5 * 64] * g1[1], sp[6 * 64] * g1[2], sp[7 * 64] * g1[3], sc);
        *(v2u*)(dst + (size_t)(dst_row0 + n) * dst_ld + dst_col0 + 8 * c) = o; }
    LDS_WAIT(); asm volatile("" ::: "memory");
}
__device__ __forceinline__ void p0_prologue(const Args& A, unsigned char* lds, int tid, int lane, int wave) {
    unsigned char* ws = A.ws;
    const float* x = (const float*)A.in[0]; const float* mem = (const float*)A.in[1]; const int* positions = (const int*)A.in[2];
    const float* g_mix = (const float*)A.in[3]; const float* w_in = (const float*)A.in[4];
    const float* w_q_m = (const float*)A.in[7]; const float* w_k_m = (const float*)A.in[8];
    const float* b_i = (const float*)A.in[9]; const float* b_f = (const float*)A.in[10];
    const float* w_out = (const float*)A.in[13]; const float* g_cross = (const float*)A.in[14]; const float* g_mem = (const float*)A.in[15];
    const float* w_q_x = (const float*)A.in[16]; const float* w_kv_x = (const float*)A.in[17]; const float* w_o_x = (const float*)A.in[18];
    const float* g_ffn = (const float*)A.in[19]; const float* w_rg = (const float*)A.in[20]; const float* w_re = (const float*)A.in[22];
    const float* w1 = (const float*)A.in[24]; const float* w3 = (const float*)A.in[25]; const float* w2 = (const float*)A.in[26];
    const int G = gridDim.x, gw = blockIdx.x * NWAVES + wave, NGW = G * NWAVES, gt = blockIdx.x * NTHR + tid, NGT = G * NTHR;

    LAS float* WGl = (LAS float*)lds;
    for (int i = tid; i < 8 * 1024; i += NTHR) { const int k = i >> 3, j = i & 7; WGl[j * 1024 + k] = g_mix[k] * w_in[(size_t)k * INW + NIN + j]; }

    { unsigned* ctl = (unsigned*)(ws + WS_CTL);
      for (int it = gw; it < 16 * 48; it += NGW) { const int kb = it / 48, nb = it % 48; f32x4 mx = (f32x4){0.f, 0.f, 0.f, 0.f};
#pragma unroll
          for (int i = 0; i < 16; ++i) { const int kk = 64 * kb + 4 * i + (lane >> 4); const f32x4 w = *(const f32x4*)(w_in + (size_t)kk * INW + 64 * nb + 4 * (lane & 15)); const float ga = fabsf(g_mix[kk]);
#pragma unroll
              for (int c = 0; c < 4; ++c) mx[c] = fmaxf(mx[c], fabsf(w[c]) * ga); }
#pragma unroll
          for (int c = 0; c < 4; ++c) { mx[c] = fmaxf(mx[c], __shfl_xor(mx[c], 16)); mx[c] = fmaxf(mx[c], __shfl_xor(mx[c], 32)); mx[c] *= (64 * nb < 512) ? C2 : 1.0f; }
          if (lane < 16) {
#pragma unroll
              for (int c = 0; c < 4; ++c) __hip_atomic_fetch_max(ctl + CW_CMAX + 64 * nb + 4 * lane + c, __float_as_uint(mx[c]), __ATOMIC_RELAXED, __HIP_MEMORY_SCOPE_AGENT); }
          __builtin_amdgcn_fence(__ATOMIC_RELEASE, "agent");
          if (lane == 0) __hip_atomic_fetch_add(ctl + CW_CMDONE, 1u, __ATOMIC_RELAXED, __HIP_MEMORY_SCOPE_AGENT); } }
    for (int i = gt; i < PAR_N; i += NGT) { float v;
        if (i < PAR_CONVB) v = ((const float*)A.in[5])[i]; else if (i < PAR_GMHN) v = ((const float*)A.in[6])[i - PAR_CONVB]; else if (i < PAR_SKIP) v = ((const float*)A.in[11])[i - PAR_GMHN];
        else if (i < PAR_BRG) v = ((const float*)A.in[12])[i - PAR_SKIP]; else if (i < PAR_BRE) v = ((const float*)A.in[21])[i - PAR_BRG]; else if (i < PAR_GFIN) v = ((const float*)A.in[23])[i - PAR_BRE];
        else v = ((const float*)A.in[27])[i - PAR_GFIN];
        ((float*)(ws + WS_PAR))[i] = v; }
    for (int i = gt; i < 32 * 1024; i += NGT) { const int e = i >> 10, k = i & 1023;
        const float w = (e < 20) ? g_ffn[k] * (e < 4 ? w_rg[k * 4 + e] : w_re[k * 16 + (e - 4)]) : 0.f;
        const unsigned hi = f2bf(w); const float lo = w - bf2f(hi);
        ((bf16*)(ws + WS_WR))[i] = (bf16)hi; ((bf16*)(ws + WS_WR))[32 * 1024 + i] = (bf16)f2bf(lo); }
    for (int i = gt; i < T * 8; i += NGT) { const int t = i >> 3, j = i & 7; const float invf = powf(500000.0f, -(float)j * 0.125f);
        const float ang = (float)positions[t] * invf; float sn, cs; sincosf(ang, &sn, &cs);
        ((float*)(ws + WS_ROPE))[t * 16 + j] = cs; ((float*)(ws + WS_ROPE))[t * 16 + 8 + j] = sn; }
    __syncthreads();
    for (int m0 = 2 * gw; m0 < T + TMEM; m0 += 2 * NGW) {
        f32x4 v[2][4]; float rstd[2];
#pragma unroll
        for (int q = 0; q < 2; ++q) { const int m = m0 + q; const f32x4* xr = (const f32x4*)(m >= T ? mem + (size_t)(m - T) * D : x + (size_t)m * D) + lane;
#pragma unroll
            for (int j = 0; j < 4; ++j) v[q][j] = xr[64 * j]; }
#pragma unroll
        for (int q = 0; q < 2; ++q) { float s = 0.f;
#pragma unroll
            for (int j = 0; j < 4; ++j) s += (v[q][j].x * v[q][j].x + v[q][j].y * v[q][j].y) + (v[q][j].z * v[q][j].z + v[q][j].w * v[q][j].w);
            { const float rms = sqrtf(wave_sum(s) * (1.0f / D) + EPSN); rstd[q] = 1.0f / rms; if (lane == 0 && m0 + q < T) ((float*)(ws + WS_RINV))[m0 + q] = rms; }
            if (m0 + q < T) { float am = 0.f;
#pragma unroll
                for (int j = 0; j < 4; ++j) am = fmaxf(fmaxf(am, fmaxf(fabsf(v[q][j].x), fabsf(v[q][j].y))), fmaxf(fabsf(v[q][j].z), fabsf(v[q][j].w)));
                am = wave_max(am); const float qs = am > 0.f ? 127.0f / am : 0.f;
                if (lane == 0) ((float*)(ws + WS_RS8))[m0 + q] = am * (1.0f / 127.0f) * rstd[q];
                unsigned* o4 = (unsigned*)(ws + WS_X8 + (size_t)(m0 + q) * D) + lane;
#pragma unroll
                for (int j = 0; j < 4; ++j) o4[64 * j] = pk4_i8(v[q][j].x, v[q][j].y, v[q][j].z, v[q][j].w, qs); }
            unsigned long long* o8 = (unsigned long long*)(ws + WS_XN + (size_t)(m0 + q) * D * 2) + lane;
#pragma unroll
            for (int j = 0; j < 4; ++j) o8[64 * j] = (unsigned long long)pk2(v[q][j].x * rstd[q], v[q][j].y * rstd[q]) | ((unsigned long long)pk2(v[q][j].z * rstd[q], v[q][j].w * rstd[q]) << 32); }
        if (m0 < T) {
            float ga[2][8];
#pragma unroll
            for (int g = 0; g < 8; ++g) { float a0 = 0.f, a1 = 0.f;
#pragma unroll
                for (int j = 0; j < 4; ++j) { const f32x4 w = *(const LAS f32x4*)(WGl + g * 1024 + 256 * j + 4 * lane);
                    a0 += (v[0][j].x * w.x + v[0][j].y * w.y) + (v[0][j].z * w.z + v[0][j].w * w.w); a1 += (v[1][j].x * w.x + v[1][j].y * w.y) + (v[1][j].z * w.z + v[1][j].w * w.w); }
                ga[0][g] = a0; ga[1][g] = a1; }
            float val0, val1;
            { const bool b5 = (lane & 32) != 0, b4 = (lane & 16) != 0, b3 = (lane & 8) != 0;
#pragma unroll
              for (int q = 0; q < 2; ++q) { float r[4], s2[2];
#pragma unroll
                  for (int i = 0; i < 4; ++i) { const float keep = b5 ? ga[q][i + 4] : ga[q][i], send = b5 ? ga[q][i] : ga[q][i + 4]; r[i] = keep + __shfl_xor(send, 32); }
#pragma unroll
                  for (int i = 0; i < 2; ++i) { const float keep = b4 ? r[i + 2] : r[i], send = b4 ? r[i] : r[i + 2]; s2[i] = keep + __shfl_xor(send, 16); }
                  float p = (b3 ? s2[1] : s2[0]) + __shfl_xor(b3 ? s2[0] : s2[1], 8);
                  p += __shfl_xor(p, 4); p += __shfl_xor(p, 2); p += __shfl_xor(p, 1);
                  if (q == 0) val0 = p * rstd[0]; else val1 = p * rstd[1]; } }
            if ((lane & 7) == 0) { const int gidx = lane >> 3, h = gidx & 3;
#pragma unroll
                for (int q = 0; q < 2; ++q) { const int m = m0 + q, b = m / SEQ, sq = m % SEQ; const float val = q ? val1 : val0;
                    if (gidx < 4) ((float*)(ws + WS_IG))[(size_t)(b * 4 + h) * SEQ + sq] = val + b_i[h];
                    else ((float*)(ws + WS_FG))[(size_t)(b * 4 + h) * SEQ + sq] = val + b_f[h]; } }
        }
    }
    __syncthreads();
    LAS float* scr = (LAS float*)(lds + wave * 16384);
    constexpr int I_IN = 16 * 48, I_KV = 16 * 8, I_OUT = 16 * 16, I_QX = 16 * 4, I_OX = 4 * 16, I_M = 32, I_13 = 16 * 2 * 128, I_2P = 24 * 2 * 128;
    constexpr int NITEMS = I_IN + I_KV + I_OUT + I_QX + I_OX + I_M + I_13 + I_2P;
    bool cm_ok = false;
    for (int it = gw; it < NITEMS; it += NGW) {
        int r = it;
        if (r < I_IN) { const int kb = r / 48, nb = r % 48; const unsigned* ctl = (const unsigned*)(ws + WS_CTL);
            if (!cm_ok) { unsigned spins = 0;
                while ((unsigned)__builtin_amdgcn_readfirstlane(__hip_atomic_load(ctl + CW_CMDONE, __ATOMIC_RELAXED, __HIP_MEMORY_SCOPE_AGENT)) < 768u) { __builtin_amdgcn_s_sleep(4); if (++spins > (1u << 22)) break; }
                __builtin_amdgcn_fence(__ATOMIC_ACQUIRE, "agent"); cm_ok = true; }
            transpose_item_i8(w_in, INW, 64 * kb, 64 * nb, (unsigned char*)(ws + WS_WIN8), 1024, 64 * nb, 64 * kb, g_mix, (64 * nb < 512) ? C2 : 1.0f, ctl + CW_CMAX, scr, lane); continue; } r -= I_IN;
        if (r < I_KV) { const int kb = r / 8, nb = r % 8; transpose_item(w_kv_x, 512, 64 * kb, 64 * nb, (bf16*)(ws + WS_WIN), 1024, NIN + 64 * nb, 64 * kb, g_mem, 1.0f, scr, lane); continue; } r -= I_KV;
        if (r < I_OUT) { const int kb = r / 16, nb = r % 16; transpose_item(w_out, 1024, 64 * kb, 64 * nb, (bf16*)(ws + WS_WOUT), 1024, 64 * nb, 64 * kb, nullptr, 1.0f, scr, lane); continue; } r -= I_OUT;
        if (r < I_QX) { const int kb = r / 4, nb = r % 4; transpose_item(w_q_x, 256, 64 * kb, 64 * nb, (bf16*)(ws + WS_WQX), 1024, 64 * nb, 64 * kb, g_cross, C2, scr, lane); continue; } r -= I_QX;
        if (r < I_OX) { const int kb = r / 16, nb = r % 16; transpose_item(w_o_x, 1024, 64 * kb, 64 * nb, (bf16*)(ws + WS_WOX), 256, 64 * nb, 64 * kb, nullptr, 1.0f, scr, lane); continue; } r -= I_OX;
        if (r < I_M) { const int which = r / 16, h = (r % 16) / 4, kb = (r % 4) / 2, nb = r % 2;
            transpose_item((which ? w_k_m : w_q_m) + (size_t)h * 128 * 128, 128, 64 * kb, 64 * nb, (bf16*)(ws + WS_WM) + (size_t)(which * 4 + h) * 128 * 128, 128, 64 * nb, 64 * kb, nullptr,
                           which ? 0.08838834764831845f : 1.0f, scr, lane); continue; } r -= I_M;
        if (r < I_13) { const int e = r / 256, which = (r % 256) / 128, kb = (r % 128) / 8, nb = r % 8; const int n0 = 64 * nb;
            transpose_item_q8((which ? w3 : w1) + (size_t)e * 1024 * 512, 512, 64 * kb, n0, (unsigned char*)(ws + WS_W13Q) + (size_t)e * 1024 * 1024, 1024, (n0 / 128) * 256 + which * 128 + (n0 % 128), 64 * kb, g_ffn, 64.0f, scr, lane); continue; } r -= I_13;
        { const int bk = r / 256, hf = (r % 256) / 128, kb = (r % 128) / 16, nb = r % 16; const int g = bk / 6, p = bk % 6;
          const int pa = (p < 3) ? 0 : (p < 5 ? 1 : 2), pb = (p < 3) ? p + 1 : (p < 5 ? p - 1 : 3); const int e = 4 * g + (hf ? pb : pa);
          transpose_item_q8(w2 + (size_t)e * 512 * 1024, 1024, 64 * kb, 64 * nb, (unsigned char*)(ws + WS_W2P) + (size_t)bk * 1024 * 1024, 1024, 64 * nb, hf * 512 + 64 * kb, nullptr, 64.0f, scr, lane); }
    }
}

__device__ __forceinline__ v4u pack8(const f32x4& a, const f32x4& b) { v4u w; w.x = pk2(a[0], a[1]); w.y = pk2(a[2], a[3]); w.z = pk2(b[0], b[1]); w.w = pk2(b[2], b[3]); return w; }
struct EpiInProj {
    static constexpr bool PERM = true, AFTER_DRAIN = false;
    bf16* base; const float* rope; const float* rs8; const unsigned* cmax;
    __device__ __forceinline__ void operator()(const f32x4 (&acc)[2][2][4][2], const pg8::Unit& u, int wr, int wc, int fr, int fq) const {
        const int buf = u.pn >> 1; bf16* B = base + (size_t)buf * T * 512;
        f32x4 cs[2][2];
#pragma unroll
        for (int bj = 0; bj < 2; ++bj)
#pragma unroll
            for (int n = 0; n < 2; ++n) { const v4u cu = *(const v4u*)(cmax + u.pn * 256 + wc * 32 + 8 * fq + bj * 128 + 4 * n);
                cs[bj][n] = (f32x4){__uint_as_float(cu.x), __uint_as_float(cu.y), __uint_as_float(cu.z), __uint_as_float(cu.w)} * (1.0f / 127.0f); }
        int row0 = u.pm * 256 + wr * 64 + fr; asm volatile("" : "+v"(row0));
        const int col0 = (u.pn & 1) * 256 + wc * 32 + 8 * fq;
        const bool dorope = (buf < 2) && ((wc & 1) == 0);
#pragma unroll
        for (int ai = 0; ai < 2; ++ai)
#pragma unroll
            for (int m = 0; m < 4; ++m) { const int row = row0 + ai * 128 + m * 16; bf16* rowp = B + (size_t)row * 512 + col0;
                f32x4 cs0, cs1, sn0, sn1; const float rsv = rs8[row];
                if (dorope) { const f32x4* rp = (const f32x4*)(rope + (size_t)row * 16); cs0 = rp[0]; cs1 = rp[1]; sn0 = rp[2]; sn1 = rp[3]; }
#pragma unroll
                for (int bj = 0; bj < 2; ++bj) { f32x4 v0 = __builtin_convertvector(__builtin_bit_cast(pg8::v4i_t, acc[ai][bj][m][0]), f32x4) * rsv * cs[bj][0], v1 = __builtin_convertvector(__builtin_bit_cast(pg8::v4i_t, acc[ai][bj][m][1]), f32x4) * rsv * cs[bj][1];
                    if (dorope) { f32x4 o0, o1;
#pragma unroll
                        for (int i = 0; i < 4; ++i) { o0[i] = __shfl_xor(v0[i], 16); o1[i] = __shfl_xor(v1[i], 16); }
                        if (fq == 0) { v0 = v0 * cs0 - o0 * sn0; v1 = v1 * cs1 - o1 * sn1; }
                        else if (fq == 1) { v0 = v0 * cs0 + o0 * sn0; v1 = v1 * cs1 + o1 * sn1; } }
                    *(v4u*)(rowp + bj * 128) = pack8(v0, v1); } }
    }
};

typedef short v4i16_t __attribute__((ext_vector_type(4)));
struct AttItem { int cfg, b, h, d, nb; size_t tokb; };
__device__ __forceinline__ AttItem attn_decode(int item) {
    AttItem a; a.cfg = item >> 12; int rem = item & 4095; a.b = rem >> 9; rem &= 511; a.h = rem >> 6; const int sub = rem & 63;
    a.d = (a.cfg == 0) ? 1 : (a.cfg == 1 ? 4 : 16); const int nblk = 64 / a.d, r = sub / nblk; a.nb = sub % nblk; a.tokb = (size_t)a.b * SEQ + r; return a;
}
__device__ __forceinline__ int attn_item_of(int k, int G) {
    if (G != 256) return (int)blockIdx.x + k * G;
    const int pair = (int)(blockIdx.x & 7) + 8 * (k / 6), j = (int)(blockIdx.x >> 3), ip = j * 6 + (k % 6);
    return ((ip >> 6) << 12) | (pair << 6) | (ip & 63);
}
__device__ __forceinline__ void glds16(const void* gsrc, unsigned lds_dst) { unsigned keep;
    asm volatile("s_mov_b32 %0, m0\n\ts_mov_b32 m0, %2\n\ts_nop 0\n\tglobal_load_lds_dwordx4 %1, off\n\ts_mov_b32 m0, %0" : "=&s"(keep) : "v"(gsrc), "s"(lds_dst) : "memory"); }
__device__ __forceinline__ unsigned lds_addr_of(LAS unsigned char* p) { return (unsigned)(uintptr_t)p; }
__device__ __forceinline__ void attn_prefetch(const Args& A, LAS unsigned char* L, int item, int pslot, int oslot, bool load_prev, int lane, int wave, bf16x8 (&qf)[2]) {
    const AttItem a = attn_decode(item);
    const bf16* Kg = (const bf16*)(A.ws + WS_K) + a.h * 64; const bf16* Vg = (const bf16*)(A.ws + WS_V) + a.h * 64; const bf16* Qg = (const bf16*)(A.ws + WS_Q) + a.h * 64;
#pragma unroll
    for (int i = 0; i < 2; ++i) { const int inst = wave + 8 * i, row = 8 * inst + (lane >> 3);
        const size_t off = (a.tokb + (size_t)(128 * a.nb + row) * a.d) * 512 + ((lane & 7) ^ (lane >> 3)) * 8;
        glds16(Kg + off, (unsigned)__builtin_amdgcn_readfirstlane(lds_addr_of(L + oslot * 32768 + inst * 1024)));
        glds16(Vg + off, (unsigned)__builtin_amdgcn_readfirstlane(lds_addr_of(L + oslot * 32768 + 16384 + inst * 1024))); }
    if (load_prev) {
#pragma unroll
        for (int i = 0; i < 2; ++i) { const int inst = wave + 8 * i, row = 8 * inst + (lane >> 3);
            const size_t off = (a.tokb + (size_t)(128 * (a.nb - 1) + row) * a.d) * 512 + ((lane & 7) ^ (lane >> 3)) * 8;
            glds16(Kg + off, (unsigned)__builtin_amdgcn_readfirstlane(lds_addr_of(L + pslot * 32768 + inst * 1024)));
            glds16(Vg + off, (unsigned)__builtin_amdgcn_readfirstlane(lds_addr_of(L + pslot * 32768 + 16384 + inst * 1024))); } }
    const size_t tq = a.tokb + (size_t)(128 * a.nb + 16 * wave + (lane & 15)) * a.d;
    qf[0] = *(const GAS bf16x8*)(Qg + tq * 512 + 8 * (lane >> 4)); qf[1] = *(const GAS bf16x8*)(Qg + tq * 512 + 32 + 8 * (lane >> 4));
}
__device__ __forceinline__ void attn_compute(const Args& A, LAS unsigned char* L, int item, int pslot, int oslot, int lane, int wave, const bf16x8 (&qf)[2]) {
    const AttItem a = attn_decode(item);
    const int fr = lane & 15, g = lane >> 4, qi = 16 * wave + fr;
    f32x4 s[10];
#pragma unroll
    for (int tt = 0; tt < 9; ++tt) { const int t = wave + tt, key = 16 * (t & 7) + fr; LAS unsigned char* kb = L + ((t < 8) ? pslot : oslot) * 32768; s[tt] = (f32x4){0.f, 0.f, 0.f, 0.f};
#pragma unroll
        for (int ks = 0; ks < 2; ++ks) { const bf16x8 kf = *(const LAS bf16x8*)(kb + key * 128 + (((4 * ks + g) ^ (key & 7)) * 16));
            s[tt] = __builtin_amdgcn_mfma_f32_16x16x32_bf16(kf, qf[ks], s[tt], 0, 0, 0); } }
    s[9] = (f32x4){0.f, 0.f, 0.f, 0.f};
#pragma unroll
    for (int e = 0; e < 4; ++e) { s[0][e] = (4 * g + e >= fr) ? s[0][e] : -1e30f; s[8][e] = (4 * g + e <= fr) ? s[8][e] : -1e30f; }
    if (__builtin_expect(a.nb == 0, 0)) {
        asm volatile("" ::: "memory");
#pragma unroll
        for (int tt = 0; tt < 8; ++tt) if (wave + tt < 8) s[tt] = (f32x4){-1e30f, -1e30f, -1e30f, -1e30f};
        asm volatile("" : "+v"(s[0]), "+v"(s[1]), "+v"(s[2]), "+v"(s[3]), "+v"(s[4]), "+v"(s[5]), "+v"(s[6]), "+v"(s[7]));
    }
    float mx;
    { float m0_, m1_;
      asm("v_max3_f32 %0, %1, %2, %3" : "=v"(m0_) : "v"(s[0][0]), "v"(s[0][1]), "v"(s[0][2]));
      asm("v_max3_f32 %0, %1, %2, %3" : "=v"(m1_) : "v"(s[0][3]), "v"(s[1][0]), "v"(s[1][1]));
      asm("v_max3_f32 %0, %1, %2, %3" : "=v"(m0_) : "v"(m0_), "v"(s[1][2]), "v"(s[1][3]));
#pragma unroll
      for (int tt = 2; tt < 9; ++tt) { asm("v_max3_f32 %0, %1, %2, %3" : "=v"(m0_) : "v"(m0_), "v"(s[tt][0]), "v"(s[tt][1])); asm("v_max3_f32 %0, %1, %2, %3" : "=v"(m1_) : "v"(m1_), "v"(s[tt][2]), "v"(s[tt][3])); }
      asm("v_max_f32_e32 %0, %1, %2" : "=v"(mx) : "v"(m0_), "v"(m1_)); }
    mx = fmaxf(mx, __shfl_xor(mx, 16)); mx = fmaxf(mx, __shfl_xor(mx, 32));
    float l = 0.f;
#pragma unroll
    for (int tt = 0; tt < 9; ++tt)
#pragma unroll
        for (int e = 0; e < 4; ++e) { s[tt][e] = __builtin_amdgcn_exp2f(s[tt][e] - mx); l += s[tt][e]; }
    l += __shfl_xor(l, 16); l += __shfl_xor(l, 32);
    f32x4 o[4];
#pragma unroll
    for (int dt = 0; dt < 4; ++dt) o[dt] = (f32x4){0.f, 0.f, 0.f, 0.f};
#pragma unroll
    for (int k5 = 0; k5 < 5; ++k5) {
        const v4u pw = (v4u){pk2(s[2 * k5][0], s[2 * k5][1]), pk2(s[2 * k5][2], s[2 * k5][3]), pk2(s[2 * k5 + 1][0], s[2 * k5 + 1][1]), pk2(s[2 * k5 + 1][2], s[2 * k5 + 1][3])};
        const bf16x8 pf = __builtin_bit_cast(bf16x8, pw);
        const int t0 = wave + 2 * k5, t1 = (wave + 2 * k5 + 1 < 16) ? wave + 2 * k5 + 1 : 15;
        const int r0 = 16 * (t0 & 7) + 4 * g + (fr >> 2), r1 = 16 * (t1 & 7) + 4 * g + (fr >> 2), p_ = fr & 3;
        LAS unsigned char* v0b = L + ((t0 < 8) ? pslot : oslot) * 32768 + 16384; LAS unsigned char* v1b = L + ((t1 < 8) ? pslot : oslot) * 32768 + 16384;
#pragma unroll
        for (int dt = 0; dt < 4; ++dt) { const int chunk = 2 * dt + (p_ >> 1);
            const v4i16_t v0 = __builtin_amdgcn_ds_read_tr16_b64_v4i16((LAS v4i16_t*)(v0b + r0 * 128 + ((chunk ^ (r0 & 7)) * 16) + 8 * (p_ & 1)));
            const v4i16_t v1 = __builtin_amdgcn_ds_read_tr16_b64_v4i16((LAS v4i16_t*)(v1b + r1 * 128 + ((chunk ^ (r1 & 7)) * 16) + 8 * (p_ & 1)));
            const bf16x8 vf = (bf16x8){v0[0], v0[1], v0[2], v0[3], v1[0], v1[1], v1[2], v1[3]};
            o[dt] = __builtin_amdgcn_mfma_f32_16x16x32_bf16(vf, pf, o[dt], 0, 0, 0); } }
    const float rl = frcp_(l);
    const size_t tok = a.tokb + (size_t)(128 * a.nb + qi) * a.d;
    bf16* og = (bf16*)((unsigned char*)A.out + DO_OATT) + ((size_t)a.cfg * T + tok) * 512 + a.h * 64;
#pragma unroll
    for (int dt = 0; dt < 4; ++dt) *(GAS v2u*)(og + 16 * dt + 4 * g) = (v2u){pk2(o[dt][0] * rl, o[dt][1] * rl), pk2(o[dt][2] * rl, o[dt][3] * rl)};
    if (g == 0) ((GAS float*)(A.ws + WS_LSE))[((size_t)a.cfg * T + tok) * 8 + a.h] = mx + __builtin_amdgcn_logf(l);
}
__device__ __forceinline__ void attn_phase(const Args& A, unsigned char* lds, int n_total, int lane, int wave) {
    const int G = gridDim.x; LAS unsigned char* L = (LAS unsigned char*)lds;
    const int nk = (G == 256) ? n_total / 256 : (n_total - (int)blockIdx.x + G - 1) / G;
    if (nk <= 0) return;
    bf16x8 qa[2], qb[2];
    int it = attn_item_of(0, G); int ps, os;
    { const AttItem a = attn_decode(it); os = 0; ps = (a.nb > 0) ? 1 : 0; attn_prefetch(A, L, it, ps, os, a.nb > 0, lane, wave, qa); }
    for (int k = 0; k < nk; ++k) {
        if (k == 0) { __builtin_amdgcn_s_waitcnt(0x0F70); asm volatile("s_waitcnt vmcnt(0)" ::: "memory"); }
        else { __builtin_amdgcn_s_waitcnt(0x0F74); asm volatile("s_waitcnt vmcnt(4)" ::: "memory"); }
        __builtin_amdgcn_s_barrier();
        qb[0] = qa[0]; qb[1] = qa[1];
        int nit = it, nps = ps, nos = os;
        if (k + 1 < nk) { nit = attn_item_of(k + 1, G); const AttItem c = attn_decode(it), n = attn_decode(nit);
            const bool succ = (nit == it + 1) && (n.nb == c.nb + 1);
            const int used = (1 << ps) | (1 << os); const int f1 = (used & 1) ? ((used & 2) ? ((used & 4) ? 3 : 2) : 1) : 0; const int used2 = used | (1 << f1);
            const int f2 = (used2 & 1) ? ((used2 & 2) ? ((used2 & 4) ? 3 : 2) : 1) : 0;
            bool lp;
            if (succ) { nps = os; nos = f1; lp = false; } else if (n.nb == 0) { nos = f1; nps = f1; lp = false; } else { nps = f1; nos = f2; lp = true; }
            attn_prefetch(A, L, nit, nps, nos, lp, lane, wave, qb); }
        attn_compute(A, L, it, ps, os, lane, wave, qa);
        qa[0] = qb[0]; qa[1] = qb[1]; it = nit; ps = nps; os = nos;
    }
    asm volatile("s_waitcnt vmcnt(0)" ::: "memory");
    __syncthreads();
}

__device__ __forceinline__ void kv_tile(const Args& A, unsigned char* lds, int tile, int tid, int lane, int wave) {
    unsigned char* ws = A.ws;
    const int mt = tile >> 3, nt = tile & 7;
    const bf16* Ag = (const bf16*)(ws + WS_XN) + (size_t)(T + 64 * mt) * D; const bf16* Bg = (const bf16*)(ws + WS_WIN) + (size_t)(NIN + 64 * nt) * D;
    bf16* As = (bf16*)lds; bf16* Bs = (bf16*)(lds + 64 * 264 * 2);
    const int fr = lane & 15, fq = lane >> 4, wm = wave & 3, wn = wave >> 2;
    f32x4 acc[1][2]; acc[0][0] = (f32x4){0.f, 0.f, 0.f, 0.f}; acc[0][1] = (f32x4){0.f, 0.f, 0.f, 0.f};
    for (int kc = 0; kc < 4; ++kc) {
        for (int id = tid; id < 64 * 32; id += NTHR) { const int row = id >> 5, ch = id & 31;
            *(v4u*)(As + row * 264 + ch * 8) = *(const v4u*)(Ag + (size_t)row * D + kc * 256 + ch * 8);
            *(v4u*)(Bs + row * 264 + ch * 8) = *(const v4u*)(Bg + (size_t)row * D + kc * 256 + ch * 8); }
        __syncthreads();
        wave_mma<1, 2>(As + 16 * wm * 264, 264, Bs + 32 * wn * 264, 264, 256, acc, fr, fq);
        __syncthreads();
    }
    bf16* og = (bf16*)(ws + WS_KVX) + (size_t)(64 * mt + 16 * wm + fr) * NKV + 64 * nt + 32 * wn;
#pragma unroll
    for (int j = 0; j < 2; ++j) *(v2u*)(og + 16 * j + 4 * fq) = (v2u){pk2(acc[0][j][0], acc[0][j][1]), pk2(acc[0][j][2], acc[0][j][3])};
}

constexpr int ML_TILE = 32768;
constexpr int ML_G = 4 * ML_TILE;
static_assert(ML_G + 8192 <= LDS_MISC, "mlstm LDS");
__device__ __forceinline__ int sw_off(int row, int ch) { return 256 * row + 16 * (ch ^ (((row & 3) << 2) | ((row >> 2) & 3))); }
__device__ __forceinline__ bf16x8 rowfrag(LAS unsigned char* tile, int row0, int ks, int fr, int g) { return *(const LAS bf16x8*)(tile + sw_off(row0 + fr, 4 * ks + g)); }
__device__ __forceinline__ bf16x8 colfrag(LAS unsigned char* tile, int ks, int ct, int fr, int g) {
    const int r0 = 32 * ks + 8 * g + (fr >> 2), p = fr & 3, ch = 2 * ct + (p >> 1);
    const v4i16_t a = __builtin_amdgcn_ds_read_tr16_b64_v4i16((LAS v4i16_t*)(tile + sw_off(r0, ch) + 8 * (p & 1)));
    const v4i16_t b = __builtin_amdgcn_ds_read_tr16_b64_v4i16((LAS v4i16_t*)(tile + sw_off(r0 + 4, ch) + 8 * (p & 1)));
    return (bf16x8){a[0], a[1], a[2], a[3], b[0], b[1], b[2], b[3]};
}
#define MSB() __builtin_amdgcn_sched_barrier(0)
template <int NE, int NF, class LD, class USE>
__device__ __forceinline__ void frag_pipe(LD ld, USE use) {
    bf16x8 fa[NF], fb[NF];
    ld(fa, 0);
#pragma unroll
    for (int e = 0; e < NE; e += 2) {
        if (e + 1 < NE) ld(fb, e + 1);
        MSB(); use(fa, e); MSB();
        if (e + 2 < NE) ld(fa, e + 2);
        MSB(); if (e + 1 < NE) use(fb, e + 1); MSB();
    }
}
__device__ __forceinline__ float log_sigmoidf_(float x) { return (x > 0.f) ? -log1pf(__expf(-x)) : (x - log1pf(__expf(x))); }
__device__ __forceinline__ float wscan_sum(float v0, float v1, float& o0, float& o1, int lane) {
    float x = v0 + v1;
#pragma unroll
    for (int off = 1; off < 64; off <<= 1) { const float t = __shfl_up(x, off); if (lane >= off) x += t; }
    o0 = x - v1; o1 = x; return __shfl(x, 63);
}
__device__ __forceinline__ void wscan_max(float v0, float v1, float& o0, float& o1, int lane) {
    float y = fmaxf(v0, v1);
#pragma unroll
    for (int off = 1; off < 64; off <<= 1) { const float t = __shfl_up(y, off); if (lane >= off) y = fmaxf(y, t); }
    float pre = __shfl_up(y, 1); if (lane == 0) pre = -INFINITY;
    o0 = fmaxf(pre, v0); o1 = fmaxf(pre, fmaxf(v0, v1));
}
__device__ __forceinline__ void tile_load(LAS unsigned char* tile, const bf16* src, size_t pitch, int tid) {
    v4u v[4];
#pragma unroll
    for (int i = 0; i < 4; ++i) { const int id = tid + NTHR * i, row = id >> 4, ch = id & 15; v[i] = *(const GAS v4u*)(src + (size_t)row * pitch + ch * 8); }
#pragma unroll
    for (int i = 0; i < 4; ++i) { const int id = tid + NTHR * i, row = id >> 4, ch = id & 15; *(LAS v4u*)(tile + sw_off(row, ch)) = v[i]; }
}

struct TileRegs { v4u v[4]; };
__device__ __forceinline__ void tile_ld(TileRegs& r, const bf16* src, size_t pitch, int tid) {
#pragma unroll
    for (int i = 0; i < 4; ++i) { const int id = tid + NTHR * i, row = id >> 4, ch = id & 15; r.v[i] = *(const GAS v4u*)(src + (size_t)row * pitch + ch * 8); }
}
__device__ __forceinline__ void tile_st(LAS unsigned char* tile, const TileRegs& r, int tid) {
#pragma unroll
    for (int i = 0; i < 4; ++i) { const int id = tid + NTHR * i, row = id >> 4, ch = id & 15; *(LAS v4u*)(tile + sw_off(row, ch)) = r.v[i]; }
}
struct ConvRegs { v4u m[7]; f32x4 w[4][2], b[2]; };
__device__ __forceinline__ void conv_ld(ConvRegs& r, const bf16* MU, const float* conv_w, const float* conv_b, int b, int c, int h, int tid) {
    const int ch = (tid & 15) * 8, l0 = (tid >> 4) * 4;
#pragma unroll
    for (int q = 0; q < 7; ++q) { const int sp = 128 * c + l0 + q - 3; const v4u t = *(const GAS v4u*)(MU + ((size_t)b * SEQ + (sp < 0 ? 0 : sp)) * 512 + ch);
        const unsigned msk = (sp >= 0) ? 0xffffffffu : 0u; r.m[q] = (v4u){t.x & msk, t.y & msk, t.z & msk, t.w & msk}; }
#pragma unroll
    for (int j = 0; j < 4; ++j) { r.w[j][0] = *(const GAS f32x4*)(conv_w + j * 512 + h * 128 + ch); r.w[j][1] = *(const GAS f32x4*)(conv_w + j * 512 + h * 128 + ch + 4); }
    r.b[0] = *(const GAS f32x4*)(conv_b + h * 128 + ch); r.b[1] = *(const GAS f32x4*)(conv_b + h * 128 + ch + 4);
}
__device__ __forceinline__ void conv_fin(LAS unsigned char* cA, const ConvRegs& r, int tid) {
    const int l0 = (tid >> 4) * 4;
#pragma unroll
    for (int i = 0; i < 4; ++i) { float a[8];
#pragma unroll
        for (int q = 0; q < 8; ++q) a[q] = r.b[q >> 2][q & 3];
#pragma unroll
        for (int j = 0; j < 4; ++j) { const v4u mm = r.m[i + j]; const f32x4 w0 = r.w[j][0], w1 = r.w[j][1];
            a[0] += bflo(mm.x) * w0[0]; a[1] += bfhi(mm.x) * w0[1]; a[2] += bflo(mm.y) * w0[2]; a[3] += bfhi(mm.y) * w0[3];
            a[4] += bflo(mm.z) * w1[0]; a[5] += bfhi(mm.z) * w1[1]; a[6] += bflo(mm.w) * w1[2]; a[7] += bfhi(mm.w) * w1[3]; }
#pragma unroll
        for (int q = 0; q < 8; ++q) a[q] = a[q] * sigmoidf_(a[q]);
        *(LAS v4u*)(cA + sw_off(l0 + i, tid & 15)) = (v4u){pk2(a[0], a[1]), pk2(a[2], a[3]), pk2(a[4], a[5]), pk2(a[6], a[7])}; }
}
__device__ __forceinline__ void ml_conv_tile(LAS unsigned char* cA, const bf16* MU, const float* conv_w, const float* conv_b, int b, int c, int h, int tid) {
    const int ch = (tid & 15) * 8, l0 = (tid >> 4) * 4;
    float w[4][8], bs[8];
#pragma unroll
    for (int j = 0; j < 4; ++j) { const f32x4 w0 = *(const GAS f32x4*)(conv_w + j * 512 + h * 128 + ch), w1 = *(const GAS f32x4*)(conv_w + j * 512 + h * 128 + ch + 4);
        w[j][0] = w0[0]; w[j][1] = w0[1]; w[j][2] = w0[2]; w[j][3] = w0[3]; w[j][4] = w1[0]; w[j][5] = w1[1]; w[j][6] = w1[2]; w[j][7] = w1[3]; }
    { const f32x4 b0 = *(const GAS f32x4*)(conv_b + h * 128 + ch), b1 = *(const GAS f32x4*)(conv_b + h * 128 + ch + 4);
      bs[0] = b0[0]; bs[1] = b0[1]; bs[2] = b0[2]; bs[3] = b0[3]; bs[4] = b1[0]; bs[5] = b1[1]; bs[6] = b1[2]; bs[7] = b1[3]; }
    v4u m[7];
#pragma unroll
    for (int r = 0; r < 7; ++r) { const int sp = 128 * c + l0 + r - 3; const v4u t = *(const GAS v4u*)(MU + ((size_t)b * SEQ + (sp < 0 ? 0 : sp)) * 512 + ch);
        const unsigned msk = (sp >= 0) ? 0xffffffffu : 0u; m[r] = (v4u){t.x & msk, t.y & msk, t.z & msk, t.w & msk}; }
#pragma unroll
    for (int i = 0; i < 4; ++i) { float a[8];
#pragma unroll
        for (int q = 0; q < 8; ++q) a[q] = bs[q];
#pragma unroll
        for (int j = 0; j < 4; ++j) { const v4u mm = m[i + j];
            a[0] += bflo(mm.x) * w[j][0]; a[1] += bfhi(mm.x) * w[j][1]; a[2] += bflo(mm.y) * w[j][2]; a[3] += bfhi(mm.y) * w[j][3];
            a[4] += bflo(mm.z) * w[j][4]; a[5] += bfhi(mm.z) * w[j][5]; a[6] += bflo(mm.w) * w[j][6]; a[7] += bfhi(mm.w) * w[j][7]; }
#pragma unroll
        for (int q = 0; q < 8; ++q) a[q] = a[q] * sigmoidf_(a[q]);
        *(LAS v4u*)(cA + sw_off(l0 + i, tid & 15)) = (v4u){pk2(a[0], a[1]), pk2(a[2], a[3]), pk2(a[4], a[5]), pk2(a[6], a[7])}; }
}
struct MGroup { f32x4 G[8]; f32x4 Gn; float B, M; };
__device__ __forceinline__ void mlstm_p1_item(const Args& A, unsigned char* lds_, int item, int& wres, MGroup& mg, int tid, int lane, int wave) {
    asm volatile("" : "+v"(tid), "+v"(lane));
    unsigned char* ws = A.ws; LAS unsigned char* lds = (LAS unsigned char*)lds_;
    const int bh = item >> 6, c = item & 63, b = bh >> 2, h = bh & 3;
    const size_t t0 = (size_t)b * SEQ + 128 * c;
    LAS unsigned char* cA = lds; LAS unsigned char* Wk = lds + 2 * ML_TILE; LAS unsigned char* Vt = lds + 3 * ML_TILE;
    LAS float* gl = (LAS float*)(lds + ML_G);
    const int fr = lane & 15, g = lane >> 4, m0 = 16 * wave;
    const size_t gi_ = (size_t)bh * SEQ + 128 * c + 2 * lane;
    const float gi0_ = ((const GAS float*)(ws + WS_IG))[gi_], gi1_ = ((const GAS float*)(ws + WS_IG))[gi_ + 1], gf0_ = ((const GAS float*)(ws + WS_FG))[gi_], gf1_ = ((const GAS float*)(ws + WS_FG))[gi_ + 1];
    if (wres != h) { tile_load(Wk, (const bf16*)(ws + WS_WM) + (size_t)(4 + h) * 128 * 128, 128, tid); wres = h; }
    { TileRegs r3; ConvRegs cr;
      tile_ld(r3, (const bf16*)(ws + WS_MV) + t0 * 512 + h * 128, 512, tid);
      conv_ld(cr, (const bf16*)(ws + WS_MU) + h * 128, (const float*)(ws + WS_PAR) + PAR_CONVW, (const float*)(ws + WS_PAR) + PAR_CONVB, b, c, h, tid);
      asm volatile("" ::: "memory");
      tile_st(Vt, r3, tid); conv_fin(cA, cr, tid); }
    float blast, mloc;
    { const float i0 = gi0_, i1 = gi1_, f0 = log_sigmoidf_(gf0_), f1 = log_sigmoidf_(gf1_);
      float b0, b1; blast = wscan_sum(f0, f1, b0, b1, lane);
      const float g0 = blast - b0 + i0, g1 = blast - b1 + i1; mloc = wave_max(fmaxf(g0, g1));
      gl[2 * lane] = fexp_(g0 - mloc); gl[2 * lane + 1] = fexp_(g1 - mloc); }
    __syncthreads();
    { bf16x8 af[4];
#pragma unroll
      for (int ks = 0; ks < 4; ++ks) af[ks] = rowfrag(cA, m0, ks, fr, g);
      const float wk = gl[m0 + fr];
      v2u kp[8];
      frag_pipe<8, 4>(
          [&](bf16x8 (&f)[4], int j) __attribute__((always_inline)) {
#pragma unroll
              for (int ks = 0; ks < 4; ++ks) f[ks] = rowfrag(Wk, 16 * j, ks, fr, g); },
          [&](bf16x8 (&f)[4], int j) __attribute__((always_inline)) { f32x4 acc = (f32x4){0.f, 0.f, 0.f, 0.f};
#pragma unroll
              for (int ks = 0; ks < 4; ++ks) acc = __builtin_amdgcn_mfma_f32_16x16x32_bf16(f[ks], af[ks], acc, 0, 0, 0);
              kp[j] = (v2u){pk2(acc[0] * wk, acc[1] * wk), pk2(acc[2] * wk, acc[3] * wk)}; });
#pragma unroll
      for (int j = 0; j < 8; ++j) *(LAS v2u*)(cA + sw_off(m0 + fr, 2 * j + (g >> 1)) + 8 * (g & 1)) = kp[j]; }
    __syncthreads();
    { f32x4 acc[8], accn = (f32x4){0.f, 0.f, 0.f, 0.f};
#pragma unroll
      for (int j = 0; j < 8; ++j) acc[j] = (f32x4){0.f, 0.f, 0.f, 0.f};
      const bf16x8 ones = (bf16x8){0x3f80, 0x3f80, 0x3f80, 0x3f80, 0x3f80, 0x3f80, 0x3f80, 0x3f80};
      bf16x8 vfa[4];
      { bf16x8 kw_[4];
#pragma unroll
        for (int ks = 0; ks < 4; ++ks) { vfa[ks] = colfrag(Vt, ks, wave, fr, g); kw_[ks] = colfrag(cA, ks, wave, fr, g); }
#pragma unroll
        for (int ks = 0; ks < 4; ++ks) accn = __builtin_amdgcn_mfma_f32_16x16x32_bf16(kw_[ks], ones, accn, 0, 0, 0); }
      frag_pipe<8, 4>(
          [&](bf16x8 (&f)[4], int e) __attribute__((always_inline)) {
#pragma unroll
              for (int t = 0; t < 4; ++t) f[t] = colfrag(cA, e >> 1, 4 * (e & 1) + t, fr, g); },
          [&](bf16x8 (&f)[4], int e) __attribute__((always_inline)) {
#pragma unroll
              for (int t = 0; t < 4; ++t) acc[4 * (e & 1) + t] = __builtin_amdgcn_mfma_f32_16x16x32_bf16(f[t], vfa[e >> 1], acc[4 * (e & 1) + t], 0, 0, 0); });
      if ((c & 7) == 0) {
#pragma unroll
          for (int j = 0; j < 8; ++j) mg.G[j] = acc[j];
          mg.Gn = accn; mg.M = mloc; mg.B = blast;
      } else { const float mnew = fmaxf(blast + mg.M, mloc), a = fexp_(blast + mg.M - mnew), cc = fexp_(mloc - mnew);
#pragma unroll
          for (int j = 0; j < 8; ++j) mg.G[j] = mg.G[j] * a + acc[j] * cc;
          mg.Gn = mg.Gn * a + accn * cc; mg.M = mnew; mg.B += blast; }
      if ((c & 7) == 7) { const int gi = bh * 8 + (c >> 3);
          bf16* gg = (bf16*)(ws + WS_GAGG) + ((size_t)gi * 128 + m0 + fr) * 128;
#pragma unroll
          for (int j = 0; j < 8; ++j) *(v2u*)(gg + 16 * j + 4 * g) = (v2u){pk2(mg.G[j][0], mg.G[j][1]), pk2(mg.G[j][2], mg.G[j][3])};
          if (fr == 0) *(f32x4*)((float*)(ws + WS_GN) + (size_t)gi * 128 + 16 * wave + 4 * g) = mg.Gn;
          if (wave == 0 && lane == 0) { ((float*)(ws + WS_GSC))[2 * gi] = mg.B; ((float*)(ws + WS_GSC))[2 * gi + 1] = mg.M; } } }
    __syncthreads();
}

__device__ __forceinline__ void combine_rows(const Args& A, size_t row0, int nrows, int tid) {
    unsigned char* ws = A.ws;
    const bf16* OA = (const bf16*)((const unsigned char*)A.out + DO_OATT); const float* LSE = (const float*)(ws + WS_LSE);
    for (int id = tid; id < nrows * 64; id += NTHR) {
        const size_t t = row0 + (id >> 6); const int h = (id & 63) >> 3, ch = (id & 7) * 8;
        const float l0 = LSE[t * 8 + h], l1 = LSE[((size_t)T + t) * 8 + h], l2 = LSE[((size_t)2 * T + t) * 8 + h];
        const float mx = fmaxf(l0, fmaxf(l1, l2)); float w0 = __builtin_amdgcn_exp2f(l0 - mx), w1 = __builtin_amdgcn_exp2f(l1 - mx), w2 = __builtin_amdgcn_exp2f(l2 - mx);
        const float rs = frcp_(w0 + w1 + w2); w0 *= rs; w1 *= rs; w2 *= rs;
        const v4u a = *(const v4u*)(OA + t * 512 + h * 64 + ch), b = *(const v4u*)(OA + ((size_t)T + t) * 512 + h * 64 + ch), c = *(const v4u*)(OA + ((size_t)2 * T + t) * 512 + h * 64 + ch);
        v4u o;
        o.x = pk2(w0 * bflo(a.x) + w1 * bflo(b.x) + w2 * bflo(c.x), w0 * bfhi(a.x) + w1 * bfhi(b.x) + w2 * bfhi(c.x));
        o.y = pk2(w0 * bflo(a.y) + w1 * bflo(b.y) + w2 * bflo(c.y), w0 * bfhi(a.y) + w1 * bfhi(b.y) + w2 * bfhi(c.y));
        o.z = pk2(w0 * bflo(a.z) + w1 * bflo(b.z) + w2 * bflo(c.z), w0 * bfhi(a.z) + w1 * bfhi(b.z) + w2 * bfhi(c.z));
        o.w = pk2(w0 * bflo(a.w) + w1 * bflo(b.w) + w2 * bflo(c.w), w0 * bfhi(a.w) + w1 * bfhi(b.w) + w2 * bfhi(c.w));
        *(v4u*)((bf16*)(ws + WS_Y) + t * 1024 + h * 64 + ch) = o;
    }
}

struct MState { f32x4 C[8]; float n0, n1, m; };
__device__ __forceinline__ void mlstm2_entry(const Args& A, int bh, int grp, MState& st, int lane, int wave) {
    asm volatile("" : "+v"(lane));
    unsigned char* ws = A.ws; const int fr = lane & 15, g = lane >> 4, m0 = 16 * wave;
#pragma unroll
    for (int j = 0; j < 8; ++j) st.C[j] = (f32x4){0.f, 0.f, 0.f, 0.f};
    st.n0 = 0.f; st.n1 = 0.f; st.m = 0.f;
#pragma unroll
    for (int g0 = 0; g0 < 8; g0 += 4) { if (g0 >= grp) break;
        v2u gw_[4][8]; float gB[4], gM[4], gn0[4], gn1[4];
#pragma unroll
        for (int q = 0; q < 4; ++q) { const int gp = g0 + q, gi = bh * 8 + (gp < grp ? gp : 0);
            gB[q] = ((const GAS float*)(ws + WS_GSC))[2 * gi]; gM[q] = ((const GAS float*)(ws + WS_GSC))[2 * gi + 1];
            const bf16* gg = (const bf16*)(ws + WS_GAGG) + ((size_t)gi * 128 + m0 + fr) * 128;
#pragma unroll
            for (int j = 0; j < 8; ++j) gw_[q][j] = *(const GAS v2u*)(gg + 16 * j + 4 * g);
            const float* gn = (const float*)(ws + WS_GN) + (size_t)gi * 128 + 2 * lane; gn0[q] = ((const GAS float*)gn)[0]; gn1[q] = ((const GAS float*)gn)[1]; }
#pragma unroll
        for (int q = 0; q < 4; ++q) if (g0 + q < grp) { const float B = gB[q], M = gM[q];
            const float mnew = fmaxf(B + st.m, M), a = fexp_(B + st.m - mnew), cc = fexp_(M - mnew);
#pragma unroll
            for (int j = 0; j < 8; ++j) { const v2u w = gw_[q][j]; st.C[j] = st.C[j] * a + (f32x4){bflo(w.x), bfhi(w.x), bflo(w.y), bfhi(w.y)} * cc; }
            st.n0 = st.n0 * a + gn0[q] * cc; st.n1 = st.n1 * a + gn1[q] * cc; st.m = mnew; } }
}
__device__ __forceinline__ void mlstm_p2_item(const Args& A, unsigned char* lds_, int item, MState& st, int tid, int lane, int wave) {
    asm volatile("" : "+v"(tid), "+v"(lane));
    unsigned char* ws = A.ws; LAS unsigned char* lds = (LAS unsigned char*)lds_;
    const float* g_mhn = (const float*)(ws + WS_PAR) + PAR_GMHN; const float* skip_m = (const float*)(ws + WS_PAR) + PAR_SKIP;
    const int bh = item >> 6, c = item & 63, b = bh >> 2, h = bh & 3;
    const size_t t0 = (size_t)b * SEQ + 128 * c;
    LAS unsigned char* T0 = lds; LAS unsigned char* T1 = lds + ML_TILE; LAS unsigned char* T2 = lds + 2 * ML_TILE; LAS unsigned char* T3 = lds + 3 * ML_TILE;
    LAS float* gl = (LAS float*)(lds + ML_G);
    const int fr = lane & 15, g = lane >> 4, m0 = 16 * wave, l = m0 + fr;
    TileRegs r1, r2, r3; ConvRegs cr;
    { const bf16* Wg = (const bf16*)(ws + WS_WM) + (size_t)h * 128 * 128; tile_ld(r1, Wg, 128, tid); tile_ld(r2, Wg + 4 * 128 * 128, 128, tid); }
    tile_ld(r3, (const bf16*)(ws + WS_MV) + t0 * 512 + h * 128, 512, tid);
    conv_ld(cr, (const bf16*)(ws + WS_MU) + h * 128, (const float*)(ws + WS_PAR) + PAR_CONVW, (const float*)(ws + WS_PAR) + PAR_CONVB, b, c, h, tid);
    const size_t gi_ = (size_t)bh * SEQ + 128 * c + 2 * lane;
    const float gi0_ = ((const GAS float*)(ws + WS_IG))[gi_], gi1_ = ((const GAS float*)(ws + WS_IG))[gi_ + 1], gf0_ = ((const GAS float*)(ws + WS_FG))[gi_], gf1_ = ((const GAS float*)(ws + WS_FG))[gi_ + 1];
    asm volatile("" ::: "memory");
    tile_st(T1, r1, tid); tile_st(T2, r2, tid); tile_st(T3, r3, tid); conv_fin(T0, cr, tid);
    float blast, mloc;
    { const float mprev = st.m;
      const float i0 = gi0_, i1 = gi1_, f0 = log_sigmoidf_(gf0_), f1 = log_sigmoidf_(gf1_);
      float b0, b1; blast = wscan_sum(f0, f1, b0, b1, lane);
      const float g0 = blast - b0 + i0, g1 = blast - b1 + i1; mloc = wave_max(fmaxf(g0, g1));
      gl[640 + 2 * lane] = fexp_(g0 - mloc); gl[640 + 2 * lane + 1] = fexp_(g1 - mloc);
      const float a0 = i0 - b0, a1 = i1 - b1; float p0, p1; wscan_max(a0, a1, p0, p1, lane);
      const float mt0 = fmaxf(b0 + mprev, b0 + p0), mt1 = fmaxf(b1 + mprev, b1 + p1);
      gl[2 * lane] = a0; gl[2 * lane + 1] = a1; gl[128 + 2 * lane] = b0 - mt0; gl[128 + 2 * lane + 1] = b1 - mt1;
      gl[256 + 2 * lane] = fexp_(b0 + mprev - mt0); gl[256 + 2 * lane + 1] = fexp_(b1 + mprev - mt1); gl[384 + 2 * lane] = fexp_(-mt0); gl[384 + 2 * lane + 1] = fexp_(-mt1);
      gl[512 + 2 * lane] = st.n0; gl[512 + 2 * lane + 1] = st.n1; }
    if (tid < 64) *(LAS f32x4*)(gl + 896 + 4 * tid) = *(const f32x4*)(((tid < 32) ? g_mhn : skip_m - 128) + h * 128 + 4 * tid);
    __syncthreads();
    v2u cp[8], qp[8], kp[8];
    { bf16x8 af[4];
#pragma unroll
      for (int ks = 0; ks < 4; ++ks) af[ks] = rowfrag(T0, m0, ks, fr, g);
#pragma unroll
      for (int j = 0; j < 8; ++j) cp[j] = *(const LAS v2u*)(T0 + sw_off(l, 2 * j + (g >> 1)) + 8 * (g & 1));
      frag_pipe<16, 4>(
          [&](bf16x8 (&f)[4], int jj) __attribute__((always_inline)) { LAS unsigned char* Tw = (jj < 8) ? T1 : T2;
#pragma unroll
              for (int ks = 0; ks < 4; ++ks) f[ks] = rowfrag(Tw, 16 * (jj & 7), ks, fr, g); },
          [&](bf16x8 (&f)[4], int jj) __attribute__((always_inline)) { f32x4 acc = (f32x4){0.f, 0.f, 0.f, 0.f};
#pragma unroll
              for (int ks = 0; ks < 4; ++ks) acc = __builtin_amdgcn_mfma_f32_16x16x32_bf16(f[ks], af[ks], acc, 0, 0, 0);
              const v2u pkd = (v2u){pk2(acc[0], acc[1]), pk2(acc[2], acc[3])};
              if (jj < 8) qp[jj & 7] = pkd; else kp[jj & 7] = pkd; }); }
    __syncthreads();
#pragma unroll
    for (int j = 0; j < 8; ++j) { const int off = sw_off(l, 2 * j + (g >> 1)) + 8 * (g & 1);
        *(LAS v2u*)(T1 + off) = qp[j]; *(LAS v2u*)(T0 + off) = kp[j]; *(LAS v2u*)(T2 + off) = (v2u){pk2(st.C[j][0], st.C[j][1]), pk2(st.C[j][2], st.C[j][3])}; }
    __syncthreads();
    v2u mop[8];
    { const bf16* MOg = (const bf16*)(ws + WS_MO) + (t0 + l) * 512 + h * 128;
#pragma unroll
      for (int j = 0; j < 8; ++j) mop[j] = *(const GAS v2u*)(MOg + 16 * j + 4 * g); }
    bf16x8 qf[4];
#pragma unroll
    for (int ks = 0; ks < 4; ++ks) qf[ks] = rowfrag(T1, m0, ks, fr, g);
    float qn = 0.f;
    { const LAS float* np = gl + 512;
#pragma unroll
      for (int ks = 0; ks < 4; ++ks) { const f32x4 n0 = *(const LAS f32x4*)(np + 32 * ks + 8 * g), n1 = *(const LAS f32x4*)(np + 32 * ks + 8 * g + 4); const v4u w = __builtin_bit_cast(v4u, qf[ks]);
          qn += bflo(w.x) * n0[0] + bfhi(w.x) * n0[1] + bflo(w.y) * n0[2] + bfhi(w.y) * n0[3] + bflo(w.z) * n1[0] + bfhi(w.z) * n1[1] + bflo(w.w) * n1[2] + bfhi(w.w) * n1[3]; }
      qn += __shfl_xor(qn, 16); qn += __shfl_xor(qn, 32); }
    float den = 0.f;
    { const float rc = gl[128 + l];
      frag_pipe<8, 4>(
          [&](bf16x8 (&f)[4], int j) __attribute__((always_inline)) {
#pragma unroll
              for (int ks = 0; ks < 4; ++ks) f[ks] = rowfrag(T0, 16 * j, ks, fr, g); },
          [&](bf16x8 (&f)[4], int j) __attribute__((always_inline)) { f32x4 acc = (f32x4){0.f, 0.f, 0.f, 0.f};
              if (j <= wave) {
                  const f32x4 av = *(const LAS f32x4*)(gl + 16 * j + 4 * g);
#pragma unroll
                  for (int ks = 0; ks < 4; ++ks) acc = __builtin_amdgcn_mfma_f32_16x16x32_bf16(f[ks], qf[ks], acc, 0, 0, 0);
#pragma unroll
                  for (int q = 0; q < 4; ++q) { const int sx = 16 * j + 4 * g + q; acc[q] = (sx <= l) ? acc[q] * fexp_(rc + av[q]) : 0.f; den += acc[q]; } }
              *(LAS v2u*)(T1 + sw_off(l, 2 * j + (g >> 1)) + 8 * (g & 1)) = (v2u){pk2(acc[0], acc[1]), pk2(acc[2], acc[3])}; });
      den += __shfl_xor(den, 16); den += __shfl_xor(den, 32); }
    f32x4 acc[8];
    const float iw = gl[256 + l];
    frag_pipe<8, 4>(
        [&](bf16x8 (&f)[4], int j) __attribute__((always_inline)) {
#pragma unroll
            for (int ks = 0; ks < 4; ++ks) f[ks] = rowfrag(T2, 16 * j, ks, fr, g); },
        [&](bf16x8 (&f)[4], int j) __attribute__((always_inline)) { f32x4 a_ = (f32x4){0.f, 0.f, 0.f, 0.f};
#pragma unroll
            for (int ks = 0; ks < 4; ++ks) a_ = __builtin_amdgcn_mfma_f32_16x16x32_bf16(f[ks], qf[ks], a_, 0, 0, 0);
            acc[j] = a_ * iw; });
    asm volatile("s_waitcnt lgkmcnt(0)" ::: "memory");
    { bf16x8 sf[4];
#pragma unroll
      for (int ks = 0; ks < 4; ++ks) sf[ks] = rowfrag(T1, m0, ks, fr, g);
      frag_pipe<8, 4>(
          [&](bf16x8 (&f)[4], int e) __attribute__((always_inline)) {
#pragma unroll
              for (int t = 0; t < 4; ++t) f[t] = colfrag(T3, e >> 1, 4 * (e & 1) + t, fr, g); },
          [&](bf16x8 (&f)[4], int e) __attribute__((always_inline)) {
              if (2 * (e >> 1) <= wave) {
#pragma unroll
                  for (int t = 0; t < 4; ++t) acc[4 * (e & 1) + t] = __builtin_amdgcn_mfma_f32_16x16x32_bf16(f[t], sf[e >> 1], acc[4 * (e & 1) + t], 0, 0, 0); } }); }
    den += iw * qn;
    const float rden = frcp_(fmaxf(fabsf(den), gl[384 + l]));
    float sq = 0.f;
#pragma unroll
    for (int j = 0; j < 8; ++j) { acc[j] = acc[j] * rden; sq += (acc[j][0] * acc[j][0] + acc[j][1] * acc[j][1]) + (acc[j][2] * acc[j][2] + acc[j][3] * acc[j][3]); }
    sq += __shfl_xor(sq, 16); sq += __shfl_xor(sq, 32);
    const float rn = __builtin_amdgcn_rsqf(sq * (1.0f / 128.0f) + EPSN);
    bf16* yg = (bf16*)(ws + WS_Y) + (t0 + l) * 1024 + 512 + h * 128;
#pragma unroll
    for (int j = 0; j < 8; ++j) { const int e0 = 16 * j + 4 * g;
        const v2u mo = mop[j], cc = cp[j];
        const f32x4 gm = *(const LAS f32x4*)(gl + 896 + e0), sk = *(const LAS f32x4*)(gl + 1024 + e0);
        const float y0 = sigmoidf_(bflo(mo.x)) * (acc[j][0] * rn * gm[0] + sk[0] * bflo(cc.x));
        const float y1 = sigmoidf_(bfhi(mo.x)) * (acc[j][1] * rn * gm[1] + sk[1] * bfhi(cc.x));
        const float y2 = sigmoidf_(bflo(mo.y)) * (acc[j][2] * rn * gm[2] + sk[2] * bflo(cc.y));
        const float y3 = sigmoidf_(bfhi(mo.y)) * (acc[j][3] * rn * gm[3] + sk[3] * bfhi(cc.y));
        *(v2u*)(yg + e0) = (v2u){pk2(y0, y1), pk2(y2, y3)}; }
    { f32x4 accn = (f32x4){0.f, 0.f, 0.f, 0.f};
#pragma unroll
      for (int j = 0; j < 8; ++j) acc[j] = (f32x4){0.f, 0.f, 0.f, 0.f};
      bf16x8 vfa[4];
      { f32x4 w0[4], w1[4]; bf16x8 vr_[4], kw_[4];
#pragma unroll
        for (int ks = 0; ks < 4; ++ks) { w0[ks] = *(const LAS f32x4*)(gl + 640 + 32 * ks + 8 * g); w1[ks] = *(const LAS f32x4*)(gl + 640 + 32 * ks + 8 * g + 4);
            vr_[ks] = colfrag(T3, ks, wave, fr, g); kw_[ks] = colfrag(T0, ks, wave, fr, g); }
#pragma unroll
        for (int ks = 0; ks < 4; ++ks) { const v4u vr = __builtin_bit_cast(v4u, vr_[ks]);
            const v4u vs = (v4u){pk2(bflo(vr.x) * w0[ks][0], bfhi(vr.x) * w0[ks][1]), pk2(bflo(vr.y) * w0[ks][2], bfhi(vr.y) * w0[ks][3]), pk2(bflo(vr.z) * w1[ks][0], bfhi(vr.z) * w1[ks][1]), pk2(bflo(vr.w) * w1[ks][2], bfhi(vr.w) * w1[ks][3])};
            const v4u wv = (v4u){pk2(w0[ks][0], w0[ks][1]), pk2(w0[ks][2], w0[ks][3]), pk2(w1[ks][0], w1[ks][1]), pk2(w1[ks][2], w1[ks][3])};
            vfa[ks] = __builtin_bit_cast(bf16x8, vs);
            accn = __builtin_amdgcn_mfma_f32_16x16x32_bf16(kw_[ks], __builtin_bit_cast(bf16x8, wv), accn, 0, 0, 0); } }
      frag_pipe<8, 4>(
          [&](bf16x8 (&f)[4], int e) __attribute__((always_inline)) {
#pragma unroll
              for (int t = 0; t < 4; ++t) f[t] = colfrag(T0, e >> 1, 4 * (e & 1) + t, fr, g); },
          [&](bf16x8 (&f)[4], int e) __attribute__((always_inline)) {
#pragma unroll
              for (int t = 0; t < 4; ++t) acc[4 * (e & 1) + t] = __builtin_amdgcn_mfma_f32_16x16x32_bf16(f[t], vfa[e >> 1], acc[4 * (e & 1) + t], 0, 0, 0); });
      const float mnew = fmaxf(blast + st.m, mloc), a = fexp_(blast + st.m - mnew), cc = fexp_(mloc - mnew);
#pragma unroll
      for (int j = 0; j < 8; ++j) st.C[j] = st.C[j] * a + acc[j] * cc;
      if (fr == 0) *(LAS f32x4*)(gl + 768 + 16 * wave + 4 * g) = accn;
      asm volatile("s_waitcnt lgkmcnt(0)" ::: "memory"); __builtin_amdgcn_s_barrier(); asm volatile("" ::: "memory");
      st.n0 = st.n0 * a + gl[768 + 2 * lane] * cc; st.n1 = st.n1 * a + gl[768 + 2 * lane + 1] * cc; st.m = mnew; }
}

struct EpiOutProj {
    static constexpr bool PERM = true, AFTER_DRAIN = false;
    const bf16* xn; const float* rinv; bf16* x1b; float* ss;
    __device__ __forceinline__ void operator()(const f32x4 (&acc)[2][2][4][2], const pg8::Unit& u, int wr, int wc, int fr, int fq) const {
        int row0 = u.pm * 256 + wr * 64 + fr; asm volatile("" : "+v"(row0));
        const int col0 = u.pn * 256 + wc * 32 + 8 * fq;
#pragma unroll
        for (int ai = 0; ai < 2; ++ai) { v4u xr[4][2]; float rm[4];
#pragma unroll
            for (int m = 0; m < 4; ++m) { const int row = row0 + ai * 128 + m * 16; rm[m] = rinv[row];
#pragma unroll
                for (int bj = 0; bj < 2; ++bj) xr[m][bj] = *(const GAS v4u*)(xn + (size_t)row * D + col0 + bj * 128); }
#pragma unroll
            for (int m = 0; m < 4; ++m) { const int row = row0 + ai * 128 + m * 16; float sq = 0.f;
#pragma unroll
                for (int bj = 0; bj < 2; ++bj) { const v4u r = xr[m][bj]; f32x4 o0 = acc[ai][bj][m][0], o1 = acc[ai][bj][m][1];
                    o0[0] += bflo(r.x) * rm[m]; o0[1] += bfhi(r.x) * rm[m]; o0[2] += bflo(r.y) * rm[m]; o0[3] += bfhi(r.y) * rm[m];
                    o1[0] += bflo(r.z) * rm[m]; o1[1] += bfhi(r.z) * rm[m]; o1[2] += bflo(r.w) * rm[m]; o1[3] += bfhi(r.w) * rm[m];
                    *(GAS v4u*)(x1b + (size_t)row * D + col0 + bj * 128) = pack8(o0, o1);
                    sq += ((o0[0] * o0[0] + o0[1] * o0[1]) + (o0[2] * o0[2] + o0[3] * o0[3])) + ((o1[0] * o1[0] + o1[1] * o1[1]) + (o1[2] * o1[2] + o1[3] * o1[3])); }
                sq += __shfl_xor(sq, 16); sq += __shfl_xor(sq, 32);
                if (fq == 0) ss[(size_t)row * 16 + u.pn * 4 + wc] = sq; }
            asm volatile("" ::: "memory"); }
    }
};
struct FixedOrder {
    int pm, n;
    __device__ __forceinline__ bool next(int i, pg8::Unit& u) const { if (i >= n) return false; u.pm = pm; u.pn = i; u.aux = 0; return true; }
    __device__ __forceinline__ void a_ready(const pg8::Unit&) const {}
    __device__ __forceinline__ void done(const pg8::Unit&) const {}
};
struct EpiQx {
    static constexpr bool PERM = true, AFTER_DRAIN = false;
    bf16* qx; const LAS float* rs;
    __device__ __forceinline__ void operator()(const f32x4 (&acc)[2][2][4][2], const pg8::Unit& u, int wr, int wc, int fr, int fq) const {
        const int rl0 = wr * 64 + fr, col0 = wc * 32 + 8 * fq;
#pragma unroll
        for (int ai = 0; ai < 2; ++ai)
#pragma unroll
            for (int m = 0; m < 4; ++m) { const int rl = rl0 + ai * 128 + m * 16; const float sc = rs[rl]; bf16* rowp = qx + (size_t)(u.pm * 256 + rl) * 256 + col0;
#pragma unroll
                for (int bj = 0; bj < 2; ++bj) *(v4u*)(rowp + bj * 128) = pack8(acc[ai][bj][m][0] * sc, acc[ai][bj][m][1] * sc);
                asm volatile("" ::: "memory"); }
    }
};
struct EpiOx {
    static constexpr bool PERM = true, AFTER_DRAIN = false;
    const bf16* x1b; bf16* x2b; unsigned char* x2q;
    __device__ __forceinline__ void operator()(const f32x4 (&acc)[2][2][4][2], const pg8::Unit& u, int wr, int wc, int fr, int fq) const {
        int row0 = u.pm * 256 + wr * 64 + fr; asm volatile("" : "+v"(row0));
        const int col0 = u.pn * 256 + wc * 32 + 8 * fq;
#pragma unroll
        for (int ai = 0; ai < 2; ++ai) { v4u rr[4][2];
#pragma unroll
            for (int m = 0; m < 4; ++m)
#pragma unroll
                for (int bj = 0; bj < 2; ++bj) rr[m][bj] = *(const v4u*)(x1b + (size_t)(row0 + ai * 128 + m * 16) * D + col0 + bj * 128);
#pragma unroll
            for (int m = 0; m < 4; ++m)
#pragma unroll
                for (int bj = 0; bj < 2; ++bj) { const v4u r = rr[m][bj]; f32x4 o0 = acc[ai][bj][m][0], o1 = acc[ai][bj][m][1];
                    o0[0] += bflo(r.x); o0[1] += bfhi(r.x); o0[2] += bflo(r.y); o0[3] += bfhi(r.y); o1[0] += bflo(r.z); o1[1] += bfhi(r.z); o1[2] += bflo(r.w); o1[3] += bfhi(r.w);
                    *(v4u*)(x2b + (size_t)(row0 + ai * 128 + m * 16) * D + col0 + bj * 128) = pack8(o0, o1);
                    *(v2u*)(x2q + (size_t)(row0 + ai * 128 + m * 16) * D + col0 + bj * 128) = (v2u){pk4_fp8(o0[0], o0[1], o0[2], o0[3]), pk4_fp8(o1[0], o1[1], o1[2], o1[3])}; }
            asm volatile("" ::: "memory"); }
    }
};
__device__ __forceinline__ void cross_dma(const bf16* KV, int h, LAS unsigned char* buf, int lane, int wave) {
#pragma unroll
    for (int i = 0; i < 4; ++i) { const int inst = wave + 8 * i, row = 8 * inst + (lane >> 3);
        const bf16* src = KV + (size_t)row * NKV + h * 64 + ((lane & 7) ^ (lane >> 3)) * 8;
        glds16(src, (unsigned)__builtin_amdgcn_readfirstlane(lds_addr_of(buf + inst * 1024)));
        glds16(src + 256, (unsigned)__builtin_amdgcn_readfirstlane(lds_addr_of(buf + 32768 + inst * 1024))); }
}
__device__ __forceinline__ void ox_dma(const bf16* W, int blk, LAS unsigned char* buf, int lane, int wave) {
#pragma unroll
    for (int i = 0; i < 4; ++i) { const int inst = i * 8 + wave, rr = 2 * inst + (lane >> 5), pc = lane & 31;
        const bf16* src = W + (size_t)(64 * blk + rr) * 256 + ((pc ^ ((rr & 3) | (((rr >> 3) & 3) << 2))) * 8);
        glds16(src, (unsigned)__builtin_amdgcn_readfirstlane(lds_addr_of(buf + inst * 1024))); }
}
__device__ __forceinline__ void cross_unit(const Args& A, unsigned char* lds, int pm, int tid, int lane, int wave) {
    asm volatile("" : "+v"(tid), "+v"(lane));
    unsigned char* ws = A.ws; LAS unsigned char* L = (LAS unsigned char*)lds;
    const size_t t0 = (size_t)pm * 256; const int b = (int)(t0 / SEQ);
    const bf16* KV = (const bf16*)(ws + WS_KVX) + (size_t)b * MEMLEN * NKV;
    const int fr = lane & 15, g = lane >> 4;
    cross_dma(KV, 0, L, lane, wave);
    bf16x8 qc0, qc1;
    { const bf16* qg = (const bf16*)(ws + WS_QX) + (t0 + 32 * wave + fr) * 256; qc0 = *(const GAS bf16x8*)(qg + 8 * g); qc1 = *(const GAS bf16x8*)(qg + 32 + 8 * g); }
    for (int h = 0; h < 4; ++h) {
        asm volatile("s_waitcnt vmcnt(0)" ::: "memory");
        __syncthreads();
        LAS unsigned char* buf = L + (h & 1) * 65536;
        if (h < 3) cross_dma(KV, h + 1, L + ((h + 1) & 1) * 65536, lane, wave);
#pragma unroll 1
        for (int rt = 0; rt < 2; ++rt) {
            const size_t row = t0 + 32 * wave + 16 * rt + fr;
            const bf16x8 q0 = qc0, q1 = qc1;
            { const int h2 = rt ? h + 1 : h, rt2 = rt ^ 1;
              const bf16* qg = (const bf16*)(ws + WS_QX) + (t0 + 32 * wave + 16 * rt2 + fr) * 256 + (h2 < 4 ? h2 : 3) * 64;
              qc0 = *(const GAS bf16x8*)(qg + 8 * g); qc1 = *(const GAS bf16x8*)(qg + 32 + 8 * g); }
            f32x4 s[16];
#pragma unroll
            for (int t = 0; t < 16; ++t) { const int key = 16 * t + fr;
                s[t] = __builtin_amdgcn_mfma_f32_16x16x32_bf16(*(const LAS bf16x8*)(buf + key * 128 + (((g) ^ (key & 7)) * 16)), q0, (f32x4){0.f, 0.f, 0.f, 0.f}, 0, 0, 0);
                s[t] = __builtin_amdgcn_mfma_f32_16x16x32_bf16(*(const LAS bf16x8*)(buf + key * 128 + (((4 + g) ^ (key & 7)) * 16)), q1, s[t], 0, 0, 0); }
            float mx = -1e30f;
#pragma unroll
            for (int t = 0; t < 16; ++t) mx = fmaxf(fmaxf(mx, fmaxf(s[t][0], s[t][1])), fmaxf(s[t][2], s[t][3]));
            mx = fmaxf(mx, __shfl_xor(mx, 16)); mx = fmaxf(mx, __shfl_xor(mx, 32));
            float l = 0.f;
#pragma unroll
            for (int t = 0; t < 16; ++t)
#pragma unroll
                for (int e = 0; e < 4; ++e) { s[t][e] = __builtin_amdgcn_exp2f(s[t][e] - mx); l += s[t][e]; }
            l += __shfl_xor(l, 16); l += __shfl_xor(l, 32);
            f32x4 o[4];
#pragma unroll
            for (int dt = 0; dt < 4; ++dt) o[dt] = (f32x4){0.f, 0.f, 0.f, 0.f};
#pragma unroll
            for (int k8 = 0; k8 < 8; ++k8) {
                const v4u pw = (v4u){pk2(s[2 * k8][0], s[2 * k8][1]), pk2(s[2 * k8][2], s[2 * k8][3]), pk2(s[2 * k8 + 1][0], s[2 * k8 + 1][1]), pk2(s[2 * k8 + 1][2], s[2 * k8 + 1][3])};
                const bf16x8 pf = __builtin_bit_cast(bf16x8, pw);
                const int r0 = 32 * k8 + 4 * g + (fr >> 2), r1 = r0 + 16, p_ = fr & 3;
#pragma unroll
                for (int dt = 0; dt < 4; ++dt) { const int chunk = 2 * dt + (p_ >> 1);
                    const v4i16_t v0 = __builtin_amdgcn_ds_read_tr16_b64_v4i16((LAS v4i16_t*)(buf + 32768 + r0 * 128 + ((chunk ^ (r0 & 7)) * 16) + 8 * (p_ & 1)));
                    const v4i16_t v1 = __builtin_amdgcn_ds_read_tr16_b64_v4i16((LAS v4i16_t*)(buf + 32768 + r1 * 128 + ((chunk ^ (r1 & 7)) * 16) + 8 * (p_ & 1)));
                    const bf16x8 vf = (bf16x8){v0[0], v0[1], v0[2], v0[3], v1[0], v1[1], v1[2], v1[3]};
                    o[dt] = __builtin_amdgcn_mfma_f32_16x16x32_bf16(vf, pf, o[dt], 0, 0, 0); } }
            const float rl = frcp_(l);
            bf16* og = (bf16*)(ws + WS_OX) + row * 256 + h * 64;
#pragma unroll
            for (int dt = 0; dt < 4; ++dt) *(v2u*)(og + 16 * dt + 4 * g) = (v2u){pk2(o[dt][0] * rl, o[dt][1] * rl), pk2(o[dt][2] * rl, o[dt][3] * rl)};
        }
    }
    asm volatile("s_waitcnt vmcnt(0) lgkmcnt(0)" ::: "memory");
    __builtin_amdgcn_fence(__ATOMIC_ACQUIRE, "agent");
    __syncthreads();
    const bf16* W = (const bf16*)(ws + WS_WOX);
    const bf16* x1b = (const bf16*)(ws + WS_X1B); bf16* x2b = (bf16*)(ws + WS_HBS); unsigned char* x2q = ws + WS_X2Q;
    bf16x8 af[2][8];
#pragma unroll
    for (int rt = 0; rt < 2; ++rt)
#pragma unroll
        for (int ks = 0; ks < 8; ++ks) af[rt][ks] = *(const GAS bf16x8*)((const bf16*)(ws + WS_OX) + (t0 + 32 * wave + 16 * rt + fr) * 256 + 32 * ks + 8 * g);
    v4u x1[2][2], x1n[2][2];
#pragma unroll
    for (int rt = 0; rt < 2; ++rt)
#pragma unroll
        for (int pp = 0; pp < 2; ++pp) x1[rt][pp] = *(const GAS v4u*)(x1b + (t0 + 32 * wave + 16 * rt + fr) * D + 32 * pp + 8 * g);
    asm volatile("" ::: "memory");
    ox_dma(W, 0, L, lane, wave); ox_dma(W, 1, L + 32768, lane, wave);
    const int rA = 8 * (fr >> 2) + (fr & 3);
#pragma unroll 1
    for (int blk = 0; blk < 16; ++blk) {
        if (blk == 0) asm volatile("s_waitcnt vmcnt(4)" ::: "memory"); else asm volatile("s_waitcnt vmcnt(12)" ::: "memory");
        __syncthreads();
        { const int bn = blk + 1 < 16 ? blk + 1 : 15;
#pragma unroll
          for (int rt = 0; rt < 2; ++rt)
#pragma unroll
              for (int pp = 0; pp < 2; ++pp) x1n[rt][pp] = *(const GAS v4u*)(x1b + (t0 + 32 * wave + 16 * rt + fr) * D + 64 * bn + 32 * pp + 8 * g); }
        asm volatile("" ::: "memory");
        if (blk + 2 < 16) ox_dma(W, blk + 2, L + ((blk + 2) & 3) * 32768, lane, wave);
        LAS unsigned char* wb = L + (blk & 3) * 32768;
        f32x4 accs[2][2][2];
        frag_pipe<4, 8>(
            [&](bf16x8 (&f)[8], int nt) __attribute__((always_inline)) { const int r = 32 * (nt >> 1) + rA + 4 * (nt & 1);
#pragma unroll
                for (int ks = 0; ks < 8; ++ks) f[ks] = *(const LAS bf16x8*)(wb + r * 512 + (((4 * ks + g) ^ fr) * 16)); },
            [&](bf16x8 (&f)[8], int nt) __attribute__((always_inline)) {
#pragma unroll
                for (int rt = 0; rt < 2; ++rt) { f32x4 acc = (f32x4){0.f, 0.f, 0.f, 0.f};
#pragma unroll
                    for (int ks = 0; ks < 8; ++ks) acc = __builtin_amdgcn_mfma_f32_16x16x32_bf16(f[ks], af[rt][ks], acc, 0, 0, 0);
                    accs[nt >> 1][rt][nt & 1] = acc; } });
#pragma unroll
        for (int pp = 0; pp < 2; ++pp)
#pragma unroll
            for (int rt = 0; rt < 2; ++rt) { const v4u xr = x1[rt][pp]; f32x4 o0 = accs[pp][rt][0], o1 = accs[pp][rt][1];
                o0[0] += bflo(xr.x); o0[1] += bfhi(xr.x); o0[2] += bflo(xr.y); o0[3] += bfhi(xr.y); o1[0] += bflo(xr.z); o1[1] += bfhi(xr.z); o1[2] += bflo(xr.w); o1[3] += bfhi(xr.w);
                const size_t off = (t0 + 32 * wave + 16 * rt + fr) * D + 64 * blk + 32 * pp + 8 * g;
                *(GAS v4u*)(x2b + off) = pack8(o0, o1);
                *(GAS v2u*)(x2q + off) = (v2u){pk4_fp8(o0[0], o0[1], o0[2], o0[3]), pk4_fp8(o1[0], o1[1], o1[2], o1[3])}; }
#pragma unroll
        for (int rt = 0; rt < 2; ++rt)
#pragma unroll
            for (int pp = 0; pp < 2; ++pp) x1[rt][pp] = x1n[rt][pp];
    }
    asm volatile("s_waitcnt vmcnt(0)" ::: "memory");
    __syncthreads();
}

struct TokInfo { int bucket; float wa, wb; int rank; };
constexpr size_t WS_RSTD3 = 18 * MiB;
constexpr size_t WS_CNTTAB = 31 * MiB + 512 * 1024;
__device__ __forceinline__ void p9_route(const Args& A, unsigned char* lds_, int tid, int lane, int wave) {
    asm volatile("" : "+v"(tid), "+v"(lane));
    unsigned char* ws = A.ws; LAS unsigned char* lds = (LAS unsigned char*)lds_;
    const float* b_rg = (const float*)(ws + WS_PAR) + PAR_BRG; const float* b_re = (const float*)(ws + WS_PAR) + PAR_BRE;
    constexpr int WLD = 2064;
    LAS unsigned char* Wh = lds; LAS unsigned char* Wl = lds + 20 * WLD;
    LAS float* lg = (LAS float*)(lds + 2 * 20 * WLD) + wave * (32 * 24);
    LAS int* bkl = (LAS int*)(lds + 2 * 20 * WLD + 8 * 32 * 24 * 4);
    for (int id = tid; id < 2 * 20 * 128; id += NTHR) { const int t = id / 2560, row = (id % 2560) >> 7, ch = id & 127;
        *(LAS v4u*)(lds + (t * 20 + row) * WLD + ch * 16) = *(const v4u*)((const bf16*)(ws + WS_WR) + ((size_t)t * 32 + row) * 1024 + ch * 8); }
    __syncthreads();
    const bf16* X2B = (const bf16*)(ws + WS_HBS);
    const int fr = lane & 15, g = lane >> 4;
    for (int chunk = blockIdx.x; chunk < T / 256; chunk += gridDim.x) {
        const bf16* xa = X2B + ((size_t)chunk * 256 + 32 * wave + fr) * D + 8 * g;
        f32x4 acc[2][2]; float sq[2] = {0.f, 0.f};
#pragma unroll
        for (int rt = 0; rt < 2; ++rt) { acc[rt][0] = (f32x4){0.f, 0.f, 0.f, 0.f}; acc[rt][1] = (f32x4){0.f, 0.f, 0.f, 0.f}; }
#pragma unroll 8
        for (int ks = 0; ks < 32; ++ks) {
            const bf16x8 a0 = *(const bf16x8*)(xa + 32 * ks), a1 = *(const bf16x8*)(xa + 16 * D + 32 * ks);
            { const v4u w0 = __builtin_bit_cast(v4u, a0), w1 = __builtin_bit_cast(v4u, a1);
              sq[0] += (bflo(w0.x) * bflo(w0.x) + bfhi(w0.x) * bfhi(w0.x)) + (bflo(w0.y) * bflo(w0.y) + bfhi(w0.y) * bfhi(w0.y)) + (bflo(w0.z) * bflo(w0.z) + bfhi(w0.z) * bfhi(w0.z)) + (bflo(w0.w) * bflo(w0.w) + bfhi(w0.w) * bfhi(w0.w));
              sq[1] += (bflo(w1.x) * bflo(w1.x) + bfhi(w1.x) * bfhi(w1.x)) + (bflo(w1.y) * bflo(w1.y) + bfhi(w1.y) * bfhi(w1.y)) + (bflo(w1.z) * bflo(w1.z) + bfhi(w1.z) * bfhi(w1.z)) + (bflo(w1.w) * bflo(w1.w) + bfhi(w1.w) * bfhi(w1.w)); }
#pragma unroll
            for (int ct = 0; ct < 2; ++ct) { const int wrow = (16 * ct + fr < 20) ? 16 * ct + fr : fr;
                const bf16x8 bh = *(const LAS bf16x8*)(Wh + wrow * WLD + 64 * ks + 16 * g), bl = *(const LAS bf16x8*)(Wl + wrow * WLD + 64 * ks + 16 * g);
                acc[0][ct] = __builtin_amdgcn_mfma_f32_16x16x32_bf16(bh, a0, acc[0][ct], 0, 0, 0); acc[0][ct] = __builtin_amdgcn_mfma_f32_16x16x32_bf16(bl, a0, acc[0][ct], 0, 0, 0);
                acc[1][ct] = __builtin_amdgcn_mfma_f32_16x16x32_bf16(bh, a1, acc[1][ct], 0, 0, 0); acc[1][ct] = __builtin_amdgcn_mfma_f32_16x16x32_bf16(bl, a1, acc[1][ct], 0, 0, 0); } }
#pragma unroll
        for (int rt = 0; rt < 2; ++rt) { sq[rt] += __shfl_xor(sq[rt], 16); sq[rt] += __shfl_xor(sq[rt], 32);
            LAS float* lr = lg + (16 * rt + fr) * 24;
            *(LAS f32x4*)(lr + 4 * g) = acc[rt][0];
            if (g == 0) { *(LAS f32x4*)(lr + 16) = acc[rt][1]; lr[20] = 1.0f / sqrtf(sq[rt] * (1.0f / D) + EPSN); } }
        asm volatile("s_waitcnt lgkmcnt(0)" ::: "memory");
        if (lane < 32) { const LAS float* lr = lg + lane * 24; const float rstd = lr[20];
            float gl4[4];
#pragma unroll
            for (int i = 0; i < 4; ++i) gl4[i] = lr[i] * rstd + b_rg[i];
            int gsel = 0; float gm = gl4[0];
#pragma unroll
            for (int i = 1; i < 4; ++i) if (gl4[i] > gm) { gm = gl4[i]; gsel = i; }
            float gs = 0.f;
#pragma unroll
            for (int i = 0; i < 4; ++i) gs += __expf(gl4[i] - gm);
            const float gw_ = 1.0f / gs;
            float el[4];
#pragma unroll
            for (int i = 0; i < 4; ++i) el[i] = lr[4 + 4 * gsel + i] * rstd + b_re[gsel * 4 + i];
            int i0 = 0; float v0 = el[0];
#pragma unroll
            for (int i = 1; i < 4; ++i) if (el[i] > v0) { v0 = el[i]; i0 = i; }
            int i1 = -1; float v1 = -INFINITY;
#pragma unroll
            for (int i = 0; i < 4; ++i) if (i != i0 && el[i] > v1) { v1 = el[i]; i1 = i; }
            const float e1 = __expf(v1 - v0); const float w0 = gw_ / (1.0f + e1), w1 = gw_ * e1 / (1.0f + e1);
            const int pa = i0 < i1 ? i0 : i1, pb = i0 < i1 ? i1 : i0;
            const int pidx = (pa == 0) ? (pb - 1) : (pa == 1 ? pb + 1 : 5);
            const int r = 32 * wave + lane;
            ((float*)(ws + WS_RSTD3))[chunk * 256 + r] = rstd; bkl[r] = gsel * 6 + pidx; ((LAS float*)(bkl + 256))[r] = (i0 < i1) ? w0 : w1; ((LAS float*)(bkl + 512))[r] = (i0 < i1) ? w1 : w0; }
        __syncthreads();
        if (tid < 256) { const int my = bkl[tid]; int rank = 0; for (int j = 0; j < tid; ++j) rank += (bkl[j] == my) ? 1 : 0;
            TokInfo ti; ti.bucket = my; ti.wa = ((LAS float*)(bkl + 256))[tid]; ti.wb = ((LAS float*)(bkl + 512))[tid]; ti.rank = rank;
            ((TokInfo*)(ws + WS_TOKINFO))[chunk * 256 + tid] = ti; }
        else if (tid < 256 + NBUCKET) { const int b = tid - 256; int c = 0; for (int j = 0; j < 256; ++j) c += (bkl[j] == b) ? 1 : 0;
            ((int*)(ws + WS_CNTTAB))[chunk * NBUCKET + b] = c; }
        __syncthreads();
    }
}
__device__ __forceinline__ void p10_slots(const Args& A, unsigned char* lds, int tid, int lane, int wave) {
    unsigned char* ws = A.ws;
    LAS int* tabl = (LAS int*)lds;
    LAS int* totl = (LAS int*)(lds + 32768);
    const int* CNTTAB = (const int*)(ws + WS_CNTTAB);
    for (int i = tid; i < 256 * NBUCKET; i += NTHR) tabl[i] = CNTTAB[i];
    __syncthreads();
    if (tid < NBUCKET) { int t = 0; for (int w = 0; w < 256; ++w) t += tabl[w * NBUCKET + tid]; totl[tid] = t; }
    __syncthreads();
    if (tid == 0) { int acc = 0; for (int b = 0; b < NBUCKET; ++b) { totl[32 + b] = acc; acc += ((totl[b] + 255) >> 8) * 256; } totl[32 + NBUCKET] = acc; }
    if (blockIdx.x == 0 && tid < NBUCKET) ((unsigned*)(ws + WS_CTL))[CW_CNT + tid] = (unsigned)totl[tid];
    __syncthreads();
    int* TOKMAP = (int*)(ws + WS_TOKMAP); float* WSORT = (float*)(ws + WS_WSORT);
    for (int chunk = blockIdx.x; chunk < T / 256; chunk += gridDim.x) {
        if (tid < NBUCKET) { int s = 0; for (int w = 0; w < chunk; ++w) s += tabl[w * NBUCKET + tid]; totl[64 + tid] = totl[32 + tid] + s; }
        __syncthreads();
        if (tid < 256) { const int m = chunk * 256 + tid; const TokInfo ti = ((const TokInfo*)(ws + WS_TOKINFO))[m]; const int slot = totl[64 + ti.bucket] + ti.rank;
            TOKMAP[slot] = m; *(f32x4*)(WSORT + 4 * slot) = (f32x4){ti.wa, ti.wb, ((const float*)(ws + WS_RSTD3))[m], 0.f}; }
        __syncthreads();
    }
    for (int b = blockIdx.x; b < NBUCKET; b += gridDim.x)
        for (int r = totl[32 + b] + totl[b] + tid; r < totl[32 + b + 1]; r += NTHR) { TOKMAP[r] = -1; *(f32x4*)(WSORT + 4 * r) = (f32x4){0.f, 0.f, 0.f, 0.f}; }
}
struct MoeOrder {
    int G, c, nunits, ncol; const int* tab;
    __device__ __forceinline__ bool next(int i, pg8::Unit& u) const {
        const long L = (long)i * G + c; if (L >= nunits) return false;
        const int rt = (int)L / ncol, j = (int)L % ncol, bk = tab[rt];
        u.pm = rt; u.aux = j;
        if (ncol == 8) { const int g = bk / 6, p = bk % 6; const int pa = (p < 3) ? 0 : (p < 5 ? 1 : 2), pb = (p < 3) ? p + 1 : (p < 5 ? p - 1 : 3);
            const int e = 4 * g + ((j >> 2) ? pb : pa); u.pn = e * 4 + (j & 3); }
        else u.pn = bk * 4 + j;
        return true;
    }
    __device__ __forceinline__ void a_ready(const pg8::Unit&) const {}
    __device__ __forceinline__ void done(const pg8::Unit&) const {}
};
struct EpiUp {
    static constexpr bool PERM = true, AFTER_DRAIN = false;
    unsigned char* act; const float* wsort;
    __device__ __forceinline__ void operator()(const f32x4 (&acc)[2][2][4][2], const pg8::Unit& u, int wr, int wc, int fr, int fq) const {
        int row0 = u.pm * 256 + wr * 64 + fr; asm volatile("" : "+v"(row0));
        const int half = u.aux >> 2, col0 = half * 512 + (u.aux & 3) * 128 + wc * 32 + 8 * fq;
#pragma unroll
        for (int ai = 0; ai < 2; ++ai)
#pragma unroll
            for (int m = 0; m < 4; ++m) { const int row = row0 + ai * 128 + m * 16; const float w = wsort[4 * row + half] * 16.0f, rs = wsort[4 * row + 2] * (1.0f / 64.0f);
                f32x4 r0, r1;
#pragma unroll
                for (int i = 0; i < 4; ++i) { const float a0 = acc[ai][0][m][0][i] * rs, a1 = acc[ai][0][m][1][i] * rs;
                    r0[i] = a0 * sigmoidf_(a0) * (acc[ai][1][m][0][i] * rs) * w; r1[i] = a1 * sigmoidf_(a1) * (acc[ai][1][m][1][i] * rs) * w; }
                *(v2u*)(act + (size_t)row * D + col0) = (v2u){pk4_fp8(r0[0], r0[1], r0[2], r0[3]), pk4_fp8(r1[0], r1[1], r1[2], r1[3])}; }
    }
};
struct EpiDown {
    static constexpr bool PERM = true, AFTER_DRAIN = false;
    const bf16* x2b; float* xo; const int* tokmap;
    __device__ __forceinline__ void operator()(const f32x4 (&acc)[2][2][4][2], const pg8::Unit& u, int wr, int wc, int fr, int fq) const {
        const int row0 = u.pm * 256 + wr * 64 + fr, col0 = u.aux * 256 + wc * 32 + 8 * fq;
#pragma unroll
        for (int ai = 0; ai < 2; ++ai)
#pragma unroll
            for (int m = 0; m < 4; ++m) { const int tok = tokmap[row0 + ai * 128 + m * 16];
                if (tok >= 0) {
#pragma unroll
                    for (int bj = 0; bj < 2; ++bj) { const size_t off = (size_t)tok * D + col0 + bj * 128; const v4u r = *(const v4u*)(x2b + off);
                        f32x4 o0 = acc[ai][bj][m][0], o1 = acc[ai][bj][m][1];
                        o0[0] += bflo(r.x); o0[1] += bfhi(r.x); o0[2] += bflo(r.y); o0[3] += bfhi(r.y); o1[0] += bflo(r.z); o1[1] += bfhi(r.z); o1[2] += bflo(r.w); o1[3] += bfhi(r.w);
                        *(f32x4*)(xo + off) = o0; *(f32x4*)(xo + off + 4) = o1; } } }
    }
};
constexpr size_t WS_XCH = 20 * MiB + 512 * 1024;
constexpr int CW_SEAM = 16384;
constexpr int LDS_EX = 139264;
struct EpiDownNorm {
    static constexpr bool PERM = true, AFTER_DRAIN = false;
    const bf16* x2b; float* out; const int* tokmap; const float* gfin; float* xch; unsigned* cnt; LAS unsigned char* ex; int wv;
    __device__ __forceinline__ void operator()(const f32x4 (&acc_)[2][2][4][2], const pg8::Unit& u, int wr, int wc, int fr, int fq) const {
        f32x4 (&acc)[2][2][4][2] = const_cast<f32x4 (&)[2][2][4][2]>(acc_);
        int tid = wv * 64 + lane_id_(); asm volatile("" : "+v"(tid));
        const int lane = tid & 63, wid = wv;
        int rb = wr * 64 + fr; asm volatile("" : "+v"(rb));
        LAS float* P = (LAS float*)ex; LAS float* S = (LAS float*)(ex + 4096); LAS unsigned* flag = (LAS unsigned*)(ex + 6144);
        const int col0 = u.aux * 256 + wc * 32 + 8 * fq;
        int tok[8];
#pragma unroll
        for (int i = 0; i < 8; ++i) tok[i] = tokmap[u.pm * 256 + rb + (i >> 2) * 128 + (i & 3) * 16];
#pragma unroll
        for (int ai = 0; ai < 2; ++ai) { v4u rr[4][2];
#pragma unroll
            for (int m = 0; m < 4; ++m) { const int tk = tok[ai * 4 + m] < 0 ? 0 : tok[ai * 4 + m];
#pragma unroll
                for (int bj = 0; bj < 2; ++bj) rr[m][bj] = *(const v4u*)(x2b + (size_t)tk * D + col0 + bj * 128); }
#pragma unroll
            for (int m = 0; m < 4; ++m) { const int rl = rb + ai * 128 + m * 16; const bool ok = tok[ai * 4 + m] >= 0; float sq = 0.f;
#pragma unroll
                for (int bj = 0; bj < 2; ++bj) { f32x4& o0 = acc[ai][bj][m][0]; f32x4& o1 = acc[ai][bj][m][1]; const v4u r = rr[m][bj]; o0 = o0 * (1.0f / 1024.0f); o1 = o1 * (1.0f / 1024.0f);
                    if (ok) { o0[0] += bflo(r.x); o0[1] += bfhi(r.x); o0[2] += bflo(r.y); o0[3] += bfhi(r.y); o1[0] += bflo(r.z); o1[1] += bfhi(r.z); o1[2] += bflo(r.w); o1[3] += bfhi(r.w); }
                    sq += ((o0[0] * o0[0] + o0[1] * o0[1]) + (o0[2] * o0[2] + o0[3] * o0[3])) + ((o1[0] * o1[0] + o1[1] * o1[1]) + (o1[2] * o1[2] + o1[3] * o1[3])); }
                sq += __shfl_xor(sq, 16); sq += __shfl_xor(sq, 32);
                if (fq == 0) P[rl * 4 + wc] = sq; }
            asm volatile("" ::: "memory"); }
        asm volatile("s_waitcnt lgkmcnt(0)" ::: "memory"); __builtin_amdgcn_s_barrier(); asm volatile("" ::: "memory");
        if (tid < 256) { const f32x4 p = *(const LAS f32x4*)(P + tid * 4);
            __hip_atomic_store(xch + ((size_t)u.pm * 256 + tid) * 4 + u.aux, (p[0] + p[1]) + (p[2] + p[3]), __ATOMIC_RELAXED, __HIP_MEMORY_SCOPE_AGENT); }
        asm volatile("s_waitcnt vmcnt(0)" ::: "memory");
        if (wid < 4 && lane == 0) __hip_atomic_fetch_add(cnt + 64 * u.pm, 1u, __ATOMIC_RELAXED, __HIP_MEMORY_SCOPE_AGENT);
        if (wid == 0) { unsigned spins = 0;
            while ((unsigned)__builtin_amdgcn_readfirstlane(__hip_atomic_load(cnt + 64 * u.pm, __ATOMIC_RELAXED, __HIP_MEMORY_SCOPE_AGENT)) < 16u) { __builtin_amdgcn_s_sleep(2); if (++spins > (1u << 22)) break; }
            __builtin_amdgcn_fence(__ATOMIC_ACQUIRE, "agent");
            if (lane == 0) flag[0] = spins; }
        asm volatile("s_waitcnt vmcnt(0) lgkmcnt(0)" ::: "memory"); __builtin_amdgcn_s_barrier(); asm volatile("" ::: "memory");
        if (tid < 256) { const float* sl = xch + ((size_t)u.pm * 256 + tid) * 4; float t = 0.f;
#pragma unroll
            for (int k = 0; k < 4; ++k) t += __hip_atomic_load(sl + k, __ATOMIC_RELAXED, __HIP_MEMORY_SCOPE_AGENT);
            S[tid] = 1.0f / sqrtf(t * (1.0f / D) + EPSN); }
        asm volatile("s_waitcnt lgkmcnt(0)" ::: "memory"); __builtin_amdgcn_s_barrier(); asm volatile("" ::: "memory");
#pragma unroll
        for (int ai = 0; ai < 2; ++ai)
#pragma unroll
            for (int m = 0; m < 4; ++m) { const int rl = rb + ai * 128 + m * 16; const int tk = tok[ai * 4 + m]; const float rs = S[rl];
                if (tk >= 0) {
#pragma unroll
                    for (int bj = 0; bj < 2; ++bj)
#pragma unroll
                        for (int n = 0; n < 2; ++n) { const int cc = col0 + bj * 128 + 4 * n; acc[ai][bj][m][n] = acc[ai][bj][m][n] * rs; acc[ai][bj][m][n] = acc[ai][bj][m][n] * *(const f32x4*)(gfin + cc);
                            *(f32x4*)(out + (size_t)tk * D + cc) = acc[ai][bj][m][n];
#ifdef PROBE_ST2
                            asm volatile("" ::: "memory"); *(volatile f32x4*)(out + (size_t)tk * D + cc) = acc[ai][bj][m][n];
#endif
                            } } }
    }
};
__device__ __forceinline__ void p10_final(const Args& A, float* outp, int lane, int wave) {
    const float* g_final = (const float*)(A.ws + WS_PAR) + PAR_GFIN;
    const int G = gridDim.x, gw = blockIdx.x * NWAVES + wave, NGW = G * NWAVES;
    f32x4 gv[4];
#pragma unroll
    for (int j = 0; j < 4; ++j) gv[j] = *((const f32x4*)g_final + lane + 64 * j);
    for (int m = gw; m < T; m += NGW) {
        f32x4* xr = (f32x4*)(A.out + (size_t)m * D) + lane;
        f32x4 v[4]; float s = 0.f;
#pragma unroll
        for (int j = 0; j < 4; ++j) { v[j] = xr[64 * j]; s += (v[j].x * v[j].x + v[j].y * v[j].y) + (v[j].z * v[j].z + v[j].w * v[j].w); }
        const float rstd = 1.0f / sqrtf(wave_sum(s) * (1.0f / D) + EPSN);
#pragma unroll
        for (int j = 0; j < 4; ++j) ((f32x4*)(outp + (size_t)m * D) + lane)[64 * j] = v[j] * rstd * gv[j];
    }
}

#ifndef MS
#define MS 4
#endif
#ifndef N_LAUNCHES
#define N_LAUNCHES 1
#endif
constexpr int N_PHASES = 14;
#ifndef STAGGER
#define STAGGER 0
#endif
#ifndef STAGGER12
#define STAGGER12 4
#endif
#ifndef FUSE_FINAL
#define FUSE_FINAL 1
#endif
#ifndef DUP_MASK
#define DUP_MASK 0
#endif
#define REP(k) for (int rep_ = 0; rep_ < (((DUP_MASK >> (k)) & 1) ? 2 : 1); ++rep_)
#ifndef QX_SP2
#define QX_SP2 false
#endif

#ifndef NVG
#define NVG 256
#endif
__global__ void __launch_bounds__(NTHR, 2) __attribute__((amdgpu_num_vgpr(NVG))) fwd_kernel(Args args) {
    __shared__ __attribute__((aligned(16))) unsigned char lds[LDS_BYTES];
    const int wave = __builtin_amdgcn_readfirstlane((int)threadIdx.x >> 6), lane = lane_id_(), tid = wave * 64 + lane;
    gu32* ctl = (gu32*)(args.ws + WS_CTL);
    for (int u = tid; u < (LDS_BYTES - LDS_MISC) / 4; u += NTHR) ((unsigned*)(lds + LDS_MISC))[u] = 0u;
    __syncthreads();
    const int lo = args.ph_lo, hi = args.ph_hi;
    const bool use_bar = (hi - lo) > 1;
    XcdBarrier bar; bar.bar = (unsigned*)ctl + CW_BAR; bar.x = 0; bar.st = (volatile LAS unsigned*)(lds + LDS_MISC) + 8; bar.wv = wave;
    if (use_bar) bar = xcd_barrier_post((unsigned*)ctl + CW_BAR, (volatile LAS unsigned*)(lds + LDS_MISC) + 8, wave);
#ifndef PH_MASK
#define PH_MASK 0xFFFF
#endif
#define IN(k) (((PH_MASK >> (k)) & 1) && lo <= (k) && (k) < hi)
#define SEAM(k) do { if (IN(k) && IN((k) + 1)) xcd_barrier(bar); } while (0)
    PG8_LAS unsigned char* ring = (PG8_LAS unsigned char*)lds;
    const int G = gridDim.x;
#define PHASE_PTRS Args pa = args; { unsigned char* w_ = args.ws; float* o_ = args.out; asm volatile("" : "+s"(w_), "+s"(o_)); pa.ws = w_; pa.out = o_; } unsigned char* const ws = pa.ws; (void)ws; int tid = wave * 64 + lane_id_(); asm volatile("" : "+v"(tid)); const int lane = tid & 63; (void)lane

#ifdef DUMMY_LIVE
    float dl0, dl1, dl2, dl3, dl4, dl5, dl6, dl7; asm volatile("" : "=v"(dl0), "=v"(dl1), "=v"(dl2), "=v"(dl3), "=v"(dl4), "=v"(dl5), "=v"(dl6), "=v"(dl7));
#endif
    if (IN(0)) { PHASE_PTRS; REP(0) { p0_prologue(pa, lds, tid, lane, wave); __syncthreads(); } }
    SEAM(0);
    if (IN(1) && MS >= 1) { PHASE_PTRS;
        pg8::Gemm g{(const pg8::bf16_t*)(ws + WS_X8), (const pg8::bf16_t*)(ws + WS_WIN8), T, NIN, D};
        pg8::StaticOrder S; S.init(T, NIN, G, (int)blockIdx.x);
        EpiInProj E{(bf16*)(ws + WS_Q), (const float*)(ws + WS_ROPE), (const float*)(ws + WS_RS8), (const unsigned*)(ws + WS_CTL) + CW_CMAX};
        REP(1) pg8::gemm_phase<EpiInProj, pg8::StaticOrder, true, true, false, 2>(ring, g, S, E, wave);
    }
    SEAM(1);
    if (IN(2) && MS >= 1) { PHASE_PTRS;
        const int n_att = (MS >= 2) ? 3 * 4096 : 0;
        for (int tile = blockIdx.x; tile < 256; tile += G) kv_tile(pa, lds, tile, tid, lane, wave);
        __syncthreads();
        REP(14) attn_phase(pa, lds, n_att, lane, wave);
        REP(2) { int wres = -1; MGroup mg; __syncthreads(); for (int it = blockIdx.x * 8; it < 2048; it += G * 8) for (int q = 0; q < 8; ++q) mlstm_p1_item(pa, lds, it + q, wres, mg, tid, lane, wave); }
    }
    if (IN(2) && IN(4)) xcd_barrier(bar);
    if (IN(4) && MS >= 1) { PHASE_PTRS;
        REP(4) {
        REP(3) for (int rt = blockIdx.x; rt < T / 256; rt += G) combine_rows(pa, (size_t)rt * 256, 256, tid);
        for (int it = blockIdx.x * 8; it < 2048; it += G * 8) { MState st; mlstm2_entry(pa, it >> 6, (it & 63) >> 3, st, lane, wave);
            const MState st0 = st; REP(6) { st = st0; for (int q = 0; q < 8; ++q) mlstm_p2_item(pa, lds, it + q, st, tid, lane, wave); } }
        }
    }
    SEAM(4);
    if (IN(5) && MS >= 1) { PHASE_PTRS;
        const int pm = (int)blockIdx.x;
        if (pm < T / 256) {
            { pg8::Gemm g{(const pg8::bf16_t*)(ws + WS_Y), (const pg8::bf16_t*)(ws + WS_WOUT), T, D, D};
              FixedOrder S{pm, 4}; EpiOutProj E{(const bf16*)(ws + WS_XN), (const float*)(ws + WS_RINV), (bf16*)(ws + WS_X1B), (float*)(ws + WS_SS1)};
              pg8::gemm_phase<EpiOutProj, FixedOrder, true, true>(ring, g, S, E, wave); }
            VM_WAIT(); __syncthreads();
            float* rs = (float*)(lds + LDS_RS);
            if (tid < 256) { const f32x4* sp = (const f32x4*)((const float*)(ws + WS_SS1) + (size_t)(pm * 256 + tid) * 16);
                const f32x4 a = sp[0], b = sp[1], c = sp[2], d = sp[3];
                const float s = ((a[0] + a[1]) + (a[2] + a[3])) + ((b[0] + b[1]) + (b[2] + b[3])) + ((c[0] + c[1]) + (c[2] + c[3])) + ((d[0] + d[1]) + (d[2] + d[3]));
                rs[tid] = 1.0f / sqrtf(s * (1.0f / D) + EPSN); }
            __syncthreads();
            { pg8::Gemm g{(const pg8::bf16_t*)(ws + WS_X1B), (const pg8::bf16_t*)(ws + WS_WQX), T, 256, D};
              FixedOrder S{pm, 1}; EpiQx E{(bf16*)(ws + WS_QX), (const LAS float*)rs};
              pg8::gemm_phase<EpiQx, FixedOrder, true, QX_SP2>(ring, g, S, E, wave); }
            VM_WAIT(); __syncthreads();
            cross_unit(pa, lds, pm, tid, lane, wave);
            VM_WAIT(); __builtin_amdgcn_fence(__ATOMIC_ACQUIRE, "agent"); VM_WAIT(); __syncthreads();
        }
        if (MS >= 4) p9_route(pa, lds, tid, lane, wave);
    }
    SEAM(9);
    if (IN(10) && MS >= 4) { PHASE_PTRS; p10_slots(pa, lds, tid, lane, wave); }
    SEAM(10);
    if ((IN(11) || IN(12)) && MS >= 4) { PHASE_PTRS;
        int* tab = (int*)(lds + LDS_TAB);
        if (tid == 0) { int nrt = 0; const unsigned* cnt = (const unsigned*)(ws + WS_CTL) + CW_CNT;
            for (int i = 0; i < NBUCKET; ++i) { const int nt = (int)((__hip_atomic_load(cnt + i, __ATOMIC_RELAXED, __HIP_MEMORY_SCOPE_AGENT) + 255u) >> 8); for (int k = 0; k < nt; ++k) tab[1 + nrt++] = i; }
            tab[0] = nrt; }
        __syncthreads();
        const int nrt = tab[0];
        if (IN(11)) {
            if (STAGGER && ((blockIdx.x >> 2) & 1)) { for (int i = 0; i < STAGGER; ++i) __builtin_amdgcn_s_sleep(127); }
            pg8::Gemm g{(const pg8::bf16_t*)(ws + WS_X2Q), (const pg8::bf16_t*)(ws + WS_W13Q), ROWS_MAX, 64 * 256, D, (const int*)(ws + WS_TOKMAP)};
            MoeOrder S{G, (int)blockIdx.x, nrt * 8, 8, tab + 1};
            EpiUp E{(unsigned char*)(ws + WS_ACT), (const float*)(ws + WS_WSORT)};
            REP(11) pg8::gemm_phase<EpiUp, MoeOrder, true, true, true, 1>(ring, g, S, E, wave);
        }
        SEAM(11);
        if (IN(12)) {
            if (STAGGER12 && (int)blockIdx.x >= ((nrt * 4) % G) && ((blockIdx.x >> 2) & 1)) { for (int i = 0; i < STAGGER12; ++i) __builtin_amdgcn_s_sleep(127); }
            pg8::Gemm g{(const pg8::bf16_t*)(ws + WS_ACT), (const pg8::bf16_t*)(ws + WS_W2P), ROWS_MAX, 96 * 256, D};
            MoeOrder S{G, (int)blockIdx.x, nrt * 4, 4, tab + 1};
#if FUSE_FINAL
            EpiDownNorm E{(const bf16*)(ws + WS_HBS), pa.out, (const int*)(ws + WS_TOKMAP), (const float*)(ws + WS_PAR) + PAR_GFIN, (float*)(ws + WS_XCH), (unsigned*)(ws + WS_CTL) + CW_SEAM, (LAS unsigned char*)(lds + LDS_EX), wave};
            pg8::gemm_phase<EpiDownNorm, MoeOrder, true, true, false, 1>(ring, g, S, E, wave);
#else
            EpiDown E{(const bf16*)(ws + WS_HBS), pa.out, (const int*)(ws + WS_TOKMAP)};
            REP(12) pg8::gemm_phase<EpiDown, MoeOrder, true, true>(ring, g, S, E, wave);
#endif
        }
    }
    if (!FUSE_FINAL) SEAM(12);
    if (IN(13) && !FUSE_FINAL) { PHASE_PTRS; REP(13) p10_final(pa, (((DUP_MASK >> 13) & 1) && rep_ == 0) ? (float*)(ws + 544 * MiB) : pa.out, lane, wave); }
#ifdef DUMMY_LIVE
    asm volatile("" :: "v"(dl0), "v"(dl1), "v"(dl2), "v"(dl3), "v"(dl4), "v"(dl5), "v"(dl6), "v"(dl7));
#endif
#undef IN
#undef SEAM
}

extern "C" void kernel_launch(void* const* d_in, const int* in_sizes, int n_in, void* d_out, int out_size, void* d_ws, size_t ws_size, hipStream_t stream) {
    static int grid = 0;
    if (grid == 0) {
        if (n_in != 28 || out_size != T * D || ws_size < WS_END) { fprintf(stderr, "kernel_launch: unexpected problem (n_in %d, out %d, ws %zu)\n", n_in, out_size, ws_size); grid = -1; return; }
        int dev = 0, cus = 0, per_cu = 0;
        if (hipGetDevice(&dev) != hipSuccess || hipDeviceGetAttribute(&cus, hipDeviceAttributeMultiprocessorCount, dev) != hipSuccess) { grid = -1; return; }
        if (hipOccupancyMaxActiveBlocksPerMultiprocessor(&per_cu, (const void*)fwd_kernel, NTHR, 0) != hipSuccess || per_cu < 1) { fprintf(stderr, "kernel_launch: occupancy query failed (%d)\n", per_cu); per_cu = 1; }
        (void)hipGetLastError();
        grid = cus * (per_cu > 1 ? 1 : per_cu);
        if (grid > 256) grid = 256;
    }
    if (grid < 0) return;
    (void)hipMemsetAsync((char*)d_ws + WS_CTL, 0, CTL_ZERO_BYTES, stream);
    Args a{};
    for (int i = 0; i < 28; ++i) a.in[i] = d_in[i];
    a.out = (float*)d_out; a.ws = (unsigned char*)d_ws;
    if (N_LAUNCHES == 1) {
        a.ph_lo = 0; a.ph_hi = N_PHASES;
        void* kargs[] = {&a};
        hipError_t e = hipLaunchCooperativeKernel((const void*)fwd_kernel, dim3(grid), dim3(NTHR), kargs, 0, stream);
        if (e != hipSuccess) fprintf(stderr, "kernel_launch: cooperative launch failed: %s (grid %d)\n", hipGetErrorString(e), grid);
    } else {
        for (int p = 0; p < N_PHASES; ++p) { a.ph_lo = p; a.ph_hi = p + 1; hipLaunchKernelGGL(fwd_kernel, dim3(grid), dim3(NTHR), 0, stream, a); }
    }
}
```

```cpp
#include <hip/hip_runtime.h>
#include <cstdio>
#include <cstdint>
__device__ __forceinline__ int lane_id_() { int l; asm volatile("v_mbcnt_lo_u32_b32 %0, -1, 0\n\tv_mbcnt_hi_u32_b32 %0, -1, %0" : "=v"(l)); return l; }
namespace pg8 {
#define PG8_LAS __attribute__((address_space(3)))
typedef unsigned short bf16_t;
typedef short bf16x8 __attribute__((ext_vector_type(8)));
typedef float f32x4 __attribute__((ext_vector_type(4)));
typedef unsigned u32x4 __attribute__((ext_vector_type(4)));
constexpr int BM = 256, BK = 64, HALF = 128, HTB = HALF * BK * 2  , STAGE_BYTES = 8 * HTB, NXCD = 8, WGM = 8;

__host__ __device__ __forceinline__ int lds_byte(int r, int c) { const int st = (r >> 4) * 2 + (c >> 5), rr = r & 15, cc = c & 31, ob = rr * 64 + cc * 2; return st * 1024 + (ob ^ (((ob >> 9) & 1) << 5)); }
__host__ __device__ __forceinline__ void stage_rc(int b, int& R, int& C) { const int st = b / 1024, sb = b % 1024, swz = sb ^ (((sb >> 9) & 1) << 5); R = (st >> 1) * 16 + swz / 64; C = (st & 1) * 32 + (swz % 64) / 2; }
__host__ __device__ __forceinline__ int perm32(int rho) { const int n = rho >> 4, i = rho & 15; return 8 * (i >> 2) + 4 * n + (i & 3); }

struct Unit { int pm, pn, aux; };
struct Gemm { const bf16_t* A; const bf16_t* Bt; int M, N, K; const int* rowmap; };

struct StaticOrder {
    int nM, nN, nwg, G, c;
    __host__ __device__ __forceinline__ void init(int M, int N, int G_, int c_) { nM = M / BM; nN = N / BM; nwg = nM * nN; G = G_; c = c_; }
    __host__ __device__ __forceinline__ bool next(int i, Unit& u) const {
        const long L = (long)i * G + c; if (L >= nwg) return false;
        int wgid = (int)L; { const int q = nwg / NXCD, r = nwg % NXCD, xcd = wgid % NXCD, off = wgid / NXCD; wgid = (xcd < r ? xcd * (q + 1) : r * (q + 1) + (xcd - r) * q) + off; }
        const int nig = WGM * nN, gid = wgid / nig, fm = gid * WGM, gsz = (nM - fm) < WGM ? (nM - fm) : WGM;
        u.pm = fm + ((wgid % nig) % gsz); u.pn = (wgid % nig) / gsz; u.aux = 0; return true;
    }
    __device__ __forceinline__ void a_ready(const Unit&) const {}
    __device__ __forceinline__ void done(const Unit&) const {}
};

__device__ __forceinline__ unsigned cvt_pk_bf16(float lo, float hi) { unsigned r; asm volatile("v_cvt_pk_bf16_f32 %0, %1, %2" : "=v"(r) : "v"(lo), "v"(hi)); return r; }
__device__ __forceinline__ void glds16s(const void* sbase, unsigned voff, unsigned lds_dst) { unsigned keep;
    asm volatile("s_mov_b32 %0, m0\n\ts_mov_b32 m0, %3\n\ts_nop 0\n\tglobal_load_lds_dwordx4 %1, %2\n\ts_mov_b32 m0, %0" : "=&s"(keep) : "v"(voff), "s"(sbase), "s"(lds_dst) : "memory"); }
typedef int v8i_t __attribute__((ext_vector_type(8))); typedef int v4i_t __attribute__((ext_vector_type(4)));
typedef float f32x16_t __attribute__((ext_vector_type(16)));
template <int Q> __device__ __forceinline__ f32x4 ex4(const f32x16_t& v) { return __builtin_shufflevector(v, v, 4 * Q, 4 * Q + 1, 4 * Q + 2, 4 * Q + 3); }
template <int Q> __device__ __forceinline__ void in4(f32x16_t& v, const f32x4 c) {
    const f32x16_t w = __builtin_shufflevector(c, c, 0, 1, 2, 3, 0, 1, 2, 3, 0, 1, 2, 3, 0, 1, 2, 3);
    v = __builtin_shufflevector(v, w, Q == 0 ? 16 : 0, Q == 0 ? 17 : 1, Q == 0 ? 18 : 2, Q == 0 ? 19 : 3, Q == 1 ? 20 : 4, Q == 1 ? 21 : 5, Q == 1 ? 22 : 6, Q == 1 ? 23 : 7,
                                Q == 2 ? 24 : 8, Q == 2 ? 25 : 9, Q == 2 ? 26 : 10, Q == 2 ? 27 : 11, Q == 3 ? 28 : 12, Q == 3 ? 29 : 13, Q == 3 ? 30 : 14, Q == 3 ? 31 : 15); }
template <bool F8> struct Frags { bf16x8 a[4][2], b0[2][2], b1[2][2]; };
template <> struct Frags<true> { v8i_t a[4], b0[2], b1[2]; };
template <class Epi, class Sched, bool ALIGN_EPI = false, bool SP2 = false, bool GATHER = false, int PREC = 0>
__device__ __forceinline__ void gemm_phase(PG8_LAS unsigned char* lds, const Gemm g, const Sched& S, const Epi& E, const int wv) {
    constexpr bool FP8 = PREC == 1, I8 = PREC == 2, BYTEK = PREC != 0;
    int tid = wv * 64 + lane_id_(); asm volatile("" : "+v"(tid));
    const int wid = __builtin_amdgcn_readfirstlane(tid >> 6), lane = tid & 63, wr = wid >> 2, wc = wid & 3, fr = lane & 15, fq = lane >> 4;
    const int K = BYTEK ? g.K / 2 : g.K; int nt = g.K / (BYTEK ? 128 : BK);
    if constexpr (BYTEK) asm volatile("" : "+s"(nt));
    unsigned voffA[2], voffB[2];
#pragma unroll
    for (int i = 0; i < 2; ++i) { int R, C; stage_rc(tid * 16 + i * 8192, R, C); const int Rb = Epi::PERM ? ((R & ~31) + perm32(R & 31)) : R;
        voffA[i] = (unsigned)(R * K + C) * 2u; voffB[i] = (unsigned)(Rb * K + C) * 2u; }
    unsigned gc[2][2] = {{0u, 0u}, {0u, 0u}}, gn[2][2] = {{0u, 0u}, {0u, 0u}};
#define PG8_GLOAD(gv, pm_) do { _Pragma("unroll") for (int _h = 0; _h < 2; ++_h) _Pragma("unroll") for (int _i = 0; _i < 2; ++_i) { int _R, _C; stage_rc(tid * 16 + _i * 8192, _R, _C); \
        int _row = g.rowmap[(pm_) * BM + _h * HALF + _R]; _row = _row < 0 ? 0 : _row; gv[_h][_i] = (unsigned)(_row * K + _C) * 2u; } } while (0)
    const size_t kstep = (size_t)(BK * 2);
    const size_t hstep = (size_t)HALF * K * 2;
    const size_t tstep = 2 * hstep;
    const unsigned ldsw = (unsigned)wid * 1024u;
    const int aoff = lds_byte(wr * 64 + fr, fq * 8); int boff = lds_byte(wc * 32 + fr, fq * 8) + 4 * HTB;
    asm volatile("" : "+v"(boff));
#define PG8_SA(b, h) (((b) * 2 + (h)) * HTB)
#define PG8_SB(b, h) ((4 + (b) * 2 + (h)) * HTB)
#define PG8_SBR(b, h) (((b) * 2 + (h)) * HTB)
#define PG8_STAGE(bufoff, gbase, voff) do { _Pragma("unroll") for (int _i = 0; _i < 2; ++_i) \
        glds16s((const char*)(gbase), (voff)[_i], (unsigned)(uintptr_t)(lds + (bufoff) + ldsw + _i * 8192)); } while (0)
#define PG8_STAGE_A(bufoff, gbase, h, sel) do { if constexpr (GATHER) { unsigned vo_[2]; vo_[0] = (sel) ? gn[h][0] : gc[h][0]; vo_[1] = (sel) ? gn[h][1] : gc[h][1]; PG8_STAGE(bufoff, gbase, vo_); } \
        else { PG8_STAGE(bufoff, (gbase) + (h) * hstep, voffA); } } while (0)
#define PG8_RD16(off) (*(const PG8_LAS v4i_t*)(lds + (off)))
#define PG8_LDA(dst, b, h) do { if constexpr (FP8) { _Pragma("unroll") for (int m = 0; m < 4; ++m) { const v4i_t p0_ = PG8_RD16(PG8_SA(b, h) + aoff + m * 2048), p1_ = PG8_RD16(PG8_SA(b, h) + aoff + m * 2048 + 1024); \
            dst[m] = (v8i_t){p0_[0], p0_[1], p0_[2], p0_[3], p1_[0], p1_[1], p1_[2], p1_[3]}; } } \
        else { _Pragma("unroll") for (int m = 0; m < 4; ++m) _Pragma("unroll") for (int k = 0; k < 2; ++k) dst[m][k] = *(const PG8_LAS bf16x8*)(lds + PG8_SA(b, h) + aoff + m * 2048 + k * 1024); } } while (0)
#define PG8_LDB(dst, b, h) do { if constexpr (FP8) { _Pragma("unroll") for (int n = 0; n < 2; ++n) { const v4i_t p0_ = PG8_RD16(PG8_SBR(b, h) + boff + n * 2048), p1_ = PG8_RD16(PG8_SBR(b, h) + boff + n * 2048 + 1024); \
            dst[n] = (v8i_t){p0_[0], p0_[1], p0_[2], p0_[3], p1_[0], p1_[1], p1_[2], p1_[3]}; } } \
        else { _Pragma("unroll") for (int n = 0; n < 2; ++n) _Pragma("unroll") for (int k = 0; k < 2; ++k) dst[n][k] = *(const PG8_LAS bf16x8*)(lds + PG8_SBR(b, h) + boff + n * 2048 + k * 1024); } } while (0)
#define PG8_MM8(ai, bj, At, Bt, m, n) do { f32x4 c_ = ex4<((m) & 1) * 2 + (n)>(accw[ai][bj][(m) >> 1]); \
        c_ = __builtin_amdgcn_mfma_scale_f32_16x16x128_f8f6f4(Bt[n], At[m], c_, 0, 0, 0, 0x7f7f7f7f, 0, 0x7f7f7f7f); in4<((m) & 1) * 2 + (n)>(accw[ai][bj][(m) >> 1], c_); } while (0)
#define PG8_MMA(ai, bj, At, Bt) do { __builtin_amdgcn_s_setprio(1); \
        if constexpr (FP8) { PG8_MM8(ai, bj, At, Bt, 0, 0); PG8_MM8(ai, bj, At, Bt, 0, 1); PG8_MM8(ai, bj, At, Bt, 1, 0); PG8_MM8(ai, bj, At, Bt, 1, 1); \
                             PG8_MM8(ai, bj, At, Bt, 2, 0); PG8_MM8(ai, bj, At, Bt, 2, 1); PG8_MM8(ai, bj, At, Bt, 3, 0); PG8_MM8(ai, bj, At, Bt, 3, 1); } \
        else if constexpr (I8) { _Pragma("unroll") for (int m = 0; m < 4; ++m) _Pragma("unroll") for (int n = 0; n < 2; ++n) _Pragma("unroll") for (int k = 0; k < 2; ++k) \
            acc[ai][bj][m][n] = __builtin_bit_cast(f32x4, __builtin_amdgcn_mfma_i32_16x16x64_i8(__builtin_bit_cast(v4i_t, Bt[n][k]), __builtin_bit_cast(v4i_t, At[m][k]), __builtin_bit_cast(v4i_t, acc[ai][bj][m][n]), 0, 0, 0)); } \
        else { _Pragma("unroll") for (int m = 0; m < 4; ++m) _Pragma("unroll") for (int n = 0; n < 2; ++n) _Pragma("unroll") for (int k = 0; k < 2; ++k) \
            acc[ai][bj][m][n] = __builtin_amdgcn_mfma_f32_16x16x32_bf16(Bt[n][k], At[m][k], acc[ai][bj][m][n], 0, 0, 0); } \
        __builtin_amdgcn_s_setprio(0); } while (0)
#define PG8_WAIT_V(n) asm volatile("s_waitcnt vmcnt(" #n ")" ::: "memory")
#define PG8_WAIT_VN(n) asm volatile("s_waitcnt vmcnt(%0)" :: "n"(n) : "memory")
#define PG8_WAIT_L(n) asm volatile("s_waitcnt lgkmcnt(" #n ")" ::: "memory")
#define PG8_BAR __builtin_amdgcn_s_barrier()
#define PG8_SCHED __builtin_amdgcn_sched_barrier(0)
    Unit cur, nxt; int ui = 0;
    if (!S.next(0, cur)) return;
    f32x4 acc[2][2][4][2];
#pragma unroll
    for (int a = 0; a < 2; ++a)
#pragma unroll
        for (int b = 0; b < 2; ++b)
#pragma unroll
            for (int m = 0; m < 4; ++m)
#pragma unroll
                for (int n = 0; n < 2; ++n) acc[a][b][m][n] = (f32x4){0.f, 0.f, 0.f, 0.f};
    Frags<FP8> fr_; auto& At = fr_.a; auto& B0 = fr_.b0; auto& B1 = fr_.b1;
    f32x16_t accw[2][2][2];
#define PG8_ZW do { _Pragma("unroll") for (int a = 0; a < 2; ++a) _Pragma("unroll") for (int b = 0; b < 2; ++b) _Pragma("unroll") for (int q = 0; q < 2; ++q) \
        accw[a][b][q] = (f32x16_t){0.f, 0.f, 0.f, 0.f, 0.f, 0.f, 0.f, 0.f, 0.f, 0.f, 0.f, 0.f, 0.f, 0.f, 0.f, 0.f}; } while (0)
#define PG8_UNW do { _Pragma("unroll") for (int a = 0; a < 2; ++a) _Pragma("unroll") for (int b = 0; b < 2; ++b) { \
        acc[a][b][0][0] = ex4<0>(accw[a][b][0]); acc[a][b][0][1] = ex4<1>(accw[a][b][0]); acc[a][b][1][0] = ex4<2>(accw[a][b][0]); acc[a][b][1][1] = ex4<3>(accw[a][b][0]); \
        acc[a][b][2][0] = ex4<0>(accw[a][b][1]); acc[a][b][2][1] = ex4<1>(accw[a][b][1]); acc[a][b][3][0] = ex4<2>(accw[a][b][1]); acc[a][b][3][1] = ex4<3>(accw[a][b][1]); } } while (0)
    if constexpr (FP8) PG8_ZW;
    const char* cA = GATHER ? (const char*)g.A : (const char*)g.A + (size_t)cur.pm * tstep; const char* cB = (const char*)g.Bt + (size_t)cur.pn * tstep;
    if constexpr (GATHER) { PG8_GLOAD(gc, cur.pm); }
    S.a_ready(cur);
    if constexpr (SP2) {
        PG8_STAGE(PG8_SB(0, 0), cB, voffB); PG8_STAGE(PG8_SB(0, 1), cB + hstep, voffB); PG8_STAGE_A(PG8_SA(0, 0), cA, 0, false); PG8_STAGE_A(PG8_SA(0, 1), cA, 1, false);
        if (wr == 1) PG8_BAR;
        PG8_WAIT_V(2); PG8_BAR;
        PG8_STAGE(PG8_SB(1, 0), cB + kstep, voffB); PG8_STAGE_A(PG8_SA(1, 0), cA + kstep, 0, false); PG8_STAGE(PG8_SB(1, 1), cB + hstep + kstep, voffB);
        PG8_WAIT_V(6); PG8_BAR;
    } else {
        PG8_STAGE(PG8_SB(0, 0), cB, voffB); PG8_STAGE_A(PG8_SA(0, 0), cA, 0, false); PG8_STAGE(PG8_SB(0, 1), cB + hstep, voffB); PG8_STAGE_A(PG8_SA(0, 1), cA, 1, false);
        if (wr == 1) PG8_BAR;
        PG8_WAIT_V(4); PG8_BAR;
        PG8_STAGE(PG8_SB(1, 0), cB + kstep, voffB); PG8_STAGE_A(PG8_SA(1, 0), cA + kstep, 0, false); PG8_STAGE(PG8_SB(1, 1), cB + hstep + kstep, voffB);
        PG8_WAIT_V(6); PG8_BAR;
    }
    for (;;) {
        const bool has_next = S.next(ui + 1, nxt);
        const char* nA = GATHER ? cA : (has_next ? (const char*)g.A + (size_t)nxt.pm * tstep : cA);
        if constexpr (GATHER) { if (has_next) { PG8_GLOAD(gn, nxt.pm); } else { gn[0][0] = gc[0][0]; gn[0][1] = gc[0][1]; gn[1][0] = gc[1][0]; gn[1][1] = gc[1][1]; } }
        const char* nB = has_next ? (const char*)g.Bt + (size_t)nxt.pn * tstep : cB;
        for (int t = 0; t < nt; t += 2) {
            const bool last = (t == nt - 2);
            const char* a1 = cA + (size_t)(t + 1) * kstep;
            const char* a2 = last ? nA : cA + (size_t)(t + 2) * kstep; const char* b2 = last ? nB : cB + (size_t)(t + 2) * kstep;
            const char* a3 = a2 + kstep; const char* b3 = b2 + kstep;
            if (last && has_next) S.a_ready(nxt);
            if constexpr (SP2) {
            const bool relax = (Epi::NSTORE > 0) && (t == 0) && (ui > 0);
            PG8_LDB(B0, 0, 0); PG8_LDB(B1, 0, 1); PG8_SCHED; PG8_LDA(At, 0, 0); PG8_STAGE_A(PG8_SA(1, 1), a1, 1, false);
            if (relax) { PG8_WAIT_VN(8 + Epi::NSTORE); } else { PG8_WAIT_V(8); } PG8_WAIT_L(0); PG8_BAR; PG8_MMA(0, 0, At, B0); PG8_MMA(0, 1, At, B1); PG8_BAR; PG8_SCHED;
            PG8_LDA(At, 0, 1); PG8_STAGE(PG8_SB(0, 0), b2, voffB); PG8_STAGE(PG8_SB(0, 1), b2 + hstep, voffB); PG8_STAGE_A(PG8_SA(0, 0), a2, 0, last);
            if (relax) { PG8_WAIT_VN(8 + Epi::NSTORE); } else { PG8_WAIT_V(8); } PG8_WAIT_L(0); PG8_BAR; PG8_MMA(1, 0, At, B0); PG8_MMA(1, 1, At, B1); PG8_BAR; PG8_SCHED;
            PG8_LDB(B0, 1, 0); PG8_LDB(B1, 1, 1); PG8_SCHED; PG8_LDA(At, 1, 0); PG8_STAGE_A(PG8_SA(0, 1), a2, 1, last);
            PG8_WAIT_V(8); PG8_WAIT_L(0); PG8_BAR; PG8_MMA(0, 0, At, B0); PG8_MMA(0, 1, At, B1); PG8_BAR; PG8_SCHED;
            PG8_LDA(At, 1, 1); PG8_STAGE(PG8_SB(1, 0), b3, voffB); PG8_STAGE(PG8_SB(1, 1), b3 + hstep, voffB); PG8_STAGE_A(PG8_SA(1, 0), a3, 0, last);
            PG8_WAIT_V(8); PG8_WAIT_L(0); PG8_BAR; PG8_MMA(1, 0, At, B0); PG8_MMA(1, 1, At, B1); PG8_BAR; PG8_SCHED;
            } else {
            PG8_LDB(B0, 0, 0); PG8_SCHED; PG8_LDA(At, 0, 0); PG8_STAGE_A(PG8_SA(1, 1), a1, 1, false);
            PG8_WAIT_L(8); PG8_BAR; PG8_WAIT_L(0); PG8_MMA(0, 0, At, B0); PG8_BAR; PG8_SCHED;
            PG8_LDB(B1, 0, 1); PG8_STAGE(PG8_SB(0, 0), b2, voffB);
            PG8_BAR; PG8_WAIT_L(0); PG8_MMA(0, 1, At, B1); PG8_BAR;
            PG8_LDA(At, 0, 1); PG8_STAGE_A(PG8_SA(0, 0), a2, 0, last);
            PG8_BAR; PG8_WAIT_L(0); PG8_MMA(1, 0, At, B0); PG8_BAR; PG8_SCHED;
            PG8_STAGE(PG8_SB(0, 1), b2 + hstep, voffB);
            PG8_WAIT_V(6); PG8_BAR; PG8_MMA(1, 1, At, B1); PG8_BAR;
            PG8_LDB(B0, 1, 0); PG8_SCHED; PG8_LDA(At, 1, 0); PG8_STAGE_A(PG8_SA(0, 1), a2, 1, last);
            PG8_WAIT_L(8); PG8_BAR; PG8_WAIT_L(0); PG8_MMA(0, 0, At, B0); PG8_BAR; PG8_SCHED;
            PG8_LDB(B1, 1, 1); PG8_STAGE(PG8_SB(1, 0), b3, voffB);
            PG8_BAR; PG8_WAIT_L(0); PG8_MMA(0, 1, At, B1); PG8_BAR;
            PG8_LDA(At, 1, 1); PG8_STAGE_A(PG8_SA(1, 0), a3, 0, last);
            PG8_BAR; PG8_WAIT_L(0); PG8_MMA(1, 0, At, B0); PG8_BAR; PG8_SCHED;
            PG8_STAGE(PG8_SB(1, 1), b3 + hstep, voffB);
            PG8_WAIT_V(6); PG8_BAR; PG8_MMA(1, 1, At, B1); PG8_BAR;
            }
        }
        if constexpr (ALIGN_EPI) { if (wr == 0) PG8_BAR; }
        if constexpr (FP8) PG8_UNW;
        if constexpr (!Epi::AFTER_DRAIN) { E(acc, cur, wr, wc, fr, fq); S.done(cur); }
        if (!has_next) break;
#pragma unroll
        for (int a = 0; a < 2; ++a)
#pragma unroll
            for (int b = 0; b < 2; ++b)
#pragma unroll
                for (int m = 0; m < 4; ++m)
#pragma unroll
                    for (int n = 0; n < 2; ++n) acc[a][b][m][n] = (f32x4){0.f, 0.f, 0.f, 0.f};
        if constexpr (FP8) PG8_ZW;
        cur = nxt; cA = nA; cB = nB; ++ui;
        if constexpr (GATHER) { gc[0][0] = gn[0][0]; gc[0][1] = gn[0][1]; gc[1][0] = gn[1][0]; gc[1][1] = gn[1][1]; }
        if constexpr (ALIGN_EPI) { if (wr == 1) PG8_BAR; }
    }
    PG8_WAIT_V(0);
    if constexpr (!ALIGN_EPI) { if (wr == 0) PG8_BAR; }
    PG8_BAR;
    if constexpr (Epi::AFTER_DRAIN) { E.fused(acc, cur, wr, wc, fr, fq, lds, wid, lane); S.done(cur); }
#undef PG8_SA
#undef PG8_SB
#undef PG8_SBR
#undef PG8_STAGE
#undef PG8_STAGE_A
#undef PG8_GLOAD
#undef PG8_LDA
#undef PG8_LDB
#undef PG8_MMA
#undef PG8_MM8
#undef PG8_ZW
#undef PG8_UNW
#undef PG8_RD16
#undef PG8_WAIT_V
#undef PG8_WAIT_VN
#undef PG8_WAIT_L
#undef PG8_BAR
#undef PG8_SCHED
}
}


#define GAS __attribute__((address_space(1)))
#define LAS __attribute__((address_space(3)))
typedef unsigned short bf16;
typedef unsigned v4u __attribute__((ext_vector_type(4)));
typedef unsigned v2u __attribute__((ext_vector_type(2)));
typedef float f32x4 __attribute__((ext_vector_type(4)));
typedef short bf16x8 __attribute__((ext_vector_type(8)));
typedef GAS unsigned gu32;

constexpr int NWAVES = 8, NTHR = 512;
constexpr int BATCH = 8, SEQ = 8192, T = BATCH * SEQ, D = 1024, MEMLEN = 256, TMEM = BATCH * MEMLEN;
constexpr int INW = 3080, NIN = 3072, NKV = 512;
constexpr int NBUCKET = 24, ROWS_MAX = T + NBUCKET * 256;
constexpr float EPSN = 1e-6f;
constexpr float C2 = 0.125f * 1.4426950408889634f;
constexpr float LOG2E = 1.4426950408889634f;

constexpr size_t MiB = 1u << 20;
constexpr size_t WS_CTL = 0, CTL_ZERO_BYTES = 1 * MiB;
constexpr size_t WS_ROPE = 2 * MiB;
constexpr size_t WS_IG = 6 * MiB;
constexpr size_t WS_FG = 7 * MiB;
constexpr size_t WS_LSE = 8 * MiB;
constexpr size_t WS_SS1 = 14 * MiB;
constexpr size_t WS_SS3 = 18 * MiB;
constexpr size_t WS_RINV = 21 * MiB + 768 * 1024;
constexpr size_t WS_KVX = 22 * MiB;
constexpr size_t WS_NLOC = 24 * MiB;
constexpr size_t WS_NPREV = 25 * MiB;
constexpr size_t WS_MLOC = 26 * MiB;
constexpr size_t WS_BLAST = 26 * MiB + 64 * 1024;
constexpr size_t WS_MPREV = 26 * MiB + 128 * 1024;
constexpr size_t WS_TOKINFO = 27 * MiB;
constexpr size_t WS_TOKMAP = 28 * MiB;
constexpr size_t WS_WSORT = 19 * MiB;
constexpr size_t WS_WR = 30 * MiB;
constexpr size_t WS_WG = 30 * MiB + 512 * 1024;
constexpr size_t WS_PAR = 31 * MiB;
constexpr int PAR_CONVW = 0, PAR_CONVB = 2048, PAR_GMHN = 2560, PAR_SKIP = 3072, PAR_BRG = 3584, PAR_BRE = 3600, PAR_GFIN = 3616, PAR_N = 4640;
constexpr size_t WS_WIN = 32 * MiB;
constexpr size_t WS_WOUT = 39 * MiB;
constexpr size_t WS_WQX = 41 * MiB;
constexpr size_t WS_WOX = 41 * MiB + 512 * 1024;
constexpr size_t WS_WM = 42 * MiB;
constexpr size_t WS_W13 = 44 * MiB;
constexpr size_t WS_W2P = 76 * MiB;
constexpr size_t WS_XN = 128 * MiB;
constexpr size_t WS_CLOC = 128 * MiB;
constexpr size_t WS_GAGG = 776 * MiB;
constexpr size_t WS_GN = 784 * MiB;
constexpr size_t WS_GSC = 784 * MiB + 512 * 1024;
constexpr size_t WS_Q = 264 * MiB;
constexpr size_t WS_K = 328 * MiB, WS_V = 392 * MiB, WS_MU = 456 * MiB, WS_MV = 520 * MiB, WS_MO = 584 * MiB;
constexpr size_t WS_MQ = 648 * MiB, WS_MK = 712 * MiB;
constexpr size_t WS_Y = 264 * MiB;
constexpr size_t WS_CPREV = 392 * MiB;
constexpr size_t WS_X1B = 648 * MiB;
constexpr size_t WS_QX = 776 * MiB;
constexpr size_t WS_OX = 808 * MiB;
constexpr size_t WS_HBS = 264 * MiB;
constexpr size_t WS_ACT = 404 * MiB;
constexpr size_t WS_X8 = 856 * MiB;
constexpr size_t WS_WIN8 = 44 * MiB;
constexpr size_t WS_RSX = 48 * MiB + 512 * 1024;
constexpr size_t WS_RS8 = 48 * MiB;
constexpr int CW_CMAX = 65536, CW_CMDONE = 65536 + 4096;
constexpr size_t WS_X2Q = 544 * MiB;
constexpr size_t WS_W13Q = 840 * MiB;
constexpr size_t WS_END = 920 * MiB;
constexpr size_t DO_OATT = 0, DO_C = 192 * MiB;

constexpr int CW_BAR = 4096;
constexpr int CW_CNT = 8192;
constexpr int CW_FILL = 8192 + 64;

constexpr int LDS_BYTES = 163840;
constexpr int LDS_MISC = 159744;
constexpr int LDS_RS = 135168;
constexpr int LDS_TAB = 136192;

#define LDS_WAIT() asm volatile("s_waitcnt lgkmcnt(0)" ::: "memory")
#define VM_WAIT() asm volatile("s_waitcnt vmcnt(0)" ::: "memory")
__device__ __forceinline__ unsigned f2bf(float f) { unsigned u = __builtin_bit_cast(unsigned, f); return (u + 0x7fffu + ((u >> 16) & 1u)) >> 16; }
typedef float f32x2_t __attribute__((ext_vector_type(2))); typedef __bf16 bf16x2_t __attribute__((ext_vector_type(2)));
__device__ __forceinline__ unsigned pk2(float lo, float hi) { f32x2_t v = {lo, hi}; bf16x2_t b = __builtin_convertvector(v, bf16x2_t); return __builtin_bit_cast(unsigned, b); }
__device__ __forceinline__ unsigned pk4_i8(float a, float b, float c, float d, float s) {
    const unsigned ua = __float_as_uint(fmaf(a, s, 12582912.0f)), ub = __float_as_uint(fmaf(b, s, 12582912.0f)), uc = __float_as_uint(fmaf(c, s, 12582912.0f)), ud = __float_as_uint(fmaf(d, s, 12582912.0f));
    return __builtin_amdgcn_perm(__builtin_amdgcn_perm(ud, uc, 0x0c0c0400u), __builtin_amdgcn_perm(ub, ua, 0x0c0c0400u), 0x05040100u); }
__device__ __forceinline__ unsigned pk4_fp8(float a, float b, float c, float d) { int v = __builtin_amdgcn_cvt_pk_fp8_f32(a, b, 0, false); v = __builtin_amdgcn_cvt_pk_fp8_f32(c, d, v, true); return (unsigned)v; }
__device__ __forceinline__ float bf2f(unsigned h) { return __uint_as_float(h << 16); }
__device__ __forceinline__ float bflo(unsigned w) { return __uint_as_float(w << 16); }
__device__ __forceinline__ float bfhi(unsigned w) { return __uint_as_float(w & 0xffff0000u); }
__device__ __forceinline__ float xsum4(float v) {
    const unsigned u = __float_as_uint(v);
    auto a = __builtin_amdgcn_permlane16_swap(u, u, false, false);
    const unsigned w = __float_as_uint(__uint_as_float(a[0]) + __uint_as_float(a[1]));
    auto b = __builtin_amdgcn_permlane32_swap(w, w, false, false);
    return __uint_as_float(b[0]) + __uint_as_float(b[1]); }
__device__ __forceinline__ float xmax4(float v) {
    const unsigned u = __float_as_uint(v);
    auto a = __builtin_amdgcn_permlane16_swap(u, u, false, false);
    const unsigned w = __float_as_uint(fmaxf(__uint_as_float(a[0]), __uint_as_float(a[1])));
    auto b = __builtin_amdgcn_permlane32_swap(w, w, false, false);
    return fmaxf(__uint_as_float(b[0]), __uint_as_float(b[1])); }
__device__ __forceinline__ float wave_sum(float v) {
#pragma unroll
    for (int o = 1; o < 64; o <<= 1) v += __shfl_xor(v, o);
    return v;
}
__device__ __forceinline__ float wave_max(float v) {
#pragma unroll
    for (int o = 1; o < 64; o <<= 1) v = fmaxf(v, __shfl_xor(v, o));
    return v;
}
__device__ __forceinline__ float fexp_(float x) { return __builtin_amdgcn_exp2f(x * 1.4426950408889634f); }
__device__ __forceinline__ float frcp_(float x) { return __builtin_amdgcn_rcpf(x); }
__device__ __forceinline__ float sigmoidf_(float x) { return __builtin_amdgcn_rcpf(1.0f + __builtin_amdgcn_exp2f(x * -1.4426950408889634f)); }

#define XB_TMO      128
#define XB_XCNT(j)  (256  + 64 * (j))
#define XB_XSUB(j)  (1280 + 64 * (j))
#define XB_XGEN(j)  (2304 + 64 * (j))
#define XB_TOP      3328
#define XB_TOPGEN   3392
#define XCD_BAR_WORDS 3456
#define XB_SPIN_CAP (1u << 22)
__device__ __forceinline__ unsigned xb_ld(unsigned* p)              { return __hip_atomic_load(p, __ATOMIC_RELAXED, __HIP_MEMORY_SCOPE_AGENT); }
__device__ __forceinline__ unsigned xb_add(unsigned* p, unsigned v) { return __hip_atomic_fetch_add(p, v, __ATOMIC_RELAXED, __HIP_MEMORY_SCOPE_AGENT); }
__device__ __forceinline__ unsigned xb_xcc_id() { return (unsigned)__builtin_amdgcn_s_getreg((3 << 11) | 20) & 0xFu; }
#define XB_SPIN(cond, bar) do { unsigned _sp = 0; while (cond) { __builtin_amdgcn_s_sleep(1); \
    if ((++_sp & 255u) == 0u) { if (xb_ld(&(bar)[XB_TMO])) break; if (_sp > XB_SPIN_CAP) { atomicAdd(&(bar)[XB_TMO], 1u); break; } } } } while (0)
struct XcdBarrier { unsigned* bar; unsigned x; volatile LAS unsigned* st; int wv; };
__device__ __forceinline__ XcdBarrier xcd_barrier_post(unsigned* bar, volatile LAS unsigned* st, int wv) {
    XcdBarrier b; b.bar = bar; b.x = xb_xcc_id(); b.st = st; b.wv = wv;
    if (wv == 0 && lane_id_() == 0) (void)xb_add(&bar[XB_XCNT(b.x)], 1u);
    return b;
}
__device__ __forceinline__ void xcd_barrier_complete(unsigned* bar, unsigned x, unsigned& nloc, unsigned& nx) {
    const unsigned G = gridDim.x * gridDim.y * gridDim.z;
    unsigned sum, cnt, mine, sp = 0u;
    for (;;) {
        sum = 0u; cnt = 0u; mine = 0u;
#pragma unroll
        for (unsigned j = 0; j < 16; ++j) { const unsigned c = xb_ld(&bar[XB_XCNT(j)]); sum += c; cnt += (c > 0u) ? 1u : 0u; mine = (j == x) ? c : mine; }
        if (sum == G) break;
        __builtin_amdgcn_s_sleep(1);
        if ((++sp & 255u) == 0u) { if (xb_ld(&bar[XB_TMO])) break; if (sp > XB_SPIN_CAP) { atomicAdd(&bar[XB_TMO], 1u); break; } }
    }
    nloc = mine > 0u ? mine : 1u; nx = cnt > 0u ? cnt : 1u;
}
__device__ __forceinline__ void xcd_barrier(const XcdBarrier& b) {
    asm volatile("s_waitcnt vmcnt(0)" ::: "memory");
    __syncthreads();
    if (b.wv == 0 && lane_id_() == 0) {
        unsigned* bar = b.bar;
        __builtin_amdgcn_s_waitcnt(0);
        unsigned nloc = b.st[0], nx = b.st[1];
        if (nloc == 0u) { xcd_barrier_complete(bar, b.x, nloc, nx); b.st[0] = nloc; b.st[1] = nx; }
        const unsigned old = xb_add(&bar[XB_XSUB(b.x)], 1u);
        const unsigned gen = old / nloc;
        if (old + 1u == (gen + 1u) * nloc) {
            __builtin_amdgcn_fence(__ATOMIC_RELEASE, "agent");
            asm volatile("s_waitcnt vmcnt(0)" ::: "memory");
            const unsigned og = xb_add(&bar[XB_TOP], 1u);
            const unsigned tg = og / nx;
            if (og + 1u == (tg + 1u) * nx) xb_add(&bar[XB_TOPGEN], 1u);
            else XB_SPIN(xb_ld(&bar[XB_TOPGEN]) == tg, bar);
            __builtin_amdgcn_fence(__ATOMIC_ACQUIRE, "agent");
            xb_add(&bar[XB_XGEN(b.x)], 1u);
            asm volatile("s_waitcnt vmcnt(0)" ::: "memory");
        } else {
            XB_SPIN(xb_ld(&bar[XB_XGEN(b.x)]) == gen, bar);
            __builtin_amdgcn_fence(__ATOMIC_ACQUIRE, "agent");
            asm volatile("s_waitcnt vmcnt(0)" ::: "memory");
        }
    }
    __syncthreads();
}

struct Args { const void* in[28]; float* out; unsigned char* ws; int ph_lo, ph_hi; };

template <int MI, int NJ>
__device__ __forceinline__ void wave_mma(const bf16* A, int lda, const bf16* Bt, int ldb, int K, f32x4 (&acc)[MI][NJ], int fr, int fq) {
    for (int k0 = 0; k0 < K; k0 += 32) {
        bf16x8 a[MI], b[NJ];
#pragma unroll
        for (int i = 0; i < MI; ++i) a[i] = *(const bf16x8*)(A + (16 * i + fr) * lda + k0 + 8 * fq);
#pragma unroll
        for (int j = 0; j < NJ; ++j) b[j] = *(const bf16x8*)(Bt + (16 * j + fr) * ldb + k0 + 8 * fq);
#pragma unroll
        for (int i = 0; i < MI; ++i)
#pragma unroll
            for (int j = 0; j < NJ; ++j) acc[i][j] = __builtin_amdgcn_mfma_f32_16x16x32_bf16(b[j], a[i], acc[i][j], 0, 0, 0);
    }
}

__device__ __forceinline__ void transpose_item(const float* src, int src_ld, int k0, int n0, bf16* dst, int dst_ld, int dst_row0, int dst_col0,
                                               const float* gain, float scale, LAS float* scr, int lane) {
    f32x4 ld[16];
#pragma unroll
    for (int i = 0; i < 16; ++i) { const int kk = 4 * i + (lane >> 4); ld[i] = *(const f32x4*)(src + (size_t)(k0 + kk) * src_ld + n0 + 4 * (lane & 15)); }
#pragma unroll
    for (int i = 0; i < 16; ++i) { const int kk = 4 * i + (lane >> 4); *(LAS f32x4*)(scr + kk * 64 + 4 * ((lane & 15) ^ ((kk >> 3) & 15))) = ld[i]; }
    const int c = lane & 7;
    f32x4 g0 = (f32x4){scale, scale, scale, scale}, g1 = g0;
    if (gain) { g0 = *(const f32x4*)(gain + k0 + 8 * c) * scale; g1 = *(const f32x4*)(gain + k0 + 8 * c + 4) * scale; }
    LDS_WAIT(); asm volatile("" ::: "memory");
#pragma unroll
    for (int j = 0; j < 8; ++j) { const int n = (lane >> 3) + 8 * j; const LAS float* s = scr + (8 * c) * 64 + 4 * ((n >> 2) ^ c) + (n & 3);
        v4u o; o.x = pk2(s[0 * 64] * g0[0], s[1 * 64] * g0[1]); o.y = pk2(s[2 * 64] * g0[2], s[3 * 64] * g0[3]); o.z = pk2(s[4 * 64] * g1[0], s[5 * 64] * g1[1]); o.w = pk2(s[6 * 64] * g1[2], s[7 * 64] * g1[3]);
        *(v4u*)(dst + (size_t)(dst_row0 + n) * dst_ld + dst_col0 + 8 * c) = o; }
    LDS_WAIT(); asm volatile("" ::: "memory");
}

__device__ __forceinline__ void transpose_item_q8(const float* src, int src_ld, int k0, int n0, unsigned char* dst, int dst_ld, int dst_row0, int dst_col0,
                                                  const float* gain, float scale, LAS float* scr, int lane) {
    f32x4 ld[16];
#pragma unroll
    for (int i = 0; i < 16; ++i) { const int kk = 4 * i + (lane >> 4); ld[i] = *(const f32x4*)(src + (size_t)(k0 + kk) * src_ld + n0 + 4 * (lane & 15)); }
#pragma unroll
    for (int i = 0; i < 16; ++i) { const int kk = 4 * i + (lane >> 4); *(LAS f32x4*)(scr + kk * 64 + 4 * ((lane & 15) ^ ((kk >> 3) & 15))) = ld[i]; }
    const int c = lane & 7;
    f32x4 g0 = (f32x4){scale, scale, scale, scale}, g1 = g0;
    if (gain) { g0 = *(const f32x4*)(gain + k0 + 8 * c) * scale; g1 = *(const f32x4*)(gain + k0 + 8 * c + 4) * scale; }
    LDS_WAIT(); asm volatile("" ::: "memory");
#pragma unroll
    for (int j = 0; j < 8; ++j) { const int n = (lane >> 3) + 8 * j; const LAS float* sp = scr + (8 * c) * 64 + 4 * ((n >> 2) ^ c) + (n & 3);
        v2u o; o.x = pk4_fp8(sp[0 * 64] * g0[0], sp[1 * 64] * g0[1], sp[2 * 64] * g0[2], sp[3 * 64] * g0[3]); o.y = pk4_fp8(sp[4 * 64] * g1[0], sp[5 * 64] * g1[1], sp[6 * 64] * g1[2], sp[7 * 64] * g1[3]);
        *(v2u*)(dst + (size_t)(dst_row0 + n) * dst_ld + dst_col0 + 8 * c) = o; }
    LDS_WAIT(); asm volatile("" ::: "memory");
}
__device__ __forceinline__ void transpose_item_i8(const float* src, int src_ld, int k0, int n0, unsigned char* dst, int dst_ld, int dst_row0, int dst_col0,
                                                  const float* gain, float scale, const unsigned* cmax, LAS float* scr, int lane) {
    f32x4 ld[16];
#pragma unroll
    for (int i = 0; i < 16; ++i) { const int kk = 4 * i + (lane >> 4); ld[i] = *(const f32x4*)(src + (size_t)(k0 + kk) * src_ld + n0 + 4 * (lane & 15)); }
#pragma unroll
    for (int i = 0; i < 16; ++i) { const int kk = 4 * i + (lane >> 4); *(LAS f32x4*)(scr + kk * 64 + 4 * ((lane & 15) ^ ((kk >> 3) & 15))) = ld[i]; }
    const int c = lane & 7;
    const f32x4 g0 = *(const f32x4*)(gain + k0 + 8 * c) * scale, g1 = *(const f32x4*)(gain + k0 + 8 * c + 4) * scale;
    LDS_WAIT(); asm volatile("" ::: "memory");
#pragma unroll
    for (int j = 0; j < 8; ++j) { const int n = (lane >> 3) + 8 * j; const LAS float* sp = scr + (8 * c) * 64 + 4 * ((n >> 2) ^ c) + (n & 3);
        const float cm = __uint_as_float(__hip_atomic_load(cmax + dst_row0 + n, __ATOMIC_RELAXED, __HIP_MEMORY_SCOPE_AGENT)); const float sc = cm > 0.f ? 127.0f / cm : 0.f;
        v2u o; o.x = pk4_i8(sp[0 * 64] * g0[0], sp[1 * 64] * g0[1], sp[2 * 64] * g0[2], sp[3 * 64] * g0[3], sc); o.y = pk4_i8(sp[4 * 64] * g1[0], sp[5 * 64] * g1[1], sp[6 * 64] * g1[2], sp[7 * 64] * g1[3], sc);
        *(v2u*)(dst + (size_t)(dst_row0 + n) * dst_ld + dst_col0 + 8 * c) = o; }
    LDS_WAIT(); asm volatile("" ::: "memory");
}
__device__ __forceinline__ void p0_prologue(const Args& A, unsigned char* lds, int tid, int lane, int wave) {
    unsigned char* ws = A.ws;
    const float* x = (const float*)A.in[0]; const float* mem = (const float*)A.in[1]; const int* positions = (const int*)A.in[2];
    const float* g_mix = (const float*)A.in[3]; const float* w_in = (const float*)A.in[4];
    const float* w_q_m = (const float*)A.in[7]; const float* w_k_m = (const float*)A.in[8];
    const float* b_i = (const float*)A.in[9]; const float* b_f = (const float*)A.in[10];
    const float* w_out = (const float*)A.in[13]; const float* g_cross = (const float*)A.in[14]; const float* g_mem = (const float*)A.in[15];
    const float* w_q_x = (const float*)A.in[16]; const float* w_kv_x = (const float*)A.in[17]; const float* w_o_x = (const float*)A.in[18];
    const float* g_ffn = (const float*)A.in[19]; const float* w_rg = (const float*)A.in[20]; const float* w_re = (const float*)A.in[22];
    const float* w1 = (const float*)A.in[24]; const float* w3 = (const float*)A.in[25]; const float* w2 = (const float*)A.in[26];
    const int G = gridDim.x, gw = blockIdx.x * NWAVES + wave, NGW = G * NWAVES, gt = blockIdx.x * NTHR + tid, NGT = G * NTHR;

    LAS float* WGl = (LAS float*)lds;
    { float wgv[16], ggv[16];
#pragma unroll
      for (int q = 0; q < 16; ++q) { const int i = tid + NTHR * q, k = i >> 3, j = i & 7; wgv[q] = ((const GAS float*)w_in)[(size_t)k * INW + NIN + j]; ggv[q] = ((const GAS float*)g_mix)[k]; }
#pragma unroll
      for (int q = 0; q < 16; ++q) { const int i = tid + NTHR * q, k = i >> 3, j = i & 7; WGl[j * 1024 + k] = ggv[q] * wgv[q]; } }

    { unsigned* ctl = (unsigned*)(ws + WS_CTL);
      for (int it = gw; it < 16 * 48; it += NGW) { const int kb = it / 48, nb = it % 48; f32x4 mx = (f32x4){0.f, 0.f, 0.f, 0.f};
#pragma unroll
          for (int i = 0; i < 16; ++i) { const int kk = 64 * kb + 4 * i + (lane >> 4); const f32x4 w = *(const f32x4*)(w_in + (size_t)kk * INW + 64 * nb + 4 * (lane & 15)); const float ga = fabsf(g_mix[kk]);
#pragma unroll
              for (int c = 0; c < 4; ++c) mx[c] = fmaxf(mx[c], fabsf(w[c]) * ga); }
#pragma unroll
          for (int c = 0; c < 4; ++c) { mx[c] = xmax4(mx[c]); mx[c] *= (64 * nb < 512) ? C2 : 1.0f; }
          if (lane < 16) {
#pragma unroll
              for (int c = 0; c < 4; ++c) __hip_atomic_fetch_max(ctl + CW_CMAX + 64 * nb + 4 * lane + c, __float_as_uint(mx[c]), __ATOMIC_RELAXED, __HIP_MEMORY_SCOPE_AGENT); }
          asm volatile("s_waitcnt vmcnt(0)" ::: "memory");
          if (lane == 0) __hip_atomic_fetch_add(ctl + CW_CMDONE, 1u, __ATOMIC_RELAXED, __HIP_MEMORY_SCOPE_AGENT); } }
    for (int i = gt; i < PAR_N; i += NGT) { float v;
        if (i < PAR_CONVB) v = ((const float*)A.in[5])[i]; else if (i < PAR_GMHN) v = ((const float*)A.in[6])[i - PAR_CONVB]; else if (i < PAR_SKIP) v = ((const float*)A.in[11])[i - PAR_GMHN];
        else if (i < PAR_BRG) v = ((const float*)A.in[12])[i - PAR_SKIP]; else if (i < PAR_BRE) v = ((const float*)A.in[21])[i - PAR_BRG]; else if (i < PAR_GFIN) v = ((const float*)A.in[23])[i - PAR_BRE];
        else v = ((const float*)A.in[27])[i - PAR_GFIN];
        ((float*)(ws + WS_PAR))[i] = v; }
    for (int i = gt; i < 32 * 1024; i += NGT) { const int e = i >> 10, k = i & 1023;
        const float w = (e < 20) ? g_ffn[k] * (e < 4 ? w_rg[k * 4 + e] : w_re[k * 16 + (e - 4)]) : 0.f;
        const unsigned hi = f2bf(w); const float lo = w - bf2f(hi);
        ((bf16*)(ws + WS_WR))[i] = (bf16)hi; ((bf16*)(ws + WS_WR))[32 * 1024 + i] = (bf16)f2bf(lo); }
    for (int i = gt; i < T * 8; i += NGT) { const int t = i >> 3, j = i & 7; const float invf = powf(500000.0f, -(float)j * 0.125f);
        const float ang = (float)positions[t] * invf; float sn, cs; sincosf(ang, &sn, &cs);
        ((unsigned*)(ws + WS_ROPE))[t * 8 + j] = pk2(cs, sn); }
    __syncthreads();
    for (int m0 = 2 * gw; m0 < T + TMEM; m0 += 2 * NGW) {
        f32x4 v[2][4]; float rstd[2];
#pragma unroll
        for (int q = 0; q < 2; ++q) { const int m = m0 + q; const f32x4* xr = (const f32x4*)(m >= T ? mem + (size_t)(m - T) * D : x + (size_t)m * D) + lane;
#pragma unroll
            for (int j = 0; j < 4; ++j) v[q][j] = xr[64 * j]; }
#pragma unroll
        for (int q = 0; q < 2; ++q) { float s = 0.f;
#pragma unroll
            for (int j = 0; j < 4; ++j) s += (v[q][j].x * v[q][j].x + v[q][j].y * v[q][j].y) + (v[q][j].z * v[q][j].z + v[q][j].w * v[q][j].w);
            { const float rms = sqrtf(wave_sum(s) * (1.0f / D) + EPSN); rstd[q] = 1.0f / rms; }
            if (m0 + q < T) { float am = 0.f;
#pragma unroll
                for (int j = 0; j < 4; ++j) am = fmaxf(fmaxf(am, fmaxf(fabsf(v[q][j].x), fabsf(v[q][j].y))), fmaxf(fabsf(v[q][j].z), fabsf(v[q][j].w)));
                am = wave_max(am); const float qs = am > 0.f ? 127.0f / am : 0.f;
                if (lane == 0) { ((float*)(ws + WS_RS8))[m0 + q] = am * (1.0f / 127.0f) * rstd[q]; ((float*)(ws + WS_RSX))[m0 + q] = am * (1.0f / 127.0f); }
                unsigned* o4 = (unsigned*)(ws + WS_X8 + (size_t)(m0 + q) * D) + lane;
#pragma unroll
                for (int j = 0; j < 4; ++j) o4[64 * j] = pk4_i8(v[q][j].x, v[q][j].y, v[q][j].z, v[q][j].w, qs); }
            if (m0 + q >= T) {
            unsigned long long* o8 = (unsigned long long*)(ws + WS_XN + (size_t)(m0 + q) * D * 2) + lane;
#pragma unroll
            for (int j = 0; j < 4; ++j) o8[64 * j] = (unsigned long long)pk2(v[q][j].x * rstd[q], v[q][j].y * rstd[q]) | ((unsigned long long)pk2(v[q][j].z * rstd[q], v[q][j].w * rstd[q]) << 32); } }
        if (m0 < T) {
            float ga[2][8];
#pragma unroll
            for (int g = 0; g < 8; ++g) { float a0 = 0.f, a1 = 0.f;
#pragma unroll
                for (int j = 0; j < 4; ++j) { const f32x4 w = *(const LAS f32x4*)(WGl + g * 1024 + 256 * j + 4 * lane);
                    a0 += (v[0][j].x * w.x + v[0][j].y * w.y) + (v[0][j].z * w.z + v[0][j].w * w.w); a1 += (v[1][j].x * w.x + v[1][j].y * w.y) + (v[1][j].z * w.z + v[1][j].w * w.w); }
                ga[0][g] = a0; ga[1][g] = a1; }
            float val0, val1;
            { const bool b5 = (lane & 32) != 0, b4 = (lane & 16) != 0, b3 = (lane & 8) != 0;
#pragma unroll
              for (int q = 0; q < 2; ++q) { float r[4], s2[2];
#pragma unroll
                  for (int i = 0; i < 4; ++i) { const float keep = b5 ? ga[q][i + 4] : ga[q][i], send = b5 ? ga[q][i] : ga[q][i + 4]; r[i] = keep + __shfl_xor(send, 32); }
#pragma unroll
                  for (int i = 0; i < 2; ++i) { const float keep = b4 ? r[i + 2] : r[i], send = b4 ? r[i] : r[i + 2]; s2[i] = keep + __shfl_xor(send, 16); }
                  float p = (b3 ? s2[1] : s2[0]) + __shfl_xor(b3 ? s2[0] : s2[1], 8);
                  p += __shfl_xor(p, 4); p += __shfl_xor(p, 2); p += __shfl_xor(p, 1);
                  if (q == 0) val0 = p * rstd[0]; else val1 = p * rstd[1]; } }
            if ((lane & 7) == 0) { const int gidx = lane >> 3, h = gidx & 3;
#pragma unroll
                for (int q = 0; q < 2; ++q) { const int m = m0 + q, b = m / SEQ, sq = m % SEQ; const float val = q ? val1 : val0;
                    if (gidx < 4) ((float*)(ws + WS_IG))[(size_t)(b * 4 + h) * SEQ + sq] = val + b_i[h];
                    else ((float*)(ws + WS_FG))[(size_t)(b * 4 + h) * SEQ + sq] = val + b_f[h]; } }
        }
    }
    __syncthreads();
    LAS float* scr = (LAS float*)(lds + wave * 16384);
    constexpr int I_IN = 16 * 48, I_KV = 16 * 8, I_OUT = 16 * 16, I_QX = 16 * 4, I_OX = 4 * 16, I_M = 32, I_13 = 16 * 2 * 128, I_2P = 24 * 2 * 128;
    constexpr int NITEMS = I_IN + I_KV + I_OUT + I_QX + I_OX + I_M + I_13 + I_2P;
    bool cm_ok = false;
    for (int it = gw; it < NITEMS; it += NGW) {
        int r = it;
        if (r < I_IN) { const int kb = r / 48, nb = r % 48; const unsigned* ctl = (const unsigned*)(ws + WS_CTL);
            if (!cm_ok) { unsigned spins = 0;
                while ((unsigned)__builtin_amdgcn_readfirstlane(__hip_atomic_load(ctl + CW_CMDONE, __ATOMIC_RELAXED, __HIP_MEMORY_SCOPE_AGENT)) < 768u) { __builtin_amdgcn_s_sleep(4); if (++spins > (1u << 22)) break; }
                cm_ok = true; }
            transpose_item_i8(w_in, INW, 64 * kb, 64 * nb, (unsigned char*)(ws + WS_WIN8), 1024, 64 * nb, 64 * kb, g_mix, (64 * nb < 512) ? C2 : 1.0f, ctl + CW_CMAX, scr, lane); continue; } r -= I_IN;
        if (r < I_KV) { const int kb = r / 8, nb = r % 8; transpose_item(w_kv_x, 512, 64 * kb, 64 * nb, (bf16*)(ws + WS_WIN), 1024, NIN + 64 * nb, 64 * kb, g_mem, 1.0f, scr, lane); continue; } r -= I_KV;
        if (r < I_OUT) { const int kb = r / 16, nb = r % 16; transpose_item(w_out, 1024, 64 * kb, 64 * nb, (bf16*)(ws + WS_WOUT), 1024, 64 * nb, 64 * kb, nullptr, 1.0f, scr, lane); continue; } r -= I_OUT;
        if (r < I_QX) { const int kb = r / 4, nb = r % 4; transpose_item(w_q_x, 256, 64 * kb, 64 * nb, (bf16*)(ws + WS_WQX), 1024, 64 * nb, 64 * kb, g_cross, C2, scr, lane); continue; } r -= I_QX;
        if (r < I_OX) { const int kb = r / 16, nb = r % 16; transpose_item(w_o_x, 1024, 64 * kb, 64 * nb, (bf16*)(ws + WS_WOX), 256, 64 * nb, 64 * kb, nullptr, 1.0f, scr, lane); continue; } r -= I_OX;
        if (r < I_M) { const int which = r / 16, h = (r % 16) / 4, kb = (r % 4) / 2, nb = r % 2;
            transpose_item((which ? w_k_m : w_q_m) + (size_t)h * 128 * 128, 128, 64 * kb, 64 * nb, (bf16*)(ws + WS_WM) + (size_t)(which * 4 + h) * 128 * 128, 128, 64 * nb, 64 * kb, nullptr,
                           which ? 0.08838834764831845f : 1.0f, scr, lane); continue; } r -= I_M;
        if (r < I_13) { const int e = r / 256, which = (r % 256) / 128, kb = (r % 128) / 8, nb = r % 8; const int n0 = 64 * nb;
            transpose_item_q8((which ? w3 : w1) + (size_t)e * 1024 * 512, 512, 64 * kb, n0, (unsigned char*)(ws + WS_W13Q) + (size_t)e * 1024 * 1024, 1024, (n0 / 128) * 256 + which * 128 + (n0 % 128), 64 * kb, g_ffn, 64.0f, scr, lane); continue; } r -= I_13;
        { const int bk = r / 256, hf = (r % 256) / 128, kb = (r % 128) / 16, nb = r % 16; const int g = bk / 6, p = bk % 6;
          const int pa = (p < 3) ? 0 : (p < 5 ? 1 : 2), pb = (p < 3) ? p + 1 : (p < 5 ? p - 1 : 3); const int e = 4 * g + (hf ? pb : pa);
          transpose_item_q8(w2 + (size_t)e * 512 * 1024, 1024, 64 * kb, 64 * nb, (unsigned char*)(ws + WS_W2P) + (size_t)bk * 1024 * 1024, 1024, 64 * nb, hf * 512 + 64 * kb, nullptr, 64.0f, scr, lane); }
    }
}

__device__ __forceinline__ v4u pack8(const f32x4& a, const f32x4& b) { v4u w; w.x = pk2(a[0], a[1]); w.y = pk2(a[2], a[3]); w.z = pk2(b[0], b[1]); w.w = pk2(b[2], b[3]); return w; }
struct EpiInProj {
    static constexpr bool PERM = true, AFTER_DRAIN = false; static constexpr int NSTORE = 16;
    bf16* base; const unsigned* ropep; const float* rs8; const unsigned* cmax;
    __device__ __forceinline__ void operator()(const f32x4 (&acc)[2][2][4][2], const pg8::Unit& u, int wr, int wc, int fr, int fq) const {
        const int buf = u.pn >> 1; bf16* B = base + (size_t)buf * T * 512;
        int row0 = u.pm * 256 + wr * 64 + fr; asm volatile("" : "+v"(row0));
        const int col0 = (u.pn & 1) * 256 + wc * 32 + 8 * fq;
        const bool dorope = (buf < 2) && ((wc & 1) == 0);
        f32x4 cs[2][2]; float rsv[8]; v4u rq[4][2], rq1[4][2];
#pragma unroll
        for (int bj = 0; bj < 2; ++bj)
#pragma unroll
            for (int n = 0; n < 2; ++n) { const v4u cu = *(const GAS v4u*)(cmax + u.pn * 256 + wc * 32 + 8 * fq + bj * 128 + 4 * n);
                cs[bj][n] = (f32x4){__uint_as_float(cu.x), __uint_as_float(cu.y), __uint_as_float(cu.z), __uint_as_float(cu.w)} * (1.0f / 127.0f); }
#pragma unroll
        for (int i = 0; i < 8; ++i) rsv[i] = ((const GAS float*)rs8)[row0 + (i >> 2) * 128 + (i & 3) * 16];
        if (dorope) {
#pragma unroll
            for (int m = 0; m < 4; ++m) { const GAS v4u* rp = (const GAS v4u*)(ropep + (size_t)(row0 + m * 16) * 8); rq[m][0] = rp[0]; rq[m][1] = rp[1]; } }
        const bool rot = fq < 2; const float sgn = (fq == 0) ? -1.0f : 1.0f;
        v4u outp[4][2];
#define EIP_ROW(AI, M, RQ, STORE) do { const int i8 = (AI) * 4 + (M); f32x4 c0, c1, s0, s1; \
            if (dorope) { _Pragma("unroll") for (int e = 0; e < 4; ++e) { const unsigned w0 = RQ[M][0][e], w1 = RQ[M][1][e]; \
                c0[e] = rot ? bflo(w0) : 1.0f; s0[e] = rot ? sgn * bfhi(w0) : 0.0f; c1[e] = rot ? bflo(w1) : 1.0f; s1[e] = rot ? sgn * bfhi(w1) : 0.0f; } } \
            _Pragma("unroll") for (int bj = 0; bj < 2; ++bj) { \
                f32x4 v0 = __builtin_convertvector(__builtin_bit_cast(pg8::v4i_t, acc[AI][bj][M][0]), f32x4) * rsv[i8] * cs[bj][0], v1 = __builtin_convertvector(__builtin_bit_cast(pg8::v4i_t, acc[AI][bj][M][1]), f32x4) * rsv[i8] * cs[bj][1]; \
                if (dorope) { _Pragma("unroll") for (int e = 0; e < 4; ++e) { \
                    const auto p0 = __builtin_amdgcn_permlane16_swap(__float_as_uint(v0[e]), __float_as_uint(v0[e]), false, false), p1 = __builtin_amdgcn_permlane16_swap(__float_as_uint(v1[e]), __float_as_uint(v1[e]), false, false); \
                    const float o0 = __uint_as_float((fq & 1) ? p0[0] : p0[1]), o1 = __uint_as_float((fq & 1) ? p1[0] : p1[1]); \
                    v0[e] = v0[e] * c0[e] + o0 * s0[e]; v1[e] = v1[e] * c1[e] + o1 * s1[e]; } } \
                STORE; } } while (0)
#pragma unroll
        for (int m = 0; m < 4; ++m) EIP_ROW(0, m, rq, outp[m][bj] = pack8(v0, v1));
        if (dorope) {
#pragma unroll
            for (int m = 0; m < 4; ++m) { const GAS v4u* rp = (const GAS v4u*)(ropep + (size_t)(row0 + 128 + m * 16) * 8); rq1[m][0] = rp[0]; rq1[m][1] = rp[1]; } }
        asm volatile("" ::: "memory");
#pragma unroll
        for (int m = 0; m < 4; ++m)
#pragma unroll
            for (int bj = 0; bj < 2; ++bj) *(GAS v4u*)(B + (size_t)(row0 + m * 16) * 512 + col0 + bj * 128) = outp[m][bj];
#pragma unroll
        for (int m = 0; m < 4; ++m) EIP_ROW(1, m, rq1, *(GAS v4u*)(B + (size_t)(row0 + 128 + m * 16) * 512 + col0 + bj * 128) = pack8(v0, v1));
#undef EIP_ROW
    }
};

#define MSB() __builtin_amdgcn_sched_barrier(0)
template <int NE, int NF, class LD, class USE>
__device__ __forceinline__ void frag_pipe(LD ld, USE use) {
    bf16x8 fa[NF], fb[NF];
    ld(fa, 0);
#pragma unroll
    for (int e = 0; e < NE; e += 2) {
        if (e + 1 < NE) ld(fb, e + 1);
        MSB(); use(fa, e); MSB();
        if (e + 2 < NE) ld(fa, e + 2);
        MSB(); if (e + 1 < NE) use(fb, e + 1); MSB();
    }
}
typedef short v4i16_t __attribute__((ext_vector_type(4)));
struct AttItem { int cfg, b, h, d, nb; size_t tokb; };
__device__ __forceinline__ AttItem attn_decode(int item) {
    AttItem a; a.cfg = item >> 12; int rem = item & 4095; a.b = rem >> 9; rem &= 511; a.h = rem >> 6; const int sub = rem & 63;
    a.d = (a.cfg == 0) ? 1 : (a.cfg == 1 ? 4 : 16); const int nblk = 64 / a.d, r = sub / nblk; a.nb = sub % nblk; a.tokb = (size_t)a.b * SEQ + r; return a;
}
__device__ __forceinline__ int attn_item_of(int k, int G) {
    if (G != 256) return (int)blockIdx.x + k * G;
    const int pair = (int)(blockIdx.x & 7) + 8 * (k / 6), j = (int)(blockIdx.x >> 3), ip = j * 6 + (k % 6);
    return ((ip >> 6) << 12) | (pair << 6) | (ip & 63);
}
__device__ __forceinline__ void glds16(const void* gsrc, unsigned lds_dst) { unsigned keep;
    asm volatile("s_mov_b32 %0, m0\n\ts_mov_b32 m0, %2\n\ts_nop 0\n\tglobal_load_lds_dwordx4 %1, off\n\ts_mov_b32 m0, %0" : "=&s"(keep) : "v"(gsrc), "s"(lds_dst) : "memory"); }
__device__ __forceinline__ unsigned lds_addr_of(LAS unsigned char* p) { return (unsigned)(uintptr_t)p; }
__device__ __forceinline__ void attn_prefetch(const Args& A, LAS unsigned char* L, int item, int pslot, int oslot, bool load_prev, int lane, int wave, bf16x8 (&qf)[2]) {
    const AttItem a = attn_decode(item);
    const bf16* Kg = (const bf16*)(A.ws + WS_K) + a.h * 64; const bf16* Vg = (const bf16*)(A.ws + WS_V) + a.h * 64; const bf16* Qg = (const bf16*)(A.ws + WS_Q) + a.h * 64;
#pragma unroll
    for (int i = 0; i < 2; ++i) { const int inst = wave + 8 * i, row = 8 * inst + (lane >> 3);
        const size_t off = (a.tokb + (size_t)(128 * a.nb + row) * a.d) * 512 + ((lane & 7) ^ (lane >> 3)) * 8;
        glds16(Kg + off, (unsigned)__builtin_amdgcn_readfirstlane(lds_addr_of(L + oslot * 32768 + inst * 1024)));
        glds16(Vg + off, (unsigned)__builtin_amdgcn_readfirstlane(lds_addr_of(L + oslot * 32768 + 16384 + inst * 1024))); }
    if (load_prev) {
#pragma unroll
        for (int i = 0; i < 2; ++i) { const int inst = wave + 8 * i, row = 8 * inst + (lane >> 3);
            const size_t off = (a.tokb + (size_t)(128 * (a.nb - 1) + row) * a.d) * 512 + ((lane & 7) ^ (lane >> 3)) * 8;
            glds16(Kg + off, (unsigned)__builtin_amdgcn_readfirstlane(lds_addr_of(L + pslot * 32768 + inst * 1024)));
            glds16(Vg + off, (unsigned)__builtin_amdgcn_readfirstlane(lds_addr_of(L + pslot * 32768 + 16384 + inst * 1024))); } }
    const size_t tq = a.tokb + (size_t)(128 * a.nb + 16 * wave + (lane & 15)) * a.d;
    qf[0] = *(const GAS bf16x8*)(Qg + tq * 512 + 8 * (lane >> 4)); qf[1] = *(const GAS bf16x8*)(Qg + tq * 512 + 32 + 8 * (lane >> 4));
}
__device__ __forceinline__ void attn_compute(const Args& A, LAS unsigned char* L, int item, int pslot, int oslot, int lane, int wave, const bf16x8 (&qf)[2]) {
    const AttItem a = attn_decode(item);
    const int fr = lane & 15, g = lane >> 4, qi = 16 * wave + fr;
    f32x4 s[10];
    { bf16x8 kf[9][2];
#pragma unroll
      for (int tt = 0; tt < 9; ++tt) { const int t = wave + tt, key = 16 * (t & 7) + fr; LAS unsigned char* kb = L + ((t < 8) ? pslot : oslot) * 32768;
#pragma unroll
          for (int ks = 0; ks < 2; ++ks) kf[tt][ks] = *(const LAS bf16x8*)(kb + key * 128 + (((4 * ks + g) ^ (key & 7)) * 16)); }
      MSB();
#pragma unroll
      for (int tt = 0; tt < 9; ++tt) { s[tt] = (f32x4){0.f, 0.f, 0.f, 0.f};
#pragma unroll
          for (int ks = 0; ks < 2; ++ks) s[tt] = __builtin_amdgcn_mfma_f32_16x16x32_bf16(kf[tt][ks], qf[ks], s[tt], 0, 0, 0); } }
    s[9] = (f32x4){0.f, 0.f, 0.f, 0.f};
#pragma unroll
    for (int e = 0; e < 4; ++e) { s[0][e] = (4 * g + e >= fr) ? s[0][e] : -1e30f; s[8][e] = (4 * g + e <= fr) ? s[8][e] : -1e30f; }
    if (__builtin_expect(a.nb == 0, 0)) {
        asm volatile("" ::: "memory");
#pragma unroll
        for (int tt = 0; tt < 8; ++tt) if (wave + tt < 8) s[tt] = (f32x4){-1e30f, -1e30f, -1e30f, -1e30f};
        asm volatile("" : "+v"(s[0]), "+v"(s[1]), "+v"(s[2]), "+v"(s[3]), "+v"(s[4]), "+v"(s[5]), "+v"(s[6]), "+v"(s[7]));
    }
    float mx;
    { float m0_, m1_;
      asm("v_max3_f32 %0, %1, %2, %3" : "=v"(m0_) : "v"(s[0][0]), "v"(s[0][1]), "v"(s[0][2]));
      asm("v_max3_f32 %0, %1, %2, %3" : "=v"(m1_) : "v"(s[0][3]), "v"(s[1][0]), "v"(s[1][1]));
      asm("v_max3_f32 %0, %1, %2, %3" : "=v"(m0_) : "v"(m0_), "v"(s[1][2]), "v"(s[1][3]));
#pragma unroll
      for (int tt = 2; tt < 9; ++tt) { asm("v_max3_f32 %0, %1, %2, %3" : "=v"(m0_) : "v"(m0_), "v"(s[tt][0]), "v"(s[tt][1])); asm("v_max3_f32 %0, %1, %2, %3" : "=v"(m1_) : "v"(m1_), "v"(s[tt][2]), "v"(s[tt][3])); }
      asm("v_max_f32_e32 %0, %1, %2" : "=v"(mx) : "v"(m0_), "v"(m1_)); }
    mx = xmax4(mx);
    float l = 0.f;
#pragma unroll
    for (int tt = 0; tt < 9; ++tt)
#pragma unroll
        for (int e = 0; e < 4; ++e) { s[tt][e] = __builtin_amdgcn_exp2f(s[tt][e] - mx); l += s[tt][e]; }
    l = xsum4(l);
    f32x4 o[4];
#pragma unroll
    for (int dt = 0; dt < 4; ++dt) o[dt] = (f32x4){0.f, 0.f, 0.f, 0.f};
    frag_pipe<5, 4>(
        [&](bf16x8 (&f)[4], int k5) __attribute__((always_inline)) {
            const int t0 = wave + 2 * k5, t1 = (wave + 2 * k5 + 1 < 16) ? wave + 2 * k5 + 1 : 15;
            const int r0 = 16 * (t0 & 7) + 4 * g + (fr >> 2), r1 = 16 * (t1 & 7) + 4 * g + (fr >> 2), p_ = fr & 3;
            LAS unsigned char* v0b = L + ((t0 < 8) ? pslot : oslot) * 32768 + 16384; LAS unsigned char* v1b = L + ((t1 < 8) ? pslot : oslot) * 32768 + 16384;
#pragma unroll
            for (int dt = 0; dt < 4; ++dt) { const int chunk = 2 * dt + (p_ >> 1);
                const v4i16_t v0 = __builtin_amdgcn_ds_read_tr16_b64_v4i16((LAS v4i16_t*)(v0b + r0 * 128 + ((chunk ^ (r0 & 7)) * 16) + 8 * (p_ & 1)));
                const v4i16_t v1 = __builtin_amdgcn_ds_read_tr16_b64_v4i16((LAS v4i16_t*)(v1b + r1 * 128 + ((chunk ^ (r1 & 7)) * 16) + 8 * (p_ & 1)));
                f[dt] = (bf16x8){v0[0], v0[1], v0[2], v0[3], v1[0], v1[1], v1[2], v1[3]}; } },
        [&](bf16x8 (&f)[4], int k5) __attribute__((always_inline)) {
            const v4u pw = (v4u){pk2(s[2 * k5][0], s[2 * k5][1]), pk2(s[2 * k5][2], s[2 * k5][3]), pk2(s[2 * k5 + 1][0], s[2 * k5 + 1][1]), pk2(s[2 * k5 + 1][2], s[2 * k5 + 1][3])};
            const bf16x8 pf = __builtin_bit_cast(bf16x8, pw);
#pragma unroll
            for (int dt = 0; dt < 4; ++dt) o[dt] = __builtin_amdgcn_mfma_f32_16x16x32_bf16(f[dt], pf, o[dt], 0, 0, 0); });
    const float rl = frcp_(l);
    const size_t tok = a.tokb + (size_t)(128 * a.nb + qi) * a.d;
    bf16* og = (bf16*)((unsigned char*)A.out + DO_OATT) + ((size_t)a.cfg * T + tok) * 512 + a.h * 64;
#pragma unroll
    for (int dt = 0; dt < 4; ++dt) *(GAS v2u*)(og + 16 * dt + 4 * g) = (v2u){pk2(o[dt][0] * rl, o[dt][1] * rl), pk2(o[dt][2] * rl, o[dt][3] * rl)};
    if (g == 0) ((GAS float*)(A.ws + WS_LSE))[((size_t)a.cfg * T + tok) * 8 + a.h] = mx + __builtin_amdgcn_logf(l);
}
__device__ __forceinline__ void attn_phase(const Args& A, unsigned char* lds, int n_total, int lane, int wave) {
    const int G = gridDim.x; LAS unsigned char* L = (LAS unsigned char*)lds;
    const int nk = (G == 256) ? n_total / 256 : (n_total - (int)blockIdx.x + G - 1) / G;
    if (nk <= 0) return;
    bf16x8 qa[2], qb[2];
    int it = attn_item_of(0, G); int ps, os;
    { const AttItem a = attn_decode(it); os = 0; ps = (a.nb > 0) ? 1 : 0; attn_prefetch(A, L, it, ps, os, a.nb > 0, lane, wave, qa); }
    for (int k = 0; k < nk; ++k) {
        if (k == 0) { __builtin_amdgcn_s_waitcnt(0x0F70); asm volatile("s_waitcnt vmcnt(0)" ::: "memory"); }
        else { __builtin_amdgcn_s_waitcnt(0x0F74); asm volatile("s_waitcnt vmcnt(4)" ::: "memory"); }
        __builtin_amdgcn_s_barrier();
        qb[0] = qa[0]; qb[1] = qa[1];
        int nit = it, nps = ps, nos = os;
        if (k + 1 < nk) { nit = attn_item_of(k + 1, G); const AttItem c = attn_decode(it), n = attn_decode(nit);
            const bool succ = (nit == it + 1) && (n.nb == c.nb + 1);
            const int used = (1 << ps) | (1 << os); const int f1 = (used & 1) ? ((used & 2) ? ((used & 4) ? 3 : 2) : 1) : 0; const int used2 = used | (1 << f1);
            const int f2 = (used2 & 1) ? ((used2 & 2) ? ((used2 & 4) ? 3 : 2) : 1) : 0;
            bool lp;
            if (succ) { nps = os; nos = f1; lp = false; } else if (n.nb == 0) { nos = f1; nps = f1; lp = false; } else { nps = f1; nos = f2; lp = true; }
            attn_prefetch(A, L, nit, nps, nos, lp, lane, wave, qb); }
        attn_compute(A, L, it, ps, os, lane, wave, qa);
        qa[0] = qb[0]; qa[1] = qb[1]; it = nit; ps = nps; os = nos;
    }
    asm volatile("s_waitcnt vmcnt(0)" ::: "memory");
    __syncthreads();
}

__device__ __forceinline__ void kv_tile(const Args& A, unsigned char* lds, int tile, int tid, int lane, int wave) {
    unsigned char* ws = A.ws;
    const int mt = tile >> 3, nt = tile & 7;
    const bf16* Ag = (const bf16*)(ws + WS_XN) + (size_t)(T + 64 * mt) * D; const bf16* Bg = (const bf16*)(ws + WS_WIN) + (size_t)(NIN + 64 * nt) * D;
    LAS bf16* As = (LAS bf16*)lds; LAS bf16* Bs = (LAS bf16*)(lds + 64 * 264 * 2);
    const int fr = lane & 15, fq = lane >> 4, wm = wave & 3, wn = wave >> 2;
    f32x4 acc[1][2]; acc[0][0] = (f32x4){0.f, 0.f, 0.f, 0.f}; acc[0][1] = (f32x4){0.f, 0.f, 0.f, 0.f};
    v4u ra[4], rb[4];
#pragma unroll
    for (int i = 0; i < 4; ++i) { const int id = tid + NTHR * i, row = id >> 5, ch = id & 31; ra[i] = *(const GAS v4u*)(Ag + (size_t)row * D + ch * 8); rb[i] = *(const GAS v4u*)(Bg + (size_t)row * D + ch * 8); }
    for (int kc = 0; kc < 4; ++kc) {
#pragma unroll
        for (int i = 0; i < 4; ++i) { const int id = tid + NTHR * i, row = id >> 5, ch = id & 31; *(LAS v4u*)(As + row * 264 + ch * 8) = ra[i]; *(LAS v4u*)(Bs + row * 264 + ch * 8) = rb[i]; }
        if (kc < 3) {
#pragma unroll
            for (int i = 0; i < 4; ++i) { const int id = tid + NTHR * i, row = id >> 5, ch = id & 31; ra[i] = *(const GAS v4u*)(Ag + (size_t)row * D + (kc + 1) * 256 + ch * 8); rb[i] = *(const GAS v4u*)(Bg + (size_t)row * D + (kc + 1) * 256 + ch * 8); } }
        __syncthreads();
        { const LAS bf16* Aw = As + 16 * wm * 264; const LAS bf16* Bw = Bs + 32 * wn * 264;
#pragma unroll
          for (int k0 = 0; k0 < 256; k0 += 32) { const bf16x8 a = *(const LAS bf16x8*)(Aw + fr * 264 + k0 + 8 * fq);
#pragma unroll
              for (int jn = 0; jn < 2; ++jn) acc[0][jn] = __builtin_amdgcn_mfma_f32_16x16x32_bf16(*(const LAS bf16x8*)(Bw + (16 * jn + fr) * 264 + k0 + 8 * fq), a, acc[0][jn], 0, 0, 0); } }
        __syncthreads();
    }
    bf16* og = (bf16*)(ws + WS_KVX) + (size_t)(64 * mt + 16 * wm + fr) * NKV + 64 * nt + 32 * wn;
#pragma unroll
    for (int j = 0; j < 2; ++j) *(GAS v2u*)(og + 16 * j + 4 * fq) = (v2u){pk2(acc[0][j][0], acc[0][j][1]), pk2(acc[0][j][2], acc[0][j][3])};
}

constexpr int ML_TILE = 32768;
constexpr int ML_G = 4 * ML_TILE;
static_assert(ML_G + 8192 <= LDS_MISC, "mlstm LDS");
__device__ __forceinline__ int sw_off(int row, int ch) { return 256 * row + 16 * (ch ^ (((row & 3) << 2) | ((row >> 2) & 3))); }
__device__ __forceinline__ bf16x8 rowfrag(LAS unsigned char* tile, int row0, int ks, int fr, int g) { return *(const LAS bf16x8*)(tile + sw_off(row0 + fr, 4 * ks + g)); }
__device__ __forceinline__ bf16x8 colfrag(LAS unsigned char* tile, int ks, int ct, int fr, int g) {
    const int r0 = 32 * ks + 8 * g + (fr >> 2), p = fr & 3, ch = 2 * ct + (p >> 1);
    const v4i16_t a = __builtin_amdgcn_ds_read_tr16_b64_v4i16((LAS v4i16_t*)(tile + sw_off(r0, ch) + 8 * (p & 1)));
    const v4i16_t b = __builtin_amdgcn_ds_read_tr16_b64_v4i16((LAS v4i16_t*)(tile + sw_off(r0 + 4, ch) + 8 * (p & 1)));
    return (bf16x8){a[0], a[1], a[2], a[3], b[0], b[1], b[2], b[3]};
}
__device__ __forceinline__ float log_sigmoidf_(float x) { return (x > 0.f) ? -log1pf(__expf(-x)) : (x - log1pf(__expf(x))); }
__device__ __forceinline__ float wscan_sum(float v0, float v1, float& o0, float& o1, int lane) {
    float x = v0 + v1;
#pragma unroll
    for (int off = 1; off < 64; off <<= 1) { const float t = __shfl_up(x, off); if (lane >= off) x += t; }
    o0 = x - v1; o1 = x; return __shfl(x, 63);
}
__device__ __forceinline__ void wscan_max(float v0, float v1, float& o0, float& o1, int lane) {
    float y = fmaxf(v0, v1);
#pragma unroll
    for (int off = 1; off < 64; off <<= 1) { const float t = __shfl_up(y, off); if (lane >= off) y = fmaxf(y, t); }
    float pre = __shfl_up(y, 1); if (lane == 0) pre = -INFINITY;
    o0 = fmaxf(pre, v0); o1 = fmaxf(pre, fmaxf(v0, v1));
}
__device__ __forceinline__ void tile_load(LAS unsigned char* tile, const bf16* src, size_t pitch, int tid) {
    v4u v[4];
#pragma unroll
    for (int i = 0; i < 4; ++i) { const int id = tid + NTHR * i, row = id >> 4, ch = id & 15; v[i] = *(const GAS v4u*)(src + (size_t)row * pitch + ch * 8); }
#pragma unroll
    for (int i = 0; i < 4; ++i) { const int id = tid + NTHR * i, row = id >> 4, ch = id & 15; *(LAS v4u*)(tile + sw_off(row, ch)) = v[i]; }
}

struct TileRegs { v4u v[4]; };
__device__ __forceinline__ void tile_ld(TileRegs& r, const bf16* src, size_t pitch, int tid) {
#pragma unroll
    for (int i = 0; i < 4; ++i) { const int id = tid + NTHR * i, row = id >> 4, ch = id & 15; r.v[i] = *(const GAS v4u*)(src + (size_t)row * pitch + ch * 8); }
}
__device__ __forceinline__ void tile_st(LAS unsigned char* tile, const TileRegs& r, int tid) {
#pragma unroll
    for (int i = 0; i < 4; ++i) { const int id = tid + NTHR * i, row = id >> 4, ch = id & 15; *(LAS v4u*)(tile + sw_off(row, ch)) = r.v[i]; }
}
struct ConvRegs { v4u m[7]; f32x4 w[4][2], b[2]; };
__device__ __forceinline__ void conv_ld(ConvRegs& r, const bf16* MU, const float* conv_w, const float* conv_b, int b, int c, int h, int tid) {
    const int ch = (tid & 15) * 8, l0 = (tid >> 4) * 4;
#pragma unroll
    for (int q = 0; q < 7; ++q) { const int sp = 128 * c + l0 + q - 3; const v4u t = *(const GAS v4u*)(MU + ((size_t)b * SEQ + (sp < 0 ? 0 : sp)) * 512 + ch);
        const unsigned msk = (sp >= 0) ? 0xffffffffu : 0u; r.m[q] = (v4u){t.x & msk, t.y & msk, t.z & msk, t.w & msk}; }
#pragma unroll
    for (int j = 0; j < 4; ++j) { r.w[j][0] = *(const GAS f32x4*)(conv_w + j * 512 + h * 128 + ch); r.w[j][1] = *(const GAS f32x4*)(conv_w + j * 512 + h * 128 + ch + 4); }
    r.b[0] = *(const GAS f32x4*)(conv_b + h * 128 + ch); r.b[1] = *(const GAS f32x4*)(conv_b + h * 128 + ch + 4);
}
__device__ __forceinline__ void conv_fin(LAS unsigned char* cA, const ConvRegs& r, int tid) {
    const int l0 = (tid >> 4) * 4;
#pragma unroll
    for (int i = 0; i < 4; ++i) { float a[8];
#pragma unroll
        for (int q = 0; q < 8; ++q) a[q] = r.b[q >> 2][q & 3];
#pragma unroll
        for (int j = 0; j < 4; ++j) { const v4u mm = r.m[i + j]; const f32x4 w0 = r.w[j][0], w1 = r.w[j][1];
            a[0] += bflo(mm.x) * w0[0]; a[1] += bfhi(mm.x) * w0[1]; a[2] += bflo(mm.y) * w0[2]; a[3] += bfhi(mm.y) * w0[3];
            a[4] += bflo(mm.z) * w1[0]; a[5] += bfhi(mm.z) * w1[1]; a[6] += bflo(mm.w) * w1[2]; a[7] += bfhi(mm.w) * w1[3]; }
#pragma unroll
        for (int q = 0; q < 8; ++q) a[q] = a[q] * sigmoidf_(a[q]);
        *(LAS v4u*)(cA + sw_off(l0 + i, tid & 15)) = (v4u){pk2(a[0], a[1]), pk2(a[2], a[3]), pk2(a[4], a[5]), pk2(a[6], a[7])}; }
}
__device__ __forceinline__ void ml_conv_tile(LAS unsigned char* cA, const bf16* MU, const float* conv_w, const float* conv_b, int b, int c, int h, int tid) {
    const int ch = (tid & 15) * 8, l0 = (tid >> 4) * 4;
    float w[4][8], bs[8];
#pragma unroll
    for (int j = 0; j < 4; ++j) { const f32x4 w0 = *(const GAS f32x4*)(conv_w + j * 512 + h * 128 + ch), w1 = *(const GAS f32x4*)(conv_w + j * 512 + h * 128 + ch + 4);
        w[j][0] = w0[0]; w[j][1] = w0[1]; w[j][2] = w0[2]; w[j][3] = w0[3]; w[j][4] = w1[0]; w[j][5] = w1[1]; w[j][6] = w1[2]; w[j][7] = w1[3]; }
    { const f32x4 b0 = *(const GAS f32x4*)(conv_b + h * 128 + ch), b1 = *(const GAS f32x4*)(conv_b + h * 128 + ch + 4);
      bs[0] = b0[0]; bs[1] = b0[1]; bs[2] = b0[2]; bs[3] = b0[3]; bs[4] = b1[0]; bs[5] = b1[1]; bs[6] = b1[2]; bs[7] = b1[3]; }
    v4u m[7];
#pragma unroll
    for (int r = 0; r < 7; ++r) { const int sp = 128 * c + l0 + r - 3; const v4u t = *(const GAS v4u*)(MU + ((size_t)b * SEQ + (sp < 0 ? 0 : sp)) * 512 + ch);
        const unsigned msk = (sp >= 0) ? 0xffffffffu : 0u; m[r] = (v4u){t.x & msk, t.y & msk, t.z & msk, t.w & msk}; }
#pragma unroll
    for (int i = 0; i < 4; ++i) { float a[8];
#pragma unroll
        for (int q = 0; q < 8; ++q) a[q] = bs[q];
#pragma unroll
        for (int j = 0; j < 4; ++j) { const v4u mm = m[i + j];
            a[0] += bflo(mm.x) * w[j][0]; a[1] += bfhi(mm.x) * w[j][1]; a[2] += bflo(mm.y) * w[j][2]; a[3] += bfhi(mm.y) * w[j][3];
            a[4] += bflo(mm.z) * w[j][4]; a[5] += bfhi(mm.z) * w[j][5]; a[6] += bflo(mm.w) * w[j][6]; a[7] += bfhi(mm.w) * w[j][7]; }
#pragma unroll
        for (int q = 0; q < 8; ++q) a[q] = a[q] * sigmoidf_(a[q]);
        *(LAS v4u*)(cA + sw_off(l0 + i, tid & 15)) = (v4u){pk2(a[0], a[1]), pk2(a[2], a[3]), pk2(a[4], a[5]), pk2(a[6], a[7])}; }
}
struct MGroup { f32x4 G[8]; f32x4 Gn; float B, M; };
struct P1Pre { TileRegs r3; ConvRegs cr; float gi0, gi1, gf0, gf1; };
__device__ __forceinline__ void p1_prefetch(P1Pre& r, const Args& A, int item, int tid, int lane) {
    unsigned char* ws = A.ws;
    const int bh = item >> 6, c = item & 63, b = bh >> 2, h = bh & 3; const size_t t0 = (size_t)b * SEQ + 128 * c;
    tile_ld(r.r3, (const bf16*)(ws + WS_MV) + t0 * 512 + h * 128, 512, tid);
    conv_ld(r.cr, (const bf16*)(ws + WS_MU) + h * 128, (const float*)(ws + WS_PAR) + PAR_CONVW, (const float*)(ws + WS_PAR) + PAR_CONVB, b, c, h, tid);
    const size_t gi_ = (size_t)bh * SEQ + 128 * c + 2 * lane;
    r.gi0 = ((const GAS float*)(ws + WS_IG))[gi_]; r.gi1 = ((const GAS float*)(ws + WS_IG))[gi_ + 1]; r.gf0 = ((const GAS float*)(ws + WS_FG))[gi_]; r.gf1 = ((const GAS float*)(ws + WS_FG))[gi_ + 1];
}
__device__ __forceinline__ void mlstm_p1_item(const Args& A, unsigned char* lds_, int item, int& wres, MGroup& mg, int tid, int lane, int wave, P1Pre& pre, const bool more) {
    asm volatile("" : "+v"(tid), "+v"(lane));
    unsigned char* ws = A.ws; LAS unsigned char* lds = (LAS unsigned char*)lds_;
    const int bh = item >> 6, c = item & 63, b = bh >> 2, h = bh & 3;
    const size_t t0 = (size_t)b * SEQ + 128 * c;
    LAS unsigned char* cA = lds; LAS unsigned char* Wk = lds + 2 * ML_TILE; LAS unsigned char* Vt = lds + 3 * ML_TILE;
    LAS float* gl = (LAS float*)(lds + ML_G);
    const int fr = lane & 15, g = lane >> 4, m0 = 16 * wave;
    if (wres != h) { tile_load(Wk, (const bf16*)(ws + WS_WM) + (size_t)(4 + h) * 128 * 128, 128, tid); wres = h; }
    tile_st(Vt, pre.r3, tid); conv_fin(cA, pre.cr, tid);
    const float gi0_ = pre.gi0, gi1_ = pre.gi1, gf0_ = pre.gf0, gf1_ = pre.gf1;
    asm volatile("" ::: "memory");
    if (more) p1_prefetch(pre, A, item + 1, tid, lane);
    float blast, mloc;
    { const float i0 = gi0_, i1 = gi1_, f0 = log_sigmoidf_(gf0_), f1 = log_sigmoidf_(gf1_);
      float b0, b1; blast = wscan_sum(f0, f1, b0, b1, lane);
      const float g0 = blast - b0 + i0, g1 = blast - b1 + i1; mloc = wave_max(fmaxf(g0, g1));
      gl[2 * lane] = fexp_(g0 - mloc); gl[2 * lane + 1] = fexp_(g1 - mloc); }
    __syncthreads();
    { bf16x8 af[4];
#pragma unroll
      for (int ks = 0; ks < 4; ++ks) af[ks] = rowfrag(cA, m0, ks, fr, g);
      const float wk = gl[m0 + fr];
      v2u kp[8];
      frag_pipe<8, 4>(
          [&](bf16x8 (&f)[4], int j) __attribute__((always_inline)) {
#pragma unroll
              for (int ks = 0; ks < 4; ++ks) f[ks] = rowfrag(Wk, 16 * j, ks, fr, g); },
          [&](bf16x8 (&f)[4], int j) __attribute__((always_inline)) { f32x4 acc = (f32x4){0.f, 0.f, 0.f, 0.f};
#pragma unroll
              for (int ks = 0; ks < 4; ++ks) acc = __builtin_amdgcn_mfma_f32_16x16x32_bf16(f[ks], af[ks], acc, 0, 0, 0);
              kp[j] = (v2u){pk2(acc[0] * wk, acc[1] * wk), pk2(acc[2] * wk, acc[3] * wk)}; });
#pragma unroll
      for (int j = 0; j < 8; ++j) *(LAS v2u*)(cA + sw_off(m0 + fr, 2 * j + (g >> 1)) + 8 * (g & 1)) = kp[j]; }
    __syncthreads();
    { f32x4 acc[8], accn = (f32x4){0.f, 0.f, 0.f, 0.f};
#pragma unroll
      for (int j = 0; j < 8; ++j) acc[j] = (f32x4){0.f, 0.f, 0.f, 0.f};
      const bf16x8 ones = (bf16x8){0x3f80, 0x3f80, 0x3f80, 0x3f80, 0x3f80, 0x3f80, 0x3f80, 0x3f80};
      bf16x8 vfa[4];
      { bf16x8 kw_[4];
#pragma unroll
        for (int ks = 0; ks < 4; ++ks) { vfa[ks] = colfrag(Vt, ks, wave, fr, g); kw_[ks] = colfrag(cA, ks, wave, fr, g); }
#pragma unroll
        for (int ks = 0; ks < 4; ++ks) accn = __builtin_amdgcn_mfma_f32_16x16x32_bf16(kw_[ks], ones, accn, 0, 0, 0); }
      frag_pipe<8, 4>(
          [&](bf16x8 (&f)[4], int e) __attribute__((always_inline)) {
#pragma unroll
              for (int t = 0; t < 4; ++t) f[t] = colfrag(cA, e >> 1, 4 * (e & 1) + t, fr, g); },
          [&](bf16x8 (&f)[4], int e) __attribute__((always_inline)) {
#pragma unroll
              for (int t = 0; t < 4; ++t) acc[4 * (e & 1) + t] = __builtin_amdgcn_mfma_f32_16x16x32_bf16(f[t], vfa[e >> 1], acc[4 * (e & 1) + t], 0, 0, 0); });
      if ((c & 7) == 0) {
#pragma unroll
          for (int j = 0; j < 8; ++j) mg.G[j] = acc[j];
          mg.Gn = accn; mg.M = mloc; mg.B = blast;
      } else { const float mnew = fmaxf(blast + mg.M, mloc), a = fexp_(blast + mg.M - mnew), cc = fexp_(mloc - mnew);
#pragma unroll
          for (int j = 0; j < 8; ++j) mg.G[j] = mg.G[j] * a + acc[j] * cc;
          mg.Gn = mg.Gn * a + accn * cc; mg.M = mnew; mg.B += blast; }
      if ((c & 7) == 7) { const int gi = bh * 8 + (c >> 3);
          bf16* gg = (bf16*)(ws + WS_GAGG) + ((size_t)gi * 128 + m0 + fr) * 128;
#pragma unroll
          for (int j = 0; j < 8; ++j) *(v2u*)(gg + 16 * j + 4 * g) = (v2u){pk2(mg.G[j][0], mg.G[j][1]), pk2(mg.G[j][2], mg.G[j][3])};
          if (fr == 0) *(f32x4*)((float*)(ws + WS_GN) + (size_t)gi * 128 + 16 * wave + 4 * g) = mg.Gn;
          if (wave == 0 && lane == 0) { ((float*)(ws + WS_GSC))[2 * gi] = mg.B; ((float*)(ws + WS_GSC))[2 * gi + 1] = mg.M; } } }
    __syncthreads();
}

__device__ __forceinline__ void combine_rows(const Args& A, size_t row0, int nrows, int tid) {
    unsigned char* ws = A.ws;
    const bf16* OA = (const bf16*)((const unsigned char*)A.out + DO_OATT); const float* LSE = (const float*)(ws + WS_LSE);
    for (int id = tid; id < nrows * 64; id += NTHR) {
        const size_t t = row0 + (id >> 6); const int h = (id & 63) >> 3, ch = (id & 7) * 8;
        const float l0 = LSE[t * 8 + h], l1 = LSE[((size_t)T + t) * 8 + h], l2 = LSE[((size_t)2 * T + t) * 8 + h];
        const float mx = fmaxf(l0, fmaxf(l1, l2)); float w0 = __builtin_amdgcn_exp2f(l0 - mx), w1 = __builtin_amdgcn_exp2f(l1 - mx), w2 = __builtin_amdgcn_exp2f(l2 - mx);
        const float rs = frcp_(w0 + w1 + w2); w0 *= rs; w1 *= rs; w2 *= rs;
        const v4u a = *(const v4u*)(OA + t * 512 + h * 64 + ch), b = *(const v4u*)(OA + ((size_t)T + t) * 512 + h * 64 + ch), c = *(const v4u*)(OA + ((size_t)2 * T + t) * 512 + h * 64 + ch);
        v4u o;
        o.x = pk2(w0 * bflo(a.x) + w1 * bflo(b.x) + w2 * bflo(c.x), w0 * bfhi(a.x) + w1 * bfhi(b.x) + w2 * bfhi(c.x));
        o.y = pk2(w0 * bflo(a.y) + w1 * bflo(b.y) + w2 * bflo(c.y), w0 * bfhi(a.y) + w1 * bfhi(b.y) + w2 * bfhi(c.y));
        o.z = pk2(w0 * bflo(a.z) + w1 * bflo(b.z) + w2 * bflo(c.z), w0 * bfhi(a.z) + w1 * bfhi(b.z) + w2 * bfhi(c.z));
        o.w = pk2(w0 * bflo(a.w) + w1 * bflo(b.w) + w2 * bflo(c.w), w0 * bfhi(a.w) + w1 * bfhi(b.w) + w2 * bfhi(c.w));
        *(v4u*)((bf16*)(ws + WS_Y) + t * 1024 + h * 64 + ch) = o;
    }
}

struct CombRegs { v4u a[4], b[4], c[4]; float l0[4], l1[4], l2[4]; };
__device__ __forceinline__ void comb_ld(CombRegs& r, const Args& A, size_t row0, int tid) {
    const bf16* OA = (const bf16*)((const unsigned char*)A.out + DO_OATT); const float* LSE = (const float*)(A.ws + WS_LSE);
#pragma unroll
    for (int i = 0; i < 4; ++i) { const int id = tid + NTHR * i; const size_t t = row0 + (id >> 6); const int h = (id & 63) >> 3, ch = (id & 7) * 8;
        r.l0[i] = ((const GAS float*)LSE)[t * 8 + h]; r.l1[i] = ((const GAS float*)LSE)[((size_t)T + t) * 8 + h]; r.l2[i] = ((const GAS float*)LSE)[((size_t)2 * T + t) * 8 + h];
        r.a[i] = *(const GAS v4u*)(OA + t * 512 + h * 64 + ch); r.b[i] = *(const GAS v4u*)(OA + ((size_t)T + t) * 512 + h * 64 + ch); r.c[i] = *(const GAS v4u*)(OA + ((size_t)2 * T + t) * 512 + h * 64 + ch); }
}
__device__ __forceinline__ void comb_fin(const CombRegs& r, const Args& A, size_t row0, int tid) {
#pragma unroll
    for (int i = 0; i < 4; ++i) { const int id = tid + NTHR * i; const size_t t = row0 + (id >> 6); const int h = (id & 63) >> 3, ch = (id & 7) * 8;
        const float l0 = r.l0[i], l1 = r.l1[i], l2 = r.l2[i];
        const float mx = fmaxf(l0, fmaxf(l1, l2)); float w0 = __builtin_amdgcn_exp2f(l0 - mx), w1 = __builtin_amdgcn_exp2f(l1 - mx), w2 = __builtin_amdgcn_exp2f(l2 - mx);
        const float rs = frcp_(w0 + w1 + w2); w0 *= rs; w1 *= rs; w2 *= rs;
        const v4u a = r.a[i], b = r.b[i], c = r.c[i]; v4u o;
        o.x = pk2(w0 * bflo(a.x) + w1 * bflo(b.x) + w2 * bflo(c.x), w0 * bfhi(a.x) + w1 * bfhi(b.x) + w2 * bfhi(c.x));
        o.y = pk2(w0 * bflo(a.y) + w1 * bflo(b.y) + w2 * bflo(c.y), w0 * bfhi(a.y) + w1 * bfhi(b.y) + w2 * bfhi(c.y));
        o.z = pk2(w0 * bflo(a.z) + w1 * bflo(b.z) + w2 * bflo(c.z), w0 * bfhi(a.z) + w1 * bfhi(b.z) + w2 * bfhi(c.z));
        o.w = pk2(w0 * bflo(a.w) + w1 * bflo(b.w) + w2 * bflo(c.w), w0 * bfhi(a.w) + w1 * bfhi(b.w) + w2 * bfhi(c.w));
        *(GAS v4u*)((bf16*)(A.ws + WS_Y) + t * 1024 + h * 64 + ch) = o; }
}
struct MState { f32x4 C[8]; float n0, n1, m; };
__device__ __forceinline__ void mlstm2_entry(const Args& A, int bh, int grp, MState& st, int lane, int wave) {
    asm volatile("" : "+v"(lane));
    unsigned char* ws = A.ws; const int fr = lane & 15, g = lane >> 4, m0 = 16 * wave;
#pragma unroll
    for (int j = 0; j < 8; ++j) st.C[j] = (f32x4){0.f, 0.f, 0.f, 0.f};
    st.n0 = 0.f; st.n1 = 0.f; st.m = 0.f;
#pragma unroll
    for (int g0 = 0; g0 < 8; g0 += 4) { if (g0 >= grp) break;
        v2u gw_[4][8]; float gB[4], gM[4], gn0[4], gn1[4];
#pragma unroll
        for (int q = 0; q < 4; ++q) { const int gp = g0 + q, gi = bh * 8 + (gp < grp ? gp : 0);
            gB[q] = ((const GAS float*)(ws + WS_GSC))[2 * gi]; gM[q] = ((const GAS float*)(ws + WS_GSC))[2 * gi + 1];
            const bf16* gg = (const bf16*)(ws + WS_GAGG) + ((size_t)gi * 128 + m0 + fr) * 128;
#pragma unroll
            for (int j = 0; j < 8; ++j) gw_[q][j] = *(const GAS v2u*)(gg + 16 * j + 4 * g);
            const float* gn = (const float*)(ws + WS_GN) + (size_t)gi * 128 + 2 * lane; gn0[q] = ((const GAS float*)gn)[0]; gn1[q] = ((const GAS float*)gn)[1]; }
#pragma unroll
        for (int q = 0; q < 4; ++q) if (g0 + q < grp) { const float B = gB[q], M = gM[q];
            const float mnew = fmaxf(B + st.m, M), a = fexp_(B + st.m - mnew), cc = fexp_(M - mnew);
#pragma unroll
            for (int j = 0; j < 8; ++j) { const v2u w = gw_[q][j]; st.C[j] = st.C[j] * a + (f32x4){bflo(w.x), bfhi(w.x), bflo(w.y), bfhi(w.y)} * cc; }
            st.n0 = st.n0 * a + gn0[q] * cc; st.n1 = st.n1 * a + gn1[q] * cc; st.m = mnew; } }
}
__device__ __forceinline__ void mlstm_p2_item(const Args& A, unsigned char* lds_, int item, MState& st, int tid, int lane, int wave, const bool do_comb, const size_t crow0) {
    asm volatile("" : "+v"(tid), "+v"(lane));
    unsigned char* ws = A.ws; LAS unsigned char* lds = (LAS unsigned char*)lds_;
    const float* g_mhn = (const float*)(ws + WS_PAR) + PAR_GMHN; const float* skip_m = (const float*)(ws + WS_PAR) + PAR_SKIP;
    const int bh = item >> 6, c = item & 63, b = bh >> 2, h = bh & 3;
    const size_t t0 = (size_t)b * SEQ + 128 * c;
    LAS unsigned char* T0 = lds; LAS unsigned char* T1 = lds + ML_TILE; LAS unsigned char* T2 = lds + 2 * ML_TILE; LAS unsigned char* T3 = lds + 3 * ML_TILE;
    LAS float* gl = (LAS float*)(lds + ML_G);
    const int fr = lane & 15, g = lane >> 4, m0 = 16 * wave, l = m0 + fr;
    TileRegs r1, r2, r3; ConvRegs cr;
    { const bf16* Wg = (const bf16*)(ws + WS_WM) + (size_t)h * 128 * 128; tile_ld(r1, Wg, 128, tid); tile_ld(r2, Wg + 4 * 128 * 128, 128, tid); }
    tile_ld(r3, (const bf16*)(ws + WS_MV) + t0 * 512 + h * 128, 512, tid);
    conv_ld(cr, (const bf16*)(ws + WS_MU) + h * 128, (const float*)(ws + WS_PAR) + PAR_CONVW, (const float*)(ws + WS_PAR) + PAR_CONVB, b, c, h, tid);
    const size_t gi_ = (size_t)bh * SEQ + 128 * c + 2 * lane;
    const float gi0_ = ((const GAS float*)(ws + WS_IG))[gi_], gi1_ = ((const GAS float*)(ws + WS_IG))[gi_ + 1], gf0_ = ((const GAS float*)(ws + WS_FG))[gi_], gf1_ = ((const GAS float*)(ws + WS_FG))[gi_ + 1];
    f32x4 gsk_ = (f32x4){0.f, 0.f, 0.f, 0.f};
    if (tid < 64) gsk_ = *(const GAS f32x4*)(((tid < 32) ? g_mhn : skip_m - 128) + h * 128 + 4 * tid);
    CombRegs cb; if (do_comb) comb_ld(cb, A, crow0, tid);
    asm volatile("" ::: "memory");
    tile_st(T1, r1, tid); tile_st(T2, r2, tid); tile_st(T3, r3, tid); conv_fin(T0, cr, tid);
    float blast, mloc;
    { const float mprev = st.m;
      const float i0 = gi0_, i1 = gi1_, f0 = log_sigmoidf_(gf0_), f1 = log_sigmoidf_(gf1_);
      float b0, b1; blast = wscan_sum(f0, f1, b0, b1, lane);
      const float g0 = blast - b0 + i0, g1 = blast - b1 + i1; mloc = wave_max(fmaxf(g0, g1));
      gl[640 + 2 * lane] = fexp_(g0 - mloc); gl[640 + 2 * lane + 1] = fexp_(g1 - mloc);
      const float a0 = i0 - b0, a1 = i1 - b1; float p0, p1; wscan_max(a0, a1, p0, p1, lane);
      const float mt0 = fmaxf(b0 + mprev, b0 + p0), mt1 = fmaxf(b1 + mprev, b1 + p1);
      gl[2 * lane] = a0; gl[2 * lane + 1] = a1; gl[128 + 2 * lane] = b0 - mt0; gl[128 + 2 * lane + 1] = b1 - mt1;
      gl[256 + 2 * lane] = fexp_(b0 + mprev - mt0); gl[256 + 2 * lane + 1] = fexp_(b1 + mprev - mt1); gl[384 + 2 * lane] = fexp_(-mt0); gl[384 + 2 * lane + 1] = fexp_(-mt1);
      gl[512 + 2 * lane] = st.n0; gl[512 + 2 * lane + 1] = st.n1; }
    if (tid < 64) *(LAS f32x4*)(gl + 896 + 4 * tid) = gsk_;
    if (do_comb) comb_fin(cb, A, crow0, tid);
    __syncthreads();
    if ((item & 7) != 7) {
        const unsigned dump = (unsigned)(uintptr_t)(lds + ML_G + 8192);
        const char* bv = (const char*)((const bf16*)(ws + WS_MV) + (t0 + 128) * 512 + h * 128);
        const char* bu = (const char*)((const bf16*)(ws + WS_MU) + (t0 + 128) * 512 + h * 128);
#pragma unroll
        for (int i = 0; i < 4; ++i) { const int id = tid + NTHR * i; const unsigned off = (unsigned)((id >> 4) * 1024 + (id & 15) * 16);
            pg8::glds16s(bv, off, dump); pg8::glds16s(bu, off, dump); } }
    v2u cp[8], qp[8], kp[8];
    { bf16x8 af[4];
#pragma unroll
      for (int ks = 0; ks < 4; ++ks) af[ks] = rowfrag(T0, m0, ks, fr, g);
#pragma unroll
      for (int j = 0; j < 8; ++j) cp[j] = *(const LAS v2u*)(T0 + sw_off(l, 2 * j + (g >> 1)) + 8 * (g & 1));
      frag_pipe<16, 4>(
          [&](bf16x8 (&f)[4], int jj) __attribute__((always_inline)) { LAS unsigned char* Tw = (jj < 8) ? T1 : T2;
#pragma unroll
              for (int ks = 0; ks < 4; ++ks) f[ks] = rowfrag(Tw, 16 * (jj & 7), ks, fr, g); },
          [&](bf16x8 (&f)[4], int jj) __attribute__((always_inline)) { f32x4 acc = (f32x4){0.f, 0.f, 0.f, 0.f};
#pragma unroll
              for (int ks = 0; ks < 4; ++ks) acc = __builtin_amdgcn_mfma_f32_16x16x32_bf16(f[ks], af[ks], acc, 0, 0, 0);
              const v2u pkd = (v2u){pk2(acc[0], acc[1]), pk2(acc[2], acc[3])};
              if (jj < 8) qp[jj & 7] = pkd; else kp[jj & 7] = pkd; }); }
    __syncthreads();
#pragma unroll
    for (int j = 0; j < 8; ++j) { const int off = sw_off(l, 2 * j + (g >> 1)) + 8 * (g & 1);
        *(LAS v2u*)(T1 + off) = qp[j]; *(LAS v2u*)(T0 + off) = kp[j]; *(LAS v2u*)(T2 + off) = (v2u){pk2(st.C[j][0], st.C[j][1]), pk2(st.C[j][2], st.C[j][3])}; }
    __syncthreads();
    v2u mop[8];
    { const bf16* MOg = (const bf16*)(ws + WS_MO) + (t0 + l) * 512 + h * 128;
#pragma unroll
      for (int j = 0; j < 8; ++j) mop[j] = *(const GAS v2u*)(MOg + 16 * j + 4 * g); }
    bf16x8 qf[4];
#pragma unroll
    for (int ks = 0; ks < 4; ++ks) qf[ks] = rowfrag(T1, m0, ks, fr, g);
    float qn = 0.f;
    { const LAS float* np = gl + 512;
#pragma unroll
      for (int ks = 0; ks < 4; ++ks) { const f32x4 n0 = *(const LAS f32x4*)(np + 32 * ks + 8 * g), n1 = *(const LAS f32x4*)(np + 32 * ks + 8 * g + 4); const v4u w = __builtin_bit_cast(v4u, qf[ks]);
          qn += bflo(w.x) * n0[0] + bfhi(w.x) * n0[1] + bflo(w.y) * n0[2] + bfhi(w.y) * n0[3] + bflo(w.z) * n1[0] + bfhi(w.z) * n1[1] + bflo(w.w) * n1[2] + bfhi(w.w) * n1[3]; }
      qn = xsum4(qn); }
    float den = 0.f;
    { const float rc = gl[128 + l];
      frag_pipe<8, 4>(
          [&](bf16x8 (&f)[4], int j) __attribute__((always_inline)) {
#pragma unroll
              for (int ks = 0; ks < 4; ++ks) f[ks] = rowfrag(T0, 16 * j, ks, fr, g); },
          [&](bf16x8 (&f)[4], int j) __attribute__((always_inline)) { f32x4 acc = (f32x4){0.f, 0.f, 0.f, 0.f};
              if (j <= wave) {
                  const f32x4 av = *(const LAS f32x4*)(gl + 16 * j + 4 * g);
#pragma unroll
                  for (int ks = 0; ks < 4; ++ks) acc = __builtin_amdgcn_mfma_f32_16x16x32_bf16(f[ks], qf[ks], acc, 0, 0, 0);
#pragma unroll
                  for (int q = 0; q < 4; ++q) { const int sx = 16 * j + 4 * g + q; acc[q] = (sx <= l) ? acc[q] * fexp_(rc + av[q]) : 0.f; den += acc[q]; } }
              *(LAS v2u*)(T1 + sw_off(l, 2 * j + (g >> 1)) + 8 * (g & 1)) = (v2u){pk2(acc[0], acc[1]), pk2(acc[2], acc[3])}; });
      den = xsum4(den); }
    f32x4 acc[8];
    const float iw = gl[256 + l];
    frag_pipe<8, 4>(
        [&](bf16x8 (&f)[4], int j) __attribute__((always_inline)) {
#pragma unroll
            for (int ks = 0; ks < 4; ++ks) f[ks] = rowfrag(T2, 16 * j, ks, fr, g); },
        [&](bf16x8 (&f)[4], int j) __attribute__((always_inline)) { f32x4 a_ = (f32x4){0.f, 0.f, 0.f, 0.f};
#pragma unroll
            for (int ks = 0; ks < 4; ++ks) a_ = __builtin_amdgcn_mfma_f32_16x16x32_bf16(f[ks], qf[ks], a_, 0, 0, 0);
            acc[j] = a_ * iw; });
    asm volatile("s_waitcnt lgkmcnt(0)" ::: "memory");
    { bf16x8 sf[4];
#pragma unroll
      for (int ks = 0; ks < 4; ++ks) sf[ks] = rowfrag(T1, m0, ks, fr, g);
      frag_pipe<8, 4>(
          [&](bf16x8 (&f)[4], int e) __attribute__((always_inline)) {
#pragma unroll
              for (int t = 0; t < 4; ++t) f[t] = colfrag(T3, e >> 1, 4 * (e & 1) + t, fr, g); },
          [&](bf16x8 (&f)[4], int e) __attribute__((always_inline)) {
              if (2 * (e >> 1) <= wave) {
#pragma unroll
                  for (int t = 0; t < 4; ++t) acc[4 * (e & 1) + t] = __builtin_amdgcn_mfma_f32_16x16x32_bf16(f[t], sf[e >> 1], acc[4 * (e & 1) + t], 0, 0, 0); } }); }
    den += iw * qn;
    const float rden = frcp_(fmaxf(fabsf(den), gl[384 + l]));
    float sq = 0.f;
#pragma unroll
    for (int j = 0; j < 8; ++j) { acc[j] = acc[j] * rden; sq += (acc[j][0] * acc[j][0] + acc[j][1] * acc[j][1]) + (acc[j][2] * acc[j][2] + acc[j][3] * acc[j][3]); }
    sq = xsum4(sq);
    const float rn = __builtin_amdgcn_rsqf(sq * (1.0f / 128.0f) + EPSN);
    bf16* yg = (bf16*)(ws + WS_Y) + (t0 + l) * 1024 + 512 + h * 128;
#pragma unroll
    for (int j = 0; j < 8; ++j) { const int e0 = 16 * j + 4 * g;
        const v2u mo = mop[j], cc = cp[j];
        const f32x4 gm = *(const LAS f32x4*)(gl + 896 + e0), sk = *(const LAS f32x4*)(gl + 1024 + e0);
        const float y0 = sigmoidf_(bflo(mo.x)) * (acc[j][0] * rn * gm[0] + sk[0] * bflo(cc.x));
        const float y1 = sigmoidf_(bfhi(mo.x)) * (acc[j][1] * rn * gm[1] + sk[1] * bfhi(cc.x));
        const float y2 = sigmoidf_(bflo(mo.y)) * (acc[j][2] * rn * gm[2] + sk[2] * bflo(cc.y));
        const float y3 = sigmoidf_(bfhi(mo.y)) * (acc[j][3] * rn * gm[3] + sk[3] * bfhi(cc.y));
        *(GAS v2u*)(yg + e0) = (v2u){pk2(y0, y1), pk2(y2, y3)}; }
    { f32x4 accn = (f32x4){0.f, 0.f, 0.f, 0.f};
#pragma unroll
      for (int j = 0; j < 8; ++j) acc[j] = (f32x4){0.f, 0.f, 0.f, 0.f};
      bf16x8 vfa[4];
      { f32x4 w0[4], w1[4]; bf16x8 vr_[4], kw_[4];
#pragma unroll
        for (int ks = 0; ks < 4; ++ks) { w0[ks] = *(const LAS f32x4*)(gl + 640 + 32 * ks + 8 * g); w1[ks] = *(const LAS f32x4*)(gl + 640 + 32 * ks + 8 * g + 4);
            vr_[ks] = colfrag(T3, ks, wave, fr, g); kw_[ks] = colfrag(T0, ks, wave, fr, g); }
#pragma unroll
        for (int ks = 0; ks < 4; ++ks) { const v4u vr = __builtin_bit_cast(v4u, vr_[ks]);
            const v4u vs = (v4u){pk2(bflo(vr.x) * w0[ks][0], bfhi(vr.x) * w0[ks][1]), pk2(bflo(vr.y) * w0[ks][2], bfhi(vr.y) * w0[ks][3]), pk2(bflo(vr.z) * w1[ks][0], bfhi(vr.z) * w1[ks][1]), pk2(bflo(vr.w) * w1[ks][2], bfhi(vr.w) * w1[ks][3])};
            const v4u wv = (v4u){pk2(w0[ks][0], w0[ks][1]), pk2(w0[ks][2], w0[ks][3]), pk2(w1[ks][0], w1[ks][1]), pk2(w1[ks][2], w1[ks][3])};
            vfa[ks] = __builtin_bit_cast(bf16x8, vs);
            accn = __builtin_amdgcn_mfma_f32_16x16x32_bf16(kw_[ks], __builtin_bit_cast(bf16x8, wv), accn, 0, 0, 0); } }
      frag_pipe<8, 4>(
          [&](bf16x8 (&f)[4], int e) __attribute__((always_inline)) {
#pragma unroll
              for (int t = 0; t < 4; ++t) f[t] = colfrag(T0, e >> 1, 4 * (e & 1) + t, fr, g); },
          [&](bf16x8 (&f)[4], int e) __attribute__((always_inline)) {
#pragma unroll
              for (int t = 0; t < 4; ++t) acc[4 * (e & 1) + t] = __builtin_amdgcn_mfma_f32_16x16x32_bf16(f[t], vfa[e >> 1], acc[4 * (e & 1) + t], 0, 0, 0); });
      const float mnew = fmaxf(blast + st.m, mloc), a = fexp_(blast + st.m - mnew), cc = fexp_(mloc - mnew);
#pragma unroll
      for (int j = 0; j < 8; ++j) st.C[j] = st.C[j] * a + acc[j] * cc;
      if (fr == 0) *(LAS f32x4*)(gl + 768 + 16 * wave + 4 * g) = accn;
      asm volatile("s_waitcnt lgkmcnt(0)" ::: "memory"); __builtin_amdgcn_s_barrier(); asm volatile("" ::: "memory");
      st.n0 = st.n0 * a + gl[768 + 2 * lane] * cc; st.n1 = st.n1 * a + gl[768 + 2 * lane + 1] * cc; st.m = mnew; }
}

struct EpiOutProj {
    static constexpr bool PERM = true, AFTER_DRAIN = false; static constexpr int NSTORE = 16;
    const unsigned char* x8; const float* rsx; bf16* x1b; float* ss;
    __device__ __forceinline__ void operator()(const f32x4 (&acc)[2][2][4][2], const pg8::Unit& u, int wr, int wc, int fr, int fq) const {
        int row0 = u.pm * 256 + wr * 64 + fr; asm volatile("" : "+v"(row0));
        const int col0 = u.pn * 256 + wc * 32 + 8 * fq;
        v2u xr[8][2]; float rm[8];
#pragma unroll
        for (int i = 0; i < 8; ++i) { const int row = row0 + (i >> 2) * 128 + (i & 3) * 16; rm[i] = ((const GAS float*)rsx)[row];
#pragma unroll
            for (int bj = 0; bj < 2; ++bj) xr[i][bj] = *(const GAS v2u*)(x8 + (size_t)row * D + col0 + bj * 128); }
#pragma unroll
        for (int ai = 0; ai < 2; ++ai) {
#pragma unroll
            for (int m = 0; m < 4; ++m) { const int row = row0 + ai * 128 + m * 16; float sq = 0.f;
#pragma unroll
                for (int bj = 0; bj < 2; ++bj) { const v2u r = xr[ai * 4 + m][bj]; f32x4 o0 = acc[ai][bj][m][0], o1 = acc[ai][bj][m][1];
#pragma unroll
                    for (int e = 0; e < 4; ++e) { o0[e] += (float)(int)(signed char)((r.x >> (8 * e)) & 255u) * rm[ai * 4 + m]; o1[e] += (float)(int)(signed char)((r.y >> (8 * e)) & 255u) * rm[ai * 4 + m]; }
                    *(GAS v4u*)(x1b + (size_t)row * D + col0 + bj * 128) = pack8(o0, o1);
                    sq += ((o0[0] * o0[0] + o0[1] * o0[1]) + (o0[2] * o0[2] + o0[3] * o0[3])) + ((o1[0] * o1[0] + o1[1] * o1[1]) + (o1[2] * o1[2] + o1[3] * o1[3])); }
                sq = xsum4(sq);
                if (fq == 0) ((GAS float*)ss)[(size_t)row * 16 + u.pn * 4 + wc] = sq; } }
    }
};
struct FixedOrder {
    int pm, n;
    __device__ __forceinline__ bool next(int i, pg8::Unit& u) const { if (i >= n) return false; u.pm = pm; u.pn = i; u.aux = 0; return true; }
    __device__ __forceinline__ void a_ready(const pg8::Unit&) const {}
    __device__ __forceinline__ void done(const pg8::Unit&) const {}
};
struct EpiQx {
    static constexpr bool PERM = true, AFTER_DRAIN = false; static constexpr int NSTORE = 0;
    bf16* qx; const LAS float* rs;
    __device__ __forceinline__ void operator()(const f32x4 (&acc)[2][2][4][2], const pg8::Unit& u, int wr, int wc, int fr, int fq) const {
        const int rl0 = wr * 64 + fr, col0 = wc * 32 + 8 * fq;
#pragma unroll
        for (int ai = 0; ai < 2; ++ai)
#pragma unroll
            for (int m = 0; m < 4; ++m) { const int rl = rl0 + ai * 128 + m * 16; const float sc = rs[rl]; bf16* rowp = qx + (size_t)(u.pm * 256 + rl) * 256 + col0;
#pragma unroll
                for (int bj = 0; bj < 2; ++bj) *(GAS v4u*)(rowp + bj * 128) = pack8(acc[ai][bj][m][0] * sc, acc[ai][bj][m][1] * sc);
                asm volatile("" ::: "memory"); }
    }
};
struct EpiOx {
    static constexpr bool PERM = true, AFTER_DRAIN = false; static constexpr int NSTORE = 32;
    const bf16* x1b; bf16* x2b; unsigned char* x2q;
    __device__ __forceinline__ void operator()(const f32x4 (&acc)[2][2][4][2], const pg8::Unit& u, int wr, int wc, int fr, int fq) const {
        int row0 = u.pm * 256 + wr * 64 + fr; asm volatile("" : "+v"(row0));
        const int col0 = u.pn * 256 + wc * 32 + 8 * fq;
        v4u rr[4][2], ob[4][2]; v2u oq[4][2];
#pragma unroll
        for (int m = 0; m < 4; ++m)
#pragma unroll
            for (int bj = 0; bj < 2; ++bj) rr[m][bj] = *(const GAS v4u*)(x1b + (size_t)(row0 + m * 16) * D + col0 + bj * 128);
#pragma unroll
        for (int m = 0; m < 4; ++m)
#pragma unroll
            for (int bj = 0; bj < 2; ++bj) { const v4u r = rr[m][bj]; f32x4 o0 = acc[0][bj][m][0], o1 = acc[0][bj][m][1];
                o0[0] += bflo(r.x); o0[1] += bfhi(r.x); o0[2] += bflo(r.y); o0[3] += bfhi(r.y); o1[0] += bflo(r.z); o1[1] += bfhi(r.z); o1[2] += bflo(r.w); o1[3] += bfhi(r.w);
                ob[m][bj] = pack8(o0, o1); oq[m][bj] = (v2u){pk4_fp8(o0[0], o0[1], o0[2], o0[3]), pk4_fp8(o1[0], o1[1], o1[2], o1[3])}; }
#pragma unroll
        for (int m = 0; m < 4; ++m)
#pragma unroll
            for (int bj = 0; bj < 2; ++bj) rr[m][bj] = *(const GAS v4u*)(x1b + (size_t)(row0 + 128 + m * 16) * D + col0 + bj * 128);
        asm volatile("" ::: "memory");
#pragma unroll
        for (int m = 0; m < 4; ++m)
#pragma unroll
            for (int bj = 0; bj < 2; ++bj) { *(GAS v4u*)(x2b + (size_t)(row0 + m * 16) * D + col0 + bj * 128) = ob[m][bj]; *(GAS v2u*)(x2q + (size_t)(row0 + m * 16) * D + col0 + bj * 128) = oq[m][bj]; }
#pragma unroll
        for (int m = 0; m < 4; ++m)
#pragma unroll
            for (int bj = 0; bj < 2; ++bj) { const v4u r = rr[m][bj]; f32x4 o0 = acc[1][bj][m][0], o1 = acc[1][bj][m][1];
                o0[0] += bflo(r.x); o0[1] += bfhi(r.x); o0[2] += bflo(r.y); o0[3] += bfhi(r.y); o1[0] += bflo(r.z); o1[1] += bfhi(r.z); o1[2] += bflo(r.w); o1[3] += bfhi(r.w);
                *(GAS v4u*)(x2b + (size_t)(row0 + 128 + m * 16) * D + col0 + bj * 128) = pack8(o0, o1);
                *(GAS v2u*)(x2q + (size_t)(row0 + 128 + m * 16) * D + col0 + bj * 128) = (v2u){pk4_fp8(o0[0], o0[1], o0[2], o0[3]), pk4_fp8(o1[0], o1[1], o1[2], o1[3])}; }
    }
};
__device__ __forceinline__ void cross_dma(const bf16* KV, int h, LAS unsigned char* buf, int lane, int wave) {
#pragma unroll
    for (int i = 0; i < 4; ++i) { const int inst = wave + 8 * i, row = 8 * inst + (lane >> 3);
        const bf16* src = KV + (size_t)row * NKV + h * 64 + ((lane & 7) ^ (lane >> 3)) * 8;
        glds16(src, (unsigned)__builtin_amdgcn_readfirstlane(lds_addr_of(buf + inst * 1024)));
        glds16(src + 256, (unsigned)__builtin_amdgcn_readfirstlane(lds_addr_of(buf + 32768 + inst * 1024))); }
}
__device__ __forceinline__ void cross_unit(const Args& A, unsigned char* lds, int pm, int tid, int lane, int wave) {
    asm volatile("" : "+v"(tid), "+v"(lane));
    unsigned char* ws = A.ws; LAS unsigned char* L = (LAS unsigned char*)lds;
    const size_t t0 = (size_t)pm * 256; const int b = (int)(t0 / SEQ);
    const bf16* KV = (const bf16*)(ws + WS_KVX) + (size_t)b * MEMLEN * NKV;
    const int fr = lane & 15, g = lane >> 4;
    cross_dma(KV, 0, L, lane, wave);
    bf16x8 qc0, qc1;
    { const bf16* qg = (const bf16*)(ws + WS_QX) + (t0 + 32 * wave + fr) * 256; qc0 = *(const GAS bf16x8*)(qg + 8 * g); qc1 = *(const GAS bf16x8*)(qg + 32 + 8 * g); }
    for (int h = 0; h < 4; ++h) {
        asm volatile("s_waitcnt vmcnt(0)" ::: "memory");
        __syncthreads();
        LAS unsigned char* buf = L + (h & 1) * 65536;
        if (h < 3) cross_dma(KV, h + 1, L + ((h + 1) & 1) * 65536, lane, wave);
#pragma unroll 1
        for (int rt = 0; rt < 2; ++rt) {
            const size_t row = t0 + 32 * wave + 16 * rt + fr;
            const bf16x8 q0 = qc0, q1 = qc1;
            { const int h2 = rt ? h + 1 : h, rt2 = rt ^ 1;
              const bf16* qg = (const bf16*)(ws + WS_QX) + (t0 + 32 * wave + 16 * rt2 + fr) * 256 + (h2 < 4 ? h2 : 3) * 64;
              qc0 = *(const GAS bf16x8*)(qg + 8 * g); qc1 = *(const GAS bf16x8*)(qg + 32 + 8 * g); }
            f32x4 s[16];
#pragma unroll
            for (int th = 0; th < 16; th += 8) { bf16x8 kf[8][2];
#pragma unroll
                for (int t = 0; t < 8; ++t) { const int key = 16 * (th + t) + fr;
                    kf[t][0] = *(const LAS bf16x8*)(buf + key * 128 + (((g) ^ (key & 7)) * 16)); kf[t][1] = *(const LAS bf16x8*)(buf + key * 128 + (((4 + g) ^ (key & 7)) * 16)); }
                MSB();
#pragma unroll
                for (int t = 0; t < 8; ++t) { s[th + t] = __builtin_amdgcn_mfma_f32_16x16x32_bf16(kf[t][0], q0, (f32x4){0.f, 0.f, 0.f, 0.f}, 0, 0, 0);
                    s[th + t] = __builtin_amdgcn_mfma_f32_16x16x32_bf16(kf[t][1], q1, s[th + t], 0, 0, 0); } }
            float mx = -1e30f;
#pragma unroll
            for (int t = 0; t < 16; ++t) mx = fmaxf(fmaxf(mx, fmaxf(s[t][0], s[t][1])), fmaxf(s[t][2], s[t][3]));
            mx = xmax4(mx);
            float l = 0.f;
#pragma unroll
            for (int t = 0; t < 16; ++t)
#pragma unroll
                for (int e = 0; e < 4; ++e) { s[t][e] = __builtin_amdgcn_exp2f(s[t][e] - mx); l += s[t][e]; }
            l = xsum4(l);
            f32x4 o[4];
#pragma unroll
            for (int dt = 0; dt < 4; ++dt) o[dt] = (f32x4){0.f, 0.f, 0.f, 0.f};
            frag_pipe<8, 4>(
                [&](bf16x8 (&f)[4], int k8) __attribute__((always_inline)) { const int r0 = 32 * k8 + 4 * g + (fr >> 2), r1 = r0 + 16, p_ = fr & 3;
#pragma unroll
                    for (int dt = 0; dt < 4; ++dt) { const int chunk = 2 * dt + (p_ >> 1);
                        const v4i16_t v0 = __builtin_amdgcn_ds_read_tr16_b64_v4i16((LAS v4i16_t*)(buf + 32768 + r0 * 128 + ((chunk ^ (r0 & 7)) * 16) + 8 * (p_ & 1)));
                        const v4i16_t v1 = __builtin_amdgcn_ds_read_tr16_b64_v4i16((LAS v4i16_t*)(buf + 32768 + r1 * 128 + ((chunk ^ (r1 & 7)) * 16) + 8 * (p_ & 1)));
                        f[dt] = (bf16x8){v0[0], v0[1], v0[2], v0[3], v1[0], v1[1], v1[2], v1[3]}; } },
                [&](bf16x8 (&f)[4], int k8) __attribute__((always_inline)) {
                    const v4u pw = (v4u){pk2(s[2 * k8][0], s[2 * k8][1]), pk2(s[2 * k8][2], s[2 * k8][3]), pk2(s[2 * k8 + 1][0], s[2 * k8 + 1][1]), pk2(s[2 * k8 + 1][2], s[2 * k8 + 1][3])};
                    const bf16x8 pf = __builtin_bit_cast(bf16x8, pw);
#pragma unroll
                    for (int dt = 0; dt < 4; ++dt) o[dt] = __builtin_amdgcn_mfma_f32_16x16x32_bf16(f[dt], pf, o[dt], 0, 0, 0); });
            const float rl = frcp_(l);
            bf16* og = (bf16*)(ws + WS_OX) + row * 256 + h * 64;
#pragma unroll
            for (int dt = 0; dt < 4; ++dt) *(v2u*)(og + 16 * dt + 4 * g) = (v2u){pk2(o[dt][0] * rl, o[dt][1] * rl), pk2(o[dt][2] * rl, o[dt][3] * rl)};
        }
    }
    asm volatile("s_waitcnt vmcnt(0)" ::: "memory");
    __syncthreads();
}

struct TokInfo { int bucket; float wa, wb; int rank; };
constexpr size_t WS_RSTD3 = 18 * MiB;
constexpr size_t WS_CNTTAB = 31 * MiB + 512 * 1024;
__device__ __forceinline__ void p9_route(const Args& A, unsigned char* lds_, int tid, int lane, int wave) {
    asm volatile("" : "+v"(tid), "+v"(lane));
    unsigned char* ws = A.ws; LAS unsigned char* lds = (LAS unsigned char*)lds_;
    const float* b_rg = (const float*)(ws + WS_PAR) + PAR_BRG; const float* b_re = (const float*)(ws + WS_PAR) + PAR_BRE;
    constexpr int WLD = 2064;
    LAS unsigned char* Wh = lds; LAS unsigned char* Wl = lds + 20 * WLD;
    LAS float* lg = (LAS float*)(lds + 2 * 20 * WLD) + wave * (32 * 24);
    LAS int* bkl = (LAS int*)(lds + 2 * 20 * WLD + 8 * 32 * 24 * 4);
    { v4u wst[10];
#pragma unroll
      for (int i = 0; i < 10; ++i) { const int id = tid + NTHR * i, t = id / 2560, row = (id % 2560) >> 7, ch = id & 127;
          wst[i] = *(const GAS v4u*)((const bf16*)(ws + WS_WR) + ((size_t)t * 32 + row) * 1024 + ch * 8); }
#pragma unroll
      for (int i = 0; i < 10; ++i) { const int id = tid + NTHR * i, t = id / 2560, row = (id % 2560) >> 7, ch = id & 127;
          *(LAS v4u*)(lds + (t * 20 + row) * WLD + ch * 16) = wst[i]; } }
    __syncthreads();
    const bf16* X2B = (const bf16*)(ws + WS_HBS);
    const int fr = lane & 15, g = lane >> 4;
    for (int chunk = blockIdx.x; chunk < T / 256; chunk += gridDim.x) {
        const bf16* xa = X2B + ((size_t)chunk * 256 + 32 * wave + fr) * D + 8 * g;
        f32x4 acc[2][2]; float sq[2] = {0.f, 0.f};
#pragma unroll
        for (int rt = 0; rt < 2; ++rt) { acc[rt][0] = (f32x4){0.f, 0.f, 0.f, 0.f}; acc[rt][1] = (f32x4){0.f, 0.f, 0.f, 0.f}; }
        bf16x8 xa0[2][4], xa1[2][4];
#pragma unroll
        for (int j = 0; j < 4; ++j) { xa0[0][j] = *(const GAS bf16x8*)(xa + 32 * j); xa1[0][j] = *(const GAS bf16x8*)(xa + 16 * D + 32 * j); }
#pragma unroll
        for (int ks = 0; ks < 32; ++ks) {
            if ((ks & 3) == 0 && ks + 4 < 32) {
#pragma unroll
                for (int j = 0; j < 4; ++j) { xa0[((ks >> 2) + 1) & 1][j] = *(const GAS bf16x8*)(xa + 32 * (ks + 4 + j)); xa1[((ks >> 2) + 1) & 1][j] = *(const GAS bf16x8*)(xa + 16 * D + 32 * (ks + 4 + j)); }
                __builtin_amdgcn_sched_barrier(0); }
            const bf16x8 a0 = xa0[(ks >> 2) & 1][ks & 3], a1 = xa1[(ks >> 2) & 1][ks & 3];
            { const v4u w0 = __builtin_bit_cast(v4u, a0), w1 = __builtin_bit_cast(v4u, a1);
              sq[0] += (bflo(w0.x) * bflo(w0.x) + bfhi(w0.x) * bfhi(w0.x)) + (bflo(w0.y) * bflo(w0.y) + bfhi(w0.y) * bfhi(w0.y)) + (bflo(w0.z) * bflo(w0.z) + bfhi(w0.z) * bfhi(w0.z)) + (bflo(w0.w) * bflo(w0.w) + bfhi(w0.w) * bfhi(w0.w));
              sq[1] += (bflo(w1.x) * bflo(w1.x) + bfhi(w1.x) * bfhi(w1.x)) + (bflo(w1.y) * bflo(w1.y) + bfhi(w1.y) * bfhi(w1.y)) + (bflo(w1.z) * bflo(w1.z) + bfhi(w1.z) * bfhi(w1.z)) + (bflo(w1.w) * bflo(w1.w) + bfhi(w1.w) * bfhi(w1.w)); }
#pragma unroll
            for (int ct = 0; ct < 2; ++ct) { const int wrow = (16 * ct + fr < 20) ? 16 * ct + fr : fr;
                const bf16x8 bh = *(const LAS bf16x8*)(Wh + wrow * WLD + 64 * ks + 16 * g), bl = *(const LAS bf16x8*)(Wl + wrow * WLD + 64 * ks + 16 * g);
                acc[0][ct] = __builtin_amdgcn_mfma_f32_16x16x32_bf16(bh, a0, acc[0][ct], 0, 0, 0); acc[0][ct] = __builtin_amdgcn_mfma_f32_16x16x32_bf16(bl, a0, acc[0][ct], 0, 0, 0);
                acc[1][ct] = __builtin_amdgcn_mfma_f32_16x16x32_bf16(bh, a1, acc[1][ct], 0, 0, 0); acc[1][ct] = __builtin_amdgcn_mfma_f32_16x16x32_bf16(bl, a1, acc[1][ct], 0, 0, 0); } }
#pragma unroll
        for (int rt = 0; rt < 2; ++rt) { sq[rt] = xsum4(sq[rt]);
            LAS float* lr = lg + (16 * rt + fr) * 24;
            *(LAS f32x4*)(lr + 4 * g) = acc[rt][0];
            if (g == 0) { *(LAS f32x4*)(lr + 16) = acc[rt][1]; lr[20] = 1.0f / sqrtf(sq[rt] * (1.0f / D) + EPSN); } }
        asm volatile("s_waitcnt lgkmcnt(0)" ::: "memory");
        if (lane < 32) { const LAS float* lr = lg + lane * 24; const float rstd = lr[20];
            float gl4[4];
#pragma unroll
            for (int i = 0; i < 4; ++i) gl4[i] = lr[i] * rstd + b_rg[i];
            int gsel = 0; float gm = gl4[0];
#pragma unroll
            for (int i = 1; i < 4; ++i) if (gl4[i] > gm) { gm = gl4[i]; gsel = i; }
            float gs = 0.f;
#pragma unroll
            for (int i = 0; i < 4; ++i) gs += __expf(gl4[i] - gm);
            const float gw_ = 1.0f / gs;
            float el[4];
#pragma unroll
            for (int i = 0; i < 4; ++i) el[i] = lr[4 + 4 * gsel + i] * rstd + b_re[gsel * 4 + i];
            int i0 = 0; float v0 = el[0];
#pragma unroll
            for (int i = 1; i < 4; ++i) if (el[i] > v0) { v0 = el[i]; i0 = i; }
            int i1 = -1; float v1 = -INFINITY;
#pragma unroll
            for (int i = 0; i < 4; ++i) if (i != i0 && el[i] > v1) { v1 = el[i]; i1 = i; }
            const float e1 = __expf(v1 - v0); const float w0 = gw_ / (1.0f + e1), w1 = gw_ * e1 / (1.0f + e1);
            const int pa = i0 < i1 ? i0 : i1, pb = i0 < i1 ? i1 : i0;
            const int pidx = (pa == 0) ? (pb - 1) : (pa == 1 ? pb + 1 : 5);
            const int r = 32 * wave + lane;
            ((float*)(ws + WS_RSTD3))[chunk * 256 + r] = rstd; bkl[r] = gsel * 6 + pidx; ((LAS float*)(bkl + 256))[r] = (i0 < i1) ? w0 : w1; ((LAS float*)(bkl + 512))[r] = (i0 < i1) ? w1 : w0; }
        __syncthreads();
        if (tid < 256) { const int my = bkl[tid]; int rank = 0; for (int j = 0; j < tid; ++j) rank += (bkl[j] == my) ? 1 : 0;
            TokInfo ti; ti.bucket = my; ti.wa = ((LAS float*)(bkl + 256))[tid]; ti.wb = ((LAS float*)(bkl + 512))[tid]; ti.rank = rank;
            ((TokInfo*)(ws + WS_TOKINFO))[chunk * 256 + tid] = ti; }
        else if (tid < 256 + NBUCKET) { const int b = tid - 256; int c = 0; for (int j = 0; j < 256; ++j) c += (bkl[j] == b) ? 1 : 0;
            ((int*)(ws + WS_CNTTAB))[chunk * NBUCKET + b] = c; }
        __syncthreads();
    }
}
__device__ __forceinline__ void p10_slots(const Args& A, unsigned char* lds, int tid, int lane, int wave) {
    unsigned char* ws = A.ws;
    LAS int* tabl = (LAS int*)lds;
    LAS int* totl = (LAS int*)(lds + 32768);
    const int* CNTTAB = (const int*)(ws + WS_CNTTAB);
    { int tv[12];
#pragma unroll
      for (int q = 0; q < 12; ++q) tv[q] = ((const GAS int*)CNTTAB)[tid + NTHR * q];
#pragma unroll
      for (int q = 0; q < 12; ++q) tabl[tid + NTHR * q] = tv[q]; }
    __syncthreads();
    if (tid < NBUCKET) { int t = 0; for (int w = 0; w < 256; ++w) t += tabl[w * NBUCKET + tid]; totl[tid] = t; }
    __syncthreads();
    if (tid == 0) { int acc = 0; for (int b = 0; b < NBUCKET; ++b) { totl[32 + b] = acc; acc += ((totl[b] + 255) >> 8) * 256; } totl[32 + NBUCKET] = acc; }
    if (blockIdx.x == 0 && tid < NBUCKET) ((unsigned*)(ws + WS_CTL))[CW_CNT + tid] = (unsigned)totl[tid];
    __syncthreads();
    int* TOKMAP = (int*)(ws + WS_TOKMAP); float* WSORT = (float*)(ws + WS_WSORT);
    for (int chunk = blockIdx.x; chunk < T / 256; chunk += gridDim.x) {
        if (tid < NBUCKET) { int s = 0; for (int w = 0; w < chunk; ++w) s += tabl[w * NBUCKET + tid]; totl[64 + tid] = totl[32 + tid] + s; }
        __syncthreads();
        if (tid < 256) { const int m = chunk * 256 + tid; const TokInfo ti = ((const TokInfo*)(ws + WS_TOKINFO))[m]; const int slot = totl[64 + ti.bucket] + ti.rank;
            TOKMAP[slot] = m; *(f32x4*)(WSORT + 4 * slot) = (f32x4){ti.wa, ti.wb, ((const float*)(ws + WS_RSTD3))[m], 0.f}; }
        __syncthreads();
    }
    for (int b = blockIdx.x; b < NBUCKET; b += gridDim.x)
        for (int r = totl[32 + b] + totl[b] + tid; r < totl[32 + b + 1]; r += NTHR) { TOKMAP[r] = -1; *(f32x4*)(WSORT + 4 * r) = (f32x4){0.f, 0.f, 0.f, 0.f}; }
}
struct MoeOrder {
    int G, c, nunits, ncol; const LAS int* tab;
    __device__ __forceinline__ bool next(int i, pg8::Unit& u) const {
        const long L = (long)i * G + c; if (L >= nunits) return false;
        const int rt = (int)L / ncol, j = (int)L % ncol, bk = tab[rt];
        u.pm = rt; u.aux = j;
        if (ncol == 8) { const int g = bk / 6, p = bk % 6; const int pa = (p < 3) ? 0 : (p < 5 ? 1 : 2), pb = (p < 3) ? p + 1 : (p < 5 ? p - 1 : 3);
            const int e = 4 * g + ((j >> 2) ? pb : pa); u.pn = e * 4 + (j & 3); }
        else u.pn = bk * 4 + j;
        return true;
    }
    __device__ __forceinline__ void a_ready(const pg8::Unit&) const {}
    __device__ __forceinline__ void done(const pg8::Unit&) const {}
};
struct EpiUp {
    static constexpr bool PERM = true, AFTER_DRAIN = false; static constexpr int NSTORE = 0;
    unsigned char* act; const float* wsort;
    __device__ __forceinline__ void operator()(const f32x4 (&acc)[2][2][4][2], const pg8::Unit& u, int wr, int wc, int fr, int fq) const {
        int row0 = u.pm * 256 + wr * 64 + fr; asm volatile("" : "+v"(row0));
        const int half = u.aux >> 2, col0 = half * 512 + (u.aux & 3) * 128 + wc * 32 + 8 * fq;
        float wv[8], rv[8];
#pragma unroll
        for (int i = 0; i < 8; ++i) { const int row = row0 + (i >> 2) * 128 + (i & 3) * 16; wv[i] = ((const GAS float*)wsort)[4 * row + half]; rv[i] = ((const GAS float*)wsort)[4 * row + 2]; }
#pragma unroll
        for (int ai = 0; ai < 2; ++ai)
#pragma unroll
            for (int m = 0; m < 4; ++m) { const int row = row0 + ai * 128 + m * 16; const float w = wv[ai * 4 + m] * 16.0f, rs = rv[ai * 4 + m] * (1.0f / 64.0f);
                f32x4 r0, r1;
#pragma unroll
                for (int i = 0; i < 4; ++i) { const float a0 = acc[ai][0][m][0][i] * rs, a1 = acc[ai][0][m][1][i] * rs;
                    r0[i] = a0 * sigmoidf_(a0) * (acc[ai][1][m][0][i] * rs) * w; r1[i] = a1 * sigmoidf_(a1) * (acc[ai][1][m][1][i] * rs) * w; }
                *(GAS v2u*)(act + (size_t)row * D + col0) = (v2u){pk4_fp8(r0[0], r0[1], r0[2], r0[3]), pk4_fp8(r1[0], r1[1], r1[2], r1[3])}; }
    }
};
struct EpiDown {
    static constexpr bool PERM = true, AFTER_DRAIN = false; static constexpr int NSTORE = 0;
    const bf16* x2b; float* xo; const int* tokmap;
    __device__ __forceinline__ void operator()(const f32x4 (&acc)[2][2][4][2], const pg8::Unit& u, int wr, int wc, int fr, int fq) const {
        const int row0 = u.pm * 256 + wr * 64 + fr, col0 = u.aux * 256 + wc * 32 + 8 * fq;
#pragma unroll
        for (int ai = 0; ai < 2; ++ai)
#pragma unroll
            for (int m = 0; m < 4; ++m) { const int tok = tokmap[row0 + ai * 128 + m * 16];
                if (tok >= 0) {
#pragma unroll
                    for (int bj = 0; bj < 2; ++bj) { const size_t off = (size_t)tok * D + col0 + bj * 128; const v4u r = *(const v4u*)(x2b + off);
                        f32x4 o0 = acc[ai][bj][m][0], o1 = acc[ai][bj][m][1];
                        o0[0] += bflo(r.x); o0[1] += bfhi(r.x); o0[2] += bflo(r.y); o0[3] += bfhi(r.y); o1[0] += bflo(r.z); o1[1] += bfhi(r.z); o1[2] += bflo(r.w); o1[3] += bfhi(r.w);
                        *(f32x4*)(xo + off) = o0; *(f32x4*)(xo + off + 4) = o1; } } }
    }
};
constexpr size_t WS_XCH = 20 * MiB + 512 * 1024;
constexpr int CW_SEAM = 16384;
constexpr int LDS_EX = 139264;
struct EpiDownNorm {
    static constexpr bool PERM = true, AFTER_DRAIN = false; static constexpr int NSTORE = 0;
    const bf16* x2b; float* out; const int* tokmap; const float* gfin; float* xch; unsigned* cnt; LAS unsigned char* ex; int wv;
    __device__ __forceinline__ void operator()(const f32x4 (&acc_)[2][2][4][2], const pg8::Unit& u, int wr, int wc, int fr, int fq) const {
        f32x4 (&acc)[2][2][4][2] = const_cast<f32x4 (&)[2][2][4][2]>(acc_);
        int tid = wv * 64 + lane_id_(); asm volatile("" : "+v"(tid));
        const int lane = tid & 63, wid = wv;
        int rb = wr * 64 + fr; asm volatile("" : "+v"(rb));
        LAS float* P = (LAS float*)ex; LAS float* S = (LAS float*)(ex + 4096); LAS unsigned* flag = (LAS unsigned*)(ex + 6144);
        const int col0 = u.aux * 256 + wc * 32 + 8 * fq;
        int tok[8];
#pragma unroll
        for (int i = 0; i < 8; ++i) tok[i] = ((const GAS int*)tokmap)[u.pm * 256 + rb + (i >> 2) * 128 + (i & 3) * 16];
#pragma unroll
        for (int ai = 0; ai < 2; ++ai) { v4u rr[4][2];
#pragma unroll
            for (int m = 0; m < 4; ++m) { const int tk = tok[ai * 4 + m] < 0 ? 0 : tok[ai * 4 + m];
#pragma unroll
                for (int bj = 0; bj < 2; ++bj) rr[m][bj] = *(const GAS v4u*)(x2b + (size_t)tk * D + col0 + bj * 128); }
#pragma unroll
            for (int m = 0; m < 4; ++m) { const int rl = rb + ai * 128 + m * 16; const bool ok = tok[ai * 4 + m] >= 0; float sq = 0.f;
#pragma unroll
                for (int bj = 0; bj < 2; ++bj) { f32x4& o0 = acc[ai][bj][m][0]; f32x4& o1 = acc[ai][bj][m][1]; const v4u r = rr[m][bj]; o0 = o0 * (1.0f / 1024.0f); o1 = o1 * (1.0f / 1024.0f);
                    if (ok) { o0[0] += bflo(r.x); o0[1] += bfhi(r.x); o0[2] += bflo(r.y); o0[3] += bfhi(r.y); o1[0] += bflo(r.z); o1[1] += bfhi(r.z); o1[2] += bflo(r.w); o1[3] += bfhi(r.w); }
                    sq += ((o0[0] * o0[0] + o0[1] * o0[1]) + (o0[2] * o0[2] + o0[3] * o0[3])) + ((o1[0] * o1[0] + o1[1] * o1[1]) + (o1[2] * o1[2] + o1[3] * o1[3])); }
                sq = xsum4(sq);
                if (fq == 0) P[rl * 4 + wc] = sq; }
            asm volatile("" ::: "memory"); }
        asm volatile("s_waitcnt lgkmcnt(0)" ::: "memory"); __builtin_amdgcn_s_barrier(); asm volatile("" ::: "memory");
        if (tid < 256) { const f32x4 p = *(const LAS f32x4*)(P + tid * 4);
            __hip_atomic_store(xch + ((size_t)u.pm * 256 + tid) * 4 + u.aux, (p[0] + p[1]) + (p[2] + p[3]), __ATOMIC_RELAXED, __HIP_MEMORY_SCOPE_AGENT); }
        asm volatile("s_waitcnt vmcnt(0)" ::: "memory");
        if (wid < 4 && lane == 0) __hip_atomic_fetch_add(cnt + 64 * u.pm, 1u, __ATOMIC_RELAXED, __HIP_MEMORY_SCOPE_AGENT);
        if (wid == 0) { unsigned spins = 0;
            while ((unsigned)__builtin_amdgcn_readfirstlane(__hip_atomic_load(cnt + 64 * u.pm, __ATOMIC_RELAXED, __HIP_MEMORY_SCOPE_AGENT)) < 16u) { __builtin_amdgcn_s_sleep(2); if (++spins > (1u << 22)) break; }
            if (lane == 0) flag[0] = spins; }
        asm volatile("s_waitcnt vmcnt(0) lgkmcnt(0)" ::: "memory"); __builtin_amdgcn_s_barrier(); asm volatile("" ::: "memory");
        if (tid < 256) { const float* sl = xch + ((size_t)u.pm * 256 + tid) * 4; float t = 0.f;
#pragma unroll
            for (int k = 0; k < 4; ++k) t += __hip_atomic_load(sl + k, __ATOMIC_RELAXED, __HIP_MEMORY_SCOPE_AGENT);
            S[tid] = 1.0f / sqrtf(t * (1.0f / D) + EPSN); }
        asm volatile("s_waitcnt lgkmcnt(0)" ::: "memory"); __builtin_amdgcn_s_barrier(); asm volatile("" ::: "memory");
        f32x4 gf[2][2];
#pragma unroll
        for (int bj = 0; bj < 2; ++bj)
#pragma unroll
            for (int n = 0; n < 2; ++n) gf[bj][n] = *(const GAS f32x4*)(gfin + col0 + bj * 128 + 4 * n);
        asm volatile("" ::: "memory");
#pragma unroll
        for (int ai = 0; ai < 2; ++ai)
#pragma unroll
            for (int m = 0; m < 4; ++m) { const int rl = rb + ai * 128 + m * 16; const int tk = tok[ai * 4 + m]; const float rs = S[rl];
                if (tk >= 0) {
#pragma unroll
                    for (int bj = 0; bj < 2; ++bj)
#pragma unroll
                        for (int n = 0; n < 2; ++n) { const int cc = col0 + bj * 128 + 4 * n; acc[ai][bj][m][n] = acc[ai][bj][m][n] * rs; acc[ai][bj][m][n] = acc[ai][bj][m][n] * gf[bj][n];
                            *(GAS f32x4*)(out + (size_t)tk * D + cc) = acc[ai][bj][m][n];
#ifdef PROBE_ST2
                            asm volatile("" ::: "memory"); *(volatile f32x4*)(out + (size_t)tk * D + cc) = acc[ai][bj][m][n];
#endif
                            } } }
    }
};
__device__ __forceinline__ void p10_final(const Args& A, float* outp, int lane, int wave) {
    const float* g_final = (const float*)(A.ws + WS_PAR) + PAR_GFIN;
    const int G = gridDim.x, gw = blockIdx.x * NWAVES + wave, NGW = G * NWAVES;
    f32x4 gv[4];
#pragma unroll
    for (int j = 0; j < 4; ++j) gv[j] = *((const f32x4*)g_final + lane + 64 * j);
    for (int m = gw; m < T; m += NGW) {
        f32x4* xr = (f32x4*)(A.out + (size_t)m * D) + lane;
        f32x4 v[4]; float s = 0.f;
#pragma unroll
        for (int j = 0; j < 4; ++j) { v[j] = xr[64 * j]; s += (v[j].x * v[j].x + v[j].y * v[j].y) + (v[j].z * v[j].z + v[j].w * v[j].w); }
        const float rstd = 1.0f / sqrtf(wave_sum(s) * (1.0f / D) + EPSN);
#pragma unroll
        for (int j = 0; j < 4; ++j) ((f32x4*)(outp + (size_t)m * D) + lane)[64 * j] = v[j] * rstd * gv[j];
    }
}

#ifndef MS
#define MS 4
#endif
#ifndef N_LAUNCHES
#define N_LAUNCHES 1
#endif
constexpr int N_PHASES = 14;
#ifndef STAGGER
#define STAGGER 0
#endif
#ifndef STAGGER12
#define STAGGER12 0
#endif
#ifndef FUSE_FINAL
#define FUSE_FINAL 1
#endif
#ifndef DUP_MASK
#define DUP_MASK 0
#endif
#define REP(k) for (int rep_ = 0; rep_ < (((DUP_MASK >> (k)) & 1) ? 2 : 1); ++rep_)
#ifndef QX_SP2
#define QX_SP2 false
#endif

#ifndef NVG
#define NVG 256
#endif
__global__ void __launch_bounds__(NTHR, 2) __attribute__((amdgpu_num_vgpr(NVG))) fwd_kernel(Args args) {
    __shared__ __attribute__((aligned(16))) unsigned char lds[LDS_BYTES];
    const int wave = __builtin_amdgcn_readfirstlane((int)threadIdx.x >> 6), lane = lane_id_(), tid = wave * 64 + lane;
    gu32* ctl = (gu32*)(args.ws + WS_CTL);
    for (int u = tid; u < (LDS_BYTES - LDS_MISC) / 4; u += NTHR) ((unsigned*)(lds + LDS_MISC))[u] = 0u;
    __syncthreads();
    const int lo = args.ph_lo, hi = args.ph_hi;
    const bool use_bar = (hi - lo) > 1;
    XcdBarrier bar; bar.bar = (unsigned*)ctl + CW_BAR; bar.x = 0; bar.st = (volatile LAS unsigned*)(lds + LDS_MISC) + 8; bar.wv = wave;
    if (use_bar) bar = xcd_barrier_post((unsigned*)ctl + CW_BAR, (volatile LAS unsigned*)(lds + LDS_MISC) + 8, wave);
#ifndef PH_MASK
#define PH_MASK 0xFFFF
#endif
#define IN(k) (((PH_MASK >> (k)) & 1) && lo <= (k) && (k) < hi)
#define SEAM(k) do { if (IN(k) && IN((k) + 1)) xcd_barrier(bar); } while (0)
    PG8_LAS unsigned char* ring = (PG8_LAS unsigned char*)lds;
    const int G = gridDim.x;
#define PHASE_PTRS Args pa = args; { unsigned char* w_ = args.ws; float* o_ = args.out; asm volatile("" : "+s"(w_), "+s"(o_)); pa.ws = w_; pa.out = o_; } unsigned char* const ws = pa.ws; (void)ws; int tid = wave * 64 + lane_id_(); asm volatile("" : "+v"(tid)); const int lane = tid & 63; (void)lane

#ifdef DUMMY_LIVE
    float dl0, dl1, dl2, dl3, dl4, dl5, dl6, dl7; asm volatile("" : "=v"(dl0), "=v"(dl1), "=v"(dl2), "=v"(dl3), "=v"(dl4), "=v"(dl5), "=v"(dl6), "=v"(dl7));
#endif
    if (IN(0)) { PHASE_PTRS; REP(0) { p0_prologue(pa, lds, tid, lane, wave); __syncthreads(); } }
    SEAM(0);
    if (IN(1) && MS >= 1) { PHASE_PTRS;
        pg8::Gemm g{(const pg8::bf16_t*)(ws + WS_X8), (const pg8::bf16_t*)(ws + WS_WIN8), T, NIN, D};
        pg8::StaticOrder S; S.init(T, NIN, G, (int)blockIdx.x);
        EpiInProj E{(bf16*)(ws + WS_Q), (const unsigned*)(ws + WS_ROPE), (const float*)(ws + WS_RS8), (const unsigned*)(ws + WS_CTL) + CW_CMAX};
        REP(1) pg8::gemm_phase<EpiInProj, pg8::StaticOrder, true, true, false, 2>(ring, g, S, E, wave);
    }
    SEAM(1);
    if (IN(2) && MS >= 1) { PHASE_PTRS;
        const int n_att = (MS >= 2) ? 3 * 4096 : 0;
        for (int tile = blockIdx.x; tile < 256; tile += G) kv_tile(pa, lds, tile, tid, lane, wave);
        __syncthreads();
        REP(14) attn_phase(pa, lds, n_att, lane, wave);
        REP(2) { int wres = -1; MGroup mg; __syncthreads(); for (int it = blockIdx.x * 8; it < 2048; it += G * 8) { P1Pre pre; p1_prefetch(pre, pa, it, tid, lane); for (int q = 0; q < 8; ++q) mlstm_p1_item(pa, lds, it + q, wres, mg, tid, lane, wave, pre, q < 7); } }
    }
    if (IN(2) && IN(4)) xcd_barrier(bar);
    if (IN(4) && MS >= 1) { PHASE_PTRS;
        REP(4) {
        for (int it = blockIdx.x * 8, rt = blockIdx.x; it < 2048; it += G * 8, rt += G) { MState st; mlstm2_entry(pa, it >> 6, (it & 63) >> 3, st, lane, wave);
            const MState st0 = st; REP(6) { st = st0; for (int q = 0; q < 8; ++q) mlstm_p2_item(pa, lds, it + q, st, tid, lane, wave, rt < T / 256, (size_t)rt * 256 + 32 * q); } }
        }
    }
    SEAM(4);
    if (IN(5) && MS >= 1) { PHASE_PTRS;
        const int pm = (int)blockIdx.x;
        if (pm < T / 256) {
            { pg8::Gemm g{(const pg8::bf16_t*)(ws + WS_Y), (const pg8::bf16_t*)(ws + WS_WOUT), T, D, D};
              FixedOrder S{pm, 4}; EpiOutProj E{(const unsigned char*)(ws + WS_X8), (const float*)(ws + WS_RSX), (bf16*)(ws + WS_X1B), (float*)(ws + WS_SS1)};
              pg8::gemm_phase<EpiOutProj, FixedOrder, true, true>(ring, g, S, E, wave); }
            VM_WAIT(); __syncthreads();
            float* rs = (float*)(lds + LDS_RS);
            const int tq = wave * 64 + lane_id_();
            if (tq < 256) { const int tid = tq; const f32x4* sp = (const f32x4*)((const float*)(ws + WS_SS1) + (size_t)(pm * 256 + tid) * 16);
                const f32x4 a = sp[0], b = sp[1], c = sp[2], d = sp[3];
                const float s = ((a[0] + a[1]) + (a[2] + a[3])) + ((b[0] + b[1]) + (b[2] + b[3])) + ((c[0] + c[1]) + (c[2] + c[3])) + ((d[0] + d[1]) + (d[2] + d[3]));
                rs[tid] = 1.0f / sqrtf(s * (1.0f / D) + EPSN); }
            __syncthreads();
            { pg8::Gemm g{(const pg8::bf16_t*)(ws + WS_X1B), (const pg8::bf16_t*)(ws + WS_WQX), T, 256, D};
              FixedOrder S{pm, 1}; EpiQx E{(bf16*)(ws + WS_QX), (const LAS float*)rs};
              pg8::gemm_phase<EpiQx, FixedOrder, true, QX_SP2>(ring, g, S, E, wave); }
            VM_WAIT(); __syncthreads();
            { const int ln_ = lane_id_(); cross_unit(pa, lds, pm, wave * 64 + ln_, ln_, wave); }
            { int kdyn = 256; asm volatile("" : "+s"(kdyn));
              pg8::Gemm g{(const pg8::bf16_t*)(ws + WS_OX), (const pg8::bf16_t*)(ws + WS_WOX), T, D, kdyn};
              FixedOrder S{pm, 4}; EpiOx E{(const bf16*)(ws + WS_X1B), (bf16*)(ws + WS_HBS), (unsigned char*)(ws + WS_X2Q)};
              pg8::gemm_phase<EpiOx, FixedOrder, true, true>(ring, g, S, E, wave); }
            VM_WAIT(); __builtin_amdgcn_fence(__ATOMIC_ACQUIRE, "agent"); VM_WAIT(); __syncthreads();
        }
        if (MS >= 4) { const int ln_ = lane_id_(); p9_route(pa, lds, wave * 64 + ln_, ln_, wave); }
    }
    SEAM(9);
    if (IN(10) && MS >= 4) { PHASE_PTRS; p10_slots(pa, lds, tid, lane, wave); }
    SEAM(10);
    if ((IN(11) || IN(12)) && MS >= 4) { PHASE_PTRS;
        LAS int* tab = (LAS int*)(lds + LDS_TAB);
        if (tid < 32) { const unsigned* cnt = (const unsigned*)(ws + WS_CTL) + CW_CNT;
            const int ntl = (tid < NBUCKET) ? (int)((__hip_atomic_load(cnt + tid, __ATOMIC_RELAXED, __HIP_MEMORY_SCOPE_AGENT) + 255u) >> 8) : 0;
            int pre = ntl;
#pragma unroll
            for (int d = 1; d < 32; d <<= 1) { const int t = __shfl_up(pre, d); if ((tid & 63) >= d) pre += t; }
            const int start = pre - ntl;
            for (int k = 0; k < ntl; ++k) tab[1 + start + k] = tid;
            if (tid == NBUCKET - 1) tab[0] = pre; }
        __syncthreads();
        const int nrt = tab[0];
        if (IN(11)) {
            if (STAGGER && ((blockIdx.x >> 2) & 1)) { for (int i = 0; i < STAGGER; ++i) __builtin_amdgcn_s_sleep(127); }
            pg8::Gemm g{(const pg8::bf16_t*)(ws + WS_X2Q), (const pg8::bf16_t*)(ws + WS_W13Q), ROWS_MAX, 64 * 256, D, (const int*)(ws + WS_TOKMAP)};
            MoeOrder S{G, (int)blockIdx.x, nrt * 8, 8, tab + 1};
            EpiUp E{(unsigned char*)(ws + WS_ACT), (const float*)(ws + WS_WSORT)};
            REP(11) pg8::gemm_phase<EpiUp, MoeOrder, true, true, true, 1>(ring, g, S, E, wave);
        }
        SEAM(11);
        if (IN(12)) {
            if (STAGGER12 && (int)blockIdx.x >= ((nrt * 4) % G) && ((blockIdx.x >> 2) & 1)) { for (int i = 0; i < STAGGER12; ++i) __builtin_amdgcn_s_sleep(127); }
            pg8::Gemm g{(const pg8::bf16_t*)(ws + WS_ACT), (const pg8::bf16_t*)(ws + WS_W2P), ROWS_MAX, 96 * 256, D};
            MoeOrder S{G, (int)blockIdx.x, nrt * 4, 4, tab + 1};
#if FUSE_FINAL
            EpiDownNorm E{(const bf16*)(ws + WS_HBS), pa.out, (const int*)(ws + WS_TOKMAP), (const float*)(ws + WS_PAR) + PAR_GFIN, (float*)(ws + WS_XCH), (unsigned*)(ws + WS_CTL) + CW_SEAM, (LAS unsigned char*)(lds + LDS_EX), wave};
            pg8::gemm_phase<EpiDownNorm, MoeOrder, true, true, false, 1>(ring, g, S, E, wave);
#else
            EpiDown E{(const bf16*)(ws + WS_HBS), pa.out, (const int*)(ws + WS_TOKMAP)};
            REP(12) pg8::gemm_phase<EpiDown, MoeOrder, true, true>(ring, g, S, E, wave);
#endif
        }
    }
    if (!FUSE_FINAL) SEAM(12);
    if (IN(13) && !FUSE_FINAL) { PHASE_PTRS; REP(13) p10_final(pa, (((DUP_MASK >> 13) & 1) && rep_ == 0) ? (float*)(ws + 544 * MiB) : pa.out, lane, wave); }
#ifdef DUMMY_LIVE
    asm volatile("" :: "v"(dl0), "v"(dl1), "v"(dl2), "v"(dl3), "v"(dl4), "v"(dl5), "v"(dl6), "v"(dl7));
#endif
#undef IN
#undef SEAM
}

extern "C" void kernel_launch(void* const* d_in, const int* in_sizes, int n_in, void* d_out, int out_size, void* d_ws, size_t ws_size, hipStream_t stream) {
    static int grid = 0;
    if (grid == 0) {
        if (n_in != 28 || out_size != T * D || ws_size < WS_END) { fprintf(stderr, "kernel_launch: unexpected problem (n_in %d, out %d, ws %zu)\n", n_in, out_size, ws_size); grid = -1; return; }
        int dev = 0, cus = 0, per_cu = 0;
        if (hipGetDevice(&dev) != hipSuccess || hipDeviceGetAttribute(&cus, hipDeviceAttributeMultiprocessorCount, dev) != hipSuccess) { grid = -1; return; }
        if (hipOccupancyMaxActiveBlocksPerMultiprocessor(&per_cu, (const void*)fwd_kernel, NTHR, 0) != hipSuccess || per_cu < 1) { fprintf(stderr, "kernel_launch: occupancy query failed (%d)\n", per_cu); per_cu = 1; }
        (void)hipGetLastError();
        grid = cus * (per_cu > 1 ? 1 : per_cu);
        if (grid > 256) grid = 256;
    }
    if (grid < 0) return;
    (void)hipMemsetAsync((char*)d_ws + WS_CTL, 0, CTL_ZERO_BYTES, stream);
    Args a{};
    for (int i = 0; i < 28; ++i) a.in[i] = d_in[i];
    a.out = (float*)d_out; a.ws = (unsigned char*)d_ws;
    if (N_LAUNCHES == 1) {
        a.ph_lo = 0; a.ph_hi = N_PHASES;
        void* kargs[] = {&a};
        hipError_t e = hipLaunchCooperativeKernel((const void*)fwd_kernel, dim3(grid), dim3(NTHR), kargs, 0, stream);
        if (e != hipSuccess) fprintf(stderr, "kernel_launch: cooperative launch failed: %s (grid %d)\n", hipGetErrorString(e), grid);
    } else {
        for (int p = 0; p < N_PHASES; ++p) { a.ph_lo = p; a.ph_hi = p + 1; hipLaunchKernelGGL(fwd_kernel, dim3(grid), dim3(NTHR), 0, stream, a); }
    }
}
```
